# Optimizing an MI355X kernel written in HIP

```python
import jax, jax.numpy as jnp
from jax import lax
import numpy as np

D_MODEL = 4096
BATCH = 1
SEQ = 8192
DEPTH = 1

NORM_EPS = 1e-6
RWKV_HEAD_DIM = 64
RWKV_WIDTH = D_MODEL // 2
RWKV_HEADS = RWKV_WIDTH // RWKV_HEAD_DIM
DECAY_LORA = 128
AAA_LORA = 128
GATE_LORA = 480
LN_X_EPS = 64e-5
MOBA_HEAD_DIM = 128
MOBA_WIDTH = D_MODEL // 2
MOBA_HEADS = MOBA_WIDTH // MOBA_HEAD_DIM
MOBA_BLOCK = 256
MOBA_TOPK = 3
MOBA_Q_CHUNK = 64
ROPE_THETA = 10000.0
PEER_HEADS = 8
PEER_N_KEYS = 128
PEER_N_EXPERTS = PEER_N_KEYS * PEER_N_KEYS
PEER_QUERY_DIM = 256
PEER_HALF = PEER_QUERY_DIM // 2
PEER_TOPK = 16
PEER_TOK_CHUNK = 128

RWKV_SHIFT_WIDTH = 3 * RWKV_WIDTH + DECAY_LORA + AAA_LORA + GATE_LORA
IN_WIDTH = RWKV_SHIFT_WIDTH + 3 * MOBA_WIDTH + 2 * D_MODEL
RWKV_SPLIT_IDX = (RWKV_WIDTH, 2 * RWKV_WIDTH, 3 * RWKV_WIDTH, 3 * RWKV_WIDTH + DECAY_LORA, 3 * RWKV_WIDTH + DECAY_LORA + AAA_LORA)
MOBA_SPLIT_IDX = (MOBA_WIDTH, 2 * MOBA_WIDTH, 3 * MOBA_WIDTH, 3 * MOBA_WIDTH + D_MODEL)

kernel_name = 'hybrid_rwkv7_moba_peer_block'


def _rms_norm(x, g):
    xf = x.astype(jnp.float32)
    y = xf * lax.rsqrt(jnp.mean(xf * xf, axis=-1, keepdims=True) + NORM_EPS)
    return (y * g.astype(jnp.float32)).astype(x.dtype)


def _token_shift(z, mu):
    z_prev = jnp.pad(z, ((0, 0), (1, 0), (0, 0)))[:, :-1]
    return z + (z_prev - z) * mu


def _rope(x, positions):
    half = x.shape[-1] // 2
    inv_freq = ROPE_THETA ** (-jnp.arange(half, dtype=jnp.float32) / half)
    ang = positions.astype(jnp.float32)[:, None] * inv_freq[None, :]
    cos = jnp.cos(ang)[None, :, None, :]
    sin = jnp.sin(ang)[None, :, None, :]
    xf = x.astype(jnp.float32)
    x1, x2 = xf[..., :half], xf[..., half:]
    return jnp.concatenate([x1 * cos - x2 * sin, x2 * cos + x1 * sin], axis=-1).astype(x.dtype)


def _rwkv7_time_mix(z, w0, w_up, a0, a_up, g_up, k_k, k_a, r_k, lnx_g, lnx_b):
    B, S, _ = z.shape
    f32 = jnp.float32
    r, k, v, wl, al, gl = jnp.split(z, RWKV_SPLIT_IDX, axis=-1)
    w = -jax.nn.softplus(-(w0 + jnp.tanh(wl) @ w_up)) - 0.5
    decay = jnp.exp(-jnp.exp(w.astype(f32)))
    a = jax.nn.sigmoid(a0 + al @ a_up)
    g = jax.nn.sigmoid(gl) @ g_up
    kk = k * k_k
    k = k * (1.0 + (a - 1.0) * k_a)

    def heads(t):
        return t.astype(f32).reshape(B, S, RWKV_HEADS, RWKV_HEAD_DIM)

    r_h, k_h, v_h, w_h, a_h, kk_h = (heads(t) for t in (r, k, v, decay, a, kk))
    kk_h = kk_h / jnp.maximum(jnp.sqrt(jnp.sum(kk_h * kk_h, axis=-1, keepdims=True)), 1e-12)

    def step(state, inp):
        r_t, w_t, k_t, v_t, kk_t, a_t = inp
        sa = jnp.einsum('bhvk,bhk->bhv', state, -kk_t)
        state = (state * w_t[:, :, None, :]
                 + sa[..., None] * (kk_t * a_t)[:, :, None, :]
                 + v_t[..., None] * k_t[:, :, None, :])
        return state, jnp.einsum('bhvk,bhk->bhv', state, r_t)

    xs = tuple(t.swapaxes(0, 1) for t in (r_h, w_h, k_h, v_h, kk_h, a_h))
    state0 = jnp.zeros((B, RWKV_HEADS, RWKV_HEAD_DIM, RWKV_HEAD_DIM), f32)
    _, y = lax.scan(step, state0, xs)
    y = y.swapaxes(0, 1)
    mu = jnp.mean(y, axis=-1, keepdims=True)
    var = jnp.mean(jnp.square(y - mu), axis=-1, keepdims=True)
    y = ((y - mu) * lax.rsqrt(var + LN_X_EPS)).reshape(B, S, RWKV_WIDTH)
    y = y * lnx_g.astype(f32) + lnx_b.astype(f32)
    bonus = (jnp.sum(r_h * k_h * r_k.astype(f32), axis=-1, keepdims=True) * v_h).reshape(B, S, RWKV_WIDTH)
    return ((y + bonus) * g.astype(f32)).astype(z.dtype)


def _moba_attention(q, k, v):
    B, S, H, Dh = q.shape
    nb = -(-S // MOBA_BLOCK)
    pad = nb * MOBA_BLOCK - S
    kp = jnp.pad(k, ((0, 0), (0, pad), (0, 0), (0, 0)))
    vp = jnp.pad(v, ((0, 0), (0, pad), (0, 0), (0, 0)))
    k_blocks = kp.reshape(B, nb, MOBA_BLOCK, H, Dh)
    k_mean = jnp.mean(k_blocks, axis=2)
    kb = k_blocks.transpose(0, 3, 1, 2, 4)
    vb = vp.reshape(B, nb, MOBA_BLOCK, H, Dh).transpose(0, 3, 1, 2, 4)
    n_sel = max(1, min(MOBA_TOPK, nb - 1))
    scale = Dh ** -0.5
    b_idx = jnp.arange(B)[:, None, None, None]
    h_idx = jnp.arange(H)[None, :, None, None]
    n_chunks = S // MOBA_Q_CHUNK
    qc = q.reshape(B, n_chunks, MOBA_Q_CHUNK, H, Dh).swapaxes(0, 1)

    def one_chunk(args):
        c, q_c = args
        start = c * MOBA_Q_CHUNK
        blk = start // MOBA_BLOCK
        q_pos = start + jnp.arange(MOBA_Q_CHUNK)
        gate = jnp.einsum('bqhd,bnhd->bhqn', q_c, k_mean).astype(jnp.float32)
        gate = jnp.where(jnp.arange(nb) < blk, gate, -jnp.inf)
        _, sel = lax.top_k(gate, n_sel)
        valid = jnp.arange(n_sel) < blk
        k_sel = kb[b_idx, h_idx, sel]
        v_sel = vb[b_idx, h_idx, sel]
        s_sel = jnp.einsum('bqhd,bhqjkd->bhqjk', q_c, k_sel).astype(jnp.float32) * scale
        s_sel = jnp.where(valid[:, None], s_sel, -jnp.inf)
        k_own = lax.dynamic_slice_in_dim(kp, blk * MOBA_BLOCK, MOBA_BLOCK, axis=1)
        v_own = lax.dynamic_slice_in_dim(vp, blk * MOBA_BLOCK, MOBA_BLOCK, axis=1)
        s_own = jnp.einsum('bqhd,bkhd->bhqk', q_c, k_own).astype(jnp.float32) * scale
        k_pos = blk * MOBA_BLOCK + jnp.arange(MOBA_BLOCK)
        s_own = jnp.where(k_pos[None, :] <= q_pos[:, None], s_own, -jnp.inf)
        scores = jnp.concatenate([s_own, s_sel.reshape(B, H, MOBA_Q_CHUNK, n_sel * MOBA_BLOCK)], axis=-1)
        p = jax.nn.softmax(scores, axis=-1).astype(v.dtype)
        p_own = p[..., :MOBA_BLOCK]
        p_sel = p[..., MOBA_BLOCK:].reshape(B, H, MOBA_Q_CHUNK, n_sel, MOBA_BLOCK)
        return (jnp.einsum('bhqk,bkhd->bqhd', p_own, v_own)
                + jnp.einsum('bhqjk,bhqjkd->bqhd', p_sel, v_sel))

    out = lax.map(one_chunk, (jnp.arange(n_chunks), qc))
    return out.swapaxes(0, 1).reshape(B, S, H * Dh)


def _peer(h, w_q, sub_keys, expert_u, expert_v):
    B, S, D = h.shape
    q = (h @ w_q).reshape(B, S, PEER_HEADS, 2, PEER_HALF)
    s = jnp.einsum('bshpd,hpnd->bshpn', q, sub_keys).astype(jnp.float32)
    s_top, i_top = lax.top_k(s, PEER_TOPK)
    n_cand = PEER_TOPK * PEER_TOPK
    cand_s = (s_top[..., 0, :, None] + s_top[..., 1, None, :]).reshape(B, S, PEER_HEADS, n_cand)
    cand_i = (i_top[..., 0, :, None] * PEER_N_KEYS + i_top[..., 1, None, :]).reshape(B, S, PEER_HEADS, n_cand)
    f_s, f_pos = lax.top_k(cand_s, PEER_TOPK)
    idx = jnp.take_along_axis(cand_i, f_pos, axis=-1)
    g = jax.nn.softmax(f_s, axis=-1)
    n_e = PEER_HEADS * PEER_TOPK
    n_chunks = (B * S) // PEER_TOK_CHUNK
    hc = h.reshape(n_chunks, PEER_TOK_CHUNK, D)
    ic = idx.reshape(n_chunks, PEER_TOK_CHUNK, n_e)
    gc = g.astype(h.dtype).reshape(n_chunks, PEER_TOK_CHUNK, n_e)

    def one_chunk(args):
        h_c, i_c, g_c = args
        u = expert_u[i_c]
        v = expert_v[i_c]
        act = jax.nn.gelu(jnp.einsum('td,ted->te', h_c, u), approximate=False)
        return jnp.einsum('te,ted->td', g_c * act, v)

    out = lax.map(one_chunk, (hc, ic, gc))
    return out.reshape(B, S, D)


def setup_inputs(seed: int = 0) -> dict:
    key = jax.random.key(seed)
    ks = jax.random.split(key, 23)
    f32 = jnp.float32
    L = DEPTH

    def nrm(k, shape, scale):
        return jax.random.normal(k, shape, f32) * scale

    def gain(k, shape):
        return 1.0 + 0.02 * jax.random.normal(k, shape, f32)

    return {
        'x': nrm(ks[0], (BATCH, SEQ, D_MODEL), 1.0),
        'norm1_g': gain(ks[1], (L, D_MODEL)),
        'w_in': nrm(ks[2], (L, D_MODEL, IN_WIDTH), D_MODEL ** -0.5),
        'rwkv_mu': jax.random.uniform(ks[3], (L, RWKV_SHIFT_WIDTH), f32),
        'rwkv_w0': jax.random.uniform(ks[4], (L, RWKV_WIDTH), f32, -6.0, -1.0),
        'rwkv_w_up': nrm(ks[5], (L, DECAY_LORA, RWKV_WIDTH), 0.5 * DECAY_LORA ** -0.5),
        'rwkv_a0': nrm(ks[6], (L, RWKV_WIDTH), 0.1),
        'rwkv_a_up': nrm(ks[7], (L, AAA_LORA, RWKV_WIDTH), AAA_LORA ** -0.5),
        'rwkv_g_up': nrm(ks[8], (L, GATE_LORA, RWKV_WIDTH), GATE_LORA ** -0.5),
        'rwkv_k_k': 0.85 + 0.02 * jax.random.normal(ks[9], (L, RWKV_WIDTH), f32),
        'rwkv_k_a': gain(ks[10], (L, RWKV_WIDTH)),
        'rwkv_r_k': nrm(ks[11], (L, RWKV_HEADS, RWKV_HEAD_DIM), 0.1),
        'rwkv_lnx_g': gain(ks[12], (L, RWKV_WIDTH)),
        'rwkv_lnx_b': nrm(ks[13], (L, RWKV_WIDTH), 0.01),
        'w_branch_rwkv': nrm(ks[14], (L, RWKV_WIDTH, D_MODEL), RWKV_WIDTH ** -0.5),
        'w_branch_moba': nrm(ks[15], (L, MOBA_WIDTH, D_MODEL), MOBA_WIDTH ** -0.5),
        'w_out': nrm(ks[16], (L, D_MODEL, D_MODEL), D_MODEL ** -0.5),
        'norm2_g': gain(ks[17], (L, D_MODEL)),
        'peer_w_q': nrm(ks[18], (L, D_MODEL, PEER_HEADS * PEER_QUERY_DIM), D_MODEL ** -0.5),
        'peer_sub_keys': nrm(ks[19], (L, PEER_HEADS, 2, PEER_N_KEYS, PEER_HALF), PEER_HALF ** -0.5),
        'peer_u': nrm(ks[20], (L, PEER_N_EXPERTS, D_MODEL), D_MODEL ** -0.5),
        'peer_v': nrm(ks[21], (L, PEER_N_EXPERTS, D_MODEL), PEER_TOPK ** -0.5),
        'final_g': gain(ks[22], (D_MODEL,)),
    }


def reference(x, norm1_g, w_in, rwkv_mu, rwkv_w0, rwkv_w_up, rwkv_a0, rwkv_a_up, rwkv_g_up,
              rwkv_k_k, rwkv_k_a, rwkv_r_k, rwkv_lnx_g, rwkv_lnx_b, w_branch_rwkv, w_branch_moba,
              w_out, norm2_g, peer_w_q, peer_sub_keys, peer_u, peer_v, final_g):
    B, S, _ = x.shape
    positions = jnp.arange(S, dtype=jnp.int32)
    for l in range(DEPTH):
        h = _rms_norm(x, norm1_g[l])
        proj = h @ w_in[l]
        rwkv_in = _token_shift(proj[..., :RWKV_SHIFT_WIDTH], rwkv_mu[l])
        q_m, k_m, v_m, gate_a, gate_b = jnp.split(proj[..., RWKV_SHIFT_WIDTH:], MOBA_SPLIT_IDX, axis=-1)
        y_a = _rwkv7_time_mix(rwkv_in, rwkv_w0[l], rwkv_w_up[l], rwkv_a0[l], rwkv_a_up[l], rwkv_g_up[l],
                              rwkv_k_k[l], rwkv_k_a[l], rwkv_r_k[l], rwkv_lnx_g[l], rwkv_lnx_b[l]) @ w_branch_rwkv[l]
        q_m = _rope(q_m.reshape(B, S, MOBA_HEADS, MOBA_HEAD_DIM), positions)
        k_m = _rope(k_m.reshape(B, S, MOBA_HEADS, MOBA_HEAD_DIM), positions)
        v_m = v_m.reshape(B, S, MOBA_HEADS, MOBA_HEAD_DIM)
        y_b = _moba_attention(q_m, k_m, v_m) @ w_branch_moba[l]
        mixed = jax.nn.sigmoid(gate_a) * y_a + jax.nn.sigmoid(gate_b) * y_b
        x = x + mixed @ w_out[l]
        h2 = _rms_norm(x, norm2_g[l])
        x = x + _peer(h2, peer_w_q[l], peer_sub_keys[l], peer_u[l], peer_v[l])
    return _rms_norm(x, final_g)
```

```cpp
#include <hip/hip_runtime.h>
#include <cstdio>
#include <cstdint>

#ifndef MK_N_LAUNCHES
#define MK_N_LAUNCHES 1
#endif

#define GAS __attribute__((address_space(1)))
#define LAS __attribute__((address_space(3)))
typedef unsigned short bf16_t;
typedef __bf16 bf16x8 __attribute__((ext_vector_type(8)));
typedef float f32x2 __attribute__((ext_vector_type(2)));
typedef float f32x4 __attribute__((ext_vector_type(4)));
typedef float f32x16 __attribute__((ext_vector_type(16)));
typedef unsigned u32x2 __attribute__((ext_vector_type(2)));
typedef unsigned u32x4 __attribute__((ext_vector_type(4)));
typedef GAS unsigned gu32;

constexpr int T = 8192, D = 4096;
constexpr int RW = 2048, RH = 32, RN = 64;
constexpr int LW = 128, LA = 128, LG = 480, LGP = 512;
constexpr int SHIFTW = 6880;
constexpr int MH = 16, MD = 128, MBLK = 256, NBLK = 32;
constexpr int INW = 21216;
constexpr int PLD = 19200;
constexpr int PC_R = 0, PC_K = 2048, PC_V = 4096, PC_WL = 6144, PC_AL = 6272, PC_GL = 6400, PC_MQ = 6912, PC_MK = 8960, PC_GA = 11008, PC_GB = 15104, PC_MV = 19200;
constexpr int WIN_ROWS = 21248;
constexpr int PH_ = 8, PNK = 128, PQD = 256, PHALF = 128, PTOPK = 16;
constexpr float NORM_EPS = 1e-6f, LNX_EPS = 64e-5f;
constexpr float QSCALE = 0.08838834764831845f * 1.4426950408889634f;

constexpr size_t MiB = 1u << 20;
constexpr size_t WS_CTL = 0, CTL_ZERO_BYTES = 1 * MiB;
constexpr size_t WS_WIN = 1 * MiB;
constexpr size_t WS_X1 = 1 * MiB, WS_PQ = 129 * MiB;
constexpr size_t WS_WA = 167 * MiB, WS_WB = 183 * MiB, WS_WOUT = 199 * MiB, WS_WQ = 231 * MiB, WS_WUP = 247 * MiB, WS_AUP = 248 * MiB, WS_GUP = 249 * MiB, WS_SUBK = 251 * MiB;
constexpr size_t WS_PU = 252 * MiB, WS_PV = 380 * MiB;
constexpr size_t WS_XN = 508 * MiB;
constexpr size_t WS_Y = 508 * MiB, WS_H2 = 508 * MiB;
constexpr size_t WS_PROJ = 572 * MiB;
constexpr size_t WS_VT = 872 * MiB;
constexpr size_t WS_ROPE = 904 * MiB, WS_KMEAN = 908 * MiB, WS_MASK = 909 * MiB, WS_AW = 910 * MiB, WS_AA = 912 * MiB, WS_AG = 914 * MiB;
constexpr size_t WS_DEC = 922 * MiB;
constexpr size_t WS_MIXED = 922 * MiB;
constexpr size_t WS_KKN = 986 * MiB, WS_BB = 1018 * MiB, WS_KP = 1050 * MiB, WS_ZR = 1082 * MiB, WS_ZV = 1114 * MiB, WS_G = 1146 * MiB;
constexpr size_t WS_YA = 1178 * MiB, WS_YB = 1210 * MiB, WS_IDX = 1242 * MiB, WS_GW = 1246 * MiB, WS_END = 1250 * MiB;

constexpr int CW_TMO = 0, CW_CODE = 1, CW_BAR = 4096;

constexpr int RING_OFF = 0, RING_BYTES = 131072;
constexpr int LDSCTL_OFF = RING_BYTES, MISC_OFF = LDSCTL_OFF + 320;
constexpr int LDS_BYTES = 147456;
constexpr int NWAVES = 8, NTHR = 512;

__device__ __forceinline__ unsigned f2bf(float f) { unsigned u = __builtin_bit_cast(unsigned, f); return (u + 0x7fffu + ((u >> 16) & 1u)) >> 16; }
__device__ __forceinline__ unsigned pk2(float lo, float hi) { unsigned r; asm volatile("v_cvt_pk_bf16_f32 %0, %1, %2" : "=v"(r) : "v"(lo), "v"(hi)); return r; }
__device__ __forceinline__ float bflo(unsigned u) { return __builtin_bit_cast(float, u << 16); }
__device__ __forceinline__ float bfhi(unsigned u) { return __builtin_bit_cast(float, u & 0xffff0000u); }
__device__ __forceinline__ float bf1(bf16_t b) { return __builtin_bit_cast(float, (unsigned)b << 16); }
__device__ __forceinline__ float fsigmoid(float x) { return __builtin_amdgcn_rcpf(1.0f + __expf(-x)); }
__device__ __forceinline__ float wave_sum(float v) {
#pragma unroll
    for (int o = 1; o < 64; o <<= 1) v += __shfl_xor(v, o);
    return v;
}
template <int CTRL> __device__ __forceinline__ float dpp_f(float v) { return __builtin_bit_cast(float, __builtin_amdgcn_update_dpp(0, __builtin_bit_cast(int, v), CTRL, 0xF, 0xF, true)); }
__device__ __forceinline__ float sum16(float x) {
    x += dpp_f<0xB1>(x); x += dpp_f<0x4E>(x); x += dpp_f<0x141>(x); x += dpp_f<0x140>(x); return x;
}
#define LDS_WAIT() asm volatile("s_waitcnt lgkmcnt(0)" ::: "memory")
#define VM_WAIT() asm volatile("s_waitcnt vmcnt(0)" ::: "memory")
#define WG_BAR() do { asm volatile("s_waitcnt lgkmcnt(0)" ::: "memory"); __builtin_amdgcn_s_barrier(); asm volatile("" ::: "memory"); } while (0)

namespace pg8 {
constexpr int BM = 256, BK = 64, HALF = 128, HTB = HALF * BK * 2, STAGE_BYTES = 8 * HTB, NXCD = 8, WGM = 8;
__host__ __device__ __forceinline__ int lds_byte(int r, int c) { const int st = (r >> 4) * 2 + (c >> 5), rr = r & 15, cc = c & 31, ob = rr * 64 + cc * 2; return st * 1024 + (ob ^ (((ob >> 9) & 1) << 5)); }
__host__ __device__ __forceinline__ void stage_rc(int b, int& R, int& C) { const int st = b / 1024, sb = b % 1024, swz = sb ^ (((sb >> 9) & 1) << 5); R = (st >> 1) * 16 + swz / 64; C = (st & 1) * 32 + (swz % 64) / 2; }
__host__ __device__ __forceinline__ int perm32(int rho) { const int n = rho >> 4, i = rho & 15; return 8 * (i >> 2) + 4 * n + (i & 3); }

struct Unit { int pm, pn; };
struct Gemm { const bf16_t* A; const bf16_t* Bt; int M, N, K; };

struct StaticOrder {
    int nM, nN, nwg, G, c;
    __host__ __device__ void init(int M, int N, int G_, int c_) { nM = M / BM; nN = N / BM; nwg = nM * nN; G = G_; c = c_; }
    __host__ __device__ bool next(int i, Unit& u) const {
        const long L = (long)i * G + c; if (L >= nwg) return false;
        int wgid = (int)L; { const int q = nwg / NXCD, r = nwg % NXCD, xcd = wgid % NXCD, off = wgid / NXCD; wgid = (xcd < r ? xcd * (q + 1) : r * (q + 1) + (xcd - r) * q) + off; }
        const int nig = WGM * nN, gid = wgid / nig, fm = gid * WGM, gsz = (nM - fm) < WGM ? (nM - fm) : WGM;
        u.pm = fm + ((wgid % nig) % gsz); u.pn = (wgid % nig) / gsz; return true;
    }
    __device__ __forceinline__ void a_ready(const Unit&) const {}
    __device__ __forceinline__ void done(const Unit&) const {}
};

template <class Epi, class Sched, bool ALIGN_EPI = false, bool SP2 = false>
__device__ __forceinline__ void gemm_phase(LAS unsigned char* lds, const Gemm g, const Sched& S, const Epi& E) {
    int tid_ = threadIdx.x; asm volatile("" : "+v"(tid_));
    const int tid = tid_, wid = __builtin_amdgcn_readfirstlane(tid >> 6), lane = tid & 63, wr = wid >> 2, wc = wid & 3, fr = lane & 15, fq = lane >> 4;
    const int K = g.K, nt = K / BK;
    unsigned voffA[2], voffB[2];
#pragma unroll
    for (int i = 0; i < 2; ++i) { int R, C; stage_rc(tid * 16 + i * 8192, R, C); const int Rb = Epi::PERM ? ((R & ~31) + perm32(R & 31)) : R;
        voffA[i] = (unsigned)(R * K + C) * 2u; voffB[i] = (unsigned)(Rb * K + C) * 2u; }
    const size_t kstep = (size_t)(BK * 2);
    const size_t hstep = (size_t)HALF * K * 2;
    const size_t tstep = 2 * hstep;
    const unsigned ldsw = (unsigned)wid * 1024u;
    const int aoff = lds_byte(wr * 64 + fr, fq * 8), boff = lds_byte(wc * 32 + fr, fq * 8);
#define PG8_SA(b, h) (((b) * 2 + (h)) * HTB)
#define PG8_SB(b, h) ((4 + (b) * 2 + (h)) * HTB)
#define PG8_STAGE(bufoff, gbase, voff) do { _Pragma("unroll") for (int _i = 0; _i < 2; ++_i) \
        __builtin_amdgcn_global_load_lds((const unsigned*)((const char*)(gbase) + (voff)[_i]), (LAS unsigned*)(lds + (bufoff) + ldsw + _i * 8192), 16, 0, 0); } while (0)
#define PG8_LDA(dst, b, h) do { _Pragma("unroll") for (int m = 0; m < 4; ++m) _Pragma("unroll") for (int k = 0; k < 2; ++k) dst[m][k] = *(const LAS bf16x8*)(lds + PG8_SA(b, h) + aoff + m * 2048 + k * 1024); } while (0)
#define PG8_LDB(dst, b, h) do { _Pragma("unroll") for (int n = 0; n < 2; ++n) _Pragma("unroll") for (int k = 0; k < 2; ++k) dst[n][k] = *(const LAS bf16x8*)(lds + PG8_SB(b, h) + boff + n * 2048 + k * 1024); } while (0)
#define PG8_MMA(ai, bj, At, Bt) do { __builtin_amdgcn_s_setprio(1); _Pragma("unroll") for (int m = 0; m < 4; ++m) _Pragma("unroll") for (int n = 0; n < 2; ++n) _Pragma("unroll") for (int k = 0; k < 2; ++k) { \
        if constexpr (Epi::SWAP) acc[ai][bj][m][n] = __builtin_amdgcn_mfma_f32_16x16x32_bf16(At[m][k], Bt[n][k], acc[ai][bj][m][n], 0, 0, 0); \
        else acc[ai][bj][m][n] = __builtin_amdgcn_mfma_f32_16x16x32_bf16(Bt[n][k], At[m][k], acc[ai][bj][m][n], 0, 0, 0); } __builtin_amdgcn_s_setprio(0); } while (0)
#define PG8_WAIT_V(n) asm volatile("s_waitcnt vmcnt(" #n ")" ::: "memory")
#define PG8_WAIT_L(n) asm volatile("s_waitcnt lgkmcnt(" #n ")" ::: "memory")
#define PG8_BAR __builtin_amdgcn_s_barrier()
#define PG8_SCHED __builtin_amdgcn_sched_barrier(0)
    Unit cur, nxt; int ui = 0;
    if (!S.next(0, cur)) return;
    f32x4 acc[2][2][4][2];
#pragma unroll
    for (int a = 0; a < 2; ++a)
#pragma unroll
        for (int b = 0; b < 2; ++b)
#pragma unroll
            for (int m = 0; m < 4; ++m)
#pragma unroll
                for (int n = 0; n < 2; ++n) acc[a][b][m][n] = (f32x4){0.f, 0.f, 0.f, 0.f};
    bf16x8 At[4][2], B0[2][2], B1[2][2];
    const char* cA = (const char*)g.A + (size_t)cur.pm * tstep; const char* cB = (const char*)g.Bt + (size_t)cur.pn * tstep;
    S.a_ready(cur);
    if constexpr (SP2) {
        PG8_STAGE(PG8_SB(0, 0), cB, voffB); PG8_STAGE(PG8_SB(0, 1), cB + hstep, voffB); PG8_STAGE(PG8_SA(0, 0), cA, voffA); PG8_STAGE(PG8_SA(0, 1), cA + hstep, voffA);
        if (wr == 1) PG8_BAR;
        PG8_WAIT_V(2); PG8_BAR;
        PG8_STAGE(PG8_SB(1, 0), cB + kstep, voffB); PG8_STAGE(PG8_SA(1, 0), cA + kstep, voffA); PG8_STAGE(PG8_SB(1, 1), cB + hstep + kstep, voffB);
        PG8_WAIT_V(6); PG8_BAR;
    } else {
        PG8_STAGE(PG8_SB(0, 0), cB, voffB); PG8_STAGE(PG8_SA(0, 0), cA, voffA); PG8_STAGE(PG8_SB(0, 1), cB + hstep, voffB); PG8_STAGE(PG8_SA(0, 1), cA + hstep, voffA);
        if (wr == 1) PG8_BAR;
        PG8_WAIT_V(4); PG8_BAR;
        PG8_STAGE(PG8_SB(1, 0), cB + kstep, voffB); PG8_STAGE(PG8_SA(1, 0), cA + kstep, voffA); PG8_STAGE(PG8_SB(1, 1), cB + hstep + kstep, voffB);
        PG8_WAIT_V(6); PG8_BAR;
    }
    for (;;) {
        const bool has_next = S.next(ui + 1, nxt);
        const char* nA = has_next ? (const char*)g.A + (size_t)nxt.pm * tstep : cA; const char* nB = has_next ? (const char*)g.Bt + (size_t)nxt.pn * tstep : cB;
        for (int t = 0; t < nt; t += 2) {
            const bool last = (t == nt - 2);
            const char* a1 = cA + (size_t)(t + 1) * kstep;
            const char* a2 = last ? nA : cA + (size_t)(t + 2) * kstep; const char* b2 = last ? nB : cB + (size_t)(t + 2) * kstep;
            const char* a3 = a2 + kstep; const char* b3 = b2 + kstep;
            if (last && has_next) S.a_ready(nxt);
            if constexpr (SP2) {
            PG8_LDB(B0, 0, 0); PG8_LDB(B1, 0, 1); PG8_SCHED; PG8_LDA(At, 0, 0); PG8_STAGE(PG8_SA(1, 1), a1 + hstep, voffA);
            PG8_WAIT_V(8); PG8_WAIT_L(0); PG8_BAR; PG8_MMA(0, 0, At, B0); PG8_MMA(0, 1, At, B1); PG8_BAR; PG8_SCHED;
            PG8_LDA(At, 0, 1); PG8_STAGE(PG8_SB(0, 0), b2, voffB); PG8_STAGE(PG8_SB(0, 1), b2 + hstep, voffB); PG8_STAGE(PG8_SA(0, 0), a2, voffA);
            PG8_WAIT_V(8); PG8_WAIT_L(0); PG8_BAR; PG8_MMA(1, 0, At, B0); PG8_MMA(1, 1, At, B1); PG8_BAR; PG8_SCHED;
            PG8_LDB(B0, 1, 0); PG8_LDB(B1, 1, 1); PG8_SCHED; PG8_LDA(At, 1, 0); PG8_STAGE(PG8_SA(0, 1), a2 + hstep, voffA);
            PG8_WAIT_V(8); PG8_WAIT_L(0); PG8_BAR; PG8_MMA(0, 0, At, B0); PG8_MMA(0, 1, At, B1); PG8_BAR; PG8_SCHED;
            PG8_LDA(At, 1, 1); PG8_STAGE(PG8_SB(1, 0), b3, voffB); PG8_STAGE(PG8_SB(1, 1), b3 + hstep, voffB); PG8_STAGE(PG8_SA(1, 0), a3, voffA);
            PG8_WAIT_V(8); PG8_WAIT_L(0); PG8_BAR; PG8_MMA(1, 0, At, B0); PG8_MMA(1, 1, At, B1); PG8_BAR; PG8_SCHED;
            } else {
            PG8_LDB(B0, 0, 0); PG8_SCHED; PG8_LDA(At, 0, 0); PG8_STAGE(PG8_SA(1, 1), a1 + hstep, voffA);
            PG8_WAIT_L(8); PG8_BAR; PG8_WAIT_L(0); PG8_MMA(0, 0, At, B0); PG8_BAR; PG8_SCHED;
            PG8_LDB(B1, 0, 1); PG8_STAGE(PG8_SB(0, 0), b2, voffB);
            PG8_BAR; PG8_WAIT_L(0); PG8_MMA(0, 1, At, B1); PG8_BAR;
            PG8_LDA(At, 0, 1); PG8_STAGE(PG8_SA(0, 0), a2, voffA);
            PG8_BAR; PG8_WAIT_L(0); PG8_MMA(1, 0, At, B0); PG8_BAR; PG8_SCHED;
            PG8_STAGE(PG8_SB(0, 1), b2 + hstep, voffB);
            PG8_WAIT_V(6); PG8_BAR; PG8_MMA(1, 1, At, B1); PG8_BAR;
            PG8_LDB(B0, 1, 0); PG8_SCHED; PG8_LDA(At, 1, 0); PG8_STAGE(PG8_SA(0, 1), a2 + hstep, voffA);
            PG8_WAIT_L(8); PG8_BAR; PG8_WAIT_L(0); PG8_MMA(0, 0, At, B0); PG8_BAR; PG8_SCHED;
            PG8_LDB(B1, 1, 1); PG8_STAGE(PG8_SB(1, 0), b3, voffB);
            PG8_BAR; PG8_WAIT_L(0); PG8_MMA(0, 1, At, B1); PG8_BAR;
            PG8_LDA(At, 1, 1); PG8_STAGE(PG8_SA(1, 0), a3, voffA);
            PG8_BAR; PG8_WAIT_L(0); PG8_MMA(1, 0, At, B0); PG8_BAR; PG8_SCHED;
            PG8_STAGE(PG8_SB(1, 1), b3 + hstep, voffB);
            PG8_WAIT_V(6); PG8_BAR; PG8_MMA(1, 1, At, B1); PG8_BAR;
            }
        }
        if constexpr (ALIGN_EPI) { if (wr == 0) PG8_BAR; }
        E(acc, cur, wr, wc, fr, fq); S.done(cur);
        if (!has_next) break;
#pragma unroll
        for (int a = 0; a < 2; ++a)
#pragma unroll
            for (int b = 0; b < 2; ++b)
#pragma unroll
                for (int m = 0; m < 4; ++m)
#pragma unroll
                    for (int n = 0; n < 2; ++n) acc[a][b][m][n] = (f32x4){0.f, 0.f, 0.f, 0.f};
        cur = nxt; cA = nA; cB = nB; ++ui;
        if constexpr (ALIGN_EPI) { if (wr == 1) PG8_BAR; }
    }
    PG8_WAIT_V(0);
    if constexpr (!ALIGN_EPI) { if (wr == 0) PG8_BAR; }
    PG8_BAR;
#undef PG8_SA
#undef PG8_SB
#undef PG8_STAGE
#undef PG8_LDA
#undef PG8_LDB
#undef PG8_MMA
#undef PG8_WAIT_V
#undef PG8_WAIT_L
#undef PG8_BAR
#undef PG8_SCHED
}

typedef const f32x4 (&AccRef)[2][2][4][2];
__device__ __forceinline__ u32x4 pack8(f32x4 v0, f32x4 v1) { u32x4 w; w.x = pk2(v0[0], v0[1]); w.y = pk2(v0[2], v0[3]); w.z = pk2(v1[0], v1[1]); w.w = pk2(v1[2], v1[3]); return w; }
__device__ __forceinline__ void unpack8(u32x4 w, f32x4& v0, f32x4& v1) { v0 = (f32x4){bflo(w.x), bfhi(w.x), bflo(w.y), bfhi(w.y)}; v1 = (f32x4){bflo(w.z), bfhi(w.z), bflo(w.w), bfhi(w.w)}; }

struct EpiBf16 {
    static constexpr bool PERM = true, SWAP = false;
    bf16_t* O; int ldc;
    __device__ __forceinline__ void operator()(AccRef acc, const Unit& u, int wr, int wc, int fr, int fq) const {
        const int row0 = u.pm * BM + wr * 64 + fr, col0 = u.pn * BM + wc * 32 + 8 * fq;
#pragma unroll
        for (int ai = 0; ai < 2; ++ai)
#pragma unroll
            for (int m = 0; m < 4; ++m) { bf16_t* rowp = O + (size_t)(row0 + ai * HALF + m * 16) * ldc + col0;
#pragma unroll
                for (int bj = 0; bj < 2; ++bj) *(u32x4*)(rowp + bj * HALF) = pack8(acc[ai][bj][m][0], acc[ai][bj][m][1]); }
    }
};
struct EpiProj {
    static constexpr bool PERM = true, SWAP = false;
    bf16_t* O; const float* rope;
    __device__ __forceinline__ void operator()(AccRef acc, const Unit& u, int wr, int wc, int fr, int fq) const {
        const int row0 = u.pm * BM + wr * 64 + fr, col0 = u.pn * BM + wc * 32 + 8 * fq;
        const int mode = (u.pn >= 27 && u.pn < 43) ? (u.pn < 35 ? 1 : 2) : 0;
        const float sc = (mode == 1) ? QSCALE : 1.0f;
#pragma unroll
        for (int ai = 0; ai < 2; ++ai)
#pragma unroll
            for (int m = 0; m < 4; ++m) { const int row = row0 + ai * HALF + m * 16; bf16_t* rowp = O + (size_t)row * PLD + col0;
#pragma unroll
                for (int bj = 0; bj < 2; ++bj) { f32x4 v0 = acc[ai][bj][m][0], v1 = acc[ai][bj][m][1];
                    if (mode) { const int i0 = ((col0 + bj * HALF) & 127) >> 1; const f32x4* rp = (const f32x4*)(rope + ((size_t)row * 64 + i0) * 2); const f32x4 c0 = rp[0], c1 = rp[1];
                        f32x4 o0, o1;
                        o0[0] = v0[0] * c0[0] - v0[1] * c0[1]; o0[1] = v0[1] * c0[0] + v0[0] * c0[1]; o0[2] = v0[2] * c0[2] - v0[3] * c0[3]; o0[3] = v0[3] * c0[2] + v0[2] * c0[3];
                        o1[0] = v1[0] * c1[0] - v1[1] * c1[1]; o1[1] = v1[1] * c1[0] + v1[0] * c1[1]; o1[2] = v1[2] * c1[2] - v1[3] * c1[3]; o1[3] = v1[3] * c1[2] + v1[2] * c1[3];
                        v0 = o0 * sc; v1 = o1 * sc; }
                    *(u32x4*)(rowp + bj * HALF) = pack8(v0, v1); } }
    }
};
struct EpiVT {
    static constexpr bool PERM = false, SWAP = true;
    bf16_t* VT;
    __device__ __forceinline__ void operator()(AccRef acc, const Unit& u, int wr, int wc, int fr, int fq) const {
        const int tok0 = u.pm * BM + wr * 64 + 4 * fq, col0 = u.pn * BM + wc * 32 + fr;
#pragma unroll
        for (int ai = 0; ai < 2; ++ai)
#pragma unroll
            for (int m = 0; m < 4; ++m)
#pragma unroll
                for (int bj = 0; bj < 2; ++bj)
#pragma unroll
                    for (int n = 0; n < 2; ++n) { const f32x4 v = acc[ai][bj][m][n]; u32x2 w; w.x = pk2(v[0], v[1]); w.y = pk2(v[2], v[3]);
                        *(u32x2*)(VT + (size_t)(col0 + bj * HALF + n * 16) * T + tok0 + ai * HALF + m * 16) = w; }
    }
};
struct EpiDec {
    static constexpr bool PERM = true, SWAP = false;
    float* O; const float* w0;
    __device__ __forceinline__ void operator()(AccRef acc, const Unit& u, int wr, int wc, int fr, int fq) const {
        const int row0 = u.pm * BM + wr * 64 + fr, col0 = u.pn * BM + wc * 32 + 8 * fq;
#pragma unroll
        for (int bj = 0; bj < 2; ++bj) { const f32x4 b0 = *(const f32x4*)(w0 + col0 + bj * HALF), b1 = *(const f32x4*)(w0 + col0 + bj * HALF + 4);
#pragma unroll
            for (int ai = 0; ai < 2; ++ai)
#pragma unroll
                for (int m = 0; m < 4; ++m) { float* rowp = O + (size_t)(row0 + ai * HALF + m * 16) * RW + col0 + bj * HALF;
#pragma unroll
                    for (int n = 0; n < 2; ++n) { const f32x4 x = acc[ai][bj][m][n] + (n ? b1 : b0); f32x4 o;
#pragma unroll
                        for (int e = 0; e < 4; ++e) { const float z = -x[e]; const float sp = fmaxf(z, 0.f) + __logf(1.0f + __expf(-fabsf(z))); o[e] = __expf(-__expf(-sp - 0.5f)); }
                        *(f32x4*)(rowp + 4 * n) = o; }
                    asm volatile("" ::: "memory"); } }
    }
};
struct EpiA {
    static constexpr bool PERM = true, SWAP = false;
    bf16_t* KP; bf16_t* BB; const bf16_t* KKN; const float* a0; const float* k_a;
    __device__ __forceinline__ void operator()(AccRef acc, const Unit& u, int wr, int wc, int fr, int fq) const {
        const int row0 = u.pm * BM + wr * 64 + fr, col0 = u.pn * BM + wc * 32 + 8 * fq;
#pragma unroll
        for (int bj = 0; bj < 2; ++bj) { const int cb = col0 + bj * HALF;
            const f32x4 b0 = *(const f32x4*)(a0 + cb), b1 = *(const f32x4*)(a0 + cb + 4), ka0 = *(const f32x4*)(k_a + cb), ka1 = *(const f32x4*)(k_a + cb + 4);
#pragma unroll
            for (int ai = 0; ai < 2; ++ai)
#pragma unroll
                for (int m = 0; m < 4; ++m) { const size_t off = (size_t)(row0 + ai * HALF + m * 16) * RW + cb;
                    f32x4 zk0, zk1, kn0, kn1; unpack8(*(const u32x4*)(KP + off), zk0, zk1); unpack8(*(const u32x4*)(KKN + off), kn0, kn1);
                    f32x4 a0v, a1v;
#pragma unroll
                    for (int e = 0; e < 4; ++e) { a0v[e] = fsigmoid(acc[ai][bj][m][0][e] + b0[e]); a1v[e] = fsigmoid(acc[ai][bj][m][1][e] + b1[e]); }
                    const f32x4 kp0 = zk0 * (1.0f + (a0v - 1.0f) * ka0), kp1 = zk1 * (1.0f + (a1v - 1.0f) * ka1);
                    *(u32x4*)(KP + off) = pack8(kp0, kp1); *(u32x4*)(BB + off) = pack8(kn0 * a0v, kn1 * a1v);
                    asm volatile("" ::: "memory"); } }
    }
};
template <bool ADD> struct EpiMix {
    static constexpr bool PERM = true, SWAP = false;
    bf16_t* O; const bf16_t* proj; int gcol0;
    __device__ __forceinline__ void operator()(AccRef acc, const Unit& u, int wr, int wc, int fr, int fq) const {
        const int row0 = u.pm * BM + wr * 64 + fr, col0 = u.pn * BM + wc * 32 + 8 * fq;
#pragma unroll
        for (int ai = 0; ai < 2; ++ai)
#pragma unroll
            for (int m = 0; m < 4; ++m) { const int row = row0 + ai * HALF + m * 16;
#pragma unroll
                for (int bj = 0; bj < 2; ++bj) { f32x4 g0, g1; unpack8(*(const u32x4*)(proj + (size_t)row * PLD + gcol0 + col0 + bj * HALF), g0, g1);
                    f32x4 o0, o1;
#pragma unroll
                    for (int e = 0; e < 4; ++e) { o0[e] = fsigmoid(g0[e]) * acc[ai][bj][m][0][e]; o1[e] = fsigmoid(g1[e]) * acc[ai][bj][m][1][e]; }
                    bf16_t* op = O + (size_t)row * D + col0 + bj * HALF;
                    if (ADD) { f32x4 p0, p1; unpack8(*(const u32x4*)op, p0, p1); o0 += p0; o1 += p1; }
                    *(u32x4*)op = pack8(o0, o1); } }
    }
};
struct EpiRes {
    static constexpr bool PERM = true, SWAP = false;
    float* O; const float* x;
    __device__ __forceinline__ void operator()(AccRef acc, const Unit& u, int wr, int wc, int fr, int fq) const {
        const int row0 = u.pm * BM + wr * 64 + fr, col0 = u.pn * BM + wc * 32 + 8 * fq;
#pragma unroll
        for (int ai = 0; ai < 2; ++ai)
#pragma unroll
            for (int m = 0; m < 4; ++m) { const size_t off = (size_t)(row0 + ai * HALF + m * 16) * D + col0;
#pragma unroll
                for (int bj = 0; bj < 2; ++bj)
#pragma unroll
                    for (int n = 0; n < 2; ++n) *(f32x4*)(O + off + bj * HALF + 4 * n) = *(const f32x4*)(x + off + bj * HALF + 4 * n) + acc[ai][bj][m][n]; }
    }
};
}

#define XB_TMO      128
#define XB_XCNT(j)  (256  + 64 * (j))
#define XB_XSUB(j)  (1280 + 64 * (j))
#define XB_XGEN(j)  (2304 + 64 * (j))
#define XB_TOP      3328
#define XB_TOPGEN   3392
#define XCD_BAR_WORDS 3456
#define XB_SPIN_CAP (1u << 18)
__device__ __forceinline__ unsigned xb_ld(unsigned* p)              { return __hip_atomic_load(p, __ATOMIC_RELAXED, __HIP_MEMORY_SCOPE_AGENT); }
__device__ __forceinline__ unsigned xb_add(unsigned* p, unsigned v) { return __hip_atomic_fetch_add(p, v, __ATOMIC_RELAXED, __HIP_MEMORY_SCOPE_AGENT); }
__device__ __forceinline__ unsigned xb_xcc_id() { return (unsigned)__builtin_amdgcn_s_getreg((3 << 11) | 20) & 0xFu; }
#define XB_SPIN(cond, bar) do { unsigned _sp = 0; while (cond) { __builtin_amdgcn_s_sleep(1); \
    if ((++_sp & 255u) == 0u) { if (xb_ld(&(bar)[XB_TMO])) break; if (_sp > XB_SPIN_CAP) { atomicAdd(&(bar)[XB_TMO], 1u); break; } } } } while (0)
struct XcdBarrier { unsigned* bar; unsigned x; volatile LAS unsigned* st; };
__device__ __forceinline__ XcdBarrier xcd_barrier_post(unsigned* bar, volatile LAS unsigned* st) {
    XcdBarrier b; b.bar = bar; b.x = xb_xcc_id(); b.st = st;
    if (threadIdx.x == 0) (void)xb_add(&bar[XB_XCNT(b.x)], 1u);
    return b;
}
__device__ __forceinline__ void xcd_barrier_complete(unsigned* bar, unsigned x, unsigned& nloc, unsigned& nx) {
    const unsigned G = gridDim.x * gridDim.y * gridDim.z;
    unsigned sum, cnt, mine, sp = 0u;
    for (;;) {
        sum = 0u; cnt = 0u; mine = 0u;
#pragma unroll
        for (unsigned j = 0; j < 16; ++j) { const unsigned c = xb_ld(&bar[XB_XCNT(j)]); sum += c; cnt += (c > 0u) ? 1u : 0u; mine = (j == x) ? c : mine; }
        if (sum == G) break;
        __builtin_amdgcn_s_sleep(1);
        if ((++sp & 255u) == 0u) { if (xb_ld(&bar[XB_TMO])) break; if (sp > XB_SPIN_CAP) { atomicAdd(&bar[XB_TMO], 1u); break; } }
    }
    nloc = mine > 0u ? mine : 1u; nx = cnt > 0u ? cnt : 1u;
}
__device__ __forceinline__ void xcd_barrier(const XcdBarrier& b) {
    asm volatile("s_waitcnt vmcnt(0)" ::: "memory");
    __syncthreads();
    if (threadIdx.x == 0) {
        unsigned* bar = b.bar;
        __builtin_amdgcn_s_waitcnt(0);
        unsigned nloc = b.st[0], nx = b.st[1];
        if (nloc == 0u) { xcd_barrier_complete(bar, b.x, nloc, nx); b.st[0] = nloc; b.st[1] = nx; }
        const unsigned old = xb_add(&bar[XB_XSUB(b.x)], 1u);
        const unsigned gen = old / nloc;
        if (old + 1u == (gen + 1u) * nloc) {
            __builtin_amdgcn_fence(__ATOMIC_RELEASE, "agent");
            asm volatile("s_waitcnt vmcnt(0)" ::: "memory");
            const unsigned og = xb_add(&bar[XB_TOP], 1u);
            const unsigned tg = og / nx;
            if (og + 1u == (tg + 1u) * nx) xb_add(&bar[XB_TOPGEN], 1u);
            else XB_SPIN(xb_ld(&bar[XB_TOPGEN]) == tg, bar);
            __builtin_amdgcn_fence(__ATOMIC_ACQUIRE, "agent");
            xb_add(&bar[XB_XGEN(b.x)], 1u);
            asm volatile("s_waitcnt vmcnt(0)" ::: "memory");
        } else {
            XB_SPIN(xb_ld(&bar[XB_XGEN(b.x)]) == gen, bar);
            __builtin_amdgcn_fence(__ATOMIC_ACQUIRE, "agent");
            asm volatile("s_waitcnt vmcnt(0)" ::: "memory");
        }
    }
    __syncthreads();
}

struct Args {
    const float *x, *norm1_g, *w_in, *mu, *w0, *w_up, *a0, *a_up, *g_up, *k_k, *k_a, *r_k, *lnx_g, *lnx_b, *w_ba, *w_bb, *w_out, *norm2_g, *peer_wq, *sub_keys, *peer_u, *peer_v, *final_g;
    float* out; unsigned char* ws; int ph_lo, ph_hi, li, pad;
};
#define CAS __attribute__((address_space(4)))
typedef const CAS Args* ArgsP;
__device__ __forceinline__ ArgsP get_args() { ArgsP p = (ArgsP)__builtin_amdgcn_kernarg_segment_ptr(); asm volatile("" : "+s"(p)); return p; }
struct Frame { LAS unsigned char* lds; int tid, lane, wave, vcu, G; };

__device__ __forceinline__ int win_dst(int s) {
    if (s < SHIFTW) return s;
    if (s < SHIFTW + 4096) { const int base = (s < SHIFTW + 2048) ? SHIFTW : SHIFTW + 2048; const int m = s - base, head = m >> 7, c = m & 127; const int j = (c < 64) ? 2 * c : 2 * (c - 64) + 1;
        return ((s < SHIFTW + 2048) ? PC_MQ : PC_MK) + head * 128 + j; }
    if (s < SHIFTW + 6144) return PC_MV + (s - (SHIFTW + 4096));
    if (s < SHIFTW + 6144 + 4096) return PC_GA + (s - (SHIFTW + 6144));
    return PC_GB + (s - (SHIFTW + 6144 + 4096));
}
template <bool MAPWIN> __device__ __forceinline__ void p0_transpose_item(const float* W, int K, int N, bf16_t* WT, int Kd, LAS float* scr, int item, int lane) {
    const int nblk = N / 32, kb = item / nblk, nb = item % nblk, k0 = 64 * kb, n0 = 32 * nb;
#pragma unroll 8
    for (int i = 0; i < 32; ++i) { const int kk = 2 * i + (lane >> 5); scr[kk * 33 + (lane & 31)] = (k0 + kk < K) ? W[(size_t)(k0 + kk) * N + n0 + (lane & 31)] : 0.f; }
    LDS_WAIT(); asm volatile("" ::: "memory");
    const int c = lane & 7;
#pragma unroll
    for (int j = 0; j < 4; ++j) { const int n = (lane >> 3) + 8 * j; const LAS float* s = scr + (8 * c) * 33 + n;
        u32x4 o; o.x = pk2(s[0 * 33], s[1 * 33]); o.y = pk2(s[2 * 33], s[3 * 33]); o.z = pk2(s[4 * 33], s[5 * 33]); o.w = pk2(s[6 * 33], s[7 * 33]);
        const int row = MAPWIN ? win_dst(n0 + n) : (n0 + n);
        *(u32x4*)(WT + (size_t)row * Kd + k0 + 8 * c) = o; }
    LDS_WAIT(); asm volatile("" ::: "memory");
}
__device__ __forceinline__ void rms_row_to_bf16(const float* xrow, const float* g, bf16_t* orow, int lane) {
    const f32x4* xr = (const f32x4*)xrow + lane; const f32x4* gr = (const f32x4*)g + lane;
    f32x4 v[16]; float s = 0.f;
#pragma unroll
    for (int j = 0; j < 16; ++j) { v[j] = xr[64 * j]; s += (v[j].x * v[j].x + v[j].y * v[j].y) + (v[j].z * v[j].z + v[j].w * v[j].w); }
    const float rs = 1.0f / sqrtf(wave_sum(s) * (1.0f / D) + NORM_EPS);
    u32x2* o8 = (u32x2*)orow + lane;
#pragma unroll
    for (int j = 0; j < 16; ++j) { const f32x4 gg = gr[64 * j]; u32x2 w; w.x = pk2(v[j].x * rs * gg.x, v[j].y * rs * gg.y); w.y = pk2(v[j].z * rs * gg.z, v[j].w * rs * gg.w); o8[64 * j] = w; }
}
__device__ __forceinline__ void cvt_table(const float* src, bf16_t* dst, size_t n8, size_t gtid, size_t nthr) {
    for (size_t i = gtid; i < n8; i += nthr) { const f32x4 a = ((const f32x4*)src)[2 * i], b = ((const f32x4*)src)[2 * i + 1]; ((u32x4*)dst)[i] = pg8::pack8(a, b); }
}
__device__ __forceinline__ void ph0_prologue(ArgsP A, Frame& F) {
    unsigned char* ws = A->ws;
    LAS float* scr = (LAS float*)(F.lds + RING_OFF + F.wave * 16384);
    const int gw = F.vcu * NWAVES + F.wave, NGW = F.G * NWAVES;
    constexpr int I_IN = 64 * (INW / 32), I_BA = 32 * 128, I_OUT = 64 * 128, I_WQ = 64 * 64, I_UP = 2 * 64, I_G = 8 * 64;
    constexpr int NITEMS = I_IN + 2 * I_BA + I_OUT + I_WQ + 2 * I_UP + I_G;
    for (int it = gw; it < NITEMS; it += NGW) {
        int r = it;
        if (r < I_IN) { p0_transpose_item<true>(A->w_in, D, INW, (bf16_t*)(ws + WS_WIN), D, scr, r, F.lane); continue; } r -= I_IN;
        if (r < I_BA) { p0_transpose_item<false>(A->w_ba, RW, D, (bf16_t*)(ws + WS_WA), RW, scr, r, F.lane); continue; } r -= I_BA;
        if (r < I_BA) { p0_transpose_item<false>(A->w_bb, RW, D, (bf16_t*)(ws + WS_WB), RW, scr, r, F.lane); continue; } r -= I_BA;
        if (r < I_OUT) { p0_transpose_item<false>(A->w_out, D, D, (bf16_t*)(ws + WS_WOUT), D, scr, r, F.lane); continue; } r -= I_OUT;
        if (r < I_WQ) { p0_transpose_item<false>(A->peer_wq, D, 2048, (bf16_t*)(ws + WS_WQ), D, scr, r, F.lane); continue; } r -= I_WQ;
        if (r < I_UP) { p0_transpose_item<false>(A->w_up, LW, RW, (bf16_t*)(ws + WS_WUP), LW, scr, r, F.lane); continue; } r -= I_UP;
        if (r < I_UP) { p0_transpose_item<false>(A->a_up, LA, RW, (bf16_t*)(ws + WS_AUP), LA, scr, r, F.lane); continue; } r -= I_UP;
        p0_transpose_item<false>(A->g_up, LG, RW, (bf16_t*)(ws + WS_GUP), LGP, scr, r, F.lane);
    }
    const size_t gtid = (size_t)F.vcu * NTHR + F.tid, nthr = (size_t)F.G * NTHR;
    for (size_t i = gtid; i < (size_t)32 * D / 8; i += nthr) ((u32x4*)((bf16_t*)(ws + WS_WIN) + (size_t)SHIFTW * D))[i] = (u32x4){0u, 0u, 0u, 0u};
    cvt_table(A->peer_u, (bf16_t*)(ws + WS_PU), (size_t)16384 * D / 8, gtid, nthr);
    cvt_table(A->peer_v, (bf16_t*)(ws + WS_PV), (size_t)16384 * D / 8, gtid, nthr);
    cvt_table(A->sub_keys, (bf16_t*)(ws + WS_SUBK), (size_t)PH_ * 2 * PNK * PHALF / 8, gtid, nthr);
    for (size_t i = gtid; i < (size_t)T * 64; i += nthr) { const int pos = (int)(i >> 6), fi = (int)(i & 63); const float inv = powf(10000.0f, -(float)fi / 64.0f); const float ang = (float)pos * inv;
        ((f32x2*)(ws + WS_ROPE))[i] = (f32x2){cosf(ang), sinf(ang)}; }
    for (int m = gw; m < T; m += NGW) rms_row_to_bf16(A->x + (size_t)m * D, A->norm1_g, (bf16_t*)(ws + WS_XN) + (size_t)m * D, F.lane);
}

__device__ __forceinline__ f32x4 ld4bf(const bf16_t* p) { const u32x2 w = *(const u32x2*)p; return (f32x4){bflo(w.x), bfhi(w.x), bflo(w.y), bfhi(w.y)}; }
__device__ __forceinline__ void st4bf(bf16_t* p, f32x4 v) { u32x2 w; w.x = pk2(v[0], v[1]); w.y = pk2(v[2], v[3]); *(u32x2*)p = w; }
__device__ __forceinline__ void ph2_prep(ArgsP A, Frame& F) {
    unsigned char* ws = A->ws; const bf16_t* PROJ = (const bf16_t*)(ws + WS_PROJ);
    LAS float* red = (LAS float*)(F.lds + RING_OFF);
    for (int it = F.vcu; it < NBLK * MH; it += F.G) { const int n = it / MH, h = it % MH, d = F.tid & 127, part = F.tid >> 7;
        const bf16_t* p = PROJ + (size_t)(n * MBLK + part * 64) * PLD + PC_MK + h * MD + d; float s = 0.f;
#pragma unroll 8
        for (int i = 0; i < 64; ++i) s += bf1(p[(size_t)i * PLD]);
        red[F.tid] = s; WG_BAR();
        if (F.tid < 128) ((float*)(ws + WS_KMEAN))[(size_t)(n * MH + h) * MD + F.tid] = (red[F.tid] + red[F.tid + 128] + red[F.tid + 256] + red[F.tid + 384]) * (1.0f / MBLK);
        WG_BAR(); }
    const int tid = F.tid;
    for (int t = F.vcu; t < T; t += F.G) { const bf16_t* P = PROJ + (size_t)t * PLD; const bf16_t* PP = P - PLD; const bool hasp = t > 0; const f32x4 zero = (f32x4){0.f, 0.f, 0.f, 0.f};
        { const int c = 4 * tid; const f32x4 p = ld4bf(P + PC_R + c), pp = hasp ? ld4bf(PP + PC_R + c) : zero, mu = *(const f32x4*)(A->mu + PC_R + c); st4bf((bf16_t*)(ws + WS_ZR) + (size_t)t * RW + c, p + (pp - p) * mu); }
        { const int c = 4 * tid; const f32x4 p = ld4bf(P + PC_K + c), pp = hasp ? ld4bf(PP + PC_K + c) : zero, mu = *(const f32x4*)(A->mu + PC_K + c); const f32x4 zk = p + (pp - p) * mu;
          st4bf((bf16_t*)(ws + WS_KP) + (size_t)t * RW + c, zk); const f32x4 kk = zk * *(const f32x4*)(A->k_k + c);
          const float ss = sum16((kk[0] * kk[0] + kk[1] * kk[1]) + (kk[2] * kk[2] + kk[3] * kk[3])); const float inv = 1.0f / fmaxf(sqrtf(ss), 1e-12f);
          st4bf((bf16_t*)(ws + WS_KKN) + (size_t)t * RW + c, kk * inv); }
        { const int c = 4 * tid; const f32x4 p = ld4bf(P + PC_V + c), pp = hasp ? ld4bf(PP + PC_V + c) : zero, mu = *(const f32x4*)(A->mu + PC_V + c); st4bf((bf16_t*)(ws + WS_ZV) + (size_t)t * RW + c, p + (pp - p) * mu); }
        if (tid < 192) {
            int c, cc; if (tid < 32) { cc = 4 * tid; c = PC_WL + cc; } else if (tid < 64) { cc = 4 * (tid - 32); c = PC_AL + cc; } else { cc = 4 * (tid - 64); c = PC_GL + cc; }
            f32x4 z = zero;
            if (tid < 64 || cc < LG) { const f32x4 p = ld4bf(P + c), pp = hasp ? ld4bf(PP + c) : zero, mu = *(const f32x4*)(A->mu + c); z = p + (pp - p) * mu; }
            if (tid < 32) { f32x4 o;
#pragma unroll
                for (int e = 0; e < 4; ++e) o[e] = 1.0f - 2.0f * __builtin_amdgcn_rcpf(__expf(2.0f * z[e]) + 1.0f);
                st4bf((bf16_t*)(ws + WS_AW) + (size_t)t * LW + cc, o); }
            else if (tid < 64) st4bf((bf16_t*)(ws + WS_AA) + (size_t)t * LA + cc, z);
            else { f32x4 o = zero; if (cc < LG) {
#pragma unroll
                for (int e = 0; e < 4; ++e) o[e] = fsigmoid(z[e]); }
                st4bf((bf16_t*)(ws + WS_AG) + (size_t)t * LGP + cc, o); }
        }
    }
}

__device__ __forceinline__ void ph3_gate(ArgsP A, Frame& F) {
    unsigned char* ws = A->ws; const bf16_t* PROJ = (const bf16_t*)(ws + WS_PROJ); const float* KM = (const float*)(ws + WS_KMEAN); unsigned* MASK = (unsigned*)(ws + WS_MASK);
    const int gw = F.vcu * NWAVES + F.wave, NGW = F.G * NWAVES; const int hh = F.lane >> 5, n = F.lane & 31;
    for (int it = gw; it < T * (MH / 2); it += NGW) { const int t = it >> 3, h = 2 * (it & 7) + hh, blk = t >> 8;
        if (blk == 0) { if (n == 0) MASK[t * MH + h] = 0u; continue; }
        const bf16_t* q = PROJ + (size_t)t * PLD + PC_MQ + h * MD; const float* km = KM + (size_t)(n * MH + h) * MD; float acc = 0.f;
#pragma unroll 8
        for (int d = 0; d < MD; d += 4) { const f32x4 qv = ld4bf(q + d), kv = *(const f32x4*)(km + d); acc += (qv[0] * kv[0] + qv[1] * kv[1]) + (qv[2] * kv[2] + qv[3] * kv[3]); }
        const float NEG = -__builtin_inff(); float v = (n < blk) ? acc : NEG; unsigned sel = 0u; const int nsel = blk < 3 ? blk : 3;
        for (int k = 0; k < nsel; ++k) { float mx = v;
#pragma unroll
            for (int o = 1; o < 32; o <<= 1) mx = fmaxf(mx, __shfl_xor(mx, o));
            const unsigned long long b = __ballot(v == mx && v > NEG); const unsigned hb = (unsigned)(b >> (32 * hh));
            const int w = __ffs(hb) - 1; sel |= 1u << w; if (n == w) v = NEG; }
        if (n == 0) MASK[t * MH + h] = sel; }
}

constexpr int SC_CH = 32, SC_STEP = 1312, SC_BUF = SC_CH * SC_STEP, SC_YOFF = 2 * SC_BUF, SC_YBUF = SC_CH * 8 * 16 * 4;
static_assert(SC_YOFF + 2 * SC_YBUF <= RING_BYTES, "scan LDS");
__device__ __forceinline__ void ph4_scan(ArgsP A, Frame& F) {
    unsigned char* ws = A->ws;
    const float* DEC = (const float*)(ws + WS_DEC); const bf16_t* KKN = (const bf16_t*)(ws + WS_KKN); const bf16_t* BB = (const bf16_t*)(ws + WS_BB); const bf16_t* KP = (const bf16_t*)(ws + WS_KP);
    const bf16_t* ZR = (const bf16_t*)(ws + WS_ZR); const bf16_t* ZV = (const bf16_t*)(ws + WS_ZV); float* Y = (float*)(ws + WS_Y);
    LAS unsigned char* L = F.lds + RING_OFF;
    const int wave = F.wave, lane = F.lane;
    const bool scanner = wave < 2, loader = (wave == 2 || wave == 3 || wave == 6 || wave == 7);
    const int ltid = ((wave & 1) + ((wave >> 2) << 1)) * 64 + lane;
    for (int unit = F.vcu; unit < 256; unit += F.G) {
        const int h = unit >> 3, r0 = (unit & 7) * 8; const size_t hc = (size_t)h * RN;
        constexpr int NC = T / SC_CH;
        f32x4 ld_dec[2]; u32x4 ld_b[4]; u32x4 ld_v;
        auto issue = [&](int c) { const int t0 = c * SC_CH;
#pragma unroll
            for (int i = 0; i < 2; ++i) { const int q = ltid + 256 * i, st = q >> 4, c4 = q & 15; ld_dec[i] = *(const f32x4*)(DEC + (size_t)(t0 + st) * RW + hc + 4 * c4); }
            { const int st = ltid >> 3, c8 = ltid & 7; const size_t o = (size_t)(t0 + st) * RW + hc + 8 * c8; ld_b[0] = *(const u32x4*)(KKN + o); ld_b[1] = *(const u32x4*)(BB + o); ld_b[2] = *(const u32x4*)(KP + o); ld_b[3] = *(const u32x4*)(ZR + o); }
            if (ltid < SC_CH) ld_v = *(const u32x4*)(ZV + (size_t)(t0 + ltid) * RW + hc + r0); };
        auto commit = [&](int buf) { LAS unsigned char* B = L + buf * SC_BUF;
#pragma unroll
            for (int i = 0; i < 2; ++i) { const int q = ltid + 256 * i, st = q >> 4, c4 = q & 15; *(LAS f32x4*)(B + st * SC_STEP + 16 * c4) = ld_dec[i]; }
            { const int st = ltid >> 3, c8 = ltid & 7;
#pragma unroll
              for (int a = 0; a < 4; ++a) { f32x4 v0, v1; pg8::unpack8(ld_b[a], v0, v1); LAS unsigned char* p = B + st * SC_STEP + 256 * (a + 1) + 32 * c8; *(LAS f32x4*)p = v0; *(LAS f32x4*)(p + 16) = v1; } }
            if (ltid < SC_CH) { f32x4 v0, v1; pg8::unpack8(ld_v, v0, v1); LAS unsigned char* p = B + ltid * SC_STEP + 1280; *(LAS f32x4*)p = v0; *(LAS f32x4*)(p + 16) = v1; } };
        auto yflush = [&](int c) { const LAS unsigned char* YB = L + SC_YOFF + (c & 1) * SC_YBUF; const int st = ltid >> 3, rr = ltid & 7; const LAS f32x4* p = (const LAS f32x4*)(YB + (st * 8 + rr) * 64);
            const f32x4 a = p[0], b = p[1], cc = p[2], d = p[3]; const f32x4 s = (a + b) + (cc + d); Y[(size_t)(c * SC_CH + st) * RW + hc + r0 + rr] = (s[0] + s[1]) + (s[2] + s[3]); };
        if (loader) { issue(0); VM_WAIT(); commit(0); issue(1); }
        WG_BAR();
        float S0 = 0.f, S1 = 0.f, S2 = 0.f, S3 = 0.f;
        const int row = wave * 4 + (lane >> 4), j = lane & 15;
        for (int c = 0; c < NC; ++c) {
            if (scanner) {
                const LAS unsigned char* B = L + (c & 1) * SC_BUF + 16 * j; LAS float* yb = (LAS float*)(L + SC_YOFF + (c & 1) * SC_YBUF) + row * 16 + j;
                const LAS unsigned char* vb = L + (c & 1) * SC_BUF + 1280 + 4 * row;
                f32x4 w = *(const LAS f32x4*)(B), kk = *(const LAS f32x4*)(B + 256), bb = *(const LAS f32x4*)(B + 512), kp = *(const LAS f32x4*)(B + 768), rr = *(const LAS f32x4*)(B + 1024); float v = *(const LAS float*)(vb);
#pragma unroll 4
                for (int tt = 0; tt < SC_CH; ++tt) {
                    const int nx = (tt + 1 < SC_CH ? tt + 1 : tt) * SC_STEP;
                    const f32x4 w_n = *(const LAS f32x4*)(B + nx), kk_n = *(const LAS f32x4*)(B + nx + 256), bb_n = *(const LAS f32x4*)(B + nx + 512), kp_n = *(const LAS f32x4*)(B + nx + 768), rr_n = *(const LAS f32x4*)(B + nx + 1024);
                    const float v_n = *(const LAS float*)(vb + nx);
                    const float d = sum16((S0 * kk[0] + S1 * kk[1]) + (S2 * kk[2] + S3 * kk[3]));
                    const float sa = -d;
                    S0 = S0 * w[0] + sa * bb[0] + v * kp[0]; S1 = S1 * w[1] + sa * bb[1] + v * kp[1]; S2 = S2 * w[2] + sa * bb[2] + v * kp[2]; S3 = S3 * w[3] + sa * bb[3] + v * kp[3];
                    yb[tt * 128] = (S0 * rr[0] + S1 * rr[1]) + (S2 * rr[2] + S3 * rr[3]);
                    w = w_n; kk = kk_n; bb = bb_n; kp = kp_n; rr = rr_n; v = v_n;
                }
            } else if (loader) {
                if (c + 1 < NC) { VM_WAIT(); commit((c + 1) & 1); }
                if (c + 2 < NC) issue(c + 2);
                if (c > 0) yflush(c - 1);
            }
            WG_BAR();
        }
        if (loader) yflush(NC - 1);
        WG_BAR();
    }
}

__device__ __forceinline__ void ph5_ypost(ArgsP A, Frame& F) {
    unsigned char* ws = A->ws; const float* Y = (const float*)(ws + WS_Y); const bf16_t* ZR = (const bf16_t*)(ws + WS_ZR); const bf16_t* KP = (const bf16_t*)(ws + WS_KP); const bf16_t* ZV = (const bf16_t*)(ws + WS_ZV);
    const bf16_t* G = (const bf16_t*)(ws + WS_G); bf16_t* YA = (bf16_t*)(ws + WS_YA);
    const int gw = F.vcu * NWAVES + F.wave, NGW = F.G * NWAVES;
    for (int it = gw; it < T * 8; it += NGW) { const int t = it >> 3, c = (it & 7) * 256 + 4 * F.lane; const size_t o = (size_t)t * RW + c;
        const f32x4 y = *(const f32x4*)(Y + o); const float mean = sum16((y[0] + y[1]) + (y[2] + y[3])) * (1.0f / 64.0f); const f32x4 d = y - mean;
        const float var = sum16((d[0] * d[0] + d[1] * d[1]) + (d[2] * d[2] + d[3] * d[3])) * (1.0f / 64.0f); const float rs = 1.0f / sqrtf(var + LNX_EPS);
        const f32x4 r = ld4bf(ZR + o), k = ld4bf(KP + o), v = ld4bf(ZV + o), g = ld4bf(G + o), rk = *(const f32x4*)(A->r_k + c), lg = *(const f32x4*)(A->lnx_g + c), lb = *(const f32x4*)(A->lnx_b + c);
        const f32x4 rkk = r * k * rk; const float bonus = sum16((rkk[0] + rkk[1]) + (rkk[2] + rkk[3]));
        st4bf(YA + o, (d * rs * lg + lb + bonus * v) * g); }
}

constexpr int AT_KP = 272, AT_VP = 136, AT_KB = 64 * AT_KP, AT_VB = 128 * AT_VP, AT_BUF = AT_KB + AT_VB;
static_assert(2 * AT_BUF <= RING_BYTES, "attention LDS");
__device__ __forceinline__ void ph5_attn(ArgsP A, Frame& F) {
    unsigned char* ws = A->ws; const bf16_t* PROJ = (const bf16_t*)(ws + WS_PROJ); const bf16_t* VT = (const bf16_t*)(ws + WS_VT); const unsigned* MASK = (const unsigned*)(ws + WS_MASK); bf16_t* YB = (bf16_t*)(ws + WS_YB);
    LAS unsigned char* L = F.lds + RING_OFF; const int tid = F.tid, wave = F.wave, lane = F.lane, r = lane & 31, hh = lane >> 5;
    const float NEG = -__builtin_inff();
    for (int u = F.vcu; u < 256; u += F.G) { const int h = u >> 4, pr = u & 15;
      for (int half = 0; half < 2; ++half) { const int ib = half == 0 ? (31 - pr) : pr;
        const int q0 = ib * MBLK + wave * 32;
        bf16x8 qf[8];
#pragma unroll
        for (int ks = 0; ks < 8; ++ks) qf[ks] = *(const bf16x8*)(PROJ + (size_t)(q0 + r) * PLD + PC_MQ + h * MD + 16 * ks + 8 * hh);
        const unsigned msk = MASK[(q0 + r) * MH + h];
        f32x16 o[4];
#pragma unroll
        for (int db = 0; db < 4; ++db)
#pragma unroll
            for (int e = 0; e < 16; ++e) o[db][e] = 0.f;
        float mrun = NEG, lrun = 0.f;
        const int ntile = 4 + 4 * ib;
        u32x4 sk[2], sv[2];
        auto tile_tok = [&](int n) { return n < 4 ? ib * MBLK + n * 64 : ((n - 4) >> 2) * MBLK + ((n - 4) & 3) * 64; };
        auto issue = [&](int n) { const int tb = tile_tok(n);
#pragma unroll
            for (int i = 0; i < 2; ++i) { const int row = (tid >> 4) + 32 * i, c16 = tid & 15; sk[i] = *(const u32x4*)(PROJ + (size_t)(tb + row) * PLD + PC_MK + h * MD + 8 * c16); }
#pragma unroll
            for (int i = 0; i < 2; ++i) { const int row = (tid >> 3) + 64 * i, c16 = tid & 7; sv[i] = *(const u32x4*)(VT + (size_t)(h * MD + row) * T + tb + 8 * c16); } };
        auto commit = [&](int buf) { LAS unsigned char* B = L + buf * AT_BUF;
#pragma unroll
            for (int i = 0; i < 2; ++i) { const int row = (tid >> 4) + 32 * i, c16 = tid & 15; *(LAS u32x4*)(B + row * AT_KP + 16 * c16) = sk[i]; }
#pragma unroll
            for (int i = 0; i < 2; ++i) { const int row = (tid >> 3) + 64 * i, c16 = tid & 7; LAS unsigned char* p = B + AT_KB + row * AT_VP + 16 * c16; *(LAS u32x2*)p = (u32x2){sv[i].x, sv[i].y}; *(LAS u32x2*)(p + 8) = (u32x2){sv[i].z, sv[i].w}; } };
        issue(0); VM_WAIT(); commit(0); WG_BAR();
        for (int n = 0; n < ntile; ++n) {
            if (n + 1 < ntile) issue(n + 1);
            bool need; int jblk = -1, tt = 0;
            if (n < 4) { tt = n; need = tt <= (wave >> 1); } else { jblk = (n - 4) >> 2; need = __ballot((msk >> jblk) & 1u) != 0ull; }
            if (need) {
                const LAS unsigned char* KB = L + (n & 1) * AT_BUF; const LAS unsigned char* VB = KB + AT_KB;
                f32x16 s[2];
#pragma unroll
                for (int kb = 0; kb < 2; ++kb) {
#pragma unroll
                    for (int e = 0; e < 16; ++e) s[kb][e] = 0.f;
#pragma unroll
                    for (int ks = 0; ks < 8; ++ks) { const bf16x8 a = *(const LAS bf16x8*)(KB + (32 * kb + r) * AT_KP + 32 * ks + 16 * hh); s[kb] = __builtin_amdgcn_mfma_f32_32x32x16_bf16(a, qf[ks], s[kb], 0, 0, 0); } }
                if (n < 4) { const int qrel = wave * 32 + r;
#pragma unroll
                    for (int kb = 0; kb < 2; ++kb)
#pragma unroll
                        for (int e = 0; e < 16; ++e) { const int krel = 64 * tt + 32 * kb + (e & 3) + 8 * (e >> 2) + 4 * hh; if (krel > qrel) s[kb][e] = NEG; } }
                else if (!((msk >> jblk) & 1u)) {
#pragma unroll
                    for (int kb = 0; kb < 2; ++kb)
#pragma unroll
                        for (int e = 0; e < 16; ++e) s[kb][e] = NEG; }
                float mx = s[0][0];
#pragma unroll
                for (int kb = 0; kb < 2; ++kb)
#pragma unroll
                    for (int e = 0; e < 16; ++e) mx = fmaxf(mx, s[kb][e]);
                mx = fmaxf(mx, __shfl_xor(mx, 32));
                const float mnew = fmaxf(mrun, mx); const float alpha = exp2f(mrun - mnew); mrun = mnew;
                float ps = 0.f;
#pragma unroll
                for (int kb = 0; kb < 2; ++kb)
#pragma unroll
                    for (int e = 0; e < 16; ++e) { const float p = exp2f(s[kb][e] - mnew); s[kb][e] = p; ps += p; }
                lrun = lrun * alpha + ps;
#pragma unroll
                for (int db = 0; db < 4; ++db)
#pragma unroll
                    for (int e = 0; e < 16; ++e) o[db][e] *= alpha;
#pragma unroll
                for (int kb = 0; kb < 2; ++kb)
#pragma unroll
                    for (int st = 0; st < 2; ++st) { u32x4 pw; pw.x = pk2(s[kb][8 * st + 0], s[kb][8 * st + 1]); pw.y = pk2(s[kb][8 * st + 2], s[kb][8 * st + 3]); pw.z = pk2(s[kb][8 * st + 4], s[kb][8 * st + 5]); pw.w = pk2(s[kb][8 * st + 6], s[kb][8 * st + 7]);
                        const bf16x8 pf = __builtin_bit_cast(bf16x8, pw); const int kbase = 32 * kb + 16 * st + 4 * hh;
#pragma unroll
                        for (int db = 0; db < 4; ++db) { const LAS unsigned char* vp = VB + (32 * db + r) * AT_VP + 2 * kbase; const u32x2 lo = *(const LAS u32x2*)vp, hi = *(const LAS u32x2*)(vp + 16);
                            const bf16x8 vf = __builtin_bit_cast(bf16x8, (u32x4){lo.x, lo.y, hi.x, hi.y}); o[db] = __builtin_amdgcn_mfma_f32_32x32x16_bf16(vf, pf, o[db], 0, 0, 0); } }
            }
            if (n + 1 < ntile) { VM_WAIT(); commit((n + 1) & 1); }
            WG_BAR();
        }
        const float ltot = lrun + __shfl_xor(lrun, 32); const float inv = 1.0f / ltot;
        bf16_t* op = YB + (size_t)(q0 + r) * RW + h * MD;
#pragma unroll
        for (int db = 0; db < 4; ++db)
#pragma unroll
            for (int g = 0; g < 4; ++g) { u32x2 w; w.x = pk2(o[db][4 * g] * inv, o[db][4 * g + 1] * inv); w.y = pk2(o[db][4 * g + 2] * inv, o[db][4 * g + 3] * inv); *(u32x2*)(op + 32 * db + 8 * g + 4 * hh) = w; }
      }
    }
}

__device__ __forceinline__ void ins16(float (&top)[16], float x) {
#pragma unroll
    for (int k = 15; k >= 1; --k) top[k] = __builtin_amdgcn_fmed3f(top[k - 1], top[k], x);
    top[0] = fmaxf(top[0], x);
}
__device__ __forceinline__ void ph10_select(ArgsP A, Frame& F) {
    unsigned char* ws = A->ws; const bf16_t* PQ = (const bf16_t*)(ws + WS_PQ); const bf16_t* SK = (const bf16_t*)(ws + WS_SUBK); int* IDX = (int*)(ws + WS_IDX); float* GW = (float*)(ws + WS_GW);
    const int gw = F.vcu * NWAVES + F.wave, NGW = F.G * NWAVES; const int r = F.lane & 31, hh = F.lane >> 5; const float NEG = -__builtin_inff();
    for (int it = gw; it < (T / 32) * PH_; it += NGW) { const int tg = it >> 3, h = it & 7, t = tg * 32 + r;
        float TA[16], TB[16];
        auto topk = [&](int p, float (&dst)[16]) {
            bf16x8 qf[8];
#pragma unroll
            for (int ks = 0; ks < 8; ++ks) qf[ks] = *(const bf16x8*)(PQ + (size_t)t * 2048 + (h * 2 + p) * PHALF + 16 * ks + 8 * hh);
            float top[16];
#pragma unroll
            for (int k = 0; k < 16; ++k) top[k] = NEG;
#pragma unroll 1
            for (int nb = 0; nb < 4; ++nb) { f32x16 acc;
#pragma unroll
                for (int e = 0; e < 16; ++e) acc[e] = 0.f;
#pragma unroll
                for (int ks = 0; ks < 8; ++ks) { const bf16x8 a = *(const bf16x8*)(SK + ((size_t)(h * 2 + p) * PNK + 32 * nb + r) * PHALF + 16 * ks + 8 * hh); acc = __builtin_amdgcn_mfma_f32_32x32x16_bf16(a, qf[ks], acc, 0, 0, 0); }
#pragma unroll
                for (int e = 0; e < 16; ++e) { const unsigned key = 32 * nb + (e & 3) + 8 * (e >> 2) + 4 * hh; float ae = acc[e]; asm volatile("" : "+v"(ae));
                    const float x = __builtin_bit_cast(float, (__builtin_bit_cast(unsigned, ae) & ~0x7Fu) | key); ins16(top, x); } }
            float oth[16];
#pragma unroll
            for (int k = 0; k < 16; ++k) oth[k] = __shfl_xor(top[k], 32);
#pragma unroll
            for (int k = 0; k < 16; ++k) ins16(top, oth[k]);
#pragma unroll
            for (int k = 0; k < 16; ++k) dst[k] = top[k];
        };
        topk(0, TA); asm volatile("" ::: "memory"); __builtin_amdgcn_sched_barrier(0); topk(1, TB); asm volatile("" ::: "memory"); __builtin_amdgcn_sched_barrier(0);
        float fin[16];
#pragma unroll
        for (int k = 0; k < 16; ++k) fin[k] = NEG;
#pragma unroll
        for (int i = 0; i < 16; ++i)
#pragma unroll
            for (int j = 0; j < 16; ++j) if ((i + 1) * (j + 1) <= 16) { const float sm = TA[i] + TB[j]; ins16(fin, __builtin_bit_cast(float, (__builtin_bit_cast(unsigned, sm) & ~0xFFu) | (unsigned)(i * 16 + j))); }
        float e[16], den = 0.f;
#pragma unroll
        for (int k = 0; k < 16; ++k) { e[k] = __expf(fin[k] - fin[0]); den += e[k]; }
        const float rden = 1.0f / den;
        int oi[8]; float og[8];
#pragma unroll
        for (int kk = 0; kk < 8; ++kk) { const float fv = hh ? fin[8 + kk] : fin[kk]; og[kk] = (hh ? e[8 + kk] : e[kk]) * rden; const unsigned id = __builtin_bit_cast(unsigned, fv) & 0xFFu; const unsigned ci = id >> 4, cj = id & 15u;
            unsigned ia = 0u, ib = 0u;
#pragma unroll
            for (int q = 0; q < 16; ++q) { ia = (ci == (unsigned)q) ? (__builtin_bit_cast(unsigned, TA[q]) & 0x7Fu) : ia; ib = (cj == (unsigned)q) ? (__builtin_bit_cast(unsigned, TB[q]) & 0x7Fu) : ib; }
            oi[kk] = (int)(ia * PNK + ib); }
        int* ip = IDX + (size_t)t * 128 + h * 16 + 8 * hh; float* gp = GW + (size_t)t * 128 + h * 16 + 8 * hh;
        *(u32x4*)ip = (u32x4){(unsigned)oi[0], (unsigned)oi[1], (unsigned)oi[2], (unsigned)oi[3]}; *(u32x4*)(ip + 4) = (u32x4){(unsigned)oi[4], (unsigned)oi[5], (unsigned)oi[6], (unsigned)oi[7]};
        *(f32x4*)gp = (f32x4){og[0], og[1], og[2], og[3]}; *(f32x4*)(gp + 4) = (f32x4){og[4], og[5], og[6], og[7]};
    }
}


__device__ __forceinline__ void ph10_select_ref(ArgsP A, Frame& F) {
    unsigned char* ws = A->ws; const bf16_t* PQ = (const bf16_t*)(ws + WS_PQ); const float* SKF = A->sub_keys; int* IDX = (int*)(ws + WS_IDX); float* GW = (float*)(ws + WS_GW);
    LAS float* sc = (LAS float*)(F.lds + RING_OFF);
    LAS float* tv = sc + 2048;
    LAS int* ti = (LAS int*)(tv + 256);
    LAS float* cand = tv + 512;
    const float NEG = -__builtin_inff();
    for (int t = F.vcu; t < T; t += F.G) {
        for (int i = 0; i < 4; ++i) { const int idx = F.tid + 512 * i, hp = idx >> 7, n = idx & 127; const bf16_t* q = PQ + (size_t)t * 2048 + hp * 128; const float* k = SKF + ((size_t)hp * 128 + n) * 128; float a = 0.f;
            for (int d = 0; d < 128; ++d) a += bf1(q[d]) * k[d];
            sc[idx] = a; }
        WG_BAR();
        if (F.tid < 16) { const int hp = F.tid;
            for (int k = 0; k < 16; ++k) { float best = NEG; int bi = 0; for (int n = 0; n < 128; ++n) { const float v = sc[hp * 128 + n]; if (v > best) { best = v; bi = n; } }
                tv[hp * 16 + k] = best; ti[hp * 16 + k] = bi; sc[hp * 128 + bi] = NEG; } }
        WG_BAR();
        if (F.tid < 8) { const int h = F.tid;
            for (int i = 0; i < 16; ++i) for (int j = 0; j < 16; ++j) cand[h * 256 + i * 16 + j] = tv[(2 * h) * 16 + i] + tv[(2 * h + 1) * 16 + j];
            float fs[16]; float mx = NEG;
            for (int k = 0; k < 16; ++k) { float best = NEG; int bi = 0; for (int c = 0; c < 256; ++c) { const float v = cand[h * 256 + c]; if (v > best) { best = v; bi = c; } }
                cand[h * 256 + bi] = NEG; tv[h * 32 + k] = best; ti[256 + h * 16 + k] = ti[(2 * h) * 16 + (bi >> 4)] * 128 + ti[(2 * h + 1) * 16 + (bi & 15)]; }
        }
        WG_BAR();
        if (F.tid < 8) { const int h = F.tid; float den = 0.f; const float m0 = tv[h * 32];
            for (int k = 0; k < 16; ++k) den += __expf(tv[h * 32 + k] - m0);
            for (int k = 0; k < 16; ++k) { GW[(size_t)t * 128 + h * 16 + k] = __expf(tv[h * 32 + k] - m0) / den; IDX[(size_t)t * 128 + h * 16 + k] = ti[256 + h * 16 + k]; } }
        WG_BAR();
    }
}

__device__ __forceinline__ float dot8(u32x4 a, u32x4 b) {
    return (bflo(a.x) * bflo(b.x) + bfhi(a.x) * bfhi(b.x)) + (bflo(a.y) * bflo(b.y) + bfhi(a.y) * bfhi(b.y)) + (bflo(a.z) * bflo(b.z) + bfhi(a.z) * bfhi(b.z)) + (bflo(a.w) * bflo(b.w) + bfhi(a.w) * bfhi(b.w));
}
__device__ __forceinline__ void ph11_gather(ArgsP A, Frame& F) {
    unsigned char* ws = A->ws; const bf16_t* H2 = (const bf16_t*)(ws + WS_H2); const bf16_t* PU = (const bf16_t*)(ws + WS_PU); const bf16_t* PV = (const bf16_t*)(ws + WS_PV);
    const int* IDX = (const int*)(ws + WS_IDX); const float* GW = (const float*)(ws + WS_GW); const float* X1 = (const float*)(ws + WS_X1);
    LAS float* coef = (LAS float*)(F.lds + RING_OFF); LAS int* eidx = (LAS int*)(F.lds + RING_OFF + 1024); LAS float* red = (LAS float*)(F.lds + RING_OFF + 2048);
    const int tid = F.tid, wave = F.wave, lane = F.lane; int par = 0;
    for (int t = F.vcu; t < T; t += F.G, par ^= 1) {
        u32x4 hv[8];
#pragma unroll
        for (int i = 0; i < 8; ++i) hv[i] = *(const u32x4*)(H2 + (size_t)t * D + i * 512 + lane * 8);
        const int myidx = (lane < 16) ? IDX[(size_t)t * 128 + wave * 16 + lane] : 0; const float myg = (lane < 16) ? GW[(size_t)t * 128 + wave * 16 + lane] : 0.f;
        float dots = 0.f;
#pragma unroll 2
        for (int k = 0; k < 16; k += 2) {
            const int e0 = __builtin_amdgcn_readlane(myidx, k), e1 = __builtin_amdgcn_readlane(myidx, k + 1);
            const bf16_t* u0 = PU + (size_t)e0 * D + lane * 8; const bf16_t* u1 = PU + (size_t)e1 * D + lane * 8;
            u32x4 a[8], b[8];
#pragma unroll
            for (int i = 0; i < 8; ++i) { a[i] = *(const u32x4*)(u0 + i * 512); b[i] = *(const u32x4*)(u1 + i * 512); }
            float d0 = 0.f, d1 = 0.f;
#pragma unroll
            for (int i = 0; i < 8; ++i) { d0 += dot8(a[i], hv[i]); d1 += dot8(b[i], hv[i]); }
            d0 = wave_sum(d0); d1 = wave_sum(d1);
            if (lane == k) dots = d0; if (lane == k + 1) dots = d1;
        }
        if (lane < 16) { const float act = 0.5f * dots * (1.0f + erff(dots * 0.70710678118654752f)); coef[par * 128 + wave * 16 + lane] = myg * act; eidx[par * 128 + wave * 16 + lane] = myidx; }
        WG_BAR();
        float acc[8];
#pragma unroll
        for (int i = 0; i < 8; ++i) acc[i] = 0.f;
#pragma unroll 1
        for (int e = 0; e < 128; e += 8) { u32x4 v[8]; float c[8];
#pragma unroll
            for (int q = 0; q < 8; ++q) { const int ei = __builtin_amdgcn_readfirstlane(eidx[par * 128 + e + q]); c[q] = coef[par * 128 + e + q]; v[q] = *(const u32x4*)(PV + (size_t)ei * D + tid * 8); }
#pragma unroll
            for (int q = 0; q < 8; ++q) { acc[0] += c[q] * bflo(v[q].x); acc[1] += c[q] * bfhi(v[q].x); acc[2] += c[q] * bflo(v[q].y); acc[3] += c[q] * bfhi(v[q].y); acc[4] += c[q] * bflo(v[q].z); acc[5] += c[q] * bfhi(v[q].z); acc[6] += c[q] * bflo(v[q].w); acc[7] += c[q] * bfhi(v[q].w); } }
        const f32x4 x0 = *(const f32x4*)(X1 + (size_t)t * D + tid * 8), x1 = *(const f32x4*)(X1 + (size_t)t * D + tid * 8 + 4);
#ifdef DBG_NO_PEER
        f32x4 y0 = x0, y1 = x1;
#else
        f32x4 y0 = x0 + (f32x4){acc[0], acc[1], acc[2], acc[3]}, y1 = x1 + (f32x4){acc[4], acc[5], acc[6], acc[7]};
#endif
        float ss = (y0[0] * y0[0] + y0[1] * y0[1]) + (y0[2] * y0[2] + y0[3] * y0[3]) + (y1[0] * y1[0] + y1[1] * y1[1]) + (y1[2] * y1[2] + y1[3] * y1[3]);
        ss = wave_sum(ss); if (lane == 0) red[par * 8 + wave] = ss;
        WG_BAR();
        float tot = 0.f;
#pragma unroll
        for (int w = 0; w < 8; ++w) tot += red[par * 8 + w];
        const float rs = 1.0f / sqrtf(tot * (1.0f / D) + NORM_EPS);
        const f32x4 g0 = *(const f32x4*)(A->final_g + tid * 8), g1 = *(const f32x4*)(A->final_g + tid * 8 + 4);
        *(f32x4*)(A->out + (size_t)t * D + tid * 8) = y0 * rs * g0; *(f32x4*)(A->out + (size_t)t * D + tid * 8 + 4) = y1 * rs * g1;
    }
}

constexpr int NPH = 12;
__device__ __forceinline__ Frame make_frame(unsigned char* lds) {
    Frame F; int t = threadIdx.x; asm volatile("" : "+v"(t));
    F.lds = (LAS unsigned char*)lds; F.tid = t; F.lane = t & 63; F.wave = __builtin_amdgcn_readfirstlane(t >> 6);
    F.G = gridDim.x; { const int bx = blockIdx.x; F.vcu = (F.G % 8 == 0) ? (bx % 8) * (F.G / 8) + bx / 8 : bx; }
    return F;
}
__global__ void __launch_bounds__(NTHR, 2) mk_fwd(Args args_by_value) {
    extern __shared__ __attribute__((aligned(16))) unsigned char lds[];
    ArgsP args = get_args();
    gu32* ctl = (gu32*)(args->ws + WS_CTL);
    for (int u = threadIdx.x; u < (LDS_BYTES - LDSCTL_OFF) / 4; u += NTHR) ((LAS unsigned*)((LAS unsigned char*)lds + LDSCTL_OFF))[u] = 0u;
    __syncthreads();
    const int lo = args->ph_lo, hi = args->ph_hi;
    volatile LAS unsigned* MISC = (volatile LAS unsigned*)((LAS unsigned char*)lds + MISC_OFF);
    XcdBarrier bar; bar.bar = (unsigned*)(ctl + CW_BAR) + args->li * XCD_BAR_WORDS; bar.x = 0; bar.st = nullptr;
    if (hi - lo > 1) bar = xcd_barrier_post((unsigned*)(ctl + CW_BAR) + args->li * XCD_BAR_WORDS, MISC + 8);
#define IN(k) (lo <= (k) && (k) < hi)
#define SEAM(k) do { if (IN(k) && IN((k) + 1)) xcd_barrier(bar); } while (0)
    const int bid = (int)blockIdx.x;

    if (IN(0)) { Frame F = make_frame(lds); ph0_prologue(get_args(), F); SEAM(0); }
    if (IN(1)) { Frame F = make_frame(lds); LAS unsigned char* ring = F.lds + RING_OFF; ArgsP a_ = get_args(); unsigned char* ws = a_->ws;
        { pg8::Gemm g{(const bf16_t*)(ws + WS_XN), (const bf16_t*)(ws + WS_WIN), T, PLD, D}; pg8::StaticOrder S; S.init(T, PLD, F.G, bid);
          pg8::EpiProj E{(bf16_t*)(ws + WS_PROJ), (const float*)(ws + WS_ROPE)}; pg8::gemm_phase<pg8::EpiProj, pg8::StaticOrder, true, true>(ring, g, S, E); }
        { pg8::Gemm g{(const bf16_t*)(ws + WS_XN), (const bf16_t*)(ws + WS_WIN) + (size_t)PC_MV * D, T, 2048, D}; pg8::StaticOrder S; S.init(T, 2048, F.G, bid);
          pg8::EpiVT E{(bf16_t*)(ws + WS_VT)}; pg8::gemm_phase<pg8::EpiVT, pg8::StaticOrder, true, true>(ring, g, S, E); }
        SEAM(1); }
    if (IN(2)) { Frame F = make_frame(lds); ph2_prep(get_args(), F); SEAM(2); }
    if (IN(3)) { Frame F = make_frame(lds); LAS unsigned char* ring = F.lds + RING_OFF; ArgsP a_ = get_args(); unsigned char* ws = a_->ws;
        { pg8::Gemm g{(const bf16_t*)(ws + WS_AW), (const bf16_t*)(ws + WS_WUP), T, RW, LW}; pg8::StaticOrder S; S.init(T, RW, F.G, bid);
          pg8::EpiDec E{(float*)(ws + WS_DEC), a_->w0}; pg8::gemm_phase<pg8::EpiDec, pg8::StaticOrder, true, true>(ring, g, S, E); }
        asm volatile("" ::: "memory"); __builtin_amdgcn_sched_barrier(0);
        { pg8::Gemm g{(const bf16_t*)(ws + WS_AA), (const bf16_t*)(ws + WS_AUP), T, RW, LA}; pg8::StaticOrder S; S.init(T, RW, F.G, bid);
          pg8::EpiA E{(bf16_t*)(ws + WS_KP), (bf16_t*)(ws + WS_BB), (const bf16_t*)(ws + WS_KKN), a_->a0, a_->k_a}; pg8::gemm_phase<pg8::EpiA, pg8::StaticOrder, true, true>(ring, g, S, E); }
        asm volatile("" ::: "memory"); __builtin_amdgcn_sched_barrier(0);
        { pg8::Gemm g{(const bf16_t*)(ws + WS_AG), (const bf16_t*)(ws + WS_GUP), T, RW, LGP}; pg8::StaticOrder S; S.init(T, RW, F.G, bid);
          pg8::EpiBf16 E{(bf16_t*)(ws + WS_G), RW}; pg8::gemm_phase<pg8::EpiBf16, pg8::StaticOrder, true, true>(ring, g, S, E); }
        { Frame F2 = make_frame(lds); ph3_gate(get_args(), F2); }
        SEAM(3); }
    if (IN(4)) { Frame F = make_frame(lds); ph4_scan(get_args(), F); SEAM(4); }
    if (IN(5)) { { Frame F = make_frame(lds); ph5_ypost(get_args(), F); } { Frame F = make_frame(lds); ph5_attn(get_args(), F); } SEAM(5); }
    if (IN(6)) { Frame F = make_frame(lds); LAS unsigned char* ring = F.lds + RING_OFF; ArgsP a_ = get_args(); unsigned char* ws = a_->ws;
        { pg8::Gemm g{(const bf16_t*)(ws + WS_YA), (const bf16_t*)(ws + WS_WA), T, D, RW}; pg8::StaticOrder S; S.init(T, D, F.G, bid);
          pg8::EpiMix<false> E{(bf16_t*)(ws + WS_MIXED), (const bf16_t*)(ws + WS_PROJ), PC_GA}; pg8::gemm_phase<pg8::EpiMix<false>, pg8::StaticOrder, true, true>(ring, g, S, E); }
        { pg8::Gemm g{(const bf16_t*)(ws + WS_YB), (const bf16_t*)(ws + WS_WB), T, D, RW}; pg8::StaticOrder S; S.init(T, D, F.G, bid);
          pg8::EpiMix<true> E{(bf16_t*)(ws + WS_MIXED), (const bf16_t*)(ws + WS_PROJ), PC_GB}; pg8::gemm_phase<pg8::EpiMix<true>, pg8::StaticOrder, true, true>(ring, g, S, E); }
        SEAM(6); }
    if (IN(7)) { Frame F = make_frame(lds); LAS unsigned char* ring = F.lds + RING_OFF; ArgsP a_ = get_args(); unsigned char* ws = a_->ws;
        pg8::Gemm g{(const bf16_t*)(ws + WS_MIXED), (const bf16_t*)(ws + WS_WOUT), T, D, D}; pg8::StaticOrder S; S.init(T, D, F.G, bid);
        pg8::EpiRes E{(float*)(ws + WS_X1), a_->x}; pg8::gemm_phase<pg8::EpiRes, pg8::StaticOrder, true, true>(ring, g, S, E);
        SEAM(7); }
    if (IN(8)) { Frame F = make_frame(lds); ArgsP a_ = get_args(); unsigned char* ws = a_->ws; const int gw = F.vcu * NWAVES + F.wave, NGW = F.G * NWAVES;
        for (int m = gw; m < T; m += NGW) rms_row_to_bf16((const float*)(ws + WS_X1) + (size_t)m * D, a_->norm2_g, (bf16_t*)(ws + WS_H2) + (size_t)m * D, F.lane);
        SEAM(8); }
    if (IN(9)) { Frame F = make_frame(lds); LAS unsigned char* ring = F.lds + RING_OFF; ArgsP a_ = get_args(); unsigned char* ws = a_->ws;
        pg8::Gemm g{(const bf16_t*)(ws + WS_H2), (const bf16_t*)(ws + WS_WQ), T, 2048, D}; pg8::StaticOrder S; S.init(T, 2048, F.G, bid);
        pg8::EpiBf16 E{(bf16_t*)(ws + WS_PQ), 2048}; pg8::gemm_phase<pg8::EpiBf16, pg8::StaticOrder, true, true>(ring, g, S, E);
        SEAM(9); }
#ifdef DBG_SELECT_REF
    if (IN(10)) { Frame F = make_frame(lds); ph10_select_ref(get_args(), F); SEAM(10); }
#else
    if (IN(10)) { Frame F = make_frame(lds); ph10_select(get_args(), F); SEAM(10); }
#endif
    if (IN(11)) { Frame F = make_frame(lds); ph11_gather(get_args(), F); }
#undef IN
#undef SEAM
}

extern "C" void kernel_launch(void* const* d_in, const int* in_sizes, int n_in, void* d_out, int out_size, void* d_ws, size_t ws_size, hipStream_t stream) {
    static int grid = 0;
    if (grid == 0) {
        if (n_in != 23 || out_size != T * D || ws_size < WS_END) { fprintf(stderr, "kernel_launch: unexpected shapes (n_in %d out %d ws %zu); nothing launched\n", n_in, out_size, ws_size); grid = -1; return; }
        int dev = 0, cus = 0, per_cu = 0;
        if (hipGetDevice(&dev) != hipSuccess || hipDeviceGetAttribute(&cus, hipDeviceAttributeMultiprocessorCount, dev) != hipSuccess) { grid = -1; return; }
        if (hipFuncSetAttribute((const void*)mk_fwd, hipFuncAttributeMaxDynamicSharedMemorySize, LDS_BYTES) != hipSuccess) { grid = -1; return; }
        if (hipOccupancyMaxActiveBlocksPerMultiprocessor(&per_cu, (const void*)mk_fwd, NTHR, LDS_BYTES) != hipSuccess || per_cu < 1) fprintf(stderr, "kernel_launch: occupancy query reports %d\n", per_cu);
        (void)hipGetLastError();
        grid = cus;
    }
    if (grid < 0) return;
    (void)hipMemsetAsync((char*)d_ws + WS_CTL, 0, CTL_ZERO_BYTES, stream);
    Args a{};
    const float** ap = (const float**)&a;
    for (int i = 0; i < 23; ++i) ap[i] = (const float*)d_in[i];
    a.out = (float*)d_out; a.ws = (unsigned char*)d_ws; a.pad = 0;
    constexpr int NL = MK_N_LAUNCHES;
    for (int li = 0; li < NL; ++li) {
        a.ph_lo = (NL == 1) ? 0 : li; a.ph_hi = (NL == 1) ? NPH : li + 1; a.li = (NL == 1) ? 0 : 0;
        hipLaunchKernelGGL(mk_fwd, dim3(grid), dim3(NTHR), LDS_BYTES, stream, a);
    }
}
```

```cpp
#include <hip/hip_runtime.h>
#include <cstdio>
#include <cstdint>

#ifndef MK_N_LAUNCHES
#define MK_N_LAUNCHES 1
#endif

#define GAS __attribute__((address_space(1)))
#define LAS __attribute__((address_space(3)))
typedef unsigned short bf16_t;
typedef __bf16 bf16x8 __attribute__((ext_vector_type(8)));
typedef float f32x2 __attribute__((ext_vector_type(2)));
typedef float f32x4 __attribute__((ext_vector_type(4)));
typedef float f32x16 __attribute__((ext_vector_type(16)));
typedef unsigned u32x2 __attribute__((ext_vector_type(2)));
typedef unsigned u32x4 __attribute__((ext_vector_type(4)));
typedef GAS unsigned gu32;

constexpr int T = 8192, D = 4096;
constexpr int RW = 2048, RH = 32, RN = 64;
constexpr int LW = 128, LA = 128, LG = 480, LGP = 512;
constexpr int SHIFTW = 6880;
constexpr int MH = 16, MD = 128, MBLK = 256, NBLK = 32;
constexpr int INW = 21216;
constexpr int PLD = 19200;
constexpr int PC_R = 0, PC_K = 2048, PC_V = 4096, PC_WL = 6144, PC_AL = 6272, PC_GL = 6400, PC_MQ = 6912, PC_MK = 8960, PC_GA = 11008, PC_GB = 15104, PC_MV = 19200;
constexpr int WIN_ROWS = 21248;
constexpr int PH_ = 8, PNK = 128, PQD = 256, PHALF = 128, PTOPK = 16;
constexpr float NORM_EPS = 1e-6f, LNX_EPS = 64e-5f;
constexpr float QSCALE = 0.08838834764831845f * 1.4426950408889634f;

constexpr size_t MiB = 1u << 20;
constexpr size_t WS_CTL = 0, CTL_ZERO_BYTES = 1 * MiB;
constexpr size_t WS_WIN = 1 * MiB;
constexpr size_t WS_X1 = 1 * MiB, WS_PQ = 129 * MiB;
constexpr size_t WS_WA = 167 * MiB, WS_WB = 183 * MiB, WS_WOUT = 199 * MiB, WS_WQ = 231 * MiB, WS_WUP = 247 * MiB, WS_AUP = 248 * MiB, WS_GUP = 249 * MiB, WS_SUBK = 251 * MiB;
constexpr size_t WS_PU = 252 * MiB, WS_PV = 380 * MiB;
constexpr size_t WS_XN = 508 * MiB;
constexpr size_t WS_Y = 508 * MiB, WS_H2 = 508 * MiB;
constexpr size_t WS_PROJ = 572 * MiB;
constexpr size_t WS_VT = 872 * MiB;
constexpr size_t WS_ROPE = 904 * MiB, WS_KMEAN = 908 * MiB, WS_MASK = 909 * MiB, WS_AW = 910 * MiB, WS_AA = 912 * MiB, WS_AG = 914 * MiB;
constexpr size_t WS_PSU = 909 * MiB + 512 * 1024, WS_PSV = WS_PSU + 64 * 1024;
constexpr size_t WS_DEC = 922 * MiB;
constexpr size_t WS_MIXED = 922 * MiB;
constexpr size_t WS_KKN = 986 * MiB, WS_BB = 1018 * MiB, WS_KP = 1050 * MiB, WS_ZR = 1082 * MiB, WS_ZV = 1114 * MiB, WS_G = 1146 * MiB;
constexpr size_t WS_YA = 1178 * MiB, WS_YB = 1210 * MiB, WS_IDX = 1242 * MiB, WS_GW = 1246 * MiB, WS_END = 1250 * MiB;

constexpr int CW_TMO = 0, CW_CODE = 1, CW_BAR = 4096;

constexpr int RING_OFF = 0, RING_BYTES = 131072;
constexpr int LDSCTL_OFF = RING_BYTES, MISC_OFF = LDSCTL_OFF + 320;
constexpr int LDS_BYTES = 147456;
constexpr int NWAVES = 8, NTHR = 512;

__device__ __forceinline__ unsigned f2bf(float f) { unsigned u = __builtin_bit_cast(unsigned, f); return (u + 0x7fffu + ((u >> 16) & 1u)) >> 16; }
__device__ __forceinline__ unsigned pk2(float lo, float hi) { unsigned r; asm volatile("v_cvt_pk_bf16_f32 %0, %1, %2" : "=v"(r) : "v"(lo), "v"(hi)); return r; }
__device__ __forceinline__ float bflo(unsigned u) { return __builtin_bit_cast(float, u << 16); }
__device__ __forceinline__ float bfhi(unsigned u) { return __builtin_bit_cast(float, u & 0xffff0000u); }
__device__ __forceinline__ float bf1(bf16_t b) { return __builtin_bit_cast(float, (unsigned)b << 16); }
__device__ __forceinline__ float fsigmoid(float x) { return __builtin_amdgcn_rcpf(1.0f + __expf(-x)); }
__device__ __forceinline__ float wave_sum(float v) {
#pragma unroll
    for (int o = 1; o < 64; o <<= 1) v += __shfl_xor(v, o);
    return v;
}
template <int CTRL> __device__ __forceinline__ float dpp_f(float v) { return __builtin_bit_cast(float, __builtin_amdgcn_update_dpp(0, __builtin_bit_cast(int, v), CTRL, 0xF, 0xF, true)); }
__device__ __forceinline__ float sum16(float x) {
    x += dpp_f<0xB1>(x); x += dpp_f<0x4E>(x); x += dpp_f<0x141>(x); x += dpp_f<0x140>(x); return x;
}
#define LDS_WAIT() asm volatile("s_waitcnt lgkmcnt(0)" ::: "memory")
#define VM_WAIT() asm volatile("s_waitcnt vmcnt(0)" ::: "memory")
#define WG_BAR() do { asm volatile("s_waitcnt lgkmcnt(0)" ::: "memory"); __builtin_amdgcn_s_barrier(); asm volatile("" ::: "memory"); } while (0)

namespace pg8 {
constexpr int BM = 256, BK = 64, HALF = 128, HTB = HALF * BK * 2, STAGE_BYTES = 8 * HTB, NXCD = 8, WGM = 8;
__host__ __device__ __forceinline__ int lds_byte(int r, int c) { const int st = (r >> 4) * 2 + (c >> 5), rr = r & 15, cc = c & 31, ob = rr * 64 + cc * 2; return st * 1024 + (ob ^ (((ob >> 9) & 1) << 5)); }
__host__ __device__ __forceinline__ void stage_rc(int b, int& R, int& C) { const int st = b / 1024, sb = b % 1024, swz = sb ^ (((sb >> 9) & 1) << 5); R = (st >> 1) * 16 + swz / 64; C = (st & 1) * 32 + (swz % 64) / 2; }
__host__ __device__ __forceinline__ int perm32(int rho) { const int n = rho >> 4, i = rho & 15; return 8 * (i >> 2) + 4 * n + (i & 3); }

struct Unit { int pm, pn; };
struct Gemm { const bf16_t* A; const bf16_t* Bt; int M, N, K; };

struct StaticOrder {
    int nM, nN, nwg, G, c;
    __host__ __device__ void init(int M, int N, int G_, int c_) { nM = M / BM; nN = N / BM; nwg = nM * nN; G = G_; c = c_; }
    __host__ __device__ bool next(int i, Unit& u) const {
        const long L = (long)i * G + c; if (L >= nwg) return false;
        int wgid = (int)L; { const int q = nwg / NXCD, r = nwg % NXCD, xcd = wgid % NXCD, off = wgid / NXCD; wgid = (xcd < r ? xcd * (q + 1) : r * (q + 1) + (xcd - r) * q) + off; }
        const int nig = WGM * nN, gid = wgid / nig, fm = gid * WGM, gsz = (nM - fm) < WGM ? (nM - fm) : WGM;
        u.pm = fm + ((wgid % nig) % gsz); u.pn = (wgid % nig) / gsz; return true;
    }
    __device__ __forceinline__ void a_ready(const Unit&) const {}
    __device__ __forceinline__ void done(const Unit&) const {}
};

template <class Epi, class Sched, bool ALIGN_EPI = false, bool SP2 = false>
__device__ __forceinline__ void gemm_phase(LAS unsigned char* lds, const Gemm g, const Sched& S, const Epi& E) {
    int tid_ = threadIdx.x; asm volatile("" : "+v"(tid_));
    const int tid = tid_, wid = __builtin_amdgcn_readfirstlane(tid >> 6), lane = tid & 63, wr = wid >> 2, wc = wid & 3, fr = lane & 15, fq = lane >> 4;
    const int K = g.K, nt = K / BK;
    unsigned voffA[2], voffB[2];
#pragma unroll
    for (int i = 0; i < 2; ++i) { int R, C; stage_rc(tid * 16 + i * 8192, R, C); const int Rb = Epi::PERM ? ((R & ~31) + perm32(R & 31)) : R;
        voffA[i] = (unsigned)(R * K + C) * 2u; voffB[i] = (unsigned)(Rb * K + C) * 2u; }
    const size_t kstep = (size_t)(BK * 2);
    const size_t hstep = (size_t)HALF * K * 2;
    const size_t tstep = 2 * hstep;
    const unsigned ldsw = (unsigned)wid * 1024u;
    const int aoff = lds_byte(wr * 64 + fr, fq * 8), boff = lds_byte(wc * 32 + fr, fq * 8);
#define PG8_SA(b, h) (((b) * 2 + (h)) * HTB)
#define PG8_SB(b, h) ((4 + (b) * 2 + (h)) * HTB)
#define PG8_STAGE(bufoff, gbase, voff) do { _Pragma("unroll") for (int _i = 0; _i < 2; ++_i) \
        __builtin_amdgcn_global_load_lds((const unsigned*)((const char*)(gbase) + (voff)[_i]), (LAS unsigned*)(lds + (bufoff) + ldsw + _i * 8192), 16, 0, 0); } while (0)
#define PG8_LDA(dst, b, h) do { _Pragma("unroll") for (int m = 0; m < 4; ++m) _Pragma("unroll") for (int k = 0; k < 2; ++k) dst[m][k] = *(const LAS bf16x8*)(lds + PG8_SA(b, h) + aoff + m * 2048 + k * 1024); } while (0)
#define PG8_LDB(dst, b, h) do { _Pragma("unroll") for (int n = 0; n < 2; ++n) _Pragma("unroll") for (int k = 0; k < 2; ++k) dst[n][k] = *(const LAS bf16x8*)(lds + PG8_SB(b, h) + boff + n * 2048 + k * 1024); } while (0)
#define PG8_MMA(ai, bj, At, Bt) do { __builtin_amdgcn_s_setprio(1); _Pragma("unroll") for (int m = 0; m < 4; ++m) _Pragma("unroll") for (int n = 0; n < 2; ++n) _Pragma("unroll") for (int k = 0; k < 2; ++k) { \
        if constexpr (Epi::SWAP) acc[ai][bj][m][n] = __builtin_amdgcn_mfma_f32_16x16x32_bf16(At[m][k], Bt[n][k], acc[ai][bj][m][n], 0, 0, 0); \
        else acc[ai][bj][m][n] = __builtin_amdgcn_mfma_f32_16x16x32_bf16(Bt[n][k], At[m][k], acc[ai][bj][m][n], 0, 0, 0); } __builtin_amdgcn_s_setprio(0); } while (0)
#define PG8_WAIT_V(n) asm volatile("s_waitcnt vmcnt(" #n ")" ::: "memory")
#define PG8_WAIT_L(n) asm volatile("s_waitcnt lgkmcnt(" #n ")" ::: "memory")
#define PG8_BAR __builtin_amdgcn_s_barrier()
#define PG8_SCHED __builtin_amdgcn_sched_barrier(0)
    Unit cur, nxt; int ui = 0;
    if (!S.next(0, cur)) return;
    f32x4 acc[2][2][4][2];
#pragma unroll
    for (int a = 0; a < 2; ++a)
#pragma unroll
        for (int b = 0; b < 2; ++b)
#pragma unroll
            for (int m = 0; m < 4; ++m)
#pragma unroll
                for (int n = 0; n < 2; ++n) acc[a][b][m][n] = (f32x4){0.f, 0.f, 0.f, 0.f};
    bf16x8 At[4][2], B0[2][2], B1[2][2];
    const char* cA = (const char*)g.A + (size_t)cur.pm * tstep; const char* cB = (const char*)g.Bt + (size_t)cur.pn * tstep;
    S.a_ready(cur);
    if constexpr (SP2) {
        PG8_STAGE(PG8_SB(0, 0), cB, voffB); PG8_STAGE(PG8_SB(0, 1), cB + hstep, voffB); PG8_STAGE(PG8_SA(0, 0), cA, voffA); PG8_STAGE(PG8_SA(0, 1), cA + hstep, voffA);
        if (wr == 1) PG8_BAR;
        PG8_WAIT_V(2); PG8_BAR;
        PG8_STAGE(PG8_SB(1, 0), cB + kstep, voffB); PG8_STAGE(PG8_SA(1, 0), cA + kstep, voffA); PG8_STAGE(PG8_SB(1, 1), cB + hstep + kstep, voffB);
        PG8_WAIT_V(6); PG8_BAR;
    } else {
        PG8_STAGE(PG8_SB(0, 0), cB, voffB); PG8_STAGE(PG8_SA(0, 0), cA, voffA); PG8_STAGE(PG8_SB(0, 1), cB + hstep, voffB); PG8_STAGE(PG8_SA(0, 1), cA + hstep, voffA);
        if (wr == 1) PG8_BAR;
        PG8_WAIT_V(4); PG8_BAR;
        PG8_STAGE(PG8_SB(1, 0), cB + kstep, voffB); PG8_STAGE(PG8_SA(1, 0), cA + kstep, voffA); PG8_STAGE(PG8_SB(1, 1), cB + hstep + kstep, voffB);
        PG8_WAIT_V(6); PG8_BAR;
    }
    for (;;) {
        const bool has_next = S.next(ui + 1, nxt);
        const char* nA = has_next ? (const char*)g.A + (size_t)nxt.pm * tstep : cA; const char* nB = has_next ? (const char*)g.Bt + (size_t)nxt.pn * tstep : cB;
        for (int t = 0; t < nt; t += 2) {
            const bool last = (t == nt - 2);
            const char* a1 = cA + (size_t)(t + 1) * kstep;
            const char* a2 = last ? nA : cA + (size_t)(t + 2) * kstep; const char* b2 = last ? nB : cB + (size_t)(t + 2) * kstep;
            const char* a3 = a2 + kstep; const char* b3 = b2 + kstep;
            if (last && has_next) S.a_ready(nxt);
            if constexpr (SP2) {
            PG8_LDB(B0, 0, 0); PG8_LDB(B1, 0, 1); PG8_SCHED; PG8_LDA(At, 0, 0); PG8_STAGE(PG8_SA(1, 1), a1 + hstep, voffA);
            PG8_WAIT_V(8); PG8_WAIT_L(0); PG8_BAR; PG8_MMA(0, 0, At, B0); PG8_MMA(0, 1, At, B1); PG8_BAR; PG8_SCHED;
            PG8_LDA(At, 0, 1); PG8_STAGE(PG8_SB(0, 0), b2, voffB); PG8_STAGE(PG8_SB(0, 1), b2 + hstep, voffB); PG8_STAGE(PG8_SA(0, 0), a2, voffA);
            PG8_WAIT_V(8); PG8_WAIT_L(0); PG8_BAR; PG8_MMA(1, 0, At, B0); PG8_MMA(1, 1, At, B1); PG8_BAR; PG8_SCHED;
            PG8_LDB(B0, 1, 0); PG8_LDB(B1, 1, 1); PG8_SCHED; PG8_LDA(At, 1, 0); PG8_STAGE(PG8_SA(0, 1), a2 + hstep, voffA);
            PG8_WAIT_V(8); PG8_WAIT_L(0); PG8_BAR; PG8_MMA(0, 0, At, B0); PG8_MMA(0, 1, At, B1); PG8_BAR; PG8_SCHED;
            PG8_LDA(At, 1, 1); PG8_STAGE(PG8_SB(1, 0), b3, voffB); PG8_STAGE(PG8_SB(1, 1), b3 + hstep, voffB); PG8_STAGE(PG8_SA(1, 0), a3, voffA);
            PG8_WAIT_V(8); PG8_WAIT_L(0); PG8_BAR; PG8_MMA(1, 0, At, B0); PG8_MMA(1, 1, At, B1); PG8_BAR; PG8_SCHED;
            } else {
            PG8_LDB(B0, 0, 0); PG8_SCHED; PG8_LDA(At, 0, 0); PG8_STAGE(PG8_SA(1, 1), a1 + hstep, voffA);
            PG8_WAIT_L(8); PG8_BAR; PG8_WAIT_L(0); PG8_MMA(0, 0, At, B0); PG8_BAR; PG8_SCHED;
            PG8_LDB(B1, 0, 1); PG8_STAGE(PG8_SB(0, 0), b2, voffB);
            PG8_BAR; PG8_WAIT_L(0); PG8_MMA(0, 1, At, B1); PG8_BAR;
            PG8_LDA(At, 0, 1); PG8_STAGE(PG8_SA(0, 0), a2, voffA);
            PG8_BAR; PG8_WAIT_L(0); PG8_MMA(1, 0, At, B0); PG8_BAR; PG8_SCHED;
            PG8_STAGE(PG8_SB(0, 1), b2 + hstep, voffB);
            PG8_WAIT_V(6); PG8_BAR; PG8_MMA(1, 1, At, B1); PG8_BAR;
            PG8_LDB(B0, 1, 0); PG8_SCHED; PG8_LDA(At, 1, 0); PG8_STAGE(PG8_SA(0, 1), a2 + hstep, voffA);
            PG8_WAIT_L(8); PG8_BAR; PG8_WAIT_L(0); PG8_MMA(0, 0, At, B0); PG8_BAR; PG8_SCHED;
            PG8_LDB(B1, 1, 1); PG8_STAGE(PG8_SB(1, 0), b3, voffB);
            PG8_BAR; PG8_WAIT_L(0); PG8_MMA(0, 1, At, B1); PG8_BAR;
            PG8_LDA(At, 1, 1); PG8_STAGE(PG8_SA(1, 0), a3, voffA);
            PG8_BAR; PG8_WAIT_L(0); PG8_MMA(1, 0, At, B0); PG8_BAR; PG8_SCHED;
            PG8_STAGE(PG8_SB(1, 1), b3 + hstep, voffB);
            PG8_WAIT_V(6); PG8_BAR; PG8_MMA(1, 1, At, B1); PG8_BAR;
            }
        }
        if constexpr (ALIGN_EPI) { if (wr == 0) PG8_BAR; }
        E(acc, cur, wr, wc, fr, fq); S.done(cur);
        if (!has_next) break;
#pragma unroll
        for (int a = 0; a < 2; ++a)
#pragma unroll
            for (int b = 0; b < 2; ++b)
#pragma unroll
                for (int m = 0; m < 4; ++m)
#pragma unroll
                    for (int n = 0; n < 2; ++n) acc[a][b][m][n] = (f32x4){0.f, 0.f, 0.f, 0.f};
        cur = nxt; cA = nA; cB = nB; ++ui;
        if constexpr (ALIGN_EPI) { if (wr == 1) PG8_BAR; }
    }
    PG8_WAIT_V(0);
    if constexpr (!ALIGN_EPI) { if (wr == 0) PG8_BAR; }
    PG8_BAR;
#undef PG8_SA
#undef PG8_SB
#undef PG8_STAGE
#undef PG8_LDA
#undef PG8_LDB
#undef PG8_MMA
#undef PG8_WAIT_V
#undef PG8_WAIT_L
#undef PG8_BAR
#undef PG8_SCHED
}

typedef const f32x4 (&AccRef)[2][2][4][2];
__device__ __forceinline__ u32x4 pack8(f32x4 v0, f32x4 v1) { u32x4 w; w.x = pk2(v0[0], v0[1]); w.y = pk2(v0[2], v0[3]); w.z = pk2(v1[0], v1[1]); w.w = pk2(v1[2], v1[3]); return w; }
__device__ __forceinline__ void unpack8(u32x4 w, f32x4& v0, f32x4& v1) { v0 = (f32x4){bflo(w.x), bfhi(w.x), bflo(w.y), bfhi(w.y)}; v1 = (f32x4){bflo(w.z), bfhi(w.z), bflo(w.w), bfhi(w.w)}; }

struct EpiBf16 {
    static constexpr bool PERM = true, SWAP = false;
    bf16_t* O; int ldc;
    __device__ __forceinline__ void operator()(AccRef acc, const Unit& u, int wr, int wc, int fr, int fq) const {
        const int row0 = u.pm * BM + wr * 64 + fr, col0 = u.pn * BM + wc * 32 + 8 * fq;
#pragma unroll
        for (int ai = 0; ai < 2; ++ai)
#pragma unroll
            for (int m = 0; m < 4; ++m) { bf16_t* rowp = O + (size_t)(row0 + ai * HALF + m * 16) * ldc + col0;
#pragma unroll
                for (int bj = 0; bj < 2; ++bj) *(u32x4*)(rowp + bj * HALF) = pack8(acc[ai][bj][m][0], acc[ai][bj][m][1]); }
    }
};
struct EpiProj {
    static constexpr bool PERM = true, SWAP = false;
    bf16_t* O; const float* rope;
    __device__ __forceinline__ void operator()(AccRef acc, const Unit& u, int wr, int wc, int fr, int fq) const {
        const int row0 = u.pm * BM + wr * 64 + fr, col0 = u.pn * BM + wc * 32 + 8 * fq;
        const int mode = (u.pn >= 27 && u.pn < 43) ? (u.pn < 35 ? 1 : 2) : 0;
        const float sc = (mode == 1) ? QSCALE : 1.0f;
#pragma unroll
        for (int ai = 0; ai < 2; ++ai)
#pragma unroll
            for (int m = 0; m < 4; ++m) { const int row = row0 + ai * HALF + m * 16; bf16_t* rowp = O + (size_t)row * PLD + col0;
#pragma unroll
                for (int bj = 0; bj < 2; ++bj) { f32x4 v0 = acc[ai][bj][m][0], v1 = acc[ai][bj][m][1];
                    if (mode) { const int i0 = ((col0 + bj * HALF) & 127) >> 1; const f32x4* rp = (const f32x4*)(rope + ((size_t)row * 64 + i0) * 2); const f32x4 c0 = rp[0], c1 = rp[1];
                        f32x4 o0, o1;
                        o0[0] = v0[0] * c0[0] - v0[1] * c0[1]; o0[1] = v0[1] * c0[0] + v0[0] * c0[1]; o0[2] = v0[2] * c0[2] - v0[3] * c0[3]; o0[3] = v0[3] * c0[2] + v0[2] * c0[3];
                        o1[0] = v1[0] * c1[0] - v1[1] * c1[1]; o1[1] = v1[1] * c1[0] + v1[0] * c1[1]; o1[2] = v1[2] * c1[2] - v1[3] * c1[3]; o1[3] = v1[3] * c1[2] + v1[2] * c1[3];
                        v0 = o0 * sc; v1 = o1 * sc; }
                    *(u32x4*)(rowp + bj * HALF) = pack8(v0, v1); } }
    }
};
struct EpiVT {
    static constexpr bool PERM = false, SWAP = true;
    bf16_t* VT;
    __device__ __forceinline__ void operator()(AccRef acc, const Unit& u, int wr, int wc, int fr, int fq) const {
        const int tok0 = u.pm * BM + wr * 64 + 4 * fq, col0 = u.pn * BM + wc * 32 + fr;
#pragma unroll
        for (int ai = 0; ai < 2; ++ai)
#pragma unroll
            for (int m = 0; m < 4; ++m)
#pragma unroll
                for (int bj = 0; bj < 2; ++bj)
#pragma unroll
                    for (int n = 0; n < 2; ++n) { const f32x4 v = acc[ai][bj][m][n]; u32x2 w; w.x = pk2(v[0], v[1]); w.y = pk2(v[2], v[3]);
                        *(u32x2*)(VT + (size_t)(col0 + bj * HALF + n * 16) * T + tok0 + ai * HALF + m * 16) = w; }
    }
};
struct EpiDec {
    static constexpr bool PERM = true, SWAP = false;
    float* O; const float* w0;
    __device__ __forceinline__ void operator()(AccRef acc, const Unit& u, int wr, int wc, int fr, int fq) const {
        const int row0 = u.pm * BM + wr * 64 + fr, col0 = u.pn * BM + wc * 32 + 8 * fq;
#pragma unroll
        for (int bj = 0; bj < 2; ++bj) { const f32x4 b0 = *(const f32x4*)(w0 + col0 + bj * HALF), b1 = *(const f32x4*)(w0 + col0 + bj * HALF + 4);
#pragma unroll
            for (int ai = 0; ai < 2; ++ai)
#pragma unroll
                for (int m = 0; m < 4; ++m) { float* rowp = O + (size_t)(row0 + ai * HALF + m * 16) * RW + col0 + bj * HALF;
#pragma unroll
                    for (int n = 0; n < 2; ++n) { const f32x4 x = acc[ai][bj][m][n] + (n ? b1 : b0); f32x4 o;
#pragma unroll
                        for (int e = 0; e < 4; ++e) { const float z = -x[e]; const float sp = fmaxf(z, 0.f) + __logf(1.0f + __expf(-fabsf(z))); o[e] = __expf(-__expf(-sp - 0.5f)); }
                        *(f32x4*)(rowp + 4 * n) = o; }
                    asm volatile("" ::: "memory"); } }
    }
};
struct EpiA {
    static constexpr bool PERM = true, SWAP = false;
    bf16_t* KP; bf16_t* BB; const bf16_t* KKN; const float* a0; const float* k_a;
    __device__ __forceinline__ void operator()(AccRef acc, const Unit& u, int wr, int wc, int fr, int fq) const {
        const int row0 = u.pm * BM + wr * 64 + fr, col0 = u.pn * BM + wc * 32 + 8 * fq;
#pragma unroll
        for (int bj = 0; bj < 2; ++bj) { const int cb = col0 + bj * HALF;
            const f32x4 b0 = *(const f32x4*)(a0 + cb), b1 = *(const f32x4*)(a0 + cb + 4), ka0 = *(const f32x4*)(k_a + cb), ka1 = *(const f32x4*)(k_a + cb + 4);
#pragma unroll
            for (int ai = 0; ai < 2; ++ai)
#pragma unroll
                for (int m = 0; m < 4; ++m) { const size_t off = (size_t)(row0 + ai * HALF + m * 16) * RW + cb;
                    f32x4 zk0, zk1, kn0, kn1; unpack8(*(const u32x4*)(KP + off), zk0, zk1); unpack8(*(const u32x4*)(KKN + off), kn0, kn1);
                    f32x4 a0v, a1v;
#pragma unroll
                    for (int e = 0; e < 4; ++e) { a0v[e] = fsigmoid(acc[ai][bj][m][0][e] + b0[e]); a1v[e] = fsigmoid(acc[ai][bj][m][1][e] + b1[e]); }
                    const f32x4 kp0 = zk0 * (1.0f + (a0v - 1.0f) * ka0), kp1 = zk1 * (1.0f + (a1v - 1.0f) * ka1);
                    *(u32x4*)(KP + off) = pack8(kp0, kp1); *(u32x4*)(BB + off) = pack8(kn0 * a0v, kn1 * a1v);
                    asm volatile("" ::: "memory"); } }
    }
};
template <bool ADD> struct EpiMix {
    static constexpr bool PERM = true, SWAP = false;
    bf16_t* O; const bf16_t* proj; int gcol0;
    __device__ __forceinline__ void operator()(AccRef acc, const Unit& u, int wr, int wc, int fr, int fq) const {
        const int row0 = u.pm * BM + wr * 64 + fr, col0 = u.pn * BM + wc * 32 + 8 * fq;
#pragma unroll
        for (int ai = 0; ai < 2; ++ai)
#pragma unroll
            for (int m = 0; m < 4; ++m) { const int row = row0 + ai * HALF + m * 16;
#pragma unroll
                for (int bj = 0; bj < 2; ++bj) { f32x4 g0, g1; unpack8(*(const u32x4*)(proj + (size_t)row * PLD + gcol0 + col0 + bj * HALF), g0, g1);
                    f32x4 o0, o1;
#pragma unroll
                    for (int e = 0; e < 4; ++e) { o0[e] = fsigmoid(g0[e]) * acc[ai][bj][m][0][e]; o1[e] = fsigmoid(g1[e]) * acc[ai][bj][m][1][e]; }
                    bf16_t* op = O + (size_t)row * D + col0 + bj * HALF;
                    if (ADD) { f32x4 p0, p1; unpack8(*(const u32x4*)op, p0, p1); o0 += p0; o1 += p1; }
                    *(u32x4*)op = pack8(o0, o1); } }
    }
};
struct EpiRes {
    static constexpr bool PERM = true, SWAP = false;
    float* O; const float* x;
    __device__ __forceinline__ void operator()(AccRef acc, const Unit& u, int wr, int wc, int fr, int fq) const {
        const int row0 = u.pm * BM + wr * 64 + fr, col0 = u.pn * BM + wc * 32 + 8 * fq;
#pragma unroll
        for (int ai = 0; ai < 2; ++ai)
#pragma unroll
            for (int m = 0; m < 4; ++m) { const size_t off = (size_t)(row0 + ai * HALF + m * 16) * D + col0;
#pragma unroll
                for (int bj = 0; bj < 2; ++bj)
#pragma unroll
                    for (int n = 0; n < 2; ++n) *(f32x4*)(O + off + bj * HALF + 4 * n) = *(const f32x4*)(x + off + bj * HALF + 4 * n) + acc[ai][bj][m][n]; }
    }
};
}

#define XB_TMO      128
#define XB_XCNT(j)  (256  + 64 * (j))
#define XB_XSUB(j)  (1280 + 64 * (j))
#define XB_XGEN(j)  (2304 + 64 * (j))
#define XB_TOP      3328
#define XB_TOPGEN   3392
#define XCD_BAR_WORDS 3456
#define XB_SPIN_CAP (1u << 18)
__device__ __forceinline__ unsigned xb_ld(unsigned* p)              { return __hip_atomic_load(p, __ATOMIC_RELAXED, __HIP_MEMORY_SCOPE_AGENT); }
__device__ __forceinline__ unsigned xb_add(unsigned* p, unsigned v) { return __hip_atomic_fetch_add(p, v, __ATOMIC_RELAXED, __HIP_MEMORY_SCOPE_AGENT); }
__device__ __forceinline__ unsigned xb_xcc_id() { return (unsigned)__builtin_amdgcn_s_getreg((3 << 11) | 20) & 0xFu; }
#define XB_SPIN(cond, bar) do { unsigned _sp = 0; while (cond) { __builtin_amdgcn_s_sleep(1); \
    if ((++_sp & 255u) == 0u) { if (xb_ld(&(bar)[XB_TMO])) break; if (_sp > XB_SPIN_CAP) { atomicAdd(&(bar)[XB_TMO], 1u); break; } } } } while (0)
struct XcdBarrier { unsigned* bar; unsigned x; volatile LAS unsigned* st; };
__device__ __forceinline__ XcdBarrier xcd_barrier_post(unsigned* bar, volatile LAS unsigned* st) {
    XcdBarrier b; b.bar = bar; b.x = xb_xcc_id(); b.st = st;
    if (threadIdx.x == 0) (void)xb_add(&bar[XB_XCNT(b.x)], 1u);
    return b;
}
__device__ __forceinline__ void xcd_barrier_complete(unsigned* bar, unsigned x, unsigned& nloc, unsigned& nx) {
    const unsigned G = gridDim.x * gridDim.y * gridDim.z;
    unsigned sum, cnt, mine, sp = 0u;
    for (;;) {
        sum = 0u; cnt = 0u; mine = 0u;
#pragma unroll
        for (unsigned j = 0; j < 16; ++j) { const unsigned c = xb_ld(&bar[XB_XCNT(j)]); sum += c; cnt += (c > 0u) ? 1u : 0u; mine = (j == x) ? c : mine; }
        if (sum == G) break;
        __builtin_amdgcn_s_sleep(1);
        if ((++sp & 255u) == 0u) { if (xb_ld(&bar[XB_TMO])) break; if (sp > XB_SPIN_CAP) { atomicAdd(&bar[XB_TMO], 1u); break; } }
    }
    nloc = mine > 0u ? mine : 1u; nx = cnt > 0u ? cnt : 1u;
}
__device__ __forceinline__ void xcd_barrier(const XcdBarrier& b) {
    asm volatile("s_waitcnt vmcnt(0)" ::: "memory");
    __syncthreads();
    if (threadIdx.x == 0) {
        unsigned* bar = b.bar;
        __builtin_amdgcn_s_waitcnt(0);
        unsigned nloc = b.st[0], nx = b.st[1];
        if (nloc == 0u) { xcd_barrier_complete(bar, b.x, nloc, nx); b.st[0] = nloc; b.st[1] = nx; }
        const unsigned old = xb_add(&bar[XB_XSUB(b.x)], 1u);
        const unsigned gen = old / nloc;
        if (old + 1u == (gen + 1u) * nloc) {
            __builtin_amdgcn_fence(__ATOMIC_RELEASE, "agent");
            asm volatile("s_waitcnt vmcnt(0)" ::: "memory");
            const unsigned og = xb_add(&bar[XB_TOP], 1u);
            const unsigned tg = og / nx;
            if (og + 1u == (tg + 1u) * nx) xb_add(&bar[XB_TOPGEN], 1u);
            else XB_SPIN(xb_ld(&bar[XB_TOPGEN]) == tg, bar);
            __builtin_amdgcn_fence(__ATOMIC_ACQUIRE, "agent");
            xb_add(&bar[XB_XGEN(b.x)], 1u);
            asm volatile("s_waitcnt vmcnt(0)" ::: "memory");
        } else {
            XB_SPIN(xb_ld(&bar[XB_XGEN(b.x)]) == gen, bar);
            __builtin_amdgcn_fence(__ATOMIC_ACQUIRE, "agent");
            asm volatile("s_waitcnt vmcnt(0)" ::: "memory");
        }
    }
    __syncthreads();
}

struct Args {
    const float *x, *norm1_g, *w_in, *mu, *w0, *w_up, *a0, *a_up, *g_up, *k_k, *k_a, *r_k, *lnx_g, *lnx_b, *w_ba, *w_bb, *w_out, *norm2_g, *peer_wq, *sub_keys, *peer_u, *peer_v, *final_g;
    float* out; unsigned char* ws; int ph_lo, ph_hi, li, pad;
};
#define CAS __attribute__((address_space(4)))
typedef const CAS Args* ArgsP;
__device__ __forceinline__ ArgsP get_args() { ArgsP p = (ArgsP)__builtin_amdgcn_kernarg_segment_ptr(); asm volatile("" : "+s"(p)); return p; }
struct Frame { LAS unsigned char* lds; int tid, lane, wave, vcu, G; };

__device__ __forceinline__ int win_dst(int s) {
    if (s < SHIFTW) return s;
    if (s < SHIFTW + 4096) { const int base = (s < SHIFTW + 2048) ? SHIFTW : SHIFTW + 2048; const int m = s - base, head = m >> 7, c = m & 127; const int j = (c < 64) ? 2 * c : 2 * (c - 64) + 1;
        return ((s < SHIFTW + 2048) ? PC_MQ : PC_MK) + head * 128 + j; }
    if (s < SHIFTW + 6144) return PC_MV + (s - (SHIFTW + 4096));
    if (s < SHIFTW + 6144 + 4096) return PC_GA + (s - (SHIFTW + 6144));
    return PC_GB + (s - (SHIFTW + 6144 + 4096));
}
template <bool MAPWIN> __device__ __forceinline__ void p0_transpose_item(const float* W, int K, int N, bf16_t* WT, int Kd, LAS float* scr, int item, int lane) {
    const int nblk = N / 32, kb = item / nblk, nb = item % nblk, k0 = 64 * kb, n0 = 32 * nb;
#pragma unroll 8
    for (int i = 0; i < 32; ++i) { const int kk = 2 * i + (lane >> 5); scr[kk * 33 + (lane & 31)] = (k0 + kk < K) ? W[(size_t)(k0 + kk) * N + n0 + (lane & 31)] : 0.f; }
    LDS_WAIT(); asm volatile("" ::: "memory");
    const int c = lane & 7;
#pragma unroll
    for (int j = 0; j < 4; ++j) { const int n = (lane >> 3) + 8 * j; const LAS float* s = scr + (8 * c) * 33 + n;
        u32x4 o; o.x = pk2(s[0 * 33], s[1 * 33]); o.y = pk2(s[2 * 33], s[3 * 33]); o.z = pk2(s[4 * 33], s[5 * 33]); o.w = pk2(s[6 * 33], s[7 * 33]);
        const int row = MAPWIN ? win_dst(n0 + n) : (n0 + n);
        *(u32x4*)(WT + (size_t)row * Kd + k0 + 8 * c) = o; }
    LDS_WAIT(); asm volatile("" ::: "memory");
}
__device__ __forceinline__ void rms_row_to_bf16(const float* xrow, const float* g, bf16_t* orow, int lane) {
    const f32x4* xr = (const f32x4*)xrow + lane; const f32x4* gr = (const f32x4*)g + lane;
    f32x4 v[16]; float s = 0.f;
#pragma unroll
    for (int j = 0; j < 16; ++j) { v[j] = xr[64 * j]; s += (v[j].x * v[j].x + v[j].y * v[j].y) + (v[j].z * v[j].z + v[j].w * v[j].w); }
    const float rs = 1.0f / sqrtf(wave_sum(s) * (1.0f / D) + NORM_EPS);
    u32x2* o8 = (u32x2*)orow + lane;
#pragma unroll
    for (int j = 0; j < 16; ++j) { const f32x4 gg = gr[64 * j]; u32x2 w; w.x = pk2(v[j].x * rs * gg.x, v[j].y * rs * gg.y); w.y = pk2(v[j].z * rs * gg.z, v[j].w * rs * gg.w); o8[64 * j] = w; }
}
__device__ __forceinline__ void cvt_table(const float* src, bf16_t* dst, size_t n8, size_t gtid, size_t nthr) {
    for (size_t i = gtid; i < n8; i += nthr) { const f32x4 a = ((const f32x4*)src)[2 * i], b = ((const f32x4*)src)[2 * i + 1]; ((u32x4*)dst)[i] = pg8::pack8(a, b); }
}
__device__ __forceinline__ void ph0_prologue(ArgsP A, Frame& F) {
    unsigned char* ws = A->ws;
    LAS float* scr = (LAS float*)(F.lds + RING_OFF + F.wave * 16384);
    const int gw = F.vcu * NWAVES + F.wave, NGW = F.G * NWAVES;
    constexpr int I_IN = 64 * (INW / 32), I_BA = 32 * 128, I_OUT = 64 * 128, I_WQ = 64 * 64, I_UP = 2 * 64, I_G = 8 * 64;
    constexpr int NITEMS = I_IN + 2 * I_BA + I_OUT + I_WQ + 2 * I_UP + I_G;
    for (int it = gw; it < NITEMS; it += NGW) {
        int r = it;
        if (r < I_IN) { p0_transpose_item<true>(A->w_in, D, INW, (bf16_t*)(ws + WS_WIN), D, scr, r, F.lane); continue; } r -= I_IN;
        if (r < I_BA) { p0_transpose_item<false>(A->w_ba, RW, D, (bf16_t*)(ws + WS_WA), RW, scr, r, F.lane); continue; } r -= I_BA;
        if (r < I_BA) { p0_transpose_item<false>(A->w_bb, RW, D, (bf16_t*)(ws + WS_WB), RW, scr, r, F.lane); continue; } r -= I_BA;
        if (r < I_OUT) { p0_transpose_item<false>(A->w_out, D, D, (bf16_t*)(ws + WS_WOUT), D, scr, r, F.lane); continue; } r -= I_OUT;
        if (r < I_WQ) { p0_transpose_item<false>(A->peer_wq, D, 2048, (bf16_t*)(ws + WS_WQ), D, scr, r, F.lane); continue; } r -= I_WQ;
        if (r < I_UP) { p0_transpose_item<false>(A->w_up, LW, RW, (bf16_t*)(ws + WS_WUP), LW, scr, r, F.lane); continue; } r -= I_UP;
        if (r < I_UP) { p0_transpose_item<false>(A->a_up, LA, RW, (bf16_t*)(ws + WS_AUP), LA, scr, r, F.lane); continue; } r -= I_UP;
        p0_transpose_item<false>(A->g_up, LG, RW, (bf16_t*)(ws + WS_GUP), LGP, scr, r, F.lane);
    }
    const size_t gtid = (size_t)F.vcu * NTHR + F.tid, nthr = (size_t)F.G * NTHR;
    for (size_t i = gtid; i < (size_t)32 * D / 8; i += nthr) ((u32x4*)((bf16_t*)(ws + WS_WIN) + (size_t)SHIFTW * D))[i] = (u32x4){0u, 0u, 0u, 0u};
    for (int row = gw; row < 2 * 16384; row += NGW) { const bool isv = row >= 16384; const int rr = isv ? row - 16384 : row;
        const f32x4* src = (const f32x4*)((isv ? A->peer_v : A->peer_u) + (size_t)rr * D) + F.lane; f32x4 v[16]; float am = 0.f;
#pragma unroll
        for (int j = 0; j < 16; ++j) { v[j] = src[64 * j]; am = fmaxf(fmaxf(am, fmaxf(fabsf(v[j].x), fabsf(v[j].y))), fmaxf(fabsf(v[j].z), fabsf(v[j].w))); }
#pragma unroll
        for (int o = 1; o < 64; o <<= 1) am = fmaxf(am, __shfl_xor(am, o));
        const float inv = am > 0.f ? 127.0f / am : 0.f; unsigned* dst = (unsigned*)(ws + (isv ? WS_PV : WS_PU)) + (size_t)rr * (D / 4) + F.lane;
#pragma unroll
        for (int j = 0; j < 16; ++j) { const unsigned q0 = (unsigned)(int)(rintf(v[j].x * inv) + 128.0f), q1 = (unsigned)(int)(rintf(v[j].y * inv) + 128.0f), q2 = (unsigned)(int)(rintf(v[j].z * inv) + 128.0f), q3 = (unsigned)(int)(rintf(v[j].w * inv) + 128.0f);
            dst[64 * j] = q0 | (q1 << 8) | (q2 << 16) | (q3 << 24); }
        if (F.lane == 0) ((float*)(ws + (isv ? WS_PSV : WS_PSU)))[rr] = am * (1.0f / 127.0f); }
    cvt_table(A->sub_keys, (bf16_t*)(ws + WS_SUBK), (size_t)PH_ * 2 * PNK * PHALF / 8, gtid, nthr);
    for (size_t i = gtid; i < (size_t)T * 64; i += nthr) { const int pos = (int)(i >> 6), fi = (int)(i & 63); const float inv = powf(10000.0f, -(float)fi / 64.0f); const float ang = (float)pos * inv;
        ((f32x2*)(ws + WS_ROPE))[i] = (f32x2){cosf(ang), sinf(ang)}; }
    for (int m = gw; m < T; m += NGW) rms_row_to_bf16(A->x + (size_t)m * D, A->norm1_g, (bf16_t*)(ws + WS_XN) + (size_t)m * D, F.lane);
}

__device__ __forceinline__ f32x4 ld4bf(const bf16_t* p) { const u32x2 w = *(const u32x2*)p; return (f32x4){bflo(w.x), bfhi(w.x), bflo(w.y), bfhi(w.y)}; }
__device__ __forceinline__ void st4bf(bf16_t* p, f32x4 v) { u32x2 w; w.x = pk2(v[0], v[1]); w.y = pk2(v[2], v[3]); *(u32x2*)p = w; }
__device__ __forceinline__ void ph2_prep(ArgsP A, Frame& F) {
    unsigned char* ws = A->ws; const bf16_t* PROJ = (const bf16_t*)(ws + WS_PROJ);
    LAS float* red = (LAS float*)(F.lds + RING_OFF);
    for (int it = F.vcu; it < NBLK * MH; it += F.G) { const int n = it / MH, h = it % MH, d = F.tid & 127, part = F.tid >> 7;
        const bf16_t* p = PROJ + (size_t)(n * MBLK + part * 64) * PLD + PC_MK + h * MD + d; float s = 0.f;
#pragma unroll 8
        for (int i = 0; i < 64; ++i) s += bf1(p[(size_t)i * PLD]);
        red[F.tid] = s; WG_BAR();
        if (F.tid < 128) ((float*)(ws + WS_KMEAN))[(size_t)(n * MH + h) * MD + F.tid] = (red[F.tid] + red[F.tid + 128] + red[F.tid + 256] + red[F.tid + 384]) * (1.0f / MBLK);
        WG_BAR(); }
    const int tid = F.tid;
    for (int t = F.vcu; t < T; t += F.G) { const bf16_t* P = PROJ + (size_t)t * PLD; const bf16_t* PP = P - PLD; const bool hasp = t > 0; const f32x4 zero = (f32x4){0.f, 0.f, 0.f, 0.f};
        { const int c = 4 * tid; const f32x4 p = ld4bf(P + PC_R + c), pp = hasp ? ld4bf(PP + PC_R + c) : zero, mu = *(const f32x4*)(A->mu + PC_R + c); st4bf((bf16_t*)(ws + WS_ZR) + (size_t)t * RW + c, p + (pp - p) * mu); }
        { const int c = 4 * tid; const f32x4 p = ld4bf(P + PC_K + c), pp = hasp ? ld4bf(PP + PC_K + c) : zero, mu = *(const f32x4*)(A->mu + PC_K + c); const f32x4 zk = p + (pp - p) * mu;
          st4bf((bf16_t*)(ws + WS_KP) + (size_t)t * RW + c, zk); const f32x4 kk = zk * *(const f32x4*)(A->k_k + c);
          const float ss = sum16((kk[0] * kk[0] + kk[1] * kk[1]) + (kk[2] * kk[2] + kk[3] * kk[3])); const float inv = 1.0f / fmaxf(sqrtf(ss), 1e-12f);
          st4bf((bf16_t*)(ws + WS_KKN) + (size_t)t * RW + c, kk * inv); }
        { const int c = 4 * tid; const f32x4 p = ld4bf(P + PC_V + c), pp = hasp ? ld4bf(PP + PC_V + c) : zero, mu = *(const f32x4*)(A->mu + PC_V + c); st4bf((bf16_t*)(ws + WS_ZV) + (size_t)t * RW + c, p + (pp - p) * mu); }
        if (tid < 192) {
            int c, cc; if (tid < 32) { cc = 4 * tid; c = PC_WL + cc; } else if (tid < 64) { cc = 4 * (tid - 32); c = PC_AL + cc; } else { cc = 4 * (tid - 64); c = PC_GL + cc; }
            f32x4 z = zero;
            if (tid < 64 || cc < LG) { const f32x4 p = ld4bf(P + c), pp = hasp ? ld4bf(PP + c) : zero, mu = *(const f32x4*)(A->mu + c); z = p + (pp - p) * mu; }
            if (tid < 32) { f32x4 o;
#pragma unroll
                for (int e = 0; e < 4; ++e) o[e] = 1.0f - 2.0f * __builtin_amdgcn_rcpf(__expf(2.0f * z[e]) + 1.0f);
                st4bf((bf16_t*)(ws + WS_AW) + (size_t)t * LW + cc, o); }
            else if (tid < 64) st4bf((bf16_t*)(ws + WS_AA) + (size_t)t * LA + cc, z);
            else { f32x4 o = zero; if (cc < LG) {
#pragma unroll
                for (int e = 0; e < 4; ++e) o[e] = fsigmoid(z[e]); }
                st4bf((bf16_t*)(ws + WS_AG) + (size_t)t * LGP + cc, o); }
        }
    }
}

__device__ __forceinline__ void ph3_gate(ArgsP A, Frame& F) {
    unsigned char* ws = A->ws; const bf16_t* PROJ = (const bf16_t*)(ws + WS_PROJ); const float* KM = (const float*)(ws + WS_KMEAN); unsigned* MASK = (unsigned*)(ws + WS_MASK);
    const int gw = F.vcu * NWAVES + F.wave, NGW = F.G * NWAVES; const int hh = F.lane >> 5, n = F.lane & 31;
    for (int it = gw; it < T * (MH / 2); it += NGW) { const int t = it >> 3, h = 2 * (it & 7) + hh, blk = t >> 8;
        if (blk == 0) { if (n == 0) MASK[t * MH + h] = 0u; continue; }
        const bf16_t* q = PROJ + (size_t)t * PLD + PC_MQ + h * MD; const float* km = KM + (size_t)(n * MH + h) * MD; float acc = 0.f;
#pragma unroll 8
        for (int d = 0; d < MD; d += 4) { const f32x4 qv = ld4bf(q + d), kv = *(const f32x4*)(km + d); acc += (qv[0] * kv[0] + qv[1] * kv[1]) + (qv[2] * kv[2] + qv[3] * kv[3]); }
        const float NEG = -__builtin_inff(); float v = (n < blk) ? acc : NEG; unsigned sel = 0u; const int nsel = blk < 3 ? blk : 3;
        for (int k = 0; k < nsel; ++k) { float mx = v;
#pragma unroll
            for (int o = 1; o < 32; o <<= 1) mx = fmaxf(mx, __shfl_xor(mx, o));
            const unsigned long long b = __ballot(v == mx && v > NEG); const unsigned hb = (unsigned)(b >> (32 * hh));
            const int w = __ffs(hb) - 1; sel |= 1u << w; if (n == w) v = NEG; }
        if (n == 0) MASK[t * MH + h] = sel; }
}

constexpr int SC_CH = 32, SC_STEP = 1312, SC_BUF = SC_CH * SC_STEP, SC_YOFF = 2 * SC_BUF, SC_YBUF = SC_CH * 8 * 16 * 4;
static_assert(SC_YOFF + 2 * SC_YBUF <= RING_BYTES, "scan LDS");
__device__ __forceinline__ void ph4_scan(ArgsP A, Frame& F) {
    unsigned char* ws = A->ws;
    const float* DEC = (const float*)(ws + WS_DEC); const bf16_t* KKN = (const bf16_t*)(ws + WS_KKN); const bf16_t* BB = (const bf16_t*)(ws + WS_BB); const bf16_t* KP = (const bf16_t*)(ws + WS_KP);
    const bf16_t* ZR = (const bf16_t*)(ws + WS_ZR); const bf16_t* ZV = (const bf16_t*)(ws + WS_ZV); float* Y = (float*)(ws + WS_Y);
    LAS unsigned char* L = F.lds + RING_OFF;
    const int wave = F.wave, lane = F.lane;
    const bool scanner = wave < 2, loader = (wave == 2 || wave == 3 || wave == 6 || wave == 7);
    const int ltid = ((wave & 1) + ((wave >> 2) << 1)) * 64 + lane;
    for (int unit = F.vcu; unit < 256; unit += F.G) {
        const int h = unit >> 3, r0 = (unit & 7) * 8; const size_t hc = (size_t)h * RN;
        constexpr int NC = T / SC_CH;
        f32x4 ld_dec[2]; u32x4 ld_b[4]; u32x4 ld_v;
        auto issue = [&](int c) { const int t0 = c * SC_CH;
#pragma unroll
            for (int i = 0; i < 2; ++i) { const int q = ltid + 256 * i, st = q >> 4, c4 = q & 15; ld_dec[i] = *(const f32x4*)(DEC + (size_t)(t0 + st) * RW + hc + 4 * c4); }
            { const int st = ltid >> 3, c8 = ltid & 7; const size_t o = (size_t)(t0 + st) * RW + hc + 8 * c8; ld_b[0] = *(const u32x4*)(KKN + o); ld_b[1] = *(const u32x4*)(BB + o); ld_b[2] = *(const u32x4*)(KP + o); ld_b[3] = *(const u32x4*)(ZR + o); }
            if (ltid < SC_CH) ld_v = *(const u32x4*)(ZV + (size_t)(t0 + ltid) * RW + hc + r0); };
        auto commit = [&](int buf) { LAS unsigned char* B = L + buf * SC_BUF;
#pragma unroll
            for (int i = 0; i < 2; ++i) { const int q = ltid + 256 * i, st = q >> 4, c4 = q & 15; *(LAS f32x4*)(B + st * SC_STEP + 16 * c4) = ld_dec[i]; }
            { const int st = ltid >> 3, c8 = ltid & 7;
#pragma unroll
              for (int a = 0; a < 4; ++a) { f32x4 v0, v1; pg8::unpack8(ld_b[a], v0, v1); LAS unsigned char* p = B + st * SC_STEP + 256 * (a + 1) + 32 * c8; *(LAS f32x4*)p = v0; *(LAS f32x4*)(p + 16) = v1; } }
            if (ltid < SC_CH) { f32x4 v0, v1; pg8::unpack8(ld_v, v0, v1); LAS unsigned char* p = B + ltid * SC_STEP + 1280; *(LAS f32x4*)p = v0; *(LAS f32x4*)(p + 16) = v1; } };
        auto yflush = [&](int c) { const LAS unsigned char* YB = L + SC_YOFF + (c & 1) * SC_YBUF; const int st = ltid >> 3, rr = ltid & 7; const LAS f32x4* p = (const LAS f32x4*)(YB + (st * 8 + rr) * 64);
            const f32x4 a = p[0], b = p[1], cc = p[2], d = p[3]; const f32x4 s = (a + b) + (cc + d); Y[(size_t)(c * SC_CH + st) * RW + hc + r0 + rr] = (s[0] + s[1]) + (s[2] + s[3]); };
        if (loader) { issue(0); VM_WAIT(); commit(0); issue(1); }
        WG_BAR();
        float S0 = 0.f, S1 = 0.f, S2 = 0.f, S3 = 0.f;
        const int row = wave * 4 + (lane >> 4), j = lane & 15;
        for (int c = 0; c < NC; ++c) {
            if (scanner) {
                const LAS unsigned char* B = L + (c & 1) * SC_BUF + 16 * j; LAS float* yb = (LAS float*)(L + SC_YOFF + (c & 1) * SC_YBUF) + row * 16 + j;
                const LAS unsigned char* vb = L + (c & 1) * SC_BUF + 1280 + 4 * row;
                f32x4 w = *(const LAS f32x4*)(B), kk = *(const LAS f32x4*)(B + 256), bb = *(const LAS f32x4*)(B + 512), kp = *(const LAS f32x4*)(B + 768), rr = *(const LAS f32x4*)(B + 1024); float v = *(const LAS float*)(vb);
#pragma unroll 4
                for (int tt = 0; tt < SC_CH; ++tt) {
                    const int nx = (tt + 1 < SC_CH ? tt + 1 : tt) * SC_STEP;
                    const f32x4 w_n = *(const LAS f32x4*)(B + nx), kk_n = *(const LAS f32x4*)(B + nx + 256), bb_n = *(const LAS f32x4*)(B + nx + 512), kp_n = *(const LAS f32x4*)(B + nx + 768), rr_n = *(const LAS f32x4*)(B + nx + 1024);
                    const float v_n = *(const LAS float*)(vb + nx);
                    const float d = sum16((S0 * kk[0] + S1 * kk[1]) + (S2 * kk[2] + S3 * kk[3]));
                    const float sa = -d;
                    S0 = S0 * w[0] + sa * bb[0] + v * kp[0]; S1 = S1 * w[1] + sa * bb[1] + v * kp[1]; S2 = S2 * w[2] + sa * bb[2] + v * kp[2]; S3 = S3 * w[3] + sa * bb[3] + v * kp[3];
                    yb[tt * 128] = (S0 * rr[0] + S1 * rr[1]) + (S2 * rr[2] + S3 * rr[3]);
                    w = w_n; kk = kk_n; bb = bb_n; kp = kp_n; rr = rr_n; v = v_n;
                }
            } else if (loader) {
                if (c + 1 < NC) { VM_WAIT(); commit((c + 1) & 1); }
                if (c + 2 < NC) issue(c + 2);
                if (c > 0) yflush(c - 1);
            }
            WG_BAR();
        }
        if (loader) yflush(NC - 1);
        WG_BAR();
    }
}

__device__ __forceinline__ void ph5_ypost(ArgsP A, Frame& F) {
    unsigned char* ws = A->ws; const float* Y = (const float*)(ws + WS_Y); const bf16_t* ZR = (const bf16_t*)(ws + WS_ZR); const bf16_t* KP = (const bf16_t*)(ws + WS_KP); const bf16_t* ZV = (const bf16_t*)(ws + WS_ZV);
    const bf16_t* G = (const bf16_t*)(ws + WS_G); bf16_t* YA = (bf16_t*)(ws + WS_YA);
    const int gw = F.vcu * NWAVES + F.wave, NGW = F.G * NWAVES;
    for (int it = gw; it < T * 8; it += NGW) { const int t = it >> 3, c = (it & 7) * 256 + 4 * F.lane; const size_t o = (size_t)t * RW + c;
        const f32x4 y = *(const f32x4*)(Y + o); const float mean = sum16((y[0] + y[1]) + (y[2] + y[3])) * (1.0f / 64.0f); const f32x4 d = y - mean;
        const float var = sum16((d[0] * d[0] + d[1] * d[1]) + (d[2] * d[2] + d[3] * d[3])) * (1.0f / 64.0f); const float rs = 1.0f / sqrtf(var + LNX_EPS);
        const f32x4 r = ld4bf(ZR + o), k = ld4bf(KP + o), v = ld4bf(ZV + o), g = ld4bf(G + o), rk = *(const f32x4*)(A->r_k + c), lg = *(const f32x4*)(A->lnx_g + c), lb = *(const f32x4*)(A->lnx_b + c);
        const f32x4 rkk = r * k * rk; const float bonus = sum16((rkk[0] + rkk[1]) + (rkk[2] + rkk[3]));
        st4bf(YA + o, (d * rs * lg + lb + bonus * v) * g); }
}

constexpr int AT_KP = 272, AT_VP = 136, AT_KB = 64 * AT_KP, AT_VB = 128 * AT_VP, AT_BUF = AT_KB + AT_VB;
static_assert(2 * AT_BUF <= RING_BYTES, "attention LDS");
__device__ __forceinline__ void ph5_attn(ArgsP A, Frame& F) {
    unsigned char* ws = A->ws; const bf16_t* PROJ = (const bf16_t*)(ws + WS_PROJ); const bf16_t* VT = (const bf16_t*)(ws + WS_VT); const unsigned* MASK = (const unsigned*)(ws + WS_MASK); bf16_t* YB = (bf16_t*)(ws + WS_YB);
    LAS unsigned char* L = F.lds + RING_OFF; const int tid = F.tid, wave = F.wave, lane = F.lane, r = lane & 31, hh = lane >> 5;
    const float NEG = -__builtin_inff();
    for (int u = F.vcu; u < 256; u += F.G) { const int h = u >> 4, pr = u & 15;
      for (int half = 0; half < 2; ++half) { const int ib = half == 0 ? (31 - pr) : pr;
        const int q0 = ib * MBLK + wave * 32;
        bf16x8 qf[8];
#pragma unroll
        for (int ks = 0; ks < 8; ++ks) qf[ks] = *(const bf16x8*)(PROJ + (size_t)(q0 + r) * PLD + PC_MQ + h * MD + 16 * ks + 8 * hh);
        const unsigned msk = MASK[(q0 + r) * MH + h];
        f32x16 o[4];
#pragma unroll
        for (int db = 0; db < 4; ++db)
#pragma unroll
            for (int e = 0; e < 16; ++e) o[db][e] = 0.f;
        float mrun = NEG, lrun = 0.f;
        const int ntile = 4 + 4 * ib;
        u32x4 sk[2], sv[2];
        auto tile_tok = [&](int n) { return n < 4 ? ib * MBLK + n * 64 : ((n - 4) >> 2) * MBLK + ((n - 4) & 3) * 64; };
        auto issue = [&](int n) { const int tb = tile_tok(n);
#pragma unroll
            for (int i = 0; i < 2; ++i) { const int row = (tid >> 4) + 32 * i, c16 = tid & 15; sk[i] = *(const u32x4*)(PROJ + (size_t)(tb + row) * PLD + PC_MK + h * MD + 8 * c16); }
#pragma unroll
            for (int i = 0; i < 2; ++i) { const int row = (tid >> 3) + 64 * i, c16 = tid & 7; sv[i] = *(const u32x4*)(VT + (size_t)(h * MD + row) * T + tb + 8 * c16); } };
        auto commit = [&](int buf) { LAS unsigned char* B = L + buf * AT_BUF;
#pragma unroll
            for (int i = 0; i < 2; ++i) { const int row = (tid >> 4) + 32 * i, c16 = tid & 15; *(LAS u32x4*)(B + row * AT_KP + 16 * c16) = sk[i]; }
#pragma unroll
            for (int i = 0; i < 2; ++i) { const int row = (tid >> 3) + 64 * i, c16 = tid & 7; LAS unsigned char* p = B + AT_KB + row * AT_VP + 16 * c16; *(LAS u32x2*)p = (u32x2){sv[i].x, sv[i].y}; *(LAS u32x2*)(p + 8) = (u32x2){sv[i].z, sv[i].w}; } };
        issue(0); VM_WAIT(); commit(0); WG_BAR();
        for (int n = 0; n < ntile; ++n) {
            if (n + 1 < ntile) issue(n + 1);
            bool need; int jblk = -1, tt = 0;
            if (n < 4) { tt = n; need = tt <= (wave >> 1); } else { jblk = (n - 4) >> 2; need = __ballot((msk >> jblk) & 1u) != 0ull; }
            if (need) {
                const LAS unsigned char* KB = L + (n & 1) * AT_BUF; const LAS unsigned char* VB = KB + AT_KB;
                f32x16 s[2];
#pragma unroll
                for (int kb = 0; kb < 2; ++kb) {
#pragma unroll
                    for (int e = 0; e < 16; ++e) s[kb][e] = 0.f;
#pragma unroll
                    for (int ks = 0; ks < 8; ++ks) { const bf16x8 a = *(const LAS bf16x8*)(KB + (32 * kb + r) * AT_KP + 32 * ks + 16 * hh); s[kb] = __builtin_amdgcn_mfma_f32_32x32x16_bf16(a, qf[ks], s[kb], 0, 0, 0); } }
                if (n < 4) { const int qrel = wave * 32 + r;
#pragma unroll
                    for (int kb = 0; kb < 2; ++kb)
#pragma unroll
                        for (int e = 0; e < 16; ++e) { const int krel = 64 * tt + 32 * kb + (e & 3) + 8 * (e >> 2) + 4 * hh; if (krel > qrel) s[kb][e] = NEG; } }
                else if (!((msk >> jblk) & 1u)) {
#pragma unroll
                    for (int kb = 0; kb < 2; ++kb)
#pragma unroll
                        for (int e = 0; e < 16; ++e) s[kb][e] = NEG; }
                float mx = s[0][0];
#pragma unroll
                for (int kb = 0; kb < 2; ++kb)
#pragma unroll
                    for (int e = 0; e < 16; ++e) mx = fmaxf(mx, s[kb][e]);
                mx = fmaxf(mx, __shfl_xor(mx, 32));
                const float mnew = fmaxf(mrun, mx); const float alpha = exp2f(mrun - mnew); mrun = mnew;
                float ps = 0.f;
#pragma unroll
                for (int kb = 0; kb < 2; ++kb)
#pragma unroll
                    for (int e = 0; e < 16; ++e) { const float p = exp2f(s[kb][e] - mnew); s[kb][e] = p; ps += p; }
                lrun = lrun * alpha + ps;
#pragma unroll
                for (int db = 0; db < 4; ++db)
#pragma unroll
                    for (int e = 0; e < 16; ++e) o[db][e] *= alpha;
#pragma unroll
                for (int kb = 0; kb < 2; ++kb)
#pragma unroll
                    for (int st = 0; st < 2; ++st) { u32x4 pw; pw.x = pk2(s[kb][8 * st + 0], s[kb][8 * st + 1]); pw.y = pk2(s[kb][8 * st + 2], s[kb][8 * st + 3]); pw.z = pk2(s[kb][8 * st + 4], s[kb][8 * st + 5]); pw.w = pk2(s[kb][8 * st + 6], s[kb][8 * st + 7]);
                        const bf16x8 pf = __builtin_bit_cast(bf16x8, pw); const int kbase = 32 * kb + 16 * st + 4 * hh;
#pragma unroll
                        for (int db = 0; db < 4; ++db) { const LAS unsigned char* vp = VB + (32 * db + r) * AT_VP + 2 * kbase; const u32x2 lo = *(const LAS u32x2*)vp, hi = *(const LAS u32x2*)(vp + 16);
                            const bf16x8 vf = __builtin_bit_cast(bf16x8, (u32x4){lo.x, lo.y, hi.x, hi.y}); o[db] = __builtin_amdgcn_mfma_f32_32x32x16_bf16(vf, pf, o[db], 0, 0, 0); } }
            }
            if (n + 1 < ntile) { VM_WAIT(); commit((n + 1) & 1); }
            WG_BAR();
        }
        const float ltot = lrun + __shfl_xor(lrun, 32); const float inv = 1.0f / ltot;
        bf16_t* op = YB + (size_t)(q0 + r) * RW + h * MD;
#pragma unroll
        for (int db = 0; db < 4; ++db)
#pragma unroll
            for (int g = 0; g < 4; ++g) { u32x2 w; w.x = pk2(o[db][4 * g] * inv, o[db][4 * g + 1] * inv); w.y = pk2(o[db][4 * g + 2] * inv, o[db][4 * g + 3] * inv); *(u32x2*)(op + 32 * db + 8 * g + 4 * hh) = w; }
      }
    }
}

__device__ __forceinline__ void ins16(float (&top)[16], float x) {
#pragma unroll
    for (int k = 15; k >= 1; --k) top[k] = __builtin_amdgcn_fmed3f(top[k - 1], top[k], x);
    top[0] = fmaxf(top[0], x);
}
__device__ __forceinline__ void ph10_select(ArgsP A, Frame& F) {
    unsigned char* ws = A->ws; const bf16_t* PQ = (const bf16_t*)(ws + WS_PQ); const bf16_t* SK = (const bf16_t*)(ws + WS_SUBK); int* IDX = (int*)(ws + WS_IDX); float* GW = (float*)(ws + WS_GW);
    const int gw = F.vcu * NWAVES + F.wave, NGW = F.G * NWAVES; const int r = F.lane & 31, hh = F.lane >> 5; const float NEG = -__builtin_inff();
    for (int it = gw; it < (T / 32) * PH_; it += NGW) { const int tg = it >> 3, h = it & 7, t = tg * 32 + r;
        float TA[16], TB[16];
        auto topk = [&](int p, float (&dst)[16]) {
            bf16x8 qf[8];
#pragma unroll
            for (int ks = 0; ks < 8; ++ks) qf[ks] = *(const bf16x8*)(PQ + (size_t)t * 2048 + (h * 2 + p) * PHALF + 16 * ks + 8 * hh);
            float top[16];
#pragma unroll
            for (int k = 0; k < 16; ++k) top[k] = NEG;
#pragma unroll 1
            for (int nb = 0; nb < 4; ++nb) { f32x16 acc;
#pragma unroll
                for (int e = 0; e < 16; ++e) acc[e] = 0.f;
#pragma unroll
                for (int ks = 0; ks < 8; ++ks) { const bf16x8 a = *(const bf16x8*)(SK + ((size_t)(h * 2 + p) * PNK + 32 * nb + r) * PHALF + 16 * ks + 8 * hh); acc = __builtin_amdgcn_mfma_f32_32x32x16_bf16(a, qf[ks], acc, 0, 0, 0); }
#pragma unroll
                for (int e = 0; e < 16; ++e) { const unsigned key = 32 * nb + (e & 3) + 8 * (e >> 2) + 4 * hh; float ae = acc[e]; asm volatile("" : "+v"(ae));
                    const float x = __builtin_bit_cast(float, (__builtin_bit_cast(unsigned, ae) & ~0x7Fu) | key); ins16(top, x); } }
            float oth[16];
#pragma unroll
            for (int k = 0; k < 16; ++k) oth[k] = __shfl_xor(top[k], 32);
#pragma unroll
            for (int k = 0; k < 16; ++k) ins16(top, oth[k]);
#pragma unroll
            for (int k = 0; k < 16; ++k) dst[k] = top[k];
        };
        topk(0, TA); asm volatile("" ::: "memory"); __builtin_amdgcn_sched_barrier(0); topk(1, TB); asm volatile("" ::: "memory"); __builtin_amdgcn_sched_barrier(0);
        float fin[16];
#pragma unroll
        for (int k = 0; k < 16; ++k) fin[k] = NEG;
#pragma unroll
        for (int i = 0; i < 16; ++i)
#pragma unroll
            for (int j = 0; j < 16; ++j) if ((i + 1) * (j + 1) <= 16) { const float sm = TA[i] + TB[j]; ins16(fin, __builtin_bit_cast(float, (__builtin_bit_cast(unsigned, sm) & ~0xFFu) | (unsigned)(i * 16 + j))); }
        float e[16], den = 0.f;
#pragma unroll
        for (int k = 0; k < 16; ++k) { e[k] = __expf(fin[k] - fin[0]); den += e[k]; }
        const float rden = 1.0f / den;
        int oi[8]; float og[8];
#pragma unroll
        for (int kk = 0; kk < 8; ++kk) { const float fv = hh ? fin[8 + kk] : fin[kk]; og[kk] = (hh ? e[8 + kk] : e[kk]) * rden; const unsigned id = __builtin_bit_cast(unsigned, fv) & 0xFFu; const unsigned ci = id >> 4, cj = id & 15u;
            unsigned ia = 0u, ib = 0u;
#pragma unroll
            for (int q = 0; q < 16; ++q) { ia = (ci == (unsigned)q) ? (__builtin_bit_cast(unsigned, TA[q]) & 0x7Fu) : ia; ib = (cj == (unsigned)q) ? (__builtin_bit_cast(unsigned, TB[q]) & 0x7Fu) : ib; }
            oi[kk] = (int)(ia * PNK + ib); }
        int* ip = IDX + (size_t)t * 128 + h * 16 + 8 * hh; float* gp = GW + (size_t)t * 128 + h * 16 + 8 * hh;
        *(u32x4*)ip = (u32x4){(unsigned)oi[0], (unsigned)oi[1], (unsigned)oi[2], (unsigned)oi[3]}; *(u32x4*)(ip + 4) = (u32x4){(unsigned)oi[4], (unsigned)oi[5], (unsigned)oi[6], (unsigned)oi[7]};
        *(f32x4*)gp = (f32x4){og[0], og[1], og[2], og[3]}; *(f32x4*)(gp + 4) = (f32x4){og[4], og[5], og[6], og[7]};
    }
}


__device__ __forceinline__ float ub0(unsigned w) { return (float)(w & 0xffu); }
__device__ __forceinline__ float ub1(unsigned w) { return (float)((w >> 8) & 0xffu); }
__device__ __forceinline__ float ub2(unsigned w) { return (float)((w >> 16) & 0xffu); }
__device__ __forceinline__ float ub3(unsigned w) { return (float)(w >> 24); }
__device__ __forceinline__ float dot16q(u32x4 q, const float (&h)[16]) {
    return ((ub0(q.x) * h[0] + ub1(q.x) * h[1]) + (ub2(q.x) * h[2] + ub3(q.x) * h[3])) + ((ub0(q.y) * h[4] + ub1(q.y) * h[5]) + (ub2(q.y) * h[6] + ub3(q.y) * h[7]))
         + ((ub0(q.z) * h[8] + ub1(q.z) * h[9]) + (ub2(q.z) * h[10] + ub3(q.z) * h[11])) + ((ub0(q.w) * h[12] + ub1(q.w) * h[13]) + (ub2(q.w) * h[14] + ub3(q.w) * h[15]));
}
__device__ __forceinline__ void ph11_gather(ArgsP A, Frame& F) {
    unsigned char* ws = A->ws; const bf16_t* H2 = (const bf16_t*)(ws + WS_H2); const unsigned char* PU = (const unsigned char*)(ws + WS_PU); const unsigned char* PV = (const unsigned char*)(ws + WS_PV);
    const float* PSU = (const float*)(ws + WS_PSU); const float* PSV = (const float*)(ws + WS_PSV);
    const int* IDX = (const int*)(ws + WS_IDX); const float* GW = (const float*)(ws + WS_GW); const float* X1 = (const float*)(ws + WS_X1);
    LAS float* coef = (LAS float*)(F.lds + RING_OFF); LAS int* eidx = (LAS int*)(F.lds + RING_OFF + 1024); LAS float* red = (LAS float*)(F.lds + RING_OFF + 2048);
    const int tid = F.tid, wave = F.wave, lane = F.lane; int par = 0;
    for (int t = F.vcu; t < T; t += F.G, par ^= 1) {
        float hv[4][16]; float hs = 0.f;
#pragma unroll
        for (int i = 0; i < 4; ++i) { const bf16_t* hp = H2 + (size_t)t * D + i * 1024 + lane * 16; f32x4 a, b, c, d; pg8::unpack8(*(const u32x4*)hp, a, b); pg8::unpack8(*(const u32x4*)(hp + 8), c, d);
#pragma unroll
            for (int e = 0; e < 4; ++e) { hv[i][e] = a[e]; hv[i][4 + e] = b[e]; hv[i][8 + e] = c[e]; hv[i][12 + e] = d[e]; }
            hs += ((a[0] + a[1]) + (a[2] + a[3])) + ((b[0] + b[1]) + (b[2] + b[3])) + ((c[0] + c[1]) + (c[2] + c[3])) + ((d[0] + d[1]) + (d[2] + d[3])); }
        hs = wave_sum(hs);
        const int myidx = (lane < 16) ? IDX[(size_t)t * 128 + wave * 16 + lane] : 0; const float myg = (lane < 16) ? GW[(size_t)t * 128 + wave * 16 + lane] : 0.f;
        float dots = 0.f;
#pragma unroll 1
        for (int k = 0; k < 16; k += 4) {
            u32x4 q[4][4];
#pragma unroll
            for (int x = 0; x < 4; ++x) { const int e = __builtin_amdgcn_readlane(myidx, k + x); const unsigned char* up = PU + (size_t)e * D + lane * 16;
#pragma unroll
                for (int i = 0; i < 4; ++i) q[x][i] = *(const u32x4*)(up + i * 1024); }
#pragma unroll
            for (int x = 0; x < 4; ++x) { float d = 0.f;
#pragma unroll
                for (int i = 0; i < 4; ++i) d += dot16q(q[x][i], hv[i]);
                d = wave_sum(d); if (lane == k + x) dots = d; }
        }
        if (lane < 16) { const float s = PSU[myidx] * (dots - 128.0f * hs); const float act = 0.5f * s * (1.0f + erff(s * 0.70710678118654752f));
            coef[par * 128 + wave * 16 + lane] = myg * act * PSV[myidx]; eidx[par * 128 + wave * 16 + lane] = myidx; }
        WG_BAR();
        float acc[8]; float csum = 0.f;
#pragma unroll
        for (int i = 0; i < 8; ++i) acc[i] = 0.f;
#pragma unroll 1
        for (int e = 0; e < 128; e += 8) { u32x2 v[8]; float c[8];
#pragma unroll
            for (int q = 0; q < 8; ++q) { const int ei = __builtin_amdgcn_readfirstlane(eidx[par * 128 + e + q]); c[q] = coef[par * 128 + e + q]; v[q] = *(const u32x2*)(PV + (size_t)ei * D + tid * 8); }
#pragma unroll
            for (int q = 0; q < 8; ++q) { csum += c[q]; acc[0] += c[q] * ub0(v[q].x); acc[1] += c[q] * ub1(v[q].x); acc[2] += c[q] * ub2(v[q].x); acc[3] += c[q] * ub3(v[q].x); acc[4] += c[q] * ub0(v[q].y); acc[5] += c[q] * ub1(v[q].y); acc[6] += c[q] * ub2(v[q].y); acc[7] += c[q] * ub3(v[q].y); } }
        const float corr = -128.0f * csum;
        const f32x4 x0 = *(const f32x4*)(X1 + (size_t)t * D + tid * 8), x1 = *(const f32x4*)(X1 + (size_t)t * D + tid * 8 + 4);
        f32x4 y0 = x0 + ((f32x4){acc[0], acc[1], acc[2], acc[3]} + corr), y1 = x1 + ((f32x4){acc[4], acc[5], acc[6], acc[7]} + corr);
        float ss = (y0[0] * y0[0] + y0[1] * y0[1]) + (y0[2] * y0[2] + y0[3] * y0[3]) + (y1[0] * y1[0] + y1[1] * y1[1]) + (y1[2] * y1[2] + y1[3] * y1[3]);
        ss = wave_sum(ss); if (lane == 0) red[par * 8 + wave] = ss;
        WG_BAR();
        float tot = 0.f;
#pragma unroll
        for (int w = 0; w < 8; ++w) tot += red[par * 8 + w];
        const float rs = 1.0f / sqrtf(tot * (1.0f / D) + NORM_EPS);
        const f32x4 g0 = *(const f32x4*)(A->final_g + tid * 8), g1 = *(const f32x4*)(A->final_g + tid * 8 + 4);
        *(f32x4*)(A->out + (size_t)t * D + tid * 8) = y0 * rs * g0; *(f32x4*)(A->out + (size_t)t * D + tid * 8 + 4) = y1 * rs * g1;
    }
}

constexpr int NPH = 12;
__device__ __forceinline__ Frame make_frame(unsigned char* lds) {
    Frame F; int t = threadIdx.x; asm volatile("" : "+v"(t));
    F.lds = (LAS unsigned char*)lds; F.tid = t; F.lane = t & 63; F.wave = __builtin_amdgcn_readfirstlane(t >> 6);
    F.G = gridDim.x; { const int bx = blockIdx.x; F.vcu = (F.G % 8 == 0) ? (bx % 8) * (F.G / 8) + bx / 8 : bx; }
    return F;
}
__global__ void __launch_bounds__(NTHR, 2) mk_fwd(Args args_by_value) {
    extern __shared__ __attribute__((aligned(16))) unsigned char lds[];
    ArgsP args = get_args();
    gu32* ctl = (gu32*)(args->ws + WS_CTL);
    for (int u = threadIdx.x; u < (LDS_BYTES - LDSCTL_OFF) / 4; u += NTHR) ((LAS unsigned*)((LAS unsigned char*)lds + LDSCTL_OFF))[u] = 0u;
    __syncthreads();
    const int lo = args->ph_lo, hi = args->ph_hi;
    volatile LAS unsigned* MISC = (volatile LAS unsigned*)((LAS unsigned char*)lds + MISC_OFF);
    XcdBarrier bar; bar.bar = (unsigned*)(ctl + CW_BAR) + args->li * XCD_BAR_WORDS; bar.x = 0; bar.st = nullptr;
    if (hi - lo > 1) bar = xcd_barrier_post((unsigned*)(ctl + CW_BAR) + args->li * XCD_BAR_WORDS, MISC + 8);
#define IN(k) (lo <= (k) && (k) < hi)
#define SEAM(k) do { if (IN(k) && IN((k) + 1)) xcd_barrier(bar); } while (0)
    const int bid = (int)blockIdx.x;

    if (IN(0)) { Frame F = make_frame(lds); ph0_prologue(get_args(), F); SEAM(0); }
    if (IN(1)) { Frame F = make_frame(lds); LAS unsigned char* ring = F.lds + RING_OFF; ArgsP a_ = get_args(); unsigned char* ws = a_->ws;
        { pg8::Gemm g{(const bf16_t*)(ws + WS_XN), (const bf16_t*)(ws + WS_WIN), T, PLD, D}; pg8::StaticOrder S; S.init(T, PLD, F.G, bid);
          pg8::EpiProj E{(bf16_t*)(ws + WS_PROJ), (const float*)(ws + WS_ROPE)}; pg8::gemm_phase<pg8::EpiProj, pg8::StaticOrder, true, true>(ring, g, S, E); }
        { pg8::Gemm g{(const bf16_t*)(ws + WS_XN), (const bf16_t*)(ws + WS_WIN) + (size_t)PC_MV * D, T, 2048, D}; pg8::StaticOrder S; S.init(T, 2048, F.G, bid);
          pg8::EpiVT E{(bf16_t*)(ws + WS_VT)}; pg8::gemm_phase<pg8::EpiVT, pg8::StaticOrder, true, true>(ring, g, S, E); }
        SEAM(1); }
    if (IN(2)) { Frame F = make_frame(lds); ph2_prep(get_args(), F); SEAM(2); }
    if (IN(3)) { Frame F = make_frame(lds); LAS unsigned char* ring = F.lds + RING_OFF; ArgsP a_ = get_args(); unsigned char* ws = a_->ws;
        { pg8::Gemm g{(const bf16_t*)(ws + WS_AW), (const bf16_t*)(ws + WS_WUP), T, RW, LW}; pg8::StaticOrder S; S.init(T, RW, F.G, bid);
          pg8::EpiDec E{(float*)(ws + WS_DEC), a_->w0}; pg8::gemm_phase<pg8::EpiDec, pg8::StaticOrder, true, true>(ring, g, S, E); }
        asm volatile("" ::: "memory"); __builtin_amdgcn_sched_barrier(0);
        { pg8::Gemm g{(const bf16_t*)(ws + WS_AA), (const bf16_t*)(ws + WS_AUP), T, RW, LA}; pg8::StaticOrder S; S.init(T, RW, F.G, bid);
          pg8::EpiA E{(bf16_t*)(ws + WS_KP), (bf16_t*)(ws + WS_BB), (const bf16_t*)(ws + WS_KKN), a_->a0, a_->k_a}; pg8::gemm_phase<pg8::EpiA, pg8::StaticOrder, true, true>(ring, g, S, E); }
        asm volatile("" ::: "memory"); __builtin_amdgcn_sched_barrier(0);
        { pg8::Gemm g{(const bf16_t*)(ws + WS_AG), (const bf16_t*)(ws + WS_GUP), T, RW, LGP}; pg8::StaticOrder S; S.init(T, RW, F.G, bid);
          pg8::EpiBf16 E{(bf16_t*)(ws + WS_G), RW}; pg8::gemm_phase<pg8::EpiBf16, pg8::StaticOrder, true, true>(ring, g, S, E); }
        { Frame F2 = make_frame(lds); ph3_gate(get_args(), F2); }
        SEAM(3); }
    if (IN(4)) { Frame F = make_frame(lds); ph4_scan(get_args(), F); SEAM(4); }
    if (IN(5)) { { Frame F = make_frame(lds); ph5_ypost(get_args(), F); } { Frame F = make_frame(lds); ph5_attn(get_args(), F); } SEAM(5); }
    if (IN(6)) { Frame F = make_frame(lds); LAS unsigned char* ring = F.lds + RING_OFF; ArgsP a_ = get_args(); unsigned char* ws = a_->ws;
        { pg8::Gemm g{(const bf16_t*)(ws + WS_YA), (const bf16_t*)(ws + WS_WA), T, D, RW}; pg8::StaticOrder S; S.init(T, D, F.G, bid);
          pg8::EpiMix<false> E{(bf16_t*)(ws + WS_MIXED), (const bf16_t*)(ws + WS_PROJ), PC_GA}; pg8::gemm_phase<pg8::EpiMix<false>, pg8::StaticOrder, true, true>(ring, g, S, E); }
        { pg8::Gemm g{(const bf16_t*)(ws + WS_YB), (const bf16_t*)(ws + WS_WB), T, D, RW}; pg8::StaticOrder S; S.init(T, D, F.G, bid);
          pg8::EpiMix<true> E{(bf16_t*)(ws + WS_MIXED), (const bf16_t*)(ws + WS_PROJ), PC_GB}; pg8::gemm_phase<pg8::EpiMix<true>, pg8::StaticOrder, true, true>(ring, g, S, E); }
        SEAM(6); }
    if (IN(7)) { Frame F = make_frame(lds); LAS unsigned char* ring = F.lds + RING_OFF; ArgsP a_ = get_args(); unsigned char* ws = a_->ws;
        pg8::Gemm g{(const bf16_t*)(ws + WS_MIXED), (const bf16_t*)(ws + WS_WOUT), T, D, D}; pg8::StaticOrder S; S.init(T, D, F.G, bid);
        pg8::EpiRes E{(float*)(ws + WS_X1), a_->x}; pg8::gemm_phase<pg8::EpiRes, pg8::StaticOrder, true, true>(ring, g, S, E);
        SEAM(7); }
    if (IN(8)) { Frame F = make_frame(lds); ArgsP a_ = get_args(); unsigned char* ws = a_->ws; const int gw = F.vcu * NWAVES + F.wave, NGW = F.G * NWAVES;
        for (int m = gw; m < T; m += NGW) rms_row_to_bf16((const float*)(ws + WS_X1) + (size_t)m * D, a_->norm2_g, (bf16_t*)(ws + WS_H2) + (size_t)m * D, F.lane);
        SEAM(8); }
    if (IN(9)) { Frame F = make_frame(lds); LAS unsigned char* ring = F.lds + RING_OFF; ArgsP a_ = get_args(); unsigned char* ws = a_->ws;
        pg8::Gemm g{(const bf16_t*)(ws + WS_H2), (const bf16_t*)(ws + WS_WQ), T, 2048, D}; pg8::StaticOrder S; S.init(T, 2048, F.G, bid);
        pg8::EpiBf16 E{(bf16_t*)(ws + WS_PQ), 2048}; pg8::gemm_phase<pg8::EpiBf16, pg8::StaticOrder, true, true>(ring, g, S, E);
        SEAM(9); }
    if (IN(10)) { Frame F = make_frame(lds); ph10_select(get_args(), F); SEAM(10); }
    if (IN(11)) { Frame F = make_frame(lds); ph11_gather(get_args(), F); }
#undef IN
#undef SEAM
}

extern "C" void kernel_launch(void* const* d_in, const int* in_sizes, int n_in, void* d_out, int out_size, void* d_ws, size_t ws_size, hipStream_t stream) {
    static int grid = 0;
    if (grid == 0) {
        if (n_in != 23 || out_size != T * D || ws_size < WS_END) { fprintf(stderr, "kernel_launch: unexpected shapes (n_in %d out %d ws %zu); nothing launched\n", n_in, out_size, ws_size); grid = -1; return; }
        int dev = 0, cus = 0, per_cu = 0;
        if (hipGetDevice(&dev) != hipSuccess || hipDeviceGetAttribute(&cus, hipDeviceAttributeMultiprocessorCount, dev) != hipSuccess) { grid = -1; return; }
        if (hipFuncSetAttribute((const void*)mk_fwd, hipFuncAttributeMaxDynamicSharedMemorySize, LDS_BYTES) != hipSuccess) { grid = -1; return; }
        if (hipOccupancyMaxActiveBlocksPerMultiprocessor(&per_cu, (const void*)mk_fwd, NTHR, LDS_BYTES) != hipSuccess || per_cu < 1) fprintf(stderr, "kernel_launch: occupancy query reports %d\n", per_cu);
        (void)hipGetLastError();
        grid = cus;
    }
    if (grid < 0) return;
    (void)hipMemsetAsync((char*)d_ws + WS_CTL, 0, CTL_ZERO_BYTES, stream);
    Args a{};
    const float** ap = (const float**)&a;
    for (int i = 0; i < 23; ++i) ap[i] = (const float*)d_in[i];
    a.out = (float*)d_out; a.ws = (unsigned char*)d_ws; a.pad = 0;
    constexpr int NL = MK_N_LAUNCHES;
    for (int li = 0; li < NL; ++li) {
        a.ph_lo = (NL == 1) ? 0 : li; a.ph_hi = (NL == 1) ? NPH : li + 1; a.li = (NL == 1) ? 0 : 0;
        hipLaunchKernelGGL(mk_fwd, dim3(grid), dim3(NTHR), LDS_BYTES, stream, a);
    }
}
```

```cpp
#include <hip/hip_runtime.h>
#include <cstdio>
#include <cstdint>

#ifndef MK_N_LAUNCHES
#define MK_N_LAUNCHES 1
#endif

#define GAS __attribute__((address_space(1)))
#define LAS __attribute__((address_space(3)))
typedef unsigned short bf16_t;
typedef __bf16 bf16x8 __attribute__((ext_vector_type(8)));
typedef float f32x2 __attribute__((ext_vector_type(2)));
typedef float f32x4 __attribute__((ext_vector_type(4)));
typedef float f32x16 __attribute__((ext_vector_type(16)));
typedef unsigned u32x2 __attribute__((ext_vector_type(2)));
typedef unsigned u32x4 __attribute__((ext_vector_type(4)));
typedef GAS unsigned gu32;

constexpr int T = 8192, D = 4096;
constexpr int RW = 2048, RH = 32, RN = 64;
constexpr int LW = 128, LA = 128, LG = 480, LGP = 512;
constexpr int SHIFTW = 6880;
constexpr int MH = 16, MD = 128, MBLK = 256, NBLK = 32;
constexpr int INW = 21216;
constexpr int PLD = 19200;
constexpr int PC_R = 0, PC_K = 2048, PC_V = 4096, PC_WL = 6144, PC_AL = 6272, PC_GL = 6400, PC_MQ = 6912, PC_MK = 8960, PC_GA = 11008, PC_GB = 15104, PC_MV = 19200;
constexpr int WIN_ROWS = 21248;
constexpr int PH_ = 8, PNK = 128, PQD = 256, PHALF = 128, PTOPK = 16;
constexpr float NORM_EPS = 1e-6f, LNX_EPS = 64e-5f;
constexpr float QSCALE = 0.08838834764831845f * 1.4426950408889634f;

constexpr size_t MiB = 1u << 20;
constexpr size_t WS_CTL = 0, CTL_ZERO_BYTES = 1 * MiB;
constexpr size_t WS_WIN = 1 * MiB;
constexpr size_t WS_X1 = 1 * MiB, WS_PQ = 129 * MiB;
constexpr size_t WS_WA = 167 * MiB, WS_WB = 183 * MiB, WS_WOUT = 199 * MiB, WS_WQ = 231 * MiB, WS_WUP = 247 * MiB, WS_AUP = 248 * MiB, WS_GUP = 249 * MiB, WS_SUBK = 251 * MiB;
constexpr size_t WS_PU = 252 * MiB, WS_PV = 380 * MiB;
constexpr size_t WS_XN = 508 * MiB;
constexpr size_t WS_Y = 508 * MiB, WS_H2 = 508 * MiB;
constexpr size_t WS_PROJ = 572 * MiB;
constexpr size_t WS_VT = 872 * MiB;
constexpr size_t WS_ROPE = 904 * MiB, WS_KMEAN = 908 * MiB, WS_MASK = 909 * MiB, WS_AW = 910 * MiB, WS_AA = 912 * MiB, WS_AG = 914 * MiB;
constexpr size_t WS_PSU = 909 * MiB + 512 * 1024, WS_PSV = WS_PSU + 64 * 1024;
constexpr size_t WS_DEC = 922 * MiB;
constexpr size_t WS_MIXED = 922 * MiB;
constexpr size_t WS_KKN = 986 * MiB, WS_BB = 1018 * MiB, WS_KP = 1050 * MiB, WS_ZR = 1082 * MiB, WS_ZV = 1114 * MiB, WS_G = 1146 * MiB;
constexpr size_t WS_YA = 1178 * MiB, WS_YB = 1210 * MiB, WS_IDX = 1242 * MiB, WS_GW = 1246 * MiB, WS_END = 1250 * MiB;

constexpr int CW_TMO = 0, CW_CODE = 1, CW_BAR = 4096;

constexpr int RING_OFF = 0, RING_BYTES = 131072;
constexpr int LDSCTL_OFF = RING_BYTES, MISC_OFF = LDSCTL_OFF + 320;
constexpr int LDS_BYTES = 147456;
constexpr int NWAVES = 8, NTHR = 512;

__device__ __forceinline__ unsigned f2bf(float f) { unsigned u = __builtin_bit_cast(unsigned, f); return (u + 0x7fffu + ((u >> 16) & 1u)) >> 16; }
__device__ __forceinline__ unsigned pk2(float lo, float hi) { unsigned r; asm volatile("v_cvt_pk_bf16_f32 %0, %1, %2" : "=v"(r) : "v"(lo), "v"(hi)); return r; }
__device__ __forceinline__ float bflo(unsigned u) { return __builtin_bit_cast(float, u << 16); }
__device__ __forceinline__ float bfhi(unsigned u) { return __builtin_bit_cast(float, u & 0xffff0000u); }
__device__ __forceinline__ float bf1(bf16_t b) { return __builtin_bit_cast(float, (unsigned)b << 16); }
__device__ __forceinline__ float fsigmoid(float x) { return __builtin_amdgcn_rcpf(1.0f + __expf(-x)); }
__device__ __forceinline__ float wave_sum(float v) {
#pragma unroll
    for (int o = 1; o < 64; o <<= 1) v += __shfl_xor(v, o);
    return v;
}
template <int CTRL> __device__ __forceinline__ float dpp_f(float v) { return __builtin_bit_cast(float, __builtin_amdgcn_update_dpp(0, __builtin_bit_cast(int, v), CTRL, 0xF, 0xF, true)); }
__device__ __forceinline__ float sum16(float x) {
    x += dpp_f<0xB1>(x); x += dpp_f<0x4E>(x); x += dpp_f<0x141>(x); x += dpp_f<0x140>(x); return x;
}
#define LDS_WAIT() asm volatile("s_waitcnt lgkmcnt(0)" ::: "memory")
#define VM_WAIT() asm volatile("s_waitcnt vmcnt(0)" ::: "memory")
#define WG_BAR() do { asm volatile("s_waitcnt lgkmcnt(0)" ::: "memory"); __builtin_amdgcn_s_barrier(); asm volatile("" ::: "memory"); } while (0)

namespace pg8 {
constexpr int BM = 256, BK = 64, HALF = 128, HTB = HALF * BK * 2, STAGE_BYTES = 8 * HTB, NXCD = 8, WGM = 8;
__host__ __device__ __forceinline__ int lds_byte(int r, int c) { const int st = (r >> 4) * 2 + (c >> 5), rr = r & 15, cc = c & 31, ob = rr * 64 + cc * 2; return st * 1024 + (ob ^ (((ob >> 9) & 1) << 5)); }
__host__ __device__ __forceinline__ void stage_rc(int b, int& R, int& C) { const int st = b / 1024, sb = b % 1024, swz = sb ^ (((sb >> 9) & 1) << 5); R = (st >> 1) * 16 + swz / 64; C = (st & 1) * 32 + (swz % 64) / 2; }
__host__ __device__ __forceinline__ int perm32(int rho) { const int n = rho >> 4, i = rho & 15; return 8 * (i >> 2) + 4 * n + (i & 3); }

struct Unit { int pm, pn; };
struct Gemm { const bf16_t* A; const bf16_t* Bt; int M, N, K; };

struct StaticOrder {
    int nM, nN, nwg, G, c;
    __host__ __device__ void init(int M, int N, int G_, int c_) { nM = M / BM; nN = N / BM; nwg = nM * nN; G = G_; c = c_; }
    __host__ __device__ bool next(int i, Unit& u) const {
        const long L = (long)i * G + c; if (L >= nwg) return false;
        int wgid = (int)L; { const int q = nwg / NXCD, r = nwg % NXCD, xcd = wgid % NXCD, off = wgid / NXCD; wgid = (xcd < r ? xcd * (q + 1) : r * (q + 1) + (xcd - r) * q) + off; }
        const int nig = WGM * nN, gid = wgid / nig, fm = gid * WGM, gsz = (nM - fm) < WGM ? (nM - fm) : WGM;
        u.pm = fm + ((wgid % nig) % gsz); u.pn = (wgid % nig) / gsz; return true;
    }
    __device__ __forceinline__ void a_ready(const Unit&) const {}
    __device__ __forceinline__ void done(const Unit&) const {}
};

template <class Epi, class Sched, bool ALIGN_EPI = false, bool SP2 = false>
__device__ __forceinline__ void gemm_phase(LAS unsigned char* lds, const Gemm g, const Sched& S, const Epi& E) {
    int tid_ = threadIdx.x; asm volatile("" : "+v"(tid_));
    const int tid = tid_, wid = __builtin_amdgcn_readfirstlane(tid >> 6), lane = tid & 63, wr = wid >> 2, wc = wid & 3, fr = lane & 15, fq = lane >> 4;
    const int K = g.K, nt = K / BK;
    unsigned voffA[2], voffB[2];
#pragma unroll
    for (int i = 0; i < 2; ++i) { int R, C; stage_rc(tid * 16 + i * 8192, R, C); const int Rb = Epi::PERM ? ((R & ~31) + perm32(R & 31)) : R;
        voffA[i] = (unsigned)(R * K + C) * 2u; voffB[i] = (unsigned)(Rb * K + C) * 2u; }
    const size_t kstep = (size_t)(BK * 2);
    const size_t hstep = (size_t)HALF * K * 2;
    const size_t tstep = 2 * hstep;
    const unsigned ldsw = (unsigned)wid * 1024u;
    const int aoff = lds_byte(wr * 64 + fr, fq * 8), boff = lds_byte(wc * 32 + fr, fq * 8);
#define PG8_SA(b, h) (((b) * 2 + (h)) * HTB)
#define PG8_SB(b, h) ((4 + (b) * 2 + (h)) * HTB)
#define PG8_STAGE(bufoff, gbase, voff) do { _Pragma("unroll") for (int _i = 0; _i < 2; ++_i) \
        __builtin_amdgcn_global_load_lds((const unsigned*)((const char*)(gbase) + (voff)[_i]), (LAS unsigned*)(lds + (bufoff) + ldsw + _i * 8192), 16, 0, 0); } while (0)
#define PG8_LDA(dst, b, h) do { _Pragma("unroll") for (int m = 0; m < 4; ++m) _Pragma("unroll") for (int k = 0; k < 2; ++k) dst[m][k] = *(const LAS bf16x8*)(lds + PG8_SA(b, h) + aoff + m * 2048 + k * 1024); } while (0)
#define PG8_LDB(dst, b, h) do { _Pragma("unroll") for (int n = 0; n < 2; ++n) _Pragma("unroll") for (int k = 0; k < 2; ++k) dst[n][k] = *(const LAS bf16x8*)(lds + PG8_SB(b, h) + boff + n * 2048 + k * 1024); } while (0)
#define PG8_MMA(ai, bj, At, Bt) do { __builtin_amdgcn_s_setprio(1); _Pragma("unroll") for (int m = 0; m < 4; ++m) _Pragma("unroll") for (int n = 0; n < 2; ++n) _Pragma("unroll") for (int k = 0; k < 2; ++k) { \
        if constexpr (Epi::SWAP) acc[ai][bj][m][n] = __builtin_amdgcn_mfma_f32_16x16x32_bf16(At[m][k], Bt[n][k], acc[ai][bj][m][n], 0, 0, 0); \
        else acc[ai][bj][m][n] = __builtin_amdgcn_mfma_f32_16x16x32_bf16(Bt[n][k], At[m][k], acc[ai][bj][m][n], 0, 0, 0); } __builtin_amdgcn_s_setprio(0); } while (0)
#define PG8_WAIT_V(n) asm volatile("s_waitcnt vmcnt(" #n ")" ::: "memory")
#define PG8_WAIT_L(n) asm volatile("s_waitcnt lgkmcnt(" #n ")" ::: "memory")
#define PG8_BAR __builtin_amdgcn_s_barrier()
#define PG8_SCHED __builtin_amdgcn_sched_barrier(0)
    Unit cur, nxt; int ui = 0;
    if (!S.next(0, cur)) return;
    f32x4 acc[2][2][4][2];
#pragma unroll
    for (int a = 0; a < 2; ++a)
#pragma unroll
        for (int b = 0; b < 2; ++b)
#pragma unroll
            for (int m = 0; m < 4; ++m)
#pragma unroll
                for (int n = 0; n < 2; ++n) acc[a][b][m][n] = (f32x4){0.f, 0.f, 0.f, 0.f};
    bf16x8 At[4][2], B0[2][2], B1[2][2];
    const char* cA = (const char*)g.A + (size_t)cur.pm * tstep; const char* cB = (const char*)g.Bt + (size_t)cur.pn * tstep;
    S.a_ready(cur);
    if constexpr (SP2) {
        PG8_STAGE(PG8_SB(0, 0), cB, voffB); PG8_STAGE(PG8_SB(0, 1), cB + hstep, voffB); PG8_STAGE(PG8_SA(0, 0), cA, voffA); PG8_STAGE(PG8_SA(0, 1), cA + hstep, voffA);
        if (wr == 1) PG8_BAR;
        PG8_WAIT_V(2); PG8_BAR;
        PG8_STAGE(PG8_SB(1, 0), cB + kstep, voffB); PG8_STAGE(PG8_SA(1, 0), cA + kstep, voffA); PG8_STAGE(PG8_SB(1, 1), cB + hstep + kstep, voffB);
        PG8_WAIT_V(6); PG8_BAR;
    } else {
        PG8_STAGE(PG8_SB(0, 0), cB, voffB); PG8_STAGE(PG8_SA(0, 0), cA, voffA); PG8_STAGE(PG8_SB(0, 1), cB + hstep, voffB); PG8_STAGE(PG8_SA(0, 1), cA + hstep, voffA);
        if (wr == 1) PG8_BAR;
        PG8_WAIT_V(4); PG8_BAR;
        PG8_STAGE(PG8_SB(1, 0), cB + kstep, voffB); PG8_STAGE(PG8_SA(1, 0), cA + kstep, voffA); PG8_STAGE(PG8_SB(1, 1), cB + hstep + kstep, voffB);
        PG8_WAIT_V(6); PG8_BAR;
    }
    for (;;) {
        const bool has_next = S.next(ui + 1, nxt);
        const char* nA = has_next ? (const char*)g.A + (size_t)nxt.pm * tstep : cA; const char* nB = has_next ? (const char*)g.Bt + (size_t)nxt.pn * tstep : cB;
        for (int t = 0; t < nt; t += 2) {
            const bool last = (t == nt - 2);
            const char* a1 = cA + (size_t)(t + 1) * kstep;
            const char* a2 = last ? nA : cA + (size_t)(t + 2) * kstep; const char* b2 = last ? nB : cB + (size_t)(t + 2) * kstep;
            const char* a3 = a2 + kstep; const char* b3 = b2 + kstep;
            if (last && has_next) S.a_ready(nxt);
            if constexpr (SP2) {
            PG8_LDB(B0, 0, 0); PG8_LDB(B1, 0, 1); PG8_SCHED; PG8_LDA(At, 0, 0); PG8_STAGE(PG8_SA(1, 1), a1 + hstep, voffA);
            PG8_WAIT_V(8); PG8_WAIT_L(0); PG8_BAR; PG8_MMA(0, 0, At, B0); PG8_MMA(0, 1, At, B1); PG8_BAR; PG8_SCHED;
            PG8_LDA(At, 0, 1); PG8_STAGE(PG8_SB(0, 0), b2, voffB); PG8_STAGE(PG8_SB(0, 1), b2 + hstep, voffB); PG8_STAGE(PG8_SA(0, 0), a2, voffA);
            PG8_WAIT_V(8); PG8_WAIT_L(0); PG8_BAR; PG8_MMA(1, 0, At, B0); PG8_MMA(1, 1, At, B1); PG8_BAR; PG8_SCHED;
            PG8_LDB(B0, 1, 0); PG8_LDB(B1, 1, 1); PG8_SCHED; PG8_LDA(At, 1, 0); PG8_STAGE(PG8_SA(0, 1), a2 + hstep, voffA);
            PG8_WAIT_V(8); PG8_WAIT_L(0); PG8_BAR; PG8_MMA(0, 0, At, B0); PG8_MMA(0, 1, At, B1); PG8_BAR; PG8_SCHED;
            PG8_LDA(At, 1, 1); PG8_STAGE(PG8_SB(1, 0), b3, voffB); PG8_STAGE(PG8_SB(1, 1), b3 + hstep, voffB); PG8_STAGE(PG8_SA(1, 0), a3, voffA);
            PG8_WAIT_V(8); PG8_WAIT_L(0); PG8_BAR; PG8_MMA(1, 0, At, B0); PG8_MMA(1, 1, At, B1); PG8_BAR; PG8_SCHED;
            } else {
            PG8_LDB(B0, 0, 0); PG8_SCHED; PG8_LDA(At, 0, 0); PG8_STAGE(PG8_SA(1, 1), a1 + hstep, voffA);
            PG8_WAIT_L(8); PG8_BAR; PG8_WAIT_L(0); PG8_MMA(0, 0, At, B0); PG8_BAR; PG8_SCHED;
            PG8_LDB(B1, 0, 1); PG8_STAGE(PG8_SB(0, 0), b2, voffB);
            PG8_BAR; PG8_WAIT_L(0); PG8_MMA(0, 1, At, B1); PG8_BAR;
            PG8_LDA(At, 0, 1); PG8_STAGE(PG8_SA(0, 0), a2, voffA);
            PG8_BAR; PG8_WAIT_L(0); PG8_MMA(1, 0, At, B0); PG8_BAR; PG8_SCHED;
            PG8_STAGE(PG8_SB(0, 1), b2 + hstep, voffB);
            PG8_WAIT_V(6); PG8_BAR; PG8_MMA(1, 1, At, B1); PG8_BAR;
            PG8_LDB(B0, 1, 0); PG8_SCHED; PG8_LDA(At, 1, 0); PG8_STAGE(PG8_SA(0, 1), a2 + hstep, voffA);
            PG8_WAIT_L(8); PG8_BAR; PG8_WAIT_L(0); PG8_MMA(0, 0, At, B0); PG8_BAR; PG8_SCHED;
            PG8_LDB(B1, 1, 1); PG8_STAGE(PG8_SB(1, 0), b3, voffB);
            PG8_BAR; PG8_WAIT_L(0); PG8_MMA(0, 1, At, B1); PG8_BAR;
            PG8_LDA(At, 1, 1); PG8_STAGE(PG8_SA(1, 0), a3, voffA);
            PG8_BAR; PG8_WAIT_L(0); PG8_MMA(1, 0, At, B0); PG8_BAR; PG8_SCHED;
            PG8_STAGE(PG8_SB(1, 1), b3 + hstep, voffB);
            PG8_WAIT_V(6); PG8_BAR; PG8_MMA(1, 1, At, B1); PG8_BAR;
            }
        }
        if constexpr (ALIGN_EPI) { if (wr == 0) PG8_BAR; }
        E(acc, cur, wr, wc, fr, fq); S.done(cur);
        if (!has_next) break;
#pragma unroll
        for (int a = 0; a < 2; ++a)
#pragma unroll
            for (int b = 0; b < 2; ++b)
#pragma unroll
                for (int m = 0; m < 4; ++m)
#pragma unroll
                    for (int n = 0; n < 2; ++n) acc[a][b][m][n] = (f32x4){0.f, 0.f, 0.f, 0.f};
        cur = nxt; cA = nA; cB = nB; ++ui;
        if constexpr (ALIGN_EPI) { if (wr == 1) PG8_BAR; }
    }
    PG8_WAIT_V(0);
    if constexpr (!ALIGN_EPI) { if (wr == 0) PG8_BAR; }
    PG8_BAR;
#undef PG8_SA
#undef PG8_SB
#undef PG8_STAGE
#undef PG8_LDA
#undef PG8_LDB
#undef PG8_MMA
#undef PG8_WAIT_V
#undef PG8_WAIT_L
#undef PG8_BAR
#undef PG8_SCHED
}

typedef const f32x4 (&AccRef)[2][2][4][2];
__device__ __forceinline__ u32x4 pack8(f32x4 v0, f32x4 v1) { u32x4 w; w.x = pk2(v0[0], v0[1]); w.y = pk2(v0[2], v0[3]); w.z = pk2(v1[0], v1[1]); w.w = pk2(v1[2], v1[3]); return w; }
__device__ __forceinline__ void unpack8(u32x4 w, f32x4& v0, f32x4& v1) { v0 = (f32x4){bflo(w.x), bfhi(w.x), bflo(w.y), bfhi(w.y)}; v1 = (f32x4){bflo(w.z), bfhi(w.z), bflo(w.w), bfhi(w.w)}; }

struct EpiBf16 {
    static constexpr bool PERM = true, SWAP = false;
    bf16_t* O; int ldc;
    __device__ __forceinline__ void operator()(AccRef acc, const Unit& u, int wr, int wc, int fr, int fq) const {
        const int row0 = u.pm * BM + wr * 64 + fr, col0 = u.pn * BM + wc * 32 + 8 * fq;
#pragma unroll
        for (int ai = 0; ai < 2; ++ai)
#pragma unroll
            for (int m = 0; m < 4; ++m) { bf16_t* rowp = O + (size_t)(row0 + ai * HALF + m * 16) * ldc + col0;
#pragma unroll
                for (int bj = 0; bj < 2; ++bj) *(u32x4*)(rowp + bj * HALF) = pack8(acc[ai][bj][m][0], acc[ai][bj][m][1]); }
    }
};
struct EpiProj {
    static constexpr bool PERM = true, SWAP = false;
    bf16_t* O; const float* rope;
    __device__ __forceinline__ void operator()(AccRef acc, const Unit& u, int wr, int wc, int fr, int fq) const {
        const int row0 = u.pm * BM + wr * 64 + fr, col0 = u.pn * BM + wc * 32 + 8 * fq;
        const int mode = (u.pn >= 27 && u.pn < 43) ? (u.pn < 35 ? 1 : 2) : 0;
        const float sc = (mode == 1) ? QSCALE : 1.0f;
#pragma unroll
        for (int ai = 0; ai < 2; ++ai)
#pragma unroll
            for (int m = 0; m < 4; ++m) { const int row = row0 + ai * HALF + m * 16; bf16_t* rowp = O + (size_t)row * PLD + col0;
#pragma unroll
                for (int bj = 0; bj < 2; ++bj) { f32x4 v0 = acc[ai][bj][m][0], v1 = acc[ai][bj][m][1];
                    if (mode) { const int i0 = ((col0 + bj * HALF) & 127) >> 1; const f32x4* rp = (const f32x4*)(rope + ((size_t)row * 64 + i0) * 2); const f32x4 c0 = rp[0], c1 = rp[1];
                        f32x4 o0, o1;
                        o0[0] = v0[0] * c0[0] - v0[1] * c0[1]; o0[1] = v0[1] * c0[0] + v0[0] * c0[1]; o0[2] = v0[2] * c0[2] - v0[3] * c0[3]; o0[3] = v0[3] * c0[2] + v0[2] * c0[3];
                        o1[0] = v1[0] * c1[0] - v1[1] * c1[1]; o1[1] = v1[1] * c1[0] + v1[0] * c1[1]; o1[2] = v1[2] * c1[2] - v1[3] * c1[3]; o1[3] = v1[3] * c1[2] + v1[2] * c1[3];
                        v0 = o0 * sc; v1 = o1 * sc; }
                    *(u32x4*)(rowp + bj * HALF) = pack8(v0, v1); } }
    }
};
struct EpiVT {
    static constexpr bool PERM = false, SWAP = true;
    bf16_t* VT;
    __device__ __forceinline__ void operator()(AccRef acc, const Unit& u, int wr, int wc, int fr, int fq) const {
        const int tok0 = u.pm * BM + wr * 64 + 4 * fq, col0 = u.pn * BM + wc * 32 + fr;
#pragma unroll
        for (int ai = 0; ai < 2; ++ai)
#pragma unroll
            for (int m = 0; m < 4; ++m)
#pragma unroll
                for (int bj = 0; bj < 2; ++bj)
#pragma unroll
                    for (int n = 0; n < 2; ++n) { const f32x4 v = acc[ai][bj][m][n]; u32x2 w; w.x = pk2(v[0], v[1]); w.y = pk2(v[2], v[3]);
                        *(u32x2*)(VT + (size_t)(col0 + bj * HALF + n * 16) * T + tok0 + ai * HALF + m * 16) = w; }
    }
};
struct EpiDec {
    static constexpr bool PERM = true, SWAP = false;
    float* O; const float* w0;
    __device__ __forceinline__ void operator()(AccRef acc, const Unit& u, int wr, int wc, int fr, int fq) const {
        const int row0 = u.pm * BM + wr * 64 + fr, col0 = u.pn * BM + wc * 32 + 8 * fq;
#pragma unroll
        for (int bj = 0; bj < 2; ++bj) { const f32x4 b0 = *(const f32x4*)(w0 + col0 + bj * HALF), b1 = *(const f32x4*)(w0 + col0 + bj * HALF + 4);
#pragma unroll
            for (int ai = 0; ai < 2; ++ai)
#pragma unroll
                for (int m = 0; m < 4; ++m) { float* rowp = O + (size_t)(row0 + ai * HALF + m * 16) * RW + col0 + bj * HALF;
#pragma unroll
                    for (int n = 0; n < 2; ++n) { const f32x4 x = acc[ai][bj][m][n] + (n ? b1 : b0); f32x4 o;
#pragma unroll
                        for (int e = 0; e < 4; ++e) { const float z = -x[e]; const float sp = fmaxf(z, 0.f) + __logf(1.0f + __expf(-fabsf(z))); o[e] = __expf(-__expf(-sp - 0.5f)); }
                        *(f32x4*)(rowp + 4 * n) = o; }
                    asm volatile("" ::: "memory"); } }
    }
};
struct EpiA {
    static constexpr bool PERM = true, SWAP = false;
    bf16_t* KP; bf16_t* BB; const bf16_t* KKN; const float* a0; const float* k_a;
    __device__ __forceinline__ void operator()(AccRef acc, const Unit& u, int wr, int wc, int fr, int fq) const {
        const int row0 = u.pm * BM + wr * 64 + fr, col0 = u.pn * BM + wc * 32 + 8 * fq;
#pragma unroll
        for (int bj = 0; bj < 2; ++bj) { const int cb = col0 + bj * HALF;
            const f32x4 b0 = *(const f32x4*)(a0 + cb), b1 = *(const f32x4*)(a0 + cb + 4), ka0 = *(const f32x4*)(k_a + cb), ka1 = *(const f32x4*)(k_a + cb + 4);
#pragma unroll
            for (int ai = 0; ai < 2; ++ai)
#pragma unroll
                for (int m = 0; m < 4; ++m) { const size_t off = (size_t)(row0 + ai * HALF + m * 16) * RW + cb;
                    f32x4 zk0, zk1, kn0, kn1; unpack8(*(const u32x4*)(KP + off), zk0, zk1); unpack8(*(const u32x4*)(KKN + off), kn0, kn1);
                    f32x4 a0v, a1v;
#pragma unroll
                    for (int e = 0; e < 4; ++e) { a0v[e] = fsigmoid(acc[ai][bj][m][0][e] + b0[e]); a1v[e] = fsigmoid(acc[ai][bj][m][1][e] + b1[e]); }
                    const f32x4 kp0 = zk0 * (1.0f + (a0v - 1.0f) * ka0), kp1 = zk1 * (1.0f + (a1v - 1.0f) * ka1);
                    *(u32x4*)(KP + off) = pack8(kp0, kp1); *(u32x4*)(BB + off) = pack8(kn0 * a0v, kn1 * a1v);
                    asm volatile("" ::: "memory"); } }
    }
};
template <bool ADD> struct EpiMix {
    static constexpr bool PERM = true, SWAP = false;
    bf16_t* O; const bf16_t* proj; int gcol0;
    __device__ __forceinline__ void operator()(AccRef acc, const Unit& u, int wr, int wc, int fr, int fq) const {
        const int row0 = u.pm * BM + wr * 64 + fr, col0 = u.pn * BM + wc * 32 + 8 * fq;
#pragma unroll
        for (int ai = 0; ai < 2; ++ai)
#pragma unroll
            for (int m = 0; m < 4; ++m) { const int row = row0 + ai * HALF + m * 16;
#pragma unroll
                for (int bj = 0; bj < 2; ++bj) { f32x4 g0, g1; unpack8(*(const u32x4*)(proj + (size_t)row * PLD + gcol0 + col0 + bj * HALF), g0, g1);
                    f32x4 o0, o1;
#pragma unroll
                    for (int e = 0; e < 4; ++e) { o0[e] = fsigmoid(g0[e]) * acc[ai][bj][m][0][e]; o1[e] = fsigmoid(g1[e]) * acc[ai][bj][m][1][e]; }
                    bf16_t* op = O + (size_t)row * D + col0 + bj * HALF;
                    if (ADD) { f32x4 p0, p1; unpack8(*(const u32x4*)op, p0, p1); o0 += p0; o1 += p1; }
                    *(u32x4*)op = pack8(o0, o1); } }
    }
};
struct EpiRes {
    static constexpr bool PERM = true, SWAP = false;
    float* O; const float* x;
    __device__ __forceinline__ void operator()(AccRef acc, const Unit& u, int wr, int wc, int fr, int fq) const {
        const int row0 = u.pm * BM + wr * 64 + fr, col0 = u.pn * BM + wc * 32 + 8 * fq;
#pragma unroll
        for (int ai = 0; ai < 2; ++ai)
#pragma unroll
            for (int m = 0; m < 4; ++m) { const size_t off = (size_t)(row0 + ai * HALF + m * 16) * D + col0;
#pragma unroll
                for (int bj = 0; bj < 2; ++bj)
#pragma unroll
                    for (int n = 0; n < 2; ++n) *(f32x4*)(O + off + bj * HALF + 4 * n) = *(const f32x4*)(x + off + bj * HALF + 4 * n) + acc[ai][bj][m][n]; }
    }
};
}

#define XB_TMO      128
#define XB_XCNT(j)  (256  + 64 * (j))
#define XB_XSUB(j)  (1280 + 64 * (j))
#define XB_XGEN(j)  (2304 + 64 * (j))
#define XB_TOP      3328
#define XB_TOPGEN   3392
#define XCD_BAR_WORDS 3456
#define XB_SPIN_CAP (1u << 18)
__device__ __forceinline__ unsigned xb_ld(unsigned* p)              { return __hip_atomic_load(p, __ATOMIC_RELAXED, __HIP_MEMORY_SCOPE_AGENT); }
__device__ __forceinline__ unsigned xb_add(unsigned* p, unsigned v) { return __hip_atomic_fetch_add(p, v, __ATOMIC_RELAXED, __HIP_MEMORY_SCOPE_AGENT); }
__device__ __forceinline__ unsigned xb_xcc_id() { return (unsigned)__builtin_amdgcn_s_getreg((3 << 11) | 20) & 0xFu; }
#define XB_SPIN(cond, bar) do { unsigned _sp = 0; while (cond) { __builtin_amdgcn_s_sleep(1); \
    if ((++_sp & 255u) == 0u) { if (xb_ld(&(bar)[XB_TMO])) break; if (_sp > XB_SPIN_CAP) { atomicAdd(&(bar)[XB_TMO], 1u); break; } } } } while (0)
struct XcdBarrier { unsigned* bar; unsigned x; volatile LAS unsigned* st; };
__device__ __forceinline__ XcdBarrier xcd_barrier_post(unsigned* bar, volatile LAS unsigned* st) {
    XcdBarrier b; b.bar = bar; b.x = xb_xcc_id(); b.st = st;
    if (threadIdx.x == 0) (void)xb_add(&bar[XB_XCNT(b.x)], 1u);
    return b;
}
__device__ __forceinline__ void xcd_barrier_complete(unsigned* bar, unsigned x, unsigned& nloc, unsigned& nx) {
    const unsigned G = gridDim.x * gridDim.y * gridDim.z;
    unsigned sum, cnt, mine, sp = 0u;
    for (;;) {
        sum = 0u; cnt = 0u; mine = 0u;
#pragma unroll
        for (unsigned j = 0; j < 16; ++j) { const unsigned c = xb_ld(&bar[XB_XCNT(j)]); sum += c; cnt += (c > 0u) ? 1u : 0u; mine = (j == x) ? c : mine; }
        if (sum == G) break;
        __builtin_amdgcn_s_sleep(1);
        if ((++sp & 255u) == 0u) { if (xb_ld(&bar[XB_TMO])) break; if (sp > XB_SPIN_CAP) { atomicAdd(&bar[XB_TMO], 1u); break; } }
    }
    nloc = mine > 0u ? mine : 1u; nx = cnt > 0u ? cnt : 1u;
}
__device__ __forceinline__ void xcd_barrier(const XcdBarrier& b) {
    asm volatile("s_waitcnt vmcnt(0)" ::: "memory");
    __syncthreads();
    if (threadIdx.x == 0) {
        unsigned* bar = b.bar;
        __builtin_amdgcn_s_waitcnt(0);
        unsigned nloc = b.st[0], nx = b.st[1];
        if (nloc == 0u) { xcd_barrier_complete(bar, b.x, nloc, nx); b.st[0] = nloc; b.st[1] = nx; }
        const unsigned old = xb_add(&bar[XB_XSUB(b.x)], 1u);
        const unsigned gen = old / nloc;
        if (old + 1u == (gen + 1u) * nloc) {
            __builtin_amdgcn_fence(__ATOMIC_RELEASE, "agent");
            asm volatile("s_waitcnt vmcnt(0)" ::: "memory");
            const unsigned og = xb_add(&bar[XB_TOP], 1u);
            const unsigned tg = og / nx;
            if (og + 1u == (tg + 1u) * nx) xb_add(&bar[XB_TOPGEN], 1u);
            else XB_SPIN(xb_ld(&bar[XB_TOPGEN]) == tg, bar);
            __builtin_amdgcn_fence(__ATOMIC_ACQUIRE, "agent");
            xb_add(&bar[XB_XGEN(b.x)], 1u);
            asm volatile("s_waitcnt vmcnt(0)" ::: "memory");
        } else {
            XB_SPIN(xb_ld(&bar[XB_XGEN(b.x)]) == gen, bar);
            __builtin_amdgcn_fence(__ATOMIC_ACQUIRE, "agent");
            asm volatile("s_waitcnt vmcnt(0)" ::: "memory");
        }
    }
    __syncthreads();
}

struct Args {
    const float *x, *norm1_g, *w_in, *mu, *w0, *w_up, *a0, *a_up, *g_up, *k_k, *k_a, *r_k, *lnx_g, *lnx_b, *w_ba, *w_bb, *w_out, *norm2_g, *peer_wq, *sub_keys, *peer_u, *peer_v, *final_g;
    float* out; unsigned char* ws; int ph_lo, ph_hi, li, pad;
};
#define CAS __attribute__((address_space(4)))
typedef const CAS Args* ArgsP;
__device__ __forceinline__ ArgsP get_args() { ArgsP p = (ArgsP)__builtin_amdgcn_kernarg_segment_ptr(); asm volatile("" : "+s"(p)); return p; }
struct Frame { LAS unsigned char* lds; int tid, lane, wave, vcu, G; };

__device__ __forceinline__ int win_dst(int s) {
    if (s < SHIFTW) return s;
    if (s < SHIFTW + 4096) { const int base = (s < SHIFTW + 2048) ? SHIFTW : SHIFTW + 2048; const int m = s - base, head = m >> 7, c = m & 127; const int j = (c < 64) ? 2 * c : 2 * (c - 64) + 1;
        return ((s < SHIFTW + 2048) ? PC_MQ : PC_MK) + head * 128 + j; }
    if (s < SHIFTW + 6144) return PC_MV + (s - (SHIFTW + 4096));
    if (s < SHIFTW + 6144 + 4096) return PC_GA + (s - (SHIFTW + 6144));
    return PC_GB + (s - (SHIFTW + 6144 + 4096));
}
template <bool MAPWIN> __device__ __forceinline__ void p0_transpose_item(const float* W, int K, int N, bf16_t* WT, int Kd, LAS float* scr, int item, int lane) {
    const int nblk = N / 32, kb = item / nblk, nb = item % nblk, k0 = 64 * kb, n0 = 32 * nb;
    { const int krow = lane >> 3, c4 = lane & 7; f32x4 v[8];
#pragma unroll
      for (int i = 0; i < 8; ++i) { const int kk = 8 * i + krow; v[i] = (k0 + kk < K) ? *(const f32x4*)(W + (size_t)(k0 + kk) * N + n0 + 4 * c4) : (f32x4){0.f, 0.f, 0.f, 0.f}; }
#pragma unroll
      for (int i = 0; i < 8; ++i) { LAS float* d = scr + (8 * i + krow) * 33 + 4 * c4; d[0] = v[i].x; d[1] = v[i].y; d[2] = v[i].z; d[3] = v[i].w; } }
    LDS_WAIT(); asm volatile("" ::: "memory");
    const int c = lane & 7;
#pragma unroll
    for (int j = 0; j < 4; ++j) { const int n = (lane >> 3) + 8 * j; const LAS float* s = scr + (8 * c) * 33 + n;
        u32x4 o; o.x = pk2(s[0 * 33], s[1 * 33]); o.y = pk2(s[2 * 33], s[3 * 33]); o.z = pk2(s[4 * 33], s[5 * 33]); o.w = pk2(s[6 * 33], s[7 * 33]);
        const int row = MAPWIN ? win_dst(n0 + n) : (n0 + n);
        *(u32x4*)(WT + (size_t)row * Kd + k0 + 8 * c) = o; }
    LDS_WAIT(); asm volatile("" ::: "memory");
}
__device__ __forceinline__ void rms_row_to_bf16(const float* xrow, const float* g, bf16_t* orow, int lane) {
    const f32x4* xr = (const f32x4*)xrow + lane; const f32x4* gr = (const f32x4*)g + lane;
    f32x4 v[16]; float s = 0.f;
#pragma unroll
    for (int j = 0; j < 16; ++j) { v[j] = xr[64 * j]; s += (v[j].x * v[j].x + v[j].y * v[j].y) + (v[j].z * v[j].z + v[j].w * v[j].w); }
    const float rs = 1.0f / sqrtf(wave_sum(s) * (1.0f / D) + NORM_EPS);
    u32x2* o8 = (u32x2*)orow + lane;
#pragma unroll
    for (int j = 0; j < 16; ++j) { const f32x4 gg = gr[64 * j]; u32x2 w; w.x = pk2(v[j].x * rs * gg.x, v[j].y * rs * gg.y); w.y = pk2(v[j].z * rs * gg.z, v[j].w * rs * gg.w); o8[64 * j] = w; }
}
__device__ __forceinline__ void cvt_table(const float* src, bf16_t* dst, size_t n8, size_t gtid, size_t nthr) {
    for (size_t i = gtid; i < n8; i += nthr) { const f32x4 a = ((const f32x4*)src)[2 * i], b = ((const f32x4*)src)[2 * i + 1]; ((u32x4*)dst)[i] = pg8::pack8(a, b); }
}
__device__ __forceinline__ void ph0_prologue(ArgsP A, Frame& F) {
    unsigned char* ws = A->ws;
    LAS float* scr = (LAS float*)(F.lds + RING_OFF + F.wave * 16384);
    const int gw = F.vcu * NWAVES + F.wave, NGW = F.G * NWAVES;
    constexpr int I_IN = 64 * (INW / 32), I_BA = 32 * 128, I_OUT = 64 * 128, I_WQ = 64 * 64, I_UP = 2 * 64, I_G = 8 * 64;
    constexpr int NITEMS = I_IN + 2 * I_BA + I_OUT + I_WQ + 2 * I_UP + I_G;
    for (int it = gw; it < NITEMS; it += NGW) {
        int r = it;
        if (r < I_IN) { p0_transpose_item<true>(A->w_in, D, INW, (bf16_t*)(ws + WS_WIN), D, scr, r, F.lane); continue; } r -= I_IN;
        if (r < I_BA) { p0_transpose_item<false>(A->w_ba, RW, D, (bf16_t*)(ws + WS_WA), RW, scr, r, F.lane); continue; } r -= I_BA;
        if (r < I_BA) { p0_transpose_item<false>(A->w_bb, RW, D, (bf16_t*)(ws + WS_WB), RW, scr, r, F.lane); continue; } r -= I_BA;
        if (r < I_OUT) { p0_transpose_item<false>(A->w_out, D, D, (bf16_t*)(ws + WS_WOUT), D, scr, r, F.lane); continue; } r -= I_OUT;
        if (r < I_WQ) { p0_transpose_item<false>(A->peer_wq, D, 2048, (bf16_t*)(ws + WS_WQ), D, scr, r, F.lane); continue; } r -= I_WQ;
        if (r < I_UP) { p0_transpose_item<false>(A->w_up, LW, RW, (bf16_t*)(ws + WS_WUP), LW, scr, r, F.lane); continue; } r -= I_UP;
        if (r < I_UP) { p0_transpose_item<false>(A->a_up, LA, RW, (bf16_t*)(ws + WS_AUP), LA, scr, r, F.lane); continue; } r -= I_UP;
        p0_transpose_item<false>(A->g_up, LG, RW, (bf16_t*)(ws + WS_GUP), LGP, scr, r, F.lane);
    }
    const size_t gtid = (size_t)F.vcu * NTHR + F.tid, nthr = (size_t)F.G * NTHR;
    for (size_t i = gtid; i < (size_t)32 * D / 8; i += nthr) ((u32x4*)((bf16_t*)(ws + WS_WIN) + (size_t)SHIFTW * D))[i] = (u32x4){0u, 0u, 0u, 0u};
    for (int row = gw; row < 2 * 16384; row += NGW) { const bool isv = row >= 16384; const int rr = isv ? row - 16384 : row;
        const f32x4* src = (const f32x4*)((isv ? A->peer_v : A->peer_u) + (size_t)rr * D) + F.lane; f32x4 v[16]; float am = 0.f;
#pragma unroll
        for (int j = 0; j < 16; ++j) { v[j] = src[64 * j]; am = fmaxf(fmaxf(am, fmaxf(fabsf(v[j].x), fabsf(v[j].y))), fmaxf(fabsf(v[j].z), fabsf(v[j].w))); }
#pragma unroll
        for (int o = 1; o < 64; o <<= 1) am = fmaxf(am, __shfl_xor(am, o));
        const float inv = am > 0.f ? 127.0f / am : 0.f; unsigned* dst = (unsigned*)(ws + (isv ? WS_PV : WS_PU)) + (size_t)rr * (D / 4) + F.lane;
#pragma unroll
        for (int j = 0; j < 16; ++j) { const unsigned q0 = (unsigned)(int)(rintf(v[j].x * inv) + 128.0f), q1 = (unsigned)(int)(rintf(v[j].y * inv) + 128.0f), q2 = (unsigned)(int)(rintf(v[j].z * inv) + 128.0f), q3 = (unsigned)(int)(rintf(v[j].w * inv) + 128.0f);
            dst[64 * j] = q0 | (q1 << 8) | (q2 << 16) | (q3 << 24); }
        if (F.lane == 0) ((float*)(ws + (isv ? WS_PSV : WS_PSU)))[rr] = am * (1.0f / 127.0f); }
    cvt_table(A->sub_keys, (bf16_t*)(ws + WS_SUBK), (size_t)PH_ * 2 * PNK * PHALF / 8, gtid, nthr);
    for (size_t i = gtid; i < (size_t)T * 64; i += nthr) { const int pos = (int)(i >> 6), fi = (int)(i & 63); const float inv = powf(10000.0f, -(float)fi / 64.0f); const float ang = (float)pos * inv;
        ((f32x2*)(ws + WS_ROPE))[i] = (f32x2){cosf(ang), sinf(ang)}; }
    for (int m = gw; m < T; m += NGW) rms_row_to_bf16(A->x + (size_t)m * D, A->norm1_g, (bf16_t*)(ws + WS_XN) + (size_t)m * D, F.lane);
}

__device__ __forceinline__ f32x4 ld4bf(const bf16_t* p) { const u32x2 w = *(const u32x2*)p; return (f32x4){bflo(w.x), bfhi(w.x), bflo(w.y), bfhi(w.y)}; }
__device__ __forceinline__ void st4bf(bf16_t* p, f32x4 v) { u32x2 w; w.x = pk2(v[0], v[1]); w.y = pk2(v[2], v[3]); *(u32x2*)p = w; }
__device__ __forceinline__ void ph2_prep(ArgsP A, Frame& F) {
    unsigned char* ws = A->ws; const bf16_t* PROJ = (const bf16_t*)(ws + WS_PROJ);
    LAS float* red = (LAS float*)(F.lds + RING_OFF);
    for (int it = F.vcu; it < NBLK * MH; it += F.G) { const int n = it / MH, h = it % MH, d = F.tid & 127, part = F.tid >> 7;
        const bf16_t* p = PROJ + (size_t)(n * MBLK + part * 64) * PLD + PC_MK + h * MD + d; float s = 0.f;
#pragma unroll 8
        for (int i = 0; i < 64; ++i) s += bf1(p[(size_t)i * PLD]);
        red[F.tid] = s; WG_BAR();
        if (F.tid < 128) { const float m = (red[F.tid] + red[F.tid + 128] + red[F.tid + 256] + red[F.tid + 384]) * (1.0f / MBLK); const unsigned hi = f2bf(m); const float lo = m - __builtin_bit_cast(float, hi << 16);
            ((bf16_t*)(ws + WS_KMEAN))[(size_t)(h * NBLK + n) * MD + F.tid] = (bf16_t)hi; ((bf16_t*)(ws + WS_KMEAN + 131072))[(size_t)(h * NBLK + n) * MD + F.tid] = (bf16_t)f2bf(lo); }
        WG_BAR(); }
    const int tid = F.tid;
    for (int t = F.vcu; t < T; t += F.G) { const bf16_t* P = PROJ + (size_t)t * PLD; const bf16_t* PP = P - PLD; const bool hasp = t > 0; const f32x4 zero = (f32x4){0.f, 0.f, 0.f, 0.f};
        { const int c = 4 * tid; const f32x4 p = ld4bf(P + PC_R + c), pp = hasp ? ld4bf(PP + PC_R + c) : zero, mu = *(const f32x4*)(A->mu + PC_R + c); st4bf((bf16_t*)(ws + WS_ZR) + (size_t)t * RW + c, p + (pp - p) * mu); }
        { const int c = 4 * tid; const f32x4 p = ld4bf(P + PC_K + c), pp = hasp ? ld4bf(PP + PC_K + c) : zero, mu = *(const f32x4*)(A->mu + PC_K + c); const f32x4 zk = p + (pp - p) * mu;
          st4bf((bf16_t*)(ws + WS_KP) + (size_t)t * RW + c, zk); const f32x4 kk = zk * *(const f32x4*)(A->k_k + c);
          const float ss = sum16((kk[0] * kk[0] + kk[1] * kk[1]) + (kk[2] * kk[2] + kk[3] * kk[3])); const float inv = 1.0f / fmaxf(sqrtf(ss), 1e-12f);
          st4bf((bf16_t*)(ws + WS_KKN) + (size_t)t * RW + c, kk * inv); }
        { const int c = 4 * tid; const f32x4 p = ld4bf(P + PC_V + c), pp = hasp ? ld4bf(PP + PC_V + c) : zero, mu = *(const f32x4*)(A->mu + PC_V + c); st4bf((bf16_t*)(ws + WS_ZV) + (size_t)t * RW + c, p + (pp - p) * mu); }
        if (tid < 192) {
            int c, cc; if (tid < 32) { cc = 4 * tid; c = PC_WL + cc; } else if (tid < 64) { cc = 4 * (tid - 32); c = PC_AL + cc; } else { cc = 4 * (tid - 64); c = PC_GL + cc; }
            f32x4 z = zero;
            if (tid < 64 || cc < LG) { const f32x4 p = ld4bf(P + c), pp = hasp ? ld4bf(PP + c) : zero, mu = *(const f32x4*)(A->mu + c); z = p + (pp - p) * mu; }
            if (tid < 32) { f32x4 o;
#pragma unroll
                for (int e = 0; e < 4; ++e) o[e] = 1.0f - 2.0f * __builtin_amdgcn_rcpf(__expf(2.0f * z[e]) + 1.0f);
                st4bf((bf16_t*)(ws + WS_AW) + (size_t)t * LW + cc, o); }
            else if (tid < 64) st4bf((bf16_t*)(ws + WS_AA) + (size_t)t * LA + cc, z);
            else { f32x4 o = zero; if (cc < LG) {
#pragma unroll
                for (int e = 0; e < 4; ++e) o[e] = fsigmoid(z[e]); }
                st4bf((bf16_t*)(ws + WS_AG) + (size_t)t * LGP + cc, o); }
        }
    }
}

__device__ __forceinline__ void ph3_gate(ArgsP A, Frame& F) {
    unsigned char* ws = A->ws; const bf16_t* PROJ = (const bf16_t*)(ws + WS_PROJ); const bf16_t* KMH = (const bf16_t*)(ws + WS_KMEAN); const bf16_t* KML = (const bf16_t*)(ws + WS_KMEAN + 131072); unsigned* MASK = (unsigned*)(ws + WS_MASK);
    const int gw = F.vcu * NWAVES + F.wave, NGW = F.G * NWAVES; const int r = F.lane & 31, hh = F.lane >> 5; const float NEG = -__builtin_inff();
    for (int it = gw; it < (T / 32) * MH; it += NGW) { const int tg = it >> 4, h = it & 15, t = tg * 32 + r, blk = tg >> 3;
        if (blk == 0) { if (hh == 0) MASK[t * MH + h] = 0u; continue; }
        f32x16 acc;
#pragma unroll
        for (int e = 0; e < 16; ++e) acc[e] = 0.f;
#pragma unroll
        for (int ks = 0; ks < 8; ++ks) { const bf16x8 q = *(const bf16x8*)(PROJ + (size_t)t * PLD + PC_MQ + h * MD + 16 * ks + 8 * hh); const size_t ko = (size_t)(h * NBLK + r) * MD + 16 * ks + 8 * hh;
            acc = __builtin_amdgcn_mfma_f32_32x32x16_bf16(*(const bf16x8*)(KMH + ko), q, acc, 0, 0, 0); acc = __builtin_amdgcn_mfma_f32_32x32x16_bf16(*(const bf16x8*)(KML + ko), q, acc, 0, 0, 0); }
        float t0 = NEG, t1 = NEG, t2 = NEG;
#pragma unroll
        for (int e = 0; e < 16; ++e) { const int n = (e & 3) + 8 * (e >> 2) + 4 * hh; float ae = acc[e]; asm volatile("" : "+v"(ae));
            float x = __builtin_bit_cast(float, (__builtin_bit_cast(unsigned, ae) & ~31u) | (unsigned)(31 - n)); x = (n < blk) ? x : NEG;
            t2 = __builtin_amdgcn_fmed3f(t1, t2, x); t1 = __builtin_amdgcn_fmed3f(t0, t1, x); t0 = fmaxf(t0, x); }
        const float o0 = __shfl_xor(t0, 32), o1 = __shfl_xor(t1, 32), o2 = __shfl_xor(t2, 32);
        t2 = __builtin_amdgcn_fmed3f(t1, t2, o0); t1 = __builtin_amdgcn_fmed3f(t0, t1, o0); t0 = fmaxf(t0, o0);
        t2 = __builtin_amdgcn_fmed3f(t1, t2, o1); t1 = __builtin_amdgcn_fmed3f(t0, t1, o1); t0 = fmaxf(t0, o1);
        t2 = __builtin_amdgcn_fmed3f(t1, t2, o2); t1 = __builtin_amdgcn_fmed3f(t0, t1, o2); t0 = fmaxf(t0, o2);
        unsigned sel = 1u << (31 - (__builtin_bit_cast(unsigned, t0) & 31u));
        if (blk > 1) sel |= 1u << (31 - (__builtin_bit_cast(unsigned, t1) & 31u));
        if (blk > 2) sel |= 1u << (31 - (__builtin_bit_cast(unsigned, t2) & 31u));
        if (hh == 0) MASK[t * MH + h] = sel; }
}

constexpr int SC_CH = 32, SC_STEP = 1312, SC_BUF = SC_CH * SC_STEP, SC_YOFF = 2 * SC_BUF, SC_YBUF = SC_CH * 8 * 16 * 4;
static_assert(SC_YOFF + 2 * SC_YBUF <= RING_BYTES, "scan LDS");
__device__ __forceinline__ void ph4_scan(ArgsP A, Frame& F) {
    unsigned char* ws = A->ws;
    const float* DEC = (const float*)(ws + WS_DEC); const bf16_t* KKN = (const bf16_t*)(ws + WS_KKN); const bf16_t* BB = (const bf16_t*)(ws + WS_BB); const bf16_t* KP = (const bf16_t*)(ws + WS_KP);
    const bf16_t* ZR = (const bf16_t*)(ws + WS_ZR); const bf16_t* ZV = (const bf16_t*)(ws + WS_ZV); float* Y = (float*)(ws + WS_Y);
    LAS unsigned char* L = F.lds + RING_OFF;
    const int wave = F.wave, lane = F.lane;
    const bool scanner = wave < 2, loader = (wave == 2 || wave == 3 || wave == 6 || wave == 7);
    const int ltid = ((wave & 1) + ((wave >> 2) << 1)) * 64 + lane;
    for (int unit = F.vcu; unit < 256; unit += F.G) {
        const int h = unit >> 3, r0 = (unit & 7) * 8; const size_t hc = (size_t)h * RN;
        constexpr int NC = T / SC_CH;
        f32x4 ld_dec[2]; u32x4 ld_b[4]; u32x4 ld_v;
        auto issue = [&](int c) { const int t0 = c * SC_CH;
#pragma unroll
            for (int i = 0; i < 2; ++i) { const int q = ltid + 256 * i, st = q >> 4, c4 = q & 15; ld_dec[i] = *(const f32x4*)(DEC + (size_t)(t0 + st) * RW + hc + 4 * c4); }
            { const int st = ltid >> 3, c8 = ltid & 7; const size_t o = (size_t)(t0 + st) * RW + hc + 8 * c8; ld_b[0] = *(const u32x4*)(KKN + o); ld_b[1] = *(const u32x4*)(BB + o); ld_b[2] = *(const u32x4*)(KP + o); ld_b[3] = *(const u32x4*)(ZR + o); }
            if (ltid < SC_CH) ld_v = *(const u32x4*)(ZV + (size_t)(t0 + ltid) * RW + hc + r0); };
        auto commit = [&](int buf) { LAS unsigned char* B = L + buf * SC_BUF;
#pragma unroll
            for (int i = 0; i < 2; ++i) { const int q = ltid + 256 * i, st = q >> 4, c4 = q & 15; *(LAS f32x4*)(B + st * SC_STEP + 16 * c4) = ld_dec[i]; }
            { const int st = ltid >> 3, c8 = ltid & 7;
#pragma unroll
              for (int a = 0; a < 4; ++a) { f32x4 v0, v1; pg8::unpack8(ld_b[a], v0, v1); LAS unsigned char* p = B + st * SC_STEP + 256 * (a + 1) + 32 * c8; *(LAS f32x4*)p = v0; *(LAS f32x4*)(p + 16) = v1; } }
            if (ltid < SC_CH) { f32x4 v0, v1; pg8::unpack8(ld_v, v0, v1); LAS unsigned char* p = B + ltid * SC_STEP + 1280; *(LAS f32x4*)p = v0; *(LAS f32x4*)(p + 16) = v1; } };
        auto yflush = [&](int c) { const LAS unsigned char* YB = L + SC_YOFF + (c & 1) * SC_YBUF; const int st = ltid >> 3, rr = ltid & 7; const LAS f32x4* p = (const LAS f32x4*)(YB + (st * 8 + rr) * 64);
            const f32x4 a = p[0], b = p[1], cc = p[2], d = p[3]; const f32x4 s = (a + b) + (cc + d); Y[(size_t)(c * SC_CH + st) * RW + hc + r0 + rr] = (s[0] + s[1]) + (s[2] + s[3]); };
        if (loader) { issue(0); VM_WAIT(); commit(0); issue(1); }
        WG_BAR();
        f32x2 S01 = {0.f, 0.f}, S23 = {0.f, 0.f};
        const int row = wave * 4 + (lane >> 4), j = lane & 15;
        for (int c = 0; c < NC; ++c) {
            if (scanner) {
                const LAS unsigned char* B = L + (c & 1) * SC_BUF + 16 * j; LAS float* yb = (LAS float*)(L + SC_YOFF + (c & 1) * SC_YBUF) + row * 16 + j;
                const LAS unsigned char* vb = L + (c & 1) * SC_BUF + 1280 + 4 * row;
#define SC_LOAD(W, KK, BBv, KPv, RR, V, tt_) do { const int o_ = (tt_) * SC_STEP; W = *(const LAS f32x4*)(B + o_); KK = *(const LAS f32x4*)(B + o_ + 256); BBv = *(const LAS f32x4*)(B + o_ + 512); KPv = *(const LAS f32x4*)(B + o_ + 768); RR = *(const LAS f32x4*)(B + o_ + 1024); V = *(const LAS float*)(vb + o_); } while (0)
#define SC_STEPF(W, KK, BBv, KPv, RR, V, tt_) do { \
                    const f32x2 kk01 = {KK[0], KK[1]}, kk23 = {KK[2], KK[3]}; f32x2 d2 = S01 * kk01; d2 = __builtin_elementwise_fma(S23, kk23, d2); \
                    const f32x2 w01 = {W[0], W[1]}, w23 = {W[2], W[3]}, kp01 = {KPv[0], KPv[1]}, kp23 = {KPv[2], KPv[3]}; const f32x2 vv = {V, V}; \
                    f32x2 t01 = S01 * w01, t23 = S23 * w23; t01 = __builtin_elementwise_fma(vv, kp01, t01); t23 = __builtin_elementwise_fma(vv, kp23, t23); \
                    const float sa = -sum16(d2[0] + d2[1]); const f32x2 sa2 = {sa, sa}; const f32x2 bb01 = {BBv[0], BBv[1]}, bb23 = {BBv[2], BBv[3]}; \
                    S01 = __builtin_elementwise_fma(sa2, bb01, t01); S23 = __builtin_elementwise_fma(sa2, bb23, t23); \
                    const f32x2 r01 = {RR[0], RR[1]}, r23 = {RR[2], RR[3]}; f32x2 y2 = S01 * r01; y2 = __builtin_elementwise_fma(S23, r23, y2); yb[(tt_) * 128] = y2[0] + y2[1]; } while (0)
                f32x4 wA, kA, bA, pA, rA, wB, kB, bB, pB, rB, wC, kC, bC, pC, rC, wD, kD, bD, pD, rD; float vA, vB, vC, vD;
                SC_LOAD(wA, kA, bA, pA, rA, vA, 0); SC_LOAD(wB, kB, bB, pB, rB, vB, 1);
#pragma unroll 1
                for (int tt = 0; tt < SC_CH; tt += 4) {
                    const int t4 = tt + 4 < SC_CH ? tt + 4 : tt, t5 = tt + 5 < SC_CH ? tt + 5 : tt + 1;
                    SC_LOAD(wC, kC, bC, pC, rC, vC, tt + 2);
                    SC_STEPF(wA, kA, bA, pA, rA, vA, tt);
                    SC_LOAD(wD, kD, bD, pD, rD, vD, tt + 3);
                    SC_STEPF(wB, kB, bB, pB, rB, vB, tt + 1);
                    SC_LOAD(wA, kA, bA, pA, rA, vA, t4);
                    SC_STEPF(wC, kC, bC, pC, rC, vC, tt + 2);
                    SC_LOAD(wB, kB, bB, pB, rB, vB, t5);
                    SC_STEPF(wD, kD, bD, pD, rD, vD, tt + 3);
                }
#undef SC_LOAD
#undef SC_STEPF
            } else if (loader) {
                if (c + 1 < NC) { VM_WAIT(); commit((c + 1) & 1); }
                if (c + 2 < NC) issue(c + 2);
                if (c > 0) yflush(c - 1);
            }
            WG_BAR();
        }
        if (loader) yflush(NC - 1);
        WG_BAR();
    }
}

__device__ __forceinline__ void ph5_ypost(ArgsP A, Frame& F) {
    unsigned char* ws = A->ws; const float* Y = (const float*)(ws + WS_Y); const bf16_t* ZR = (const bf16_t*)(ws + WS_ZR); const bf16_t* KP = (const bf16_t*)(ws + WS_KP); const bf16_t* ZV = (const bf16_t*)(ws + WS_ZV);
    const bf16_t* G = (const bf16_t*)(ws + WS_G); bf16_t* YA = (bf16_t*)(ws + WS_YA);
    const int gw = F.vcu * NWAVES + F.wave, NGW = F.G * NWAVES;
    for (int it = gw; it < T * 8; it += NGW) { const int t = it >> 3, c = (it & 7) * 256 + 4 * F.lane; const size_t o = (size_t)t * RW + c;
        const f32x4 y = *(const f32x4*)(Y + o); const float mean = sum16((y[0] + y[1]) + (y[2] + y[3])) * (1.0f / 64.0f); const f32x4 d = y - mean;
        const float var = sum16((d[0] * d[0] + d[1] * d[1]) + (d[2] * d[2] + d[3] * d[3])) * (1.0f / 64.0f); const float rs = 1.0f / sqrtf(var + LNX_EPS);
        const f32x4 r = ld4bf(ZR + o), k = ld4bf(KP + o), v = ld4bf(ZV + o), g = ld4bf(G + o), rk = *(const f32x4*)(A->r_k + c), lg = *(const f32x4*)(A->lnx_g + c), lb = *(const f32x4*)(A->lnx_b + c);
        const f32x4 rkk = r * k * rk; const float bonus = sum16((rkk[0] + rkk[1]) + (rkk[2] + rkk[3]));
        st4bf(YA + o, (d * rs * lg + lb + bonus * v) * g); }
}

constexpr int AT_KP = 272, AT_VP = 136, AT_KB = 64 * AT_KP, AT_VB = 128 * AT_VP, AT_BUF = AT_KB + AT_VB;
static_assert(2 * AT_BUF <= RING_BYTES, "attention LDS");
__device__ __forceinline__ void ph5_attn(ArgsP A, Frame& F) {
    unsigned char* ws = A->ws; const bf16_t* PROJ = (const bf16_t*)(ws + WS_PROJ); const bf16_t* VT = (const bf16_t*)(ws + WS_VT); const unsigned* MASK = (const unsigned*)(ws + WS_MASK); bf16_t* YB = (bf16_t*)(ws + WS_YB);
    LAS unsigned char* L = F.lds + RING_OFF; const int tid = F.tid, wave = F.wave, lane = F.lane, r = lane & 31, hh = lane >> 5;
    const float NEG = -__builtin_inff();
    for (int u = F.vcu; u < 256; u += F.G) { const int h = u >> 4, pr = u & 15;
      for (int half = 0; half < 2; ++half) { const int ib = half == 0 ? (31 - pr) : pr;
        const int q0 = ib * MBLK + wave * 32;
        bf16x8 qf[8];
#pragma unroll
        for (int ks = 0; ks < 8; ++ks) qf[ks] = *(const bf16x8*)(PROJ + (size_t)(q0 + r) * PLD + PC_MQ + h * MD + 16 * ks + 8 * hh);
        const unsigned msk = MASK[(q0 + r) * MH + h];
        f32x16 o[4];
#pragma unroll
        for (int db = 0; db < 4; ++db)
#pragma unroll
            for (int e = 0; e < 16; ++e) o[db][e] = 0.f;
        float mrun = NEG, lrun = 0.f;
        const int ntile = 4 + 4 * ib;
        u32x4 sk[2], sv[2];
        auto tile_tok = [&](int n) { return n < 4 ? ib * MBLK + n * 64 : ((n - 4) >> 2) * MBLK + ((n - 4) & 3) * 64; };
        auto issue = [&](int n) { const int tb = tile_tok(n);
#pragma unroll
            for (int i = 0; i < 2; ++i) { const int row = (tid >> 4) + 32 * i, c16 = tid & 15; sk[i] = *(const u32x4*)(PROJ + (size_t)(tb + row) * PLD + PC_MK + h * MD + 8 * c16); }
#pragma unroll
            for (int i = 0; i < 2; ++i) { const int row = (tid >> 3) + 64 * i, c16 = tid & 7; sv[i] = *(const u32x4*)(VT + (size_t)(h * MD + row) * T + tb + 8 * c16); } };
        auto commit = [&](int buf) { LAS unsigned char* B = L + buf * AT_BUF;
#pragma unroll
            for (int i = 0; i < 2; ++i) { const int row = (tid >> 4) + 32 * i, c16 = tid & 15; *(LAS u32x4*)(B + row * AT_KP + 16 * c16) = sk[i]; }
#pragma unroll
            for (int i = 0; i < 2; ++i) { const int row = (tid >> 3) + 64 * i, c16 = tid & 7; LAS unsigned char* p = B + AT_KB + row * AT_VP + 16 * c16; *(LAS u32x2*)p = (u32x2){sv[i].x, sv[i].y}; *(LAS u32x2*)(p + 8) = (u32x2){sv[i].z, sv[i].w}; } };
        issue(0); VM_WAIT(); commit(0); WG_BAR();
        for (int n = 0; n < ntile; ++n) {
            if (n + 1 < ntile) issue(n + 1);
            bool need; int jblk = -1, tt = 0;
            if (n < 4) { tt = n; need = tt <= (wave >> 1); } else { jblk = (n - 4) >> 2; need = __ballot((msk >> jblk) & 1u) != 0ull; }
            if (need) {
                const LAS unsigned char* KB = L + (n & 1) * AT_BUF; const LAS unsigned char* VB = KB + AT_KB;
                f32x16 s[2];
#pragma unroll
                for (int kb = 0; kb < 2; ++kb) {
#pragma unroll
                    for (int e = 0; e < 16; ++e) s[kb][e] = 0.f;
#pragma unroll
                    for (int ks = 0; ks < 8; ++ks) { const bf16x8 a = *(const LAS bf16x8*)(KB + (32 * kb + r) * AT_KP + 32 * ks + 16 * hh); s[kb] = __builtin_amdgcn_mfma_f32_32x32x16_bf16(a, qf[ks], s[kb], 0, 0, 0); } }
                if (n < 4) { const int qrel = wave * 32 + r;
#pragma unroll
                    for (int kb = 0; kb < 2; ++kb)
#pragma unroll
                        for (int e = 0; e < 16; ++e) { const int krel = 64 * tt + 32 * kb + (e & 3) + 8 * (e >> 2) + 4 * hh; if (krel > qrel) s[kb][e] = NEG; } }
                else if (!((msk >> jblk) & 1u)) {
#pragma unroll
                    for (int kb = 0; kb < 2; ++kb)
#pragma unroll
                        for (int e = 0; e < 16; ++e) s[kb][e] = NEG; }
                float mx = s[0][0];
#pragma unroll
                for (int kb = 0; kb < 2; ++kb)
#pragma unroll
                    for (int e = 0; e < 16; ++e) mx = fmaxf(mx, s[kb][e]);
                mx = fmaxf(mx, __shfl_xor(mx, 32));
                const float mnew = fmaxf(mrun, mx); const float alpha = exp2f(mrun - mnew); mrun = mnew;
                float ps = 0.f;
#pragma unroll
                for (int kb = 0; kb < 2; ++kb)
#pragma unroll
                    for (int e = 0; e < 16; ++e) { const float p = exp2f(s[kb][e] - mnew); s[kb][e] = p; ps += p; }
                lrun = lrun * alpha + ps;
#pragma unroll
                for (int db = 0; db < 4; ++db)
#pragma unroll
                    for (int e = 0; e < 16; ++e) o[db][e] *= alpha;
#pragma unroll
                for (int kb = 0; kb < 2; ++kb)
#pragma unroll
                    for (int st = 0; st < 2; ++st) { u32x4 pw; pw.x = pk2(s[kb][8 * st + 0], s[kb][8 * st + 1]); pw.y = pk2(s[kb][8 * st + 2], s[kb][8 * st + 3]); pw.z = pk2(s[kb][8 * st + 4], s[kb][8 * st + 5]); pw.w = pk2(s[kb][8 * st + 6], s[kb][8 * st + 7]);
                        const bf16x8 pf = __builtin_bit_cast(bf16x8, pw); const int kbase = 32 * kb + 16 * st + 4 * hh;
#pragma unroll
                        for (int db = 0; db < 4; ++db) { const LAS unsigned char* vp = VB + (32 * db + r) * AT_VP + 2 * kbase; const u32x2 lo = *(const LAS u32x2*)vp, hi = *(const LAS u32x2*)(vp + 16);
                            const bf16x8 vf = __builtin_bit_cast(bf16x8, (u32x4){lo.x, lo.y, hi.x, hi.y}); o[db] = __builtin_amdgcn_mfma_f32_32x32x16_bf16(vf, pf, o[db], 0, 0, 0); } }
            }
            if (n + 1 < ntile) { VM_WAIT(); commit((n + 1) & 1); }
            WG_BAR();
        }
        const float ltot = lrun + __shfl_xor(lrun, 32); const float inv = 1.0f / ltot;
        bf16_t* op = YB + (size_t)(q0 + r) * RW + h * MD;
#pragma unroll
        for (int db = 0; db < 4; ++db)
#pragma unroll
            for (int g = 0; g < 4; ++g) { u32x2 w; w.x = pk2(o[db][4 * g] * inv, o[db][4 * g + 1] * inv); w.y = pk2(o[db][4 * g + 2] * inv, o[db][4 * g + 3] * inv); *(u32x2*)(op + 32 * db + 8 * g + 4 * hh) = w; }
      }
    }
}

__device__ __forceinline__ void ins16(float (&top)[16], float x) {
#pragma unroll
    for (int k = 15; k >= 1; --k) top[k] = __builtin_amdgcn_fmed3f(top[k - 1], top[k], x);
    top[0] = fmaxf(top[0], x);
}
__device__ __forceinline__ void ph10_select(ArgsP A, Frame& F) {
    unsigned char* ws = A->ws; const bf16_t* PQ = (const bf16_t*)(ws + WS_PQ); const bf16_t* SK = (const bf16_t*)(ws + WS_SUBK); int* IDX = (int*)(ws + WS_IDX); float* GW = (float*)(ws + WS_GW);
    const int gw = F.vcu * NWAVES + F.wave, NGW = F.G * NWAVES; const int r = F.lane & 31, hh = F.lane >> 5; const float NEG = -__builtin_inff();
    for (int it = gw; it < (T / 32) * PH_; it += NGW) { const int tg = it >> 3, h = it & 7, t = tg * 32 + r;
        float TA[16], TB[16];
        auto topk = [&](int p, float (&dst)[16]) {
            bf16x8 qf[8];
#pragma unroll
            for (int ks = 0; ks < 8; ++ks) qf[ks] = *(const bf16x8*)(PQ + (size_t)t * 2048 + (h * 2 + p) * PHALF + 16 * ks + 8 * hh);
            float top[16];
#pragma unroll
            for (int k = 0; k < 16; ++k) top[k] = NEG;
#pragma unroll 1
            for (int nb = 0; nb < 4; ++nb) { f32x16 acc;
#pragma unroll
                for (int e = 0; e < 16; ++e) acc[e] = 0.f;
#pragma unroll
                for (int ks = 0; ks < 8; ++ks) { const bf16x8 a = *(const bf16x8*)(SK + ((size_t)(h * 2 + p) * PNK + 32 * nb + r) * PHALF + 16 * ks + 8 * hh); acc = __builtin_amdgcn_mfma_f32_32x32x16_bf16(a, qf[ks], acc, 0, 0, 0); }
#pragma unroll
                for (int e = 0; e < 16; ++e) { const unsigned key = 32 * nb + (e & 3) + 8 * (e >> 2) + 4 * hh; float ae = acc[e]; asm volatile("" : "+v"(ae));
                    const float x = __builtin_bit_cast(float, (__builtin_bit_cast(unsigned, ae) & ~0x7Fu) | key); ins16(top, x); } }
            float oth[16];
#pragma unroll
            for (int k = 0; k < 16; ++k) oth[k] = __shfl_xor(top[k], 32);
#pragma unroll
            for (int k = 0; k < 16; ++k) ins16(top, oth[k]);
#pragma unroll
            for (int k = 0; k < 16; ++k) dst[k] = top[k];
        };
        topk(0, TA); asm volatile("" ::: "memory"); __builtin_amdgcn_sched_barrier(0); topk(1, TB); asm volatile("" ::: "memory"); __builtin_amdgcn_sched_barrier(0);
        float fin[16];
#pragma unroll
        for (int k = 0; k < 16; ++k) fin[k] = NEG;
#pragma unroll
        for (int i = 0; i < 16; ++i)
#pragma unroll
            for (int j = 0; j < 16; ++j) if ((i + 1) * (j + 1) <= 16) { const float sm = TA[i] + TB[j]; ins16(fin, __builtin_bit_cast(float, (__builtin_bit_cast(unsigned, sm) & ~0xFFu) | (unsigned)(i * 16 + j))); }
        float e[16], den = 0.f;
#pragma unroll
        for (int k = 0; k < 16; ++k) { e[k] = __expf(fin[k] - fin[0]); den += e[k]; }
        const float rden = 1.0f / den;
        int oi[8]; float og[8];
#pragma unroll
        for (int kk = 0; kk < 8; ++kk) { const float fv = hh ? fin[8 + kk] : fin[kk]; og[kk] = (hh ? e[8 + kk] : e[kk]) * rden; const unsigned id = __builtin_bit_cast(unsigned, fv) & 0xFFu; const unsigned ci = id >> 4, cj = id & 15u;
            unsigned ia = 0u, ib = 0u;
#pragma unroll
            for (int q = 0; q < 16; ++q) { ia = (ci == (unsigned)q) ? (__builtin_bit_cast(unsigned, TA[q]) & 0x7Fu) : ia; ib = (cj == (unsigned)q) ? (__builtin_bit_cast(unsigned, TB[q]) & 0x7Fu) : ib; }
            oi[kk] = (int)(ia * PNK + ib); }
        int* ip = IDX + (size_t)t * 128 + h * 16 + 8 * hh; float* gp = GW + (size_t)t * 128 + h * 16 + 8 * hh;
        *(u32x4*)ip = (u32x4){(unsigned)oi[0], (unsigned)oi[1], (unsigned)oi[2], (unsigned)oi[3]}; *(u32x4*)(ip + 4) = (u32x4){(unsigned)oi[4], (unsigned)oi[5], (unsigned)oi[6], (unsigned)oi[7]};
        *(f32x4*)gp = (f32x4){og[0], og[1], og[2], og[3]}; *(f32x4*)(gp + 4) = (f32x4){og[4], og[5], og[6], og[7]};
    }
}


__device__ __forceinline__ float ub0(unsigned w) { return (float)(w & 0xffu); }
__device__ __forceinline__ float ub1(unsigned w) { return (float)((w >> 8) & 0xffu); }
__device__ __forceinline__ float ub2(unsigned w) { return (float)((w >> 16) & 0xffu); }
__device__ __forceinline__ float ub3(unsigned w) { return (float)(w >> 24); }
__device__ __forceinline__ float dot16q(u32x4 q, const float (&h)[16]) {
    return ((ub0(q.x) * h[0] + ub1(q.x) * h[1]) + (ub2(q.x) * h[2] + ub3(q.x) * h[3])) + ((ub0(q.y) * h[4] + ub1(q.y) * h[5]) + (ub2(q.y) * h[6] + ub3(q.y) * h[7]))
         + ((ub0(q.z) * h[8] + ub1(q.z) * h[9]) + (ub2(q.z) * h[10] + ub3(q.z) * h[11])) + ((ub0(q.w) * h[12] + ub1(q.w) * h[13]) + (ub2(q.w) * h[14] + ub3(q.w) * h[15]));
}
__device__ __forceinline__ void ph11_gather(ArgsP A, Frame& F) {
    unsigned char* ws = A->ws; const bf16_t* H2 = (const bf16_t*)(ws + WS_H2); const unsigned char* PU = (const unsigned char*)(ws + WS_PU); const unsigned char* PV = (const unsigned char*)(ws + WS_PV);
    const float* PSU = (const float*)(ws + WS_PSU); const float* PSV = (const float*)(ws + WS_PSV);
    const int* IDX = (const int*)(ws + WS_IDX); const float* GW = (const float*)(ws + WS_GW); const float* X1 = (const float*)(ws + WS_X1);
    LAS float* coef = (LAS float*)(F.lds + RING_OFF); LAS int* eidx = (LAS int*)(F.lds + RING_OFF + 1024); LAS float* red = (LAS float*)(F.lds + RING_OFF + 2048);
    const int tid = F.tid, wave = F.wave, lane = F.lane; int par = 0;
    for (int t = F.vcu; t < T; t += F.G, par ^= 1) {
        float hv[4][16]; float hs = 0.f;
#pragma unroll
        for (int i = 0; i < 4; ++i) { const bf16_t* hp = H2 + (size_t)t * D + i * 1024 + lane * 16; f32x4 a, b, c, d; pg8::unpack8(*(const u32x4*)hp, a, b); pg8::unpack8(*(const u32x4*)(hp + 8), c, d);
#pragma unroll
            for (int e = 0; e < 4; ++e) { hv[i][e] = a[e]; hv[i][4 + e] = b[e]; hv[i][8 + e] = c[e]; hv[i][12 + e] = d[e]; }
            hs += ((a[0] + a[1]) + (a[2] + a[3])) + ((b[0] + b[1]) + (b[2] + b[3])) + ((c[0] + c[1]) + (c[2] + c[3])) + ((d[0] + d[1]) + (d[2] + d[3])); }
        hs = wave_sum(hs);
        const int myidx = (lane < 16) ? IDX[(size_t)t * 128 + wave * 16 + lane] : 0; const float myg = (lane < 16) ? GW[(size_t)t * 128 + wave * 16 + lane] : 0.f;
        float dots = 0.f;
#pragma unroll 1
        for (int k = 0; k < 16; k += 4) {
            u32x4 q[4][4];
#pragma unroll
            for (int x = 0; x < 4; ++x) { const int e = __builtin_amdgcn_readlane(myidx, k + x); const unsigned char* up = PU + (size_t)e * D + lane * 16;
#pragma unroll
                for (int i = 0; i < 4; ++i) q[x][i] = *(const u32x4*)(up + i * 1024); }
#pragma unroll
            for (int x = 0; x < 4; ++x) { float d = 0.f;
#pragma unroll
                for (int i = 0; i < 4; ++i) d += dot16q(q[x][i], hv[i]);
                d = wave_sum(d); if (lane == k + x) dots = d; }
        }
        if (lane < 16) { const float s = PSU[myidx] * (dots - 128.0f * hs); const float act = 0.5f * s * (1.0f + erff(s * 0.70710678118654752f));
            coef[par * 128 + wave * 16 + lane] = myg * act * PSV[myidx]; eidx[par * 128 + wave * 16 + lane] = myidx; }
        WG_BAR();
        float acc[8]; float csum = 0.f;
#pragma unroll
        for (int i = 0; i < 8; ++i) acc[i] = 0.f;
#pragma unroll 1
        for (int e = 0; e < 128; e += 8) { u32x2 v[8]; float c[8];
#pragma unroll
            for (int q = 0; q < 8; ++q) { const int ei = __builtin_amdgcn_readfirstlane(eidx[par * 128 + e + q]); c[q] = coef[par * 128 + e + q]; v[q] = *(const u32x2*)(PV + (size_t)ei * D + tid * 8); }
#pragma unroll
            for (int q = 0; q < 8; ++q) { csum += c[q]; acc[0] += c[q] * ub0(v[q].x); acc[1] += c[q] * ub1(v[q].x); acc[2] += c[q] * ub2(v[q].x); acc[3] += c[q] * ub3(v[q].x); acc[4] += c[q] * ub0(v[q].y); acc[5] += c[q] * ub1(v[q].y); acc[6] += c[q] * ub2(v[q].y); acc[7] += c[q] * ub3(v[q].y); } }
        const float corr = -128.0f * csum;
        const f32x4 x0 = *(const f32x4*)(X1 + (size_t)t * D + tid * 8), x1 = *(const f32x4*)(X1 + (size_t)t * D + tid * 8 + 4);
        f32x4 y0 = x0 + ((f32x4){acc[0], acc[1], acc[2], acc[3]} + corr), y1 = x1 + ((f32x4){acc[4], acc[5], acc[6], acc[7]} + corr);
        float ss = (y0[0] * y0[0] + y0[1] * y0[1]) + (y0[2] * y0[2] + y0[3] * y0[3]) + (y1[0] * y1[0] + y1[1] * y1[1]) + (y1[2] * y1[2] + y1[3] * y1[3]);
        ss = wave_sum(ss); if (lane == 0) red[par * 8 + wave] = ss;
        WG_BAR();
        float tot = 0.f;
#pragma unroll
        for (int w = 0; w < 8; ++w) tot += red[par * 8 + w];
        const float rs = 1.0f / sqrtf(tot * (1.0f / D) + NORM_EPS);
        const f32x4 g0 = *(const f32x4*)(A->final_g + tid * 8), g1 = *(const f32x4*)(A->final_g + tid * 8 + 4);
        *(f32x4*)(A->out + (size_t)t * D + tid * 8) = y0 * rs * g0; *(f32x4*)(A->out + (size_t)t * D + tid * 8 + 4) = y1 * rs * g1;
    }
}

constexpr int NPH = 12;
__device__ __forceinline__ Frame make_frame(unsigned char* lds) {
    Frame F; int t = threadIdx.x; asm volatile("" : "+v"(t));
    F.lds = (LAS unsigned char*)lds; F.tid = t; F.lane = t & 63; F.wave = __builtin_amdgcn_readfirstlane(t >> 6);
    F.G = gridDim.x; { const int bx = blockIdx.x; F.vcu = (F.G % 8 == 0) ? (bx % 8) * (F.G / 8) + bx / 8 : bx; }
    return F;
}
__global__ void __launch_bounds__(NTHR, 2) mk_fwd(Args args_by_value) {
    extern __shared__ __attribute__((aligned(16))) unsigned char lds[];
    ArgsP args = get_args();
    gu32* ctl = (gu32*)(args->ws + WS_CTL);
    for (int u = threadIdx.x; u < (LDS_BYTES - LDSCTL_OFF) / 4; u += NTHR) ((LAS unsigned*)((LAS unsigned char*)lds + LDSCTL_OFF))[u] = 0u;
    __syncthreads();
    const int lo = args->ph_lo, hi = args->ph_hi;
    volatile LAS unsigned* MISC = (volatile LAS unsigned*)((LAS unsigned char*)lds + MISC_OFF);
    XcdBarrier bar; bar.bar = (unsigned*)(ctl + CW_BAR) + args->li * XCD_BAR_WORDS; bar.x = 0; bar.st = nullptr;
    if (hi - lo > 1) bar = xcd_barrier_post((unsigned*)(ctl + CW_BAR) + args->li * XCD_BAR_WORDS, MISC + 8);
#define IN(k) (lo <= (k) && (k) < hi)
#define SEAM(k) do { if (IN(k) && IN((k) + 1)) xcd_barrier(bar); } while (0)
    const int bid = (int)blockIdx.x;

    if (IN(0)) { Frame F = make_frame(lds); ph0_prologue(get_args(), F); SEAM(0); }
    if (IN(1)) { Frame F = make_frame(lds); LAS unsigned char* ring = F.lds + RING_OFF; ArgsP a_ = get_args(); unsigned char* ws = a_->ws;
        { pg8::Gemm g{(const bf16_t*)(ws + WS_XN), (const bf16_t*)(ws + WS_WIN), T, PLD, D}; pg8::StaticOrder S; S.init(T, PLD, F.G, bid);
          pg8::EpiProj E{(bf16_t*)(ws + WS_PROJ), (const float*)(ws + WS_ROPE)}; pg8::gemm_phase<pg8::EpiProj, pg8::StaticOrder, true, true>(ring, g, S, E); }
        { pg8::Gemm g{(const bf16_t*)(ws + WS_XN), (const bf16_t*)(ws + WS_WIN) + (size_t)PC_MV * D, T, 2048, D}; pg8::StaticOrder S; S.init(T, 2048, F.G, bid);
          pg8::EpiVT E{(bf16_t*)(ws + WS_VT)}; pg8::gemm_phase<pg8::EpiVT, pg8::StaticOrder, true, true>(ring, g, S, E); }
        SEAM(1); }
    if (IN(2)) { Frame F = make_frame(lds); ph2_prep(get_args(), F); SEAM(2); }
    if (IN(3)) { Frame F = make_frame(lds); LAS unsigned char* ring = F.lds + RING_OFF; ArgsP a_ = get_args(); unsigned char* ws = a_->ws;
        { pg8::Gemm g{(const bf16_t*)(ws + WS_AW), (const bf16_t*)(ws + WS_WUP), T, RW, LW}; pg8::StaticOrder S; S.init(T, RW, F.G, bid);
          pg8::EpiDec E{(float*)(ws + WS_DEC), a_->w0}; pg8::gemm_phase<pg8::EpiDec, pg8::StaticOrder, true, true>(ring, g, S, E); }
        asm volatile("" ::: "memory"); __builtin_amdgcn_sched_barrier(0);
        { pg8::Gemm g{(const bf16_t*)(ws + WS_AA), (const bf16_t*)(ws + WS_AUP), T, RW, LA}; pg8::StaticOrder S; S.init(T, RW, F.G, bid);
          pg8::EpiA E{(bf16_t*)(ws + WS_KP), (bf16_t*)(ws + WS_BB), (const bf16_t*)(ws + WS_KKN), a_->a0, a_->k_a}; pg8::gemm_phase<pg8::EpiA, pg8::StaticOrder, true, true>(ring, g, S, E); }
        asm volatile("" ::: "memory"); __builtin_amdgcn_sched_barrier(0);
        { pg8::Gemm g{(const bf16_t*)(ws + WS_AG), (const bf16_t*)(ws + WS_GUP), T, RW, LGP}; pg8::StaticOrder S; S.init(T, RW, F.G, bid);
          pg8::EpiBf16 E{(bf16_t*)(ws + WS_G), RW}; pg8::gemm_phase<pg8::EpiBf16, pg8::StaticOrder, true, true>(ring, g, S, E); }
        { Frame F2 = make_frame(lds); ph3_gate(get_args(), F2); }
        SEAM(3); }
    if (IN(4)) { Frame F = make_frame(lds); ph4_scan(get_args(), F); SEAM(4); }
    if (IN(5)) { { Frame F = make_frame(lds); ph5_ypost(get_args(), F); } { Frame F = make_frame(lds); ph5_attn(get_args(), F); } SEAM(5); }
    if (IN(6)) { Frame F = make_frame(lds); LAS unsigned char* ring = F.lds + RING_OFF; ArgsP a_ = get_args(); unsigned char* ws = a_->ws;
        { pg8::Gemm g{(const bf16_t*)(ws + WS_YA), (const bf16_t*)(ws + WS_WA), T, D, RW}; pg8::StaticOrder S; S.init(T, D, F.G, bid);
          pg8::EpiMix<false> E{(bf16_t*)(ws + WS_MIXED), (const bf16_t*)(ws + WS_PROJ), PC_GA}; pg8::gemm_phase<pg8::EpiMix<false>, pg8::StaticOrder, true, true>(ring, g, S, E); }
        { pg8::Gemm g{(const bf16_t*)(ws + WS_YB), (const bf16_t*)(ws + WS_WB), T, D, RW}; pg8::StaticOrder S; S.init(T, D, F.G, bid);
          pg8::EpiMix<true> E{(bf16_t*)(ws + WS_MIXED), (const bf16_t*)(ws + WS_PROJ), PC_GB}; pg8::gemm_phase<pg8::EpiMix<true>, pg8::StaticOrder, true, true>(ring, g, S, E); }
        SEAM(6); }
    if (IN(7)) { Frame F = make_frame(lds); LAS unsigned char* ring = F.lds + RING_OFF; ArgsP a_ = get_args(); unsigned char* ws = a_->ws;
        pg8::Gemm g{(const bf16_t*)(ws + WS_MIXED), (const bf16_t*)(ws + WS_WOUT), T, D, D}; pg8::StaticOrder S; S.init(T, D, F.G, bid);
        pg8::EpiRes E{(float*)(ws + WS_X1), a_->x}; pg8::gemm_phase<pg8::EpiRes, pg8::StaticOrder, true, true>(ring, g, S, E);
        SEAM(7); }
    if (IN(8)) { Frame F = make_frame(lds); ArgsP a_ = get_args(); unsigned char* ws = a_->ws; const int gw = F.vcu * NWAVES + F.wave, NGW = F.G * NWAVES;
        for (int m = gw; m < T; m += NGW) rms_row_to_bf16((const float*)(ws + WS_X1) + (size_t)m * D, a_->norm2_g, (bf16_t*)(ws + WS_H2) + (size_t)m * D, F.lane);
        SEAM(8); }
    if (IN(9)) { Frame F = make_frame(lds); LAS unsigned char* ring = F.lds + RING_OFF; ArgsP a_ = get_args(); unsigned char* ws = a_->ws;
        pg8::Gemm g{(const bf16_t*)(ws + WS_H2), (const bf16_t*)(ws + WS_WQ), T, 2048, D}; pg8::StaticOrder S; S.init(T, 2048, F.G, bid);
        pg8::EpiBf16 E{(bf16_t*)(ws + WS_PQ), 2048}; pg8::gemm_phase<pg8::EpiBf16, pg8::StaticOrder, true, true>(ring, g, S, E);
        SEAM(9); }
    if (IN(10)) { Frame F = make_frame(lds); ph10_select(get_args(), F); SEAM(10); }
    if (IN(11)) { Frame F = make_frame(lds); ph11_gather(get_args(), F); }
#undef IN
#undef SEAM
}

extern "C" void kernel_launch(void* const* d_in, const int* in_sizes, int n_in, void* d_out, int out_size, void* d_ws, size_t ws_size, hipStream_t stream) {
    static int grid = 0;
    if (grid == 0) {
        if (n_in != 23 || out_size != T * D || ws_size < WS_END) { fprintf(stderr, "kernel_launch: unexpected shapes (n_in %d out %d ws %zu); nothing launched\n", n_in, out_size, ws_size); grid = -1; return; }
        int dev = 0, cus = 0, per_cu = 0;
        if (hipGetDevice(&dev) != hipSuccess || hipDeviceGetAttribute(&cus, hipDeviceAttributeMultiprocessorCount, dev) != hipSuccess) { grid = -1; return; }
        if (hipFuncSetAttribute((const void*)mk_fwd, hipFuncAttributeMaxDynamicSharedMemorySize, LDS_BYTES) != hipSuccess) { grid = -1; return; }
        if (hipOccupancyMaxActiveBlocksPerMultiprocessor(&per_cu, (const void*)mk_fwd, NTHR, LDS_BYTES) != hipSuccess || per_cu < 1) fprintf(stderr, "kernel_launch: occupancy query reports %d\n", per_cu);
        (void)hipGetLastError();
        grid = cus;
    }
    if (grid < 0) return;
    (void)hipMemsetAsync((char*)d_ws + WS_CTL, 0, CTL_ZERO_BYTES, stream);
    Args a{};
    const float** ap = (const float**)&a;
    for (int i = 0; i < 23; ++i) ap[i] = (const float*)d_in[i];
    a.out = (float*)d_out; a.ws = (unsigned char*)d_ws; a.pad = 0;
    constexpr int NL = MK_N_LAUNCHES;
    for (int li = 0; li < NL; ++li) {
        a.ph_lo = (NL == 1) ? 0 : li; a.ph_hi = (NL == 1) ? NPH : li + 1; a.li = (NL == 1) ? 0 : 0;
        hipLaunchKernelGGL(mk_fwd, dim3(grid), dim3(NTHR), LDS_BYTES, stream, a);
#ifdef DUP_HI
        if (NL > 1 && li == DUP_HI) for (int l2 = DUP_LO; l2 <= DUP_HI; ++l2) { a.ph_lo = l2; a.ph_hi = l2 + 1; hipLaunchKernelGGL(mk_fwd, dim3(grid), dim3(NTHR), LDS_BYTES, stream, a); }
#endif
    }
}
```

```cpp
#include <hip/hip_runtime.h>
#include <cstdio>
#include <cstdint>

#ifndef MK_N_LAUNCHES
#define MK_N_LAUNCHES 1
#endif

#define GAS __attribute__((address_space(1)))
#define LAS __attribute__((address_space(3)))
typedef unsigned short bf16_t;
typedef __bf16 bf16x8 __attribute__((ext_vector_type(8)));
typedef float f32x2 __attribute__((ext_vector_type(2)));
typedef float f32x4 __attribute__((ext_vector_type(4)));
typedef float f32x16 __attribute__((ext_vector_type(16)));
typedef unsigned u32x2 __attribute__((ext_vector_type(2)));
typedef unsigned u32x4 __attribute__((ext_vector_type(4)));
typedef GAS unsigned gu32;

constexpr int T = 8192, D = 4096;
constexpr int RW = 2048, RH = 32, RN = 64;
constexpr int LW = 128, LA = 128, LG = 480, LGP = 512;
constexpr int SHIFTW = 6880;
constexpr int MH = 16, MD = 128, MBLK = 256, NBLK = 32;
constexpr int INW = 21216;
constexpr int PLD = 19200;
constexpr int PC_R = 0, PC_K = 2048, PC_V = 4096, PC_WL = 6144, PC_AL = 6272, PC_GL = 6400, PC_MQ = 6912, PC_MK = 8960, PC_GA = 11008, PC_GB = 15104, PC_MV = 19200;
constexpr int WIN_ROWS = 21248;
constexpr int PH_ = 8, PNK = 128, PQD = 256, PHALF = 128, PTOPK = 16;
constexpr float NORM_EPS = 1e-6f, LNX_EPS = 64e-5f;
constexpr float QSCALE = 0.08838834764831845f * 1.4426950408889634f;

constexpr size_t MiB = 1u << 20;
constexpr size_t WS_CTL = 0, CTL_ZERO_BYTES = 1 * MiB;
constexpr size_t WS_WIN = 1 * MiB;
constexpr size_t WS_X1 = 1 * MiB, WS_PQ = 129 * MiB;
constexpr size_t WS_WA = 167 * MiB, WS_WB = 183 * MiB, WS_WOUT = 199 * MiB, WS_WQ = 231 * MiB, WS_WUP = 247 * MiB, WS_AUP = 248 * MiB, WS_GUP = 249 * MiB, WS_SUBK = 251 * MiB;
constexpr size_t WS_PU = 252 * MiB, WS_PV = 380 * MiB;
constexpr size_t WS_XN = 508 * MiB;
constexpr size_t WS_Y = 508 * MiB, WS_H2 = 508 * MiB;
constexpr size_t WS_PROJ = 572 * MiB;
constexpr size_t WS_VT = 872 * MiB;
constexpr size_t WS_ROPE = 904 * MiB, WS_KMEAN = 908 * MiB, WS_MASK = 909 * MiB, WS_AW = 910 * MiB, WS_AA = 912 * MiB, WS_AG = 914 * MiB;
constexpr size_t WS_PSU = 909 * MiB + 512 * 1024, WS_PSV = WS_PSU + 64 * 1024;
constexpr size_t WS_DEC = 922 * MiB;
constexpr size_t WS_MIXED = 922 * MiB;
constexpr size_t WS_KKN = 986 * MiB, WS_BB = 1018 * MiB, WS_KP = 1050 * MiB, WS_ZR = 1082 * MiB, WS_ZV = 1114 * MiB, WS_G = 1146 * MiB;
constexpr size_t WS_YA = 1178 * MiB, WS_YB = 1210 * MiB, WS_IDX = 1242 * MiB, WS_GW = 1246 * MiB, WS_Z = 1250 * MiB, WS_SINIT = 1266 * MiB, WS_END = 1267 * MiB;

constexpr int CW_TMO = 0, CW_CODE = 1, CW_BAR = 4096;

constexpr int RING_OFF = 0, RING_BYTES = 135168;
constexpr int LDSCTL_OFF = RING_BYTES, MISC_OFF = LDSCTL_OFF + 320;
constexpr int LDS_BYTES = 147456;
constexpr int NWAVES = 8, NTHR = 512;

__device__ __forceinline__ unsigned f2bf(float f) { unsigned u = __builtin_bit_cast(unsigned, f); return (u + 0x7fffu + ((u >> 16) & 1u)) >> 16; }
__device__ __forceinline__ unsigned pk2(float lo, float hi) { unsigned r; asm volatile("v_cvt_pk_bf16_f32 %0, %1, %2" : "=v"(r) : "v"(lo), "v"(hi)); return r; }
__device__ __forceinline__ float bflo(unsigned u) { return __builtin_bit_cast(float, u << 16); }
__device__ __forceinline__ float bfhi(unsigned u) { return __builtin_bit_cast(float, u & 0xffff0000u); }
__device__ __forceinline__ float bf1(bf16_t b) { return __builtin_bit_cast(float, (unsigned)b << 16); }
__device__ __forceinline__ float fsigmoid(float x) { return __builtin_amdgcn_rcpf(1.0f + __expf(-x)); }
__device__ __forceinline__ float wave_sum(float v) {
#pragma unroll
    for (int o = 1; o < 64; o <<= 1) v += __shfl_xor(v, o);
    return v;
}
template <int CTRL> __device__ __forceinline__ float dpp_f(float v) { return __builtin_bit_cast(float, __builtin_amdgcn_update_dpp(0, __builtin_bit_cast(int, v), CTRL, 0xF, 0xF, true)); }
__device__ __forceinline__ float sum16(float x) {
    x += dpp_f<0xB1>(x); x += dpp_f<0x4E>(x); x += dpp_f<0x141>(x); x += dpp_f<0x140>(x); return x;
}
__device__ __forceinline__ float vmul(float a, float b) { float r; asm("v_mul_f32_e32 %0, %1, %2" : "=v"(r) : "v"(a), "v"(b)); return r; }
__device__ __forceinline__ float vfma(float a, float b, float c) { float r; asm("v_fma_f32 %0, %1, %2, %3" : "=v"(r) : "v"(a), "v"(b), "v"(c)); return r; }
#define LDS_WAIT() asm volatile("s_waitcnt lgkmcnt(0)" ::: "memory")
#define VM_WAIT() asm volatile("s_waitcnt vmcnt(0)" ::: "memory")
#define WG_BAR() do { asm volatile("s_waitcnt lgkmcnt(0)" ::: "memory"); __builtin_amdgcn_s_barrier(); asm volatile("" ::: "memory"); } while (0)

namespace pg8 {
constexpr int BM = 256, BK = 64, HALF = 128, HTB = HALF * BK * 2, STAGE_BYTES = 8 * HTB, NXCD = 8, WGM = 8;
__host__ __device__ __forceinline__ int lds_byte(int r, int c) { const int st = (r >> 4) * 2 + (c >> 5), rr = r & 15, cc = c & 31, ob = rr * 64 + cc * 2; return st * 1024 + (ob ^ (((ob >> 9) & 1) << 5)); }
__host__ __device__ __forceinline__ void stage_rc(int b, int& R, int& C) { const int st = b / 1024, sb = b % 1024, swz = sb ^ (((sb >> 9) & 1) << 5); R = (st >> 1) * 16 + swz / 64; C = (st & 1) * 32 + (swz % 64) / 2; }
__host__ __device__ __forceinline__ int perm32(int rho) { const int n = rho >> 4, i = rho & 15; return 8 * (i >> 2) + 4 * n + (i & 3); }

struct Unit { int pm, pn; };
struct Gemm { const bf16_t* A; const bf16_t* Bt; int M, N, K; };

struct StaticOrder {
    int nM, nN, nwg, G, c;
    __host__ __device__ void init(int M, int N, int G_, int c_) { nM = M / BM; nN = N / BM; nwg = nM * nN; G = G_; c = c_; }
    __host__ __device__ bool next(int i, Unit& u) const {
        const long L = (long)i * G + c; if (L >= nwg) return false;
        int wgid = (int)L; { const int q = nwg / NXCD, r = nwg % NXCD, xcd = wgid % NXCD, off = wgid / NXCD; wgid = (xcd < r ? xcd * (q + 1) : r * (q + 1) + (xcd - r) * q) + off; }
        const int nig = WGM * nN, gid = wgid / nig, fm = gid * WGM, gsz = (nM - fm) < WGM ? (nM - fm) : WGM;
        u.pm = fm + ((wgid % nig) % gsz); u.pn = (wgid % nig) / gsz; return true;
    }
    __device__ __forceinline__ void a_ready(const Unit&) const {}
    __device__ __forceinline__ void done(const Unit&) const {}
};

template <class Epi, class Sched, bool ALIGN_EPI = false, bool SP2 = false>
__device__ __forceinline__ void gemm_phase(LAS unsigned char* lds, const Gemm g, const Sched& S, const Epi& E) {
    int tid_ = threadIdx.x; asm volatile("" : "+v"(tid_));
    const int tid = tid_, wid = __builtin_amdgcn_readfirstlane(tid >> 6), lane = tid & 63, wr = wid >> 2, wc = wid & 3, fr = lane & 15, fq = lane >> 4;
    int K_ = g.K; asm volatile("" : "+s"(K_));
    const int K = K_, nt = K / BK;
    unsigned voffA[2], voffB[2];
#pragma unroll
    for (int i = 0; i < 2; ++i) { int R, C; stage_rc(tid * 16 + i * 8192, R, C); const int Rb = Epi::PERM ? ((R & ~31) + perm32(R & 31)) : R;
        voffA[i] = (unsigned)(R * K + C) * 2u; voffB[i] = (unsigned)(Rb * K + C) * 2u; }
    const size_t kstep = (size_t)(BK * 2);
    const size_t hstep = (size_t)HALF * K * 2;
    const size_t tstep = 2 * hstep;
    const unsigned ldsw = (unsigned)wid * 1024u;
    const int aoff = lds_byte(wr * 64 + fr, fq * 8), boff = lds_byte(wc * 32 + fr, fq * 8);
#define PG8_SA(b, h) (((b) * 2 + (h)) * HTB)
#define PG8_SB(b, h) ((4 + (b) * 2 + (h)) * HTB)
#define PG8_STAGE(bufoff, gbase, voff) do { _Pragma("unroll") for (int _i = 0; _i < 2; ++_i) \
        __builtin_amdgcn_global_load_lds((const unsigned*)((const char*)(gbase) + (voff)[_i]), (LAS unsigned*)(lds + (bufoff) + ldsw + _i * 8192), 16, 0, 0); } while (0)
#define PG8_LDA(dst, b, h) do { _Pragma("unroll") for (int m = 0; m < 4; ++m) _Pragma("unroll") for (int k = 0; k < 2; ++k) dst[m][k] = *(const LAS bf16x8*)(lds + PG8_SA(b, h) + aoff + m * 2048 + k * 1024); } while (0)
#define PG8_LDB(dst, b, h) do { _Pragma("unroll") for (int n = 0; n < 2; ++n) _Pragma("unroll") for (int k = 0; k < 2; ++k) dst[n][k] = *(const LAS bf16x8*)(lds + PG8_SB(b, h) + boff + n * 2048 + k * 1024); } while (0)
#define PG8_MMA(ai, bj, At, Bt) do { __builtin_amdgcn_s_setprio(1); _Pragma("unroll") for (int m = 0; m < 4; ++m) _Pragma("unroll") for (int n = 0; n < 2; ++n) _Pragma("unroll") for (int k = 0; k < 2; ++k) { \
        if constexpr (Epi::SWAP) acc[ai][bj][m][n] = __builtin_amdgcn_mfma_f32_16x16x32_bf16(At[m][k], Bt[n][k], acc[ai][bj][m][n], 0, 0, 0); \
        else acc[ai][bj][m][n] = __builtin_amdgcn_mfma_f32_16x16x32_bf16(Bt[n][k], At[m][k], acc[ai][bj][m][n], 0, 0, 0); } __builtin_amdgcn_s_setprio(0); } while (0)
#define PG8_WAIT_V(n) asm volatile("s_waitcnt vmcnt(" #n ")" ::: "memory")
#define PG8_WAIT_L(n) asm volatile("s_waitcnt lgkmcnt(" #n ")" ::: "memory")
#define PG8_BAR __builtin_amdgcn_s_barrier()
#define PG8_SCHED __builtin_amdgcn_sched_barrier(0)
    Unit cur, nxt; int ui = 0;
    if (!S.next(0, cur)) return;
    f32x4 acc[2][2][4][2];
#pragma unroll
    for (int a = 0; a < 2; ++a)
#pragma unroll
        for (int b = 0; b < 2; ++b)
#pragma unroll
            for (int m = 0; m < 4; ++m)
#pragma unroll
                for (int n = 0; n < 2; ++n) acc[a][b][m][n] = (f32x4){0.f, 0.f, 0.f, 0.f};
    bf16x8 At[4][2], B0[2][2], B1[2][2];
    const char* cA = (const char*)g.A + (size_t)cur.pm * tstep; const char* cB = (const char*)g.Bt + (size_t)cur.pn * tstep;
    S.a_ready(cur);
    if constexpr (SP2) {
        PG8_STAGE(PG8_SB(0, 0), cB, voffB); PG8_STAGE(PG8_SB(0, 1), cB + hstep, voffB); PG8_STAGE(PG8_SA(0, 0), cA, voffA); PG8_STAGE(PG8_SA(0, 1), cA + hstep, voffA);
        if (wr == 1) PG8_BAR;
        PG8_WAIT_V(2); PG8_BAR;
        PG8_STAGE(PG8_SB(1, 0), cB + kstep, voffB); PG8_STAGE(PG8_SA(1, 0), cA + kstep, voffA); PG8_STAGE(PG8_SB(1, 1), cB + hstep + kstep, voffB);
        PG8_WAIT_V(6); PG8_BAR;
    } else {
        PG8_STAGE(PG8_SB(0, 0), cB, voffB); PG8_STAGE(PG8_SA(0, 0), cA, voffA); PG8_STAGE(PG8_SB(0, 1), cB + hstep, voffB); PG8_STAGE(PG8_SA(0, 1), cA + hstep, voffA);
        if (wr == 1) PG8_BAR;
        PG8_WAIT_V(4); PG8_BAR;
        PG8_STAGE(PG8_SB(1, 0), cB + kstep, voffB); PG8_STAGE(PG8_SA(1, 0), cA + kstep, voffA); PG8_STAGE(PG8_SB(1, 1), cB + hstep + kstep, voffB);
        PG8_WAIT_V(6); PG8_BAR;
    }
    for (;;) {
        const bool has_next = S.next(ui + 1, nxt);
        const char* nA = has_next ? (const char*)g.A + (size_t)nxt.pm * tstep : cA; const char* nB = has_next ? (const char*)g.Bt + (size_t)nxt.pn * tstep : cB;
        for (int t = 0; t < nt; t += 2) {
            const bool last = (t == nt - 2);
            const char* a1 = cA + (size_t)(t + 1) * kstep;
            const char* a2 = last ? nA : cA + (size_t)(t + 2) * kstep; const char* b2 = last ? nB : cB + (size_t)(t + 2) * kstep;
            const char* a3 = a2 + kstep; const char* b3 = b2 + kstep;
            if (last && has_next) S.a_ready(nxt);
            if constexpr (SP2) {
            PG8_LDB(B0, 0, 0); PG8_LDB(B1, 0, 1); PG8_SCHED; PG8_LDA(At, 0, 0); PG8_STAGE(PG8_SA(1, 1), a1 + hstep, voffA);
            PG8_WAIT_V(8); PG8_WAIT_L(0); PG8_BAR; PG8_MMA(0, 0, At, B0); PG8_MMA(0, 1, At, B1); PG8_BAR; PG8_SCHED;
            PG8_LDA(At, 0, 1); PG8_STAGE(PG8_SB(0, 0), b2, voffB); PG8_STAGE(PG8_SB(0, 1), b2 + hstep, voffB); PG8_STAGE(PG8_SA(0, 0), a2, voffA);
            PG8_WAIT_V(8); PG8_WAIT_L(0); PG8_BAR; PG8_MMA(1, 0, At, B0); PG8_MMA(1, 1, At, B1); PG8_BAR; PG8_SCHED;
            PG8_LDB(B0, 1, 0); PG8_LDB(B1, 1, 1); PG8_SCHED; PG8_LDA(At, 1, 0); PG8_STAGE(PG8_SA(0, 1), a2 + hstep, voffA);
            PG8_WAIT_V(8); PG8_WAIT_L(0); PG8_BAR; PG8_MMA(0, 0, At, B0); PG8_MMA(0, 1, At, B1); PG8_BAR; PG8_SCHED;
            PG8_LDA(At, 1, 1); PG8_STAGE(PG8_SB(1, 0), b3, voffB); PG8_STAGE(PG8_SB(1, 1), b3 + hstep, voffB); PG8_STAGE(PG8_SA(1, 0), a3, voffA);
            PG8_WAIT_V(8); PG8_WAIT_L(0); PG8_BAR; PG8_MMA(1, 0, At, B0); PG8_MMA(1, 1, At, B1); PG8_BAR; PG8_SCHED;
            } else {
            PG8_LDB(B0, 0, 0); PG8_SCHED; PG8_LDA(At, 0, 0); PG8_STAGE(PG8_SA(1, 1), a1 + hstep, voffA);
            PG8_WAIT_L(8); PG8_BAR; PG8_WAIT_L(0); PG8_MMA(0, 0, At, B0); PG8_BAR; PG8_SCHED;
            PG8_LDB(B1, 0, 1); PG8_STAGE(PG8_SB(0, 0), b2, voffB);
            PG8_BAR; PG8_WAIT_L(0); PG8_MMA(0, 1, At, B1); PG8_BAR;
            PG8_LDA(At, 0, 1); PG8_STAGE(PG8_SA(0, 0), a2, voffA);
            PG8_BAR; PG8_WAIT_L(0); PG8_MMA(1, 0, At, B0); PG8_BAR; PG8_SCHED;
            PG8_STAGE(PG8_SB(0, 1), b2 + hstep, voffB);
            PG8_WAIT_V(6); PG8_BAR; PG8_MMA(1, 1, At, B1); PG8_BAR;
            PG8_LDB(B0, 1, 0); PG8_SCHED; PG8_LDA(At, 1, 0); PG8_STAGE(PG8_SA(0, 1), a2 + hstep, voffA);
            PG8_WAIT_L(8); PG8_BAR; PG8_WAIT_L(0); PG8_MMA(0, 0, At, B0); PG8_BAR; PG8_SCHED;
            PG8_LDB(B1, 1, 1); PG8_STAGE(PG8_SB(1, 0), b3, voffB);
            PG8_BAR; PG8_WAIT_L(0); PG8_MMA(0, 1, At, B1); PG8_BAR;
            PG8_LDA(At, 1, 1); PG8_STAGE(PG8_SA(1, 0), a3, voffA);
            PG8_BAR; PG8_WAIT_L(0); PG8_MMA(1, 0, At, B0); PG8_BAR; PG8_SCHED;
            PG8_STAGE(PG8_SB(1, 1), b3 + hstep, voffB);
            PG8_WAIT_V(6); PG8_BAR; PG8_MMA(1, 1, At, B1); PG8_BAR;
            }
        }
        if constexpr (ALIGN_EPI) { if (wr == 0) PG8_BAR; }
        E(acc, cur, wr, wc, fr, fq); S.done(cur);
        if (!has_next) break;
#pragma unroll
        for (int a = 0; a < 2; ++a)
#pragma unroll
            for (int b = 0; b < 2; ++b)
#pragma unroll
                for (int m = 0; m < 4; ++m)
#pragma unroll
                    for (int n = 0; n < 2; ++n) acc[a][b][m][n] = (f32x4){0.f, 0.f, 0.f, 0.f};
        cur = nxt; cA = nA; cB = nB; ++ui;
        if constexpr (ALIGN_EPI) { if (wr == 1) PG8_BAR; }
    }
    PG8_WAIT_V(0);
    if constexpr (!ALIGN_EPI) { if (wr == 0) PG8_BAR; }
    PG8_BAR;
#undef PG8_SA
#undef PG8_SB
#undef PG8_STAGE
#undef PG8_LDA
#undef PG8_LDB
#undef PG8_MMA
#undef PG8_WAIT_V
#undef PG8_WAIT_L
#undef PG8_BAR
#undef PG8_SCHED
}

typedef const f32x4 (&AccRef)[2][2][4][2];
__device__ __forceinline__ u32x4 pack8(f32x4 v0, f32x4 v1) { u32x4 w; w.x = pk2(v0[0], v0[1]); w.y = pk2(v0[2], v0[3]); w.z = pk2(v1[0], v1[1]); w.w = pk2(v1[2], v1[3]); return w; }
__device__ __forceinline__ void unpack8(u32x4 w, f32x4& v0, f32x4& v1) { v0 = (f32x4){bflo(w.x), bfhi(w.x), bflo(w.y), bfhi(w.y)}; v1 = (f32x4){bflo(w.z), bfhi(w.z), bflo(w.w), bfhi(w.w)}; }

struct EpiBf16 {
    static constexpr bool PERM = true, SWAP = false;
    bf16_t* O; int ldc;
    __device__ __forceinline__ void operator()(AccRef acc, const Unit& u, int wr, int wc, int fr, int fq) const {
        const int row0 = u.pm * BM + wr * 64 + fr, col0 = u.pn * BM + wc * 32 + 8 * fq;
#pragma unroll
        for (int ai = 0; ai < 2; ++ai)
#pragma unroll
            for (int m = 0; m < 4; ++m) { bf16_t* rowp = O + (size_t)(row0 + ai * HALF + m * 16) * ldc + col0;
#pragma unroll
                for (int bj = 0; bj < 2; ++bj) *(u32x4*)(rowp + bj * HALF) = pack8(acc[ai][bj][m][0], acc[ai][bj][m][1]); }
    }
};
struct EpiProj {
    static constexpr bool PERM = true, SWAP = false;
    bf16_t* O; const float* rope;
    __device__ __forceinline__ void operator()(AccRef acc, const Unit& u, int wr, int wc, int fr, int fq) const {
        const int row0 = u.pm * BM + wr * 64 + fr, col0 = u.pn * BM + wc * 32 + 8 * fq;
        const int mode = (u.pn >= 27 && u.pn < 43) ? (u.pn < 35 ? 1 : 2) : 0;
        const float sc = (mode == 1) ? QSCALE : 1.0f;
#pragma unroll
        for (int ai = 0; ai < 2; ++ai)
#pragma unroll
            for (int m = 0; m < 4; ++m) { const int row = row0 + ai * HALF + m * 16; bf16_t* rowp = O + (size_t)row * PLD + col0;
#pragma unroll
                for (int bj = 0; bj < 2; ++bj) { f32x4 v0 = acc[ai][bj][m][0], v1 = acc[ai][bj][m][1];
                    if (mode) { const int i0 = ((col0 + bj * HALF) & 127) >> 1; const f32x4* rp = (const f32x4*)(rope + ((size_t)row * 64 + i0) * 2); const f32x4 c0 = rp[0], c1 = rp[1];
                        f32x4 o0, o1;
                        o0[0] = v0[0] * c0[0] - v0[1] * c0[1]; o0[1] = v0[1] * c0[0] + v0[0] * c0[1]; o0[2] = v0[2] * c0[2] - v0[3] * c0[3]; o0[3] = v0[3] * c0[2] + v0[2] * c0[3];
                        o1[0] = v1[0] * c1[0] - v1[1] * c1[1]; o1[1] = v1[1] * c1[0] + v1[0] * c1[1]; o1[2] = v1[2] * c1[2] - v1[3] * c1[3]; o1[3] = v1[3] * c1[2] + v1[2] * c1[3];
                        v0 = o0 * sc; v1 = o1 * sc; }
                    *(u32x4*)(rowp + bj * HALF) = pack8(v0, v1); } }
    }
};
struct EpiVT {
    static constexpr bool PERM = false, SWAP = true;
    bf16_t* VT;
    __device__ __forceinline__ void operator()(AccRef acc, const Unit& u, int wr, int wc, int fr, int fq) const {
        const int tok0 = u.pm * BM + wr * 64 + 4 * fq, col0 = u.pn * BM + wc * 32 + fr;
#pragma unroll
        for (int ai = 0; ai < 2; ++ai)
#pragma unroll
            for (int m = 0; m < 4; ++m)
#pragma unroll
                for (int bj = 0; bj < 2; ++bj)
#pragma unroll
                    for (int n = 0; n < 2; ++n) { const f32x4 v = acc[ai][bj][m][n]; u32x2 w; w.x = pk2(v[0], v[1]); w.y = pk2(v[2], v[3]);
                        *(u32x2*)(VT + (size_t)(col0 + bj * HALF + n * 16) * T + tok0 + ai * HALF + m * 16) = w; }
    }
};
struct EpiDec {
    static constexpr bool PERM = true, SWAP = false;
    float* O; const float* w0;
    __device__ __forceinline__ void operator()(AccRef acc, const Unit& u, int wr, int wc, int fr, int fq) const {
        const int row0 = u.pm * BM + wr * 64 + fr, col0 = u.pn * BM + wc * 32 + 8 * fq;
#pragma unroll
        for (int bj = 0; bj < 2; ++bj) { const f32x4 b0 = *(const f32x4*)(w0 + col0 + bj * HALF), b1 = *(const f32x4*)(w0 + col0 + bj * HALF + 4);
#pragma unroll
            for (int ai = 0; ai < 2; ++ai)
#pragma unroll
                for (int m = 0; m < 4; ++m) { float* rowp = O + (size_t)(row0 + ai * HALF + m * 16) * RW + col0 + bj * HALF;
#pragma unroll
                    for (int n = 0; n < 2; ++n) { const f32x4 x = acc[ai][bj][m][n] + (n ? b1 : b0); f32x4 o;
#pragma unroll
                        for (int e = 0; e < 4; ++e) { const float z = -x[e]; const float sp = fmaxf(z, 0.f) + __logf(1.0f + __expf(-fabsf(z))); o[e] = __expf(-__expf(-sp - 0.5f)); }
                        *(f32x4*)(rowp + 4 * n) = o; }
                    asm volatile("" ::: "memory"); } }
    }
};
struct EpiA {
    static constexpr bool PERM = true, SWAP = false;
    bf16_t* KP; bf16_t* BB; const bf16_t* KKN; const float* a0; const float* k_a;
    __device__ __forceinline__ void operator()(AccRef acc, const Unit& u, int wr, int wc, int fr, int fq) const {
        const int row0 = u.pm * BM + wr * 64 + fr, col0 = u.pn * BM + wc * 32 + 8 * fq;
#pragma unroll
        for (int bj = 0; bj < 2; ++bj) { const int cb = col0 + bj * HALF;
            const f32x4 b0 = *(const f32x4*)(a0 + cb), b1 = *(const f32x4*)(a0 + cb + 4), ka0 = *(const f32x4*)(k_a + cb), ka1 = *(const f32x4*)(k_a + cb + 4);
#pragma unroll
            for (int ai = 0; ai < 2; ++ai)
#pragma unroll
                for (int m = 0; m < 4; ++m) { const size_t off = (size_t)(row0 + ai * HALF + m * 16) * RW + cb;
                    f32x4 zk0, zk1, kn0, kn1; unpack8(*(const u32x4*)(KP + off), zk0, zk1); unpack8(*(const u32x4*)(KKN + off), kn0, kn1);
                    f32x4 a0v, a1v;
#pragma unroll
                    for (int e = 0; e < 4; ++e) { a0v[e] = fsigmoid(acc[ai][bj][m][0][e] + b0[e]); a1v[e] = fsigmoid(acc[ai][bj][m][1][e] + b1[e]); }
                    const f32x4 kp0 = zk0 * (1.0f + (a0v - 1.0f) * ka0), kp1 = zk1 * (1.0f + (a1v - 1.0f) * ka1);
                    *(u32x4*)(KP + off) = pack8(kp0, kp1); *(u32x4*)(BB + off) = pack8(-(kn0 * a0v), -(kn1 * a1v));
                    asm volatile("" ::: "memory"); } }
    }
};
template <bool ADD> struct EpiMix {
    static constexpr bool PERM = true, SWAP = false;
    bf16_t* O; const bf16_t* proj; int gcol0;
    __device__ __forceinline__ void operator()(AccRef acc, const Unit& u, int wr, int wc, int fr, int fq) const {
        const int row0 = u.pm * BM + wr * 64 + fr, col0 = u.pn * BM + wc * 32 + 8 * fq;
#pragma unroll
        for (int ai = 0; ai < 2; ++ai)
#pragma unroll
            for (int m = 0; m < 4; ++m) { const int row = row0 + ai * HALF + m * 16;
#pragma unroll
                for (int bj = 0; bj < 2; ++bj) { f32x4 g0, g1; unpack8(*(const u32x4*)(proj + (size_t)row * PLD + gcol0 + col0 + bj * HALF), g0, g1);
                    f32x4 o0, o1;
#pragma unroll
                    for (int e = 0; e < 4; ++e) { o0[e] = fsigmoid(g0[e]) * acc[ai][bj][m][0][e]; o1[e] = fsigmoid(g1[e]) * acc[ai][bj][m][1][e]; }
                    bf16_t* op = O + (size_t)row * D + col0 + bj * HALF;
                    if (ADD) { f32x4 p0, p1; unpack8(*(const u32x4*)op, p0, p1); o0 += p0; o1 += p1; }
                    *(u32x4*)op = pack8(o0, o1); } }
    }
};
struct EpiRes {
    static constexpr bool PERM = true, SWAP = false;
    float* O; const float* x;
    __device__ __forceinline__ void operator()(AccRef acc, const Unit& u, int wr, int wc, int fr, int fq) const {
        const int row0 = u.pm * BM + wr * 64 + fr, col0 = u.pn * BM + wc * 32 + 8 * fq;
#pragma unroll
        for (int ai = 0; ai < 2; ++ai)
#pragma unroll
            for (int m = 0; m < 4; ++m) { const size_t off = (size_t)(row0 + ai * HALF + m * 16) * D + col0;
#pragma unroll
                for (int bj = 0; bj < 2; ++bj)
#pragma unroll
                    for (int n = 0; n < 2; ++n) *(f32x4*)(O + off + bj * HALF + 4 * n) = *(const f32x4*)(x + off + bj * HALF + 4 * n) + acc[ai][bj][m][n]; }
    }
};
}

#define XB_TMO      128
#define XB_XCNT(j)  (256  + 64 * (j))
#define XB_XSUB(j)  (1280 + 64 * (j))
#define XB_XGEN(j)  (2304 + 64 * (j))
#define XB_TOP      3328
#define XB_TOPGEN   3392
#define XCD_BAR_WORDS 3456
#define XB_SPIN_CAP (1u << 18)
__device__ __forceinline__ unsigned xb_ld(unsigned* p)              { return __hip_atomic_load(p, __ATOMIC_RELAXED, __HIP_MEMORY_SCOPE_AGENT); }
__device__ __forceinline__ unsigned xb_add(unsigned* p, unsigned v) { return __hip_atomic_fetch_add(p, v, __ATOMIC_RELAXED, __HIP_MEMORY_SCOPE_AGENT); }
__device__ __forceinline__ unsigned xb_xcc_id() { return (unsigned)__builtin_amdgcn_s_getreg((3 << 11) | 20) & 0xFu; }
#define XB_SPIN(cond, bar) do { unsigned _sp = 0; while (cond) { __builtin_amdgcn_s_sleep(1); \
    if ((++_sp & 255u) == 0u) { if (xb_ld(&(bar)[XB_TMO])) break; if (_sp > XB_SPIN_CAP) { atomicAdd(&(bar)[XB_TMO], 1u); break; } } } } while (0)
struct XcdBarrier { unsigned* bar; unsigned x; volatile LAS unsigned* st; };
__device__ __forceinline__ XcdBarrier xcd_barrier_post(unsigned* bar, volatile LAS unsigned* st) {
    XcdBarrier b; b.bar = bar; b.x = xb_xcc_id(); b.st = st;
    if (threadIdx.x == 0) (void)xb_add(&bar[XB_XCNT(b.x)], 1u);
    return b;
}
__device__ __forceinline__ void xcd_barrier_complete(unsigned* bar, unsigned x, unsigned& nloc, unsigned& nx) {
    const unsigned G = gridDim.x * gridDim.y * gridDim.z;
    unsigned sum, cnt, mine, sp = 0u;
    for (;;) {
        sum = 0u; cnt = 0u; mine = 0u;
#pragma unroll
        for (unsigned j = 0; j < 16; ++j) { const unsigned c = xb_ld(&bar[XB_XCNT(j)]); sum += c; cnt += (c > 0u) ? 1u : 0u; mine = (j == x) ? c : mine; }
        if (sum == G) break;
        __builtin_amdgcn_s_sleep(1);
        if ((++sp & 255u) == 0u) { if (xb_ld(&bar[XB_TMO])) break; if (sp > XB_SPIN_CAP) { atomicAdd(&bar[XB_TMO], 1u); break; } }
    }
    nloc = mine > 0u ? mine : 1u; nx = cnt > 0u ? cnt : 1u;
}
__device__ __forceinline__ void xcd_barrier(const XcdBarrier& b) {
    asm volatile("s_waitcnt vmcnt(0)" ::: "memory");
    __syncthreads();
    if (threadIdx.x == 0) {
        unsigned* bar = b.bar;
        __builtin_amdgcn_s_waitcnt(0);
        unsigned nloc = b.st[0], nx = b.st[1];
        if (nloc == 0u) { xcd_barrier_complete(bar, b.x, nloc, nx); b.st[0] = nloc; b.st[1] = nx; }
        const unsigned old = xb_add(&bar[XB_XSUB(b.x)], 1u);
        const unsigned gen = old / nloc;
        if (old + 1u == (gen + 1u) * nloc) {
            __builtin_amdgcn_fence(__ATOMIC_RELEASE, "agent");
            asm volatile("s_waitcnt vmcnt(0)" ::: "memory");
            const unsigned og = xb_add(&bar[XB_TOP], 1u);
            const unsigned tg = og / nx;
            if (og + 1u == (tg + 1u) * nx) xb_add(&bar[XB_TOPGEN], 1u);
            else XB_SPIN(xb_ld(&bar[XB_TOPGEN]) == tg, bar);
            __builtin_amdgcn_fence(__ATOMIC_ACQUIRE, "agent");
            xb_add(&bar[XB_XGEN(b.x)], 1u);
            asm volatile("s_waitcnt vmcnt(0)" ::: "memory");
        } else {
            XB_SPIN(xb_ld(&bar[XB_XGEN(b.x)]) == gen, bar);
            __builtin_amdgcn_fence(__ATOMIC_ACQUIRE, "agent");
            asm volatile("s_waitcnt vmcnt(0)" ::: "memory");
        }
    }
    __syncthreads();
}

struct Args {
    const float *x, *norm1_g, *w_in, *mu, *w0, *w_up, *a0, *a_up, *g_up, *k_k, *k_a, *r_k, *lnx_g, *lnx_b, *w_ba, *w_bb, *w_out, *norm2_g, *peer_wq, *sub_keys, *peer_u, *peer_v, *final_g;
    float* out; unsigned char* ws; int ph_lo, ph_hi, li, pad;
};
#define CAS __attribute__((address_space(4)))
typedef const CAS Args* ArgsP;
__device__ __forceinline__ ArgsP get_args() { ArgsP p = (ArgsP)__builtin_amdgcn_kernarg_segment_ptr(); asm volatile("" : "+s"(p)); return p; }
struct Frame { LAS unsigned char* lds; int tid, lane, wave, vcu, G; };

__device__ __forceinline__ int win_dst(int s) {
    if (s < SHIFTW) return s;
    if (s < SHIFTW + 4096) { const int base = (s < SHIFTW + 2048) ? SHIFTW : SHIFTW + 2048; const int m = s - base, head = m >> 7, c = m & 127; const int j = (c < 64) ? 2 * c : 2 * (c - 64) + 1;
        return ((s < SHIFTW + 2048) ? PC_MQ : PC_MK) + head * 128 + j; }
    if (s < SHIFTW + 6144) return PC_MV + (s - (SHIFTW + 4096));
    if (s < SHIFTW + 6144 + 4096) return PC_GA + (s - (SHIFTW + 6144));
    return PC_GB + (s - (SHIFTW + 6144 + 4096));
}
template <bool MAPWIN> __device__ __forceinline__ void p0_transpose_item(const float* W, int K, int N, bf16_t* WT, int Kd, LAS float* scr, int item, int lane) {
    const int nblk = N / 32, kb = item / nblk, nb = item % nblk, k0 = 64 * kb, n0 = 32 * nb;
    { const int krow = lane >> 3, c4 = lane & 7; f32x4 v[8];
#pragma unroll
      for (int i = 0; i < 8; ++i) { const int kk = 8 * i + krow; v[i] = (k0 + kk < K) ? *(const f32x4*)(W + (size_t)(k0 + kk) * N + n0 + 4 * c4) : (f32x4){0.f, 0.f, 0.f, 0.f}; }
#pragma unroll
      for (int i = 0; i < 8; ++i) { LAS float* d = scr + (8 * i + krow) * 33 + 4 * c4; d[0] = v[i].x; d[1] = v[i].y; d[2] = v[i].z; d[3] = v[i].w; } }
    LDS_WAIT(); asm volatile("" ::: "memory");
    const int c = lane & 7;
#pragma unroll
    for (int j = 0; j < 4; ++j) { const int n = (lane >> 3) + 8 * j; const LAS float* s = scr + (8 * c) * 33 + n;
        u32x4 o; o.x = pk2(s[0 * 33], s[1 * 33]); o.y = pk2(s[2 * 33], s[3 * 33]); o.z = pk2(s[4 * 33], s[5 * 33]); o.w = pk2(s[6 * 33], s[7 * 33]);
        const int row = MAPWIN ? win_dst(n0 + n) : (n0 + n);
        *(u32x4*)(WT + (size_t)row * Kd + k0 + 8 * c) = o; }
    LDS_WAIT(); asm volatile("" ::: "memory");
}
__device__ __forceinline__ void rms_row_to_bf16(const float* xrow, const float* g, bf16_t* orow, int lane) {
    const f32x4* xr = (const f32x4*)xrow + lane; const f32x4* gr = (const f32x4*)g + lane;
    f32x4 v[16]; float s = 0.f;
#pragma unroll
    for (int j = 0; j < 16; ++j) { v[j] = xr[64 * j]; s += (v[j].x * v[j].x + v[j].y * v[j].y) + (v[j].z * v[j].z + v[j].w * v[j].w); }
    const float rs = 1.0f / sqrtf(wave_sum(s) * (1.0f / D) + NORM_EPS);
    u32x2* o8 = (u32x2*)orow + lane;
#pragma unroll
    for (int j = 0; j < 16; ++j) { const f32x4 gg = gr[64 * j]; u32x2 w; w.x = pk2(v[j].x * rs * gg.x, v[j].y * rs * gg.y); w.y = pk2(v[j].z * rs * gg.z, v[j].w * rs * gg.w); o8[64 * j] = w; }
}
__device__ __forceinline__ void cvt_table(const float* src, bf16_t* dst, size_t n8, size_t gtid, size_t nthr) {
    for (size_t i = gtid; i < n8; i += nthr) { const f32x4 a = ((const f32x4*)src)[2 * i], b = ((const f32x4*)src)[2 * i + 1]; ((u32x4*)dst)[i] = pg8::pack8(a, b); }
}
__device__ __forceinline__ void ph0_prologue(ArgsP A, Frame& F) {
    unsigned char* ws = A->ws;
    LAS float* scr = (LAS float*)(F.lds + RING_OFF + F.wave * 16384);
    const int gw = F.vcu * NWAVES + F.wave, NGW = F.G * NWAVES;
    constexpr int I_IN = 64 * (INW / 32), I_BA = 32 * 128, I_OUT = 64 * 128, I_WQ = 64 * 64, I_UP = 2 * 64, I_G = 8 * 64;
    constexpr int NITEMS = I_IN + 2 * I_BA + I_OUT + I_WQ + 2 * I_UP + I_G;
    for (int it = gw; it < NITEMS; it += NGW) {
        int r = it;
        if (r < I_IN) { p0_transpose_item<true>(A->w_in, D, INW, (bf16_t*)(ws + WS_WIN), D, scr, r, F.lane); continue; } r -= I_IN;
        if (r < I_BA) { p0_transpose_item<false>(A->w_ba, RW, D, (bf16_t*)(ws + WS_WA), RW, scr, r, F.lane); continue; } r -= I_BA;
        if (r < I_BA) { p0_transpose_item<false>(A->w_bb, RW, D, (bf16_t*)(ws + WS_WB), RW, scr, r, F.lane); continue; } r -= I_BA;
        if (r < I_OUT) { p0_transpose_item<false>(A->w_out, D, D, (bf16_t*)(ws + WS_WOUT), D, scr, r, F.lane); continue; } r -= I_OUT;
        if (r < I_WQ) { p0_transpose_item<false>(A->peer_wq, D, 2048, (bf16_t*)(ws + WS_WQ), D, scr, r, F.lane); continue; } r -= I_WQ;
        if (r < I_UP) { p0_transpose_item<false>(A->w_up, LW, RW, (bf16_t*)(ws + WS_WUP), LW, scr, r, F.lane); continue; } r -= I_UP;
        if (r < I_UP) { p0_transpose_item<false>(A->a_up, LA, RW, (bf16_t*)(ws + WS_AUP), LA, scr, r, F.lane); continue; } r -= I_UP;
        p0_transpose_item<false>(A->g_up, LG, RW, (bf16_t*)(ws + WS_GUP), LGP, scr, r, F.lane);
    }
    const size_t gtid = (size_t)F.vcu * NTHR + F.tid, nthr = (size_t)F.G * NTHR;
    for (size_t i = gtid; i < (size_t)32 * D / 8; i += nthr) ((u32x4*)((bf16_t*)(ws + WS_WIN) + (size_t)SHIFTW * D))[i] = (u32x4){0u, 0u, 0u, 0u};
    for (int row = gw; row < 2 * 16384; row += NGW) { const bool isv = row >= 16384; const int rr = isv ? row - 16384 : row;
        const f32x4* src = (const f32x4*)((isv ? A->peer_v : A->peer_u) + (size_t)rr * D) + F.lane; f32x4 v[16]; float am = 0.f;
#pragma unroll
        for (int j = 0; j < 16; ++j) { v[j] = src[64 * j]; am = fmaxf(fmaxf(am, fmaxf(fabsf(v[j].x), fabsf(v[j].y))), fmaxf(fabsf(v[j].z), fabsf(v[j].w))); }
#pragma unroll
        for (int o = 1; o < 64; o <<= 1) am = fmaxf(am, __shfl_xor(am, o));
        const float inv = am > 0.f ? 127.0f / am : 0.f; unsigned* dst = (unsigned*)(ws + (isv ? WS_PV : WS_PU)) + (size_t)rr * (D / 4) + F.lane;
#pragma unroll
        for (int j = 0; j < 16; ++j) { const unsigned q0 = (unsigned)(int)(rintf(v[j].x * inv) + 128.0f), q1 = (unsigned)(int)(rintf(v[j].y * inv) + 128.0f), q2 = (unsigned)(int)(rintf(v[j].z * inv) + 128.0f), q3 = (unsigned)(int)(rintf(v[j].w * inv) + 128.0f);
            dst[64 * j] = q0 | (q1 << 8) | (q2 << 16) | (q3 << 24); }
        if (F.lane == 0) ((float*)(ws + (isv ? WS_PSV : WS_PSU)))[rr] = am * (1.0f / 127.0f); }
    cvt_table(A->sub_keys, (bf16_t*)(ws + WS_SUBK), (size_t)PH_ * 2 * PNK * PHALF / 8, gtid, nthr);
    for (size_t i = gtid; i < (size_t)T * 64; i += nthr) { const int pos = (int)(i >> 6), fi = (int)(i & 63); const float inv = powf(10000.0f, -(float)fi / 64.0f); const float ang = (float)pos * inv;
        ((f32x2*)(ws + WS_ROPE))[i] = (f32x2){cosf(ang), sinf(ang)}; }
    for (int m = gw; m < T; m += NGW) rms_row_to_bf16(A->x + (size_t)m * D, A->norm1_g, (bf16_t*)(ws + WS_XN) + (size_t)m * D, F.lane);
}

__device__ __forceinline__ f32x4 ld4bf(const bf16_t* p) { const u32x2 w = *(const u32x2*)p; return (f32x4){bflo(w.x), bfhi(w.x), bflo(w.y), bfhi(w.y)}; }
__device__ __forceinline__ void st4bf(bf16_t* p, f32x4 v) { u32x2 w; w.x = pk2(v[0], v[1]); w.y = pk2(v[2], v[3]); *(u32x2*)p = w; }
__device__ __forceinline__ void ph2_prep(ArgsP A, Frame& F) {
    unsigned char* ws = A->ws; const bf16_t* PROJ = (const bf16_t*)(ws + WS_PROJ);
    LAS float* red = (LAS float*)(F.lds + RING_OFF);
    for (int it = F.vcu; it < NBLK * MH; it += F.G) { const int n = it / MH, h = it % MH, d = F.tid & 127, part = F.tid >> 7;
        const bf16_t* p = PROJ + (size_t)(n * MBLK + part * 64) * PLD + PC_MK + h * MD + d; float s = 0.f;
#pragma unroll 8
        for (int i = 0; i < 64; ++i) s += bf1(p[(size_t)i * PLD]);
        red[F.tid] = s; WG_BAR();
        if (F.tid < 128) { const float m = (red[F.tid] + red[F.tid + 128] + red[F.tid + 256] + red[F.tid + 384]) * (1.0f / MBLK); const unsigned hi = f2bf(m); const float lo = m - __builtin_bit_cast(float, hi << 16);
            ((bf16_t*)(ws + WS_KMEAN))[(size_t)(h * NBLK + n) * MD + F.tid] = (bf16_t)hi; ((bf16_t*)(ws + WS_KMEAN + 131072))[(size_t)(h * NBLK + n) * MD + F.tid] = (bf16_t)f2bf(lo); }
        WG_BAR(); }
    const int tid = F.tid;
    for (int t = F.vcu; t < T; t += F.G) { const bf16_t* P = PROJ + (size_t)t * PLD; const bf16_t* PP = P - PLD; const bool hasp = t > 0; const f32x4 zero = (f32x4){0.f, 0.f, 0.f, 0.f};
        { const int c = 4 * tid; const f32x4 p = ld4bf(P + PC_R + c), pp = hasp ? ld4bf(PP + PC_R + c) : zero, mu = *(const f32x4*)(A->mu + PC_R + c); st4bf((bf16_t*)(ws + WS_ZR) + (size_t)t * RW + c, p + (pp - p) * mu); }
        { const int c = 4 * tid; const f32x4 p = ld4bf(P + PC_K + c), pp = hasp ? ld4bf(PP + PC_K + c) : zero, mu = *(const f32x4*)(A->mu + PC_K + c); const f32x4 zk = p + (pp - p) * mu;
          st4bf((bf16_t*)(ws + WS_KP) + (size_t)t * RW + c, zk); const f32x4 kk = zk * *(const f32x4*)(A->k_k + c);
          const float ss = sum16((kk[0] * kk[0] + kk[1] * kk[1]) + (kk[2] * kk[2] + kk[3] * kk[3])); const float inv = 1.0f / fmaxf(sqrtf(ss), 1e-12f);
          st4bf((bf16_t*)(ws + WS_KKN) + (size_t)t * RW + c, kk * inv); }
        { const int c = 4 * tid; const f32x4 p = ld4bf(P + PC_V + c), pp = hasp ? ld4bf(PP + PC_V + c) : zero, mu = *(const f32x4*)(A->mu + PC_V + c); st4bf((bf16_t*)(ws + WS_ZV) + (size_t)t * RW + c, p + (pp - p) * mu); }
        if (tid < 192) {
            int c, cc; if (tid < 32) { cc = 4 * tid; c = PC_WL + cc; } else if (tid < 64) { cc = 4 * (tid - 32); c = PC_AL + cc; } else { cc = 4 * (tid - 64); c = PC_GL + cc; }
            f32x4 z = zero;
            if (tid < 64 || cc < LG) { const f32x4 p = ld4bf(P + c), pp = hasp ? ld4bf(PP + c) : zero, mu = *(const f32x4*)(A->mu + c); z = p + (pp - p) * mu; }
            if (tid < 32) { f32x4 o;
#pragma unroll
                for (int e = 0; e < 4; ++e) o[e] = 1.0f - 2.0f * __builtin_amdgcn_rcpf(__expf(2.0f * z[e]) + 1.0f);
                st4bf((bf16_t*)(ws + WS_AW) + (size_t)t * LW + cc, o); }
            else if (tid < 64) st4bf((bf16_t*)(ws + WS_AA) + (size_t)t * LA + cc, z);
            else { f32x4 o = zero; if (cc < LG) {
#pragma unroll
                for (int e = 0; e < 4; ++e) o[e] = fsigmoid(z[e]); }
                st4bf((bf16_t*)(ws + WS_AG) + (size_t)t * LGP + cc, o); }
        }
    }
}

__device__ __forceinline__ void ph3_gate(ArgsP A, Frame& F) {
    unsigned char* ws = A->ws; const bf16_t* PROJ = (const bf16_t*)(ws + WS_PROJ); const bf16_t* KMH = (const bf16_t*)(ws + WS_KMEAN); const bf16_t* KML = (const bf16_t*)(ws + WS_KMEAN + 131072); unsigned* MASK = (unsigned*)(ws + WS_MASK);
    const int gw = F.vcu * NWAVES + F.wave, NGW = F.G * NWAVES; const int r = F.lane & 31, hh = F.lane >> 5; const float NEG = -__builtin_inff();
    for (int it = gw; it < (T / 32) * MH; it += NGW) { const int tg = it >> 4, h = it & 15, t = tg * 32 + r, blk = tg >> 3;
        if (blk == 0) { if (hh == 0) MASK[t * MH + h] = 0u; continue; }
        f32x16 acc;
#pragma unroll
        for (int e = 0; e < 16; ++e) acc[e] = 0.f;
#pragma unroll
        for (int ks = 0; ks < 8; ++ks) { const bf16x8 q = *(const bf16x8*)(PROJ + (size_t)t * PLD + PC_MQ + h * MD + 16 * ks + 8 * hh); const size_t ko = (size_t)(h * NBLK + r) * MD + 16 * ks + 8 * hh;
            acc = __builtin_amdgcn_mfma_f32_32x32x16_bf16(*(const bf16x8*)(KMH + ko), q, acc, 0, 0, 0); acc = __builtin_amdgcn_mfma_f32_32x32x16_bf16(*(const bf16x8*)(KML + ko), q, acc, 0, 0, 0); }
        float t0 = NEG, t1 = NEG, t2 = NEG;
#pragma unroll
        for (int e = 0; e < 16; ++e) { const int n = (e & 3) + 8 * (e >> 2) + 4 * hh; float ae = acc[e]; asm volatile("" : "+v"(ae));
            float x = __builtin_bit_cast(float, (__builtin_bit_cast(unsigned, ae) & ~31u) | (unsigned)(31 - n)); x = (n < blk) ? x : NEG;
            t2 = __builtin_amdgcn_fmed3f(t1, t2, x); t1 = __builtin_amdgcn_fmed3f(t0, t1, x); t0 = fmaxf(t0, x); }
        const float o0 = __shfl_xor(t0, 32), o1 = __shfl_xor(t1, 32), o2 = __shfl_xor(t2, 32);
        t2 = __builtin_amdgcn_fmed3f(t1, t2, o0); t1 = __builtin_amdgcn_fmed3f(t0, t1, o0); t0 = fmaxf(t0, o0);
        t2 = __builtin_amdgcn_fmed3f(t1, t2, o1); t1 = __builtin_amdgcn_fmed3f(t0, t1, o1); t0 = fmaxf(t0, o1);
        t2 = __builtin_amdgcn_fmed3f(t1, t2, o2); t1 = __builtin_amdgcn_fmed3f(t0, t1, o2); t0 = fmaxf(t0, o2);
        unsigned sel = 1u << (31 - (__builtin_bit_cast(unsigned, t0) & 31u));
        if (blk > 1) sel |= 1u << (31 - (__builtin_bit_cast(unsigned, t1) & 31u));
        if (blk > 2) sel |= 1u << (31 - (__builtin_bit_cast(unsigned, t2) & 31u));
        if (hh == 0) MASK[t * MH + h] = sel; }
}

constexpr int SC_CH = 16, SC_STEP = 1312, SC_BUF = SC_CH * SC_STEP, SC_YOFF = 4 * SC_BUF, SC_YBUF = SC_CH * 8 * 16 * 4, SEG = T / 2;
static_assert(SC_YOFF + 6 * SC_YBUF <= RING_BYTES, "scan LDS");
__device__ __forceinline__ void ph4_scan(ArgsP A, Frame& F) {
    unsigned char* ws = A->ws;
    const float* DEC = (const float*)(ws + WS_DEC); const bf16_t* KKN = (const bf16_t*)(ws + WS_KKN); const bf16_t* BB = (const bf16_t*)(ws + WS_BB); const bf16_t* KP = (const bf16_t*)(ws + WS_KP);
    const bf16_t* ZR = (const bf16_t*)(ws + WS_ZR); const bf16_t* ZV = (const bf16_t*)(ws + WS_ZV); float* Y = (float*)(ws + WS_Y); bf16_t* Z = (bf16_t*)(ws + WS_Z); float* SINIT = (float*)(ws + WS_SINIT);
    LAS unsigned char* L = F.lds + RING_OFF;
    const int wave = F.wave, lane = F.lane;
    const bool scanner = wave < 6; const int pr = wave >> 1, stream = pr == 0 ? 0 : 1;
    const int ltid = (wave & 1) * 64 + lane;
    for (int unit = F.vcu; unit < 256; unit += F.G) {
        const int h = unit >> 3, r0 = (unit & 7) * 8; const size_t hc = (size_t)h * RN;
        constexpr int NC = SEG / SC_CH;
        const unsigned voffB = (unsigned)(((ltid >> 3) * RW + (int)hc + 8 * (ltid & 7)) * 2), voffD0 = (unsigned)(((ltid >> 4) * RW + (int)hc + 4 * (ltid & 15)) * 4), voffD1 = voffD0 + 8u * RW * 4u,
                       voffV = (unsigned)((((ltid & 31) >> 4) * SEG + (ltid & 15)) * RW + (int)hc + r0) * 2u;
#define SC_ISSUE(SET, c_) do { const size_t cb_ = (size_t)(c_) * SC_CH * RW; \
            _Pragma("unroll") for (int i = 0; i < 4; ++i) { const char* sb = (const char*)(DEC + (size_t)(i >> 1) * SEG * RW + cb_); ld_dec[SET][i] = *(const f32x4*)(sb + ((i & 1) ? voffD1 : voffD0)); } \
            _Pragma("unroll") for (int i = 0; i < 8; ++i) { const bf16_t* arr = (i >> 1) == 0 ? KKN : (i >> 1) == 1 ? BB : (i >> 1) == 2 ? KP : ZR; const char* sb = (const char*)(arr + (size_t)(i & 1) * SEG * RW + cb_); \
                ld_b[SET][i] = *(const u32x4*)(sb + voffB); } \
            { const char* sb = (const char*)(ZV + cb_); ld_v[SET] = *(const u32x4*)(sb + voffV); } } while (0)
#define SC_COMMIT(SET, par_) do { const int par = (par_); \
            _Pragma("unroll") for (int i = 0; i < 4; ++i) { const int st = (i & 1) * 8 + (ltid >> 4), c4 = ltid & 15; *(LAS f32x4*)(L + ((i >> 1) * 2 + par) * SC_BUF + st * SC_STEP + 16 * c4) = ld_dec[SET][i]; } \
            _Pragma("unroll") for (int i = 0; i < 8; ++i) { const int st = ltid >> 3, c8 = ltid & 7; f32x4 v0, v1; pg8::unpack8(ld_b[SET][i], v0, v1); \
                LAS unsigned char* p = L + ((i & 1) * 2 + par) * SC_BUF + st * SC_STEP + 256 * ((i >> 1) + 1) + 32 * c8; *(LAS f32x4*)p = v0; *(LAS f32x4*)(p + 16) = v1; asm volatile("" ::: "memory"); __builtin_amdgcn_sched_barrier(0); } \
            if (ltid < 32) { f32x4 v0, v1; pg8::unpack8(ld_v[SET], v0, v1); LAS unsigned char* p = L + ((ltid >> 4) * 2 + par) * SC_BUF + (ltid & 15) * SC_STEP + 1280; *(LAS f32x4*)p = v0; *(LAS f32x4*)(p + 16) = v1; } } while (0)
        auto yflush = [&](int c) { const int st = ltid >> 3, rr = ltid & 7;
#pragma unroll
            for (int p = 0; p < 3; ++p) { const LAS f32x4* q = (const LAS f32x4*)(L + SC_YOFF + (p * 2 + (c & 1)) * SC_YBUF + (st * 8 + rr) * 64);
                const f32x4 a = q[0], b = q[1], cc = q[2], d = q[3]; const f32x4 s4 = (a + b) + (cc + d); const float val = (s4[0] + s4[1]) + (s4[2] + s4[3]);
                if (p == 0) Y[(size_t)(c * SC_CH + st) * RW + hc + r0 + rr] = val;
                else if (p == 1) Y[(size_t)(SEG + c * SC_CH + st) * RW + hc + r0 + rr] = val;
                else Z[(size_t)(c * SC_CH + st) * RW + hc + r0 + rr] = (bf16_t)f2bf(val);
                asm volatile("" ::: "memory"); __builtin_amdgcn_sched_barrier(0); } };
        const int row = (wave & 1) * 4 + (lane >> 4), j = lane & 15;
        float S0 = 0.f, S1 = 0.f, S2 = 0.f, S3 = 0.f;
        if (pr == 2) { const int d = (r0 + row) - 4 * j; S0 = d == 0 ? 1.f : 0.f; S1 = d == 1 ? 1.f : 0.f; S2 = d == 2 ? 1.f : 0.f; S3 = d == 3 ? 1.f : 0.f; }
#define SC_LOAD(W, KK, BBv, KPv, RR, V, tt_) do { const int o_ = (tt_) * SC_STEP; W = *(const LAS f32x4*)(B + o_); KK = *(const LAS f32x4*)(B + o_ + 256); BBv = *(const LAS f32x4*)(B + o_ + 512); KPv = *(const LAS f32x4*)(B + o_ + 768); RR = *(const LAS f32x4*)(B + o_ + 1024); if (USEV) V = *(const LAS float*)(vb + o_); } while (0)
#define SC_STEPF(W, KK, BBv, KPv, RR, V, tt_) do { \
            float p_ = vmul(S0, KK[0]), q_ = vmul(S2, KK[2]); p_ = vfma(S1, KK[1], p_); q_ = vfma(S3, KK[3], q_); \
            float t0_ = vmul(S0, W[0]), t1_ = vmul(S1, W[1]), t2_ = vmul(S2, W[2]), t3_ = vmul(S3, W[3]); \
            if (USEV) { t0_ = vfma(V, KPv[0], t0_); t1_ = vfma(V, KPv[1], t1_); t2_ = vfma(V, KPv[2], t2_); t3_ = vfma(V, KPv[3], t3_); } \
            const float d_ = sum16(p_ + q_);                        \
            S0 = vfma(d_, BBv[0], t0_); S1 = vfma(d_, BBv[1], t1_); S2 = vfma(d_, BBv[2], t2_); S3 = vfma(d_, BBv[3], t3_); \
            float y0_ = vmul(S0, RR[0]), y1_ = vmul(S2, RR[2]); y0_ = vfma(S1, RR[1], y0_); y1_ = vfma(S3, RR[3], y1_); yb[(tt_) * 128] = y0_ + y1_; } while (0)
#define SC_SCAN_LOOP() do { _Pragma("unroll 1") for (int c = 0; c < NC; ++c) { \
            const LAS unsigned char* B = L + (stream * 2 + (c & 1)) * SC_BUF + 16 * j; LAS float* yb = (LAS float*)(L + SC_YOFF + (pr * 2 + (c & 1)) * SC_YBUF) + row * 16 + j; \
            const LAS unsigned char* vb = L + (stream * 2 + (c & 1)) * SC_BUF + 1280 + 4 * row; \
            f32x4 wA, kA, bA, pA, rA, wB, kB, bB, pB, rB, wC, kC, bC, pC, rC, wD, kD, bD, pD, rD; float vA = 0.f, vB = 0.f, vC = 0.f, vD = 0.f; \
            SC_LOAD(wA, kA, bA, pA, rA, vA, 0); SC_LOAD(wB, kB, bB, pB, rB, vB, 1); \
            _Pragma("unroll 1") for (int tt = 0; tt < SC_CH; tt += 4) { const int t4 = tt + 4 < SC_CH ? tt + 4 : tt, t5 = tt + 5 < SC_CH ? tt + 5 : tt + 1; \
                SC_LOAD(wC, kC, bC, pC, rC, vC, tt + 2); SC_STEPF(wA, kA, bA, pA, rA, vA, tt); SC_LOAD(wD, kD, bD, pD, rD, vD, tt + 3); SC_STEPF(wB, kB, bB, pB, rB, vB, tt + 1); \
                SC_LOAD(wA, kA, bA, pA, rA, vA, t4); SC_STEPF(wC, kC, bC, pC, rC, vC, tt + 2); SC_LOAD(wB, kB, bB, pB, rB, vB, t5); SC_STEPF(wD, kD, bD, pD, rD, vD, tt + 3); } \
            WG_BAR(); } } while (0)
        if (scanner) {
            WG_BAR();
            if (pr == 2) {
#define USEV false
                SC_SCAN_LOOP();
#undef USEV
            } else {
#define USEV true
                SC_SCAN_LOOP();
#undef USEV
            }
        } else {
            f32x4 ld_dec[2][4]; u32x4 ld_b[2][8]; u32x4 ld_v[2];
            SC_ISSUE(0, 0); VM_WAIT(); SC_COMMIT(0, 0); SC_ISSUE(1, 1); SC_ISSUE(0, 2);
            WG_BAR();
#pragma unroll 1
            for (int c = 0; c < NC; c += 2) {
                if (c > 0) yflush(c - 1);
                SC_COMMIT(1, 1);
                if (c + 3 < NC) SC_ISSUE(1, c + 3);
                WG_BAR();
                yflush(c);
                if (c + 2 < NC) SC_COMMIT(0, 0);
                if (c + 4 < NC) SC_ISSUE(0, c + 4);
                WG_BAR();
            }
            yflush(NC - 1);
        }
#undef SC_ISSUE
#undef SC_COMMIT
#undef SC_LOAD
#undef SC_STEPF
#undef SC_SCAN_LOOP
        if (pr == 0) *(f32x4*)(SINIT + ((size_t)hc + r0 + row) * RN + 4 * j) = (f32x4){S0, S1, S2, S3};
        WG_BAR();
    }
}

__device__ __forceinline__ void ph5_ycorr(ArgsP A, Frame& F) {
    unsigned char* ws = A->ws; float* Y = (float*)(ws + WS_Y); const bf16_t* Z = (const bf16_t*)(ws + WS_Z); const float* SINIT = (const float*)(ws + WS_SINIT);
    const int r = F.lane & 31, hh = F.lane >> 5;
    for (int tg = F.vcu; tg < T / 32; tg += F.G) { if (tg * 32 < SEG) continue;
        for (int h = F.wave; h < RH; h += NWAVES) {
            bf16x8 zf[4];
#pragma unroll
            for (int ks = 0; ks < 4; ++ks) zf[ks] = *(const bf16x8*)(Z + (size_t)(tg * 32 - SEG + r) * RW + h * RN + 16 * ks + 8 * hh);
#pragma unroll
            for (int rb = 0; rb < 2; ++rb) { f32x16 acc;
#pragma unroll
                for (int e = 0; e < 16; ++e) acc[e] = 0.f;
#pragma unroll
                for (int ks = 0; ks < 4; ++ks) { const float* sp = SINIT + ((size_t)h * RN + 32 * rb + r) * RN + 16 * ks + 8 * hh; const f32x4 s0 = *(const f32x4*)sp, s1 = *(const f32x4*)(sp + 4);
                    const bf16x8 sf = __builtin_bit_cast(bf16x8, pg8::pack8(s0, s1)); acc = __builtin_amdgcn_mfma_f32_32x32x16_bf16(zf[ks], sf, acc, 0, 0, 0); }
#pragma unroll
                for (int e = 0; e < 16; ++e) { const int tk = (e & 3) + 8 * (e >> 2) + 4 * hh; float* yp = Y + (size_t)(tg * 32 + tk) * RW + h * RN + 32 * rb + r; *yp += acc[e]; } }
        }
    }
    VM_WAIT(); __builtin_amdgcn_fence(__ATOMIC_RELEASE, "workgroup"); __syncthreads();
    __builtin_amdgcn_fence(__ATOMIC_ACQUIRE, "agent"); VM_WAIT(); __syncthreads();
}

__device__ __forceinline__ void ph5_ypost(ArgsP A, Frame& F) {
    unsigned char* ws = A->ws; const float* Y = (const float*)(ws + WS_Y); const bf16_t* ZR = (const bf16_t*)(ws + WS_ZR); const bf16_t* KP = (const bf16_t*)(ws + WS_KP); const bf16_t* ZV = (const bf16_t*)(ws + WS_ZV);
    const bf16_t* G = (const bf16_t*)(ws + WS_G); bf16_t* YA = (bf16_t*)(ws + WS_YA);
    const int gw = F.vcu * NWAVES + F.wave, NGW = F.G * NWAVES;
    for (int tg = F.vcu; tg < T / 32; tg += F.G) for (int it = F.wave; it < 256; it += NWAVES) { const int t = tg * 32 + (it >> 3), c = (it & 7) * 256 + 4 * F.lane; const size_t o = (size_t)t * RW + c;
        const f32x4 y = *(const f32x4*)(Y + o); const float mean = sum16((y[0] + y[1]) + (y[2] + y[3])) * (1.0f / 64.0f); const f32x4 d = y - mean;
        const float var = sum16((d[0] * d[0] + d[1] * d[1]) + (d[2] * d[2] + d[3] * d[3])) * (1.0f / 64.0f); const float rs = 1.0f / sqrtf(var + LNX_EPS);
        const f32x4 r = ld4bf(ZR + o), k = ld4bf(KP + o), v = ld4bf(ZV + o), g = ld4bf(G + o), rk = *(const f32x4*)(A->r_k + c), lg = *(const f32x4*)(A->lnx_g + c), lb = *(const f32x4*)(A->lnx_b + c);
        const f32x4 rkk = r * k * rk; const float bonus = sum16((rkk[0] + rkk[1]) + (rkk[2] + rkk[3]));
        st4bf(YA + o, (d * rs * lg + lb + bonus * v) * g); }
}

constexpr int AT_KB = 64 * 256, AT_VB = 128 * 128, AT_BUF = AT_KB + AT_VB;
static_assert(3 * AT_BUF <= RING_BYTES, "attention LDS");
__device__ __forceinline__ void ph5_attn(ArgsP A, Frame& F) {
    unsigned char* ws = A->ws; const bf16_t* PROJ = (const bf16_t*)(ws + WS_PROJ); const bf16_t* VT = (const bf16_t*)(ws + WS_VT); const unsigned* MASK = (const unsigned*)(ws + WS_MASK); bf16_t* YB = (bf16_t*)(ws + WS_YB);
    LAS unsigned char* L = F.lds + RING_OFF; const int tid = F.tid, wave = F.wave, lane = F.lane, r = lane & 31, hh = lane >> 5;
    const float NEG = -__builtin_inff();
    for (int u = F.vcu; u < 256; u += F.G) { const int h = u >> 4, pr = u & 15;
      for (int half = 0; half < 2; ++half) { const int ib = half == 0 ? (31 - pr) : pr;
        const int q0 = ib * MBLK + wave * 32;
        bf16x8 qf[8];
#pragma unroll
        for (int ks = 0; ks < 8; ++ks) qf[ks] = *(const bf16x8*)(PROJ + (size_t)(q0 + r) * PLD + PC_MQ + h * MD + 16 * ks + 8 * hh);
        const unsigned msk = MASK[(q0 + r) * MH + h];
        f32x16 o[4];
#pragma unroll
        for (int db = 0; db < 4; ++db)
#pragma unroll
            for (int e = 0; e < 16; ++e) o[db][e] = 0.f;
        float mrun = NEG, lrun = 0.f;
        const int ntile = 4 + 4 * ib;
        auto tile_tok = [&](int n) { return n < 4 ? ib * MBLK + n * 64 : ((n - 4) >> 2) * MBLK + ((n - 4) & 3) * 64; };
        const int krow_ = lane >> 4, kslot = lane & 15, vrow_ = lane >> 3, vslot = lane & 7;
        auto dma_tile = [&](int n, int b3) { const int tb = tile_tok(n); LAS unsigned char* B = L + b3 * AT_BUF;
#pragma unroll
            for (int i = 0; i < 2; ++i) { const int p = wave * 2 + i, row = 4 * p + krow_, c = kslot ^ (row & 15);
                __builtin_amdgcn_global_load_lds((const unsigned*)(PROJ + (size_t)(tb + row) * PLD + PC_MK + h * MD + 8 * c), (LAS unsigned*)(B + p * 1024), 16, 0, 0); }
#pragma unroll
            for (int i = 0; i < 2; ++i) { const int p = wave * 2 + i, row = 8 * p + vrow_, c = vslot ^ (row & 7);
                __builtin_amdgcn_global_load_lds((const unsigned*)(VT + (size_t)(h * MD + row) * T + tb + 8 * c), (LAS unsigned*)(B + AT_KB + p * 1024), 16, 0, 0); } };
        dma_tile(0, 0); dma_tile(1, 1);
        asm volatile("s_waitcnt vmcnt(4)" ::: "memory"); WG_BAR();
        int b3 = 0;
        for (int n = 0; n < ntile; ++n) {
            { const int bn = b3 >= 1 ? b3 - 1 : 2; if (n + 2 < ntile) dma_tile(n + 2, bn); }
            bool need; int jblk = -1, tt = 0;
            if (n < 4) { tt = n; need = tt <= (wave >> 1); } else { jblk = (n - 4) >> 2; need = __ballot((msk >> jblk) & 1u) != 0ull; }
            if (need) {
                const LAS unsigned char* KB = L + b3 * AT_BUF; const LAS unsigned char* VB = KB + AT_KB;
                f32x16 s[2];
#pragma unroll
                for (int kb = 0; kb < 2; ++kb) {
#pragma unroll
                    for (int e = 0; e < 16; ++e) s[kb][e] = 0.f;
#pragma unroll
                    for (int ks = 0; ks < 8; ++ks) { const bf16x8 a = *(const LAS bf16x8*)(KB + (32 * kb + r) * 256 + (((2 * ks + hh) ^ (r & 15)) << 4)); s[kb] = __builtin_amdgcn_mfma_f32_32x32x16_bf16(a, qf[ks], s[kb], 0, 0, 0); } }
                if (n < 4) { if (64 * tt + 63 > wave * 32) { const int qrel = wave * 32 + r;
#pragma unroll
                    for (int kb = 0; kb < 2; ++kb)
#pragma unroll
                        for (int e = 0; e < 16; ++e) { const int krel = 64 * tt + 32 * kb + (e & 3) + 8 * (e >> 2) + 4 * hh; if (krel > qrel) s[kb][e] = NEG; } } }
                else if (!((msk >> jblk) & 1u)) {
#pragma unroll
                    for (int kb = 0; kb < 2; ++kb)
#pragma unroll
                        for (int e = 0; e < 16; ++e) s[kb][e] = NEG; }
                float mx = s[0][0];
#pragma unroll
                for (int kb = 0; kb < 2; ++kb)
#pragma unroll
                    for (int e = 0; e < 16; ++e) mx = fmaxf(mx, s[kb][e]);
                mx = fmaxf(mx, __shfl_xor(mx, 32));
                const float mnew = fmaxf(mrun, mx); const float alpha = __builtin_amdgcn_exp2f(mrun - mnew); mrun = mnew;
                float ps = 0.f;
#pragma unroll
                for (int kb = 0; kb < 2; ++kb)
#pragma unroll
                    for (int e = 0; e < 16; ++e) { const float p = __builtin_amdgcn_exp2f(s[kb][e] - mnew); s[kb][e] = p; ps += p; }
                lrun = lrun * alpha + ps;
                if (__ballot(alpha != 1.0f) != 0ull) {
#pragma unroll
                    for (int db = 0; db < 4; ++db)
#pragma unroll
                        for (int e = 0; e < 16; ++e) o[db][e] *= alpha; }
#pragma unroll
                for (int kb = 0; kb < 2; ++kb)
#pragma unroll
                    for (int st = 0; st < 2; ++st) { u32x4 pw; pw.x = pk2(s[kb][8 * st + 0], s[kb][8 * st + 1]); pw.y = pk2(s[kb][8 * st + 2], s[kb][8 * st + 3]); pw.z = pk2(s[kb][8 * st + 4], s[kb][8 * st + 5]); pw.w = pk2(s[kb][8 * st + 6], s[kb][8 * st + 7]);
                        const bf16x8 pf = __builtin_bit_cast(bf16x8, pw); const int kbase = 32 * kb + 16 * st + 4 * hh;
#pragma unroll
                        for (int db = 0; db < 4; ++db) { const LAS unsigned char* vrow = VB + (32 * db + r) * 128 + 8 * hh; const int c0 = 4 * kb + 2 * st; const u32x2 lo = *(const LAS u32x2*)(vrow + ((c0 ^ (r & 7)) << 4)), hi = *(const LAS u32x2*)(vrow + (((c0 + 1) ^ (r & 7)) << 4));
                            const bf16x8 vf = __builtin_bit_cast(bf16x8, (u32x4){lo.x, lo.y, hi.x, hi.y}); o[db] = __builtin_amdgcn_mfma_f32_32x32x16_bf16(vf, pf, o[db], 0, 0, 0); } }
            }
            if (n + 2 < ntile) asm volatile("s_waitcnt vmcnt(4)" ::: "memory"); else asm volatile("s_waitcnt vmcnt(0)" ::: "memory");
            b3 = b3 == 2 ? 0 : b3 + 1;
            WG_BAR();
        }
        const float ltot = lrun + __shfl_xor(lrun, 32); const float inv = 1.0f / ltot;
        bf16_t* op = YB + (size_t)(q0 + r) * RW + h * MD;
#pragma unroll
        for (int db = 0; db < 4; ++db)
#pragma unroll
            for (int g = 0; g < 4; ++g) { u32x2 w; w.x = pk2(o[db][4 * g] * inv, o[db][4 * g + 1] * inv); w.y = pk2(o[db][4 * g + 2] * inv, o[db][4 * g + 3] * inv); *(u32x2*)(op + 32 * db + 8 * g + 4 * hh) = w; }
      }
    }
}

__device__ __forceinline__ void ins16(float (&top)[16], float x) {
#pragma unroll
    for (int k = 15; k >= 1; --k) top[k] = __builtin_amdgcn_fmed3f(top[k - 1], top[k], x);
    top[0] = fmaxf(top[0], x);
}
__device__ __forceinline__ void ph10_select(ArgsP A, Frame& F) {
    unsigned char* ws = A->ws; const bf16_t* PQ = (const bf16_t*)(ws + WS_PQ); const bf16_t* SK = (const bf16_t*)(ws + WS_SUBK); int* IDX = (int*)(ws + WS_IDX); float* GW = (float*)(ws + WS_GW);
    const int gw = F.vcu * NWAVES + F.wave, NGW = F.G * NWAVES; const int r = F.lane & 31, hh = F.lane >> 5; const float NEG = -__builtin_inff();
    for (int it = gw; it < (T / 32) * PH_; it += NGW) { const int tg = it >> 3, h = it & 7, t = tg * 32 + r;
        float TA[16], TB[16];
        auto topk = [&](int p, float (&dst)[16]) {
            bf16x8 qf[8];
#pragma unroll
            for (int ks = 0; ks < 8; ++ks) qf[ks] = *(const bf16x8*)(PQ + (size_t)t * 2048 + (h * 2 + p) * PHALF + 16 * ks + 8 * hh);
            float top[16];
#pragma unroll
            for (int k = 0; k < 16; ++k) top[k] = NEG;
#pragma unroll 1
            for (int nb = 0; nb < 4; ++nb) { f32x16 acc;
#pragma unroll
                for (int e = 0; e < 16; ++e) acc[e] = 0.f;
#pragma unroll
                for (int ks = 0; ks < 8; ++ks) { const bf16x8 a = *(const bf16x8*)(SK + ((size_t)(h * 2 + p) * PNK + 32 * nb + r) * PHALF + 16 * ks + 8 * hh); acc = __builtin_amdgcn_mfma_f32_32x32x16_bf16(a, qf[ks], acc, 0, 0, 0); }
#pragma unroll
                for (int e = 0; e < 16; ++e) { const unsigned key = 32 * nb + (e & 3) + 8 * (e >> 2) + 4 * hh; float ae = acc[e]; asm volatile("" : "+v"(ae));
                    const float x = __builtin_bit_cast(float, (__builtin_bit_cast(unsigned, ae) & ~0x7Fu) | key); ins16(top, x); } }
            float oth[16];
#pragma unroll
            for (int k = 0; k < 16; ++k) oth[k] = __shfl_xor(top[k], 32);
#pragma unroll
            for (int k = 0; k < 16; ++k) ins16(top, oth[k]);
#pragma unroll
            for (int k = 0; k < 16; ++k) dst[k] = top[k];
        };
        topk(0, TA); asm volatile("" ::: "memory"); __builtin_amdgcn_sched_barrier(0); topk(1, TB); asm volatile("" ::: "memory"); __builtin_amdgcn_sched_barrier(0);
        float fin[16];
#pragma unroll
        for (int k = 0; k < 16; ++k) fin[k] = NEG;
#pragma unroll
        for (int i = 0; i < 16; ++i)
#pragma unroll
            for (int j = 0; j < 16; ++j) if ((i + 1) * (j + 1) <= 16) { const float sm = TA[i] + TB[j]; ins16(fin, __builtin_bit_cast(float, (__builtin_bit_cast(unsigned, sm) & ~0xFFu) | (unsigned)(i * 16 + j))); }
        float e[16], den = 0.f;
#pragma unroll
        for (int k = 0; k < 16; ++k) { e[k] = __expf(fin[k] - fin[0]); den += e[k]; }
        const float rden = 1.0f / den;
        int oi[8]; float og[8];
#pragma unroll
        for (int kk = 0; kk < 8; ++kk) { const float fv = hh ? fin[8 + kk] : fin[kk]; og[kk] = (hh ? e[8 + kk] : e[kk]) * rden; const unsigned id = __builtin_bit_cast(unsigned, fv) & 0xFFu; const unsigned ci = id >> 4, cj = id & 15u;
            unsigned ia = 0u, ib = 0u;
#pragma unroll
            for (int q = 0; q < 16; ++q) { ia = (ci == (unsigned)q) ? (__builtin_bit_cast(unsigned, TA[q]) & 0x7Fu) : ia; ib = (cj == (unsigned)q) ? (__builtin_bit_cast(unsigned, TB[q]) & 0x7Fu) : ib; }
            oi[kk] = (int)(ia * PNK + ib); }
        int* ip = IDX + (size_t)t * 128 + h * 16 + 8 * hh; float* gp = GW + (size_t)t * 128 + h * 16 + 8 * hh;
        *(u32x4*)ip = (u32x4){(unsigned)oi[0], (unsigned)oi[1], (unsigned)oi[2], (unsigned)oi[3]}; *(u32x4*)(ip + 4) = (u32x4){(unsigned)oi[4], (unsigned)oi[5], (unsigned)oi[6], (unsigned)oi[7]};
        *(f32x4*)gp = (f32x4){og[0], og[1], og[2], og[3]}; *(f32x4*)(gp + 4) = (f32x4){og[4], og[5], og[6], og[7]};
    }
}


__device__ __forceinline__ float ub0(unsigned w) { return (float)(w & 0xffu); }
__device__ __forceinline__ float ub1(unsigned w) { return (float)((w >> 8) & 0xffu); }
__device__ __forceinline__ float ub2(unsigned w) { return (float)((w >> 16) & 0xffu); }
__device__ __forceinline__ float ub3(unsigned w) { return (float)(w >> 24); }
__device__ __forceinline__ float dot16q(u32x4 q, const float (&h)[16]) {
    return ((ub0(q.x) * h[0] + ub1(q.x) * h[1]) + (ub2(q.x) * h[2] + ub3(q.x) * h[3])) + ((ub0(q.y) * h[4] + ub1(q.y) * h[5]) + (ub2(q.y) * h[6] + ub3(q.y) * h[7]))
         + ((ub0(q.z) * h[8] + ub1(q.z) * h[9]) + (ub2(q.z) * h[10] + ub3(q.z) * h[11])) + ((ub0(q.w) * h[12] + ub1(q.w) * h[13]) + (ub2(q.w) * h[14] + ub3(q.w) * h[15]));
}
__device__ __forceinline__ void ph11_gather(ArgsP A, Frame& F) {
    unsigned char* ws = A->ws; const bf16_t* H2 = (const bf16_t*)(ws + WS_H2); const unsigned char* PU = (const unsigned char*)(ws + WS_PU); const unsigned char* PV = (const unsigned char*)(ws + WS_PV);
    const float* PSU = (const float*)(ws + WS_PSU); const float* PSV = (const float*)(ws + WS_PSV);
    const int* IDX = (const int*)(ws + WS_IDX); const float* GW = (const float*)(ws + WS_GW); const float* X1 = (const float*)(ws + WS_X1);
    LAS float* coef = (LAS float*)(F.lds + RING_OFF); LAS int* eidx = (LAS int*)(F.lds + RING_OFF + 1024); LAS float* red = (LAS float*)(F.lds + RING_OFF + 2048);
    const int tid = F.tid, wave = F.wave, lane = F.lane; int par = 0;
    for (int t = F.vcu; t < T; t += F.G, par ^= 1) {
        float hv[4][16]; float hs = 0.f;
#pragma unroll
        for (int i = 0; i < 4; ++i) { const bf16_t* hp = H2 + (size_t)t * D + i * 1024 + lane * 16; f32x4 a, b, c, d; pg8::unpack8(*(const u32x4*)hp, a, b); pg8::unpack8(*(const u32x4*)(hp + 8), c, d);
#pragma unroll
            for (int e = 0; e < 4; ++e) { hv[i][e] = a[e]; hv[i][4 + e] = b[e]; hv[i][8 + e] = c[e]; hv[i][12 + e] = d[e]; }
            hs += ((a[0] + a[1]) + (a[2] + a[3])) + ((b[0] + b[1]) + (b[2] + b[3])) + ((c[0] + c[1]) + (c[2] + c[3])) + ((d[0] + d[1]) + (d[2] + d[3])); }
        hs = wave_sum(hs);
        const int myidx = (lane < 16) ? IDX[(size_t)t * 128 + wave * 16 + lane] : 0; const float myg = (lane < 16) ? GW[(size_t)t * 128 + wave * 16 + lane] : 0.f;
        float dots = 0.f;
#pragma unroll 1
        for (int k = 0; k < 16; k += 4) {
            u32x4 q[4][4];
#pragma unroll
            for (int x = 0; x < 4; ++x) { const int e = __builtin_amdgcn_readlane(myidx, k + x); const unsigned char* up = PU + (size_t)e * D + lane * 16;
#pragma unroll
                for (int i = 0; i < 4; ++i) q[x][i] = *(const u32x4*)(up + i * 1024); }
#pragma unroll
            for (int x = 0; x < 4; ++x) { float d = 0.f;
#pragma unroll
                for (int i = 0; i < 4; ++i) d += dot16q(q[x][i], hv[i]);
                d = wave_sum(d); if (lane == k + x) dots = d; }
        }
        if (lane < 16) { const float s = PSU[myidx] * (dots - 128.0f * hs); const float act = 0.5f * s * (1.0f + erff(s * 0.70710678118654752f));
            coef[par * 128 + wave * 16 + lane] = myg * act * PSV[myidx]; eidx[par * 128 + wave * 16 + lane] = myidx; }
        WG_BAR();
        float acc[8]; float csum = 0.f;
#pragma unroll
        for (int i = 0; i < 8; ++i) acc[i] = 0.f;
#pragma unroll 1
        for (int e = 0; e < 128; e += 8) { u32x2 v[8]; float c[8];
#pragma unroll
            for (int q = 0; q < 8; ++q) { const int ei = __builtin_amdgcn_readfirstlane(eidx[par * 128 + e + q]); c[q] = coef[par * 128 + e + q]; v[q] = *(const u32x2*)(PV + (size_t)ei * D + tid * 8); }
#pragma unroll
            for (int q = 0; q < 8; ++q) { csum += c[q]; acc[0] += c[q] * ub0(v[q].x); acc[1] += c[q] * ub1(v[q].x); acc[2] += c[q] * ub2(v[q].x); acc[3] += c[q] * ub3(v[q].x); acc[4] += c[q] * ub0(v[q].y); acc[5] += c[q] * ub1(v[q].y); acc[6] += c[q] * ub2(v[q].y); acc[7] += c[q] * ub3(v[q].y); } }
        const float corr = -128.0f * csum;
        const f32x4 x0 = *(const f32x4*)(X1 + (size_t)t * D + tid * 8), x1 = *(const f32x4*)(X1 + (size_t)t * D + tid * 8 + 4);
        f32x4 y0 = x0 + ((f32x4){acc[0], acc[1], acc[2], acc[3]} + corr), y1 = x1 + ((f32x4){acc[4], acc[5], acc[6], acc[7]} + corr);
        float ss = (y0[0] * y0[0] + y0[1] * y0[1]) + (y0[2] * y0[2] + y0[3] * y0[3]) + (y1[0] * y1[0] + y1[1] * y1[1]) + (y1[2] * y1[2] + y1[3] * y1[3]);
        ss = wave_sum(ss); if (lane == 0) red[par * 8 + wave] = ss;
        WG_BAR();
        float tot = 0.f;
#pragma unroll
        for (int w = 0; w < 8; ++w) tot += red[par * 8 + w];
        const float rs = 1.0f / sqrtf(tot * (1.0f / D) + NORM_EPS);
        const f32x4 g0 = *(const f32x4*)(A->final_g + tid * 8), g1 = *(const f32x4*)(A->final_g + tid * 8 + 4);
        *(f32x4*)(A->out + (size_t)t * D + tid * 8) = y0 * rs * g0; *(f32x4*)(A->out + (size_t)t * D + tid * 8 + 4) = y1 * rs * g1;
    }
}

constexpr int NPH = 12;
__device__ __forceinline__ Frame make_frame(unsigned char* lds) {
    Frame F; int t = threadIdx.x; asm volatile("" : "+v"(t));
    F.lds = (LAS unsigned char*)lds; F.tid = t; F.lane = t & 63; F.wave = __builtin_amdgcn_readfirstlane(t >> 6);
    F.G = gridDim.x; { const int bx = blockIdx.x; F.vcu = (F.G % 8 == 0) ? (bx % 8) * (F.G / 8) + bx / 8 : bx; }
    return F;
}
__global__ void __launch_bounds__(NTHR, 2) mk_fwd(Args args_by_value) {
    extern __shared__ __attribute__((aligned(16))) unsigned char lds[];
    ArgsP args = get_args();
    gu32* ctl = (gu32*)(args->ws + WS_CTL);
    for (int u = threadIdx.x; u < (LDS_BYTES - LDSCTL_OFF) / 4; u += NTHR) ((LAS unsigned*)((LAS unsigned char*)lds + LDSCTL_OFF))[u] = 0u;
    __syncthreads();
    const int lo = args->ph_lo, hi = args->ph_hi;
    volatile LAS unsigned* MISC = (volatile LAS unsigned*)((LAS unsigned char*)lds + MISC_OFF);
    XcdBarrier bar; bar.bar = (unsigned*)(ctl + CW_BAR) + args->li * XCD_BAR_WORDS; bar.x = 0; bar.st = nullptr;
    if (hi - lo > 1) bar = xcd_barrier_post((unsigned*)(ctl + CW_BAR) + args->li * XCD_BAR_WORDS, MISC + 8);
#define IN(k) (lo <= (k) && (k) < hi)
#define SEAM(k) do { if (IN(k) && IN((k) + 1)) xcd_barrier(bar); } while (0)
    const int bid = (int)blockIdx.x;

    if (IN(0)) { Frame F = make_frame(lds); ph0_prologue(get_args(), F); SEAM(0); }
    if (IN(1)) { Frame F = make_frame(lds); LAS unsigned char* ring = F.lds + RING_OFF; ArgsP a_ = get_args(); unsigned char* ws = a_->ws;
        { pg8::Gemm g{(const bf16_t*)(ws + WS_XN), (const bf16_t*)(ws + WS_WIN), T, PLD, D}; pg8::StaticOrder S; S.init(T, PLD, F.G, bid);
          pg8::EpiProj E{(bf16_t*)(ws + WS_PROJ), (const float*)(ws + WS_ROPE)}; pg8::gemm_phase<pg8::EpiProj, pg8::StaticOrder, true, true>(ring, g, S, E); }
        { pg8::Gemm g{(const bf16_t*)(ws + WS_XN), (const bf16_t*)(ws + WS_WIN) + (size_t)PC_MV * D, T, 2048, D}; pg8::StaticOrder S; S.init(T, 2048, F.G, bid);
          pg8::EpiVT E{(bf16_t*)(ws + WS_VT)}; pg8::gemm_phase<pg8::EpiVT, pg8::StaticOrder, true, true>(ring, g, S, E); }
        SEAM(1); }
    if (IN(2)) { Frame F = make_frame(lds); ph2_prep(get_args(), F); SEAM(2); }
    if (IN(3)) { Frame F = make_frame(lds); LAS unsigned char* ring = F.lds + RING_OFF; ArgsP a_ = get_args(); unsigned char* ws = a_->ws;
        { pg8::Gemm g{(const bf16_t*)(ws + WS_AW), (const bf16_t*)(ws + WS_WUP), T, RW, LW}; pg8::StaticOrder S; S.init(T, RW, F.G, bid);
          pg8::EpiDec E{(float*)(ws + WS_DEC), a_->w0}; pg8::gemm_phase<pg8::EpiDec, pg8::StaticOrder, true, true>(ring, g, S, E); }
        asm volatile("" ::: "memory"); __builtin_amdgcn_sched_barrier(0);
        { pg8::Gemm g{(const bf16_t*)(ws + WS_AA), (const bf16_t*)(ws + WS_AUP), T, RW, LA}; pg8::StaticOrder S; S.init(T, RW, F.G, bid);
          pg8::EpiA E{(bf16_t*)(ws + WS_KP), (bf16_t*)(ws + WS_BB), (const bf16_t*)(ws + WS_KKN), a_->a0, a_->k_a}; pg8::gemm_phase<pg8::EpiA, pg8::StaticOrder, true, true>(ring, g, S, E); }
        asm volatile("" ::: "memory"); __builtin_amdgcn_sched_barrier(0);
        { pg8::Gemm g{(const bf16_t*)(ws + WS_AG), (const bf16_t*)(ws + WS_GUP), T, RW, LGP}; pg8::StaticOrder S; S.init(T, RW, F.G, bid);
          pg8::EpiBf16 E{(bf16_t*)(ws + WS_G), RW}; pg8::gemm_phase<pg8::EpiBf16, pg8::StaticOrder, true, true>(ring, g, S, E); }
        { Frame F2 = make_frame(lds); ph3_gate(get_args(), F2); }
        SEAM(3); }
    if (IN(4)) { Frame F = make_frame(lds); ph4_scan(get_args(), F); SEAM(4); }
    if (IN(5)) { { Frame F = make_frame(lds); ph5_ycorr(get_args(), F); } { Frame F = make_frame(lds); ph5_ypost(get_args(), F); } { Frame F = make_frame(lds); ph5_attn(get_args(), F); } SEAM(5); }
    if (IN(6)) { Frame F = make_frame(lds); LAS unsigned char* ring = F.lds + RING_OFF; ArgsP a_ = get_args(); unsigned char* ws = a_->ws;
        { pg8::Gemm g{(const bf16_t*)(ws + WS_YA), (const bf16_t*)(ws + WS_WA), T, D, RW}; pg8::StaticOrder S; S.init(T, D, F.G, bid);
          pg8::EpiMix<false> E{(bf16_t*)(ws + WS_MIXED), (const bf16_t*)(ws + WS_PROJ), PC_GA}; pg8::gemm_phase<pg8::EpiMix<false>, pg8::StaticOrder, true, true>(ring, g, S, E); }
        { pg8::Gemm g{(const bf16_t*)(ws + WS_YB), (const bf16_t*)(ws + WS_WB), T, D, RW}; pg8::StaticOrder S; S.init(T, D, F.G, bid);
          pg8::EpiMix<true> E{(bf16_t*)(ws + WS_MIXED), (const bf16_t*)(ws + WS_PROJ), PC_GB}; pg8::gemm_phase<pg8::EpiMix<true>, pg8::StaticOrder, true, true>(ring, g, S, E); }
        SEAM(6); }
    if (IN(7)) { Frame F = make_frame(lds); LAS unsigned char* ring = F.lds + RING_OFF; ArgsP a_ = get_args(); unsigned char* ws = a_->ws;
        pg8::Gemm g{(const bf16_t*)(ws + WS_MIXED), (const bf16_t*)(ws + WS_WOUT), T, D, D}; pg8::StaticOrder S; S.init(T, D, F.G, bid);
        pg8::EpiRes E{(float*)(ws + WS_X1), a_->x}; pg8::gemm_phase<pg8::EpiRes, pg8::StaticOrder, true, true>(ring, g, S, E);
        SEAM(7); }
    if (IN(8)) { Frame F = make_frame(lds); ArgsP a_ = get_args(); unsigned char* ws = a_->ws; const int gw = F.vcu * NWAVES + F.wave, NGW = F.G * NWAVES;
        for (int m = gw; m < T; m += NGW) rms_row_to_bf16((const float*)(ws + WS_X1) + (size_t)m * D, a_->norm2_g, (bf16_t*)(ws + WS_H2) + (size_t)m * D, F.lane);
        SEAM(8); }
    if (IN(9)) { Frame F = make_frame(lds); LAS unsigned char* ring = F.lds + RING_OFF; ArgsP a_ = get_args(); unsigned char* ws = a_->ws;
        pg8::Gemm g{(const bf16_t*)(ws + WS_H2), (const bf16_t*)(ws + WS_WQ), T, 2048, D}; pg8::StaticOrder S; S.init(T, 2048, F.G, bid);
        pg8::EpiBf16 E{(bf16_t*)(ws + WS_PQ), 2048}; pg8::gemm_phase<pg8::EpiBf16, pg8::StaticOrder, true, true>(ring, g, S, E);
        SEAM(9); }
    if (IN(10)) { Frame F = make_frame(lds); ph10_select(get_args(), F); SEAM(10); }
    if (IN(11)) { Frame F = make_frame(lds); ph11_gather(get_args(), F); }
#undef IN
#undef SEAM
}

extern "C" void kernel_launch(void* const* d_in, const int* in_sizes, int n_in, void* d_out, int out_size, void* d_ws, size_t ws_size, hipStream_t stream) {
    static int grid = 0;
    if (grid == 0) {
        if (n_in != 23 || out_size != T * D || ws_size < WS_END) { fprintf(stderr, "kernel_launch: unexpected shapes (n_in %d out %d ws %zu); nothing launched\n", n_in, out_size, ws_size); grid = -1; return; }
        int dev = 0, cus = 0, per_cu = 0;
        if (hipGetDevice(&dev) != hipSuccess || hipDeviceGetAttribute(&cus, hipDeviceAttributeMultiprocessorCount, dev) != hipSuccess) { grid = -1; return; }
        if (hipFuncSetAttribute((const void*)mk_fwd, hipFuncAttributeMaxDynamicSharedMemorySize, LDS_BYTES) != hipSuccess) { grid = -1; return; }
        if (hipOccupancyMaxActiveBlocksPerMultiprocessor(&per_cu, (const void*)mk_fwd, NTHR, LDS_BYTES) != hipSuccess || per_cu < 1) fprintf(stderr, "kernel_launch: occupancy query reports %d\n", per_cu);
        (void)hipGetLastError();
        grid = cus;
    }
    if (grid < 0) return;
    (void)hipMemsetAsync((char*)d_ws + WS_CTL, 0, CTL_ZERO_BYTES, stream);
    Args a{};
    const float** ap = (const float**)&a;
    for (int i = 0; i < 23; ++i) ap[i] = (const float*)d_in[i];
    a.out = (float*)d_out; a.ws = (unsigned char*)d_ws; a.pad = 0;
    constexpr int NL = MK_N_LAUNCHES;
    for (int li = 0; li < NL; ++li) {
        a.ph_lo = (NL == 1) ? 0 : li; a.ph_hi = (NL == 1) ? NPH : li + 1; a.li = (NL == 1) ? 0 : 0;
        hipLaunchKernelGGL(mk_fwd, dim3(grid), dim3(NTHR), LDS_BYTES, stream, a);
#ifdef DUP_HI
        if (NL > 1 && li == DUP_HI) for (int l2 = DUP_LO; l2 <= DUP_HI; ++l2) { a.ph_lo = l2; a.ph_hi = l2 + 1; hipLaunchKernelGGL(mk_fwd, dim3(grid), dim3(NTHR), LDS_BYTES, stream, a); }
#endif
    }
}
```

```cpp
#include <hip/hip_runtime.h>
#include <cstdio>
#include <cstdint>

#ifndef MK_N_LAUNCHES
#define MK_N_LAUNCHES 1
#endif

#define GAS __attribute__((address_space(1)))
#define LAS __attribute__((address_space(3)))
typedef unsigned short bf16_t;
typedef __bf16 bf16x8 __attribute__((ext_vector_type(8)));
typedef float f32x2 __attribute__((ext_vector_type(2)));
typedef float f32x4 __attribute__((ext_vector_type(4)));
typedef float f32x16 __attribute__((ext_vector_type(16)));
typedef unsigned u32x2 __attribute__((ext_vector_type(2)));
typedef unsigned u32x4 __attribute__((ext_vector_type(4)));
typedef GAS unsigned gu32;

constexpr int T = 8192, D = 4096;
constexpr int RW = 2048, RH = 32, RN = 64;
constexpr int LW = 128, LA = 128, LG = 480, LGP = 512;
constexpr int SHIFTW = 6880;
constexpr int MH = 16, MD = 128, MBLK = 256, NBLK = 32;
constexpr int INW = 21216;
constexpr int PLD = 19200;
constexpr int PC_R = 0, PC_K = 2048, PC_V = 4096, PC_WL = 6144, PC_AL = 6272, PC_GL = 6400, PC_MQ = 6912, PC_MK = 8960, PC_GA = 11008, PC_GB = 15104, PC_MV = 19200;
constexpr int WIN_ROWS = 21248;
constexpr int PH_ = 8, PNK = 128, PQD = 256, PHALF = 128, PTOPK = 16;
constexpr float NORM_EPS = 1e-6f, LNX_EPS = 64e-5f;
constexpr float QSCALE = 0.08838834764831845f * 1.4426950408889634f;

constexpr size_t MiB = 1u << 20;
constexpr size_t WS_CTL = 0, CTL_ZERO_BYTES = 1 * MiB;
constexpr size_t WS_WIN = 1 * MiB;
constexpr size_t WS_X1 = 1 * MiB, WS_PQ = 129 * MiB;
constexpr size_t WS_WA = 167 * MiB, WS_WB = 183 * MiB, WS_WOUT = 199 * MiB, WS_WQ = 231 * MiB, WS_WUP = 247 * MiB, WS_AUP = 248 * MiB, WS_GUP = 249 * MiB, WS_SUBK = 251 * MiB;
constexpr size_t WS_PU = 252 * MiB, WS_PV = 380 * MiB;
constexpr size_t WS_XN = 508 * MiB;
constexpr size_t WS_Y = 508 * MiB, WS_H2 = 508 * MiB;
constexpr size_t WS_PROJ = 572 * MiB;
constexpr size_t WS_VT = 872 * MiB;
constexpr size_t WS_ROPE = 904 * MiB, WS_KMEAN = 908 * MiB, WS_MASK = 909 * MiB, WS_AW = 910 * MiB, WS_AA = 912 * MiB, WS_AG = 914 * MiB;
constexpr size_t WS_PSU = 909 * MiB + 512 * 1024, WS_PSV = WS_PSU + 64 * 1024;
constexpr size_t WS_DEC = 922 * MiB;
constexpr size_t WS_MIXED = 922 * MiB;
constexpr size_t WS_KKN = 986 * MiB, WS_BB = 1018 * MiB, WS_KP = 1050 * MiB, WS_ZR = 1082 * MiB, WS_ZV = 1114 * MiB, WS_G = 1146 * MiB;
constexpr size_t WS_YA = 1178 * MiB, WS_YB = 1210 * MiB, WS_IDX = 1242 * MiB, WS_GW = 1246 * MiB, WS_Z = 1250 * MiB, WS_SINIT = 1266 * MiB, WS_END = 1267 * MiB;

constexpr int CW_TMO = 0, CW_CODE = 1, CW_BAR = 4096;

constexpr int RING_OFF = 0, RING_BYTES = 135168;
constexpr int LDSCTL_OFF = RING_BYTES, MISC_OFF = LDSCTL_OFF + 320;
constexpr int LDS_BYTES = 147456;
constexpr int NWAVES = 8, NTHR = 512;

__device__ __forceinline__ unsigned f2bf(float f) { unsigned u = __builtin_bit_cast(unsigned, f); return (u + 0x7fffu + ((u >> 16) & 1u)) >> 16; }
__device__ __forceinline__ unsigned pk2(float lo, float hi) { unsigned r; asm volatile("v_cvt_pk_bf16_f32 %0, %1, %2" : "=v"(r) : "v"(lo), "v"(hi)); return r; }
__device__ __forceinline__ float bflo(unsigned u) { return __builtin_bit_cast(float, u << 16); }
__device__ __forceinline__ float bfhi(unsigned u) { return __builtin_bit_cast(float, u & 0xffff0000u); }
__device__ __forceinline__ float bf1(bf16_t b) { return __builtin_bit_cast(float, (unsigned)b << 16); }
__device__ __forceinline__ float fsigmoid(float x) { return __builtin_amdgcn_rcpf(1.0f + __expf(-x)); }
__device__ __forceinline__ float wave_sum(float v) {
#pragma unroll
    for (int o = 1; o < 64; o <<= 1) v += __shfl_xor(v, o);
    return v;
}
template <int CTRL> __device__ __forceinline__ float dpp_f(float v) { return __builtin_bit_cast(float, __builtin_amdgcn_update_dpp(0, __builtin_bit_cast(int, v), CTRL, 0xF, 0xF, true)); }
__device__ __forceinline__ float sum16(float x) {
    x += dpp_f<0xB1>(x); x += dpp_f<0x4E>(x); x += dpp_f<0x141>(x); x += dpp_f<0x140>(x); return x;
}
__device__ __forceinline__ float vmul(float a, float b) { float r; asm("v_mul_f32_e32 %0, %1, %2" : "=v"(r) : "v"(a), "v"(b)); return r; }
__device__ __forceinline__ float vfma(float a, float b, float c) { float r; asm("v_fma_f32 %0, %1, %2, %3" : "=v"(r) : "v"(a), "v"(b), "v"(c)); return r; }
#define LDS_WAIT() asm volatile("s_waitcnt lgkmcnt(0)" ::: "memory")
#define VM_WAIT() asm volatile("s_waitcnt vmcnt(0)" ::: "memory")
#define WG_BAR() do { asm volatile("s_waitcnt lgkmcnt(0)" ::: "memory"); __builtin_amdgcn_s_barrier(); asm volatile("" ::: "memory"); } while (0)

namespace pg8 {
constexpr int BM = 256, BK = 64, HALF = 128, HTB = HALF * BK * 2, STAGE_BYTES = 8 * HTB, NXCD = 8, WGM = 8;
__host__ __device__ __forceinline__ int lds_byte(int r, int c) { const int st = (r >> 4) * 2 + (c >> 5), rr = r & 15, cc = c & 31, ob = rr * 64 + cc * 2; return st * 1024 + (ob ^ (((ob >> 9) & 1) << 5)); }
__host__ __device__ __forceinline__ void stage_rc(int b, int& R, int& C) { const int st = b / 1024, sb = b % 1024, swz = sb ^ (((sb >> 9) & 1) << 5); R = (st >> 1) * 16 + swz / 64; C = (st & 1) * 32 + (swz % 64) / 2; }
__host__ __device__ __forceinline__ int perm32(int rho) { const int n = rho >> 4, i = rho & 15; return 8 * (i >> 2) + 4 * n + (i & 3); }

struct Unit { int pm, pn; };
struct Gemm { const bf16_t* A; const bf16_t* Bt; int M, N, K; };

struct StaticOrder {
    int nM, nN, nwg, G, c;
    __host__ __device__ void init(int M, int N, int G_, int c_) { nM = M / BM; nN = N / BM; nwg = nM * nN; G = G_; c = c_; }
    __host__ __device__ bool next(int i, Unit& u) const {
        const long L = (long)i * G + c; if (L >= nwg) return false;
        int wgid = (int)L; { const int q = nwg / NXCD, r = nwg % NXCD, xcd = wgid % NXCD, off = wgid / NXCD; wgid = (xcd < r ? xcd * (q + 1) : r * (q + 1) + (xcd - r) * q) + off; }
        const int nig = WGM * nN, gid = wgid / nig, fm = gid * WGM, gsz = (nM - fm) < WGM ? (nM - fm) : WGM;
        u.pm = fm + ((wgid % nig) % gsz); u.pn = (wgid % nig) / gsz; return true;
    }
    __device__ __forceinline__ void a_ready(const Unit&) const {}
    __device__ __forceinline__ void done(const Unit&) const {}
};

template <class Epi, class Sched, bool ALIGN_EPI = false, bool SP2 = false>
__device__ __forceinline__ void gemm_phase(LAS unsigned char* lds, const Gemm g, const Sched& S, const Epi& E) {
    int tid_ = threadIdx.x; asm volatile("" : "+v"(tid_));
    const int tid = tid_, wid = __builtin_amdgcn_readfirstlane(tid >> 6), lane = tid & 63, wr = wid >> 2, wc = wid & 3, fr = lane & 15, fq = lane >> 4;
    int K_ = g.K; asm volatile("" : "+s"(K_));
    const int K = K_, nt = K / BK;
    unsigned voffA[2], voffB[2];
#pragma unroll
    for (int i = 0; i < 2; ++i) { int R, C; stage_rc(tid * 16 + i * 8192, R, C); const int Rb = Epi::PERM ? ((R & ~31) + perm32(R & 31)) : R;
        voffA[i] = (unsigned)(R * K + C) * 2u; voffB[i] = (unsigned)(Rb * K + C) * 2u; }
    const size_t kstep = (size_t)(BK * 2);
    const size_t hstep = (size_t)HALF * K * 2;
    const size_t tstep = 2 * hstep;
    const unsigned ldsw = (unsigned)wid * 1024u;
    const int aoff = lds_byte(wr * 64 + fr, fq * 8), boff = lds_byte(wc * 32 + fr, fq * 8);
#define PG8_SA(b, h) (((b) * 2 + (h)) * HTB)
#define PG8_SB(b, h) ((4 + (b) * 2 + (h)) * HTB)
#define PG8_STAGE(bufoff, gbase, voff) do { _Pragma("unroll") for (int _i = 0; _i < 2; ++_i) \
        __builtin_amdgcn_global_load_lds((const unsigned*)((const char*)(gbase) + (voff)[_i]), (LAS unsigned*)(lds + (bufoff) + ldsw + _i * 8192), 16, 0, 0); } while (0)
#define PG8_LDA(dst, b, h) do { _Pragma("unroll") for (int m = 0; m < 4; ++m) _Pragma("unroll") for (int k = 0; k < 2; ++k) dst[m][k] = *(const LAS bf16x8*)(lds + PG8_SA(b, h) + aoff + m * 2048 + k * 1024); } while (0)
#define PG8_LDB(dst, b, h) do { _Pragma("unroll") for (int n = 0; n < 2; ++n) _Pragma("unroll") for (int k = 0; k < 2; ++k) dst[n][k] = *(const LAS bf16x8*)(lds + PG8_SB(b, h) + boff + n * 2048 + k * 1024); } while (0)
#define PG8_MMA(ai, bj, At, Bt) do { __builtin_amdgcn_s_setprio(1); _Pragma("unroll") for (int m = 0; m < 4; ++m) _Pragma("unroll") for (int n = 0; n < 2; ++n) _Pragma("unroll") for (int k = 0; k < 2; ++k) { \
        if constexpr (Epi::SWAP) acc[ai][bj][m][n] = __builtin_amdgcn_mfma_f32_16x16x32_bf16(At[m][k], Bt[n][k], acc[ai][bj][m][n], 0, 0, 0); \
        else acc[ai][bj][m][n] = __builtin_amdgcn_mfma_f32_16x16x32_bf16(Bt[n][k], At[m][k], acc[ai][bj][m][n], 0, 0, 0); } __builtin_amdgcn_s_setprio(0); } while (0)
#define PG8_WAIT_V(n) asm volatile("s_waitcnt vmcnt(" #n ")" ::: "memory")
#define PG8_WAIT_L(n) asm volatile("s_waitcnt lgkmcnt(" #n ")" ::: "memory")
#define PG8_BAR __builtin_amdgcn_s_barrier()
#define PG8_SCHED __builtin_amdgcn_sched_barrier(0)
    Unit cur, nxt; int ui = 0;
    if (!S.next(0, cur)) return;
    f32x4 acc[2][2][4][2];
#pragma unroll
    for (int a = 0; a < 2; ++a)
#pragma unroll
        for (int b = 0; b < 2; ++b)
#pragma unroll
            for (int m = 0; m < 4; ++m)
#pragma unroll
                for (int n = 0; n < 2; ++n) acc[a][b][m][n] = (f32x4){0.f, 0.f, 0.f, 0.f};
    bf16x8 At[4][2], B0[2][2], B1[2][2];
    const char* cA = (const char*)g.A + (size_t)cur.pm * tstep; const char* cB = (const char*)g.Bt + (size_t)cur.pn * tstep;
    S.a_ready(cur);
    if constexpr (SP2) {
        PG8_STAGE(PG8_SB(0, 0), cB, voffB); PG8_STAGE(PG8_SB(0, 1), cB + hstep, voffB); PG8_STAGE(PG8_SA(0, 0), cA, voffA); PG8_STAGE(PG8_SA(0, 1), cA + hstep, voffA);
        if (wr == 1) PG8_BAR;
        PG8_WAIT_V(2); PG8_BAR;
        PG8_STAGE(PG8_SB(1, 0), cB + kstep, voffB); PG8_STAGE(PG8_SA(1, 0), cA + kstep, voffA); PG8_STAGE(PG8_SB(1, 1), cB + hstep + kstep, voffB);
        PG8_WAIT_V(6); PG8_BAR;
    } else {
        PG8_STAGE(PG8_SB(0, 0), cB, voffB); PG8_STAGE(PG8_SA(0, 0), cA, voffA); PG8_STAGE(PG8_SB(0, 1), cB + hstep, voffB); PG8_STAGE(PG8_SA(0, 1), cA + hstep, voffA);
        if (wr == 1) PG8_BAR;
        PG8_WAIT_V(4); PG8_BAR;
        PG8_STAGE(PG8_SB(1, 0), cB + kstep, voffB); PG8_STAGE(PG8_SA(1, 0), cA + kstep, voffA); PG8_STAGE(PG8_SB(1, 1), cB + hstep + kstep, voffB);
        PG8_WAIT_V(6); PG8_BAR;
    }
    for (;;) {
        const bool has_next = S.next(ui + 1, nxt);
        const char* nA = has_next ? (const char*)g.A + (size_t)nxt.pm * tstep : cA; const char* nB = has_next ? (const char*)g.Bt + (size_t)nxt.pn * tstep : cB;
        for (int t = 0; t < nt; t += 2) {
            const bool last = (t == nt - 2);
            const char* a1 = cA + (size_t)(t + 1) * kstep;
            const char* a2 = last ? nA : cA + (size_t)(t + 2) * kstep; const char* b2 = last ? nB : cB + (size_t)(t + 2) * kstep;
            const char* a3 = a2 + kstep; const char* b3 = b2 + kstep;
            if (last && has_next) S.a_ready(nxt);
            if constexpr (SP2) {
            PG8_LDB(B0, 0, 0); PG8_LDB(B1, 0, 1); PG8_SCHED; PG8_LDA(At, 0, 0); PG8_STAGE(PG8_SA(1, 1), a1 + hstep, voffA);
            PG8_WAIT_V(8); PG8_WAIT_L(0); PG8_BAR; PG8_MMA(0, 0, At, B0); PG8_MMA(0, 1, At, B1); PG8_BAR; PG8_SCHED;
            PG8_LDA(At, 0, 1); PG8_STAGE(PG8_SB(0, 0), b2, voffB); PG8_STAGE(PG8_SB(0, 1), b2 + hstep, voffB); PG8_STAGE(PG8_SA(0, 0), a2, voffA);
            PG8_WAIT_V(8); PG8_WAIT_L(0); PG8_BAR; PG8_MMA(1, 0, At, B0); PG8_MMA(1, 1, At, B1); PG8_BAR; PG8_SCHED;
            PG8_LDB(B0, 1, 0); PG8_LDB(B1, 1, 1); PG8_SCHED; PG8_LDA(At, 1, 0); PG8_STAGE(PG8_SA(0, 1), a2 + hstep, voffA);
            PG8_WAIT_V(8); PG8_WAIT_L(0); PG8_BAR; PG8_MMA(0, 0, At, B0); PG8_MMA(0, 1, At, B1); PG8_BAR; PG8_SCHED;
            PG8_LDA(At, 1, 1); PG8_STAGE(PG8_SB(1, 0), b3, voffB); PG8_STAGE(PG8_SB(1, 1), b3 + hstep, voffB); PG8_STAGE(PG8_SA(1, 0), a3, voffA);
            PG8_WAIT_V(8); PG8_WAIT_L(0); PG8_BAR; PG8_MMA(1, 0, At, B0); PG8_MMA(1, 1, At, B1); PG8_BAR; PG8_SCHED;
            } else {
            PG8_LDB(B0, 0, 0); PG8_SCHED; PG8_LDA(At, 0, 0); PG8_STAGE(PG8_SA(1, 1), a1 + hstep, voffA);
            PG8_WAIT_L(8); PG8_BAR; PG8_WAIT_L(0); PG8_MMA(0, 0, At, B0); PG8_BAR; PG8_SCHED;
            PG8_LDB(B1, 0, 1); PG8_STAGE(PG8_SB(0, 0), b2, voffB);
            PG8_BAR; PG8_WAIT_L(0); PG8_MMA(0, 1, At, B1); PG8_BAR;
            PG8_LDA(At, 0, 1); PG8_STAGE(PG8_SA(0, 0), a2, voffA);
            PG8_BAR; PG8_WAIT_L(0); PG8_MMA(1, 0, At, B0); PG8_BAR; PG8_SCHED;
            PG8_STAGE(PG8_SB(0, 1), b2 + hstep, voffB);
            PG8_WAIT_V(6); PG8_BAR; PG8_MMA(1, 1, At, B1); PG8_BAR;
            PG8_LDB(B0, 1, 0); PG8_SCHED; PG8_LDA(At, 1, 0); PG8_STAGE(PG8_SA(0, 1), a2 + hstep, voffA);
            PG8_WAIT_L(8); PG8_BAR; PG8_WAIT_L(0); PG8_MMA(0, 0, At, B0); PG8_BAR; PG8_SCHED;
            PG8_LDB(B1, 1, 1); PG8_STAGE(PG8_SB(1, 0), b3, voffB);
            PG8_BAR; PG8_WAIT_L(0); PG8_MMA(0, 1, At, B1); PG8_BAR;
            PG8_LDA(At, 1, 1); PG8_STAGE(PG8_SA(1, 0), a3, voffA);
            PG8_BAR; PG8_WAIT_L(0); PG8_MMA(1, 0, At, B0); PG8_BAR; PG8_SCHED;
            PG8_STAGE(PG8_SB(1, 1), b3 + hstep, voffB);
            PG8_WAIT_V(6); PG8_BAR; PG8_MMA(1, 1, At, B1); PG8_BAR;
            }
        }
        if constexpr (ALIGN_EPI) { if (wr == 0) PG8_BAR; }
        E(acc, cur, wr, wc, fr, fq); S.done(cur);
        if (!has_next) break;
#pragma unroll
        for (int a = 0; a < 2; ++a)
#pragma unroll
            for (int b = 0; b < 2; ++b)
#pragma unroll
                for (int m = 0; m < 4; ++m)
#pragma unroll
                    for (int n = 0; n < 2; ++n) acc[a][b][m][n] = (f32x4){0.f, 0.f, 0.f, 0.f};
        cur = nxt; cA = nA; cB = nB; ++ui;
        if constexpr (ALIGN_EPI) { if (wr == 1) PG8_BAR; }
    }
    PG8_WAIT_V(0);
    if constexpr (!ALIGN_EPI) { if (wr == 0) PG8_BAR; }
    PG8_BAR;
#undef PG8_SA
#undef PG8_SB
#undef PG8_STAGE
#undef PG8_LDA
#undef PG8_LDB
#undef PG8_MMA
#undef PG8_WAIT_V
#undef PG8_WAIT_L
#undef PG8_BAR
#undef PG8_SCHED
}

typedef const f32x4 (&AccRef)[2][2][4][2];
__device__ __forceinline__ u32x4 pack8(f32x4 v0, f32x4 v1) { u32x4 w; w.x = pk2(v0[0], v0[1]); w.y = pk2(v0[2], v0[3]); w.z = pk2(v1[0], v1[1]); w.w = pk2(v1[2], v1[3]); return w; }
__device__ __forceinline__ void unpack8(u32x4 w, f32x4& v0, f32x4& v1) { v0 = (f32x4){bflo(w.x), bfhi(w.x), bflo(w.y), bfhi(w.y)}; v1 = (f32x4){bflo(w.z), bfhi(w.z), bflo(w.w), bfhi(w.w)}; }

struct EpiBf16 {
    static constexpr bool PERM = true, SWAP = false;
    bf16_t* O; int ldc;
    __device__ __forceinline__ void operator()(AccRef acc, const Unit& u, int wr, int wc, int fr, int fq) const {
        const int row0 = u.pm * BM + wr * 64 + fr, col0 = u.pn * BM + wc * 32 + 8 * fq;
#pragma unroll
        for (int ai = 0; ai < 2; ++ai)
#pragma unroll
            for (int m = 0; m < 4; ++m) { bf16_t* rowp = O + (size_t)(row0 + ai * HALF + m * 16) * ldc + col0;
#pragma unroll
                for (int bj = 0; bj < 2; ++bj) *(u32x4*)(rowp + bj * HALF) = pack8(acc[ai][bj][m][0], acc[ai][bj][m][1]); }
    }
};
struct EpiProj {
    static constexpr bool PERM = true, SWAP = false;
    bf16_t* O; const float* rope;
    __device__ __forceinline__ void operator()(AccRef acc, const Unit& u, int wr, int wc, int fr, int fq) const {
        const int row0 = u.pm * BM + wr * 64 + fr, col0 = u.pn * BM + wc * 32 + 8 * fq;
        const int mode = (u.pn >= 27 && u.pn < 43) ? (u.pn < 35 ? 1 : 2) : 0;
        const float sc = (mode == 1) ? QSCALE : 1.0f;
#pragma unroll
        for (int ai = 0; ai < 2; ++ai)
#pragma unroll
            for (int m = 0; m < 4; ++m) { const int row = row0 + ai * HALF + m * 16; bf16_t* rowp = O + (size_t)row * PLD + col0;
#pragma unroll
                for (int bj = 0; bj < 2; ++bj) { f32x4 v0 = acc[ai][bj][m][0], v1 = acc[ai][bj][m][1];
                    if (mode) { const int i0 = ((col0 + bj * HALF) & 127) >> 1; const f32x4* rp = (const f32x4*)(rope + ((size_t)row * 64 + i0) * 2); const f32x4 c0 = rp[0], c1 = rp[1];
                        f32x4 o0, o1;
                        o0[0] = v0[0] * c0[0] - v0[1] * c0[1]; o0[1] = v0[1] * c0[0] + v0[0] * c0[1]; o0[2] = v0[2] * c0[2] - v0[3] * c0[3]; o0[3] = v0[3] * c0[2] + v0[2] * c0[3];
                        o1[0] = v1[0] * c1[0] - v1[1] * c1[1]; o1[1] = v1[1] * c1[0] + v1[0] * c1[1]; o1[2] = v1[2] * c1[2] - v1[3] * c1[3]; o1[3] = v1[3] * c1[2] + v1[2] * c1[3];
                        v0 = o0 * sc; v1 = o1 * sc; }
                    *(u32x4*)(rowp + bj * HALF) = pack8(v0, v1); } }
    }
};
struct EpiVT {
    static constexpr bool PERM = false, SWAP = true;
    bf16_t* VT;
    __device__ __forceinline__ void operator()(AccRef acc, const Unit& u, int wr, int wc, int fr, int fq) const {
        const int tok0 = u.pm * BM + wr * 64 + 4 * fq, col0 = u.pn * BM + wc * 32 + fr;
#pragma unroll
        for (int ai = 0; ai < 2; ++ai)
#pragma unroll
            for (int m = 0; m < 4; ++m)
#pragma unroll
                for (int bj = 0; bj < 2; ++bj)
#pragma unroll
                    for (int n = 0; n < 2; ++n) { const f32x4 v = acc[ai][bj][m][n]; u32x2 w; w.x = pk2(v[0], v[1]); w.y = pk2(v[2], v[3]);
                        *(u32x2*)(VT + (size_t)(col0 + bj * HALF + n * 16) * T + tok0 + ai * HALF + m * 16) = w; }
    }
};
struct EpiDec {
    static constexpr bool PERM = true, SWAP = false;
    float* O; const float* w0;
    __device__ __forceinline__ void operator()(AccRef acc, const Unit& u, int wr, int wc, int fr, int fq) const {
        const int row0 = u.pm * BM + wr * 64 + fr, col0 = u.pn * BM + wc * 32 + 8 * fq;
#pragma unroll
        for (int bj = 0; bj < 2; ++bj) { const f32x4 b0 = *(const f32x4*)(w0 + col0 + bj * HALF), b1 = *(const f32x4*)(w0 + col0 + bj * HALF + 4);
#pragma unroll
            for (int ai = 0; ai < 2; ++ai)
#pragma unroll
                for (int m = 0; m < 4; ++m) { float* rowp = O + (size_t)(row0 + ai * HALF + m * 16) * RW + col0 + bj * HALF;
#pragma unroll
                    for (int n = 0; n < 2; ++n) { const f32x4 x = acc[ai][bj][m][n] + (n ? b1 : b0); f32x4 o;
#pragma unroll
                        for (int e = 0; e < 4; ++e) { const float z = -x[e]; const float sp = fmaxf(z, 0.f) + __logf(1.0f + __expf(-fabsf(z))); o[e] = __expf(-__expf(-sp - 0.5f)); }
                        *(f32x4*)(rowp + 4 * n) = o; }
                    asm volatile("" ::: "memory"); } }
    }
};
struct EpiA {
    static constexpr bool PERM = true, SWAP = false;
    bf16_t* KP; bf16_t* BB; const bf16_t* KKN; const float* a0; const float* k_a;
    __device__ __forceinline__ void operator()(AccRef acc, const Unit& u, int wr, int wc, int fr, int fq) const {
        const int row0 = u.pm * BM + wr * 64 + fr, col0 = u.pn * BM + wc * 32 + 8 * fq;
#pragma unroll
        for (int bj = 0; bj < 2; ++bj) { const int cb = col0 + bj * HALF;
            const f32x4 b0 = *(const f32x4*)(a0 + cb), b1 = *(const f32x4*)(a0 + cb + 4), ka0 = *(const f32x4*)(k_a + cb), ka1 = *(const f32x4*)(k_a + cb + 4);
#pragma unroll
            for (int ai = 0; ai < 2; ++ai)
#pragma unroll
                for (int m = 0; m < 4; ++m) { const size_t off = (size_t)(row0 + ai * HALF + m * 16) * RW + cb;
                    f32x4 zk0, zk1, kn0, kn1; unpack8(*(const u32x4*)(KP + off), zk0, zk1); unpack8(*(const u32x4*)(KKN + off), kn0, kn1);
                    f32x4 a0v, a1v;
#pragma unroll
                    for (int e = 0; e < 4; ++e) { a0v[e] = fsigmoid(acc[ai][bj][m][0][e] + b0[e]); a1v[e] = fsigmoid(acc[ai][bj][m][1][e] + b1[e]); }
                    const f32x4 kp0 = zk0 * (1.0f + (a0v - 1.0f) * ka0), kp1 = zk1 * (1.0f + (a1v - 1.0f) * ka1);
                    *(u32x4*)(KP + off) = pack8(kp0, kp1); *(u32x4*)(BB + off) = pack8(-(kn0 * a0v), -(kn1 * a1v));
                    asm volatile("" ::: "memory"); } }
    }
};
template <bool ADD> struct EpiMix {
    static constexpr bool PERM = true, SWAP = false;
    bf16_t* O; const bf16_t* proj; int gcol0;
    __device__ __forceinline__ void operator()(AccRef acc, const Unit& u, int wr, int wc, int fr, int fq) const {
        const int row0 = u.pm * BM + wr * 64 + fr, col0 = u.pn * BM + wc * 32 + 8 * fq;
#pragma unroll
        for (int ai = 0; ai < 2; ++ai)
#pragma unroll
            for (int m = 0; m < 4; ++m) { const int row = row0 + ai * HALF + m * 16;
#pragma unroll
                for (int bj = 0; bj < 2; ++bj) { f32x4 g0, g1; unpack8(*(const u32x4*)(proj + (size_t)row * PLD + gcol0 + col0 + bj * HALF), g0, g1);
                    f32x4 o0, o1;
#pragma unroll
                    for (int e = 0; e < 4; ++e) { o0[e] = fsigmoid(g0[e]) * acc[ai][bj][m][0][e]; o1[e] = fsigmoid(g1[e]) * acc[ai][bj][m][1][e]; }
                    bf16_t* op = O + (size_t)row * D + col0 + bj * HALF;
                    if (ADD) { f32x4 p0, p1; unpack8(*(const u32x4*)op, p0, p1); o0 += p0; o1 += p1; }
                    *(u32x4*)op = pack8(o0, o1); } }
    }
};
struct EpiRes {
    static constexpr bool PERM = true, SWAP = false;
    float* O; const float* x;
    __device__ __forceinline__ void operator()(AccRef acc, const Unit& u, int wr, int wc, int fr, int fq) const {
        const int row0 = u.pm * BM + wr * 64 + fr, col0 = u.pn * BM + wc * 32 + 8 * fq;
#pragma unroll
        for (int ai = 0; ai < 2; ++ai)
#pragma unroll
            for (int m = 0; m < 4; ++m) { const size_t off = (size_t)(row0 + ai * HALF + m * 16) * D + col0;
#pragma unroll
                for (int bj = 0; bj < 2; ++bj)
#pragma unroll
                    for (int n = 0; n < 2; ++n) *(f32x4*)(O + off + bj * HALF + 4 * n) = *(const f32x4*)(x + off + bj * HALF + 4 * n) + acc[ai][bj][m][n]; }
    }
};
}

#define XB_TMO      128
#define XB_XCNT(j)  (256  + 64 * (j))
#define XB_XSUB(j)  (1280 + 64 * (j))
#define XB_XGEN(j)  (2304 + 64 * (j))
#define XB_TOP      3328
#define XB_TOPGEN   3392
#define XCD_BAR_WORDS 3456
#define XB_SPIN_CAP (1u << 18)
__device__ __forceinline__ unsigned xb_ld(unsigned* p)              { return __hip_atomic_load(p, __ATOMIC_RELAXED, __HIP_MEMORY_SCOPE_AGENT); }
__device__ __forceinline__ unsigned xb_add(unsigned* p, unsigned v) { return __hip_atomic_fetch_add(p, v, __ATOMIC_RELAXED, __HIP_MEMORY_SCOPE_AGENT); }
__device__ __forceinline__ unsigned xb_xcc_id() { return (unsigned)__builtin_amdgcn_s_getreg((3 << 11) | 20) & 0xFu; }
#define XB_SPIN(cond, bar) do { unsigned _sp = 0; while (cond) { __builtin_amdgcn_s_sleep(1); \
    if ((++_sp & 255u) == 0u) { if (xb_ld(&(bar)[XB_TMO])) break; if (_sp > XB_SPIN_CAP) { atomicAdd(&(bar)[XB_TMO], 1u); break; } } } } while (0)
struct XcdBarrier { unsigned* bar; unsigned x; volatile LAS unsigned* st; };
__device__ __forceinline__ XcdBarrier xcd_barrier_post(unsigned* bar, volatile LAS unsigned* st) {
    XcdBarrier b; b.bar = bar; b.x = xb_xcc_id(); b.st = st;
    if (threadIdx.x == 0) (void)xb_add(&bar[XB_XCNT(b.x)], 1u);
    return b;
}
__device__ __forceinline__ void xcd_barrier_complete(unsigned* bar, unsigned x, unsigned& nloc, unsigned& nx) {
    const unsigned G = gridDim.x * gridDim.y * gridDim.z;
    unsigned sum, cnt, mine, sp = 0u;
    for (;;) {
        sum = 0u; cnt = 0u; mine = 0u;
#pragma unroll
        for (unsigned j = 0; j < 16; ++j) { const unsigned c = xb_ld(&bar[XB_XCNT(j)]); sum += c; cnt += (c > 0u) ? 1u : 0u; mine = (j == x) ? c : mine; }
        if (sum == G) break;
        __builtin_amdgcn_s_sleep(1);
        if ((++sp & 255u) == 0u) { if (xb_ld(&bar[XB_TMO])) break; if (sp > XB_SPIN_CAP) { atomicAdd(&bar[XB_TMO], 1u); break; } }
    }
    nloc = mine > 0u ? mine : 1u; nx = cnt > 0u ? cnt : 1u;
}
__device__ __forceinline__ void xcd_barrier(const XcdBarrier& b) {
    asm volatile("s_waitcnt vmcnt(0)" ::: "memory");
    __syncthreads();
    if (threadIdx.x == 0) {
        unsigned* bar = b.bar;
        __builtin_amdgcn_s_waitcnt(0);
        unsigned nloc = b.st[0], nx = b.st[1];
        if (nloc == 0u) { xcd_barrier_complete(bar, b.x, nloc, nx); b.st[0] = nloc; b.st[1] = nx; }
        const unsigned old = xb_add(&bar[XB_XSUB(b.x)], 1u);
        const unsigned gen = old / nloc;
        if (old + 1u == (gen + 1u) * nloc) {
            __builtin_amdgcn_fence(__ATOMIC_RELEASE, "agent");
            asm volatile("s_waitcnt vmcnt(0)" ::: "memory");
            const unsigned og = xb_add(&bar[XB_TOP], 1u);
            const unsigned tg = og / nx;
            if (og + 1u == (tg + 1u) * nx) xb_add(&bar[XB_TOPGEN], 1u);
            else XB_SPIN(xb_ld(&bar[XB_TOPGEN]) == tg, bar);
            __builtin_amdgcn_fence(__ATOMIC_ACQUIRE, "agent");
            xb_add(&bar[XB_XGEN(b.x)], 1u);
            asm volatile("s_waitcnt vmcnt(0)" ::: "memory");
        } else {
            XB_SPIN(xb_ld(&bar[XB_XGEN(b.x)]) == gen, bar);
            __builtin_amdgcn_fence(__ATOMIC_ACQUIRE, "agent");
            asm volatile("s_waitcnt vmcnt(0)" ::: "memory");
        }
    }
    __syncthreads();
}

struct Args {
    const float *x, *norm1_g, *w_in, *mu, *w0, *w_up, *a0, *a_up, *g_up, *k_k, *k_a, *r_k, *lnx_g, *lnx_b, *w_ba, *w_bb, *w_out, *norm2_g, *peer_wq, *sub_keys, *peer_u, *peer_v, *final_g;
    float* out; unsigned char* ws; int ph_lo, ph_hi, li, pad;
};
#define CAS __attribute__((address_space(4)))
typedef const CAS Args* ArgsP;
__device__ __forceinline__ ArgsP get_args() { ArgsP p = (ArgsP)__builtin_amdgcn_kernarg_segment_ptr(); asm volatile("" : "+s"(p)); return p; }
struct Frame { LAS unsigned char* lds; int tid, lane, wave, vcu, G; };

__device__ __forceinline__ int win_dst(int s) {
    if (s < SHIFTW) return s;
    if (s < SHIFTW + 4096) { const int base = (s < SHIFTW + 2048) ? SHIFTW : SHIFTW + 2048; const int m = s - base, head = m >> 7, c = m & 127; const int j = (c < 64) ? 2 * c : 2 * (c - 64) + 1;
        return ((s < SHIFTW + 2048) ? PC_MQ : PC_MK) + head * 128 + j; }
    if (s < SHIFTW + 6144) return PC_MV + (s - (SHIFTW + 4096));
    if (s < SHIFTW + 6144 + 4096) return PC_GA + (s - (SHIFTW + 6144));
    return PC_GB + (s - (SHIFTW + 6144 + 4096));
}
template <bool MAPWIN> __device__ __forceinline__ void p0_transpose_item(const float* W, int K, int N, bf16_t* WT, int Kd, LAS float* scr, int item, int lane) {
    const int nblk = N / 32, kb = item / nblk, nb = item % nblk, k0 = 64 * kb, n0 = 32 * nb;
    { const int krow = lane >> 3, c4 = lane & 7; f32x4 v[8];
#pragma unroll
      for (int i = 0; i < 8; ++i) { const int kk = 8 * i + krow; v[i] = (k0 + kk < K) ? *(const f32x4*)(W + (size_t)(k0 + kk) * N + n0 + 4 * c4) : (f32x4){0.f, 0.f, 0.f, 0.f}; }
#pragma unroll
      for (int i = 0; i < 8; ++i) { LAS float* d = scr + (8 * i + krow) * 33 + 4 * c4; d[0] = v[i].x; d[1] = v[i].y; d[2] = v[i].z; d[3] = v[i].w; } }
    LDS_WAIT(); asm volatile("" ::: "memory");
    const int c = lane & 7;
#pragma unroll
    for (int j = 0; j < 4; ++j) { const int n = (lane >> 3) + 8 * j; const LAS float* s = scr + (8 * c) * 33 + n;
        u32x4 o; o.x = pk2(s[0 * 33], s[1 * 33]); o.y = pk2(s[2 * 33], s[3 * 33]); o.z = pk2(s[4 * 33], s[5 * 33]); o.w = pk2(s[6 * 33], s[7 * 33]);
        const int row = MAPWIN ? win_dst(n0 + n) : (n0 + n);
        *(u32x4*)(WT + (size_t)row * Kd + k0 + 8 * c) = o; }
    LDS_WAIT(); asm volatile("" ::: "memory");
}
__device__ __forceinline__ void rms_row_to_bf16(const float* xrow, const float* g, bf16_t* orow, int lane) {
    const f32x4* xr = (const f32x4*)xrow + lane; const f32x4* gr = (const f32x4*)g + lane;
    f32x4 v[16]; float s = 0.f;
#pragma unroll
    for (int j = 0; j < 16; ++j) { v[j] = xr[64 * j]; s += (v[j].x * v[j].x + v[j].y * v[j].y) + (v[j].z * v[j].z + v[j].w * v[j].w); }
    const float rs = 1.0f / sqrtf(wave_sum(s) * (1.0f / D) + NORM_EPS);
    u32x2* o8 = (u32x2*)orow + lane;
#pragma unroll
    for (int j = 0; j < 16; ++j) { const f32x4 gg = gr[64 * j]; u32x2 w; w.x = pk2(v[j].x * rs * gg.x, v[j].y * rs * gg.y); w.y = pk2(v[j].z * rs * gg.z, v[j].w * rs * gg.w); o8[64 * j] = w; }
}
__device__ __forceinline__ void cvt_table(const float* src, bf16_t* dst, size_t n8, size_t gtid, size_t nthr) {
    for (size_t i = gtid; i < n8; i += nthr) { const f32x4 a = ((const f32x4*)src)[2 * i], b = ((const f32x4*)src)[2 * i + 1]; ((u32x4*)dst)[i] = pg8::pack8(a, b); }
}
__device__ __forceinline__ void peer_quant(ArgsP A, Frame& F, int w0, int wstride) {
    unsigned char* ws = A->ws;
    for (int row = w0; row < 2 * 16384; row += wstride) { const bool isv = row >= 16384; const int rr = isv ? row - 16384 : row;
        const f32x4* src = (const f32x4*)((isv ? A->peer_v : A->peer_u) + (size_t)rr * D) + F.lane; f32x4 v[16]; float am = 0.f;
#pragma unroll
        for (int j = 0; j < 16; ++j) { v[j] = src[64 * j]; am = fmaxf(fmaxf(am, fmaxf(fabsf(v[j].x), fabsf(v[j].y))), fmaxf(fabsf(v[j].z), fabsf(v[j].w))); }
#pragma unroll
        for (int o = 1; o < 64; o <<= 1) am = fmaxf(am, __shfl_xor(am, o));
        const float inv = am > 0.f ? 127.0f / am : 0.f; unsigned* dst = (unsigned*)(ws + (isv ? WS_PV : WS_PU)) + (size_t)rr * (D / 4) + F.lane;
#pragma unroll
        for (int j = 0; j < 16; ++j) { const unsigned q0 = (unsigned)(int)(rintf(v[j].x * inv) + 128.0f), q1 = (unsigned)(int)(rintf(v[j].y * inv) + 128.0f), q2 = (unsigned)(int)(rintf(v[j].z * inv) + 128.0f), q3 = (unsigned)(int)(rintf(v[j].w * inv) + 128.0f);
            dst[64 * j] = q0 | (q1 << 8) | (q2 << 16) | (q3 << 24); }
        if (F.lane == 0) ((float*)(ws + (isv ? WS_PSV : WS_PSU)))[rr] = am * (1.0f / 127.0f); }
}
__device__ __forceinline__ void late_weights(ArgsP A, Frame& F, int w0, int wstride) {
    unsigned char* ws = A->ws;
    LAS float* scr = (LAS float*)(F.lds + RING_OFF + F.wave * 16384);
    constexpr int I_BA = 32 * 128, I_OUT = 64 * 128, I_WQ = 64 * 64, I_SK = PH_ * 2 * PNK * PHALF / 512;
    constexpr int NITEMS = 2 * I_BA + I_OUT + I_WQ + I_SK;
    for (int it = w0; it < NITEMS; it += wstride) {
        int r = it;
        if (r < I_BA) { p0_transpose_item<false>(A->w_ba, RW, D, (bf16_t*)(ws + WS_WA), RW, scr, r, F.lane); continue; } r -= I_BA;
        if (r < I_BA) { p0_transpose_item<false>(A->w_bb, RW, D, (bf16_t*)(ws + WS_WB), RW, scr, r, F.lane); continue; } r -= I_BA;
        if (r < I_OUT) { p0_transpose_item<false>(A->w_out, D, D, (bf16_t*)(ws + WS_WOUT), D, scr, r, F.lane); continue; } r -= I_OUT;
        if (r < I_WQ) { p0_transpose_item<false>(A->peer_wq, D, 2048, (bf16_t*)(ws + WS_WQ), D, scr, r, F.lane); continue; } r -= I_WQ;
        { const size_t i = (size_t)r * 64 + F.lane; const f32x4 a = ((const f32x4*)A->sub_keys)[2 * i], b = ((const f32x4*)A->sub_keys)[2 * i + 1]; ((u32x4*)(ws + WS_SUBK))[i] = pg8::pack8(a, b); }
    }
}
__device__ __forceinline__ void ph0_prologue(ArgsP A, Frame& F) {
    unsigned char* ws = A->ws;
    LAS float* scr = (LAS float*)(F.lds + RING_OFF + F.wave * 16384);
    const int gw = F.vcu * NWAVES + F.wave, NGW = F.G * NWAVES;
    constexpr int I_IN = 64 * (INW / 32), I_UP = 2 * 64, I_G = 8 * 64;
    constexpr int NITEMS = I_IN + 2 * I_UP + I_G;
    for (int it = gw; it < NITEMS; it += NGW) {
        int r = it;
        if (r < I_IN) { p0_transpose_item<true>(A->w_in, D, INW, (bf16_t*)(ws + WS_WIN), D, scr, r, F.lane); continue; } r -= I_IN;
        if (r < I_UP) { p0_transpose_item<false>(A->w_up, LW, RW, (bf16_t*)(ws + WS_WUP), LW, scr, r, F.lane); continue; } r -= I_UP;
        if (r < I_UP) { p0_transpose_item<false>(A->a_up, LA, RW, (bf16_t*)(ws + WS_AUP), LA, scr, r, F.lane); continue; } r -= I_UP;
        p0_transpose_item<false>(A->g_up, LG, RW, (bf16_t*)(ws + WS_GUP), LGP, scr, r, F.lane);
    }
    const size_t gtid = (size_t)F.vcu * NTHR + F.tid, nthr = (size_t)F.G * NTHR;
    for (size_t i = gtid; i < (size_t)32 * D / 8; i += nthr) ((u32x4*)((bf16_t*)(ws + WS_WIN) + (size_t)SHIFTW * D))[i] = (u32x4){0u, 0u, 0u, 0u};
    for (size_t i = gtid; i < (size_t)T * 64; i += nthr) { const int pos = (int)(i >> 6), fi = (int)(i & 63); const float inv = powf(10000.0f, -(float)fi / 64.0f); const float ang = (float)pos * inv;
        ((f32x2*)(ws + WS_ROPE))[i] = (f32x2){cosf(ang), sinf(ang)}; }
    for (int m = gw; m < T; m += NGW) rms_row_to_bf16(A->x + (size_t)m * D, A->norm1_g, (bf16_t*)(ws + WS_XN) + (size_t)m * D, F.lane);
}

__device__ __forceinline__ f32x4 ld4bf(const bf16_t* p) { const u32x2 w = *(const u32x2*)p; return (f32x4){bflo(w.x), bfhi(w.x), bflo(w.y), bfhi(w.y)}; }
__device__ __forceinline__ void st4bf(bf16_t* p, f32x4 v) { u32x2 w; w.x = pk2(v[0], v[1]); w.y = pk2(v[2], v[3]); *(u32x2*)p = w; }
__device__ __forceinline__ void ph2_prep(ArgsP A, Frame& F) {
    unsigned char* ws = A->ws; const bf16_t* PROJ = (const bf16_t*)(ws + WS_PROJ);
    LAS float* red = (LAS float*)(F.lds + RING_OFF);
    for (int it = F.vcu; it < NBLK * MH; it += F.G) { const int n = it / MH, h = it % MH, d = F.tid & 127, part = F.tid >> 7;
        const bf16_t* p = PROJ + (size_t)(n * MBLK + part * 64) * PLD + PC_MK + h * MD + d; float s = 0.f;
#pragma unroll 8
        for (int i = 0; i < 64; ++i) s += bf1(p[(size_t)i * PLD]);
        red[F.tid] = s; WG_BAR();
        if (F.tid < 128) { const float m = (red[F.tid] + red[F.tid + 128] + red[F.tid + 256] + red[F.tid + 384]) * (1.0f / MBLK); const unsigned hi = f2bf(m); const float lo = m - __builtin_bit_cast(float, hi << 16);
            ((bf16_t*)(ws + WS_KMEAN))[(size_t)(h * NBLK + n) * MD + F.tid] = (bf16_t)hi; ((bf16_t*)(ws + WS_KMEAN + 131072))[(size_t)(h * NBLK + n) * MD + F.tid] = (bf16_t)f2bf(lo); }
        WG_BAR(); }
    const int tid = F.tid;
    for (int t = F.vcu; t < T; t += F.G) { const bf16_t* P = PROJ + (size_t)t * PLD; const bf16_t* PP = P - PLD; const bool hasp = t > 0; const f32x4 zero = (f32x4){0.f, 0.f, 0.f, 0.f};
        { const int c = 4 * tid; const f32x4 p = ld4bf(P + PC_R + c), pp = hasp ? ld4bf(PP + PC_R + c) : zero, mu = *(const f32x4*)(A->mu + PC_R + c); st4bf((bf16_t*)(ws + WS_ZR) + (size_t)t * RW + c, p + (pp - p) * mu); }
        { const int c = 4 * tid; const f32x4 p = ld4bf(P + PC_K + c), pp = hasp ? ld4bf(PP + PC_K + c) : zero, mu = *(const f32x4*)(A->mu + PC_K + c); const f32x4 zk = p + (pp - p) * mu;
          st4bf((bf16_t*)(ws + WS_KP) + (size_t)t * RW + c, zk); const f32x4 kk = zk * *(const f32x4*)(A->k_k + c);
          const float ss = sum16((kk[0] * kk[0] + kk[1] * kk[1]) + (kk[2] * kk[2] + kk[3] * kk[3])); const float inv = 1.0f / fmaxf(sqrtf(ss), 1e-12f);
          st4bf((bf16_t*)(ws + WS_KKN) + (size_t)t * RW + c, kk * inv); }
        { const int c = 4 * tid; const f32x4 p = ld4bf(P + PC_V + c), pp = hasp ? ld4bf(PP + PC_V + c) : zero, mu = *(const f32x4*)(A->mu + PC_V + c); st4bf((bf16_t*)(ws + WS_ZV) + (size_t)t * RW + c, p + (pp - p) * mu); }
        if (tid < 192) {
            int c, cc; if (tid < 32) { cc = 4 * tid; c = PC_WL + cc; } else if (tid < 64) { cc = 4 * (tid - 32); c = PC_AL + cc; } else { cc = 4 * (tid - 64); c = PC_GL + cc; }
            f32x4 z = zero;
            if (tid < 64 || cc < LG) { const f32x4 p = ld4bf(P + c), pp = hasp ? ld4bf(PP + c) : zero, mu = *(const f32x4*)(A->mu + c); z = p + (pp - p) * mu; }
            if (tid < 32) { f32x4 o;
#pragma unroll
                for (int e = 0; e < 4; ++e) o[e] = 1.0f - 2.0f * __builtin_amdgcn_rcpf(__expf(2.0f * z[e]) + 1.0f);
                st4bf((bf16_t*)(ws + WS_AW) + (size_t)t * LW + cc, o); }
            else if (tid < 64) st4bf((bf16_t*)(ws + WS_AA) + (size_t)t * LA + cc, z);
            else { f32x4 o = zero; if (cc < LG) {
#pragma unroll
                for (int e = 0; e < 4; ++e) o[e] = fsigmoid(z[e]); }
                st4bf((bf16_t*)(ws + WS_AG) + (size_t)t * LGP + cc, o); }
        }
    }
}

__device__ __forceinline__ void ph3_gate(ArgsP A, Frame& F) {
    unsigned char* ws = A->ws; const bf16_t* PROJ = (const bf16_t*)(ws + WS_PROJ); const bf16_t* KMH = (const bf16_t*)(ws + WS_KMEAN); const bf16_t* KML = (const bf16_t*)(ws + WS_KMEAN + 131072); unsigned* MASK = (unsigned*)(ws + WS_MASK);
    const int gw = F.vcu * NWAVES + F.wave, NGW = F.G * NWAVES; const int r = F.lane & 31, hh = F.lane >> 5; const float NEG = -__builtin_inff();
    for (int it = gw; it < (T / 32) * MH; it += NGW) { const int tg = it >> 4, h = it & 15, t = tg * 32 + r, blk = tg >> 3;
        if (blk == 0) { if (hh == 0) MASK[t * MH + h] = 0u; continue; }
        f32x16 acc;
#pragma unroll
        for (int e = 0; e < 16; ++e) acc[e] = 0.f;
#pragma unroll
        for (int ks = 0; ks < 8; ++ks) { const bf16x8 q = *(const bf16x8*)(PROJ + (size_t)t * PLD + PC_MQ + h * MD + 16 * ks + 8 * hh); const size_t ko = (size_t)(h * NBLK + r) * MD + 16 * ks + 8 * hh;
            acc = __builtin_amdgcn_mfma_f32_32x32x16_bf16(*(const bf16x8*)(KMH + ko), q, acc, 0, 0, 0); acc = __builtin_amdgcn_mfma_f32_32x32x16_bf16(*(const bf16x8*)(KML + ko), q, acc, 0, 0, 0); }
        float t0 = NEG, t1 = NEG, t2 = NEG;
#pragma unroll
        for (int e = 0; e < 16; ++e) { const int n = (e & 3) + 8 * (e >> 2) + 4 * hh; float ae = acc[e]; asm volatile("" : "+v"(ae));
            float x = __builtin_bit_cast(float, (__builtin_bit_cast(unsigned, ae) & ~31u) | (unsigned)(31 - n)); x = (n < blk) ? x : NEG;
            t2 = __builtin_amdgcn_fmed3f(t1, t2, x); t1 = __builtin_amdgcn_fmed3f(t0, t1, x); t0 = fmaxf(t0, x); }
        const float o0 = __shfl_xor(t0, 32), o1 = __shfl_xor(t1, 32), o2 = __shfl_xor(t2, 32);
        t2 = __builtin_amdgcn_fmed3f(t1, t2, o0); t1 = __builtin_amdgcn_fmed3f(t0, t1, o0); t0 = fmaxf(t0, o0);
        t2 = __builtin_amdgcn_fmed3f(t1, t2, o1); t1 = __builtin_amdgcn_fmed3f(t0, t1, o1); t0 = fmaxf(t0, o1);
        t2 = __builtin_amdgcn_fmed3f(t1, t2, o2); t1 = __builtin_amdgcn_fmed3f(t0, t1, o2); t0 = fmaxf(t0, o2);
        unsigned sel = 1u << (31 - (__builtin_bit_cast(unsigned, t0) & 31u));
        if (blk > 1) sel |= 1u << (31 - (__builtin_bit_cast(unsigned, t1) & 31u));
        if (blk > 2) sel |= 1u << (31 - (__builtin_bit_cast(unsigned, t2) & 31u));
        if (hh == 0) MASK[t * MH + h] = sel; }
}

constexpr int SC_CH = 32, SC_STEP = 1344, SC_BUF = SC_CH * SC_STEP, SC_YOFF = 2 * SC_BUF, SC_YBUF = SC_CH * 16 * 4 * 4;
static_assert(SC_YOFF + 2 * SC_YBUF <= RING_BYTES, "scan LDS");
__device__ __forceinline__ void ph4_scan(ArgsP A, Frame& F, int unit0, int ustride) {
    unsigned char* ws = A->ws;
    const float* DEC = (const float*)(ws + WS_DEC); const bf16_t* KKN = (const bf16_t*)(ws + WS_KKN); const bf16_t* BB = (const bf16_t*)(ws + WS_BB); const bf16_t* KP = (const bf16_t*)(ws + WS_KP);
    const bf16_t* ZR = (const bf16_t*)(ws + WS_ZR); const bf16_t* ZV = (const bf16_t*)(ws + WS_ZV); float* Y = (float*)(ws + WS_Y);
    LAS unsigned char* L = F.lds + RING_OFF;
    const int wave = F.wave, lane = F.lane;
    for (int unit = unit0; unit < 128; unit += ustride) {
        const int h = unit >> 2, r0 = (unit & 3) * 16; const size_t hc = (size_t)h * RN;
        constexpr int NC = T / SC_CH;
        if (wave < 4) {
            const int row = wave * 4 + (lane >> 4), j = lane & 15;
            f32x2 S01 = {0.f, 0.f}, S23 = {0.f, 0.f};
            __builtin_amdgcn_s_setprio(3);
            WG_BAR();
#define SC_LOAD(W, KK, BBv, KPv, RR, V, tt_) do { const int o_ = (tt_) * SC_STEP; W = *(const LAS f32x4*)(B + o_); KK = *(const LAS f32x4*)(B + o_ + 256); BBv = *(const LAS f32x4*)(B + o_ + 512); KPv = *(const LAS f32x4*)(B + o_ + 768); RR = *(const LAS f32x4*)(B + o_ + 1024); V = *(const LAS float*)(vb + o_); } while (0)
#define SC_STEPF(W, KK, BBv, KPv, RR, V, tt_) do { \
            const f32x2 kk01 = {KK[0], KK[1]}, kk23 = {KK[2], KK[3]}; f32x2 d2 = S01 * kk01; d2 = __builtin_elementwise_fma(S23, kk23, d2); \
            const f32x2 w01 = {W[0], W[1]}, w23 = {W[2], W[3]}, kp01 = {KPv[0], KPv[1]}, kp23 = {KPv[2], KPv[3]}; const f32x2 vv = {V, V}; \
            f32x2 t01 = S01 * w01, t23 = S23 * w23; t01 = __builtin_elementwise_fma(vv, kp01, t01); t23 = __builtin_elementwise_fma(vv, kp23, t23); \
            const float d_ = sum16(d2[0] + d2[1]); const f32x2 dd = {d_, d_}; const f32x2 bb01 = {BBv[0], BBv[1]}, bb23 = {BBv[2], BBv[3]};        \
            S01 = __builtin_elementwise_fma(dd, bb01, t01); S23 = __builtin_elementwise_fma(dd, bb23, t23); \
            const f32x2 r01 = {RR[0], RR[1]}, r23 = {RR[2], RR[3]}; f32x2 y2 = S01 * r01; y2 = __builtin_elementwise_fma(S23, r23, y2); float yq_ = y2[0] + y2[1]; yq_ += dpp_f<0xB1>(yq_); yq_ += dpp_f<0x4E>(yq_); yb[(tt_) * 64] = yq_; } while (0)
#pragma unroll 1
            for (int c = 0; c < NC; ++c) {
                const LAS unsigned char* B = L + (c & 1) * SC_BUF + 16 * j; LAS float* yb = (LAS float*)(L + SC_YOFF + (c & 1) * SC_YBUF) + row * 4 + (j >> 2);
                const LAS unsigned char* vb = L + (c & 1) * SC_BUF + 1280 + 4 * row;
                f32x4 wA, kA, bA, pA, rA, wB, kB, bB, pB, rB, wC, kC, bC, pC, rC, wD, kD, bD, pD, rD; float vA, vB, vC, vD;
                SC_LOAD(wA, kA, bA, pA, rA, vA, 0); SC_LOAD(wB, kB, bB, pB, rB, vB, 1);
#pragma unroll 1
                for (int tt = 0; tt < SC_CH; tt += 4) {
                    const int t4 = tt + 4 < SC_CH ? tt + 4 : tt, t5 = tt + 5 < SC_CH ? tt + 5 : tt + 1;
                    SC_LOAD(wC, kC, bC, pC, rC, vC, tt + 2); SC_STEPF(wA, kA, bA, pA, rA, vA, tt); SC_LOAD(wD, kD, bD, pD, rD, vD, tt + 3); SC_STEPF(wB, kB, bB, pB, rB, vB, tt + 1);
                    SC_LOAD(wA, kA, bA, pA, rA, vA, t4); SC_STEPF(wC, kC, bC, pC, rC, vC, tt + 2); SC_LOAD(wB, kB, bB, pB, rB, vB, t5); SC_STEPF(wD, kD, bD, pD, rD, vD, tt + 3);
                }
                WG_BAR();
            }
            __builtin_amdgcn_s_setprio(0);
#undef SC_LOAD
#undef SC_STEPF
        } else {
            const int ltid = (wave - 4) * 64 + lane;
            f32x4 ld_dec[2]; u32x4 ld_b[4]; u32x4 ld_v;
            auto issue = [&](int c) { const int t0 = c * SC_CH;
#pragma unroll
                for (int i = 0; i < 2; ++i) { const int q = ltid + 256 * i, st = q >> 4, c4 = q & 15; ld_dec[i] = *(const f32x4*)(DEC + (size_t)(t0 + st) * RW + hc + 4 * c4); }
                { const int st = ltid >> 3, c8 = ltid & 7; const size_t o = (size_t)(t0 + st) * RW + hc + 8 * c8; ld_b[0] = *(const u32x4*)(KKN + o); ld_b[1] = *(const u32x4*)(BB + o); ld_b[2] = *(const u32x4*)(KP + o); ld_b[3] = *(const u32x4*)(ZR + o); }
                { const int l6 = ltid & 63; ld_v = *(const u32x4*)(ZV + (size_t)(t0 + (l6 >> 1)) * RW + hc + r0 + 8 * (l6 & 1)); } };
            auto commit = [&](int buf) { LAS unsigned char* B = L + buf * SC_BUF;
#pragma unroll
                for (int i = 0; i < 2; ++i) { const int q = ltid + 256 * i, st = q >> 4, c4 = q & 15; *(LAS f32x4*)(B + st * SC_STEP + 16 * c4) = ld_dec[i]; }
                { const int st = ltid >> 3, c8 = ltid & 7;
#pragma unroll
                  for (int a = 0; a < 4; ++a) { f32x4 v0, v1; pg8::unpack8(ld_b[a], v0, v1); LAS unsigned char* p = B + st * SC_STEP + 256 * (a + 1) + 32 * c8; *(LAS f32x4*)p = v0; *(LAS f32x4*)(p + 16) = v1; } }
                if (ltid < 64) { f32x4 v0, v1; pg8::unpack8(ld_v, v0, v1); LAS unsigned char* p = B + (ltid >> 1) * SC_STEP + 1280 + 32 * (ltid & 1); *(LAS f32x4*)p = v0; *(LAS f32x4*)(p + 16) = v1; } };
            auto yflush = [&](int c) {
#pragma unroll
                for (int i = 0; i < 2; ++i) { const int o = ltid + 256 * i, st = o >> 4, rr = o & 15; const f32x4 a = *(const LAS f32x4*)(L + SC_YOFF + (c & 1) * SC_YBUF + (st * 16 + rr) * 16);
                    Y[(size_t)(c * SC_CH + st) * RW + hc + r0 + rr] = (a[0] + a[1]) + (a[2] + a[3]); } };
            issue(0); VM_WAIT(); commit(0); issue(1);
            WG_BAR();
#pragma unroll 1
            for (int c = 0; c < NC; ++c) {
                if (c + 1 < NC) { VM_WAIT(); commit((c + 1) & 1); }
                if (c + 2 < NC) issue(c + 2);
                if (c > 0) yflush(c - 1);
                WG_BAR();
            }
            yflush(NC - 1);
        }
        WG_BAR();
    }
}

__device__ __forceinline__ void ph5_ypost(ArgsP A, Frame& F) {
    unsigned char* ws = A->ws; const float* Y = (const float*)(ws + WS_Y); const bf16_t* ZR = (const bf16_t*)(ws + WS_ZR); const bf16_t* KP = (const bf16_t*)(ws + WS_KP); const bf16_t* ZV = (const bf16_t*)(ws + WS_ZV);
    const bf16_t* G = (const bf16_t*)(ws + WS_G); bf16_t* YA = (bf16_t*)(ws + WS_YA);
    const int gw = F.vcu * NWAVES + F.wave, NGW = F.G * NWAVES;
    for (int tg = F.vcu; tg < T / 32; tg += F.G) for (int it = F.wave; it < 256; it += NWAVES) { const int t = tg * 32 + (it >> 3), c = (it & 7) * 256 + 4 * F.lane; const size_t o = (size_t)t * RW + c;
        const f32x4 y = *(const f32x4*)(Y + o); const float mean = sum16((y[0] + y[1]) + (y[2] + y[3])) * (1.0f / 64.0f); const f32x4 d = y - mean;
        const float var = sum16((d[0] * d[0] + d[1] * d[1]) + (d[2] * d[2] + d[3] * d[3])) * (1.0f / 64.0f); const float rs = 1.0f / sqrtf(var + LNX_EPS);
        const f32x4 r = ld4bf(ZR + o), k = ld4bf(KP + o), v = ld4bf(ZV + o), g = ld4bf(G + o), rk = *(const f32x4*)(A->r_k + c), lg = *(const f32x4*)(A->lnx_g + c), lb = *(const f32x4*)(A->lnx_b + c);
        const f32x4 rkk = r * k * rk; const float bonus = sum16((rkk[0] + rkk[1]) + (rkk[2] + rkk[3]));
        st4bf(YA + o, (d * rs * lg + lb + bonus * v) * g); }
}

constexpr int AT_KB = 64 * 256, AT_VB = 128 * 128, AT_BUF = AT_KB + AT_VB;
static_assert(3 * AT_BUF <= RING_BYTES, "attention LDS");
__device__ __forceinline__ void ph5_attn(ArgsP A, Frame& F, int slot0, int sstride) {
    unsigned char* ws = A->ws; const bf16_t* PROJ = (const bf16_t*)(ws + WS_PROJ); const bf16_t* VT = (const bf16_t*)(ws + WS_VT); const unsigned* MASK = (const unsigned*)(ws + WS_MASK); bf16_t* YB = (bf16_t*)(ws + WS_YB);
    LAS unsigned char* L = F.lds + RING_OFF; const int tid = F.tid, wave = F.wave, lane = F.lane, r = lane & 31, hh = lane >> 5;
    const float NEG = -__builtin_inff();
    for (int sl = slot0; sl < 128; sl += sstride) { const int h = sl >> 3, pr0 = (sl & 7) * 2;
      for (int half = 0; half < 4; ++half) { const int pr = pr0 + (half >> 1); const int ib = (half & 1) == 0 ? (31 - pr) : pr;
        const int q0 = ib * MBLK + wave * 32;
        bf16x8 qf[8];
#pragma unroll
        for (int ks = 0; ks < 8; ++ks) qf[ks] = *(const bf16x8*)(PROJ + (size_t)(q0 + r) * PLD + PC_MQ + h * MD + 16 * ks + 8 * hh);
        const unsigned msk = MASK[(q0 + r) * MH + h];
        f32x16 o[4];
#pragma unroll
        for (int db = 0; db < 4; ++db)
#pragma unroll
            for (int e = 0; e < 16; ++e) o[db][e] = 0.f;
        float mrun = NEG, lrun = 0.f;
        const int ntile = 4 + 4 * ib;
        auto tile_tok = [&](int n) { return n < 4 ? ib * MBLK + n * 64 : ((n - 4) >> 2) * MBLK + ((n - 4) & 3) * 64; };
        const int krow_ = lane >> 4, kslot = lane & 15, vrow_ = lane >> 3, vslot = lane & 7;
        auto dma_tile = [&](int n, int b3) { const int tb = tile_tok(n); LAS unsigned char* B = L + b3 * AT_BUF;
#pragma unroll
            for (int i = 0; i < 2; ++i) { const int p = wave * 2 + i, row = 4 * p + krow_, c = kslot ^ (row & 15);
                __builtin_amdgcn_global_load_lds((const unsigned*)(PROJ + (size_t)(tb + row) * PLD + PC_MK + h * MD + 8 * c), (LAS unsigned*)(B + p * 1024), 16, 0, 0); }
#pragma unroll
            for (int i = 0; i < 2; ++i) { const int p = wave * 2 + i, row = 8 * p + vrow_, c = vslot ^ (row & 7);
                __builtin_amdgcn_global_load_lds((const unsigned*)(VT + (size_t)(h * MD + row) * T + tb + 8 * c), (LAS unsigned*)(B + AT_KB + p * 1024), 16, 0, 0); } };
        dma_tile(0, 0); dma_tile(1, 1);
        asm volatile("s_waitcnt vmcnt(4)" ::: "memory"); WG_BAR();
        int b3 = 0;
        for (int n = 0; n < ntile; ++n) {
            { const int bn = b3 >= 1 ? b3 - 1 : 2; if (n + 2 < ntile) dma_tile(n + 2, bn); }
            bool need; int jblk = -1, tt = 0;
            if (n < 4) { tt = n; need = tt <= (wave >> 1); } else { jblk = (n - 4) >> 2; need = __ballot((msk >> jblk) & 1u) != 0ull; }
            if (need) {
                const LAS unsigned char* KB = L + b3 * AT_BUF; const LAS unsigned char* VB = KB + AT_KB;
                f32x16 s[2];
#pragma unroll
                for (int kb = 0; kb < 2; ++kb) {
#pragma unroll
                    for (int e = 0; e < 16; ++e) s[kb][e] = 0.f;
#pragma unroll
                    for (int ks = 0; ks < 8; ++ks) { const bf16x8 a = *(const LAS bf16x8*)(KB + (32 * kb + r) * 256 + (((2 * ks + hh) ^ (r & 15)) << 4)); s[kb] = __builtin_amdgcn_mfma_f32_32x32x16_bf16(a, qf[ks], s[kb], 0, 0, 0); } }
                if (n < 4) { if (64 * tt + 63 > wave * 32) { const int qrel = wave * 32 + r;
#pragma unroll
                    for (int kb = 0; kb < 2; ++kb)
#pragma unroll
                        for (int e = 0; e < 16; ++e) { const int krel = 64 * tt + 32 * kb + (e & 3) + 8 * (e >> 2) + 4 * hh; if (krel > qrel) s[kb][e] = NEG; } } }
                else if (!((msk >> jblk) & 1u)) {
#pragma unroll
                    for (int kb = 0; kb < 2; ++kb)
#pragma unroll
                        for (int e = 0; e < 16; ++e) s[kb][e] = NEG; }
                float mx = s[0][0];
#pragma unroll
                for (int kb = 0; kb < 2; ++kb)
#pragma unroll
                    for (int e = 0; e < 16; ++e) mx = fmaxf(mx, s[kb][e]);
                mx = fmaxf(mx, __shfl_xor(mx, 32));
                const float mnew = fmaxf(mrun, mx); const float alpha = __builtin_amdgcn_exp2f(mrun - mnew); mrun = mnew;
                float ps = 0.f;
#pragma unroll
                for (int kb = 0; kb < 2; ++kb)
#pragma unroll
                    for (int e = 0; e < 16; ++e) { const float p = __builtin_amdgcn_exp2f(s[kb][e] - mnew); s[kb][e] = p; ps += p; }
                lrun = lrun * alpha + ps;
                if (__ballot(alpha != 1.0f) != 0ull) {
#pragma unroll
                    for (int db = 0; db < 4; ++db)
#pragma unroll
                        for (int e = 0; e < 16; ++e) o[db][e] *= alpha; }
#pragma unroll
                for (int kb = 0; kb < 2; ++kb)
#pragma unroll
                    for (int st = 0; st < 2; ++st) { u32x4 pw; pw.x = pk2(s[kb][8 * st + 0], s[kb][8 * st + 1]); pw.y = pk2(s[kb][8 * st + 2], s[kb][8 * st + 3]); pw.z = pk2(s[kb][8 * st + 4], s[kb][8 * st + 5]); pw.w = pk2(s[kb][8 * st + 6], s[kb][8 * st + 7]);
                        const bf16x8 pf = __builtin_bit_cast(bf16x8, pw); const int kbase = 32 * kb + 16 * st + 4 * hh;
#pragma unroll
                        for (int db = 0; db < 4; ++db) { const LAS unsigned char* vrow = VB + (32 * db + r) * 128 + 8 * hh; const int c0 = 4 * kb + 2 * st; const u32x2 lo = *(const LAS u32x2*)(vrow + ((c0 ^ (r & 7)) << 4)), hi = *(const LAS u32x2*)(vrow + (((c0 + 1) ^ (r & 7)) << 4));
                            const bf16x8 vf = __builtin_bit_cast(bf16x8, (u32x4){lo.x, lo.y, hi.x, hi.y}); o[db] = __builtin_amdgcn_mfma_f32_32x32x16_bf16(vf, pf, o[db], 0, 0, 0); } }
            }
            if (n + 2 < ntile) asm volatile("s_waitcnt vmcnt(4)" ::: "memory"); else asm volatile("s_waitcnt vmcnt(0)" ::: "memory");
            b3 = b3 == 2 ? 0 : b3 + 1;
            WG_BAR();
        }
        const float ltot = lrun + __shfl_xor(lrun, 32); const float inv = 1.0f / ltot;
        bf16_t* op = YB + (size_t)(q0 + r) * RW + h * MD;
#pragma unroll
        for (int db = 0; db < 4; ++db)
#pragma unroll
            for (int g = 0; g < 4; ++g) { u32x2 w; w.x = pk2(o[db][4 * g] * inv, o[db][4 * g + 1] * inv); w.y = pk2(o[db][4 * g + 2] * inv, o[db][4 * g + 3] * inv); *(u32x2*)(op + 32 * db + 8 * g + 4 * hh) = w; }
      }
    }
}

__device__ __forceinline__ void ins16(float (&top)[16], float x) {
#pragma unroll
    for (int k = 15; k >= 1; --k) top[k] = __builtin_amdgcn_fmed3f(top[k - 1], top[k], x);
    top[0] = fmaxf(top[0], x);
}
__device__ __forceinline__ void ph10_select(ArgsP A, Frame& F) {
    unsigned char* ws = A->ws; const bf16_t* PQ = (const bf16_t*)(ws + WS_PQ); const bf16_t* SK = (const bf16_t*)(ws + WS_SUBK); int* IDX = (int*)(ws + WS_IDX); float* GW = (float*)(ws + WS_GW);
    const int gw = F.vcu * NWAVES + F.wave, NGW = F.G * NWAVES; const int r = F.lane & 31, hh = F.lane >> 5; const float NEG = -__builtin_inff();
    for (int it = gw; it < (T / 32) * PH_; it += NGW) { const int tg = it >> 3, h = it & 7, t = tg * 32 + r;
        float TA[16], TB[16];
        auto topk = [&](int p, float (&dst)[16]) {
            bf16x8 qf[8];
#pragma unroll
            for (int ks = 0; ks < 8; ++ks) qf[ks] = *(const bf16x8*)(PQ + (size_t)t * 2048 + (h * 2 + p) * PHALF + 16 * ks + 8 * hh);
            float top[16];
#pragma unroll
            for (int k = 0; k < 16; ++k) top[k] = NEG;
#pragma unroll 1
            for (int nb = 0; nb < 4; ++nb) { f32x16 acc;
#pragma unroll
                for (int e = 0; e < 16; ++e) acc[e] = 0.f;
#pragma unroll
                for (int ks = 0; ks < 8; ++ks) { const bf16x8 a = *(const bf16x8*)(SK + ((size_t)(h * 2 + p) * PNK + 32 * nb + r) * PHALF + 16 * ks + 8 * hh); acc = __builtin_amdgcn_mfma_f32_32x32x16_bf16(a, qf[ks], acc, 0, 0, 0); }
#pragma unroll
                for (int e = 0; e < 16; ++e) { const unsigned key = 32 * nb + (e & 3) + 8 * (e >> 2) + 4 * hh; float ae = acc[e]; asm volatile("" : "+v"(ae));
                    const float x = __builtin_bit_cast(float, (__builtin_bit_cast(unsigned, ae) & ~0x7Fu) | key); ins16(top, x); } }
            float oth[16];
#pragma unroll
            for (int k = 0; k < 16; ++k) oth[k] = __shfl_xor(top[k], 32);
#pragma unroll
            for (int k = 0; k < 16; ++k) ins16(top, oth[k]);
#pragma unroll
            for (int k = 0; k < 16; ++k) dst[k] = top[k];
        };
        topk(0, TA); asm volatile("" ::: "memory"); __builtin_amdgcn_sched_barrier(0); topk(1, TB); asm volatile("" ::: "memory"); __builtin_amdgcn_sched_barrier(0);
        float fin[16];
#pragma unroll
        for (int k = 0; k < 16; ++k) fin[k] = NEG;
#pragma unroll
        for (int i = 0; i < 16; ++i)
#pragma unroll
            for (int j = 0; j < 16; ++j) if ((i + 1) * (j + 1) <= 16) { const float sm = TA[i] + TB[j]; ins16(fin, __builtin_bit_cast(float, (__builtin_bit_cast(unsigned, sm) & ~0xFFu) | (unsigned)(i * 16 + j))); }
        float e[16], den = 0.f;
#pragma unroll
        for (int k = 0; k < 16; ++k) { e[k] = __expf(fin[k] - fin[0]); den += e[k]; }
        const float rden = 1.0f / den;
        int oi[8]; float og[8];
#pragma unroll
        for (int kk = 0; kk < 8; ++kk) { const float fv = hh ? fin[8 + kk] : fin[kk]; og[kk] = (hh ? e[8 + kk] : e[kk]) * rden; const unsigned id = __builtin_bit_cast(unsigned, fv) & 0xFFu; const unsigned ci = id >> 4, cj = id & 15u;
            unsigned ia = 0u, ib = 0u;
#pragma unroll
            for (int q = 0; q < 16; ++q) { ia = (ci == (unsigned)q) ? (__builtin_bit_cast(unsigned, TA[q]) & 0x7Fu) : ia; ib = (cj == (unsigned)q) ? (__builtin_bit_cast(unsigned, TB[q]) & 0x7Fu) : ib; }
            oi[kk] = (int)(ia * PNK + ib); }
        int* ip = IDX + (size_t)t * 128 + h * 16 + 8 * hh; float* gp = GW + (size_t)t * 128 + h * 16 + 8 * hh;
        *(u32x4*)ip = (u32x4){(unsigned)oi[0], (unsigned)oi[1], (unsigned)oi[2], (unsigned)oi[3]}; *(u32x4*)(ip + 4) = (u32x4){(unsigned)oi[4], (unsigned)oi[5], (unsigned)oi[6], (unsigned)oi[7]};
        *(f32x4*)gp = (f32x4){og[0], og[1], og[2], og[3]}; *(f32x4*)(gp + 4) = (f32x4){og[4], og[5], og[6], og[7]};
    }
}


__device__ __forceinline__ float ub0(unsigned w) { return (float)(w & 0xffu); }
__device__ __forceinline__ float ub1(unsigned w) { return (float)((w >> 8) & 0xffu); }
__device__ __forceinline__ float ub2(unsigned w) { return (float)((w >> 16) & 0xffu); }
__device__ __forceinline__ float ub3(unsigned w) { return (float)(w >> 24); }
__device__ __forceinline__ float dot16q(u32x4 q, const float (&h)[16]) {
    return ((ub0(q.x) * h[0] + ub1(q.x) * h[1]) + (ub2(q.x) * h[2] + ub3(q.x) * h[3])) + ((ub0(q.y) * h[4] + ub1(q.y) * h[5]) + (ub2(q.y) * h[6] + ub3(q.y) * h[7]))
         + ((ub0(q.z) * h[8] + ub1(q.z) * h[9]) + (ub2(q.z) * h[10] + ub3(q.z) * h[11])) + ((ub0(q.w) * h[12] + ub1(q.w) * h[13]) + (ub2(q.w) * h[14] + ub3(q.w) * h[15]));
}
__device__ __forceinline__ void ph11_gather(ArgsP A, Frame& F) {
    unsigned char* ws = A->ws; const bf16_t* H2 = (const bf16_t*)(ws + WS_H2); const unsigned char* PU = (const unsigned char*)(ws + WS_PU); const unsigned char* PV = (const unsigned char*)(ws + WS_PV);
    const float* PSU = (const float*)(ws + WS_PSU); const float* PSV = (const float*)(ws + WS_PSV);
    const int* IDX = (const int*)(ws + WS_IDX); const float* GW = (const float*)(ws + WS_GW); const float* X1 = (const float*)(ws + WS_X1);
    LAS float* coef = (LAS float*)(F.lds + RING_OFF); LAS int* eidx = (LAS int*)(F.lds + RING_OFF + 1024); LAS float* red = (LAS float*)(F.lds + RING_OFF + 2048);
    const int tid = F.tid, wave = F.wave, lane = F.lane; int par = 0;
    for (int t = F.vcu; t < T; t += F.G, par ^= 1) {
        float hv[4][16]; float hs = 0.f;
#pragma unroll
        for (int i = 0; i < 4; ++i) { const bf16_t* hp = H2 + (size_t)t * D + i * 1024 + lane * 16; f32x4 a, b, c, d; pg8::unpack8(*(const u32x4*)hp, a, b); pg8::unpack8(*(const u32x4*)(hp + 8), c, d);
#pragma unroll
            for (int e = 0; e < 4; ++e) { hv[i][e] = a[e]; hv[i][4 + e] = b[e]; hv[i][8 + e] = c[e]; hv[i][12 + e] = d[e]; }
            hs += ((a[0] + a[1]) + (a[2] + a[3])) + ((b[0] + b[1]) + (b[2] + b[3])) + ((c[0] + c[1]) + (c[2] + c[3])) + ((d[0] + d[1]) + (d[2] + d[3])); }
        hs = wave_sum(hs);
        const int myidx = (lane < 16) ? IDX[(size_t)t * 128 + wave * 16 + lane] : 0; const float myg = (lane < 16) ? GW[(size_t)t * 128 + wave * 16 + lane] : 0.f;
        float dots = 0.f;
#pragma unroll 1
        for (int k = 0; k < 16; k += 4) {
            u32x4 q[4][4];
#pragma unroll
            for (int x = 0; x < 4; ++x) { const int e = __builtin_amdgcn_readlane(myidx, k + x); const unsigned char* up = PU + (size_t)e * D + lane * 16;
#pragma unroll
                for (int i = 0; i < 4; ++i) q[x][i] = *(const u32x4*)(up + i * 1024); }
#pragma unroll
            for (int x = 0; x < 4; ++x) { float d = 0.f;
#pragma unroll
                for (int i = 0; i < 4; ++i) d += dot16q(q[x][i], hv[i]);
                d = wave_sum(d); if (lane == k + x) dots = d; }
        }
        if (lane < 16) { const float s = PSU[myidx] * (dots - 128.0f * hs); const float act = 0.5f * s * (1.0f + erff(s * 0.70710678118654752f));
            coef[par * 128 + wave * 16 + lane] = myg * act * PSV[myidx]; eidx[par * 128 + wave * 16 + lane] = myidx; }
        WG_BAR();
        float acc[8]; float csum = 0.f;
#pragma unroll
        for (int i = 0; i < 8; ++i) acc[i] = 0.f;
#pragma unroll 1
        for (int e = 0; e < 128; e += 8) { u32x2 v[8]; float c[8];
#pragma unroll
            for (int q = 0; q < 8; ++q) { const int ei = __builtin_amdgcn_readfirstlane(eidx[par * 128 + e + q]); c[q] = coef[par * 128 + e + q]; v[q] = *(const u32x2*)(PV + (size_t)ei * D + tid * 8); }
#pragma unroll
            for (int q = 0; q < 8; ++q) { csum += c[q]; acc[0] += c[q] * ub0(v[q].x); acc[1] += c[q] * ub1(v[q].x); acc[2] += c[q] * ub2(v[q].x); acc[3] += c[q] * ub3(v[q].x); acc[4] += c[q] * ub0(v[q].y); acc[5] += c[q] * ub1(v[q].y); acc[6] += c[q] * ub2(v[q].y); acc[7] += c[q] * ub3(v[q].y); } }
        const float corr = -128.0f * csum;
        const f32x4 x0 = *(const f32x4*)(X1 + (size_t)t * D + tid * 8), x1 = *(const f32x4*)(X1 + (size_t)t * D + tid * 8 + 4);
        f32x4 y0 = x0 + ((f32x4){acc[0], acc[1], acc[2], acc[3]} + corr), y1 = x1 + ((f32x4){acc[4], acc[5], acc[6], acc[7]} + corr);
        float ss = (y0[0] * y0[0] + y0[1] * y0[1]) + (y0[2] * y0[2] + y0[3] * y0[3]) + (y1[0] * y1[0] + y1[1] * y1[1]) + (y1[2] * y1[2] + y1[3] * y1[3]);
        ss = wave_sum(ss); if (lane == 0) red[par * 8 + wave] = ss;
        WG_BAR();
        float tot = 0.f;
#pragma unroll
        for (int w = 0; w < 8; ++w) tot += red[par * 8 + w];
        const float rs = 1.0f / sqrtf(tot * (1.0f / D) + NORM_EPS);
        const f32x4 g0 = *(const f32x4*)(A->final_g + tid * 8), g1 = *(const f32x4*)(A->final_g + tid * 8 + 4);
        *(f32x4*)(A->out + (size_t)t * D + tid * 8) = y0 * rs * g0; *(f32x4*)(A->out + (size_t)t * D + tid * 8 + 4) = y1 * rs * g1;
    }
}

constexpr int NPH = 12;
__device__ __forceinline__ Frame make_frame(unsigned char* lds) {
    Frame F; int t = threadIdx.x; asm volatile("" : "+v"(t));
    F.lds = (LAS unsigned char*)lds; F.tid = t; F.lane = t & 63; F.wave = __builtin_amdgcn_readfirstlane(t >> 6);
    F.G = gridDim.x; { const int bx = blockIdx.x; F.vcu = (F.G % 8 == 0) ? (bx % 8) * (F.G / 8) + bx / 8 : bx; }
    return F;
}
__global__ void __launch_bounds__(NTHR, 2) mk_fwd(Args args_by_value) {
    extern __shared__ __attribute__((aligned(16))) unsigned char lds[];
    ArgsP args = get_args();
    gu32* ctl = (gu32*)(args->ws + WS_CTL);
    for (int u = threadIdx.x; u < (LDS_BYTES - LDSCTL_OFF) / 4; u += NTHR) ((LAS unsigned*)((LAS unsigned char*)lds + LDSCTL_OFF))[u] = 0u;
    __syncthreads();
    const int lo = args->ph_lo, hi = args->ph_hi;
    volatile LAS unsigned* MISC = (volatile LAS unsigned*)((LAS unsigned char*)lds + MISC_OFF);
    XcdBarrier bar; bar.bar = (unsigned*)(ctl + CW_BAR) + args->li * XCD_BAR_WORDS; bar.x = 0; bar.st = nullptr;
    if (hi - lo > 1) bar = xcd_barrier_post((unsigned*)(ctl + CW_BAR) + args->li * XCD_BAR_WORDS, MISC + 8);
#define IN(k) (lo <= (k) && (k) < hi)
#define SEAM(k) do { if (IN(k) && IN((k) + 1)) xcd_barrier(bar); } while (0)
    const int bid = (int)blockIdx.x;

    if (IN(0)) { Frame F = make_frame(lds); ph0_prologue(get_args(), F); SEAM(0); }
    if (IN(1)) { Frame F = make_frame(lds); LAS unsigned char* ring = F.lds + RING_OFF; ArgsP a_ = get_args(); unsigned char* ws = a_->ws;
        { pg8::Gemm g{(const bf16_t*)(ws + WS_XN), (const bf16_t*)(ws + WS_WIN), T, PLD, D}; pg8::StaticOrder S; S.init(T, PLD, F.G, bid);
          pg8::EpiProj E{(bf16_t*)(ws + WS_PROJ), (const float*)(ws + WS_ROPE)}; pg8::gemm_phase<pg8::EpiProj, pg8::StaticOrder, true, true>(ring, g, S, E); }
        { pg8::Gemm g{(const bf16_t*)(ws + WS_XN), (const bf16_t*)(ws + WS_WIN) + (size_t)PC_MV * D, T, 2048, D}; pg8::StaticOrder S; S.init(T, 2048, F.G, bid);
          pg8::EpiVT E{(bf16_t*)(ws + WS_VT)}; pg8::gemm_phase<pg8::EpiVT, pg8::StaticOrder, true, true>(ring, g, S, E); }
        { Frame F2 = make_frame(lds); const int rem = ((T / 256) * (PLD / 256)) % F2.G;
          if (rem == 0) peer_quant(get_args(), F2, bid * NWAVES + F2.wave, F2.G * NWAVES);
          else if (bid >= rem) peer_quant(get_args(), F2, (bid - rem) * NWAVES + F2.wave, (F2.G - rem) * NWAVES); }
        SEAM(1); }
    if (IN(2)) { Frame F = make_frame(lds); ph2_prep(get_args(), F); SEAM(2); }
    if (IN(3)) { Frame F = make_frame(lds); LAS unsigned char* ring = F.lds + RING_OFF; ArgsP a_ = get_args(); unsigned char* ws = a_->ws;
        { pg8::Gemm g{(const bf16_t*)(ws + WS_AW), (const bf16_t*)(ws + WS_WUP), T, RW, LW}; pg8::StaticOrder S; S.init(T, RW, F.G, bid);
          pg8::EpiDec E{(float*)(ws + WS_DEC), a_->w0}; pg8::gemm_phase<pg8::EpiDec, pg8::StaticOrder, true, true>(ring, g, S, E); }
        asm volatile("" ::: "memory"); __builtin_amdgcn_sched_barrier(0);
        { pg8::Gemm g{(const bf16_t*)(ws + WS_AA), (const bf16_t*)(ws + WS_AUP), T, RW, LA}; pg8::StaticOrder S; S.init(T, RW, F.G, bid);
          pg8::EpiA E{(bf16_t*)(ws + WS_KP), (bf16_t*)(ws + WS_BB), (const bf16_t*)(ws + WS_KKN), a_->a0, a_->k_a}; pg8::gemm_phase<pg8::EpiA, pg8::StaticOrder, true, true>(ring, g, S, E); }
        asm volatile("" ::: "memory"); __builtin_amdgcn_sched_barrier(0);
        { pg8::Gemm g{(const bf16_t*)(ws + WS_AG), (const bf16_t*)(ws + WS_GUP), T, RW, LGP}; pg8::StaticOrder S; S.init(T, RW, F.G, bid);
          pg8::EpiBf16 E{(bf16_t*)(ws + WS_G), RW}; pg8::gemm_phase<pg8::EpiBf16, pg8::StaticOrder, true, true>(ring, g, S, E); }
        { Frame F2 = make_frame(lds); ph3_gate(get_args(), F2); }
        SEAM(3); }
    if (IN(4)) {
        Frame F = make_frame(lds); const int nscan = F.G / 2;
        if (F.vcu < nscan) ph4_scan(get_args(), F, F.vcu, nscan);
        else { ph5_attn(get_args(), F, F.vcu - nscan, F.G - nscan); Frame F2 = make_frame(lds); late_weights(get_args(), F2, (F2.vcu - nscan) * NWAVES + F2.wave, (F2.G - nscan) * NWAVES); }
        SEAM(4); }
    if (IN(5)) { Frame F = make_frame(lds); ph5_ypost(get_args(), F); SEAM(5); }
    if (IN(6)) { Frame F = make_frame(lds); LAS unsigned char* ring = F.lds + RING_OFF; ArgsP a_ = get_args(); unsigned char* ws = a_->ws;
        { pg8::Gemm g{(const bf16_t*)(ws + WS_YA), (const bf16_t*)(ws + WS_WA), T, D, RW}; pg8::StaticOrder S; S.init(T, D, F.G, bid);
          pg8::EpiMix<false> E{(bf16_t*)(ws + WS_MIXED), (const bf16_t*)(ws + WS_PROJ), PC_GA}; pg8::gemm_phase<pg8::EpiMix<false>, pg8::StaticOrder, true, true>(ring, g, S, E); }
        { pg8::Gemm g{(const bf16_t*)(ws + WS_YB), (const bf16_t*)(ws + WS_WB), T, D, RW}; pg8::StaticOrder S; S.init(T, D, F.G, bid);
          pg8::EpiMix<true> E{(bf16_t*)(ws + WS_MIXED), (const bf16_t*)(ws + WS_PROJ), PC_GB}; pg8::gemm_phase<pg8::EpiMix<true>, pg8::StaticOrder, true, true>(ring, g, S, E); }
        SEAM(6); }
    if (IN(7)) { Frame F = make_frame(lds); LAS unsigned char* ring = F.lds + RING_OFF; ArgsP a_ = get_args(); unsigned char* ws = a_->ws;
        pg8::Gemm g{(const bf16_t*)(ws + WS_MIXED), (const bf16_t*)(ws + WS_WOUT), T, D, D}; pg8::StaticOrder S; S.init(T, D, F.G, bid);
        pg8::EpiRes E{(float*)(ws + WS_X1), a_->x}; pg8::gemm_phase<pg8::EpiRes, pg8::StaticOrder, true, true>(ring, g, S, E);
        SEAM(7); }
    if (IN(8)) { Frame F = make_frame(lds); ArgsP a_ = get_args(); unsigned char* ws = a_->ws; const int gw = F.vcu * NWAVES + F.wave, NGW = F.G * NWAVES;
        for (int m = gw; m < T; m += NGW) rms_row_to_bf16((const float*)(ws + WS_X1) + (size_t)m * D, a_->norm2_g, (bf16_t*)(ws + WS_H2) + (size_t)m * D, F.lane);
        SEAM(8); }
    if (IN(9)) { Frame F = make_frame(lds); LAS unsigned char* ring = F.lds + RING_OFF; ArgsP a_ = get_args(); unsigned char* ws = a_->ws;
        pg8::Gemm g{(const bf16_t*)(ws + WS_H2), (const bf16_t*)(ws + WS_WQ), T, 2048, D}; pg8::StaticOrder S; S.init(T, 2048, F.G, bid);
        pg8::EpiBf16 E{(bf16_t*)(ws + WS_PQ), 2048}; pg8::gemm_phase<pg8::EpiBf16, pg8::StaticOrder, true, true>(ring, g, S, E);
        SEAM(9); }
    if (IN(10)) { Frame F = make_frame(lds); ph10_select(get_args(), F); SEAM(10); }
    if (IN(11)) { Frame F = make_frame(lds); ph11_gather(get_args(), F); }
#undef IN
#undef SEAM
}

extern "C" void kernel_launch(void* const* d_in, const int* in_sizes, int n_in, void* d_out, int out_size, void* d_ws, size_t ws_size, hipStream_t stream) {
    static int grid = 0;
    if (grid == 0) {
        if (n_in != 23 || out_size != T * D || ws_size < WS_END) { fprintf(stderr, "kernel_launch: unexpected shapes (n_in %d out %d ws %zu); nothing launched\n", n_in, out_size, ws_size); grid = -1; return; }
        int dev = 0, cus = 0, per_cu = 0;
        if (hipGetDevice(&dev) != hipSuccess || hipDeviceGetAttribute(&cus, hipDeviceAttributeMultiprocessorCount, dev) != hipSuccess) { grid = -1; return; }
        if (hipFuncSetAttribute((const void*)mk_fwd, hipFuncAttributeMaxDynamicSharedMemorySize, LDS_BYTES) != hipSuccess) { grid = -1; return; }
        if (hipOccupancyMaxActiveBlocksPerMultiprocessor(&per_cu, (const void*)mk_fwd, NTHR, LDS_BYTES) != hipSuccess || per_cu < 1) fprintf(stderr, "kernel_launch: occupancy query reports %d\n", per_cu);
        (void)hipGetLastError();
        grid = cus;
    }
    if (grid < 0) return;
    (void)hipMemsetAsync((char*)d_ws + WS_CTL, 0, CTL_ZERO_BYTES, stream);
    Args a{};
    const float** ap = (const float**)&a;
    for (int i = 0; i < 23; ++i) ap[i] = (const float*)d_in[i];
    a.out = (float*)d_out; a.ws = (unsigned char*)d_ws; a.pad = 0;
    constexpr int NL = MK_N_LAUNCHES;
    for (int li = 0; li < NL; ++li) {
        a.ph_lo = (NL == 1) ? 0 : li; a.ph_hi = (NL == 1) ? NPH : li + 1; a.li = (NL == 1) ? 0 : 0;
        hipLaunchKernelGGL(mk_fwd, dim3(grid), dim3(NTHR), LDS_BYTES, stream, a);
#ifdef DUP_HI
        if (NL > 1 && li == DUP_HI) for (int l2 = DUP_LO; l2 <= DUP_HI; ++l2) { a.ph_lo = l2; a.ph_hi = l2 + 1; hipLaunchKernelGGL(mk_fwd, dim3(grid), dim3(NTHR), LDS_BYTES, stream, a); }
#endif
    }
}
```

```cpp
#include <hip/hip_runtime.h>
#include <cstdio>
#include <cstdint>

#ifndef MK_N_LAUNCHES
#define MK_N_LAUNCHES 1
#endif

#define GAS __attribute__((address_space(1)))
#define LAS __attribute__((address_space(3)))
typedef unsigned short bf16_t;
typedef __bf16 bf16x8 __attribute__((ext_vector_type(8)));
typedef float f32x2 __attribute__((ext_vector_type(2)));
typedef float f32x4 __attribute__((ext_vector_type(4)));
typedef float f32x16 __attribute__((ext_vector_type(16)));
typedef unsigned u32x2 __attribute__((ext_vector_type(2)));
typedef unsigned u32x4 __attribute__((ext_vector_type(4)));
typedef GAS unsigned gu32;

constexpr int T = 8192, D = 4096;
constexpr int RW = 2048, RH = 32, RN = 64;
constexpr int LW = 128, LA = 128, LG = 480, LGP = 512;
constexpr int SHIFTW = 6880;
constexpr int MH = 16, MD = 128, MBLK = 256, NBLK = 32;
constexpr int INW = 21216;
constexpr int PLD = 19200;
constexpr int PC_R = 0, PC_K = 2048, PC_V = 4096, PC_WL = 6144, PC_AL = 6272, PC_GL = 6400, PC_MQ = 6912, PC_MK = 8960, PC_GA = 11008, PC_GB = 15104, PC_MV = 19200;
constexpr int WIN_ROWS = 21248;
constexpr int PH_ = 8, PNK = 128, PQD = 256, PHALF = 128, PTOPK = 16;
constexpr float NORM_EPS = 1e-6f, LNX_EPS = 64e-5f;
constexpr float QSCALE = 0.08838834764831845f * 1.4426950408889634f;

constexpr size_t MiB = 1u << 20;
constexpr size_t WS_CTL = 0, CTL_ZERO_BYTES = 1 * MiB;
constexpr size_t WS_WIN = 1 * MiB;
constexpr size_t WS_X1 = 1 * MiB, WS_PQ = 129 * MiB;
constexpr size_t WS_WA = 167 * MiB, WS_WB = 183 * MiB, WS_WOUT = 199 * MiB, WS_WQ = 231 * MiB, WS_WUP = 247 * MiB, WS_AUP = 248 * MiB, WS_GUP = 249 * MiB, WS_SUBK = 251 * MiB;
constexpr size_t WS_PU = 252 * MiB, WS_PV = 380 * MiB;
constexpr size_t WS_XN = 508 * MiB;
constexpr size_t WS_Y = 508 * MiB, WS_H2 = 508 * MiB;
constexpr size_t WS_PROJ = 572 * MiB;
constexpr size_t WS_VT = 872 * MiB;
constexpr size_t WS_ROPE = 904 * MiB, WS_KMEAN = 908 * MiB, WS_MASK = 909 * MiB, WS_AW = 910 * MiB, WS_AA = 912 * MiB, WS_AG = 914 * MiB;
constexpr size_t WS_PSU = 909 * MiB + 512 * 1024, WS_PSV = WS_PSU + 64 * 1024;
constexpr size_t WS_DEC = 922 * MiB;
constexpr size_t WS_MIXED = 922 * MiB;
constexpr size_t WS_KKN = 986 * MiB, WS_BB = 1018 * MiB, WS_KP = 1050 * MiB, WS_ZR = 1082 * MiB, WS_ZV = 1114 * MiB, WS_G = 1146 * MiB;
constexpr size_t WS_YA = 1178 * MiB, WS_YB = 1210 * MiB, WS_IDX = 1242 * MiB, WS_GW = 1246 * MiB, WS_Z = 1250 * MiB, WS_SINIT = 1266 * MiB, WS_END = 1267 * MiB;

constexpr int CW_TMO = 0, CW_CODE = 1, CW_BAR = 4096;

constexpr int RING_OFF = 0, RING_BYTES = 155648;
constexpr int LDSCTL_OFF = RING_BYTES, MISC_OFF = LDSCTL_OFF + 320;
constexpr int LDS_BYTES = 163840;
constexpr int NWAVES = 8, NTHR = 512;

__device__ __forceinline__ unsigned f2bf(float f) { unsigned u = __builtin_bit_cast(unsigned, f); return (u + 0x7fffu + ((u >> 16) & 1u)) >> 16; }
__device__ __forceinline__ unsigned pk2(float lo, float hi) { unsigned r; asm volatile("v_cvt_pk_bf16_f32 %0, %1, %2" : "=v"(r) : "v"(lo), "v"(hi)); return r; }
__device__ __forceinline__ float bflo(unsigned u) { return __builtin_bit_cast(float, u << 16); }
__device__ __forceinline__ float bfhi(unsigned u) { return __builtin_bit_cast(float, u & 0xffff0000u); }
__device__ __forceinline__ float bf1(bf16_t b) { return __builtin_bit_cast(float, (unsigned)b << 16); }
__device__ __forceinline__ float fsigmoid(float x) { return __builtin_amdgcn_rcpf(1.0f + __expf(-x)); }
__device__ __forceinline__ float wave_sum(float v) {
#pragma unroll
    for (int o = 1; o < 64; o <<= 1) v += __shfl_xor(v, o);
    return v;
}
template <int CTRL> __device__ __forceinline__ float dpp_f(float v) { return __builtin_bit_cast(float, __builtin_amdgcn_update_dpp(0, __builtin_bit_cast(int, v), CTRL, 0xF, 0xF, true)); }
__device__ __forceinline__ float sum16(float x) {
    x += dpp_f<0xB1>(x); x += dpp_f<0x4E>(x); x += dpp_f<0x141>(x); x += dpp_f<0x140>(x); return x;
}
__device__ __forceinline__ float vmul(float a, float b) { float r; asm("v_mul_f32_e32 %0, %1, %2" : "=v"(r) : "v"(a), "v"(b)); return r; }
__device__ __forceinline__ float vfma(float a, float b, float c) { float r; asm("v_fma_f32 %0, %1, %2, %3" : "=v"(r) : "v"(a), "v"(b), "v"(c)); return r; }
#define LDS_WAIT() asm volatile("s_waitcnt lgkmcnt(0)" ::: "memory")
#define VM_WAIT() asm volatile("s_waitcnt vmcnt(0)" ::: "memory")
#define WG_BAR() do { asm volatile("s_waitcnt lgkmcnt(0)" ::: "memory"); __builtin_amdgcn_s_barrier(); asm volatile("" ::: "memory"); } while (0)

namespace pg8 {
constexpr int BM = 256, BK = 64, HALF = 128, HTB = HALF * BK * 2, STAGE_BYTES = 8 * HTB, NXCD = 8, WGM = 8;
__host__ __device__ __forceinline__ int lds_byte(int r, int c) { const int st = (r >> 4) * 2 + (c >> 5), rr = r & 15, cc = c & 31, ob = rr * 64 + cc * 2; return st * 1024 + (ob ^ (((ob >> 9) & 1) << 5)); }
__host__ __device__ __forceinline__ void stage_rc(int b, int& R, int& C) { const int st = b / 1024, sb = b % 1024, swz = sb ^ (((sb >> 9) & 1) << 5); R = (st >> 1) * 16 + swz / 64; C = (st & 1) * 32 + (swz % 64) / 2; }
__host__ __device__ __forceinline__ int perm32(int rho) { const int n = rho >> 4, i = rho & 15; return 8 * (i >> 2) + 4 * n + (i & 3); }

struct Unit { int pm, pn; };
struct Gemm { const bf16_t* A; const bf16_t* Bt; int M, N, K; };

struct StaticOrder {
    int nM, nN, nwg, G, c;
    __host__ __device__ void init(int M, int N, int G_, int c_) { nM = M / BM; nN = N / BM; nwg = nM * nN; G = G_; c = c_; }
    __host__ __device__ bool next(int i, Unit& u) const {
        const long L = (long)i * G + c; if (L >= nwg) return false;
        int wgid = (int)L; { const int q = nwg / NXCD, r = nwg % NXCD, xcd = wgid % NXCD, off = wgid / NXCD; wgid = (xcd < r ? xcd * (q + 1) : r * (q + 1) + (xcd - r) * q) + off; }
        const int nig = WGM * nN, gid = wgid / nig, fm = gid * WGM, gsz = (nM - fm) < WGM ? (nM - fm) : WGM;
        u.pm = fm + ((wgid % nig) % gsz); u.pn = (wgid % nig) / gsz; return true;
    }
    __device__ __forceinline__ void a_ready(const Unit&) const {}
    __device__ __forceinline__ void done(const Unit&) const {}
};

template <class Epi, class Sched, bool ALIGN_EPI = false, bool SP2 = false>
__device__ __forceinline__ void gemm_phase(LAS unsigned char* lds, const Gemm g, const Sched& S, const Epi& E) {
    int tid_ = threadIdx.x; asm volatile("" : "+v"(tid_));
    const int tid = tid_, wid = __builtin_amdgcn_readfirstlane(tid >> 6), lane = tid & 63, wr = wid >> 2, wc = wid & 3, fr = lane & 15, fq = lane >> 4;
    int K_ = g.K; asm volatile("" : "+s"(K_));
    const int K = K_, nt = K / BK;
    unsigned voffA[2], voffB[2];
#pragma unroll
    for (int i = 0; i < 2; ++i) { int R, C; stage_rc(tid * 16 + i * 8192, R, C); const int Rb = Epi::PERM ? ((R & ~31) + perm32(R & 31)) : R;
        voffA[i] = (unsigned)(R * K + C) * 2u; voffB[i] = (unsigned)(Rb * K + C) * 2u; }
    const size_t kstep = (size_t)(BK * 2);
    const size_t hstep = (size_t)HALF * K * 2;
    const size_t tstep = 2 * hstep;
    const unsigned ldsw = (unsigned)wid * 1024u;
    const int aoff = lds_byte(wr * 64 + fr, fq * 8), boff = lds_byte(wc * 32 + fr, fq * 8);
#define PG8_SA(b, h) (((b) * 2 + (h)) * HTB)
#define PG8_SB(b, h) ((4 + (b) * 2 + (h)) * HTB)
#define PG8_STAGE(bufoff, gbase, voff) do { _Pragma("unroll") for (int _i = 0; _i < 2; ++_i) \
        __builtin_amdgcn_global_load_lds((const unsigned*)((const char*)(gbase) + (voff)[_i]), (LAS unsigned*)(lds + (bufoff) + ldsw + _i * 8192), 16, 0, 0); } while (0)
#define PG8_LDA(dst, b, h) do { _Pragma("unroll") for (int m = 0; m < 4; ++m) _Pragma("unroll") for (int k = 0; k < 2; ++k) dst[m][k] = *(const LAS bf16x8*)(lds + PG8_SA(b, h) + aoff + m * 2048 + k * 1024); } while (0)
#define PG8_LDB(dst, b, h) do { _Pragma("unroll") for (int n = 0; n < 2; ++n) _Pragma("unroll") for (int k = 0; k < 2; ++k) dst[n][k] = *(const LAS bf16x8*)(lds + PG8_SB(b, h) + boff + n * 2048 + k * 1024); } while (0)
#define PG8_MMA(ai, bj, At, Bt) do { __builtin_amdgcn_s_setprio(1); _Pragma("unroll") for (int m = 0; m < 4; ++m) _Pragma("unroll") for (int n = 0; n < 2; ++n) _Pragma("unroll") for (int k = 0; k < 2; ++k) { \
        if constexpr (Epi::SWAP) acc[ai][bj][m][n] = __builtin_amdgcn_mfma_f32_16x16x32_bf16(At[m][k], Bt[n][k], acc[ai][bj][m][n], 0, 0, 0); \
        else acc[ai][bj][m][n] = __builtin_amdgcn_mfma_f32_16x16x32_bf16(Bt[n][k], At[m][k], acc[ai][bj][m][n], 0, 0, 0); } __builtin_amdgcn_s_setprio(0); } while (0)
#define PG8_WAIT_V(n) asm volatile("s_waitcnt vmcnt(" #n ")" ::: "memory")
#define PG8_WAIT_L(n) asm volatile("s_waitcnt lgkmcnt(" #n ")" ::: "memory")
#define PG8_BAR __builtin_amdgcn_s_barrier()
#define PG8_SCHED __builtin_amdgcn_sched_barrier(0)
    Unit cur, nxt; int ui = 0;
    if (!S.next(0, cur)) return;
    f32x4 acc[2][2][4][2];
#pragma unroll
    for (int a = 0; a < 2; ++a)
#pragma unroll
        for (int b = 0; b < 2; ++b)
#pragma unroll
            for (int m = 0; m < 4; ++m)
#pragma unroll
                for (int n = 0; n < 2; ++n) acc[a][b][m][n] = (f32x4){0.f, 0.f, 0.f, 0.f};
    bf16x8 At[4][2], B0[2][2], B1[2][2];
    const char* cA = (const char*)g.A + (size_t)cur.pm * tstep; const char* cB = (const char*)g.Bt + (size_t)cur.pn * tstep;
    S.a_ready(cur);
    if constexpr (SP2) {
        PG8_STAGE(PG8_SB(0, 0), cB, voffB); PG8_STAGE(PG8_SB(0, 1), cB + hstep, voffB); PG8_STAGE(PG8_SA(0, 0), cA, voffA); PG8_STAGE(PG8_SA(0, 1), cA + hstep, voffA);
        if (wr == 1) PG8_BAR;
        PG8_WAIT_V(2); PG8_BAR;
        PG8_STAGE(PG8_SB(1, 0), cB + kstep, voffB); PG8_STAGE(PG8_SA(1, 0), cA + kstep, voffA); PG8_STAGE(PG8_SB(1, 1), cB + hstep + kstep, voffB);
        PG8_WAIT_V(6); PG8_BAR;
    } else {
        PG8_STAGE(PG8_SB(0, 0), cB, voffB); PG8_STAGE(PG8_SA(0, 0), cA, voffA); PG8_STAGE(PG8_SB(0, 1), cB + hstep, voffB); PG8_STAGE(PG8_SA(0, 1), cA + hstep, voffA);
        if (wr == 1) PG8_BAR;
        PG8_WAIT_V(4); PG8_BAR;
        PG8_STAGE(PG8_SB(1, 0), cB + kstep, voffB); PG8_STAGE(PG8_SA(1, 0), cA + kstep, voffA); PG8_STAGE(PG8_SB(1, 1), cB + hstep + kstep, voffB);
        PG8_WAIT_V(6); PG8_BAR;
    }
    for (;;) {
        const bool has_next = S.next(ui + 1, nxt);
        const char* nA = has_next ? (const char*)g.A + (size_t)nxt.pm * tstep : cA; const char* nB = has_next ? (const char*)g.Bt + (size_t)nxt.pn * tstep : cB;
        for (int t = 0; t < nt; t += 2) {
            const bool last = (t == nt - 2);
            const char* a1 = cA + (size_t)(t + 1) * kstep;
            const char* a2 = last ? nA : cA + (size_t)(t + 2) * kstep; const char* b2 = last ? nB : cB + (size_t)(t + 2) * kstep;
            const char* a3 = a2 + kstep; const char* b3 = b2 + kstep;
            if (last && has_next) S.a_ready(nxt);
            if constexpr (SP2) {
            PG8_LDB(B0, 0, 0); PG8_LDB(B1, 0, 1); PG8_SCHED; PG8_LDA(At, 0, 0); PG8_STAGE(PG8_SA(1, 1), a1 + hstep, voffA);
            PG8_WAIT_V(8); PG8_WAIT_L(0); PG8_BAR; PG8_MMA(0, 0, At, B0); PG8_MMA(0, 1, At, B1); PG8_BAR; PG8_SCHED;
            PG8_LDA(At, 0, 1); PG8_STAGE(PG8_SB(0, 0), b2, voffB); PG8_STAGE(PG8_SB(0, 1), b2 + hstep, voffB); PG8_STAGE(PG8_SA(0, 0), a2, voffA);
            PG8_WAIT_V(8); PG8_WAIT_L(0); PG8_BAR; PG8_MMA(1, 0, At, B0); PG8_MMA(1, 1, At, B1); PG8_BAR; PG8_SCHED;
            PG8_LDB(B0, 1, 0); PG8_LDB(B1, 1, 1); PG8_SCHED; PG8_LDA(At, 1, 0); PG8_STAGE(PG8_SA(0, 1), a2 + hstep, voffA);
            PG8_WAIT_V(8); PG8_WAIT_L(0); PG8_BAR; PG8_MMA(0, 0, At, B0); PG8_MMA(0, 1, At, B1); PG8_BAR; PG8_SCHED;
            PG8_LDA(At, 1, 1); PG8_STAGE(PG8_SB(1, 0), b3, voffB); PG8_STAGE(PG8_SB(1, 1), b3 + hstep, voffB); PG8_STAGE(PG8_SA(1, 0), a3, voffA);
            PG8_WAIT_V(8); PG8_WAIT_L(0); PG8_BAR; PG8_MMA(1, 0, At, B0); PG8_MMA(1, 1, At, B1); PG8_BAR; PG8_SCHED;
            } else {
            PG8_LDB(B0, 0, 0); PG8_SCHED; PG8_LDA(At, 0, 0); PG8_STAGE(PG8_SA(1, 1), a1 + hstep, voffA);
            PG8_WAIT_L(8); PG8_BAR; PG8_WAIT_L(0); PG8_MMA(0, 0, At, B0); PG8_BAR; PG8_SCHED;
            PG8_LDB(B1, 0, 1); PG8_STAGE(PG8_SB(0, 0), b2, voffB);
            PG8_BAR; PG8_WAIT_L(0); PG8_MMA(0, 1, At, B1); PG8_BAR;
            PG8_LDA(At, 0, 1); PG8_STAGE(PG8_SA(0, 0), a2, voffA);
            PG8_BAR; PG8_WAIT_L(0); PG8_MMA(1, 0, At, B0); PG8_BAR; PG8_SCHED;
            PG8_STAGE(PG8_SB(0, 1), b2 + hstep, voffB);
            PG8_WAIT_V(6); PG8_BAR; PG8_MMA(1, 1, At, B1); PG8_BAR;
            PG8_LDB(B0, 1, 0); PG8_SCHED; PG8_LDA(At, 1, 0); PG8_STAGE(PG8_SA(0, 1), a2 + hstep, voffA);
            PG8_WAIT_L(8); PG8_BAR; PG8_WAIT_L(0); PG8_MMA(0, 0, At, B0); PG8_BAR; PG8_SCHED;
            PG8_LDB(B1, 1, 1); PG8_STAGE(PG8_SB(1, 0), b3, voffB);
            PG8_BAR; PG8_WAIT_L(0); PG8_MMA(0, 1, At, B1); PG8_BAR;
            PG8_LDA(At, 1, 1); PG8_STAGE(PG8_SA(1, 0), a3, voffA);
            PG8_BAR; PG8_WAIT_L(0); PG8_MMA(1, 0, At, B0); PG8_BAR; PG8_SCHED;
            PG8_STAGE(PG8_SB(1, 1), b3 + hstep, voffB);
            PG8_WAIT_V(6); PG8_BAR; PG8_MMA(1, 1, At, B1); PG8_BAR;
            }
        }
        if constexpr (ALIGN_EPI) { if (wr == 0) PG8_BAR; }
        E(acc, cur, wr, wc, fr, fq); S.done(cur);
        if (!has_next) break;
#pragma unroll
        for (int a = 0; a < 2; ++a)
#pragma unroll
            for (int b = 0; b < 2; ++b)
#pragma unroll
                for (int m = 0; m < 4; ++m)
#pragma unroll
                    for (int n = 0; n < 2; ++n) acc[a][b][m][n] = (f32x4){0.f, 0.f, 0.f, 0.f};
        cur = nxt; cA = nA; cB = nB; ++ui;
        if constexpr (ALIGN_EPI) { if (wr == 1) PG8_BAR; }
    }
    PG8_WAIT_V(0);
    if constexpr (!ALIGN_EPI) { if (wr == 0) PG8_BAR; }
    PG8_BAR;
#undef PG8_SA
#undef PG8_SB
#undef PG8_STAGE
#undef PG8_LDA
#undef PG8_LDB
#undef PG8_MMA
#undef PG8_WAIT_V
#undef PG8_WAIT_L
#undef PG8_BAR
#undef PG8_SCHED
}

typedef const f32x4 (&AccRef)[2][2][4][2];
__device__ __forceinline__ u32x4 pack8(f32x4 v0, f32x4 v1) { u32x4 w; w.x = pk2(v0[0], v0[1]); w.y = pk2(v0[2], v0[3]); w.z = pk2(v1[0], v1[1]); w.w = pk2(v1[2], v1[3]); return w; }
__device__ __forceinline__ void unpack8(u32x4 w, f32x4& v0, f32x4& v1) { v0 = (f32x4){bflo(w.x), bfhi(w.x), bflo(w.y), bfhi(w.y)}; v1 = (f32x4){bflo(w.z), bfhi(w.z), bflo(w.w), bfhi(w.w)}; }

struct EpiBf16 {
    static constexpr bool PERM = true, SWAP = false;
    bf16_t* O; int ldc;
    __device__ __forceinline__ void operator()(AccRef acc, const Unit& u, int wr, int wc, int fr, int fq) const {
        const int row0 = u.pm * BM + wr * 64 + fr, col0 = u.pn * BM + wc * 32 + 8 * fq;
#pragma unroll
        for (int ai = 0; ai < 2; ++ai)
#pragma unroll
            for (int m = 0; m < 4; ++m) { bf16_t* rowp = O + (size_t)(row0 + ai * HALF + m * 16) * ldc + col0;
#pragma unroll
                for (int bj = 0; bj < 2; ++bj) *(u32x4*)(rowp + bj * HALF) = pack8(acc[ai][bj][m][0], acc[ai][bj][m][1]); }
    }
};
struct EpiProj {
    static constexpr bool PERM = true, SWAP = false;
    bf16_t* O; const float* rope;
    __device__ __forceinline__ void operator()(AccRef acc, const Unit& u, int wr, int wc, int fr, int fq) const {
        const int row0 = u.pm * BM + wr * 64 + fr, col0 = u.pn * BM + wc * 32 + 8 * fq;
        const int mode = (u.pn >= 27 && u.pn < 43) ? (u.pn < 35 ? 1 : 2) : 0;
        const float sc = (mode == 1) ? QSCALE : 1.0f;
#pragma unroll
        for (int ai = 0; ai < 2; ++ai)
#pragma unroll
            for (int m = 0; m < 4; ++m) { const int row = row0 + ai * HALF + m * 16; bf16_t* rowp = O + (size_t)row * PLD + col0;
#pragma unroll
                for (int bj = 0; bj < 2; ++bj) { f32x4 v0 = acc[ai][bj][m][0], v1 = acc[ai][bj][m][1];
                    if (mode) { const int i0 = ((col0 + bj * HALF) & 127) >> 1; const f32x4* rp = (const f32x4*)(rope + ((size_t)row * 64 + i0) * 2); const f32x4 c0 = rp[0], c1 = rp[1];
                        f32x4 o0, o1;
                        o0[0] = v0[0] * c0[0] - v0[1] * c0[1]; o0[1] = v0[1] * c0[0] + v0[0] * c0[1]; o0[2] = v0[2] * c0[2] - v0[3] * c0[3]; o0[3] = v0[3] * c0[2] + v0[2] * c0[3];
                        o1[0] = v1[0] * c1[0] - v1[1] * c1[1]; o1[1] = v1[1] * c1[0] + v1[0] * c1[1]; o1[2] = v1[2] * c1[2] - v1[3] * c1[3]; o1[3] = v1[3] * c1[2] + v1[2] * c1[3];
                        v0 = o0 * sc; v1 = o1 * sc; }
                    *(u32x4*)(rowp + bj * HALF) = pack8(v0, v1); } }
    }
};
struct EpiVT {
    static constexpr bool PERM = false, SWAP = true;
    bf16_t* VT;
    __device__ __forceinline__ void operator()(AccRef acc, const Unit& u, int wr, int wc, int fr, int fq) const {
        const int tok0 = u.pm * BM + wr * 64 + 4 * fq, col0 = u.pn * BM + wc * 32 + fr;
#pragma unroll
        for (int ai = 0; ai < 2; ++ai)
#pragma unroll
            for (int m = 0; m < 4; ++m)
#pragma unroll
                for (int bj = 0; bj < 2; ++bj)
#pragma unroll
                    for (int n = 0; n < 2; ++n) { const f32x4 v = acc[ai][bj][m][n]; u32x2 w; w.x = pk2(v[0], v[1]); w.y = pk2(v[2], v[3]);
                        *(u32x2*)(VT + (size_t)(col0 + bj * HALF + n * 16) * T + tok0 + ai * HALF + m * 16) = w; }
    }
};
struct EpiDec {
    static constexpr bool PERM = true, SWAP = false;
    float* O; const float* w0;
    __device__ __forceinline__ void operator()(AccRef acc, const Unit& u, int wr, int wc, int fr, int fq) const {
        const int row0 = u.pm * BM + wr * 64 + fr, col0 = u.pn * BM + wc * 32 + 8 * fq;
#pragma unroll
        for (int bj = 0; bj < 2; ++bj) { const f32x4 b0 = *(const f32x4*)(w0 + col0 + bj * HALF), b1 = *(const f32x4*)(w0 + col0 + bj * HALF + 4);
#pragma unroll
            for (int ai = 0; ai < 2; ++ai)
#pragma unroll
                for (int m = 0; m < 4; ++m) { float* rowp = O + (size_t)(row0 + ai * HALF + m * 16) * RW + col0 + bj * HALF;
#pragma unroll
                    for (int n = 0; n < 2; ++n) { const f32x4 x = acc[ai][bj][m][n] + (n ? b1 : b0); f32x4 o;
#pragma unroll
                        for (int e = 0; e < 4; ++e) { const float z = -x[e]; const float sp = fmaxf(z, 0.f) + __logf(1.0f + __expf(-fabsf(z))); o[e] = __expf(-__expf(-sp - 0.5f)); }
                        *(f32x4*)(rowp + 4 * n) = o; }
                    asm volatile("" ::: "memory"); } }
    }
};
struct EpiA {
    static constexpr bool PERM = true, SWAP = false;
    bf16_t* KP; bf16_t* BB; const bf16_t* KKN; const float* a0; const float* k_a;
    __device__ __forceinline__ void operator()(AccRef acc, const Unit& u, int wr, int wc, int fr, int fq) const {
        const int row0 = u.pm * BM + wr * 64 + fr, col0 = u.pn * BM + wc * 32 + 8 * fq;
#pragma unroll
        for (int bj = 0; bj < 2; ++bj) { const int cb = col0 + bj * HALF;
            const f32x4 b0 = *(const f32x4*)(a0 + cb), b1 = *(const f32x4*)(a0 + cb + 4), ka0 = *(const f32x4*)(k_a + cb), ka1 = *(const f32x4*)(k_a + cb + 4);
#pragma unroll
            for (int ai = 0; ai < 2; ++ai)
#pragma unroll
                for (int m = 0; m < 4; ++m) { const size_t off = (size_t)(row0 + ai * HALF + m * 16) * RW + cb;
                    f32x4 zk0, zk1, kn0, kn1; unpack8(*(const u32x4*)(KP + off), zk0, zk1); unpack8(*(const u32x4*)(KKN + off), kn0, kn1);
                    f32x4 a0v, a1v;
#pragma unroll
                    for (int e = 0; e < 4; ++e) { a0v[e] = fsigmoid(acc[ai][bj][m][0][e] + b0[e]); a1v[e] = fsigmoid(acc[ai][bj][m][1][e] + b1[e]); }
                    const f32x4 kp0 = zk0 * (1.0f + (a0v - 1.0f) * ka0), kp1 = zk1 * (1.0f + (a1v - 1.0f) * ka1);
                    *(u32x4*)(KP + off) = pack8(kp0, kp1); *(u32x4*)(BB + off) = pack8(-(kn0 * a0v), -(kn1 * a1v));
                    asm volatile("" ::: "memory"); } }
    }
};
template <bool ADD> struct EpiMix {
    static constexpr bool PERM = true, SWAP = false;
    bf16_t* O; const bf16_t* proj; int gcol0;
    __device__ __forceinline__ void operator()(AccRef acc, const Unit& u, int wr, int wc, int fr, int fq) const {
        const int row0 = u.pm * BM + wr * 64 + fr, col0 = u.pn * BM + wc * 32 + 8 * fq;
#pragma unroll
        for (int ai = 0; ai < 2; ++ai)
#pragma unroll
            for (int m = 0; m < 4; ++m) { const int row = row0 + ai * HALF + m * 16;
#pragma unroll
                for (int bj = 0; bj < 2; ++bj) { f32x4 g0, g1; unpack8(*(const u32x4*)(proj + (size_t)row * PLD + gcol0 + col0 + bj * HALF), g0, g1);
                    f32x4 o0, o1;
#pragma unroll
                    for (int e = 0; e < 4; ++e) { o0[e] = fsigmoid(g0[e]) * acc[ai][bj][m][0][e]; o1[e] = fsigmoid(g1[e]) * acc[ai][bj][m][1][e]; }
                    bf16_t* op = O + (size_t)row * D + col0 + bj * HALF;
                    if (ADD) { f32x4 p0, p1; unpack8(*(const u32x4*)op, p0, p1); o0 += p0; o1 += p1; }
                    *(u32x4*)op = pack8(o0, o1); } }
    }
};
struct EpiRes {
    static constexpr bool PERM = true, SWAP = false;
    float* O; const float* x;
    __device__ __forceinline__ void operator()(AccRef acc, const Unit& u, int wr, int wc, int fr, int fq) const {
        const int row0 = u.pm * BM + wr * 64 + fr, col0 = u.pn * BM + wc * 32 + 8 * fq;
#pragma unroll
        for (int ai = 0; ai < 2; ++ai)
#pragma unroll
            for (int m = 0; m < 4; ++m) { const size_t off = (size_t)(row0 + ai * HALF + m * 16) * D + col0;
#pragma unroll
                for (int bj = 0; bj < 2; ++bj)
#pragma unroll
                    for (int n = 0; n < 2; ++n) *(f32x4*)(O + off + bj * HALF + 4 * n) = *(const f32x4*)(x + off + bj * HALF + 4 * n) + acc[ai][bj][m][n]; }
    }
};
}

#define XB_TMO      128
#define XB_XCNT(j)  (256  + 64 * (j))
#define XB_XSUB(j)  (1280 + 64 * (j))
#define XB_XGEN(j)  (2304 + 64 * (j))
#define XB_TOP      3328
#define XB_TOPGEN   3392
#define XCD_BAR_WORDS 3456
#define XB_SPIN_CAP (1u << 18)
__device__ __forceinline__ unsigned xb_ld(unsigned* p)              { return __hip_atomic_load(p, __ATOMIC_RELAXED, __HIP_MEMORY_SCOPE_AGENT); }
__device__ __forceinline__ unsigned xb_add(unsigned* p, unsigned v) { return __hip_atomic_fetch_add(p, v, __ATOMIC_RELAXED, __HIP_MEMORY_SCOPE_AGENT); }
__device__ __forceinline__ unsigned xb_xcc_id() { return (unsigned)__builtin_amdgcn_s_getreg((3 << 11) | 20) & 0xFu; }
#define XB_SPIN(cond, bar) do { unsigned _sp = 0; while (cond) { __builtin_amdgcn_s_sleep(1); \
    if ((++_sp & 255u) == 0u) { if (xb_ld(&(bar)[XB_TMO])) break; if (_sp > XB_SPIN_CAP) { atomicAdd(&(bar)[XB_TMO], 1u); break; } } } } while (0)
struct XcdBarrier { unsigned* bar; unsigned x; volatile LAS unsigned* st; };
__device__ __forceinline__ XcdBarrier xcd_barrier_post(unsigned* bar, volatile LAS unsigned* st) {
    XcdBarrier b; b.bar = bar; b.x = xb_xcc_id(); b.st = st;
    if (threadIdx.x == 0) (void)xb_add(&bar[XB_XCNT(b.x)], 1u);
    return b;
}
__device__ __forceinline__ void xcd_barrier_complete(unsigned* bar, unsigned x, unsigned& nloc, unsigned& nx) {
    const unsigned G = gridDim.x * gridDim.y * gridDim.z;
    unsigned sum, cnt, mine, sp = 0u;
    for (;;) {
        sum = 0u; cnt = 0u; mine = 0u;
#pragma unroll
        for (unsigned j = 0; j < 16; ++j) { const unsigned c = xb_ld(&bar[XB_XCNT(j)]); sum += c; cnt += (c > 0u) ? 1u : 0u; mine = (j == x) ? c : mine; }
        if (sum == G) break;
        __builtin_amdgcn_s_sleep(1);
        if ((++sp & 255u) == 0u) { if (xb_ld(&bar[XB_TMO])) break; if (sp > XB_SPIN_CAP) { atomicAdd(&bar[XB_TMO], 1u); break; } }
    }
    nloc = mine > 0u ? mine : 1u; nx = cnt > 0u ? cnt : 1u;
}
__device__ __forceinline__ void xcd_barrier(const XcdBarrier& b) {
    asm volatile("s_waitcnt vmcnt(0)" ::: "memory");
    __syncthreads();
    if (threadIdx.x == 0) {
        unsigned* bar = b.bar;
        __builtin_amdgcn_s_waitcnt(0);
        unsigned nloc = b.st[0], nx = b.st[1];
        if (nloc == 0u) { xcd_barrier_complete(bar, b.x, nloc, nx); b.st[0] = nloc; b.st[1] = nx; }
        const unsigned old = xb_add(&bar[XB_XSUB(b.x)], 1u);
        const unsigned gen = old / nloc;
        if (old + 1u == (gen + 1u) * nloc) {
            __builtin_amdgcn_fence(__ATOMIC_RELEASE, "agent");
            asm volatile("s_waitcnt vmcnt(0)" ::: "memory");
            const unsigned og = xb_add(&bar[XB_TOP], 1u);
            const unsigned tg = og / nx;
            if (og + 1u == (tg + 1u) * nx) xb_add(&bar[XB_TOPGEN], 1u);
            else XB_SPIN(xb_ld(&bar[XB_TOPGEN]) == tg, bar);
            __builtin_amdgcn_fence(__ATOMIC_ACQUIRE, "agent");
            xb_add(&bar[XB_XGEN(b.x)], 1u);
            asm volatile("s_waitcnt vmcnt(0)" ::: "memory");
        } else {
            XB_SPIN(xb_ld(&bar[XB_XGEN(b.x)]) == gen, bar);
            __builtin_amdgcn_fence(__ATOMIC_ACQUIRE, "agent");
            asm volatile("s_waitcnt vmcnt(0)" ::: "memory");
        }
    }
    __syncthreads();
}

struct Args {
    const float *x, *norm1_g, *w_in, *mu, *w0, *w_up, *a0, *a_up, *g_up, *k_k, *k_a, *r_k, *lnx_g, *lnx_b, *w_ba, *w_bb, *w_out, *norm2_g, *peer_wq, *sub_keys, *peer_u, *peer_v, *final_g;
    float* out; unsigned char* ws; int ph_lo, ph_hi, li, pad;
};
#define CAS __attribute__((address_space(4)))
typedef const CAS Args* ArgsP;
__device__ __forceinline__ ArgsP get_args() { ArgsP p = (ArgsP)__builtin_amdgcn_kernarg_segment_ptr(); asm volatile("" : "+s"(p)); return p; }
struct Frame { LAS unsigned char* lds; int tid, lane, wave, vcu, G; };

__device__ __forceinline__ int win_dst(int s) {
    if (s < SHIFTW) return s;
    if (s < SHIFTW + 4096) { const int base = (s < SHIFTW + 2048) ? SHIFTW : SHIFTW + 2048; const int m = s - base, head = m >> 7, c = m & 127; const int j = (c < 64) ? 2 * c : 2 * (c - 64) + 1;
        return ((s < SHIFTW + 2048) ? PC_MQ : PC_MK) + head * 128 + j; }
    if (s < SHIFTW + 6144) return PC_MV + (s - (SHIFTW + 4096));
    if (s < SHIFTW + 6144 + 4096) return PC_GA + (s - (SHIFTW + 6144));
    return PC_GB + (s - (SHIFTW + 6144 + 4096));
}
template <bool MAPWIN> __device__ __forceinline__ void p0_transpose_item(const float* W, int K, int N, bf16_t* WT, int Kd, LAS float* scr, int item, int lane) {
    const int nblk = N / 32, kb = item / nblk, nb = item % nblk, k0 = 64 * kb, n0 = 32 * nb;
    { const int krow = lane >> 3, c4 = lane & 7; f32x4 v[8];
#pragma unroll
      for (int i = 0; i < 8; ++i) { const int kk = 8 * i + krow; v[i] = (k0 + kk < K) ? *(const f32x4*)(W + (size_t)(k0 + kk) * N + n0 + 4 * c4) : (f32x4){0.f, 0.f, 0.f, 0.f}; }
#pragma unroll
      for (int i = 0; i < 8; ++i) { LAS float* d = scr + (8 * i + krow) * 33 + 4 * c4; d[0] = v[i].x; d[1] = v[i].y; d[2] = v[i].z; d[3] = v[i].w; } }
    LDS_WAIT(); asm volatile("" ::: "memory");
    const int c = lane & 7;
#pragma unroll
    for (int j = 0; j < 4; ++j) { const int n = (lane >> 3) + 8 * j; const LAS float* s = scr + (8 * c) * 33 + n;
        u32x4 o; o.x = pk2(s[0 * 33], s[1 * 33]); o.y = pk2(s[2 * 33], s[3 * 33]); o.z = pk2(s[4 * 33], s[5 * 33]); o.w = pk2(s[6 * 33], s[7 * 33]);
        const int row = MAPWIN ? win_dst(n0 + n) : (n0 + n);
        *(u32x4*)(WT + (size_t)row * Kd + k0 + 8 * c) = o; }
    LDS_WAIT(); asm volatile("" ::: "memory");
}
__device__ __forceinline__ void rms_rows_to_bf16(const float* x, const float* g, bf16_t* o, int m0, int mstride, int lane) {
    const f32x4* gr = (const f32x4*)g + lane;
    f32x4 v[16], w[16];
    if (m0 < T) {
#pragma unroll
        for (int j = 0; j < 16; ++j) v[j] = ((const f32x4*)(x + (size_t)m0 * D) + lane)[64 * j]; }
    for (int m = m0; m < T; m += mstride) { const bool hasn = m + mstride < T;
        if (hasn) {
#pragma unroll
            for (int j = 0; j < 16; ++j) w[j] = ((const f32x4*)(x + (size_t)(m + mstride) * D) + lane)[64 * j]; }
        float s = 0.f;
#pragma unroll
        for (int j = 0; j < 16; ++j) s += (v[j].x * v[j].x + v[j].y * v[j].y) + (v[j].z * v[j].z + v[j].w * v[j].w);
        const float rs = 1.0f / sqrtf(wave_sum(s) * (1.0f / D) + NORM_EPS);
        u32x2* o8 = (u32x2*)(o + (size_t)m * D) + lane;
#pragma unroll
        for (int j = 0; j < 16; ++j) { const f32x4 gg = gr[64 * j]; u32x2 q; q.x = pk2(v[j].x * rs * gg.x, v[j].y * rs * gg.y); q.y = pk2(v[j].z * rs * gg.z, v[j].w * rs * gg.w); o8[64 * j] = q; }
        if (hasn) {
#pragma unroll
            for (int j = 0; j < 16; ++j) v[j] = w[j]; }
    }
}
__device__ __forceinline__ void cvt_table(const float* src, bf16_t* dst, size_t n8, size_t gtid, size_t nthr) {
    for (size_t i = gtid; i < n8; i += nthr) { const f32x4 a = ((const f32x4*)src)[2 * i], b = ((const f32x4*)src)[2 * i + 1]; ((u32x4*)dst)[i] = pg8::pack8(a, b); }
}
__device__ __forceinline__ void peer_quant(ArgsP A, Frame& F, int w0, int wstride) {
    unsigned char* ws = A->ws; const float* pu = A->peer_u; const float* pv = A->peer_v;
    f32x4 v[16], w[16];
    auto rowp = [&](int row) { return (const f32x4*)((row >= 16384 ? pv + (size_t)(row - 16384) * D : pu + (size_t)row * D)) + F.lane; };
    if (w0 < 2 * 16384) { const f32x4* src = rowp(w0);
#pragma unroll
        for (int j = 0; j < 16; ++j) v[j] = __builtin_nontemporal_load(src + 64 * j); }
    for (int row = w0; row < 2 * 16384; row += wstride) { const bool isv = row >= 16384; const int rr = isv ? row - 16384 : row; const bool hasn = row + wstride < 2 * 16384;
        if (hasn) { const f32x4* src = rowp(row + wstride);
#pragma unroll
            for (int j = 0; j < 16; ++j) w[j] = __builtin_nontemporal_load(src + 64 * j); }
        float am = 0.f;
#pragma unroll
        for (int j = 0; j < 16; ++j) am = fmaxf(fmaxf(am, fmaxf(fabsf(v[j].x), fabsf(v[j].y))), fmaxf(fabsf(v[j].z), fabsf(v[j].w)));
#pragma unroll
        for (int o = 1; o < 64; o <<= 1) am = fmaxf(am, __shfl_xor(am, o));
        const float inv = am > 0.f ? 127.0f / am : 0.f; unsigned* dst = (unsigned*)(ws + (isv ? WS_PV : WS_PU)) + (size_t)rr * (D / 4) + F.lane;
#pragma unroll
        for (int j = 0; j < 16; ++j) { const unsigned q0 = (unsigned)(int)(rintf(v[j].x * inv) + 128.0f), q1 = (unsigned)(int)(rintf(v[j].y * inv) + 128.0f), q2 = (unsigned)(int)(rintf(v[j].z * inv) + 128.0f), q3 = (unsigned)(int)(rintf(v[j].w * inv) + 128.0f);
            dst[64 * j] = q0 | (q1 << 8) | (q2 << 16) | (q3 << 24); }
        if (F.lane == 0) ((float*)(ws + (isv ? WS_PSV : WS_PSU)))[rr] = am * (1.0f / 127.0f);
        if (hasn) {
#pragma unroll
            for (int j = 0; j < 16; ++j) v[j] = w[j]; }
    }
}
__device__ __forceinline__ void late_weights(ArgsP A, Frame& F, int w0, int wstride) {
    unsigned char* ws = A->ws;
    LAS float* scr = (LAS float*)(F.lds + RING_OFF + F.wave * 16384);
    constexpr int I_BA = 32 * 128, I_OUT = 64 * 128, I_WQ = 64 * 64, I_SK = PH_ * 2 * PNK * PHALF / 512;
    constexpr int NITEMS = 2 * I_BA + I_OUT + I_WQ + I_SK;
    for (int it = w0; it < NITEMS; it += wstride) {
        int r = it;
        if (r < I_BA) { p0_transpose_item<false>(A->w_ba, RW, D, (bf16_t*)(ws + WS_WA), RW, scr, r, F.lane); continue; } r -= I_BA;
        if (r < I_BA) { p0_transpose_item<false>(A->w_bb, RW, D, (bf16_t*)(ws + WS_WB), RW, scr, r, F.lane); continue; } r -= I_BA;
        if (r < I_OUT) { p0_transpose_item<false>(A->w_out, D, D, (bf16_t*)(ws + WS_WOUT), D, scr, r, F.lane); continue; } r -= I_OUT;
        if (r < I_WQ) { p0_transpose_item<false>(A->peer_wq, D, 2048, (bf16_t*)(ws + WS_WQ), D, scr, r, F.lane); continue; } r -= I_WQ;
        { const size_t i = (size_t)r * 64 + F.lane; const f32x4 a = ((const f32x4*)A->sub_keys)[2 * i], b = ((const f32x4*)A->sub_keys)[2 * i + 1]; ((u32x4*)(ws + WS_SUBK))[i] = pg8::pack8(a, b); }
    }
}
__device__ __forceinline__ void ph0_prologue(ArgsP A, Frame& F) {
    unsigned char* ws = A->ws;
    LAS float* scr = (LAS float*)(F.lds + RING_OFF + F.wave * 16384);
    const int gw = F.vcu * NWAVES + F.wave, NGW = F.G * NWAVES;
    constexpr int I_IN = 64 * (INW / 32), I_UP = 2 * 64, I_G = 8 * 64;
    constexpr int NITEMS = I_IN + 2 * I_UP + I_G;
    for (int it = gw; it < NITEMS; it += NGW) {
        int r = it;
        if (r < I_IN) { p0_transpose_item<true>(A->w_in, D, INW, (bf16_t*)(ws + WS_WIN), D, scr, r, F.lane); continue; } r -= I_IN;
        if (r < I_UP) { p0_transpose_item<false>(A->w_up, LW, RW, (bf16_t*)(ws + WS_WUP), LW, scr, r, F.lane); continue; } r -= I_UP;
        if (r < I_UP) { p0_transpose_item<false>(A->a_up, LA, RW, (bf16_t*)(ws + WS_AUP), LA, scr, r, F.lane); continue; } r -= I_UP;
        p0_transpose_item<false>(A->g_up, LG, RW, (bf16_t*)(ws + WS_GUP), LGP, scr, r, F.lane);
    }
    const size_t gtid = (size_t)F.vcu * NTHR + F.tid, nthr = (size_t)F.G * NTHR;
    for (size_t i = gtid; i < (size_t)32 * D / 8; i += nthr) ((u32x4*)((bf16_t*)(ws + WS_WIN) + (size_t)SHIFTW * D))[i] = (u32x4){0u, 0u, 0u, 0u};
    for (size_t i = gtid; i < (size_t)T * 64; i += nthr) { const int pos = (int)(i >> 6), fi = (int)(i & 63); const float inv = powf(10000.0f, -(float)fi / 64.0f); const float ang = (float)pos * inv;
        ((f32x2*)(ws + WS_ROPE))[i] = (f32x2){cosf(ang), sinf(ang)}; }
    rms_rows_to_bf16(A->x, A->norm1_g, (bf16_t*)(ws + WS_XN), gw, NGW, F.lane);
}

__device__ __forceinline__ f32x4 ld4bf(const bf16_t* p) { const u32x2 w = *(const u32x2*)p; return (f32x4){bflo(w.x), bfhi(w.x), bflo(w.y), bfhi(w.y)}; }
__device__ __forceinline__ void st4bf(bf16_t* p, f32x4 v) { u32x2 w; w.x = pk2(v[0], v[1]); w.y = pk2(v[2], v[3]); *(u32x2*)p = w; }
__device__ __forceinline__ void ph2_prep(ArgsP A, Frame& F) {
    unsigned char* ws = A->ws; const bf16_t* PROJ = (const bf16_t*)(ws + WS_PROJ);
    LAS float* red = (LAS float*)(F.lds + RING_OFF);
    for (int it = F.vcu; it < NBLK * MH; it += F.G) { const int n = it / MH, h = it % MH, d = F.tid & 127, part = F.tid >> 7;
        const bf16_t* p = PROJ + (size_t)(n * MBLK + part * 64) * PLD + PC_MK + h * MD + d; float s = 0.f;
#pragma unroll 8
        for (int i = 0; i < 64; ++i) s += bf1(p[(size_t)i * PLD]);
        red[F.tid] = s; WG_BAR();
        if (F.tid < 128) { const float m = (red[F.tid] + red[F.tid + 128] + red[F.tid + 256] + red[F.tid + 384]) * (1.0f / MBLK); const unsigned hi = f2bf(m); const float lo = m - __builtin_bit_cast(float, hi << 16);
            ((bf16_t*)(ws + WS_KMEAN))[(size_t)(h * NBLK + n) * MD + F.tid] = (bf16_t)hi; ((bf16_t*)(ws + WS_KMEAN + 131072))[(size_t)(h * NBLK + n) * MD + F.tid] = (bf16_t)f2bf(lo); }
        WG_BAR(); }
    const int tid = F.tid; const int c = 4 * tid;
    const f32x4 mu_r = *(const f32x4*)(A->mu + PC_R + c), mu_k = *(const f32x4*)(A->mu + PC_K + c), mu_v = *(const f32x4*)(A->mu + PC_V + c), kkw = *(const f32x4*)(A->k_k + c);
    int lc = 0, lcc = 0; if (tid < 32) { lcc = 4 * tid; lc = PC_WL + lcc; } else if (tid < 64) { lcc = 4 * (tid - 32); lc = PC_AL + lcc; } else { lcc = 4 * (tid - 64); lc = PC_GL + lcc; }
    const bool lact = tid < 64 || (tid < 192 && lcc < LG);
    const f32x4 mu_l = lact ? *(const f32x4*)(A->mu + lc) : (f32x4){0.f, 0.f, 0.f, 0.f};
    u32x2 cur[8], nxt[8];
    auto tload = [&](int t, u32x2 (&rg)[8]) { const bf16_t* P = PROJ + (size_t)t * PLD; const bf16_t* PP = t > 0 ? P - PLD : P;
        rg[0] = *(const u32x2*)(P + PC_R + c); rg[1] = *(const u32x2*)(PP + PC_R + c); rg[2] = *(const u32x2*)(P + PC_K + c); rg[3] = *(const u32x2*)(PP + PC_K + c);
        rg[4] = *(const u32x2*)(P + PC_V + c); rg[5] = *(const u32x2*)(PP + PC_V + c);
        if (lact) { rg[6] = *(const u32x2*)(P + lc); rg[7] = *(const u32x2*)(PP + lc); } else { rg[6] = (u32x2){0u, 0u}; rg[7] = (u32x2){0u, 0u}; } };
    auto up4 = [](u32x2 w) { return (f32x4){bflo(w.x), bfhi(w.x), bflo(w.y), bfhi(w.y)}; };
    if (F.vcu < T) tload(F.vcu, cur);
    for (int t = F.vcu; t < T; t += F.G) { const bool hasn = t + F.G < T; if (hasn) tload(t + F.G, nxt);
        const float hp = t > 0 ? 1.0f : 0.0f;
        { const f32x4 p = up4(cur[0]), pp = up4(cur[1]) * hp; st4bf((bf16_t*)(ws + WS_ZR) + (size_t)t * RW + c, p + (pp - p) * mu_r); }
        { const f32x4 p = up4(cur[2]), pp = up4(cur[3]) * hp; const f32x4 zk = p + (pp - p) * mu_k;
          st4bf((bf16_t*)(ws + WS_KP) + (size_t)t * RW + c, zk); const f32x4 kk = zk * kkw;
          const float ss = sum16((kk[0] * kk[0] + kk[1] * kk[1]) + (kk[2] * kk[2] + kk[3] * kk[3])); const float inv = 1.0f / fmaxf(sqrtf(ss), 1e-12f);
          st4bf((bf16_t*)(ws + WS_KKN) + (size_t)t * RW + c, kk * inv); }
        { const f32x4 p = up4(cur[4]), pp = up4(cur[5]) * hp; st4bf((bf16_t*)(ws + WS_ZV) + (size_t)t * RW + c, p + (pp - p) * mu_v); }
        if (tid < 192) { const f32x4 zero = (f32x4){0.f, 0.f, 0.f, 0.f};
            f32x4 z = zero; if (lact) { const f32x4 p = up4(cur[6]), pp = up4(cur[7]) * hp; z = p + (pp - p) * mu_l; }
            if (tid < 32) { f32x4 o;
#pragma unroll
                for (int e = 0; e < 4; ++e) o[e] = 1.0f - 2.0f * __builtin_amdgcn_rcpf(__expf(2.0f * z[e]) + 1.0f);
                st4bf((bf16_t*)(ws + WS_AW) + (size_t)t * LW + lcc, o); }
            else if (tid < 64) st4bf((bf16_t*)(ws + WS_AA) + (size_t)t * LA + lcc, z);
            else { f32x4 o = zero; if (lcc < LG) {
#pragma unroll
                for (int e = 0; e < 4; ++e) o[e] = fsigmoid(z[e]); }
                st4bf((bf16_t*)(ws + WS_AG) + (size_t)t * LGP + lcc, o); }
        }
        if (hasn) {
#pragma unroll
            for (int i = 0; i < 8; ++i) cur[i] = nxt[i]; }
    }
}

__device__ __forceinline__ void ph3_gate(ArgsP A, Frame& F) {
    unsigned char* ws = A->ws; const bf16_t* PROJ = (const bf16_t*)(ws + WS_PROJ); const bf16_t* KMH = (const bf16_t*)(ws + WS_KMEAN); const bf16_t* KML = (const bf16_t*)(ws + WS_KMEAN + 131072); unsigned* MASK = (unsigned*)(ws + WS_MASK);
    const int gw = F.vcu * NWAVES + F.wave, NGW = F.G * NWAVES; const int r = F.lane & 31, hh = F.lane >> 5; const float NEG = -__builtin_inff();
    for (int it = gw; it < (T / 32) * MH; it += NGW) { const int tg = it >> 4, h = it & 15, t = tg * 32 + r, blk = tg >> 3;
        if (blk == 0) { if (hh == 0) MASK[t * MH + h] = 0u; continue; }
        f32x16 acc;
#pragma unroll
        for (int e = 0; e < 16; ++e) acc[e] = 0.f;
#pragma unroll
        for (int ks = 0; ks < 8; ++ks) { const bf16x8 q = *(const bf16x8*)(PROJ + (size_t)t * PLD + PC_MQ + h * MD + 16 * ks + 8 * hh); const size_t ko = (size_t)(h * NBLK + r) * MD + 16 * ks + 8 * hh;
            acc = __builtin_amdgcn_mfma_f32_32x32x16_bf16(*(const bf16x8*)(KMH + ko), q, acc, 0, 0, 0); acc = __builtin_amdgcn_mfma_f32_32x32x16_bf16(*(const bf16x8*)(KML + ko), q, acc, 0, 0, 0); }
        float t0 = NEG, t1 = NEG, t2 = NEG;
#pragma unroll
        for (int e = 0; e < 16; ++e) { const int n = (e & 3) + 8 * (e >> 2) + 4 * hh; float ae = acc[e]; asm volatile("" : "+v"(ae));
            float x = __builtin_bit_cast(float, (__builtin_bit_cast(unsigned, ae) & ~31u) | (unsigned)(31 - n)); x = (n < blk) ? x : NEG;
            t2 = __builtin_amdgcn_fmed3f(t1, t2, x); t1 = __builtin_amdgcn_fmed3f(t0, t1, x); t0 = fmaxf(t0, x); }
        const float o0 = __shfl_xor(t0, 32), o1 = __shfl_xor(t1, 32), o2 = __shfl_xor(t2, 32);
        t2 = __builtin_amdgcn_fmed3f(t1, t2, o0); t1 = __builtin_amdgcn_fmed3f(t0, t1, o0); t0 = fmaxf(t0, o0);
        t2 = __builtin_amdgcn_fmed3f(t1, t2, o1); t1 = __builtin_amdgcn_fmed3f(t0, t1, o1); t0 = fmaxf(t0, o1);
        t2 = __builtin_amdgcn_fmed3f(t1, t2, o2); t1 = __builtin_amdgcn_fmed3f(t0, t1, o2); t0 = fmaxf(t0, o2);
        unsigned sel = 1u << (31 - (__builtin_bit_cast(unsigned, t0) & 31u));
        if (blk > 1) sel |= 1u << (31 - (__builtin_bit_cast(unsigned, t1) & 31u));
        if (blk > 2) sel |= 1u << (31 - (__builtin_bit_cast(unsigned, t2) & 31u));
        if (hh == 0) MASK[t * MH + h] = sel; }
}

constexpr int SC_CH = 32, SC_STEP = 1344, SC_BUF = SC_CH * SC_STEP, SC_YOFF = 2 * SC_BUF, SC_YBUF = SC_CH * 16 * 16 * 4;
static_assert(SC_YOFF + 2 * SC_YBUF <= RING_BYTES, "scan LDS");
__device__ __forceinline__ void ph4_scan(ArgsP A, Frame& F, int unit0, int ustride) {
    unsigned char* ws = A->ws;
    const float* DEC = (const float*)(ws + WS_DEC); const bf16_t* KKN = (const bf16_t*)(ws + WS_KKN); const bf16_t* BB = (const bf16_t*)(ws + WS_BB); const bf16_t* KP = (const bf16_t*)(ws + WS_KP);
    const bf16_t* ZR = (const bf16_t*)(ws + WS_ZR); const bf16_t* ZV = (const bf16_t*)(ws + WS_ZV); float* Y = (float*)(ws + WS_Y);
    LAS unsigned char* L = F.lds + RING_OFF;
    const int wave = F.wave, lane = F.lane;
    for (int unit = unit0; unit < 128; unit += ustride) {
        const int h = unit >> 2, r0 = (unit & 3) * 16; const size_t hc = (size_t)h * RN;
        constexpr int NC = T / SC_CH;
        if (wave < 4) {
            const int row = wave * 4 + (lane >> 4), j = lane & 15;
            f32x2 S01 = {0.f, 0.f}, S23 = {0.f, 0.f};
            __builtin_amdgcn_s_setprio(3);
            WG_BAR();
#define SC_LOAD(W, KK, BBv, KPv, RR, V, tt_) do { const int o_ = (tt_) * SC_STEP; W = *(const LAS f32x4*)(B + o_); KK = *(const LAS f32x4*)(B + o_ + 256); BBv = *(const LAS f32x4*)(B + o_ + 512); KPv = *(const LAS f32x4*)(B + o_ + 768); RR = *(const LAS f32x4*)(B + o_ + 1024); V = *(const LAS float*)(vb + o_); } while (0)
#define SC_STEPF(W, KK, BBv, KPv, RR, V, tt_) do { \
            const f32x2 kk01 = {KK[0], KK[1]}, kk23 = {KK[2], KK[3]}; f32x2 d2 = S01 * kk01; d2 = __builtin_elementwise_fma(S23, kk23, d2); \
            const f32x2 w01 = {W[0], W[1]}, w23 = {W[2], W[3]}, kp01 = {KPv[0], KPv[1]}, kp23 = {KPv[2], KPv[3]}; const f32x2 vv = {V, V}; \
            f32x2 t01 = S01 * w01, t23 = S23 * w23; t01 = __builtin_elementwise_fma(vv, kp01, t01); t23 = __builtin_elementwise_fma(vv, kp23, t23); \
            const float d_ = sum16(d2[0] + d2[1]); const f32x2 dd = {d_, d_}; const f32x2 bb01 = {BBv[0], BBv[1]}, bb23 = {BBv[2], BBv[3]};        \
            S01 = __builtin_elementwise_fma(dd, bb01, t01); S23 = __builtin_elementwise_fma(dd, bb23, t23); \
            const f32x2 r01 = {RR[0], RR[1]}, r23 = {RR[2], RR[3]}; f32x2 y2 = S01 * r01; y2 = __builtin_elementwise_fma(S23, r23, y2); yb[(tt_) * 256] = y2[0] + y2[1]; } while (0)
#pragma unroll 1
            for (int c = 0; c < NC; ++c) {
                const LAS unsigned char* B = L + (c & 1) * SC_BUF + 16 * j; LAS float* yb = (LAS float*)(L + SC_YOFF + (c & 1) * SC_YBUF) + row * 16 + j;
                const LAS unsigned char* vb = L + (c & 1) * SC_BUF + 1280 + 4 * row;
                f32x4 wA, kA, bA, pA, rA, wB, kB, bB, pB, rB, wC, kC, bC, pC, rC, wD, kD, bD, pD, rD; float vA, vB, vC, vD;
                SC_LOAD(wA, kA, bA, pA, rA, vA, 0); SC_LOAD(wB, kB, bB, pB, rB, vB, 1);
#pragma unroll 1
                for (int tt = 0; tt < SC_CH; tt += 4) {
                    const int t4 = tt + 4 < SC_CH ? tt + 4 : tt, t5 = tt + 5 < SC_CH ? tt + 5 : tt + 1;
                    SC_LOAD(wC, kC, bC, pC, rC, vC, tt + 2); SC_STEPF(wA, kA, bA, pA, rA, vA, tt); SC_LOAD(wD, kD, bD, pD, rD, vD, tt + 3); SC_STEPF(wB, kB, bB, pB, rB, vB, tt + 1);
                    SC_LOAD(wA, kA, bA, pA, rA, vA, t4); SC_STEPF(wC, kC, bC, pC, rC, vC, tt + 2); SC_LOAD(wB, kB, bB, pB, rB, vB, t5); SC_STEPF(wD, kD, bD, pD, rD, vD, tt + 3);
                }
                WG_BAR();
            }
            __builtin_amdgcn_s_setprio(0);
#undef SC_LOAD
#undef SC_STEPF
        } else {
            const int ltid = (wave - 4) * 64 + lane;
            f32x4 ld_dec[2]; u32x4 ld_b[4]; u32x4 ld_v;
            auto issue = [&](int c) { const int t0 = c * SC_CH;
#pragma unroll
                for (int i = 0; i < 2; ++i) { const int q = ltid + 256 * i, st = q >> 4, c4 = q & 15; ld_dec[i] = *(const f32x4*)(DEC + (size_t)(t0 + st) * RW + hc + 4 * c4); }
                { const int st = ltid >> 3, c8 = ltid & 7; const size_t o = (size_t)(t0 + st) * RW + hc + 8 * c8; ld_b[0] = *(const u32x4*)(KKN + o); ld_b[1] = *(const u32x4*)(BB + o); ld_b[2] = *(const u32x4*)(KP + o); ld_b[3] = *(const u32x4*)(ZR + o); }
                { const int l6 = ltid & 63; ld_v = *(const u32x4*)(ZV + (size_t)(t0 + (l6 >> 1)) * RW + hc + r0 + 8 * (l6 & 1)); } };
            auto commit = [&](int buf) { LAS unsigned char* B = L + buf * SC_BUF;
#pragma unroll
                for (int i = 0; i < 2; ++i) { const int q = ltid + 256 * i, st = q >> 4, c4 = q & 15; *(LAS f32x4*)(B + st * SC_STEP + 16 * c4) = ld_dec[i]; }
                { const int st = ltid >> 3, c8 = ltid & 7;
#pragma unroll
                  for (int a = 0; a < 4; ++a) { f32x4 v0, v1; pg8::unpack8(ld_b[a], v0, v1); LAS unsigned char* p = B + st * SC_STEP + 256 * (a + 1) + 32 * c8; *(LAS f32x4*)p = v0; *(LAS f32x4*)(p + 16) = v1; } }
                if (ltid < 64) { f32x4 v0, v1; pg8::unpack8(ld_v, v0, v1); LAS unsigned char* p = B + (ltid >> 1) * SC_STEP + 1280 + 32 * (ltid & 1); *(LAS f32x4*)p = v0; *(LAS f32x4*)(p + 16) = v1; } };
            auto yflush = [&](int c) {
#pragma unroll
                for (int i = 0; i < 2; ++i) { const int o = ltid + 256 * i, st = o >> 4, rr = o & 15; const LAS f32x4* p = (const LAS f32x4*)(L + SC_YOFF + (c & 1) * SC_YBUF + (st * 16 + rr) * 64);
                    const f32x4 a = p[0], b = p[1], cc = p[2], d = p[3]; const f32x4 s4 = (a + b) + (cc + d); Y[(size_t)(c * SC_CH + st) * RW + hc + r0 + rr] = (s4[0] + s4[1]) + (s4[2] + s4[3]); } };
            issue(0); VM_WAIT(); commit(0); issue(1);
            WG_BAR();
#pragma unroll 1
            for (int c = 0; c < NC; ++c) {
                if (c + 1 < NC) { VM_WAIT(); commit((c + 1) & 1); }
                if (c + 2 < NC) issue(c + 2);
                if (c > 0) yflush(c - 1);
                WG_BAR();
            }
            yflush(NC - 1);
        }
        WG_BAR();
    }
}

__device__ __forceinline__ void ph5_ypost(ArgsP A, Frame& F) {
    unsigned char* ws = A->ws; const float* Y = (const float*)(ws + WS_Y); const bf16_t* ZR = (const bf16_t*)(ws + WS_ZR); const bf16_t* KP = (const bf16_t*)(ws + WS_KP); const bf16_t* ZV = (const bf16_t*)(ws + WS_ZV);
    const bf16_t* G = (const bf16_t*)(ws + WS_G); bf16_t* YA = (bf16_t*)(ws + WS_YA);
    const int gw = F.vcu * NWAVES + F.wave, NGW = F.G * NWAVES;
    for (int tg = F.vcu; tg < T / 32; tg += F.G) for (int it = F.wave; it < 256; it += NWAVES) { const int t = tg * 32 + (it >> 3), c = (it & 7) * 256 + 4 * F.lane; const size_t o = (size_t)t * RW + c;
        const f32x4 y = *(const f32x4*)(Y + o); const float mean = sum16((y[0] + y[1]) + (y[2] + y[3])) * (1.0f / 64.0f); const f32x4 d = y - mean;
        const float var = sum16((d[0] * d[0] + d[1] * d[1]) + (d[2] * d[2] + d[3] * d[3])) * (1.0f / 64.0f); const float rs = 1.0f / sqrtf(var + LNX_EPS);
        const f32x4 r = ld4bf(ZR + o), k = ld4bf(KP + o), v = ld4bf(ZV + o), g = ld4bf(G + o), rk = *(const f32x4*)(A->r_k + c), lg = *(const f32x4*)(A->lnx_g + c), lb = *(const f32x4*)(A->lnx_b + c);
        const f32x4 rkk = r * k * rk; const float bonus = sum16((rkk[0] + rkk[1]) + (rkk[2] + rkk[3]));
        st4bf(YA + o, (d * rs * lg + lb + bonus * v) * g); }
}

constexpr int AT_KB = 64 * 256, AT_VB = 128 * 128, AT_BUF = AT_KB + AT_VB;
static_assert(3 * AT_BUF <= RING_BYTES, "attention LDS");
__device__ __forceinline__ void ph5_attn(ArgsP A, Frame& F, int slot0, int sstride) {
    unsigned char* ws = A->ws; const bf16_t* PROJ = (const bf16_t*)(ws + WS_PROJ); const bf16_t* VT = (const bf16_t*)(ws + WS_VT); const unsigned* MASK = (const unsigned*)(ws + WS_MASK); bf16_t* YB = (bf16_t*)(ws + WS_YB);
    LAS unsigned char* L = F.lds + RING_OFF; const int tid = F.tid, wave = F.wave, lane = F.lane, r = lane & 31, hh = lane >> 5;
    const float NEG = -__builtin_inff();
    for (int sl = slot0; sl < 128; sl += sstride) { const int h = sl >> 3, pr0 = (sl & 7) * 2;
      for (int half = 0; half < 4; ++half) { const int pr = pr0 + (half >> 1); const int ib = (half & 1) == 0 ? (31 - pr) : pr;
        const int q0 = ib * MBLK + wave * 32;
        bf16x8 qf[8];
#pragma unroll
        for (int ks = 0; ks < 8; ++ks) qf[ks] = *(const bf16x8*)(PROJ + (size_t)(q0 + r) * PLD + PC_MQ + h * MD + 16 * ks + 8 * hh);
        const unsigned msk = MASK[(q0 + r) * MH + h];
        f32x16 o[4];
#pragma unroll
        for (int db = 0; db < 4; ++db)
#pragma unroll
            for (int e = 0; e < 16; ++e) o[db][e] = 0.f;
        float mrun = NEG, lrun = 0.f;
        const int ntile = 4 + 4 * ib;
        auto tile_tok = [&](int n) { return n < 4 ? ib * MBLK + n * 64 : ((n - 4) >> 2) * MBLK + ((n - 4) & 3) * 64; };
        const int krow_ = lane >> 4, kslot = lane & 15, vrow_ = lane >> 3, vslot = lane & 7;
        auto dma_tile = [&](int n, int b3) { const int tb = tile_tok(n); LAS unsigned char* B = L + b3 * AT_BUF;
#pragma unroll
            for (int i = 0; i < 2; ++i) { const int p = wave * 2 + i, row = 4 * p + krow_, c = kslot ^ (row & 15);
                __builtin_amdgcn_global_load_lds((const unsigned*)(PROJ + (size_t)(tb + row) * PLD + PC_MK + h * MD + 8 * c), (LAS unsigned*)(B + p * 1024), 16, 0, 0); }
#pragma unroll
            for (int i = 0; i < 2; ++i) { const int p = wave * 2 + i, row = 8 * p + vrow_, c = vslot ^ (row & 7);
                __builtin_amdgcn_global_load_lds((const unsigned*)(VT + (size_t)(h * MD + row) * T + tb + 8 * c), (LAS unsigned*)(B + AT_KB + p * 1024), 16, 0, 0); } };
        dma_tile(0, 0); dma_tile(1, 1);
        asm volatile("s_waitcnt vmcnt(4)" ::: "memory"); WG_BAR();
        int b3 = 0;
        for (int n = 0; n < ntile; ++n) {
            { const int bn = b3 >= 1 ? b3 - 1 : 2; if (n + 2 < ntile) dma_tile(n + 2, bn); }
            bool need; int jblk = -1, tt = 0;
            if (n < 4) { tt = n; need = tt <= (wave >> 1); } else { jblk = (n - 4) >> 2; need = __ballot((msk >> jblk) & 1u) != 0ull; }
            if (need) {
                const LAS unsigned char* KB = L + b3 * AT_BUF; const LAS unsigned char* VB = KB + AT_KB;
                f32x16 s[2];
#pragma unroll
                for (int kb = 0; kb < 2; ++kb) {
#pragma unroll
                    for (int e = 0; e < 16; ++e) s[kb][e] = 0.f;
#pragma unroll
                    for (int ks = 0; ks < 8; ++ks) { const bf16x8 a = *(const LAS bf16x8*)(KB + (32 * kb + r) * 256 + (((2 * ks + hh) ^ (r & 15)) << 4)); s[kb] = __builtin_amdgcn_mfma_f32_32x32x16_bf16(a, qf[ks], s[kb], 0, 0, 0); } }
                if (n < 4) { if (64 * tt + 63 > wave * 32) { const int qrel = wave * 32 + r;
#pragma unroll
                    for (int kb = 0; kb < 2; ++kb)
#pragma unroll
                        for (int e = 0; e < 16; ++e) { const int krel = 64 * tt + 32 * kb + (e & 3) + 8 * (e >> 2) + 4 * hh; if (krel > qrel) s[kb][e] = NEG; } } }
                else if (!((msk >> jblk) & 1u)) {
#pragma unroll
                    for (int kb = 0; kb < 2; ++kb)
#pragma unroll
                        for (int e = 0; e < 16; ++e) s[kb][e] = NEG; }
                float mx = s[0][0];
#pragma unroll
                for (int kb = 0; kb < 2; ++kb)
#pragma unroll
                    for (int e = 0; e < 16; ++e) mx = fmaxf(mx, s[kb][e]);
                mx = fmaxf(mx, __shfl_xor(mx, 32));
                const float mnew = fmaxf(mrun, mx); const float alpha = __builtin_amdgcn_exp2f(mrun - mnew); mrun = mnew;
                float ps = 0.f;
#pragma unroll
                for (int kb = 0; kb < 2; ++kb)
#pragma unroll
                    for (int e = 0; e < 16; ++e) { const float p = __builtin_amdgcn_exp2f(s[kb][e] - mnew); s[kb][e] = p; ps += p; }
                lrun = lrun * alpha + ps;
                if (__ballot(alpha != 1.0f) != 0ull) {
#pragma unroll
                    for (int db = 0; db < 4; ++db)
#pragma unroll
                        for (int e = 0; e < 16; ++e) o[db][e] *= alpha; }
#pragma unroll
                for (int kb = 0; kb < 2; ++kb)
#pragma unroll
                    for (int st = 0; st < 2; ++st) { u32x4 pw; pw.x = pk2(s[kb][8 * st + 0], s[kb][8 * st + 1]); pw.y = pk2(s[kb][8 * st + 2], s[kb][8 * st + 3]); pw.z = pk2(s[kb][8 * st + 4], s[kb][8 * st + 5]); pw.w = pk2(s[kb][8 * st + 6], s[kb][8 * st + 7]);
                        const bf16x8 pf = __builtin_bit_cast(bf16x8, pw); const int kbase = 32 * kb + 16 * st + 4 * hh;
#pragma unroll
                        for (int db = 0; db < 4; ++db) { const LAS unsigned char* vrow = VB + (32 * db + r) * 128 + 8 * hh; const int c0 = 4 * kb + 2 * st; const u32x2 lo = *(const LAS u32x2*)(vrow + ((c0 ^ (r & 7)) << 4)), hi = *(const LAS u32x2*)(vrow + (((c0 + 1) ^ (r & 7)) << 4));
                            const bf16x8 vf = __builtin_bit_cast(bf16x8, (u32x4){lo.x, lo.y, hi.x, hi.y}); o[db] = __builtin_amdgcn_mfma_f32_32x32x16_bf16(vf, pf, o[db], 0, 0, 0); } }
            }
            if (n + 2 < ntile) asm volatile("s_waitcnt vmcnt(4)" ::: "memory"); else asm volatile("s_waitcnt vmcnt(0)" ::: "memory");
            b3 = b3 == 2 ? 0 : b3 + 1;
            WG_BAR();
        }
        const float ltot = lrun + __shfl_xor(lrun, 32); const float inv = 1.0f / ltot;
        bf16_t* op = YB + (size_t)(q0 + r) * RW + h * MD;
#pragma unroll
        for (int db = 0; db < 4; ++db)
#pragma unroll
            for (int g = 0; g < 4; ++g) { u32x2 w; w.x = pk2(o[db][4 * g] * inv, o[db][4 * g + 1] * inv); w.y = pk2(o[db][4 * g + 2] * inv, o[db][4 * g + 3] * inv); *(u32x2*)(op + 32 * db + 8 * g + 4 * hh) = w; }
      }
    }
}

__device__ __forceinline__ void ins16(float (&top)[16], float x) {
#pragma unroll
    for (int k = 15; k >= 1; --k) top[k] = __builtin_amdgcn_fmed3f(top[k - 1], top[k], x);
    top[0] = fmaxf(top[0], x);
}
__device__ __forceinline__ void ph10_select(ArgsP A, Frame& F) {
    unsigned char* ws = A->ws; const bf16_t* PQ = (const bf16_t*)(ws + WS_PQ); const bf16_t* SK = (const bf16_t*)(ws + WS_SUBK); int* IDX = (int*)(ws + WS_IDX); float* GW = (float*)(ws + WS_GW);
    const int gw = F.vcu * NWAVES + F.wave, NGW = F.G * NWAVES; const int r = F.lane & 31, hh = F.lane >> 5; const float NEG = -__builtin_inff();
    for (int it = gw; it < (T / 32) * PH_; it += NGW) { const int tg = it >> 3, h = it & 7, t = tg * 32 + r;
        float TA[16], TB[16];
        auto topk = [&](int p, float (&dst)[16]) {
            bf16x8 qf[8];
#pragma unroll
            for (int ks = 0; ks < 8; ++ks) qf[ks] = *(const bf16x8*)(PQ + (size_t)t * 2048 + (h * 2 + p) * PHALF + 16 * ks + 8 * hh);
            float top[16];
#pragma unroll
            for (int k = 0; k < 16; ++k) top[k] = NEG;
#pragma unroll 1
            for (int nb = 0; nb < 4; ++nb) { f32x16 acc;
#pragma unroll
                for (int e = 0; e < 16; ++e) acc[e] = 0.f;
#pragma unroll
                for (int ks = 0; ks < 8; ++ks) { const bf16x8 a = *(const bf16x8*)(SK + ((size_t)(h * 2 + p) * PNK + 32 * nb + r) * PHALF + 16 * ks + 8 * hh); acc = __builtin_amdgcn_mfma_f32_32x32x16_bf16(a, qf[ks], acc, 0, 0, 0); }
#pragma unroll
                for (int e = 0; e < 16; ++e) { const unsigned key = 32 * nb + (e & 3) + 8 * (e >> 2) + 4 * hh; float ae = acc[e]; asm volatile("" : "+v"(ae));
                    const float x = __builtin_bit_cast(float, (__builtin_bit_cast(unsigned, ae) & ~0x7Fu) | key); ins16(top, x); } }
            float oth[16];
#pragma unroll
            for (int k = 0; k < 16; ++k) oth[k] = __shfl_xor(top[k], 32);
#pragma unroll
            for (int k = 0; k < 16; ++k) ins16(top, oth[k]);
#pragma unroll
            for (int k = 0; k < 16; ++k) dst[k] = top[k];
        };
        topk(0, TA); asm volatile("" ::: "memory"); __builtin_amdgcn_sched_barrier(0); topk(1, TB); asm volatile("" ::: "memory"); __builtin_amdgcn_sched_barrier(0);
        float fin[16];
#pragma unroll
        for (int k = 0; k < 16; ++k) fin[k] = NEG;
#pragma unroll
        for (int i = 0; i < 16; ++i)
#pragma unroll
            for (int j = 0; j < 16; ++j) if ((i + 1) * (j + 1) <= 16) { const float sm = TA[i] + TB[j]; ins16(fin, __builtin_bit_cast(float, (__builtin_bit_cast(unsigned, sm) & ~0xFFu) | (unsigned)(i * 16 + j))); }
        float e[16], den = 0.f;
#pragma unroll
        for (int k = 0; k < 16; ++k) { e[k] = __expf(fin[k] - fin[0]); den += e[k]; }
        const float rden = 1.0f / den;
        int oi[8]; float og[8];
#pragma unroll
        for (int kk = 0; kk < 8; ++kk) { const float fv = hh ? fin[8 + kk] : fin[kk]; og[kk] = (hh ? e[8 + kk] : e[kk]) * rden; const unsigned id = __builtin_bit_cast(unsigned, fv) & 0xFFu; const unsigned ci = id >> 4, cj = id & 15u;
            unsigned ia = 0u, ib = 0u;
#pragma unroll
            for (int q = 0; q < 16; ++q) { ia = (ci == (unsigned)q) ? (__builtin_bit_cast(unsigned, TA[q]) & 0x7Fu) : ia; ib = (cj == (unsigned)q) ? (__builtin_bit_cast(unsigned, TB[q]) & 0x7Fu) : ib; }
            oi[kk] = (int)(ia * PNK + ib); }
        int* ip = IDX + (size_t)t * 128 + h * 16 + 8 * hh; float* gp = GW + (size_t)t * 128 + h * 16 + 8 * hh;
        *(u32x4*)ip = (u32x4){(unsigned)oi[0], (unsigned)oi[1], (unsigned)oi[2], (unsigned)oi[3]}; *(u32x4*)(ip + 4) = (u32x4){(unsigned)oi[4], (unsigned)oi[5], (unsigned)oi[6], (unsigned)oi[7]};
        *(f32x4*)gp = (f32x4){og[0], og[1], og[2], og[3]}; *(f32x4*)(gp + 4) = (f32x4){og[4], og[5], og[6], og[7]};
    }
}


__device__ __forceinline__ float ub0(unsigned w) { return (float)(w & 0xffu); }
__device__ __forceinline__ float ub1(unsigned w) { return (float)((w >> 8) & 0xffu); }
__device__ __forceinline__ float ub2(unsigned w) { return (float)((w >> 16) & 0xffu); }
__device__ __forceinline__ float ub3(unsigned w) { return (float)(w >> 24); }
__device__ __forceinline__ float dot16q(u32x4 q, const float (&h)[16]) {
    return ((ub0(q.x) * h[0] + ub1(q.x) * h[1]) + (ub2(q.x) * h[2] + ub3(q.x) * h[3])) + ((ub0(q.y) * h[4] + ub1(q.y) * h[5]) + (ub2(q.y) * h[6] + ub3(q.y) * h[7]))
         + ((ub0(q.z) * h[8] + ub1(q.z) * h[9]) + (ub2(q.z) * h[10] + ub3(q.z) * h[11])) + ((ub0(q.w) * h[12] + ub1(q.w) * h[13]) + (ub2(q.w) * h[14] + ub3(q.w) * h[15]));
}
__device__ __forceinline__ void ph11_gather(ArgsP A, Frame& F) {
    unsigned char* ws = A->ws; const bf16_t* H2 = (const bf16_t*)(ws + WS_H2); const unsigned char* PU = (const unsigned char*)(ws + WS_PU); const unsigned char* PV = (const unsigned char*)(ws + WS_PV);
    const float* PSU = (const float*)(ws + WS_PSU); const float* PSV = (const float*)(ws + WS_PSV);
    const int* IDX = (const int*)(ws + WS_IDX); const float* GW = (const float*)(ws + WS_GW); const float* X1 = (const float*)(ws + WS_X1);
    LAS float* coef = (LAS float*)(F.lds + RING_OFF); LAS int* eidx = (LAS int*)(F.lds + RING_OFF + 1024); LAS float* red = (LAS float*)(F.lds + RING_OFF + 2048);
    const int tid = F.tid, wave = F.wave, lane = F.lane; int par = 0;
    for (int t = F.vcu; t < T; t += F.G, par ^= 1) {
        float hv[4][16]; float hs = 0.f;
#pragma unroll
        for (int i = 0; i < 4; ++i) { const bf16_t* hp = H2 + (size_t)t * D + i * 1024 + lane * 16; f32x4 a, b, c, d; pg8::unpack8(*(const u32x4*)hp, a, b); pg8::unpack8(*(const u32x4*)(hp + 8), c, d);
#pragma unroll
            for (int e = 0; e < 4; ++e) { hv[i][e] = a[e]; hv[i][4 + e] = b[e]; hv[i][8 + e] = c[e]; hv[i][12 + e] = d[e]; }
            hs += ((a[0] + a[1]) + (a[2] + a[3])) + ((b[0] + b[1]) + (b[2] + b[3])) + ((c[0] + c[1]) + (c[2] + c[3])) + ((d[0] + d[1]) + (d[2] + d[3])); }
        hs = wave_sum(hs);
        const int myidx = (lane < 16) ? IDX[(size_t)t * 128 + wave * 16 + lane] : 0; const float myg = (lane < 16) ? GW[(size_t)t * 128 + wave * 16 + lane] : 0.f;
        float dots = 0.f;
#pragma unroll 1
        for (int k = 0; k < 16; k += 4) {
            u32x4 q[4][4];
#pragma unroll
            for (int x = 0; x < 4; ++x) { const int e = __builtin_amdgcn_readlane(myidx, k + x); const unsigned char* up = PU + (size_t)e * D + lane * 16;
#pragma unroll
                for (int i = 0; i < 4; ++i) q[x][i] = *(const u32x4*)(up + i * 1024); }
#pragma unroll
            for (int x = 0; x < 4; ++x) { float d = 0.f;
#pragma unroll
                for (int i = 0; i < 4; ++i) d += dot16q(q[x][i], hv[i]);
                d = wave_sum(d); if (lane == k + x) dots = d; }
        }
        if (lane < 16) { const float s = PSU[myidx] * (dots - 128.0f * hs); const float act = 0.5f * s * (1.0f + erff(s * 0.70710678118654752f));
            coef[par * 128 + wave * 16 + lane] = myg * act * PSV[myidx]; eidx[par * 128 + wave * 16 + lane] = myidx; }
        WG_BAR();
        float acc[8]; float csum = 0.f;
#pragma unroll
        for (int i = 0; i < 8; ++i) acc[i] = 0.f;
#pragma unroll 1
        for (int e = 0; e < 128; e += 16) { u32x2 v[16]; float c[16];
#pragma unroll
            for (int q = 0; q < 16; ++q) { const int ei = __builtin_amdgcn_readfirstlane(eidx[par * 128 + e + q]); c[q] = coef[par * 128 + e + q]; v[q] = *(const u32x2*)(PV + (size_t)ei * D + tid * 8); }
#pragma unroll
            for (int q = 0; q < 16; ++q) { csum += c[q]; acc[0] += c[q] * ub0(v[q].x); acc[1] += c[q] * ub1(v[q].x); acc[2] += c[q] * ub2(v[q].x); acc[3] += c[q] * ub3(v[q].x); acc[4] += c[q] * ub0(v[q].y); acc[5] += c[q] * ub1(v[q].y); acc[6] += c[q] * ub2(v[q].y); acc[7] += c[q] * ub3(v[q].y); } }
        const float corr = -128.0f * csum;
        const f32x4 x0 = *(const f32x4*)(X1 + (size_t)t * D + tid * 8), x1 = *(const f32x4*)(X1 + (size_t)t * D + tid * 8 + 4);
        f32x4 y0 = x0 + ((f32x4){acc[0], acc[1], acc[2], acc[3]} + corr), y1 = x1 + ((f32x4){acc[4], acc[5], acc[6], acc[7]} + corr);
        float ss = (y0[0] * y0[0] + y0[1] * y0[1]) + (y0[2] * y0[2] + y0[3] * y0[3]) + (y1[0] * y1[0] + y1[1] * y1[1]) + (y1[2] * y1[2] + y1[3] * y1[3]);
        ss = wave_sum(ss); if (lane == 0) red[par * 8 + wave] = ss;
        WG_BAR();
        float tot = 0.f;
#pragma unroll
        for (int w = 0; w < 8; ++w) tot += red[par * 8 + w];
        const float rs = 1.0f / sqrtf(tot * (1.0f / D) + NORM_EPS);
        const f32x4 g0 = *(const f32x4*)(A->final_g + tid * 8), g1 = *(const f32x4*)(A->final_g + tid * 8 + 4);
        *(f32x4*)(A->out + (size_t)t * D + tid * 8) = y0 * rs * g0; *(f32x4*)(A->out + (size_t)t * D + tid * 8 + 4) = y1 * rs * g1;
    }
}

constexpr int NPH = 12;
__device__ __forceinline__ Frame make_frame(unsigned char* lds) {
    Frame F; int t = threadIdx.x; asm volatile("" : "+v"(t));
    F.lds = (LAS unsigned char*)lds; F.tid = t; F.lane = t & 63; F.wave = __builtin_amdgcn_readfirstlane(t >> 6);
    F.G = gridDim.x; { const int bx = blockIdx.x; F.vcu = (F.G % 8 == 0) ? (bx % 8) * (F.G / 8) + bx / 8 : bx; }
    return F;
}
__global__ void __launch_bounds__(NTHR, 2) mk_fwd(Args args_by_value) {
    extern __shared__ __attribute__((aligned(16))) unsigned char lds[];
    ArgsP args = get_args();
    gu32* ctl = (gu32*)(args->ws + WS_CTL);
    for (int u = threadIdx.x; u < (LDS_BYTES - LDSCTL_OFF) / 4; u += NTHR) ((LAS unsigned*)((LAS unsigned char*)lds + LDSCTL_OFF))[u] = 0u;
    __syncthreads();
    const int lo = args->ph_lo, hi = args->ph_hi;
    volatile LAS unsigned* MISC = (volatile LAS unsigned*)((LAS unsigned char*)lds + MISC_OFF);
    XcdBarrier bar; bar.bar = (unsigned*)(ctl + CW_BAR) + args->li * XCD_BAR_WORDS; bar.x = 0; bar.st = nullptr;
    if (hi - lo > 1) bar = xcd_barrier_post((unsigned*)(ctl + CW_BAR) + args->li * XCD_BAR_WORDS, MISC + 8);
#define IN(k) (lo <= (k) && (k) < hi)
#define SEAM(k) do { if (IN(k) && IN((k) + 1)) xcd_barrier(bar); } while (0)
    const int bid = (int)blockIdx.x;

    if (IN(0)) { Frame F = make_frame(lds); ph0_prologue(get_args(), F); SEAM(0); }
    if (IN(1)) { Frame F = make_frame(lds); LAS unsigned char* ring = F.lds + RING_OFF; ArgsP a_ = get_args(); unsigned char* ws = a_->ws;
        { pg8::Gemm g{(const bf16_t*)(ws + WS_XN), (const bf16_t*)(ws + WS_WIN), T, PLD, D}; pg8::StaticOrder S; S.init(T, PLD, F.G, bid);
          pg8::EpiProj E{(bf16_t*)(ws + WS_PROJ), (const float*)(ws + WS_ROPE)}; pg8::gemm_phase<pg8::EpiProj, pg8::StaticOrder, true, true>(ring, g, S, E); }
        { pg8::Gemm g{(const bf16_t*)(ws + WS_XN), (const bf16_t*)(ws + WS_WIN) + (size_t)PC_MV * D, T, 2048, D}; pg8::StaticOrder S; S.init(T, 2048, F.G, bid);
          pg8::EpiVT E{(bf16_t*)(ws + WS_VT)}; pg8::gemm_phase<pg8::EpiVT, pg8::StaticOrder, true, true>(ring, g, S, E); }
        { Frame F2 = make_frame(lds); const int rem = ((T / 256) * (PLD / 256)) % F2.G;
          if (rem == 0) peer_quant(get_args(), F2, bid * NWAVES + F2.wave, F2.G * NWAVES);
          else if (bid >= rem) peer_quant(get_args(), F2, (bid - rem) * NWAVES + F2.wave, (F2.G - rem) * NWAVES); }
        SEAM(1); }
    if (IN(2)) { Frame F = make_frame(lds); ph2_prep(get_args(), F); SEAM(2); }
    if (IN(3)) { Frame F = make_frame(lds); LAS unsigned char* ring = F.lds + RING_OFF; ArgsP a_ = get_args(); unsigned char* ws = a_->ws;
        { pg8::Gemm g{(const bf16_t*)(ws + WS_AW), (const bf16_t*)(ws + WS_WUP), T, RW, LW}; pg8::StaticOrder S; S.init(T, RW, F.G, bid);
          pg8::EpiDec E{(float*)(ws + WS_DEC), a_->w0}; pg8::gemm_phase<pg8::EpiDec, pg8::StaticOrder, true, true>(ring, g, S, E); }
        asm volatile("" ::: "memory"); __builtin_amdgcn_sched_barrier(0);
        { pg8::Gemm g{(const bf16_t*)(ws + WS_AA), (const bf16_t*)(ws + WS_AUP), T, RW, LA}; pg8::StaticOrder S; S.init(T, RW, F.G, bid);
          pg8::EpiA E{(bf16_t*)(ws + WS_KP), (bf16_t*)(ws + WS_BB), (const bf16_t*)(ws + WS_KKN), a_->a0, a_->k_a}; pg8::gemm_phase<pg8::EpiA, pg8::StaticOrder, true, true>(ring, g, S, E); }
        asm volatile("" ::: "memory"); __builtin_amdgcn_sched_barrier(0);
        { pg8::Gemm g{(const bf16_t*)(ws + WS_AG), (const bf16_t*)(ws + WS_GUP), T, RW, LGP}; pg8::StaticOrder S; S.init(T, RW, F.G, bid);
          pg8::EpiBf16 E{(bf16_t*)(ws + WS_G), RW}; pg8::gemm_phase<pg8::EpiBf16, pg8::StaticOrder, true, true>(ring, g, S, E); }
        { Frame F2 = make_frame(lds); ph3_gate(get_args(), F2); }
        SEAM(3); }
    if (IN(4)) {
        Frame F = make_frame(lds); const int nscan = F.G / 2;
        if (F.vcu < nscan) ph4_scan(get_args(), F, F.vcu, nscan);
        else { ph5_attn(get_args(), F, F.vcu - nscan, F.G - nscan); Frame F2 = make_frame(lds); late_weights(get_args(), F2, (F2.vcu - nscan) * NWAVES + F2.wave, (F2.G - nscan) * NWAVES); }
        SEAM(4); }
    if (IN(5)) { Frame F = make_frame(lds); ph5_ypost(get_args(), F); SEAM(5); }
    if (IN(6)) { Frame F = make_frame(lds); LAS unsigned char* ring = F.lds + RING_OFF; ArgsP a_ = get_args(); unsigned char* ws = a_->ws;
        { pg8::Gemm g{(const bf16_t*)(ws + WS_YA), (const bf16_t*)(ws + WS_WA), T, D, RW}; pg8::StaticOrder S; S.init(T, D, F.G, bid);
          pg8::EpiMix<false> E{(bf16_t*)(ws + WS_MIXED), (const bf16_t*)(ws + WS_PROJ), PC_GA}; pg8::gemm_phase<pg8::EpiMix<false>, pg8::StaticOrder, true, true>(ring, g, S, E); }
        { pg8::Gemm g{(const bf16_t*)(ws + WS_YB), (const bf16_t*)(ws + WS_WB), T, D, RW}; pg8::StaticOrder S; S.init(T, D, F.G, bid);
          pg8::EpiMix<true> E{(bf16_t*)(ws + WS_MIXED), (const bf16_t*)(ws + WS_PROJ), PC_GB}; pg8::gemm_phase<pg8::EpiMix<true>, pg8::StaticOrder, true, true>(ring, g, S, E); }
        SEAM(6); }
    if (IN(7)) { Frame F = make_frame(lds); LAS unsigned char* ring = F.lds + RING_OFF; ArgsP a_ = get_args(); unsigned char* ws = a_->ws;
        pg8::Gemm g{(const bf16_t*)(ws + WS_MIXED), (const bf16_t*)(ws + WS_WOUT), T, D, D}; pg8::StaticOrder S; S.init(T, D, F.G, bid);
        pg8::EpiRes E{(float*)(ws + WS_X1), a_->x}; pg8::gemm_phase<pg8::EpiRes, pg8::StaticOrder, true, true>(ring, g, S, E);
        SEAM(7); }
    if (IN(8)) { Frame F = make_frame(lds); ArgsP a_ = get_args(); unsigned char* ws = a_->ws; const int gw = F.vcu * NWAVES + F.wave, NGW = F.G * NWAVES;
        rms_rows_to_bf16((const float*)(ws + WS_X1), a_->norm2_g, (bf16_t*)(ws + WS_H2), gw, NGW, F.lane);
        SEAM(8); }
    if (IN(9)) { Frame F = make_frame(lds); LAS unsigned char* ring = F.lds + RING_OFF; ArgsP a_ = get_args(); unsigned char* ws = a_->ws;
        pg8::Gemm g{(const bf16_t*)(ws + WS_H2), (const bf16_t*)(ws + WS_WQ), T, 2048, D}; pg8::StaticOrder S; S.init(T, 2048, F.G, bid);
        pg8::EpiBf16 E{(bf16_t*)(ws + WS_PQ), 2048}; pg8::gemm_phase<pg8::EpiBf16, pg8::StaticOrder, true, true>(ring, g, S, E);
        SEAM(9); }
    if (IN(10)) { Frame F = make_frame(lds); ph10_select(get_args(), F); SEAM(10); }
    if (IN(11)) { Frame F = make_frame(lds); ph11_gather(get_args(), F); }
#undef IN
#undef SEAM
}

extern "C" void kernel_launch(void* const* d_in, const int* in_sizes, int n_in, void* d_out, int out_size, void* d_ws, size_t ws_size, hipStream_t stream) {
    static int grid = 0;
    if (grid == 0) {
        if (n_in != 23 || out_size != T * D || ws_size < WS_END) { fprintf(stderr, "kernel_launch: unexpected shapes (n_in %d out %d ws %zu); nothing launched\n", n_in, out_size, ws_size); grid = -1; return; }
        int dev = 0, cus = 0, per_cu = 0;
        if (hipGetDevice(&dev) != hipSuccess || hipDeviceGetAttribute(&cus, hipDeviceAttributeMultiprocessorCount, dev) != hipSuccess) { grid = -1; return; }
        if (hipFuncSetAttribute((const void*)mk_fwd, hipFuncAttributeMaxDynamicSharedMemorySize, LDS_BYTES) != hipSuccess) { grid = -1; return; }
        if (hipOccupancyMaxActiveBlocksPerMultiprocessor(&per_cu, (const void*)mk_fwd, NTHR, LDS_BYTES) != hipSuccess || per_cu < 1) fprintf(stderr, "kernel_launch: occupancy query reports %d\n", per_cu);
        (void)hipGetLastError();
        grid = cus;
    }
    if (grid < 0) return;
    (void)hipMemsetAsync((char*)d_ws + WS_CTL, 0, CTL_ZERO_BYTES, stream);
    Args a{};
    const float** ap = (const float**)&a;
    for (int i = 0; i < 23; ++i) ap[i] = (const float*)d_in[i];
    a.out = (float*)d_out; a.ws = (unsigned char*)d_ws; a.pad = 0;
    constexpr int NL = MK_N_LAUNCHES;
    for (int li = 0; li < NL; ++li) {
        a.ph_lo = (NL == 1) ? 0 : li; a.ph_hi = (NL == 1) ? NPH : li + 1; a.li = (NL == 1) ? 0 : 0;
        hipLaunchKernelGGL(mk_fwd, dim3(grid), dim3(NTHR), LDS_BYTES, stream, a);
#ifdef DUP_HI
        if (NL > 1 && li == DUP_HI) for (int l2 = DUP_LO; l2 <= DUP_HI; ++l2) { a.ph_lo = l2; a.ph_hi = l2 + 1; hipLaunchKernelGGL(mk_fwd, dim3(grid), dim3(NTHR), LDS_BYTES, stream, a); }
#endif
    }
}
```

```cpp
#include <hip/hip_runtime.h>
#include <cstdio>
#include <cstdint>

#ifndef MK_N_LAUNCHES
#define MK_N_LAUNCHES 1
#endif

#define GAS __attribute__((address_space(1)))
#define LAS __attribute__((address_space(3)))
typedef unsigned short bf16_t;
typedef __bf16 bf16x8 __attribute__((ext_vector_type(8)));
typedef float f32x2 __attribute__((ext_vector_type(2)));
typedef float f32x4 __attribute__((ext_vector_type(4)));
typedef float f32x16 __attribute__((ext_vector_type(16)));
typedef unsigned u32x2 __attribute__((ext_vector_type(2)));
typedef unsigned u32x4 __attribute__((ext_vector_type(4)));
typedef GAS unsigned gu32;

constexpr int T = 8192, D = 4096;
constexpr int RW = 2048, RH = 32, RN = 64;
constexpr int LW = 128, LA = 128, LG = 480, LGP = 512;
constexpr int SHIFTW = 6880;
constexpr int MH = 16, MD = 128, MBLK = 256, NBLK = 32;
constexpr int INW = 21216;
constexpr int PLD = 19200;
constexpr int PC_R = 0, PC_K = 2048, PC_V = 4096, PC_WL = 6144, PC_AL = 6272, PC_GL = 6400, PC_MQ = 6912, PC_MK = 8960, PC_GA = 11008, PC_GB = 15104, PC_MV = 19200;
constexpr int WIN_ROWS = 21248;
constexpr int PQ_SPLIT = 16384;
constexpr int PH_ = 8, PNK = 128, PQD = 256, PHALF = 128, PTOPK = 16;
constexpr float NORM_EPS = 1e-6f, LNX_EPS = 64e-5f;
constexpr float QSCALE = 0.08838834764831845f * 1.4426950408889634f;

constexpr size_t MiB = 1u << 20;
constexpr size_t WS_CTL = 0, CTL_ZERO_BYTES = 1 * MiB;
constexpr size_t WS_WIN = 1 * MiB;
constexpr size_t WS_X1 = 1 * MiB, WS_PQ = 129 * MiB;
constexpr size_t WS_WA = 167 * MiB, WS_WB = 183 * MiB, WS_WOUT = 199 * MiB, WS_WQ = 231 * MiB, WS_WUP = 247 * MiB, WS_AUP = 248 * MiB, WS_GUP = 249 * MiB, WS_SUBK = 251 * MiB;
constexpr size_t WS_PU = 252 * MiB, WS_PV = 380 * MiB;
constexpr size_t WS_XN = 508 * MiB;
constexpr size_t WS_Y = 508 * MiB, WS_H2 = 508 * MiB;
constexpr size_t WS_PROJ = 572 * MiB;
constexpr size_t WS_VT = 872 * MiB;
constexpr size_t WS_ROPE = 904 * MiB, WS_KMEAN = 908 * MiB, WS_MASK = 909 * MiB, WS_AW = 910 * MiB, WS_AA = 912 * MiB, WS_AG = 914 * MiB;
constexpr size_t WS_PSU = 909 * MiB + 512 * 1024, WS_PSV = WS_PSU + 64 * 1024;
constexpr size_t WS_DEC = 922 * MiB;
constexpr size_t WS_MIXED = 922 * MiB;
constexpr size_t WS_KKN = 986 * MiB, WS_BB = 1018 * MiB, WS_KP = 1050 * MiB, WS_ZR = 1082 * MiB, WS_ZV = 1114 * MiB, WS_G = 1146 * MiB;
constexpr size_t WS_YA = 1178 * MiB, WS_YB = 1210 * MiB, WS_IDX = 1242 * MiB, WS_GW = 1246 * MiB, WS_Z = 1250 * MiB, WS_SINIT = 1266 * MiB, WS_END = 1267 * MiB;

constexpr int CW_TMO = 0, CW_CODE = 1, CW_BAR = 4096;

constexpr int RING_OFF = 0, RING_BYTES = 155648;
constexpr int LDSCTL_OFF = RING_BYTES, MISC_OFF = LDSCTL_OFF + 320;
constexpr int LDS_BYTES = 163840;
constexpr int NWAVES = 8, NTHR = 512;

__device__ __forceinline__ unsigned f2bf(float f) { unsigned u = __builtin_bit_cast(unsigned, f); return (u + 0x7fffu + ((u >> 16) & 1u)) >> 16; }
__device__ __forceinline__ unsigned pk2(float lo, float hi) { unsigned r; asm volatile("v_cvt_pk_bf16_f32 %0, %1, %2" : "=v"(r) : "v"(lo), "v"(hi)); return r; }
__device__ __forceinline__ float bflo(unsigned u) { return __builtin_bit_cast(float, u << 16); }
__device__ __forceinline__ float bfhi(unsigned u) { return __builtin_bit_cast(float, u & 0xffff0000u); }
__device__ __forceinline__ float bf1(bf16_t b) { return __builtin_bit_cast(float, (unsigned)b << 16); }
__device__ __forceinline__ float fsigmoid(float x) { return __builtin_amdgcn_rcpf(1.0f + __expf(-x)); }
__device__ __forceinline__ float wave_sum(float v) {
#pragma unroll
    for (int o = 1; o < 64; o <<= 1) v += __shfl_xor(v, o);
    return v;
}
template <int CTRL> __device__ __forceinline__ float dpp_f(float v) { return __builtin_bit_cast(float, __builtin_amdgcn_update_dpp(0, __builtin_bit_cast(int, v), CTRL, 0xF, 0xF, true)); }
__device__ __forceinline__ float sum16(float x) {
    x += dpp_f<0xB1>(x); x += dpp_f<0x4E>(x); x += dpp_f<0x141>(x); x += dpp_f<0x140>(x); return x;
}
__device__ __forceinline__ float vmul(float a, float b) { float r; asm("v_mul_f32_e32 %0, %1, %2" : "=v"(r) : "v"(a), "v"(b)); return r; }
__device__ __forceinline__ float vfma(float a, float b, float c) { float r; asm("v_fma_f32 %0, %1, %2, %3" : "=v"(r) : "v"(a), "v"(b), "v"(c)); return r; }
#define LDS_WAIT() asm volatile("s_waitcnt lgkmcnt(0)" ::: "memory")
#define VM_WAIT() asm volatile("s_waitcnt vmcnt(0)" ::: "memory")
#define WG_BAR() do { asm volatile("s_waitcnt lgkmcnt(0)" ::: "memory"); __builtin_amdgcn_s_barrier(); asm volatile("" ::: "memory"); } while (0)

namespace pg8 {
constexpr int BM = 256, BK = 64, HALF = 128, HTB = HALF * BK * 2, STAGE_BYTES = 8 * HTB, NXCD = 8, WGM = 8;
__host__ __device__ __forceinline__ int lds_byte(int r, int c) { const int st = (r >> 4) * 2 + (c >> 5), rr = r & 15, cc = c & 31, ob = rr * 64 + cc * 2; return st * 1024 + (ob ^ (((ob >> 9) & 1) << 5)); }
__host__ __device__ __forceinline__ void stage_rc(int b, int& R, int& C) { const int st = b / 1024, sb = b % 1024, swz = sb ^ (((sb >> 9) & 1) << 5); R = (st >> 1) * 16 + swz / 64; C = (st & 1) * 32 + (swz % 64) / 2; }
__host__ __device__ __forceinline__ int perm32(int rho) { const int n = rho >> 4, i = rho & 15; return 8 * (i >> 2) + 4 * n + (i & 3); }

struct Unit { int pm, pn; };
struct Gemm { const bf16_t* A; const bf16_t* Bt; int M, N, K; };

struct StaticOrder {
    int nM, nN, nwg, G, c;
    __host__ __device__ void init(int M, int N, int G_, int c_) { nM = M / BM; nN = N / BM; nwg = nM * nN; G = G_; c = c_; }
    __host__ __device__ bool next(int i, Unit& u) const {
        const long L = (long)i * G + c; if (L >= nwg) return false;
        int wgid = (int)L; { const int q = nwg / NXCD, r = nwg % NXCD, xcd = wgid % NXCD, off = wgid / NXCD; wgid = (xcd < r ? xcd * (q + 1) : r * (q + 1) + (xcd - r) * q) + off; }
        const int nig = WGM * nN, gid = wgid / nig, fm = gid * WGM, gsz = (nM - fm) < WGM ? (nM - fm) : WGM;
        u.pm = fm + ((wgid % nig) % gsz); u.pn = (wgid % nig) / gsz; return true;
    }
    __device__ __forceinline__ void a_ready(const Unit&) const {}
    __device__ __forceinline__ void done(const Unit&) const {}
};

template <class Epi, class Sched, bool ALIGN_EPI = false, bool SP2 = false>
__device__ __forceinline__ void gemm_phase(LAS unsigned char* lds, const Gemm g, const Sched& S, const Epi& E) {
    int tid_ = threadIdx.x; asm volatile("" : "+v"(tid_));
    const int tid = tid_, wid = __builtin_amdgcn_readfirstlane(tid >> 6), lane = tid & 63, wr = wid >> 2, wc = wid & 3, fr = lane & 15, fq = lane >> 4;
    int K_ = g.K; asm volatile("" : "+s"(K_));
    const int K = K_, nt = K / BK;
    unsigned voffA[2], voffB[2];
#pragma unroll
    for (int i = 0; i < 2; ++i) { int R, C; stage_rc(tid * 16 + i * 8192, R, C); const int Rb = Epi::PERM ? ((R & ~31) + perm32(R & 31)) : R;
        voffA[i] = (unsigned)(R * K + C) * 2u; voffB[i] = (unsigned)(Rb * K + C) * 2u; }
    const size_t kstep = (size_t)(BK * 2);
    const size_t hstep = (size_t)HALF * K * 2;
    const size_t tstep = 2 * hstep;
    const unsigned ldsw = (unsigned)wid * 1024u;
    const int aoff = lds_byte(wr * 64 + fr, fq * 8), boff = lds_byte(wc * 32 + fr, fq * 8);
#define PG8_SA(b, h) (((b) * 2 + (h)) * HTB)
#define PG8_SB(b, h) ((4 + (b) * 2 + (h)) * HTB)
#define PG8_STAGE(bufoff, gbase, voff) do { _Pragma("unroll") for (int _i = 0; _i < 2; ++_i) \
        __builtin_amdgcn_global_load_lds((const unsigned*)((const char*)(gbase) + (voff)[_i]), (LAS unsigned*)(lds + (bufoff) + ldsw + _i * 8192), 16, 0, 0); } while (0)
#define PG8_LDA(dst, b, h) do { _Pragma("unroll") for (int m = 0; m < 4; ++m) _Pragma("unroll") for (int k = 0; k < 2; ++k) dst[m][k] = *(const LAS bf16x8*)(lds + PG8_SA(b, h) + aoff + m * 2048 + k * 1024); } while (0)
#define PG8_LDB(dst, b, h) do { _Pragma("unroll") for (int n = 0; n < 2; ++n) _Pragma("unroll") for (int k = 0; k < 2; ++k) dst[n][k] = *(const LAS bf16x8*)(lds + PG8_SB(b, h) + boff + n * 2048 + k * 1024); } while (0)
#define PG8_MMA(ai, bj, At, Bt) do { __builtin_amdgcn_s_setprio(1); _Pragma("unroll") for (int m = 0; m < 4; ++m) _Pragma("unroll") for (int n = 0; n < 2; ++n) _Pragma("unroll") for (int k = 0; k < 2; ++k) { \
        if constexpr (Epi::SWAP) acc[ai][bj][m][n] = __builtin_amdgcn_mfma_f32_16x16x32_bf16(At[m][k], Bt[n][k], acc[ai][bj][m][n], 0, 0, 0); \
        else acc[ai][bj][m][n] = __builtin_amdgcn_mfma_f32_16x16x32_bf16(Bt[n][k], At[m][k], acc[ai][bj][m][n], 0, 0, 0); } __builtin_amdgcn_s_setprio(0); } while (0)
#define PG8_WAIT_V(n) asm volatile("s_waitcnt vmcnt(" #n ")" ::: "memory")
#define PG8_WAIT_L(n) asm volatile("s_waitcnt lgkmcnt(" #n ")" ::: "memory")
#define PG8_BAR __builtin_amdgcn_s_barrier()
#define PG8_SCHED __builtin_amdgcn_sched_barrier(0)
    Unit cur, nxt; int ui = 0;
    if (!S.next(0, cur)) return;
    f32x4 acc[2][2][4][2];
#pragma unroll
    for (int a = 0; a < 2; ++a)
#pragma unroll
        for (int b = 0; b < 2; ++b)
#pragma unroll
            for (int m = 0; m < 4; ++m)
#pragma unroll
                for (int n = 0; n < 2; ++n) acc[a][b][m][n] = (f32x4){0.f, 0.f, 0.f, 0.f};
    bf16x8 At[4][2], B0[2][2], B1[2][2];
    const char* cA = (const char*)g.A + (size_t)cur.pm * tstep; const char* cB = (const char*)g.Bt + (size_t)cur.pn * tstep;
    S.a_ready(cur);
    if constexpr (SP2) {
        PG8_STAGE(PG8_SB(0, 0), cB, voffB); PG8_STAGE(PG8_SB(0, 1), cB + hstep, voffB); PG8_STAGE(PG8_SA(0, 0), cA, voffA); PG8_STAGE(PG8_SA(0, 1), cA + hstep, voffA);
        if (wr == 1) PG8_BAR;
        PG8_WAIT_V(2); PG8_BAR;
        PG8_STAGE(PG8_SB(1, 0), cB + kstep, voffB); PG8_STAGE(PG8_SA(1, 0), cA + kstep, voffA); PG8_STAGE(PG8_SB(1, 1), cB + hstep + kstep, voffB);
        PG8_WAIT_V(6); PG8_BAR;
    } else {
        PG8_STAGE(PG8_SB(0, 0), cB, voffB); PG8_STAGE(PG8_SA(0, 0), cA, voffA); PG8_STAGE(PG8_SB(0, 1), cB + hstep, voffB); PG8_STAGE(PG8_SA(0, 1), cA + hstep, voffA);
        if (wr == 1) PG8_BAR;
        PG8_WAIT_V(4); PG8_BAR;
        PG8_STAGE(PG8_SB(1, 0), cB + kstep, voffB); PG8_STAGE(PG8_SA(1, 0), cA + kstep, voffA); PG8_STAGE(PG8_SB(1, 1), cB + hstep + kstep, voffB);
        PG8_WAIT_V(6); PG8_BAR;
    }
    for (;;) {
        const bool has_next = S.next(ui + 1, nxt);
        const char* nA = has_next ? (const char*)g.A + (size_t)nxt.pm * tstep : cA; const char* nB = has_next ? (const char*)g.Bt + (size_t)nxt.pn * tstep : cB;
        for (int t = 0; t < nt; t += 2) {
            const bool last = (t == nt - 2);
            const char* a1 = cA + (size_t)(t + 1) * kstep;
            const char* a2 = last ? nA : cA + (size_t)(t + 2) * kstep; const char* b2 = last ? nB : cB + (size_t)(t + 2) * kstep;
            const char* a3 = a2 + kstep; const char* b3 = b2 + kstep;
            if (last && has_next) S.a_ready(nxt);
            if constexpr (SP2) {
            PG8_LDB(B0, 0, 0); PG8_LDB(B1, 0, 1); PG8_SCHED; PG8_LDA(At, 0, 0); PG8_STAGE(PG8_SA(1, 1), a1 + hstep, voffA);
            PG8_WAIT_V(8); PG8_WAIT_L(0); PG8_BAR; PG8_MMA(0, 0, At, B0); PG8_MMA(0, 1, At, B1); PG8_BAR; PG8_SCHED;
            PG8_LDA(At, 0, 1); PG8_STAGE(PG8_SB(0, 0), b2, voffB); PG8_STAGE(PG8_SB(0, 1), b2 + hstep, voffB); PG8_STAGE(PG8_SA(0, 0), a2, voffA);
            PG8_WAIT_V(8); PG8_WAIT_L(0); PG8_BAR; PG8_MMA(1, 0, At, B0); PG8_MMA(1, 1, At, B1); PG8_BAR; PG8_SCHED;
            PG8_LDB(B0, 1, 0); PG8_LDB(B1, 1, 1); PG8_SCHED; PG8_LDA(At, 1, 0); PG8_STAGE(PG8_SA(0, 1), a2 + hstep, voffA);
            PG8_WAIT_V(8); PG8_WAIT_L(0); PG8_BAR; PG8_MMA(0, 0, At, B0); PG8_MMA(0, 1, At, B1); PG8_BAR; PG8_SCHED;
            PG8_LDA(At, 1, 1); PG8_STAGE(PG8_SB(1, 0), b3, voffB); PG8_STAGE(PG8_SB(1, 1), b3 + hstep, voffB); PG8_STAGE(PG8_SA(1, 0), a3, voffA);
            PG8_WAIT_V(8); PG8_WAIT_L(0); PG8_BAR; PG8_MMA(1, 0, At, B0); PG8_MMA(1, 1, At, B1); PG8_BAR; PG8_SCHED;
            } else {
            PG8_LDB(B0, 0, 0); PG8_SCHED; PG8_LDA(At, 0, 0); PG8_STAGE(PG8_SA(1, 1), a1 + hstep, voffA);
            PG8_WAIT_L(8); PG8_BAR; PG8_WAIT_L(0); PG8_MMA(0, 0, At, B0); PG8_BAR; PG8_SCHED;
            PG8_LDB(B1, 0, 1); PG8_STAGE(PG8_SB(0, 0), b2, voffB);
            PG8_BAR; PG8_WAIT_L(0); PG8_MMA(0, 1, At, B1); PG8_BAR;
            PG8_LDA(At, 0, 1); PG8_STAGE(PG8_SA(0, 0), a2, voffA);
            PG8_BAR; PG8_WAIT_L(0); PG8_MMA(1, 0, At, B0); PG8_BAR; PG8_SCHED;
            PG8_STAGE(PG8_SB(0, 1), b2 + hstep, voffB);
            PG8_WAIT_V(6); PG8_BAR; PG8_MMA(1, 1, At, B1); PG8_BAR;
            PG8_LDB(B0, 1, 0); PG8_SCHED; PG8_LDA(At, 1, 0); PG8_STAGE(PG8_SA(0, 1), a2 + hstep, voffA);
            PG8_WAIT_L(8); PG8_BAR; PG8_WAIT_L(0); PG8_MMA(0, 0, At, B0); PG8_BAR; PG8_SCHED;
            PG8_LDB(B1, 1, 1); PG8_STAGE(PG8_SB(1, 0), b3, voffB);
            PG8_BAR; PG8_WAIT_L(0); PG8_MMA(0, 1, At, B1); PG8_BAR;
            PG8_LDA(At, 1, 1); PG8_STAGE(PG8_SA(1, 0), a3, voffA);
            PG8_BAR; PG8_WAIT_L(0); PG8_MMA(1, 0, At, B0); PG8_BAR; PG8_SCHED;
            PG8_STAGE(PG8_SB(1, 1), b3 + hstep, voffB);
            PG8_WAIT_V(6); PG8_BAR; PG8_MMA(1, 1, At, B1); PG8_BAR;
            }
        }
        if constexpr (ALIGN_EPI) { if (wr == 0) PG8_BAR; }
        E(acc, cur, wr, wc, fr, fq); S.done(cur);
        if (!has_next) break;
#pragma unroll
        for (int a = 0; a < 2; ++a)
#pragma unroll
            for (int b = 0; b < 2; ++b)
#pragma unroll
                for (int m = 0; m < 4; ++m)
#pragma unroll
                    for (int n = 0; n < 2; ++n) acc[a][b][m][n] = (f32x4){0.f, 0.f, 0.f, 0.f};
        cur = nxt; cA = nA; cB = nB; ++ui;
        if constexpr (ALIGN_EPI) { if (wr == 1) PG8_BAR; }
    }
    PG8_WAIT_V(0);
    if constexpr (!ALIGN_EPI) { if (wr == 0) PG8_BAR; }
    PG8_BAR;
#undef PG8_SA
#undef PG8_SB
#undef PG8_STAGE
#undef PG8_LDA
#undef PG8_LDB
#undef PG8_MMA
#undef PG8_WAIT_V
#undef PG8_WAIT_L
#undef PG8_BAR
#undef PG8_SCHED
}

typedef const f32x4 (&AccRef)[2][2][4][2];
__device__ __forceinline__ u32x4 pack8(f32x4 v0, f32x4 v1) { u32x4 w; w.x = pk2(v0[0], v0[1]); w.y = pk2(v0[2], v0[3]); w.z = pk2(v1[0], v1[1]); w.w = pk2(v1[2], v1[3]); return w; }
__device__ __forceinline__ void unpack8(u32x4 w, f32x4& v0, f32x4& v1) { v0 = (f32x4){bflo(w.x), bfhi(w.x), bflo(w.y), bfhi(w.y)}; v1 = (f32x4){bflo(w.z), bfhi(w.z), bflo(w.w), bfhi(w.w)}; }

struct EpiBf16 {
    static constexpr bool PERM = true, SWAP = false;
    bf16_t* O; int ldc;
    __device__ __forceinline__ void operator()(AccRef acc, const Unit& u, int wr, int wc, int fr, int fq) const {
        const int row0 = u.pm * BM + wr * 64 + fr, col0 = u.pn * BM + wc * 32 + 8 * fq;
#pragma unroll
        for (int ai = 0; ai < 2; ++ai)
#pragma unroll
            for (int m = 0; m < 4; ++m) { bf16_t* rowp = O + (size_t)(row0 + ai * HALF + m * 16) * ldc + col0;
#pragma unroll
                for (int bj = 0; bj < 2; ++bj) *(u32x4*)(rowp + bj * HALF) = pack8(acc[ai][bj][m][0], acc[ai][bj][m][1]); }
    }
};
struct EpiProj {
    static constexpr bool PERM = true, SWAP = false;
    bf16_t* O; const float* rope;
    __device__ __forceinline__ void operator()(AccRef acc, const Unit& u, int wr, int wc, int fr, int fq) const {
        const int row0 = u.pm * BM + wr * 64 + fr, col0 = u.pn * BM + wc * 32 + 8 * fq;
        const int mode = (u.pn >= 27 && u.pn < 43) ? (u.pn < 35 ? 1 : 2) : 0;
        const float sc = (mode == 1) ? QSCALE : 1.0f;
#pragma unroll
        for (int ai = 0; ai < 2; ++ai)
#pragma unroll
            for (int m = 0; m < 4; ++m) { const int row = row0 + ai * HALF + m * 16; bf16_t* rowp = O + (size_t)row * PLD + col0;
#pragma unroll
                for (int bj = 0; bj < 2; ++bj) { f32x4 v0 = acc[ai][bj][m][0], v1 = acc[ai][bj][m][1];
                    if (mode) { const int i0 = ((col0 + bj * HALF) & 127) >> 1; const f32x4* rp = (const f32x4*)(rope + ((size_t)row * 64 + i0) * 2); const f32x4 c0 = rp[0], c1 = rp[1];
                        f32x4 o0, o1;
                        o0[0] = v0[0] * c0[0] - v0[1] * c0[1]; o0[1] = v0[1] * c0[0] + v0[0] * c0[1]; o0[2] = v0[2] * c0[2] - v0[3] * c0[3]; o0[3] = v0[3] * c0[2] + v0[2] * c0[3];
                        o1[0] = v1[0] * c1[0] - v1[1] * c1[1]; o1[1] = v1[1] * c1[0] + v1[0] * c1[1]; o1[2] = v1[2] * c1[2] - v1[3] * c1[3]; o1[3] = v1[3] * c1[2] + v1[2] * c1[3];
                        v0 = o0 * sc; v1 = o1 * sc; }
                    *(u32x4*)(rowp + bj * HALF) = pack8(v0, v1); } }
    }
};
struct EpiVT {
    static constexpr bool PERM = false, SWAP = true;
    bf16_t* VT;
    __device__ __forceinline__ void operator()(AccRef acc, const Unit& u, int wr, int wc, int fr, int fq) const {
        const int tok0 = u.pm * BM + wr * 64 + 4 * fq, col0 = u.pn * BM + wc * 32 + fr;
#pragma unroll
        for (int ai = 0; ai < 2; ++ai)
#pragma unroll
            for (int m = 0; m < 4; ++m)
#pragma unroll
                for (int bj = 0; bj < 2; ++bj)
#pragma unroll
                    for (int n = 0; n < 2; ++n) { const f32x4 v = acc[ai][bj][m][n]; u32x2 w; w.x = pk2(v[0], v[1]); w.y = pk2(v[2], v[3]);
                        *(u32x2*)(VT + (size_t)(col0 + bj * HALF + n * 16) * T + tok0 + ai * HALF + m * 16) = w; }
    }
};
struct EpiDec {
    static constexpr bool PERM = true, SWAP = false;
    float* O; const float* w0;
    __device__ __forceinline__ void operator()(AccRef acc, const Unit& u, int wr, int wc, int fr, int fq) const {
        const int row0 = u.pm * BM + wr * 64 + fr, col0 = u.pn * BM + wc * 32 + 8 * fq;
#pragma unroll
        for (int bj = 0; bj < 2; ++bj) { const f32x4 b0 = *(const f32x4*)(w0 + col0 + bj * HALF), b1 = *(const f32x4*)(w0 + col0 + bj * HALF + 4);
#pragma unroll
            for (int ai = 0; ai < 2; ++ai)
#pragma unroll
                for (int m = 0; m < 4; ++m) { float* rowp = O + (size_t)(row0 + ai * HALF + m * 16) * RW + col0 + bj * HALF;
#pragma unroll
                    for (int n = 0; n < 2; ++n) { const f32x4 x = acc[ai][bj][m][n] + (n ? b1 : b0); f32x4 o;
#pragma unroll
                        for (int e = 0; e < 4; ++e) { const float z = -x[e]; const float sp = fmaxf(z, 0.f) + __logf(1.0f + __expf(-fabsf(z))); o[e] = __expf(-__expf(-sp - 0.5f)); }
                        *(f32x4*)(rowp + 4 * n) = o; }
                    asm volatile("" ::: "memory"); } }
    }
};
struct EpiA {
    static constexpr bool PERM = true, SWAP = false;
    bf16_t* KP; bf16_t* BB; const bf16_t* KKN; const float* a0; const float* k_a;
    __device__ __forceinline__ void operator()(AccRef acc, const Unit& u, int wr, int wc, int fr, int fq) const {
        const int row0 = u.pm * BM + wr * 64 + fr, col0 = u.pn * BM + wc * 32 + 8 * fq;
#pragma unroll
        for (int bj = 0; bj < 2; ++bj) { const int cb = col0 + bj * HALF;
            const f32x4 b0 = *(const f32x4*)(a0 + cb), b1 = *(const f32x4*)(a0 + cb + 4), ka0 = *(const f32x4*)(k_a + cb), ka1 = *(const f32x4*)(k_a + cb + 4);
#pragma unroll
            for (int ai = 0; ai < 2; ++ai)
#pragma unroll
                for (int m = 0; m < 4; ++m) { const size_t off = (size_t)(row0 + ai * HALF + m * 16) * RW + cb;
                    f32x4 zk0, zk1, kn0, kn1; unpack8(*(const u32x4*)(KP + off), zk0, zk1); unpack8(*(const u32x4*)(KKN + off), kn0, kn1);
                    f32x4 a0v, a1v;
#pragma unroll
                    for (int e = 0; e < 4; ++e) { a0v[e] = fsigmoid(acc[ai][bj][m][0][e] + b0[e]); a1v[e] = fsigmoid(acc[ai][bj][m][1][e] + b1[e]); }
                    const f32x4 kp0 = zk0 * (1.0f + (a0v - 1.0f) * ka0), kp1 = zk1 * (1.0f + (a1v - 1.0f) * ka1);
                    *(u32x4*)(KP + off) = pack8(kp0, kp1); *(u32x4*)(BB + off) = pack8(-(kn0 * a0v), -(kn1 * a1v));
                    asm volatile("" ::: "memory"); } }
    }
};
template <bool ADD> struct EpiMix {
    static constexpr bool PERM = true, SWAP = false;
    bf16_t* O; const bf16_t* proj; int gcol0;
    __device__ __forceinline__ void operator()(AccRef acc, const Unit& u, int wr, int wc, int fr, int fq) const {
        const int row0 = u.pm * BM + wr * 64 + fr, col0 = u.pn * BM + wc * 32 + 8 * fq;
#pragma unroll
        for (int ai = 0; ai < 2; ++ai)
#pragma unroll
            for (int m = 0; m < 4; ++m) { const int row = row0 + ai * HALF + m * 16;
#pragma unroll
                for (int bj = 0; bj < 2; ++bj) { f32x4 g0, g1; unpack8(*(const u32x4*)(proj + (size_t)row * PLD + gcol0 + col0 + bj * HALF), g0, g1);
                    f32x4 o0, o1;
#pragma unroll
                    for (int e = 0; e < 4; ++e) { o0[e] = fsigmoid(g0[e]) * acc[ai][bj][m][0][e]; o1[e] = fsigmoid(g1[e]) * acc[ai][bj][m][1][e]; }
                    bf16_t* op = O + (size_t)row * D + col0 + bj * HALF;
                    if (ADD) { f32x4 p0, p1; unpack8(*(const u32x4*)op, p0, p1); o0 += p0; o1 += p1; }
                    *(u32x4*)op = pack8(o0, o1); } }
    }
};
struct EpiRes {
    static constexpr bool PERM = true, SWAP = false;
    float* O; const float* x;
    __device__ __forceinline__ void operator()(AccRef acc, const Unit& u, int wr, int wc, int fr, int fq) const {
        const int row0 = u.pm * BM + wr * 64 + fr, col0 = u.pn * BM + wc * 32 + 8 * fq;
#pragma unroll
        for (int ai = 0; ai < 2; ++ai)
#pragma unroll
            for (int m = 0; m < 4; ++m) { const size_t off = (size_t)(row0 + ai * HALF + m * 16) * D + col0;
#pragma unroll
                for (int bj = 0; bj < 2; ++bj)
#pragma unroll
                    for (int n = 0; n < 2; ++n) *(f32x4*)(O + off + bj * HALF + 4 * n) = *(const f32x4*)(x + off + bj * HALF + 4 * n) + acc[ai][bj][m][n]; }
    }
};
}

#define XB_TMO      128
#define XB_XCNT(j)  (256  + 64 * (j))
#define XB_XSUB(j)  (1280 + 64 * (j))
#define XB_XGEN(j)  (2304 + 64 * (j))
#define XB_TOP      3328
#define XB_TOPGEN   3392
#define XCD_BAR_WORDS 3456
#define XB_SPIN_CAP (1u << 18)
__device__ __forceinline__ unsigned xb_ld(unsigned* p)              { return __hip_atomic_load(p, __ATOMIC_RELAXED, __HIP_MEMORY_SCOPE_AGENT); }
__device__ __forceinline__ unsigned xb_add(unsigned* p, unsigned v) { return __hip_atomic_fetch_add(p, v, __ATOMIC_RELAXED, __HIP_MEMORY_SCOPE_AGENT); }
__device__ __forceinline__ unsigned xb_xcc_id() { return (unsigned)__builtin_amdgcn_s_getreg((3 << 11) | 20) & 0xFu; }
#define XB_SPIN(cond, bar) do { unsigned _sp = 0; while (cond) { __builtin_amdgcn_s_sleep(1); \
    if ((++_sp & 255u) == 0u) { if (xb_ld(&(bar)[XB_TMO])) break; if (_sp > XB_SPIN_CAP) { atomicAdd(&(bar)[XB_TMO], 1u); break; } } } } while (0)
struct XcdBarrier { unsigned* bar; unsigned x; volatile LAS unsigned* st; };
__device__ __forceinline__ XcdBarrier xcd_barrier_post(unsigned* bar, volatile LAS unsigned* st) {
    XcdBarrier b; b.bar = bar; b.x = xb_xcc_id(); b.st = st;
    if (threadIdx.x == 0) (void)xb_add(&bar[XB_XCNT(b.x)], 1u);
    return b;
}
__device__ __forceinline__ void xcd_barrier_complete(unsigned* bar, unsigned x, unsigned& nloc, unsigned& nx) {
    const unsigned G = gridDim.x * gridDim.y * gridDim.z;
    unsigned sum, cnt, mine, sp = 0u;
    for (;;) {
        sum = 0u; cnt = 0u; mine = 0u;
#pragma unroll
        for (unsigned j = 0; j < 16; ++j) { const unsigned c = xb_ld(&bar[XB_XCNT(j)]); sum += c; cnt += (c > 0u) ? 1u : 0u; mine = (j == x) ? c : mine; }
        if (sum == G) break;
        __builtin_amdgcn_s_sleep(1);
        if ((++sp & 255u) == 0u) { if (xb_ld(&bar[XB_TMO])) break; if (sp > XB_SPIN_CAP) { atomicAdd(&bar[XB_TMO], 1u); break; } }
    }
    nloc = mine > 0u ? mine : 1u; nx = cnt > 0u ? cnt : 1u;
}
__device__ __forceinline__ void xcd_barrier(const XcdBarrier& b) {
    asm volatile("s_waitcnt vmcnt(0)" ::: "memory");
    __syncthreads();
    if (threadIdx.x == 0) {
        unsigned* bar = b.bar;
        __builtin_amdgcn_s_waitcnt(0);
        unsigned nloc = b.st[0], nx = b.st[1];
        if (nloc == 0u) { xcd_barrier_complete(bar, b.x, nloc, nx); b.st[0] = nloc; b.st[1] = nx; }
        const unsigned old = xb_add(&bar[XB_XSUB(b.x)], 1u);
        const unsigned gen = old / nloc;
        if (old + 1u == (gen + 1u) * nloc) {
            __builtin_amdgcn_fence(__ATOMIC_RELEASE, "agent");
            asm volatile("s_waitcnt vmcnt(0)" ::: "memory");
            const unsigned og = xb_add(&bar[XB_TOP], 1u);
            const unsigned tg = og / nx;
            if (og + 1u == (tg + 1u) * nx) xb_add(&bar[XB_TOPGEN], 1u);
            else XB_SPIN(xb_ld(&bar[XB_TOPGEN]) == tg, bar);
            __builtin_amdgcn_fence(__ATOMIC_ACQUIRE, "agent");
            xb_add(&bar[XB_XGEN(b.x)], 1u);
            asm volatile("s_waitcnt vmcnt(0)" ::: "memory");
        } else {
            XB_SPIN(xb_ld(&bar[XB_XGEN(b.x)]) == gen, bar);
            __builtin_amdgcn_fence(__ATOMIC_ACQUIRE, "agent");
            asm volatile("s_waitcnt vmcnt(0)" ::: "memory");
        }
    }
    __syncthreads();
}

struct Args {
    const float *x, *norm1_g, *w_in, *mu, *w0, *w_up, *a0, *a_up, *g_up, *k_k, *k_a, *r_k, *lnx_g, *lnx_b, *w_ba, *w_bb, *w_out, *norm2_g, *peer_wq, *sub_keys, *peer_u, *peer_v, *final_g;
    float* out; unsigned char* ws; int ph_lo, ph_hi, li, pad;
};
#define CAS __attribute__((address_space(4)))
typedef const CAS Args* ArgsP;
__device__ __forceinline__ ArgsP get_args() { ArgsP p = (ArgsP)__builtin_amdgcn_kernarg_segment_ptr(); asm volatile("" : "+s"(p)); return p; }
struct Frame { LAS unsigned char* lds; int tid, lane, wave, vcu, G; };

__device__ __forceinline__ int win_dst(int s) {
    if (s < SHIFTW) return s;
    if (s < SHIFTW + 4096) { const int base = (s < SHIFTW + 2048) ? SHIFTW : SHIFTW + 2048; const int m = s - base, head = m >> 7, c = m & 127; const int j = (c < 64) ? 2 * c : 2 * (c - 64) + 1;
        return ((s < SHIFTW + 2048) ? PC_MQ : PC_MK) + head * 128 + j; }
    if (s < SHIFTW + 6144) return PC_MV + (s - (SHIFTW + 4096));
    if (s < SHIFTW + 6144 + 4096) return PC_GA + (s - (SHIFTW + 6144));
    return PC_GB + (s - (SHIFTW + 6144 + 4096));
}
template <bool MAPWIN> __device__ __forceinline__ void p0_transpose_item(const float* W, int K, int N, bf16_t* WT, int Kd, LAS float* scr, int item, int lane) {
    const int nblk = N / 32, kb = item / nblk, nb = item % nblk, k0 = 64 * kb, n0 = 32 * nb;
    { const int krow = lane >> 3, c4 = lane & 7; f32x4 v[8];
#pragma unroll
      for (int i = 0; i < 8; ++i) { const int kk = 8 * i + krow; v[i] = (k0 + kk < K) ? *(const f32x4*)(W + (size_t)(k0 + kk) * N + n0 + 4 * c4) : (f32x4){0.f, 0.f, 0.f, 0.f}; }
#pragma unroll
      for (int i = 0; i < 8; ++i) { LAS float* d = scr + (8 * i + krow) * 33 + 4 * c4; d[0] = v[i].x; d[1] = v[i].y; d[2] = v[i].z; d[3] = v[i].w; } }
    LDS_WAIT(); asm volatile("" ::: "memory");
    const int c = lane & 7;
#pragma unroll
    for (int j = 0; j < 4; ++j) { const int n = (lane >> 3) + 8 * j; const LAS float* s = scr + (8 * c) * 33 + n;
        u32x4 o; o.x = pk2(s[0 * 33], s[1 * 33]); o.y = pk2(s[2 * 33], s[3 * 33]); o.z = pk2(s[4 * 33], s[5 * 33]); o.w = pk2(s[6 * 33], s[7 * 33]);
        const int row = MAPWIN ? win_dst(n0 + n) : (n0 + n);
        *(u32x4*)(WT + (size_t)row * Kd + k0 + 8 * c) = o; }
    LDS_WAIT(); asm volatile("" ::: "memory");
}
__device__ __forceinline__ void rms_rows_to_bf16(const float* x, const float* g, bf16_t* o, int m0, int mstride, int lane) {
    const f32x4* gr = (const f32x4*)g + lane;
    f32x4 v[16], w[16];
    if (m0 < T) {
#pragma unroll
        for (int j = 0; j < 16; ++j) v[j] = ((const f32x4*)(x + (size_t)m0 * D) + lane)[64 * j]; }
    for (int m = m0; m < T; m += mstride) { const bool hasn = m + mstride < T;
        if (hasn) {
#pragma unroll
            for (int j = 0; j < 16; ++j) w[j] = ((const f32x4*)(x + (size_t)(m + mstride) * D) + lane)[64 * j]; }
        float s = 0.f;
#pragma unroll
        for (int j = 0; j < 16; ++j) s += (v[j].x * v[j].x + v[j].y * v[j].y) + (v[j].z * v[j].z + v[j].w * v[j].w);
        const float rs = 1.0f / sqrtf(wave_sum(s) * (1.0f / D) + NORM_EPS);
        u32x2* o8 = (u32x2*)(o + (size_t)m * D) + lane;
#pragma unroll
        for (int j = 0; j < 16; ++j) { const f32x4 gg = gr[64 * j]; u32x2 q; q.x = pk2(v[j].x * rs * gg.x, v[j].y * rs * gg.y); q.y = pk2(v[j].z * rs * gg.z, v[j].w * rs * gg.w); o8[64 * j] = q; }
        if (hasn) {
#pragma unroll
            for (int j = 0; j < 16; ++j) v[j] = w[j]; }
    }
}
__device__ __forceinline__ void cvt_table(const float* src, bf16_t* dst, size_t n8, size_t gtid, size_t nthr) {
    for (size_t i = gtid; i < n8; i += nthr) { const f32x4 a = ((const f32x4*)src)[2 * i], b = ((const f32x4*)src)[2 * i + 1]; ((u32x4*)dst)[i] = pg8::pack8(a, b); }
}
__device__ __forceinline__ void pq_load(ArgsP A, int row, int lane, f32x4 (&v)[16]) {
    const f32x4* src = (const f32x4*)((row >= 16384 ? A->peer_v + (size_t)(row - 16384) * D : A->peer_u + (size_t)row * D)) + lane;
#pragma unroll
    for (int j = 0; j < 16; ++j) v[j] = __builtin_nontemporal_load(src + 64 * j);
}
__device__ __forceinline__ void pq_finish(unsigned char* ws, int row, int lane, const f32x4 (&v)[16]) {
    const bool isv = row >= 16384; const int rr = isv ? row - 16384 : row; float am = 0.f;
#pragma unroll
    for (int j = 0; j < 16; ++j) am = fmaxf(fmaxf(am, fmaxf(fabsf(v[j].x), fabsf(v[j].y))), fmaxf(fabsf(v[j].z), fabsf(v[j].w)));
#pragma unroll
    for (int o = 1; o < 64; o <<= 1) am = fmaxf(am, __shfl_xor(am, o));
    const float inv = am > 0.f ? 127.0f / am : 0.f; unsigned* dst = (unsigned*)(ws + (isv ? WS_PV : WS_PU)) + (size_t)rr * (D / 4) + lane;
#pragma unroll
    for (int j = 0; j < 16; ++j) { const unsigned q0 = (unsigned)(int)(rintf(v[j].x * inv) + 128.0f), q1 = (unsigned)(int)(rintf(v[j].y * inv) + 128.0f), q2 = (unsigned)(int)(rintf(v[j].z * inv) + 128.0f), q3 = (unsigned)(int)(rintf(v[j].w * inv) + 128.0f);
        dst[64 * j] = q0 | (q1 << 8) | (q2 << 16) | (q3 << 24); }
    if (lane == 0) ((float*)(ws + (isv ? WS_PSV : WS_PSU)))[rr] = am * (1.0f / 127.0f);
}
__device__ __forceinline__ void peer_quant(ArgsP A, Frame& F, int w0, int wstride) {
    unsigned char* ws = A->ws; const float* pu = A->peer_u; const float* pv = A->peer_v;
    f32x4 v[16], w[16];
    auto rowp = [&](int row) { return (const f32x4*)((row >= 16384 ? pv + (size_t)(row - 16384) * D : pu + (size_t)row * D)) + F.lane; };
    if (w0 < 2 * 16384) { const f32x4* src = rowp(w0);
#pragma unroll
        for (int j = 0; j < 16; ++j) v[j] = __builtin_nontemporal_load(src + 64 * j); }
    for (int row = w0; row < 2 * 16384; row += wstride) { const bool isv = row >= 16384; const int rr = isv ? row - 16384 : row; const bool hasn = row + wstride < 2 * 16384;
        if (hasn) { const f32x4* src = rowp(row + wstride);
#pragma unroll
            for (int j = 0; j < 16; ++j) w[j] = __builtin_nontemporal_load(src + 64 * j); }
        float am = 0.f;
#pragma unroll
        for (int j = 0; j < 16; ++j) am = fmaxf(fmaxf(am, fmaxf(fabsf(v[j].x), fabsf(v[j].y))), fmaxf(fabsf(v[j].z), fabsf(v[j].w)));
#pragma unroll
        for (int o = 1; o < 64; o <<= 1) am = fmaxf(am, __shfl_xor(am, o));
        const float inv = am > 0.f ? 127.0f / am : 0.f; unsigned* dst = (unsigned*)(ws + (isv ? WS_PV : WS_PU)) + (size_t)rr * (D / 4) + F.lane;
#pragma unroll
        for (int j = 0; j < 16; ++j) { const unsigned q0 = (unsigned)(int)(rintf(v[j].x * inv) + 128.0f), q1 = (unsigned)(int)(rintf(v[j].y * inv) + 128.0f), q2 = (unsigned)(int)(rintf(v[j].z * inv) + 128.0f), q3 = (unsigned)(int)(rintf(v[j].w * inv) + 128.0f);
            dst[64 * j] = q0 | (q1 << 8) | (q2 << 16) | (q3 << 24); }
        if (F.lane == 0) ((float*)(ws + (isv ? WS_PSV : WS_PSU)))[rr] = am * (1.0f / 127.0f);
        if (hasn) {
#pragma unroll
            for (int j = 0; j < 16; ++j) v[j] = w[j]; }
    }
}
__device__ __forceinline__ void late_weights(ArgsP A, Frame& F, int w0, int wstride) {
    unsigned char* ws = A->ws;
    LAS float* scr = (LAS float*)(F.lds + RING_OFF + F.wave * 16384);
    constexpr int I_BA = 32 * 128, I_OUT = 64 * 128, I_WQ = 64 * 64, I_SK = PH_ * 2 * PNK * PHALF / 512;
    constexpr int NITEMS = 2 * I_BA + I_OUT + I_WQ + I_SK;
    for (int it = w0; it < NITEMS; it += wstride) {
        int r = it;
        if (r < I_BA) { p0_transpose_item<false>(A->w_ba, RW, D, (bf16_t*)(ws + WS_WA), RW, scr, r, F.lane); continue; } r -= I_BA;
        if (r < I_BA) { p0_transpose_item<false>(A->w_bb, RW, D, (bf16_t*)(ws + WS_WB), RW, scr, r, F.lane); continue; } r -= I_BA;
        if (r < I_OUT) { p0_transpose_item<false>(A->w_out, D, D, (bf16_t*)(ws + WS_WOUT), D, scr, r, F.lane); continue; } r -= I_OUT;
        if (r < I_WQ) { p0_transpose_item<false>(A->peer_wq, D, 2048, (bf16_t*)(ws + WS_WQ), D, scr, r, F.lane); continue; } r -= I_WQ;
        { const size_t i = (size_t)r * 64 + F.lane; const f32x4 a = ((const f32x4*)A->sub_keys)[2 * i], b = ((const f32x4*)A->sub_keys)[2 * i + 1]; ((u32x4*)(ws + WS_SUBK))[i] = pg8::pack8(a, b); }
    }
}
__device__ __forceinline__ void ph0_prologue(ArgsP A, Frame& F) {
    unsigned char* ws = A->ws;
    LAS float* scr = (LAS float*)(F.lds + RING_OFF + F.wave * 16384);
    const int gw = F.vcu * NWAVES + F.wave, NGW = F.G * NWAVES;
    constexpr int I_IN = 64 * (INW / 32), I_UP = 2 * 64, I_G = 8 * 64;
    constexpr int NITEMS = I_IN + 2 * I_UP + I_G;
    for (int it = gw; it < NITEMS; it += NGW) {
        int r = it;
        if (r < I_IN) { p0_transpose_item<true>(A->w_in, D, INW, (bf16_t*)(ws + WS_WIN), D, scr, r, F.lane); continue; } r -= I_IN;
        if (r < I_UP) { p0_transpose_item<false>(A->w_up, LW, RW, (bf16_t*)(ws + WS_WUP), LW, scr, r, F.lane); continue; } r -= I_UP;
        if (r < I_UP) { p0_transpose_item<false>(A->a_up, LA, RW, (bf16_t*)(ws + WS_AUP), LA, scr, r, F.lane); continue; } r -= I_UP;
        p0_transpose_item<false>(A->g_up, LG, RW, (bf16_t*)(ws + WS_GUP), LGP, scr, r, F.lane);
    }
    const size_t gtid = (size_t)F.vcu * NTHR + F.tid, nthr = (size_t)F.G * NTHR;
    for (size_t i = gtid; i < (size_t)32 * D / 8; i += nthr) ((u32x4*)((bf16_t*)(ws + WS_WIN) + (size_t)SHIFTW * D))[i] = (u32x4){0u, 0u, 0u, 0u};
    for (size_t i = gtid; i < (size_t)T * 64; i += nthr) { const int pos = (int)(i >> 6), fi = (int)(i & 63); const float inv = powf(10000.0f, -(float)fi / 64.0f); const float ang = (float)pos * inv;
        ((f32x2*)(ws + WS_ROPE))[i] = (f32x2){cosf(ang), sinf(ang)}; }
    rms_rows_to_bf16(A->x, A->norm1_g, (bf16_t*)(ws + WS_XN), gw, NGW, F.lane);
}

__device__ __forceinline__ f32x4 ld4bf(const bf16_t* p) { const u32x2 w = *(const u32x2*)p; return (f32x4){bflo(w.x), bfhi(w.x), bflo(w.y), bfhi(w.y)}; }
__device__ __forceinline__ void st4bf(bf16_t* p, f32x4 v) { u32x2 w; w.x = pk2(v[0], v[1]); w.y = pk2(v[2], v[3]); *(u32x2*)p = w; }
__device__ __forceinline__ void ph2_prep(ArgsP A, Frame& F) {
    unsigned char* ws = A->ws; const bf16_t* PROJ = (const bf16_t*)(ws + WS_PROJ);
    LAS float* red = (LAS float*)(F.lds + RING_OFF);
    for (int it = F.vcu; it < NBLK * MH; it += F.G) { const int n = it / MH, h = it % MH, d = F.tid & 127, part = F.tid >> 7;
        const bf16_t* p = PROJ + (size_t)(n * MBLK + part * 64) * PLD + PC_MK + h * MD + d; float s = 0.f;
#pragma unroll 8
        for (int i = 0; i < 64; ++i) s += bf1(p[(size_t)i * PLD]);
        red[F.tid] = s; WG_BAR();
        if (F.tid < 128) { const float m = (red[F.tid] + red[F.tid + 128] + red[F.tid + 256] + red[F.tid + 384]) * (1.0f / MBLK); const unsigned hi = f2bf(m); const float lo = m - __builtin_bit_cast(float, hi << 16);
            ((bf16_t*)(ws + WS_KMEAN))[(size_t)(h * NBLK + n) * MD + F.tid] = (bf16_t)hi; ((bf16_t*)(ws + WS_KMEAN + 131072))[(size_t)(h * NBLK + n) * MD + F.tid] = (bf16_t)f2bf(lo); }
        WG_BAR(); }
    const int tid = F.tid; const int c = 4 * tid;
    const f32x4 mu_r = *(const f32x4*)(A->mu + PC_R + c), mu_k = *(const f32x4*)(A->mu + PC_K + c), mu_v = *(const f32x4*)(A->mu + PC_V + c), kkw = *(const f32x4*)(A->k_k + c);
    int lc = 0, lcc = 0; if (tid < 32) { lcc = 4 * tid; lc = PC_WL + lcc; } else if (tid < 64) { lcc = 4 * (tid - 32); lc = PC_AL + lcc; } else { lcc = 4 * (tid - 64); lc = PC_GL + lcc; }
    const bool lact = tid < 64 || (tid < 192 && lcc < LG);
    const f32x4 mu_l = lact ? *(const f32x4*)(A->mu + lc) : (f32x4){0.f, 0.f, 0.f, 0.f};
    u32x2 cur[8], nxt[8];
    auto tload = [&](int t, u32x2 (&rg)[8]) { const bf16_t* P = PROJ + (size_t)t * PLD; const bf16_t* PP = t > 0 ? P - PLD : P;
        rg[0] = *(const u32x2*)(P + PC_R + c); rg[1] = *(const u32x2*)(PP + PC_R + c); rg[2] = *(const u32x2*)(P + PC_K + c); rg[3] = *(const u32x2*)(PP + PC_K + c);
        rg[4] = *(const u32x2*)(P + PC_V + c); rg[5] = *(const u32x2*)(PP + PC_V + c);
        if (lact) { rg[6] = *(const u32x2*)(P + lc); rg[7] = *(const u32x2*)(PP + lc); } else { rg[6] = (u32x2){0u, 0u}; rg[7] = (u32x2){0u, 0u}; } };
    auto up4 = [](u32x2 w) { return (f32x4){bflo(w.x), bfhi(w.x), bflo(w.y), bfhi(w.y)}; };
    if (F.vcu < T) tload(F.vcu, cur);
    for (int t = F.vcu; t < T; t += F.G) { const bool hasn = t + F.G < T; if (hasn) tload(t + F.G, nxt);
        const float hp = t > 0 ? 1.0f : 0.0f;
        { const f32x4 p = up4(cur[0]), pp = up4(cur[1]) * hp; st4bf((bf16_t*)(ws + WS_ZR) + (size_t)t * RW + c, p + (pp - p) * mu_r); }
        { const f32x4 p = up4(cur[2]), pp = up4(cur[3]) * hp; const f32x4 zk = p + (pp - p) * mu_k;
          st4bf((bf16_t*)(ws + WS_KP) + (size_t)t * RW + c, zk); const f32x4 kk = zk * kkw;
          const float ss = sum16((kk[0] * kk[0] + kk[1] * kk[1]) + (kk[2] * kk[2] + kk[3] * kk[3])); const float inv = 1.0f / fmaxf(sqrtf(ss), 1e-12f);
          st4bf((bf16_t*)(ws + WS_KKN) + (size_t)t * RW + c, kk * inv); }
        { const f32x4 p = up4(cur[4]), pp = up4(cur[5]) * hp; st4bf((bf16_t*)(ws + WS_ZV) + (size_t)t * RW + c, p + (pp - p) * mu_v); }
        if (tid < 192) { const f32x4 zero = (f32x4){0.f, 0.f, 0.f, 0.f};
            f32x4 z = zero; if (lact) { const f32x4 p = up4(cur[6]), pp = up4(cur[7]) * hp; z = p + (pp - p) * mu_l; }
            if (tid < 32) { f32x4 o;
#pragma unroll
                for (int e = 0; e < 4; ++e) o[e] = 1.0f - 2.0f * __builtin_amdgcn_rcpf(__expf(2.0f * z[e]) + 1.0f);
                st4bf((bf16_t*)(ws + WS_AW) + (size_t)t * LW + lcc, o); }
            else if (tid < 64) st4bf((bf16_t*)(ws + WS_AA) + (size_t)t * LA + lcc, z);
            else { f32x4 o = zero; if (lcc < LG) {
#pragma unroll
                for (int e = 0; e < 4; ++e) o[e] = fsigmoid(z[e]); }
                st4bf((bf16_t*)(ws + WS_AG) + (size_t)t * LGP + lcc, o); }
        }
        if (hasn) {
#pragma unroll
            for (int i = 0; i < 8; ++i) cur[i] = nxt[i]; }
    }
}

__device__ __forceinline__ void ph3_gate(ArgsP A, Frame& F) {
    unsigned char* ws = A->ws; const bf16_t* PROJ = (const bf16_t*)(ws + WS_PROJ); const bf16_t* KMH = (const bf16_t*)(ws + WS_KMEAN); const bf16_t* KML = (const bf16_t*)(ws + WS_KMEAN + 131072); unsigned* MASK = (unsigned*)(ws + WS_MASK);
    const int gw = F.vcu * NWAVES + F.wave, NGW = F.G * NWAVES; const int r = F.lane & 31, hh = F.lane >> 5; const float NEG = -__builtin_inff();
    for (int it = gw; it < (T / 32) * MH; it += NGW) { const int tg = it >> 4, h = it & 15, t = tg * 32 + r, blk = tg >> 3;
        if (blk == 0) { if (hh == 0) MASK[t * MH + h] = 0u; continue; }
        f32x16 acc;
#pragma unroll
        for (int e = 0; e < 16; ++e) acc[e] = 0.f;
#pragma unroll
        for (int ks = 0; ks < 8; ++ks) { const bf16x8 q = *(const bf16x8*)(PROJ + (size_t)t * PLD + PC_MQ + h * MD + 16 * ks + 8 * hh); const size_t ko = (size_t)(h * NBLK + r) * MD + 16 * ks + 8 * hh;
            acc = __builtin_amdgcn_mfma_f32_32x32x16_bf16(*(const bf16x8*)(KMH + ko), q, acc, 0, 0, 0); acc = __builtin_amdgcn_mfma_f32_32x32x16_bf16(*(const bf16x8*)(KML + ko), q, acc, 0, 0, 0); }
        float t0 = NEG, t1 = NEG, t2 = NEG;
#pragma unroll
        for (int e = 0; e < 16; ++e) { const int n = (e & 3) + 8 * (e >> 2) + 4 * hh; float ae = acc[e]; asm volatile("" : "+v"(ae));
            float x = __builtin_bit_cast(float, (__builtin_bit_cast(unsigned, ae) & ~31u) | (unsigned)(31 - n)); x = (n < blk) ? x : NEG;
            t2 = __builtin_amdgcn_fmed3f(t1, t2, x); t1 = __builtin_amdgcn_fmed3f(t0, t1, x); t0 = fmaxf(t0, x); }
        const float o0 = __shfl_xor(t0, 32), o1 = __shfl_xor(t1, 32), o2 = __shfl_xor(t2, 32);
        t2 = __builtin_amdgcn_fmed3f(t1, t2, o0); t1 = __builtin_amdgcn_fmed3f(t0, t1, o0); t0 = fmaxf(t0, o0);
        t2 = __builtin_amdgcn_fmed3f(t1, t2, o1); t1 = __builtin_amdgcn_fmed3f(t0, t1, o1); t0 = fmaxf(t0, o1);
        t2 = __builtin_amdgcn_fmed3f(t1, t2, o2); t1 = __builtin_amdgcn_fmed3f(t0, t1, o2); t0 = fmaxf(t0, o2);
        unsigned sel = 1u << (31 - (__builtin_bit_cast(unsigned, t0) & 31u));
        if (blk > 1) sel |= 1u << (31 - (__builtin_bit_cast(unsigned, t1) & 31u));
        if (blk > 2) sel |= 1u << (31 - (__builtin_bit_cast(unsigned, t2) & 31u));
        if (hh == 0) MASK[t * MH + h] = sel; }
}

constexpr int SC_CH = 32, SC_STEP = 1344, SC_BUF = SC_CH * SC_STEP, SC_YOFF = 2 * SC_BUF, SC_YBUF = SC_CH * 16 * 16 * 4;
static_assert(SC_YOFF + 2 * SC_YBUF <= RING_BYTES, "scan LDS");
__device__ __forceinline__ void ph4_scan(ArgsP A, Frame& F, int unit0, int ustride) {
    unsigned char* ws = A->ws;
    const float* DEC = (const float*)(ws + WS_DEC); const bf16_t* KKN = (const bf16_t*)(ws + WS_KKN); const bf16_t* BB = (const bf16_t*)(ws + WS_BB); const bf16_t* KP = (const bf16_t*)(ws + WS_KP);
    const bf16_t* ZR = (const bf16_t*)(ws + WS_ZR); const bf16_t* ZV = (const bf16_t*)(ws + WS_ZV); float* Y = (float*)(ws + WS_Y);
    LAS unsigned char* L = F.lds + RING_OFF;
    const int wave = F.wave, lane = F.lane;
    for (int unit = unit0; unit < 128; unit += ustride) {
        const int h = unit >> 2, r0 = (unit & 3) * 16; const size_t hc = (size_t)h * RN;
        constexpr int NC = T / SC_CH;
        if (wave < 4) {
            const int row = wave * 4 + (lane >> 4), j = lane & 15;
            f32x2 S01 = {0.f, 0.f}, S23 = {0.f, 0.f};
            __builtin_amdgcn_s_setprio(3);
            WG_BAR();
#define SC_LOAD(W, KK, BBv, KPv, RR, V, tt_) do { const int o_ = (tt_) * SC_STEP; W = *(const LAS f32x4*)(B + o_); KK = *(const LAS f32x4*)(B + o_ + 256); BBv = *(const LAS f32x4*)(B + o_ + 512); KPv = *(const LAS f32x4*)(B + o_ + 768); RR = *(const LAS f32x4*)(B + o_ + 1024); V = *(const LAS float*)(vb + o_); } while (0)
#define SC_STEPF(W, KK, BBv, KPv, RR, V, tt_) do { \
            const f32x2 kk01 = {KK[0], KK[1]}, kk23 = {KK[2], KK[3]}; f32x2 d2 = S01 * kk01; d2 = __builtin_elementwise_fma(S23, kk23, d2); \
            const f32x2 w01 = {W[0], W[1]}, w23 = {W[2], W[3]}, kp01 = {KPv[0], KPv[1]}, kp23 = {KPv[2], KPv[3]}; const f32x2 vv = {V, V}; \
            f32x2 t01 = S01 * w01, t23 = S23 * w23; t01 = __builtin_elementwise_fma(vv, kp01, t01); t23 = __builtin_elementwise_fma(vv, kp23, t23); \
            const float d_ = sum16(d2[0] + d2[1]); const f32x2 dd = {d_, d_}; const f32x2 bb01 = {BBv[0], BBv[1]}, bb23 = {BBv[2], BBv[3]};        \
            S01 = __builtin_elementwise_fma(dd, bb01, t01); S23 = __builtin_elementwise_fma(dd, bb23, t23); \
            const f32x2 r01 = {RR[0], RR[1]}, r23 = {RR[2], RR[3]}; f32x2 y2 = S01 * r01; y2 = __builtin_elementwise_fma(S23, r23, y2); yb[(tt_) * 256] = y2[0] + y2[1]; } while (0)
#pragma unroll 1
            for (int c = 0; c < NC; ++c) {
                const LAS unsigned char* B = L + (c & 1) * SC_BUF + 16 * j; LAS float* yb = (LAS float*)(L + SC_YOFF + (c & 1) * SC_YBUF) + row * 16 + j;
                const LAS unsigned char* vb = L + (c & 1) * SC_BUF + 1280 + 4 * row;
                f32x4 wA, kA, bA, pA, rA, wB, kB, bB, pB, rB, wC, kC, bC, pC, rC, wD, kD, bD, pD, rD; float vA, vB, vC, vD;
                SC_LOAD(wA, kA, bA, pA, rA, vA, 0); SC_LOAD(wB, kB, bB, pB, rB, vB, 1);
#pragma unroll 1
                for (int tt = 0; tt < SC_CH; tt += 4) {
                    const int t4 = tt + 4 < SC_CH ? tt + 4 : tt, t5 = tt + 5 < SC_CH ? tt + 5 : tt + 1;
                    SC_LOAD(wC, kC, bC, pC, rC, vC, tt + 2); SC_STEPF(wA, kA, bA, pA, rA, vA, tt); SC_LOAD(wD, kD, bD, pD, rD, vD, tt + 3); SC_STEPF(wB, kB, bB, pB, rB, vB, tt + 1);
                    SC_LOAD(wA, kA, bA, pA, rA, vA, t4); SC_STEPF(wC, kC, bC, pC, rC, vC, tt + 2); SC_LOAD(wB, kB, bB, pB, rB, vB, t5); SC_STEPF(wD, kD, bD, pD, rD, vD, tt + 3);
                }
                WG_BAR();
            }
            __builtin_amdgcn_s_setprio(0);
#undef SC_LOAD
#undef SC_STEPF
        } else {
            const int ltid = (wave - 4) * 64 + lane;
            f32x4 ld_dec[2]; u32x4 ld_b[4]; u32x4 ld_v;
            auto issue = [&](int c) { const int t0 = c * SC_CH;
#pragma unroll
                for (int i = 0; i < 2; ++i) { const int q = ltid + 256 * i, st = q >> 4, c4 = q & 15; ld_dec[i] = *(const f32x4*)(DEC + (size_t)(t0 + st) * RW + hc + 4 * c4); }
                { const int st = ltid >> 3, c8 = ltid & 7; const size_t o = (size_t)(t0 + st) * RW + hc + 8 * c8; ld_b[0] = *(const u32x4*)(KKN + o); ld_b[1] = *(const u32x4*)(BB + o); ld_b[2] = *(const u32x4*)(KP + o); ld_b[3] = *(const u32x4*)(ZR + o); }
                { const int l6 = ltid & 63; ld_v = *(const u32x4*)(ZV + (size_t)(t0 + (l6 >> 1)) * RW + hc + r0 + 8 * (l6 & 1)); } };
            auto commit = [&](int buf) { LAS unsigned char* B = L + buf * SC_BUF;
#pragma unroll
                for (int i = 0; i < 2; ++i) { const int q = ltid + 256 * i, st = q >> 4, c4 = q & 15; *(LAS f32x4*)(B + st * SC_STEP + 16 * c4) = ld_dec[i]; }
                { const int st = ltid >> 3, c8 = ltid & 7;
#pragma unroll
                  for (int a = 0; a < 4; ++a) { f32x4 v0, v1; pg8::unpack8(ld_b[a], v0, v1); LAS unsigned char* p = B + st * SC_STEP + 256 * (a + 1) + 32 * c8; *(LAS f32x4*)p = v0; *(LAS f32x4*)(p + 16) = v1; } }
                if (ltid < 64) { f32x4 v0, v1; pg8::unpack8(ld_v, v0, v1); LAS unsigned char* p = B + (ltid >> 1) * SC_STEP + 1280 + 32 * (ltid & 1); *(LAS f32x4*)p = v0; *(LAS f32x4*)(p + 16) = v1; } };
            auto yflush = [&](int c) {
#pragma unroll
                for (int i = 0; i < 2; ++i) { const int o = ltid + 256 * i, st = o >> 4, rr = o & 15; const LAS f32x4* p = (const LAS f32x4*)(L + SC_YOFF + (c & 1) * SC_YBUF + (st * 16 + rr) * 64);
                    const f32x4 a = p[0], b = p[1], cc = p[2], d = p[3]; const f32x4 s4 = (a + b) + (cc + d); Y[(size_t)(c * SC_CH + st) * RW + hc + r0 + rr] = (s4[0] + s4[1]) + (s4[2] + s4[3]); } };
            const bool quant = wave >= 6; const int qstride = 2 * (ustride < 128 ? ustride : 128); int qrow = PQ_SPLIT + (unit0 < 128 ? unit0 : 0) * 2 + (wave - 6); f32x4 qv[16];
            if (unit != unit0) qrow = 2 * 16384;
            issue(0); VM_WAIT(); commit(0); issue(1);
            WG_BAR();
#pragma unroll 1
            for (int c = 0; c < NC; ++c) {
                if (c + 1 < NC) { VM_WAIT(); commit((c + 1) & 1); } else VM_WAIT();
                if (c + 2 < NC) issue(c + 2);
                if (c > 0) yflush(c - 1);
                if (quant && qrow < 2 * 16384) { if ((c & 1) == 0) pq_load(A, qrow, lane, qv); else { pq_finish(ws, qrow, lane, qv); qrow += qstride; } }
                WG_BAR();
            }
            yflush(NC - 1);
            if (quant) { if ((NC & 1) && qrow < 2 * 16384) { VM_WAIT(); pq_finish(ws, qrow, lane, qv); qrow += qstride; }
                for (; qrow < 2 * 16384; qrow += qstride) { pq_load(A, qrow, lane, qv); pq_finish(ws, qrow, lane, qv); } }
        }
        WG_BAR();
    }
}

__device__ __forceinline__ void ph5_ypost(ArgsP A, Frame& F) {
    unsigned char* ws = A->ws; const float* Y = (const float*)(ws + WS_Y); const bf16_t* ZR = (const bf16_t*)(ws + WS_ZR); const bf16_t* KP = (const bf16_t*)(ws + WS_KP); const bf16_t* ZV = (const bf16_t*)(ws + WS_ZV);
    const bf16_t* G = (const bf16_t*)(ws + WS_G); bf16_t* YA = (bf16_t*)(ws + WS_YA);
    const int gw = F.vcu * NWAVES + F.wave, NGW = F.G * NWAVES;
    for (int tg = F.vcu; tg < T / 32; tg += F.G) for (int it = F.wave; it < 256; it += NWAVES) { const int t = tg * 32 + (it >> 3), c = (it & 7) * 256 + 4 * F.lane; const size_t o = (size_t)t * RW + c;
        const f32x4 y = *(const f32x4*)(Y + o); const float mean = sum16((y[0] + y[1]) + (y[2] + y[3])) * (1.0f / 64.0f); const f32x4 d = y - mean;
        const float var = sum16((d[0] * d[0] + d[1] * d[1]) + (d[2] * d[2] + d[3] * d[3])) * (1.0f / 64.0f); const float rs = 1.0f / sqrtf(var + LNX_EPS);
        const f32x4 r = ld4bf(ZR + o), k = ld4bf(KP + o), v = ld4bf(ZV + o), g = ld4bf(G + o), rk = *(const f32x4*)(A->r_k + c), lg = *(const f32x4*)(A->lnx_g + c), lb = *(const f32x4*)(A->lnx_b + c);
        const f32x4 rkk = r * k * rk; const float bonus = sum16((rkk[0] + rkk[1]) + (rkk[2] + rkk[3]));
        st4bf(YA + o, (d * rs * lg + lb + bonus * v) * g); }
}

constexpr int AT_KB = 64 * 256, AT_VB = 128 * 128, AT_BUF = AT_KB + AT_VB;
static_assert(3 * AT_BUF <= RING_BYTES, "attention LDS");
__device__ __forceinline__ void ph5_attn(ArgsP A, Frame& F, int slot0, int sstride) {
    unsigned char* ws = A->ws; const bf16_t* PROJ = (const bf16_t*)(ws + WS_PROJ); const bf16_t* VT = (const bf16_t*)(ws + WS_VT); const unsigned* MASK = (const unsigned*)(ws + WS_MASK); bf16_t* YB = (bf16_t*)(ws + WS_YB);
    LAS unsigned char* L = F.lds + RING_OFF; const int tid = F.tid, wave = F.wave, lane = F.lane, r = lane & 31, hh = lane >> 5;
    const float NEG = -__builtin_inff();
    for (int sl = slot0; sl < 128; sl += sstride) { const int h = sl >> 3, pr0 = (sl & 7) * 2;
      for (int half = 0; half < 4; ++half) { const int pr = pr0 + (half >> 1); const int ib = (half & 1) == 0 ? (31 - pr) : pr;
        const int q0 = ib * MBLK + wave * 32;
        bf16x8 qf[8];
#pragma unroll
        for (int ks = 0; ks < 8; ++ks) qf[ks] = *(const bf16x8*)(PROJ + (size_t)(q0 + r) * PLD + PC_MQ + h * MD + 16 * ks + 8 * hh);
        const unsigned msk = MASK[(q0 + r) * MH + h];
        f32x16 o[4];
#pragma unroll
        for (int db = 0; db < 4; ++db)
#pragma unroll
            for (int e = 0; e < 16; ++e) o[db][e] = 0.f;
        float mrun = NEG, lrun = 0.f;
        const int ntile = 4 + 4 * ib;
        auto tile_tok = [&](int n) { return n < 4 ? ib * MBLK + n * 64 : ((n - 4) >> 2) * MBLK + ((n - 4) & 3) * 64; };
        const int krow_ = lane >> 4, kslot = lane & 15, vrow_ = lane >> 3, vslot = lane & 7;
        auto dma_tile = [&](int n, int b3) { const int tb = tile_tok(n); LAS unsigned char* B = L + b3 * AT_BUF;
#pragma unroll
            for (int i = 0; i < 2; ++i) { const int p = wave * 2 + i, row = 4 * p + krow_, c = kslot ^ (row & 15);
                __builtin_amdgcn_global_load_lds((const unsigned*)(PROJ + (size_t)(tb + row) * PLD + PC_MK + h * MD + 8 * c), (LAS unsigned*)(B + p * 1024), 16, 0, 0); }
#pragma unroll
            for (int i = 0; i < 2; ++i) { const int p = wave * 2 + i, row = 8 * p + vrow_, c = vslot ^ (row & 7);
                __builtin_amdgcn_global_load_lds((const unsigned*)(VT + (size_t)(h * MD + row) * T + tb + 8 * c), (LAS unsigned*)(B + AT_KB + p * 1024), 16, 0, 0); } };
        dma_tile(0, 0); dma_tile(1, 1);
        asm volatile("s_waitcnt vmcnt(4)" ::: "memory"); WG_BAR();
        int b3 = 0;
        for (int n = 0; n < ntile; ++n) {
            { const int bn = b3 >= 1 ? b3 - 1 : 2; if (n + 2 < ntile) dma_tile(n + 2, bn); }
            bool need; int jblk = -1, tt = 0;
            if (n < 4) { tt = n; need = tt <= (wave >> 1); } else { jblk = (n - 4) >> 2; need = __ballot((msk >> jblk) & 1u) != 0ull; }
            if (need) {
                const LAS unsigned char* KB = L + b3 * AT_BUF; const LAS unsigned char* VB = KB + AT_KB;
                f32x16 s[2];
#pragma unroll
                for (int kb = 0; kb < 2; ++kb) {
#pragma unroll
                    for (int e = 0; e < 16; ++e) s[kb][e] = 0.f;
#pragma unroll
                    for (int ks = 0; ks < 8; ++ks) { const bf16x8 a = *(const LAS bf16x8*)(KB + (32 * kb + r) * 256 + (((2 * ks + hh) ^ (r & 15)) << 4)); s[kb] = __builtin_amdgcn_mfma_f32_32x32x16_bf16(a, qf[ks], s[kb], 0, 0, 0); } }
                if (n < 4) { if (64 * tt + 63 > wave * 32) { const int qrel = wave * 32 + r;
#pragma unroll
                    for (int kb = 0; kb < 2; ++kb)
#pragma unroll
                        for (int e = 0; e < 16; ++e) { const int krel = 64 * tt + 32 * kb + (e & 3) + 8 * (e >> 2) + 4 * hh; if (krel > qrel) s[kb][e] = NEG; } } }
                else if (!((msk >> jblk) & 1u)) {
#pragma unroll
                    for (int kb = 0; kb < 2; ++kb)
#pragma unroll
                        for (int e = 0; e < 16; ++e) s[kb][e] = NEG; }
                float mx = s[0][0];
#pragma unroll
                for (int kb = 0; kb < 2; ++kb)
#pragma unroll
                    for (int e = 0; e < 16; ++e) mx = fmaxf(mx, s[kb][e]);
                mx = fmaxf(mx, __shfl_xor(mx, 32));
                const float mnew = fmaxf(mrun, mx); const float alpha = __builtin_amdgcn_exp2f(mrun - mnew); mrun = mnew;
                float ps = 0.f;
#pragma unroll
                for (int kb = 0; kb < 2; ++kb)
#pragma unroll
                    for (int e = 0; e < 16; ++e) { const float p = __builtin_amdgcn_exp2f(s[kb][e] - mnew); s[kb][e] = p; ps += p; }
                lrun = lrun * alpha + ps;
                if (__ballot(alpha != 1.0f) != 0ull) {
#pragma unroll
                    for (int db = 0; db < 4; ++db)
#pragma unroll
                        for (int e = 0; e < 16; ++e) o[db][e] *= alpha; }
#pragma unroll
                for (int kb = 0; kb < 2; ++kb)
#pragma unroll
                    for (int st = 0; st < 2; ++st) { u32x4 pw; pw.x = pk2(s[kb][8 * st + 0], s[kb][8 * st + 1]); pw.y = pk2(s[kb][8 * st + 2], s[kb][8 * st + 3]); pw.z = pk2(s[kb][8 * st + 4], s[kb][8 * st + 5]); pw.w = pk2(s[kb][8 * st + 6], s[kb][8 * st + 7]);
                        const bf16x8 pf = __builtin_bit_cast(bf16x8, pw); const int kbase = 32 * kb + 16 * st + 4 * hh;
#pragma unroll
                        for (int db = 0; db < 4; ++db) { const LAS unsigned char* vrow = VB + (32 * db + r) * 128 + 8 * hh; const int c0 = 4 * kb + 2 * st; const u32x2 lo = *(const LAS u32x2*)(vrow + ((c0 ^ (r & 7)) << 4)), hi = *(const LAS u32x2*)(vrow + (((c0 + 1) ^ (r & 7)) << 4));
                            const bf16x8 vf = __builtin_bit_cast(bf16x8, (u32x4){lo.x, lo.y, hi.x, hi.y}); o[db] = __builtin_amdgcn_mfma_f32_32x32x16_bf16(vf, pf, o[db], 0, 0, 0); } }
            }
            if (n + 2 < ntile) asm volatile("s_waitcnt vmcnt(4)" ::: "memory"); else asm volatile("s_waitcnt vmcnt(0)" ::: "memory");
            b3 = b3 == 2 ? 0 : b3 + 1;
            WG_BAR();
        }
        const float ltot = lrun + __shfl_xor(lrun, 32); const float inv = 1.0f / ltot;
        bf16_t* op = YB + (size_t)(q0 + r) * RW + h * MD;
#pragma unroll
        for (int db = 0; db < 4; ++db)
#pragma unroll
            for (int g = 0; g < 4; ++g) { u32x2 w; w.x = pk2(o[db][4 * g] * inv, o[db][4 * g + 1] * inv); w.y = pk2(o[db][4 * g + 2] * inv, o[db][4 * g + 3] * inv); *(u32x2*)(op + 32 * db + 8 * g + 4 * hh) = w; }
      }
    }
}

__device__ __forceinline__ void ins16(float (&top)[16], float x) {
#pragma unroll
    for (int k = 15; k >= 1; --k) top[k] = __builtin_amdgcn_fmed3f(top[k - 1], top[k], x);
    top[0] = fmaxf(top[0], x);
}
__device__ __forceinline__ void ph10_select(ArgsP A, Frame& F) {
    unsigned char* ws = A->ws; const bf16_t* PQ = (const bf16_t*)(ws + WS_PQ); const bf16_t* SK = (const bf16_t*)(ws + WS_SUBK); int* IDX = (int*)(ws + WS_IDX); float* GW = (float*)(ws + WS_GW);
    const int gw = F.vcu * NWAVES + F.wave, NGW = F.G * NWAVES; const int r = F.lane & 31, hh = F.lane >> 5; const float NEG = -__builtin_inff();
    for (int it = gw; it < (T / 32) * PH_; it += NGW) { const int tg = it >> 3, h = it & 7, t = tg * 32 + r;
        float TA[16], TB[16];
        auto topk = [&](int p, float (&dst)[16]) {
            bf16x8 qf[8];
#pragma unroll
            for (int ks = 0; ks < 8; ++ks) qf[ks] = *(const bf16x8*)(PQ + (size_t)t * 2048 + (h * 2 + p) * PHALF + 16 * ks + 8 * hh);
            float top[16];
#pragma unroll
            for (int k = 0; k < 16; ++k) top[k] = NEG;
#pragma unroll 1
            for (int nb = 0; nb < 4; ++nb) { f32x16 acc;
#pragma unroll
                for (int e = 0; e < 16; ++e) acc[e] = 0.f;
#pragma unroll
                for (int ks = 0; ks < 8; ++ks) { const bf16x8 a = *(const bf16x8*)(SK + ((size_t)(h * 2 + p) * PNK + 32 * nb + r) * PHALF + 16 * ks + 8 * hh); acc = __builtin_amdgcn_mfma_f32_32x32x16_bf16(a, qf[ks], acc, 0, 0, 0); }
#pragma unroll
                for (int e = 0; e < 16; ++e) { const unsigned key = 32 * nb + (e & 3) + 8 * (e >> 2) + 4 * hh; float ae = acc[e]; asm volatile("" : "+v"(ae));
                    const float x = __builtin_bit_cast(float, (__builtin_bit_cast(unsigned, ae) & ~0x7Fu) | key); ins16(top, x); } }
            float oth[16];
#pragma unroll
            for (int k = 0; k < 16; ++k) oth[k] = __shfl_xor(top[k], 32);
#pragma unroll
            for (int k = 0; k < 16; ++k) ins16(top, oth[k]);
#pragma unroll
            for (int k = 0; k < 16; ++k) dst[k] = top[k];
        };
        topk(0, TA); asm volatile("" ::: "memory"); __builtin_amdgcn_sched_barrier(0); topk(1, TB); asm volatile("" ::: "memory"); __builtin_amdgcn_sched_barrier(0);
        float fin[16];
#pragma unroll
        for (int k = 0; k < 16; ++k) fin[k] = NEG;
#pragma unroll
        for (int i = 0; i < 16; ++i)
#pragma unroll
            for (int j = 0; j < 16; ++j) if ((i + 1) * (j + 1) <= 16) { const float sm = TA[i] + TB[j]; ins16(fin, __builtin_bit_cast(float, (__builtin_bit_cast(unsigned, sm) & ~0xFFu) | (unsigned)(i * 16 + j))); }
        float e[16], den = 0.f;
#pragma unroll
        for (int k = 0; k < 16; ++k) { e[k] = __expf(fin[k] - fin[0]); den += e[k]; }
        const float rden = 1.0f / den;
        int oi[8]; float og[8];
#pragma unroll
        for (int kk = 0; kk < 8; ++kk) { const float fv = hh ? fin[8 + kk] : fin[kk]; og[kk] = (hh ? e[8 + kk] : e[kk]) * rden; const unsigned id = __builtin_bit_cast(unsigned, fv) & 0xFFu; const unsigned ci = id >> 4, cj = id & 15u;
            unsigned ia = 0u, ib = 0u;
#pragma unroll
            for (int q = 0; q < 16; ++q) { ia = (ci == (unsigned)q) ? (__builtin_bit_cast(unsigned, TA[q]) & 0x7Fu) : ia; ib = (cj == (unsigned)q) ? (__builtin_bit_cast(unsigned, TB[q]) & 0x7Fu) : ib; }
            oi[kk] = (int)(ia * PNK + ib); }
        int* ip = IDX + (size_t)t * 128 + h * 16 + 8 * hh; float* gp = GW + (size_t)t * 128 + h * 16 + 8 * hh;
        *(u32x4*)ip = (u32x4){(unsigned)oi[0], (unsigned)oi[1], (unsigned)oi[2], (unsigned)oi[3]}; *(u32x4*)(ip + 4) = (u32x4){(unsigned)oi[4], (unsigned)oi[5], (unsigned)oi[6], (unsigned)oi[7]};
        *(f32x4*)gp = (f32x4){og[0], og[1], og[2], og[3]}; *(f32x4*)(gp + 4) = (f32x4){og[4], og[5], og[6], og[7]};
    }
}


__device__ __forceinline__ float ub0(unsigned w) { return (float)(w & 0xffu); }
__device__ __forceinline__ float ub1(unsigned w) { return (float)((w >> 8) & 0xffu); }
__device__ __forceinline__ float ub2(unsigned w) { return (float)((w >> 16) & 0xffu); }
__device__ __forceinline__ float ub3(unsigned w) { return (float)(w >> 24); }
__device__ __forceinline__ float dot16q(u32x4 q, const float (&h)[16]) {
    return ((ub0(q.x) * h[0] + ub1(q.x) * h[1]) + (ub2(q.x) * h[2] + ub3(q.x) * h[3])) + ((ub0(q.y) * h[4] + ub1(q.y) * h[5]) + (ub2(q.y) * h[6] + ub3(q.y) * h[7]))
         + ((ub0(q.z) * h[8] + ub1(q.z) * h[9]) + (ub2(q.z) * h[10] + ub3(q.z) * h[11])) + ((ub0(q.w) * h[12] + ub1(q.w) * h[13]) + (ub2(q.w) * h[14] + ub3(q.w) * h[15]));
}
__device__ __forceinline__ void ph11_gather(ArgsP A, Frame& F) {
    unsigned char* ws = A->ws; const bf16_t* H2 = (const bf16_t*)(ws + WS_H2); const unsigned char* PU = (const unsigned char*)(ws + WS_PU); const unsigned char* PV = (const unsigned char*)(ws + WS_PV);
    const float* PSU = (const float*)(ws + WS_PSU); const float* PSV = (const float*)(ws + WS_PSV);
    const int* IDX = (const int*)(ws + WS_IDX); const float* GW = (const float*)(ws + WS_GW); const float* X1 = (const float*)(ws + WS_X1);
    LAS float* coef = (LAS float*)(F.lds + RING_OFF); LAS int* eidx = (LAS int*)(F.lds + RING_OFF + 1024); LAS float* red = (LAS float*)(F.lds + RING_OFF + 2048);
    const int tid = F.tid, wave = F.wave, lane = F.lane; int par = 0;
    for (int t = F.vcu; t < T; t += F.G, par ^= 1) {
        float hv[4][16]; float hs = 0.f;
#pragma unroll
        for (int i = 0; i < 4; ++i) { const bf16_t* hp = H2 + (size_t)t * D + i * 1024 + lane * 16; f32x4 a, b, c, d; pg8::unpack8(*(const u32x4*)hp, a, b); pg8::unpack8(*(const u32x4*)(hp + 8), c, d);
#pragma unroll
            for (int e = 0; e < 4; ++e) { hv[i][e] = a[e]; hv[i][4 + e] = b[e]; hv[i][8 + e] = c[e]; hv[i][12 + e] = d[e]; }
            hs += ((a[0] + a[1]) + (a[2] + a[3])) + ((b[0] + b[1]) + (b[2] + b[3])) + ((c[0] + c[1]) + (c[2] + c[3])) + ((d[0] + d[1]) + (d[2] + d[3])); }
        hs = wave_sum(hs);
        const int myidx = (lane < 16) ? IDX[(size_t)t * 128 + wave * 16 + lane] : 0; const float myg = (lane < 16) ? GW[(size_t)t * 128 + wave * 16 + lane] : 0.f;
        float dots = 0.f;
#pragma unroll 1
        for (int k = 0; k < 16; k += 4) {
            u32x4 q[4][4];
#pragma unroll
            for (int x = 0; x < 4; ++x) { const int e = __builtin_amdgcn_readlane(myidx, k + x); const unsigned char* up = PU + (size_t)e * D + lane * 16;
#pragma unroll
                for (int i = 0; i < 4; ++i) q[x][i] = *(const u32x4*)(up + i * 1024); }
#pragma unroll
            for (int x = 0; x < 4; ++x) { float d = 0.f;
#pragma unroll
                for (int i = 0; i < 4; ++i) d += dot16q(q[x][i], hv[i]);
                d = wave_sum(d); if (lane == k + x) dots = d; }
        }
        if (lane < 16) { const float s = PSU[myidx] * (dots - 128.0f * hs); const float act = 0.5f * s * (1.0f + erff(s * 0.70710678118654752f));
            coef[par * 128 + wave * 16 + lane] = myg * act * PSV[myidx]; eidx[par * 128 + wave * 16 + lane] = myidx; }
        WG_BAR();
        float acc[8]; float csum = 0.f;
#pragma unroll
        for (int i = 0; i < 8; ++i) acc[i] = 0.f;
#pragma unroll 1
        for (int e = 0; e < 128; e += 16) { u32x2 v[16]; float c[16];
#pragma unroll
            for (int q = 0; q < 16; ++q) { const int ei = __builtin_amdgcn_readfirstlane(eidx[par * 128 + e + q]); c[q] = coef[par * 128 + e + q]; v[q] = *(const u32x2*)(PV + (size_t)ei * D + tid * 8); }
#pragma unroll
            for (int q = 0; q < 16; ++q) { csum += c[q]; acc[0] += c[q] * ub0(v[q].x); acc[1] += c[q] * ub1(v[q].x); acc[2] += c[q] * ub2(v[q].x); acc[3] += c[q] * ub3(v[q].x); acc[4] += c[q] * ub0(v[q].y); acc[5] += c[q] * ub1(v[q].y); acc[6] += c[q] * ub2(v[q].y); acc[7] += c[q] * ub3(v[q].y); } }
        const float corr = -128.0f * csum;
        const f32x4 x0 = *(const f32x4*)(X1 + (size_t)t * D + tid * 8), x1 = *(const f32x4*)(X1 + (size_t)t * D + tid * 8 + 4);
        f32x4 y0 = x0 + ((f32x4){acc[0], acc[1], acc[2], acc[3]} + corr), y1 = x1 + ((f32x4){acc[4], acc[5], acc[6], acc[7]} + corr);
        float ss = (y0[0] * y0[0] + y0[1] * y0[1]) + (y0[2] * y0[2] + y0[3] * y0[3]) + (y1[0] * y1[0] + y1[1] * y1[1]) + (y1[2] * y1[2] + y1[3] * y1[3]);
        ss = wave_sum(ss); if (lane == 0) red[par * 8 + wave] = ss;
        WG_BAR();
        float tot = 0.f;
#pragma unroll
        for (int w = 0; w < 8; ++w) tot += red[par * 8 + w];
        const float rs = 1.0f / sqrtf(tot * (1.0f / D) + NORM_EPS);
        const f32x4 g0 = *(const f32x4*)(A->final_g + tid * 8), g1 = *(const f32x4*)(A->final_g + tid * 8 + 4);
        *(f32x4*)(A->out + (size_t)t * D + tid * 8) = y0 * rs * g0; *(f32x4*)(A->out + (size_t)t * D + tid * 8 + 4) = y1 * rs * g1;
    }
}

constexpr int NPH = 12;
__device__ __forceinline__ Frame make_frame(unsigned char* lds) {
    Frame F; int t = threadIdx.x; asm volatile("" : "+v"(t));
    F.lds = (LAS unsigned char*)lds; F.tid = t; F.lane = t & 63; F.wave = __builtin_amdgcn_readfirstlane(t >> 6);
    F.G = gridDim.x; { const int bx = blockIdx.x; F.vcu = (F.G % 8 == 0) ? (bx % 8) * (F.G / 8) + bx / 8 : bx; }
    return F;
}
__global__ void __launch_bounds__(NTHR, 2) mk_fwd(Args args_by_value) {
    extern __shared__ __attribute__((aligned(16))) unsigned char lds[];
    ArgsP args = get_args();
    gu32* ctl = (gu32*)(args->ws + WS_CTL);
    for (int u = threadIdx.x; u < (LDS_BYTES - LDSCTL_OFF) / 4; u += NTHR) ((LAS unsigned*)((LAS unsigned char*)lds + LDSCTL_OFF))[u] = 0u;
    __syncthreads();
    const int lo = args->ph_lo, hi = args->ph_hi;
    volatile LAS unsigned* MISC = (volatile LAS unsigned*)((LAS unsigned char*)lds + MISC_OFF);
    XcdBarrier bar; bar.bar = (unsigned*)(ctl + CW_BAR) + args->li * XCD_BAR_WORDS; bar.x = 0; bar.st = nullptr;
    if (hi - lo > 1) bar = xcd_barrier_post((unsigned*)(ctl + CW_BAR) + args->li * XCD_BAR_WORDS, MISC + 8);
#define IN(k) (lo <= (k) && (k) < hi)
#define SEAM(k) do { if (IN(k) && IN((k) + 1)) xcd_barrier(bar); } while (0)
    const int bid = (int)blockIdx.x;

    if (IN(0)) { Frame F = make_frame(lds); ph0_prologue(get_args(), F); SEAM(0); }
    if (IN(1)) { Frame F = make_frame(lds); LAS unsigned char* ring = F.lds + RING_OFF; ArgsP a_ = get_args(); unsigned char* ws = a_->ws;
        { pg8::Gemm g{(const bf16_t*)(ws + WS_XN), (const bf16_t*)(ws + WS_WIN), T, PLD, D}; pg8::StaticOrder S; S.init(T, PLD, F.G, bid);
          pg8::EpiProj E{(bf16_t*)(ws + WS_PROJ), (const float*)(ws + WS_ROPE)}; pg8::gemm_phase<pg8::EpiProj, pg8::StaticOrder, true, true>(ring, g, S, E); }
        { pg8::Gemm g{(const bf16_t*)(ws + WS_XN), (const bf16_t*)(ws + WS_WIN) + (size_t)PC_MV * D, T, 2048, D}; pg8::StaticOrder S; S.init(T, 2048, F.G, bid);
          pg8::EpiVT E{(bf16_t*)(ws + WS_VT)}; pg8::gemm_phase<pg8::EpiVT, pg8::StaticOrder, true, true>(ring, g, S, E); }
        { Frame F2 = make_frame(lds); const int rem = ((T / 256) * (PLD / 256)) % F2.G;
          const int w0 = rem == 0 ? bid * NWAVES + F2.wave : (bid - rem) * NWAVES + F2.wave, wst = (rem == 0 ? F2.G : F2.G - rem) * NWAVES;
          if (rem == 0 || bid >= rem) { ArgsP a2 = get_args(); f32x4 qv[16]; for (int row = w0; row < PQ_SPLIT; row += wst) { pq_load(a2, row, F2.lane, qv); pq_finish(a2->ws, row, F2.lane, qv); } } }
        SEAM(1); }
    if (IN(2)) { Frame F = make_frame(lds); ph2_prep(get_args(), F); SEAM(2); }
    if (IN(3)) { Frame F = make_frame(lds); LAS unsigned char* ring = F.lds + RING_OFF; ArgsP a_ = get_args(); unsigned char* ws = a_->ws;
        { pg8::Gemm g{(const bf16_t*)(ws + WS_AW), (const bf16_t*)(ws + WS_WUP), T, RW, LW}; pg8::StaticOrder S; S.init(T, RW, F.G, bid);
          pg8::EpiDec E{(float*)(ws + WS_DEC), a_->w0}; pg8::gemm_phase<pg8::EpiDec, pg8::StaticOrder, true, true>(ring, g, S, E); }
        asm volatile("" ::: "memory"); __builtin_amdgcn_sched_barrier(0);
        { pg8::Gemm g{(const bf16_t*)(ws + WS_AA), (const bf16_t*)(ws + WS_AUP), T, RW, LA}; pg8::StaticOrder S; S.init(T, RW, F.G, bid);
          pg8::EpiA E{(bf16_t*)(ws + WS_KP), (bf16_t*)(ws + WS_BB), (const bf16_t*)(ws + WS_KKN), a_->a0, a_->k_a}; pg8::gemm_phase<pg8::EpiA, pg8::StaticOrder, true, true>(ring, g, S, E); }
        asm volatile("" ::: "memory"); __builtin_amdgcn_sched_barrier(0);
        { pg8::Gemm g{(const bf16_t*)(ws + WS_AG), (const bf16_t*)(ws + WS_GUP), T, RW, LGP}; pg8::StaticOrder S; S.init(T, RW, F.G, bid);
          pg8::EpiBf16 E{(bf16_t*)(ws + WS_G), RW}; pg8::gemm_phase<pg8::EpiBf16, pg8::StaticOrder, true, true>(ring, g, S, E); }
        { Frame F2 = make_frame(lds); ph3_gate(get_args(), F2); }
        SEAM(3); }
    if (IN(4)) {
        Frame F = make_frame(lds); const int nscan = F.G / 2;
        if (F.vcu < nscan) ph4_scan(get_args(), F, F.vcu, nscan);
        else { ph5_attn(get_args(), F, F.vcu - nscan, F.G - nscan); Frame F2 = make_frame(lds); late_weights(get_args(), F2, (F2.vcu - nscan) * NWAVES + F2.wave, (F2.G - nscan) * NWAVES); }
        SEAM(4); }
    if (IN(5)) { Frame F = make_frame(lds); ph5_ypost(get_args(), F); SEAM(5); }
    if (IN(6)) { Frame F = make_frame(lds); LAS unsigned char* ring = F.lds + RING_OFF; ArgsP a_ = get_args(); unsigned char* ws = a_->ws;
        { pg8::Gemm g{(const bf16_t*)(ws + WS_YA), (const bf16_t*)(ws + WS_WA), T, D, RW}; pg8::StaticOrder S; S.init(T, D, F.G, bid);
          pg8::EpiMix<false> E{(bf16_t*)(ws + WS_MIXED), (const bf16_t*)(ws + WS_PROJ), PC_GA}; pg8::gemm_phase<pg8::EpiMix<false>, pg8::StaticOrder, true, true>(ring, g, S, E); }
        { pg8::Gemm g{(const bf16_t*)(ws + WS_YB), (const bf16_t*)(ws + WS_WB), T, D, RW}; pg8::StaticOrder S; S.init(T, D, F.G, bid);
          pg8::EpiMix<true> E{(bf16_t*)(ws + WS_MIXED), (const bf16_t*)(ws + WS_PROJ), PC_GB}; pg8::gemm_phase<pg8::EpiMix<true>, pg8::StaticOrder, true, true>(ring, g, S, E); }
        SEAM(6); }
    if (IN(7)) { Frame F = make_frame(lds); LAS unsigned char* ring = F.lds + RING_OFF; ArgsP a_ = get_args(); unsigned char* ws = a_->ws;
        pg8::Gemm g{(const bf16_t*)(ws + WS_MIXED), (const bf16_t*)(ws + WS_WOUT), T, D, D}; pg8::StaticOrder S; S.init(T, D, F.G, bid);
        pg8::EpiRes E{(float*)(ws + WS_X1), a_->x}; pg8::gemm_phase<pg8::EpiRes, pg8::StaticOrder, true, true>(ring, g, S, E);
        SEAM(7); }
    if (IN(8)) { Frame F = make_frame(lds); ArgsP a_ = get_args(); unsigned char* ws = a_->ws; const int gw = F.vcu * NWAVES + F.wave, NGW = F.G * NWAVES;
        rms_rows_to_bf16((const float*)(ws + WS_X1), a_->norm2_g, (bf16_t*)(ws + WS_H2), gw, NGW, F.lane);
        SEAM(8); }
    if (IN(9)) { Frame F = make_frame(lds); LAS unsigned char* ring = F.lds + RING_OFF; ArgsP a_ = get_args(); unsigned char* ws = a_->ws;
        pg8::Gemm g{(const bf16_t*)(ws + WS_H2), (const bf16_t*)(ws + WS_WQ), T, 2048, D}; pg8::StaticOrder S; S.init(T, 2048, F.G, bid);
        pg8::EpiBf16 E{(bf16_t*)(ws + WS_PQ), 2048}; pg8::gemm_phase<pg8::EpiBf16, pg8::StaticOrder, true, true>(ring, g, S, E);
        SEAM(9); }
    if (IN(10)) { Frame F = make_frame(lds); ph10_select(get_args(), F); SEAM(10); }
    if (IN(11)) { Frame F = make_frame(lds); ph11_gather(get_args(), F); }
#undef IN
#undef SEAM
}

extern "C" void kernel_launch(void* const* d_in, const int* in_sizes, int n_in, void* d_out, int out_size, void* d_ws, size_t ws_size, hipStream_t stream) {
    static int grid = 0;
    if (grid == 0) {
        if (n_in != 23 || out_size != T * D || ws_size < WS_END) { fprintf(stderr, "kernel_launch: unexpected shapes (n_in %d out %d ws %zu); nothing launched\n", n_in, out_size, ws_size); grid = -1; return; }
        int dev = 0, cus = 0, per_cu = 0;
        if (hipGetDevice(&dev) != hipSuccess || hipDeviceGetAttribute(&cus, hipDeviceAttributeMultiprocessorCount, dev) != hipSuccess) { grid = -1; return; }
        if (hipFuncSetAttribute((const void*)mk_fwd, hipFuncAttributeMaxDynamicSharedMemorySize, LDS_BYTES) != hipSuccess) { grid = -1; return; }
        if (hipOccupancyMaxActiveBlocksPerMultiprocessor(&per_cu, (const void*)mk_fwd, NTHR, LDS_BYTES) != hipSuccess || per_cu < 1) fprintf(stderr, "kernel_launch: occupancy query reports %d\n", per_cu);
        (void)hipGetLastError();
        grid = cus;
    }
    if (grid < 0) return;
    (void)hipMemsetAsync((char*)d_ws + WS_CTL, 0, CTL_ZERO_BYTES, stream);
    Args a{};
    const float** ap = (const float**)&a;
    for (int i = 0; i < 23; ++i) ap[i] = (const float*)d_in[i];
    a.out = (float*)d_out; a.ws = (unsigned char*)d_ws; a.pad = 0;
    constexpr int NL = MK_N_LAUNCHES;
    for (int li = 0; li < NL; ++li) {
        a.ph_lo = (NL == 1) ? 0 : li; a.ph_hi = (NL == 1) ? NPH : li + 1; a.li = (NL == 1) ? 0 : 0;
        hipLaunchKernelGGL(mk_fwd, dim3(grid), dim3(NTHR), LDS_BYTES, stream, a);
#ifdef DUP_HI
        if (NL > 1 && li == DUP_HI) for (int l2 = DUP_LO; l2 <= DUP_HI; ++l2) { a.ph_lo = l2; a.ph_hi = l2 + 1; hipLaunchKernelGGL(mk_fwd, dim3(grid), dim3(NTHR), LDS_BYTES, stream, a); }
#endif
    }
}
```

```cpp
#include <hip/hip_runtime.h>
#include <cstdio>
#include <cstdint>

#ifndef MK_N_LAUNCHES
#define MK_N_LAUNCHES 1
#endif

#define GAS __attribute__((address_space(1)))
#define LAS __attribute__((address_space(3)))
typedef unsigned short bf16_t;
typedef __bf16 bf16x8 __attribute__((ext_vector_type(8)));
typedef float f32x2 __attribute__((ext_vector_type(2)));
typedef float f32x4 __attribute__((ext_vector_type(4)));
typedef float f32x16 __attribute__((ext_vector_type(16)));
typedef unsigned u32x2 __attribute__((ext_vector_type(2)));
typedef unsigned u32x4 __attribute__((ext_vector_type(4)));
typedef GAS unsigned gu32;

constexpr int T = 8192, D = 4096;
constexpr int RW = 2048, RH = 32, RN = 64;
constexpr int LW = 128, LA = 128, LG = 480, LGP = 512;
constexpr int SHIFTW = 6880;
constexpr int MH = 16, MD = 128, MBLK = 256, NBLK = 32;
constexpr int INW = 21216;
constexpr int PLD = 19200;
constexpr int PC_R = 0, PC_K = 2048, PC_V = 4096, PC_WL = 6144, PC_AL = 6272, PC_GL = 6400, PC_MQ = 6912, PC_MK = 8960, PC_GA = 11008, PC_GB = 15104, PC_MV = 19200;
constexpr int WIN_ROWS = 21248;
constexpr int PQ_SPLIT = 16384;
constexpr int PH_ = 8, PNK = 128, PQD = 256, PHALF = 128, PTOPK = 16;
constexpr float NORM_EPS = 1e-6f, LNX_EPS = 64e-5f;
constexpr float QSCALE = 0.08838834764831845f * 1.4426950408889634f;

constexpr size_t MiB = 1u << 20;
constexpr size_t WS_CTL = 0, CTL_ZERO_BYTES = 1 * MiB;
constexpr size_t WS_WIN = 1 * MiB;
constexpr size_t WS_X1 = 1 * MiB, WS_PQ = 129 * MiB;
constexpr size_t WS_WA = 167 * MiB, WS_WB = 183 * MiB, WS_WOUT = 199 * MiB, WS_WQ = 231 * MiB, WS_WUP = 247 * MiB, WS_AUP = 248 * MiB, WS_GUP = 249 * MiB, WS_SUBK = 251 * MiB;
constexpr size_t WS_PU = 252 * MiB, WS_PV = 380 * MiB;
constexpr size_t WS_XN = 508 * MiB;
constexpr size_t WS_Y = 508 * MiB, WS_H2 = 508 * MiB;
constexpr size_t WS_PROJ = 572 * MiB;
constexpr size_t WS_VT = 872 * MiB;
constexpr size_t WS_ROPE = 904 * MiB, WS_KMEAN = 908 * MiB, WS_MASK = 909 * MiB, WS_AW = 910 * MiB, WS_AA = 912 * MiB, WS_AG = 914 * MiB;
constexpr size_t WS_PSU = 909 * MiB + 512 * 1024, WS_PSV = WS_PSU + 64 * 1024;
constexpr size_t WS_DEC = 922 * MiB;
constexpr size_t WS_MIXED = 922 * MiB;
constexpr size_t WS_KKN = 986 * MiB, WS_BB = 1018 * MiB, WS_KP = 1050 * MiB, WS_ZR = 1082 * MiB, WS_ZV = 1114 * MiB, WS_G = 1146 * MiB;
constexpr size_t WS_YA = 1178 * MiB, WS_YB = 1210 * MiB, WS_IDX = 1242 * MiB, WS_GW = 1246 * MiB, WS_Z = 1250 * MiB, WS_SINIT = 1266 * MiB, WS_END = 1267 * MiB;

constexpr int CW_TMO = 0, CW_CODE = 1, CW_ATTNQ = 64, CW_BAR = 4096;

constexpr int RING_OFF = 0, RING_BYTES = 155648;
constexpr int LDSCTL_OFF = RING_BYTES, MISC_OFF = LDSCTL_OFF + 320;
constexpr int LDS_BYTES = 163840;
constexpr int NWAVES = 8, NTHR = 512;

__device__ __forceinline__ unsigned f2bf(float f) { unsigned u = __builtin_bit_cast(unsigned, f); return (u + 0x7fffu + ((u >> 16) & 1u)) >> 16; }
typedef __bf16 bf16x2 __attribute__((ext_vector_type(2)));
__device__ __forceinline__ unsigned pk2(float lo, float hi) { const f32x2 v = {lo, hi}; return __builtin_bit_cast(unsigned, __builtin_convertvector(v, bf16x2)); }
__device__ __forceinline__ float bflo(unsigned u) { return __builtin_bit_cast(float, u << 16); }
__device__ __forceinline__ float bfhi(unsigned u) { return __builtin_bit_cast(float, u & 0xffff0000u); }
__device__ __forceinline__ float bf1(bf16_t b) { return __builtin_bit_cast(float, (unsigned)b << 16); }
__device__ __forceinline__ float fsigmoid(float x) { return __builtin_amdgcn_rcpf(1.0f + __expf(-x)); }
__device__ __forceinline__ float wave_sum(float v) {
#pragma unroll
    for (int o = 1; o < 64; o <<= 1) v += __shfl_xor(v, o);
    return v;
}
template <int CTRL> __device__ __forceinline__ float dpp_f(float v) { return __builtin_bit_cast(float, __builtin_amdgcn_update_dpp(0, __builtin_bit_cast(int, v), CTRL, 0xF, 0xF, true)); }
__device__ __forceinline__ float sum16(float x) {
    x += dpp_f<0xB1>(x); x += dpp_f<0x4E>(x); x += dpp_f<0x141>(x); x += dpp_f<0x140>(x); return x;
}
__device__ __forceinline__ float vmul(float a, float b) { float r; asm("v_mul_f32_e32 %0, %1, %2" : "=v"(r) : "v"(a), "v"(b)); return r; }
__device__ __forceinline__ float vfma(float a, float b, float c) { float r; asm("v_fma_f32 %0, %1, %2, %3" : "=v"(r) : "v"(a), "v"(b), "v"(c)); return r; }
#define LDS_WAIT() asm volatile("s_waitcnt lgkmcnt(0)" ::: "memory")
#define VM_WAIT() asm volatile("s_waitcnt vmcnt(0)" ::: "memory")
#define WG_BAR() do { asm volatile("s_waitcnt lgkmcnt(0)" ::: "memory"); __builtin_amdgcn_s_barrier(); asm volatile("" ::: "memory"); } while (0)

namespace pg8 {
constexpr int BM = 256, BK = 64, HALF = 128, HTB = HALF * BK * 2, STAGE_BYTES = 8 * HTB, NXCD = 8, WGM = 8;
__host__ __device__ __forceinline__ int lds_byte(int r, int c) { const int st = (r >> 4) * 2 + (c >> 5), rr = r & 15, cc = c & 31, ob = rr * 64 + cc * 2; return st * 1024 + (ob ^ (((ob >> 9) & 1) << 5)); }
__host__ __device__ __forceinline__ void stage_rc(int b, int& R, int& C) { const int st = b / 1024, sb = b % 1024, swz = sb ^ (((sb >> 9) & 1) << 5); R = (st >> 1) * 16 + swz / 64; C = (st & 1) * 32 + (swz % 64) / 2; }
__host__ __device__ __forceinline__ int perm32(int rho) { const int n = rho >> 4, i = rho & 15; return 8 * (i >> 2) + 4 * n + (i & 3); }

struct Unit { int pm, pn; };
struct Gemm { const bf16_t* A; const bf16_t* Bt; int M, N, K; };

struct StaticOrder {
    int nM, nN, nwg, G, c;
    __host__ __device__ void init(int M, int N, int G_, int c_) { nM = M / BM; nN = N / BM; nwg = nM * nN; G = G_; c = c_; }
    __host__ __device__ bool next(int i, Unit& u) const {
        const long L = (long)i * G + c; if (L >= nwg) return false;
        int wgid = (int)L; { const int q = nwg / NXCD, r = nwg % NXCD, xcd = wgid % NXCD, off = wgid / NXCD; wgid = (xcd < r ? xcd * (q + 1) : r * (q + 1) + (xcd - r) * q) + off; }
        const int nig = WGM * nN, gid = wgid / nig, fm = gid * WGM, gsz = (nM - fm) < WGM ? (nM - fm) : WGM;
        u.pm = fm + ((wgid % nig) % gsz); u.pn = (wgid % nig) / gsz; return true;
    }
    __device__ __forceinline__ void a_ready(const Unit&) const {}
    __device__ __forceinline__ void done(const Unit&) const {}
};

template <class Epi, class Sched, bool ALIGN_EPI = false, bool SP2 = false>
__device__ __forceinline__ void gemm_phase(LAS unsigned char* lds, const Gemm g, const Sched& S, const Epi& E) {
    int tid_ = threadIdx.x; asm volatile("" : "+v"(tid_));
    const int tid = tid_, wid = __builtin_amdgcn_readfirstlane(tid >> 6), lane = tid & 63, wr = wid >> 2, wc = wid & 3, fr = lane & 15, fq = lane >> 4;
    int K_ = g.K; asm volatile("" : "+s"(K_));
    const int K = K_, nt = K / BK;
    unsigned voffA[2], voffB[2];
#pragma unroll
    for (int i = 0; i < 2; ++i) { int R, C; stage_rc(tid * 16 + i * 8192, R, C); const int Rb = Epi::PERM ? ((R & ~31) + perm32(R & 31)) : R;
        voffA[i] = (unsigned)(R * K + C) * 2u; voffB[i] = (unsigned)(Rb * K + C) * 2u; }
    const size_t kstep = (size_t)(BK * 2);
    const size_t hstep = (size_t)HALF * K * 2;
    const size_t tstep = 2 * hstep;
    const unsigned ldsw = (unsigned)wid * 1024u;
    const int aoff = lds_byte(wr * 64 + fr, fq * 8), boff = lds_byte(wc * 32 + fr, fq * 8);
#define PG8_SA(b, h) (((b) * 2 + (h)) * HTB)
#define PG8_SB(b, h) ((4 + (b) * 2 + (h)) * HTB)
#define PG8_STAGE(bufoff, gbase, voff) do { _Pragma("unroll") for (int _i = 0; _i < 2; ++_i) \
        __builtin_amdgcn_global_load_lds((const unsigned*)((const char*)(gbase) + (voff)[_i]), (LAS unsigned*)(lds + (bufoff) + ldsw + _i * 8192), 16, 0, 0); } while (0)
#define PG8_LDA(dst, b, h) do { _Pragma("unroll") for (int m = 0; m < 4; ++m) _Pragma("unroll") for (int k = 0; k < 2; ++k) dst[m][k] = *(const LAS bf16x8*)(lds + PG8_SA(b, h) + aoff + m * 2048 + k * 1024); } while (0)
#define PG8_LDB(dst, b, h) do { _Pragma("unroll") for (int n = 0; n < 2; ++n) _Pragma("unroll") for (int k = 0; k < 2; ++k) dst[n][k] = *(const LAS bf16x8*)(lds + PG8_SB(b, h) + boff + n * 2048 + k * 1024); } while (0)
#define PG8_MMA(ai, bj, At, Bt) do { __builtin_amdgcn_s_setprio(1); _Pragma("unroll") for (int m = 0; m < 4; ++m) _Pragma("unroll") for (int n = 0; n < 2; ++n) _Pragma("unroll") for (int k = 0; k < 2; ++k) { \
        if constexpr (Epi::SWAP) acc[ai][bj][m][n] = __builtin_amdgcn_mfma_f32_16x16x32_bf16(At[m][k], Bt[n][k], acc[ai][bj][m][n], 0, 0, 0); \
        else acc[ai][bj][m][n] = __builtin_amdgcn_mfma_f32_16x16x32_bf16(Bt[n][k], At[m][k], acc[ai][bj][m][n], 0, 0, 0); } __builtin_amdgcn_s_setprio(0); } while (0)
#define PG8_WAIT_V(n) asm volatile("s_waitcnt vmcnt(" #n ")" ::: "memory")
#define PG8_WAIT_L(n) asm volatile("s_waitcnt lgkmcnt(" #n ")" ::: "memory")
#define PG8_BAR __builtin_amdgcn_s_barrier()
#define PG8_SCHED __builtin_amdgcn_sched_barrier(0)
    Unit cur, nxt; int ui = 0;
    if (!S.next(0, cur)) return;
    f32x4 acc[2][2][4][2];
#pragma unroll
    for (int a = 0; a < 2; ++a)
#pragma unroll
        for (int b = 0; b < 2; ++b)
#pragma unroll
            for (int m = 0; m < 4; ++m)
#pragma unroll
                for (int n = 0; n < 2; ++n) acc[a][b][m][n] = (f32x4){0.f, 0.f, 0.f, 0.f};
    bf16x8 At[4][2], B0[2][2], B1[2][2];
    const char* cA = (const char*)g.A + (size_t)cur.pm * tstep; const char* cB = (const char*)g.Bt + (size_t)cur.pn * tstep;
    S.a_ready(cur);
    if constexpr (SP2) {
        PG8_STAGE(PG8_SB(0, 0), cB, voffB); PG8_STAGE(PG8_SB(0, 1), cB + hstep, voffB); PG8_STAGE(PG8_SA(0, 0), cA, voffA); PG8_STAGE(PG8_SA(0, 1), cA + hstep, voffA);
        if (wr == 1) PG8_BAR;
        PG8_WAIT_V(2); PG8_BAR;
        PG8_STAGE(PG8_SB(1, 0), cB + kstep, voffB); PG8_STAGE(PG8_SA(1, 0), cA + kstep, voffA); PG8_STAGE(PG8_SB(1, 1), cB + hstep + kstep, voffB);
        PG8_WAIT_V(6); PG8_BAR;
    } else {
        PG8_STAGE(PG8_SB(0, 0), cB, voffB); PG8_STAGE(PG8_SA(0, 0), cA, voffA); PG8_STAGE(PG8_SB(0, 1), cB + hstep, voffB); PG8_STAGE(PG8_SA(0, 1), cA + hstep, voffA);
        if (wr == 1) PG8_BAR;
        PG8_WAIT_V(4); PG8_BAR;
        PG8_STAGE(PG8_SB(1, 0), cB + kstep, voffB); PG8_STAGE(PG8_SA(1, 0), cA + kstep, voffA); PG8_STAGE(PG8_SB(1, 1), cB + hstep + kstep, voffB);
        PG8_WAIT_V(6); PG8_BAR;
    }
    for (;;) {
        const bool has_next = S.next(ui + 1, nxt);
        const char* nA = has_next ? (const char*)g.A + (size_t)nxt.pm * tstep : cA; const char* nB = has_next ? (const char*)g.Bt + (size_t)nxt.pn * tstep : cB;
        for (int t = 0; t < nt; t += 2) {
            const bool last = (t == nt - 2);
            const char* a1 = cA + (size_t)(t + 1) * kstep;
            const char* a2 = last ? nA : cA + (size_t)(t + 2) * kstep; const char* b2 = last ? nB : cB + (size_t)(t + 2) * kstep;
            const char* a3 = a2 + kstep; const char* b3 = b2 + kstep;
            if (last && has_next) S.a_ready(nxt);
            if constexpr (SP2) {
            PG8_LDB(B0, 0, 0); PG8_LDB(B1, 0, 1); PG8_SCHED; PG8_LDA(At, 0, 0); PG8_STAGE(PG8_SA(1, 1), a1 + hstep, voffA);
            PG8_WAIT_V(8); PG8_WAIT_L(0); PG8_BAR; PG8_MMA(0, 0, At, B0); PG8_MMA(0, 1, At, B1); PG8_BAR; PG8_SCHED;
            PG8_LDA(At, 0, 1); PG8_STAGE(PG8_SB(0, 0), b2, voffB); PG8_STAGE(PG8_SB(0, 1), b2 + hstep, voffB); PG8_STAGE(PG8_SA(0, 0), a2, voffA);
            PG8_WAIT_V(8); PG8_WAIT_L(0); PG8_BAR; PG8_MMA(1, 0, At, B0); PG8_MMA(1, 1, At, B1); PG8_BAR; PG8_SCHED;
            PG8_LDB(B0, 1, 0); PG8_LDB(B1, 1, 1); PG8_SCHED; PG8_LDA(At, 1, 0); PG8_STAGE(PG8_SA(0, 1), a2 + hstep, voffA);
            PG8_WAIT_V(8); PG8_WAIT_L(0); PG8_BAR; PG8_MMA(0, 0, At, B0); PG8_MMA(0, 1, At, B1); PG8_BAR; PG8_SCHED;
            PG8_LDA(At, 1, 1); PG8_STAGE(PG8_SB(1, 0), b3, voffB); PG8_STAGE(PG8_SB(1, 1), b3 + hstep, voffB); PG8_STAGE(PG8_SA(1, 0), a3, voffA);
            PG8_WAIT_V(8); PG8_WAIT_L(0); PG8_BAR; PG8_MMA(1, 0, At, B0); PG8_MMA(1, 1, At, B1); PG8_BAR; PG8_SCHED;
            } else {
            PG8_LDB(B0, 0, 0); PG8_SCHED; PG8_LDA(At, 0, 0); PG8_STAGE(PG8_SA(1, 1), a1 + hstep, voffA);
            PG8_WAIT_L(8); PG8_BAR; PG8_WAIT_L(0); PG8_MMA(0, 0, At, B0); PG8_BAR; PG8_SCHED;
            PG8_LDB(B1, 0, 1); PG8_STAGE(PG8_SB(0, 0), b2, voffB);
            PG8_BAR; PG8_WAIT_L(0); PG8_MMA(0, 1, At, B1); PG8_BAR;
            PG8_LDA(At, 0, 1); PG8_STAGE(PG8_SA(0, 0), a2, voffA);
            PG8_BAR; PG8_WAIT_L(0); PG8_MMA(1, 0, At, B0); PG8_BAR; PG8_SCHED;
            PG8_STAGE(PG8_SB(0, 1), b2 + hstep, voffB);
            PG8_WAIT_V(6); PG8_BAR; PG8_MMA(1, 1, At, B1); PG8_BAR;
            PG8_LDB(B0, 1, 0); PG8_SCHED; PG8_LDA(At, 1, 0); PG8_STAGE(PG8_SA(0, 1), a2 + hstep, voffA);
            PG8_WAIT_L(8); PG8_BAR; PG8_WAIT_L(0); PG8_MMA(0, 0, At, B0); PG8_BAR; PG8_SCHED;
            PG8_LDB(B1, 1, 1); PG8_STAGE(PG8_SB(1, 0), b3, voffB);
            PG8_BAR; PG8_WAIT_L(0); PG8_MMA(0, 1, At, B1); PG8_BAR;
            PG8_LDA(At, 1, 1); PG8_STAGE(PG8_SA(1, 0), a3, voffA);
            PG8_BAR; PG8_WAIT_L(0); PG8_MMA(1, 0, At, B0); PG8_BAR; PG8_SCHED;
            PG8_STAGE(PG8_SB(1, 1), b3 + hstep, voffB);
            PG8_WAIT_V(6); PG8_BAR; PG8_MMA(1, 1, At, B1); PG8_BAR;
            }
        }
        if constexpr (ALIGN_EPI) { if (wr == 0) PG8_BAR; }
        E(acc, cur, wr, wc, fr, fq); S.done(cur);
        if (!has_next) break;
#pragma unroll
        for (int a = 0; a < 2; ++a)
#pragma unroll
            for (int b = 0; b < 2; ++b)
#pragma unroll
                for (int m = 0; m < 4; ++m)
#pragma unroll
                    for (int n = 0; n < 2; ++n) acc[a][b][m][n] = (f32x4){0.f, 0.f, 0.f, 0.f};
        cur = nxt; cA = nA; cB = nB; ++ui;
        if constexpr (ALIGN_EPI) { if (wr == 1) PG8_BAR; }
    }
    PG8_WAIT_V(0);
    if constexpr (!ALIGN_EPI) { if (wr == 0) PG8_BAR; }
    PG8_BAR;
#undef PG8_SA
#undef PG8_SB
#undef PG8_STAGE
#undef PG8_LDA
#undef PG8_LDB
#undef PG8_MMA
#undef PG8_WAIT_V
#undef PG8_WAIT_L
#undef PG8_BAR
#undef PG8_SCHED
}

typedef const f32x4 (&AccRef)[2][2][4][2];
__device__ __forceinline__ u32x4 pack8(f32x4 v0, f32x4 v1) { u32x4 w; w.x = pk2(v0[0], v0[1]); w.y = pk2(v0[2], v0[3]); w.z = pk2(v1[0], v1[1]); w.w = pk2(v1[2], v1[3]); return w; }
__device__ __forceinline__ void unpack8(u32x4 w, f32x4& v0, f32x4& v1) { v0 = (f32x4){bflo(w.x), bfhi(w.x), bflo(w.y), bfhi(w.y)}; v1 = (f32x4){bflo(w.z), bfhi(w.z), bflo(w.w), bfhi(w.w)}; }

struct EpiBf16 {
    static constexpr bool PERM = true, SWAP = false;
    bf16_t* O; int ldc;
    __device__ __forceinline__ void operator()(AccRef acc, const Unit& u, int wr, int wc, int fr, int fq) const {
        const int row0 = u.pm * BM + wr * 64 + fr, col0 = u.pn * BM + wc * 32 + 8 * fq;
#pragma unroll
        for (int ai = 0; ai < 2; ++ai)
#pragma unroll
            for (int m = 0; m < 4; ++m) { bf16_t* rowp = O + (size_t)(row0 + ai * HALF + m * 16) * ldc + col0;
#pragma unroll
                for (int bj = 0; bj < 2; ++bj) *(u32x4*)(rowp + bj * HALF) = pack8(acc[ai][bj][m][0], acc[ai][bj][m][1]); }
    }
};
struct EpiProj {
    static constexpr bool PERM = true, SWAP = false;
    bf16_t* O; const float* rope;
    __device__ __forceinline__ void operator()(AccRef acc, const Unit& u, int wr, int wc, int fr, int fq) const {
        const int row0 = u.pm * BM + wr * 64 + fr, col0 = u.pn * BM + wc * 32 + 8 * fq;
        const int mode = (u.pn >= 27 && u.pn < 43) ? (u.pn < 35 ? 1 : 2) : 0;
        const float sc = (mode == 1) ? QSCALE : 1.0f;
#pragma unroll
        for (int ai = 0; ai < 2; ++ai)
#pragma unroll
            for (int m = 0; m < 4; ++m) { const int row = row0 + ai * HALF + m * 16; bf16_t* rowp = O + (size_t)row * PLD + col0;
#pragma unroll
                for (int bj = 0; bj < 2; ++bj) { f32x4 v0 = acc[ai][bj][m][0], v1 = acc[ai][bj][m][1];
                    if (mode) { const int i0 = ((col0 + bj * HALF) & 127) >> 1; const f32x4* rp = (const f32x4*)(rope + ((size_t)row * 64 + i0) * 2); const f32x4 c0 = rp[0], c1 = rp[1];
                        f32x4 o0, o1;
                        o0[0] = v0[0] * c0[0] - v0[1] * c0[1]; o0[1] = v0[1] * c0[0] + v0[0] * c0[1]; o0[2] = v0[2] * c0[2] - v0[3] * c0[3]; o0[3] = v0[3] * c0[2] + v0[2] * c0[3];
                        o1[0] = v1[0] * c1[0] - v1[1] * c1[1]; o1[1] = v1[1] * c1[0] + v1[0] * c1[1]; o1[2] = v1[2] * c1[2] - v1[3] * c1[3]; o1[3] = v1[3] * c1[2] + v1[2] * c1[3];
                        v0 = o0 * sc; v1 = o1 * sc; }
                    *(u32x4*)(rowp + bj * HALF) = pack8(v0, v1); } }
    }
};
struct EpiVT {
    static constexpr bool PERM = false, SWAP = true;
    bf16_t* VT;
    __device__ __forceinline__ void operator()(AccRef acc, const Unit& u, int wr, int wc, int fr, int fq) const {
        const int tok0 = u.pm * BM + wr * 64 + 4 * fq, col0 = u.pn * BM + wc * 32 + fr;
#pragma unroll
        for (int ai = 0; ai < 2; ++ai)
#pragma unroll
            for (int m = 0; m < 4; ++m)
#pragma unroll
                for (int bj = 0; bj < 2; ++bj)
#pragma unroll
                    for (int n = 0; n < 2; ++n) { const f32x4 v = acc[ai][bj][m][n]; u32x2 w; w.x = pk2(v[0], v[1]); w.y = pk2(v[2], v[3]);
                        *(u32x2*)(VT + (size_t)(col0 + bj * HALF + n * 16) * T + tok0 + ai * HALF + m * 16) = w; }
    }
};
struct EpiDec {
    static constexpr bool PERM = true, SWAP = false;
    float* O; const float* w0;
    __device__ __forceinline__ void operator()(AccRef acc, const Unit& u, int wr, int wc, int fr, int fq) const {
        const int row0 = u.pm * BM + wr * 64 + fr, col0 = u.pn * BM + wc * 32 + 8 * fq;
#pragma unroll
        for (int bj = 0; bj < 2; ++bj) { const f32x4 b0 = *(const f32x4*)(w0 + col0 + bj * HALF), b1 = *(const f32x4*)(w0 + col0 + bj * HALF + 4);
#pragma unroll
            for (int ai = 0; ai < 2; ++ai)
#pragma unroll
                for (int m = 0; m < 4; ++m) { float* rowp = O + (size_t)(row0 + ai * HALF + m * 16) * RW + col0 + bj * HALF;
#pragma unroll
                    for (int n = 0; n < 2; ++n) { const f32x4 x = acc[ai][bj][m][n] + (n ? b1 : b0); f32x4 o;
#pragma unroll
                        for (int e = 0; e < 4; ++e) { const float z = -x[e]; const float sp = fmaxf(z, 0.f) + __logf(1.0f + __expf(-fabsf(z))); o[e] = __expf(-__expf(-sp - 0.5f)); }
                        *(f32x4*)(rowp + 4 * n) = o; }
                    asm volatile("" ::: "memory"); } }
    }
};
struct EpiA {
    static constexpr bool PERM = true, SWAP = false;
    bf16_t* KP; bf16_t* BB; const bf16_t* KKN; const float* a0; const float* k_a;
    __device__ __forceinline__ void operator()(AccRef acc, const Unit& u, int wr, int wc, int fr, int fq) const {
        const int row0 = u.pm * BM + wr * 64 + fr, col0 = u.pn * BM + wc * 32 + 8 * fq;
#pragma unroll
        for (int bj = 0; bj < 2; ++bj) { const int cb = col0 + bj * HALF;
            const f32x4 b0 = *(const f32x4*)(a0 + cb), b1 = *(const f32x4*)(a0 + cb + 4), ka0 = *(const f32x4*)(k_a + cb), ka1 = *(const f32x4*)(k_a + cb + 4);
#pragma unroll
            for (int ai = 0; ai < 2; ++ai)
#pragma unroll
                for (int m = 0; m < 4; ++m) { const size_t off = (size_t)(row0 + ai * HALF + m * 16) * RW + cb;
                    f32x4 zk0, zk1, kn0, kn1; unpack8(*(const u32x4*)(KP + off), zk0, zk1); unpack8(*(const u32x4*)(KKN + off), kn0, kn1);
                    f32x4 a0v, a1v;
#pragma unroll
                    for (int e = 0; e < 4; ++e) { a0v[e] = fsigmoid(acc[ai][bj][m][0][e] + b0[e]); a1v[e] = fsigmoid(acc[ai][bj][m][1][e] + b1[e]); }
                    const f32x4 kp0 = zk0 * (1.0f + (a0v - 1.0f) * ka0), kp1 = zk1 * (1.0f + (a1v - 1.0f) * ka1);
                    *(u32x4*)(KP + off) = pack8(kp0, kp1); *(u32x4*)(BB + off) = pack8(-(kn0 * a0v), -(kn1 * a1v));
                    asm volatile("" ::: "memory"); } }
    }
};
template <bool ADD> struct EpiMix {
    static constexpr bool PERM = true, SWAP = false;
    bf16_t* O; const bf16_t* proj; int gcol0;
    __device__ __forceinline__ void operator()(AccRef acc, const Unit& u, int wr, int wc, int fr, int fq) const {
        const int row0 = u.pm * BM + wr * 64 + fr, col0 = u.pn * BM + wc * 32 + 8 * fq;
#pragma unroll
        for (int ai = 0; ai < 2; ++ai)
#pragma unroll
            for (int m = 0; m < 4; ++m) { const int row = row0 + ai * HALF + m * 16;
#pragma unroll
                for (int bj = 0; bj < 2; ++bj) { f32x4 g0, g1; unpack8(*(const u32x4*)(proj + (size_t)row * PLD + gcol0 + col0 + bj * HALF), g0, g1);
                    f32x4 o0, o1;
#pragma unroll
                    for (int e = 0; e < 4; ++e) { o0[e] = fsigmoid(g0[e]) * acc[ai][bj][m][0][e]; o1[e] = fsigmoid(g1[e]) * acc[ai][bj][m][1][e]; }
                    bf16_t* op = O + (size_t)row * D + col0 + bj * HALF;
                    if (ADD) { f32x4 p0, p1; unpack8(*(const u32x4*)op, p0, p1); o0 += p0; o1 += p1; }
                    *(u32x4*)op = pack8(o0, o1); } }
    }
};
struct EpiRes {
    static constexpr bool PERM = true, SWAP = false;
    float* O; const float* x;
    __device__ __forceinline__ void operator()(AccRef acc, const Unit& u, int wr, int wc, int fr, int fq) const {
        const int row0 = u.pm * BM + wr * 64 + fr, col0 = u.pn * BM + wc * 32 + 8 * fq;
#pragma unroll
        for (int ai = 0; ai < 2; ++ai)
#pragma unroll
            for (int m = 0; m < 4; ++m) { const size_t off = (size_t)(row0 + ai * HALF + m * 16) * D + col0;
#pragma unroll
                for (int bj = 0; bj < 2; ++bj)
#pragma unroll
                    for (int n = 0; n < 2; ++n) *(f32x4*)(O + off + bj * HALF + 4 * n) = *(const f32x4*)(x + off + bj * HALF + 4 * n) + acc[ai][bj][m][n]; }
    }
};
}

#define XB_TMO      128
#define XB_XCNT(j)  (256  + 64 * (j))
#define XB_XSUB(j)  (1280 + 64 * (j))
#define XB_XGEN(j)  (2304 + 64 * (j))
#define XB_TOP      3328
#define XB_TOPGEN   3392
#define XCD_BAR_WORDS 3456
#define XB_SPIN_CAP (1u << 18)
__device__ __forceinline__ unsigned xb_ld(unsigned* p)              { return __hip_atomic_load(p, __ATOMIC_RELAXED, __HIP_MEMORY_SCOPE_AGENT); }
__device__ __forceinline__ unsigned xb_add(unsigned* p, unsigned v) { return __hip_atomic_fetch_add(p, v, __ATOMIC_RELAXED, __HIP_MEMORY_SCOPE_AGENT); }
__device__ __forceinline__ unsigned xb_xcc_id() { return (unsigned)__builtin_amdgcn_s_getreg((3 << 11) | 20) & 0xFu; }
#define XB_SPIN(cond, bar) do { unsigned _sp = 0; while (cond) { __builtin_amdgcn_s_sleep(1); \
    if ((++_sp & 255u) == 0u) { if (xb_ld(&(bar)[XB_TMO])) break; if (_sp > XB_SPIN_CAP) { atomicAdd(&(bar)[XB_TMO], 1u); break; } } } } while (0)
struct XcdBarrier { unsigned* bar; unsigned x; volatile LAS unsigned* st; };
__device__ __forceinline__ XcdBarrier xcd_barrier_post(unsigned* bar, volatile LAS unsigned* st) {
    XcdBarrier b; b.bar = bar; b.x = xb_xcc_id(); b.st = st;
    if (threadIdx.x == 0) (void)xb_add(&bar[XB_XCNT(b.x)], 1u);
    return b;
}
__device__ __forceinline__ void xcd_barrier_complete(unsigned* bar, unsigned x, unsigned& nloc, unsigned& nx) {
    const unsigned G = gridDim.x * gridDim.y * gridDim.z;
    unsigned sum, cnt, mine, sp = 0u;
    for (;;) {
        sum = 0u; cnt = 0u; mine = 0u;
#pragma unroll
        for (unsigned j = 0; j < 16; ++j) { const unsigned c = xb_ld(&bar[XB_XCNT(j)]); sum += c; cnt += (c > 0u) ? 1u : 0u; mine = (j == x) ? c : mine; }
        if (sum == G) break;
        __builtin_amdgcn_s_sleep(1);
        if ((++sp & 255u) == 0u) { if (xb_ld(&bar[XB_TMO])) break; if (sp > XB_SPIN_CAP) { atomicAdd(&bar[XB_TMO], 1u); break; } }
    }
    nloc = mine > 0u ? mine : 1u; nx = cnt > 0u ? cnt : 1u;
}
__device__ __forceinline__ void xcd_barrier(const XcdBarrier& b) {
    asm volatile("s_waitcnt vmcnt(0)" ::: "memory");
    __syncthreads();
    if (threadIdx.x == 0) {
        unsigned* bar = b.bar;
        __builtin_amdgcn_s_waitcnt(0);
        unsigned nloc = b.st[0], nx = b.st[1];
        if (nloc == 0u) { xcd_barrier_complete(bar, b.x, nloc, nx); b.st[0] = nloc; b.st[1] = nx; }
        const unsigned old = xb_add(&bar[XB_XSUB(b.x)], 1u);
        const unsigned gen = old / nloc;
        if (old + 1u == (gen + 1u) * nloc) {
            __builtin_amdgcn_fence(__ATOMIC_RELEASE, "agent");
            asm volatile("s_waitcnt vmcnt(0)" ::: "memory");
            const unsigned og = xb_add(&bar[XB_TOP], 1u);
            const unsigned tg = og / nx;
            if (og + 1u == (tg + 1u) * nx) xb_add(&bar[XB_TOPGEN], 1u);
            else XB_SPIN(xb_ld(&bar[XB_TOPGEN]) == tg, bar);
            __builtin_amdgcn_fence(__ATOMIC_ACQUIRE, "agent");
            xb_add(&bar[XB_XGEN(b.x)], 1u);
            asm volatile("s_waitcnt vmcnt(0)" ::: "memory");
        } else {
            XB_SPIN(xb_ld(&bar[XB_XGEN(b.x)]) == gen, bar);
            __builtin_amdgcn_fence(__ATOMIC_ACQUIRE, "agent");
            asm volatile("s_waitcnt vmcnt(0)" ::: "memory");
        }
    }
    __syncthreads();
}

struct Args {
    const float *x, *norm1_g, *w_in, *mu, *w0, *w_up, *a0, *a_up, *g_up, *k_k, *k_a, *r_k, *lnx_g, *lnx_b, *w_ba, *w_bb, *w_out, *norm2_g, *peer_wq, *sub_keys, *peer_u, *peer_v, *final_g;
    float* out; unsigned char* ws; int ph_lo, ph_hi, li, pad;
};
#define CAS __attribute__((address_space(4)))
typedef const CAS Args* ArgsP;
__device__ __forceinline__ ArgsP get_args() { ArgsP p = (ArgsP)__builtin_amdgcn_kernarg_segment_ptr(); asm volatile("" : "+s"(p)); return p; }
struct Frame { LAS unsigned char* lds; int tid, lane, wave, vcu, G; };

__device__ __forceinline__ int win_dst(int s) {
    if (s < SHIFTW) return s;
    if (s < SHIFTW + 4096) { const int base = (s < SHIFTW + 2048) ? SHIFTW : SHIFTW + 2048; const int m = s - base, head = m >> 7, c = m & 127; const int j = (c < 64) ? 2 * c : 2 * (c - 64) + 1;
        return ((s < SHIFTW + 2048) ? PC_MQ : PC_MK) + head * 128 + j; }
    if (s < SHIFTW + 6144) return PC_MV + (s - (SHIFTW + 4096));
    if (s < SHIFTW + 6144 + 4096) return PC_GA + (s - (SHIFTW + 6144));
    return PC_GB + (s - (SHIFTW + 6144 + 4096));
}
template <bool MAPWIN> __device__ __forceinline__ void p0_transpose_item(const float* W, int K, int N, bf16_t* WT, int Kd, LAS float* scr, int item, int lane) {
    const int nblk = N / 32, kb = item / nblk, nb = item % nblk, k0 = 64 * kb, n0 = 32 * nb;
    { const int krow = lane >> 3, c4 = lane & 7; f32x4 v[8];
#pragma unroll
      for (int i = 0; i < 8; ++i) { const int kk = 8 * i + krow; v[i] = (k0 + kk < K) ? *(const f32x4*)(W + (size_t)(k0 + kk) * N + n0 + 4 * c4) : (f32x4){0.f, 0.f, 0.f, 0.f}; }
#pragma unroll
      for (int i = 0; i < 8; ++i) { LAS float* d = scr + (8 * i + krow) * 33 + 4 * c4; d[0] = v[i].x; d[1] = v[i].y; d[2] = v[i].z; d[3] = v[i].w; } }
    LDS_WAIT(); asm volatile("" ::: "memory");
    const int c = lane & 7;
#pragma unroll
    for (int j = 0; j < 4; ++j) { const int n = (lane >> 3) + 8 * j; const LAS float* s = scr + (8 * c) * 33 + n;
        u32x4 o; o.x = pk2(s[0 * 33], s[1 * 33]); o.y = pk2(s[2 * 33], s[3 * 33]); o.z = pk2(s[4 * 33], s[5 * 33]); o.w = pk2(s[6 * 33], s[7 * 33]);
        const int row = MAPWIN ? win_dst(n0 + n) : (n0 + n);
        *(u32x4*)(WT + (size_t)row * Kd + k0 + 8 * c) = o; }
    LDS_WAIT(); asm volatile("" ::: "memory");
}
__device__ __forceinline__ void rms_rows_to_bf16(const float* x, const float* g, bf16_t* o, int m0, int mstride, int lane) {
    const f32x4* gr = (const f32x4*)g + lane;
    f32x4 v[16], w[16];
    if (m0 < T) {
#pragma unroll
        for (int j = 0; j < 16; ++j) v[j] = ((const f32x4*)(x + (size_t)m0 * D) + lane)[64 * j]; }
    for (int m = m0; m < T; m += mstride) { const bool hasn = m + mstride < T;
        if (hasn) {
#pragma unroll
            for (int j = 0; j < 16; ++j) w[j] = ((const f32x4*)(x + (size_t)(m + mstride) * D) + lane)[64 * j]; }
        float s = 0.f;
#pragma unroll
        for (int j = 0; j < 16; ++j) s += (v[j].x * v[j].x + v[j].y * v[j].y) + (v[j].z * v[j].z + v[j].w * v[j].w);
        const float rs = 1.0f / sqrtf(wave_sum(s) * (1.0f / D) + NORM_EPS);
        u32x2* o8 = (u32x2*)(o + (size_t)m * D) + lane;
#pragma unroll
        for (int j = 0; j < 16; ++j) { const f32x4 gg = gr[64 * j]; u32x2 q; q.x = pk2(v[j].x * rs * gg.x, v[j].y * rs * gg.y); q.y = pk2(v[j].z * rs * gg.z, v[j].w * rs * gg.w); o8[64 * j] = q; }
        if (hasn) {
#pragma unroll
            for (int j = 0; j < 16; ++j) v[j] = w[j]; }
    }
}
__device__ __forceinline__ void cvt_table(const float* src, bf16_t* dst, size_t n8, size_t gtid, size_t nthr) {
    for (size_t i = gtid; i < n8; i += nthr) { const f32x4 a = ((const f32x4*)src)[2 * i], b = ((const f32x4*)src)[2 * i + 1]; ((u32x4*)dst)[i] = pg8::pack8(a, b); }
}
__device__ __forceinline__ void pq_load(ArgsP A, int row, int lane, f32x4 (&v)[16]) {
    const f32x4* src = (const f32x4*)((row >= 16384 ? A->peer_v + (size_t)(row - 16384) * D : A->peer_u + (size_t)row * D)) + lane;
#pragma unroll
    for (int j = 0; j < 16; ++j) v[j] = __builtin_nontemporal_load(src + 64 * j);
}
__device__ __forceinline__ void pq_finish(unsigned char* ws, int row, int lane, const f32x4 (&v)[16]) {
    const bool isv = row >= 16384; const int rr = isv ? row - 16384 : row; float am = 0.f;
#pragma unroll
    for (int j = 0; j < 16; ++j) am = fmaxf(fmaxf(am, fmaxf(fabsf(v[j].x), fabsf(v[j].y))), fmaxf(fabsf(v[j].z), fabsf(v[j].w)));
#pragma unroll
    for (int o = 1; o < 64; o <<= 1) am = fmaxf(am, __shfl_xor(am, o));
    const float inv = am > 0.f ? 127.0f / am : 0.f; unsigned* dst = (unsigned*)(ws + (isv ? WS_PV : WS_PU)) + (size_t)rr * (D / 4) + lane;
#pragma unroll
    for (int j = 0; j < 16; ++j) { const unsigned q0 = (unsigned)(int)(rintf(v[j].x * inv) + 128.0f), q1 = (unsigned)(int)(rintf(v[j].y * inv) + 128.0f), q2 = (unsigned)(int)(rintf(v[j].z * inv) + 128.0f), q3 = (unsigned)(int)(rintf(v[j].w * inv) + 128.0f);
        dst[64 * j] = q0 | (q1 << 8) | (q2 << 16) | (q3 << 24); }
    if (lane == 0) ((float*)(ws + (isv ? WS_PSV : WS_PSU)))[rr] = am * (1.0f / 127.0f);
}
__device__ __forceinline__ void peer_quant(ArgsP A, Frame& F, int w0, int wstride) {
    unsigned char* ws = A->ws; const float* pu = A->peer_u; const float* pv = A->peer_v;
    f32x4 v[16], w[16];
    auto rowp = [&](int row) { return (const f32x4*)((row >= 16384 ? pv + (size_t)(row - 16384) * D : pu + (size_t)row * D)) + F.lane; };
    if (w0 < 2 * 16384) { const f32x4* src = rowp(w0);
#pragma unroll
        for (int j = 0; j < 16; ++j) v[j] = __builtin_nontemporal_load(src + 64 * j); }
    for (int row = w0; row < 2 * 16384; row += wstride) { const bool isv = row >= 16384; const int rr = isv ? row - 16384 : row; const bool hasn = row + wstride < 2 * 16384;
        if (hasn) { const f32x4* src = rowp(row + wstride);
#pragma unroll
            for (int j = 0; j < 16; ++j) w[j] = __builtin_nontemporal_load(src + 64 * j); }
        float am = 0.f;
#pragma unroll
        for (int j = 0; j < 16; ++j) am = fmaxf(fmaxf(am, fmaxf(fabsf(v[j].x), fabsf(v[j].y))), fmaxf(fabsf(v[j].z), fabsf(v[j].w)));
#pragma unroll
        for (int o = 1; o < 64; o <<= 1) am = fmaxf(am, __shfl_xor(am, o));
        const float inv = am > 0.f ? 127.0f / am : 0.f; unsigned* dst = (unsigned*)(ws + (isv ? WS_PV : WS_PU)) + (size_t)rr * (D / 4) + F.lane;
#pragma unroll
        for (int j = 0; j < 16; ++j) { const unsigned q0 = (unsigned)(int)(rintf(v[j].x * inv) + 128.0f), q1 = (unsigned)(int)(rintf(v[j].y * inv) + 128.0f), q2 = (unsigned)(int)(rintf(v[j].z * inv) + 128.0f), q3 = (unsigned)(int)(rintf(v[j].w * inv) + 128.0f);
            dst[64 * j] = q0 | (q1 << 8) | (q2 << 16) | (q3 << 24); }
        if (F.lane == 0) ((float*)(ws + (isv ? WS_PSV : WS_PSU)))[rr] = am * (1.0f / 127.0f);
        if (hasn) {
#pragma unroll
            for (int j = 0; j < 16; ++j) v[j] = w[j]; }
    }
}
__device__ __forceinline__ void late_weights(ArgsP A, Frame& F, int w0, int wstride) {
    unsigned char* ws = A->ws;
    LAS float* scr = (LAS float*)(F.lds + RING_OFF + F.wave * 16384);
    constexpr int I_BA = 32 * 128, I_OUT = 64 * 128, I_WQ = 64 * 64, I_SK = PH_ * 2 * PNK * PHALF / 512;
    constexpr int NITEMS = 2 * I_BA + I_OUT + I_WQ + I_SK;
    for (int it = w0; it < NITEMS; it += wstride) {
        int r = it;
        if (r < I_BA) { p0_transpose_item<false>(A->w_ba, RW, D, (bf16_t*)(ws + WS_WA), RW, scr, r, F.lane); continue; } r -= I_BA;
        if (r < I_BA) { p0_transpose_item<false>(A->w_bb, RW, D, (bf16_t*)(ws + WS_WB), RW, scr, r, F.lane); continue; } r -= I_BA;
        if (r < I_OUT) { p0_transpose_item<false>(A->w_out, D, D, (bf16_t*)(ws + WS_WOUT), D, scr, r, F.lane); continue; } r -= I_OUT;
        if (r < I_WQ) { p0_transpose_item<false>(A->peer_wq, D, 2048, (bf16_t*)(ws + WS_WQ), D, scr, r, F.lane); continue; } r -= I_WQ;
        { const size_t i = (size_t)r * 64 + F.lane; const f32x4 a = ((const f32x4*)A->sub_keys)[2 * i], b = ((const f32x4*)A->sub_keys)[2 * i + 1]; ((u32x4*)(ws + WS_SUBK))[i] = pg8::pack8(a, b); }
    }
}
__device__ __forceinline__ void ph0_prologue(ArgsP A, Frame& F) {
    unsigned char* ws = A->ws;
    LAS float* scr = (LAS float*)(F.lds + RING_OFF + F.wave * 16384);
    const int gw = F.vcu * NWAVES + F.wave, NGW = F.G * NWAVES;
    constexpr int I_IN = 64 * (INW / 32), I_UP = 2 * 64, I_G = 8 * 64;
    constexpr int NITEMS = I_IN + 2 * I_UP + I_G;
    for (int it = gw; it < NITEMS; it += NGW) {
        int r = it;
        if (r < I_IN) { p0_transpose_item<true>(A->w_in, D, INW, (bf16_t*)(ws + WS_WIN), D, scr, r, F.lane); continue; } r -= I_IN;
        if (r < I_UP) { p0_transpose_item<false>(A->w_up, LW, RW, (bf16_t*)(ws + WS_WUP), LW, scr, r, F.lane); continue; } r -= I_UP;
        if (r < I_UP) { p0_transpose_item<false>(A->a_up, LA, RW, (bf16_t*)(ws + WS_AUP), LA, scr, r, F.lane); continue; } r -= I_UP;
        p0_transpose_item<false>(A->g_up, LG, RW, (bf16_t*)(ws + WS_GUP), LGP, scr, r, F.lane);
    }
    const size_t gtid = (size_t)F.vcu * NTHR + F.tid, nthr = (size_t)F.G * NTHR;
    for (size_t i = gtid; i < (size_t)32 * D / 8; i += nthr) ((u32x4*)((bf16_t*)(ws + WS_WIN) + (size_t)SHIFTW * D))[i] = (u32x4){0u, 0u, 0u, 0u};
    for (size_t i = gtid; i < (size_t)T * 64; i += nthr) { const int pos = (int)(i >> 6), fi = (int)(i & 63); const float inv = powf(10000.0f, -(float)fi / 64.0f); const float ang = (float)pos * inv;
        ((f32x2*)(ws + WS_ROPE))[i] = (f32x2){cosf(ang), sinf(ang)}; }
    rms_rows_to_bf16(A->x, A->norm1_g, (bf16_t*)(ws + WS_XN), gw, NGW, F.lane);
}

__device__ __forceinline__ f32x4 ld4bf(const bf16_t* p) { const u32x2 w = *(const u32x2*)p; return (f32x4){bflo(w.x), bfhi(w.x), bflo(w.y), bfhi(w.y)}; }
__device__ __forceinline__ void st4bf(bf16_t* p, f32x4 v) { u32x2 w; w.x = pk2(v[0], v[1]); w.y = pk2(v[2], v[3]); *(u32x2*)p = w; }
__device__ __forceinline__ void ph2_prep(ArgsP A, Frame& F) {
    unsigned char* ws = A->ws; const bf16_t* PROJ = (const bf16_t*)(ws + WS_PROJ);
    LAS float* red = (LAS float*)(F.lds + RING_OFF);
    for (int it = F.vcu; it < NBLK * MH; it += F.G) { const int n = it / MH, h = it % MH, d = F.tid & 127, part = F.tid >> 7;
        const bf16_t* p = PROJ + (size_t)(n * MBLK + part * 64) * PLD + PC_MK + h * MD + d; float s = 0.f;
#pragma unroll 8
        for (int i = 0; i < 64; ++i) s += bf1(p[(size_t)i * PLD]);
        red[F.tid] = s; WG_BAR();
        if (F.tid < 128) { const float m = (red[F.tid] + red[F.tid + 128] + red[F.tid + 256] + red[F.tid + 384]) * (1.0f / MBLK); const unsigned hi = f2bf(m); const float lo = m - __builtin_bit_cast(float, hi << 16);
            ((bf16_t*)(ws + WS_KMEAN))[(size_t)(h * NBLK + n) * MD + F.tid] = (bf16_t)hi; ((bf16_t*)(ws + WS_KMEAN + 131072))[(size_t)(h * NBLK + n) * MD + F.tid] = (bf16_t)f2bf(lo); }
        WG_BAR(); }
    const int tid = F.tid; const int c = 4 * tid;
    const f32x4 mu_r = *(const f32x4*)(A->mu + PC_R + c), mu_k = *(const f32x4*)(A->mu + PC_K + c), mu_v = *(const f32x4*)(A->mu + PC_V + c), kkw = *(const f32x4*)(A->k_k + c);
    int lc = 0, lcc = 0; if (tid < 32) { lcc = 4 * tid; lc = PC_WL + lcc; } else if (tid < 64) { lcc = 4 * (tid - 32); lc = PC_AL + lcc; } else { lcc = 4 * (tid - 64); lc = PC_GL + lcc; }
    const bool lact = tid < 64 || (tid < 192 && lcc < LG);
    const f32x4 mu_l = lact ? *(const f32x4*)(A->mu + lc) : (f32x4){0.f, 0.f, 0.f, 0.f};
    u32x2 cur[8], nxt[8];
    auto tload = [&](int t, u32x2 (&rg)[8]) { const bf16_t* P = PROJ + (size_t)t * PLD; const bf16_t* PP = t > 0 ? P - PLD : P;
        rg[0] = *(const u32x2*)(P + PC_R + c); rg[1] = *(const u32x2*)(PP + PC_R + c); rg[2] = *(const u32x2*)(P + PC_K + c); rg[3] = *(const u32x2*)(PP + PC_K + c);
        rg[4] = *(const u32x2*)(P + PC_V + c); rg[5] = *(const u32x2*)(PP + PC_V + c);
        if (lact) { rg[6] = *(const u32x2*)(P + lc); rg[7] = *(const u32x2*)(PP + lc); } else { rg[6] = (u32x2){0u, 0u}; rg[7] = (u32x2){0u, 0u}; } };
    auto up4 = [](u32x2 w) { return (f32x4){bflo(w.x), bfhi(w.x), bflo(w.y), bfhi(w.y)}; };
    if (F.vcu < T) tload(F.vcu, cur);
    for (int t = F.vcu; t < T; t += F.G) { const bool hasn = t + F.G < T; if (hasn) tload(t + F.G, nxt);
        const float hp = t > 0 ? 1.0f : 0.0f;
        { const f32x4 p = up4(cur[0]), pp = up4(cur[1]) * hp; st4bf((bf16_t*)(ws + WS_ZR) + (size_t)t * RW + c, p + (pp - p) * mu_r); }
        { const f32x4 p = up4(cur[2]), pp = up4(cur[3]) * hp; const f32x4 zk = p + (pp - p) * mu_k;
          st4bf((bf16_t*)(ws + WS_KP) + (size_t)t * RW + c, zk); const f32x4 kk = zk * kkw;
          const float ss = sum16((kk[0] * kk[0] + kk[1] * kk[1]) + (kk[2] * kk[2] + kk[3] * kk[3])); const float inv = 1.0f / fmaxf(sqrtf(ss), 1e-12f);
          st4bf((bf16_t*)(ws + WS_KKN) + (size_t)t * RW + c, kk * inv); }
        { const f32x4 p = up4(cur[4]), pp = up4(cur[5]) * hp; st4bf((bf16_t*)(ws + WS_ZV) + (size_t)t * RW + c, p + (pp - p) * mu_v); }
        if (tid < 192) { const f32x4 zero = (f32x4){0.f, 0.f, 0.f, 0.f};
            f32x4 z = zero; if (lact) { const f32x4 p = up4(cur[6]), pp = up4(cur[7]) * hp; z = p + (pp - p) * mu_l; }
            if (tid < 32) { f32x4 o;
#pragma unroll
                for (int e = 0; e < 4; ++e) o[e] = 1.0f - 2.0f * __builtin_amdgcn_rcpf(__expf(2.0f * z[e]) + 1.0f);
                st4bf((bf16_t*)(ws + WS_AW) + (size_t)t * LW + lcc, o); }
            else if (tid < 64) st4bf((bf16_t*)(ws + WS_AA) + (size_t)t * LA + lcc, z);
            else { f32x4 o = zero; if (lcc < LG) {
#pragma unroll
                for (int e = 0; e < 4; ++e) o[e] = fsigmoid(z[e]); }
                st4bf((bf16_t*)(ws + WS_AG) + (size_t)t * LGP + lcc, o); }
        }
        if (hasn) {
#pragma unroll
            for (int i = 0; i < 8; ++i) cur[i] = nxt[i]; }
    }
}

__device__ __forceinline__ void ph3_gate(ArgsP A, Frame& F) {
    unsigned char* ws = A->ws; const bf16_t* PROJ = (const bf16_t*)(ws + WS_PROJ); const bf16_t* KMH = (const bf16_t*)(ws + WS_KMEAN); const bf16_t* KML = (const bf16_t*)(ws + WS_KMEAN + 131072); unsigned* MASK = (unsigned*)(ws + WS_MASK);
    const int gw = F.vcu * NWAVES + F.wave, NGW = F.G * NWAVES; const int r = F.lane & 31, hh = F.lane >> 5; const float NEG = -__builtin_inff();
    for (int it = gw; it < (T / 32) * MH; it += NGW) { const int tg = it >> 4, h = it & 15, t = tg * 32 + r, blk = tg >> 3;
        if (blk == 0) { if (hh == 0) MASK[t * MH + h] = 0u; continue; }
        f32x16 acc;
#pragma unroll
        for (int e = 0; e < 16; ++e) acc[e] = 0.f;
#pragma unroll
        for (int ks = 0; ks < 8; ++ks) { const bf16x8 q = *(const bf16x8*)(PROJ + (size_t)t * PLD + PC_MQ + h * MD + 16 * ks + 8 * hh); const size_t ko = (size_t)(h * NBLK + r) * MD + 16 * ks + 8 * hh;
            acc = __builtin_amdgcn_mfma_f32_32x32x16_bf16(*(const bf16x8*)(KMH + ko), q, acc, 0, 0, 0); acc = __builtin_amdgcn_mfma_f32_32x32x16_bf16(*(const bf16x8*)(KML + ko), q, acc, 0, 0, 0); }
        float t0 = NEG, t1 = NEG, t2 = NEG;
#pragma unroll
        for (int e = 0; e < 16; ++e) { const int n = (e & 3) + 8 * (e >> 2) + 4 * hh; float ae = acc[e]; asm volatile("" : "+v"(ae));
            float x = __builtin_bit_cast(float, (__builtin_bit_cast(unsigned, ae) & ~31u) | (unsigned)(31 - n)); x = (n < blk) ? x : NEG;
            t2 = __builtin_amdgcn_fmed3f(t1, t2, x); t1 = __builtin_amdgcn_fmed3f(t0, t1, x); t0 = fmaxf(t0, x); }
        const float o0 = __shfl_xor(t0, 32), o1 = __shfl_xor(t1, 32), o2 = __shfl_xor(t2, 32);
        t2 = __builtin_amdgcn_fmed3f(t1, t2, o0); t1 = __builtin_amdgcn_fmed3f(t0, t1, o0); t0 = fmaxf(t0, o0);
        t2 = __builtin_amdgcn_fmed3f(t1, t2, o1); t1 = __builtin_amdgcn_fmed3f(t0, t1, o1); t0 = fmaxf(t0, o1);
        t2 = __builtin_amdgcn_fmed3f(t1, t2, o2); t1 = __builtin_amdgcn_fmed3f(t0, t1, o2); t0 = fmaxf(t0, o2);
        unsigned sel = 1u << (31 - (__builtin_bit_cast(unsigned, t0) & 31u));
        if (blk > 1) sel |= 1u << (31 - (__builtin_bit_cast(unsigned, t1) & 31u));
        if (blk > 2) sel |= 1u << (31 - (__builtin_bit_cast(unsigned, t2) & 31u));
        if (hh == 0) MASK[t * MH + h] = sel; }
}

constexpr int CK = 64, NCHK = T / CK, CP = 144, CPF = 272;
constexpr int L_AT = 0, L_BT = 9216, L_KT = 18432, L_RT = 27648, L_ATT = 36864, L_BTT = 46080, L_V = 55296, L_MKA = 64512, L_MBRT = 73728, L_MKRT = 82944, L_A2 = 92160, L_MBA = 101376, L_PC = 118784, L_WT = 119040, L_MBH = 121088, L_TD = 130304, L_PT = 134912, L_CEND = 139520;
constexpr int L_TT = L_AT, L_A1 = L_BT, L_Y2T = L_MKA, L_G2T = L_ATT;
static_assert(L_CEND <= RING_BYTES, "chunk prep LDS");
constexpr size_t CHW_ITEM = 32768;
__device__ __forceinline__ f32x16 nt_quad(const LAS unsigned char* X, const LAS unsigned char* Y, int qp, int qq, int r, int hh) {
    f32x16 acc;
#pragma unroll
    for (int e = 0; e < 16; ++e) acc[e] = 0.f;
#pragma unroll
    for (int ks = 0; ks < 4; ++ks) { const bf16x8 a = *(const LAS bf16x8*)(Y + (32 * qq + r) * CP + 32 * ks + 16 * hh), b = *(const LAS bf16x8*)(X + (32 * qp + r) * CP + 32 * ks + 16 * hh);
        acc = __builtin_amdgcn_mfma_f32_32x32x16_bf16(a, b, acc, 0, 0, 0); }
    return acc;
}
__device__ __forceinline__ int nt_q(int qq, int e, int hh) { return 32 * qq + (e & 3) + 8 * (e >> 2) + 4 * hh; }
__device__ __forceinline__ void nt_store_bf16(LAS unsigned char* O, int p, int qq, int hh, const f32x16& v) {
#pragma unroll
    for (int g = 0; g < 4; ++g) { u32x2 w; w.x = pk2(v[4 * g], v[4 * g + 1]); w.y = pk2(v[4 * g + 2], v[4 * g + 3]); *(LAS u32x2*)(O + p * CP + (32 * qq + 8 * g + 4 * hh) * 2) = w; }
}
__device__ __forceinline__ void ph4_chunkprep(ArgsP A, Frame& F) {
    unsigned char* ws = A->ws;
    const float* DEC = (const float*)(ws + WS_DEC); const bf16_t* KKN = (const bf16_t*)(ws + WS_KKN); const bf16_t* BBg = (const bf16_t*)(ws + WS_BB); const bf16_t* KPg = (const bf16_t*)(ws + WS_KP);
    const bf16_t* ZR = (const bf16_t*)(ws + WS_ZR); const bf16_t* ZV = (const bf16_t*)(ws + WS_ZV); float* Yg = (float*)(ws + WS_Y); unsigned char* CHW = ws + WS_WIN;
    LAS unsigned char* L = F.lds + RING_OFF; const int wave = F.wave, lane = F.lane, r = lane & 31, hh = lane >> 5;
    const int prod = wave >> 2, qp = (wave >> 1) & 1, qq = wave & 1, p = 32 * qp + r;
    float nwv[8]; bf16_t nkk[8], nbb[8], nkp[8], nr[8], nv[8];
    if (F.vcu < RH * NCHK) { const int h2 = F.vcu / NCHK, c2 = F.vcu % NCHK;
#pragma unroll
        for (int k = 0; k < 8; ++k) { const size_t o = (size_t)(c2 * CK + 8 * wave + k) * RW + (size_t)h2 * RN + lane; nwv[k] = DEC[o]; nkk[k] = KKN[o]; nbb[k] = BBg[o]; nkp[k] = KPg[o]; nr[k] = ZR[o]; nv[k] = ZV[o]; } }
    int qrow = F.vcu * NWAVES + wave; const int qstride = F.G * NWAVES; f32x4 qv[16];
    for (int item = F.vcu; item < RH * NCHK; item += F.G) { const int h = item / NCHK, c = item % NCHK; const size_t hc = (size_t)h * RN; const int t0 = c * CK;
        const bool qdo = qrow < 2 * 16384; if (qdo) pq_load(A, qrow, lane, qv);
        { float wv[8], kkv[8], bbv[8], kpv[8], rv[8]; bf16_t vv[8];
#pragma unroll
          for (int k = 0; k < 8; ++k) { wv[k] = nwv[k]; kkv[k] = bf1(nkk[k]); bbv[k] = bf1(nbb[k]); kpv[k] = bf1(nkp[k]); rv[k] = bf1(nr[k]); vv[k] = nv[k]; }
          { const int nit = item + F.G; if (nit < RH * NCHK) { const int h2 = nit / NCHK, c2 = nit % NCHK;
#pragma unroll
              for (int k = 0; k < 8; ++k) { const size_t o = (size_t)(c2 * CK + 8 * wave + k) * RW + (size_t)h2 * RN + lane; nwv[k] = DEC[o]; nkk[k] = KKN[o]; nbb[k] = BBg[o]; nkp[k] = KPg[o]; nr[k] = ZR[o]; nv[k] = ZV[o]; } } }
          float pl[8]; pl[0] = wv[0];
#pragma unroll
          for (int k = 1; k < 8; ++k) pl[k] = pl[k - 1] * wv[k];
          ((LAS float*)(L + L_WT))[wave * 64 + lane] = pl[7];
          WG_BAR();
          float pre = 1.f;
#pragma unroll
          for (int w2 = 0; w2 < 7; ++w2) { const float x = ((const LAS float*)(L + L_WT))[w2 * 64 + lane]; pre = (w2 < wave) ? pre * x : pre; }
          unsigned atp[4], btp[4], vtp[4];
#pragma unroll
          for (int k = 0; k < 8; ++k) { const float Pt = pre * pl[k], Pm = (k == 0) ? pre : pre * pl[k - 1], ip = __builtin_amdgcn_rcpf(Pt); const int t = 8 * wave + k;
              const unsigned a16 = f2bf(Pm * kkv[k]), b16 = f2bf(bbv[k] * ip), k16 = f2bf(kpv[k] * ip), r16 = f2bf(Pt * rv[k]);
              *(LAS bf16_t*)(L + L_AT + t * CP + 2 * lane) = (bf16_t)a16; *(LAS bf16_t*)(L + L_BT + t * CP + 2 * lane) = (bf16_t)b16; *(LAS bf16_t*)(L + L_KT + t * CP + 2 * lane) = (bf16_t)k16; *(LAS bf16_t*)(L + L_RT + t * CP + 2 * lane) = (bf16_t)r16;
              if (k & 1) { atp[k >> 1] |= a16 << 16; btp[k >> 1] |= b16 << 16; vtp[k >> 1] |= (unsigned)vv[k] << 16; } else { atp[k >> 1] = a16; btp[k >> 1] = b16; vtp[k >> 1] = (unsigned)vv[k]; }
              if (wave == 7 && k == 7) ((LAS float*)(L + L_PC))[lane] = Pt; }
          *(LAS u32x4*)(L + L_ATT + lane * CP + 16 * wave) = (u32x4){atp[0], atp[1], atp[2], atp[3]}; *(LAS u32x4*)(L + L_BTT + lane * CP + 16 * wave) = (u32x4){btp[0], btp[1], btp[2], btp[3]};
          *(LAS u32x4*)(L + L_V + lane * CP + 16 * wave) = (u32x4){vtp[0], vtp[1], vtp[2], vtp[3]}; }
        WG_BAR();
        { const f32x16 v = nt_quad(L + (prod ? L_KT : L_BT), L + L_AT, qp, qq, r, hh); f32x16 m;
#pragma unroll
          for (int e = 0; e < 16; ++e) m[e] = nt_q(qq, e, hh) > p ? v[e] : 0.f;
          if (prod == 0) {
#pragma unroll
              for (int g = 0; g < 4; ++g) *(LAS f32x4*)(L + L_MBA + p * CPF + (32 * qq + 8 * g + 4 * hh) * 4) = (f32x4){m[4 * g], m[4 * g + 1], m[4 * g + 2], m[4 * g + 3]}; }
          if (prod == 0) nt_store_bf16(L + L_MBH, p, qq, hh, m);
          else nt_store_bf16(L + L_MKA, p, qq, hh, m); }
        { const f32x16 v = nt_quad(L + L_RT, L + (prod ? L_KT : L_BT), qp, qq, r, hh); f32x16 m;
#pragma unroll
          for (int e = 0; e < 16; ++e) m[e] = nt_q(qq, e, hh) <= p ? v[e] : 0.f;
          nt_store_bf16(L + (prod ? L_MKRT : L_MBRT), p, qq, hh, m); }
        WG_BAR();
        { const int t = 8 * wave + (lane >> 3), g = lane & 7, base = 32 * (t >> 5); float T4[4] = {0.f, 0.f, 0.f, 0.f};
          const LAS unsigned char* mrow = L + L_MBA + (base + 4 * g) * 4;
          f32x4 m = *(const LAS f32x4*)(mrow + (base + 31) * CPF);
#pragma unroll 1
          for (int Sx = 7; Sx >= 0; --Sx) {
#pragma unroll
              for (int q = 3; q >= 0; --q) { const int sl = 4 * Sx + q, sr = base + sl, sn = sl > 0 ? sr - 1 : sr; const f32x4 n = *(const LAS f32x4*)(mrow + sn * CPF);
                  float part = (m[0] * T4[0] + m[1] * T4[1]) + (m[2] * T4[2] + m[3] * T4[3]);
                  part += dpp_f<0xB1>(part); part += dpp_f<0x4E>(part); part += dpp_f<0x141>(part);
                  const float val = (sr == t) ? 1.0f : part; T4[q] = (g == Sx) ? val : T4[q]; m = n; } }
          const unsigned w0 = pk2(T4[0], T4[1]), w1 = pk2(T4[2], T4[3]);
          *(LAS u32x2*)(L + L_TT + t * CP + (base + 4 * g) * 2) = (u32x2){w0, w1};
          if (base == 0) { *(LAS u32x2*)(L + L_TT + t * CP + (32 + 4 * g) * 2) = (u32x2){0u, 0u};
              *(LAS bf16_t*)(L + L_TD + (4 * g) * CP + 2 * t) = (bf16_t)(w0 & 0xffffu); *(LAS bf16_t*)(L + L_TD + (4 * g + 1) * CP + 2 * t) = (bf16_t)(w0 >> 16);
              *(LAS bf16_t*)(L + L_TD + (4 * g + 2) * CP + 2 * t) = (bf16_t)(w1 & 0xffffu); *(LAS bf16_t*)(L + L_TD + (4 * g + 3) * CP + 2 * t) = (bf16_t)(w1 >> 16); } }
        WG_BAR();
        if (wave == 0) {
            f32x16 acc;
#pragma unroll
            for (int e = 0; e < 16; ++e) acc[e] = 0.f;
#pragma unroll
            for (int ks = 0; ks < 2; ++ks) { const bf16x8 a = *(const LAS bf16x8*)(L + L_MBH + r * CP + 64 + 32 * ks + 16 * hh), b = *(const LAS bf16x8*)(L + L_TT + (32 + r) * CP + 64 + 32 * ks + 16 * hh);
                acc = __builtin_amdgcn_mfma_f32_32x32x16_bf16(a, b, acc, 0, 0, 0); }
            nt_store_bf16(L + L_PT, r, 0, hh, acc);
            LDS_WAIT(); asm volatile("" ::: "memory");
#pragma unroll
            for (int e = 0; e < 16; ++e) acc[e] = 0.f;
#pragma unroll
            for (int ks = 0; ks < 2; ++ks) { const bf16x8 a = *(const LAS bf16x8*)(L + L_TD + r * CP + 32 * ks + 16 * hh), b = *(const LAS bf16x8*)(L + L_PT + r * CP + 32 * ks + 16 * hh);
                acc = __builtin_amdgcn_mfma_f32_32x32x16_bf16(a, b, acc, 0, 0, 0); }
            nt_store_bf16(L + L_TT, 32 + r, 0, hh, acc);
        }
        WG_BAR();
        { const f32x16 v = nt_quad(L + (prod ? L_MKA : L_ATT), L + L_TT, qp, qq, r, hh);
          nt_store_bf16(L + (prod ? L_A2 : L_A1), p, qq, hh, v); }
        WG_BAR();
        unsigned char* cw = CHW + (size_t)item * CHW_ITEM;
        { const f32x16 v = nt_quad(L + L_MBRT, L + (prod ? L_A2 : L_A1), qp, qq, r, hh); f32x16 o;
          const LAS unsigned char* addm = L + (prod ? L_MKRT : L_RT);
#pragma unroll
          for (int g = 0; g < 4; ++g) { const u32x2 w = *(const LAS u32x2*)(addm + p * CP + (32 * qq + 8 * g + 4 * hh) * 2); o[4 * g] = v[4 * g] + bflo(w.x); o[4 * g + 1] = v[4 * g + 1] + bfhi(w.x); o[4 * g + 2] = v[4 * g + 2] + bflo(w.y); o[4 * g + 3] = v[4 * g + 3] + bfhi(w.y); }
          if (prod) nt_store_bf16(L + L_Y2T, p, qq, hh, o);
          else {
#pragma unroll
              for (int g = 0; g < 4; ++g) { u32x2 w; w.x = pk2(o[4 * g], o[4 * g + 1]); w.y = pk2(o[4 * g + 2], o[4 * g + 3]); *(u32x2*)(cw + (size_t)p * 128 + (32 * qq + 8 * g + 4 * hh) * 2) = w; } } }
        { const f32x16 v = nt_quad(L + L_BTT, L + (prod ? L_A2 : L_A1), qp, qq, r, hh); const float pc = ((const LAS float*)(L + L_PC))[p]; f32x16 o;
          if (prod) {
#pragma unroll
              for (int e = 0; e < 16; ++e) o[e] = (v[e] + bf1(*(const LAS bf16_t*)(L + L_KT + nt_q(qq, e, hh) * CP + 2 * p))) * pc;
              nt_store_bf16(L + L_G2T, p, qq, hh, o); }
          else {
#pragma unroll
              for (int e = 0; e < 16; ++e) o[e] = (v[e] + (nt_q(qq, e, hh) == p ? 1.0f : 0.0f)) * pc;
#pragma unroll
              for (int g = 0; g < 4; ++g) { u32x2 w; w.x = pk2(o[4 * g], o[4 * g + 1]); w.y = pk2(o[4 * g + 2], o[4 * g + 3]); *(u32x2*)(cw + 8192 + (size_t)p * 128 + (32 * qq + 8 * g + 4 * hh) * 2) = w; } } }
        WG_BAR();
        { const f32x16 v = prod ? nt_quad(L + L_V, L + L_G2T, qp, qq, r, hh) : nt_quad(L + L_Y2T, L + L_V, qp, qq, r, hh);
          float* dst = prod ? (float*)(cw + 16384) + (size_t)p * 64 : Yg + (size_t)(t0 + p) * RW + hc;
#pragma unroll
          for (int g = 0; g < 4; ++g) *(f32x4*)(dst + 32 * qq + 8 * g + 4 * hh) = (f32x4){v[4 * g], v[4 * g + 1], v[4 * g + 2], v[4 * g + 3]}; }
        if (qdo) { pq_finish(ws, qrow, lane, qv); qrow += qstride; }
        WG_BAR();
    }
    for (; qrow < 2 * 16384; qrow += qstride) { pq_load(A, qrow, lane, qv); pq_finish(ws, qrow, lane, qv); }
}
__device__ __forceinline__ void ph5_chain(ArgsP A, Frame& F, int h) {
    unsigned char* ws = A->ws; float* Yg = (float*)(ws + WS_Y); const unsigned char* CHW = ws + WS_WIN;
    LAS unsigned char* L = F.lds + RING_OFF; const int wave = F.wave, lane = F.lane, tid = F.tid, r = lane & 31, hh = lane >> 5;
    const int prod = wave >> 2, qp = (wave >> 1) & 1, qq = wave & 1, p = 32 * qp + r; const size_t hc = (size_t)h * RN;
    constexpr int L_S = 0, L_G = 2 * 9216, L_Y1 = 3 * 9216;
    for (int i = tid; i < 2 * 9216 / 4; i += NTHR) ((LAS unsigned*)(L + L_S))[i] = 0u;
    const int srow = tid >> 3, sc16 = tid & 7; u32x4 sg, sy;
    auto stage_ld = [&](int c) { const unsigned char* cw = CHW + (size_t)(h * NCHK + c) * CHW_ITEM; sy = *(const u32x4*)(cw + srow * 128 + sc16 * 16); sg = *(const u32x4*)(cw + 8192 + srow * 128 + sc16 * 16); };
    f32x4 nad[4];
    auto ad_ld = [&](int c) { const unsigned char* cw2 = CHW + (size_t)(h * NCHK + c) * CHW_ITEM; const float* addp = prod ? Yg + (size_t)(c * CK + p) * RW + hc : (const float*)(cw2 + 16384) + (size_t)p * 64;
#pragma unroll
        for (int g = 0; g < 4; ++g) nad[g] = *(const f32x4*)(addp + 32 * qq + 8 * g + 4 * hh); };
    stage_ld(0); ad_ld(0);
    int sb = 0;
    for (int c = 0; c < NCHK; ++c) {
        *(LAS u32x4*)(L + L_Y1 + srow * CP + sc16 * 16) = sy; *(LAS u32x4*)(L + L_G + srow * CP + sc16 * 16) = sg;
        const unsigned char* cw = CHW + (size_t)(h * NCHK + c) * CHW_ITEM;
        f32x4 ad[4];
#pragma unroll
        for (int g = 0; g < 4; ++g) ad[g] = nad[g];
        if (c + 1 < NCHK) { stage_ld(c + 1); ad_ld(c + 1); }
        WG_BAR();
        const f32x16 v = prod ? nt_quad(L + L_Y1, L + L_S + sb * 9216, qp, qq, r, hh) : nt_quad(L + L_S + sb * 9216, L + L_G, qp, qq, r, hh);
        f32x16 o;
#pragma unroll
        for (int g = 0; g < 4; ++g) { o[4 * g] = v[4 * g] + ad[g][0]; o[4 * g + 1] = v[4 * g + 1] + ad[g][1]; o[4 * g + 2] = v[4 * g + 2] + ad[g][2]; o[4 * g + 3] = v[4 * g + 3] + ad[g][3]; }
        if (prod) { float* yp = Yg + (size_t)(c * CK + p) * RW + hc;
#pragma unroll
            for (int g = 0; g < 4; ++g) *(f32x4*)(yp + 32 * qq + 8 * g + 4 * hh) = (f32x4){o[4 * g], o[4 * g + 1], o[4 * g + 2], o[4 * g + 3]}; }
        else nt_store_bf16(L + L_S + (sb ^ 1) * 9216, p, qq, hh, o);
        sb ^= 1;
        WG_BAR();
    }
}

__device__ __forceinline__ void ph5_ypost(ArgsP A, Frame& F) {
    unsigned char* ws = A->ws; const float* Y = (const float*)(ws + WS_Y); const bf16_t* ZR = (const bf16_t*)(ws + WS_ZR); const bf16_t* KP = (const bf16_t*)(ws + WS_KP); const bf16_t* ZV = (const bf16_t*)(ws + WS_ZV);
    const bf16_t* G = (const bf16_t*)(ws + WS_G); bf16_t* YA = (bf16_t*)(ws + WS_YA);
    const int gw = F.vcu * NWAVES + F.wave, NGW = F.G * NWAVES;
    for (int tg = F.vcu; tg < T / 32; tg += F.G) for (int it = F.wave; it < 256; it += NWAVES) { const int t = tg * 32 + (it >> 3), c = (it & 7) * 256 + 4 * F.lane; const size_t o = (size_t)t * RW + c;
        const f32x4 y = *(const f32x4*)(Y + o); const float mean = sum16((y[0] + y[1]) + (y[2] + y[3])) * (1.0f / 64.0f); const f32x4 d = y - mean;
        const float var = sum16((d[0] * d[0] + d[1] * d[1]) + (d[2] * d[2] + d[3] * d[3])) * (1.0f / 64.0f); const float rs = 1.0f / sqrtf(var + LNX_EPS);
        const f32x4 r = ld4bf(ZR + o), k = ld4bf(KP + o), v = ld4bf(ZV + o), g = ld4bf(G + o), rk = *(const f32x4*)(A->r_k + c), lg = *(const f32x4*)(A->lnx_g + c), lb = *(const f32x4*)(A->lnx_b + c);
        const f32x4 rkk = r * k * rk; const float bonus = sum16((rkk[0] + rkk[1]) + (rkk[2] + rkk[3]));
        st4bf(YA + o, (d * rs * lg + lb + bonus * v) * g); }
}

constexpr int AT_KB = 64 * 256, AT_VB = 128 * 128, AT_BUF = AT_KB + AT_VB;
static_assert(3 * AT_BUF <= RING_BYTES, "attention LDS");
__device__ __forceinline__ void ph5_attn(ArgsP A, Frame& F) {
    unsigned char* ws = A->ws; const bf16_t* PROJ = (const bf16_t*)(ws + WS_PROJ); const bf16_t* VT = (const bf16_t*)(ws + WS_VT); const unsigned* MASK = (const unsigned*)(ws + WS_MASK); bf16_t* YB = (bf16_t*)(ws + WS_YB);
    LAS unsigned char* L = F.lds + RING_OFF; const int tid = F.tid, wave = F.wave, lane = F.lane, r = lane & 31, hh = lane >> 5;
    const float NEG = -__builtin_inff();
    gu32* qctr = (gu32*)(ws + WS_CTL) + CW_ATTNQ; LAS int* qslot = (LAS int*)(F.lds + LDSCTL_OFF);
    for (;;) { {
        if (tid == 0) qslot[0] = (int)__hip_atomic_fetch_add(qctr, 1u, __ATOMIC_RELAXED, __HIP_MEMORY_SCOPE_AGENT);
        WG_BAR(); const int u = __builtin_amdgcn_readfirstlane(qslot[0]); WG_BAR();
        if (u >= MH * NBLK) break;
        const int h = u & 15, ib = 31 - (u >> 4);
        const int q0 = ib * MBLK + wave * 32;
        bf16x8 qf[8];
#pragma unroll
        for (int ks = 0; ks < 8; ++ks) qf[ks] = *(const bf16x8*)(PROJ + (size_t)(q0 + r) * PLD + PC_MQ + h * MD + 16 * ks + 8 * hh);
        const unsigned msk = MASK[(q0 + r) * MH + h];
        f32x16 o[4];
#pragma unroll
        for (int db = 0; db < 4; ++db)
#pragma unroll
            for (int e = 0; e < 16; ++e) o[db][e] = 0.f;
        float mrun = NEG, lrun = 0.f;
        const int ntile = 4 + 4 * ib;
        auto tile_tok = [&](int n) { return n < 4 ? ib * MBLK + n * 64 : ((n - 4) >> 2) * MBLK + ((n - 4) & 3) * 64; };
        const int krow_ = lane >> 4, kslot = lane & 15, vrow_ = lane >> 3, vslot = lane & 7;
        auto dma_tile = [&](int n, int b3) { const int tb = tile_tok(n); LAS unsigned char* B = L + b3 * AT_BUF;
#pragma unroll
            for (int i = 0; i < 2; ++i) { const int p = wave * 2 + i, row = 4 * p + krow_, c = kslot ^ (row & 15);
                __builtin_amdgcn_global_load_lds((const unsigned*)(PROJ + (size_t)(tb + row) * PLD + PC_MK + h * MD + 8 * c), (LAS unsigned*)(B + p * 1024), 16, 0, 0); }
#pragma unroll
            for (int i = 0; i < 2; ++i) { const int p = wave * 2 + i, row = 8 * p + vrow_, c = vslot ^ (row & 7);
                __builtin_amdgcn_global_load_lds((const unsigned*)(VT + (size_t)(h * MD + row) * T + tb + 8 * c), (LAS unsigned*)(B + AT_KB + p * 1024), 16, 0, 0); } };
        dma_tile(0, 0); dma_tile(1, 1);
        asm volatile("s_waitcnt vmcnt(4)" ::: "memory"); WG_BAR();
        int b3 = 0;
        for (int n = 0; n < ntile; ++n) {
            { const int bn = b3 >= 1 ? b3 - 1 : 2; if (n + 2 < ntile) dma_tile(n + 2, bn); }
            bool need; int jblk = -1, tt = 0;
            if (n < 4) { tt = n; need = tt <= (wave >> 1); } else { jblk = (n - 4) >> 2; need = __ballot((msk >> jblk) & 1u) != 0ull; }
            if (need) {
                const LAS unsigned char* KB = L + b3 * AT_BUF; const LAS unsigned char* VB = KB + AT_KB;
                f32x16 s[2];
#pragma unroll
                for (int kb = 0; kb < 2; ++kb) {
#pragma unroll
                    for (int e = 0; e < 16; ++e) s[kb][e] = 0.f;
#pragma unroll
                    for (int ks = 0; ks < 8; ++ks) { const bf16x8 a = *(const LAS bf16x8*)(KB + (32 * kb + r) * 256 + (((2 * ks + hh) ^ (r & 15)) << 4)); s[kb] = __builtin_amdgcn_mfma_f32_32x32x16_bf16(a, qf[ks], s[kb], 0, 0, 0); } }
                if (n < 4) { if (64 * tt + 63 > wave * 32) { const int qrel = wave * 32 + r;
#pragma unroll
                    for (int kb = 0; kb < 2; ++kb)
#pragma unroll
                        for (int e = 0; e < 16; ++e) { const int krel = 64 * tt + 32 * kb + (e & 3) + 8 * (e >> 2) + 4 * hh; if (krel > qrel) s[kb][e] = NEG; } } }
                else if (!((msk >> jblk) & 1u)) {
#pragma unroll
                    for (int kb = 0; kb < 2; ++kb)
#pragma unroll
                        for (int e = 0; e < 16; ++e) s[kb][e] = NEG; }
                float mx = s[0][0];
#pragma unroll
                for (int kb = 0; kb < 2; ++kb)
#pragma unroll
                    for (int e = 0; e < 16; ++e) mx = fmaxf(mx, s[kb][e]);
                mx = fmaxf(mx, __shfl_xor(mx, 32));
                const float mnew = fmaxf(mrun, mx); const float alpha = __builtin_amdgcn_exp2f(mrun - mnew); mrun = mnew;
                float ps = 0.f;
#pragma unroll
                for (int kb = 0; kb < 2; ++kb)
#pragma unroll
                    for (int e = 0; e < 16; ++e) { const float p = __builtin_amdgcn_exp2f(s[kb][e] - mnew); s[kb][e] = p; ps += p; }
                lrun = lrun * alpha + ps;
                if (__ballot(alpha != 1.0f) != 0ull) {
#pragma unroll
                    for (int db = 0; db < 4; ++db)
#pragma unroll
                        for (int e = 0; e < 16; ++e) o[db][e] *= alpha; }
#pragma unroll
                for (int kb = 0; kb < 2; ++kb)
#pragma unroll
                    for (int st = 0; st < 2; ++st) { u32x4 pw; pw.x = pk2(s[kb][8 * st + 0], s[kb][8 * st + 1]); pw.y = pk2(s[kb][8 * st + 2], s[kb][8 * st + 3]); pw.z = pk2(s[kb][8 * st + 4], s[kb][8 * st + 5]); pw.w = pk2(s[kb][8 * st + 6], s[kb][8 * st + 7]);
                        const bf16x8 pf = __builtin_bit_cast(bf16x8, pw); const int kbase = 32 * kb + 16 * st + 4 * hh;
#pragma unroll
                        for (int db = 0; db < 4; ++db) { const LAS unsigned char* vrow = VB + (32 * db + r) * 128 + 8 * hh; const int c0 = 4 * kb + 2 * st; const u32x2 lo = *(const LAS u32x2*)(vrow + ((c0 ^ (r & 7)) << 4)), hi = *(const LAS u32x2*)(vrow + (((c0 + 1) ^ (r & 7)) << 4));
                            const bf16x8 vf = __builtin_bit_cast(bf16x8, (u32x4){lo.x, lo.y, hi.x, hi.y}); o[db] = __builtin_amdgcn_mfma_f32_32x32x16_bf16(vf, pf, o[db], 0, 0, 0); } }
            }
            if (n + 2 < ntile) asm volatile("s_waitcnt vmcnt(4)" ::: "memory"); else asm volatile("s_waitcnt vmcnt(0)" ::: "memory");
            b3 = b3 == 2 ? 0 : b3 + 1;
            WG_BAR();
        }
        const float ltot = lrun + __shfl_xor(lrun, 32); const float inv = 1.0f / ltot;
        bf16_t* op = YB + (size_t)(q0 + r) * RW + h * MD;
#pragma unroll
        for (int db = 0; db < 4; ++db)
#pragma unroll
            for (int g = 0; g < 4; ++g) { u32x2 w; w.x = pk2(o[db][4 * g] * inv, o[db][4 * g + 1] * inv); w.y = pk2(o[db][4 * g + 2] * inv, o[db][4 * g + 3] * inv); *(u32x2*)(op + 32 * db + 8 * g + 4 * hh) = w; }
      }
    }
}

__device__ __forceinline__ void ins16(float (&top)[16], float x) {
#pragma unroll
    for (int k = 15; k >= 1; --k) top[k] = __builtin_amdgcn_fmed3f(top[k - 1], top[k], x);
    top[0] = fmaxf(top[0], x);
}
__device__ __forceinline__ void ph10_select(ArgsP A, Frame& F) {
    unsigned char* ws = A->ws; const bf16_t* PQ = (const bf16_t*)(ws + WS_PQ); const bf16_t* SK = (const bf16_t*)(ws + WS_SUBK); int* IDX = (int*)(ws + WS_IDX); float* GW = (float*)(ws + WS_GW);
    const int gw = F.vcu * NWAVES + F.wave, NGW = F.G * NWAVES; const int r = F.lane & 31, hh = F.lane >> 5; const float NEG = -__builtin_inff();
    for (int it = gw; it < (T / 32) * PH_; it += NGW) { const int tg = it >> 3, h = it & 7, t = tg * 32 + r;
        float TA[16], TB[16];
        auto topk = [&](int p, float (&dst)[16]) {
            bf16x8 qf[8];
#pragma unroll
            for (int ks = 0; ks < 8; ++ks) qf[ks] = *(const bf16x8*)(PQ + (size_t)t * 2048 + (h * 2 + p) * PHALF + 16 * ks + 8 * hh);
            float top[16];
#pragma unroll
            for (int k = 0; k < 16; ++k) top[k] = NEG;
#pragma unroll 1
            for (int nb = 0; nb < 4; ++nb) { f32x16 acc;
#pragma unroll
                for (int e = 0; e < 16; ++e) acc[e] = 0.f;
#pragma unroll
                for (int ks = 0; ks < 8; ++ks) { const bf16x8 a = *(const bf16x8*)(SK + ((size_t)(h * 2 + p) * PNK + 32 * nb + r) * PHALF + 16 * ks + 8 * hh); acc = __builtin_amdgcn_mfma_f32_32x32x16_bf16(a, qf[ks], acc, 0, 0, 0); }
#pragma unroll
                for (int e = 0; e < 16; ++e) { const unsigned key = 32 * nb + (e & 3) + 8 * (e >> 2) + 4 * hh; float ae = acc[e]; asm volatile("" : "+v"(ae));
                    const float x = __builtin_bit_cast(float, (__builtin_bit_cast(unsigned, ae) & ~0x7Fu) | key); ins16(top, x); } }
            float oth[16];
#pragma unroll
            for (int k = 0; k < 16; ++k) oth[k] = __shfl_xor(top[k], 32);
#pragma unroll
            for (int k = 0; k < 16; ++k) ins16(top, oth[k]);
#pragma unroll
            for (int k = 0; k < 16; ++k) dst[k] = top[k];
        };
        topk(0, TA); asm volatile("" ::: "memory"); __builtin_amdgcn_sched_barrier(0); topk(1, TB); asm volatile("" ::: "memory"); __builtin_amdgcn_sched_barrier(0);
        float fin[16];
#pragma unroll
        for (int k = 0; k < 16; ++k) fin[k] = NEG;
#pragma unroll
        for (int i = 0; i < 16; ++i)
#pragma unroll
            for (int j = 0; j < 16; ++j) if ((i + 1) * (j + 1) <= 16) { const float sm = TA[i] + TB[j]; ins16(fin, __builtin_bit_cast(float, (__builtin_bit_cast(unsigned, sm) & ~0xFFu) | (unsigned)(i * 16 + j))); }
        float e[16], den = 0.f;
#pragma unroll
        for (int k = 0; k < 16; ++k) { e[k] = __expf(fin[k] - fin[0]); den += e[k]; }
        const float rden = 1.0f / den;
        int oi[8]; float og[8];
#pragma unroll
        for (int kk = 0; kk < 8; ++kk) { const float fv = hh ? fin[8 + kk] : fin[kk]; og[kk] = (hh ? e[8 + kk] : e[kk]) * rden; const unsigned id = __builtin_bit_cast(unsigned, fv) & 0xFFu; const unsigned ci = id >> 4, cj = id & 15u;
            unsigned ia = 0u, ib = 0u;
#pragma unroll
            for (int q = 0; q < 16; ++q) { ia = (ci == (unsigned)q) ? (__builtin_bit_cast(unsigned, TA[q]) & 0x7Fu) : ia; ib = (cj == (unsigned)q) ? (__builtin_bit_cast(unsigned, TB[q]) & 0x7Fu) : ib; }
            oi[kk] = (int)(ia * PNK + ib); }
        int* ip = IDX + (size_t)t * 128 + h * 16 + 8 * hh; float* gp = GW + (size_t)t * 128 + h * 16 + 8 * hh;
        *(u32x4*)ip = (u32x4){(unsigned)oi[0], (unsigned)oi[1], (unsigned)oi[2], (unsigned)oi[3]}; *(u32x4*)(ip + 4) = (u32x4){(unsigned)oi[4], (unsigned)oi[5], (unsigned)oi[6], (unsigned)oi[7]};
        *(f32x4*)gp = (f32x4){og[0], og[1], og[2], og[3]}; *(f32x4*)(gp + 4) = (f32x4){og[4], og[5], og[6], og[7]};
    }
}


__device__ __forceinline__ float ub0(unsigned w) { return (float)(w & 0xffu); }
__device__ __forceinline__ float ub1(unsigned w) { return (float)((w >> 8) & 0xffu); }
__device__ __forceinline__ float ub2(unsigned w) { return (float)((w >> 16) & 0xffu); }
__device__ __forceinline__ float ub3(unsigned w) { return (float)(w >> 24); }
__device__ __forceinline__ float dot16q(u32x4 q, const float (&h)[16]) {
    return ((ub0(q.x) * h[0] + ub1(q.x) * h[1]) + (ub2(q.x) * h[2] + ub3(q.x) * h[3])) + ((ub0(q.y) * h[4] + ub1(q.y) * h[5]) + (ub2(q.y) * h[6] + ub3(q.y) * h[7]))
         + ((ub0(q.z) * h[8] + ub1(q.z) * h[9]) + (ub2(q.z) * h[10] + ub3(q.z) * h[11])) + ((ub0(q.w) * h[12] + ub1(q.w) * h[13]) + (ub2(q.w) * h[14] + ub3(q.w) * h[15]));
}
__device__ __forceinline__ void ph11_gather(ArgsP A, Frame& F) {
    unsigned char* ws = A->ws; const bf16_t* H2 = (const bf16_t*)(ws + WS_H2); const unsigned char* PU = (const unsigned char*)(ws + WS_PU); const unsigned char* PV = (const unsigned char*)(ws + WS_PV);
    const float* PSU = (const float*)(ws + WS_PSU); const float* PSV = (const float*)(ws + WS_PSV);
    const int* IDX = (const int*)(ws + WS_IDX); const float* GW = (const float*)(ws + WS_GW); const float* X1 = (const float*)(ws + WS_X1);
    LAS float* coef = (LAS float*)(F.lds + RING_OFF); LAS int* eidx = (LAS int*)(F.lds + RING_OFF + 1024); LAS float* red = (LAS float*)(F.lds + RING_OFF + 2048);
    const int tid = F.tid, wave = F.wave, lane = F.lane; int par = 0;
    for (int t = F.vcu; t < T; t += F.G, par ^= 1) {
        float hv[4][16]; float hs = 0.f;
#pragma unroll
        for (int i = 0; i < 4; ++i) { const bf16_t* hp = H2 + (size_t)t * D + i * 1024 + lane * 16; f32x4 a, b, c, d; pg8::unpack8(*(const u32x4*)hp, a, b); pg8::unpack8(*(const u32x4*)(hp + 8), c, d);
#pragma unroll
            for (int e = 0; e < 4; ++e) { hv[i][e] = a[e]; hv[i][4 + e] = b[e]; hv[i][8 + e] = c[e]; hv[i][12 + e] = d[e]; }
            hs += ((a[0] + a[1]) + (a[2] + a[3])) + ((b[0] + b[1]) + (b[2] + b[3])) + ((c[0] + c[1]) + (c[2] + c[3])) + ((d[0] + d[1]) + (d[2] + d[3])); }
        hs = wave_sum(hs);
        const int myidx = (lane < 16) ? IDX[(size_t)t * 128 + wave * 16 + lane] : 0; const float myg = (lane < 16) ? GW[(size_t)t * 128 + wave * 16 + lane] : 0.f;
        float dots = 0.f;
#pragma unroll 1
        for (int k = 0; k < 16; k += 4) {
            u32x4 q[4][4];
#pragma unroll
            for (int x = 0; x < 4; ++x) { const int e = __builtin_amdgcn_readlane(myidx, k + x); const unsigned char* up = PU + (size_t)e * D + lane * 16;
#pragma unroll
                for (int i = 0; i < 4; ++i) q[x][i] = *(const u32x4*)(up + i * 1024); }
#pragma unroll
            for (int x = 0; x < 4; ++x) { float d = 0.f;
#pragma unroll
                for (int i = 0; i < 4; ++i) d += dot16q(q[x][i], hv[i]);
                d = wave_sum(d); if (lane == k + x) dots = d; }
        }
        if (lane < 16) { const float s = PSU[myidx] * (dots - 128.0f * hs); const float act = 0.5f * s * (1.0f + erff(s * 0.70710678118654752f));
            coef[par * 128 + wave * 16 + lane] = myg * act * PSV[myidx]; eidx[par * 128 + wave * 16 + lane] = myidx; }
        WG_BAR();
        float acc[8]; float csum = 0.f;
#pragma unroll
        for (int i = 0; i < 8; ++i) acc[i] = 0.f;
#pragma unroll 1
        for (int e = 0; e < 128; e += 16) { u32x2 v[16]; float c[16];
#pragma unroll
            for (int q = 0; q < 16; ++q) { const int ei = __builtin_amdgcn_readfirstlane(eidx[par * 128 + e + q]); c[q] = coef[par * 128 + e + q]; v[q] = *(const u32x2*)(PV + (size_t)ei * D + tid * 8); }
#pragma unroll
            for (int q = 0; q < 16; ++q) { csum += c[q]; acc[0] += c[q] * ub0(v[q].x); acc[1] += c[q] * ub1(v[q].x); acc[2] += c[q] * ub2(v[q].x); acc[3] += c[q] * ub3(v[q].x); acc[4] += c[q] * ub0(v[q].y); acc[5] += c[q] * ub1(v[q].y); acc[6] += c[q] * ub2(v[q].y); acc[7] += c[q] * ub3(v[q].y); } }
        const float corr = -128.0f * csum;
        const f32x4 x0 = *(const f32x4*)(X1 + (size_t)t * D + tid * 8), x1 = *(const f32x4*)(X1 + (size_t)t * D + tid * 8 + 4);
        f32x4 y0 = x0 + ((f32x4){acc[0], acc[1], acc[2], acc[3]} + corr), y1 = x1 + ((f32x4){acc[4], acc[5], acc[6], acc[7]} + corr);
        float ss = (y0[0] * y0[0] + y0[1] * y0[1]) + (y0[2] * y0[2] + y0[3] * y0[3]) + (y1[0] * y1[0] + y1[1] * y1[1]) + (y1[2] * y1[2] + y1[3] * y1[3]);
        ss = wave_sum(ss); if (lane == 0) red[par * 8 + wave] = ss;
        WG_BAR();
        float tot = 0.f;
#pragma unroll
        for (int w = 0; w < 8; ++w) tot += red[par * 8 + w];
        const float rs = 1.0f / sqrtf(tot * (1.0f / D) + NORM_EPS);
        const f32x4 g0 = *(const f32x4*)(A->final_g + tid * 8), g1 = *(const f32x4*)(A->final_g + tid * 8 + 4);
        *(f32x4*)(A->out + (size_t)t * D + tid * 8) = y0 * rs * g0; *(f32x4*)(A->out + (size_t)t * D + tid * 8 + 4) = y1 * rs * g1;
    }
}

constexpr int NPH = 13;
__device__ __forceinline__ Frame make_frame(unsigned char* lds) {
    Frame F; int t = threadIdx.x; asm volatile("" : "+v"(t));
    F.lds = (LAS unsigned char*)lds; F.tid = t; F.lane = t & 63; F.wave = __builtin_amdgcn_readfirstlane(t >> 6);
    F.G = gridDim.x; { const int bx = blockIdx.x; F.vcu = (F.G % 8 == 0) ? (bx % 8) * (F.G / 8) + bx / 8 : bx; }
    return F;
}
__global__ void __launch_bounds__(NTHR, 2) mk_fwd(Args args_by_value) {
    extern __shared__ __attribute__((aligned(16))) unsigned char lds[];
    ArgsP args = get_args();
    gu32* ctl = (gu32*)(args->ws + WS_CTL);
    for (int u = threadIdx.x; u < (LDS_BYTES - LDSCTL_OFF) / 4; u += NTHR) ((LAS unsigned*)((LAS unsigned char*)lds + LDSCTL_OFF))[u] = 0u;
    __syncthreads();
    const int lo = args->ph_lo, hi = args->ph_hi;
    volatile LAS unsigned* MISC = (volatile LAS unsigned*)((LAS unsigned char*)lds + MISC_OFF);
    XcdBarrier bar; bar.bar = (unsigned*)(ctl + CW_BAR) + args->li * XCD_BAR_WORDS; bar.x = 0; bar.st = nullptr;
    if (hi - lo > 1) bar = xcd_barrier_post((unsigned*)(ctl + CW_BAR) + args->li * XCD_BAR_WORDS, MISC + 8);
#define IN(k) (lo <= (k) && (k) < hi)
#define SEAM(k) do { if (IN(k) && IN((k) + 1)) xcd_barrier(bar); } while (0)
    const int bid = (int)blockIdx.x;

    if (IN(0)) { Frame F = make_frame(lds); ph0_prologue(get_args(), F); SEAM(0); }
    if (IN(1)) { Frame F = make_frame(lds); LAS unsigned char* ring = F.lds + RING_OFF; ArgsP a_ = get_args(); unsigned char* ws = a_->ws;
        { pg8::Gemm g{(const bf16_t*)(ws + WS_XN), (const bf16_t*)(ws + WS_WIN), T, PLD, D}; pg8::StaticOrder S; S.init(T, PLD, F.G, bid);
          pg8::EpiProj E{(bf16_t*)(ws + WS_PROJ), (const float*)(ws + WS_ROPE)}; pg8::gemm_phase<pg8::EpiProj, pg8::StaticOrder, true, true>(ring, g, S, E); }
        { pg8::Gemm g{(const bf16_t*)(ws + WS_XN), (const bf16_t*)(ws + WS_WIN) + (size_t)PC_MV * D, T, 2048, D}; pg8::StaticOrder S; S.init(T, 2048, F.G, bid);
          pg8::EpiVT E{(bf16_t*)(ws + WS_VT)}; pg8::gemm_phase<pg8::EpiVT, pg8::StaticOrder, true, true>(ring, g, S, E); }
        SEAM(1); }
    if (IN(2)) { Frame F = make_frame(lds); ph2_prep(get_args(), F); SEAM(2); }
    if (IN(3)) { Frame F = make_frame(lds); LAS unsigned char* ring = F.lds + RING_OFF; ArgsP a_ = get_args(); unsigned char* ws = a_->ws;
        { pg8::Gemm g{(const bf16_t*)(ws + WS_AW), (const bf16_t*)(ws + WS_WUP), T, RW, LW}; pg8::StaticOrder S; S.init(T, RW, F.G, bid);
          pg8::EpiDec E{(float*)(ws + WS_DEC), a_->w0}; pg8::gemm_phase<pg8::EpiDec, pg8::StaticOrder, true, true>(ring, g, S, E); }
        asm volatile("" ::: "memory"); __builtin_amdgcn_sched_barrier(0);
        { pg8::Gemm g{(const bf16_t*)(ws + WS_AA), (const bf16_t*)(ws + WS_AUP), T, RW, LA}; pg8::StaticOrder S; S.init(T, RW, F.G, bid);
          pg8::EpiA E{(bf16_t*)(ws + WS_KP), (bf16_t*)(ws + WS_BB), (const bf16_t*)(ws + WS_KKN), a_->a0, a_->k_a}; pg8::gemm_phase<pg8::EpiA, pg8::StaticOrder, true, true>(ring, g, S, E); }
        asm volatile("" ::: "memory"); __builtin_amdgcn_sched_barrier(0);
        { pg8::Gemm g{(const bf16_t*)(ws + WS_AG), (const bf16_t*)(ws + WS_GUP), T, RW, LGP}; pg8::StaticOrder S; S.init(T, RW, F.G, bid);
          pg8::EpiBf16 E{(bf16_t*)(ws + WS_G), RW}; pg8::gemm_phase<pg8::EpiBf16, pg8::StaticOrder, true, true>(ring, g, S, E); }
        { Frame F2 = make_frame(lds); ph3_gate(get_args(), F2); }
        SEAM(3); }
    if (IN(4)) { Frame F = make_frame(lds); ph4_chunkprep(get_args(), F); SEAM(4); }
    if (IN(5)) {
        { Frame F = make_frame(lds); if (F.vcu < RH) ph5_chain(get_args(), F, F.vcu); }
        { Frame F = make_frame(lds); ph5_attn(get_args(), F); }
        { Frame F = make_frame(lds); const int gw = F.vcu * NWAVES + F.wave, NGW = F.G * NWAVES; ArgsP a2 = get_args();
          late_weights(a2, F, gw, NGW); }
        SEAM(5); }
    if (IN(6)) { Frame F = make_frame(lds); ph5_ypost(get_args(), F); SEAM(6); }
    if (IN(7)) { Frame F = make_frame(lds); LAS unsigned char* ring = F.lds + RING_OFF; ArgsP a_ = get_args(); unsigned char* ws = a_->ws;
        { pg8::Gemm g{(const bf16_t*)(ws + WS_YA), (const bf16_t*)(ws + WS_WA), T, D, RW}; pg8::StaticOrder S; S.init(T, D, F.G, bid);
          pg8::EpiMix<false> E{(bf16_t*)(ws + WS_MIXED), (const bf16_t*)(ws + WS_PROJ), PC_GA}; pg8::gemm_phase<pg8::EpiMix<false>, pg8::StaticOrder, true, true>(ring, g, S, E); }
        { pg8::Gemm g{(const bf16_t*)(ws + WS_YB), (const bf16_t*)(ws + WS_WB), T, D, RW}; pg8::StaticOrder S; S.init(T, D, F.G, bid);
          pg8::EpiMix<true> E{(bf16_t*)(ws + WS_MIXED), (const bf16_t*)(ws + WS_PROJ), PC_GB}; pg8::gemm_phase<pg8::EpiMix<true>, pg8::StaticOrder, true, true>(ring, g, S, E); }
        SEAM(7); }
    if (IN(8)) { Frame F = make_frame(lds); LAS unsigned char* ring = F.lds + RING_OFF; ArgsP a_ = get_args(); unsigned char* ws = a_->ws;
        pg8::Gemm g{(const bf16_t*)(ws + WS_MIXED), (const bf16_t*)(ws + WS_WOUT), T, D, D}; pg8::StaticOrder S; S.init(T, D, F.G, bid);
        pg8::EpiRes E{(float*)(ws + WS_X1), a_->x}; pg8::gemm_phase<pg8::EpiRes, pg8::StaticOrder, true, true>(ring, g, S, E);
        SEAM(8); }
    if (IN(9)) { Frame F = make_frame(lds); ArgsP a_ = get_args(); unsigned char* ws = a_->ws; const int gw = F.vcu * NWAVES + F.wave, NGW = F.G * NWAVES;
        rms_rows_to_bf16((const float*)(ws + WS_X1), a_->norm2_g, (bf16_t*)(ws + WS_H2), gw, NGW, F.lane);
        SEAM(9); }
    if (IN(10)) { Frame F = make_frame(lds); LAS unsigned char* ring = F.lds + RING_OFF; ArgsP a_ = get_args(); unsigned char* ws = a_->ws;
        pg8::Gemm g{(const bf16_t*)(ws + WS_H2), (const bf16_t*)(ws + WS_WQ), T, 2048, D}; pg8::StaticOrder S; S.init(T, 2048, F.G, bid);
        pg8::EpiBf16 E{(bf16_t*)(ws + WS_PQ), 2048}; pg8::gemm_phase<pg8::EpiBf16, pg8::StaticOrder, true, true>(ring, g, S, E);
        SEAM(10); }
    if (IN(11)) { Frame F = make_frame(lds); ph10_select(get_args(), F); SEAM(11); }
    if (IN(12)) { Frame F = make_frame(lds); ph11_gather(get_args(), F); }
#undef IN
#undef SEAM
}

extern "C" void kernel_launch(void* const* d_in, const int* in_sizes, int n_in, void* d_out, int out_size, void* d_ws, size_t ws_size, hipStream_t stream) {
    static int grid = 0;
    if (grid == 0) {
        if (n_in != 23 || out_size != T * D || ws_size < WS_END) { fprintf(stderr, "kernel_launch: unexpected shapes (n_in %d out %d ws %zu); nothing launched\n", n_in, out_size, ws_size); grid = -1; return; }
        int dev = 0, cus = 0, per_cu = 0;
        if (hipGetDevice(&dev) != hipSuccess || hipDeviceGetAttribute(&cus, hipDeviceAttributeMultiprocessorCount, dev) != hipSuccess) { grid = -1; return; }
        if (hipFuncSetAttribute((const void*)mk_fwd, hipFuncAttributeMaxDynamicSharedMemorySize, LDS_BYTES) != hipSuccess) { grid = -1; return; }
        if (hipOccupancyMaxActiveBlocksPerMultiprocessor(&per_cu, (const void*)mk_fwd, NTHR, LDS_BYTES) != hipSuccess || per_cu < 1) fprintf(stderr, "kernel_launch: occupancy query reports %d\n", per_cu);
        (void)hipGetLastError();
        grid = cus;
    }
    if (grid < 0) return;
    (void)hipMemsetAsync((char*)d_ws + WS_CTL, 0, CTL_ZERO_BYTES, stream);
    Args a{};
    const float** ap = (const float**)&a;
    for (int i = 0; i < 23; ++i) ap[i] = (const float*)d_in[i];
    a.out = (float*)d_out; a.ws = (unsigned char*)d_ws; a.pad = 0;
    constexpr int NL = MK_N_LAUNCHES;
    for (int li = 0; li < NL; ++li) {
        a.ph_lo = (NL == 1) ? 0 : li; a.ph_hi = (NL == 1) ? NPH : li + 1; a.li = (NL == 1) ? 0 : 0;
        hipLaunchKernelGGL(mk_fwd, dim3(grid), dim3(NTHR), LDS_BYTES, stream, a);
#ifdef DUP_HI
        if (NL > 1 && li == DUP_HI) for (int l2 = DUP_LO; l2 <= DUP_HI; ++l2) { a.ph_lo = l2; a.ph_hi = l2 + 1; hipLaunchKernelGGL(mk_fwd, dim3(grid), dim3(NTHR), LDS_BYTES, stream, a); }
#endif
    }
}
```

```cpp
#include <hip/hip_runtime.h>
#include <cstdio>
#include <cstdint>

#ifndef MK_N_LAUNCHES
#define MK_N_LAUNCHES 1
#endif

#define GAS __attribute__((address_space(1)))
#define LAS __attribute__((address_space(3)))
typedef unsigned short bf16_t;
typedef __bf16 bf16x8 __attribute__((ext_vector_type(8)));
typedef float f32x2 __attribute__((ext_vector_type(2)));
typedef float f32x4 __attribute__((ext_vector_type(4)));
typedef float f32x16 __attribute__((ext_vector_type(16)));
typedef unsigned u32x2 __attribute__((ext_vector_type(2)));
typedef unsigned u32x4 __attribute__((ext_vector_type(4)));
typedef GAS unsigned gu32;

constexpr int T = 8192, D = 4096;
constexpr int RW = 2048, RH = 32, RN = 64;
constexpr int LW = 128, LA = 128, LG = 480, LGP = 512;
constexpr int SHIFTW = 6880;
constexpr int MH = 16, MD = 128, MBLK = 256, NBLK = 32;
constexpr int INW = 21216;
constexpr int PLD = 19200;
constexpr int PC_R = 0, PC_K = 2048, PC_V = 4096, PC_WL = 6144, PC_AL = 6272, PC_GL = 6400, PC_MQ = 6912, PC_MK = 8960, PC_GA = 11008, PC_GB = 15104, PC_MV = 19200;
constexpr int WIN_ROWS = 21248;
constexpr int PQ_SPLIT = 16384;
constexpr int PH_ = 8, PNK = 128, PQD = 256, PHALF = 128, PTOPK = 16;
constexpr float NORM_EPS = 1e-6f, LNX_EPS = 64e-5f;
constexpr float QSCALE = 0.08838834764831845f * 1.4426950408889634f;

constexpr size_t MiB = 1u << 20;
constexpr size_t WS_CTL = 0, CTL_ZERO_BYTES = 1 * MiB;
constexpr size_t WS_WIN = 1 * MiB;
constexpr size_t WS_X1 = 1 * MiB, WS_PQ = 129 * MiB;
constexpr size_t WS_WA = 167 * MiB, WS_WB = 183 * MiB, WS_WOUT = 199 * MiB, WS_WQ = 231 * MiB, WS_WUP = 247 * MiB, WS_AUP = 248 * MiB, WS_GUP = 249 * MiB, WS_SUBK = 251 * MiB;
constexpr size_t WS_PU = 252 * MiB, WS_PV = 380 * MiB;
constexpr size_t WS_XN = 508 * MiB;
constexpr size_t WS_Y = 508 * MiB, WS_H2 = 508 * MiB;
constexpr size_t WS_PROJ = 572 * MiB;
constexpr size_t WS_VT = 872 * MiB;
constexpr size_t WS_ROPE = 904 * MiB, WS_KMEAN = 908 * MiB, WS_MASK = 909 * MiB, WS_AW = 910 * MiB, WS_AA = 912 * MiB, WS_AG = 914 * MiB;
constexpr size_t WS_PSU = 909 * MiB + 512 * 1024, WS_PSV = WS_PSU + 64 * 1024;
constexpr size_t WS_DEC = 922 * MiB;
constexpr size_t WS_MIXED = 922 * MiB;
constexpr size_t WS_KKN = 986 * MiB, WS_BB = 1018 * MiB, WS_KP = 1050 * MiB, WS_ZR = 1082 * MiB, WS_ZV = 1114 * MiB, WS_G = 1146 * MiB;
constexpr size_t WS_YA = 1178 * MiB, WS_YB = 1210 * MiB, WS_IDX = 1242 * MiB, WS_GW = 1246 * MiB, WS_PARTML = 1250 * MiB, WS_LIST = 1254 * MiB, WS_UDESC = 1262 * MiB, WS_END = 1267 * MiB;
constexpr size_t WS_PARTO = 922 * MiB;

constexpr int CW_TMO = 0, CW_CODE = 1, CW_ATTNQ = 64, CW_CNT = 1024, CW_BAR = 4096;

constexpr int RING_OFF = 0, RING_BYTES = 155648;
constexpr int LDSCTL_OFF = RING_BYTES, MISC_OFF = LDSCTL_OFF + 320;
constexpr int LDS_BYTES = 163840;
constexpr int NWAVES = 8, NTHR = 512;

__device__ __forceinline__ unsigned f2bf(float f) { unsigned u = __builtin_bit_cast(unsigned, f); return (u + 0x7fffu + ((u >> 16) & 1u)) >> 16; }
typedef __bf16 bf16x2 __attribute__((ext_vector_type(2)));
__device__ __forceinline__ unsigned pk2(float lo, float hi) { const f32x2 v = {lo, hi}; return __builtin_bit_cast(unsigned, __builtin_convertvector(v, bf16x2)); }
__device__ __forceinline__ float bflo(unsigned u) { return __builtin_bit_cast(float, u << 16); }
__device__ __forceinline__ float bfhi(unsigned u) { return __builtin_bit_cast(float, u & 0xffff0000u); }
__device__ __forceinline__ float bf1(bf16_t b) { return __builtin_bit_cast(float, (unsigned)b << 16); }
__device__ __forceinline__ float fsigmoid(float x) { return __builtin_amdgcn_rcpf(1.0f + __expf(-x)); }
__device__ __forceinline__ float wave_sum(float v) {
#pragma unroll
    for (int o = 1; o < 64; o <<= 1) v += __shfl_xor(v, o);
    return v;
}
template <int CTRL> __device__ __forceinline__ float dpp_f(float v) { return __builtin_bit_cast(float, __builtin_amdgcn_update_dpp(0, __builtin_bit_cast(int, v), CTRL, 0xF, 0xF, true)); }
__device__ __forceinline__ float sum16(float x) {
    x += dpp_f<0xB1>(x); x += dpp_f<0x4E>(x); x += dpp_f<0x141>(x); x += dpp_f<0x140>(x); return x;
}
__device__ __forceinline__ float vmul(float a, float b) { float r; asm("v_mul_f32_e32 %0, %1, %2" : "=v"(r) : "v"(a), "v"(b)); return r; }
__device__ __forceinline__ float vfma(float a, float b, float c) { float r; asm("v_fma_f32 %0, %1, %2, %3" : "=v"(r) : "v"(a), "v"(b), "v"(c)); return r; }
#define LDS_WAIT() asm volatile("s_waitcnt lgkmcnt(0)" ::: "memory")
#define VM_WAIT() asm volatile("s_waitcnt vmcnt(0)" ::: "memory")
#define WG_BAR() do { asm volatile("s_waitcnt lgkmcnt(0)" ::: "memory"); __builtin_amdgcn_s_barrier(); asm volatile("" ::: "memory"); } while (0)

namespace pg8 {
constexpr int BM = 256, BK = 64, HALF = 128, HTB = HALF * BK * 2, STAGE_BYTES = 8 * HTB, NXCD = 8, WGM = 8;
__host__ __device__ __forceinline__ int lds_byte(int r, int c) { const int st = (r >> 4) * 2 + (c >> 5), rr = r & 15, cc = c & 31, ob = rr * 64 + cc * 2; return st * 1024 + (ob ^ (((ob >> 9) & 1) << 5)); }
__host__ __device__ __forceinline__ void stage_rc(int b, int& R, int& C) { const int st = b / 1024, sb = b % 1024, swz = sb ^ (((sb >> 9) & 1) << 5); R = (st >> 1) * 16 + swz / 64; C = (st & 1) * 32 + (swz % 64) / 2; }
__host__ __device__ __forceinline__ int perm32(int rho) { const int n = rho >> 4, i = rho & 15; return 8 * (i >> 2) + 4 * n + (i & 3); }

struct Unit { int pm, pn; };
struct Gemm { const bf16_t* A; const bf16_t* Bt; int M, N, K; };

struct StaticOrder {
    int nM, nN, nwg, G, c;
    __host__ __device__ void init(int M, int N, int G_, int c_) { nM = M / BM; nN = N / BM; nwg = nM * nN; G = G_; c = c_; }
    __host__ __device__ bool next(int i, Unit& u) const {
        const long L = (long)i * G + c; if (L >= nwg) return false;
        int wgid = (int)L; { const int q = nwg / NXCD, r = nwg % NXCD, xcd = wgid % NXCD, off = wgid / NXCD; wgid = (xcd < r ? xcd * (q + 1) : r * (q + 1) + (xcd - r) * q) + off; }
        const int nig = WGM * nN, gid = wgid / nig, fm = gid * WGM, gsz = (nM - fm) < WGM ? (nM - fm) : WGM;
        u.pm = fm + ((wgid % nig) % gsz); u.pn = (wgid % nig) / gsz; return true;
    }
    __device__ __forceinline__ void a_ready(const Unit&) const {}
    __device__ __forceinline__ void done(const Unit&) const {}
};

template <class Epi, class Sched, bool ALIGN_EPI = false, bool SP2 = false>
__device__ __forceinline__ void gemm_phase(LAS unsigned char* lds, const Gemm g, const Sched& S, const Epi& E) {
    int tid_ = threadIdx.x; asm volatile("" : "+v"(tid_));
    const int tid = tid_, wid = __builtin_amdgcn_readfirstlane(tid >> 6), lane = tid & 63, wr = wid >> 2, wc = wid & 3, fr = lane & 15, fq = lane >> 4;
    int K_ = g.K; asm volatile("" : "+s"(K_));
    const int K = K_, nt = K / BK;
    unsigned voffA[2], voffB[2];
#pragma unroll
    for (int i = 0; i < 2; ++i) { int R, C; stage_rc(tid * 16 + i * 8192, R, C); const int Rb = Epi::PERM ? ((R & ~31) + perm32(R & 31)) : R;
        voffA[i] = (unsigned)(R * K + C) * 2u; voffB[i] = (unsigned)(Rb * K + C) * 2u; }
    const size_t kstep = (size_t)(BK * 2);
    const size_t hstep = (size_t)HALF * K * 2;
    const size_t tstep = 2 * hstep;
    const unsigned ldsw = (unsigned)wid * 1024u;
    const int aoff = lds_byte(wr * 64 + fr, fq * 8), boff = lds_byte(wc * 32 + fr, fq * 8);
#define PG8_SA(b, h) (((b) * 2 + (h)) * HTB)
#define PG8_SB(b, h) ((4 + (b) * 2 + (h)) * HTB)
#define PG8_STAGE(bufoff, gbase, voff) do { _Pragma("unroll") for (int _i = 0; _i < 2; ++_i) \
        __builtin_amdgcn_global_load_lds((const unsigned*)((const char*)(gbase) + (voff)[_i]), (LAS unsigned*)(lds + (bufoff) + ldsw + _i * 8192), 16, 0, 0); } while (0)
#define PG8_LDA(dst, b, h) do { _Pragma("unroll") for (int m = 0; m < 4; ++m) _Pragma("unroll") for (int k = 0; k < 2; ++k) dst[m][k] = *(const LAS bf16x8*)(lds + PG8_SA(b, h) + aoff + m * 2048 + k * 1024); } while (0)
#define PG8_LDB(dst, b, h) do { _Pragma("unroll") for (int n = 0; n < 2; ++n) _Pragma("unroll") for (int k = 0; k < 2; ++k) dst[n][k] = *(const LAS bf16x8*)(lds + PG8_SB(b, h) + boff + n * 2048 + k * 1024); } while (0)
#define PG8_MMA(ai, bj, At, Bt) do { __builtin_amdgcn_s_setprio(1); _Pragma("unroll") for (int m = 0; m < 4; ++m) _Pragma("unroll") for (int n = 0; n < 2; ++n) _Pragma("unroll") for (int k = 0; k < 2; ++k) { \
        if constexpr (Epi::SWAP) acc[ai][bj][m][n] = __builtin_amdgcn_mfma_f32_16x16x32_bf16(At[m][k], Bt[n][k], acc[ai][bj][m][n], 0, 0, 0); \
        else acc[ai][bj][m][n] = __builtin_amdgcn_mfma_f32_16x16x32_bf16(Bt[n][k], At[m][k], acc[ai][bj][m][n], 0, 0, 0); } __builtin_amdgcn_s_setprio(0); } while (0)
#define PG8_WAIT_V(n) asm volatile("s_waitcnt vmcnt(" #n ")" ::: "memory")
#define PG8_WAIT_L(n) asm volatile("s_waitcnt lgkmcnt(" #n ")" ::: "memory")
#define PG8_BAR __builtin_amdgcn_s_barrier()
#define PG8_SCHED __builtin_amdgcn_sched_barrier(0)
    Unit cur, nxt; int ui = 0;
    if (!S.next(0, cur)) return;
    f32x4 acc[2][2][4][2];
#pragma unroll
    for (int a = 0; a < 2; ++a)
#pragma unroll
        for (int b = 0; b < 2; ++b)
#pragma unroll
            for (int m = 0; m < 4; ++m)
#pragma unroll
                for (int n = 0; n < 2; ++n) acc[a][b][m][n] = (f32x4){0.f, 0.f, 0.f, 0.f};
    bf16x8 At[4][2], B0[2][2], B1[2][2];
    const char* cA = (const char*)g.A + (size_t)cur.pm * tstep; const char* cB = (const char*)g.Bt + (size_t)cur.pn * tstep;
    S.a_ready(cur);
    if constexpr (SP2) {
        PG8_STAGE(PG8_SB(0, 0), cB, voffB); PG8_STAGE(PG8_SB(0, 1), cB + hstep, voffB); PG8_STAGE(PG8_SA(0, 0), cA, voffA); PG8_STAGE(PG8_SA(0, 1), cA + hstep, voffA);
        if (wr == 1) PG8_BAR;
        PG8_WAIT_V(2); PG8_BAR;
        PG8_STAGE(PG8_SB(1, 0), cB + kstep, voffB); PG8_STAGE(PG8_SA(1, 0), cA + kstep, voffA); PG8_STAGE(PG8_SB(1, 1), cB + hstep + kstep, voffB);
        PG8_WAIT_V(6); PG8_BAR;
    } else {
        PG8_STAGE(PG8_SB(0, 0), cB, voffB); PG8_STAGE(PG8_SA(0, 0), cA, voffA); PG8_STAGE(PG8_SB(0, 1), cB + hstep, voffB); PG8_STAGE(PG8_SA(0, 1), cA + hstep, voffA);
        if (wr == 1) PG8_BAR;
        PG8_WAIT_V(4); PG8_BAR;
        PG8_STAGE(PG8_SB(1, 0), cB + kstep, voffB); PG8_STAGE(PG8_SA(1, 0), cA + kstep, voffA); PG8_STAGE(PG8_SB(1, 1), cB + hstep + kstep, voffB);
        PG8_WAIT_V(6); PG8_BAR;
    }
    for (;;) {
        const bool has_next = S.next(ui + 1, nxt);
        const char* nA = has_next ? (const char*)g.A + (size_t)nxt.pm * tstep : cA; const char* nB = has_next ? (const char*)g.Bt + (size_t)nxt.pn * tstep : cB;
        for (int t = 0; t < nt; t += 2) {
            const bool last = (t == nt - 2);
            const char* a1 = cA + (size_t)(t + 1) * kstep;
            const char* a2 = last ? nA : cA + (size_t)(t + 2) * kstep; const char* b2 = last ? nB : cB + (size_t)(t + 2) * kstep;
            const char* a3 = a2 + kstep; const char* b3 = b2 + kstep;
            if (last && has_next) S.a_ready(nxt);
            if constexpr (SP2) {
            PG8_LDB(B0, 0, 0); PG8_LDB(B1, 0, 1); PG8_SCHED; PG8_LDA(At, 0, 0); PG8_STAGE(PG8_SA(1, 1), a1 + hstep, voffA);
            PG8_WAIT_V(8); PG8_WAIT_L(0); PG8_BAR; PG8_MMA(0, 0, At, B0); PG8_MMA(0, 1, At, B1); PG8_BAR; PG8_SCHED;
            PG8_LDA(At, 0, 1); PG8_STAGE(PG8_SB(0, 0), b2, voffB); PG8_STAGE(PG8_SB(0, 1), b2 + hstep, voffB); PG8_STAGE(PG8_SA(0, 0), a2, voffA);
            PG8_WAIT_V(8); PG8_WAIT_L(0); PG8_BAR; PG8_MMA(1, 0, At, B0); PG8_MMA(1, 1, At, B1); PG8_BAR; PG8_SCHED;
            PG8_LDB(B0, 1, 0); PG8_LDB(B1, 1, 1); PG8_SCHED; PG8_LDA(At, 1, 0); PG8_STAGE(PG8_SA(0, 1), a2 + hstep, voffA);
            PG8_WAIT_V(8); PG8_WAIT_L(0); PG8_BAR; PG8_MMA(0, 0, At, B0); PG8_MMA(0, 1, At, B1); PG8_BAR; PG8_SCHED;
            PG8_LDA(At, 1, 1); PG8_STAGE(PG8_SB(1, 0), b3, voffB); PG8_STAGE(PG8_SB(1, 1), b3 + hstep, voffB); PG8_STAGE(PG8_SA(1, 0), a3, voffA);
            PG8_WAIT_V(8); PG8_WAIT_L(0); PG8_BAR; PG8_MMA(1, 0, At, B0); PG8_MMA(1, 1, At, B1); PG8_BAR; PG8_SCHED;
            } else {
            PG8_LDB(B0, 0, 0); PG8_SCHED; PG8_LDA(At, 0, 0); PG8_STAGE(PG8_SA(1, 1), a1 + hstep, voffA);
            PG8_WAIT_L(8); PG8_BAR; PG8_WAIT_L(0); PG8_MMA(0, 0, At, B0); PG8_BAR; PG8_SCHED;
            PG8_LDB(B1, 0, 1); PG8_STAGE(PG8_SB(0, 0), b2, voffB);
            PG8_BAR; PG8_WAIT_L(0); PG8_MMA(0, 1, At, B1); PG8_BAR;
            PG8_LDA(At, 0, 1); PG8_STAGE(PG8_SA(0, 0), a2, voffA);
            PG8_BAR; PG8_WAIT_L(0); PG8_MMA(1, 0, At, B0); PG8_BAR; PG8_SCHED;
            PG8_STAGE(PG8_SB(0, 1), b2 + hstep, voffB);
            PG8_WAIT_V(6); PG8_BAR; PG8_MMA(1, 1, At, B1); PG8_BAR;
            PG8_LDB(B0, 1, 0); PG8_SCHED; PG8_LDA(At, 1, 0); PG8_STAGE(PG8_SA(0, 1), a2 + hstep, voffA);
            PG8_WAIT_L(8); PG8_BAR; PG8_WAIT_L(0); PG8_MMA(0, 0, At, B0); PG8_BAR; PG8_SCHED;
            PG8_LDB(B1, 1, 1); PG8_STAGE(PG8_SB(1, 0), b3, voffB);
            PG8_BAR; PG8_WAIT_L(0); PG8_MMA(0, 1, At, B1); PG8_BAR;
            PG8_LDA(At, 1, 1); PG8_STAGE(PG8_SA(1, 0), a3, voffA);
            PG8_BAR; PG8_WAIT_L(0); PG8_MMA(1, 0, At, B0); PG8_BAR; PG8_SCHED;
            PG8_STAGE(PG8_SB(1, 1), b3 + hstep, voffB);
            PG8_WAIT_V(6); PG8_BAR; PG8_MMA(1, 1, At, B1); PG8_BAR;
            }
        }
        if constexpr (ALIGN_EPI) { if (wr == 0) PG8_BAR; }
        E(acc, cur, wr, wc, fr, fq); S.done(cur);
        if (!has_next) break;
#pragma unroll
        for (int a = 0; a < 2; ++a)
#pragma unroll
            for (int b = 0; b < 2; ++b)
#pragma unroll
                for (int m = 0; m < 4; ++m)
#pragma unroll
                    for (int n = 0; n < 2; ++n) acc[a][b][m][n] = (f32x4){0.f, 0.f, 0.f, 0.f};
        cur = nxt; cA = nA; cB = nB; ++ui;
        if constexpr (ALIGN_EPI) { if (wr == 1) PG8_BAR; }
    }
    PG8_WAIT_V(0);
    if constexpr (!ALIGN_EPI) { if (wr == 0) PG8_BAR; }
    PG8_BAR;
#undef PG8_SA
#undef PG8_SB
#undef PG8_STAGE
#undef PG8_LDA
#undef PG8_LDB
#undef PG8_MMA
#undef PG8_WAIT_V
#undef PG8_WAIT_L
#undef PG8_BAR
#undef PG8_SCHED
}

typedef const f32x4 (&AccRef)[2][2][4][2];
__device__ __forceinline__ u32x4 pack8(f32x4 v0, f32x4 v1) { u32x4 w; w.x = pk2(v0[0], v0[1]); w.y = pk2(v0[2], v0[3]); w.z = pk2(v1[0], v1[1]); w.w = pk2(v1[2], v1[3]); return w; }
__device__ __forceinline__ void unpack8(u32x4 w, f32x4& v0, f32x4& v1) { v0 = (f32x4){bflo(w.x), bfhi(w.x), bflo(w.y), bfhi(w.y)}; v1 = (f32x4){bflo(w.z), bfhi(w.z), bflo(w.w), bfhi(w.w)}; }

struct EpiBf16 {
    static constexpr bool PERM = true, SWAP = false;
    bf16_t* O; int ldc;
    __device__ __forceinline__ void operator()(AccRef acc, const Unit& u, int wr, int wc, int fr, int fq) const {
        const int row0 = u.pm * BM + wr * 64 + fr, col0 = u.pn * BM + wc * 32 + 8 * fq;
#pragma unroll
        for (int ai = 0; ai < 2; ++ai)
#pragma unroll
            for (int m = 0; m < 4; ++m) { bf16_t* rowp = O + (size_t)(row0 + ai * HALF + m * 16) * ldc + col0;
#pragma unroll
                for (int bj = 0; bj < 2; ++bj) *(u32x4*)(rowp + bj * HALF) = pack8(acc[ai][bj][m][0], acc[ai][bj][m][1]); }
    }
};
struct EpiProj {
    static constexpr bool PERM = true, SWAP = false;
    bf16_t* O; const float* rope;
    __device__ __forceinline__ void operator()(AccRef acc, const Unit& u, int wr, int wc, int fr, int fq) const {
        const int row0 = u.pm * BM + wr * 64 + fr, col0 = u.pn * BM + wc * 32 + 8 * fq;
        const int mode = (u.pn >= 27 && u.pn < 43) ? (u.pn < 35 ? 1 : 2) : 0;
        const float sc = (mode == 1) ? QSCALE : 1.0f;
#pragma unroll
        for (int ai = 0; ai < 2; ++ai)
#pragma unroll
            for (int m = 0; m < 4; ++m) { const int row = row0 + ai * HALF + m * 16; bf16_t* rowp = O + (size_t)row * PLD + col0;
#pragma unroll
                for (int bj = 0; bj < 2; ++bj) { f32x4 v0 = acc[ai][bj][m][0], v1 = acc[ai][bj][m][1];
                    if (mode) { const int i0 = ((col0 + bj * HALF) & 127) >> 1; const f32x4* rp = (const f32x4*)(rope + ((size_t)row * 64 + i0) * 2); const f32x4 c0 = rp[0], c1 = rp[1];
                        f32x4 o0, o1;
                        o0[0] = v0[0] * c0[0] - v0[1] * c0[1]; o0[1] = v0[1] * c0[0] + v0[0] * c0[1]; o0[2] = v0[2] * c0[2] - v0[3] * c0[3]; o0[3] = v0[3] * c0[2] + v0[2] * c0[3];
                        o1[0] = v1[0] * c1[0] - v1[1] * c1[1]; o1[1] = v1[1] * c1[0] + v1[0] * c1[1]; o1[2] = v1[2] * c1[2] - v1[3] * c1[3]; o1[3] = v1[3] * c1[2] + v1[2] * c1[3];
                        v0 = o0 * sc; v1 = o1 * sc; }
                    *(u32x4*)(rowp + bj * HALF) = pack8(v0, v1); } }
    }
};
struct EpiVT {
    static constexpr bool PERM = false, SWAP = true;
    bf16_t* VT;
    __device__ __forceinline__ void operator()(AccRef acc, const Unit& u, int wr, int wc, int fr, int fq) const {
        const int tok0 = u.pm * BM + wr * 64 + 4 * fq, col0 = u.pn * BM + wc * 32 + fr;
#pragma unroll
        for (int ai = 0; ai < 2; ++ai)
#pragma unroll
            for (int m = 0; m < 4; ++m)
#pragma unroll
                for (int bj = 0; bj < 2; ++bj)
#pragma unroll
                    for (int n = 0; n < 2; ++n) { const f32x4 v = acc[ai][bj][m][n]; u32x2 w; w.x = pk2(v[0], v[1]); w.y = pk2(v[2], v[3]);
                        *(u32x2*)(VT + (size_t)(col0 + bj * HALF + n * 16) * T + tok0 + ai * HALF + m * 16) = w; }
    }
};
struct EpiDec {
    static constexpr bool PERM = true, SWAP = false;
    float* O; const float* w0;
    __device__ __forceinline__ void operator()(AccRef acc, const Unit& u, int wr, int wc, int fr, int fq) const {
        const int row0 = u.pm * BM + wr * 64 + fr, col0 = u.pn * BM + wc * 32 + 8 * fq;
#pragma unroll
        for (int bj = 0; bj < 2; ++bj) { const f32x4 b0 = *(const f32x4*)(w0 + col0 + bj * HALF), b1 = *(const f32x4*)(w0 + col0 + bj * HALF + 4);
#pragma unroll
            for (int ai = 0; ai < 2; ++ai)
#pragma unroll
                for (int m = 0; m < 4; ++m) { float* rowp = O + (size_t)(row0 + ai * HALF + m * 16) * RW + col0 + bj * HALF;
#pragma unroll
                    for (int n = 0; n < 2; ++n) { const f32x4 x = acc[ai][bj][m][n] + (n ? b1 : b0); f32x4 o;
#pragma unroll
                        for (int e = 0; e < 4; ++e) { const float z = -x[e]; const float sp = fmaxf(z, 0.f) + __logf(1.0f + __expf(-fabsf(z))); o[e] = __expf(-__expf(-sp - 0.5f)); }
                        *(f32x4*)(rowp + 4 * n) = o; }
                    asm volatile("" ::: "memory"); } }
    }
};
struct EpiA {
    static constexpr bool PERM = true, SWAP = false;
    bf16_t* KP; bf16_t* BB; const bf16_t* KKN; const float* a0; const float* k_a;
    __device__ __forceinline__ void operator()(AccRef acc, const Unit& u, int wr, int wc, int fr, int fq) const {
        const int row0 = u.pm * BM + wr * 64 + fr, col0 = u.pn * BM + wc * 32 + 8 * fq;
#pragma unroll
        for (int bj = 0; bj < 2; ++bj) { const int cb = col0 + bj * HALF;
            const f32x4 b0 = *(const f32x4*)(a0 + cb), b1 = *(const f32x4*)(a0 + cb + 4), ka0 = *(const f32x4*)(k_a + cb), ka1 = *(const f32x4*)(k_a + cb + 4);
#pragma unroll
            for (int ai = 0; ai < 2; ++ai)
#pragma unroll
                for (int m = 0; m < 4; ++m) { const size_t off = (size_t)(row0 + ai * HALF + m * 16) * RW + cb;
                    f32x4 zk0, zk1, kn0, kn1; unpack8(*(const u32x4*)(KP + off), zk0, zk1); unpack8(*(const u32x4*)(KKN + off), kn0, kn1);
                    f32x4 a0v, a1v;
#pragma unroll
                    for (int e = 0; e < 4; ++e) { a0v[e] = fsigmoid(acc[ai][bj][m][0][e] + b0[e]); a1v[e] = fsigmoid(acc[ai][bj][m][1][e] + b1[e]); }
                    const f32x4 kp0 = zk0 * (1.0f + (a0v - 1.0f) * ka0), kp1 = zk1 * (1.0f + (a1v - 1.0f) * ka1);
                    *(u32x4*)(KP + off) = pack8(kp0, kp1); *(u32x4*)(BB + off) = pack8(-(kn0 * a0v), -(kn1 * a1v));
                    asm volatile("" ::: "memory"); } }
    }
};
template <bool ADD> struct EpiMix {
    static constexpr bool PERM = true, SWAP = false;
    bf16_t* O; const bf16_t* proj; int gcol0;
    __device__ __forceinline__ void operator()(AccRef acc, const Unit& u, int wr, int wc, int fr, int fq) const {
        const int row0 = u.pm * BM + wr * 64 + fr, col0 = u.pn * BM + wc * 32 + 8 * fq;
#pragma unroll
        for (int ai = 0; ai < 2; ++ai)
#pragma unroll
            for (int m = 0; m < 4; ++m) { const int row = row0 + ai * HALF + m * 16;
#pragma unroll
                for (int bj = 0; bj < 2; ++bj) { f32x4 g0, g1; unpack8(*(const u32x4*)(proj + (size_t)row * PLD + gcol0 + col0 + bj * HALF), g0, g1);
                    f32x4 o0, o1;
#pragma unroll
                    for (int e = 0; e < 4; ++e) { o0[e] = fsigmoid(g0[e]) * acc[ai][bj][m][0][e]; o1[e] = fsigmoid(g1[e]) * acc[ai][bj][m][1][e]; }
                    bf16_t* op = O + (size_t)row * D + col0 + bj * HALF;
                    if (ADD) { f32x4 p0, p1; unpack8(*(const u32x4*)op, p0, p1); o0 += p0; o1 += p1; }
                    *(u32x4*)op = pack8(o0, o1); } }
    }
};
struct EpiRes {
    static constexpr bool PERM = true, SWAP = false;
    float* O; const float* x;
    __device__ __forceinline__ void operator()(AccRef acc, const Unit& u, int wr, int wc, int fr, int fq) const {
        const int row0 = u.pm * BM + wr * 64 + fr, col0 = u.pn * BM + wc * 32 + 8 * fq;
#pragma unroll
        for (int ai = 0; ai < 2; ++ai)
#pragma unroll
            for (int m = 0; m < 4; ++m) { const size_t off = (size_t)(row0 + ai * HALF + m * 16) * D + col0;
#pragma unroll
                for (int bj = 0; bj < 2; ++bj)
#pragma unroll
                    for (int n = 0; n < 2; ++n) *(f32x4*)(O + off + bj * HALF + 4 * n) = *(const f32x4*)(x + off + bj * HALF + 4 * n) + acc[ai][bj][m][n]; }
    }
};
}

#define XB_TMO      128
#define XB_XCNT(j)  (256  + 64 * (j))
#define XB_XSUB(j)  (1280 + 64 * (j))
#define XB_XGEN(j)  (2304 + 64 * (j))
#define XB_TOP      3328
#define XB_TOPGEN   3392
#define XCD_BAR_WORDS 3456
#define XB_SPIN_CAP (1u << 18)
__device__ __forceinline__ unsigned xb_ld(unsigned* p)              { return __hip_atomic_load(p, __ATOMIC_RELAXED, __HIP_MEMORY_SCOPE_AGENT); }
__device__ __forceinline__ unsigned xb_add(unsigned* p, unsigned v) { return __hip_atomic_fetch_add(p, v, __ATOMIC_RELAXED, __HIP_MEMORY_SCOPE_AGENT); }
__device__ __forceinline__ unsigned xb_xcc_id() { return (unsigned)__builtin_amdgcn_s_getreg((3 << 11) | 20) & 0xFu; }
#define XB_SPIN(cond, bar) do { unsigned _sp = 0; while (cond) { __builtin_amdgcn_s_sleep(1); \
    if ((++_sp & 255u) == 0u) { if (xb_ld(&(bar)[XB_TMO])) break; if (_sp > XB_SPIN_CAP) { atomicAdd(&(bar)[XB_TMO], 1u); break; } } } } while (0)
struct XcdBarrier { unsigned* bar; unsigned x; volatile LAS unsigned* st; };
__device__ __forceinline__ XcdBarrier xcd_barrier_post(unsigned* bar, volatile LAS unsigned* st) {
    XcdBarrier b; b.bar = bar; b.x = xb_xcc_id(); b.st = st;
    if (threadIdx.x == 0) (void)xb_add(&bar[XB_XCNT(b.x)], 1u);
    return b;
}
__device__ __forceinline__ void xcd_barrier_complete(unsigned* bar, unsigned x, unsigned& nloc, unsigned& nx) {
    const unsigned G = gridDim.x * gridDim.y * gridDim.z;
    unsigned sum, cnt, mine, sp = 0u;
    for (;;) {
        sum = 0u; cnt = 0u; mine = 0u;
#pragma unroll
        for (unsigned j = 0; j < 16; ++j) { const unsigned c = xb_ld(&bar[XB_XCNT(j)]); sum += c; cnt += (c > 0u) ? 1u : 0u; mine = (j == x) ? c : mine; }
        if (sum == G) break;
        __builtin_amdgcn_s_sleep(1);
        if ((++sp & 255u) == 0u) { if (xb_ld(&bar[XB_TMO])) break; if (sp > XB_SPIN_CAP) { atomicAdd(&bar[XB_TMO], 1u); break; } }
    }
    nloc = mine > 0u ? mine : 1u; nx = cnt > 0u ? cnt : 1u;
}
__device__ __forceinline__ void xcd_barrier(const XcdBarrier& b) {
    asm volatile("s_waitcnt vmcnt(0)" ::: "memory");
    __syncthreads();
    if (threadIdx.x == 0) {
        unsigned* bar = b.bar;
        __builtin_amdgcn_s_waitcnt(0);
        unsigned nloc = b.st[0], nx = b.st[1];
        if (nloc == 0u) { xcd_barrier_complete(bar, b.x, nloc, nx); b.st[0] = nloc; b.st[1] = nx; }
        const unsigned old = xb_add(&bar[XB_XSUB(b.x)], 1u);
        const unsigned gen = old / nloc;
        if (old + 1u == (gen + 1u) * nloc) {
            __builtin_amdgcn_fence(__ATOMIC_RELEASE, "agent");
            asm volatile("s_waitcnt vmcnt(0)" ::: "memory");
            const unsigned og = xb_add(&bar[XB_TOP], 1u);
            const unsigned tg = og / nx;
            if (og + 1u == (tg + 1u) * nx) xb_add(&bar[XB_TOPGEN], 1u);
            else XB_SPIN(xb_ld(&bar[XB_TOPGEN]) == tg, bar);
            __builtin_amdgcn_fence(__ATOMIC_ACQUIRE, "agent");
            xb_add(&bar[XB_XGEN(b.x)], 1u);
            asm volatile("s_waitcnt vmcnt(0)" ::: "memory");
        } else {
            XB_SPIN(xb_ld(&bar[XB_XGEN(b.x)]) == gen, bar);
            __builtin_amdgcn_fence(__ATOMIC_ACQUIRE, "agent");
            asm volatile("s_waitcnt vmcnt(0)" ::: "memory");
        }
    }
    __syncthreads();
}

struct Args {
    const float *x, *norm1_g, *w_in, *mu, *w0, *w_up, *a0, *a_up, *g_up, *k_k, *k_a, *r_k, *lnx_g, *lnx_b, *w_ba, *w_bb, *w_out, *norm2_g, *peer_wq, *sub_keys, *peer_u, *peer_v, *final_g;
    float* out; unsigned char* ws; int ph_lo, ph_hi, li, pad;
};
#define CAS __attribute__((address_space(4)))
typedef const CAS Args* ArgsP;
__device__ __forceinline__ ArgsP get_args() { ArgsP p = (ArgsP)__builtin_amdgcn_kernarg_segment_ptr(); asm volatile("" : "+s"(p)); return p; }
struct Frame { LAS unsigned char* lds; int tid, lane, wave, vcu, G; };

__device__ __forceinline__ int win_dst(int s) {
    if (s < SHIFTW) return s;
    if (s < SHIFTW + 4096) { const int base = (s < SHIFTW + 2048) ? SHIFTW : SHIFTW + 2048; const int m = s - base, head = m >> 7, c = m & 127; const int j = (c < 64) ? 2 * c : 2 * (c - 64) + 1;
        return ((s < SHIFTW + 2048) ? PC_MQ : PC_MK) + head * 128 + j; }
    if (s < SHIFTW + 6144) return PC_MV + (s - (SHIFTW + 4096));
    if (s < SHIFTW + 6144 + 4096) return PC_GA + (s - (SHIFTW + 6144));
    return PC_GB + (s - (SHIFTW + 6144 + 4096));
}
template <bool MAPWIN> __device__ __forceinline__ void p0_transpose_item(const float* W, int K, int N, bf16_t* WT, int Kd, LAS float* scr, int item, int lane) {
    const int nblk = N / 32, kb = item / nblk, nb = item % nblk, k0 = 64 * kb, n0 = 32 * nb;
    { const int krow = lane >> 3, c4 = lane & 7; f32x4 v[8];
#pragma unroll
      for (int i = 0; i < 8; ++i) { const int kk = 8 * i + krow; v[i] = (k0 + kk < K) ? *(const f32x4*)(W + (size_t)(k0 + kk) * N + n0 + 4 * c4) : (f32x4){0.f, 0.f, 0.f, 0.f}; }
#pragma unroll
      for (int i = 0; i < 8; ++i) { LAS float* d = scr + (8 * i + krow) * 33 + 4 * c4; d[0] = v[i].x; d[1] = v[i].y; d[2] = v[i].z; d[3] = v[i].w; } }
    LDS_WAIT(); asm volatile("" ::: "memory");
    const int c = lane & 7;
#pragma unroll
    for (int j = 0; j < 4; ++j) { const int n = (lane >> 3) + 8 * j; const LAS float* s = scr + (8 * c) * 33 + n;
        u32x4 o; o.x = pk2(s[0 * 33], s[1 * 33]); o.y = pk2(s[2 * 33], s[3 * 33]); o.z = pk2(s[4 * 33], s[5 * 33]); o.w = pk2(s[6 * 33], s[7 * 33]);
        const int row = MAPWIN ? win_dst(n0 + n) : (n0 + n);
        *(u32x4*)(WT + (size_t)row * Kd + k0 + 8 * c) = o; }
    LDS_WAIT(); asm volatile("" ::: "memory");
}
__device__ __forceinline__ void rms_rows_to_bf16(const float* x, const float* g, bf16_t* o, int m0, int mstride, int lane) {
    const f32x4* gr = (const f32x4*)g + lane;
    f32x4 v[16], w[16];
    if (m0 < T) {
#pragma unroll
        for (int j = 0; j < 16; ++j) v[j] = ((const f32x4*)(x + (size_t)m0 * D) + lane)[64 * j]; }
    for (int m = m0; m < T; m += mstride) { const bool hasn = m + mstride < T;
        if (hasn) {
#pragma unroll
            for (int j = 0; j < 16; ++j) w[j] = ((const f32x4*)(x + (size_t)(m + mstride) * D) + lane)[64 * j]; }
        float s = 0.f;
#pragma unroll
        for (int j = 0; j < 16; ++j) s += (v[j].x * v[j].x + v[j].y * v[j].y) + (v[j].z * v[j].z + v[j].w * v[j].w);
        const float rs = 1.0f / sqrtf(wave_sum(s) * (1.0f / D) + NORM_EPS);
        u32x2* o8 = (u32x2*)(o + (size_t)m * D) + lane;
#pragma unroll
        for (int j = 0; j < 16; ++j) { const f32x4 gg = gr[64 * j]; u32x2 q; q.x = pk2(v[j].x * rs * gg.x, v[j].y * rs * gg.y); q.y = pk2(v[j].z * rs * gg.z, v[j].w * rs * gg.w); o8[64 * j] = q; }
        if (hasn) {
#pragma unroll
            for (int j = 0; j < 16; ++j) v[j] = w[j]; }
    }
}
__device__ __forceinline__ void cvt_table(const float* src, bf16_t* dst, size_t n8, size_t gtid, size_t nthr) {
    for (size_t i = gtid; i < n8; i += nthr) { const f32x4 a = ((const f32x4*)src)[2 * i], b = ((const f32x4*)src)[2 * i + 1]; ((u32x4*)dst)[i] = pg8::pack8(a, b); }
}
__device__ __forceinline__ void pq_load(ArgsP A, int row, int lane, f32x4 (&v)[16]) {
    const f32x4* src = (const f32x4*)((row >= 16384 ? A->peer_v + (size_t)(row - 16384) * D : A->peer_u + (size_t)row * D)) + lane;
#pragma unroll
    for (int j = 0; j < 16; ++j) v[j] = __builtin_nontemporal_load(src + 64 * j);
}
__device__ __forceinline__ void pq_finish(unsigned char* ws, int row, int lane, const f32x4 (&v)[16]) {
    const bool isv = row >= 16384; const int rr = isv ? row - 16384 : row; float am = 0.f;
#pragma unroll
    for (int j = 0; j < 16; ++j) am = fmaxf(fmaxf(am, fmaxf(fabsf(v[j].x), fabsf(v[j].y))), fmaxf(fabsf(v[j].z), fabsf(v[j].w)));
#pragma unroll
    for (int o = 1; o < 64; o <<= 1) am = fmaxf(am, __shfl_xor(am, o));
    const float inv = am > 0.f ? 127.0f / am : 0.f; unsigned* dst = (unsigned*)(ws + (isv ? WS_PV : WS_PU)) + (size_t)rr * (D / 4) + lane;
#pragma unroll
    for (int j = 0; j < 16; ++j) { const unsigned q0 = (unsigned)(int)(rintf(v[j].x * inv) + 128.0f), q1 = (unsigned)(int)(rintf(v[j].y * inv) + 128.0f), q2 = (unsigned)(int)(rintf(v[j].z * inv) + 128.0f), q3 = (unsigned)(int)(rintf(v[j].w * inv) + 128.0f);
        dst[64 * j] = q0 | (q1 << 8) | (q2 << 16) | (q3 << 24); }
    if (lane == 0) ((float*)(ws + (isv ? WS_PSV : WS_PSU)))[rr] = am * (1.0f / 127.0f);
}
__device__ __forceinline__ void peer_quant(ArgsP A, Frame& F, int w0, int wstride) {
    unsigned char* ws = A->ws; const float* pu = A->peer_u; const float* pv = A->peer_v;
    f32x4 v[16], w[16];
    auto rowp = [&](int row) { return (const f32x4*)((row >= 16384 ? pv + (size_t)(row - 16384) * D : pu + (size_t)row * D)) + F.lane; };
    if (w0 < 2 * 16384) { const f32x4* src = rowp(w0);
#pragma unroll
        for (int j = 0; j < 16; ++j) v[j] = __builtin_nontemporal_load(src + 64 * j); }
    for (int row = w0; row < 2 * 16384; row += wstride) { const bool isv = row >= 16384; const int rr = isv ? row - 16384 : row; const bool hasn = row + wstride < 2 * 16384;
        if (hasn) { const f32x4* src = rowp(row + wstride);
#pragma unroll
            for (int j = 0; j < 16; ++j) w[j] = __builtin_nontemporal_load(src + 64 * j); }
        float am = 0.f;
#pragma unroll
        for (int j = 0; j < 16; ++j) am = fmaxf(fmaxf(am, fmaxf(fabsf(v[j].x), fabsf(v[j].y))), fmaxf(fabsf(v[j].z), fabsf(v[j].w)));
#pragma unroll
        for (int o = 1; o < 64; o <<= 1) am = fmaxf(am, __shfl_xor(am, o));
        const float inv = am > 0.f ? 127.0f / am : 0.f; unsigned* dst = (unsigned*)(ws + (isv ? WS_PV : WS_PU)) + (size_t)rr * (D / 4) + F.lane;
#pragma unroll
        for (int j = 0; j < 16; ++j) { const unsigned q0 = (unsigned)(int)(rintf(v[j].x * inv) + 128.0f), q1 = (unsigned)(int)(rintf(v[j].y * inv) + 128.0f), q2 = (unsigned)(int)(rintf(v[j].z * inv) + 128.0f), q3 = (unsigned)(int)(rintf(v[j].w * inv) + 128.0f);
            dst[64 * j] = q0 | (q1 << 8) | (q2 << 16) | (q3 << 24); }
        if (F.lane == 0) ((float*)(ws + (isv ? WS_PSV : WS_PSU)))[rr] = am * (1.0f / 127.0f);
        if (hasn) {
#pragma unroll
            for (int j = 0; j < 16; ++j) v[j] = w[j]; }
    }
}
__device__ __forceinline__ void late_weights(ArgsP A, Frame& F, int w0, int wstride) {
    unsigned char* ws = A->ws;
    LAS float* scr = (LAS float*)(F.lds + RING_OFF + F.wave * 16384);
    constexpr int I_BA = 32 * 128, I_OUT = 64 * 128, I_WQ = 64 * 64, I_SK = PH_ * 2 * PNK * PHALF / 512;
    constexpr int NITEMS = 2 * I_BA + I_OUT + I_WQ + I_SK;
    for (int it = w0; it < NITEMS; it += wstride) {
        int r = it;
        if (r < I_BA) { p0_transpose_item<false>(A->w_ba, RW, D, (bf16_t*)(ws + WS_WA), RW, scr, r, F.lane); continue; } r -= I_BA;
        if (r < I_BA) { p0_transpose_item<false>(A->w_bb, RW, D, (bf16_t*)(ws + WS_WB), RW, scr, r, F.lane); continue; } r -= I_BA;
        if (r < I_OUT) { p0_transpose_item<false>(A->w_out, D, D, (bf16_t*)(ws + WS_WOUT), D, scr, r, F.lane); continue; } r -= I_OUT;
        if (r < I_WQ) { p0_transpose_item<false>(A->peer_wq, D, 2048, (bf16_t*)(ws + WS_WQ), D, scr, r, F.lane); continue; } r -= I_WQ;
        { const size_t i = (size_t)r * 64 + F.lane; const f32x4 a = ((const f32x4*)A->sub_keys)[2 * i], b = ((const f32x4*)A->sub_keys)[2 * i + 1]; ((u32x4*)(ws + WS_SUBK))[i] = pg8::pack8(a, b); }
    }
}
__device__ __forceinline__ void ph0_prologue(ArgsP A, Frame& F) {
    unsigned char* ws = A->ws;
    LAS float* scr = (LAS float*)(F.lds + RING_OFF + F.wave * 16384);
    const int gw = F.vcu * NWAVES + F.wave, NGW = F.G * NWAVES;
    constexpr int I_IN = 64 * (INW / 32), I_UP = 2 * 64, I_G = 8 * 64;
    constexpr int NITEMS = I_IN + 2 * I_UP + I_G;
    for (int it = gw; it < NITEMS; it += NGW) {
        int r = it;
        if (r < I_IN) { p0_transpose_item<true>(A->w_in, D, INW, (bf16_t*)(ws + WS_WIN), D, scr, r, F.lane); continue; } r -= I_IN;
        if (r < I_UP) { p0_transpose_item<false>(A->w_up, LW, RW, (bf16_t*)(ws + WS_WUP), LW, scr, r, F.lane); continue; } r -= I_UP;
        if (r < I_UP) { p0_transpose_item<false>(A->a_up, LA, RW, (bf16_t*)(ws + WS_AUP), LA, scr, r, F.lane); continue; } r -= I_UP;
        p0_transpose_item<false>(A->g_up, LG, RW, (bf16_t*)(ws + WS_GUP), LGP, scr, r, F.lane);
    }
    const size_t gtid = (size_t)F.vcu * NTHR + F.tid, nthr = (size_t)F.G * NTHR;
    for (size_t i = gtid; i < (size_t)32 * D / 8; i += nthr) ((u32x4*)((bf16_t*)(ws + WS_WIN) + (size_t)SHIFTW * D))[i] = (u32x4){0u, 0u, 0u, 0u};
    for (size_t i = gtid; i < (size_t)T * 64; i += nthr) { const int pos = (int)(i >> 6), fi = (int)(i & 63); const float inv = powf(10000.0f, -(float)fi / 64.0f); const float ang = (float)pos * inv;
        ((f32x2*)(ws + WS_ROPE))[i] = (f32x2){cosf(ang), sinf(ang)}; }
    rms_rows_to_bf16(A->x, A->norm1_g, (bf16_t*)(ws + WS_XN), gw, NGW, F.lane);
}

__device__ __forceinline__ f32x4 ld4bf(const bf16_t* p) { const u32x2 w = *(const u32x2*)p; return (f32x4){bflo(w.x), bfhi(w.x), bflo(w.y), bfhi(w.y)}; }
__device__ __forceinline__ void st4bf(bf16_t* p, f32x4 v) { u32x2 w; w.x = pk2(v[0], v[1]); w.y = pk2(v[2], v[3]); *(u32x2*)p = w; }
__device__ __forceinline__ void ph2_prep(ArgsP A, Frame& F) {
    unsigned char* ws = A->ws; const bf16_t* PROJ = (const bf16_t*)(ws + WS_PROJ);
    LAS float* red = (LAS float*)(F.lds + RING_OFF);
    for (int it = F.vcu; it < NBLK * MH; it += F.G) { const int n = it / MH, h = it % MH, d = F.tid & 127, part = F.tid >> 7;
        const bf16_t* p = PROJ + (size_t)(n * MBLK + part * 64) * PLD + PC_MK + h * MD + d; float s = 0.f;
#pragma unroll 8
        for (int i = 0; i < 64; ++i) s += bf1(p[(size_t)i * PLD]);
        red[F.tid] = s; WG_BAR();
        if (F.tid < 128) { const float m = (red[F.tid] + red[F.tid + 128] + red[F.tid + 256] + red[F.tid + 384]) * (1.0f / MBLK); const unsigned hi = f2bf(m); const float lo = m - __builtin_bit_cast(float, hi << 16);
            ((bf16_t*)(ws + WS_KMEAN))[(size_t)(h * NBLK + n) * MD + F.tid] = (bf16_t)hi; ((bf16_t*)(ws + WS_KMEAN + 131072))[(size_t)(h * NBLK + n) * MD + F.tid] = (bf16_t)f2bf(lo); }
        WG_BAR(); }
    const int tid = F.tid; const int c = 4 * tid;
    const f32x4 mu_r = *(const f32x4*)(A->mu + PC_R + c), mu_k = *(const f32x4*)(A->mu + PC_K + c), mu_v = *(const f32x4*)(A->mu + PC_V + c), kkw = *(const f32x4*)(A->k_k + c);
    int lc = 0, lcc = 0; if (tid < 32) { lcc = 4 * tid; lc = PC_WL + lcc; } else if (tid < 64) { lcc = 4 * (tid - 32); lc = PC_AL + lcc; } else { lcc = 4 * (tid - 64); lc = PC_GL + lcc; }
    const bool lact = tid < 64 || (tid < 192 && lcc < LG);
    const f32x4 mu_l = lact ? *(const f32x4*)(A->mu + lc) : (f32x4){0.f, 0.f, 0.f, 0.f};
    u32x2 cur[8], nxt[8];
    auto tload = [&](int t, u32x2 (&rg)[8]) { const bf16_t* P = PROJ + (size_t)t * PLD; const bf16_t* PP = t > 0 ? P - PLD : P;
        rg[0] = *(const u32x2*)(P + PC_R + c); rg[1] = *(const u32x2*)(PP + PC_R + c); rg[2] = *(const u32x2*)(P + PC_K + c); rg[3] = *(const u32x2*)(PP + PC_K + c);
        rg[4] = *(const u32x2*)(P + PC_V + c); rg[5] = *(const u32x2*)(PP + PC_V + c);
        if (lact) { rg[6] = *(const u32x2*)(P + lc); rg[7] = *(const u32x2*)(PP + lc); } else { rg[6] = (u32x2){0u, 0u}; rg[7] = (u32x2){0u, 0u}; } };
    auto up4 = [](u32x2 w) { return (f32x4){bflo(w.x), bfhi(w.x), bflo(w.y), bfhi(w.y)}; };
    if (F.vcu < T) tload(F.vcu, cur);
    for (int t = F.vcu; t < T; t += F.G) { const bool hasn = t + F.G < T; if (hasn) tload(t + F.G, nxt);
        const float hp = t > 0 ? 1.0f : 0.0f;
        { const f32x4 p = up4(cur[0]), pp = up4(cur[1]) * hp; st4bf((bf16_t*)(ws + WS_ZR) + (size_t)t * RW + c, p + (pp - p) * mu_r); }
        { const f32x4 p = up4(cur[2]), pp = up4(cur[3]) * hp; const f32x4 zk = p + (pp - p) * mu_k;
          st4bf((bf16_t*)(ws + WS_KP) + (size_t)t * RW + c, zk); const f32x4 kk = zk * kkw;
          const float ss = sum16((kk[0] * kk[0] + kk[1] * kk[1]) + (kk[2] * kk[2] + kk[3] * kk[3])); const float inv = 1.0f / fmaxf(sqrtf(ss), 1e-12f);
          st4bf((bf16_t*)(ws + WS_KKN) + (size_t)t * RW + c, kk * inv); }
        { const f32x4 p = up4(cur[4]), pp = up4(cur[5]) * hp; st4bf((bf16_t*)(ws + WS_ZV) + (size_t)t * RW + c, p + (pp - p) * mu_v); }
        if (tid < 192) { const f32x4 zero = (f32x4){0.f, 0.f, 0.f, 0.f};
            f32x4 z = zero; if (lact) { const f32x4 p = up4(cur[6]), pp = up4(cur[7]) * hp; z = p + (pp - p) * mu_l; }
            if (tid < 32) { f32x4 o;
#pragma unroll
                for (int e = 0; e < 4; ++e) o[e] = 1.0f - 2.0f * __builtin_amdgcn_rcpf(__expf(2.0f * z[e]) + 1.0f);
                st4bf((bf16_t*)(ws + WS_AW) + (size_t)t * LW + lcc, o); }
            else if (tid < 64) st4bf((bf16_t*)(ws + WS_AA) + (size_t)t * LA + lcc, z);
            else { f32x4 o = zero; if (lcc < LG) {
#pragma unroll
                for (int e = 0; e < 4; ++e) o[e] = fsigmoid(z[e]); }
                st4bf((bf16_t*)(ws + WS_AG) + (size_t)t * LGP + lcc, o); }
        }
        if (hasn) {
#pragma unroll
            for (int i = 0; i < 8; ++i) cur[i] = nxt[i]; }
    }
}

__device__ __forceinline__ void ph3_gate(ArgsP A, Frame& F) {
    unsigned char* ws = A->ws; const bf16_t* PROJ = (const bf16_t*)(ws + WS_PROJ); const bf16_t* KMH = (const bf16_t*)(ws + WS_KMEAN); const bf16_t* KML = (const bf16_t*)(ws + WS_KMEAN + 131072); unsigned* MASK = (unsigned*)(ws + WS_MASK);
    const int gw = F.vcu * NWAVES + F.wave, NGW = F.G * NWAVES; const int r = F.lane & 31, hh = F.lane >> 5; const float NEG = -__builtin_inff();
    for (int it = gw; it < (T / 32) * MH; it += NGW) { const int tg = it >> 4, h = it & 15, t = tg * 32 + r, blk = tg >> 3;
        if (blk == 0) { if (hh == 0) MASK[t * MH + h] = 0u; continue; }
        f32x16 acc;
#pragma unroll
        for (int e = 0; e < 16; ++e) acc[e] = 0.f;
#pragma unroll
        for (int ks = 0; ks < 8; ++ks) { const bf16x8 q = *(const bf16x8*)(PROJ + (size_t)t * PLD + PC_MQ + h * MD + 16 * ks + 8 * hh); const size_t ko = (size_t)(h * NBLK + r) * MD + 16 * ks + 8 * hh;
            acc = __builtin_amdgcn_mfma_f32_32x32x16_bf16(*(const bf16x8*)(KMH + ko), q, acc, 0, 0, 0); acc = __builtin_amdgcn_mfma_f32_32x32x16_bf16(*(const bf16x8*)(KML + ko), q, acc, 0, 0, 0); }
        float t0 = NEG, t1 = NEG, t2 = NEG;
#pragma unroll
        for (int e = 0; e < 16; ++e) { const int n = (e & 3) + 8 * (e >> 2) + 4 * hh; float ae = acc[e]; asm volatile("" : "+v"(ae));
            float x = __builtin_bit_cast(float, (__builtin_bit_cast(unsigned, ae) & ~31u) | (unsigned)(31 - n)); x = (n < blk) ? x : NEG;
            t2 = __builtin_amdgcn_fmed3f(t1, t2, x); t1 = __builtin_amdgcn_fmed3f(t0, t1, x); t0 = fmaxf(t0, x); }
        const float o0 = __shfl_xor(t0, 32), o1 = __shfl_xor(t1, 32), o2 = __shfl_xor(t2, 32);
        t2 = __builtin_amdgcn_fmed3f(t1, t2, o0); t1 = __builtin_amdgcn_fmed3f(t0, t1, o0); t0 = fmaxf(t0, o0);
        t2 = __builtin_amdgcn_fmed3f(t1, t2, o1); t1 = __builtin_amdgcn_fmed3f(t0, t1, o1); t0 = fmaxf(t0, o1);
        t2 = __builtin_amdgcn_fmed3f(t1, t2, o2); t1 = __builtin_amdgcn_fmed3f(t0, t1, o2); t0 = fmaxf(t0, o2);
        unsigned sel = 1u << (31 - (__builtin_bit_cast(unsigned, t0) & 31u));
        if (blk > 1) sel |= 1u << (31 - (__builtin_bit_cast(unsigned, t1) & 31u));
        if (blk > 2) sel |= 1u << (31 - (__builtin_bit_cast(unsigned, t2) & 31u));
        if (hh == 0) MASK[t * MH + h] = sel;
        { gu32* cnt = (gu32*)(ws + WS_CTL) + CW_CNT + h * 32; unsigned short* lst = (unsigned short*)(ws + WS_LIST) + (size_t)h * 32 * 8192; const unsigned mysel = hh == 0 ? sel : 0u;
          unsigned mycnt = 0u;
          for (int j = 0; j < blk; ++j) { const unsigned long long bal = __ballot((mysel >> j) & 1u); const unsigned c = (unsigned)__builtin_popcountll(bal); mycnt = (F.lane == j) ? c : mycnt; }
          unsigned base = 0u; if (F.lane < blk && mycnt) base = __hip_atomic_fetch_add(cnt + F.lane, mycnt, __ATOMIC_RELAXED, __HIP_MEMORY_SCOPE_AGENT);
          for (int j = 0; j < blk; ++j) { const unsigned long long bal = __ballot((mysel >> j) & 1u); const unsigned bj = (unsigned)__builtin_amdgcn_readlane((int)base, j);
              if ((mysel >> j) & 1u) { const unsigned off = __builtin_amdgcn_mbcnt_hi((unsigned)(bal >> 32), __builtin_amdgcn_mbcnt_lo((unsigned)bal, 0u)); const unsigned slot = (unsigned)__builtin_popcount(mysel & ((1u << j) - 1u));
                  lst[(size_t)j * 8192 + bj + off] = (unsigned short)((unsigned)t | (slot << 13)); } } } }
}

constexpr int CK = 64, NCHK = T / CK, CP = 144, CPF = 272;
constexpr int L_AT = 0, L_BT = 9216, L_KT = 18432, L_RT = 27648, L_ATT = 36864, L_BTT = 46080, L_V = 55296, L_MKA = 64512, L_MBRT = 73728, L_MKRT = 82944, L_A2 = 92160, L_MBA = 101376, L_PC = 118784, L_WT = 119040, L_MBH = 121088, L_TD = 130304, L_PT = 134912, L_CEND = 139520;
constexpr int L_TT = L_AT, L_A1 = L_BT, L_Y2T = L_MKA, L_G2T = L_ATT;
static_assert(L_CEND <= RING_BYTES, "chunk prep LDS");
constexpr size_t CHW_ITEM = 32768;
__device__ __forceinline__ f32x16 nt_quad(const LAS unsigned char* X, const LAS unsigned char* Y, int qp, int qq, int r, int hh) {
    f32x16 acc;
#pragma unroll
    for (int e = 0; e < 16; ++e) acc[e] = 0.f;
#pragma unroll
    for (int ks = 0; ks < 4; ++ks) { const bf16x8 a = *(const LAS bf16x8*)(Y + (32 * qq + r) * CP + 32 * ks + 16 * hh), b = *(const LAS bf16x8*)(X + (32 * qp + r) * CP + 32 * ks + 16 * hh);
        acc = __builtin_amdgcn_mfma_f32_32x32x16_bf16(a, b, acc, 0, 0, 0); }
    return acc;
}
__device__ __forceinline__ int nt_q(int qq, int e, int hh) { return 32 * qq + (e & 3) + 8 * (e >> 2) + 4 * hh; }
__device__ __forceinline__ void nt_store_bf16(LAS unsigned char* O, int p, int qq, int hh, const f32x16& v) {
#pragma unroll
    for (int g = 0; g < 4; ++g) { u32x2 w; w.x = pk2(v[4 * g], v[4 * g + 1]); w.y = pk2(v[4 * g + 2], v[4 * g + 3]); *(LAS u32x2*)(O + p * CP + (32 * qq + 8 * g + 4 * hh) * 2) = w; }
}
__device__ __forceinline__ void ph4_chunkprep(ArgsP A, Frame& F) {
    unsigned char* ws = A->ws;
    const float* DEC = (const float*)(ws + WS_DEC); const bf16_t* KKN = (const bf16_t*)(ws + WS_KKN); const bf16_t* BBg = (const bf16_t*)(ws + WS_BB); const bf16_t* KPg = (const bf16_t*)(ws + WS_KP);
    const bf16_t* ZR = (const bf16_t*)(ws + WS_ZR); const bf16_t* ZV = (const bf16_t*)(ws + WS_ZV); float* Yg = (float*)(ws + WS_Y); unsigned char* CHW = ws + WS_WIN;
    LAS unsigned char* L = F.lds + RING_OFF; const int wave = F.wave, lane = F.lane, r = lane & 31, hh = lane >> 5;
    const int prod = wave >> 2, qp = (wave >> 1) & 1, qq = wave & 1, p = 32 * qp + r;
    float nwv[8]; bf16_t nkk[8], nbb[8], nkp[8], nr[8], nv[8];
    if (F.vcu < RH * NCHK) { const int h2 = F.vcu / NCHK, c2 = F.vcu % NCHK;
#pragma unroll
        for (int k = 0; k < 8; ++k) { const size_t o = (size_t)(c2 * CK + 8 * wave + k) * RW + (size_t)h2 * RN + lane; nwv[k] = DEC[o]; nkk[k] = KKN[o]; nbb[k] = BBg[o]; nkp[k] = KPg[o]; nr[k] = ZR[o]; nv[k] = ZV[o]; } }
    if (F.vcu == 0 && wave == 0) {
        const gu32* cnt = (const gu32*)(ws + WS_CTL) + CW_CNT; unsigned* ud = (unsigned*)(ws + WS_UDESC); unsigned np[8], tot = 0u;
#pragma unroll
        for (int k = 0; k < 8; ++k) { const unsigned c = __hip_atomic_load(cnt + 8 * lane + k, __ATOMIC_RELAXED, __HIP_MEMORY_SCOPE_AGENT); np[k] = (c + 255u) >> 8; tot += np[k]; }
        unsigned incl = tot;
#pragma unroll
        for (int o = 1; o < 64; o <<= 1) { const unsigned v = __shfl_up(incl, o); if (lane >= o) incl += v; }
        unsigned pos = incl - tot;
#pragma unroll
        for (int k = 0; k < 8; ++k) for (unsigned ps = 0; ps < np[k]; ++ps) ud[1 + pos++] = (unsigned)(8 * lane + k) | (ps << 16);
        if (lane == 63) ud[0] = incl; }
    int qrow = F.vcu * NWAVES + wave; const int qstride = F.G * NWAVES; f32x4 qv[16];
    for (int item = F.vcu; item < RH * NCHK; item += F.G) { const int h = item / NCHK, c = item % NCHK; const size_t hc = (size_t)h * RN; const int t0 = c * CK;
        const bool qdo = qrow < 2 * 16384; if (qdo) pq_load(A, qrow, lane, qv);
        { float wv[8], kkv[8], bbv[8], kpv[8], rv[8]; bf16_t vv[8];
#pragma unroll
          for (int k = 0; k < 8; ++k) { wv[k] = nwv[k]; kkv[k] = bf1(nkk[k]); bbv[k] = bf1(nbb[k]); kpv[k] = bf1(nkp[k]); rv[k] = bf1(nr[k]); vv[k] = nv[k]; }
          { const int nit = item + F.G; if (nit < RH * NCHK) { const int h2 = nit / NCHK, c2 = nit % NCHK;
#pragma unroll
              for (int k = 0; k < 8; ++k) { const size_t o = (size_t)(c2 * CK + 8 * wave + k) * RW + (size_t)h2 * RN + lane; nwv[k] = DEC[o]; nkk[k] = KKN[o]; nbb[k] = BBg[o]; nkp[k] = KPg[o]; nr[k] = ZR[o]; nv[k] = ZV[o]; } } }
          float pl[8]; pl[0] = wv[0];
#pragma unroll
          for (int k = 1; k < 8; ++k) pl[k] = pl[k - 1] * wv[k];
          ((LAS float*)(L + L_WT))[wave * 64 + lane] = pl[7];
          WG_BAR();
          float pre = 1.f;
#pragma unroll
          for (int w2 = 0; w2 < 7; ++w2) { const float x = ((const LAS float*)(L + L_WT))[w2 * 64 + lane]; pre = (w2 < wave) ? pre * x : pre; }
          unsigned atp[4], btp[4], vtp[4];
#pragma unroll
          for (int k = 0; k < 8; ++k) { const float Pt = pre * pl[k], Pm = (k == 0) ? pre : pre * pl[k - 1], ip = __builtin_amdgcn_rcpf(Pt); const int t = 8 * wave + k;
              const unsigned a16 = f2bf(Pm * kkv[k]), b16 = f2bf(bbv[k] * ip), k16 = f2bf(kpv[k] * ip), r16 = f2bf(Pt * rv[k]);
              *(LAS bf16_t*)(L + L_AT + t * CP + 2 * lane) = (bf16_t)a16; *(LAS bf16_t*)(L + L_BT + t * CP + 2 * lane) = (bf16_t)b16; *(LAS bf16_t*)(L + L_KT + t * CP + 2 * lane) = (bf16_t)k16; *(LAS bf16_t*)(L + L_RT + t * CP + 2 * lane) = (bf16_t)r16;
              if (k & 1) { atp[k >> 1] |= a16 << 16; btp[k >> 1] |= b16 << 16; vtp[k >> 1] |= (unsigned)vv[k] << 16; } else { atp[k >> 1] = a16; btp[k >> 1] = b16; vtp[k >> 1] = (unsigned)vv[k]; }
              if (wave == 7 && k == 7) ((LAS float*)(L + L_PC))[lane] = Pt; }
          *(LAS u32x4*)(L + L_ATT + lane * CP + 16 * wave) = (u32x4){atp[0], atp[1], atp[2], atp[3]}; *(LAS u32x4*)(L + L_BTT + lane * CP + 16 * wave) = (u32x4){btp[0], btp[1], btp[2], btp[3]};
          *(LAS u32x4*)(L + L_V + lane * CP + 16 * wave) = (u32x4){vtp[0], vtp[1], vtp[2], vtp[3]}; }
        WG_BAR();
        { const f32x16 v = nt_quad(L + (prod ? L_KT : L_BT), L + L_AT, qp, qq, r, hh); f32x16 m;
#pragma unroll
          for (int e = 0; e < 16; ++e) m[e] = nt_q(qq, e, hh) > p ? v[e] : 0.f;
          if (prod == 0) {
#pragma unroll
              for (int g = 0; g < 4; ++g) *(LAS f32x4*)(L + L_MBA + p * CPF + (32 * qq + 8 * g + 4 * hh) * 4) = (f32x4){m[4 * g], m[4 * g + 1], m[4 * g + 2], m[4 * g + 3]}; }
          if (prod == 0) nt_store_bf16(L + L_MBH, p, qq, hh, m);
          else nt_store_bf16(L + L_MKA, p, qq, hh, m); }
        { const f32x16 v = nt_quad(L + L_RT, L + (prod ? L_KT : L_BT), qp, qq, r, hh); f32x16 m;
#pragma unroll
          for (int e = 0; e < 16; ++e) m[e] = nt_q(qq, e, hh) <= p ? v[e] : 0.f;
          nt_store_bf16(L + (prod ? L_MKRT : L_MBRT), p, qq, hh, m); }
        WG_BAR();
        { const int t = 8 * wave + (lane >> 3), g = lane & 7, base = 32 * (t >> 5); float T4[4] = {0.f, 0.f, 0.f, 0.f};
          const LAS unsigned char* mrow = L + L_MBA + (base + 4 * g) * 4;
          f32x4 m = *(const LAS f32x4*)(mrow + (base + 31) * CPF);
#pragma unroll 1
          for (int Sx = 7; Sx >= 0; --Sx) {
#pragma unroll
              for (int q = 3; q >= 0; --q) { const int sl = 4 * Sx + q, sr = base + sl, sn = sl > 0 ? sr - 1 : sr; const f32x4 n = *(const LAS f32x4*)(mrow + sn * CPF);
                  float part = (m[0] * T4[0] + m[1] * T4[1]) + (m[2] * T4[2] + m[3] * T4[3]);
                  part += dpp_f<0xB1>(part); part += dpp_f<0x4E>(part); part += dpp_f<0x141>(part);
                  const float val = (sr == t) ? 1.0f : part; T4[q] = (g == Sx) ? val : T4[q]; m = n; } }
          const unsigned w0 = pk2(T4[0], T4[1]), w1 = pk2(T4[2], T4[3]);
          *(LAS u32x2*)(L + L_TT + t * CP + (base + 4 * g) * 2) = (u32x2){w0, w1};
          if (base == 0) { *(LAS u32x2*)(L + L_TT + t * CP + (32 + 4 * g) * 2) = (u32x2){0u, 0u};
              *(LAS bf16_t*)(L + L_TD + (4 * g) * CP + 2 * t) = (bf16_t)(w0 & 0xffffu); *(LAS bf16_t*)(L + L_TD + (4 * g + 1) * CP + 2 * t) = (bf16_t)(w0 >> 16);
              *(LAS bf16_t*)(L + L_TD + (4 * g + 2) * CP + 2 * t) = (bf16_t)(w1 & 0xffffu); *(LAS bf16_t*)(L + L_TD + (4 * g + 3) * CP + 2 * t) = (bf16_t)(w1 >> 16); } }
        WG_BAR();
        if (wave == 0) {
            f32x16 acc;
#pragma unroll
            for (int e = 0; e < 16; ++e) acc[e] = 0.f;
#pragma unroll
            for (int ks = 0; ks < 2; ++ks) { const bf16x8 a = *(const LAS bf16x8*)(L + L_MBH + r * CP + 64 + 32 * ks + 16 * hh), b = *(const LAS bf16x8*)(L + L_TT + (32 + r) * CP + 64 + 32 * ks + 16 * hh);
                acc = __builtin_amdgcn_mfma_f32_32x32x16_bf16(a, b, acc, 0, 0, 0); }
            nt_store_bf16(L + L_PT, r, 0, hh, acc);
            LDS_WAIT(); asm volatile("" ::: "memory");
#pragma unroll
            for (int e = 0; e < 16; ++e) acc[e] = 0.f;
#pragma unroll
            for (int ks = 0; ks < 2; ++ks) { const bf16x8 a = *(const LAS bf16x8*)(L + L_TD + r * CP + 32 * ks + 16 * hh), b = *(const LAS bf16x8*)(L + L_PT + r * CP + 32 * ks + 16 * hh);
                acc = __builtin_amdgcn_mfma_f32_32x32x16_bf16(a, b, acc, 0, 0, 0); }
            nt_store_bf16(L + L_TT, 32 + r, 0, hh, acc);
        }
        WG_BAR();
        { const f32x16 v = nt_quad(L + (prod ? L_MKA : L_ATT), L + L_TT, qp, qq, r, hh);
          nt_store_bf16(L + (prod ? L_A2 : L_A1), p, qq, hh, v); }
        WG_BAR();
        unsigned char* cw = CHW + (size_t)item * CHW_ITEM;
        { const f32x16 v = nt_quad(L + L_MBRT, L + (prod ? L_A2 : L_A1), qp, qq, r, hh); f32x16 o;
          const LAS unsigned char* addm = L + (prod ? L_MKRT : L_RT);
#pragma unroll
          for (int g = 0; g < 4; ++g) { const u32x2 w = *(const LAS u32x2*)(addm + p * CP + (32 * qq + 8 * g + 4 * hh) * 2); o[4 * g] = v[4 * g] + bflo(w.x); o[4 * g + 1] = v[4 * g + 1] + bfhi(w.x); o[4 * g + 2] = v[4 * g + 2] + bflo(w.y); o[4 * g + 3] = v[4 * g + 3] + bfhi(w.y); }
          if (prod) nt_store_bf16(L + L_Y2T, p, qq, hh, o);
          else {
#pragma unroll
              for (int g = 0; g < 4; ++g) { u32x2 w; w.x = pk2(o[4 * g], o[4 * g + 1]); w.y = pk2(o[4 * g + 2], o[4 * g + 3]); *(u32x2*)(cw + (size_t)p * 128 + (32 * qq + 8 * g + 4 * hh) * 2) = w; } } }
        { const f32x16 v = nt_quad(L + L_BTT, L + (prod ? L_A2 : L_A1), qp, qq, r, hh); const float pc = ((const LAS float*)(L + L_PC))[p]; f32x16 o;
          if (prod) {
#pragma unroll
              for (int e = 0; e < 16; ++e) o[e] = (v[e] + bf1(*(const LAS bf16_t*)(L + L_KT + nt_q(qq, e, hh) * CP + 2 * p))) * pc;
              nt_store_bf16(L + L_G2T, p, qq, hh, o); }
          else {
#pragma unroll
              for (int e = 0; e < 16; ++e) o[e] = (v[e] + (nt_q(qq, e, hh) == p ? 1.0f : 0.0f)) * pc;
#pragma unroll
              for (int g = 0; g < 4; ++g) { u32x2 w; w.x = pk2(o[4 * g], o[4 * g + 1]); w.y = pk2(o[4 * g + 2], o[4 * g + 3]); *(u32x2*)(cw + 8192 + (size_t)p * 128 + (32 * qq + 8 * g + 4 * hh) * 2) = w; } } }
        WG_BAR();
        { const f32x16 v = prod ? nt_quad(L + L_V, L + L_G2T, qp, qq, r, hh) : nt_quad(L + L_Y2T, L + L_V, qp, qq, r, hh);
          float* dst = prod ? (float*)(cw + 16384) + (size_t)p * 64 : Yg + (size_t)(t0 + p) * RW + hc;
#pragma unroll
          for (int g = 0; g < 4; ++g) *(f32x4*)(dst + 32 * qq + 8 * g + 4 * hh) = (f32x4){v[4 * g], v[4 * g + 1], v[4 * g + 2], v[4 * g + 3]}; }
        if (qdo) { pq_finish(ws, qrow, lane, qv); qrow += qstride; }
        WG_BAR();
    }
    for (; qrow < 2 * 16384; qrow += qstride) { pq_load(A, qrow, lane, qv); pq_finish(ws, qrow, lane, qv); }
}
__device__ __forceinline__ void ph5_chain(ArgsP A, Frame& F, int h) {
    unsigned char* ws = A->ws; float* Yg = (float*)(ws + WS_Y); const unsigned char* CHW = ws + WS_WIN;
    LAS unsigned char* L = F.lds + RING_OFF; const int wave = F.wave, lane = F.lane, tid = F.tid, r = lane & 31, hh = lane >> 5;
    const int prod = wave >> 2, qp = (wave >> 1) & 1, qq = wave & 1, p = 32 * qp + r; const size_t hc = (size_t)h * RN;
    constexpr int L_S = 0, L_G = 2 * 9216, L_Y1 = 3 * 9216;
    for (int i = tid; i < 2 * 9216 / 4; i += NTHR) ((LAS unsigned*)(L + L_S))[i] = 0u;
    const int srow = tid >> 3, sc16 = tid & 7; u32x4 sg, sy;
    auto stage_ld = [&](int c) { const unsigned char* cw = CHW + (size_t)(h * NCHK + c) * CHW_ITEM; sy = *(const u32x4*)(cw + srow * 128 + sc16 * 16); sg = *(const u32x4*)(cw + 8192 + srow * 128 + sc16 * 16); };
    f32x4 nad[4];
    auto ad_ld = [&](int c) { const unsigned char* cw2 = CHW + (size_t)(h * NCHK + c) * CHW_ITEM; const float* addp = prod ? Yg + (size_t)(c * CK + p) * RW + hc : (const float*)(cw2 + 16384) + (size_t)p * 64;
#pragma unroll
        for (int g = 0; g < 4; ++g) nad[g] = *(const f32x4*)(addp + 32 * qq + 8 * g + 4 * hh); };
    stage_ld(0); ad_ld(0);
    int sb = 0;
    for (int c = 0; c < NCHK; ++c) {
        *(LAS u32x4*)(L + L_Y1 + srow * CP + sc16 * 16) = sy; *(LAS u32x4*)(L + L_G + srow * CP + sc16 * 16) = sg;
        const unsigned char* cw = CHW + (size_t)(h * NCHK + c) * CHW_ITEM;
        f32x4 ad[4];
#pragma unroll
        for (int g = 0; g < 4; ++g) ad[g] = nad[g];
        if (c + 1 < NCHK) { stage_ld(c + 1); ad_ld(c + 1); }
        WG_BAR();
        const f32x16 v = prod ? nt_quad(L + L_Y1, L + L_S + sb * 9216, qp, qq, r, hh) : nt_quad(L + L_S + sb * 9216, L + L_G, qp, qq, r, hh);
        f32x16 o;
#pragma unroll
        for (int g = 0; g < 4; ++g) { o[4 * g] = v[4 * g] + ad[g][0]; o[4 * g + 1] = v[4 * g + 1] + ad[g][1]; o[4 * g + 2] = v[4 * g + 2] + ad[g][2]; o[4 * g + 3] = v[4 * g + 3] + ad[g][3]; }
        if (prod) { float* yp = Yg + (size_t)(c * CK + p) * RW + hc;
#pragma unroll
            for (int g = 0; g < 4; ++g) *(f32x4*)(yp + 32 * qq + 8 * g + 4 * hh) = (f32x4){o[4 * g], o[4 * g + 1], o[4 * g + 2], o[4 * g + 3]}; }
        else nt_store_bf16(L + L_S + (sb ^ 1) * 9216, p, qq, hh, o);
        sb ^= 1;
        WG_BAR();
    }
}

__device__ __forceinline__ void ph5_ypost(ArgsP A, Frame& F) {
    unsigned char* ws = A->ws; const float* Y = (const float*)(ws + WS_Y); const bf16_t* ZR = (const bf16_t*)(ws + WS_ZR); const bf16_t* KP = (const bf16_t*)(ws + WS_KP); const bf16_t* ZV = (const bf16_t*)(ws + WS_ZV);
    const bf16_t* G = (const bf16_t*)(ws + WS_G); bf16_t* YA = (bf16_t*)(ws + WS_YA);
    const int gw = F.vcu * NWAVES + F.wave, NGW = F.G * NWAVES;
    for (int tg = F.vcu; tg < T / 32; tg += F.G) for (int it = F.wave; it < 256; it += NWAVES) { const int t = tg * 32 + (it >> 3), c = (it & 7) * 256 + 4 * F.lane; const size_t o = (size_t)t * RW + c;
        const f32x4 y = *(const f32x4*)(Y + o); const float mean = sum16((y[0] + y[1]) + (y[2] + y[3])) * (1.0f / 64.0f); const f32x4 d = y - mean;
        const float var = sum16((d[0] * d[0] + d[1] * d[1]) + (d[2] * d[2] + d[3] * d[3])) * (1.0f / 64.0f); const float rs = 1.0f / sqrtf(var + LNX_EPS);
        const f32x4 r = ld4bf(ZR + o), k = ld4bf(KP + o), v = ld4bf(ZV + o), g = ld4bf(G + o), rk = *(const f32x4*)(A->r_k + c), lg = *(const f32x4*)(A->lnx_g + c), lb = *(const f32x4*)(A->lnx_b + c);
        const f32x4 rkk = r * k * rk; const float bonus = sum16((rkk[0] + rkk[1]) + (rkk[2] + rkk[3]));
        st4bf(YA + o, (d * rs * lg + lb + bonus * v) * g); }
}

constexpr int AT_KB = 64 * 256, AT_VB = 128 * 128, AT_BUF = AT_KB + AT_VB;
static_assert(3 * AT_BUF <= RING_BYTES, "attention LDS");
__device__ __forceinline__ void ph5_attn(ArgsP A, Frame& F) {
    unsigned char* ws = A->ws; const bf16_t* PROJ = (const bf16_t*)(ws + WS_PROJ); const bf16_t* VT = (const bf16_t*)(ws + WS_VT);
    bf16_t* PO = (bf16_t*)(ws + WS_PARTO); float* PML = (float*)(ws + WS_PARTML); const unsigned short* LST = (const unsigned short*)(ws + WS_LIST); const unsigned* UD = (const unsigned*)(ws + WS_UDESC);
    LAS unsigned char* L = F.lds + RING_OFF; const int tid = F.tid, wave = F.wave, lane = F.lane, r = lane & 31, hh = lane >> 5;
    const float NEG = -__builtin_inff();
    gu32* qctr = (gu32*)(ws + WS_CTL) + CW_ATTNQ; const gu32* cntw = (const gu32*)(ws + WS_CTL) + CW_CNT; LAS int* qslot = (LAS int*)(F.lds + LDSCTL_OFF);
    const int nunit = MH * NBLK + (int)UD[0];
    for (;;) {
        if (tid == 0) qslot[0] = (int)__hip_atomic_fetch_add(qctr, 1u, __ATOMIC_RELAXED, __HIP_MEMORY_SCOPE_AGENT);
        WG_BAR(); const int u = __builtin_amdgcn_readfirstlane(qslot[0]); WG_BAR();
        if (u >= nunit) break;
        int h, kblk, qtok, slot; bool valid, wvalid; const bool typeA = u < MH * NBLK;
        if (typeA) { h = u & 15; kblk = u >> 4; qtok = kblk * MBLK + wave * 32 + r; slot = 3; valid = true; wvalid = true; }
        else { const unsigned d = UD[1 + u - MH * NBLK]; const int Lx = (int)(d & 0xffffu), ps = (int)(d >> 16); h = Lx >> 5; kblk = Lx & 31;
            const int cnt = (int)__hip_atomic_load(cntw + Lx, __ATOMIC_RELAXED, __HIP_MEMORY_SCOPE_AGENT), idx = ps * 256 + wave * 32 + r; valid = idx < cnt; wvalid = ps * 256 + wave * 32 < cnt;
            const unsigned e = LST[(size_t)Lx * 8192 + (valid ? idx : 0)]; qtok = (int)(e & 0x1fffu); slot = (int)(e >> 13); }
        h = __builtin_amdgcn_readfirstlane(h); kblk = __builtin_amdgcn_readfirstlane(kblk);
        bf16x8 qf[8];
#pragma unroll
        for (int ks = 0; ks < 8; ++ks) qf[ks] = *(const bf16x8*)(PROJ + (size_t)qtok * PLD + PC_MQ + h * MD + 16 * ks + 8 * hh);
        f32x16 o[4];
#pragma unroll
        for (int db = 0; db < 4; ++db)
#pragma unroll
            for (int e = 0; e < 16; ++e) o[db][e] = 0.f;
        float mrun = NEG, lrun = 0.f;
        constexpr int ntile = 4;
        const int krow_ = lane >> 4, kslot = lane & 15, vrow_ = lane >> 3, vslot = lane & 7;
        auto dma_tile = [&](int n, int b3) { const int tb = kblk * MBLK + n * 64; LAS unsigned char* B = L + b3 * AT_BUF;
#pragma unroll
            for (int i = 0; i < 2; ++i) { const int p = wave * 2 + i, row = 4 * p + krow_, c = kslot ^ (row & 15);
                __builtin_amdgcn_global_load_lds((const unsigned*)(PROJ + (size_t)(tb + row) * PLD + PC_MK + h * MD + 8 * c), (LAS unsigned*)(B + p * 1024), 16, 0, 0); }
#pragma unroll
            for (int i = 0; i < 2; ++i) { const int p = wave * 2 + i, row = 8 * p + vrow_, c = vslot ^ (row & 7);
                __builtin_amdgcn_global_load_lds((const unsigned*)(VT + (size_t)(h * MD + row) * T + tb + 8 * c), (LAS unsigned*)(B + AT_KB + p * 1024), 16, 0, 0); } };
        dma_tile(0, 0); dma_tile(1, 1);
        asm volatile("s_waitcnt vmcnt(4)" ::: "memory"); WG_BAR();
        int b3 = 0;
#pragma unroll 1
        for (int n = 0; n < ntile; ++n) {
            { const int bn = b3 >= 1 ? b3 - 1 : 2; if (n + 2 < ntile) dma_tile(n + 2, bn); }
            const bool need = typeA ? (n <= (wave >> 1)) : wvalid;
            if (need) {
                const LAS unsigned char* KB = L + b3 * AT_BUF; const LAS unsigned char* VB = KB + AT_KB;
                f32x16 s[2];
#pragma unroll
                for (int kb = 0; kb < 2; ++kb) {
#pragma unroll
                    for (int e = 0; e < 16; ++e) s[kb][e] = 0.f;
#pragma unroll
                    for (int ks = 0; ks < 8; ++ks) { const bf16x8 a = *(const LAS bf16x8*)(KB + (32 * kb + r) * 256 + (((2 * ks + hh) ^ (r & 15)) << 4)); s[kb] = __builtin_amdgcn_mfma_f32_32x32x16_bf16(a, qf[ks], s[kb], 0, 0, 0); } }
                if (typeA && 64 * n + 63 > wave * 32) { const int qrel = wave * 32 + r;
#pragma unroll
                    for (int kb = 0; kb < 2; ++kb)
#pragma unroll
                        for (int e = 0; e < 16; ++e) { const int krel = 64 * n + 32 * kb + (e & 3) + 8 * (e >> 2) + 4 * hh; if (krel > qrel) s[kb][e] = NEG; } }
                float mx = s[0][0];
#pragma unroll
                for (int kb = 0; kb < 2; ++kb)
#pragma unroll
                    for (int e = 0; e < 16; ++e) mx = fmaxf(mx, s[kb][e]);
                mx = fmaxf(mx, __shfl_xor(mx, 32));
                const float mnew = fmaxf(mrun, mx); const float alpha = __builtin_amdgcn_exp2f(mrun - mnew); mrun = mnew;
                float ps = 0.f;
#pragma unroll
                for (int kb = 0; kb < 2; ++kb)
#pragma unroll
                    for (int e = 0; e < 16; ++e) { const float p = __builtin_amdgcn_exp2f(s[kb][e] - mnew); s[kb][e] = p; ps += p; }
                lrun = lrun * alpha + ps;
                if (__ballot(alpha != 1.0f) != 0ull) {
#pragma unroll
                    for (int db = 0; db < 4; ++db)
#pragma unroll
                        for (int e = 0; e < 16; ++e) o[db][e] *= alpha; }
#pragma unroll
                for (int kb = 0; kb < 2; ++kb)
#pragma unroll
                    for (int st = 0; st < 2; ++st) { u32x4 pw; pw.x = pk2(s[kb][8 * st + 0], s[kb][8 * st + 1]); pw.y = pk2(s[kb][8 * st + 2], s[kb][8 * st + 3]); pw.z = pk2(s[kb][8 * st + 4], s[kb][8 * st + 5]); pw.w = pk2(s[kb][8 * st + 6], s[kb][8 * st + 7]);
                        const bf16x8 pf = __builtin_bit_cast(bf16x8, pw);
#pragma unroll
                        for (int db = 0; db < 4; ++db) { const LAS unsigned char* vrow = VB + (32 * db + r) * 128 + 8 * hh; const int c0 = 4 * kb + 2 * st; const u32x2 lo = *(const LAS u32x2*)(vrow + ((c0 ^ (r & 7)) << 4)), hi = *(const LAS u32x2*)(vrow + (((c0 + 1) ^ (r & 7)) << 4));
                            const bf16x8 vf = __builtin_bit_cast(bf16x8, (u32x4){lo.x, lo.y, hi.x, hi.y}); o[db] = __builtin_amdgcn_mfma_f32_32x32x16_bf16(vf, pf, o[db], 0, 0, 0); } }
            }
            if (n + 2 < ntile) asm volatile("s_waitcnt vmcnt(4)" ::: "memory"); else asm volatile("s_waitcnt vmcnt(0)" ::: "memory");
            b3 = b3 == 2 ? 0 : b3 + 1;
            WG_BAR();
        }
        if (valid) { const float ltot = lrun + __shfl_xor(lrun, 32); const float inv = 1.0f / ltot; const size_t pi = ((size_t)qtok * MH + h) * 4 + slot;
            bf16_t* op = PO + pi * MD;
#pragma unroll
            for (int db = 0; db < 4; ++db)
#pragma unroll
                for (int g = 0; g < 4; ++g) { u32x2 w; w.x = pk2(o[db][4 * g] * inv, o[db][4 * g + 1] * inv); w.y = pk2(o[db][4 * g + 2] * inv, o[db][4 * g + 3] * inv); *(u32x2*)(op + 32 * db + 8 * g + 4 * hh) = w; }
            if (hh == 0) *(f32x2*)(PML + pi * 2) = (f32x2){mrun, ltot}; }
        else { (void)__shfl_xor(lrun, 32); }
    }
}
__device__ __forceinline__ void ph6_merge(ArgsP A, Frame& F) {
    unsigned char* ws = A->ws; const bf16_t* PO = (const bf16_t*)(ws + WS_PARTO); const float* PML = (const float*)(ws + WS_PARTML); bf16_t* YB = (bf16_t*)(ws + WS_YB);
    const int gw = F.vcu * NWAVES + F.wave, NGW = F.G * NWAVES, hl = F.lane >> 5, dg = F.lane & 31;
    for (int it0 = gw * 4; it0 < T * 8; it0 += NGW * 4) {
        u32x2 ov[4][4]; f32x2 ml[4][4];
#pragma unroll
        for (int k = 0; k < 4; ++k) { const int it = it0 + k, t = it >> 3, h = 2 * (it & 7) + hl; const size_t pi = ((size_t)t * MH + h) * 4;
#pragma unroll
            for (int sl = 0; sl < 4; ++sl) { ov[k][sl] = *(const u32x2*)(PO + (pi + sl) * MD + 4 * dg); ml[k][sl] = *(const f32x2*)(PML + (pi + sl) * 2); } }
#pragma unroll
        for (int k = 0; k < 4; ++k) { const int it = it0 + k, t = it >> 3, h = 2 * (it & 7) + hl, blk = t >> 8, nsel = blk < 3 ? blk : 3;
            float mmax = ml[k][3][0];
#pragma unroll
            for (int sl = 0; sl < 3; ++sl) if (sl < nsel) mmax = fmaxf(mmax, ml[k][sl][0]);
            f32x4 acc = (f32x4){0.f, 0.f, 0.f, 0.f}; float wsum = 0.f;
#pragma unroll
            for (int sl = 0; sl < 4; ++sl) { if (sl == 3 || sl < nsel) { const float w = ml[k][sl][1] * __builtin_amdgcn_exp2f(ml[k][sl][0] - mmax); wsum += w;
                acc += w * (f32x4){bflo(ov[k][sl].x), bfhi(ov[k][sl].x), bflo(ov[k][sl].y), bfhi(ov[k][sl].y)}; } }
            const float inv = 1.0f / wsum; st4bf(YB + (size_t)t * RW + h * MD + 4 * dg, acc * inv); }
    }
}

__device__ __forceinline__ void ins16(float (&top)[16], float x) {
#pragma unroll
    for (int k = 15; k >= 1; --k) top[k] = __builtin_amdgcn_fmed3f(top[k - 1], top[k], x);
    top[0] = fmaxf(top[0], x);
}
__device__ __forceinline__ void ph10_select(ArgsP A, Frame& F) {
    unsigned char* ws = A->ws; const bf16_t* PQ = (const bf16_t*)(ws + WS_PQ); const bf16_t* SK = (const bf16_t*)(ws + WS_SUBK); int* IDX = (int*)(ws + WS_IDX); float* GW = (float*)(ws + WS_GW);
    const int gw = F.vcu * NWAVES + F.wave, NGW = F.G * NWAVES; const int r = F.lane & 31, hh = F.lane >> 5; const float NEG = -__builtin_inff();
    for (int it = gw; it < (T / 32) * PH_; it += NGW) { const int tg = it >> 3, h = it & 7, t = tg * 32 + r;
        float TA[16], TB[16];
        auto topk = [&](int p, float (&dst)[16]) {
            bf16x8 qf[8];
#pragma unroll
            for (int ks = 0; ks < 8; ++ks) qf[ks] = *(const bf16x8*)(PQ + (size_t)t * 2048 + (h * 2 + p) * PHALF + 16 * ks + 8 * hh);
            float top[16];
#pragma unroll
            for (int k = 0; k < 16; ++k) top[k] = NEG;
#pragma unroll 1
            for (int nb = 0; nb < 4; ++nb) { f32x16 acc;
#pragma unroll
                for (int e = 0; e < 16; ++e) acc[e] = 0.f;
#pragma unroll
                for (int ks = 0; ks < 8; ++ks) { const bf16x8 a = *(const bf16x8*)(SK + ((size_t)(h * 2 + p) * PNK + 32 * nb + r) * PHALF + 16 * ks + 8 * hh); acc = __builtin_amdgcn_mfma_f32_32x32x16_bf16(a, qf[ks], acc, 0, 0, 0); }
#pragma unroll
                for (int e = 0; e < 16; ++e) { const unsigned key = 32 * nb + (e & 3) + 8 * (e >> 2) + 4 * hh; float ae = acc[e]; asm volatile("" : "+v"(ae));
                    const float x = __builtin_bit_cast(float, (__builtin_bit_cast(unsigned, ae) & ~0x7Fu) | key); ins16(top, x); } }
            float oth[16];
#pragma unroll
            for (int k = 0; k < 16; ++k) oth[k] = __shfl_xor(top[k], 32);
#pragma unroll
            for (int k = 0; k < 16; ++k) ins16(top, oth[k]);
#pragma unroll
            for (int k = 0; k < 16; ++k) dst[k] = top[k];
        };
        topk(0, TA); asm volatile("" ::: "memory"); __builtin_amdgcn_sched_barrier(0); topk(1, TB); asm volatile("" ::: "memory"); __builtin_amdgcn_sched_barrier(0);
        float fin[16];
#pragma unroll
        for (int k = 0; k < 16; ++k) fin[k] = NEG;
#pragma unroll
        for (int i = 0; i < 16; ++i)
#pragma unroll
            for (int j = 0; j < 16; ++j) if ((i + 1) * (j + 1) <= 16) { const float sm = TA[i] + TB[j]; ins16(fin, __builtin_bit_cast(float, (__builtin_bit_cast(unsigned, sm) & ~0xFFu) | (unsigned)(i * 16 + j))); }
        float e[16], den = 0.f;
#pragma unroll
        for (int k = 0; k < 16; ++k) { e[k] = __expf(fin[k] - fin[0]); den += e[k]; }
        const float rden = 1.0f / den;
        int oi[8]; float og[8];
#pragma unroll
        for (int kk = 0; kk < 8; ++kk) { const float fv = hh ? fin[8 + kk] : fin[kk]; og[kk] = (hh ? e[8 + kk] : e[kk]) * rden; const unsigned id = __builtin_bit_cast(unsigned, fv) & 0xFFu; const unsigned ci = id >> 4, cj = id & 15u;
            unsigned ia = 0u, ib = 0u;
#pragma unroll
            for (int q = 0; q < 16; ++q) { ia = (ci == (unsigned)q) ? (__builtin_bit_cast(unsigned, TA[q]) & 0x7Fu) : ia; ib = (cj == (unsigned)q) ? (__builtin_bit_cast(unsigned, TB[q]) & 0x7Fu) : ib; }
            oi[kk] = (int)(ia * PNK + ib); }
        int* ip = IDX + (size_t)t * 128 + h * 16 + 8 * hh; float* gp = GW + (size_t)t * 128 + h * 16 + 8 * hh;
        *(u32x4*)ip = (u32x4){(unsigned)oi[0], (unsigned)oi[1], (unsigned)oi[2], (unsigned)oi[3]}; *(u32x4*)(ip + 4) = (u32x4){(unsigned)oi[4], (unsigned)oi[5], (unsigned)oi[6], (unsigned)oi[7]};
        *(f32x4*)gp = (f32x4){og[0], og[1], og[2], og[3]}; *(f32x4*)(gp + 4) = (f32x4){og[4], og[5], og[6], og[7]};
    }
}


__device__ __forceinline__ float ub0(unsigned w) { return (float)(w & 0xffu); }
__device__ __forceinline__ float ub1(unsigned w) { return (float)((w >> 8) & 0xffu); }
__device__ __forceinline__ float ub2(unsigned w) { return (float)((w >> 16) & 0xffu); }
__device__ __forceinline__ float ub3(unsigned w) { return (float)(w >> 24); }
__device__ __forceinline__ float dot16q(u32x4 q, const float (&h)[16]) {
    return ((ub0(q.x) * h[0] + ub1(q.x) * h[1]) + (ub2(q.x) * h[2] + ub3(q.x) * h[3])) + ((ub0(q.y) * h[4] + ub1(q.y) * h[5]) + (ub2(q.y) * h[6] + ub3(q.y) * h[7]))
         + ((ub0(q.z) * h[8] + ub1(q.z) * h[9]) + (ub2(q.z) * h[10] + ub3(q.z) * h[11])) + ((ub0(q.w) * h[12] + ub1(q.w) * h[13]) + (ub2(q.w) * h[14] + ub3(q.w) * h[15]));
}
__device__ __forceinline__ void ph11_gather(ArgsP A, Frame& F) {
    unsigned char* ws = A->ws; const bf16_t* H2 = (const bf16_t*)(ws + WS_H2); const unsigned char* PU = (const unsigned char*)(ws + WS_PU); const unsigned char* PV = (const unsigned char*)(ws + WS_PV);
    const float* PSU = (const float*)(ws + WS_PSU); const float* PSV = (const float*)(ws + WS_PSV);
    const int* IDX = (const int*)(ws + WS_IDX); const float* GW = (const float*)(ws + WS_GW); const float* X1 = (const float*)(ws + WS_X1);
    LAS float* coef = (LAS float*)(F.lds + RING_OFF); LAS int* eidx = (LAS int*)(F.lds + RING_OFF + 1024); LAS float* red = (LAS float*)(F.lds + RING_OFF + 2048);
    const int tid = F.tid, wave = F.wave, lane = F.lane; int par = 0;
    for (int t = F.vcu; t < T; t += F.G, par ^= 1) {
        float hv[4][16]; float hs = 0.f;
#pragma unroll
        for (int i = 0; i < 4; ++i) { const bf16_t* hp = H2 + (size_t)t * D + i * 1024 + lane * 16; f32x4 a, b, c, d; pg8::unpack8(*(const u32x4*)hp, a, b); pg8::unpack8(*(const u32x4*)(hp + 8), c, d);
#pragma unroll
            for (int e = 0; e < 4; ++e) { hv[i][e] = a[e]; hv[i][4 + e] = b[e]; hv[i][8 + e] = c[e]; hv[i][12 + e] = d[e]; }
            hs += ((a[0] + a[1]) + (a[2] + a[3])) + ((b[0] + b[1]) + (b[2] + b[3])) + ((c[0] + c[1]) + (c[2] + c[3])) + ((d[0] + d[1]) + (d[2] + d[3])); }
        hs = wave_sum(hs);
        const int myidx = (lane < 16) ? IDX[(size_t)t * 128 + wave * 16 + lane] : 0; const float myg = (lane < 16) ? GW[(size_t)t * 128 + wave * 16 + lane] : 0.f;
        float dots = 0.f;
#pragma unroll 1
        for (int k = 0; k < 16; k += 4) {
            u32x4 q[4][4];
#pragma unroll
            for (int x = 0; x < 4; ++x) { const int e = __builtin_amdgcn_readlane(myidx, k + x); const unsigned char* up = PU + (size_t)e * D + lane * 16;
#pragma unroll
                for (int i = 0; i < 4; ++i) q[x][i] = *(const u32x4*)(up + i * 1024); }
#pragma unroll
            for (int x = 0; x < 4; ++x) { float d = 0.f;
#pragma unroll
                for (int i = 0; i < 4; ++i) d += dot16q(q[x][i], hv[i]);
                d = wave_sum(d); if (lane == k + x) dots = d; }
        }
        if (lane < 16) { const float s = PSU[myidx] * (dots - 128.0f * hs); const float act = 0.5f * s * (1.0f + erff(s * 0.70710678118654752f));
            coef[par * 128 + wave * 16 + lane] = myg * act * PSV[myidx]; eidx[par * 128 + wave * 16 + lane] = myidx; }
        WG_BAR();
        float acc[8]; float csum = 0.f;
#pragma unroll
        for (int i = 0; i < 8; ++i) acc[i] = 0.f;
#pragma unroll 1
        for (int e = 0; e < 128; e += 16) { u32x2 v[16]; float c[16];
#pragma unroll
            for (int q = 0; q < 16; ++q) { const int ei = __builtin_amdgcn_readfirstlane(eidx[par * 128 + e + q]); c[q] = coef[par * 128 + e + q]; v[q] = *(const u32x2*)(PV + (size_t)ei * D + tid * 8); }
#pragma unroll
            for (int q = 0; q < 16; ++q) { csum += c[q]; acc[0] += c[q] * ub0(v[q].x); acc[1] += c[q] * ub1(v[q].x); acc[2] += c[q] * ub2(v[q].x); acc[3] += c[q] * ub3(v[q].x); acc[4] += c[q] * ub0(v[q].y); acc[5] += c[q] * ub1(v[q].y); acc[6] += c[q] * ub2(v[q].y); acc[7] += c[q] * ub3(v[q].y); } }
        const float corr = -128.0f * csum;
        const f32x4 x0 = *(const f32x4*)(X1 + (size_t)t * D + tid * 8), x1 = *(const f32x4*)(X1 + (size_t)t * D + tid * 8 + 4);
        f32x4 y0 = x0 + ((f32x4){acc[0], acc[1], acc[2], acc[3]} + corr), y1 = x1 + ((f32x4){acc[4], acc[5], acc[6], acc[7]} + corr);
        float ss = (y0[0] * y0[0] + y0[1] * y0[1]) + (y0[2] * y0[2] + y0[3] * y0[3]) + (y1[0] * y1[0] + y1[1] * y1[1]) + (y1[2] * y1[2] + y1[3] * y1[3]);
        ss = wave_sum(ss); if (lane == 0) red[par * 8 + wave] = ss;
        WG_BAR();
        float tot = 0.f;
#pragma unroll
        for (int w = 0; w < 8; ++w) tot += red[par * 8 + w];
        const float rs = 1.0f / sqrtf(tot * (1.0f / D) + NORM_EPS);
        const f32x4 g0 = *(const f32x4*)(A->final_g + tid * 8), g1 = *(const f32x4*)(A->final_g + tid * 8 + 4);
        *(f32x4*)(A->out + (size_t)t * D + tid * 8) = y0 * rs * g0; *(f32x4*)(A->out + (size_t)t * D + tid * 8 + 4) = y1 * rs * g1;
    }
}

constexpr int NPH = 13;
__device__ __forceinline__ Frame make_frame(unsigned char* lds) {
    Frame F; int t = threadIdx.x; asm volatile("" : "+v"(t));
    F.lds = (LAS unsigned char*)lds; F.tid = t; F.lane = t & 63; F.wave = __builtin_amdgcn_readfirstlane(t >> 6);
    F.G = gridDim.x; { const int bx = blockIdx.x; F.vcu = (F.G % 8 == 0) ? (bx % 8) * (F.G / 8) + bx / 8 : bx; }
    return F;
}
__global__ void __launch_bounds__(NTHR, 2) mk_fwd(Args args_by_value) {
    extern __shared__ __attribute__((aligned(16))) unsigned char lds[];
    ArgsP args = get_args();
    gu32* ctl = (gu32*)(args->ws + WS_CTL);
    for (int u = threadIdx.x; u < (LDS_BYTES - LDSCTL_OFF) / 4; u += NTHR) ((LAS unsigned*)((LAS unsigned char*)lds + LDSCTL_OFF))[u] = 0u;
    __syncthreads();
    const int lo = args->ph_lo, hi = args->ph_hi;
    volatile LAS unsigned* MISC = (volatile LAS unsigned*)((LAS unsigned char*)lds + MISC_OFF);
    XcdBarrier bar; bar.bar = (unsigned*)(ctl + CW_BAR) + args->li * XCD_BAR_WORDS; bar.x = 0; bar.st = nullptr;
    if (hi - lo > 1) bar = xcd_barrier_post((unsigned*)(ctl + CW_BAR) + args->li * XCD_BAR_WORDS, MISC + 8);
#define IN(k) (lo <= (k) && (k) < hi)
#define SEAM(k) do { if (IN(k) && IN((k) + 1)) xcd_barrier(bar); } while (0)
    const int bid = (int)blockIdx.x;

    if (IN(0)) { Frame F = make_frame(lds); ph0_prologue(get_args(), F); SEAM(0); }
    if (IN(1)) { Frame F = make_frame(lds); LAS unsigned char* ring = F.lds + RING_OFF; ArgsP a_ = get_args(); unsigned char* ws = a_->ws;
        { pg8::Gemm g{(const bf16_t*)(ws + WS_XN), (const bf16_t*)(ws + WS_WIN), T, PLD, D}; pg8::StaticOrder S; S.init(T, PLD, F.G, bid);
          pg8::EpiProj E{(bf16_t*)(ws + WS_PROJ), (const float*)(ws + WS_ROPE)}; pg8::gemm_phase<pg8::EpiProj, pg8::StaticOrder, true, true>(ring, g, S, E); }
        { pg8::Gemm g{(const bf16_t*)(ws + WS_XN), (const bf16_t*)(ws + WS_WIN) + (size_t)PC_MV * D, T, 2048, D}; pg8::StaticOrder S; S.init(T, 2048, F.G, bid);
          pg8::EpiVT E{(bf16_t*)(ws + WS_VT)}; pg8::gemm_phase<pg8::EpiVT, pg8::StaticOrder, true, true>(ring, g, S, E); }
        SEAM(1); }
    if (IN(2)) { Frame F = make_frame(lds); ph2_prep(get_args(), F); SEAM(2); }
    if (IN(3)) { Frame F = make_frame(lds); LAS unsigned char* ring = F.lds + RING_OFF; ArgsP a_ = get_args(); unsigned char* ws = a_->ws;
        { pg8::Gemm g{(const bf16_t*)(ws + WS_AW), (const bf16_t*)(ws + WS_WUP), T, RW, LW}; pg8::StaticOrder S; S.init(T, RW, F.G, bid);
          pg8::EpiDec E{(float*)(ws + WS_DEC), a_->w0}; pg8::gemm_phase<pg8::EpiDec, pg8::StaticOrder, true, true>(ring, g, S, E); }
        asm volatile("" ::: "memory"); __builtin_amdgcn_sched_barrier(0);
        { pg8::Gemm g{(const bf16_t*)(ws + WS_AA), (const bf16_t*)(ws + WS_AUP), T, RW, LA}; pg8::StaticOrder S; S.init(T, RW, F.G, bid);
          pg8::EpiA E{(bf16_t*)(ws + WS_KP), (bf16_t*)(ws + WS_BB), (const bf16_t*)(ws + WS_KKN), a_->a0, a_->k_a}; pg8::gemm_phase<pg8::EpiA, pg8::StaticOrder, true, true>(ring, g, S, E); }
        asm volatile("" ::: "memory"); __builtin_amdgcn_sched_barrier(0);
        { pg8::Gemm g{(const bf16_t*)(ws + WS_AG), (const bf16_t*)(ws + WS_GUP), T, RW, LGP}; pg8::StaticOrder S; S.init(T, RW, F.G, bid);
          pg8::EpiBf16 E{(bf16_t*)(ws + WS_G), RW}; pg8::gemm_phase<pg8::EpiBf16, pg8::StaticOrder, true, true>(ring, g, S, E); }
        { Frame F2 = make_frame(lds); ph3_gate(get_args(), F2); }
        SEAM(3); }
    if (IN(4)) { Frame F = make_frame(lds); ph4_chunkprep(get_args(), F); SEAM(4); }
    if (IN(5)) {
        { Frame F = make_frame(lds); if (F.vcu < RH) ph5_chain(get_args(), F, F.vcu); }
        { Frame F = make_frame(lds); ph5_attn(get_args(), F); }
        { Frame F = make_frame(lds); const int gw = F.vcu * NWAVES + F.wave, NGW = F.G * NWAVES; ArgsP a2 = get_args();
          late_weights(a2, F, gw, NGW); }
        SEAM(5); }
    if (IN(6)) { { Frame F = make_frame(lds); ph6_merge(get_args(), F); } { Frame F = make_frame(lds); ph5_ypost(get_args(), F); } SEAM(6); }
    if (IN(7)) { Frame F = make_frame(lds); LAS unsigned char* ring = F.lds + RING_OFF; ArgsP a_ = get_args(); unsigned char* ws = a_->ws;
        { pg8::Gemm g{(const bf16_t*)(ws + WS_YA), (const bf16_t*)(ws + WS_WA), T, D, RW}; pg8::StaticOrder S; S.init(T, D, F.G, bid);
          pg8::EpiMix<false> E{(bf16_t*)(ws + WS_MIXED), (const bf16_t*)(ws + WS_PROJ), PC_GA}; pg8::gemm_phase<pg8::EpiMix<false>, pg8::StaticOrder, true, true>(ring, g, S, E); }
        { pg8::Gemm g{(const bf16_t*)(ws + WS_YB), (const bf16_t*)(ws + WS_WB), T, D, RW}; pg8::StaticOrder S; S.init(T, D, F.G, bid);
          pg8::EpiMix<true> E{(bf16_t*)(ws + WS_MIXED), (const bf16_t*)(ws + WS_PROJ), PC_GB}; pg8::gemm_phase<pg8::EpiMix<true>, pg8::StaticOrder, true, true>(ring, g, S, E); }
        SEAM(7); }
    if (IN(8)) { Frame F = make_frame(lds); LAS unsigned char* ring = F.lds + RING_OFF; ArgsP a_ = get_args(); unsigned char* ws = a_->ws;
        pg8::Gemm g{(const bf16_t*)(ws + WS_MIXED), (const bf16_t*)(ws + WS_WOUT), T, D, D}; pg8::StaticOrder S; S.init(T, D, F.G, bid);
        pg8::EpiRes E{(float*)(ws + WS_X1), a_->x}; pg8::gemm_phase<pg8::EpiRes, pg8::StaticOrder, true, true>(ring, g, S, E);
        SEAM(8); }
    if (IN(9)) { Frame F = make_frame(lds); ArgsP a_ = get_args(); unsigned char* ws = a_->ws; const int gw = F.vcu * NWAVES + F.wave, NGW = F.G * NWAVES;
        rms_rows_to_bf16((const float*)(ws + WS_X1), a_->norm2_g, (bf16_t*)(ws + WS_H2), gw, NGW, F.lane);
        SEAM(9); }
    if (IN(10)) { Frame F = make_frame(lds); LAS unsigned char* ring = F.lds + RING_OFF; ArgsP a_ = get_args(); unsigned char* ws = a_->ws;
        pg8::Gemm g{(const bf16_t*)(ws + WS_H2), (const bf16_t*)(ws + WS_WQ), T, 2048, D}; pg8::StaticOrder S; S.init(T, 2048, F.G, bid);
        pg8::EpiBf16 E{(bf16_t*)(ws + WS_PQ), 2048}; pg8::gemm_phase<pg8::EpiBf16, pg8::StaticOrder, true, true>(ring, g, S, E);
        SEAM(10); }
    if (IN(11)) { Frame F = make_frame(lds); ph10_select(get_args(), F); SEAM(11); }
    if (IN(12)) { Frame F = make_frame(lds); ph11_gather(get_args(), F); }
#undef IN
#undef SEAM
}

extern "C" void kernel_launch(void* const* d_in, const int* in_sizes, int n_in, void* d_out, int out_size, void* d_ws, size_t ws_size, hipStream_t stream) {
    static int grid = 0;
    if (grid == 0) {
        if (n_in != 23 || out_size != T * D || ws_size < WS_END) { fprintf(stderr, "kernel_launch: unexpected shapes (n_in %d out %d ws %zu); nothing launched\n", n_in, out_size, ws_size); grid = -1; return; }
        int dev = 0, cus = 0, per_cu = 0;
        if (hipGetDevice(&dev) != hipSuccess || hipDeviceGetAttribute(&cus, hipDeviceAttributeMultiprocessorCount, dev) != hipSuccess) { grid = -1; return; }
        if (hipFuncSetAttribute((const void*)mk_fwd, hipFuncAttributeMaxDynamicSharedMemorySize, LDS_BYTES) != hipSuccess) { grid = -1; return; }
        if (hipOccupancyMaxActiveBlocksPerMultiprocessor(&per_cu, (const void*)mk_fwd, NTHR, LDS_BYTES) != hipSuccess || per_cu < 1) fprintf(stderr, "kernel_launch: occupancy query reports %d\n", per_cu);
        (void)hipGetLastError();
        grid = cus;
    }
    if (grid < 0) return;
    (void)hipMemsetAsync((char*)d_ws + WS_CTL, 0, CTL_ZERO_BYTES, stream);
    Args a{};
    const float** ap = (const float**)&a;
    for (int i = 0; i < 23; ++i) ap[i] = (const float*)d_in[i];
    a.out = (float*)d_out; a.ws = (unsigned char*)d_ws; a.pad = 0;
    constexpr int NL = MK_N_LAUNCHES;
    for (int li = 0; li < NL; ++li) {
        a.ph_lo = (NL == 1) ? 0 : li; a.ph_hi = (NL == 1) ? NPH : li + 1; a.li = (NL == 1) ? 0 : 0;
        hipLaunchKernelGGL(mk_fwd, dim3(grid), dim3(NTHR), LDS_BYTES, stream, a);
#ifdef DUP_HI
        if (NL > 1 && li == DUP_HI) for (int l2 = DUP_LO; l2 <= DUP_HI; ++l2) { a.ph_lo = l2; a.ph_hi = l2 + 1; hipLaunchKernelGGL(mk_fwd, dim3(grid), dim3(NTHR), LDS_BYTES, stream, a); }
#endif
    }
}
```

```cpp
#include <hip/hip_runtime.h>
#include <cstdio>
#include <cstdint>

#ifndef MK_N_LAUNCHES
#define MK_N_LAUNCHES 1
#endif

#define GAS __attribute__((address_space(1)))
#define LAS __attribute__((address_space(3)))
typedef unsigned short bf16_t;
typedef __bf16 bf16x8 __attribute__((ext_vector_type(8)));
typedef float f32x2 __attribute__((ext_vector_type(2)));
typedef float f32x4 __attribute__((ext_vector_type(4)));
typedef float f32x16 __attribute__((ext_vector_type(16)));
typedef unsigned u32x2 __attribute__((ext_vector_type(2)));
typedef unsigned u32x4 __attribute__((ext_vector_type(4)));
typedef GAS unsigned gu32;

constexpr int T = 8192, D = 4096;
constexpr int RW = 2048, RH = 32, RN = 64;
constexpr int LW = 128, LA = 128, LG = 480, LGP = 512;
constexpr int SHIFTW = 6880;
constexpr int MH = 16, MD = 128, MBLK = 256, NBLK = 32;
constexpr int INW = 21216;
constexpr int PLD = 19200;
constexpr int PC_R = 0, PC_K = 2048, PC_V = 4096, PC_WL = 6144, PC_AL = 6272, PC_GL = 6400, PC_MQ = 6912, PC_MK = 8960, PC_GA = 11008, PC_GB = 15104, PC_MV = 19200;
constexpr int WIN_ROWS = 21248;
constexpr int PQ_SPLIT = 16384;
constexpr int PH_ = 8, PNK = 128, PQD = 256, PHALF = 128, PTOPK = 16;
constexpr float NORM_EPS = 1e-6f, LNX_EPS = 64e-5f;
constexpr float QSCALE = 0.08838834764831845f * 1.4426950408889634f;

constexpr size_t MiB = 1u << 20;
constexpr size_t WS_CTL = 0, CTL_ZERO_BYTES = 1 * MiB;
constexpr size_t WS_WIN = 1 * MiB;
constexpr size_t WS_X1 = 1 * MiB, WS_PQ = 129 * MiB;
constexpr size_t WS_WA = 167 * MiB, WS_WB = 183 * MiB, WS_WOUT = 199 * MiB, WS_WQ = 231 * MiB, WS_WUP = 247 * MiB, WS_AUP = 248 * MiB, WS_GUP = 249 * MiB, WS_SUBK = 251 * MiB;
constexpr size_t WS_PU = 252 * MiB, WS_PV = 380 * MiB;
constexpr size_t WS_XN = 508 * MiB;
constexpr size_t WS_Y = 508 * MiB, WS_H2 = 508 * MiB;
constexpr size_t WS_PROJ = 572 * MiB;
constexpr size_t WS_VT = 872 * MiB;
constexpr size_t WS_ROPE = 904 * MiB, WS_KMEAN = 908 * MiB, WS_MASK = 909 * MiB, WS_AW = 910 * MiB, WS_AA = 912 * MiB, WS_AG = 914 * MiB;
constexpr size_t WS_PSU = 909 * MiB + 512 * 1024, WS_PSV = WS_PSU + 64 * 1024;
constexpr size_t WS_DEC = 922 * MiB;
constexpr size_t WS_MIXED = 922 * MiB;
constexpr size_t WS_KKN = 986 * MiB, WS_BB = 1018 * MiB, WS_KP = 1050 * MiB, WS_ZR = 1082 * MiB, WS_ZV = 1114 * MiB, WS_G = 1146 * MiB;
constexpr size_t WS_YA = 1178 * MiB, WS_YB = 1210 * MiB, WS_IDX = 1242 * MiB, WS_GW = 1246 * MiB, WS_PARTML = 1250 * MiB, WS_LIST = 1254 * MiB, WS_UDESC = 1262 * MiB, WS_KB = 1267 * MiB, WS_END = 1299 * MiB;
constexpr size_t WS_PARTO = 922 * MiB;

constexpr int CW_TMO = 0, CW_CODE = 1, CW_ATTNQ = 64, CW_CNT = 1024, CW_BAR = 4096;

constexpr int RING_OFF = 0, RING_BYTES = 155648;
constexpr int LDSCTL_OFF = RING_BYTES, MISC_OFF = LDSCTL_OFF + 320;
constexpr int LDS_BYTES = 163840;
constexpr int NWAVES = 8, NTHR = 512;

__device__ __forceinline__ unsigned f2bf(float f) { unsigned u = __builtin_bit_cast(unsigned, f); return (u + 0x7fffu + ((u >> 16) & 1u)) >> 16; }
typedef __bf16 bf16x2 __attribute__((ext_vector_type(2)));
__device__ __forceinline__ unsigned pk2(float lo, float hi) { const f32x2 v = {lo, hi}; return __builtin_bit_cast(unsigned, __builtin_convertvector(v, bf16x2)); }
__device__ __forceinline__ float bflo(unsigned u) { return __builtin_bit_cast(float, u << 16); }
__device__ __forceinline__ float bfhi(unsigned u) { return __builtin_bit_cast(float, u & 0xffff0000u); }
__device__ __forceinline__ float bf1(bf16_t b) { return __builtin_bit_cast(float, (unsigned)b << 16); }
__device__ __forceinline__ float fsigmoid(float x) { return __builtin_amdgcn_rcpf(1.0f + __expf(-x)); }
__device__ __forceinline__ float wave_sum(float v) {
#pragma unroll
    for (int o = 1; o < 64; o <<= 1) v += __shfl_xor(v, o);
    return v;
}
template <int CTRL> __device__ __forceinline__ float dpp_f(float v) { return __builtin_bit_cast(float, __builtin_amdgcn_update_dpp(0, __builtin_bit_cast(int, v), CTRL, 0xF, 0xF, true)); }
__device__ __forceinline__ float sum16(float x) {
    x += dpp_f<0xB1>(x); x += dpp_f<0x4E>(x); x += dpp_f<0x141>(x); x += dpp_f<0x140>(x); return x;
}
__device__ __forceinline__ float vmul(float a, float b) { float r; asm("v_mul_f32_e32 %0, %1, %2" : "=v"(r) : "v"(a), "v"(b)); return r; }
__device__ __forceinline__ float vfma(float a, float b, float c) { float r; asm("v_fma_f32 %0, %1, %2, %3" : "=v"(r) : "v"(a), "v"(b), "v"(c)); return r; }
#define LDS_WAIT() asm volatile("s_waitcnt lgkmcnt(0)" ::: "memory")
#define VM_WAIT() asm volatile("s_waitcnt vmcnt(0)" ::: "memory")
#define WG_BAR() do { asm volatile("s_waitcnt lgkmcnt(0)" ::: "memory"); __builtin_amdgcn_s_barrier(); asm volatile("" ::: "memory"); } while (0)

namespace pg8 {
constexpr int BM = 256, BK = 64, HALF = 128, HTB = HALF * BK * 2, STAGE_BYTES = 8 * HTB, NXCD = 8, WGM = 8;
__host__ __device__ __forceinline__ int lds_byte(int r, int c) { const int st = (r >> 4) * 2 + (c >> 5), rr = r & 15, cc = c & 31, ob = rr * 64 + cc * 2; return st * 1024 + (ob ^ (((ob >> 9) & 1) << 5)); }
__host__ __device__ __forceinline__ void stage_rc(int b, int& R, int& C) { const int st = b / 1024, sb = b % 1024, swz = sb ^ (((sb >> 9) & 1) << 5); R = (st >> 1) * 16 + swz / 64; C = (st & 1) * 32 + (swz % 64) / 2; }
__host__ __device__ __forceinline__ int perm32(int rho) { const int n = rho >> 4, i = rho & 15; return 8 * (i >> 2) + 4 * n + (i & 3); }

struct Unit { int pm, pn; };
struct Gemm { const bf16_t* A; const bf16_t* Bt; int M, N, K; };

struct StaticOrder {
    int nM, nN, nwg, G, c;
    __host__ __device__ void init(int M, int N, int G_, int c_) { nM = M / BM; nN = N / BM; nwg = nM * nN; G = G_; c = c_; }
    __host__ __device__ bool next(int i, Unit& u) const {
        const long L = (long)i * G + c; if (L >= nwg) return false;
        int wgid = (int)L; { const int q = nwg / NXCD, r = nwg % NXCD, xcd = wgid % NXCD, off = wgid / NXCD; wgid = (xcd < r ? xcd * (q + 1) : r * (q + 1) + (xcd - r) * q) + off; }
        const int nig = WGM * nN, gid = wgid / nig, fm = gid * WGM, gsz = (nM - fm) < WGM ? (nM - fm) : WGM;
        u.pm = fm + ((wgid % nig) % gsz); u.pn = (wgid % nig) / gsz; return true;
    }
    __device__ __forceinline__ void a_ready(const Unit&) const {}
    __device__ __forceinline__ void done(const Unit&) const {}
};

template <class Epi, class Sched, bool ALIGN_EPI = false, bool SP2 = false>
__device__ __forceinline__ void gemm_phase(LAS unsigned char* lds, const Gemm g, const Sched& S, const Epi& E) {
    int tid_ = threadIdx.x; asm volatile("" : "+v"(tid_));
    const int tid = tid_, wid = __builtin_amdgcn_readfirstlane(tid >> 6), lane = tid & 63, wr = wid >> 2, wc = wid & 3, fr = lane & 15, fq = lane >> 4;
    int K_ = g.K; asm volatile("" : "+s"(K_));
    const int K = K_, nt = K / BK;
    unsigned voffA[2], voffB[2];
#pragma unroll
    for (int i = 0; i < 2; ++i) { int R, C; stage_rc(tid * 16 + i * 8192, R, C); const int Rb = Epi::PERM ? ((R & ~31) + perm32(R & 31)) : R;
        voffA[i] = (unsigned)(R * K + C) * 2u; voffB[i] = (unsigned)(Rb * K + C) * 2u; }
    const size_t kstep = (size_t)(BK * 2);
    const size_t hstep = (size_t)HALF * K * 2;
    const size_t tstep = 2 * hstep;
    const unsigned ldsw = (unsigned)wid * 1024u;
    const int aoff = lds_byte(wr * 64 + fr, fq * 8), boff = lds_byte(wc * 32 + fr, fq * 8);
#define PG8_SA(b, h) (((b) * 2 + (h)) * HTB)
#define PG8_SB(b, h) ((4 + (b) * 2 + (h)) * HTB)
#define PG8_STAGE(bufoff, gbase, voff) do { _Pragma("unroll") for (int _i = 0; _i < 2; ++_i) \
        __builtin_amdgcn_global_load_lds((const unsigned*)((const char*)(gbase) + (voff)[_i]), (LAS unsigned*)(lds + (bufoff) + ldsw + _i * 8192), 16, 0, 0); } while (0)
#define PG8_LDA(dst, b, h) do { _Pragma("unroll") for (int m = 0; m < 4; ++m) _Pragma("unroll") for (int k = 0; k < 2; ++k) dst[m][k] = *(const LAS bf16x8*)(lds + PG8_SA(b, h) + aoff + m * 2048 + k * 1024); } while (0)
#define PG8_LDB(dst, b, h) do { _Pragma("unroll") for (int n = 0; n < 2; ++n) _Pragma("unroll") for (int k = 0; k < 2; ++k) dst[n][k] = *(const LAS bf16x8*)(lds + PG8_SB(b, h) + boff + n * 2048 + k * 1024); } while (0)
#define PG8_MMA(ai, bj, At, Bt) do { __builtin_amdgcn_s_setprio(1); _Pragma("unroll") for (int m = 0; m < 4; ++m) _Pragma("unroll") for (int n = 0; n < 2; ++n) _Pragma("unroll") for (int k = 0; k < 2; ++k) { \
        if constexpr (Epi::SWAP) acc[ai][bj][m][n] = __builtin_amdgcn_mfma_f32_16x16x32_bf16(At[m][k], Bt[n][k], acc[ai][bj][m][n], 0, 0, 0); \
        else acc[ai][bj][m][n] = __builtin_amdgcn_mfma_f32_16x16x32_bf16(Bt[n][k], At[m][k], acc[ai][bj][m][n], 0, 0, 0); } __builtin_amdgcn_s_setprio(0); } while (0)
#define PG8_WAIT_V(n) asm volatile("s_waitcnt vmcnt(" #n ")" ::: "memory")
#define PG8_WAIT_L(n) asm volatile("s_waitcnt lgkmcnt(" #n ")" ::: "memory")
#define PG8_BAR __builtin_amdgcn_s_barrier()
#define PG8_SCHED __builtin_amdgcn_sched_barrier(0)
    Unit cur, nxt; int ui = 0;
    if (!S.next(0, cur)) return;
    f32x4 acc[2][2][4][2];
#pragma unroll
    for (int a = 0; a < 2; ++a)
#pragma unroll
        for (int b = 0; b < 2; ++b)
#pragma unroll
            for (int m = 0; m < 4; ++m)
#pragma unroll
                for (int n = 0; n < 2; ++n) acc[a][b][m][n] = (f32x4){0.f, 0.f, 0.f, 0.f};
    bf16x8 At[4][2], B0[2][2], B1[2][2];
    const char* cA = (const char*)g.A + (size_t)cur.pm * tstep; const char* cB = (const char*)g.Bt + (size_t)cur.pn * tstep;
    S.a_ready(cur);
    if constexpr (SP2) {
        PG8_STAGE(PG8_SB(0, 0), cB, voffB); PG8_STAGE(PG8_SB(0, 1), cB + hstep, voffB); PG8_STAGE(PG8_SA(0, 0), cA, voffA); PG8_STAGE(PG8_SA(0, 1), cA + hstep, voffA);
        if (wr == 1) PG8_BAR;
        PG8_WAIT_V(2); PG8_BAR;
        PG8_STAGE(PG8_SB(1, 0), cB + kstep, voffB); PG8_STAGE(PG8_SA(1, 0), cA + kstep, voffA); PG8_STAGE(PG8_SB(1, 1), cB + hstep + kstep, voffB);
        PG8_WAIT_V(6); PG8_BAR;
    } else {
        PG8_STAGE(PG8_SB(0, 0), cB, voffB); PG8_STAGE(PG8_SA(0, 0), cA, voffA); PG8_STAGE(PG8_SB(0, 1), cB + hstep, voffB); PG8_STAGE(PG8_SA(0, 1), cA + hstep, voffA);
        if (wr == 1) PG8_BAR;
        PG8_WAIT_V(4); PG8_BAR;
        PG8_STAGE(PG8_SB(1, 0), cB + kstep, voffB); PG8_STAGE(PG8_SA(1, 0), cA + kstep, voffA); PG8_STAGE(PG8_SB(1, 1), cB + hstep + kstep, voffB);
        PG8_WAIT_V(6); PG8_BAR;
    }
    for (;;) {
        const bool has_next = S.next(ui + 1, nxt);
        const char* nA = has_next ? (const char*)g.A + (size_t)nxt.pm * tstep : cA; const char* nB = has_next ? (const char*)g.Bt + (size_t)nxt.pn * tstep : cB;
        for (int t = 0; t < nt; t += 2) {
            const bool last = (t == nt - 2);
            const char* a1 = cA + (size_t)(t + 1) * kstep;
            const char* a2 = last ? nA : cA + (size_t)(t + 2) * kstep; const char* b2 = last ? nB : cB + (size_t)(t + 2) * kstep;
            const char* a3 = a2 + kstep; const char* b3 = b2 + kstep;
            if (last && has_next) S.a_ready(nxt);
            if constexpr (SP2) {
            PG8_LDB(B0, 0, 0); PG8_LDB(B1, 0, 1); PG8_SCHED; PG8_LDA(At, 0, 0); PG8_STAGE(PG8_SA(1, 1), a1 + hstep, voffA);
            PG8_WAIT_V(8); PG8_WAIT_L(0); PG8_BAR; PG8_MMA(0, 0, At, B0); PG8_MMA(0, 1, At, B1); PG8_BAR; PG8_SCHED;
            PG8_LDA(At, 0, 1); PG8_STAGE(PG8_SB(0, 0), b2, voffB); PG8_STAGE(PG8_SB(0, 1), b2 + hstep, voffB); PG8_STAGE(PG8_SA(0, 0), a2, voffA);
            PG8_WAIT_V(8); PG8_WAIT_L(0); PG8_BAR; PG8_MMA(1, 0, At, B0); PG8_MMA(1, 1, At, B1); PG8_BAR; PG8_SCHED;
            PG8_LDB(B0, 1, 0); PG8_LDB(B1, 1, 1); PG8_SCHED; PG8_LDA(At, 1, 0); PG8_STAGE(PG8_SA(0, 1), a2 + hstep, voffA);
            PG8_WAIT_V(8); PG8_WAIT_L(0); PG8_BAR; PG8_MMA(0, 0, At, B0); PG8_MMA(0, 1, At, B1); PG8_BAR; PG8_SCHED;
            PG8_LDA(At, 1, 1); PG8_STAGE(PG8_SB(1, 0), b3, voffB); PG8_STAGE(PG8_SB(1, 1), b3 + hstep, voffB); PG8_STAGE(PG8_SA(1, 0), a3, voffA);
            PG8_WAIT_V(8); PG8_WAIT_L(0); PG8_BAR; PG8_MMA(1, 0, At, B0); PG8_MMA(1, 1, At, B1); PG8_BAR; PG8_SCHED;
            } else {
            PG8_LDB(B0, 0, 0); PG8_SCHED; PG8_LDA(At, 0, 0); PG8_STAGE(PG8_SA(1, 1), a1 + hstep, voffA);
            PG8_WAIT_L(8); PG8_BAR; PG8_WAIT_L(0); PG8_MMA(0, 0, At, B0); PG8_BAR; PG8_SCHED;
            PG8_LDB(B1, 0, 1); PG8_STAGE(PG8_SB(0, 0), b2, voffB);
            PG8_BAR; PG8_WAIT_L(0); PG8_MMA(0, 1, At, B1); PG8_BAR;
            PG8_LDA(At, 0, 1); PG8_STAGE(PG8_SA(0, 0), a2, voffA);
            PG8_BAR; PG8_WAIT_L(0); PG8_MMA(1, 0, At, B0); PG8_BAR; PG8_SCHED;
            PG8_STAGE(PG8_SB(0, 1), b2 + hstep, voffB);
            PG8_WAIT_V(6); PG8_BAR; PG8_MMA(1, 1, At, B1); PG8_BAR;
            PG8_LDB(B0, 1, 0); PG8_SCHED; PG8_LDA(At, 1, 0); PG8_STAGE(PG8_SA(0, 1), a2 + hstep, voffA);
            PG8_WAIT_L(8); PG8_BAR; PG8_WAIT_L(0); PG8_MMA(0, 0, At, B0); PG8_BAR; PG8_SCHED;
            PG8_LDB(B1, 1, 1); PG8_STAGE(PG8_SB(1, 0), b3, voffB);
            PG8_BAR; PG8_WAIT_L(0); PG8_MMA(0, 1, At, B1); PG8_BAR;
            PG8_LDA(At, 1, 1); PG8_STAGE(PG8_SA(1, 0), a3, voffA);
            PG8_BAR; PG8_WAIT_L(0); PG8_MMA(1, 0, At, B0); PG8_BAR; PG8_SCHED;
            PG8_STAGE(PG8_SB(1, 1), b3 + hstep, voffB);
            PG8_WAIT_V(6); PG8_BAR; PG8_MMA(1, 1, At, B1); PG8_BAR;
            }
        }
        if constexpr (ALIGN_EPI) { if (wr == 0) PG8_BAR; }
        E(acc, cur, wr, wc, fr, fq); S.done(cur);
        if (!has_next) break;
#pragma unroll
        for (int a = 0; a < 2; ++a)
#pragma unroll
            for (int b = 0; b < 2; ++b)
#pragma unroll
                for (int m = 0; m < 4; ++m)
#pragma unroll
                    for (int n = 0; n < 2; ++n) acc[a][b][m][n] = (f32x4){0.f, 0.f, 0.f, 0.f};
        cur = nxt; cA = nA; cB = nB; ++ui;
        if constexpr (ALIGN_EPI) { if (wr == 1) PG8_BAR; }
    }
    PG8_WAIT_V(0);
    if constexpr (!ALIGN_EPI) { if (wr == 0) PG8_BAR; }
    PG8_BAR;
#undef PG8_SA
#undef PG8_SB
#undef PG8_STAGE
#undef PG8_LDA
#undef PG8_LDB
#undef PG8_MMA
#undef PG8_WAIT_V
#undef PG8_WAIT_L
#undef PG8_BAR
#undef PG8_SCHED
}

typedef const f32x4 (&AccRef)[2][2][4][2];
__device__ __forceinline__ u32x4 pack8(f32x4 v0, f32x4 v1) { u32x4 w; w.x = pk2(v0[0], v0[1]); w.y = pk2(v0[2], v0[3]); w.z = pk2(v1[0], v1[1]); w.w = pk2(v1[2], v1[3]); return w; }
__device__ __forceinline__ void unpack8(u32x4 w, f32x4& v0, f32x4& v1) { v0 = (f32x4){bflo(w.x), bfhi(w.x), bflo(w.y), bfhi(w.y)}; v1 = (f32x4){bflo(w.z), bfhi(w.z), bflo(w.w), bfhi(w.w)}; }

struct EpiBf16 {
    static constexpr bool PERM = true, SWAP = false;
    bf16_t* O; int ldc;
    __device__ __forceinline__ void operator()(AccRef acc, const Unit& u, int wr, int wc, int fr, int fq) const {
        const int row0 = u.pm * BM + wr * 64 + fr, col0 = u.pn * BM + wc * 32 + 8 * fq;
#pragma unroll
        for (int ai = 0; ai < 2; ++ai)
#pragma unroll
            for (int m = 0; m < 4; ++m) { bf16_t* rowp = O + (size_t)(row0 + ai * HALF + m * 16) * ldc + col0;
#pragma unroll
                for (int bj = 0; bj < 2; ++bj) *(u32x4*)(rowp + bj * HALF) = pack8(acc[ai][bj][m][0], acc[ai][bj][m][1]); }
    }
};
struct EpiProj {
    static constexpr bool PERM = true, SWAP = false;
    bf16_t* O; const float* rope; bf16_t* KB;
    __device__ __forceinline__ void operator()(AccRef acc, const Unit& u, int wr, int wc, int fr, int fq) const {
        const int row0 = u.pm * BM + wr * 64 + fr, col0 = u.pn * BM + wc * 32 + 8 * fq;
        const int mode = (u.pn >= 27 && u.pn < 43) ? (u.pn < 35 ? 1 : 2) : 0;
        const float sc = (mode == 1) ? QSCALE : 1.0f;
#pragma unroll
        for (int ai = 0; ai < 2; ++ai)
#pragma unroll
            for (int m = 0; m < 4; ++m) { const int row = row0 + ai * HALF + m * 16; bf16_t* rowp = O + (size_t)row * PLD + col0;
#pragma unroll
                for (int bj = 0; bj < 2; ++bj) { f32x4 v0 = acc[ai][bj][m][0], v1 = acc[ai][bj][m][1];
                    if (mode) { const int i0 = ((col0 + bj * HALF) & 127) >> 1; const f32x4* rp = (const f32x4*)(rope + ((size_t)row * 64 + i0) * 2); const f32x4 c0 = rp[0], c1 = rp[1];
                        f32x4 o0, o1;
                        o0[0] = v0[0] * c0[0] - v0[1] * c0[1]; o0[1] = v0[1] * c0[0] + v0[0] * c0[1]; o0[2] = v0[2] * c0[2] - v0[3] * c0[3]; o0[3] = v0[3] * c0[2] + v0[2] * c0[3];
                        o1[0] = v1[0] * c1[0] - v1[1] * c1[1]; o1[1] = v1[1] * c1[0] + v1[0] * c1[1]; o1[2] = v1[2] * c1[2] - v1[3] * c1[3]; o1[3] = v1[3] * c1[2] + v1[2] * c1[3];
                        v0 = o0 * sc; v1 = o1 * sc; }
                    if (mode == 2) *(u32x4*)(KB + ((size_t)((u.pn - 35) * 2 + bj) * T + row) * MD + wc * 32 + 8 * fq) = pack8(v0, v1);
                    else *(u32x4*)(rowp + bj * HALF) = pack8(v0, v1); } }
    }
};
struct EpiVT {
    static constexpr bool PERM = false, SWAP = true;
    bf16_t* VT;
    __device__ __forceinline__ void operator()(AccRef acc, const Unit& u, int wr, int wc, int fr, int fq) const {
        const int tok0 = u.pm * BM + wr * 64 + 4 * fq, col0 = u.pn * BM + wc * 32 + fr;
#pragma unroll
        for (int ai = 0; ai < 2; ++ai)
#pragma unroll
            for (int m = 0; m < 4; ++m)
#pragma unroll
                for (int bj = 0; bj < 2; ++bj)
#pragma unroll
                    for (int n = 0; n < 2; ++n) { const f32x4 v = acc[ai][bj][m][n]; u32x2 w; w.x = pk2(v[0], v[1]); w.y = pk2(v[2], v[3]);
                        const int d = col0 + bj * HALF + n * 16, tl = (u.pm * BM + wr * 64 + ai * HALF) >> 6;
                        *(u32x2*)(VT + ((size_t)((d >> 7) * (T / 64) + tl) * MD + (d & 127)) * 64 + m * 16 + 4 * (((fq & 1) << 1) | (fq >> 1))) = w; }
    }
};
struct EpiDec {
    static constexpr bool PERM = true, SWAP = false;
    float* O; const float* w0;
    __device__ __forceinline__ void operator()(AccRef acc, const Unit& u, int wr, int wc, int fr, int fq) const {
        const int row0 = u.pm * BM + wr * 64 + fr, col0 = u.pn * BM + wc * 32 + 8 * fq;
#pragma unroll
        for (int bj = 0; bj < 2; ++bj) { const f32x4 b0 = *(const f32x4*)(w0 + col0 + bj * HALF), b1 = *(const f32x4*)(w0 + col0 + bj * HALF + 4);
#pragma unroll
            for (int ai = 0; ai < 2; ++ai)
#pragma unroll
                for (int m = 0; m < 4; ++m) { float* rowp = O + (size_t)(row0 + ai * HALF + m * 16) * RW + col0 + bj * HALF;
#pragma unroll
                    for (int n = 0; n < 2; ++n) { const f32x4 x = acc[ai][bj][m][n] + (n ? b1 : b0); f32x4 o;
#pragma unroll
                        for (int e = 0; e < 4; ++e) { const float z = -x[e]; const float sp = fmaxf(z, 0.f) + __logf(1.0f + __expf(-fabsf(z))); o[e] = __expf(-__expf(-sp - 0.5f)); }
                        *(f32x4*)(rowp + 4 * n) = o; }
                    asm volatile("" ::: "memory"); } }
    }
};
struct EpiA {
    static constexpr bool PERM = true, SWAP = false;
    bf16_t* KP; bf16_t* BB; const bf16_t* KKN; const float* a0; const float* k_a;
    __device__ __forceinline__ void operator()(AccRef acc, const Unit& u, int wr, int wc, int fr, int fq) const {
        const int row0 = u.pm * BM + wr * 64 + fr, col0 = u.pn * BM + wc * 32 + 8 * fq;
#pragma unroll
        for (int bj = 0; bj < 2; ++bj) { const int cb = col0 + bj * HALF;
            const f32x4 b0 = *(const f32x4*)(a0 + cb), b1 = *(const f32x4*)(a0 + cb + 4), ka0 = *(const f32x4*)(k_a + cb), ka1 = *(const f32x4*)(k_a + cb + 4);
#pragma unroll
            for (int ai = 0; ai < 2; ++ai)
#pragma unroll
                for (int m = 0; m < 4; ++m) { const size_t off = (size_t)(row0 + ai * HALF + m * 16) * RW + cb;
                    f32x4 zk0, zk1, kn0, kn1; unpack8(*(const u32x4*)(KP + off), zk0, zk1); unpack8(*(const u32x4*)(KKN + off), kn0, kn1);
                    f32x4 a0v, a1v;
#pragma unroll
                    for (int e = 0; e < 4; ++e) { a0v[e] = fsigmoid(acc[ai][bj][m][0][e] + b0[e]); a1v[e] = fsigmoid(acc[ai][bj][m][1][e] + b1[e]); }
                    const f32x4 kp0 = zk0 * (1.0f + (a0v - 1.0f) * ka0), kp1 = zk1 * (1.0f + (a1v - 1.0f) * ka1);
                    *(u32x4*)(KP + off) = pack8(kp0, kp1); *(u32x4*)(BB + off) = pack8(-(kn0 * a0v), -(kn1 * a1v));
                    asm volatile("" ::: "memory"); } }
    }
};
template <bool ADD> struct EpiMix {
    static constexpr bool PERM = true, SWAP = false;
    bf16_t* O; const bf16_t* proj; int gcol0;
    __device__ __forceinline__ void operator()(AccRef acc, const Unit& u, int wr, int wc, int fr, int fq) const {
        const int row0 = u.pm * BM + wr * 64 + fr, col0 = u.pn * BM + wc * 32 + 8 * fq;
#pragma unroll
        for (int ai = 0; ai < 2; ++ai)
#pragma unroll
            for (int m = 0; m < 4; ++m) { const int row = row0 + ai * HALF + m * 16;
#pragma unroll
                for (int bj = 0; bj < 2; ++bj) { f32x4 g0, g1; unpack8(*(const u32x4*)(proj + (size_t)row * PLD + gcol0 + col0 + bj * HALF), g0, g1);
                    f32x4 o0, o1;
#pragma unroll
                    for (int e = 0; e < 4; ++e) { o0[e] = fsigmoid(g0[e]) * acc[ai][bj][m][0][e]; o1[e] = fsigmoid(g1[e]) * acc[ai][bj][m][1][e]; }
                    bf16_t* op = O + (size_t)row * D + col0 + bj * HALF;
                    if (ADD) { f32x4 p0, p1; unpack8(*(const u32x4*)op, p0, p1); o0 += p0; o1 += p1; }
                    *(u32x4*)op = pack8(o0, o1); } }
    }
};
struct EpiRes {
    static constexpr bool PERM = true, SWAP = false;
    float* O; const float* x;
    __device__ __forceinline__ void operator()(AccRef acc, const Unit& u, int wr, int wc, int fr, int fq) const {
        const int row0 = u.pm * BM + wr * 64 + fr, col0 = u.pn * BM + wc * 32 + 8 * fq;
#pragma unroll
        for (int ai = 0; ai < 2; ++ai)
#pragma unroll
            for (int m = 0; m < 4; ++m) { const size_t off = (size_t)(row0 + ai * HALF + m * 16) * D + col0;
#pragma unroll
                for (int bj = 0; bj < 2; ++bj)
#pragma unroll
                    for (int n = 0; n < 2; ++n) *(f32x4*)(O + off + bj * HALF + 4 * n) = *(const f32x4*)(x + off + bj * HALF + 4 * n) + acc[ai][bj][m][n]; }
    }
};
}

#define XB_TMO      128
#define XB_XCNT(j)  (256  + 64 * (j))
#define XB_XSUB(j)  (1280 + 64 * (j))
#define XB_XGEN(j)  (2304 + 64 * (j))
#define XB_TOP      3328
#define XB_TOPGEN   3392
#define XCD_BAR_WORDS 3456
#define XB_SPIN_CAP (1u << 18)
__device__ __forceinline__ unsigned xb_ld(unsigned* p)              { return __hip_atomic_load(p, __ATOMIC_RELAXED, __HIP_MEMORY_SCOPE_AGENT); }
__device__ __forceinline__ unsigned xb_add(unsigned* p, unsigned v) { return __hip_atomic_fetch_add(p, v, __ATOMIC_RELAXED, __HIP_MEMORY_SCOPE_AGENT); }
__device__ __forceinline__ unsigned xb_xcc_id() { return (unsigned)__builtin_amdgcn_s_getreg((3 << 11) | 20) & 0xFu; }
#define XB_SPIN(cond, bar) do { unsigned _sp = 0; while (cond) { __builtin_amdgcn_s_sleep(1); \
    if ((++_sp & 255u) == 0u) { if (xb_ld(&(bar)[XB_TMO])) break; if (_sp > XB_SPIN_CAP) { atomicAdd(&(bar)[XB_TMO], 1u); break; } } } } while (0)
struct XcdBarrier { unsigned* bar; unsigned x; volatile LAS unsigned* st; };
__device__ __forceinline__ XcdBarrier xcd_barrier_post(unsigned* bar, volatile LAS unsigned* st) {
    XcdBarrier b; b.bar = bar; b.x = xb_xcc_id(); b.st = st;
    if (threadIdx.x == 0) (void)xb_add(&bar[XB_XCNT(b.x)], 1u);
    return b;
}
__device__ __forceinline__ void xcd_barrier_complete(unsigned* bar, unsigned x, unsigned& nloc, unsigned& nx) {
    const unsigned G = gridDim.x * gridDim.y * gridDim.z;
    unsigned sum, cnt, mine, sp = 0u;
    for (;;) {
        sum = 0u; cnt = 0u; mine = 0u;
#pragma unroll
        for (unsigned j = 0; j < 16; ++j) { const unsigned c = xb_ld(&bar[XB_XCNT(j)]); sum += c; cnt += (c > 0u) ? 1u : 0u; mine = (j == x) ? c : mine; }
        if (sum == G) break;
        __builtin_amdgcn_s_sleep(1);
        if ((++sp & 255u) == 0u) { if (xb_ld(&bar[XB_TMO])) break; if (sp > XB_SPIN_CAP) { atomicAdd(&bar[XB_TMO], 1u); break; } }
    }
    nloc = mine > 0u ? mine : 1u; nx = cnt > 0u ? cnt : 1u;
}
__device__ __forceinline__ void xcd_barrier(const XcdBarrier& b) {
    asm volatile("s_waitcnt vmcnt(0)" ::: "memory");
    __syncthreads();
    if (threadIdx.x == 0) {
        unsigned* bar = b.bar;
        __builtin_amdgcn_s_waitcnt(0);
        unsigned nloc = b.st[0], nx = b.st[1];
        if (nloc == 0u) { xcd_barrier_complete(bar, b.x, nloc, nx); b.st[0] = nloc; b.st[1] = nx; }
        const unsigned old = xb_add(&bar[XB_XSUB(b.x)], 1u);
        const unsigned gen = old / nloc;
        if (old + 1u == (gen + 1u) * nloc) {
            __builtin_amdgcn_fence(__ATOMIC_RELEASE, "agent");
            asm volatile("s_waitcnt vmcnt(0)" ::: "memory");
            const unsigned og = xb_add(&bar[XB_TOP], 1u);
            const unsigned tg = og / nx;
            if (og + 1u == (tg + 1u) * nx) xb_add(&bar[XB_TOPGEN], 1u);
            else XB_SPIN(xb_ld(&bar[XB_TOPGEN]) == tg, bar);
            __builtin_amdgcn_fence(__ATOMIC_ACQUIRE, "agent");
            xb_add(&bar[XB_XGEN(b.x)], 1u);
            asm volatile("s_waitcnt vmcnt(0)" ::: "memory");
        } else {
            XB_SPIN(xb_ld(&bar[XB_XGEN(b.x)]) == gen, bar);
            __builtin_amdgcn_fence(__ATOMIC_ACQUIRE, "agent");
            asm volatile("s_waitcnt vmcnt(0)" ::: "memory");
        }
    }
    __syncthreads();
}

struct Args {
    const float *x, *norm1_g, *w_in, *mu, *w0, *w_up, *a0, *a_up, *g_up, *k_k, *k_a, *r_k, *lnx_g, *lnx_b, *w_ba, *w_bb, *w_out, *norm2_g, *peer_wq, *sub_keys, *peer_u, *peer_v, *final_g;
    float* out; unsigned char* ws; int ph_lo, ph_hi, li, pad;
};
#define CAS __attribute__((address_space(4)))
typedef const CAS Args* ArgsP;
__device__ __forceinline__ ArgsP get_args() { ArgsP p = (ArgsP)__builtin_amdgcn_kernarg_segment_ptr(); asm volatile("" : "+s"(p)); return p; }
struct Frame { LAS unsigned char* lds; int tid, lane, wave, vcu, G; };

__device__ __forceinline__ int win_dst(int s) {
    if (s < SHIFTW) return s;
    if (s < SHIFTW + 4096) { const int base = (s < SHIFTW + 2048) ? SHIFTW : SHIFTW + 2048; const int m = s - base, head = m >> 7, c = m & 127; const int j = (c < 64) ? 2 * c : 2 * (c - 64) + 1;
        return ((s < SHIFTW + 2048) ? PC_MQ : PC_MK) + head * 128 + j; }
    if (s < SHIFTW + 6144) return PC_MV + (s - (SHIFTW + 4096));
    if (s < SHIFTW + 6144 + 4096) return PC_GA + (s - (SHIFTW + 6144));
    return PC_GB + (s - (SHIFTW + 6144 + 4096));
}
template <bool MAPWIN> __device__ __forceinline__ void p0_transpose_item(const float* W, int K, int N, bf16_t* WT, int Kd, LAS float* scr, int item, int lane) {
    const int nblk = N / 32, kb = item / nblk, nb = item % nblk, k0 = 64 * kb, n0 = 32 * nb;
    { const int krow = lane >> 3, c4 = lane & 7; f32x4 v[8];
#pragma unroll
      for (int i = 0; i < 8; ++i) { const int kk = 8 * i + krow; v[i] = (k0 + kk < K) ? *(const f32x4*)(W + (size_t)(k0 + kk) * N + n0 + 4 * c4) : (f32x4){0.f, 0.f, 0.f, 0.f}; }
#pragma unroll
      for (int i = 0; i < 8; ++i) { LAS float* d = scr + (8 * i + krow) * 33 + 4 * c4; d[0] = v[i].x; d[1] = v[i].y; d[2] = v[i].z; d[3] = v[i].w; } }
    LDS_WAIT(); asm volatile("" ::: "memory");
    const int c = lane & 7;
#pragma unroll
    for (int j = 0; j < 4; ++j) { const int n = (lane >> 3) + 8 * j; const LAS float* s = scr + (8 * c) * 33 + n;
        u32x4 o; o.x = pk2(s[0 * 33], s[1 * 33]); o.y = pk2(s[2 * 33], s[3 * 33]); o.z = pk2(s[4 * 33], s[5 * 33]); o.w = pk2(s[6 * 33], s[7 * 33]);
        const int row = MAPWIN ? win_dst(n0 + n) : (n0 + n);
        *(u32x4*)(WT + (size_t)row * Kd + k0 + 8 * c) = o; }
    LDS_WAIT(); asm volatile("" ::: "memory");
}
__device__ __forceinline__ void rms_rows_to_bf16(const float* x, const float* g, bf16_t* o, int m0, int mstride, int lane) {
    const f32x4* gr = (const f32x4*)g + lane;
    f32x4 v[16], w[16];
    if (m0 < T) {
#pragma unroll
        for (int j = 0; j < 16; ++j) v[j] = ((const f32x4*)(x + (size_t)m0 * D) + lane)[64 * j]; }
    for (int m = m0; m < T; m += mstride) { const bool hasn = m + mstride < T;
        if (hasn) {
#pragma unroll
            for (int j = 0; j < 16; ++j) w[j] = ((const f32x4*)(x + (size_t)(m + mstride) * D) + lane)[64 * j]; }
        float s = 0.f;
#pragma unroll
        for (int j = 0; j < 16; ++j) s += (v[j].x * v[j].x + v[j].y * v[j].y) + (v[j].z * v[j].z + v[j].w * v[j].w);
        const float rs = 1.0f / sqrtf(wave_sum(s) * (1.0f / D) + NORM_EPS);
        u32x2* o8 = (u32x2*)(o + (size_t)m * D) + lane;
#pragma unroll
        for (int j = 0; j < 16; ++j) { const f32x4 gg = gr[64 * j]; u32x2 q; q.x = pk2(v[j].x * rs * gg.x, v[j].y * rs * gg.y); q.y = pk2(v[j].z * rs * gg.z, v[j].w * rs * gg.w); o8[64 * j] = q; }
        if (hasn) {
#pragma unroll
            for (int j = 0; j < 16; ++j) v[j] = w[j]; }
    }
}
__device__ __forceinline__ void cvt_table(const float* src, bf16_t* dst, size_t n8, size_t gtid, size_t nthr) {
    for (size_t i = gtid; i < n8; i += nthr) { const f32x4 a = ((const f32x4*)src)[2 * i], b = ((const f32x4*)src)[2 * i + 1]; ((u32x4*)dst)[i] = pg8::pack8(a, b); }
}
__device__ __forceinline__ void pq_load(ArgsP A, int row, int lane, f32x4 (&v)[16]) {
    const f32x4* src = (const f32x4*)((row >= 16384 ? A->peer_v + (size_t)(row - 16384) * D : A->peer_u + (size_t)row * D)) + lane;
#pragma unroll
    for (int j = 0; j < 16; ++j) v[j] = __builtin_nontemporal_load(src + 64 * j);
}
__device__ __forceinline__ void pq_finish(unsigned char* ws, int row, int lane, const f32x4 (&v)[16]) {
    const bool isv = row >= 16384; const int rr = isv ? row - 16384 : row; float am = 0.f;
#pragma unroll
    for (int j = 0; j < 16; ++j) am = fmaxf(fmaxf(am, fmaxf(fabsf(v[j].x), fabsf(v[j].y))), fmaxf(fabsf(v[j].z), fabsf(v[j].w)));
#pragma unroll
    for (int o = 1; o < 64; o <<= 1) am = fmaxf(am, __shfl_xor(am, o));
    const float inv = am > 0.f ? 127.0f / am : 0.f; unsigned* dst = (unsigned*)(ws + (isv ? WS_PV : WS_PU)) + (size_t)rr * (D / 4) + lane;
#pragma unroll
    for (int j = 0; j < 16; ++j) { const unsigned q0 = (unsigned)(int)(rintf(v[j].x * inv) + 128.0f), q1 = (unsigned)(int)(rintf(v[j].y * inv) + 128.0f), q2 = (unsigned)(int)(rintf(v[j].z * inv) + 128.0f), q3 = (unsigned)(int)(rintf(v[j].w * inv) + 128.0f);
        dst[64 * j] = q0 | (q1 << 8) | (q2 << 16) | (q3 << 24); }
    if (lane == 0) ((float*)(ws + (isv ? WS_PSV : WS_PSU)))[rr] = am * (1.0f / 127.0f);
}
__device__ __forceinline__ void peer_quant(ArgsP A, Frame& F, int w0, int wstride) {
    unsigned char* ws = A->ws; const float* pu = A->peer_u; const float* pv = A->peer_v;
    f32x4 v[16], w[16];
    auto rowp = [&](int row) { return (const f32x4*)((row >= 16384 ? pv + (size_t)(row - 16384) * D : pu + (size_t)row * D)) + F.lane; };
    if (w0 < 2 * 16384) { const f32x4* src = rowp(w0);
#pragma unroll
        for (int j = 0; j < 16; ++j) v[j] = __builtin_nontemporal_load(src + 64 * j); }
    for (int row = w0; row < 2 * 16384; row += wstride) { const bool isv = row >= 16384; const int rr = isv ? row - 16384 : row; const bool hasn = row + wstride < 2 * 16384;
        if (hasn) { const f32x4* src = rowp(row + wstride);
#pragma unroll
            for (int j = 0; j < 16; ++j) w[j] = __builtin_nontemporal_load(src + 64 * j); }
        float am = 0.f;
#pragma unroll
        for (int j = 0; j < 16; ++j) am = fmaxf(fmaxf(am, fmaxf(fabsf(v[j].x), fabsf(v[j].y))), fmaxf(fabsf(v[j].z), fabsf(v[j].w)));
#pragma unroll
        for (int o = 1; o < 64; o <<= 1) am = fmaxf(am, __shfl_xor(am, o));
        const float inv = am > 0.f ? 127.0f / am : 0.f; unsigned* dst = (unsigned*)(ws + (isv ? WS_PV : WS_PU)) + (size_t)rr * (D / 4) + F.lane;
#pragma unroll
        for (int j = 0; j < 16; ++j) { const unsigned q0 = (unsigned)(int)(rintf(v[j].x * inv) + 128.0f), q1 = (unsigned)(int)(rintf(v[j].y * inv) + 128.0f), q2 = (unsigned)(int)(rintf(v[j].z * inv) + 128.0f), q3 = (unsigned)(int)(rintf(v[j].w * inv) + 128.0f);
            dst[64 * j] = q0 | (q1 << 8) | (q2 << 16) | (q3 << 24); }
        if (F.lane == 0) ((float*)(ws + (isv ? WS_PSV : WS_PSU)))[rr] = am * (1.0f / 127.0f);
        if (hasn) {
#pragma unroll
            for (int j = 0; j < 16; ++j) v[j] = w[j]; }
    }
}
__device__ __forceinline__ void late_weights(ArgsP A, Frame& F, int w0, int wstride) {
    unsigned char* ws = A->ws;
    LAS float* scr = (LAS float*)(F.lds + RING_OFF + F.wave * 16384);
    constexpr int I_BA = 32 * 128, I_OUT = 64 * 128, I_WQ = 64 * 64, I_SK = PH_ * 2 * PNK * PHALF / 512;
    constexpr int NITEMS = 2 * I_BA + I_OUT + I_WQ + I_SK;
    for (int it = w0; it < NITEMS; it += wstride) {
        int r = it;
        if (r < I_BA) { p0_transpose_item<false>(A->w_ba, RW, D, (bf16_t*)(ws + WS_WA), RW, scr, r, F.lane); continue; } r -= I_BA;
        if (r < I_BA) { p0_transpose_item<false>(A->w_bb, RW, D, (bf16_t*)(ws + WS_WB), RW, scr, r, F.lane); continue; } r -= I_BA;
        if (r < I_OUT) { p0_transpose_item<false>(A->w_out, D, D, (bf16_t*)(ws + WS_WOUT), D, scr, r, F.lane); continue; } r -= I_OUT;
        if (r < I_WQ) { p0_transpose_item<false>(A->peer_wq, D, 2048, (bf16_t*)(ws + WS_WQ), D, scr, r, F.lane); continue; } r -= I_WQ;
        { const size_t i = (size_t)r * 64 + F.lane; const f32x4 a = ((const f32x4*)A->sub_keys)[2 * i], b = ((const f32x4*)A->sub_keys)[2 * i + 1]; ((u32x4*)(ws + WS_SUBK))[i] = pg8::pack8(a, b); }
    }
}
__device__ __forceinline__ void ph0_prologue(ArgsP A, Frame& F) {
    unsigned char* ws = A->ws;
    LAS float* scr = (LAS float*)(F.lds + RING_OFF + F.wave * 16384);
    const int gw = F.vcu * NWAVES + F.wave, NGW = F.G * NWAVES;
    constexpr int I_IN = 64 * (INW / 32), I_UP = 2 * 64, I_G = 8 * 64;
    constexpr int NITEMS = I_IN + 2 * I_UP + I_G;
    for (int it = gw; it < NITEMS; it += NGW) {
        int r = it;
        if (r < I_IN) { p0_transpose_item<true>(A->w_in, D, INW, (bf16_t*)(ws + WS_WIN), D, scr, r, F.lane); continue; } r -= I_IN;
        if (r < I_UP) { p0_transpose_item<false>(A->w_up, LW, RW, (bf16_t*)(ws + WS_WUP), LW, scr, r, F.lane); continue; } r -= I_UP;
        if (r < I_UP) { p0_transpose_item<false>(A->a_up, LA, RW, (bf16_t*)(ws + WS_AUP), LA, scr, r, F.lane); continue; } r -= I_UP;
        p0_transpose_item<false>(A->g_up, LG, RW, (bf16_t*)(ws + WS_GUP), LGP, scr, r, F.lane);
    }
    const size_t gtid = (size_t)F.vcu * NTHR + F.tid, nthr = (size_t)F.G * NTHR;
    for (size_t i = gtid; i < (size_t)32 * D / 8; i += nthr) ((u32x4*)((bf16_t*)(ws + WS_WIN) + (size_t)SHIFTW * D))[i] = (u32x4){0u, 0u, 0u, 0u};
    for (size_t i = gtid; i < (size_t)T * 64; i += nthr) { const int pos = (int)(i >> 6), fi = (int)(i & 63); const float inv = powf(10000.0f, -(float)fi / 64.0f); const float ang = (float)pos * inv;
        ((f32x2*)(ws + WS_ROPE))[i] = (f32x2){cosf(ang), sinf(ang)}; }
    rms_rows_to_bf16(A->x, A->norm1_g, (bf16_t*)(ws + WS_XN), gw, NGW, F.lane);
}

__device__ __forceinline__ f32x4 ld4bf(const bf16_t* p) { const u32x2 w = *(const u32x2*)p; return (f32x4){bflo(w.x), bfhi(w.x), bflo(w.y), bfhi(w.y)}; }
__device__ __forceinline__ void st4bf(bf16_t* p, f32x4 v) { u32x2 w; w.x = pk2(v[0], v[1]); w.y = pk2(v[2], v[3]); *(u32x2*)p = w; }
__device__ __forceinline__ void ph2_prep(ArgsP A, Frame& F) {
    unsigned char* ws = A->ws; const bf16_t* PROJ = (const bf16_t*)(ws + WS_PROJ);
    LAS float* red = (LAS float*)(F.lds + RING_OFF);
    for (int it = F.vcu; it < NBLK * MH; it += F.G) { const int n = it / MH, h = it % MH, d = F.tid & 127, part = F.tid >> 7;
        const bf16_t* p = (const bf16_t*)(ws + WS_KB) + ((size_t)h * T + n * MBLK + part * 64) * MD + d; float s = 0.f;
#pragma unroll 8
        for (int i = 0; i < 64; ++i) s += bf1(p[(size_t)i * MD]);
        red[F.tid] = s; WG_BAR();
        if (F.tid < 128) { const float m = (red[F.tid] + red[F.tid + 128] + red[F.tid + 256] + red[F.tid + 384]) * (1.0f / MBLK); const unsigned hi = f2bf(m); const float lo = m - __builtin_bit_cast(float, hi << 16);
            ((bf16_t*)(ws + WS_KMEAN))[(size_t)(h * NBLK + n) * MD + F.tid] = (bf16_t)hi; ((bf16_t*)(ws + WS_KMEAN + 131072))[(size_t)(h * NBLK + n) * MD + F.tid] = (bf16_t)f2bf(lo); }
        WG_BAR(); }
    const int tid = F.tid; const int c = 4 * tid;
    const f32x4 mu_r = *(const f32x4*)(A->mu + PC_R + c), mu_k = *(const f32x4*)(A->mu + PC_K + c), mu_v = *(const f32x4*)(A->mu + PC_V + c), kkw = *(const f32x4*)(A->k_k + c);
    int lc = 0, lcc = 0; if (tid < 32) { lcc = 4 * tid; lc = PC_WL + lcc; } else if (tid < 64) { lcc = 4 * (tid - 32); lc = PC_AL + lcc; } else { lcc = 4 * (tid - 64); lc = PC_GL + lcc; }
    const bool lact = tid < 64 || (tid < 192 && lcc < LG);
    const f32x4 mu_l = lact ? *(const f32x4*)(A->mu + lc) : (f32x4){0.f, 0.f, 0.f, 0.f};
    u32x2 cur[8], nxt[8];
    auto tload = [&](int t, u32x2 (&rg)[8]) { const bf16_t* P = PROJ + (size_t)t * PLD; const bf16_t* PP = t > 0 ? P - PLD : P;
        rg[0] = *(const u32x2*)(P + PC_R + c); rg[1] = *(const u32x2*)(PP + PC_R + c); rg[2] = *(const u32x2*)(P + PC_K + c); rg[3] = *(const u32x2*)(PP + PC_K + c);
        rg[4] = *(const u32x2*)(P + PC_V + c); rg[5] = *(const u32x2*)(PP + PC_V + c);
        if (lact) { rg[6] = *(const u32x2*)(P + lc); rg[7] = *(const u32x2*)(PP + lc); } else { rg[6] = (u32x2){0u, 0u}; rg[7] = (u32x2){0u, 0u}; } };
    auto up4 = [](u32x2 w) { return (f32x4){bflo(w.x), bfhi(w.x), bflo(w.y), bfhi(w.y)}; };
    if (F.vcu < T) tload(F.vcu, cur);
    for (int t = F.vcu; t < T; t += F.G) { const bool hasn = t + F.G < T; if (hasn) tload(t + F.G, nxt);
        const float hp = t > 0 ? 1.0f : 0.0f;
        { const f32x4 p = up4(cur[0]), pp = up4(cur[1]) * hp; st4bf((bf16_t*)(ws + WS_ZR) + (size_t)t * RW + c, p + (pp - p) * mu_r); }
        { const f32x4 p = up4(cur[2]), pp = up4(cur[3]) * hp; const f32x4 zk = p + (pp - p) * mu_k;
          st4bf((bf16_t*)(ws + WS_KP) + (size_t)t * RW + c, zk); const f32x4 kk = zk * kkw;
          const float ss = sum16((kk[0] * kk[0] + kk[1] * kk[1]) + (kk[2] * kk[2] + kk[3] * kk[3])); const float inv = 1.0f / fmaxf(sqrtf(ss), 1e-12f);
          st4bf((bf16_t*)(ws + WS_KKN) + (size_t)t * RW + c, kk * inv); }
        { const f32x4 p = up4(cur[4]), pp = up4(cur[5]) * hp; st4bf((bf16_t*)(ws + WS_ZV) + (size_t)t * RW + c, p + (pp - p) * mu_v); }
        if (tid < 192) { const f32x4 zero = (f32x4){0.f, 0.f, 0.f, 0.f};
            f32x4 z = zero; if (lact) { const f32x4 p = up4(cur[6]), pp = up4(cur[7]) * hp; z = p + (pp - p) * mu_l; }
            if (tid < 32) { f32x4 o;
#pragma unroll
                for (int e = 0; e < 4; ++e) o[e] = 1.0f - 2.0f * __builtin_amdgcn_rcpf(__expf(2.0f * z[e]) + 1.0f);
                st4bf((bf16_t*)(ws + WS_AW) + (size_t)t * LW + lcc, o); }
            else if (tid < 64) st4bf((bf16_t*)(ws + WS_AA) + (size_t)t * LA + lcc, z);
            else { f32x4 o = zero; if (lcc < LG) {
#pragma unroll
                for (int e = 0; e < 4; ++e) o[e] = fsigmoid(z[e]); }
                st4bf((bf16_t*)(ws + WS_AG) + (size_t)t * LGP + lcc, o); }
        }
        if (hasn) {
#pragma unroll
            for (int i = 0; i < 8; ++i) cur[i] = nxt[i]; }
    }
}

__device__ __forceinline__ void ph3_gate(ArgsP A, Frame& F) {
    unsigned char* ws = A->ws; const bf16_t* PROJ = (const bf16_t*)(ws + WS_PROJ); const bf16_t* KMH = (const bf16_t*)(ws + WS_KMEAN); const bf16_t* KML = (const bf16_t*)(ws + WS_KMEAN + 131072); unsigned* MASK = (unsigned*)(ws + WS_MASK);
    const int gw = F.vcu * NWAVES + F.wave, NGW = F.G * NWAVES; const int r = F.lane & 31, hh = F.lane >> 5; const float NEG = -__builtin_inff();
    for (int it = gw; it < (T / 32) * MH; it += NGW) { const int tg = it >> 4, h = it & 15, t = tg * 32 + r, blk = tg >> 3;
        if (blk == 0) { if (hh == 0) MASK[t * MH + h] = 0u; continue; }
        f32x16 acc;
#pragma unroll
        for (int e = 0; e < 16; ++e) acc[e] = 0.f;
#pragma unroll
        for (int ks = 0; ks < 8; ++ks) { const bf16x8 q = *(const bf16x8*)(PROJ + (size_t)t * PLD + PC_MQ + h * MD + 16 * ks + 8 * hh); const size_t ko = (size_t)(h * NBLK + r) * MD + 16 * ks + 8 * hh;
            acc = __builtin_amdgcn_mfma_f32_32x32x16_bf16(*(const bf16x8*)(KMH + ko), q, acc, 0, 0, 0); acc = __builtin_amdgcn_mfma_f32_32x32x16_bf16(*(const bf16x8*)(KML + ko), q, acc, 0, 0, 0); }
        float t0 = NEG, t1 = NEG, t2 = NEG;
#pragma unroll
        for (int e = 0; e < 16; ++e) { const int n = (e & 3) + 8 * (e >> 2) + 4 * hh; float ae = acc[e]; asm volatile("" : "+v"(ae));
            float x = __builtin_bit_cast(float, (__builtin_bit_cast(unsigned, ae) & ~31u) | (unsigned)(31 - n)); x = (n < blk) ? x : NEG;
            t2 = __builtin_amdgcn_fmed3f(t1, t2, x); t1 = __builtin_amdgcn_fmed3f(t0, t1, x); t0 = fmaxf(t0, x); }
        const float o0 = __shfl_xor(t0, 32), o1 = __shfl_xor(t1, 32), o2 = __shfl_xor(t2, 32);
        t2 = __builtin_amdgcn_fmed3f(t1, t2, o0); t1 = __builtin_amdgcn_fmed3f(t0, t1, o0); t0 = fmaxf(t0, o0);
        t2 = __builtin_amdgcn_fmed3f(t1, t2, o1); t1 = __builtin_amdgcn_fmed3f(t0, t1, o1); t0 = fmaxf(t0, o1);
        t2 = __builtin_amdgcn_fmed3f(t1, t2, o2); t1 = __builtin_amdgcn_fmed3f(t0, t1, o2); t0 = fmaxf(t0, o2);
        unsigned sel = 1u << (31 - (__builtin_bit_cast(unsigned, t0) & 31u));
        if (blk > 1) sel |= 1u << (31 - (__builtin_bit_cast(unsigned, t1) & 31u));
        if (blk > 2) sel |= 1u << (31 - (__builtin_bit_cast(unsigned, t2) & 31u));
        if (hh == 0) MASK[t * MH + h] = sel;
        { gu32* cnt = (gu32*)(ws + WS_CTL) + CW_CNT + h * 32; unsigned short* lst = (unsigned short*)(ws + WS_LIST) + (size_t)h * 32 * 8192; const unsigned mysel = hh == 0 ? sel : 0u;
          unsigned mycnt = 0u;
          for (int j = 0; j < blk; ++j) { const unsigned long long bal = __ballot((mysel >> j) & 1u); const unsigned c = (unsigned)__builtin_popcountll(bal); mycnt = (F.lane == j) ? c : mycnt; }
          unsigned base = 0u; if (F.lane < blk && mycnt) base = __hip_atomic_fetch_add(cnt + F.lane, mycnt, __ATOMIC_RELAXED, __HIP_MEMORY_SCOPE_AGENT);
          for (int j = 0; j < blk; ++j) { const unsigned long long bal = __ballot((mysel >> j) & 1u); const unsigned bj = (unsigned)__builtin_amdgcn_readlane((int)base, j);
              if ((mysel >> j) & 1u) { const unsigned off = __builtin_amdgcn_mbcnt_hi((unsigned)(bal >> 32), __builtin_amdgcn_mbcnt_lo((unsigned)bal, 0u)); const unsigned slot = (unsigned)__builtin_popcount(mysel & ((1u << j) - 1u));
                  lst[(size_t)j * 8192 + bj + off] = (unsigned short)((unsigned)t | (slot << 13)); } } } }
}

constexpr int CK = 64, NCHK = T / CK, CP = 144, CPF = 272;
constexpr int L_AT = 0, L_BT = 9216, L_KT = 18432, L_RT = 27648, L_ATT = 36864, L_BTT = 46080, L_V = 55296, L_MKA = 64512, L_MBRT = 73728, L_MKRT = 82944, L_A2 = 92160, L_MBA = 101376, L_PC = 118784, L_WT = 119040, L_MBH = 121088, L_TD = 130304, L_PT = 134912, L_CEND = 139520;
constexpr int L_TT = L_AT, L_A1 = L_BT, L_Y2T = L_MKA, L_G2T = L_ATT;
static_assert(L_CEND <= RING_BYTES, "chunk prep LDS");
constexpr size_t CHW_ITEM = 32768;
__device__ __forceinline__ f32x16 nt_quad(const LAS unsigned char* X, const LAS unsigned char* Y, int qp, int qq, int r, int hh) {
    f32x16 acc;
#pragma unroll
    for (int e = 0; e < 16; ++e) acc[e] = 0.f;
#pragma unroll
    for (int ks = 0; ks < 4; ++ks) { const bf16x8 a = *(const LAS bf16x8*)(Y + (32 * qq + r) * CP + 32 * ks + 16 * hh), b = *(const LAS bf16x8*)(X + (32 * qp + r) * CP + 32 * ks + 16 * hh);
        acc = __builtin_amdgcn_mfma_f32_32x32x16_bf16(a, b, acc, 0, 0, 0); }
    return acc;
}
__device__ __forceinline__ int nt_q(int qq, int e, int hh) { return 32 * qq + (e & 3) + 8 * (e >> 2) + 4 * hh; }
__device__ __forceinline__ void nt_store_bf16(LAS unsigned char* O, int p, int qq, int hh, const f32x16& v) {
#pragma unroll
    for (int g = 0; g < 4; ++g) { u32x2 w; w.x = pk2(v[4 * g], v[4 * g + 1]); w.y = pk2(v[4 * g + 2], v[4 * g + 3]); *(LAS u32x2*)(O + p * CP + (32 * qq + 8 * g + 4 * hh) * 2) = w; }
}
__device__ __forceinline__ void ph4_chunkprep(ArgsP A, Frame& F) {
    unsigned char* ws = A->ws;
    const float* DEC = (const float*)(ws + WS_DEC); const bf16_t* KKN = (const bf16_t*)(ws + WS_KKN); const bf16_t* BBg = (const bf16_t*)(ws + WS_BB); const bf16_t* KPg = (const bf16_t*)(ws + WS_KP);
    const bf16_t* ZR = (const bf16_t*)(ws + WS_ZR); const bf16_t* ZV = (const bf16_t*)(ws + WS_ZV); float* Yg = (float*)(ws + WS_Y); unsigned char* CHW = ws + WS_WIN;
    LAS unsigned char* L = F.lds + RING_OFF; const int wave = F.wave, lane = F.lane, r = lane & 31, hh = lane >> 5;
    const int prod = wave >> 2, qp = (wave >> 1) & 1, qq = wave & 1, p = 32 * qp + r;
    float nwv[8]; bf16_t nkk[8], nbb[8], nkp[8], nr[8], nv[8];
    if (F.vcu < RH * NCHK) { const int h2 = F.vcu / NCHK, c2 = F.vcu % NCHK;
#pragma unroll
        for (int k = 0; k < 8; ++k) { const size_t o = (size_t)(c2 * CK + 8 * wave + k) * RW + (size_t)h2 * RN + lane; nwv[k] = DEC[o]; nkk[k] = KKN[o]; nbb[k] = BBg[o]; nkp[k] = KPg[o]; nr[k] = ZR[o]; nv[k] = ZV[o]; } }
    if (F.vcu == 0 && wave == 0) {
        const gu32* cnt = (const gu32*)(ws + WS_CTL) + CW_CNT; unsigned* ud = (unsigned*)(ws + WS_UDESC); unsigned np[8], tot = 0u;
#pragma unroll
        for (int k = 0; k < 8; ++k) { const unsigned c = __hip_atomic_load(cnt + 8 * lane + k, __ATOMIC_RELAXED, __HIP_MEMORY_SCOPE_AGENT); np[k] = (c + 255u) >> 8; tot += np[k]; }
        unsigned incl = tot;
#pragma unroll
        for (int o = 1; o < 64; o <<= 1) { const unsigned v = __shfl_up(incl, o); if (lane >= o) incl += v; }
        unsigned pos = incl - tot;
#pragma unroll
        for (int k = 0; k < 8; ++k) { const unsigned c = __hip_atomic_load(cnt + 8 * lane + k, __ATOMIC_RELAXED, __HIP_MEMORY_SCOPE_AGENT); for (unsigned ps = 0; ps < np[k]; ++ps) { ud[1 + 2 * pos] = (unsigned)(8 * lane + k) | (ps << 16); ud[2 + 2 * pos] = c; ++pos; } }
        if (lane == 63) ud[0] = incl; }
    int qrow = F.vcu * NWAVES + wave; const int qstride = F.G * NWAVES; f32x4 qv[16];
    for (int item = F.vcu; item < RH * NCHK; item += F.G) { const int h = item / NCHK, c = item % NCHK; const size_t hc = (size_t)h * RN; const int t0 = c * CK;
        const bool qdo = qrow < 2 * 16384; if (qdo) pq_load(A, qrow, lane, qv);
        { float wv[8], kkv[8], bbv[8], kpv[8], rv[8]; bf16_t vv[8];
#pragma unroll
          for (int k = 0; k < 8; ++k) { wv[k] = nwv[k]; kkv[k] = bf1(nkk[k]); bbv[k] = bf1(nbb[k]); kpv[k] = bf1(nkp[k]); rv[k] = bf1(nr[k]); vv[k] = nv[k]; }
          { const int nit = item + F.G; if (nit < RH * NCHK) { const int h2 = nit / NCHK, c2 = nit % NCHK;
#pragma unroll
              for (int k = 0; k < 8; ++k) { const size_t o = (size_t)(c2 * CK + 8 * wave + k) * RW + (size_t)h2 * RN + lane; nwv[k] = DEC[o]; nkk[k] = KKN[o]; nbb[k] = BBg[o]; nkp[k] = KPg[o]; nr[k] = ZR[o]; nv[k] = ZV[o]; } } }
          float pl[8]; pl[0] = wv[0];
#pragma unroll
          for (int k = 1; k < 8; ++k) pl[k] = pl[k - 1] * wv[k];
          ((LAS float*)(L + L_WT))[wave * 64 + lane] = pl[7];
          WG_BAR();
          float pre = 1.f;
#pragma unroll
          for (int w2 = 0; w2 < 7; ++w2) { const float x = ((const LAS float*)(L + L_WT))[w2 * 64 + lane]; pre = (w2 < wave) ? pre * x : pre; }
          unsigned atp[4], btp[4], vtp[4];
#pragma unroll
          for (int k = 0; k < 8; ++k) { const float Pt = pre * pl[k], Pm = (k == 0) ? pre : pre * pl[k - 1], ip = __builtin_amdgcn_rcpf(Pt); const int t = 8 * wave + k;
              const unsigned a16 = f2bf(Pm * kkv[k]), b16 = f2bf(bbv[k] * ip), k16 = f2bf(kpv[k] * ip), r16 = f2bf(Pt * rv[k]);
              *(LAS bf16_t*)(L + L_AT + t * CP + 2 * lane) = (bf16_t)a16; *(LAS bf16_t*)(L + L_BT + t * CP + 2 * lane) = (bf16_t)b16; *(LAS bf16_t*)(L + L_KT + t * CP + 2 * lane) = (bf16_t)k16; *(LAS bf16_t*)(L + L_RT + t * CP + 2 * lane) = (bf16_t)r16;
              if (k & 1) { atp[k >> 1] |= a16 << 16; btp[k >> 1] |= b16 << 16; vtp[k >> 1] |= (unsigned)vv[k] << 16; } else { atp[k >> 1] = a16; btp[k >> 1] = b16; vtp[k >> 1] = (unsigned)vv[k]; }
              if (wave == 7 && k == 7) ((LAS float*)(L + L_PC))[lane] = Pt; }
          *(LAS u32x4*)(L + L_ATT + lane * CP + 16 * wave) = (u32x4){atp[0], atp[1], atp[2], atp[3]}; *(LAS u32x4*)(L + L_BTT + lane * CP + 16 * wave) = (u32x4){btp[0], btp[1], btp[2], btp[3]};
          *(LAS u32x4*)(L + L_V + lane * CP + 16 * wave) = (u32x4){vtp[0], vtp[1], vtp[2], vtp[3]}; }
        WG_BAR();
        { const f32x16 v = nt_quad(L + (prod ? L_KT : L_BT), L + L_AT, qp, qq, r, hh); f32x16 m;
#pragma unroll
          for (int e = 0; e < 16; ++e) m[e] = nt_q(qq, e, hh) > p ? v[e] : 0.f;
          if (prod == 0) {
#pragma unroll
              for (int g = 0; g < 4; ++g) *(LAS f32x4*)(L + L_MBA + p * CPF + (32 * qq + 8 * g + 4 * hh) * 4) = (f32x4){m[4 * g], m[4 * g + 1], m[4 * g + 2], m[4 * g + 3]}; }
          if (prod == 0) nt_store_bf16(L + L_MBH, p, qq, hh, m);
          else nt_store_bf16(L + L_MKA, p, qq, hh, m); }
        { const f32x16 v = nt_quad(L + L_RT, L + (prod ? L_KT : L_BT), qp, qq, r, hh); f32x16 m;
#pragma unroll
          for (int e = 0; e < 16; ++e) m[e] = nt_q(qq, e, hh) <= p ? v[e] : 0.f;
          nt_store_bf16(L + (prod ? L_MKRT : L_MBRT), p, qq, hh, m); }
        WG_BAR();
        { const int t = 8 * wave + (lane >> 3), g = lane & 7, base = 32 * (t >> 5); float T4[4] = {0.f, 0.f, 0.f, 0.f};
          const LAS unsigned char* mrow = L + L_MBA + (base + 4 * g) * 4;
          f32x4 m = *(const LAS f32x4*)(mrow + (base + 31) * CPF);
#pragma unroll 1
          for (int Sx = 7; Sx >= 0; --Sx) {
#pragma unroll
              for (int q = 3; q >= 0; --q) { const int sl = 4 * Sx + q, sr = base + sl, sn = sl > 0 ? sr - 1 : sr; const f32x4 n = *(const LAS f32x4*)(mrow + sn * CPF);
                  float part = (m[0] * T4[0] + m[1] * T4[1]) + (m[2] * T4[2] + m[3] * T4[3]);
                  part += dpp_f<0xB1>(part); part += dpp_f<0x4E>(part); part += dpp_f<0x141>(part);
                  const float val = (sr == t) ? 1.0f : part; T4[q] = (g == Sx) ? val : T4[q]; m = n; } }
          const unsigned w0 = pk2(T4[0], T4[1]), w1 = pk2(T4[2], T4[3]);
          *(LAS u32x2*)(L + L_TT + t * CP + (base + 4 * g) * 2) = (u32x2){w0, w1};
          if (base == 0) { *(LAS u32x2*)(L + L_TT + t * CP + (32 + 4 * g) * 2) = (u32x2){0u, 0u};
              *(LAS bf16_t*)(L + L_TD + (4 * g) * CP + 2 * t) = (bf16_t)(w0 & 0xffffu); *(LAS bf16_t*)(L + L_TD + (4 * g + 1) * CP + 2 * t) = (bf16_t)(w0 >> 16);
              *(LAS bf16_t*)(L + L_TD + (4 * g + 2) * CP + 2 * t) = (bf16_t)(w1 & 0xffffu); *(LAS bf16_t*)(L + L_TD + (4 * g + 3) * CP + 2 * t) = (bf16_t)(w1 >> 16); } }
        WG_BAR();
        if (wave == 0) {
            f32x16 acc;
#pragma unroll
            for (int e = 0; e < 16; ++e) acc[e] = 0.f;
#pragma unroll
            for (int ks = 0; ks < 2; ++ks) { const bf16x8 a = *(const LAS bf16x8*)(L + L_MBH + r * CP + 64 + 32 * ks + 16 * hh), b = *(const LAS bf16x8*)(L + L_TT + (32 + r) * CP + 64 + 32 * ks + 16 * hh);
                acc = __builtin_amdgcn_mfma_f32_32x32x16_bf16(a, b, acc, 0, 0, 0); }
            nt_store_bf16(L + L_PT, r, 0, hh, acc);
            LDS_WAIT(); asm volatile("" ::: "memory");
#pragma unroll
            for (int e = 0; e < 16; ++e) acc[e] = 0.f;
#pragma unroll
            for (int ks = 0; ks < 2; ++ks) { const bf16x8 a = *(const LAS bf16x8*)(L + L_TD + r * CP + 32 * ks + 16 * hh), b = *(const LAS bf16x8*)(L + L_PT + r * CP + 32 * ks + 16 * hh);
                acc = __builtin_amdgcn_mfma_f32_32x32x16_bf16(a, b, acc, 0, 0, 0); }
            nt_store_bf16(L + L_TT, 32 + r, 0, hh, acc);
        }
        WG_BAR();
        { const f32x16 v = nt_quad(L + (prod ? L_MKA : L_ATT), L + L_TT, qp, qq, r, hh);
          nt_store_bf16(L + (prod ? L_A2 : L_A1), p, qq, hh, v); }
        WG_BAR();
        unsigned char* cw = CHW + (size_t)item * CHW_ITEM;
        { const f32x16 v = nt_quad(L + L_MBRT, L + (prod ? L_A2 : L_A1), qp, qq, r, hh); f32x16 o;
          const LAS unsigned char* addm = L + (prod ? L_MKRT : L_RT);
#pragma unroll
          for (int g = 0; g < 4; ++g) { const u32x2 w = *(const LAS u32x2*)(addm + p * CP + (32 * qq + 8 * g + 4 * hh) * 2); o[4 * g] = v[4 * g] + bflo(w.x); o[4 * g + 1] = v[4 * g + 1] + bfhi(w.x); o[4 * g + 2] = v[4 * g + 2] + bflo(w.y); o[4 * g + 3] = v[4 * g + 3] + bfhi(w.y); }
          if (prod) nt_store_bf16(L + L_Y2T, p, qq, hh, o);
          else {
#pragma unroll
              for (int g = 0; g < 4; ++g) { u32x2 w; w.x = pk2(o[4 * g], o[4 * g + 1]); w.y = pk2(o[4 * g + 2], o[4 * g + 3]); *(u32x2*)(cw + (size_t)p * 128 + (32 * qq + 8 * g + 4 * hh) * 2) = w; } } }
        { const f32x16 v = nt_quad(L + L_BTT, L + (prod ? L_A2 : L_A1), qp, qq, r, hh); const float pc = ((const LAS float*)(L + L_PC))[p]; f32x16 o;
          if (prod) {
#pragma unroll
              for (int e = 0; e < 16; ++e) o[e] = (v[e] + bf1(*(const LAS bf16_t*)(L + L_KT + nt_q(qq, e, hh) * CP + 2 * p))) * pc;
              nt_store_bf16(L + L_G2T, p, qq, hh, o); }
          else {
#pragma unroll
              for (int e = 0; e < 16; ++e) o[e] = (v[e] + (nt_q(qq, e, hh) == p ? 1.0f : 0.0f)) * pc;
#pragma unroll
              for (int g = 0; g < 4; ++g) { u32x2 w; w.x = pk2(o[4 * g], o[4 * g + 1]); w.y = pk2(o[4 * g + 2], o[4 * g + 3]); *(u32x2*)(cw + 8192 + (size_t)p * 128 + (32 * qq + 8 * g + 4 * hh) * 2) = w; } } }
        WG_BAR();
        { const f32x16 v = prod ? nt_quad(L + L_V, L + L_G2T, qp, qq, r, hh) : nt_quad(L + L_Y2T, L + L_V, qp, qq, r, hh);
          float* dst = prod ? (float*)(cw + 16384) + (size_t)p * 64 : Yg + (size_t)(t0 + p) * RW + hc;
#pragma unroll
          for (int g = 0; g < 4; ++g) *(f32x4*)(dst + 32 * qq + 8 * g + 4 * hh) = (f32x4){v[4 * g], v[4 * g + 1], v[4 * g + 2], v[4 * g + 3]}; }
        if (qdo) { pq_finish(ws, qrow, lane, qv); qrow += qstride; }
        WG_BAR();
    }
    for (; qrow < 2 * 16384; qrow += qstride) { pq_load(A, qrow, lane, qv); pq_finish(ws, qrow, lane, qv); }
}
__device__ __forceinline__ void ph5_chain(ArgsP A, Frame& F, int h) {
    unsigned char* ws = A->ws; float* Yg = (float*)(ws + WS_Y); const unsigned char* CHW = ws + WS_WIN;
    LAS unsigned char* L = F.lds + RING_OFF; const int wave = F.wave, lane = F.lane, tid = F.tid, r = lane & 31, hh = lane >> 5;
    const int prod = wave >> 2, qp = (wave >> 1) & 1, qq = wave & 1, p = 32 * qp + r; const size_t hc = (size_t)h * RN;
    constexpr int L_S = 0, L_G = 2 * 9216, L_Y1 = 3 * 9216;
    for (int i = tid; i < 2 * 9216 / 4; i += NTHR) ((LAS unsigned*)(L + L_S))[i] = 0u;
    const int srow = tid >> 3, sc16 = tid & 7; u32x4 sg, sy;
    auto stage_ld = [&](int c) { const unsigned char* cw = CHW + (size_t)(h * NCHK + c) * CHW_ITEM; sy = *(const u32x4*)(cw + srow * 128 + sc16 * 16); sg = *(const u32x4*)(cw + 8192 + srow * 128 + sc16 * 16); };
    f32x4 nad[4];
    auto ad_ld = [&](int c) { const unsigned char* cw2 = CHW + (size_t)(h * NCHK + c) * CHW_ITEM; const float* addp = prod ? Yg + (size_t)(c * CK + p) * RW + hc : (const float*)(cw2 + 16384) + (size_t)p * 64;
#pragma unroll
        for (int g = 0; g < 4; ++g) nad[g] = *(const f32x4*)(addp + 32 * qq + 8 * g + 4 * hh); };
    stage_ld(0); ad_ld(0);
    int sb = 0;
    for (int c = 0; c < NCHK; ++c) {
        *(LAS u32x4*)(L + L_Y1 + srow * CP + sc16 * 16) = sy; *(LAS u32x4*)(L + L_G + srow * CP + sc16 * 16) = sg;
        const unsigned char* cw = CHW + (size_t)(h * NCHK + c) * CHW_ITEM;
        f32x4 ad[4];
#pragma unroll
        for (int g = 0; g < 4; ++g) ad[g] = nad[g];
        if (c + 1 < NCHK) { stage_ld(c + 1); ad_ld(c + 1); }
        WG_BAR();
        const f32x16 v = prod ? nt_quad(L + L_Y1, L + L_S + sb * 9216, qp, qq, r, hh) : nt_quad(L + L_S + sb * 9216, L + L_G, qp, qq, r, hh);
        f32x16 o;
#pragma unroll
        for (int g = 0; g < 4; ++g) { o[4 * g] = v[4 * g] + ad[g][0]; o[4 * g + 1] = v[4 * g + 1] + ad[g][1]; o[4 * g + 2] = v[4 * g + 2] + ad[g][2]; o[4 * g + 3] = v[4 * g + 3] + ad[g][3]; }
        if (prod) { float* yp = Yg + (size_t)(c * CK + p) * RW + hc;
#pragma unroll
            for (int g = 0; g < 4; ++g) *(f32x4*)(yp + 32 * qq + 8 * g + 4 * hh) = (f32x4){o[4 * g], o[4 * g + 1], o[4 * g + 2], o[4 * g + 3]}; }
        else nt_store_bf16(L + L_S + (sb ^ 1) * 9216, p, qq, hh, o);
        sb ^= 1;
        WG_BAR();
    }
}

__device__ __forceinline__ void ph5_ypost(ArgsP A, Frame& F) {
    unsigned char* ws = A->ws; const float* Y = (const float*)(ws + WS_Y); const bf16_t* ZR = (const bf16_t*)(ws + WS_ZR); const bf16_t* KP = (const bf16_t*)(ws + WS_KP); const bf16_t* ZV = (const bf16_t*)(ws + WS_ZV);
    const bf16_t* G = (const bf16_t*)(ws + WS_G); bf16_t* YA = (bf16_t*)(ws + WS_YA);
    const int gw = F.vcu * NWAVES + F.wave, NGW = F.G * NWAVES;
    for (int tg = F.vcu; tg < T / 32; tg += F.G) for (int it = F.wave; it < 256; it += NWAVES) { const int t = tg * 32 + (it >> 3), c = (it & 7) * 256 + 4 * F.lane; const size_t o = (size_t)t * RW + c;
        const f32x4 y = *(const f32x4*)(Y + o); const float mean = sum16((y[0] + y[1]) + (y[2] + y[3])) * (1.0f / 64.0f); const f32x4 d = y - mean;
        const float var = sum16((d[0] * d[0] + d[1] * d[1]) + (d[2] * d[2] + d[3] * d[3])) * (1.0f / 64.0f); const float rs = 1.0f / sqrtf(var + LNX_EPS);
        const f32x4 r = ld4bf(ZR + o), k = ld4bf(KP + o), v = ld4bf(ZV + o), g = ld4bf(G + o), rk = *(const f32x4*)(A->r_k + c), lg = *(const f32x4*)(A->lnx_g + c), lb = *(const f32x4*)(A->lnx_b + c);
        const f32x4 rkk = r * k * rk; const float bonus = sum16((rkk[0] + rkk[1]) + (rkk[2] + rkk[3]));
        st4bf(YA + o, (d * rs * lg + lb + bonus * v) * g); }
}

constexpr int AT_KB = 64 * 256, AT_VB = 128 * 128, AT_BUF = AT_KB + AT_VB;
static_assert(3 * AT_BUF <= RING_BYTES, "attention LDS");
__device__ __forceinline__ void q8_load(u32x4 (&q)[8], const void* p) {
    asm volatile("global_load_dwordx4 %0, %8, off\n\tglobal_load_dwordx4 %1, %8, off offset:32\n\tglobal_load_dwordx4 %2, %8, off offset:64\n\tglobal_load_dwordx4 %3, %8, off offset:96\n\t"
                 "global_load_dwordx4 %4, %8, off offset:128\n\tglobal_load_dwordx4 %5, %8, off offset:160\n\tglobal_load_dwordx4 %6, %8, off offset:192\n\tglobal_load_dwordx4 %7, %8, off offset:224"
                 : "=&v"(q[0]), "=&v"(q[1]), "=&v"(q[2]), "=&v"(q[3]), "=&v"(q[4]), "=&v"(q[5]), "=&v"(q[6]), "=&v"(q[7]) : "v"(p) : "memory"); }
__device__ __forceinline__ void q8_settle(u32x4 (&q)[8]) {
#pragma unroll
    for (int i = 0; i < 8; ++i) asm volatile("" : "+v"(q[i])); }
__device__ __forceinline__ unsigned u16_load(const void* p) { unsigned v; asm volatile("global_load_ushort %0, %1, off" : "=&v"(v) : "v"(p) : "memory"); return v; }
__device__ __forceinline__ void ph5_attn(ArgsP A, Frame& F) {
    unsigned char* ws = A->ws; const bf16_t* PROJ = (const bf16_t*)(ws + WS_PROJ); const bf16_t* VT = (const bf16_t*)(ws + WS_VT); const bf16_t* KBp = (const bf16_t*)(ws + WS_KB);
    bf16_t* PO = (bf16_t*)(ws + WS_PARTO); float* PML = (float*)(ws + WS_PARTML); const unsigned short* LST = (const unsigned short*)(ws + WS_LIST); const unsigned* UD = (const unsigned*)(ws + WS_UDESC);
    LAS unsigned char* L = F.lds + RING_OFF; const int wave = F.wave, lane = F.lane, r = lane & 31, hh = lane >> 5;
    const float NEG = -__builtin_inff();
    const int NA = MH * NBLK, N = NA + (int)UD[0], w = F.vcu, nfree = F.G - RH; const bool chainwg = w < RH;
    auto unit_of = [&](int k) { return k * nfree + (w - RH); };
    int k = 0;
    if (chainwg) return;
    if (unit_of(k) >= N) return;
    int h, kblk, qtok, slot; bool typeA, valid, wvalid;
    { const int u = unit_of(k); typeA = u < NA;
      if (typeA) { h = u & 15; kblk = u >> 4; qtok = kblk * MBLK + wave * 32 + r; slot = 3; valid = true; wvalid = true; }
      else { const unsigned d = UD[1 + 2 * (u - NA)]; const int cnt = (int)UD[2 + 2 * (u - NA)]; const int Lx = (int)(d & 0xffffu), ps = (int)(d >> 16); h = Lx >> 5; kblk = Lx & 31;
          const int idx = ps * 256 + wave * 32 + r; valid = idx < cnt; wvalid = ps * 256 + wave * 32 < cnt; unsigned e = u16_load(LST + (size_t)Lx * 8192 + (valid ? idx : 0));
          asm volatile("s_waitcnt vmcnt(0)" ::: "memory"); asm volatile("" : "+v"(e)); qtok = (int)(e & 0x1fffu); slot = (int)(e >> 13); }
      h = __builtin_amdgcn_readfirstlane(h); kblk = __builtin_amdgcn_readfirstlane(kblk); }
    u32x4 qf[8], qfn[8];
    q8_load(qf, PROJ + (size_t)qtok * PLD + PC_MQ + h * MD + 8 * hh);
    const int krow_ = lane >> 4, kslot = lane & 15, vrow_ = lane >> 3, vslot = lane & 7;
    auto dma_tile = [&](int hd, int kb_, int n, int b3) { const int tb = kb_ * MBLK + n * 64; LAS unsigned char* B = L + b3 * AT_BUF;
#pragma unroll
        for (int i = 0; i < 2; ++i) { const int p = wave * 2 + i, row = 4 * p + krow_, c = kslot ^ (row & 15);
            __builtin_amdgcn_global_load_lds((const unsigned*)(KBp + ((size_t)hd * T + tb + row) * MD + 8 * c), (LAS unsigned*)(B + p * 1024), 16, 0, 0); }
#pragma unroll
        for (int i = 0; i < 2; ++i) { const int p = wave * 2 + i, row = 8 * p + vrow_, c = vslot ^ ((row >> 1) & 7);
            __builtin_amdgcn_global_load_lds((const unsigned*)(VT + ((size_t)(hd * (T / 64) + kb_ * 4 + n) * MD + row) * 64 + 8 * c), (LAS unsigned*)(B + AT_KB + p * 1024), 16, 0, 0); } };
    dma_tile(h, kblk, 0, 0); dma_tile(h, kblk, 1, 1);
    asm volatile("s_waitcnt vmcnt(4)" ::: "memory"); q8_settle(qf); WG_BAR();
    int b3 = 0;
    for (;;) {
        const int un = unit_of(k + 1); const bool has_next = un < N, nA = un < NA;
        int hN = 0, kblkN = 0, qtokN = 0, slotN = 3, LxN = 0, idxN = 0, cntN = 0; bool validN = true, wvalidN = true; unsigned udw = 0u, udc = 0u, entN = 0u;
        f32x16 o[4];
#pragma unroll
        for (int db = 0; db < 4; ++db)
#pragma unroll
            for (int e = 0; e < 16; ++e) o[db][e] = 0.f;
        float mrun = NEG, lrun = 0.f;
#pragma unroll
        for (int n = 0; n < 4; ++n) {
            if (has_next) {
                if (n == 0) { if (nA) { hN = un & 15; kblkN = un >> 4; } else { udw = UD[1 + 2 * (un - NA)]; udc = UD[2 + 2 * (un - NA)]; } }
                if (n == 1) { if (nA) { qtokN = kblkN * MBLK + wave * 32 + r; } else { LxN = (int)(udw & 0xffffu); const int ps = (int)(udw >> 16); cntN = (int)udc; hN = LxN >> 5; kblkN = LxN & 31;
                                  idxN = ps * 256 + wave * 32 + r; validN = idxN < cntN; wvalidN = ps * 256 + wave * 32 < cntN; entN = u16_load(LST + (size_t)LxN * 8192 + (validN ? idxN : 0)); }
                              hN = __builtin_amdgcn_readfirstlane(hN); kblkN = __builtin_amdgcn_readfirstlane(kblkN); }
                if (n == 2) { if (!nA) { qtokN = (int)(entN & 0x1fffu); slotN = (int)(entN >> 13); }
                              q8_load(qfn, PROJ + (size_t)qtokN * PLD + PC_MQ + hN * MD + 8 * hh); }
            }
            const int bn = b3 >= 1 ? b3 - 1 : 2; bool issued = false;
            if (n < 2) { dma_tile(h, kblk, n + 2, bn); issued = true; } else if (has_next) { dma_tile(hN, kblkN, n - 2, bn); issued = true; }
            const bool need = typeA ? (n <= (wave >> 1)) : wvalid;
            if (need) {
                const LAS unsigned char* KB = L + b3 * AT_BUF; const LAS unsigned char* VB = KB + AT_KB;
                f32x16 s[2];
#pragma unroll
                for (int kb = 0; kb < 2; ++kb) {
#pragma unroll
                    for (int e = 0; e < 16; ++e) s[kb][e] = 0.f;
#pragma unroll
                    for (int ks = 0; ks < 8; ++ks) { const bf16x8 a = *(const LAS bf16x8*)(KB + (32 * kb + r) * 256 + (((2 * ks + hh) ^ (r & 15)) << 4)); s[kb] = __builtin_amdgcn_mfma_f32_32x32x16_bf16(a, __builtin_bit_cast(bf16x8, qf[ks]), s[kb], 0, 0, 0); } }
                if (typeA && 64 * n + 63 > wave * 32) { const int qrel = wave * 32 + r;
#pragma unroll
                    for (int kb = 0; kb < 2; ++kb)
#pragma unroll
                        for (int e = 0; e < 16; ++e) { const int krel = 64 * n + 32 * kb + (e & 3) + 8 * (e >> 2) + 4 * hh; if (krel > qrel) s[kb][e] = NEG; } }
                float mx = s[0][0];
#pragma unroll
                for (int kb = 0; kb < 2; ++kb)
#pragma unroll
                    for (int e = 0; e < 16; ++e) mx = fmaxf(mx, s[kb][e]);
                mx = fmaxf(mx, __shfl_xor(mx, 32));
                const float mnew = fmaxf(mrun, mx); const float alpha = __builtin_amdgcn_exp2f(mrun - mnew); mrun = mnew;
                float ps = 0.f;
#pragma unroll
                for (int kb = 0; kb < 2; ++kb)
#pragma unroll
                    for (int e = 0; e < 16; ++e) { const float p = __builtin_amdgcn_exp2f(s[kb][e] - mnew); s[kb][e] = p; ps += p; }
                lrun = lrun * alpha + ps;
                if (__ballot(alpha != 1.0f) != 0ull) {
#pragma unroll
                    for (int db = 0; db < 4; ++db)
#pragma unroll
                        for (int e = 0; e < 16; ++e) o[db][e] *= alpha; }
#pragma unroll
                for (int kb = 0; kb < 2; ++kb)
#pragma unroll
                    for (int st = 0; st < 2; ++st) { u32x4 pw; pw.x = pk2(s[kb][8 * st + 0], s[kb][8 * st + 1]); pw.y = pk2(s[kb][8 * st + 2], s[kb][8 * st + 3]); pw.z = pk2(s[kb][8 * st + 4], s[kb][8 * st + 5]); pw.w = pk2(s[kb][8 * st + 6], s[kb][8 * st + 7]);
                        const bf16x8 pf = __builtin_bit_cast(bf16x8, pw);
#pragma unroll
                        for (int db = 0; db < 4; ++db) { const bf16x8 vf = *(const LAS bf16x8*)(VB + (32 * db + r) * 128 + (((4 * kb + 2 * st + hh) ^ ((r >> 1) & 7)) << 4));
                            o[db] = __builtin_amdgcn_mfma_f32_32x32x16_bf16(vf, pf, o[db], 0, 0, 0); } }
            }
            if (issued) asm volatile("s_waitcnt vmcnt(4)" ::: "memory"); else asm volatile("s_waitcnt vmcnt(0)" ::: "memory");
            if (n == 1) asm volatile("" : "+v"(entN));
            if (n == 2) q8_settle(qfn);
            b3 = b3 == 2 ? 0 : b3 + 1;
            WG_BAR();
        }
        { const float ltot = lrun + __shfl_xor(lrun, 32);
          if (valid) { const float inv = 1.0f / ltot; const size_t pi = ((size_t)qtok * MH + h) * 4 + slot; bf16_t* op = PO + pi * MD;
#pragma unroll
            for (int db = 0; db < 4; ++db)
#pragma unroll
                for (int g = 0; g < 4; ++g) { u32x2 wv; wv.x = pk2(o[db][4 * g] * inv, o[db][4 * g + 1] * inv); wv.y = pk2(o[db][4 * g + 2] * inv, o[db][4 * g + 3] * inv); *(u32x2*)(op + 32 * db + 8 * g + 4 * hh) = wv; }
            if (hh == 0) *(f32x2*)(PML + pi * 2) = (f32x2){mrun, ltot}; } }
        if (!has_next) break;
        h = hN; kblk = kblkN; qtok = qtokN; slot = slotN; typeA = nA; valid = nA ? true : validN; wvalid = nA ? true : wvalidN; ++k;
#pragma unroll
        for (int ks = 0; ks < 8; ++ks) qf[ks] = qfn[ks];
    }
}
__device__ __forceinline__ void ph6_merge(ArgsP A, Frame& F) {
    unsigned char* ws = A->ws; const bf16_t* PO = (const bf16_t*)(ws + WS_PARTO); const float* PML = (const float*)(ws + WS_PARTML); bf16_t* YB = (bf16_t*)(ws + WS_YB);
    const int gw = F.vcu * NWAVES + F.wave, NGW = F.G * NWAVES, hl = F.lane >> 5, dg = F.lane & 31;
    for (int it0 = gw * 4; it0 < T * 8; it0 += NGW * 4) {
        u32x2 ov[4][4]; f32x2 ml[4][4];
#pragma unroll
        for (int k = 0; k < 4; ++k) { const int it = it0 + k, t = it >> 3, h = 2 * (it & 7) + hl; const size_t pi = ((size_t)t * MH + h) * 4;
#pragma unroll
            for (int sl = 0; sl < 4; ++sl) { ov[k][sl] = *(const u32x2*)(PO + (pi + sl) * MD + 4 * dg); ml[k][sl] = *(const f32x2*)(PML + (pi + sl) * 2); } }
#pragma unroll
        for (int k = 0; k < 4; ++k) { const int it = it0 + k, t = it >> 3, h = 2 * (it & 7) + hl, blk = t >> 8, nsel = blk < 3 ? blk : 3;
            float mmax = ml[k][3][0];
#pragma unroll
            for (int sl = 0; sl < 3; ++sl) if (sl < nsel) mmax = fmaxf(mmax, ml[k][sl][0]);
            f32x4 acc = (f32x4){0.f, 0.f, 0.f, 0.f}; float wsum = 0.f;
#pragma unroll
            for (int sl = 0; sl < 4; ++sl) { if (sl == 3 || sl < nsel) { const float w = ml[k][sl][1] * __builtin_amdgcn_exp2f(ml[k][sl][0] - mmax); wsum += w;
                acc += w * (f32x4){bflo(ov[k][sl].x), bfhi(ov[k][sl].x), bflo(ov[k][sl].y), bfhi(ov[k][sl].y)}; } }
            const float inv = 1.0f / wsum; st4bf(YB + (size_t)t * RW + h * MD + 4 * dg, acc * inv); }
    }
}

__device__ __forceinline__ void ins16(float (&top)[16], float x) {
#pragma unroll
    for (int k = 15; k >= 1; --k) top[k] = __builtin_amdgcn_fmed3f(top[k - 1], top[k], x);
    top[0] = fmaxf(top[0], x);
}
__device__ __forceinline__ void ph10_select(ArgsP A, Frame& F) {
    unsigned char* ws = A->ws; const bf16_t* PQ = (const bf16_t*)(ws + WS_PQ); const bf16_t* SK = (const bf16_t*)(ws + WS_SUBK); int* IDX = (int*)(ws + WS_IDX); float* GW = (float*)(ws + WS_GW);
    const int gw = F.vcu * NWAVES + F.wave, NGW = F.G * NWAVES; const int r = F.lane & 31, hh = F.lane >> 5; const float NEG = -__builtin_inff();
    for (int it = gw; it < (T / 32) * PH_; it += NGW) { const int tg = it >> 3, h = it & 7, t = tg * 32 + r;
        float TA[16], TB[16];
        auto topk = [&](int p, float (&dst)[16]) {
            bf16x8 qf[8];
#pragma unroll
            for (int ks = 0; ks < 8; ++ks) qf[ks] = *(const bf16x8*)(PQ + (size_t)t * 2048 + (h * 2 + p) * PHALF + 16 * ks + 8 * hh);
            float top[16];
#pragma unroll
            for (int k = 0; k < 16; ++k) top[k] = NEG;
#pragma unroll 1
            for (int nb = 0; nb < 4; ++nb) { f32x16 acc;
#pragma unroll
                for (int e = 0; e < 16; ++e) acc[e] = 0.f;
#pragma unroll
                for (int ks = 0; ks < 8; ++ks) { const bf16x8 a = *(const bf16x8*)(SK + ((size_t)(h * 2 + p) * PNK + 32 * nb + r) * PHALF + 16 * ks + 8 * hh); acc = __builtin_amdgcn_mfma_f32_32x32x16_bf16(a, qf[ks], acc, 0, 0, 0); }
#pragma unroll
                for (int e = 0; e < 16; ++e) { const unsigned key = 32 * nb + (e & 3) + 8 * (e >> 2) + 4 * hh; float ae = acc[e]; asm volatile("" : "+v"(ae));
                    const float x = __builtin_bit_cast(float, (__builtin_bit_cast(unsigned, ae) & ~0x7Fu) | key); ins16(top, x); } }
            float oth[16];
#pragma unroll
            for (int k = 0; k < 16; ++k) oth[k] = __shfl_xor(top[k], 32);
#pragma unroll
            for (int k = 0; k < 16; ++k) ins16(top, oth[k]);
#pragma unroll
            for (int k = 0; k < 16; ++k) dst[k] = top[k];
        };
        topk(0, TA); asm volatile("" ::: "memory"); __builtin_amdgcn_sched_barrier(0); topk(1, TB); asm volatile("" ::: "memory"); __builtin_amdgcn_sched_barrier(0);
        float fin[16];
#pragma unroll
        for (int k = 0; k < 16; ++k) fin[k] = NEG;
#pragma unroll
        for (int i = 0; i < 16; ++i)
#pragma unroll
            for (int j = 0; j < 16; ++j) if ((i + 1) * (j + 1) <= 16) { const float sm = TA[i] + TB[j]; ins16(fin, __builtin_bit_cast(float, (__builtin_bit_cast(unsigned, sm) & ~0xFFu) | (unsigned)(i * 16 + j))); }
        float e[16], den = 0.f;
#pragma unroll
        for (int k = 0; k < 16; ++k) { e[k] = __expf(fin[k] - fin[0]); den += e[k]; }
        const float rden = 1.0f / den;
        int oi[8]; float og[8];
#pragma unroll
        for (int kk = 0; kk < 8; ++kk) { const float fv = hh ? fin[8 + kk] : fin[kk]; og[kk] = (hh ? e[8 + kk] : e[kk]) * rden; const unsigned id = __builtin_bit_cast(unsigned, fv) & 0xFFu; const unsigned ci = id >> 4, cj = id & 15u;
            unsigned ia = 0u, ib = 0u;
#pragma unroll
            for (int q = 0; q < 16; ++q) { ia = (ci == (unsigned)q) ? (__builtin_bit_cast(unsigned, TA[q]) & 0x7Fu) : ia; ib = (cj == (unsigned)q) ? (__builtin_bit_cast(unsigned, TB[q]) & 0x7Fu) : ib; }
            oi[kk] = (int)(ia * PNK + ib); }
        int* ip = IDX + (size_t)t * 128 + h * 16 + 8 * hh; float* gp = GW + (size_t)t * 128 + h * 16 + 8 * hh;
        *(u32x4*)ip = (u32x4){(unsigned)oi[0], (unsigned)oi[1], (unsigned)oi[2], (unsigned)oi[3]}; *(u32x4*)(ip + 4) = (u32x4){(unsigned)oi[4], (unsigned)oi[5], (unsigned)oi[6], (unsigned)oi[7]};
        *(f32x4*)gp = (f32x4){og[0], og[1], og[2], og[3]}; *(f32x4*)(gp + 4) = (f32x4){og[4], og[5], og[6], og[7]};
    }
}


__device__ __forceinline__ float ub0(unsigned w) { return (float)(w & 0xffu); }
__device__ __forceinline__ float ub1(unsigned w) { return (float)((w >> 8) & 0xffu); }
__device__ __forceinline__ float ub2(unsigned w) { return (float)((w >> 16) & 0xffu); }
__device__ __forceinline__ float ub3(unsigned w) { return (float)(w >> 24); }
__device__ __forceinline__ float dot16q(u32x4 q, const float (&h)[16]) {
    return ((ub0(q.x) * h[0] + ub1(q.x) * h[1]) + (ub2(q.x) * h[2] + ub3(q.x) * h[3])) + ((ub0(q.y) * h[4] + ub1(q.y) * h[5]) + (ub2(q.y) * h[6] + ub3(q.y) * h[7]))
         + ((ub0(q.z) * h[8] + ub1(q.z) * h[9]) + (ub2(q.z) * h[10] + ub3(q.z) * h[11])) + ((ub0(q.w) * h[12] + ub1(q.w) * h[13]) + (ub2(q.w) * h[14] + ub3(q.w) * h[15]));
}
__device__ __forceinline__ void ph11_gather(ArgsP A, Frame& F) {
    unsigned char* ws = A->ws; const bf16_t* H2 = (const bf16_t*)(ws + WS_H2); const unsigned char* PU = (const unsigned char*)(ws + WS_PU); const unsigned char* PV = (const unsigned char*)(ws + WS_PV);
    const float* PSU = (const float*)(ws + WS_PSU); const float* PSV = (const float*)(ws + WS_PSV);
    const int* IDX = (const int*)(ws + WS_IDX); const float* GW = (const float*)(ws + WS_GW); const float* X1 = (const float*)(ws + WS_X1);
    LAS float* coef = (LAS float*)(F.lds + RING_OFF); LAS int* eidx = (LAS int*)(F.lds + RING_OFF + 1024); LAS float* red = (LAS float*)(F.lds + RING_OFF + 2048);
    const int tid = F.tid, wave = F.wave, lane = F.lane; int par = 0;
    for (int t = F.vcu; t < T; t += F.G, par ^= 1) {
        float hv[4][16]; float hs = 0.f;
#pragma unroll
        for (int i = 0; i < 4; ++i) { const bf16_t* hp = H2 + (size_t)t * D + i * 1024 + lane * 16; f32x4 a, b, c, d; pg8::unpack8(*(const u32x4*)hp, a, b); pg8::unpack8(*(const u32x4*)(hp + 8), c, d);
#pragma unroll
            for (int e = 0; e < 4; ++e) { hv[i][e] = a[e]; hv[i][4 + e] = b[e]; hv[i][8 + e] = c[e]; hv[i][12 + e] = d[e]; }
            hs += ((a[0] + a[1]) + (a[2] + a[3])) + ((b[0] + b[1]) + (b[2] + b[3])) + ((c[0] + c[1]) + (c[2] + c[3])) + ((d[0] + d[1]) + (d[2] + d[3])); }
        hs = wave_sum(hs);
        const int myidx = (lane < 16) ? IDX[(size_t)t * 128 + wave * 16 + lane] : 0; const float myg = (lane < 16) ? GW[(size_t)t * 128 + wave * 16 + lane] : 0.f;
        float dots = 0.f;
#pragma unroll 1
        for (int k = 0; k < 16; k += 4) {
            u32x4 q[4][4];
#pragma unroll
            for (int x = 0; x < 4; ++x) { const int e = __builtin_amdgcn_readlane(myidx, k + x); const unsigned char* up = PU + (size_t)e * D + lane * 16;
#pragma unroll
                for (int i = 0; i < 4; ++i) q[x][i] = *(const u32x4*)(up + i * 1024); }
#pragma unroll
            for (int x = 0; x < 4; ++x) { float d = 0.f;
#pragma unroll
                for (int i = 0; i < 4; ++i) d += dot16q(q[x][i], hv[i]);
                d = wave_sum(d); if (lane == k + x) dots = d; }
        }
        if (lane < 16) { const float s = PSU[myidx] * (dots - 128.0f * hs); const float act = 0.5f * s * (1.0f + erff(s * 0.70710678118654752f));
            coef[par * 128 + wave * 16 + lane] = myg * act * PSV[myidx]; eidx[par * 128 + wave * 16 + lane] = myidx; }
        WG_BAR();
        float acc[8]; float csum = 0.f;
#pragma unroll
        for (int i = 0; i < 8; ++i) acc[i] = 0.f;
#pragma unroll 1
        for (int e = 0; e < 128; e += 16) { u32x2 v[16]; float c[16];
#pragma unroll
            for (int q = 0; q < 16; ++q) { const int ei = __builtin_amdgcn_readfirstlane(eidx[par * 128 + e + q]); c[q] = coef[par * 128 + e + q]; v[q] = *(const u32x2*)(PV + (size_t)ei * D + tid * 8); }
#pragma unroll
            for (int q = 0; q < 16; ++q) { csum += c[q]; acc[0] += c[q] * ub0(v[q].x); acc[1] += c[q] * ub1(v[q].x); acc[2] += c[q] * ub2(v[q].x); acc[3] += c[q] * ub3(v[q].x); acc[4] += c[q] * ub0(v[q].y); acc[5] += c[q] * ub1(v[q].y); acc[6] += c[q] * ub2(v[q].y); acc[7] += c[q] * ub3(v[q].y); } }
        const float corr = -128.0f * csum;
        const f32x4 x0 = *(const f32x4*)(X1 + (size_t)t * D + tid * 8), x1 = *(const f32x4*)(X1 + (size_t)t * D + tid * 8 + 4);
        f32x4 y0 = x0 + ((f32x4){acc[0], acc[1], acc[2], acc[3]} + corr), y1 = x1 + ((f32x4){acc[4], acc[5], acc[6], acc[7]} + corr);
        float ss = (y0[0] * y0[0] + y0[1] * y0[1]) + (y0[2] * y0[2] + y0[3] * y0[3]) + (y1[0] * y1[0] + y1[1] * y1[1]) + (y1[2] * y1[2] + y1[3] * y1[3]);
        ss = wave_sum(ss); if (lane == 0) red[par * 8 + wave] = ss;
        WG_BAR();
        float tot = 0.f;
#pragma unroll
        for (int w = 0; w < 8; ++w) tot += red[par * 8 + w];
        const float rs = 1.0f / sqrtf(tot * (1.0f / D) + NORM_EPS);
        const f32x4 g0 = *(const f32x4*)(A->final_g + tid * 8), g1 = *(const f32x4*)(A->final_g + tid * 8 + 4);
        *(f32x4*)(A->out + (size_t)t * D + tid * 8) = y0 * rs * g0; *(f32x4*)(A->out + (size_t)t * D + tid * 8 + 4) = y1 * rs * g1;
    }
}

constexpr int NPH = 13;
__device__ __forceinline__ Frame make_frame(unsigned char* lds) {
    Frame F; int t = threadIdx.x; asm volatile("" : "+v"(t));
    F.lds = (LAS unsigned char*)lds; F.tid = t; F.lane = t & 63; F.wave = __builtin_amdgcn_readfirstlane(t >> 6);
    F.G = gridDim.x; { const int bx = blockIdx.x; F.vcu = (F.G % 8 == 0) ? (bx % 8) * (F.G / 8) + bx / 8 : bx; }
    return F;
}
__global__ void __launch_bounds__(NTHR, 2) mk_fwd(Args args_by_value) {
    extern __shared__ __attribute__((aligned(16))) unsigned char lds[];
    ArgsP args = get_args();
    gu32* ctl = (gu32*)(args->ws + WS_CTL);
    for (int u = threadIdx.x; u < (LDS_BYTES - LDSCTL_OFF) / 4; u += NTHR) ((LAS unsigned*)((LAS unsigned char*)lds + LDSCTL_OFF))[u] = 0u;
    __syncthreads();
    const int lo = args->ph_lo, hi = args->ph_hi;
    volatile LAS unsigned* MISC = (volatile LAS unsigned*)((LAS unsigned char*)lds + MISC_OFF);
    XcdBarrier bar; bar.bar = (unsigned*)(ctl + CW_BAR) + args->li * XCD_BAR_WORDS; bar.x = 0; bar.st = nullptr;
    if (hi - lo > 1) bar = xcd_barrier_post((unsigned*)(ctl + CW_BAR) + args->li * XCD_BAR_WORDS, MISC + 8);
#define IN(k) (lo <= (k) && (k) < hi)
#define SEAM(k) do { if (IN(k) && IN((k) + 1)) xcd_barrier(bar); } while (0)
    const int bid = (int)blockIdx.x;

    if (IN(0)) { Frame F = make_frame(lds); ph0_prologue(get_args(), F); SEAM(0); }
    if (IN(1)) { Frame F = make_frame(lds); LAS unsigned char* ring = F.lds + RING_OFF; ArgsP a_ = get_args(); unsigned char* ws = a_->ws;
        { pg8::Gemm g{(const bf16_t*)(ws + WS_XN), (const bf16_t*)(ws + WS_WIN), T, PLD, D}; pg8::StaticOrder S; S.init(T, PLD, F.G, bid);
          pg8::EpiProj E{(bf16_t*)(ws + WS_PROJ), (const float*)(ws + WS_ROPE), (bf16_t*)(ws + WS_KB)}; pg8::gemm_phase<pg8::EpiProj, pg8::StaticOrder, true, true>(ring, g, S, E); }
        { pg8::Gemm g{(const bf16_t*)(ws + WS_XN), (const bf16_t*)(ws + WS_WIN) + (size_t)PC_MV * D, T, 2048, D}; pg8::StaticOrder S; S.init(T, 2048, F.G, bid);
          pg8::EpiVT E{(bf16_t*)(ws + WS_VT)}; pg8::gemm_phase<pg8::EpiVT, pg8::StaticOrder, true, true>(ring, g, S, E); }
        { constexpr int NT1 = (T / 256) * (PLD / 256); const int nx = NT1 % F.G;
          if (bid >= nx) { WG_BAR(); Frame F2 = make_frame(lds); late_weights(get_args(), F2, (bid - nx) * NWAVES + F2.wave, (F2.G - nx) * NWAVES); } }
        SEAM(1); }
    if (IN(2)) { Frame F = make_frame(lds); ph2_prep(get_args(), F); SEAM(2); }
    if (IN(3)) { Frame F = make_frame(lds); LAS unsigned char* ring = F.lds + RING_OFF; ArgsP a_ = get_args(); unsigned char* ws = a_->ws;
        { pg8::Gemm g{(const bf16_t*)(ws + WS_AW), (const bf16_t*)(ws + WS_WUP), T, RW, LW}; pg8::StaticOrder S; S.init(T, RW, F.G, bid);
          pg8::EpiDec E{(float*)(ws + WS_DEC), a_->w0}; pg8::gemm_phase<pg8::EpiDec, pg8::StaticOrder, true, true>(ring, g, S, E); }
        asm volatile("" ::: "memory"); __builtin_amdgcn_sched_barrier(0);
        { pg8::Gemm g{(const bf16_t*)(ws + WS_AA), (const bf16_t*)(ws + WS_AUP), T, RW, LA}; pg8::StaticOrder S; S.init(T, RW, F.G, bid);
          pg8::EpiA E{(bf16_t*)(ws + WS_KP), (bf16_t*)(ws + WS_BB), (const bf16_t*)(ws + WS_KKN), a_->a0, a_->k_a}; pg8::gemm_phase<pg8::EpiA, pg8::StaticOrder, true, true>(ring, g, S, E); }
        asm volatile("" ::: "memory"); __builtin_amdgcn_sched_barrier(0);
        { pg8::Gemm g{(const bf16_t*)(ws + WS_AG), (const bf16_t*)(ws + WS_GUP), T, RW, LGP}; pg8::StaticOrder S; S.init(T, RW, F.G, bid);
          pg8::EpiBf16 E{(bf16_t*)(ws + WS_G), RW}; pg8::gemm_phase<pg8::EpiBf16, pg8::StaticOrder, true, true>(ring, g, S, E); }
        { Frame F2 = make_frame(lds); ph3_gate(get_args(), F2); }
        SEAM(3); }
    if (IN(4)) { Frame F = make_frame(lds); ph4_chunkprep(get_args(), F); SEAM(4); }
    if (IN(5)) {
        { Frame F = make_frame(lds); if (F.vcu < RH) ph5_chain(get_args(), F, F.vcu); }
        { Frame F = make_frame(lds); ph5_attn(get_args(), F); }
        SEAM(5); }
    if (IN(6)) { { Frame F = make_frame(lds); ph6_merge(get_args(), F); } { Frame F = make_frame(lds); ph5_ypost(get_args(), F); } SEAM(6); }
    if (IN(7)) { Frame F = make_frame(lds); LAS unsigned char* ring = F.lds + RING_OFF; ArgsP a_ = get_args(); unsigned char* ws = a_->ws;
        { pg8::Gemm g{(const bf16_t*)(ws + WS_YA), (const bf16_t*)(ws + WS_WA), T, D, RW}; pg8::StaticOrder S; S.init(T, D, F.G, bid);
          pg8::EpiMix<false> E{(bf16_t*)(ws + WS_MIXED), (const bf16_t*)(ws + WS_PROJ), PC_GA}; pg8::gemm_phase<pg8::EpiMix<false>, pg8::StaticOrder, true, true>(ring, g, S, E); }
        { pg8::Gemm g{(const bf16_t*)(ws + WS_YB), (const bf16_t*)(ws + WS_WB), T, D, RW}; pg8::StaticOrder S; S.init(T, D, F.G, bid);
          pg8::EpiMix<true> E{(bf16_t*)(ws + WS_MIXED), (const bf16_t*)(ws + WS_PROJ), PC_GB}; pg8::gemm_phase<pg8::EpiMix<true>, pg8::StaticOrder, true, true>(ring, g, S, E); }
        SEAM(7); }
    if (IN(8)) { Frame F = make_frame(lds); LAS unsigned char* ring = F.lds + RING_OFF; ArgsP a_ = get_args(); unsigned char* ws = a_->ws;
        pg8::Gemm g{(const bf16_t*)(ws + WS_MIXED), (const bf16_t*)(ws + WS_WOUT), T, D, D}; pg8::StaticOrder S; S.init(T, D, F.G, bid);
        pg8::EpiRes E{(float*)(ws + WS_X1), a_->x}; pg8::gemm_phase<pg8::EpiRes, pg8::StaticOrder, true, true>(ring, g, S, E);
        SEAM(8); }
    if (IN(9)) { Frame F = make_frame(lds); ArgsP a_ = get_args(); unsigned char* ws = a_->ws; const int gw = F.vcu * NWAVES + F.wave, NGW = F.G * NWAVES;
        rms_rows_to_bf16((const float*)(ws + WS_X1), a_->norm2_g, (bf16_t*)(ws + WS_H2), gw, NGW, F.lane);
        SEAM(9); }
    if (IN(10)) { Frame F = make_frame(lds); LAS unsigned char* ring = F.lds + RING_OFF; ArgsP a_ = get_args(); unsigned char* ws = a_->ws;
        pg8::Gemm g{(const bf16_t*)(ws + WS_H2), (const bf16_t*)(ws + WS_WQ), T, 2048, D}; pg8::StaticOrder S; S.init(T, 2048, F.G, bid);
        pg8::EpiBf16 E{(bf16_t*)(ws + WS_PQ), 2048}; pg8::gemm_phase<pg8::EpiBf16, pg8::StaticOrder, true, true>(ring, g, S, E);
        SEAM(10); }
    if (IN(11)) { Frame F = make_frame(lds); ph10_select(get_args(), F); SEAM(11); }
    if (IN(12)) { Frame F = make_frame(lds); ph11_gather(get_args(), F); }
#undef IN
#undef SEAM
}

extern "C" void kernel_launch(void* const* d_in, const int* in_sizes, int n_in, void* d_out, int out_size, void* d_ws, size_t ws_size, hipStream_t stream) {
    static int grid = 0;
    if (grid == 0) {
        if (n_in != 23 || out_size != T * D || ws_size < WS_END) { fprintf(stderr, "kernel_launch: unexpected shapes (n_in %d out %d ws %zu); nothing launched\n", n_in, out_size, ws_size); grid = -1; return; }
        int dev = 0, cus = 0, per_cu = 0;
        if (hipGetDevice(&dev) != hipSuccess || hipDeviceGetAttribute(&cus, hipDeviceAttributeMultiprocessorCount, dev) != hipSuccess) { grid = -1; return; }
        if (hipFuncSetAttribute((const void*)mk_fwd, hipFuncAttributeMaxDynamicSharedMemorySize, LDS_BYTES) != hipSuccess) { grid = -1; return; }
        if (hipOccupancyMaxActiveBlocksPerMultiprocessor(&per_cu, (const void*)mk_fwd, NTHR, LDS_BYTES) != hipSuccess || per_cu < 1) fprintf(stderr, "kernel_launch: occupancy query reports %d\n", per_cu);
        (void)hipGetLastError();
        grid = cus;
    }
    if (grid < 0) return;
    (void)hipMemsetAsync((char*)d_ws + WS_CTL, 0, CTL_ZERO_BYTES, stream);
    Args a{};
    const float** ap = (const float**)&a;
    for (int i = 0; i < 23; ++i) ap[i] = (const float*)d_in[i];
    a.out = (float*)d_out; a.ws = (unsigned char*)d_ws; a.pad = 0;
    constexpr int NL = MK_N_LAUNCHES;
    for (int li = 0; li < NL; ++li) {
        a.ph_lo = (NL == 1) ? 0 : li; a.ph_hi = (NL == 1) ? NPH : li + 1; a.li = (NL == 1) ? 0 : 0;
        hipLaunchKernelGGL(mk_fwd, dim3(grid), dim3(NTHR), LDS_BYTES, stream, a);
#ifdef DUP_HI
        if (NL > 1 && li == DUP_HI) for (int l2 = DUP_LO; l2 <= DUP_HI; ++l2) { a.ph_lo = l2; a.ph_hi = l2 + 1; hipLaunchKernelGGL(mk_fwd, dim3(grid), dim3(NTHR), LDS_BYTES, stream, a); }
#endif
    }
}
```

```cpp
#include <hip/hip_runtime.h>
#include <cstdio>
#include <cstdint>

#ifndef MK_N_LAUNCHES
#define MK_N_LAUNCHES 1
#endif

#define GAS __attribute__((address_space(1)))
#define LAS __attribute__((address_space(3)))
typedef unsigned short bf16_t;
typedef __bf16 bf16x8 __attribute__((ext_vector_type(8)));
typedef float f32x2 __attribute__((ext_vector_type(2)));
typedef float f32x4 __attribute__((ext_vector_type(4)));
typedef float f32x16 __attribute__((ext_vector_type(16)));
typedef unsigned u32x2 __attribute__((ext_vector_type(2)));
typedef unsigned u32x4 __attribute__((ext_vector_type(4)));
typedef GAS unsigned gu32;

constexpr int T = 8192, D = 4096;
constexpr int RW = 2048, RH = 32, RN = 64;
constexpr int LW = 128, LA = 128, LG = 480, LGP = 512;
constexpr int SHIFTW = 6880;
constexpr int MH = 16, MD = 128, MBLK = 256, NBLK = 32;
constexpr int INW = 21216;
constexpr int PLD = 19200;
constexpr int PC_R = 0, PC_K = 2048, PC_V = 4096, PC_WL = 6144, PC_AL = 6272, PC_GL = 6400, PC_MQ = 6912, PC_MK = 8960, PC_GA = 11008, PC_GB = 15104, PC_MV = 19200;
constexpr int WIN_ROWS = 21248;
constexpr int PQ_SPLIT = 16384;
constexpr int PH_ = 8, PNK = 128, PQD = 256, PHALF = 128, PTOPK = 16;
constexpr float NORM_EPS = 1e-6f, LNX_EPS = 64e-5f;
constexpr float QSCALE = 0.08838834764831845f * 1.4426950408889634f;

constexpr size_t MiB = 1u << 20;
constexpr size_t WS_CTL = 0, CTL_ZERO_BYTES = 1 * MiB;
constexpr size_t WS_WIN = 1 * MiB;
constexpr size_t WS_X1 = 1 * MiB, WS_PQ = 129 * MiB;
constexpr size_t WS_WA = 167 * MiB, WS_WB = 183 * MiB, WS_WOUT = 199 * MiB, WS_WQ = 231 * MiB, WS_WUP = 247 * MiB, WS_AUP = 248 * MiB, WS_GUP = 249 * MiB, WS_SUBK = 251 * MiB;
constexpr size_t WS_PU = 252 * MiB, WS_PV = 380 * MiB;
constexpr size_t WS_XN = 508 * MiB;
constexpr size_t WS_Y = 508 * MiB, WS_H2 = 508 * MiB;
constexpr size_t WS_PROJ = 572 * MiB;
constexpr size_t WS_VT = 872 * MiB;
constexpr size_t WS_ROPE = 904 * MiB, WS_KMEAN = 908 * MiB, WS_MASK = 909 * MiB, WS_AW = 910 * MiB, WS_AA = 912 * MiB, WS_AG = 914 * MiB;
constexpr size_t WS_PSU = 909 * MiB + 512 * 1024, WS_PSV = WS_PSU + 64 * 1024;
constexpr size_t WS_DEC = 922 * MiB;
constexpr size_t WS_MIXED = 922 * MiB;
constexpr size_t WS_KKN = 986 * MiB, WS_BB = 1018 * MiB, WS_KP = 1050 * MiB, WS_ZR = 1082 * MiB, WS_ZV = 1114 * MiB, WS_G = 1146 * MiB;
constexpr size_t WS_YA = 1178 * MiB, WS_YB = 1210 * MiB, WS_IDX = 1242 * MiB, WS_GW = 1246 * MiB, WS_PARTML = 1250 * MiB, WS_LIST = 1254 * MiB, WS_UDESC = 1262 * MiB, WS_KB = 1267 * MiB, WS_END = 1299 * MiB;
constexpr size_t WS_PARTO = 922 * MiB;

constexpr int CW_TMO = 0, CW_CODE = 1, CW_ATTNQ = 64, CW_CNT = 1024, CW_BAR = 4096;

constexpr int RING_OFF = 0, RING_BYTES = 155648;
constexpr int LDSCTL_OFF = RING_BYTES, MISC_OFF = LDSCTL_OFF + 320;
constexpr int LDS_BYTES = 163840;
constexpr int NWAVES = 8, NTHR = 512;

__device__ __forceinline__ unsigned f2bf(float f) { unsigned u = __builtin_bit_cast(unsigned, f); return (u + 0x7fffu + ((u >> 16) & 1u)) >> 16; }
typedef __bf16 bf16x2 __attribute__((ext_vector_type(2)));
__device__ __forceinline__ unsigned pk2(float lo, float hi) { const f32x2 v = {lo, hi}; return __builtin_bit_cast(unsigned, __builtin_convertvector(v, bf16x2)); }
__device__ __forceinline__ float bflo(unsigned u) { return __builtin_bit_cast(float, u << 16); }
__device__ __forceinline__ float bfhi(unsigned u) { return __builtin_bit_cast(float, u & 0xffff0000u); }
__device__ __forceinline__ float bf1(bf16_t b) { return __builtin_bit_cast(float, (unsigned)b << 16); }
__device__ __forceinline__ float fsigmoid(float x) { return __builtin_amdgcn_rcpf(1.0f + __expf(-x)); }
__device__ __forceinline__ float wave_sum(float v) {
#pragma unroll
    for (int o = 1; o < 64; o <<= 1) v += __shfl_xor(v, o);
    return v;
}
template <int CTRL> __device__ __forceinline__ float dpp_f(float v) { return __builtin_bit_cast(float, __builtin_amdgcn_update_dpp(0, __builtin_bit_cast(int, v), CTRL, 0xF, 0xF, true)); }
__device__ __forceinline__ float sum16(float x) {
    x += dpp_f<0xB1>(x); x += dpp_f<0x4E>(x); x += dpp_f<0x141>(x); x += dpp_f<0x140>(x); return x;
}
__device__ __forceinline__ float vmul(float a, float b) { float r; asm("v_mul_f32_e32 %0, %1, %2" : "=v"(r) : "v"(a), "v"(b)); return r; }
__device__ __forceinline__ float vfma(float a, float b, float c) { float r; asm("v_fma_f32 %0, %1, %2, %3" : "=v"(r) : "v"(a), "v"(b), "v"(c)); return r; }
#define LDS_WAIT() asm volatile("s_waitcnt lgkmcnt(0)" ::: "memory")
#define VM_WAIT() asm volatile("s_waitcnt vmcnt(0)" ::: "memory")
#define WG_BAR() do { asm volatile("s_waitcnt lgkmcnt(0)" ::: "memory"); __builtin_amdgcn_s_barrier(); asm volatile("" ::: "memory"); } while (0)

namespace pg8 {
constexpr int BM = 256, BK = 64, HALF = 128, HTB = HALF * BK * 2, STAGE_BYTES = 8 * HTB, NXCD = 8, WGM = 8;
__host__ __device__ __forceinline__ int lds_byte(int r, int c) { const int st = (r >> 4) * 2 + (c >> 5), rr = r & 15, cc = c & 31, ob = rr * 64 + cc * 2; return st * 1024 + (ob ^ (((ob >> 9) & 1) << 5)); }
__host__ __device__ __forceinline__ void stage_rc(int b, int& R, int& C) { const int st = b / 1024, sb = b % 1024, swz = sb ^ (((sb >> 9) & 1) << 5); R = (st >> 1) * 16 + swz / 64; C = (st & 1) * 32 + (swz % 64) / 2; }
__host__ __device__ __forceinline__ int perm32(int rho) { const int n = rho >> 4, i = rho & 15; return 8 * (i >> 2) + 4 * n + (i & 3); }

struct Unit { int pm, pn; };
struct Gemm { const bf16_t* A; const bf16_t* Bt; int M, N, K; };

struct StaticOrder {
    int nM, nN, nwg, G, c;
    __host__ __device__ void init(int M, int N, int G_, int c_) { nM = M / BM; nN = N / BM; nwg = nM * nN; G = G_; c = c_; }
    __host__ __device__ bool next(int i, Unit& u) const {
        const long L = (long)i * G + c; if (L >= nwg) return false;
        int wgid = (int)L; { const int q = nwg / NXCD, r = nwg % NXCD, xcd = wgid % NXCD, off = wgid / NXCD; wgid = (xcd < r ? xcd * (q + 1) : r * (q + 1) + (xcd - r) * q) + off; }
        const int nig = WGM * nN, gid = wgid / nig, fm = gid * WGM, gsz = (nM - fm) < WGM ? (nM - fm) : WGM;
        u.pm = fm + ((wgid % nig) % gsz); u.pn = (wgid % nig) / gsz; return true;
    }
    __device__ __forceinline__ void a_ready(const Unit&) const {}
    __device__ __forceinline__ void done(const Unit&) const {}
};

template <class Epi, class Sched, bool ALIGN_EPI = false, bool SP2 = false>
__device__ __forceinline__ void gemm_phase(LAS unsigned char* lds, const Gemm g, const Sched& S, const Epi& E) {
    int tid_ = threadIdx.x; asm volatile("" : "+v"(tid_));
    const int tid = tid_, wid = __builtin_amdgcn_readfirstlane(tid >> 6), lane = tid & 63, wr = wid >> 2, wc = wid & 3, fr = lane & 15, fq = lane >> 4;
    int K_ = g.K; asm volatile("" : "+s"(K_));
    const int K = K_, nt = K / BK;
    unsigned voffA[2], voffB[2];
#pragma unroll
    for (int i = 0; i < 2; ++i) { int R, C; stage_rc(tid * 16 + i * 8192, R, C); const int Rb = Epi::PERM ? ((R & ~31) + perm32(R & 31)) : R;
        voffA[i] = (unsigned)(R * K + C) * 2u; voffB[i] = (unsigned)(Rb * K + C) * 2u; }
    const size_t kstep = (size_t)(BK * 2);
    const size_t hstep = (size_t)HALF * K * 2;
    const size_t tstep = 2 * hstep;
    const unsigned ldsw = (unsigned)wid * 1024u;
    const int aoff = lds_byte(wr * 64 + fr, fq * 8), boff = lds_byte(wc * 32 + fr, fq * 8);
#define PG8_SA(b, h) (((b) * 2 + (h)) * HTB)
#define PG8_SB(b, h) ((4 + (b) * 2 + (h)) * HTB)
#define PG8_STAGE(bufoff, gbase, voff) do { _Pragma("unroll") for (int _i = 0; _i < 2; ++_i) \
        __builtin_amdgcn_global_load_lds((const unsigned*)((const char*)(gbase) + (voff)[_i]), (LAS unsigned*)(lds + (bufoff) + ldsw + _i * 8192), 16, 0, 0); } while (0)
#define PG8_LDA(dst, b, h) do { _Pragma("unroll") for (int m = 0; m < 4; ++m) _Pragma("unroll") for (int k = 0; k < 2; ++k) dst[m][k] = *(const LAS bf16x8*)(lds + PG8_SA(b, h) + aoff + m * 2048 + k * 1024); } while (0)
#define PG8_LDB(dst, b, h) do { _Pragma("unroll") for (int n = 0; n < 2; ++n) _Pragma("unroll") for (int k = 0; k < 2; ++k) dst[n][k] = *(const LAS bf16x8*)(lds + PG8_SB(b, h) + boff + n * 2048 + k * 1024); } while (0)
#define PG8_MMA(ai, bj, At, Bt) do { __builtin_amdgcn_s_setprio(1); _Pragma("unroll") for (int m = 0; m < 4; ++m) _Pragma("unroll") for (int n = 0; n < 2; ++n) _Pragma("unroll") for (int k = 0; k < 2; ++k) { \
        if constexpr (Epi::SWAP) acc[ai][bj][m][n] = __builtin_amdgcn_mfma_f32_16x16x32_bf16(At[m][k], Bt[n][k], acc[ai][bj][m][n], 0, 0, 0); \
        else acc[ai][bj][m][n] = __builtin_amdgcn_mfma_f32_16x16x32_bf16(Bt[n][k], At[m][k], acc[ai][bj][m][n], 0, 0, 0); } __builtin_amdgcn_s_setprio(0); } while (0)
#define PG8_WAIT_V(n) asm volatile("s_waitcnt vmcnt(" #n ")" ::: "memory")
#define PG8_WAIT_L(n) asm volatile("s_waitcnt lgkmcnt(" #n ")" ::: "memory")
#define PG8_BAR __builtin_amdgcn_s_barrier()
#define PG8_SCHED __builtin_amdgcn_sched_barrier(0)
    Unit cur, nxt; int ui = 0;
    if (!S.next(0, cur)) return;
    f32x4 acc[2][2][4][2];
#pragma unroll
    for (int a = 0; a < 2; ++a)
#pragma unroll
        for (int b = 0; b < 2; ++b)
#pragma unroll
            for (int m = 0; m < 4; ++m)
#pragma unroll
                for (int n = 0; n < 2; ++n) acc[a][b][m][n] = (f32x4){0.f, 0.f, 0.f, 0.f};
    bf16x8 At[4][2], B0[2][2], B1[2][2];
    const char* cA = (const char*)g.A + (size_t)cur.pm * tstep; const char* cB = (const char*)g.Bt + (size_t)cur.pn * tstep;
    S.a_ready(cur);
    if constexpr (SP2) {
        PG8_STAGE(PG8_SB(0, 0), cB, voffB); PG8_STAGE(PG8_SB(0, 1), cB + hstep, voffB); PG8_STAGE(PG8_SA(0, 0), cA, voffA); PG8_STAGE(PG8_SA(0, 1), cA + hstep, voffA);
        if (wr == 1) PG8_BAR;
        PG8_WAIT_V(2); PG8_BAR;
        PG8_STAGE(PG8_SB(1, 0), cB + kstep, voffB); PG8_STAGE(PG8_SA(1, 0), cA + kstep, voffA); PG8_STAGE(PG8_SB(1, 1), cB + hstep + kstep, voffB);
        PG8_WAIT_V(6); PG8_BAR;
    } else {
        PG8_STAGE(PG8_SB(0, 0), cB, voffB); PG8_STAGE(PG8_SA(0, 0), cA, voffA); PG8_STAGE(PG8_SB(0, 1), cB + hstep, voffB); PG8_STAGE(PG8_SA(0, 1), cA + hstep, voffA);
        if (wr == 1) PG8_BAR;
        PG8_WAIT_V(4); PG8_BAR;
        PG8_STAGE(PG8_SB(1, 0), cB + kstep, voffB); PG8_STAGE(PG8_SA(1, 0), cA + kstep, voffA); PG8_STAGE(PG8_SB(1, 1), cB + hstep + kstep, voffB);
        PG8_WAIT_V(6); PG8_BAR;
    }
    for (;;) {
        const bool has_next = S.next(ui + 1, nxt);
        const char* nA = has_next ? (const char*)g.A + (size_t)nxt.pm * tstep : cA; const char* nB = has_next ? (const char*)g.Bt + (size_t)nxt.pn * tstep : cB;
        for (int t = 0; t < nt; t += 2) {
            const bool last = (t == nt - 2);
            const char* a1 = cA + (size_t)(t + 1) * kstep;
            const char* a2 = last ? nA : cA + (size_t)(t + 2) * kstep; const char* b2 = last ? nB : cB + (size_t)(t + 2) * kstep;
            const char* a3 = a2 + kstep; const char* b3 = b2 + kstep;
            if (last && has_next) S.a_ready(nxt);
            if constexpr (SP2) {
            PG8_LDB(B0, 0, 0); PG8_LDB(B1, 0, 1); PG8_SCHED; PG8_LDA(At, 0, 0); PG8_STAGE(PG8_SA(1, 1), a1 + hstep, voffA);
            PG8_WAIT_V(8); PG8_WAIT_L(0); PG8_BAR; PG8_MMA(0, 0, At, B0); PG8_MMA(0, 1, At, B1); PG8_BAR; PG8_SCHED;
            PG8_LDA(At, 0, 1); PG8_STAGE(PG8_SB(0, 0), b2, voffB); PG8_STAGE(PG8_SB(0, 1), b2 + hstep, voffB); PG8_STAGE(PG8_SA(0, 0), a2, voffA);
            PG8_WAIT_V(8); PG8_WAIT_L(0); PG8_BAR; PG8_MMA(1, 0, At, B0); PG8_MMA(1, 1, At, B1); PG8_BAR; PG8_SCHED;
            PG8_LDB(B0, 1, 0); PG8_LDB(B1, 1, 1); PG8_SCHED; PG8_LDA(At, 1, 0); PG8_STAGE(PG8_SA(0, 1), a2 + hstep, voffA);
            PG8_WAIT_V(8); PG8_WAIT_L(0); PG8_BAR; PG8_MMA(0, 0, At, B0); PG8_MMA(0, 1, At, B1); PG8_BAR; PG8_SCHED;
            PG8_LDA(At, 1, 1); PG8_STAGE(PG8_SB(1, 0), b3, voffB); PG8_STAGE(PG8_SB(1, 1), b3 + hstep, voffB); PG8_STAGE(PG8_SA(1, 0), a3, voffA);
            PG8_WAIT_V(8); PG8_WAIT_L(0); PG8_BAR; PG8_MMA(1, 0, At, B0); PG8_MMA(1, 1, At, B1); PG8_BAR; PG8_SCHED;
            } else {
            PG8_LDB(B0, 0, 0); PG8_SCHED; PG8_LDA(At, 0, 0); PG8_STAGE(PG8_SA(1, 1), a1 + hstep, voffA);
            PG8_WAIT_L(8); PG8_BAR; PG8_WAIT_L(0); PG8_MMA(0, 0, At, B0); PG8_BAR; PG8_SCHED;
            PG8_LDB(B1, 0, 1); PG8_STAGE(PG8_SB(0, 0), b2, voffB);
            PG8_BAR; PG8_WAIT_L(0); PG8_MMA(0, 1, At, B1); PG8_BAR;
            PG8_LDA(At, 0, 1); PG8_STAGE(PG8_SA(0, 0), a2, voffA);
            PG8_BAR; PG8_WAIT_L(0); PG8_MMA(1, 0, At, B0); PG8_BAR; PG8_SCHED;
            PG8_STAGE(PG8_SB(0, 1), b2 + hstep, voffB);
            PG8_WAIT_V(6); PG8_BAR; PG8_MMA(1, 1, At, B1); PG8_BAR;
            PG8_LDB(B0, 1, 0); PG8_SCHED; PG8_LDA(At, 1, 0); PG8_STAGE(PG8_SA(0, 1), a2 + hstep, voffA);
            PG8_WAIT_L(8); PG8_BAR; PG8_WAIT_L(0); PG8_MMA(0, 0, At, B0); PG8_BAR; PG8_SCHED;
            PG8_LDB(B1, 1, 1); PG8_STAGE(PG8_SB(1, 0), b3, voffB);
            PG8_BAR; PG8_WAIT_L(0); PG8_MMA(0, 1, At, B1); PG8_BAR;
            PG8_LDA(At, 1, 1); PG8_STAGE(PG8_SA(1, 0), a3, voffA);
            PG8_BAR; PG8_WAIT_L(0); PG8_MMA(1, 0, At, B0); PG8_BAR; PG8_SCHED;
            PG8_STAGE(PG8_SB(1, 1), b3 + hstep, voffB);
            PG8_WAIT_V(6); PG8_BAR; PG8_MMA(1, 1, At, B1); PG8_BAR;
            }
        }
        if constexpr (ALIGN_EPI) { if (wr == 0) PG8_BAR; }
        E(acc, cur, wr, wc, fr, fq); S.done(cur);
        if (!has_next) break;
#pragma unroll
        for (int a = 0; a < 2; ++a)
#pragma unroll
            for (int b = 0; b < 2; ++b)
#pragma unroll
                for (int m = 0; m < 4; ++m)
#pragma unroll
                    for (int n = 0; n < 2; ++n) acc[a][b][m][n] = (f32x4){0.f, 0.f, 0.f, 0.f};
        cur = nxt; cA = nA; cB = nB; ++ui;
        if constexpr (ALIGN_EPI) { if (wr == 1) PG8_BAR; }
    }
    PG8_WAIT_V(0);
    if constexpr (!ALIGN_EPI) { if (wr == 0) PG8_BAR; }
    PG8_BAR;
#undef PG8_SA
#undef PG8_SB
#undef PG8_STAGE
#undef PG8_LDA
#undef PG8_LDB
#undef PG8_MMA
#undef PG8_WAIT_V
#undef PG8_WAIT_L
#undef PG8_BAR
#undef PG8_SCHED
}

typedef const f32x4 (&AccRef)[2][2][4][2];
__device__ __forceinline__ u32x4 pack8(f32x4 v0, f32x4 v1) { u32x4 w; w.x = pk2(v0[0], v0[1]); w.y = pk2(v0[2], v0[3]); w.z = pk2(v1[0], v1[1]); w.w = pk2(v1[2], v1[3]); return w; }
__device__ __forceinline__ void unpack8(u32x4 w, f32x4& v0, f32x4& v1) { v0 = (f32x4){bflo(w.x), bfhi(w.x), bflo(w.y), bfhi(w.y)}; v1 = (f32x4){bflo(w.z), bfhi(w.z), bflo(w.w), bfhi(w.w)}; }

struct EpiBf16 {
    static constexpr bool PERM = true, SWAP = false;
    bf16_t* O; int ldc;
    __device__ __forceinline__ void operator()(AccRef acc, const Unit& u, int wr, int wc, int fr, int fq) const {
        const int row0 = u.pm * BM + wr * 64 + fr, col0 = u.pn * BM + wc * 32 + 8 * fq;
#pragma unroll
        for (int ai = 0; ai < 2; ++ai)
#pragma unroll
            for (int m = 0; m < 4; ++m) { bf16_t* rowp = O + (size_t)(row0 + ai * HALF + m * 16) * ldc + col0;
#pragma unroll
                for (int bj = 0; bj < 2; ++bj) *(u32x4*)(rowp + bj * HALF) = pack8(acc[ai][bj][m][0], acc[ai][bj][m][1]); }
    }
};
struct EpiProj {
    static constexpr bool PERM = true, SWAP = false;
    bf16_t* O; const float* rope; bf16_t* KB;
    __device__ __forceinline__ void operator()(AccRef acc, const Unit& u, int wr, int wc, int fr, int fq) const {
        const int row0 = u.pm * BM + wr * 64 + fr, col0 = u.pn * BM + wc * 32 + 8 * fq;
        const int mode = (u.pn >= 27 && u.pn < 43) ? (u.pn < 35 ? 1 : 2) : 0;
        const float sc = (mode == 1) ? QSCALE : 1.0f;
#pragma unroll
        for (int ai = 0; ai < 2; ++ai)
#pragma unroll
            for (int m = 0; m < 4; ++m) { const int row = row0 + ai * HALF + m * 16; bf16_t* rowp = O + (size_t)row * PLD + col0;
#pragma unroll
                for (int bj = 0; bj < 2; ++bj) { f32x4 v0 = acc[ai][bj][m][0], v1 = acc[ai][bj][m][1];
                    if (mode) { const int i0 = ((col0 + bj * HALF) & 127) >> 1; const f32x4* rp = (const f32x4*)(rope + ((size_t)row * 64 + i0) * 2); const f32x4 c0 = rp[0], c1 = rp[1];
                        f32x4 o0, o1;
                        o0[0] = v0[0] * c0[0] - v0[1] * c0[1]; o0[1] = v0[1] * c0[0] + v0[0] * c0[1]; o0[2] = v0[2] * c0[2] - v0[3] * c0[3]; o0[3] = v0[3] * c0[2] + v0[2] * c0[3];
                        o1[0] = v1[0] * c1[0] - v1[1] * c1[1]; o1[1] = v1[1] * c1[0] + v1[0] * c1[1]; o1[2] = v1[2] * c1[2] - v1[3] * c1[3]; o1[3] = v1[3] * c1[2] + v1[2] * c1[3];
                        v0 = o0 * sc; v1 = o1 * sc; }
                    if (mode == 2) *(u32x4*)(KB + ((size_t)((u.pn - 35) * 2 + bj) * T + row) * MD + wc * 32 + 8 * fq) = pack8(v0, v1);
                    else *(u32x4*)(rowp + bj * HALF) = pack8(v0, v1); } }
    }
};
struct EpiVT {
    static constexpr bool PERM = false, SWAP = true;
    bf16_t* VT;
    __device__ __forceinline__ void operator()(AccRef acc, const Unit& u, int wr, int wc, int fr, int fq) const {
        const int tok0 = u.pm * BM + wr * 64 + 4 * fq, col0 = u.pn * BM + wc * 32 + fr;
#pragma unroll
        for (int ai = 0; ai < 2; ++ai)
#pragma unroll
            for (int m = 0; m < 4; ++m)
#pragma unroll
                for (int bj = 0; bj < 2; ++bj)
#pragma unroll
                    for (int n = 0; n < 2; ++n) { const f32x4 v = acc[ai][bj][m][n]; u32x2 w; w.x = pk2(v[0], v[1]); w.y = pk2(v[2], v[3]);
                        const int d = col0 + bj * HALF + n * 16, tl = (u.pm * BM + wr * 64 + ai * HALF) >> 6;
                        *(u32x2*)(VT + ((size_t)((d >> 7) * (T / 64) + tl) * MD + (d & 127)) * 64 + m * 16 + 4 * (((fq & 1) << 1) | (fq >> 1))) = w; }
    }
};
struct EpiDec {
    static constexpr bool PERM = true, SWAP = false;
    float* O; const float* w0;
    __device__ __forceinline__ void operator()(AccRef acc, const Unit& u, int wr, int wc, int fr, int fq) const {
        const int row0 = u.pm * BM + wr * 64 + fr, col0 = u.pn * BM + wc * 32 + 8 * fq;
#pragma unroll
        for (int bj = 0; bj < 2; ++bj) { const f32x4 b0 = *(const f32x4*)(w0 + col0 + bj * HALF), b1 = *(const f32x4*)(w0 + col0 + bj * HALF + 4);
#pragma unroll
            for (int ai = 0; ai < 2; ++ai)
#pragma unroll
                for (int m = 0; m < 4; ++m) { float* rowp = O + (size_t)(row0 + ai * HALF + m * 16) * RW + col0 + bj * HALF;
#pragma unroll
                    for (int n = 0; n < 2; ++n) { const f32x4 x = acc[ai][bj][m][n] + (n ? b1 : b0); f32x4 o;
#pragma unroll
                        for (int e = 0; e < 4; ++e) { const float z = -x[e]; const float sp = fmaxf(z, 0.f) + __logf(1.0f + __expf(-fabsf(z))); o[e] = __expf(-__expf(-sp - 0.5f)); }
                        *(f32x4*)(rowp + 4 * n) = o; }
                    asm volatile("" ::: "memory"); } }
    }
};
struct EpiA {
    static constexpr bool PERM = true, SWAP = false;
    bf16_t* KP; bf16_t* BB; const bf16_t* KKN; const float* a0; const float* k_a;
    __device__ __forceinline__ void operator()(AccRef acc, const Unit& u, int wr, int wc, int fr, int fq) const {
        const int row0 = u.pm * BM + wr * 64 + fr, col0 = u.pn * BM + wc * 32 + 8 * fq;
#pragma unroll
        for (int bj = 0; bj < 2; ++bj) { const int cb = col0 + bj * HALF;
            const f32x4 b0 = *(const f32x4*)(a0 + cb), b1 = *(const f32x4*)(a0 + cb + 4), ka0 = *(const f32x4*)(k_a + cb), ka1 = *(const f32x4*)(k_a + cb + 4);
#pragma unroll
            for (int ai = 0; ai < 2; ++ai)
#pragma unroll
                for (int m = 0; m < 4; ++m) { const size_t off = (size_t)(row0 + ai * HALF + m * 16) * RW + cb;
                    f32x4 zk0, zk1, kn0, kn1; unpack8(*(const u32x4*)(KP + off), zk0, zk1); unpack8(*(const u32x4*)(KKN + off), kn0, kn1);
                    f32x4 a0v, a1v;
#pragma unroll
                    for (int e = 0; e < 4; ++e) { a0v[e] = fsigmoid(acc[ai][bj][m][0][e] + b0[e]); a1v[e] = fsigmoid(acc[ai][bj][m][1][e] + b1[e]); }
                    const f32x4 kp0 = zk0 * (1.0f + (a0v - 1.0f) * ka0), kp1 = zk1 * (1.0f + (a1v - 1.0f) * ka1);
                    *(u32x4*)(KP + off) = pack8(kp0, kp1); *(u32x4*)(BB + off) = pack8(-(kn0 * a0v), -(kn1 * a1v));
                    asm volatile("" ::: "memory"); } }
    }
};
template <bool ADD> struct EpiMix {
    static constexpr bool PERM = true, SWAP = false;
    bf16_t* O; const bf16_t* proj; int gcol0;
    __device__ __forceinline__ void operator()(AccRef acc, const Unit& u, int wr, int wc, int fr, int fq) const {
        const int row0 = u.pm * BM + wr * 64 + fr, col0 = u.pn * BM + wc * 32 + 8 * fq;
#pragma unroll
        for (int ai = 0; ai < 2; ++ai)
#pragma unroll
            for (int m = 0; m < 4; ++m) { const int row = row0 + ai * HALF + m * 16;
#pragma unroll
                for (int bj = 0; bj < 2; ++bj) { f32x4 g0, g1; unpack8(*(const u32x4*)(proj + (size_t)row * PLD + gcol0 + col0 + bj * HALF), g0, g1);
                    f32x4 o0, o1;
#pragma unroll
                    for (int e = 0; e < 4; ++e) { o0[e] = fsigmoid(g0[e]) * acc[ai][bj][m][0][e]; o1[e] = fsigmoid(g1[e]) * acc[ai][bj][m][1][e]; }
                    bf16_t* op = O + (size_t)row * D + col0 + bj * HALF;
                    if (ADD) { f32x4 p0, p1; unpack8(*(const u32x4*)op, p0, p1); o0 += p0; o1 += p1; }
                    *(u32x4*)op = pack8(o0, o1); } }
    }
};
struct EpiRes {
    static constexpr bool PERM = true, SWAP = false;
    float* O; const float* x;
    __device__ __forceinline__ void operator()(AccRef acc, const Unit& u, int wr, int wc, int fr, int fq) const {
        const int row0 = u.pm * BM + wr * 64 + fr, col0 = u.pn * BM + wc * 32 + 8 * fq;
#pragma unroll
        for (int ai = 0; ai < 2; ++ai)
#pragma unroll
            for (int m = 0; m < 4; ++m) { const size_t off = (size_t)(row0 + ai * HALF + m * 16) * D + col0;
#pragma unroll
                for (int bj = 0; bj < 2; ++bj)
#pragma unroll
                    for (int n = 0; n < 2; ++n) *(f32x4*)(O + off + bj * HALF + 4 * n) = *(const f32x4*)(x + off + bj * HALF + 4 * n) + acc[ai][bj][m][n]; }
    }
};
}

#define XB_TMO      128
#define XB_XCNT(j)  (256  + 64 * (j))
#define XB_XSUB(j)  (1280 + 64 * (j))
#define XB_XGEN(j)  (2304 + 64 * (j))
#define XB_TOP      3328
#define XB_TOPGEN   3392
#define XCD_BAR_WORDS 3456
#define XB_SPIN_CAP (1u << 18)
__device__ __forceinline__ unsigned xb_ld(unsigned* p)              { return __hip_atomic_load(p, __ATOMIC_RELAXED, __HIP_MEMORY_SCOPE_AGENT); }
__device__ __forceinline__ unsigned xb_add(unsigned* p, unsigned v) { return __hip_atomic_fetch_add(p, v, __ATOMIC_RELAXED, __HIP_MEMORY_SCOPE_AGENT); }
__device__ __forceinline__ unsigned xb_xcc_id() { return (unsigned)__builtin_amdgcn_s_getreg((3 << 11) | 20) & 0xFu; }
#define XB_SPIN(cond, bar) do { unsigned _sp = 0; while (cond) { __builtin_amdgcn_s_sleep(1); \
    if ((++_sp & 255u) == 0u) { if (xb_ld(&(bar)[XB_TMO])) break; if (_sp > XB_SPIN_CAP) { atomicAdd(&(bar)[XB_TMO], 1u); break; } } } } while (0)
struct XcdBarrier { unsigned* bar; unsigned x; volatile LAS unsigned* st; };
__device__ __forceinline__ XcdBarrier xcd_barrier_post(unsigned* bar, volatile LAS unsigned* st) {
    XcdBarrier b; b.bar = bar; b.x = xb_xcc_id(); b.st = st;
    if (threadIdx.x == 0) (void)xb_add(&bar[XB_XCNT(b.x)], 1u);
    return b;
}
__device__ __forceinline__ void xcd_barrier_complete(unsigned* bar, unsigned x, unsigned& nloc, unsigned& nx) {
    const unsigned G = gridDim.x * gridDim.y * gridDim.z;
    unsigned sum, cnt, mine, sp = 0u;
    for (;;) {
        sum = 0u; cnt = 0u; mine = 0u;
#pragma unroll
        for (unsigned j = 0; j < 16; ++j) { const unsigned c = xb_ld(&bar[XB_XCNT(j)]); sum += c; cnt += (c > 0u) ? 1u : 0u; mine = (j == x) ? c : mine; }
        if (sum == G) break;
        __builtin_amdgcn_s_sleep(1);
        if ((++sp & 255u) == 0u) { if (xb_ld(&bar[XB_TMO])) break; if (sp > XB_SPIN_CAP) { atomicAdd(&bar[XB_TMO], 1u); break; } }
    }
    nloc = mine > 0u ? mine : 1u; nx = cnt > 0u ? cnt : 1u;
}
__device__ __forceinline__ void xcd_barrier(const XcdBarrier& b) {
    asm volatile("s_waitcnt vmcnt(0)" ::: "memory");
    __syncthreads();
    if (threadIdx.x == 0) {
        unsigned* bar = b.bar;
        __builtin_amdgcn_s_waitcnt(0);
        unsigned nloc = b.st[0], nx = b.st[1];
        if (nloc == 0u) { xcd_barrier_complete(bar, b.x, nloc, nx); b.st[0] = nloc; b.st[1] = nx; }
        const unsigned old = xb_add(&bar[XB_XSUB(b.x)], 1u);
        const unsigned gen = old / nloc;
        if (old + 1u == (gen + 1u) * nloc) {
            __builtin_amdgcn_fence(__ATOMIC_RELEASE, "agent");
            asm volatile("s_waitcnt vmcnt(0)" ::: "memory");
            const unsigned og = xb_add(&bar[XB_TOP], 1u);
            const unsigned tg = og / nx;
            if (og + 1u == (tg + 1u) * nx) xb_add(&bar[XB_TOPGEN], 1u);
            else XB_SPIN(xb_ld(&bar[XB_TOPGEN]) == tg, bar);
            __builtin_amdgcn_fence(__ATOMIC_ACQUIRE, "agent");
            xb_add(&bar[XB_XGEN(b.x)], 1u);
            asm volatile("s_waitcnt vmcnt(0)" ::: "memory");
        } else {
            XB_SPIN(xb_ld(&bar[XB_XGEN(b.x)]) == gen, bar);
            __builtin_amdgcn_fence(__ATOMIC_ACQUIRE, "agent");
            asm volatile("s_waitcnt vmcnt(0)" ::: "memory");
        }
    }
    __syncthreads();
}

struct Args {
    const float *x, *norm1_g, *w_in, *mu, *w0, *w_up, *a0, *a_up, *g_up, *k_k, *k_a, *r_k, *lnx_g, *lnx_b, *w_ba, *w_bb, *w_out, *norm2_g, *peer_wq, *sub_keys, *peer_u, *peer_v, *final_g;
    float* out; unsigned char* ws; int ph_lo, ph_hi, li, pad;
};
#define CAS __attribute__((address_space(4)))
typedef const CAS Args* ArgsP;
__device__ __forceinline__ ArgsP get_args() { ArgsP p = (ArgsP)__builtin_amdgcn_kernarg_segment_ptr(); asm volatile("" : "+s"(p)); return p; }
struct Frame { LAS unsigned char* lds; int tid, lane, wave, vcu, G; };

__device__ __forceinline__ int win_dst(int s) {
    if (s < SHIFTW) return s;
    if (s < SHIFTW + 4096) { const int base = (s < SHIFTW + 2048) ? SHIFTW : SHIFTW + 2048; const int m = s - base, head = m >> 7, c = m & 127; const int j = (c < 64) ? 2 * c : 2 * (c - 64) + 1;
        return ((s < SHIFTW + 2048) ? PC_MQ : PC_MK) + head * 128 + j; }
    if (s < SHIFTW + 6144) return PC_MV + (s - (SHIFTW + 4096));
    if (s < SHIFTW + 6144 + 4096) return PC_GA + (s - (SHIFTW + 6144));
    return PC_GB + (s - (SHIFTW + 6144 + 4096));
}
template <bool MAPWIN> __device__ __forceinline__ void p0_transpose_item(const float* W, int K, int N, bf16_t* WT, int Kd, LAS float* scr, int item, int lane) {
    const int nblk = N / 32, kb = item / nblk, nb = item % nblk, k0 = 64 * kb, n0 = 32 * nb;
    { const int krow = lane >> 3, c4 = lane & 7; f32x4 v[8];
#pragma unroll
      for (int i = 0; i < 8; ++i) { const int kk = 8 * i + krow; v[i] = (k0 + kk < K) ? *(const f32x4*)(W + (size_t)(k0 + kk) * N + n0 + 4 * c4) : (f32x4){0.f, 0.f, 0.f, 0.f}; }
#pragma unroll
      for (int i = 0; i < 8; ++i) { LAS float* d = scr + (8 * i + krow) * 33 + 4 * c4; d[0] = v[i].x; d[1] = v[i].y; d[2] = v[i].z; d[3] = v[i].w; } }
    LDS_WAIT(); asm volatile("" ::: "memory");
    const int c = lane & 7;
#pragma unroll
    for (int j = 0; j < 4; ++j) { const int n = (lane >> 3) + 8 * j; const LAS float* s = scr + (8 * c) * 33 + n;
        u32x4 o; o.x = pk2(s[0 * 33], s[1 * 33]); o.y = pk2(s[2 * 33], s[3 * 33]); o.z = pk2(s[4 * 33], s[5 * 33]); o.w = pk2(s[6 * 33], s[7 * 33]);
        const int row = MAPWIN ? win_dst(n0 + n) : (n0 + n);
        *(u32x4*)(WT + (size_t)row * Kd + k0 + 8 * c) = o; }
    LDS_WAIT(); asm volatile("" ::: "memory");
}
__device__ __forceinline__ void rms_rows_to_bf16(const float* x, const float* g, bf16_t* o, int m0, int mstride, int lane) {
    const f32x4* gr = (const f32x4*)g + lane;
    f32x4 v[16], w[16];
    if (m0 < T) {
#pragma unroll
        for (int j = 0; j < 16; ++j) v[j] = ((const f32x4*)(x + (size_t)m0 * D) + lane)[64 * j]; }
    for (int m = m0; m < T; m += mstride) { const bool hasn = m + mstride < T;
        if (hasn) {
#pragma unroll
            for (int j = 0; j < 16; ++j) w[j] = ((const f32x4*)(x + (size_t)(m + mstride) * D) + lane)[64 * j]; }
        float s = 0.f;
#pragma unroll
        for (int j = 0; j < 16; ++j) s += (v[j].x * v[j].x + v[j].y * v[j].y) + (v[j].z * v[j].z + v[j].w * v[j].w);
        const float rs = 1.0f / sqrtf(wave_sum(s) * (1.0f / D) + NORM_EPS);
        u32x2* o8 = (u32x2*)(o + (size_t)m * D) + lane;
#pragma unroll
        for (int j = 0; j < 16; ++j) { const f32x4 gg = gr[64 * j]; u32x2 q; q.x = pk2(v[j].x * rs * gg.x, v[j].y * rs * gg.y); q.y = pk2(v[j].z * rs * gg.z, v[j].w * rs * gg.w); o8[64 * j] = q; }
        if (hasn) {
#pragma unroll
            for (int j = 0; j < 16; ++j) v[j] = w[j]; }
    }
}
__device__ __forceinline__ void cvt_table(const float* src, bf16_t* dst, size_t n8, size_t gtid, size_t nthr) {
    for (size_t i = gtid; i < n8; i += nthr) { const f32x4 a = ((const f32x4*)src)[2 * i], b = ((const f32x4*)src)[2 * i + 1]; ((u32x4*)dst)[i] = pg8::pack8(a, b); }
}
__device__ __forceinline__ void pq_load(ArgsP A, int row, int lane, f32x4 (&v)[16]) {
    const f32x4* src = (const f32x4*)((row >= 16384 ? A->peer_v + (size_t)(row - 16384) * D : A->peer_u + (size_t)row * D)) + lane;
#pragma unroll
    for (int j = 0; j < 16; ++j) v[j] = __builtin_nontemporal_load(src + 64 * j);
}
__device__ __forceinline__ void pq_finish(unsigned char* ws, int row, int lane, const f32x4 (&v)[16]) {
    const bool isv = row >= 16384; const int rr = isv ? row - 16384 : row; float am = 0.f;
#pragma unroll
    for (int j = 0; j < 16; ++j) am = fmaxf(fmaxf(am, fmaxf(fabsf(v[j].x), fabsf(v[j].y))), fmaxf(fabsf(v[j].z), fabsf(v[j].w)));
#pragma unroll
    for (int o = 1; o < 64; o <<= 1) am = fmaxf(am, __shfl_xor(am, o));
    const float inv = am > 0.f ? 127.0f / am : 0.f; unsigned* dst = (unsigned*)(ws + (isv ? WS_PV : WS_PU)) + (size_t)rr * (D / 4) + lane;
#pragma unroll
    for (int j = 0; j < 16; ++j) { const unsigned q0 = (unsigned)(int)(rintf(v[j].x * inv) + 128.0f), q1 = (unsigned)(int)(rintf(v[j].y * inv) + 128.0f), q2 = (unsigned)(int)(rintf(v[j].z * inv) + 128.0f), q3 = (unsigned)(int)(rintf(v[j].w * inv) + 128.0f);
        dst[64 * j] = q0 | (q1 << 8) | (q2 << 16) | (q3 << 24); }
    if (lane == 0) ((float*)(ws + (isv ? WS_PSV : WS_PSU)))[rr] = am * (1.0f / 127.0f);
}
__device__ __forceinline__ void peer_quant(ArgsP A, Frame& F, int w0, int wstride) {
    unsigned char* ws = A->ws; const float* pu = A->peer_u; const float* pv = A->peer_v;
    f32x4 v[16], w[16];
    auto rowp = [&](int row) { return (const f32x4*)((row >= 16384 ? pv + (size_t)(row - 16384) * D : pu + (size_t)row * D)) + F.lane; };
    if (w0 < 2 * 16384) { const f32x4* src = rowp(w0);
#pragma unroll
        for (int j = 0; j < 16; ++j) v[j] = __builtin_nontemporal_load(src + 64 * j); }
    for (int row = w0; row < 2 * 16384; row += wstride) { const bool isv = row >= 16384; const int rr = isv ? row - 16384 : row; const bool hasn = row + wstride < 2 * 16384;
        if (hasn) { const f32x4* src = rowp(row + wstride);
#pragma unroll
            for (int j = 0; j < 16; ++j) w[j] = __builtin_nontemporal_load(src + 64 * j); }
        float am = 0.f;
#pragma unroll
        for (int j = 0; j < 16; ++j) am = fmaxf(fmaxf(am, fmaxf(fabsf(v[j].x), fabsf(v[j].y))), fmaxf(fabsf(v[j].z), fabsf(v[j].w)));
#pragma unroll
        for (int o = 1; o < 64; o <<= 1) am = fmaxf(am, __shfl_xor(am, o));
        const float inv = am > 0.f ? 127.0f / am : 0.f; unsigned* dst = (unsigned*)(ws + (isv ? WS_PV : WS_PU)) + (size_t)rr * (D / 4) + F.lane;
#pragma unroll
        for (int j = 0; j < 16; ++j) { const unsigned q0 = (unsigned)(int)(rintf(v[j].x * inv) + 128.0f), q1 = (unsigned)(int)(rintf(v[j].y * inv) + 128.0f), q2 = (unsigned)(int)(rintf(v[j].z * inv) + 128.0f), q3 = (unsigned)(int)(rintf(v[j].w * inv) + 128.0f);
            dst[64 * j] = q0 | (q1 << 8) | (q2 << 16) | (q3 << 24); }
        if (F.lane == 0) ((float*)(ws + (isv ? WS_PSV : WS_PSU)))[rr] = am * (1.0f / 127.0f);
        if (hasn) {
#pragma unroll
            for (int j = 0; j < 16; ++j) v[j] = w[j]; }
    }
}
__device__ __forceinline__ void late_weights(ArgsP A, Frame& F, int w0, int wstride) {
    unsigned char* ws = A->ws;
    LAS float* scr = (LAS float*)(F.lds + RING_OFF + F.wave * 16384);
    constexpr int I_BA = 32 * 128, I_OUT = 64 * 128, I_WQ = 64 * 64, I_SK = PH_ * 2 * PNK * PHALF / 512;
    constexpr int NITEMS = 2 * I_BA + I_OUT + I_WQ + I_SK;
    for (int it = w0; it < NITEMS; it += wstride) {
        int r = it;
        if (r < I_BA) { p0_transpose_item<false>(A->w_ba, RW, D, (bf16_t*)(ws + WS_WA), RW, scr, r, F.lane); continue; } r -= I_BA;
        if (r < I_BA) { p0_transpose_item<false>(A->w_bb, RW, D, (bf16_t*)(ws + WS_WB), RW, scr, r, F.lane); continue; } r -= I_BA;
        if (r < I_OUT) { p0_transpose_item<false>(A->w_out, D, D, (bf16_t*)(ws + WS_WOUT), D, scr, r, F.lane); continue; } r -= I_OUT;
        if (r < I_WQ) { p0_transpose_item<false>(A->peer_wq, D, 2048, (bf16_t*)(ws + WS_WQ), D, scr, r, F.lane); continue; } r -= I_WQ;
        { const size_t i = (size_t)r * 64 + F.lane; const f32x4 a = ((const f32x4*)A->sub_keys)[2 * i], b = ((const f32x4*)A->sub_keys)[2 * i + 1]; ((u32x4*)(ws + WS_SUBK))[i] = pg8::pack8(a, b); }
    }
}
__device__ __forceinline__ void ph0_prologue(ArgsP A, Frame& F) {
    unsigned char* ws = A->ws;
    LAS float* scr = (LAS float*)(F.lds + RING_OFF + F.wave * 16384);
    const int gw = F.vcu * NWAVES + F.wave, NGW = F.G * NWAVES;
    constexpr int I_IN = 64 * (INW / 32), I_UP = 2 * 64, I_G = 8 * 64;
    constexpr int NITEMS = I_IN + 2 * I_UP + I_G;
    for (int it = gw; it < NITEMS; it += NGW) {
        int r = it;
        if (r < I_IN) { p0_transpose_item<true>(A->w_in, D, INW, (bf16_t*)(ws + WS_WIN), D, scr, r, F.lane); continue; } r -= I_IN;
        if (r < I_UP) { p0_transpose_item<false>(A->w_up, LW, RW, (bf16_t*)(ws + WS_WUP), LW, scr, r, F.lane); continue; } r -= I_UP;
        if (r < I_UP) { p0_transpose_item<false>(A->a_up, LA, RW, (bf16_t*)(ws + WS_AUP), LA, scr, r, F.lane); continue; } r -= I_UP;
        p0_transpose_item<false>(A->g_up, LG, RW, (bf16_t*)(ws + WS_GUP), LGP, scr, r, F.lane);
    }
    const size_t gtid = (size_t)F.vcu * NTHR + F.tid, nthr = (size_t)F.G * NTHR;
    for (size_t i = gtid; i < (size_t)32 * D / 8; i += nthr) ((u32x4*)((bf16_t*)(ws + WS_WIN) + (size_t)SHIFTW * D))[i] = (u32x4){0u, 0u, 0u, 0u};
    for (size_t i = gtid; i < (size_t)T * 64; i += nthr) { const int pos = (int)(i >> 6), fi = (int)(i & 63); const float inv = powf(10000.0f, -(float)fi / 64.0f); const float ang = (float)pos * inv;
        ((f32x2*)(ws + WS_ROPE))[i] = (f32x2){cosf(ang), sinf(ang)}; }
    rms_rows_to_bf16(A->x, A->norm1_g, (bf16_t*)(ws + WS_XN), gw, NGW, F.lane);
}

__device__ __forceinline__ f32x4 ld4bf(const bf16_t* p) { const u32x2 w = *(const u32x2*)p; return (f32x4){bflo(w.x), bfhi(w.x), bflo(w.y), bfhi(w.y)}; }
__device__ __forceinline__ void st4bf(bf16_t* p, f32x4 v) { u32x2 w; w.x = pk2(v[0], v[1]); w.y = pk2(v[2], v[3]); *(u32x2*)p = w; }
__device__ __forceinline__ void ph2_prep(ArgsP A, Frame& F) {
    unsigned char* ws = A->ws; const bf16_t* PROJ = (const bf16_t*)(ws + WS_PROJ);
    LAS float* red = (LAS float*)(F.lds + RING_OFF);
    for (int it = F.vcu; it < NBLK * MH; it += F.G) { const int n = it / MH, h = it % MH, d = F.tid & 127, part = F.tid >> 7;
        const bf16_t* p = (const bf16_t*)(ws + WS_KB) + ((size_t)h * T + n * MBLK + part * 64) * MD + d; float s = 0.f;
#pragma unroll 8
        for (int i = 0; i < 64; ++i) s += bf1(p[(size_t)i * MD]);
        red[F.tid] = s; WG_BAR();
        if (F.tid < 128) { const float m = (red[F.tid] + red[F.tid + 128] + red[F.tid + 256] + red[F.tid + 384]) * (1.0f / MBLK); const unsigned hi = f2bf(m); const float lo = m - __builtin_bit_cast(float, hi << 16);
            ((bf16_t*)(ws + WS_KMEAN))[(size_t)(h * NBLK + n) * MD + F.tid] = (bf16_t)hi; ((bf16_t*)(ws + WS_KMEAN + 131072))[(size_t)(h * NBLK + n) * MD + F.tid] = (bf16_t)f2bf(lo); }
        WG_BAR(); }
    const int tid = F.tid; const int c = 4 * tid;
    const f32x4 mu_r = *(const f32x4*)(A->mu + PC_R + c), mu_k = *(const f32x4*)(A->mu + PC_K + c), mu_v = *(const f32x4*)(A->mu + PC_V + c), kkw = *(const f32x4*)(A->k_k + c);
    int lc = 0, lcc = 0; if (tid < 32) { lcc = 4 * tid; lc = PC_WL + lcc; } else if (tid < 64) { lcc = 4 * (tid - 32); lc = PC_AL + lcc; } else { lcc = 4 * (tid - 64); lc = PC_GL + lcc; }
    const bool lact = tid < 64 || (tid < 192 && lcc < LG);
    const f32x4 mu_l = lact ? *(const f32x4*)(A->mu + lc) : (f32x4){0.f, 0.f, 0.f, 0.f};
    u32x2 cur[8], nxt[8];
    auto tload = [&](int t, u32x2 (&rg)[8]) { const bf16_t* P = PROJ + (size_t)t * PLD; const bf16_t* PP = t > 0 ? P - PLD : P;
        rg[0] = *(const u32x2*)(P + PC_R + c); rg[1] = *(const u32x2*)(PP + PC_R + c); rg[2] = *(const u32x2*)(P + PC_K + c); rg[3] = *(const u32x2*)(PP + PC_K + c);
        rg[4] = *(const u32x2*)(P + PC_V + c); rg[5] = *(const u32x2*)(PP + PC_V + c);
        if (lact) { rg[6] = *(const u32x2*)(P + lc); rg[7] = *(const u32x2*)(PP + lc); } else { rg[6] = (u32x2){0u, 0u}; rg[7] = (u32x2){0u, 0u}; } };
    auto up4 = [](u32x2 w) { return (f32x4){bflo(w.x), bfhi(w.x), bflo(w.y), bfhi(w.y)}; };
    if (F.vcu < T) tload(F.vcu, cur);
    for (int t = F.vcu; t < T; t += F.G) { const bool hasn = t + F.G < T; if (hasn) tload(t + F.G, nxt);
        const float hp = t > 0 ? 1.0f : 0.0f;
        { const f32x4 p = up4(cur[0]), pp = up4(cur[1]) * hp; st4bf((bf16_t*)(ws + WS_ZR) + (size_t)t * RW + c, p + (pp - p) * mu_r); }
        { const f32x4 p = up4(cur[2]), pp = up4(cur[3]) * hp; const f32x4 zk = p + (pp - p) * mu_k;
          st4bf((bf16_t*)(ws + WS_KP) + (size_t)t * RW + c, zk); const f32x4 kk = zk * kkw;
          const float ss = sum16((kk[0] * kk[0] + kk[1] * kk[1]) + (kk[2] * kk[2] + kk[3] * kk[3])); const float inv = 1.0f / fmaxf(sqrtf(ss), 1e-12f);
          st4bf((bf16_t*)(ws + WS_KKN) + (size_t)t * RW + c, kk * inv); }
        { const f32x4 p = up4(cur[4]), pp = up4(cur[5]) * hp; st4bf((bf16_t*)(ws + WS_ZV) + (size_t)t * RW + c, p + (pp - p) * mu_v); }
        if (tid < 192) { const f32x4 zero = (f32x4){0.f, 0.f, 0.f, 0.f};
            f32x4 z = zero; if (lact) { const f32x4 p = up4(cur[6]), pp = up4(cur[7]) * hp; z = p + (pp - p) * mu_l; }
            if (tid < 32) { f32x4 o;
#pragma unroll
                for (int e = 0; e < 4; ++e) o[e] = 1.0f - 2.0f * __builtin_amdgcn_rcpf(__expf(2.0f * z[e]) + 1.0f);
                st4bf((bf16_t*)(ws + WS_AW) + (size_t)t * LW + lcc, o); }
            else if (tid < 64) st4bf((bf16_t*)(ws + WS_AA) + (size_t)t * LA + lcc, z);
            else { f32x4 o = zero; if (lcc < LG) {
#pragma unroll
                for (int e = 0; e < 4; ++e) o[e] = fsigmoid(z[e]); }
                st4bf((bf16_t*)(ws + WS_AG) + (size_t)t * LGP + lcc, o); }
        }
        if (hasn) {
#pragma unroll
            for (int i = 0; i < 8; ++i) cur[i] = nxt[i]; }
    }
}

__device__ __forceinline__ void ph3_gate(ArgsP A, Frame& F) {
    unsigned char* ws = A->ws; const bf16_t* PROJ = (const bf16_t*)(ws + WS_PROJ); const bf16_t* KMH = (const bf16_t*)(ws + WS_KMEAN); const bf16_t* KML = (const bf16_t*)(ws + WS_KMEAN + 131072); unsigned* MASK = (unsigned*)(ws + WS_MASK);
    const int gw = F.vcu * NWAVES + F.wave, NGW = F.G * NWAVES; const int r = F.lane & 31, hh = F.lane >> 5; const float NEG = -__builtin_inff();
    for (int it = gw; it < (T / 32) * MH; it += NGW) { const int tg = it >> 4, h = it & 15, t = tg * 32 + r, blk = tg >> 3;
        if (blk == 0) { if (hh == 0) MASK[t * MH + h] = 0u; continue; }
        f32x16 acc;
#pragma unroll
        for (int e = 0; e < 16; ++e) acc[e] = 0.f;
#pragma unroll
        for (int ks = 0; ks < 8; ++ks) { const bf16x8 q = *(const bf16x8*)(PROJ + (size_t)t * PLD + PC_MQ + h * MD + 16 * ks + 8 * hh); const size_t ko = (size_t)(h * NBLK + r) * MD + 16 * ks + 8 * hh;
            acc = __builtin_amdgcn_mfma_f32_32x32x16_bf16(*(const bf16x8*)(KMH + ko), q, acc, 0, 0, 0); acc = __builtin_amdgcn_mfma_f32_32x32x16_bf16(*(const bf16x8*)(KML + ko), q, acc, 0, 0, 0); }
        float t0 = NEG, t1 = NEG, t2 = NEG;
#pragma unroll
        for (int e = 0; e < 16; ++e) { const int n = (e & 3) + 8 * (e >> 2) + 4 * hh; float ae = acc[e]; asm volatile("" : "+v"(ae));
            float x = __builtin_bit_cast(float, (__builtin_bit_cast(unsigned, ae) & ~31u) | (unsigned)(31 - n)); x = (n < blk) ? x : NEG;
            t2 = __builtin_amdgcn_fmed3f(t1, t2, x); t1 = __builtin_amdgcn_fmed3f(t0, t1, x); t0 = fmaxf(t0, x); }
        const float o0 = __shfl_xor(t0, 32), o1 = __shfl_xor(t1, 32), o2 = __shfl_xor(t2, 32);
        t2 = __builtin_amdgcn_fmed3f(t1, t2, o0); t1 = __builtin_amdgcn_fmed3f(t0, t1, o0); t0 = fmaxf(t0, o0);
        t2 = __builtin_amdgcn_fmed3f(t1, t2, o1); t1 = __builtin_amdgcn_fmed3f(t0, t1, o1); t0 = fmaxf(t0, o1);
        t2 = __builtin_amdgcn_fmed3f(t1, t2, o2); t1 = __builtin_amdgcn_fmed3f(t0, t1, o2); t0 = fmaxf(t0, o2);
        unsigned sel = 1u << (31 - (__builtin_bit_cast(unsigned, t0) & 31u));
        if (blk > 1) sel |= 1u << (31 - (__builtin_bit_cast(unsigned, t1) & 31u));
        if (blk > 2) sel |= 1u << (31 - (__builtin_bit_cast(unsigned, t2) & 31u));
        if (hh == 0) MASK[t * MH + h] = sel;
        { gu32* cnt = (gu32*)(ws + WS_CTL) + CW_CNT + h * 32; unsigned short* lst = (unsigned short*)(ws + WS_LIST) + (size_t)h * 32 * 8192; const unsigned mysel = hh == 0 ? sel : 0u;
          unsigned mycnt = 0u;
          for (int j = 0; j < blk; ++j) { const unsigned long long bal = __ballot((mysel >> j) & 1u); const unsigned c = (unsigned)__builtin_popcountll(bal); mycnt = (F.lane == j) ? c : mycnt; }
          unsigned base = 0u; if (F.lane < blk && mycnt) base = __hip_atomic_fetch_add(cnt + F.lane, mycnt, __ATOMIC_RELAXED, __HIP_MEMORY_SCOPE_AGENT);
          for (int j = 0; j < blk; ++j) { const unsigned long long bal = __ballot((mysel >> j) & 1u); const unsigned bj = (unsigned)__builtin_amdgcn_readlane((int)base, j);
              if ((mysel >> j) & 1u) { const unsigned off = __builtin_amdgcn_mbcnt_hi((unsigned)(bal >> 32), __builtin_amdgcn_mbcnt_lo((unsigned)bal, 0u)); const unsigned slot = (unsigned)__builtin_popcount(mysel & ((1u << j) - 1u));
                  lst[(size_t)j * 8192 + bj + off] = (unsigned short)((unsigned)t | (slot << 13)); } } } }
}

constexpr int CK = 64, NCHK = T / CK, CP = 144, CPF = 272;
constexpr int L_AT = 0, L_BT = 9216, L_KT = 18432, L_RT = 27648, L_ATT = 36864, L_BTT = 46080, L_V = 55296, L_MKA = 64512, L_MBRT = 73728, L_MKRT = 82944, L_A2 = 92160, L_MBA = 101376, L_PC = 118784, L_WT = 119040, L_MBH = 121088, L_TD = 130304, L_PT = 134912, L_CEND = 139520;
constexpr int L_TT = L_AT, L_A1 = L_BT, L_Y2T = L_MKA, L_G2T = L_ATT;
static_assert(L_CEND <= RING_BYTES, "chunk prep LDS");
constexpr size_t CHW_ITEM = 32768;
__device__ __forceinline__ f32x16 nt_quad(const LAS unsigned char* X, const LAS unsigned char* Y, int qp, int qq, int r, int hh) {
    f32x16 acc;
#pragma unroll
    for (int e = 0; e < 16; ++e) acc[e] = 0.f;
#pragma unroll
    for (int ks = 0; ks < 4; ++ks) { const bf16x8 a = *(const LAS bf16x8*)(Y + (32 * qq + r) * CP + 32 * ks + 16 * hh), b = *(const LAS bf16x8*)(X + (32 * qp + r) * CP + 32 * ks + 16 * hh);
        acc = __builtin_amdgcn_mfma_f32_32x32x16_bf16(a, b, acc, 0, 0, 0); }
    return acc;
}
__device__ __forceinline__ int nt_q(int qq, int e, int hh) { return 32 * qq + (e & 3) + 8 * (e >> 2) + 4 * hh; }
__device__ __forceinline__ void nt_store_bf16(LAS unsigned char* O, int p, int qq, int hh, const f32x16& v) {
#pragma unroll
    for (int g = 0; g < 4; ++g) { u32x2 w; w.x = pk2(v[4 * g], v[4 * g + 1]); w.y = pk2(v[4 * g + 2], v[4 * g + 3]); *(LAS u32x2*)(O + p * CP + (32 * qq + 8 * g + 4 * hh) * 2) = w; }
}
__device__ __forceinline__ void ph4_chunkprep(ArgsP A, Frame& F) {
    unsigned char* ws = A->ws;
    const float* DEC = (const float*)(ws + WS_DEC); const bf16_t* KKN = (const bf16_t*)(ws + WS_KKN); const bf16_t* BBg = (const bf16_t*)(ws + WS_BB); const bf16_t* KPg = (const bf16_t*)(ws + WS_KP);
    const bf16_t* ZR = (const bf16_t*)(ws + WS_ZR); const bf16_t* ZV = (const bf16_t*)(ws + WS_ZV); float* Yg = (float*)(ws + WS_Y); unsigned char* CHW = ws + WS_WIN;
    LAS unsigned char* L = F.lds + RING_OFF; const int wave = F.wave, lane = F.lane, r = lane & 31, hh = lane >> 5;
    const int prod = wave >> 2, qp = (wave >> 1) & 1, qq = wave & 1, p = 32 * qp + r;
    float nwv[8]; unsigned nkk[4], nbb[4], nkp[4], nr[4], nv[4];
    auto request = [&](int h2, int c2) {
#pragma unroll
        for (int k = 0; k < 8; ++k) nwv[k] = DEC[(size_t)(c2 * CK + 8 * wave + k) * RW + (size_t)h2 * RN + lane];
#pragma unroll
        for (int i = 0; i < 4; ++i) { const size_t o = (size_t)(c2 * CK + 8 * wave + 2 * i + hh) * RW + (size_t)h2 * RN + 2 * r;
            nkk[i] = *(const unsigned*)(KKN + o); nbb[i] = *(const unsigned*)(BBg + o); nkp[i] = *(const unsigned*)(KPg + o); nr[i] = *(const unsigned*)(ZR + o); nv[i] = *(const unsigned*)(ZV + o); } };
    if (F.vcu < RH * NCHK) request(F.vcu / NCHK, F.vcu % NCHK);
    if (F.vcu == 0 && wave == 0) {
        const gu32* cnt = (const gu32*)(ws + WS_CTL) + CW_CNT; unsigned* ud = (unsigned*)(ws + WS_UDESC); unsigned np[8], tot = 0u;
#pragma unroll
        for (int k = 0; k < 8; ++k) { const unsigned c = __hip_atomic_load(cnt + 8 * lane + k, __ATOMIC_RELAXED, __HIP_MEMORY_SCOPE_AGENT); np[k] = (c + 255u) >> 8; tot += np[k]; }
        unsigned incl = tot;
#pragma unroll
        for (int o = 1; o < 64; o <<= 1) { const unsigned v = __shfl_up(incl, o); if (lane >= o) incl += v; }
        unsigned pos = incl - tot;
#pragma unroll
        for (int k = 0; k < 8; ++k) { const unsigned c = __hip_atomic_load(cnt + 8 * lane + k, __ATOMIC_RELAXED, __HIP_MEMORY_SCOPE_AGENT); for (unsigned ps = 0; ps < np[k]; ++ps) { ud[1 + 2 * pos] = (unsigned)(8 * lane + k) | (ps << 16); ud[2 + 2 * pos] = c; ++pos; } }
        if (lane == 63) ud[0] = incl; }
    int qrow = F.vcu * NWAVES + wave; const int qstride = F.G * NWAVES; f32x4 qv[16];
    for (int item = F.vcu; item < RH * NCHK; item += F.G) { const int h = item / NCHK, c = item % NCHK; const size_t hc = (size_t)h * RN; const int t0 = c * CK;
        const bool qdo = qrow < 2 * 16384;
        { float wv[8], kkv[8], bbv[8], kpv[8], rv[8]; unsigned vv[8];
#pragma unroll
          for (int k = 0; k < 8; ++k) { const int src = ((k & 1) << 7) | ((lane >> 1) << 2); const bool odd = lane & 1;
              auto mine = [&](unsigned x) { const unsigned w = (unsigned)__builtin_amdgcn_ds_bpermute(src, (int)x); return odd ? (w & 0xffff0000u) : (w << 16); };
              wv[k] = nwv[k]; kkv[k] = __builtin_bit_cast(float, mine(nkk[k >> 1])); bbv[k] = __builtin_bit_cast(float, mine(nbb[k >> 1])); kpv[k] = __builtin_bit_cast(float, mine(nkp[k >> 1]));
              rv[k] = __builtin_bit_cast(float, mine(nr[k >> 1])); vv[k] = mine(nv[k >> 1]) >> 16; }
          { const int nit = item + F.G; if (nit < RH * NCHK) request(nit / NCHK, nit % NCHK); }
          if (qdo) pq_load(A, qrow, lane, qv);
          float pl[8]; pl[0] = wv[0];
#pragma unroll
          for (int k = 1; k < 8; ++k) pl[k] = pl[k - 1] * wv[k];
          ((LAS float*)(L + L_WT))[wave * 64 + lane] = pl[7];
          WG_BAR();
          float pre = 1.f;
#pragma unroll
          for (int w2 = 0; w2 < 7; ++w2) { const float x = ((const LAS float*)(L + L_WT))[w2 * 64 + lane]; pre = (w2 < wave) ? pre * x : pre; }
          unsigned atp[4], btp[4], vtp[4];
#pragma unroll
          for (int k = 0; k < 8; ++k) { const float Pt = pre * pl[k], Pm = (k == 0) ? pre : pre * pl[k - 1], ip = __builtin_amdgcn_rcpf(Pt); const int t = 8 * wave + k;
              const unsigned a16 = f2bf(Pm * kkv[k]), b16 = f2bf(bbv[k] * ip), k16 = f2bf(kpv[k] * ip), r16 = f2bf(Pt * rv[k]);
              *(LAS bf16_t*)(L + L_AT + t * CP + 2 * lane) = (bf16_t)a16; *(LAS bf16_t*)(L + L_BT + t * CP + 2 * lane) = (bf16_t)b16; *(LAS bf16_t*)(L + L_KT + t * CP + 2 * lane) = (bf16_t)k16; *(LAS bf16_t*)(L + L_RT + t * CP + 2 * lane) = (bf16_t)r16;
              if (k & 1) { atp[k >> 1] |= a16 << 16; btp[k >> 1] |= b16 << 16; vtp[k >> 1] |= vv[k] << 16; } else { atp[k >> 1] = a16; btp[k >> 1] = b16; vtp[k >> 1] = vv[k]; }
              if (wave == 7 && k == 7) ((LAS float*)(L + L_PC))[lane] = Pt; }
          *(LAS u32x4*)(L + L_ATT + lane * CP + 16 * wave) = (u32x4){atp[0], atp[1], atp[2], atp[3]}; *(LAS u32x4*)(L + L_BTT + lane * CP + 16 * wave) = (u32x4){btp[0], btp[1], btp[2], btp[3]};
          *(LAS u32x4*)(L + L_V + lane * CP + 16 * wave) = (u32x4){vtp[0], vtp[1], vtp[2], vtp[3]}; }
        WG_BAR();
        { const f32x16 v = nt_quad(L + (prod ? L_KT : L_BT), L + L_AT, qp, qq, r, hh); f32x16 m;
#pragma unroll
          for (int e = 0; e < 16; ++e) m[e] = nt_q(qq, e, hh) > p ? v[e] : 0.f;
          if (prod == 0) {
#pragma unroll
              for (int g = 0; g < 4; ++g) *(LAS f32x4*)(L + L_MBA + p * CPF + (32 * qq + 8 * g + 4 * hh) * 4) = (f32x4){m[4 * g], m[4 * g + 1], m[4 * g + 2], m[4 * g + 3]}; }
          if (prod == 0) nt_store_bf16(L + L_MBH, p, qq, hh, m);
          else nt_store_bf16(L + L_MKA, p, qq, hh, m); }
        { const f32x16 v = nt_quad(L + L_RT, L + (prod ? L_KT : L_BT), qp, qq, r, hh); f32x16 m;
#pragma unroll
          for (int e = 0; e < 16; ++e) m[e] = nt_q(qq, e, hh) <= p ? v[e] : 0.f;
          nt_store_bf16(L + (prod ? L_MKRT : L_MBRT), p, qq, hh, m); }
        WG_BAR();
        { const int t = 8 * wave + (lane >> 3), g = lane & 7, base = 32 * (t >> 5); float T4[4] = {0.f, 0.f, 0.f, 0.f};
          const LAS unsigned char* mrow = L + L_MBA + (base + 4 * g) * 4;
          f32x4 m = *(const LAS f32x4*)(mrow + (base + 31) * CPF);
#pragma unroll 1
          for (int Sx = 7; Sx >= 0; --Sx) {
#pragma unroll
              for (int q = 3; q >= 0; --q) { const int sl = 4 * Sx + q, sr = base + sl, sn = sl > 0 ? sr - 1 : sr; const f32x4 n = *(const LAS f32x4*)(mrow + sn * CPF);
                  float part = (m[0] * T4[0] + m[1] * T4[1]) + (m[2] * T4[2] + m[3] * T4[3]);
                  part += dpp_f<0xB1>(part); part += dpp_f<0x4E>(part); part += dpp_f<0x141>(part);
                  const float val = (sr == t) ? 1.0f : part; T4[q] = (g == Sx) ? val : T4[q]; m = n; } }
          const unsigned w0 = pk2(T4[0], T4[1]), w1 = pk2(T4[2], T4[3]);
          *(LAS u32x2*)(L + L_TT + t * CP + (base + 4 * g) * 2) = (u32x2){w0, w1};
          if (base == 0) { *(LAS u32x2*)(L + L_TT + t * CP + (32 + 4 * g) * 2) = (u32x2){0u, 0u};
              *(LAS bf16_t*)(L + L_TD + (4 * g) * CP + 2 * t) = (bf16_t)(w0 & 0xffffu); *(LAS bf16_t*)(L + L_TD + (4 * g + 1) * CP + 2 * t) = (bf16_t)(w0 >> 16);
              *(LAS bf16_t*)(L + L_TD + (4 * g + 2) * CP + 2 * t) = (bf16_t)(w1 & 0xffffu); *(LAS bf16_t*)(L + L_TD + (4 * g + 3) * CP + 2 * t) = (bf16_t)(w1 >> 16); } }
        WG_BAR();
        if (wave == 0) {
            f32x16 acc;
#pragma unroll
            for (int e = 0; e < 16; ++e) acc[e] = 0.f;
#pragma unroll
            for (int ks = 0; ks < 2; ++ks) { const bf16x8 a = *(const LAS bf16x8*)(L + L_MBH + r * CP + 64 + 32 * ks + 16 * hh), b = *(const LAS bf16x8*)(L + L_TT + (32 + r) * CP + 64 + 32 * ks + 16 * hh);
                acc = __builtin_amdgcn_mfma_f32_32x32x16_bf16(a, b, acc, 0, 0, 0); }
            nt_store_bf16(L + L_PT, r, 0, hh, acc);
            LDS_WAIT(); asm volatile("" ::: "memory");
#pragma unroll
            for (int e = 0; e < 16; ++e) acc[e] = 0.f;
#pragma unroll
            for (int ks = 0; ks < 2; ++ks) { const bf16x8 a = *(const LAS bf16x8*)(L + L_TD + r * CP + 32 * ks + 16 * hh), b = *(const LAS bf16x8*)(L + L_PT + r * CP + 32 * ks + 16 * hh);
                acc = __builtin_amdgcn_mfma_f32_32x32x16_bf16(a, b, acc, 0, 0, 0); }
            nt_store_bf16(L + L_TT, 32 + r, 0, hh, acc);
        }
        WG_BAR();
        { const f32x16 v = nt_quad(L + (prod ? L_MKA : L_ATT), L + L_TT, qp, qq, r, hh);
          nt_store_bf16(L + (prod ? L_A2 : L_A1), p, qq, hh, v); }
        WG_BAR();
        unsigned char* cw = CHW + (size_t)item * CHW_ITEM;
        { const f32x16 v = nt_quad(L + L_MBRT, L + (prod ? L_A2 : L_A1), qp, qq, r, hh); f32x16 o;
          const LAS unsigned char* addm = L + (prod ? L_MKRT : L_RT);
#pragma unroll
          for (int g = 0; g < 4; ++g) { const u32x2 w = *(const LAS u32x2*)(addm + p * CP + (32 * qq + 8 * g + 4 * hh) * 2); o[4 * g] = v[4 * g] + bflo(w.x); o[4 * g + 1] = v[4 * g + 1] + bfhi(w.x); o[4 * g + 2] = v[4 * g + 2] + bflo(w.y); o[4 * g + 3] = v[4 * g + 3] + bfhi(w.y); }
          if (prod) nt_store_bf16(L + L_Y2T, p, qq, hh, o);
          else {
#pragma unroll
              for (int g = 0; g < 4; ++g) { u32x2 w; w.x = pk2(o[4 * g], o[4 * g + 1]); w.y = pk2(o[4 * g + 2], o[4 * g + 3]); *(u32x2*)(cw + (size_t)p * 128 + (32 * qq + 8 * g + 4 * hh) * 2) = w; } } }
        { const f32x16 v = nt_quad(L + L_BTT, L + (prod ? L_A2 : L_A1), qp, qq, r, hh); const float pc = ((const LAS float*)(L + L_PC))[p]; f32x16 o;
          if (prod) {
#pragma unroll
              for (int e = 0; e < 16; ++e) o[e] = (v[e] + bf1(*(const LAS bf16_t*)(L + L_KT + nt_q(qq, e, hh) * CP + 2 * p))) * pc;
              nt_store_bf16(L + L_G2T, p, qq, hh, o); }
          else {
#pragma unroll
              for (int e = 0; e < 16; ++e) o[e] = (v[e] + (nt_q(qq, e, hh) == p ? 1.0f : 0.0f)) * pc;
#pragma unroll
              for (int g = 0; g < 4; ++g) { u32x2 w; w.x = pk2(o[4 * g], o[4 * g + 1]); w.y = pk2(o[4 * g + 2], o[4 * g + 3]); *(u32x2*)(cw + 8192 + (size_t)p * 128 + (32 * qq + 8 * g + 4 * hh) * 2) = w; } } }
        WG_BAR();
        { const f32x16 v = prod ? nt_quad(L + L_V, L + L_G2T, qp, qq, r, hh) : nt_quad(L + L_Y2T, L + L_V, qp, qq, r, hh);
          float* dst = prod ? (float*)(cw + 16384) + (size_t)p * 64 : Yg + (size_t)(t0 + p) * RW + hc;
#pragma unroll
          for (int g = 0; g < 4; ++g) *(f32x4*)(dst + 32 * qq + 8 * g + 4 * hh) = (f32x4){v[4 * g], v[4 * g + 1], v[4 * g + 2], v[4 * g + 3]}; }
        if (qdo) { pq_finish(ws, qrow, lane, qv); qrow += qstride; }
        WG_BAR();
    }
    for (; qrow < 2 * 16384; qrow += qstride) { pq_load(A, qrow, lane, qv); pq_finish(ws, qrow, lane, qv); }
}
__device__ __forceinline__ void ph5_chain(ArgsP A, Frame& F, int h) {
    unsigned char* ws = A->ws; float* Yg = (float*)(ws + WS_Y); const unsigned char* CHW = ws + WS_WIN;
    LAS unsigned char* L = F.lds + RING_OFF; const int wave = F.wave, lane = F.lane, tid = F.tid, r = lane & 31, hh = lane >> 5;
    const int prod = wave >> 2, qp = (wave >> 1) & 1, qq = wave & 1, p = 32 * qp + r; const size_t hc = (size_t)h * RN;
    constexpr int L_S = 0, L_G = 2 * 9216, L_Y1 = 3 * 9216;
    for (int i = tid; i < 2 * 9216 / 4; i += NTHR) ((LAS unsigned*)(L + L_S))[i] = 0u;
    const int srow = tid >> 3, sc16 = tid & 7; u32x4 sg, sy;
    auto stage_ld = [&](int c) { const unsigned char* cw = CHW + (size_t)(h * NCHK + c) * CHW_ITEM; sy = *(const u32x4*)(cw + srow * 128 + sc16 * 16); sg = *(const u32x4*)(cw + 8192 + srow * 128 + sc16 * 16); };
    f32x4 nad[4];
    auto ad_ld = [&](int c) { const unsigned char* cw2 = CHW + (size_t)(h * NCHK + c) * CHW_ITEM; const float* addp = prod ? Yg + (size_t)(c * CK + p) * RW + hc : (const float*)(cw2 + 16384) + (size_t)p * 64;
#pragma unroll
        for (int g = 0; g < 4; ++g) nad[g] = *(const f32x4*)(addp + 32 * qq + 8 * g + 4 * hh); };
    stage_ld(0); ad_ld(0);
    int sb = 0;
    for (int c = 0; c < NCHK; ++c) {
        *(LAS u32x4*)(L + L_Y1 + srow * CP + sc16 * 16) = sy; *(LAS u32x4*)(L + L_G + srow * CP + sc16 * 16) = sg;
        const unsigned char* cw = CHW + (size_t)(h * NCHK + c) * CHW_ITEM;
        f32x4 ad[4];
#pragma unroll
        for (int g = 0; g < 4; ++g) ad[g] = nad[g];
        if (c + 1 < NCHK) { stage_ld(c + 1); ad_ld(c + 1); }
        WG_BAR();
        const f32x16 v = prod ? nt_quad(L + L_Y1, L + L_S + sb * 9216, qp, qq, r, hh) : nt_quad(L + L_S + sb * 9216, L + L_G, qp, qq, r, hh);
        f32x16 o;
#pragma unroll
        for (int g = 0; g < 4; ++g) { o[4 * g] = v[4 * g] + ad[g][0]; o[4 * g + 1] = v[4 * g + 1] + ad[g][1]; o[4 * g + 2] = v[4 * g + 2] + ad[g][2]; o[4 * g + 3] = v[4 * g + 3] + ad[g][3]; }
        if (prod) { float* yp = Yg + (size_t)(c * CK + p) * RW + hc;
#pragma unroll
            for (int g = 0; g < 4; ++g) *(f32x4*)(yp + 32 * qq + 8 * g + 4 * hh) = (f32x4){o[4 * g], o[4 * g + 1], o[4 * g + 2], o[4 * g + 3]}; }
        else nt_store_bf16(L + L_S + (sb ^ 1) * 9216, p, qq, hh, o);
        sb ^= 1;
        WG_BAR();
    }
}

__device__ __forceinline__ void ph5_ypost(ArgsP A, Frame& F) {
    unsigned char* ws = A->ws; const float* Y = (const float*)(ws + WS_Y); const bf16_t* ZR = (const bf16_t*)(ws + WS_ZR); const bf16_t* KP = (const bf16_t*)(ws + WS_KP); const bf16_t* ZV = (const bf16_t*)(ws + WS_ZV);
    const bf16_t* G = (const bf16_t*)(ws + WS_G); bf16_t* YA = (bf16_t*)(ws + WS_YA);
    const int gw = F.vcu * NWAVES + F.wave, NGW = F.G * NWAVES;
    for (int tg = F.vcu; tg < T / 32; tg += F.G) for (int it = F.wave; it < 256; it += NWAVES) { const int t = tg * 32 + (it >> 3), c = (it & 7) * 256 + 4 * F.lane; const size_t o = (size_t)t * RW + c;
        const f32x4 y = *(const f32x4*)(Y + o); const float mean = sum16((y[0] + y[1]) + (y[2] + y[3])) * (1.0f / 64.0f); const f32x4 d = y - mean;
        const float var = sum16((d[0] * d[0] + d[1] * d[1]) + (d[2] * d[2] + d[3] * d[3])) * (1.0f / 64.0f); const float rs = 1.0f / sqrtf(var + LNX_EPS);
        const f32x4 r = ld4bf(ZR + o), k = ld4bf(KP + o), v = ld4bf(ZV + o), g = ld4bf(G + o), rk = *(const f32x4*)(A->r_k + c), lg = *(const f32x4*)(A->lnx_g + c), lb = *(const f32x4*)(A->lnx_b + c);
        const f32x4 rkk = r * k * rk; const float bonus = sum16((rkk[0] + rkk[1]) + (rkk[2] + rkk[3]));
        st4bf(YA + o, (d * rs * lg + lb + bonus * v) * g); }
}

constexpr int AT_KB = 64 * 256, AT_VB = 128 * 128, AT_BUF = AT_KB + AT_VB;
static_assert(3 * AT_BUF <= RING_BYTES, "attention LDS");
__device__ __forceinline__ void q8_load(u32x4 (&q)[8], const void* p) {
    asm volatile("global_load_dwordx4 %0, %8, off\n\tglobal_load_dwordx4 %1, %8, off offset:32\n\tglobal_load_dwordx4 %2, %8, off offset:64\n\tglobal_load_dwordx4 %3, %8, off offset:96\n\t"
                 "global_load_dwordx4 %4, %8, off offset:128\n\tglobal_load_dwordx4 %5, %8, off offset:160\n\tglobal_load_dwordx4 %6, %8, off offset:192\n\tglobal_load_dwordx4 %7, %8, off offset:224"
                 : "=&v"(q[0]), "=&v"(q[1]), "=&v"(q[2]), "=&v"(q[3]), "=&v"(q[4]), "=&v"(q[5]), "=&v"(q[6]), "=&v"(q[7]) : "v"(p) : "memory"); }
__device__ __forceinline__ void q8_settle(u32x4 (&q)[8]) {
#pragma unroll
    for (int i = 0; i < 8; ++i) asm volatile("" : "+v"(q[i])); }
__device__ __forceinline__ unsigned u16_load(const void* p) { unsigned v; asm volatile("global_load_ushort %0, %1, off" : "=&v"(v) : "v"(p) : "memory"); return v; }
__device__ __forceinline__ void ph5_attn(ArgsP A, Frame& F) {
    unsigned char* ws = A->ws; const bf16_t* PROJ = (const bf16_t*)(ws + WS_PROJ); const bf16_t* VT = (const bf16_t*)(ws + WS_VT); const bf16_t* KBp = (const bf16_t*)(ws + WS_KB);
    bf16_t* PO = (bf16_t*)(ws + WS_PARTO); float* PML = (float*)(ws + WS_PARTML); const unsigned short* LST = (const unsigned short*)(ws + WS_LIST); const unsigned* UD = (const unsigned*)(ws + WS_UDESC);
    LAS unsigned char* L = F.lds + RING_OFF; const int wave = F.wave, lane = F.lane, r = lane & 31, hh = lane >> 5;
    const float NEG = -__builtin_inff();
    const int NA = MH * NBLK, N = NA + (int)UD[0], w = F.vcu, nfree = F.G - RH; const bool chainwg = w < RH;
    auto unit_of = [&](int k) { return k * nfree + (w - RH); };
    int k = 0;
    if (chainwg) return;
    if (unit_of(k) >= N) return;
    int h, kblk, qtok, slot; bool typeA, valid, wvalid;
    { const int u = unit_of(k); typeA = u < NA;
      if (typeA) { h = u & 15; kblk = u >> 4; qtok = kblk * MBLK + wave * 32 + r; slot = 3; valid = true; wvalid = true; }
      else { const unsigned d = UD[1 + 2 * (u - NA)]; const int cnt = (int)UD[2 + 2 * (u - NA)]; const int Lx = (int)(d & 0xffffu), ps = (int)(d >> 16); h = Lx >> 5; kblk = Lx & 31;
          const int idx = ps * 256 + wave * 32 + r; valid = idx < cnt; wvalid = ps * 256 + wave * 32 < cnt; unsigned e = u16_load(LST + (size_t)Lx * 8192 + (valid ? idx : 0));
          asm volatile("s_waitcnt vmcnt(0)" ::: "memory"); asm volatile("" : "+v"(e)); qtok = (int)(e & 0x1fffu); slot = (int)(e >> 13); }
      h = __builtin_amdgcn_readfirstlane(h); kblk = __builtin_amdgcn_readfirstlane(kblk); }
    u32x4 qf[8], qfn[8];
    q8_load(qf, PROJ + (size_t)qtok * PLD + PC_MQ + h * MD + 8 * hh);
    const int krow_ = lane >> 4, kslot = lane & 15, vrow_ = lane >> 3, vslot = lane & 7;
    auto dma_tile = [&](int hd, int kb_, int n, int b3) { const int tb = kb_ * MBLK + n * 64; LAS unsigned char* B = L + b3 * AT_BUF;
#pragma unroll
        for (int i = 0; i < 2; ++i) { const int p = wave * 2 + i, row = 4 * p + krow_, c = kslot ^ (row & 15);
            __builtin_amdgcn_global_load_lds((const unsigned*)(KBp + ((size_t)hd * T + tb + row) * MD + 8 * c), (LAS unsigned*)(B + p * 1024), 16, 0, 0); }
#pragma unroll
        for (int i = 0; i < 2; ++i) { const int p = wave * 2 + i, row = 8 * p + vrow_, c = vslot ^ ((row >> 1) & 7);
            __builtin_amdgcn_global_load_lds((const unsigned*)(VT + ((size_t)(hd * (T / 64) + kb_ * 4 + n) * MD + row) * 64 + 8 * c), (LAS unsigned*)(B + AT_KB + p * 1024), 16, 0, 0); } };
    dma_tile(h, kblk, 0, 0); dma_tile(h, kblk, 1, 1);
    asm volatile("s_waitcnt vmcnt(4)" ::: "memory"); q8_settle(qf); WG_BAR();
    int b3 = 0;
    for (;;) {
        const int un = unit_of(k + 1); const bool has_next = un < N, nA = un < NA;
        int hN = 0, kblkN = 0, qtokN = 0, slotN = 3, LxN = 0, idxN = 0, cntN = 0; bool validN = true, wvalidN = true; unsigned udw = 0u, udc = 0u, entN = 0u;
        f32x16 o[4];
#pragma unroll
        for (int db = 0; db < 4; ++db)
#pragma unroll
            for (int e = 0; e < 16; ++e) o[db][e] = 0.f;
        float mrun = NEG, lrun = 0.f;
#pragma unroll
        for (int n = 0; n < 4; ++n) {
            if (has_next) {
                if (n == 0) { if (nA) { hN = un & 15; kblkN = un >> 4; } else { udw = UD[1 + 2 * (un - NA)]; udc = UD[2 + 2 * (un - NA)]; } }
                if (n == 1) { if (nA) { qtokN = kblkN * MBLK + wave * 32 + r; } else { LxN = (int)(udw & 0xffffu); const int ps = (int)(udw >> 16); cntN = (int)udc; hN = LxN >> 5; kblkN = LxN & 31;
                                  idxN = ps * 256 + wave * 32 + r; validN = idxN < cntN; wvalidN = ps * 256 + wave * 32 < cntN; entN = u16_load(LST + (size_t)LxN * 8192 + (validN ? idxN : 0)); }
                              hN = __builtin_amdgcn_readfirstlane(hN); kblkN = __builtin_amdgcn_readfirstlane(kblkN); }
                if (n == 2) { if (!nA) { qtokN = (int)(entN & 0x1fffu); slotN = (int)(entN >> 13); }
                              q8_load(qfn, PROJ + (size_t)qtokN * PLD + PC_MQ + hN * MD + 8 * hh); }
            }
            const int bn = b3 >= 1 ? b3 - 1 : 2; bool issued = false;
            if (n < 2) { dma_tile(h, kblk, n + 2, bn); issued = true; } else if (has_next) { dma_tile(hN, kblkN, n - 2, bn); issued = true; }
            const bool need = typeA ? (n <= (wave >> 1)) : wvalid;
            if (need) {
                const LAS unsigned char* KB = L + b3 * AT_BUF; const LAS unsigned char* VB = KB + AT_KB;
                f32x16 s[2];
#pragma unroll
                for (int kb = 0; kb < 2; ++kb) {
#pragma unroll
                    for (int e = 0; e < 16; ++e) s[kb][e] = 0.f;
#pragma unroll
                    for (int ks = 0; ks < 8; ++ks) { const bf16x8 a = *(const LAS bf16x8*)(KB + (32 * kb + r) * 256 + (((2 * ks + hh) ^ (r & 15)) << 4)); s[kb] = __builtin_amdgcn_mfma_f32_32x32x16_bf16(a, __builtin_bit_cast(bf16x8, qf[ks]), s[kb], 0, 0, 0); } }
                if (typeA && 64 * n + 63 > wave * 32) { const int qrel = wave * 32 + r;
#pragma unroll
                    for (int kb = 0; kb < 2; ++kb)
#pragma unroll
                        for (int e = 0; e < 16; ++e) { const int krel = 64 * n + 32 * kb + (e & 3) + 8 * (e >> 2) + 4 * hh; if (krel > qrel) s[kb][e] = NEG; } }
                float mx = s[0][0];
#pragma unroll
                for (int kb = 0; kb < 2; ++kb)
#pragma unroll
                    for (int e = 0; e < 16; ++e) mx = fmaxf(mx, s[kb][e]);
                mx = fmaxf(mx, __shfl_xor(mx, 32));
                const float mnew = fmaxf(mrun, mx); const float alpha = __builtin_amdgcn_exp2f(mrun - mnew); mrun = mnew;
                float ps = 0.f;
#pragma unroll
                for (int kb = 0; kb < 2; ++kb)
#pragma unroll
                    for (int e = 0; e < 16; ++e) { const float p = __builtin_amdgcn_exp2f(s[kb][e] - mnew); s[kb][e] = p; ps += p; }
                lrun = lrun * alpha + ps;
                if (__ballot(alpha != 1.0f) != 0ull) {
#pragma unroll
                    for (int db = 0; db < 4; ++db)
#pragma unroll
                        for (int e = 0; e < 16; ++e) o[db][e] *= alpha; }
#pragma unroll
                for (int kb = 0; kb < 2; ++kb)
#pragma unroll
                    for (int st = 0; st < 2; ++st) { u32x4 pw; pw.x = pk2(s[kb][8 * st + 0], s[kb][8 * st + 1]); pw.y = pk2(s[kb][8 * st + 2], s[kb][8 * st + 3]); pw.z = pk2(s[kb][8 * st + 4], s[kb][8 * st + 5]); pw.w = pk2(s[kb][8 * st + 6], s[kb][8 * st + 7]);
                        const bf16x8 pf = __builtin_bit_cast(bf16x8, pw);
#pragma unroll
                        for (int db = 0; db < 4; ++db) { const bf16x8 vf = *(const LAS bf16x8*)(VB + (32 * db + r) * 128 + (((4 * kb + 2 * st + hh) ^ ((r >> 1) & 7)) << 4));
                            o[db] = __builtin_amdgcn_mfma_f32_32x32x16_bf16(vf, pf, o[db], 0, 0, 0); } }
            }
            if (issued) asm volatile("s_waitcnt vmcnt(4)" ::: "memory"); else asm volatile("s_waitcnt vmcnt(0)" ::: "memory");
            if (n == 1) asm volatile("" : "+v"(entN));
            if (n == 2) q8_settle(qfn);
            b3 = b3 == 2 ? 0 : b3 + 1;
            WG_BAR();
        }
        { const float ltot = lrun + __shfl_xor(lrun, 32);
          if (valid) { const float inv = 1.0f / ltot; const size_t pi = ((size_t)qtok * MH + h) * 4 + slot; bf16_t* op = PO + pi * MD;
#pragma unroll
            for (int db = 0; db < 4; ++db)
#pragma unroll
                for (int g = 0; g < 4; ++g) { u32x2 wv; wv.x = pk2(o[db][4 * g] * inv, o[db][4 * g + 1] * inv); wv.y = pk2(o[db][4 * g + 2] * inv, o[db][4 * g + 3] * inv); *(u32x2*)(op + 32 * db + 8 * g + 4 * hh) = wv; }
            if (hh == 0) *(f32x2*)(PML + pi * 2) = (f32x2){mrun, ltot}; } }
        if (!has_next) break;
        h = hN; kblk = kblkN; qtok = qtokN; slot = slotN; typeA = nA; valid = nA ? true : validN; wvalid = nA ? true : wvalidN; ++k;
#pragma unroll
        for (int ks = 0; ks < 8; ++ks) qf[ks] = qfn[ks];
    }
}
__device__ __forceinline__ void ph6_merge(ArgsP A, Frame& F) {
    unsigned char* ws = A->ws; const bf16_t* PO = (const bf16_t*)(ws + WS_PARTO); const float* PML = (const float*)(ws + WS_PARTML); bf16_t* YB = (bf16_t*)(ws + WS_YB);
    const int gw = F.vcu * NWAVES + F.wave, NGW = F.G * NWAVES, hl = F.lane >> 5, dg = F.lane & 31;
    for (int it0 = gw * 4; it0 < T * 8; it0 += NGW * 4) {
        u32x2 ov[4][4]; f32x2 ml[4][4];
#pragma unroll
        for (int k = 0; k < 4; ++k) { const int it = it0 + k, t = it >> 3, h = 2 * (it & 7) + hl; const size_t pi = ((size_t)t * MH + h) * 4;
#pragma unroll
            for (int sl = 0; sl < 4; ++sl) { ov[k][sl] = *(const u32x2*)(PO + (pi + sl) * MD + 4 * dg); ml[k][sl] = *(const f32x2*)(PML + (pi + sl) * 2); } }
#pragma unroll
        for (int k = 0; k < 4; ++k) { const int it = it0 + k, t = it >> 3, h = 2 * (it & 7) + hl, blk = t >> 8, nsel = blk < 3 ? blk : 3;
            float mmax = ml[k][3][0];
#pragma unroll
            for (int sl = 0; sl < 3; ++sl) if (sl < nsel) mmax = fmaxf(mmax, ml[k][sl][0]);
            f32x4 acc = (f32x4){0.f, 0.f, 0.f, 0.f}; float wsum = 0.f;
#pragma unroll
            for (int sl = 0; sl < 4; ++sl) { if (sl == 3 || sl < nsel) { const float w = ml[k][sl][1] * __builtin_amdgcn_exp2f(ml[k][sl][0] - mmax); wsum += w;
                acc += w * (f32x4){bflo(ov[k][sl].x), bfhi(ov[k][sl].x), bflo(ov[k][sl].y), bfhi(ov[k][sl].y)}; } }
            const float inv = 1.0f / wsum; st4bf(YB + (size_t)t * RW + h * MD + 4 * dg, acc * inv); }
    }
}

__device__ __forceinline__ void ins16(float (&top)[16], float x) {
#pragma unroll
    for (int k = 15; k >= 1; --k) top[k] = __builtin_amdgcn_fmed3f(top[k - 1], top[k], x);
    top[0] = fmaxf(top[0], x);
}
__device__ __forceinline__ void ph10_select(ArgsP A, Frame& F) {
    unsigned char* ws = A->ws; const bf16_t* PQ = (const bf16_t*)(ws + WS_PQ); const bf16_t* SK = (const bf16_t*)(ws + WS_SUBK); int* IDX = (int*)(ws + WS_IDX); float* GW = (float*)(ws + WS_GW);
    const int gw = F.vcu * NWAVES + F.wave, NGW = F.G * NWAVES; const int r = F.lane & 31, hh = F.lane >> 5; const float NEG = -__builtin_inff();
    for (int it = gw; it < (T / 32) * PH_; it += NGW) { const int tg = it >> 3, h = it & 7, t = tg * 32 + r;
        float TA[16], TB[16];
        auto topk = [&](int p, float (&dst)[16]) {
            bf16x8 qf[8];
#pragma unroll
            for (int ks = 0; ks < 8; ++ks) qf[ks] = *(const bf16x8*)(PQ + (size_t)t * 2048 + (h * 2 + p) * PHALF + 16 * ks + 8 * hh);
            float top[16];
#pragma unroll
            for (int k = 0; k < 16; ++k) top[k] = NEG;
#pragma unroll 1
            for (int nb = 0; nb < 4; ++nb) { f32x16 acc;
#pragma unroll
                for (int e = 0; e < 16; ++e) acc[e] = 0.f;
#pragma unroll
                for (int ks = 0; ks < 8; ++ks) { const bf16x8 a = *(const bf16x8*)(SK + ((size_t)(h * 2 + p) * PNK + 32 * nb + r) * PHALF + 16 * ks + 8 * hh); acc = __builtin_amdgcn_mfma_f32_32x32x16_bf16(a, qf[ks], acc, 0, 0, 0); }
#pragma unroll
                for (int e = 0; e < 16; ++e) { const unsigned key = 32 * nb + (e & 3) + 8 * (e >> 2) + 4 * hh; float ae = acc[e]; asm volatile("" : "+v"(ae));
                    const float x = __builtin_bit_cast(float, (__builtin_bit_cast(unsigned, ae) & ~0x7Fu) | key); ins16(top, x); } }
            float oth[16];
#pragma unroll
            for (int k = 0; k < 16; ++k) oth[k] = __shfl_xor(top[k], 32);
#pragma unroll
            for (int k = 0; k < 16; ++k) ins16(top, oth[k]);
#pragma unroll
            for (int k = 0; k < 16; ++k) dst[k] = top[k];
        };
        topk(0, TA); asm volatile("" ::: "memory"); __builtin_amdgcn_sched_barrier(0); topk(1, TB); asm volatile("" ::: "memory"); __builtin_amdgcn_sched_barrier(0);
        float fin[16];
#pragma unroll
        for (int k = 0; k < 16; ++k) fin[k] = NEG;
#pragma unroll
        for (int i = 0; i < 16; ++i)
#pragma unroll
            for (int j = 0; j < 16; ++j) if ((i + 1) * (j + 1) <= 16) { const float sm = TA[i] + TB[j]; ins16(fin, __builtin_bit_cast(float, (__builtin_bit_cast(unsigned, sm) & ~0xFFu) | (unsigned)(i * 16 + j))); }
        float e[16], den = 0.f;
#pragma unroll
        for (int k = 0; k < 16; ++k) { e[k] = __expf(fin[k] - fin[0]); den += e[k]; }
        const float rden = 1.0f / den;
        int oi[8]; float og[8];
#pragma unroll
        for (int kk = 0; kk < 8; ++kk) { const float fv = hh ? fin[8 + kk] : fin[kk]; og[kk] = (hh ? e[8 + kk] : e[kk]) * rden; const unsigned id = __builtin_bit_cast(unsigned, fv) & 0xFFu; const unsigned ci = id >> 4, cj = id & 15u;
            unsigned ia = 0u, ib = 0u;
#pragma unroll
            for (int q = 0; q < 16; ++q) { ia = (ci == (unsigned)q) ? (__builtin_bit_cast(unsigned, TA[q]) & 0x7Fu) : ia; ib = (cj == (unsigned)q) ? (__builtin_bit_cast(unsigned, TB[q]) & 0x7Fu) : ib; }
            oi[kk] = (int)(ia * PNK + ib); }
        int* ip = IDX + (size_t)t * 128 + h * 16 + 8 * hh; float* gp = GW + (size_t)t * 128 + h * 16 + 8 * hh;
        *(u32x4*)ip = (u32x4){(unsigned)oi[0], (unsigned)oi[1], (unsigned)oi[2], (unsigned)oi[3]}; *(u32x4*)(ip + 4) = (u32x4){(unsigned)oi[4], (unsigned)oi[5], (unsigned)oi[6], (unsigned)oi[7]};
        *(f32x4*)gp = (f32x4){og[0], og[1], og[2], og[3]}; *(f32x4*)(gp + 4) = (f32x4){og[4], og[5], og[6], og[7]};
    }
}


__device__ __forceinline__ float ub0(unsigned w) { return (float)(w & 0xffu); }
__device__ __forceinline__ float ub1(unsigned w) { return (float)((w >> 8) & 0xffu); }
__device__ __forceinline__ float ub2(unsigned w) { return (float)((w >> 16) & 0xffu); }
__device__ __forceinline__ float ub3(unsigned w) { return (float)(w >> 24); }
__device__ __forceinline__ float dot16q(u32x4 q, const float (&h)[16]) {
    return ((ub0(q.x) * h[0] + ub1(q.x) * h[1]) + (ub2(q.x) * h[2] + ub3(q.x) * h[3])) + ((ub0(q.y) * h[4] + ub1(q.y) * h[5]) + (ub2(q.y) * h[6] + ub3(q.y) * h[7]))
         + ((ub0(q.z) * h[8] + ub1(q.z) * h[9]) + (ub2(q.z) * h[10] + ub3(q.z) * h[11])) + ((ub0(q.w) * h[12] + ub1(q.w) * h[13]) + (ub2(q.w) * h[14] + ub3(q.w) * h[15]));
}
__device__ __forceinline__ void ph11_gather(ArgsP A, Frame& F) {
    unsigned char* ws = A->ws; const bf16_t* H2 = (const bf16_t*)(ws + WS_H2); const unsigned char* PU = (const unsigned char*)(ws + WS_PU); const unsigned char* PV = (const unsigned char*)(ws + WS_PV);
    const float* PSU = (const float*)(ws + WS_PSU); const float* PSV = (const float*)(ws + WS_PSV);
    const int* IDX = (const int*)(ws + WS_IDX); const float* GW = (const float*)(ws + WS_GW); const float* X1 = (const float*)(ws + WS_X1);
    LAS float* coef = (LAS float*)(F.lds + RING_OFF); LAS int* eidx = (LAS int*)(F.lds + RING_OFF + 1024); LAS float* red = (LAS float*)(F.lds + RING_OFF + 2048);
    const int tid = F.tid, wave = F.wave, lane = F.lane; int par = 0;
    for (int t = F.vcu; t < T; t += F.G, par ^= 1) {
        float hv[4][16]; float hs = 0.f;
#pragma unroll
        for (int i = 0; i < 4; ++i) { const bf16_t* hp = H2 + (size_t)t * D + i * 1024 + lane * 16; f32x4 a, b, c, d; pg8::unpack8(*(const u32x4*)hp, a, b); pg8::unpack8(*(const u32x4*)(hp + 8), c, d);
#pragma unroll
            for (int e = 0; e < 4; ++e) { hv[i][e] = a[e]; hv[i][4 + e] = b[e]; hv[i][8 + e] = c[e]; hv[i][12 + e] = d[e]; }
            hs += ((a[0] + a[1]) + (a[2] + a[3])) + ((b[0] + b[1]) + (b[2] + b[3])) + ((c[0] + c[1]) + (c[2] + c[3])) + ((d[0] + d[1]) + (d[2] + d[3])); }
        hs = wave_sum(hs);
        const int myidx = (lane < 16) ? IDX[(size_t)t * 128 + wave * 16 + lane] : 0; const float myg = (lane < 16) ? GW[(size_t)t * 128 + wave * 16 + lane] : 0.f;
        float dots = 0.f;
#pragma unroll 1
        for (int k = 0; k < 16; k += 4) {
            u32x4 q[4][4];
#pragma unroll
            for (int x = 0; x < 4; ++x) { const int e = __builtin_amdgcn_readlane(myidx, k + x); const unsigned char* up = PU + (size_t)e * D + lane * 16;
#pragma unroll
                for (int i = 0; i < 4; ++i) q[x][i] = *(const u32x4*)(up + i * 1024); }
#pragma unroll
            for (int x = 0; x < 4; ++x) { float d = 0.f;
#pragma unroll
                for (int i = 0; i < 4; ++i) d += dot16q(q[x][i], hv[i]);
                d = wave_sum(d); if (lane == k + x) dots = d; }
        }
        if (lane < 16) { const float s = PSU[myidx] * (dots - 128.0f * hs); const float act = 0.5f * s * (1.0f + erff(s * 0.70710678118654752f));
            coef[par * 128 + wave * 16 + lane] = myg * act * PSV[myidx]; eidx[par * 128 + wave * 16 + lane] = myidx; }
        WG_BAR();
        float acc[8]; float csum = 0.f;
#pragma unroll
        for (int i = 0; i < 8; ++i) acc[i] = 0.f;
#pragma unroll 1
        for (int e = 0; e < 128; e += 16) { u32x2 v[16]; float c[16];
#pragma unroll
            for (int q = 0; q < 16; ++q) { const int ei = __builtin_amdgcn_readfirstlane(eidx[par * 128 + e + q]); c[q] = coef[par * 128 + e + q]; v[q] = *(const u32x2*)(PV + (size_t)ei * D + tid * 8); }
#pragma unroll
            for (int q = 0; q < 16; ++q) { csum += c[q]; acc[0] += c[q] * ub0(v[q].x); acc[1] += c[q] * ub1(v[q].x); acc[2] += c[q] * ub2(v[q].x); acc[3] += c[q] * ub3(v[q].x); acc[4] += c[q] * ub0(v[q].y); acc[5] += c[q] * ub1(v[q].y); acc[6] += c[q] * ub2(v[q].y); acc[7] += c[q] * ub3(v[q].y); } }
        const float corr = -128.0f * csum;
        const f32x4 x0 = *(const f32x4*)(X1 + (size_t)t * D + tid * 8), x1 = *(const f32x4*)(X1 + (size_t)t * D + tid * 8 + 4);
        f32x4 y0 = x0 + ((f32x4){acc[0], acc[1], acc[2], acc[3]} + corr), y1 = x1 + ((f32x4){acc[4], acc[5], acc[6], acc[7]} + corr);
        float ss = (y0[0] * y0[0] + y0[1] * y0[1]) + (y0[2] * y0[2] + y0[3] * y0[3]) + (y1[0] * y1[0] + y1[1] * y1[1]) + (y1[2] * y1[2] + y1[3] * y1[3]);
        ss = wave_sum(ss); if (lane == 0) red[par * 8 + wave] = ss;
        WG_BAR();
        float tot = 0.f;
#pragma unroll
        for (int w = 0; w < 8; ++w) tot += red[par * 8 + w];
        const float rs = 1.0f / sqrtf(tot * (1.0f / D) + NORM_EPS);
        const f32x4 g0 = *(const f32x4*)(A->final_g + tid * 8), g1 = *(const f32x4*)(A->final_g + tid * 8 + 4);
        *(f32x4*)(A->out + (size_t)t * D + tid * 8) = y0 * rs * g0; *(f32x4*)(A->out + (size_t)t * D + tid * 8 + 4) = y1 * rs * g1;
    }
}

constexpr int NPH = 13;
__device__ __forceinline__ Frame make_frame(unsigned char* lds) {
    Frame F; int t = threadIdx.x; asm volatile("" : "+v"(t));
    F.lds = (LAS unsigned char*)lds; F.tid = t; F.lane = t & 63; F.wave = __builtin_amdgcn_readfirstlane(t >> 6);
    F.G = gridDim.x; { const int bx = blockIdx.x; F.vcu = (F.G % 8 == 0) ? (bx % 8) * (F.G / 8) + bx / 8 : bx; }
    return F;
}
__global__ void __launch_bounds__(NTHR, 2) mk_fwd(Args args_by_value) {
    extern __shared__ __attribute__((aligned(16))) unsigned char lds[];
    ArgsP args = get_args();
    gu32* ctl = (gu32*)(args->ws + WS_CTL);
    for (int u = threadIdx.x; u < (LDS_BYTES - LDSCTL_OFF) / 4; u += NTHR) ((LAS unsigned*)((LAS unsigned char*)lds + LDSCTL_OFF))[u] = 0u;
    __syncthreads();
    const int lo = args->ph_lo, hi = args->ph_hi;
    volatile LAS unsigned* MISC = (volatile LAS unsigned*)((LAS unsigned char*)lds + MISC_OFF);
    XcdBarrier bar; bar.bar = (unsigned*)(ctl + CW_BAR) + args->li * XCD_BAR_WORDS; bar.x = 0; bar.st = nullptr;
    if (hi - lo > 1) bar = xcd_barrier_post((unsigned*)(ctl + CW_BAR) + args->li * XCD_BAR_WORDS, MISC + 8);
#define IN(k) (lo <= (k) && (k) < hi)
#define SEAM(k) do { if (IN(k) && IN((k) + 1)) xcd_barrier(bar); } while (0)
    const int bid = (int)blockIdx.x;

    if (IN(0)) { Frame F = make_frame(lds); ph0_prologue(get_args(), F); SEAM(0); }
    if (IN(1)) { Frame F = make_frame(lds); LAS unsigned char* ring = F.lds + RING_OFF; ArgsP a_ = get_args(); unsigned char* ws = a_->ws;
        { pg8::Gemm g{(const bf16_t*)(ws + WS_XN), (const bf16_t*)(ws + WS_WIN), T, PLD, D}; pg8::StaticOrder S; S.init(T, PLD, F.G, bid);
          pg8::EpiProj E{(bf16_t*)(ws + WS_PROJ), (const float*)(ws + WS_ROPE), (bf16_t*)(ws + WS_KB)}; pg8::gemm_phase<pg8::EpiProj, pg8::StaticOrder, true, true>(ring, g, S, E); }
        { pg8::Gemm g{(const bf16_t*)(ws + WS_XN), (const bf16_t*)(ws + WS_WIN) + (size_t)PC_MV * D, T, 2048, D}; pg8::StaticOrder S; S.init(T, 2048, F.G, bid);
          pg8::EpiVT E{(bf16_t*)(ws + WS_VT)}; pg8::gemm_phase<pg8::EpiVT, pg8::StaticOrder, true, true>(ring, g, S, E); }
        { constexpr int NT1 = (T / 256) * (PLD / 256); const int nx = NT1 % F.G;
          if (bid >= nx) { WG_BAR(); Frame F2 = make_frame(lds); late_weights(get_args(), F2, (bid - nx) * NWAVES + F2.wave, (F2.G - nx) * NWAVES); } }
        SEAM(1); }
    if (IN(2)) { Frame F = make_frame(lds); ph2_prep(get_args(), F); SEAM(2); }
    if (IN(3)) { Frame F = make_frame(lds); LAS unsigned char* ring = F.lds + RING_OFF; ArgsP a_ = get_args(); unsigned char* ws = a_->ws;
        { pg8::Gemm g{(const bf16_t*)(ws + WS_AW), (const bf16_t*)(ws + WS_WUP), T, RW, LW}; pg8::StaticOrder S; S.init(T, RW, F.G, bid);
          pg8::EpiDec E{(float*)(ws + WS_DEC), a_->w0}; pg8::gemm_phase<pg8::EpiDec, pg8::StaticOrder, true, true>(ring, g, S, E); }
        asm volatile("" ::: "memory"); __builtin_amdgcn_sched_barrier(0);
        { pg8::Gemm g{(const bf16_t*)(ws + WS_AA), (const bf16_t*)(ws + WS_AUP), T, RW, LA}; pg8::StaticOrder S; S.init(T, RW, F.G, bid);
          pg8::EpiA E{(bf16_t*)(ws + WS_KP), (bf16_t*)(ws + WS_BB), (const bf16_t*)(ws + WS_KKN), a_->a0, a_->k_a}; pg8::gemm_phase<pg8::EpiA, pg8::StaticOrder, true, true>(ring, g, S, E); }
        asm volatile("" ::: "memory"); __builtin_amdgcn_sched_barrier(0);
        { pg8::Gemm g{(const bf16_t*)(ws + WS_AG), (const bf16_t*)(ws + WS_GUP), T, RW, LGP}; pg8::StaticOrder S; S.init(T, RW, F.G, bid);
          pg8::EpiBf16 E{(bf16_t*)(ws + WS_G), RW}; pg8::gemm_phase<pg8::EpiBf16, pg8::StaticOrder, true, true>(ring, g, S, E); }
        { Frame F2 = make_frame(lds); ph3_gate(get_args(), F2); }
        SEAM(3); }
    if (IN(4)) { Frame F = make_frame(lds); ph4_chunkprep(get_args(), F); SEAM(4); }
    if (IN(5)) {
        { Frame F = make_frame(lds); if (F.vcu < RH) ph5_chain(get_args(), F, F.vcu); }
        { Frame F = make_frame(lds); ph5_attn(get_args(), F); }
        SEAM(5); }
    if (IN(6)) { { Frame F = make_frame(lds); ph6_merge(get_args(), F); } { Frame F = make_frame(lds); ph5_ypost(get_args(), F); } SEAM(6); }
    if (IN(7)) { Frame F = make_frame(lds); LAS unsigned char* ring = F.lds + RING_OFF; ArgsP a_ = get_args(); unsigned char* ws = a_->ws;
        { pg8::Gemm g{(const bf16_t*)(ws + WS_YA), (const bf16_t*)(ws + WS_WA), T, D, RW}; pg8::StaticOrder S; S.init(T, D, F.G, bid);
          pg8::EpiMix<false> E{(bf16_t*)(ws + WS_MIXED), (const bf16_t*)(ws + WS_PROJ), PC_GA}; pg8::gemm_phase<pg8::EpiMix<false>, pg8::StaticOrder, true, true>(ring, g, S, E); }
        { pg8::Gemm g{(const bf16_t*)(ws + WS_YB), (const bf16_t*)(ws + WS_WB), T, D, RW}; pg8::StaticOrder S; S.init(T, D, F.G, bid);
          pg8::EpiMix<true> E{(bf16_t*)(ws + WS_MIXED), (const bf16_t*)(ws + WS_PROJ), PC_GB}; pg8::gemm_phase<pg8::EpiMix<true>, pg8::StaticOrder, true, true>(ring, g, S, E); }
        SEAM(7); }
    if (IN(8)) { Frame F = make_frame(lds); LAS unsigned char* ring = F.lds + RING_OFF; ArgsP a_ = get_args(); unsigned char* ws = a_->ws;
        pg8::Gemm g{(const bf16_t*)(ws + WS_MIXED), (const bf16_t*)(ws + WS_WOUT), T, D, D}; pg8::StaticOrder S; S.init(T, D, F.G, bid);
        pg8::EpiRes E{(float*)(ws + WS_X1), a_->x}; pg8::gemm_phase<pg8::EpiRes, pg8::StaticOrder, true, true>(ring, g, S, E);
        SEAM(8); }
    if (IN(9)) { Frame F = make_frame(lds); ArgsP a_ = get_args(); unsigned char* ws = a_->ws; const int gw = F.vcu * NWAVES + F.wave, NGW = F.G * NWAVES;
        rms_rows_to_bf16((const float*)(ws + WS_X1), a_->norm2_g, (bf16_t*)(ws + WS_H2), gw, NGW, F.lane);
        SEAM(9); }
    if (IN(10)) { Frame F = make_frame(lds); LAS unsigned char* ring = F.lds + RING_OFF; ArgsP a_ = get_args(); unsigned char* ws = a_->ws;
        pg8::Gemm g{(const bf16_t*)(ws + WS_H2), (const bf16_t*)(ws + WS_WQ), T, 2048, D}; pg8::StaticOrder S; S.init(T, 2048, F.G, bid);
        pg8::EpiBf16 E{(bf16_t*)(ws + WS_PQ), 2048}; pg8::gemm_phase<pg8::EpiBf16, pg8::StaticOrder, true, true>(ring, g, S, E);
        SEAM(10); }
    if (IN(11)) { Frame F = make_frame(lds); ph10_select(get_args(), F); SEAM(11); }
    if (IN(12)) { Frame F = make_frame(lds); ph11_gather(get_args(), F); }
#undef IN
#undef SEAM
}

extern "C" void kernel_launch(void* const* d_in, const int* in_sizes, int n_in, void* d_out, int out_size, void* d_ws, size_t ws_size, hipStream_t stream) {
    static int grid = 0;
    if (grid == 0) {
        if (n_in != 23 || out_size != T * D || ws_size < WS_END) { fprintf(stderr, "kernel_launch: unexpected shapes (n_in %d out %d ws %zu); nothing launched\n", n_in, out_size, ws_size); grid = -1; return; }
        int dev = 0, cus = 0, per_cu = 0;
        if (hipGetDevice(&dev) != hipSuccess || hipDeviceGetAttribute(&cus, hipDeviceAttributeMultiprocessorCount, dev) != hipSuccess) { grid = -1; return; }
        if (hipFuncSetAttribute((const void*)mk_fwd, hipFuncAttributeMaxDynamicSharedMemorySize, LDS_BYTES) != hipSuccess) { grid = -1; return; }
        if (hipOccupancyMaxActiveBlocksPerMultiprocessor(&per_cu, (const void*)mk_fwd, NTHR, LDS_BYTES) != hipSuccess || per_cu < 1) fprintf(stderr, "kernel_launch: occupancy query reports %d\n", per_cu);
        (void)hipGetLastError();
        grid = cus;
    }
    if (grid < 0) return;
    (void)hipMemsetAsync((char*)d_ws + WS_CTL, 0, CTL_ZERO_BYTES, stream);
    Args a{};
    const float** ap = (const float**)&a;
    for (int i = 0; i < 23; ++i) ap[i] = (const float*)d_in[i];
    a.out = (float*)d_out; a.ws = (unsigned char*)d_ws; a.pad = 0;
    constexpr int NL = MK_N_LAUNCHES;
    for (int li = 0; li < NL; ++li) {
        a.ph_lo = (NL == 1) ? 0 : li; a.ph_hi = (NL == 1) ? NPH : li + 1; a.li = (NL == 1) ? 0 : 0;
        hipLaunchKernelGGL(mk_fwd, dim3(grid), dim3(NTHR), LDS_BYTES, stream, a);
#ifdef DUP_HI
        if (NL > 1 && li == DUP_HI) for (int l2 = DUP_LO; l2 <= DUP_HI; ++l2) { a.ph_lo = l2; a.ph_hi = l2 + 1; hipLaunchKernelGGL(mk_fwd, dim3(grid), dim3(NTHR), LDS_BYTES, stream, a); }
#endif
    }
}
```

```cpp
#include <hip/hip_runtime.h>
#include <cstdio>
#include <cstdint>

#ifndef MK_N_LAUNCHES
#define MK_N_LAUNCHES 1
#endif

#define GAS __attribute__((address_space(1)))
#define LAS __attribute__((address_space(3)))
typedef unsigned short bf16_t;
typedef __bf16 bf16x8 __attribute__((ext_vector_type(8)));
typedef float f32x2 __attribute__((ext_vector_type(2)));
typedef float f32x4 __attribute__((ext_vector_type(4)));
typedef float f32x16 __attribute__((ext_vector_type(16)));
typedef unsigned u32x2 __attribute__((ext_vector_type(2)));
typedef unsigned u32x4 __attribute__((ext_vector_type(4)));
typedef GAS unsigned gu32;

constexpr int T = 8192, D = 4096;
constexpr int RW = 2048, RH = 32, RN = 64;
constexpr int LW = 128, LA = 128, LG = 480, LGP = 512;
constexpr int SHIFTW = 6880;
constexpr int MH = 16, MD = 128, MBLK = 256, NBLK = 32;
constexpr int INW = 21216;
constexpr int PLD = 19200;
constexpr int PC_R = 0, PC_K = 2048, PC_V = 4096, PC_WL = 6144, PC_AL = 6272, PC_GL = 6400, PC_MQ = 6912, PC_MK = 8960, PC_GA = 11008, PC_GB = 15104, PC_MV = 19200;
constexpr int WIN_ROWS = 21248;
constexpr int PQ_SPLIT = 16384;
constexpr int PH_ = 8, PNK = 128, PQD = 256, PHALF = 128, PTOPK = 16;
constexpr float NORM_EPS = 1e-6f, LNX_EPS = 64e-5f;
constexpr float QSCALE = 0.08838834764831845f * 1.4426950408889634f;

constexpr size_t MiB = 1u << 20;
constexpr size_t WS_CTL = 0, CTL_ZERO_BYTES = 1 * MiB;
constexpr size_t WS_WIN = 1 * MiB;
constexpr size_t WS_X1 = 1 * MiB, WS_PQ = 129 * MiB;
constexpr size_t WS_WA = 167 * MiB, WS_WB = 183 * MiB, WS_WOUT = 199 * MiB, WS_WQ = 231 * MiB, WS_WUP = 247 * MiB, WS_AUP = 248 * MiB, WS_GUP = 249 * MiB, WS_SUBK = 251 * MiB;
constexpr size_t WS_PU = 252 * MiB, WS_PV = 380 * MiB;
constexpr size_t WS_XN = 508 * MiB;
constexpr size_t WS_Y = 508 * MiB, WS_H2 = 508 * MiB;
constexpr size_t WS_PROJ = 572 * MiB;
constexpr size_t WS_VT = 872 * MiB;
constexpr size_t WS_ROPE = 904 * MiB, WS_KMEAN = 908 * MiB, WS_MASK = 909 * MiB, WS_AW = 910 * MiB, WS_AA = 912 * MiB, WS_AG = 914 * MiB;
constexpr size_t WS_PSU = 909 * MiB + 512 * 1024, WS_PSV = WS_PSU + 64 * 1024;
constexpr size_t WS_DEC = 922 * MiB;
constexpr size_t WS_MIXED = 922 * MiB;
constexpr size_t WS_KKN = 986 * MiB, WS_BB = 1018 * MiB, WS_KP = 1050 * MiB, WS_ZR = 1082 * MiB, WS_ZV = 1114 * MiB, WS_G = 1146 * MiB;
constexpr size_t WS_YA = 1178 * MiB, WS_YB = 1210 * MiB, WS_IDX = 1242 * MiB, WS_GW = 1246 * MiB, WS_PARTML = 1250 * MiB, WS_LIST = 1254 * MiB, WS_UDESC = 1262 * MiB, WS_KB = 1267 * MiB, WS_END = 1299 * MiB;
constexpr size_t WS_PARTO = 922 * MiB;

constexpr int CW_TMO = 0, CW_CODE = 1, CW_ATTNQ = 64, CW_CNT = 1024, CW_BAR = 4096;

constexpr int RING_OFF = 0, RING_BYTES = 155648;
constexpr int LDSCTL_OFF = RING_BYTES, MISC_OFF = LDSCTL_OFF + 320;
constexpr int LDS_BYTES = 163840;
constexpr int NWAVES = 8, NTHR = 512;

__device__ __forceinline__ unsigned f2bf(float f) { unsigned u = __builtin_bit_cast(unsigned, f); return (u + 0x7fffu + ((u >> 16) & 1u)) >> 16; }
typedef __bf16 bf16x2 __attribute__((ext_vector_type(2)));
__device__ __forceinline__ unsigned pk2(float lo, float hi) { const f32x2 v = {lo, hi}; return __builtin_bit_cast(unsigned, __builtin_convertvector(v, bf16x2)); }
__device__ __forceinline__ float bflo(unsigned u) { return __builtin_bit_cast(float, u << 16); }
__device__ __forceinline__ float bfhi(unsigned u) { return __builtin_bit_cast(float, u & 0xffff0000u); }
__device__ __forceinline__ float bf1(bf16_t b) { return __builtin_bit_cast(float, (unsigned)b << 16); }
__device__ __forceinline__ float fsigmoid(float x) { return __builtin_amdgcn_rcpf(1.0f + __expf(-x)); }
__device__ __forceinline__ float wave_sum(float v) {
#pragma unroll
    for (int o = 1; o < 64; o <<= 1) v += __shfl_xor(v, o);
    return v;
}
template <int CTRL> __device__ __forceinline__ float dpp_f(float v) { return __builtin_bit_cast(float, __builtin_amdgcn_update_dpp(0, __builtin_bit_cast(int, v), CTRL, 0xF, 0xF, true)); }
__device__ __forceinline__ float sum16(float x) {
    x += dpp_f<0xB1>(x); x += dpp_f<0x4E>(x); x += dpp_f<0x141>(x); x += dpp_f<0x140>(x); return x;
}
__device__ __forceinline__ float vmul(float a, float b) { float r; asm("v_mul_f32_e32 %0, %1, %2" : "=v"(r) : "v"(a), "v"(b)); return r; }
__device__ __forceinline__ float vfma(float a, float b, float c) { float r; asm("v_fma_f32 %0, %1, %2, %3" : "=v"(r) : "v"(a), "v"(b), "v"(c)); return r; }
#define LDS_WAIT() asm volatile("s_waitcnt lgkmcnt(0)" ::: "memory")
#define VM_WAIT() asm volatile("s_waitcnt vmcnt(0)" ::: "memory")
#define WG_BAR() do { asm volatile("s_waitcnt lgkmcnt(0)" ::: "memory"); __builtin_amdgcn_s_barrier(); asm volatile("" ::: "memory"); } while (0)

namespace pg8 {
constexpr int BM = 256, BK = 64, HALF = 128, HTB = HALF * BK * 2, STAGE_BYTES = 8 * HTB, NXCD = 8, WGM = 8;
__host__ __device__ __forceinline__ int lds_byte(int r, int c) { const int st = (r >> 4) * 2 + (c >> 5), rr = r & 15, cc = c & 31, ob = rr * 64 + cc * 2; return st * 1024 + (ob ^ (((ob >> 9) & 1) << 5)); }
__host__ __device__ __forceinline__ void stage_rc(int b, int& R, int& C) { const int st = b / 1024, sb = b % 1024, swz = sb ^ (((sb >> 9) & 1) << 5); R = (st >> 1) * 16 + swz / 64; C = (st & 1) * 32 + (swz % 64) / 2; }
__host__ __device__ __forceinline__ int perm32(int rho) { const int n = rho >> 4, i = rho & 15; return 8 * (i >> 2) + 4 * n + (i & 3); }

struct Unit { int pm, pn; };
struct Gemm { const bf16_t* A; const bf16_t* Bt; int M, N, K; };

struct StaticOrder {
    int nM, nN, nwg, G, c;
    __host__ __device__ void init(int M, int N, int G_, int c_) { nM = M / BM; nN = N / BM; nwg = nM * nN; G = G_; c = c_; }
    __host__ __device__ bool next(int i, Unit& u) const {
        const long L = (long)i * G + c; if (L >= nwg) return false;
        int wgid = (int)L; { const int q = nwg / NXCD, r = nwg % NXCD, xcd = wgid % NXCD, off = wgid / NXCD; wgid = (xcd < r ? xcd * (q + 1) : r * (q + 1) + (xcd - r) * q) + off; }
        const int nig = WGM * nN, gid = wgid / nig, fm = gid * WGM, gsz = (nM - fm) < WGM ? (nM - fm) : WGM;
        u.pm = fm + ((wgid % nig) % gsz); u.pn = (wgid % nig) / gsz; return true;
    }
    __device__ __forceinline__ void a_ready(const Unit&) const {}
    __device__ __forceinline__ void done(const Unit&) const {}
};

template <class Epi, class Sched, bool ALIGN_EPI = false, bool SP2 = false>
__device__ __forceinline__ void gemm_phase(LAS unsigned char* lds, const Gemm g, const Sched& S, const Epi& E) {
    int tid_ = threadIdx.x; asm volatile("" : "+v"(tid_));
    const int tid = tid_, wid = __builtin_amdgcn_readfirstlane(tid >> 6), lane = tid & 63, wr = wid >> 2, wc = wid & 3, fr = lane & 15, fq = lane >> 4;
    int K_ = g.K; asm volatile("" : "+s"(K_));
    const int K = K_, nt = K / BK;
    unsigned voffA[2], voffB[2];
#pragma unroll
    for (int i = 0; i < 2; ++i) { int R, C; stage_rc(tid * 16 + i * 8192, R, C); const int Rb = Epi::PERM ? ((R & ~31) + perm32(R & 31)) : R;
        voffA[i] = (unsigned)(R * K + C) * 2u; voffB[i] = (unsigned)(Rb * K + C) * 2u; }
    const size_t kstep = (size_t)(BK * 2);
    const size_t hstep = (size_t)HALF * K * 2;
    const size_t tstep = 2 * hstep;
    const unsigned ldsw = (unsigned)wid * 1024u;
    const int aoff = lds_byte(wr * 64 + fr, fq * 8), boff = lds_byte(wc * 32 + fr, fq * 8);
#define PG8_SA(b, h) (((b) * 2 + (h)) * HTB)
#define PG8_SB(b, h) ((4 + (b) * 2 + (h)) * HTB)
#define PG8_STAGE(bufoff, gbase, voff) do { _Pragma("unroll") for (int _i = 0; _i < 2; ++_i) \
        __builtin_amdgcn_global_load_lds((const unsigned*)((const char*)(gbase) + (voff)[_i]), (LAS unsigned*)(lds + (bufoff) + ldsw + _i * 8192), 16, 0, 0); } while (0)
#define PG8_LDA(dst, b, h) do { _Pragma("unroll") for (int m = 0; m < 4; ++m) _Pragma("unroll") for (int k = 0; k < 2; ++k) dst[m][k] = *(const LAS bf16x8*)(lds + PG8_SA(b, h) + aoff + m * 2048 + k * 1024); } while (0)
#define PG8_LDB(dst, b, h) do { _Pragma("unroll") for (int n = 0; n < 2; ++n) _Pragma("unroll") for (int k = 0; k < 2; ++k) dst[n][k] = *(const LAS bf16x8*)(lds + PG8_SB(b, h) + boff + n * 2048 + k * 1024); } while (0)
#define PG8_MMA(ai, bj, At, Bt) do { __builtin_amdgcn_s_setprio(1); _Pragma("unroll") for (int m = 0; m < 4; ++m) _Pragma("unroll") for (int n = 0; n < 2; ++n) _Pragma("unroll") for (int k = 0; k < 2; ++k) { \
        if constexpr (Epi::SWAP) acc[ai][bj][m][n] = __builtin_amdgcn_mfma_f32_16x16x32_bf16(At[m][k], Bt[n][k], acc[ai][bj][m][n], 0, 0, 0); \
        else acc[ai][bj][m][n] = __builtin_amdgcn_mfma_f32_16x16x32_bf16(Bt[n][k], At[m][k], acc[ai][bj][m][n], 0, 0, 0); } __builtin_amdgcn_s_setprio(0); } while (0)
#define PG8_WAIT_V(n) asm volatile("s_waitcnt vmcnt(" #n ")" ::: "memory")
#define PG8_WAIT_L(n) asm volatile("s_waitcnt lgkmcnt(" #n ")" ::: "memory")
#define PG8_BAR __builtin_amdgcn_s_barrier()
#define PG8_SCHED __builtin_amdgcn_sched_barrier(0)
    Unit cur, nxt; int ui = 0;
    if (!S.next(0, cur)) return;
    f32x4 acc[2][2][4][2];
#pragma unroll
    for (int a = 0; a < 2; ++a)
#pragma unroll
        for (int b = 0; b < 2; ++b)
#pragma unroll
            for (int m = 0; m < 4; ++m)
#pragma unroll
                for (int n = 0; n < 2; ++n) acc[a][b][m][n] = (f32x4){0.f, 0.f, 0.f, 0.f};
    bf16x8 At[4][2], B0[2][2], B1[2][2];
    const char* cA = (const char*)g.A + (size_t)cur.pm * tstep; const char* cB = (const char*)g.Bt + (size_t)cur.pn * tstep;
    S.a_ready(cur);
    if constexpr (SP2) {
        PG8_STAGE(PG8_SB(0, 0), cB, voffB); PG8_STAGE(PG8_SB(0, 1), cB + hstep, voffB); PG8_STAGE(PG8_SA(0, 0), cA, voffA); PG8_STAGE(PG8_SA(0, 1), cA + hstep, voffA);
        if (wr == 1) PG8_BAR;
        PG8_WAIT_V(2); PG8_BAR;
        PG8_STAGE(PG8_SB(1, 0), cB + kstep, voffB); PG8_STAGE(PG8_SA(1, 0), cA + kstep, voffA); PG8_STAGE(PG8_SB(1, 1), cB + hstep + kstep, voffB);
        PG8_WAIT_V(6); PG8_BAR;
    } else {
        PG8_STAGE(PG8_SB(0, 0), cB, voffB); PG8_STAGE(PG8_SA(0, 0), cA, voffA); PG8_STAGE(PG8_SB(0, 1), cB + hstep, voffB); PG8_STAGE(PG8_SA(0, 1), cA + hstep, voffA);
        if (wr == 1) PG8_BAR;
        PG8_WAIT_V(4); PG8_BAR;
        PG8_STAGE(PG8_SB(1, 0), cB + kstep, voffB); PG8_STAGE(PG8_SA(1, 0), cA + kstep, voffA); PG8_STAGE(PG8_SB(1, 1), cB + hstep + kstep, voffB);
        PG8_WAIT_V(6); PG8_BAR;
    }
    for (;;) {
        const bool has_next = S.next(ui + 1, nxt);
        const char* nA = has_next ? (const char*)g.A + (size_t)nxt.pm * tstep : cA; const char* nB = has_next ? (const char*)g.Bt + (size_t)nxt.pn * tstep : cB;
        for (int t = 0; t < nt; t += 2) {
            const bool last = (t == nt - 2);
            const char* a1 = cA + (size_t)(t + 1) * kstep;
            const char* a2 = last ? nA : cA + (size_t)(t + 2) * kstep; const char* b2 = last ? nB : cB + (size_t)(t + 2) * kstep;
            const char* a3 = a2 + kstep; const char* b3 = b2 + kstep;
            if (last && has_next) S.a_ready(nxt);
            if constexpr (SP2) {
            PG8_LDB(B0, 0, 0); PG8_LDB(B1, 0, 1); PG8_SCHED; PG8_LDA(At, 0, 0); PG8_STAGE(PG8_SA(1, 1), a1 + hstep, voffA);
            PG8_WAIT_V(8); PG8_WAIT_L(0); PG8_BAR; PG8_MMA(0, 0, At, B0); PG8_MMA(0, 1, At, B1); PG8_BAR; PG8_SCHED;
            PG8_LDA(At, 0, 1); PG8_STAGE(PG8_SB(0, 0), b2, voffB); PG8_STAGE(PG8_SB(0, 1), b2 + hstep, voffB); PG8_STAGE(PG8_SA(0, 0), a2, voffA);
            PG8_WAIT_V(8); PG8_WAIT_L(0); PG8_BAR; PG8_MMA(1, 0, At, B0); PG8_MMA(1, 1, At, B1); PG8_BAR; PG8_SCHED;
            PG8_LDB(B0, 1, 0); PG8_LDB(B1, 1, 1); PG8_SCHED; PG8_LDA(At, 1, 0); PG8_STAGE(PG8_SA(0, 1), a2 + hstep, voffA);
            PG8_WAIT_V(8); PG8_WAIT_L(0); PG8_BAR; PG8_MMA(0, 0, At, B0); PG8_MMA(0, 1, At, B1); PG8_BAR; PG8_SCHED;
            PG8_LDA(At, 1, 1); PG8_STAGE(PG8_SB(1, 0), b3, voffB); PG8_STAGE(PG8_SB(1, 1), b3 + hstep, voffB); PG8_STAGE(PG8_SA(1, 0), a3, voffA);
            PG8_WAIT_V(8); PG8_WAIT_L(0); PG8_BAR; PG8_MMA(1, 0, At, B0); PG8_MMA(1, 1, At, B1); PG8_BAR; PG8_SCHED;
            } else {
            PG8_LDB(B0, 0, 0); PG8_SCHED; PG8_LDA(At, 0, 0); PG8_STAGE(PG8_SA(1, 1), a1 + hstep, voffA);
            PG8_WAIT_L(8); PG8_BAR; PG8_WAIT_L(0); PG8_MMA(0, 0, At, B0); PG8_BAR; PG8_SCHED;
            PG8_LDB(B1, 0, 1); PG8_STAGE(PG8_SB(0, 0), b2, voffB);
            PG8_BAR; PG8_WAIT_L(0); PG8_MMA(0, 1, At, B1); PG8_BAR;
            PG8_LDA(At, 0, 1); PG8_STAGE(PG8_SA(0, 0), a2, voffA);
            PG8_BAR; PG8_WAIT_L(0); PG8_MMA(1, 0, At, B0); PG8_BAR; PG8_SCHED;
            PG8_STAGE(PG8_SB(0, 1), b2 + hstep, voffB);
            PG8_WAIT_V(6); PG8_BAR; PG8_MMA(1, 1, At, B1); PG8_BAR;
            PG8_LDB(B0, 1, 0); PG8_SCHED; PG8_LDA(At, 1, 0); PG8_STAGE(PG8_SA(0, 1), a2 + hstep, voffA);
            PG8_WAIT_L(8); PG8_BAR; PG8_WAIT_L(0); PG8_MMA(0, 0, At, B0); PG8_BAR; PG8_SCHED;
            PG8_LDB(B1, 1, 1); PG8_STAGE(PG8_SB(1, 0), b3, voffB);
            PG8_BAR; PG8_WAIT_L(0); PG8_MMA(0, 1, At, B1); PG8_BAR;
            PG8_LDA(At, 1, 1); PG8_STAGE(PG8_SA(1, 0), a3, voffA);
            PG8_BAR; PG8_WAIT_L(0); PG8_MMA(1, 0, At, B0); PG8_BAR; PG8_SCHED;
            PG8_STAGE(PG8_SB(1, 1), b3 + hstep, voffB);
            PG8_WAIT_V(6); PG8_BAR; PG8_MMA(1, 1, At, B1); PG8_BAR;
            }
        }
        if constexpr (ALIGN_EPI) { if (wr == 0) PG8_BAR; }
        E(acc, cur, wr, wc, fr, fq); S.done(cur);
        if (!has_next) break;
#pragma unroll
        for (int a = 0; a < 2; ++a)
#pragma unroll
            for (int b = 0; b < 2; ++b)
#pragma unroll
                for (int m = 0; m < 4; ++m)
#pragma unroll
                    for (int n = 0; n < 2; ++n) acc[a][b][m][n] = (f32x4){0.f, 0.f, 0.f, 0.f};
        cur = nxt; cA = nA; cB = nB; ++ui;
        if constexpr (ALIGN_EPI) { if (wr == 1) PG8_BAR; }
    }
    PG8_WAIT_V(0);
    if constexpr (!ALIGN_EPI) { if (wr == 0) PG8_BAR; }
    PG8_BAR;
#undef PG8_SA
#undef PG8_SB
#undef PG8_STAGE
#undef PG8_LDA
#undef PG8_LDB
#undef PG8_MMA
#undef PG8_WAIT_V
#undef PG8_WAIT_L
#undef PG8_BAR
#undef PG8_SCHED
}

typedef const f32x4 (&AccRef)[2][2][4][2];
__device__ __forceinline__ u32x4 pack8(f32x4 v0, f32x4 v1) { u32x4 w; w.x = pk2(v0[0], v0[1]); w.y = pk2(v0[2], v0[3]); w.z = pk2(v1[0], v1[1]); w.w = pk2(v1[2], v1[3]); return w; }
__device__ __forceinline__ void unpack8(u32x4 w, f32x4& v0, f32x4& v1) { v0 = (f32x4){bflo(w.x), bfhi(w.x), bflo(w.y), bfhi(w.y)}; v1 = (f32x4){bflo(w.z), bfhi(w.z), bflo(w.w), bfhi(w.w)}; }

struct EpiBf16 {
    static constexpr bool PERM = true, SWAP = false;
    bf16_t* O; int ldc;
    __device__ __forceinline__ void operator()(AccRef acc, const Unit& u, int wr, int wc, int fr, int fq) const {
        const int row0 = u.pm * BM + wr * 64 + fr, col0 = u.pn * BM + wc * 32 + 8 * fq;
#pragma unroll
        for (int ai = 0; ai < 2; ++ai)
#pragma unroll
            for (int m = 0; m < 4; ++m) { bf16_t* rowp = O + (size_t)(row0 + ai * HALF + m * 16) * ldc + col0;
#pragma unroll
                for (int bj = 0; bj < 2; ++bj) *(u32x4*)(rowp + bj * HALF) = pack8(acc[ai][bj][m][0], acc[ai][bj][m][1]); }
    }
};
struct EpiProj {
    static constexpr bool PERM = true, SWAP = false;
    bf16_t* O; const float* rope; bf16_t* KB;
    __device__ __forceinline__ void operator()(AccRef acc, const Unit& u, int wr, int wc, int fr, int fq) const {
        const int row0 = u.pm * BM + wr * 64 + fr, col0 = u.pn * BM + wc * 32 + 8 * fq;
        const int mode = (u.pn >= 27 && u.pn < 43) ? (u.pn < 35 ? 1 : 2) : 0;
        const float sc = (mode == 1) ? QSCALE : 1.0f;
#pragma unroll
        for (int ai = 0; ai < 2; ++ai)
#pragma unroll
            for (int m = 0; m < 4; ++m) { const int row = row0 + ai * HALF + m * 16; bf16_t* rowp = O + (size_t)row * PLD + col0;
#pragma unroll
                for (int bj = 0; bj < 2; ++bj) { f32x4 v0 = acc[ai][bj][m][0], v1 = acc[ai][bj][m][1];
                    if (mode) { const int i0 = ((col0 + bj * HALF) & 127) >> 1; const f32x4* rp = (const f32x4*)(rope + ((size_t)row * 64 + i0) * 2); const f32x4 c0 = rp[0], c1 = rp[1];
                        f32x4 o0, o1;
                        o0[0] = v0[0] * c0[0] - v0[1] * c0[1]; o0[1] = v0[1] * c0[0] + v0[0] * c0[1]; o0[2] = v0[2] * c0[2] - v0[3] * c0[3]; o0[3] = v0[3] * c0[2] + v0[2] * c0[3];
                        o1[0] = v1[0] * c1[0] - v1[1] * c1[1]; o1[1] = v1[1] * c1[0] + v1[0] * c1[1]; o1[2] = v1[2] * c1[2] - v1[3] * c1[3]; o1[3] = v1[3] * c1[2] + v1[2] * c1[3];
                        v0 = o0 * sc; v1 = o1 * sc; }
                    if (mode == 2) *(u32x4*)(KB + ((size_t)((u.pn - 35) * 2 + bj) * T + row) * MD + wc * 32 + 8 * fq) = pack8(v0, v1);
                    else *(u32x4*)(rowp + bj * HALF) = pack8(v0, v1); } }
    }
};
struct EpiVT {
    static constexpr bool PERM = false, SWAP = true;
    bf16_t* VT;
    __device__ __forceinline__ void operator()(AccRef acc, const Unit& u, int wr, int wc, int fr, int fq) const {
        const int tok0 = u.pm * BM + wr * 64 + 4 * fq, col0 = u.pn * BM + wc * 32 + fr;
#pragma unroll
        for (int ai = 0; ai < 2; ++ai)
#pragma unroll
            for (int m = 0; m < 4; ++m)
#pragma unroll
                for (int bj = 0; bj < 2; ++bj)
#pragma unroll
                    for (int n = 0; n < 2; ++n) { const f32x4 v = acc[ai][bj][m][n]; u32x2 w; w.x = pk2(v[0], v[1]); w.y = pk2(v[2], v[3]);
                        const int d = col0 + bj * HALF + n * 16, tl = (u.pm * BM + wr * 64 + ai * HALF) >> 6;
                        *(u32x2*)(VT + ((size_t)((d >> 7) * (T / 64) + tl) * MD + (d & 127)) * 64 + m * 16 + 4 * (((fq & 1) << 1) | (fq >> 1))) = w; }
    }
};
struct EpiDec {
    static constexpr bool PERM = true, SWAP = false;
    float* O; const float* w0;
    __device__ __forceinline__ void operator()(AccRef acc, const Unit& u, int wr, int wc, int fr, int fq) const {
        const int row0 = u.pm * BM + wr * 64 + fr, col0 = u.pn * BM + wc * 32 + 8 * fq;
#pragma unroll
        for (int bj = 0; bj < 2; ++bj) { const f32x4 b0 = *(const f32x4*)(w0 + col0 + bj * HALF), b1 = *(const f32x4*)(w0 + col0 + bj * HALF + 4);
#pragma unroll
            for (int ai = 0; ai < 2; ++ai)
#pragma unroll
                for (int m = 0; m < 4; ++m) { float* rowp = O + (size_t)(row0 + ai * HALF + m * 16) * RW + col0 + bj * HALF;
#pragma unroll
                    for (int n = 0; n < 2; ++n) { const f32x4 x = acc[ai][bj][m][n] + (n ? b1 : b0); f32x4 o;
#pragma unroll
                        for (int e = 0; e < 4; ++e) { const float z = -x[e]; const float sp = fmaxf(z, 0.f) + __logf(1.0f + __expf(-fabsf(z))); o[e] = __expf(-__expf(-sp - 0.5f)); }
                        *(f32x4*)(rowp + 4 * n) = o; }
                    asm volatile("" ::: "memory"); } }
    }
};
struct EpiA {
    static constexpr bool PERM = true, SWAP = false;
    bf16_t* KP; bf16_t* BB; const bf16_t* KKN; const float* a0; const float* k_a;
    __device__ __forceinline__ void operator()(AccRef acc, const Unit& u, int wr, int wc, int fr, int fq) const {
        const int row0 = u.pm * BM + wr * 64 + fr, col0 = u.pn * BM + wc * 32 + 8 * fq;
#pragma unroll
        for (int bj = 0; bj < 2; ++bj) { const int cb = col0 + bj * HALF;
            const f32x4 b0 = *(const f32x4*)(a0 + cb), b1 = *(const f32x4*)(a0 + cb + 4), ka0 = *(const f32x4*)(k_a + cb), ka1 = *(const f32x4*)(k_a + cb + 4);
#pragma unroll
            for (int ai = 0; ai < 2; ++ai)
#pragma unroll
                for (int m = 0; m < 4; ++m) { const size_t off = (size_t)(row0 + ai * HALF + m * 16) * RW + cb;
                    f32x4 zk0, zk1, kn0, kn1; unpack8(*(const u32x4*)(KP + off), zk0, zk1); unpack8(*(const u32x4*)(KKN + off), kn0, kn1);
                    f32x4 a0v, a1v;
#pragma unroll
                    for (int e = 0; e < 4; ++e) { a0v[e] = fsigmoid(acc[ai][bj][m][0][e] + b0[e]); a1v[e] = fsigmoid(acc[ai][bj][m][1][e] + b1[e]); }
                    const f32x4 kp0 = zk0 * (1.0f + (a0v - 1.0f) * ka0), kp1 = zk1 * (1.0f + (a1v - 1.0f) * ka1);
                    *(u32x4*)(KP + off) = pack8(kp0, kp1); *(u32x4*)(BB + off) = pack8(-(kn0 * a0v), -(kn1 * a1v));
                    asm volatile("" ::: "memory"); } }
    }
};
template <bool ADD> struct EpiMix {
    static constexpr bool PERM = true, SWAP = false;
    bf16_t* O; const bf16_t* proj; int gcol0;
    __device__ __forceinline__ void operator()(AccRef acc, const Unit& u, int wr, int wc, int fr, int fq) const {
        const int row0 = u.pm * BM + wr * 64 + fr, col0 = u.pn * BM + wc * 32 + 8 * fq;
#pragma unroll
        for (int ai = 0; ai < 2; ++ai)
#pragma unroll
            for (int m = 0; m < 4; ++m) { const int row = row0 + ai * HALF + m * 16;
#pragma unroll
                for (int bj = 0; bj < 2; ++bj) { f32x4 g0, g1; unpack8(*(const u32x4*)(proj + (size_t)row * PLD + gcol0 + col0 + bj * HALF), g0, g1);
                    f32x4 o0, o1;
#pragma unroll
                    for (int e = 0; e < 4; ++e) { o0[e] = fsigmoid(g0[e]) * acc[ai][bj][m][0][e]; o1[e] = fsigmoid(g1[e]) * acc[ai][bj][m][1][e]; }
                    bf16_t* op = O + (size_t)row * D + col0 + bj * HALF;
                    if (ADD) { f32x4 p0, p1; unpack8(*(const u32x4*)op, p0, p1); o0 += p0; o1 += p1; }
                    *(u32x4*)op = pack8(o0, o1); } }
    }
};
struct EpiRes {
    static constexpr bool PERM = true, SWAP = false;
    float* O; const float* x;
    __device__ __forceinline__ void operator()(AccRef acc, const Unit& u, int wr, int wc, int fr, int fq) const {
        const int row0 = u.pm * BM + wr * 64 + fr, col0 = u.pn * BM + wc * 32 + 8 * fq;
#pragma unroll
        for (int ai = 0; ai < 2; ++ai)
#pragma unroll
            for (int m = 0; m < 4; ++m) { const size_t off = (size_t)(row0 + ai * HALF + m * 16) * D + col0;
#pragma unroll
                for (int bj = 0; bj < 2; ++bj)
#pragma unroll
                    for (int n = 0; n < 2; ++n) *(f32x4*)(O + off + bj * HALF + 4 * n) = *(const f32x4*)(x + off + bj * HALF + 4 * n) + acc[ai][bj][m][n]; }
    }
};
}

#define XB_TMO      128
#define XB_XCNT(j)  (256  + 64 * (j))
#define XB_XSUB(j)  (1280 + 64 * (j))
#define XB_XGEN(j)  (2304 + 64 * (j))
#define XB_TOP      3328
#define XB_TOPGEN   3392
#define XCD_BAR_WORDS 3456
#define XB_SPIN_CAP (1u << 18)
__device__ __forceinline__ unsigned xb_ld(unsigned* p)              { return __hip_atomic_load(p, __ATOMIC_RELAXED, __HIP_MEMORY_SCOPE_AGENT); }
__device__ __forceinline__ unsigned xb_add(unsigned* p, unsigned v) { return __hip_atomic_fetch_add(p, v, __ATOMIC_RELAXED, __HIP_MEMORY_SCOPE_AGENT); }
__device__ __forceinline__ unsigned xb_xcc_id() { return (unsigned)__builtin_amdgcn_s_getreg((3 << 11) | 20) & 0xFu; }
#define XB_SPIN(cond, bar) do { unsigned _sp = 0; while (cond) { __builtin_amdgcn_s_sleep(1); \
    if ((++_sp & 255u) == 0u) { if (xb_ld(&(bar)[XB_TMO])) break; if (_sp > XB_SPIN_CAP) { atomicAdd(&(bar)[XB_TMO], 1u); break; } } } } while (0)
struct XcdBarrier { unsigned* bar; unsigned x; volatile LAS unsigned* st; };
__device__ __forceinline__ XcdBarrier xcd_barrier_post(unsigned* bar, volatile LAS unsigned* st) {
    XcdBarrier b; b.bar = bar; b.x = xb_xcc_id(); b.st = st;
    if (threadIdx.x == 0) (void)xb_add(&bar[XB_XCNT(b.x)], 1u);
    return b;
}
__device__ __forceinline__ void xcd_barrier_complete(unsigned* bar, unsigned x, unsigned& nloc, unsigned& nx) {
    const unsigned G = gridDim.x * gridDim.y * gridDim.z;
    unsigned sum, cnt, mine, sp = 0u;
    for (;;) {
        sum = 0u; cnt = 0u; mine = 0u;
#pragma unroll
        for (unsigned j = 0; j < 16; ++j) { const unsigned c = xb_ld(&bar[XB_XCNT(j)]); sum += c; cnt += (c > 0u) ? 1u : 0u; mine = (j == x) ? c : mine; }
        if (sum == G) break;
        __builtin_amdgcn_s_sleep(1);
        if ((++sp & 255u) == 0u) { if (xb_ld(&bar[XB_TMO])) break; if (sp > XB_SPIN_CAP) { atomicAdd(&bar[XB_TMO], 1u); break; } }
    }
    nloc = mine > 0u ? mine : 1u; nx = cnt > 0u ? cnt : 1u;
}
__device__ __forceinline__ void xcd_barrier(const XcdBarrier& b) {
    asm volatile("s_waitcnt vmcnt(0)" ::: "memory");
    __syncthreads();
    if (threadIdx.x == 0) {
        unsigned* bar = b.bar;
        __builtin_amdgcn_s_waitcnt(0);
        unsigned nloc = b.st[0], nx = b.st[1];
        if (nloc == 0u) { xcd_barrier_complete(bar, b.x, nloc, nx); b.st[0] = nloc; b.st[1] = nx; }
        const unsigned old = xb_add(&bar[XB_XSUB(b.x)], 1u);
        const unsigned gen = old / nloc;
        if (old + 1u == (gen + 1u) * nloc) {
            __builtin_amdgcn_fence(__ATOMIC_RELEASE, "agent");
            asm volatile("s_waitcnt vmcnt(0)" ::: "memory");
            const unsigned og = xb_add(&bar[XB_TOP], 1u);
            const unsigned tg = og / nx;
            if (og + 1u == (tg + 1u) * nx) xb_add(&bar[XB_TOPGEN], 1u);
            else XB_SPIN(xb_ld(&bar[XB_TOPGEN]) == tg, bar);
            __builtin_amdgcn_fence(__ATOMIC_ACQUIRE, "agent");
            xb_add(&bar[XB_XGEN(b.x)], 1u);
            asm volatile("s_waitcnt vmcnt(0)" ::: "memory");
        } else {
            XB_SPIN(xb_ld(&bar[XB_XGEN(b.x)]) == gen, bar);
            __builtin_amdgcn_fence(__ATOMIC_ACQUIRE, "agent");
            asm volatile("s_waitcnt vmcnt(0)" ::: "memory");
        }
    }
    __syncthreads();
}

struct Args {
    const float *x, *norm1_g, *w_in, *mu, *w0, *w_up, *a0, *a_up, *g_up, *k_k, *k_a, *r_k, *lnx_g, *lnx_b, *w_ba, *w_bb, *w_out, *norm2_g, *peer_wq, *sub_keys, *peer_u, *peer_v, *final_g;
    float* out; unsigned char* ws; int ph_lo, ph_hi, li, pad;
};
#define CAS __attribute__((address_space(4)))
typedef const CAS Args* ArgsP;
__device__ __forceinline__ ArgsP get_args() { ArgsP p = (ArgsP)__builtin_amdgcn_kernarg_segment_ptr(); asm volatile("" : "+s"(p)); return p; }
struct Frame { LAS unsigned char* lds; int tid, lane, wave, vcu, G; };

__device__ __forceinline__ int win_dst(int s) {
    if (s < SHIFTW) return s;
    if (s < SHIFTW + 4096) { const int base = (s < SHIFTW + 2048) ? SHIFTW : SHIFTW + 2048; const int m = s - base, head = m >> 7, c = m & 127; const int j = (c < 64) ? 2 * c : 2 * (c - 64) + 1;
        return ((s < SHIFTW + 2048) ? PC_MQ : PC_MK) + head * 128 + j; }
    if (s < SHIFTW + 6144) return PC_MV + (s - (SHIFTW + 4096));
    if (s < SHIFTW + 6144 + 4096) return PC_GA + (s - (SHIFTW + 6144));
    return PC_GB + (s - (SHIFTW + 6144 + 4096));
}
template <bool MAPWIN> __device__ __forceinline__ void p0_transpose_item(const float* W, int K, int N, bf16_t* WT, int Kd, LAS float* scr, int item, int lane) {
    const int nblk = N / 32, kb = item / nblk, nb = item % nblk, k0 = 64 * kb, n0 = 32 * nb;
    { const int krow = lane >> 3, c4 = lane & 7; f32x4 v[8];
#pragma unroll
      for (int i = 0; i < 8; ++i) { const int kk = 8 * i + krow; v[i] = (k0 + kk < K) ? *(const f32x4*)(W + (size_t)(k0 + kk) * N + n0 + 4 * c4) : (f32x4){0.f, 0.f, 0.f, 0.f}; }
#pragma unroll
      for (int i = 0; i < 8; ++i) { LAS float* d = scr + (8 * i + krow) * 33 + 4 * c4; d[0] = v[i].x; d[1] = v[i].y; d[2] = v[i].z; d[3] = v[i].w; } }
    LDS_WAIT(); asm volatile("" ::: "memory");
    const int c = lane & 7;
#pragma unroll
    for (int j = 0; j < 4; ++j) { const int n = (lane >> 3) + 8 * j; const LAS float* s = scr + (8 * c) * 33 + n;
        u32x4 o; o.x = pk2(s[0 * 33], s[1 * 33]); o.y = pk2(s[2 * 33], s[3 * 33]); o.z = pk2(s[4 * 33], s[5 * 33]); o.w = pk2(s[6 * 33], s[7 * 33]);
        const int row = MAPWIN ? win_dst(n0 + n) : (n0 + n);
        *(u32x4*)(WT + (size_t)row * Kd + k0 + 8 * c) = o; }
    LDS_WAIT(); asm volatile("" ::: "memory");
}
__device__ __forceinline__ void rms_rows_to_bf16(const float* x, const float* g, bf16_t* o, int m0, int mstride, int lane) {
    const f32x4* gr = (const f32x4*)g + lane;
    f32x4 v[16], w[16];
    if (m0 < T) {
#pragma unroll
        for (int j = 0; j < 16; ++j) v[j] = ((const f32x4*)(x + (size_t)m0 * D) + lane)[64 * j]; }
    for (int m = m0; m < T; m += mstride) { const bool hasn = m + mstride < T;
        if (hasn) {
#pragma unroll
            for (int j = 0; j < 16; ++j) w[j] = ((const f32x4*)(x + (size_t)(m + mstride) * D) + lane)[64 * j]; }
        float s = 0.f;
#pragma unroll
        for (int j = 0; j < 16; ++j) s += (v[j].x * v[j].x + v[j].y * v[j].y) + (v[j].z * v[j].z + v[j].w * v[j].w);
        const float rs = 1.0f / sqrtf(wave_sum(s) * (1.0f / D) + NORM_EPS);
        u32x2* o8 = (u32x2*)(o + (size_t)m * D) + lane;
#pragma unroll
        for (int j = 0; j < 16; ++j) { const f32x4 gg = gr[64 * j]; u32x2 q; q.x = pk2(v[j].x * rs * gg.x, v[j].y * rs * gg.y); q.y = pk2(v[j].z * rs * gg.z, v[j].w * rs * gg.w); o8[64 * j] = q; }
        if (hasn) {
#pragma unroll
            for (int j = 0; j < 16; ++j) v[j] = w[j]; }
    }
}
__device__ __forceinline__ void cvt_table(const float* src, bf16_t* dst, size_t n8, size_t gtid, size_t nthr) {
    for (size_t i = gtid; i < n8; i += nthr) { const f32x4 a = ((const f32x4*)src)[2 * i], b = ((const f32x4*)src)[2 * i + 1]; ((u32x4*)dst)[i] = pg8::pack8(a, b); }
}
__device__ __forceinline__ void pq_load(ArgsP A, int row, int lane, f32x4 (&v)[16]) {
    const f32x4* src = (const f32x4*)((row >= 16384 ? A->peer_v + (size_t)(row - 16384) * D : A->peer_u + (size_t)row * D)) + lane;
#pragma unroll
    for (int j = 0; j < 16; ++j) v[j] = __builtin_nontemporal_load(src + 64 * j);
}
__device__ __forceinline__ void pq_finish(unsigned char* ws, int row, int lane, const f32x4 (&v)[16]) {
    const bool isv = row >= 16384; const int rr = isv ? row - 16384 : row; float am = 0.f;
#pragma unroll
    for (int j = 0; j < 16; ++j) am = fmaxf(fmaxf(am, fmaxf(fabsf(v[j].x), fabsf(v[j].y))), fmaxf(fabsf(v[j].z), fabsf(v[j].w)));
#pragma unroll
    for (int o = 1; o < 64; o <<= 1) am = fmaxf(am, __shfl_xor(am, o));
    const float inv = am > 0.f ? 127.0f / am : 0.f; unsigned* dst = (unsigned*)(ws + (isv ? WS_PV : WS_PU)) + (size_t)rr * (D / 4) + lane;
    constexpr float MAGIC = 8388608.0f + 128.0f;
#pragma unroll
    for (int j = 0; j < 16; ++j) { const unsigned b0 = __builtin_bit_cast(unsigned, __builtin_fmaf(v[j].x, inv, MAGIC)), b1 = __builtin_bit_cast(unsigned, __builtin_fmaf(v[j].y, inv, MAGIC)),
                                                  b2 = __builtin_bit_cast(unsigned, __builtin_fmaf(v[j].z, inv, MAGIC)), b3 = __builtin_bit_cast(unsigned, __builtin_fmaf(v[j].w, inv, MAGIC));
        dst[64 * j] = __builtin_amdgcn_perm(__builtin_amdgcn_perm(b3, b2, 0x0c0c0400u), __builtin_amdgcn_perm(b1, b0, 0x0c0c0400u), 0x05040100u); }
    if (lane == 0) ((float*)(ws + (isv ? WS_PSV : WS_PSU)))[rr] = am * (1.0f / 127.0f);
}
__device__ __forceinline__ int pq_ra(int G) { constexpr int NT1 = (T / 256) * (PLD / 256); const int nx = NT1 % G, idle = nx ? G - nx : 0, n = idle * NWAVES * 7; return n < 2 * 16384 ? n : 2 * 16384; }
__device__ __forceinline__ void peer_quant(ArgsP A, Frame& F, int r0, int r1, int w0, int wstride) {
    f32x4 v[16], w[16];
    int row = r0 + w0;
    if (row < r1) pq_load(A, row, F.lane, v);
    for (; row < r1; row += wstride) { const bool hasn = row + wstride < r1;
        if (hasn) pq_load(A, row + wstride, F.lane, w);
        pq_finish(A->ws, row, F.lane, v);
        if (hasn) {
#pragma unroll
            for (int j = 0; j < 16; ++j) v[j] = w[j]; }
    }
}
__device__ __forceinline__ void late_weights(ArgsP A, Frame& F, int w0, int wstride) {
    unsigned char* ws = A->ws;
    LAS float* scr = (LAS float*)(F.lds + RING_OFF + F.wave * 16384);
    constexpr int I_BA = 32 * 128, I_OUT = 64 * 128, I_WQ = 64 * 64, I_SK = PH_ * 2 * PNK * PHALF / 512;
    constexpr int NITEMS = 2 * I_BA + I_OUT + I_WQ + I_SK;
    for (int it = w0; it < NITEMS; it += wstride) {
        int r = it;
        if (r < I_BA) { p0_transpose_item<false>(A->w_ba, RW, D, (bf16_t*)(ws + WS_WA), RW, scr, r, F.lane); continue; } r -= I_BA;
        if (r < I_BA) { p0_transpose_item<false>(A->w_bb, RW, D, (bf16_t*)(ws + WS_WB), RW, scr, r, F.lane); continue; } r -= I_BA;
        if (r < I_OUT) { p0_transpose_item<false>(A->w_out, D, D, (bf16_t*)(ws + WS_WOUT), D, scr, r, F.lane); continue; } r -= I_OUT;
        if (r < I_WQ) { p0_transpose_item<false>(A->peer_wq, D, 2048, (bf16_t*)(ws + WS_WQ), D, scr, r, F.lane); continue; } r -= I_WQ;
        { const size_t i = (size_t)r * 64 + F.lane; const f32x4 a = ((const f32x4*)A->sub_keys)[2 * i], b = ((const f32x4*)A->sub_keys)[2 * i + 1]; ((u32x4*)(ws + WS_SUBK))[i] = pg8::pack8(a, b); }
    }
}
__device__ __forceinline__ void ph0_prologue(ArgsP A, Frame& F) {
    unsigned char* ws = A->ws;
    LAS float* scr = (LAS float*)(F.lds + RING_OFF + F.wave * 16384);
    const int gw = F.vcu * NWAVES + F.wave, NGW = F.G * NWAVES;
    constexpr int I_IN = 64 * (INW / 32), I_UP = 2 * 64, I_G = 8 * 64;
    constexpr int NITEMS = I_IN + 2 * I_UP + I_G;
    for (int it = gw; it < NITEMS; it += NGW) {
        int r = it;
        if (r < I_IN) { p0_transpose_item<true>(A->w_in, D, INW, (bf16_t*)(ws + WS_WIN), D, scr, r, F.lane); continue; } r -= I_IN;
        if (r < I_UP) { p0_transpose_item<false>(A->w_up, LW, RW, (bf16_t*)(ws + WS_WUP), LW, scr, r, F.lane); continue; } r -= I_UP;
        if (r < I_UP) { p0_transpose_item<false>(A->a_up, LA, RW, (bf16_t*)(ws + WS_AUP), LA, scr, r, F.lane); continue; } r -= I_UP;
        p0_transpose_item<false>(A->g_up, LG, RW, (bf16_t*)(ws + WS_GUP), LGP, scr, r, F.lane);
    }
    const size_t gtid = (size_t)F.vcu * NTHR + F.tid, nthr = (size_t)F.G * NTHR;
    for (size_t i = gtid; i < (size_t)32 * D / 8; i += nthr) ((u32x4*)((bf16_t*)(ws + WS_WIN) + (size_t)SHIFTW * D))[i] = (u32x4){0u, 0u, 0u, 0u};
    for (size_t i = gtid; i < (size_t)T * 64; i += nthr) { const int pos = (int)(i >> 6), fi = (int)(i & 63); const float inv = powf(10000.0f, -(float)fi / 64.0f); const float ang = (float)pos * inv;
        ((f32x2*)(ws + WS_ROPE))[i] = (f32x2){cosf(ang), sinf(ang)}; }
    rms_rows_to_bf16(A->x, A->norm1_g, (bf16_t*)(ws + WS_XN), gw, NGW, F.lane);
}

__device__ __forceinline__ f32x4 ld4bf(const bf16_t* p) { const u32x2 w = *(const u32x2*)p; return (f32x4){bflo(w.x), bfhi(w.x), bflo(w.y), bfhi(w.y)}; }
__device__ __forceinline__ void st4bf(bf16_t* p, f32x4 v) { u32x2 w; w.x = pk2(v[0], v[1]); w.y = pk2(v[2], v[3]); *(u32x2*)p = w; }
__device__ __forceinline__ void ph2_prep(ArgsP A, Frame& F) {
    unsigned char* ws = A->ws; const bf16_t* PROJ = (const bf16_t*)(ws + WS_PROJ);
    LAS float* red = (LAS float*)(F.lds + RING_OFF);
    for (int it = F.vcu; it < NBLK * MH; it += F.G) { const int n = it / MH, h = it % MH, d = F.tid & 127, part = F.tid >> 7;
        const bf16_t* p = (const bf16_t*)(ws + WS_KB) + ((size_t)h * T + n * MBLK + part * 64) * MD + d; float s = 0.f;
#pragma unroll 8
        for (int i = 0; i < 64; ++i) s += bf1(p[(size_t)i * MD]);
        red[F.tid] = s; WG_BAR();
        if (F.tid < 128) { const float m = (red[F.tid] + red[F.tid + 128] + red[F.tid + 256] + red[F.tid + 384]) * (1.0f / MBLK); const unsigned hi = f2bf(m); const float lo = m - __builtin_bit_cast(float, hi << 16);
            ((bf16_t*)(ws + WS_KMEAN))[(size_t)(h * NBLK + n) * MD + F.tid] = (bf16_t)hi; ((bf16_t*)(ws + WS_KMEAN + 131072))[(size_t)(h * NBLK + n) * MD + F.tid] = (bf16_t)f2bf(lo); }
        WG_BAR(); }
    const int tid = F.tid; const int c = 4 * tid;
    const f32x4 mu_r = *(const f32x4*)(A->mu + PC_R + c), mu_k = *(const f32x4*)(A->mu + PC_K + c), mu_v = *(const f32x4*)(A->mu + PC_V + c), kkw = *(const f32x4*)(A->k_k + c);
    int lc = 0, lcc = 0; if (tid < 32) { lcc = 4 * tid; lc = PC_WL + lcc; } else if (tid < 64) { lcc = 4 * (tid - 32); lc = PC_AL + lcc; } else { lcc = 4 * (tid - 64); lc = PC_GL + lcc; }
    const bool lact = tid < 64 || (tid < 192 && lcc < LG);
    const f32x4 mu_l = lact ? *(const f32x4*)(A->mu + lc) : (f32x4){0.f, 0.f, 0.f, 0.f};
    u32x2 cur[8], nxt[8];
    auto tload = [&](int t, u32x2 (&rg)[8]) { const bf16_t* P = PROJ + (size_t)t * PLD; const bf16_t* PP = t > 0 ? P - PLD : P;
        rg[0] = *(const u32x2*)(P + PC_R + c); rg[1] = *(const u32x2*)(PP + PC_R + c); rg[2] = *(const u32x2*)(P + PC_K + c); rg[3] = *(const u32x2*)(PP + PC_K + c);
        rg[4] = *(const u32x2*)(P + PC_V + c); rg[5] = *(const u32x2*)(PP + PC_V + c);
        if (lact) { rg[6] = *(const u32x2*)(P + lc); rg[7] = *(const u32x2*)(PP + lc); } else { rg[6] = (u32x2){0u, 0u}; rg[7] = (u32x2){0u, 0u}; } };
    auto up4 = [](u32x2 w) { return (f32x4){bflo(w.x), bfhi(w.x), bflo(w.y), bfhi(w.y)}; };
    if (F.vcu < T) tload(F.vcu, cur);
    for (int t = F.vcu; t < T; t += F.G) { const bool hasn = t + F.G < T; if (hasn) tload(t + F.G, nxt);
        const float hp = t > 0 ? 1.0f : 0.0f;
        { const f32x4 p = up4(cur[0]), pp = up4(cur[1]) * hp; st4bf((bf16_t*)(ws + WS_ZR) + (size_t)t * RW + c, p + (pp - p) * mu_r); }
        { const f32x4 p = up4(cur[2]), pp = up4(cur[3]) * hp; const f32x4 zk = p + (pp - p) * mu_k;
          st4bf((bf16_t*)(ws + WS_KP) + (size_t)t * RW + c, zk); const f32x4 kk = zk * kkw;
          const float ss = sum16((kk[0] * kk[0] + kk[1] * kk[1]) + (kk[2] * kk[2] + kk[3] * kk[3])); const float inv = 1.0f / fmaxf(sqrtf(ss), 1e-12f);
          st4bf((bf16_t*)(ws + WS_KKN) + (size_t)t * RW + c, kk * inv); }
        { const f32x4 p = up4(cur[4]), pp = up4(cur[5]) * hp; st4bf((bf16_t*)(ws + WS_ZV) + (size_t)t * RW + c, p + (pp - p) * mu_v); }
        if (tid < 192) { const f32x4 zero = (f32x4){0.f, 0.f, 0.f, 0.f};
            f32x4 z = zero; if (lact) { const f32x4 p = up4(cur[6]), pp = up4(cur[7]) * hp; z = p + (pp - p) * mu_l; }
            if (tid < 32) { f32x4 o;
#pragma unroll
                for (int e = 0; e < 4; ++e) o[e] = 1.0f - 2.0f * __builtin_amdgcn_rcpf(__expf(2.0f * z[e]) + 1.0f);
                st4bf((bf16_t*)(ws + WS_AW) + (size_t)t * LW + lcc, o); }
            else if (tid < 64) st4bf((bf16_t*)(ws + WS_AA) + (size_t)t * LA + lcc, z);
            else { f32x4 o = zero; if (lcc < LG) {
#pragma unroll
                for (int e = 0; e < 4; ++e) o[e] = fsigmoid(z[e]); }
                st4bf((bf16_t*)(ws + WS_AG) + (size_t)t * LGP + lcc, o); }
        }
        if (hasn) {
#pragma unroll
            for (int i = 0; i < 8; ++i) cur[i] = nxt[i]; }
    }
}

__device__ __forceinline__ void ph3_gate(ArgsP A, Frame& F) {
    unsigned char* ws = A->ws; const bf16_t* PROJ = (const bf16_t*)(ws + WS_PROJ); const bf16_t* KMH = (const bf16_t*)(ws + WS_KMEAN); const bf16_t* KML = (const bf16_t*)(ws + WS_KMEAN + 131072); unsigned* MASK = (unsigned*)(ws + WS_MASK);
    const int gw = F.vcu * NWAVES + F.wave, NGW = F.G * NWAVES; const int r = F.lane & 31, hh = F.lane >> 5; const float NEG = -__builtin_inff();
    for (int it = gw; it < (T / 32) * MH; it += NGW) { const int tg = it >> 4, h = it & 15, t = tg * 32 + r, blk = tg >> 3;
        if (blk == 0) { if (hh == 0) MASK[t * MH + h] = 0u; continue; }
        f32x16 acc;
#pragma unroll
        for (int e = 0; e < 16; ++e) acc[e] = 0.f;
#pragma unroll
        for (int ks = 0; ks < 8; ++ks) { const bf16x8 q = *(const bf16x8*)(PROJ + (size_t)t * PLD + PC_MQ + h * MD + 16 * ks + 8 * hh); const size_t ko = (size_t)(h * NBLK + r) * MD + 16 * ks + 8 * hh;
            acc = __builtin_amdgcn_mfma_f32_32x32x16_bf16(*(const bf16x8*)(KMH + ko), q, acc, 0, 0, 0); acc = __builtin_amdgcn_mfma_f32_32x32x16_bf16(*(const bf16x8*)(KML + ko), q, acc, 0, 0, 0); }
        float t0 = NEG, t1 = NEG, t2 = NEG;
#pragma unroll
        for (int e = 0; e < 16; ++e) { const int n = (e & 3) + 8 * (e >> 2) + 4 * hh; float ae = acc[e]; asm volatile("" : "+v"(ae));
            float x = __builtin_bit_cast(float, (__builtin_bit_cast(unsigned, ae) & ~31u) | (unsigned)(31 - n)); x = (n < blk) ? x : NEG;
            t2 = __builtin_amdgcn_fmed3f(t1, t2, x); t1 = __builtin_amdgcn_fmed3f(t0, t1, x); t0 = fmaxf(t0, x); }
        const float o0 = __shfl_xor(t0, 32), o1 = __shfl_xor(t1, 32), o2 = __shfl_xor(t2, 32);
        t2 = __builtin_amdgcn_fmed3f(t1, t2, o0); t1 = __builtin_amdgcn_fmed3f(t0, t1, o0); t0 = fmaxf(t0, o0);
        t2 = __builtin_amdgcn_fmed3f(t1, t2, o1); t1 = __builtin_amdgcn_fmed3f(t0, t1, o1); t0 = fmaxf(t0, o1);
        t2 = __builtin_amdgcn_fmed3f(t1, t2, o2); t1 = __builtin_amdgcn_fmed3f(t0, t1, o2); t0 = fmaxf(t0, o2);
        unsigned sel = 1u << (31 - (__builtin_bit_cast(unsigned, t0) & 31u));
        if (blk > 1) sel |= 1u << (31 - (__builtin_bit_cast(unsigned, t1) & 31u));
        if (blk > 2) sel |= 1u << (31 - (__builtin_bit_cast(unsigned, t2) & 31u));
        if (hh == 0) MASK[t * MH + h] = sel;
        { gu32* cnt = (gu32*)(ws + WS_CTL) + CW_CNT + h * 32; unsigned short* lst = (unsigned short*)(ws + WS_LIST) + (size_t)h * 32 * 8192; const unsigned mysel = hh == 0 ? sel : 0u;
          unsigned mycnt = 0u;
          for (int j = 0; j < blk; ++j) { const unsigned long long bal = __ballot((mysel >> j) & 1u); const unsigned c = (unsigned)__builtin_popcountll(bal); mycnt = (F.lane == j) ? c : mycnt; }
          unsigned base = 0u; if (F.lane < blk && mycnt) base = __hip_atomic_fetch_add(cnt + F.lane, mycnt, __ATOMIC_RELAXED, __HIP_MEMORY_SCOPE_AGENT);
          for (int j = 0; j < blk; ++j) { const unsigned long long bal = __ballot((mysel >> j) & 1u); const unsigned bj = (unsigned)__builtin_amdgcn_readlane((int)base, j);
              if ((mysel >> j) & 1u) { const unsigned off = __builtin_amdgcn_mbcnt_hi((unsigned)(bal >> 32), __builtin_amdgcn_mbcnt_lo((unsigned)bal, 0u)); const unsigned slot = (unsigned)__builtin_popcount(mysel & ((1u << j) - 1u));
                  lst[(size_t)j * 8192 + bj + off] = (unsigned short)((unsigned)t | (slot << 13)); } } } }
}

constexpr int CK = 64, NCHK = T / CK, CP = 144, CPF = 272;
constexpr int L_AT = 0, L_BT = 9216, L_KT = 18432, L_RT = 27648, L_ATT = 36864, L_BTT = 46080, L_V = 55296, L_MKA = 64512, L_MBRT = 73728, L_MKRT = 82944, L_A2 = 92160, L_MBA = 101376, L_PC = 118784, L_WT = 119040, L_MBH = 121088, L_TD = 130304, L_PT = 134912, L_CEND = 139520;
constexpr int L_TT = L_AT, L_A1 = L_BT, L_Y2T = L_MKA, L_G2T = L_ATT;
static_assert(L_CEND <= RING_BYTES, "chunk prep LDS");
constexpr size_t CHW_ITEM = 32768;
__device__ __forceinline__ f32x16 nt_quad(const LAS unsigned char* X, const LAS unsigned char* Y, int qp, int qq, int r, int hh) {
    f32x16 acc;
#pragma unroll
    for (int e = 0; e < 16; ++e) acc[e] = 0.f;
#pragma unroll
    for (int ks = 0; ks < 4; ++ks) { const bf16x8 a = *(const LAS bf16x8*)(Y + (32 * qq + r) * CP + 32 * ks + 16 * hh), b = *(const LAS bf16x8*)(X + (32 * qp + r) * CP + 32 * ks + 16 * hh);
        acc = __builtin_amdgcn_mfma_f32_32x32x16_bf16(a, b, acc, 0, 0, 0); }
    return acc;
}
__device__ __forceinline__ int nt_q(int qq, int e, int hh) { return 32 * qq + (e & 3) + 8 * (e >> 2) + 4 * hh; }
__device__ __forceinline__ void nt_store_bf16(LAS unsigned char* O, int p, int qq, int hh, const f32x16& v) {
#pragma unroll
    for (int g = 0; g < 4; ++g) { u32x2 w; w.x = pk2(v[4 * g], v[4 * g + 1]); w.y = pk2(v[4 * g + 2], v[4 * g + 3]); *(LAS u32x2*)(O + p * CP + (32 * qq + 8 * g + 4 * hh) * 2) = w; }
}
__device__ __forceinline__ void ph4_chunkprep(ArgsP A, Frame& F) {
    unsigned char* ws = A->ws;
    const float* DEC = (const float*)(ws + WS_DEC); const bf16_t* KKN = (const bf16_t*)(ws + WS_KKN); const bf16_t* BBg = (const bf16_t*)(ws + WS_BB); const bf16_t* KPg = (const bf16_t*)(ws + WS_KP);
    const bf16_t* ZR = (const bf16_t*)(ws + WS_ZR); const bf16_t* ZV = (const bf16_t*)(ws + WS_ZV); float* Yg = (float*)(ws + WS_Y); unsigned char* CHW = ws + WS_WIN;
    LAS unsigned char* L = F.lds + RING_OFF; const int wave = F.wave, lane = F.lane, r = lane & 31, hh = lane >> 5;
    const int prod = wave >> 2, qp = (wave >> 1) & 1, qq = wave & 1, p = 32 * qp + r;
    float nwv[8]; unsigned nkk[4], nbb[4], nkp[4], nr[4], nv[4];
    auto request = [&](int h2, int c2) {
#pragma unroll
        for (int k = 0; k < 8; ++k) nwv[k] = DEC[(size_t)(c2 * CK + 8 * wave + k) * RW + (size_t)h2 * RN + lane];
#pragma unroll
        for (int i = 0; i < 4; ++i) { const size_t o = (size_t)(c2 * CK + 8 * wave + 2 * i + hh) * RW + (size_t)h2 * RN + 2 * r;
            nkk[i] = *(const unsigned*)(KKN + o); nbb[i] = *(const unsigned*)(BBg + o); nkp[i] = *(const unsigned*)(KPg + o); nr[i] = *(const unsigned*)(ZR + o); nv[i] = *(const unsigned*)(ZV + o); } };
    if (F.vcu < RH * NCHK) request(F.vcu / NCHK, F.vcu % NCHK);
    if (F.vcu == 0 && wave == 0) {
        const gu32* cnt = (const gu32*)(ws + WS_CTL) + CW_CNT; unsigned* ud = (unsigned*)(ws + WS_UDESC); unsigned np[8], tot = 0u;
#pragma unroll
        for (int k = 0; k < 8; ++k) { const unsigned c = __hip_atomic_load(cnt + 8 * lane + k, __ATOMIC_RELAXED, __HIP_MEMORY_SCOPE_AGENT); np[k] = (c + 255u) >> 8; tot += np[k]; }
        unsigned incl = tot;
#pragma unroll
        for (int o = 1; o < 64; o <<= 1) { const unsigned v = __shfl_up(incl, o); if (lane >= o) incl += v; }
        unsigned pos = incl - tot;
#pragma unroll
        for (int k = 0; k < 8; ++k) { const unsigned c = __hip_atomic_load(cnt + 8 * lane + k, __ATOMIC_RELAXED, __HIP_MEMORY_SCOPE_AGENT); for (unsigned ps = 0; ps < np[k]; ++ps) { ud[1 + 2 * pos] = (unsigned)(8 * lane + k) | (ps << 16); ud[2 + 2 * pos] = c; ++pos; } }
        if (lane == 63) ud[0] = incl; }
    for (int item = F.vcu; item < RH * NCHK; item += F.G) { const int h = item / NCHK, c = item % NCHK; const size_t hc = (size_t)h * RN; const int t0 = c * CK;
        { float wv[8], kkv[8], bbv[8], kpv[8], rv[8]; unsigned vv[8];
#pragma unroll
          for (int k = 0; k < 8; ++k) { const int src = ((k & 1) << 7) | ((lane >> 1) << 2); const bool odd = lane & 1;
              auto mine = [&](unsigned x) { const unsigned w = (unsigned)__builtin_amdgcn_ds_bpermute(src, (int)x); return odd ? (w & 0xffff0000u) : (w << 16); };
              wv[k] = nwv[k]; kkv[k] = __builtin_bit_cast(float, mine(nkk[k >> 1])); bbv[k] = __builtin_bit_cast(float, mine(nbb[k >> 1])); kpv[k] = __builtin_bit_cast(float, mine(nkp[k >> 1]));
              rv[k] = __builtin_bit_cast(float, mine(nr[k >> 1])); vv[k] = mine(nv[k >> 1]) >> 16; }
          { const int nit = item + F.G; if (nit < RH * NCHK) request(nit / NCHK, nit % NCHK); }
          float pl[8]; pl[0] = wv[0];
#pragma unroll
          for (int k = 1; k < 8; ++k) pl[k] = pl[k - 1] * wv[k];
          ((LAS float*)(L + L_WT))[wave * 64 + lane] = pl[7];
          WG_BAR();
          float pre = 1.f;
#pragma unroll
          for (int w2 = 0; w2 < 7; ++w2) { const float x = ((const LAS float*)(L + L_WT))[w2 * 64 + lane]; pre = (w2 < wave) ? pre * x : pre; }
          unsigned atp[4], btp[4], vtp[4];
#pragma unroll
          for (int k = 0; k < 8; ++k) { const float Pt = pre * pl[k], Pm = (k == 0) ? pre : pre * pl[k - 1], ip = __builtin_amdgcn_rcpf(Pt); const int t = 8 * wave + k;
              const unsigned a16 = f2bf(Pm * kkv[k]), b16 = f2bf(bbv[k] * ip), k16 = f2bf(kpv[k] * ip), r16 = f2bf(Pt * rv[k]);
              *(LAS bf16_t*)(L + L_AT + t * CP + 2 * lane) = (bf16_t)a16; *(LAS bf16_t*)(L + L_BT + t * CP + 2 * lane) = (bf16_t)b16; *(LAS bf16_t*)(L + L_KT + t * CP + 2 * lane) = (bf16_t)k16; *(LAS bf16_t*)(L + L_RT + t * CP + 2 * lane) = (bf16_t)r16;
              if (k & 1) { atp[k >> 1] |= a16 << 16; btp[k >> 1] |= b16 << 16; vtp[k >> 1] |= vv[k] << 16; } else { atp[k >> 1] = a16; btp[k >> 1] = b16; vtp[k >> 1] = vv[k]; }
              if (wave == 7 && k == 7) ((LAS float*)(L + L_PC))[lane] = Pt; }
          *(LAS u32x4*)(L + L_ATT + lane * CP + 16 * wave) = (u32x4){atp[0], atp[1], atp[2], atp[3]}; *(LAS u32x4*)(L + L_BTT + lane * CP + 16 * wave) = (u32x4){btp[0], btp[1], btp[2], btp[3]};
          *(LAS u32x4*)(L + L_V + lane * CP + 16 * wave) = (u32x4){vtp[0], vtp[1], vtp[2], vtp[3]}; }
        WG_BAR();
        { const f32x16 v = nt_quad(L + (prod ? L_KT : L_BT), L + L_AT, qp, qq, r, hh); f32x16 m;
#pragma unroll
          for (int e = 0; e < 16; ++e) m[e] = nt_q(qq, e, hh) > p ? v[e] : 0.f;
          if (prod == 0) {
#pragma unroll
              for (int g = 0; g < 4; ++g) *(LAS f32x4*)(L + L_MBA + p * CPF + (32 * qq + 8 * g + 4 * hh) * 4) = (f32x4){m[4 * g], m[4 * g + 1], m[4 * g + 2], m[4 * g + 3]}; }
          if (prod == 0) nt_store_bf16(L + L_MBH, p, qq, hh, m);
          else nt_store_bf16(L + L_MKA, p, qq, hh, m); }
        { const f32x16 v = nt_quad(L + L_RT, L + (prod ? L_KT : L_BT), qp, qq, r, hh); f32x16 m;
#pragma unroll
          for (int e = 0; e < 16; ++e) m[e] = nt_q(qq, e, hh) <= p ? v[e] : 0.f;
          nt_store_bf16(L + (prod ? L_MKRT : L_MBRT), p, qq, hh, m); }
        WG_BAR();
        { const int t = 8 * wave + (lane >> 3), g = lane & 7, base = 32 * (t >> 5); float T4[4] = {0.f, 0.f, 0.f, 0.f};
          const LAS unsigned char* mrow = L + L_MBA + (base + 4 * g) * 4;
          f32x4 m = *(const LAS f32x4*)(mrow + (base + 31) * CPF);
#pragma unroll 1
          for (int Sx = 7; Sx >= 0; --Sx) {
#pragma unroll
              for (int q = 3; q >= 0; --q) { const int sl = 4 * Sx + q, sr = base + sl, sn = sl > 0 ? sr - 1 : sr; const f32x4 n = *(const LAS f32x4*)(mrow + sn * CPF);
                  float part = (m[0] * T4[0] + m[1] * T4[1]) + (m[2] * T4[2] + m[3] * T4[3]);
                  part += dpp_f<0xB1>(part); part += dpp_f<0x4E>(part); part += dpp_f<0x141>(part);
                  const float val = (sr == t) ? 1.0f : part; T4[q] = (g == Sx) ? val : T4[q]; m = n; } }
          const unsigned w0 = pk2(T4[0], T4[1]), w1 = pk2(T4[2], T4[3]);
          *(LAS u32x2*)(L + L_TT + t * CP + (base + 4 * g) * 2) = (u32x2){w0, w1};
          if (base == 0) { *(LAS u32x2*)(L + L_TT + t * CP + (32 + 4 * g) * 2) = (u32x2){0u, 0u};
              *(LAS bf16_t*)(L + L_TD + (4 * g) * CP + 2 * t) = (bf16_t)(w0 & 0xffffu); *(LAS bf16_t*)(L + L_TD + (4 * g + 1) * CP + 2 * t) = (bf16_t)(w0 >> 16);
              *(LAS bf16_t*)(L + L_TD + (4 * g + 2) * CP + 2 * t) = (bf16_t)(w1 & 0xffffu); *(LAS bf16_t*)(L + L_TD + (4 * g + 3) * CP + 2 * t) = (bf16_t)(w1 >> 16); } }
        WG_BAR();
        if (wave == 0) {
            f32x16 acc;
#pragma unroll
            for (int e = 0; e < 16; ++e) acc[e] = 0.f;
#pragma unroll
            for (int ks = 0; ks < 2; ++ks) { const bf16x8 a = *(const LAS bf16x8*)(L + L_MBH + r * CP + 64 + 32 * ks + 16 * hh), b = *(const LAS bf16x8*)(L + L_TT + (32 + r) * CP + 64 + 32 * ks + 16 * hh);
                acc = __builtin_amdgcn_mfma_f32_32x32x16_bf16(a, b, acc, 0, 0, 0); }
            nt_store_bf16(L + L_PT, r, 0, hh, acc);
            LDS_WAIT(); asm volatile("" ::: "memory");
#pragma unroll
            for (int e = 0; e < 16; ++e) acc[e] = 0.f;
#pragma unroll
            for (int ks = 0; ks < 2; ++ks) { const bf16x8 a = *(const LAS bf16x8*)(L + L_TD + r * CP + 32 * ks + 16 * hh), b = *(const LAS bf16x8*)(L + L_PT + r * CP + 32 * ks + 16 * hh);
                acc = __builtin_amdgcn_mfma_f32_32x32x16_bf16(a, b, acc, 0, 0, 0); }
            nt_store_bf16(L + L_TT, 32 + r, 0, hh, acc);
        }
        WG_BAR();
        { const f32x16 v = nt_quad(L + (prod ? L_MKA : L_ATT), L + L_TT, qp, qq, r, hh);
          nt_store_bf16(L + (prod ? L_A2 : L_A1), p, qq, hh, v); }
        WG_BAR();
        unsigned char* cw = CHW + (size_t)item * CHW_ITEM;
        { const f32x16 v = nt_quad(L + L_MBRT, L + (prod ? L_A2 : L_A1), qp, qq, r, hh); f32x16 o;
          const LAS unsigned char* addm = L + (prod ? L_MKRT : L_RT);
#pragma unroll
          for (int g = 0; g < 4; ++g) { const u32x2 w = *(const LAS u32x2*)(addm + p * CP + (32 * qq + 8 * g + 4 * hh) * 2); o[4 * g] = v[4 * g] + bflo(w.x); o[4 * g + 1] = v[4 * g + 1] + bfhi(w.x); o[4 * g + 2] = v[4 * g + 2] + bflo(w.y); o[4 * g + 3] = v[4 * g + 3] + bfhi(w.y); }
          if (prod) nt_store_bf16(L + L_Y2T, p, qq, hh, o);
          else {
#pragma unroll
              for (int g = 0; g < 4; ++g) { u32x2 w; w.x = pk2(o[4 * g], o[4 * g + 1]); w.y = pk2(o[4 * g + 2], o[4 * g + 3]); *(u32x2*)(cw + (size_t)p * 128 + (32 * qq + 8 * g + 4 * hh) * 2) = w; } } }
        { const f32x16 v = nt_quad(L + L_BTT, L + (prod ? L_A2 : L_A1), qp, qq, r, hh); const float pc = ((const LAS float*)(L + L_PC))[p]; f32x16 o;
          if (prod) {
#pragma unroll
              for (int e = 0; e < 16; ++e) o[e] = (v[e] + bf1(*(const LAS bf16_t*)(L + L_KT + nt_q(qq, e, hh) * CP + 2 * p))) * pc;
              nt_store_bf16(L + L_G2T, p, qq, hh, o); }
          else {
#pragma unroll
              for (int e = 0; e < 16; ++e) o[e] = (v[e] + (nt_q(qq, e, hh) == p ? 1.0f : 0.0f)) * pc;
#pragma unroll
              for (int g = 0; g < 4; ++g) { u32x2 w; w.x = pk2(o[4 * g], o[4 * g + 1]); w.y = pk2(o[4 * g + 2], o[4 * g + 3]); *(u32x2*)(cw + 8192 + (size_t)p * 128 + (32 * qq + 8 * g + 4 * hh) * 2) = w; } } }
        WG_BAR();
        { const f32x16 v = prod ? nt_quad(L + L_V, L + L_G2T, qp, qq, r, hh) : nt_quad(L + L_Y2T, L + L_V, qp, qq, r, hh);
          float* dst = prod ? (float*)(cw + 16384) + (size_t)p * 64 : Yg + (size_t)(t0 + p) * RW + hc;
#pragma unroll
          for (int g = 0; g < 4; ++g) *(f32x4*)(dst + 32 * qq + 8 * g + 4 * hh) = (f32x4){v[4 * g], v[4 * g + 1], v[4 * g + 2], v[4 * g + 3]}; }
        WG_BAR();
    }
}
__device__ __forceinline__ void ph5_chain(ArgsP A, Frame& F, int h) {
    unsigned char* ws = A->ws; float* Yg = (float*)(ws + WS_Y); const unsigned char* CHW = ws + WS_WIN;
    LAS unsigned char* L = F.lds + RING_OFF; const int wave = F.wave, lane = F.lane, tid = F.tid, r = lane & 31, hh = lane >> 5;
    const int prod = wave >> 2, qp = (wave >> 1) & 1, qq = wave & 1, p = 32 * qp + r; const size_t hc = (size_t)h * RN;
    constexpr int L_S = 0, L_G = 2 * 9216, L_Y1 = 3 * 9216;
    for (int i = tid; i < 2 * 9216 / 4; i += NTHR) ((LAS unsigned*)(L + L_S))[i] = 0u;
    const int srow = tid >> 3, sc16 = tid & 7; u32x4 sg, sy;
    auto stage_ld = [&](int c) { const unsigned char* cw = CHW + (size_t)(h * NCHK + c) * CHW_ITEM; sy = *(const u32x4*)(cw + srow * 128 + sc16 * 16); sg = *(const u32x4*)(cw + 8192 + srow * 128 + sc16 * 16); };
    f32x4 nad[4];
    auto ad_ld = [&](int c) { const unsigned char* cw2 = CHW + (size_t)(h * NCHK + c) * CHW_ITEM; const float* addp = prod ? Yg + (size_t)(c * CK + p) * RW + hc : (const float*)(cw2 + 16384) + (size_t)p * 64;
#pragma unroll
        for (int g = 0; g < 4; ++g) nad[g] = *(const f32x4*)(addp + 32 * qq + 8 * g + 4 * hh); };
    stage_ld(0); ad_ld(0);
    int sb = 0;
    for (int c = 0; c < NCHK; ++c) {
        *(LAS u32x4*)(L + L_Y1 + srow * CP + sc16 * 16) = sy; *(LAS u32x4*)(L + L_G + srow * CP + sc16 * 16) = sg;
        const unsigned char* cw = CHW + (size_t)(h * NCHK + c) * CHW_ITEM;
        f32x4 ad[4];
#pragma unroll
        for (int g = 0; g < 4; ++g) ad[g] = nad[g];
        if (c + 1 < NCHK) { stage_ld(c + 1); ad_ld(c + 1); }
        WG_BAR();
        const f32x16 v = prod ? nt_quad(L + L_Y1, L + L_S + sb * 9216, qp, qq, r, hh) : nt_quad(L + L_S + sb * 9216, L + L_G, qp, qq, r, hh);
        f32x16 o;
#pragma unroll
        for (int g = 0; g < 4; ++g) { o[4 * g] = v[4 * g] + ad[g][0]; o[4 * g + 1] = v[4 * g + 1] + ad[g][1]; o[4 * g + 2] = v[4 * g + 2] + ad[g][2]; o[4 * g + 3] = v[4 * g + 3] + ad[g][3]; }
        if (prod) { float* yp = Yg + (size_t)(c * CK + p) * RW + hc;
#pragma unroll
            for (int g = 0; g < 4; ++g) *(f32x4*)(yp + 32 * qq + 8 * g + 4 * hh) = (f32x4){o[4 * g], o[4 * g + 1], o[4 * g + 2], o[4 * g + 3]}; }
        else nt_store_bf16(L + L_S + (sb ^ 1) * 9216, p, qq, hh, o);
        sb ^= 1;
        WG_BAR();
    }
}

__device__ __forceinline__ void ph5_ypost(ArgsP A, Frame& F) {
    unsigned char* ws = A->ws; const float* Y = (const float*)(ws + WS_Y); const bf16_t* ZR = (const bf16_t*)(ws + WS_ZR); const bf16_t* KP = (const bf16_t*)(ws + WS_KP); const bf16_t* ZV = (const bf16_t*)(ws + WS_ZV);
    const bf16_t* G = (const bf16_t*)(ws + WS_G); bf16_t* YA = (bf16_t*)(ws + WS_YA);
    const int gw = F.vcu * NWAVES + F.wave, NGW = F.G * NWAVES;
    for (int tg = F.vcu; tg < T / 32; tg += F.G) for (int it = F.wave; it < 256; it += NWAVES) { const int t = tg * 32 + (it >> 3), c = (it & 7) * 256 + 4 * F.lane; const size_t o = (size_t)t * RW + c;
        const f32x4 y = *(const f32x4*)(Y + o); const float mean = sum16((y[0] + y[1]) + (y[2] + y[3])) * (1.0f / 64.0f); const f32x4 d = y - mean;
        const float var = sum16((d[0] * d[0] + d[1] * d[1]) + (d[2] * d[2] + d[3] * d[3])) * (1.0f / 64.0f); const float rs = 1.0f / sqrtf(var + LNX_EPS);
        const f32x4 r = ld4bf(ZR + o), k = ld4bf(KP + o), v = ld4bf(ZV + o), g = ld4bf(G + o), rk = *(const f32x4*)(A->r_k + c), lg = *(const f32x4*)(A->lnx_g + c), lb = *(const f32x4*)(A->lnx_b + c);
        const f32x4 rkk = r * k * rk; const float bonus = sum16((rkk[0] + rkk[1]) + (rkk[2] + rkk[3]));
        st4bf(YA + o, (d * rs * lg + lb + bonus * v) * g); }
}

constexpr int AT_KB = 64 * 256, AT_VB = 128 * 128, AT_BUF = AT_KB + AT_VB;
static_assert(3 * AT_BUF <= RING_BYTES, "attention LDS");
__device__ __forceinline__ void q8_load(u32x4 (&q)[8], const void* p) {
    asm volatile("global_load_dwordx4 %0, %8, off\n\tglobal_load_dwordx4 %1, %8, off offset:32\n\tglobal_load_dwordx4 %2, %8, off offset:64\n\tglobal_load_dwordx4 %3, %8, off offset:96\n\t"
                 "global_load_dwordx4 %4, %8, off offset:128\n\tglobal_load_dwordx4 %5, %8, off offset:160\n\tglobal_load_dwordx4 %6, %8, off offset:192\n\tglobal_load_dwordx4 %7, %8, off offset:224"
                 : "=&v"(q[0]), "=&v"(q[1]), "=&v"(q[2]), "=&v"(q[3]), "=&v"(q[4]), "=&v"(q[5]), "=&v"(q[6]), "=&v"(q[7]) : "v"(p) : "memory"); }
__device__ __forceinline__ void q8_settle(u32x4 (&q)[8]) {
#pragma unroll
    for (int i = 0; i < 8; ++i) asm volatile("" : "+v"(q[i])); }
__device__ __forceinline__ unsigned u16_load(const void* p) { unsigned v; asm volatile("global_load_ushort %0, %1, off" : "=&v"(v) : "v"(p) : "memory"); return v; }
__device__ __forceinline__ void ph5_attn(ArgsP A, Frame& F) {
    unsigned char* ws = A->ws; const bf16_t* PROJ = (const bf16_t*)(ws + WS_PROJ); const bf16_t* VT = (const bf16_t*)(ws + WS_VT); const bf16_t* KBp = (const bf16_t*)(ws + WS_KB);
    bf16_t* PO = (bf16_t*)(ws + WS_PARTO); float* PML = (float*)(ws + WS_PARTML); const unsigned short* LST = (const unsigned short*)(ws + WS_LIST); const unsigned* UD = (const unsigned*)(ws + WS_UDESC);
    LAS unsigned char* L = F.lds + RING_OFF; const int wave = F.wave, lane = F.lane, r = lane & 31, hh = lane >> 5;
    const float NEG = -__builtin_inff();
    const int NA = MH * NBLK, N = NA + (int)UD[0], w = F.vcu, nfree = F.G - RH; const bool chainwg = w < RH;
    auto unit_of = [&](int k) { return k * nfree + (w - RH); };
    int k = 0;
    if (chainwg) return;
    if (unit_of(k) >= N) return;
    int h, kblk, qtok, slot; bool typeA, valid, wvalid;
    { const int u = unit_of(k); typeA = u < NA;
      if (typeA) { h = u & 15; kblk = u >> 4; qtok = kblk * MBLK + wave * 32 + r; slot = 3; valid = true; wvalid = true; }
      else { const unsigned d = UD[1 + 2 * (u - NA)]; const int cnt = (int)UD[2 + 2 * (u - NA)]; const int Lx = (int)(d & 0xffffu), ps = (int)(d >> 16); h = Lx >> 5; kblk = Lx & 31;
          const int idx = ps * 256 + wave * 32 + r; valid = idx < cnt; wvalid = ps * 256 + wave * 32 < cnt; unsigned e = u16_load(LST + (size_t)Lx * 8192 + (valid ? idx : 0));
          asm volatile("s_waitcnt vmcnt(0)" ::: "memory"); asm volatile("" : "+v"(e)); qtok = (int)(e & 0x1fffu); slot = (int)(e >> 13); }
      h = __builtin_amdgcn_readfirstlane(h); kblk = __builtin_amdgcn_readfirstlane(kblk); }
    u32x4 qf[8], qfn[8];
    q8_load(qf, PROJ + (size_t)qtok * PLD + PC_MQ + h * MD + 8 * hh);
    const int krow_ = lane >> 4, kslot = lane & 15, vrow_ = lane >> 3, vslot = lane & 7;
    auto dma_tile = [&](int hd, int kb_, int n, int b3) { const int tb = kb_ * MBLK + n * 64; LAS unsigned char* B = L + b3 * AT_BUF;
#pragma unroll
        for (int i = 0; i < 2; ++i) { const int p = wave * 2 + i, row = 4 * p + krow_, c = kslot ^ (row & 15);
            __builtin_amdgcn_global_load_lds((const unsigned*)(KBp + ((size_t)hd * T + tb + row) * MD + 8 * c), (LAS unsigned*)(B + p * 1024), 16, 0, 0); }
#pragma unroll
        for (int i = 0; i < 2; ++i) { const int p = wave * 2 + i, row = 8 * p + vrow_, c = vslot ^ ((row >> 1) & 7);
            __builtin_amdgcn_global_load_lds((const unsigned*)(VT + ((size_t)(hd * (T / 64) + kb_ * 4 + n) * MD + row) * 64 + 8 * c), (LAS unsigned*)(B + AT_KB + p * 1024), 16, 0, 0); } };
    dma_tile(h, kblk, 0, 0); dma_tile(h, kblk, 1, 1);
    asm volatile("s_waitcnt vmcnt(4)" ::: "memory"); q8_settle(qf); WG_BAR();
    int b3 = 0;
    for (;;) {
        const int un = unit_of(k + 1); const bool has_next = un < N, nA = un < NA;
        int hN = 0, kblkN = 0, qtokN = 0, slotN = 3, LxN = 0, idxN = 0, cntN = 0; bool validN = true, wvalidN = true; unsigned udw = 0u, udc = 0u, entN = 0u;
        f32x16 o[4];
#pragma unroll
        for (int db = 0; db < 4; ++db)
#pragma unroll
            for (int e = 0; e < 16; ++e) o[db][e] = 0.f;
        float mrun = NEG, lrun = 0.f;
#pragma unroll
        for (int n = 0; n < 4; ++n) {
            if (has_next) {
                if (n == 0) { if (nA) { hN = un & 15; kblkN = un >> 4; } else { udw = UD[1 + 2 * (un - NA)]; udc = UD[2 + 2 * (un - NA)]; } }
                if (n == 1) { if (nA) { qtokN = kblkN * MBLK + wave * 32 + r; } else { LxN = (int)(udw & 0xffffu); const int ps = (int)(udw >> 16); cntN = (int)udc; hN = LxN >> 5; kblkN = LxN & 31;
                                  idxN = ps * 256 + wave * 32 + r; validN = idxN < cntN; wvalidN = ps * 256 + wave * 32 < cntN; entN = u16_load(LST + (size_t)LxN * 8192 + (validN ? idxN : 0)); }
                              hN = __builtin_amdgcn_readfirstlane(hN); kblkN = __builtin_amdgcn_readfirstlane(kblkN); }
                if (n == 2) { if (!nA) { qtokN = (int)(entN & 0x1fffu); slotN = (int)(entN >> 13); }
                              q8_load(qfn, PROJ + (size_t)qtokN * PLD + PC_MQ + hN * MD + 8 * hh); }
            }
            const int bn = b3 >= 1 ? b3 - 1 : 2; bool issued = false;
            if (n < 2) { dma_tile(h, kblk, n + 2, bn); issued = true; } else if (has_next) { dma_tile(hN, kblkN, n - 2, bn); issued = true; }
            const bool need = typeA ? (n <= (wave >> 1)) : wvalid;
            if (need) {
                const LAS unsigned char* KB = L + b3 * AT_BUF; const LAS unsigned char* VB = KB + AT_KB;
                f32x16 s[2];
#pragma unroll
                for (int kb = 0; kb < 2; ++kb) {
#pragma unroll
                    for (int e = 0; e < 16; ++e) s[kb][e] = 0.f;
#pragma unroll
                    for (int ks = 0; ks < 8; ++ks) { const bf16x8 a = *(const LAS bf16x8*)(KB + (32 * kb + r) * 256 + (((2 * ks + hh) ^ (r & 15)) << 4)); s[kb] = __builtin_amdgcn_mfma_f32_32x32x16_bf16(a, __builtin_bit_cast(bf16x8, qf[ks]), s[kb], 0, 0, 0); } }
                if (typeA && 64 * n + 63 > wave * 32) { const int qrel = wave * 32 + r;
#pragma unroll
                    for (int kb = 0; kb < 2; ++kb)
#pragma unroll
                        for (int e = 0; e < 16; ++e) { const int krel = 64 * n + 32 * kb + (e & 3) + 8 * (e >> 2) + 4 * hh; if (krel > qrel) s[kb][e] = NEG; } }
                float mx = s[0][0];
#pragma unroll
                for (int kb = 0; kb < 2; ++kb)
#pragma unroll
                    for (int e = 0; e < 16; ++e) mx = fmaxf(mx, s[kb][e]);
                mx = fmaxf(mx, __shfl_xor(mx, 32));
                const float mnew = fmaxf(mrun, mx); const float alpha = __builtin_amdgcn_exp2f(mrun - mnew); mrun = mnew;
                float ps = 0.f;
#pragma unroll
                for (int kb = 0; kb < 2; ++kb)
#pragma unroll
                    for (int e = 0; e < 16; ++e) { const float p = __builtin_amdgcn_exp2f(s[kb][e] - mnew); s[kb][e] = p; ps += p; }
                lrun = lrun * alpha + ps;
                if (__ballot(alpha != 1.0f) != 0ull) {
#pragma unroll
                    for (int db = 0; db < 4; ++db)
#pragma unroll
                        for (int e = 0; e < 16; ++e) o[db][e] *= alpha; }
#pragma unroll
                for (int kb = 0; kb < 2; ++kb)
#pragma unroll
                    for (int st = 0; st < 2; ++st) { u32x4 pw; pw.x = pk2(s[kb][8 * st + 0], s[kb][8 * st + 1]); pw.y = pk2(s[kb][8 * st + 2], s[kb][8 * st + 3]); pw.z = pk2(s[kb][8 * st + 4], s[kb][8 * st + 5]); pw.w = pk2(s[kb][8 * st + 6], s[kb][8 * st + 7]);
                        const bf16x8 pf = __builtin_bit_cast(bf16x8, pw);
#pragma unroll
                        for (int db = 0; db < 4; ++db) { const bf16x8 vf = *(const LAS bf16x8*)(VB + (32 * db + r) * 128 + (((4 * kb + 2 * st + hh) ^ ((r >> 1) & 7)) << 4));
                            o[db] = __builtin_amdgcn_mfma_f32_32x32x16_bf16(vf, pf, o[db], 0, 0, 0); } }
            }
            if (issued) asm volatile("s_waitcnt vmcnt(4)" ::: "memory"); else asm volatile("s_waitcnt vmcnt(0)" ::: "memory");
            if (n == 1) asm volatile("" : "+v"(entN));
            if (n == 2) q8_settle(qfn);
            b3 = b3 == 2 ? 0 : b3 + 1;
            WG_BAR();
        }
        { const float ltot = lrun + __shfl_xor(lrun, 32);
          if (valid) { const float inv = 1.0f / ltot; const size_t pi = ((size_t)qtok * MH + h) * 4 + slot; bf16_t* op = PO + pi * MD;
#pragma unroll
            for (int db = 0; db < 4; ++db)
#pragma unroll
                for (int g = 0; g < 4; ++g) { u32x2 wv; wv.x = pk2(o[db][4 * g] * inv, o[db][4 * g + 1] * inv); wv.y = pk2(o[db][4 * g + 2] * inv, o[db][4 * g + 3] * inv); *(u32x2*)(op + 32 * db + 8 * g + 4 * hh) = wv; }
            if (hh == 0) *(f32x2*)(PML + pi * 2) = (f32x2){mrun, ltot}; } }
        if (!has_next) break;
        h = hN; kblk = kblkN; qtok = qtokN; slot = slotN; typeA = nA; valid = nA ? true : validN; wvalid = nA ? true : wvalidN; ++k;
#pragma unroll
        for (int ks = 0; ks < 8; ++ks) qf[ks] = qfn[ks];
    }
}
__device__ __forceinline__ void ph6_merge(ArgsP A, Frame& F) {
    unsigned char* ws = A->ws; const bf16_t* PO = (const bf16_t*)(ws + WS_PARTO); const float* PML = (const float*)(ws + WS_PARTML); bf16_t* YB = (bf16_t*)(ws + WS_YB);
    const int gw = F.vcu * NWAVES + F.wave, NGW = F.G * NWAVES, hl = F.lane >> 5, dg = F.lane & 31;
    for (int it0 = gw * 4; it0 < T * 8; it0 += NGW * 4) {
        u32x2 ov[4][4]; f32x2 ml[4][4];
#pragma unroll
        for (int k = 0; k < 4; ++k) { const int it = it0 + k, t = it >> 3, h = 2 * (it & 7) + hl; const size_t pi = ((size_t)t * MH + h) * 4;
#pragma unroll
            for (int sl = 0; sl < 4; ++sl) { ov[k][sl] = *(const u32x2*)(PO + (pi + sl) * MD + 4 * dg); ml[k][sl] = *(const f32x2*)(PML + (pi + sl) * 2); } }
#pragma unroll
        for (int k = 0; k < 4; ++k) { const int it = it0 + k, t = it >> 3, h = 2 * (it & 7) + hl, blk = t >> 8, nsel = blk < 3 ? blk : 3;
            float mmax = ml[k][3][0];
#pragma unroll
            for (int sl = 0; sl < 3; ++sl) if (sl < nsel) mmax = fmaxf(mmax, ml[k][sl][0]);
            f32x4 acc = (f32x4){0.f, 0.f, 0.f, 0.f}; float wsum = 0.f;
#pragma unroll
            for (int sl = 0; sl < 4; ++sl) { if (sl == 3 || sl < nsel) { const float w = ml[k][sl][1] * __builtin_amdgcn_exp2f(ml[k][sl][0] - mmax); wsum += w;
                acc += w * (f32x4){bflo(ov[k][sl].x), bfhi(ov[k][sl].x), bflo(ov[k][sl].y), bfhi(ov[k][sl].y)}; } }
            const float inv = 1.0f / wsum; st4bf(YB + (size_t)t * RW + h * MD + 4 * dg, acc * inv); }
    }
}

__device__ __forceinline__ void ins16(float (&top)[16], float x) {
#pragma unroll
    for (int k = 15; k >= 1; --k) top[k] = __builtin_amdgcn_fmed3f(top[k - 1], top[k], x);
    top[0] = fmaxf(top[0], x);
}
__device__ __forceinline__ void ph10_select(ArgsP A, Frame& F) {
    unsigned char* ws = A->ws; const bf16_t* PQ = (const bf16_t*)(ws + WS_PQ); const bf16_t* SK = (const bf16_t*)(ws + WS_SUBK); int* IDX = (int*)(ws + WS_IDX); float* GW = (float*)(ws + WS_GW);
    const int gw = F.vcu * NWAVES + F.wave, NGW = F.G * NWAVES; const int r = F.lane & 31, hh = F.lane >> 5; const float NEG = -__builtin_inff();
    for (int it = gw; it < (T / 32) * PH_; it += NGW) { const int tg = it >> 3, h = it & 7, t = tg * 32 + r;
        float TA[16], TB[16];
        auto topk = [&](int p, float (&dst)[16]) {
            bf16x8 qf[8];
#pragma unroll
            for (int ks = 0; ks < 8; ++ks) qf[ks] = *(const bf16x8*)(PQ + (size_t)t * 2048 + (h * 2 + p) * PHALF + 16 * ks + 8 * hh);
            float top[16];
#pragma unroll
            for (int k = 0; k < 16; ++k) top[k] = NEG;
#pragma unroll 1
            for (int nb = 0; nb < 4; ++nb) { f32x16 acc;
#pragma unroll
                for (int e = 0; e < 16; ++e) acc[e] = 0.f;
#pragma unroll
                for (int ks = 0; ks < 8; ++ks) { const bf16x8 a = *(const bf16x8*)(SK + ((size_t)(h * 2 + p) * PNK + 32 * nb + r) * PHALF + 16 * ks + 8 * hh); acc = __builtin_amdgcn_mfma_f32_32x32x16_bf16(a, qf[ks], acc, 0, 0, 0); }
#pragma unroll
                for (int e = 0; e < 16; ++e) { const unsigned key = 32 * nb + (e & 3) + 8 * (e >> 2) + 4 * hh; float ae = acc[e]; asm volatile("" : "+v"(ae));
                    const float x = __builtin_bit_cast(float, (__builtin_bit_cast(unsigned, ae) & ~0x7Fu) | key); ins16(top, x); } }
            float oth[16];
#pragma unroll
            for (int k = 0; k < 16; ++k) oth[k] = __shfl_xor(top[k], 32);
#pragma unroll
            for (int k = 0; k < 16; ++k) ins16(top, oth[k]);
#pragma unroll
            for (int k = 0; k < 16; ++k) dst[k] = top[k];
        };
        topk(0, TA); asm volatile("" ::: "memory"); __builtin_amdgcn_sched_barrier(0); topk(1, TB); asm volatile("" ::: "memory"); __builtin_amdgcn_sched_barrier(0);
        float fin[16];
#pragma unroll
        for (int k = 0; k < 16; ++k) fin[k] = NEG;
#pragma unroll
        for (int i = 0; i < 16; ++i)
#pragma unroll
            for (int j = 0; j < 16; ++j) if ((i + 1) * (j + 1) <= 16) { const float sm = TA[i] + TB[j]; ins16(fin, __builtin_bit_cast(float, (__builtin_bit_cast(unsigned, sm) & ~0xFFu) | (unsigned)(i * 16 + j))); }
        float e[16], den = 0.f;
#pragma unroll
        for (int k = 0; k < 16; ++k) { e[k] = __expf(fin[k] - fin[0]); den += e[k]; }
        const float rden = 1.0f / den;
        int oi[8]; float og[8];
#pragma unroll
        for (int kk = 0; kk < 8; ++kk) { const float fv = hh ? fin[8 + kk] : fin[kk]; og[kk] = (hh ? e[8 + kk] : e[kk]) * rden; const unsigned id = __builtin_bit_cast(unsigned, fv) & 0xFFu; const unsigned ci = id >> 4, cj = id & 15u;
            unsigned ia = 0u, ib = 0u;
#pragma unroll
            for (int q = 0; q < 16; ++q) { ia = (ci == (unsigned)q) ? (__builtin_bit_cast(unsigned, TA[q]) & 0x7Fu) : ia; ib = (cj == (unsigned)q) ? (__builtin_bit_cast(unsigned, TB[q]) & 0x7Fu) : ib; }
            oi[kk] = (int)(ia * PNK + ib); }
        int* ip = IDX + (size_t)t * 128 + h * 16 + 8 * hh; float* gp = GW + (size_t)t * 128 + h * 16 + 8 * hh;
        *(u32x4*)ip = (u32x4){(unsigned)oi[0], (unsigned)oi[1], (unsigned)oi[2], (unsigned)oi[3]}; *(u32x4*)(ip + 4) = (u32x4){(unsigned)oi[4], (unsigned)oi[5], (unsigned)oi[6], (unsigned)oi[7]};
        *(f32x4*)gp = (f32x4){og[0], og[1], og[2], og[3]}; *(f32x4*)(gp + 4) = (f32x4){og[4], og[5], og[6], og[7]};
    }
}


__device__ __forceinline__ float ub0(unsigned w) { return (float)(w & 0xffu); }
__device__ __forceinline__ float ub1(unsigned w) { return (float)((w >> 8) & 0xffu); }
__device__ __forceinline__ float ub2(unsigned w) { return (float)((w >> 16) & 0xffu); }
__device__ __forceinline__ float ub3(unsigned w) { return (float)(w >> 24); }
__device__ __forceinline__ float dot16q(u32x4 q, const float (&h)[16]) {
    return ((ub0(q.x) * h[0] + ub1(q.x) * h[1]) + (ub2(q.x) * h[2] + ub3(q.x) * h[3])) + ((ub0(q.y) * h[4] + ub1(q.y) * h[5]) + (ub2(q.y) * h[6] + ub3(q.y) * h[7]))
         + ((ub0(q.z) * h[8] + ub1(q.z) * h[9]) + (ub2(q.z) * h[10] + ub3(q.z) * h[11])) + ((ub0(q.w) * h[12] + ub1(q.w) * h[13]) + (ub2(q.w) * h[14] + ub3(q.w) * h[15]));
}
__device__ __forceinline__ void ph11_gather(ArgsP A, Frame& F) {
    unsigned char* ws = A->ws; const bf16_t* H2 = (const bf16_t*)(ws + WS_H2); const unsigned char* PU = (const unsigned char*)(ws + WS_PU); const unsigned char* PV = (const unsigned char*)(ws + WS_PV);
    const float* PSU = (const float*)(ws + WS_PSU); const float* PSV = (const float*)(ws + WS_PSV);
    const int* IDX = (const int*)(ws + WS_IDX); const float* GW = (const float*)(ws + WS_GW); const float* X1 = (const float*)(ws + WS_X1);
    LAS float* coef = (LAS float*)(F.lds + RING_OFF); LAS int* eidx = (LAS int*)(F.lds + RING_OFF + 1024); LAS float* red = (LAS float*)(F.lds + RING_OFF + 2048);
    const int tid = F.tid, wave = F.wave, lane = F.lane; int par = 0;
    for (int t = F.vcu; t < T; t += F.G, par ^= 1) {
        float hv[4][16]; float hs = 0.f;
#pragma unroll
        for (int i = 0; i < 4; ++i) { const bf16_t* hp = H2 + (size_t)t * D + i * 1024 + lane * 16; f32x4 a, b, c, d; pg8::unpack8(*(const u32x4*)hp, a, b); pg8::unpack8(*(const u32x4*)(hp + 8), c, d);
#pragma unroll
            for (int e = 0; e < 4; ++e) { hv[i][e] = a[e]; hv[i][4 + e] = b[e]; hv[i][8 + e] = c[e]; hv[i][12 + e] = d[e]; }
            hs += ((a[0] + a[1]) + (a[2] + a[3])) + ((b[0] + b[1]) + (b[2] + b[3])) + ((c[0] + c[1]) + (c[2] + c[3])) + ((d[0] + d[1]) + (d[2] + d[3])); }
        hs = wave_sum(hs);
        const int myidx = (lane < 16) ? IDX[(size_t)t * 128 + wave * 16 + lane] : 0; const float myg = (lane < 16) ? GW[(size_t)t * 128 + wave * 16 + lane] : 0.f;
        float dots = 0.f;
#pragma unroll 1
        for (int k = 0; k < 16; k += 4) {
            u32x4 q[4][4];
#pragma unroll
            for (int x = 0; x < 4; ++x) { const int e = __builtin_amdgcn_readlane(myidx, k + x); const unsigned char* up = PU + (size_t)e * D + lane * 16;
#pragma unroll
                for (int i = 0; i < 4; ++i) q[x][i] = *(const u32x4*)(up + i * 1024); }
#pragma unroll
            for (int x = 0; x < 4; ++x) { float d = 0.f;
#pragma unroll
                for (int i = 0; i < 4; ++i) d += dot16q(q[x][i], hv[i]);
                d = wave_sum(d); if (lane == k + x) dots = d; }
        }
        if (lane < 16) { const float s = PSU[myidx] * (dots - 128.0f * hs); const float act = 0.5f * s * (1.0f + erff(s * 0.70710678118654752f));
            coef[par * 128 + wave * 16 + lane] = myg * act * PSV[myidx]; eidx[par * 128 + wave * 16 + lane] = myidx; }
        WG_BAR();
        float acc[8]; float csum = 0.f;
#pragma unroll
        for (int i = 0; i < 8; ++i) acc[i] = 0.f;
#pragma unroll 1
        for (int e = 0; e < 128; e += 16) { u32x2 v[16]; float c[16];
#pragma unroll
            for (int q = 0; q < 16; ++q) { const int ei = __builtin_amdgcn_readfirstlane(eidx[par * 128 + e + q]); c[q] = coef[par * 128 + e + q]; v[q] = *(const u32x2*)(PV + (size_t)ei * D + tid * 8); }
#pragma unroll
            for (int q = 0; q < 16; ++q) { csum += c[q]; acc[0] += c[q] * ub0(v[q].x); acc[1] += c[q] * ub1(v[q].x); acc[2] += c[q] * ub2(v[q].x); acc[3] += c[q] * ub3(v[q].x); acc[4] += c[q] * ub0(v[q].y); acc[5] += c[q] * ub1(v[q].y); acc[6] += c[q] * ub2(v[q].y); acc[7] += c[q] * ub3(v[q].y); } }
        const float corr = -128.0f * csum;
        const f32x4 x0 = *(const f32x4*)(X1 + (size_t)t * D + tid * 8), x1 = *(const f32x4*)(X1 + (size_t)t * D + tid * 8 + 4);
        f32x4 y0 = x0 + ((f32x4){acc[0], acc[1], acc[2], acc[3]} + corr), y1 = x1 + ((f32x4){acc[4], acc[5], acc[6], acc[7]} + corr);
        float ss = (y0[0] * y0[0] + y0[1] * y0[1]) + (y0[2] * y0[2] + y0[3] * y0[3]) + (y1[0] * y1[0] + y1[1] * y1[1]) + (y1[2] * y1[2] + y1[3] * y1[3]);
        ss = wave_sum(ss); if (lane == 0) red[par * 8 + wave] = ss;
        WG_BAR();
        float tot = 0.f;
#pragma unroll
        for (int w = 0; w < 8; ++w) tot += red[par * 8 + w];
        const float rs = 1.0f / sqrtf(tot * (1.0f / D) + NORM_EPS);
        const f32x4 g0 = *(const f32x4*)(A->final_g + tid * 8), g1 = *(const f32x4*)(A->final_g + tid * 8 + 4);
        *(f32x4*)(A->out + (size_t)t * D + tid * 8) = y0 * rs * g0; *(f32x4*)(A->out + (size_t)t * D + tid * 8 + 4) = y1 * rs * g1;
    }
}

constexpr int NPH = 13;
__device__ __forceinline__ Frame make_frame(unsigned char* lds) {
    Frame F; int t = threadIdx.x; asm volatile("" : "+v"(t));
    F.lds = (LAS unsigned char*)lds; F.tid = t; F.lane = t & 63; F.wave = __builtin_amdgcn_readfirstlane(t >> 6);
    F.G = gridDim.x; { const int bx = blockIdx.x; F.vcu = (F.G % 8 == 0) ? (bx % 8) * (F.G / 8) + bx / 8 : bx; }
    return F;
}
__global__ void __launch_bounds__(NTHR, 2) mk_fwd(Args args_by_value) {
    extern __shared__ __attribute__((aligned(16))) unsigned char lds[];
    ArgsP args = get_args();
    gu32* ctl = (gu32*)(args->ws + WS_CTL);
    for (int u = threadIdx.x; u < (LDS_BYTES - LDSCTL_OFF) / 4; u += NTHR) ((LAS unsigned*)((LAS unsigned char*)lds + LDSCTL_OFF))[u] = 0u;
    __syncthreads();
    const int lo = args->ph_lo, hi = args->ph_hi;
    volatile LAS unsigned* MISC = (volatile LAS unsigned*)((LAS unsigned char*)lds + MISC_OFF);
    XcdBarrier bar; bar.bar = (unsigned*)(ctl + CW_BAR) + args->li * XCD_BAR_WORDS; bar.x = 0; bar.st = nullptr;
    if (hi - lo > 1) bar = xcd_barrier_post((unsigned*)(ctl + CW_BAR) + args->li * XCD_BAR_WORDS, MISC + 8);
#define IN(k) (lo <= (k) && (k) < hi)
#define SEAM(k) do { if (IN(k) && IN((k) + 1)) xcd_barrier(bar); } while (0)
    const int bid = (int)blockIdx.x;

    if (IN(0)) { Frame F = make_frame(lds); ph0_prologue(get_args(), F); SEAM(0); }
    if (IN(1)) { Frame F = make_frame(lds); LAS unsigned char* ring = F.lds + RING_OFF; ArgsP a_ = get_args(); unsigned char* ws = a_->ws;
        { pg8::Gemm g{(const bf16_t*)(ws + WS_XN), (const bf16_t*)(ws + WS_WIN), T, PLD, D}; pg8::StaticOrder S; S.init(T, PLD, F.G, bid);
          pg8::EpiProj E{(bf16_t*)(ws + WS_PROJ), (const float*)(ws + WS_ROPE), (bf16_t*)(ws + WS_KB)}; pg8::gemm_phase<pg8::EpiProj, pg8::StaticOrder, true, true>(ring, g, S, E); }
        { pg8::Gemm g{(const bf16_t*)(ws + WS_XN), (const bf16_t*)(ws + WS_WIN) + (size_t)PC_MV * D, T, 2048, D}; pg8::StaticOrder S; S.init(T, 2048, F.G, bid);
          pg8::EpiVT E{(bf16_t*)(ws + WS_VT)}; pg8::gemm_phase<pg8::EpiVT, pg8::StaticOrder, true, true>(ring, g, S, E); }
        { constexpr int NT1 = (T / 256) * (PLD / 256); const int nx = NT1 % F.G;
          if (bid >= nx) { WG_BAR(); { Frame F2 = make_frame(lds); late_weights(get_args(), F2, (bid - nx) * NWAVES + F2.wave, (F2.G - nx) * NWAVES); }
              if (nx) { Frame F2 = make_frame(lds); peer_quant(get_args(), F2, 0, pq_ra(F2.G), (bid - nx) * NWAVES + F2.wave, (F2.G - nx) * NWAVES); } } }
        SEAM(1); }
    if (IN(2)) { Frame F = make_frame(lds); ph2_prep(get_args(), F); SEAM(2); }
    if (IN(3)) { Frame F = make_frame(lds); LAS unsigned char* ring = F.lds + RING_OFF; ArgsP a_ = get_args(); unsigned char* ws = a_->ws;
        { pg8::Gemm g{(const bf16_t*)(ws + WS_AW), (const bf16_t*)(ws + WS_WUP), T, RW, LW}; pg8::StaticOrder S; S.init(T, RW, F.G, bid);
          pg8::EpiDec E{(float*)(ws + WS_DEC), a_->w0}; pg8::gemm_phase<pg8::EpiDec, pg8::StaticOrder, true, true>(ring, g, S, E); }
        asm volatile("" ::: "memory"); __builtin_amdgcn_sched_barrier(0);
        { pg8::Gemm g{(const bf16_t*)(ws + WS_AA), (const bf16_t*)(ws + WS_AUP), T, RW, LA}; pg8::StaticOrder S; S.init(T, RW, F.G, bid);
          pg8::EpiA E{(bf16_t*)(ws + WS_KP), (bf16_t*)(ws + WS_BB), (const bf16_t*)(ws + WS_KKN), a_->a0, a_->k_a}; pg8::gemm_phase<pg8::EpiA, pg8::StaticOrder, true, true>(ring, g, S, E); }
        asm volatile("" ::: "memory"); __builtin_amdgcn_sched_barrier(0);
        { pg8::Gemm g{(const bf16_t*)(ws + WS_AG), (const bf16_t*)(ws + WS_GUP), T, RW, LGP}; pg8::StaticOrder S; S.init(T, RW, F.G, bid);
          pg8::EpiBf16 E{(bf16_t*)(ws + WS_G), RW}; pg8::gemm_phase<pg8::EpiBf16, pg8::StaticOrder, true, true>(ring, g, S, E); }
        { Frame F2 = make_frame(lds); ph3_gate(get_args(), F2); }
        SEAM(3); }
    if (IN(4)) { Frame F = make_frame(lds); ph4_chunkprep(get_args(), F); SEAM(4); }
    if (IN(5)) {
        { Frame F = make_frame(lds); if (F.vcu < RH) ph5_chain(get_args(), F, F.vcu); }
        { Frame F = make_frame(lds); ph5_attn(get_args(), F); }
        { Frame F = make_frame(lds); if (F.vcu >= RH) peer_quant(get_args(), F, pq_ra(F.G), 2 * 16384, (F.vcu - RH) * NWAVES + F.wave, (F.G - RH) * NWAVES); }
        SEAM(5); }
    if (IN(6)) { { Frame F = make_frame(lds); ph6_merge(get_args(), F); } { Frame F = make_frame(lds); ph5_ypost(get_args(), F); } SEAM(6); }
    if (IN(7)) { Frame F = make_frame(lds); LAS unsigned char* ring = F.lds + RING_OFF; ArgsP a_ = get_args(); unsigned char* ws = a_->ws;
        { pg8::Gemm g{(const bf16_t*)(ws + WS_YA), (const bf16_t*)(ws + WS_WA), T, D, RW}; pg8::StaticOrder S; S.init(T, D, F.G, bid);
          pg8::EpiMix<false> E{(bf16_t*)(ws + WS_MIXED), (const bf16_t*)(ws + WS_PROJ), PC_GA}; pg8::gemm_phase<pg8::EpiMix<false>, pg8::StaticOrder, true, true>(ring, g, S, E); }
        { pg8::Gemm g{(const bf16_t*)(ws + WS_YB), (const bf16_t*)(ws + WS_WB), T, D, RW}; pg8::StaticOrder S; S.init(T, D, F.G, bid);
          pg8::EpiMix<true> E{(bf16_t*)(ws + WS_MIXED), (const bf16_t*)(ws + WS_PROJ), PC_GB}; pg8::gemm_phase<pg8::EpiMix<true>, pg8::StaticOrder, true, true>(ring, g, S, E); }
        SEAM(7); }
    if (IN(8)) { Frame F = make_frame(lds); LAS unsigned char* ring = F.lds + RING_OFF; ArgsP a_ = get_args(); unsigned char* ws = a_->ws;
        pg8::Gemm g{(const bf16_t*)(ws + WS_MIXED), (const bf16_t*)(ws + WS_WOUT), T, D, D}; pg8::StaticOrder S; S.init(T, D, F.G, bid);
        pg8::EpiRes E{(float*)(ws + WS_X1), a_->x}; pg8::gemm_phase<pg8::EpiRes, pg8::StaticOrder, true, true>(ring, g, S, E);
        SEAM(8); }
    if (IN(9)) { Frame F = make_frame(lds); ArgsP a_ = get_args(); unsigned char* ws = a_->ws; const int gw = F.vcu * NWAVES + F.wave, NGW = F.G * NWAVES;
        rms_rows_to_bf16((const float*)(ws + WS_X1), a_->norm2_g, (bf16_t*)(ws + WS_H2), gw, NGW, F.lane);
        SEAM(9); }
    if (IN(10)) { Frame F = make_frame(lds); LAS unsigned char* ring = F.lds + RING_OFF; ArgsP a_ = get_args(); unsigned char* ws = a_->ws;
        pg8::Gemm g{(const bf16_t*)(ws + WS_H2), (const bf16_t*)(ws + WS_WQ), T, 2048, D}; pg8::StaticOrder S; S.init(T, 2048, F.G, bid);
        pg8::EpiBf16 E{(bf16_t*)(ws + WS_PQ), 2048}; pg8::gemm_phase<pg8::EpiBf16, pg8::StaticOrder, true, true>(ring, g, S, E);
        SEAM(10); }
    if (IN(11)) { Frame F = make_frame(lds); ph10_select(get_args(), F); SEAM(11); }
    if (IN(12)) { Frame F = make_frame(lds); ph11_gather(get_args(), F); }
#undef IN
#undef SEAM
}

extern "C" void kernel_launch(void* const* d_in, const int* in_sizes, int n_in, void* d_out, int out_size, void* d_ws, size_t ws_size, hipStream_t stream) {
    static int grid = 0;
    if (grid == 0) {
        if (n_in != 23 || out_size != T * D || ws_size < WS_END) { fprintf(stderr, "kernel_launch: unexpected shapes (n_in %d out %d ws %zu); nothing launched\n", n_in, out_size, ws_size); grid = -1; return; }
        int dev = 0, cus = 0, per_cu = 0;
        if (hipGetDevice(&dev) != hipSuccess || hipDeviceGetAttribute(&cus, hipDeviceAttributeMultiprocessorCount, dev) != hipSuccess) { grid = -1; return; }
        if (hipFuncSetAttribute((const void*)mk_fwd, hipFuncAttributeMaxDynamicSharedMemorySize, LDS_BYTES) != hipSuccess) { grid = -1; return; }
        if (hipOccupancyMaxActiveBlocksPerMultiprocessor(&per_cu, (const void*)mk_fwd, NTHR, LDS_BYTES) != hipSuccess || per_cu < 1) fprintf(stderr, "kernel_launch: occupancy query reports %d\n", per_cu);
        (void)hipGetLastError();
        grid = cus;
    }
    if (grid < 0) return;
    (void)hipMemsetAsync((char*)d_ws + WS_CTL, 0, CTL_ZERO_BYTES, stream);
    Args a{};
    const float** ap = (const float**)&a;
    for (int i = 0; i < 23; ++i) ap[i] = (const float*)d_in[i];
    a.out = (float*)d_out; a.ws = (unsigned char*)d_ws; a.pad = 0;
    constexpr int NL = MK_N_LAUNCHES;
    for (int li = 0; li < NL; ++li) {
        a.ph_lo = (NL == 1) ? 0 : li; a.ph_hi = (NL == 1) ? NPH : li + 1; a.li = (NL == 1) ? 0 : 0;
        hipLaunchKernelGGL(mk_fwd, dim3(grid), dim3(NTHR), LDS_BYTES, stream, a);
#ifdef DUP_HI
        if (NL > 1 && li == DUP_HI) for (int l2 = DUP_LO; l2 <= DUP_HI; ++l2) { a.ph_lo = l2; a.ph_hi = l2 + 1; hipLaunchKernelGGL(mk_fwd, dim3(grid), dim3(NTHR), LDS_BYTES, stream, a); }
#endif
    }
}
```

```cpp
#include <hip/hip_runtime.h>
#include <cstdio>
#include <cstdint>

#ifndef MK_N_LAUNCHES
#define MK_N_LAUNCHES 1
#endif

#define GAS __attribute__((address_space(1)))
#define LAS __attribute__((address_space(3)))
typedef unsigned short bf16_t;
typedef __bf16 bf16x8 __attribute__((ext_vector_type(8)));
typedef float f32x2 __attribute__((ext_vector_type(2)));
typedef float f32x4 __attribute__((ext_vector_type(4)));
typedef float f32x16 __attribute__((ext_vector_type(16)));
typedef unsigned u32x2 __attribute__((ext_vector_type(2)));
typedef unsigned u32x4 __attribute__((ext_vector_type(4)));
typedef GAS unsigned gu32;

constexpr int T = 8192, D = 4096;
constexpr int RW = 2048, RH = 32, RN = 64;
constexpr int LW = 128, LA = 128, LG = 480, LGP = 512;
constexpr int SHIFTW = 6880;
constexpr int MH = 16, MD = 128, MBLK = 256, NBLK = 32;
constexpr int INW = 21216;
constexpr int PLD = 19200;
constexpr int PC_R = 0, PC_K = 2048, PC_V = 4096, PC_WL = 6144, PC_AL = 6272, PC_GL = 6400, PC_MQ = 6912, PC_MK = 8960, PC_GA = 11008, PC_GB = 15104, PC_MV = 19200;
constexpr int WIN_ROWS = 21248;
constexpr int PQ_SPLIT = 16384;
constexpr int PH_ = 8, PNK = 128, PQD = 256, PHALF = 128, PTOPK = 16;
constexpr float NORM_EPS = 1e-6f, LNX_EPS = 64e-5f;
constexpr float QSCALE = 0.08838834764831845f * 1.4426950408889634f;

constexpr size_t MiB = 1u << 20;
constexpr size_t WS_CTL = 0, CTL_ZERO_BYTES = 1 * MiB;
constexpr size_t WS_WIN = 1 * MiB;
constexpr size_t WS_X1 = 1 * MiB, WS_PQ = 129 * MiB;
constexpr size_t WS_WA = 167 * MiB, WS_WB = 183 * MiB, WS_WOUT = 199 * MiB, WS_WQ = 231 * MiB, WS_WUP = 247 * MiB, WS_AUP = 248 * MiB, WS_GUP = 249 * MiB, WS_SUBK = 251 * MiB;
constexpr size_t WS_PU = 252 * MiB, WS_PV = 380 * MiB;
constexpr size_t WS_XN = 508 * MiB;
constexpr size_t WS_Y = 508 * MiB, WS_H2 = 508 * MiB;
constexpr size_t WS_PROJ = 572 * MiB;
constexpr size_t WS_VT = 872 * MiB;
constexpr size_t WS_ROPE = 904 * MiB, WS_KMEAN = 908 * MiB, WS_MASK = 909 * MiB, WS_AW = 910 * MiB, WS_AA = 912 * MiB, WS_AG = 914 * MiB;
constexpr size_t WS_PSU = 909 * MiB + 512 * 1024, WS_PSV = WS_PSU + 64 * 1024;
constexpr size_t WS_DEC = 922 * MiB;
constexpr size_t WS_MIXED = 922 * MiB;
constexpr size_t WS_KKN = 986 * MiB, WS_BB = 1018 * MiB, WS_KP = 1050 * MiB, WS_ZR = 1082 * MiB, WS_ZV = 1114 * MiB, WS_G = 1146 * MiB;
constexpr size_t WS_YA = 1178 * MiB, WS_YB = 1210 * MiB, WS_IDX = 1242 * MiB, WS_GW = 1246 * MiB, WS_PARTML = 1250 * MiB, WS_LIST = 1254 * MiB, WS_UDESC = 1262 * MiB, WS_KB = 1267 * MiB, WS_END = 1299 * MiB;
constexpr size_t WS_PARTO = 922 * MiB;

constexpr int CW_TMO = 0, CW_CODE = 1, CW_ATTNQ = 64, CW_CNT = 1024, CW_BAR = 4096;

constexpr int RING_OFF = 0, RING_BYTES = 155648;
constexpr int LDSCTL_OFF = RING_BYTES, MISC_OFF = LDSCTL_OFF + 320;
constexpr int LDS_BYTES = 163840;
constexpr int NWAVES = 8, NTHR = 512;

__device__ __forceinline__ unsigned f2bf(float f) { unsigned u = __builtin_bit_cast(unsigned, f); return (u + 0x7fffu + ((u >> 16) & 1u)) >> 16; }
typedef __bf16 bf16x2 __attribute__((ext_vector_type(2)));
__device__ __forceinline__ unsigned pk2(float lo, float hi) { const f32x2 v = {lo, hi}; return __builtin_bit_cast(unsigned, __builtin_convertvector(v, bf16x2)); }
__device__ __forceinline__ float bflo(unsigned u) { return __builtin_bit_cast(float, u << 16); }
__device__ __forceinline__ float bfhi(unsigned u) { return __builtin_bit_cast(float, u & 0xffff0000u); }
__device__ __forceinline__ float bf1(bf16_t b) { return __builtin_bit_cast(float, (unsigned)b << 16); }
__device__ __forceinline__ float fsigmoid(float x) { return __builtin_amdgcn_rcpf(1.0f + __expf(-x)); }
__device__ __forceinline__ float wave_sum(float v) {
#pragma unroll
    for (int o = 1; o < 64; o <<= 1) v += __shfl_xor(v, o);
    return v;
}
template <int CTRL> __device__ __forceinline__ float dpp_f(float v) { return __builtin_bit_cast(float, __builtin_amdgcn_update_dpp(0, __builtin_bit_cast(int, v), CTRL, 0xF, 0xF, true)); }
__device__ __forceinline__ float sum16(float x) {
    x += dpp_f<0xB1>(x); x += dpp_f<0x4E>(x); x += dpp_f<0x141>(x); x += dpp_f<0x140>(x); return x;
}
__device__ __forceinline__ float vmul(float a, float b) { float r; asm("v_mul_f32_e32 %0, %1, %2" : "=v"(r) : "v"(a), "v"(b)); return r; }
__device__ __forceinline__ float vfma(float a, float b, float c) { float r; asm("v_fma_f32 %0, %1, %2, %3" : "=v"(r) : "v"(a), "v"(b), "v"(c)); return r; }
#define LDS_WAIT() asm volatile("s_waitcnt lgkmcnt(0)" ::: "memory")
#define VM_WAIT() asm volatile("s_waitcnt vmcnt(0)" ::: "memory")
#define WG_BAR() do { asm volatile("s_waitcnt lgkmcnt(0)" ::: "memory"); __builtin_amdgcn_s_barrier(); asm volatile("" ::: "memory"); } while (0)

namespace pg8 {
constexpr int BM = 256, BK = 64, HALF = 128, HTB = HALF * BK * 2, STAGE_BYTES = 8 * HTB, NXCD = 8, WGM = 8;
__host__ __device__ __forceinline__ int lds_byte(int r, int c) { const int st = (r >> 4) * 2 + (c >> 5), rr = r & 15, cc = c & 31, ob = rr * 64 + cc * 2; return st * 1024 + (ob ^ (((ob >> 9) & 1) << 5)); }
__host__ __device__ __forceinline__ void stage_rc(int b, int& R, int& C) { const int st = b / 1024, sb = b % 1024, swz = sb ^ (((sb >> 9) & 1) << 5); R = (st >> 1) * 16 + swz / 64; C = (st & 1) * 32 + (swz % 64) / 2; }
__host__ __device__ __forceinline__ int perm32(int rho) { const int n = rho >> 4, i = rho & 15; return 8 * (i >> 2) + 4 * n + (i & 3); }

struct Unit { int pm, pn; };
struct Gemm { const bf16_t* A; const bf16_t* Bt; int M, N, K; };

struct StaticOrder {
    int nM, nN, nwg, G, c;
    __host__ __device__ void init(int M, int N, int G_, int c_) { nM = M / BM; nN = N / BM; nwg = nM * nN; G = G_; c = c_; }
    __host__ __device__ bool next(int i, Unit& u) const {
        const long L = (long)i * G + c; if (L >= nwg) return false;
        int wgid = (int)L; { const int q = nwg / NXCD, r = nwg % NXCD, xcd = wgid % NXCD, off = wgid / NXCD; wgid = (xcd < r ? xcd * (q + 1) : r * (q + 1) + (xcd - r) * q) + off; }
        const int nig = WGM * nN, gid = wgid / nig, fm = gid * WGM, gsz = (nM - fm) < WGM ? (nM - fm) : WGM;
        u.pm = fm + ((wgid % nig) % gsz); u.pn = (wgid % nig) / gsz; return true;
    }
    __device__ __forceinline__ void a_ready(const Unit&) const {}
    __device__ __forceinline__ void done(const Unit&) const {}
};

template <class Epi, class Sched, bool ALIGN_EPI = false, bool SP2 = false>
__device__ __forceinline__ void gemm_phase(LAS unsigned char* lds, const Gemm g, const Sched& S, const Epi& E) {
    int tid_ = threadIdx.x; asm volatile("" : "+v"(tid_));
    const int tid = tid_, wid = __builtin_amdgcn_readfirstlane(tid >> 6), lane = tid & 63, wr = wid >> 2, wc = wid & 3, fr = lane & 15, fq = lane >> 4;
    int K_ = g.K; asm volatile("" : "+s"(K_));
    const int K = K_, nt = K / BK;
    unsigned voffA[2], voffB[2];
#pragma unroll
    for (int i = 0; i < 2; ++i) { int R, C; stage_rc(tid * 16 + i * 8192, R, C); const int Rb = Epi::PERM ? ((R & ~31) + perm32(R & 31)) : R;
        voffA[i] = (unsigned)(R * K + C) * 2u; voffB[i] = (unsigned)(Rb * K + C) * 2u; }
    const size_t kstep = (size_t)(BK * 2);
    const size_t hstep = (size_t)HALF * K * 2;
    const size_t tstep = 2 * hstep;
    const unsigned ldsw = (unsigned)wid * 1024u;
    const int aoff = lds_byte(wr * 64 + fr, fq * 8), boff = lds_byte(wc * 32 + fr, fq * 8);
#define PG8_SA(b, h) (((b) * 2 + (h)) * HTB)
#define PG8_SB(b, h) ((4 + (b) * 2 + (h)) * HTB)
#define PG8_STAGE(bufoff, gbase, voff) do { _Pragma("unroll") for (int _i = 0; _i < 2; ++_i) \
        __builtin_amdgcn_global_load_lds((const unsigned*)((const char*)(gbase) + (voff)[_i]), (LAS unsigned*)(lds + (bufoff) + ldsw + _i * 8192), 16, 0, 0); } while (0)
#define PG8_LDA(dst, b, h) do { _Pragma("unroll") for (int m = 0; m < 4; ++m) _Pragma("unroll") for (int k = 0; k < 2; ++k) dst[m][k] = *(const LAS bf16x8*)(lds + PG8_SA(b, h) + aoff + m * 2048 + k * 1024); } while (0)
#define PG8_LDB(dst, b, h) do { _Pragma("unroll") for (int n = 0; n < 2; ++n) _Pragma("unroll") for (int k = 0; k < 2; ++k) dst[n][k] = *(const LAS bf16x8*)(lds + PG8_SB(b, h) + boff + n * 2048 + k * 1024); } while (0)
#define PG8_MMA(ai, bj, At, Bt) do { __builtin_amdgcn_s_setprio(1); _Pragma("unroll") for (int m = 0; m < 4; ++m) _Pragma("unroll") for (int n = 0; n < 2; ++n) _Pragma("unroll") for (int k = 0; k < 2; ++k) { \
        if constexpr (Epi::SWAP) acc[ai][bj][m][n] = __builtin_amdgcn_mfma_f32_16x16x32_bf16(At[m][k], Bt[n][k], acc[ai][bj][m][n], 0, 0, 0); \
        else acc[ai][bj][m][n] = __builtin_amdgcn_mfma_f32_16x16x32_bf16(Bt[n][k], At[m][k], acc[ai][bj][m][n], 0, 0, 0); } __builtin_amdgcn_s_setprio(0); } while (0)
#define PG8_WAIT_V(n) asm volatile("s_waitcnt vmcnt(" #n ")" ::: "memory")
#define PG8_WAIT_L(n) asm volatile("s_waitcnt lgkmcnt(" #n ")" ::: "memory")
#define PG8_BAR __builtin_amdgcn_s_barrier()
#define PG8_SCHED __builtin_amdgcn_sched_barrier(0)
    Unit cur, nxt; int ui = 0;
    if (!S.next(0, cur)) return;
    f32x4 acc[2][2][4][2];
#pragma unroll
    for (int a = 0; a < 2; ++a)
#pragma unroll
        for (int b = 0; b < 2; ++b)
#pragma unroll
            for (int m = 0; m < 4; ++m)
#pragma unroll
                for (int n = 0; n < 2; ++n) acc[a][b][m][n] = (f32x4){0.f, 0.f, 0.f, 0.f};
    bf16x8 At[4][2], B0[2][2], B1[2][2];
    const char* cA = (const char*)g.A + (size_t)cur.pm * tstep; const char* cB = (const char*)g.Bt + (size_t)cur.pn * tstep;
    S.a_ready(cur);
    if constexpr (SP2) {
        PG8_STAGE(PG8_SB(0, 0), cB, voffB); PG8_STAGE(PG8_SB(0, 1), cB + hstep, voffB); PG8_STAGE(PG8_SA(0, 0), cA, voffA); PG8_STAGE(PG8_SA(0, 1), cA + hstep, voffA);
        if (wr == 1) PG8_BAR;
        PG8_WAIT_V(2); PG8_BAR;
        PG8_STAGE(PG8_SB(1, 0), cB + kstep, voffB); PG8_STAGE(PG8_SA(1, 0), cA + kstep, voffA); PG8_STAGE(PG8_SB(1, 1), cB + hstep + kstep, voffB);
        PG8_WAIT_V(6); PG8_BAR;
    } else {
        PG8_STAGE(PG8_SB(0, 0), cB, voffB); PG8_STAGE(PG8_SA(0, 0), cA, voffA); PG8_STAGE(PG8_SB(0, 1), cB + hstep, voffB); PG8_STAGE(PG8_SA(0, 1), cA + hstep, voffA);
        if (wr == 1) PG8_BAR;
        PG8_WAIT_V(4); PG8_BAR;
        PG8_STAGE(PG8_SB(1, 0), cB + kstep, voffB); PG8_STAGE(PG8_SA(1, 0), cA + kstep, voffA); PG8_STAGE(PG8_SB(1, 1), cB + hstep + kstep, voffB);
        PG8_WAIT_V(6); PG8_BAR;
    }
    for (;;) {
        const bool has_next = S.next(ui + 1, nxt);
        const char* nA = has_next ? (const char*)g.A + (size_t)nxt.pm * tstep : cA; const char* nB = has_next ? (const char*)g.Bt + (size_t)nxt.pn * tstep : cB;
        for (int t = 0; t < nt; t += 2) {
            const bool last = (t == nt - 2);
            const char* a1 = cA + (size_t)(t + 1) * kstep;
            const char* a2 = last ? nA : cA + (size_t)(t + 2) * kstep; const char* b2 = last ? nB : cB + (size_t)(t + 2) * kstep;
            const char* a3 = a2 + kstep; const char* b3 = b2 + kstep;
            if (last && has_next) S.a_ready(nxt);
            if constexpr (SP2) {
            PG8_LDB(B0, 0, 0); PG8_LDB(B1, 0, 1); PG8_SCHED; PG8_LDA(At, 0, 0); PG8_STAGE(PG8_SA(1, 1), a1 + hstep, voffA);
            PG8_WAIT_V(8); PG8_WAIT_L(0); PG8_BAR; PG8_MMA(0, 0, At, B0); PG8_MMA(0, 1, At, B1); PG8_BAR; PG8_SCHED;
            PG8_LDA(At, 0, 1); PG8_STAGE(PG8_SB(0, 0), b2, voffB); PG8_STAGE(PG8_SB(0, 1), b2 + hstep, voffB); PG8_STAGE(PG8_SA(0, 0), a2, voffA);
            PG8_WAIT_V(8); PG8_WAIT_L(0); PG8_BAR; PG8_MMA(1, 0, At, B0); PG8_MMA(1, 1, At, B1); PG8_BAR; PG8_SCHED;
            PG8_LDB(B0, 1, 0); PG8_LDB(B1, 1, 1); PG8_SCHED; PG8_LDA(At, 1, 0); PG8_STAGE(PG8_SA(0, 1), a2 + hstep, voffA);
            PG8_WAIT_V(8); PG8_WAIT_L(0); PG8_BAR; PG8_MMA(0, 0, At, B0); PG8_MMA(0, 1, At, B1); PG8_BAR; PG8_SCHED;
            PG8_LDA(At, 1, 1); PG8_STAGE(PG8_SB(1, 0), b3, voffB); PG8_STAGE(PG8_SB(1, 1), b3 + hstep, voffB); PG8_STAGE(PG8_SA(1, 0), a3, voffA);
            PG8_WAIT_V(8); PG8_WAIT_L(0); PG8_BAR; PG8_MMA(1, 0, At, B0); PG8_MMA(1, 1, At, B1); PG8_BAR; PG8_SCHED;
            } else {
            PG8_LDB(B0, 0, 0); PG8_SCHED; PG8_LDA(At, 0, 0); PG8_STAGE(PG8_SA(1, 1), a1 + hstep, voffA);
            PG8_WAIT_L(8); PG8_BAR; PG8_WAIT_L(0); PG8_MMA(0, 0, At, B0); PG8_BAR; PG8_SCHED;
            PG8_LDB(B1, 0, 1); PG8_STAGE(PG8_SB(0, 0), b2, voffB);
            PG8_BAR; PG8_WAIT_L(0); PG8_MMA(0, 1, At, B1); PG8_BAR;
            PG8_LDA(At, 0, 1); PG8_STAGE(PG8_SA(0, 0), a2, voffA);
            PG8_BAR; PG8_WAIT_L(0); PG8_MMA(1, 0, At, B0); PG8_BAR; PG8_SCHED;
            PG8_STAGE(PG8_SB(0, 1), b2 + hstep, voffB);
            PG8_WAIT_V(6); PG8_BAR; PG8_MMA(1, 1, At, B1); PG8_BAR;
            PG8_LDB(B0, 1, 0); PG8_SCHED; PG8_LDA(At, 1, 0); PG8_STAGE(PG8_SA(0, 1), a2 + hstep, voffA);
            PG8_WAIT_L(8); PG8_BAR; PG8_WAIT_L(0); PG8_MMA(0, 0, At, B0); PG8_BAR; PG8_SCHED;
            PG8_LDB(B1, 1, 1); PG8_STAGE(PG8_SB(1, 0), b3, voffB);
            PG8_BAR; PG8_WAIT_L(0); PG8_MMA(0, 1, At, B1); PG8_BAR;
            PG8_LDA(At, 1, 1); PG8_STAGE(PG8_SA(1, 0), a3, voffA);
            PG8_BAR; PG8_WAIT_L(0); PG8_MMA(1, 0, At, B0); PG8_BAR; PG8_SCHED;
            PG8_STAGE(PG8_SB(1, 1), b3 + hstep, voffB);
            PG8_WAIT_V(6); PG8_BAR; PG8_MMA(1, 1, At, B1); PG8_BAR;
            }
        }
        if constexpr (ALIGN_EPI) { if (wr == 0) PG8_BAR; }
        E(acc, cur, wr, wc, fr, fq); S.done(cur);
        if (!has_next) break;
#pragma unroll
        for (int a = 0; a < 2; ++a)
#pragma unroll
            for (int b = 0; b < 2; ++b)
#pragma unroll
                for (int m = 0; m < 4; ++m)
#pragma unroll
                    for (int n = 0; n < 2; ++n) acc[a][b][m][n] = (f32x4){0.f, 0.f, 0.f, 0.f};
        cur = nxt; cA = nA; cB = nB; ++ui;
        if constexpr (ALIGN_EPI) { if (wr == 1) PG8_BAR; }
    }
    PG8_WAIT_V(0);
    if constexpr (!ALIGN_EPI) { if (wr == 0) PG8_BAR; }
    PG8_BAR;
#undef PG8_SA
#undef PG8_SB
#undef PG8_STAGE
#undef PG8_LDA
#undef PG8_LDB
#undef PG8_MMA
#undef PG8_WAIT_V
#undef PG8_WAIT_L
#undef PG8_BAR
#undef PG8_SCHED
}

typedef const f32x4 (&AccRef)[2][2][4][2];
__device__ __forceinline__ u32x4 pack8(f32x4 v0, f32x4 v1) { u32x4 w; w.x = pk2(v0[0], v0[1]); w.y = pk2(v0[2], v0[3]); w.z = pk2(v1[0], v1[1]); w.w = pk2(v1[2], v1[3]); return w; }
__device__ __forceinline__ void unpack8(u32x4 w, f32x4& v0, f32x4& v1) { v0 = (f32x4){bflo(w.x), bfhi(w.x), bflo(w.y), bfhi(w.y)}; v1 = (f32x4){bflo(w.z), bfhi(w.z), bflo(w.w), bfhi(w.w)}; }

struct EpiBf16 {
    static constexpr bool PERM = true, SWAP = false;
    bf16_t* O; int ldc;
    __device__ __forceinline__ void operator()(AccRef acc, const Unit& u, int wr, int wc, int fr, int fq) const {
        const int row0 = u.pm * BM + wr * 64 + fr, col0 = u.pn * BM + wc * 32 + 8 * fq;
#pragma unroll
        for (int ai = 0; ai < 2; ++ai)
#pragma unroll
            for (int m = 0; m < 4; ++m) { bf16_t* rowp = O + (size_t)(row0 + ai * HALF + m * 16) * ldc + col0;
#pragma unroll
                for (int bj = 0; bj < 2; ++bj) *(u32x4*)(rowp + bj * HALF) = pack8(acc[ai][bj][m][0], acc[ai][bj][m][1]); }
    }
};
struct EpiProj {
    static constexpr bool PERM = true, SWAP = false;
    bf16_t* O; const float* rope; bf16_t* KB;
    __device__ __forceinline__ void operator()(AccRef acc, const Unit& u, int wr, int wc, int fr, int fq) const {
        const int row0 = u.pm * BM + wr * 64 + fr, col0 = u.pn * BM + wc * 32 + 8 * fq;
        const int mode = (u.pn >= 27 && u.pn < 43) ? (u.pn < 35 ? 1 : 2) : 0;
        const float sc = (mode == 1) ? QSCALE : 1.0f;
#pragma unroll
        for (int ai = 0; ai < 2; ++ai)
#pragma unroll
            for (int m = 0; m < 4; ++m) { const int row = row0 + ai * HALF + m * 16; bf16_t* rowp = O + (size_t)row * PLD + col0;
#pragma unroll
                for (int bj = 0; bj < 2; ++bj) { f32x4 v0 = acc[ai][bj][m][0], v1 = acc[ai][bj][m][1];
                    if (mode) { const int i0 = ((col0 + bj * HALF) & 127) >> 1; const f32x4* rp = (const f32x4*)(rope + ((size_t)row * 64 + i0) * 2); const f32x4 c0 = rp[0], c1 = rp[1];
                        f32x4 o0, o1;
                        o0[0] = v0[0] * c0[0] - v0[1] * c0[1]; o0[1] = v0[1] * c0[0] + v0[0] * c0[1]; o0[2] = v0[2] * c0[2] - v0[3] * c0[3]; o0[3] = v0[3] * c0[2] + v0[2] * c0[3];
                        o1[0] = v1[0] * c1[0] - v1[1] * c1[1]; o1[1] = v1[1] * c1[0] + v1[0] * c1[1]; o1[2] = v1[2] * c1[2] - v1[3] * c1[3]; o1[3] = v1[3] * c1[2] + v1[2] * c1[3];
                        v0 = o0 * sc; v1 = o1 * sc; }
                    if (mode == 2) *(u32x4*)(KB + ((size_t)((u.pn - 35) * 2 + bj) * T + row) * MD + wc * 32 + 8 * fq) = pack8(v0, v1);
                    else *(u32x4*)(rowp + bj * HALF) = pack8(v0, v1); } }
    }
};
struct EpiVT {
    static constexpr bool PERM = false, SWAP = true;
    bf16_t* VT;
    __device__ __forceinline__ void operator()(AccRef acc, const Unit& u, int wr, int wc, int fr, int fq) const {
        const int tok0 = u.pm * BM + wr * 64 + 4 * fq, col0 = u.pn * BM + wc * 32 + fr;
#pragma unroll
        for (int ai = 0; ai < 2; ++ai)
#pragma unroll
            for (int m = 0; m < 4; ++m)
#pragma unroll
                for (int bj = 0; bj < 2; ++bj)
#pragma unroll
                    for (int n = 0; n < 2; ++n) { const f32x4 v = acc[ai][bj][m][n]; u32x2 w; w.x = pk2(v[0], v[1]); w.y = pk2(v[2], v[3]);
                        const int d = col0 + bj * HALF + n * 16, tl = (u.pm * BM + wr * 64 + ai * HALF) >> 6;
                        *(u32x2*)(VT + ((size_t)((d >> 7) * (T / 64) + tl) * MD + (d & 127)) * 64 + m * 16 + 4 * (((fq & 1) << 1) | (fq >> 1))) = w; }
    }
};
struct EpiDec {
    static constexpr bool PERM = true, SWAP = false;
    float* O; const float* w0;
    __device__ __forceinline__ void operator()(AccRef acc, const Unit& u, int wr, int wc, int fr, int fq) const {
        const int row0 = u.pm * BM + wr * 64 + fr, col0 = u.pn * BM + wc * 32 + 8 * fq;
#pragma unroll
        for (int bj = 0; bj < 2; ++bj) { const f32x4 b0 = *(const f32x4*)(w0 + col0 + bj * HALF), b1 = *(const f32x4*)(w0 + col0 + bj * HALF + 4);
#pragma unroll
            for (int ai = 0; ai < 2; ++ai)
#pragma unroll
                for (int m = 0; m < 4; ++m) { float* rowp = O + (size_t)(row0 + ai * HALF + m * 16) * RW + col0 + bj * HALF;
#pragma unroll
                    for (int n = 0; n < 2; ++n) { const f32x4 x = acc[ai][bj][m][n] + (n ? b1 : b0); f32x4 o;
#pragma unroll
                        for (int e = 0; e < 4; ++e) { const float z = -x[e]; const float sp = fmaxf(z, 0.f) + __logf(1.0f + __expf(-fabsf(z))); o[e] = __expf(-__expf(-sp - 0.5f)); }
                        *(f32x4*)(rowp + 4 * n) = o; }
                    asm volatile("" ::: "memory"); } }
    }
};
struct EpiA {
    static constexpr bool PERM = true, SWAP = false;
    bf16_t* KP; bf16_t* BB; const bf16_t* KKN; const float* a0; const float* k_a;
    __device__ __forceinline__ void operator()(AccRef acc, const Unit& u, int wr, int wc, int fr, int fq) const {
        const int row0 = u.pm * BM + wr * 64 + fr, col0 = u.pn * BM + wc * 32 + 8 * fq;
#pragma unroll
        for (int bj = 0; bj < 2; ++bj) { const int cb = col0 + bj * HALF;
            const f32x4 b0 = *(const f32x4*)(a0 + cb), b1 = *(const f32x4*)(a0 + cb + 4), ka0 = *(const f32x4*)(k_a + cb), ka1 = *(const f32x4*)(k_a + cb + 4);
#pragma unroll
            for (int ai = 0; ai < 2; ++ai)
#pragma unroll
                for (int m = 0; m < 4; ++m) { const size_t off = (size_t)(row0 + ai * HALF + m * 16) * RW + cb;
                    f32x4 zk0, zk1, kn0, kn1; unpack8(*(const u32x4*)(KP + off), zk0, zk1); unpack8(*(const u32x4*)(KKN + off), kn0, kn1);
                    f32x4 a0v, a1v;
#pragma unroll
                    for (int e = 0; e < 4; ++e) { a0v[e] = fsigmoid(acc[ai][bj][m][0][e] + b0[e]); a1v[e] = fsigmoid(acc[ai][bj][m][1][e] + b1[e]); }
                    const f32x4 kp0 = zk0 * (1.0f + (a0v - 1.0f) * ka0), kp1 = zk1 * (1.0f + (a1v - 1.0f) * ka1);
                    *(u32x4*)(KP + off) = pack8(kp0, kp1); *(u32x4*)(BB + off) = pack8(-(kn0 * a0v), -(kn1 * a1v));
                    asm volatile("" ::: "memory"); } }
    }
};
template <bool ADD> struct EpiMix {
    static constexpr bool PERM = true, SWAP = false;
    bf16_t* O; const bf16_t* proj; int gcol0;
    __device__ __forceinline__ void operator()(AccRef acc, const Unit& u, int wr, int wc, int fr, int fq) const {
        const int row0 = u.pm * BM + wr * 64 + fr, col0 = u.pn * BM + wc * 32 + 8 * fq;
#pragma unroll
        for (int ai = 0; ai < 2; ++ai)
#pragma unroll
            for (int m = 0; m < 4; ++m) { const int row = row0 + ai * HALF + m * 16;
#pragma unroll
                for (int bj = 0; bj < 2; ++bj) { f32x4 g0, g1; unpack8(*(const u32x4*)(proj + (size_t)row * PLD + gcol0 + col0 + bj * HALF), g0, g1);
                    f32x4 o0, o1;
#pragma unroll
                    for (int e = 0; e < 4; ++e) { o0[e] = fsigmoid(g0[e]) * acc[ai][bj][m][0][e]; o1[e] = fsigmoid(g1[e]) * acc[ai][bj][m][1][e]; }
                    bf16_t* op = O + (size_t)row * D + col0 + bj * HALF;
                    if (ADD) { f32x4 p0, p1; unpack8(*(const u32x4*)op, p0, p1); o0 += p0; o1 += p1; }
                    *(u32x4*)op = pack8(o0, o1); } }
    }
};
struct EpiRes {
    static constexpr bool PERM = true, SWAP = false;
    float* O; const float* x;
    __device__ __forceinline__ void operator()(AccRef acc, const Unit& u, int wr, int wc, int fr, int fq) const {
        const int row0 = u.pm * BM + wr * 64 + fr, col0 = u.pn * BM + wc * 32 + 8 * fq;
#pragma unroll
        for (int ai = 0; ai < 2; ++ai)
#pragma unroll
            for (int m = 0; m < 4; ++m) { const size_t off = (size_t)(row0 + ai * HALF + m * 16) * D + col0;
#pragma unroll
                for (int bj = 0; bj < 2; ++bj)
#pragma unroll
                    for (int n = 0; n < 2; ++n) *(f32x4*)(O + off + bj * HALF + 4 * n) = *(const f32x4*)(x + off + bj * HALF + 4 * n) + acc[ai][bj][m][n]; }
    }
};
}

#define XB_TMO      128
#define XB_XCNT(j)  (256  + 64 * (j))
#define XB_XSUB(j)  (1280 + 64 * (j))
#define XB_XGEN(j)  (2304 + 64 * (j))
#define XB_TOP      3328
#define XB_TOPGEN   3392
#define XCD_BAR_WORDS 3456
#define XB_SPIN_CAP (1u << 18)
__device__ __forceinline__ unsigned xb_ld(unsigned* p)              { return __hip_atomic_load(p, __ATOMIC_RELAXED, __HIP_MEMORY_SCOPE_AGENT); }
__device__ __forceinline__ unsigned xb_add(unsigned* p, unsigned v) { return __hip_atomic_fetch_add(p, v, __ATOMIC_RELAXED, __HIP_MEMORY_SCOPE_AGENT); }
__device__ __forceinline__ unsigned xb_xcc_id() { return (unsigned)__builtin_amdgcn_s_getreg((3 << 11) | 20) & 0xFu; }
#define XB_SPIN(cond, bar) do { unsigned _sp = 0; while (cond) { __builtin_amdgcn_s_sleep(1); \
    if ((++_sp & 255u) == 0u) { if (xb_ld(&(bar)[XB_TMO])) break; if (_sp > XB_SPIN_CAP) { atomicAdd(&(bar)[XB_TMO], 1u); break; } } } } while (0)
struct XcdBarrier { unsigned* bar; unsigned x; volatile LAS unsigned* st; };
__device__ __forceinline__ XcdBarrier xcd_barrier_post(unsigned* bar, volatile LAS unsigned* st) {
    XcdBarrier b; b.bar = bar; b.x = xb_xcc_id(); b.st = st;
    if (threadIdx.x == 0) (void)xb_add(&bar[XB_XCNT(b.x)], 1u);
    return b;
}
__device__ __forceinline__ void xcd_barrier_complete(unsigned* bar, unsigned x, unsigned& nloc, unsigned& nx) {
    const unsigned G = gridDim.x * gridDim.y * gridDim.z;
    unsigned sum, cnt, mine, sp = 0u;
    for (;;) {
        sum = 0u; cnt = 0u; mine = 0u;
#pragma unroll
        for (unsigned j = 0; j < 16; ++j) { const unsigned c = xb_ld(&bar[XB_XCNT(j)]); sum += c; cnt += (c > 0u) ? 1u : 0u; mine = (j == x) ? c : mine; }
        if (sum == G) break;
        __builtin_amdgcn_s_sleep(1);
        if ((++sp & 255u) == 0u) { if (xb_ld(&bar[XB_TMO])) break; if (sp > XB_SPIN_CAP) { atomicAdd(&bar[XB_TMO], 1u); break; } }
    }
    nloc = mine > 0u ? mine : 1u; nx = cnt > 0u ? cnt : 1u;
}
__device__ __forceinline__ void xcd_barrier(const XcdBarrier& b) {
    asm volatile("s_waitcnt vmcnt(0)" ::: "memory");
    __syncthreads();
    if (threadIdx.x == 0) {
        unsigned* bar = b.bar;
        __builtin_amdgcn_s_waitcnt(0);
        unsigned nloc = b.st[0], nx = b.st[1];
        if (nloc == 0u) { xcd_barrier_complete(bar, b.x, nloc, nx); b.st[0] = nloc; b.st[1] = nx; }
        const unsigned old = xb_add(&bar[XB_XSUB(b.x)], 1u);
        const unsigned gen = old / nloc;
        if (old + 1u == (gen + 1u) * nloc) {
            __builtin_amdgcn_fence(__ATOMIC_RELEASE, "agent");
            asm volatile("s_waitcnt vmcnt(0)" ::: "memory");
            const unsigned og = xb_add(&bar[XB_TOP], 1u);
            const unsigned tg = og / nx;
            if (og + 1u == (tg + 1u) * nx) xb_add(&bar[XB_TOPGEN], 1u);
            else XB_SPIN(xb_ld(&bar[XB_TOPGEN]) == tg, bar);
            __builtin_amdgcn_fence(__ATOMIC_ACQUIRE, "agent");
            xb_add(&bar[XB_XGEN(b.x)], 1u);
            asm volatile("s_waitcnt vmcnt(0)" ::: "memory");
        } else {
            XB_SPIN(xb_ld(&bar[XB_XGEN(b.x)]) == gen, bar);
            __builtin_amdgcn_fence(__ATOMIC_ACQUIRE, "agent");
            asm volatile("s_waitcnt vmcnt(0)" ::: "memory");
        }
    }
    __syncthreads();
}

struct Args {
    const float *x, *norm1_g, *w_in, *mu, *w0, *w_up, *a0, *a_up, *g_up, *k_k, *k_a, *r_k, *lnx_g, *lnx_b, *w_ba, *w_bb, *w_out, *norm2_g, *peer_wq, *sub_keys, *peer_u, *peer_v, *final_g;
    float* out; unsigned char* ws; int ph_lo, ph_hi, li, pad;
};
#define CAS __attribute__((address_space(4)))
typedef const CAS Args* ArgsP;
__device__ __forceinline__ ArgsP get_args() { ArgsP p = (ArgsP)__builtin_amdgcn_kernarg_segment_ptr(); asm volatile("" : "+s"(p)); return p; }
struct Frame { LAS unsigned char* lds; int tid, lane, wave, vcu, G; };

__device__ __forceinline__ int win_dst(int s) {
    if (s < SHIFTW) return s;
    if (s < SHIFTW + 4096) { const int base = (s < SHIFTW + 2048) ? SHIFTW : SHIFTW + 2048; const int m = s - base, head = m >> 7, c = m & 127; const int j = (c < 64) ? 2 * c : 2 * (c - 64) + 1;
        return ((s < SHIFTW + 2048) ? PC_MQ : PC_MK) + head * 128 + j; }
    if (s < SHIFTW + 6144) return PC_MV + (s - (SHIFTW + 4096));
    if (s < SHIFTW + 6144 + 4096) return PC_GA + (s - (SHIFTW + 6144));
    return PC_GB + (s - (SHIFTW + 6144 + 4096));
}
template <bool MAPWIN> __device__ __forceinline__ void p0_transpose_item(const float* W, int K, int N, bf16_t* WT, int Kd, LAS float* scr, int item, int lane) {
    const int nblk = N / 32, kb = item / nblk, nb = item % nblk, k0 = 64 * kb, n0 = 32 * nb;
    { const int krow = lane >> 3, c4 = lane & 7; f32x4 v[8];
#pragma unroll
      for (int i = 0; i < 8; ++i) { const int kk = 8 * i + krow; v[i] = (k0 + kk < K) ? *(const f32x4*)(W + (size_t)(k0 + kk) * N + n0 + 4 * c4) : (f32x4){0.f, 0.f, 0.f, 0.f}; }
#pragma unroll
      for (int i = 0; i < 8; ++i) { LAS float* d = scr + (8 * i + krow) * 33 + 4 * c4; d[0] = v[i].x; d[1] = v[i].y; d[2] = v[i].z; d[3] = v[i].w; } }
    LDS_WAIT(); asm volatile("" ::: "memory");
    const int c = lane & 7;
#pragma unroll
    for (int j = 0; j < 4; ++j) { const int n = (lane >> 3) + 8 * j; const LAS float* s = scr + (8 * c) * 33 + n;
        u32x4 o; o.x = pk2(s[0 * 33], s[1 * 33]); o.y = pk2(s[2 * 33], s[3 * 33]); o.z = pk2(s[4 * 33], s[5 * 33]); o.w = pk2(s[6 * 33], s[7 * 33]);
        const int row = MAPWIN ? win_dst(n0 + n) : (n0 + n);
        *(u32x4*)(WT + (size_t)row * Kd + k0 + 8 * c) = o; }
    LDS_WAIT(); asm volatile("" ::: "memory");
}
__device__ __forceinline__ void rms_rows_to_bf16(const float* x, const float* g, bf16_t* o, int m0, int mstride, int lane) {
    const f32x4* gr = (const f32x4*)g + lane;
    f32x4 v[16], w[16];
    if (m0 < T) {
#pragma unroll
        for (int j = 0; j < 16; ++j) v[j] = ((const f32x4*)(x + (size_t)m0 * D) + lane)[64 * j]; }
    for (int m = m0; m < T; m += mstride) { const bool hasn = m + mstride < T;
        if (hasn) {
#pragma unroll
            for (int j = 0; j < 16; ++j) w[j] = ((const f32x4*)(x + (size_t)(m + mstride) * D) + lane)[64 * j]; }
        float s = 0.f;
#pragma unroll
        for (int j = 0; j < 16; ++j) s += (v[j].x * v[j].x + v[j].y * v[j].y) + (v[j].z * v[j].z + v[j].w * v[j].w);
        const float rs = 1.0f / sqrtf(wave_sum(s) * (1.0f / D) + NORM_EPS);
        u32x2* o8 = (u32x2*)(o + (size_t)m * D) + lane;
#pragma unroll
        for (int j = 0; j < 16; ++j) { const f32x4 gg = gr[64 * j]; u32x2 q; q.x = pk2(v[j].x * rs * gg.x, v[j].y * rs * gg.y); q.y = pk2(v[j].z * rs * gg.z, v[j].w * rs * gg.w); o8[64 * j] = q; }
        if (hasn) {
#pragma unroll
            for (int j = 0; j < 16; ++j) v[j] = w[j]; }
    }
}
__device__ __forceinline__ void cvt_table(const float* src, bf16_t* dst, size_t n8, size_t gtid, size_t nthr) {
    for (size_t i = gtid; i < n8; i += nthr) { const f32x4 a = ((const f32x4*)src)[2 * i], b = ((const f32x4*)src)[2 * i + 1]; ((u32x4*)dst)[i] = pg8::pack8(a, b); }
}
__device__ __forceinline__ void pq_load(ArgsP A, int row, int lane, f32x4 (&v)[16]) {
    const f32x4* src = (const f32x4*)((row >= 16384 ? A->peer_v + (size_t)(row - 16384) * D : A->peer_u + (size_t)row * D)) + lane;
#pragma unroll
    for (int j = 0; j < 16; ++j) v[j] = __builtin_nontemporal_load(src + 64 * j);
}
__device__ __forceinline__ void pq_finish(unsigned char* ws, int row, int lane, const f32x4 (&v)[16]) {
    const bool isv = row >= 16384; const int rr = isv ? row - 16384 : row; float am = 0.f;
#pragma unroll
    for (int j = 0; j < 16; ++j) am = fmaxf(fmaxf(am, fmaxf(fabsf(v[j].x), fabsf(v[j].y))), fmaxf(fabsf(v[j].z), fabsf(v[j].w)));
#pragma unroll
    for (int o = 1; o < 64; o <<= 1) am = fmaxf(am, __shfl_xor(am, o));
    const float inv = am > 0.f ? 127.0f / am : 0.f; unsigned* dst = (unsigned*)(ws + (isv ? WS_PV : WS_PU)) + (size_t)rr * (D / 4) + lane;
    constexpr float MAGIC = 8388608.0f + 128.0f;
#pragma unroll
    for (int j = 0; j < 16; ++j) { const unsigned b0 = __builtin_bit_cast(unsigned, __builtin_fmaf(v[j].x, inv, MAGIC)), b1 = __builtin_bit_cast(unsigned, __builtin_fmaf(v[j].y, inv, MAGIC)),
                                                  b2 = __builtin_bit_cast(unsigned, __builtin_fmaf(v[j].z, inv, MAGIC)), b3 = __builtin_bit_cast(unsigned, __builtin_fmaf(v[j].w, inv, MAGIC));
        dst[64 * j] = __builtin_amdgcn_perm(__builtin_amdgcn_perm(b3, b2, 0x0c0c0400u), __builtin_amdgcn_perm(b1, b0, 0x0c0c0400u), 0x05040100u); }
    if (lane == 0) ((float*)(ws + (isv ? WS_PSV : WS_PSU)))[rr] = am * (1.0f / 127.0f);
}
__device__ __forceinline__ int pq_ra(int G) { constexpr int NT1 = (T / 256) * (PLD / 256); const int nx = NT1 % G, idle = nx ? G - nx : 0, n = idle * NWAVES * 7; return n < 2 * 16384 ? n : 2 * 16384; }
__device__ __forceinline__ void peer_quant(ArgsP A, Frame& F, int r0, int r1, int w0, int wstride) {
    f32x4 v[16], w[16];
    int row = r0 + w0;
    if (row < r1) pq_load(A, row, F.lane, v);
    for (; row < r1; row += wstride) { const bool hasn = row + wstride < r1;
        if (hasn) pq_load(A, row + wstride, F.lane, w);
        pq_finish(A->ws, row, F.lane, v);
        if (hasn) {
#pragma unroll
            for (int j = 0; j < 16; ++j) v[j] = w[j]; }
    }
}
__device__ __forceinline__ void late_weights(ArgsP A, Frame& F, int w0, int wstride) {
    unsigned char* ws = A->ws;
    LAS float* scr = (LAS float*)(F.lds + RING_OFF + F.wave * 16384);
    constexpr int I_BA = 32 * 128, I_OUT = 64 * 128, I_WQ = 64 * 64, I_SK = PH_ * 2 * PNK * PHALF / 512;
    constexpr int NITEMS = 2 * I_BA + I_OUT + I_WQ + I_SK;
    for (int it = w0; it < NITEMS; it += wstride) {
        int r = it;
        if (r < I_BA) { p0_transpose_item<false>(A->w_ba, RW, D, (bf16_t*)(ws + WS_WA), RW, scr, r, F.lane); continue; } r -= I_BA;
        if (r < I_BA) { p0_transpose_item<false>(A->w_bb, RW, D, (bf16_t*)(ws + WS_WB), RW, scr, r, F.lane); continue; } r -= I_BA;
        if (r < I_OUT) { p0_transpose_item<false>(A->w_out, D, D, (bf16_t*)(ws + WS_WOUT), D, scr, r, F.lane); continue; } r -= I_OUT;
        if (r < I_WQ) { p0_transpose_item<false>(A->peer_wq, D, 2048, (bf16_t*)(ws + WS_WQ), D, scr, r, F.lane); continue; } r -= I_WQ;
        { const size_t i = (size_t)r * 64 + F.lane; const f32x4 a = ((const f32x4*)A->sub_keys)[2 * i], b = ((const f32x4*)A->sub_keys)[2 * i + 1]; ((u32x4*)(ws + WS_SUBK))[i] = pg8::pack8(a, b); }
    }
}
__device__ __forceinline__ void ph0_prologue(ArgsP A, Frame& F) {
    unsigned char* ws = A->ws;
    LAS float* scr = (LAS float*)(F.lds + RING_OFF + F.wave * 16384);
    const int gw = F.vcu * NWAVES + F.wave, NGW = F.G * NWAVES;
    constexpr int I_IN = 64 * (INW / 32), I_UP = 2 * 64, I_G = 8 * 64;
    constexpr int NITEMS = I_IN + 2 * I_UP + I_G;
    for (int it = gw; it < NITEMS; it += NGW) {
        int r = it;
        if (r < I_IN) { p0_transpose_item<true>(A->w_in, D, INW, (bf16_t*)(ws + WS_WIN), D, scr, r, F.lane); continue; } r -= I_IN;
        if (r < I_UP) { p0_transpose_item<false>(A->w_up, LW, RW, (bf16_t*)(ws + WS_WUP), LW, scr, r, F.lane); continue; } r -= I_UP;
        if (r < I_UP) { p0_transpose_item<false>(A->a_up, LA, RW, (bf16_t*)(ws + WS_AUP), LA, scr, r, F.lane); continue; } r -= I_UP;
        p0_transpose_item<false>(A->g_up, LG, RW, (bf16_t*)(ws + WS_GUP), LGP, scr, r, F.lane);
    }
    const size_t gtid = (size_t)F.vcu * NTHR + F.tid, nthr = (size_t)F.G * NTHR;
    for (size_t i = gtid; i < (size_t)32 * D / 8; i += nthr) ((u32x4*)((bf16_t*)(ws + WS_WIN) + (size_t)SHIFTW * D))[i] = (u32x4){0u, 0u, 0u, 0u};
    for (size_t i = gtid; i < (size_t)T * 64; i += nthr) { const int pos = (int)(i >> 6), fi = (int)(i & 63); const float inv = powf(10000.0f, -(float)fi / 64.0f); const float ang = (float)pos * inv;
        ((f32x2*)(ws + WS_ROPE))[i] = (f32x2){cosf(ang), sinf(ang)}; }
    rms_rows_to_bf16(A->x, A->norm1_g, (bf16_t*)(ws + WS_XN), gw, NGW, F.lane);
}

__device__ __forceinline__ f32x4 ld4bf(const bf16_t* p) { const u32x2 w = *(const u32x2*)p; return (f32x4){bflo(w.x), bfhi(w.x), bflo(w.y), bfhi(w.y)}; }
__device__ __forceinline__ void st4bf(bf16_t* p, f32x4 v) { u32x2 w; w.x = pk2(v[0], v[1]); w.y = pk2(v[2], v[3]); *(u32x2*)p = w; }
__device__ __forceinline__ void ph2_prep(ArgsP A, Frame& F) {
    unsigned char* ws = A->ws; const bf16_t* PROJ = (const bf16_t*)(ws + WS_PROJ);
    LAS float* red = (LAS float*)(F.lds + RING_OFF);
    for (int it = F.vcu; it < NBLK * MH; it += F.G) { const int n = it / MH, h = it % MH, d = F.tid & 127, part = F.tid >> 7;
        const bf16_t* p = (const bf16_t*)(ws + WS_KB) + ((size_t)h * T + n * MBLK + part * 64) * MD + d; float s = 0.f;
#pragma unroll 8
        for (int i = 0; i < 64; ++i) s += bf1(p[(size_t)i * MD]);
        red[F.tid] = s; WG_BAR();
        if (F.tid < 128) { const float m = (red[F.tid] + red[F.tid + 128] + red[F.tid + 256] + red[F.tid + 384]) * (1.0f / MBLK); const unsigned hi = f2bf(m); const float lo = m - __builtin_bit_cast(float, hi << 16);
            ((bf16_t*)(ws + WS_KMEAN))[(size_t)(h * NBLK + n) * MD + F.tid] = (bf16_t)hi; ((bf16_t*)(ws + WS_KMEAN + 131072))[(size_t)(h * NBLK + n) * MD + F.tid] = (bf16_t)f2bf(lo); }
        WG_BAR(); }
    const int tid = F.tid; const int c = 4 * tid;
    const f32x4 mu_r = *(const f32x4*)(A->mu + PC_R + c), mu_k = *(const f32x4*)(A->mu + PC_K + c), mu_v = *(const f32x4*)(A->mu + PC_V + c), kkw = *(const f32x4*)(A->k_k + c);
    int lc = 0, lcc = 0; if (tid < 32) { lcc = 4 * tid; lc = PC_WL + lcc; } else if (tid < 64) { lcc = 4 * (tid - 32); lc = PC_AL + lcc; } else { lcc = 4 * (tid - 64); lc = PC_GL + lcc; }
    const bool lact = tid < 64 || (tid < 192 && lcc < LG);
    const f32x4 mu_l = lact ? *(const f32x4*)(A->mu + lc) : (f32x4){0.f, 0.f, 0.f, 0.f};
    u32x2 cur[8], nxt[8];
    auto tload = [&](int t, u32x2 (&rg)[8]) { const bf16_t* P = PROJ + (size_t)t * PLD; const bf16_t* PP = t > 0 ? P - PLD : P;
        rg[0] = *(const u32x2*)(P + PC_R + c); rg[1] = *(const u32x2*)(PP + PC_R + c); rg[2] = *(const u32x2*)(P + PC_K + c); rg[3] = *(const u32x2*)(PP + PC_K + c);
        rg[4] = *(const u32x2*)(P + PC_V + c); rg[5] = *(const u32x2*)(PP + PC_V + c);
        if (lact) { rg[6] = *(const u32x2*)(P + lc); rg[7] = *(const u32x2*)(PP + lc); } else { rg[6] = (u32x2){0u, 0u}; rg[7] = (u32x2){0u, 0u}; } };
    auto up4 = [](u32x2 w) { return (f32x4){bflo(w.x), bfhi(w.x), bflo(w.y), bfhi(w.y)}; };
    if (F.vcu < T) tload(F.vcu, cur);
    for (int t = F.vcu; t < T; t += F.G) { const bool hasn = t + F.G < T; if (hasn) tload(t + F.G, nxt);
        const float hp = t > 0 ? 1.0f : 0.0f;
        { const f32x4 p = up4(cur[0]), pp = up4(cur[1]) * hp; st4bf((bf16_t*)(ws + WS_ZR) + (size_t)t * RW + c, p + (pp - p) * mu_r); }
        { const f32x4 p = up4(cur[2]), pp = up4(cur[3]) * hp; const f32x4 zk = p + (pp - p) * mu_k;
          st4bf((bf16_t*)(ws + WS_KP) + (size_t)t * RW + c, zk); const f32x4 kk = zk * kkw;
          const float ss = sum16((kk[0] * kk[0] + kk[1] * kk[1]) + (kk[2] * kk[2] + kk[3] * kk[3])); const float inv = 1.0f / fmaxf(sqrtf(ss), 1e-12f);
          st4bf((bf16_t*)(ws + WS_KKN) + (size_t)t * RW + c, kk * inv); }
        { const f32x4 p = up4(cur[4]), pp = up4(cur[5]) * hp; st4bf((bf16_t*)(ws + WS_ZV) + (size_t)t * RW + c, p + (pp - p) * mu_v); }
        if (tid < 192) { const f32x4 zero = (f32x4){0.f, 0.f, 0.f, 0.f};
            f32x4 z = zero; if (lact) { const f32x4 p = up4(cur[6]), pp = up4(cur[7]) * hp; z = p + (pp - p) * mu_l; }
            if (tid < 32) { f32x4 o;
#pragma unroll
                for (int e = 0; e < 4; ++e) o[e] = 1.0f - 2.0f * __builtin_amdgcn_rcpf(__expf(2.0f * z[e]) + 1.0f);
                st4bf((bf16_t*)(ws + WS_AW) + (size_t)t * LW + lcc, o); }
            else if (tid < 64) st4bf((bf16_t*)(ws + WS_AA) + (size_t)t * LA + lcc, z);
            else { f32x4 o = zero; if (lcc < LG) {
#pragma unroll
                for (int e = 0; e < 4; ++e) o[e] = fsigmoid(z[e]); }
                st4bf((bf16_t*)(ws + WS_AG) + (size_t)t * LGP + lcc, o); }
        }
        if (hasn) {
#pragma unroll
            for (int i = 0; i < 8; ++i) cur[i] = nxt[i]; }
    }
}

__device__ __forceinline__ void ph3_gate(ArgsP A, Frame& F) {
    unsigned char* ws = A->ws; const bf16_t* PROJ = (const bf16_t*)(ws + WS_PROJ); const bf16_t* KMH = (const bf16_t*)(ws + WS_KMEAN); const bf16_t* KML = (const bf16_t*)(ws + WS_KMEAN + 131072); unsigned* MASK = (unsigned*)(ws + WS_MASK);
    const int gw = F.vcu * NWAVES + F.wave, NGW = F.G * NWAVES; const int r = F.lane & 31, hh = F.lane >> 5; const float NEG = -__builtin_inff();
    for (int it = gw; it < (T / 32) * MH; it += NGW) { const int tg = it >> 4, h = it & 15, t = tg * 32 + r, blk = tg >> 3;
        if (blk == 0) { if (hh == 0) MASK[t * MH + h] = 0u; continue; }
        f32x16 acc;
#pragma unroll
        for (int e = 0; e < 16; ++e) acc[e] = 0.f;
#pragma unroll
        for (int ks = 0; ks < 8; ++ks) { const bf16x8 q = *(const bf16x8*)(PROJ + (size_t)t * PLD + PC_MQ + h * MD + 16 * ks + 8 * hh); const size_t ko = (size_t)(h * NBLK + r) * MD + 16 * ks + 8 * hh;
            acc = __builtin_amdgcn_mfma_f32_32x32x16_bf16(*(const bf16x8*)(KMH + ko), q, acc, 0, 0, 0); acc = __builtin_amdgcn_mfma_f32_32x32x16_bf16(*(const bf16x8*)(KML + ko), q, acc, 0, 0, 0); }
        float t0 = NEG, t1 = NEG, t2 = NEG;
#pragma unroll
        for (int e = 0; e < 16; ++e) { const int n = (e & 3) + 8 * (e >> 2) + 4 * hh; float ae = acc[e]; asm volatile("" : "+v"(ae));
            float x = __builtin_bit_cast(float, (__builtin_bit_cast(unsigned, ae) & ~31u) | (unsigned)(31 - n)); x = (n < blk) ? x : NEG;
            t2 = __builtin_amdgcn_fmed3f(t1, t2, x); t1 = __builtin_amdgcn_fmed3f(t0, t1, x); t0 = fmaxf(t0, x); }
        const float o0 = __shfl_xor(t0, 32), o1 = __shfl_xor(t1, 32), o2 = __shfl_xor(t2, 32);
        t2 = __builtin_amdgcn_fmed3f(t1, t2, o0); t1 = __builtin_amdgcn_fmed3f(t0, t1, o0); t0 = fmaxf(t0, o0);
        t2 = __builtin_amdgcn_fmed3f(t1, t2, o1); t1 = __builtin_amdgcn_fmed3f(t0, t1, o1); t0 = fmaxf(t0, o1);
        t2 = __builtin_amdgcn_fmed3f(t1, t2, o2); t1 = __builtin_amdgcn_fmed3f(t0, t1, o2); t0 = fmaxf(t0, o2);
        unsigned sel = 1u << (31 - (__builtin_bit_cast(unsigned, t0) & 31u));
        if (blk > 1) sel |= 1u << (31 - (__builtin_bit_cast(unsigned, t1) & 31u));
        if (blk > 2) sel |= 1u << (31 - (__builtin_bit_cast(unsigned, t2) & 31u));
        if (hh == 0) MASK[t * MH + h] = sel;
        { gu32* cnt = (gu32*)(ws + WS_CTL) + CW_CNT + h * 32; unsigned short* lst = (unsigned short*)(ws + WS_LIST) + (size_t)h * 32 * 8192; const unsigned mysel = hh == 0 ? sel : 0u;
          unsigned mycnt = 0u;
          for (int j = 0; j < blk; ++j) { const unsigned long long bal = __ballot((mysel >> j) & 1u); const unsigned c = (unsigned)__builtin_popcountll(bal); mycnt = (F.lane == j) ? c : mycnt; }
          unsigned base = 0u; if (F.lane < blk && mycnt) base = __hip_atomic_fetch_add(cnt + F.lane, mycnt, __ATOMIC_RELAXED, __HIP_MEMORY_SCOPE_AGENT);
          for (int j = 0; j < blk; ++j) { const unsigned long long bal = __ballot((mysel >> j) & 1u); const unsigned bj = (unsigned)__builtin_amdgcn_readlane((int)base, j);
              if ((mysel >> j) & 1u) { const unsigned off = __builtin_amdgcn_mbcnt_hi((unsigned)(bal >> 32), __builtin_amdgcn_mbcnt_lo((unsigned)bal, 0u)); const unsigned slot = (unsigned)__builtin_popcount(mysel & ((1u << j) - 1u));
                  lst[(size_t)j * 8192 + bj + off] = (unsigned short)((unsigned)t | (slot << 13)); } } } }
}

constexpr int CK = 64, NCHK = T / CK, CP = 144, CPF = 272;
constexpr int L_AT = 0, L_BT = 9216, L_KT = 18432, L_RT = 27648, L_ATT = 36864, L_BTT = 46080, L_V = 55296, L_MKA = 64512, L_MBRT = 73728, L_MKRT = 82944, L_A2 = 92160, L_MBA = 101376, L_PC = 118784, L_WT = 119040, L_MBH = 121088, L_TD = 130304, L_PT = 134912, L_CEND = 139520;
constexpr int L_TT = L_AT, L_A1 = L_BT, L_Y2T = L_MKA, L_G2T = L_ATT;
static_assert(L_CEND <= RING_BYTES, "chunk prep LDS");
constexpr size_t CHW_ITEM = 32768;
__device__ __forceinline__ f32x16 nt_quad(const LAS unsigned char* X, const LAS unsigned char* Y, int qp, int qq, int r, int hh) {
    f32x16 acc;
#pragma unroll
    for (int e = 0; e < 16; ++e) acc[e] = 0.f;
#pragma unroll
    for (int ks = 0; ks < 4; ++ks) { const bf16x8 a = *(const LAS bf16x8*)(Y + (32 * qq + r) * CP + 32 * ks + 16 * hh), b = *(const LAS bf16x8*)(X + (32 * qp + r) * CP + 32 * ks + 16 * hh);
        acc = __builtin_amdgcn_mfma_f32_32x32x16_bf16(a, b, acc, 0, 0, 0); }
    return acc;
}
__device__ __forceinline__ int nt_q(int qq, int e, int hh) { return 32 * qq + (e & 3) + 8 * (e >> 2) + 4 * hh; }
__device__ __forceinline__ void nt_store_bf16(LAS unsigned char* O, int p, int qq, int hh, const f32x16& v) {
#pragma unroll
    for (int g = 0; g < 4; ++g) { u32x2 w; w.x = pk2(v[4 * g], v[4 * g + 1]); w.y = pk2(v[4 * g + 2], v[4 * g + 3]); *(LAS u32x2*)(O + p * CP + (32 * qq + 8 * g + 4 * hh) * 2) = w; }
}
__device__ __forceinline__ void ph4_chunkprep(ArgsP A, Frame& F) {
    unsigned char* ws = A->ws;
    const float* DEC = (const float*)(ws + WS_DEC); const bf16_t* KKN = (const bf16_t*)(ws + WS_KKN); const bf16_t* BBg = (const bf16_t*)(ws + WS_BB); const bf16_t* KPg = (const bf16_t*)(ws + WS_KP);
    const bf16_t* ZR = (const bf16_t*)(ws + WS_ZR); const bf16_t* ZV = (const bf16_t*)(ws + WS_ZV); float* Yg = (float*)(ws + WS_Y); unsigned char* CHW = ws + WS_WIN;
    LAS unsigned char* L = F.lds + RING_OFF; const int wave = F.wave, lane = F.lane, r = lane & 31, hh = lane >> 5;
    const int prod = wave >> 2, qp = (wave >> 1) & 1, qq = wave & 1, p = 32 * qp + r;
    float nwv[8]; unsigned nkk[4], nbb[4], nkp[4], nr[4], nv[4];
    auto request = [&](int h2, int c2) {
#pragma unroll
        for (int k = 0; k < 8; ++k) nwv[k] = DEC[(size_t)(c2 * CK + 8 * wave + k) * RW + (size_t)h2 * RN + lane];
#pragma unroll
        for (int i = 0; i < 4; ++i) { const size_t o = (size_t)(c2 * CK + 8 * wave + 2 * i + hh) * RW + (size_t)h2 * RN + 2 * r;
            nkk[i] = *(const unsigned*)(KKN + o); nbb[i] = *(const unsigned*)(BBg + o); nkp[i] = *(const unsigned*)(KPg + o); nr[i] = *(const unsigned*)(ZR + o); nv[i] = *(const unsigned*)(ZV + o); } };
    if (F.vcu < RH * NCHK) request(F.vcu / NCHK, F.vcu % NCHK);
    if (F.vcu == 0 && wave == 0) {
        const gu32* cnt = (const gu32*)(ws + WS_CTL) + CW_CNT; unsigned* ud = (unsigned*)(ws + WS_UDESC); unsigned np[8], tot = 0u;
#pragma unroll
        for (int k = 0; k < 8; ++k) { const unsigned c = __hip_atomic_load(cnt + 8 * lane + k, __ATOMIC_RELAXED, __HIP_MEMORY_SCOPE_AGENT); np[k] = (c + 255u) >> 8; tot += np[k]; }
        unsigned incl = tot;
#pragma unroll
        for (int o = 1; o < 64; o <<= 1) { const unsigned v = __shfl_up(incl, o); if (lane >= o) incl += v; }
        unsigned pos = incl - tot;
#pragma unroll
        for (int k = 0; k < 8; ++k) { const unsigned c = __hip_atomic_load(cnt + 8 * lane + k, __ATOMIC_RELAXED, __HIP_MEMORY_SCOPE_AGENT); for (unsigned ps = 0; ps < np[k]; ++ps) { ud[1 + 2 * pos] = (unsigned)(8 * lane + k) | (ps << 16); ud[2 + 2 * pos] = c; ++pos; } }
        if (lane == 63) ud[0] = incl; }
    for (int item = F.vcu; item < RH * NCHK; item += F.G) { const int h = item / NCHK, c = item % NCHK; const size_t hc = (size_t)h * RN; const int t0 = c * CK;
        { float wv[8], kkv[8], bbv[8], kpv[8], rv[8]; unsigned vv[8];
#pragma unroll
          for (int k = 0; k < 8; ++k) { const int src = ((k & 1) << 7) | ((lane >> 1) << 2); const bool odd = lane & 1;
              auto mine = [&](unsigned x) { const unsigned w = (unsigned)__builtin_amdgcn_ds_bpermute(src, (int)x); return odd ? (w & 0xffff0000u) : (w << 16); };
              wv[k] = nwv[k]; kkv[k] = __builtin_bit_cast(float, mine(nkk[k >> 1])); bbv[k] = __builtin_bit_cast(float, mine(nbb[k >> 1])); kpv[k] = __builtin_bit_cast(float, mine(nkp[k >> 1]));
              rv[k] = __builtin_bit_cast(float, mine(nr[k >> 1])); vv[k] = mine(nv[k >> 1]) >> 16; }
          { const int nit = item + F.G; if (nit < RH * NCHK) request(nit / NCHK, nit % NCHK); }
          float pl[8]; pl[0] = wv[0];
#pragma unroll
          for (int k = 1; k < 8; ++k) pl[k] = pl[k - 1] * wv[k];
          ((LAS float*)(L + L_WT))[wave * 64 + lane] = pl[7];
          WG_BAR();
          float pre = 1.f;
#pragma unroll
          for (int w2 = 0; w2 < 7; ++w2) { const float x = ((const LAS float*)(L + L_WT))[w2 * 64 + lane]; pre = (w2 < wave) ? pre * x : pre; }
          unsigned atp[4], btp[4], vtp[4];
#pragma unroll
          for (int k = 0; k < 8; ++k) { const float Pt = pre * pl[k], Pm = (k == 0) ? pre : pre * pl[k - 1], ip = __builtin_amdgcn_rcpf(Pt); const int t = 8 * wave + k;
              const unsigned a16 = f2bf(Pm * kkv[k]), b16 = f2bf(bbv[k] * ip), k16 = f2bf(kpv[k] * ip), r16 = f2bf(Pt * rv[k]);
              *(LAS bf16_t*)(L + L_AT + t * CP + 2 * lane) = (bf16_t)a16; *(LAS bf16_t*)(L + L_BT + t * CP + 2 * lane) = (bf16_t)b16; *(LAS bf16_t*)(L + L_KT + t * CP + 2 * lane) = (bf16_t)k16; *(LAS bf16_t*)(L + L_RT + t * CP + 2 * lane) = (bf16_t)r16;
              if (k & 1) { atp[k >> 1] |= a16 << 16; btp[k >> 1] |= b16 << 16; vtp[k >> 1] |= vv[k] << 16; } else { atp[k >> 1] = a16; btp[k >> 1] = b16; vtp[k >> 1] = vv[k]; }
              if (wave == 7 && k == 7) ((LAS float*)(L + L_PC))[lane] = Pt; }
          *(LAS u32x4*)(L + L_ATT + lane * CP + 16 * wave) = (u32x4){atp[0], atp[1], atp[2], atp[3]}; *(LAS u32x4*)(L + L_BTT + lane * CP + 16 * wave) = (u32x4){btp[0], btp[1], btp[2], btp[3]};
          *(LAS u32x4*)(L + L_V + lane * CP + 16 * wave) = (u32x4){vtp[0], vtp[1], vtp[2], vtp[3]}; }
        WG_BAR();
        { const f32x16 v = nt_quad(L + (prod ? L_KT : L_BT), L + L_AT, qp, qq, r, hh); f32x16 m;
#pragma unroll
          for (int e = 0; e < 16; ++e) m[e] = nt_q(qq, e, hh) > p ? v[e] : 0.f;
          if (prod == 0) {
#pragma unroll
              for (int g = 0; g < 4; ++g) *(LAS f32x4*)(L + L_MBA + p * CPF + (32 * qq + 8 * g + 4 * hh) * 4) = (f32x4){m[4 * g], m[4 * g + 1], m[4 * g + 2], m[4 * g + 3]}; }
          if (prod == 0) nt_store_bf16(L + L_MBH, p, qq, hh, m);
          else nt_store_bf16(L + L_MKA, p, qq, hh, m); }
        { const f32x16 v = nt_quad(L + L_RT, L + (prod ? L_KT : L_BT), qp, qq, r, hh); f32x16 m;
#pragma unroll
          for (int e = 0; e < 16; ++e) m[e] = nt_q(qq, e, hh) <= p ? v[e] : 0.f;
          nt_store_bf16(L + (prod ? L_MKRT : L_MBRT), p, qq, hh, m); }
        WG_BAR();
        { const int t = 8 * wave + (lane >> 3), g = lane & 7, base = 32 * (t >> 5); float T4[4] = {0.f, 0.f, 0.f, 0.f};
          const LAS unsigned char* mrow = L + L_MBA + (base + 4 * g) * 4;
          f32x4 m = *(const LAS f32x4*)(mrow + (base + 31) * CPF);
#pragma unroll 1
          for (int Sx = 7; Sx >= 0; --Sx) {
#pragma unroll
              for (int q = 3; q >= 0; --q) { const int sl = 4 * Sx + q, sr = base + sl, sn = sl > 0 ? sr - 1 : sr; const f32x4 n = *(const LAS f32x4*)(mrow + sn * CPF);
                  float part = (m[0] * T4[0] + m[1] * T4[1]) + (m[2] * T4[2] + m[3] * T4[3]);
                  part += dpp_f<0xB1>(part); part += dpp_f<0x4E>(part); part += dpp_f<0x141>(part);
                  const float val = (sr == t) ? 1.0f : part; T4[q] = (g == Sx) ? val : T4[q]; m = n; } }
          const unsigned w0 = pk2(T4[0], T4[1]), w1 = pk2(T4[2], T4[3]);
          *(LAS u32x2*)(L + L_TT + t * CP + (base + 4 * g) * 2) = (u32x2){w0, w1};
          if (base == 0) { *(LAS u32x2*)(L + L_TT + t * CP + (32 + 4 * g) * 2) = (u32x2){0u, 0u};
              *(LAS bf16_t*)(L + L_TD + (4 * g) * CP + 2 * t) = (bf16_t)(w0 & 0xffffu); *(LAS bf16_t*)(L + L_TD + (4 * g + 1) * CP + 2 * t) = (bf16_t)(w0 >> 16);
              *(LAS bf16_t*)(L + L_TD + (4 * g + 2) * CP + 2 * t) = (bf16_t)(w1 & 0xffffu); *(LAS bf16_t*)(L + L_TD + (4 * g + 3) * CP + 2 * t) = (bf16_t)(w1 >> 16); } }
        WG_BAR();
        if (wave == 0) {
            f32x16 acc;
#pragma unroll
            for (int e = 0; e < 16; ++e) acc[e] = 0.f;
#pragma unroll
            for (int ks = 0; ks < 2; ++ks) { const bf16x8 a = *(const LAS bf16x8*)(L + L_MBH + r * CP + 64 + 32 * ks + 16 * hh), b = *(const LAS bf16x8*)(L + L_TT + (32 + r) * CP + 64 + 32 * ks + 16 * hh);
                acc = __builtin_amdgcn_mfma_f32_32x32x16_bf16(a, b, acc, 0, 0, 0); }
            nt_store_bf16(L + L_PT, r, 0, hh, acc);
            LDS_WAIT(); asm volatile("" ::: "memory");
#pragma unroll
            for (int e = 0; e < 16; ++e) acc[e] = 0.f;
#pragma unroll
            for (int ks = 0; ks < 2; ++ks) { const bf16x8 a = *(const LAS bf16x8*)(L + L_TD + r * CP + 32 * ks + 16 * hh), b = *(const LAS bf16x8*)(L + L_PT + r * CP + 32 * ks + 16 * hh);
                acc = __builtin_amdgcn_mfma_f32_32x32x16_bf16(a, b, acc, 0, 0, 0); }
            nt_store_bf16(L + L_TT, 32 + r, 0, hh, acc);
        }
        WG_BAR();
        { const f32x16 v = nt_quad(L + (prod ? L_MKA : L_ATT), L + L_TT, qp, qq, r, hh);
          nt_store_bf16(L + (prod ? L_A2 : L_A1), p, qq, hh, v); }
        WG_BAR();
        unsigned char* cw = CHW + (size_t)item * CHW_ITEM;
        { const f32x16 v = nt_quad(L + L_MBRT, L + (prod ? L_A2 : L_A1), qp, qq, r, hh); f32x16 o;
          const LAS unsigned char* addm = L + (prod ? L_MKRT : L_RT);
#pragma unroll
          for (int g = 0; g < 4; ++g) { const u32x2 w = *(const LAS u32x2*)(addm + p * CP + (32 * qq + 8 * g + 4 * hh) * 2); o[4 * g] = v[4 * g] + bflo(w.x); o[4 * g + 1] = v[4 * g + 1] + bfhi(w.x); o[4 * g + 2] = v[4 * g + 2] + bflo(w.y); o[4 * g + 3] = v[4 * g + 3] + bfhi(w.y); }
          if (prod) nt_store_bf16(L + L_Y2T, p, qq, hh, o);
          else {
#pragma unroll
              for (int g = 0; g < 4; ++g) { u32x2 w; w.x = pk2(o[4 * g], o[4 * g + 1]); w.y = pk2(o[4 * g + 2], o[4 * g + 3]); *(u32x2*)(cw + (size_t)p * 128 + (32 * qq + 8 * g + 4 * hh) * 2) = w; } } }
        { const f32x16 v = nt_quad(L + L_BTT, L + (prod ? L_A2 : L_A1), qp, qq, r, hh); const float pc = ((const LAS float*)(L + L_PC))[p]; f32x16 o;
          if (prod) {
#pragma unroll
              for (int e = 0; e < 16; ++e) o[e] = (v[e] + bf1(*(const LAS bf16_t*)(L + L_KT + nt_q(qq, e, hh) * CP + 2 * p))) * pc;
              nt_store_bf16(L + L_G2T, p, qq, hh, o); }
          else {
#pragma unroll
              for (int e = 0; e < 16; ++e) o[e] = (v[e] + (nt_q(qq, e, hh) == p ? 1.0f : 0.0f)) * pc;
#pragma unroll
              for (int g = 0; g < 4; ++g) { u32x2 w; w.x = pk2(o[4 * g], o[4 * g + 1]); w.y = pk2(o[4 * g + 2], o[4 * g + 3]); *(u32x2*)(cw + 8192 + (size_t)p * 128 + (32 * qq + 8 * g + 4 * hh) * 2) = w; } } }
        WG_BAR();
        { const f32x16 v = prod ? nt_quad(L + L_V, L + L_G2T, qp, qq, r, hh) : nt_quad(L + L_Y2T, L + L_V, qp, qq, r, hh);
          float* dst = prod ? (float*)(cw + 16384) + (size_t)p * 64 : Yg + (size_t)(t0 + p) * RW + hc;
#pragma unroll
          for (int g = 0; g < 4; ++g) *(f32x4*)(dst + 32 * qq + 8 * g + 4 * hh) = (f32x4){v[4 * g], v[4 * g + 1], v[4 * g + 2], v[4 * g + 3]}; }
        WG_BAR();
    }
}
__device__ __forceinline__ void ph5_chain(ArgsP A, Frame& F, int h) {
    unsigned char* ws = A->ws; float* Yg = (float*)(ws + WS_Y); const unsigned char* CHW = ws + WS_WIN;
    LAS unsigned char* L = F.lds + RING_OFF; const int wave = F.wave, lane = F.lane, tid = F.tid, r = lane & 31, hh = lane >> 5;
    const int prod = wave >> 2, qp = (wave >> 1) & 1, qq = wave & 1, p = 32 * qp + r; const size_t hc = (size_t)h * RN;
    constexpr int L_S = 0, L_G = 2 * 9216, L_Y1 = 3 * 9216;
    for (int i = tid; i < 2 * 9216 / 4; i += NTHR) ((LAS unsigned*)(L + L_S))[i] = 0u;
    const int srow = tid >> 3, sc16 = tid & 7; u32x4 sg, sy;
    auto stage_ld = [&](int c) { const unsigned char* cw = CHW + (size_t)(h * NCHK + c) * CHW_ITEM; sy = *(const u32x4*)(cw + srow * 128 + sc16 * 16); sg = *(const u32x4*)(cw + 8192 + srow * 128 + sc16 * 16); };
    f32x4 nad[4];
    auto ad_ld = [&](int c) { const unsigned char* cw2 = CHW + (size_t)(h * NCHK + c) * CHW_ITEM; const float* addp = prod ? Yg + (size_t)(c * CK + p) * RW + hc : (const float*)(cw2 + 16384) + (size_t)p * 64;
#pragma unroll
        for (int g = 0; g < 4; ++g) nad[g] = *(const f32x4*)(addp + 32 * qq + 8 * g + 4 * hh); };
    stage_ld(0); ad_ld(0);
    int sb = 0;
    for (int c = 0; c < NCHK; ++c) {
        *(LAS u32x4*)(L + L_Y1 + srow * CP + sc16 * 16) = sy; *(LAS u32x4*)(L + L_G + srow * CP + sc16 * 16) = sg;
        const unsigned char* cw = CHW + (size_t)(h * NCHK + c) * CHW_ITEM;
        f32x4 ad[4];
#pragma unroll
        for (int g = 0; g < 4; ++g) ad[g] = nad[g];
        if (c + 1 < NCHK) { stage_ld(c + 1); ad_ld(c + 1); }
        WG_BAR();
        const f32x16 v = prod ? nt_quad(L + L_Y1, L + L_S + sb * 9216, qp, qq, r, hh) : nt_quad(L + L_S + sb * 9216, L + L_G, qp, qq, r, hh);
        f32x16 o;
#pragma unroll
        for (int g = 0; g < 4; ++g) { o[4 * g] = v[4 * g] + ad[g][0]; o[4 * g + 1] = v[4 * g + 1] + ad[g][1]; o[4 * g + 2] = v[4 * g + 2] + ad[g][2]; o[4 * g + 3] = v[4 * g + 3] + ad[g][3]; }
        if (prod) { float* yp = Yg + (size_t)(c * CK + p) * RW + hc;
#pragma unroll
            for (int g = 0; g < 4; ++g) *(f32x4*)(yp + 32 * qq + 8 * g + 4 * hh) = (f32x4){o[4 * g], o[4 * g + 1], o[4 * g + 2], o[4 * g + 3]}; }
        else nt_store_bf16(L + L_S + (sb ^ 1) * 9216, p, qq, hh, o);
        sb ^= 1;
        WG_BAR();
    }
}

__device__ __forceinline__ void ph5_ypost(ArgsP A, Frame& F) {
    unsigned char* ws = A->ws; const float* Y = (const float*)(ws + WS_Y); const bf16_t* ZR = (const bf16_t*)(ws + WS_ZR); const bf16_t* KP = (const bf16_t*)(ws + WS_KP); const bf16_t* ZV = (const bf16_t*)(ws + WS_ZV);
    const bf16_t* G = (const bf16_t*)(ws + WS_G); bf16_t* YA = (bf16_t*)(ws + WS_YA);
    const int gw = F.vcu * NWAVES + F.wave, NGW = F.G * NWAVES;
    const int c = F.wave * 256 + 4 * F.lane; const f32x4 rk = *(const f32x4*)(A->r_k + c), lg = *(const f32x4*)(A->lnx_g + c), lb = *(const f32x4*)(A->lnx_b + c);
    for (int tg = F.vcu; tg < T / 32; tg += F.G) for (int tq = 0; tq < 32; tq += 4) {
        f32x4 y[4]; u32x2 rr[4], kk[4], vv[4], gg[4];
#pragma unroll
        for (int u = 0; u < 4; ++u) { const size_t o = (size_t)(tg * 32 + tq + u) * RW + c; y[u] = *(const f32x4*)(Y + o); rr[u] = *(const u32x2*)(ZR + o); kk[u] = *(const u32x2*)(KP + o); vv[u] = *(const u32x2*)(ZV + o); gg[u] = *(const u32x2*)(G + o); }
#pragma unroll
        for (int u = 0; u < 4; ++u) { const size_t o = (size_t)(tg * 32 + tq + u) * RW + c;
            const float mean = sum16((y[u][0] + y[u][1]) + (y[u][2] + y[u][3])) * (1.0f / 64.0f); const f32x4 d = y[u] - mean;
            const float var = sum16((d[0] * d[0] + d[1] * d[1]) + (d[2] * d[2] + d[3] * d[3])) * (1.0f / 64.0f); const float rs = 1.0f / sqrtf(var + LNX_EPS);
            const f32x4 r = (f32x4){bflo(rr[u].x), bfhi(rr[u].x), bflo(rr[u].y), bfhi(rr[u].y)}, k = (f32x4){bflo(kk[u].x), bfhi(kk[u].x), bflo(kk[u].y), bfhi(kk[u].y)};
            const f32x4 v = (f32x4){bflo(vv[u].x), bfhi(vv[u].x), bflo(vv[u].y), bfhi(vv[u].y)}, g = (f32x4){bflo(gg[u].x), bfhi(gg[u].x), bflo(gg[u].y), bfhi(gg[u].y)};
            const f32x4 rkk = r * k * rk; const float bonus = sum16((rkk[0] + rkk[1]) + (rkk[2] + rkk[3]));
            st4bf(YA + o, (d * rs * lg + lb + bonus * v) * g); } }
}

constexpr int AT_KB = 64 * 256, AT_VB = 128 * 128, AT_BUF = AT_KB + AT_VB;
static_assert(3 * AT_BUF <= RING_BYTES, "attention LDS");
__device__ __forceinline__ void q8_load(u32x4 (&q)[8], const void* p) {
    asm volatile("global_load_dwordx4 %0, %8, off\n\tglobal_load_dwordx4 %1, %8, off offset:32\n\tglobal_load_dwordx4 %2, %8, off offset:64\n\tglobal_load_dwordx4 %3, %8, off offset:96\n\t"
                 "global_load_dwordx4 %4, %8, off offset:128\n\tglobal_load_dwordx4 %5, %8, off offset:160\n\tglobal_load_dwordx4 %6, %8, off offset:192\n\tglobal_load_dwordx4 %7, %8, off offset:224"
                 : "=&v"(q[0]), "=&v"(q[1]), "=&v"(q[2]), "=&v"(q[3]), "=&v"(q[4]), "=&v"(q[5]), "=&v"(q[6]), "=&v"(q[7]) : "v"(p) : "memory"); }
__device__ __forceinline__ void q8_settle(u32x4 (&q)[8]) {
#pragma unroll
    for (int i = 0; i < 8; ++i) asm volatile("" : "+v"(q[i])); }
__device__ __forceinline__ unsigned u16_load(const void* p) { unsigned v; asm volatile("global_load_ushort %0, %1, off" : "=&v"(v) : "v"(p) : "memory"); return v; }
__device__ __forceinline__ void ph5_attn(ArgsP A, Frame& F) {
    unsigned char* ws = A->ws; const bf16_t* PROJ = (const bf16_t*)(ws + WS_PROJ); const bf16_t* VT = (const bf16_t*)(ws + WS_VT); const bf16_t* KBp = (const bf16_t*)(ws + WS_KB);
    bf16_t* PO = (bf16_t*)(ws + WS_PARTO); float* PML = (float*)(ws + WS_PARTML); const unsigned short* LST = (const unsigned short*)(ws + WS_LIST); const unsigned* UD = (const unsigned*)(ws + WS_UDESC);
    LAS unsigned char* L = F.lds + RING_OFF; const int wave = F.wave, lane = F.lane, r = lane & 31, hh = lane >> 5;
    const float NEG = -__builtin_inff();
    const int NA = MH * NBLK, N = NA + (int)UD[0], w = F.vcu, nfree = F.G - RH; const bool chainwg = w < RH;
    auto unit_of = [&](int k) { return k * nfree + (w - RH); };
    int k = 0;
    if (chainwg) return;
    if (unit_of(k) >= N) return;
    int h, kblk, qtok, slot; bool typeA, valid, wvalid;
    { const int u = unit_of(k); typeA = u < NA;
      if (typeA) { h = u & 15; kblk = u >> 4; qtok = kblk * MBLK + wave * 32 + r; slot = 3; valid = true; wvalid = true; }
      else { const unsigned d = UD[1 + 2 * (u - NA)]; const int cnt = (int)UD[2 + 2 * (u - NA)]; const int Lx = (int)(d & 0xffffu), ps = (int)(d >> 16); h = Lx >> 5; kblk = Lx & 31;
          const int idx = ps * 256 + wave * 32 + r; valid = idx < cnt; wvalid = ps * 256 + wave * 32 < cnt; unsigned e = u16_load(LST + (size_t)Lx * 8192 + (valid ? idx : 0));
          asm volatile("s_waitcnt vmcnt(0)" ::: "memory"); asm volatile("" : "+v"(e)); qtok = (int)(e & 0x1fffu); slot = (int)(e >> 13); }
      h = __builtin_amdgcn_readfirstlane(h); kblk = __builtin_amdgcn_readfirstlane(kblk); }
    u32x4 qf[8], qfn[8];
    q8_load(qf, PROJ + (size_t)qtok * PLD + PC_MQ + h * MD + 8 * hh);
    const int krow_ = lane >> 4, kslot = lane & 15, vrow_ = lane >> 3, vslot = lane & 7;
    auto dma_tile = [&](int hd, int kb_, int n, int b3) { const int tb = kb_ * MBLK + n * 64; LAS unsigned char* B = L + b3 * AT_BUF;
#pragma unroll
        for (int i = 0; i < 2; ++i) { const int p = wave * 2 + i, row = 4 * p + krow_, c = kslot ^ (row & 15);
            __builtin_amdgcn_global_load_lds((const unsigned*)(KBp + ((size_t)hd * T + tb + row) * MD + 8 * c), (LAS unsigned*)(B + p * 1024), 16, 0, 0); }
#pragma unroll
        for (int i = 0; i < 2; ++i) { const int p = wave * 2 + i, row = 8 * p + vrow_, c = vslot ^ ((row >> 1) & 7);
            __builtin_amdgcn_global_load_lds((const unsigned*)(VT + ((size_t)(hd * (T / 64) + kb_ * 4 + n) * MD + row) * 64 + 8 * c), (LAS unsigned*)(B + AT_KB + p * 1024), 16, 0, 0); } };
    dma_tile(h, kblk, 0, 0); dma_tile(h, kblk, 1, 1);
    asm volatile("s_waitcnt vmcnt(4)" ::: "memory"); q8_settle(qf); WG_BAR();
    int b3 = 0;
    for (;;) {
        const int un = unit_of(k + 1); const bool has_next = un < N, nA = un < NA;
        int hN = 0, kblkN = 0, qtokN = 0, slotN = 3, LxN = 0, idxN = 0, cntN = 0; bool validN = true, wvalidN = true; unsigned udw = 0u, udc = 0u, entN = 0u;
        f32x16 o[4];
#pragma unroll
        for (int db = 0; db < 4; ++db)
#pragma unroll
            for (int e = 0; e < 16; ++e) o[db][e] = 0.f;
        float mrun = NEG, lrun = 0.f;
#pragma unroll
        for (int n = 0; n < 4; ++n) {
            if (has_next) {
                if (n == 0) { if (nA) { hN = un & 15; kblkN = un >> 4; } else { udw = UD[1 + 2 * (un - NA)]; udc = UD[2 + 2 * (un - NA)]; } }
                if (n == 1) { if (nA) { qtokN = kblkN * MBLK + wave * 32 + r; } else { LxN = (int)(udw & 0xffffu); const int ps = (int)(udw >> 16); cntN = (int)udc; hN = LxN >> 5; kblkN = LxN & 31;
                                  idxN = ps * 256 + wave * 32 + r; validN = idxN < cntN; wvalidN = ps * 256 + wave * 32 < cntN; entN = u16_load(LST + (size_t)LxN * 8192 + (validN ? idxN : 0)); }
                              hN = __builtin_amdgcn_readfirstlane(hN); kblkN = __builtin_amdgcn_readfirstlane(kblkN); }
                if (n == 2) { if (!nA) { qtokN = (int)(entN & 0x1fffu); slotN = (int)(entN >> 13); }
                              q8_load(qfn, PROJ + (size_t)qtokN * PLD + PC_MQ + hN * MD + 8 * hh); }
            }
            const int bn = b3 >= 1 ? b3 - 1 : 2; bool issued = false;
            if (n < 2) { dma_tile(h, kblk, n + 2, bn); issued = true; } else if (has_next) { dma_tile(hN, kblkN, n - 2, bn); issued = true; }
            const bool need = typeA ? (n <= (wave >> 1)) : wvalid;
            if (need) {
                const LAS unsigned char* KB = L + b3 * AT_BUF; const LAS unsigned char* VB = KB + AT_KB;
                f32x16 s[2];
#pragma unroll
                for (int kb = 0; kb < 2; ++kb) {
#pragma unroll
                    for (int e = 0; e < 16; ++e) s[kb][e] = 0.f;
#pragma unroll
                    for (int ks = 0; ks < 8; ++ks) { const bf16x8 a = *(const LAS bf16x8*)(KB + (32 * kb + r) * 256 + (((2 * ks + hh) ^ (r & 15)) << 4)); s[kb] = __builtin_amdgcn_mfma_f32_32x32x16_bf16(a, __builtin_bit_cast(bf16x8, qf[ks]), s[kb], 0, 0, 0); } }
                if (typeA && 64 * n + 63 > wave * 32) { const int qrel = wave * 32 + r;
#pragma unroll
                    for (int kb = 0; kb < 2; ++kb)
#pragma unroll
                        for (int e = 0; e < 16; ++e) { const int krel = 64 * n + 32 * kb + (e & 3) + 8 * (e >> 2) + 4 * hh; if (krel > qrel) s[kb][e] = NEG; } }
                float mx = s[0][0];
#pragma unroll
                for (int kb = 0; kb < 2; ++kb)
#pragma unroll
                    for (int e = 0; e < 16; ++e) mx = fmaxf(mx, s[kb][e]);
                mx = fmaxf(mx, __shfl_xor(mx, 32));
                const float mnew = fmaxf(mrun, mx); const float alpha = __builtin_amdgcn_exp2f(mrun - mnew); mrun = mnew;
                float ps = 0.f;
#pragma unroll
                for (int kb = 0; kb < 2; ++kb)
#pragma unroll
                    for (int e = 0; e < 16; ++e) { const float p = __builtin_amdgcn_exp2f(s[kb][e] - mnew); s[kb][e] = p; ps += p; }
                lrun = lrun * alpha + ps;
                if (__ballot(alpha != 1.0f) != 0ull) {
#pragma unroll
                    for (int db = 0; db < 4; ++db)
#pragma unroll
                        for (int e = 0; e < 16; ++e) o[db][e] *= alpha; }
#pragma unroll
                for (int kb = 0; kb < 2; ++kb)
#pragma unroll
                    for (int st = 0; st < 2; ++st) { u32x4 pw; pw.x = pk2(s[kb][8 * st + 0], s[kb][8 * st + 1]); pw.y = pk2(s[kb][8 * st + 2], s[kb][8 * st + 3]); pw.z = pk2(s[kb][8 * st + 4], s[kb][8 * st + 5]); pw.w = pk2(s[kb][8 * st + 6], s[kb][8 * st + 7]);
                        const bf16x8 pf = __builtin_bit_cast(bf16x8, pw);
#pragma unroll
                        for (int db = 0; db < 4; ++db) { const bf16x8 vf = *(const LAS bf16x8*)(VB + (32 * db + r) * 128 + (((4 * kb + 2 * st + hh) ^ ((r >> 1) & 7)) << 4));
                            o[db] = __builtin_amdgcn_mfma_f32_32x32x16_bf16(vf, pf, o[db], 0, 0, 0); } }
            }
            if (issued) asm volatile("s_waitcnt vmcnt(4)" ::: "memory"); else asm volatile("s_waitcnt vmcnt(0)" ::: "memory");
            if (n == 1) asm volatile("" : "+v"(entN));
            if (n == 2) q8_settle(qfn);
            b3 = b3 == 2 ? 0 : b3 + 1;
            WG_BAR();
        }
        { const float ltot = lrun + __shfl_xor(lrun, 32);
          if (valid) { const float inv = 1.0f / ltot; const size_t pi = ((size_t)qtok * MH + h) * 4 + slot; bf16_t* op = PO + pi * MD;
#pragma unroll
            for (int db = 0; db < 4; ++db)
#pragma unroll
                for (int g = 0; g < 4; ++g) { u32x2 wv; wv.x = pk2(o[db][4 * g] * inv, o[db][4 * g + 1] * inv); wv.y = pk2(o[db][4 * g + 2] * inv, o[db][4 * g + 3] * inv); *(u32x2*)(op + 32 * db + 8 * g + 4 * hh) = wv; }
            if (hh == 0) *(f32x2*)(PML + pi * 2) = (f32x2){mrun, ltot}; } }
        if (!has_next) break;
        h = hN; kblk = kblkN; qtok = qtokN; slot = slotN; typeA = nA; valid = nA ? true : validN; wvalid = nA ? true : wvalidN; ++k;
#pragma unroll
        for (int ks = 0; ks < 8; ++ks) qf[ks] = qfn[ks];
    }
}
__device__ __forceinline__ void ph6_merge(ArgsP A, Frame& F) {
    unsigned char* ws = A->ws; const bf16_t* PO = (const bf16_t*)(ws + WS_PARTO); const float* PML = (const float*)(ws + WS_PARTML); bf16_t* YB = (bf16_t*)(ws + WS_YB);
    const int gw = F.vcu * NWAVES + F.wave, NGW = F.G * NWAVES, hl = F.lane >> 5, dg = F.lane & 31;
    for (int it0 = gw * 4; it0 < T * 8; it0 += NGW * 4) {
        u32x2 ov[4][4]; f32x2 ml[4][4];
#pragma unroll
        for (int k = 0; k < 4; ++k) { const int it = it0 + k, t = it >> 3, h = 2 * (it & 7) + hl; const size_t pi = ((size_t)t * MH + h) * 4;
#pragma unroll
            for (int sl = 0; sl < 4; ++sl) { ov[k][sl] = *(const u32x2*)(PO + (pi + sl) * MD + 4 * dg); ml[k][sl] = *(const f32x2*)(PML + (pi + sl) * 2); } }
#pragma unroll
        for (int k = 0; k < 4; ++k) { const int it = it0 + k, t = it >> 3, h = 2 * (it & 7) + hl, blk = t >> 8, nsel = blk < 3 ? blk : 3;
            float mmax = ml[k][3][0];
#pragma unroll
            for (int sl = 0; sl < 3; ++sl) if (sl < nsel) mmax = fmaxf(mmax, ml[k][sl][0]);
            f32x4 acc = (f32x4){0.f, 0.f, 0.f, 0.f}; float wsum = 0.f;
#pragma unroll
            for (int sl = 0; sl < 4; ++sl) { if (sl == 3 || sl < nsel) { const float w = ml[k][sl][1] * __builtin_amdgcn_exp2f(ml[k][sl][0] - mmax); wsum += w;
                acc += w * (f32x4){bflo(ov[k][sl].x), bfhi(ov[k][sl].x), bflo(ov[k][sl].y), bfhi(ov[k][sl].y)}; } }
            const float inv = 1.0f / wsum; st4bf(YB + (size_t)t * RW + h * MD + 4 * dg, acc * inv); }
    }
}

__device__ __forceinline__ void ins16(float (&top)[16], float x) {
#pragma unroll
    for (int k = 15; k >= 1; --k) top[k] = __builtin_amdgcn_fmed3f(top[k - 1], top[k], x);
    top[0] = fmaxf(top[0], x);
}
__device__ __forceinline__ void ph10_select(ArgsP A, Frame& F) {
    unsigned char* ws = A->ws; const bf16_t* PQ = (const bf16_t*)(ws + WS_PQ); const bf16_t* SK = (const bf16_t*)(ws + WS_SUBK); int* IDX = (int*)(ws + WS_IDX); float* GW = (float*)(ws + WS_GW);
    const int gw = F.vcu * NWAVES + F.wave, NGW = F.G * NWAVES; const int r = F.lane & 31, hh = F.lane >> 5; const float NEG = -__builtin_inff();
    for (int it = gw; it < (T / 32) * PH_; it += NGW) { const int tg = it >> 3, h = it & 7, t = tg * 32 + r;
        float TA[16], TB[16];
        auto topk = [&](int p, float (&dst)[16]) {
            bf16x8 qf[8];
#pragma unroll
            for (int ks = 0; ks < 8; ++ks) qf[ks] = *(const bf16x8*)(PQ + (size_t)t * 2048 + (h * 2 + p) * PHALF + 16 * ks + 8 * hh);
            float top[16];
#pragma unroll
            for (int k = 0; k < 16; ++k) top[k] = NEG;
#pragma unroll 1
            for (int nb = 0; nb < 4; ++nb) { f32x16 acc;
#pragma unroll
                for (int e = 0; e < 16; ++e) acc[e] = 0.f;
#pragma unroll
                for (int ks = 0; ks < 8; ++ks) { const bf16x8 a = *(const bf16x8*)(SK + ((size_t)(h * 2 + p) * PNK + 32 * nb + r) * PHALF + 16 * ks + 8 * hh); acc = __builtin_amdgcn_mfma_f32_32x32x16_bf16(a, qf[ks], acc, 0, 0, 0); }
#pragma unroll
                for (int e = 0; e < 16; ++e) { const unsigned key = 32 * nb + (e & 3) + 8 * (e >> 2) + 4 * hh; float ae = acc[e]; asm volatile("" : "+v"(ae));
                    const float x = __builtin_bit_cast(float, (__builtin_bit_cast(unsigned, ae) & ~0x7Fu) | key); ins16(top, x); } }
            float oth[16];
#pragma unroll
            for (int k = 0; k < 16; ++k) oth[k] = __shfl_xor(top[k], 32);
#pragma unroll
            for (int k = 0; k < 16; ++k) ins16(top, oth[k]);
#pragma unroll
            for (int k = 0; k < 16; ++k) dst[k] = top[k];
        };
        topk(0, TA); asm volatile("" ::: "memory"); __builtin_amdgcn_sched_barrier(0); topk(1, TB); asm volatile("" ::: "memory"); __builtin_amdgcn_sched_barrier(0);
        float fin[16];
#pragma unroll
        for (int k = 0; k < 16; ++k) fin[k] = NEG;
#pragma unroll
        for (int i = 0; i < 16; ++i)
#pragma unroll
            for (int j = 0; j < 16; ++j) if ((i + 1) * (j + 1) <= 16) { const float sm = TA[i] + TB[j]; ins16(fin, __builtin_bit_cast(float, (__builtin_bit_cast(unsigned, sm) & ~0xFFu) | (unsigned)(i * 16 + j))); }
        float e[16], den = 0.f;
#pragma unroll
        for (int k = 0; k < 16; ++k) { e[k] = __expf(fin[k] - fin[0]); den += e[k]; }
        const float rden = 1.0f / den;
        int oi[8]; float og[8];
#pragma unroll
        for (int kk = 0; kk < 8; ++kk) { const float fv = hh ? fin[8 + kk] : fin[kk]; og[kk] = (hh ? e[8 + kk] : e[kk]) * rden; const unsigned id = __builtin_bit_cast(unsigned, fv) & 0xFFu; const unsigned ci = id >> 4, cj = id & 15u;
            unsigned ia = 0u, ib = 0u;
#pragma unroll
            for (int q = 0; q < 16; ++q) { ia = (ci == (unsigned)q) ? (__builtin_bit_cast(unsigned, TA[q]) & 0x7Fu) : ia; ib = (cj == (unsigned)q) ? (__builtin_bit_cast(unsigned, TB[q]) & 0x7Fu) : ib; }
            oi[kk] = (int)(ia * PNK + ib); }
        int* ip = IDX + (size_t)t * 128 + h * 16 + 8 * hh; float* gp = GW + (size_t)t * 128 + h * 16 + 8 * hh;
        *(u32x4*)ip = (u32x4){(unsigned)oi[0], (unsigned)oi[1], (unsigned)oi[2], (unsigned)oi[3]}; *(u32x4*)(ip + 4) = (u32x4){(unsigned)oi[4], (unsigned)oi[5], (unsigned)oi[6], (unsigned)oi[7]};
        *(f32x4*)gp = (f32x4){og[0], og[1], og[2], og[3]}; *(f32x4*)(gp + 4) = (f32x4){og[4], og[5], og[6], og[7]};
    }
}


__device__ __forceinline__ float ub0(unsigned w) { return (float)(w & 0xffu); }
__device__ __forceinline__ float ub1(unsigned w) { return (float)((w >> 8) & 0xffu); }
__device__ __forceinline__ float ub2(unsigned w) { return (float)((w >> 16) & 0xffu); }
__device__ __forceinline__ float ub3(unsigned w) { return (float)(w >> 24); }
__device__ __forceinline__ float dot16q(u32x4 q, const float (&h)[16]) {
    return ((ub0(q.x) * h[0] + ub1(q.x) * h[1]) + (ub2(q.x) * h[2] + ub3(q.x) * h[3])) + ((ub0(q.y) * h[4] + ub1(q.y) * h[5]) + (ub2(q.y) * h[6] + ub3(q.y) * h[7]))
         + ((ub0(q.z) * h[8] + ub1(q.z) * h[9]) + (ub2(q.z) * h[10] + ub3(q.z) * h[11])) + ((ub0(q.w) * h[12] + ub1(q.w) * h[13]) + (ub2(q.w) * h[14] + ub3(q.w) * h[15]));
}
__device__ __forceinline__ void ph11_gather(ArgsP A, Frame& F) {
    unsigned char* ws = A->ws; const bf16_t* H2 = (const bf16_t*)(ws + WS_H2); const unsigned char* PU = (const unsigned char*)(ws + WS_PU); const unsigned char* PV = (const unsigned char*)(ws + WS_PV);
    const float* PSU = (const float*)(ws + WS_PSU); const float* PSV = (const float*)(ws + WS_PSV);
    const int* IDX = (const int*)(ws + WS_IDX); const float* GW = (const float*)(ws + WS_GW); const float* X1 = (const float*)(ws + WS_X1);
    LAS float* coef = (LAS float*)(F.lds + RING_OFF); LAS int* eidx = (LAS int*)(F.lds + RING_OFF + 1024); LAS float* red = (LAS float*)(F.lds + RING_OFF + 2048);
    const int tid = F.tid, wave = F.wave, lane = F.lane; int par = 0;
    for (int tgk = F.vcu * 32; tgk < T; tgk = ((tgk & 31) == 31) ? tgk + (F.G - 1) * 32 + 1 : tgk + 1, par ^= 1) { const int t = tgk;
        float hv[4][16]; float hs = 0.f;
#pragma unroll
        for (int i = 0; i < 4; ++i) { const bf16_t* hp = H2 + (size_t)t * D + i * 1024 + lane * 16; f32x4 a, b, c, d; pg8::unpack8(*(const u32x4*)hp, a, b); pg8::unpack8(*(const u32x4*)(hp + 8), c, d);
#pragma unroll
            for (int e = 0; e < 4; ++e) { hv[i][e] = a[e]; hv[i][4 + e] = b[e]; hv[i][8 + e] = c[e]; hv[i][12 + e] = d[e]; }
            hs += ((a[0] + a[1]) + (a[2] + a[3])) + ((b[0] + b[1]) + (b[2] + b[3])) + ((c[0] + c[1]) + (c[2] + c[3])) + ((d[0] + d[1]) + (d[2] + d[3])); }
        hs = wave_sum(hs);
        const int myidx = (lane < 16) ? IDX[(size_t)t * 128 + wave * 16 + lane] : 0; const float myg = (lane < 16) ? GW[(size_t)t * 128 + wave * 16 + lane] : 0.f;
        float dots = 0.f;
#pragma unroll 1
        for (int k = 0; k < 16; k += 4) {
            u32x4 q[4][4];
#pragma unroll
            for (int x = 0; x < 4; ++x) { const int e = __builtin_amdgcn_readlane(myidx, k + x); const unsigned char* up = PU + (size_t)e * D + lane * 16;
#pragma unroll
                for (int i = 0; i < 4; ++i) q[x][i] = *(const u32x4*)(up + i * 1024); }
#pragma unroll
            for (int x = 0; x < 4; ++x) { float d = 0.f;
#pragma unroll
                for (int i = 0; i < 4; ++i) d += dot16q(q[x][i], hv[i]);
                d = wave_sum(d); if (lane == k + x) dots = d; }
        }
        if (lane < 16) { const float s = PSU[myidx] * (dots - 128.0f * hs); const float act = 0.5f * s * (1.0f + erff(s * 0.70710678118654752f));
            coef[par * 128 + wave * 16 + lane] = myg * act * PSV[myidx]; eidx[par * 128 + wave * 16 + lane] = myidx; }
        WG_BAR();
        float acc[8]; float csum = 0.f;
#pragma unroll
        for (int i = 0; i < 8; ++i) acc[i] = 0.f;
#pragma unroll 1
        for (int e = 0; e < 128; e += 16) { u32x2 v[16]; float c[16];
#pragma unroll
            for (int q = 0; q < 16; ++q) { const int ei = __builtin_amdgcn_readfirstlane(eidx[par * 128 + e + q]); c[q] = coef[par * 128 + e + q]; v[q] = *(const u32x2*)(PV + (size_t)ei * D + tid * 8); }
#pragma unroll
            for (int q = 0; q < 16; ++q) { csum += c[q]; acc[0] += c[q] * ub0(v[q].x); acc[1] += c[q] * ub1(v[q].x); acc[2] += c[q] * ub2(v[q].x); acc[3] += c[q] * ub3(v[q].x); acc[4] += c[q] * ub0(v[q].y); acc[5] += c[q] * ub1(v[q].y); acc[6] += c[q] * ub2(v[q].y); acc[7] += c[q] * ub3(v[q].y); } }
        const float corr = -128.0f * csum;
        const f32x4 x0 = *(const f32x4*)(X1 + (size_t)t * D + tid * 8), x1 = *(const f32x4*)(X1 + (size_t)t * D + tid * 8 + 4);
        f32x4 y0 = x0 + ((f32x4){acc[0], acc[1], acc[2], acc[3]} + corr), y1 = x1 + ((f32x4){acc[4], acc[5], acc[6], acc[7]} + corr);
        float ss = (y0[0] * y0[0] + y0[1] * y0[1]) + (y0[2] * y0[2] + y0[3] * y0[3]) + (y1[0] * y1[0] + y1[1] * y1[1]) + (y1[2] * y1[2] + y1[3] * y1[3]);
        ss = wave_sum(ss); if (lane == 0) red[par * 8 + wave] = ss;
        WG_BAR();
        float tot = 0.f;
#pragma unroll
        for (int w = 0; w < 8; ++w) tot += red[par * 8 + w];
        const float rs = 1.0f / sqrtf(tot * (1.0f / D) + NORM_EPS);
        const f32x4 g0 = *(const f32x4*)(A->final_g + tid * 8), g1 = *(const f32x4*)(A->final_g + tid * 8 + 4);
        *(f32x4*)(A->out + (size_t)t * D + tid * 8) = y0 * rs * g0; *(f32x4*)(A->out + (size_t)t * D + tid * 8 + 4) = y1 * rs * g1;
    }
}

constexpr int NPH = 13;
__device__ __forceinline__ Frame make_frame(unsigned char* lds) {
    Frame F; int t = threadIdx.x; asm volatile("" : "+v"(t));
    F.lds = (LAS unsigned char*)lds; F.tid = t; F.lane = t & 63; F.wave = __builtin_amdgcn_readfirstlane(t >> 6);
    F.G = gridDim.x; { const int bx = blockIdx.x; F.vcu = (F.G % 8 == 0) ? (bx % 8) * (F.G / 8) + bx / 8 : bx; }
    return F;
}
__global__ void __launch_bounds__(NTHR, 2) mk_fwd(Args args_by_value) {
    extern __shared__ __attribute__((aligned(16))) unsigned char lds[];
    ArgsP args = get_args();
    gu32* ctl = (gu32*)(args->ws + WS_CTL);
    for (int u = threadIdx.x; u < (LDS_BYTES - LDSCTL_OFF) / 4; u += NTHR) ((LAS unsigned*)((LAS unsigned char*)lds + LDSCTL_OFF))[u] = 0u;
    __syncthreads();
    const int lo = args->ph_lo, hi = args->ph_hi;
    volatile LAS unsigned* MISC = (volatile LAS unsigned*)((LAS unsigned char*)lds + MISC_OFF);
    XcdBarrier bar; bar.bar = (unsigned*)(ctl + CW_BAR) + args->li * XCD_BAR_WORDS; bar.x = 0; bar.st = nullptr;
    if (hi - lo > 1) bar = xcd_barrier_post((unsigned*)(ctl + CW_BAR) + args->li * XCD_BAR_WORDS, MISC + 8);
#define IN(k) (lo <= (k) && (k) < hi)
#define SEAM(k) do { if (IN(k) && IN((k) + 1)) xcd_barrier(bar); } while (0)
    const int bid = (int)blockIdx.x;

    if (IN(0)) { Frame F = make_frame(lds); ph0_prologue(get_args(), F); SEAM(0); }
    if (IN(1)) { Frame F = make_frame(lds); LAS unsigned char* ring = F.lds + RING_OFF; ArgsP a_ = get_args(); unsigned char* ws = a_->ws;
        { pg8::Gemm g{(const bf16_t*)(ws + WS_XN), (const bf16_t*)(ws + WS_WIN), T, PLD, D}; pg8::StaticOrder S; S.init(T, PLD, F.G, bid);
          pg8::EpiProj E{(bf16_t*)(ws + WS_PROJ), (const float*)(ws + WS_ROPE), (bf16_t*)(ws + WS_KB)}; pg8::gemm_phase<pg8::EpiProj, pg8::StaticOrder, true, true>(ring, g, S, E); }
        { pg8::Gemm g{(const bf16_t*)(ws + WS_XN), (const bf16_t*)(ws + WS_WIN) + (size_t)PC_MV * D, T, 2048, D}; pg8::StaticOrder S; S.init(T, 2048, F.G, bid);
          pg8::EpiVT E{(bf16_t*)(ws + WS_VT)}; pg8::gemm_phase<pg8::EpiVT, pg8::StaticOrder, true, true>(ring, g, S, E); }
        { constexpr int NT1 = (T / 256) * (PLD / 256); const int nx = NT1 % F.G;
          if (bid >= nx) { WG_BAR(); { Frame F2 = make_frame(lds); late_weights(get_args(), F2, (bid - nx) * NWAVES + F2.wave, (F2.G - nx) * NWAVES); }
              if (nx) { Frame F2 = make_frame(lds); peer_quant(get_args(), F2, 0, pq_ra(F2.G), (bid - nx) * NWAVES + F2.wave, (F2.G - nx) * NWAVES); } } }
        SEAM(1); }
    if (IN(2)) { Frame F = make_frame(lds); ph2_prep(get_args(), F); SEAM(2); }
    if (IN(3)) { Frame F = make_frame(lds); LAS unsigned char* ring = F.lds + RING_OFF; ArgsP a_ = get_args(); unsigned char* ws = a_->ws;
        { pg8::Gemm g{(const bf16_t*)(ws + WS_AW), (const bf16_t*)(ws + WS_WUP), T, RW, LW}; pg8::StaticOrder S; S.init(T, RW, F.G, bid);
          pg8::EpiDec E{(float*)(ws + WS_DEC), a_->w0}; pg8::gemm_phase<pg8::EpiDec, pg8::StaticOrder, true, true>(ring, g, S, E); }
        asm volatile("" ::: "memory"); __builtin_amdgcn_sched_barrier(0);
        { pg8::Gemm g{(const bf16_t*)(ws + WS_AA), (const bf16_t*)(ws + WS_AUP), T, RW, LA}; pg8::StaticOrder S; S.init(T, RW, F.G, bid);
          pg8::EpiA E{(bf16_t*)(ws + WS_KP), (bf16_t*)(ws + WS_BB), (const bf16_t*)(ws + WS_KKN), a_->a0, a_->k_a}; pg8::gemm_phase<pg8::EpiA, pg8::StaticOrder, true, true>(ring, g, S, E); }
        asm volatile("" ::: "memory"); __builtin_amdgcn_sched_barrier(0);
        { pg8::Gemm g{(const bf16_t*)(ws + WS_AG), (const bf16_t*)(ws + WS_GUP), T, RW, LGP}; pg8::StaticOrder S; S.init(T, RW, F.G, bid);
          pg8::EpiBf16 E{(bf16_t*)(ws + WS_G), RW}; pg8::gemm_phase<pg8::EpiBf16, pg8::StaticOrder, true, true>(ring, g, S, E); }
        { Frame F2 = make_frame(lds); ph3_gate(get_args(), F2); }
        SEAM(3); }
    if (IN(4)) { Frame F = make_frame(lds); ph4_chunkprep(get_args(), F); SEAM(4); }
    if (IN(5)) {
        { Frame F = make_frame(lds); if (F.vcu < RH) ph5_chain(get_args(), F, F.vcu); }
        { Frame F = make_frame(lds); ph5_attn(get_args(), F); }
        { Frame F = make_frame(lds); if (F.vcu >= RH) peer_quant(get_args(), F, pq_ra(F.G), 2 * 16384, (F.vcu - RH) * NWAVES + F.wave, (F.G - RH) * NWAVES); }
        SEAM(5); }
    if (IN(6)) { { Frame F = make_frame(lds); ph6_merge(get_args(), F); } { Frame F = make_frame(lds); ph5_ypost(get_args(), F); } SEAM(6); }
    if (IN(7)) { Frame F = make_frame(lds); LAS unsigned char* ring = F.lds + RING_OFF; ArgsP a_ = get_args(); unsigned char* ws = a_->ws;
        { pg8::Gemm g{(const bf16_t*)(ws + WS_YA), (const bf16_t*)(ws + WS_WA), T, D, RW}; pg8::StaticOrder S; S.init(T, D, F.G, bid);
          pg8::EpiMix<false> E{(bf16_t*)(ws + WS_MIXED), (const bf16_t*)(ws + WS_PROJ), PC_GA}; pg8::gemm_phase<pg8::EpiMix<false>, pg8::StaticOrder, true, true>(ring, g, S, E); }
        { pg8::Gemm g{(const bf16_t*)(ws + WS_YB), (const bf16_t*)(ws + WS_WB), T, D, RW}; pg8::StaticOrder S; S.init(T, D, F.G, bid);
          pg8::EpiMix<true> E{(bf16_t*)(ws + WS_MIXED), (const bf16_t*)(ws + WS_PROJ), PC_GB}; pg8::gemm_phase<pg8::EpiMix<true>, pg8::StaticOrder, true, true>(ring, g, S, E); }
        SEAM(7); }
    if (IN(8)) { Frame F = make_frame(lds); LAS unsigned char* ring = F.lds + RING_OFF; ArgsP a_ = get_args(); unsigned char* ws = a_->ws;
        pg8::Gemm g{(const bf16_t*)(ws + WS_MIXED), (const bf16_t*)(ws + WS_WOUT), T, D, D}; pg8::StaticOrder S; S.init(T, D, F.G, bid);
        pg8::EpiRes E{(float*)(ws + WS_X1), a_->x}; pg8::gemm_phase<pg8::EpiRes, pg8::StaticOrder, true, true>(ring, g, S, E);
        SEAM(8); }
    if (IN(9)) { Frame F = make_frame(lds); ArgsP a_ = get_args(); unsigned char* ws = a_->ws; const int gw = F.vcu * NWAVES + F.wave, NGW = F.G * NWAVES;
        rms_rows_to_bf16((const float*)(ws + WS_X1), a_->norm2_g, (bf16_t*)(ws + WS_H2), gw, NGW, F.lane);
        SEAM(9); }
    if (IN(10)) { Frame F = make_frame(lds); LAS unsigned char* ring = F.lds + RING_OFF; ArgsP a_ = get_args(); unsigned char* ws = a_->ws;
        pg8::Gemm g{(const bf16_t*)(ws + WS_H2), (const bf16_t*)(ws + WS_WQ), T, 2048, D}; pg8::StaticOrder S; S.init(T, 2048, F.G, bid);
        pg8::EpiBf16 E{(bf16_t*)(ws + WS_PQ), 2048}; pg8::gemm_phase<pg8::EpiBf16, pg8::StaticOrder, true, true>(ring, g, S, E);
        SEAM(10); }
    if (IN(11)) { Frame F = make_frame(lds); ph10_select(get_args(), F);
        if (IN(12)) { __builtin_amdgcn_fence(__ATOMIC_RELEASE, "workgroup"); WG_BAR(); __builtin_amdgcn_fence(__ATOMIC_ACQUIRE, "workgroup"); } }
    if (IN(12)) { Frame F = make_frame(lds); ph11_gather(get_args(), F); }
#undef IN
#undef SEAM
}

extern "C" void kernel_launch(void* const* d_in, const int* in_sizes, int n_in, void* d_out, int out_size, void* d_ws, size_t ws_size, hipStream_t stream) {
    static int grid = 0;
    if (grid == 0) {
        if (n_in != 23 || out_size != T * D || ws_size < WS_END) { fprintf(stderr, "kernel_launch: unexpected shapes (n_in %d out %d ws %zu); nothing launched\n", n_in, out_size, ws_size); grid = -1; return; }
        int dev = 0, cus = 0, per_cu = 0;
        if (hipGetDevice(&dev) != hipSuccess || hipDeviceGetAttribute(&cus, hipDeviceAttributeMultiprocessorCount, dev) != hipSuccess) { grid = -1; return; }
        if (hipFuncSetAttribute((const void*)mk_fwd, hipFuncAttributeMaxDynamicSharedMemorySize, LDS_BYTES) != hipSuccess) { grid = -1; return; }
        if (hipOccupancyMaxActiveBlocksPerMultiprocessor(&per_cu, (const void*)mk_fwd, NTHR, LDS_BYTES) != hipSuccess || per_cu < 1) fprintf(stderr, "kernel_launch: occupancy query reports %d\n", per_cu);
        (void)hipGetLastError();
        grid = cus;
    }
    if (grid < 0) return;
    (void)hipMemsetAsync((char*)d_ws + WS_CTL, 0, CTL_ZERO_BYTES, stream);
    Args a{};
    const float** ap = (const float**)&a;
    for (int i = 0; i < 23; ++i) ap[i] = (const float*)d_in[i];
    a.out = (float*)d_out; a.ws = (unsigned char*)d_ws; a.pad = 0;
    constexpr int NL = MK_N_LAUNCHES;
    for (int li = 0; li < NL; ++li) {
        a.ph_lo = (NL == 1) ? 0 : li; a.ph_hi = (NL == 1) ? NPH : li + 1; a.li = (NL == 1) ? 0 : 0;
        hipLaunchKernelGGL(mk_fwd, dim3(grid), dim3(NTHR), LDS_BYTES, stream, a);
#ifdef DUP_HI
        if (NL > 1 && li == DUP_HI) for (int l2 = DUP_LO; l2 <= DUP_HI; ++l2) { a.ph_lo = l2; a.ph_hi = l2 + 1; hipLaunchKernelGGL(mk_fwd, dim3(grid), dim3(NTHR), LDS_BYTES, stream, a); }
#endif
    }
}
```

```cpp
#include <hip/hip_runtime.h>
#include <cstdio>
#include <cstdint>

#ifndef MK_N_LAUNCHES
#define MK_N_LAUNCHES 1
#endif

#define GAS __attribute__((address_space(1)))
#define LAS __attribute__((address_space(3)))
typedef unsigned short bf16_t;
typedef __bf16 bf16x8 __attribute__((ext_vector_type(8)));
typedef float f32x2 __attribute__((ext_vector_type(2)));
typedef float f32x4 __attribute__((ext_vector_type(4)));
typedef float f32x16 __attribute__((ext_vector_type(16)));
typedef unsigned u32x2 __attribute__((ext_vector_type(2)));
typedef unsigned u32x4 __attribute__((ext_vector_type(4)));
typedef GAS unsigned gu32;

constexpr int T = 8192, D = 4096;
constexpr int RW = 2048, RH = 32, RN = 64;
constexpr int LW = 128, LA = 128, LG = 480, LGP = 512;
constexpr int SHIFTW = 6880;
constexpr int MH = 16, MD = 128, MBLK = 256, NBLK = 32;
constexpr int INW = 21216;
constexpr int PLD = 19200;
constexpr int PC_R = 0, PC_K = 2048, PC_V = 4096, PC_WL = 6144, PC_AL = 6272, PC_GL = 6400, PC_MQ = 6912, PC_MK = 8960, PC_GA = 11008, PC_GB = 15104, PC_MV = 19200;
constexpr int WIN_ROWS = 21248;
constexpr int PQ_SPLIT = 16384;
constexpr int PH_ = 8, PNK = 128, PQD = 256, PHALF = 128, PTOPK = 16;
constexpr float NORM_EPS = 1e-6f, LNX_EPS = 64e-5f;
constexpr float QSCALE = 0.08838834764831845f * 1.4426950408889634f;

constexpr size_t MiB = 1u << 20;
constexpr size_t WS_CTL = 0, CTL_ZERO_BYTES = 1 * MiB;
constexpr size_t WS_WIN = 1 * MiB;
constexpr size_t WS_X1 = 1 * MiB, WS_PQ = 129 * MiB;
constexpr size_t WS_WA = 167 * MiB, WS_WB = 183 * MiB, WS_WOUT = 199 * MiB, WS_WQ = 231 * MiB, WS_WUP = 247 * MiB, WS_AUP = 248 * MiB, WS_GUP = 249 * MiB, WS_SUBK = 251 * MiB;
constexpr size_t WS_PU = 252 * MiB, WS_PV = 380 * MiB;
constexpr size_t WS_XN = 508 * MiB;
constexpr size_t WS_Y = 508 * MiB, WS_H2 = 508 * MiB;
constexpr size_t WS_PROJ = 572 * MiB;
constexpr size_t WS_VT = 872 * MiB;
constexpr size_t WS_ROPE = 904 * MiB, WS_KMEAN = 908 * MiB, WS_MASK = 909 * MiB, WS_AW = 910 * MiB, WS_AA = 912 * MiB, WS_AG = 914 * MiB;
constexpr size_t WS_PSU = 909 * MiB + 512 * 1024, WS_PSV = WS_PSU + 64 * 1024;
constexpr size_t WS_DEC = 922 * MiB;
constexpr size_t WS_MIXED = 922 * MiB;
constexpr size_t WS_KKN = 986 * MiB, WS_BB = 1018 * MiB, WS_KP = 1050 * MiB, WS_ZR = 1082 * MiB, WS_ZV = 1114 * MiB, WS_G = 1146 * MiB;
constexpr size_t WS_YA = 1178 * MiB, WS_YB = 1210 * MiB, WS_IDX = 1242 * MiB, WS_GW = 1246 * MiB, WS_PARTML = 1250 * MiB, WS_LIST = 1254 * MiB, WS_UDESC = 1262 * MiB, WS_KB = 1267 * MiB, WS_END = 1299 * MiB;
constexpr size_t WS_PARTO = 922 * MiB;

constexpr int CW_TMO = 0, CW_CODE = 1, CW_ATTNQ = 64, CW_CNT = 1024, CW_BAR = 4096;

constexpr int RING_OFF = 0, RING_BYTES = 155648;
constexpr int LDSCTL_OFF = RING_BYTES, MISC_OFF = LDSCTL_OFF + 320;
constexpr int LDS_BYTES = 163840;
constexpr int NWAVES = 8, NTHR = 512;

__device__ __forceinline__ unsigned f2bf(float f) { unsigned u = __builtin_bit_cast(unsigned, f); return (u + 0x7fffu + ((u >> 16) & 1u)) >> 16; }
typedef __bf16 bf16x2 __attribute__((ext_vector_type(2)));
__device__ __forceinline__ unsigned pk2(float lo, float hi) { const f32x2 v = {lo, hi}; return __builtin_bit_cast(unsigned, __builtin_convertvector(v, bf16x2)); }
__device__ __forceinline__ float bflo(unsigned u) { return __builtin_bit_cast(float, u << 16); }
__device__ __forceinline__ float bfhi(unsigned u) { return __builtin_bit_cast(float, u & 0xffff0000u); }
__device__ __forceinline__ float bf1(bf16_t b) { return __builtin_bit_cast(float, (unsigned)b << 16); }
__device__ __forceinline__ float fsigmoid(float x) { return __builtin_amdgcn_rcpf(1.0f + __expf(-x)); }
__device__ __forceinline__ float wave_sum(float v) {
#pragma unroll
    for (int o = 1; o < 64; o <<= 1) v += __shfl_xor(v, o);
    return v;
}
template <int CTRL> __device__ __forceinline__ float dpp_f(float v) { return __builtin_bit_cast(float, __builtin_amdgcn_update_dpp(0, __builtin_bit_cast(int, v), CTRL, 0xF, 0xF, true)); }
__device__ __forceinline__ float sum16(float x) {
    x += dpp_f<0xB1>(x); x += dpp_f<0x4E>(x); x += dpp_f<0x141>(x); x += dpp_f<0x140>(x); return x;
}
__device__ __forceinline__ float vmul(float a, float b) { float r; asm("v_mul_f32_e32 %0, %1, %2" : "=v"(r) : "v"(a), "v"(b)); return r; }
__device__ __forceinline__ float vfma(float a, float b, float c) { float r; asm("v_fma_f32 %0, %1, %2, %3" : "=v"(r) : "v"(a), "v"(b), "v"(c)); return r; }
#define LDS_WAIT() asm volatile("s_waitcnt lgkmcnt(0)" ::: "memory")
#define VM_WAIT() asm volatile("s_waitcnt vmcnt(0)" ::: "memory")
#define WG_BAR() do { asm volatile("s_waitcnt lgkmcnt(0)" ::: "memory"); __builtin_amdgcn_s_barrier(); asm volatile("" ::: "memory"); } while (0)

namespace pg8 {
constexpr int BM = 256, BK = 64, HALF = 128, HTB = HALF * BK * 2, STAGE_BYTES = 8 * HTB, NXCD = 8, WGM = 8;
__host__ __device__ __forceinline__ int lds_byte(int r, int c) { const int st = (r >> 4) * 2 + (c >> 5), rr = r & 15, cc = c & 31, ob = rr * 64 + cc * 2; return st * 1024 + (ob ^ (((ob >> 9) & 1) << 5)); }
__host__ __device__ __forceinline__ void stage_rc(int b, int& R, int& C) { const int st = b / 1024, sb = b % 1024, swz = sb ^ (((sb >> 9) & 1) << 5); R = (st >> 1) * 16 + swz / 64; C = (st & 1) * 32 + (swz % 64) / 2; }
__host__ __device__ __forceinline__ int perm32(int rho) { const int n = rho >> 4, i = rho & 15; return 8 * (i >> 2) + 4 * n + (i & 3); }

struct Unit { int pm, pn; };
struct Gemm { const bf16_t* A; const bf16_t* Bt; int M, N, K; };

struct StaticOrder {
    int nM, nN, nwg, G, c;
    __host__ __device__ void init(int M, int N, int G_, int c_) { nM = M / BM; nN = N / BM; nwg = nM * nN; G = G_; c = c_; }
    __host__ __device__ bool next(int i, Unit& u) const {
        const long L = (long)i * G + c; if (L >= nwg) return false;
        int wgid = (int)L; { const int q = nwg / NXCD, r = nwg % NXCD, xcd = wgid % NXCD, off = wgid / NXCD; wgid = (xcd < r ? xcd * (q + 1) : r * (q + 1) + (xcd - r) * q) + off; }
        const int nig = WGM * nN, gid = wgid / nig, fm = gid * WGM, gsz = (nM - fm) < WGM ? (nM - fm) : WGM;
        u.pm = fm + ((wgid % nig) % gsz); u.pn = (wgid % nig) / gsz; return true;
    }
    __device__ __forceinline__ void a_ready(const Unit&) const {}
    __device__ __forceinline__ void done(const Unit&) const {}
};

template <class Epi, class Sched, bool ALIGN_EPI = false, bool SP2 = false>
__device__ __forceinline__ void gemm_phase(LAS unsigned char* lds, const Gemm g, const Sched& S, const Epi& E) {
    int tid_ = threadIdx.x; asm volatile("" : "+v"(tid_));
    const int tid = tid_, wid = __builtin_amdgcn_readfirstlane(tid >> 6), lane = tid & 63, wr = wid >> 2, wc = wid & 3, fr = lane & 15, fq = lane >> 4;
    int K_ = g.K; asm volatile("" : "+s"(K_));
    const int K = K_, nt = K / BK;
    unsigned voffA[2], voffB[2];
#pragma unroll
    for (int i = 0; i < 2; ++i) { int R, C; stage_rc(tid * 16 + i * 8192, R, C); const int Rb = Epi::PERM ? ((R & ~31) + perm32(R & 31)) : R;
        voffA[i] = (unsigned)(R * K + C) * 2u; voffB[i] = (unsigned)(Rb * K + C) * 2u; }
    const size_t kstep = (size_t)(BK * 2);
    const size_t hstep = (size_t)HALF * K * 2;
    const size_t tstep = 2 * hstep;
    const unsigned ldsw = (unsigned)wid * 1024u;
    const int aoff = lds_byte(wr * 64 + fr, fq * 8), boff = lds_byte(wc * 32 + fr, fq * 8);
#define PG8_SA(b, h) (((b) * 2 + (h)) * HTB)
#define PG8_SB(b, h) ((4 + (b) * 2 + (h)) * HTB)
#define PG8_STAGE(bufoff, gbase, voff) do { _Pragma("unroll") for (int _i = 0; _i < 2; ++_i) \
        __builtin_amdgcn_global_load_lds((const unsigned*)((const char*)(gbase) + (voff)[_i]), (LAS unsigned*)(lds + (bufoff) + ldsw + _i * 8192), 16, 0, 0); } while (0)
#define PG8_LDA(dst, b, h) do { _Pragma("unroll") for (int m = 0; m < 4; ++m) _Pragma("unroll") for (int k = 0; k < 2; ++k) dst[m][k] = *(const LAS bf16x8*)(lds + PG8_SA(b, h) + aoff + m * 2048 + k * 1024); } while (0)
#define PG8_LDB(dst, b, h) do { _Pragma("unroll") for (int n = 0; n < 2; ++n) _Pragma("unroll") for (int k = 0; k < 2; ++k) dst[n][k] = *(const LAS bf16x8*)(lds + PG8_SB(b, h) + boff + n * 2048 + k * 1024); } while (0)
#define PG8_MMA(ai, bj, At, Bt) do { __builtin_amdgcn_s_setprio(1); _Pragma("unroll") for (int m = 0; m < 4; ++m) _Pragma("unroll") for (int n = 0; n < 2; ++n) _Pragma("unroll") for (int k = 0; k < 2; ++k) { \
        if constexpr (Epi::SWAP) acc[ai][bj][m][n] = __builtin_amdgcn_mfma_f32_16x16x32_bf16(At[m][k], Bt[n][k], acc[ai][bj][m][n], 0, 0, 0); \
        else acc[ai][bj][m][n] = __builtin_amdgcn_mfma_f32_16x16x32_bf16(Bt[n][k], At[m][k], acc[ai][bj][m][n], 0, 0, 0); } __builtin_amdgcn_s_setprio(0); } while (0)
#define PG8_WAIT_V(n) asm volatile("s_waitcnt vmcnt(" #n ")" ::: "memory")
#define PG8_WAIT_L(n) asm volatile("s_waitcnt lgkmcnt(" #n ")" ::: "memory")
#define PG8_BAR __builtin_amdgcn_s_barrier()
#define PG8_SCHED __builtin_amdgcn_sched_barrier(0)
    Unit cur, nxt; int ui = 0;
    if (!S.next(0, cur)) return;
    f32x4 acc[2][2][4][2];
#pragma unroll
    for (int a = 0; a < 2; ++a)
#pragma unroll
        for (int b = 0; b < 2; ++b)
#pragma unroll
            for (int m = 0; m < 4; ++m)
#pragma unroll
                for (int n = 0; n < 2; ++n) acc[a][b][m][n] = (f32x4){0.f, 0.f, 0.f, 0.f};
    bf16x8 At[4][2], B0[2][2], B1[2][2];
    const char* cA = (const char*)g.A + (size_t)cur.pm * tstep; const char* cB = (const char*)g.Bt + (size_t)cur.pn * tstep;
    S.a_ready(cur);
    if constexpr (SP2) {
        PG8_STAGE(PG8_SB(0, 0), cB, voffB); PG8_STAGE(PG8_SB(0, 1), cB + hstep, voffB); PG8_STAGE(PG8_SA(0, 0), cA, voffA); PG8_STAGE(PG8_SA(0, 1), cA + hstep, voffA);
        if (wr == 1) PG8_BAR;
        PG8_WAIT_V(2); PG8_BAR;
        PG8_STAGE(PG8_SB(1, 0), cB + kstep, voffB); PG8_STAGE(PG8_SA(1, 0), cA + kstep, voffA); PG8_STAGE(PG8_SB(1, 1), cB + hstep + kstep, voffB);
        PG8_WAIT_V(6); PG8_BAR;
    } else {
        PG8_STAGE(PG8_SB(0, 0), cB, voffB); PG8_STAGE(PG8_SA(0, 0), cA, voffA); PG8_STAGE(PG8_SB(0, 1), cB + hstep, voffB); PG8_STAGE(PG8_SA(0, 1), cA + hstep, voffA);
        if (wr == 1) PG8_BAR;
        PG8_WAIT_V(4); PG8_BAR;
        PG8_STAGE(PG8_SB(1, 0), cB + kstep, voffB); PG8_STAGE(PG8_SA(1, 0), cA + kstep, voffA); PG8_STAGE(PG8_SB(1, 1), cB + hstep + kstep, voffB);
        PG8_WAIT_V(6); PG8_BAR;
    }
    for (;;) {
        const bool has_next = S.next(ui + 1, nxt);
        const char* nA = has_next ? (const char*)g.A + (size_t)nxt.pm * tstep : cA; const char* nB = has_next ? (const char*)g.Bt + (size_t)nxt.pn * tstep : cB;
        for (int t = 0; t < nt; t += 2) {
            const bool last = (t == nt - 2);
            const char* a1 = cA + (size_t)(t + 1) * kstep;
            const char* a2 = last ? nA : cA + (size_t)(t + 2) * kstep; const char* b2 = last ? nB : cB + (size_t)(t + 2) * kstep;
            const char* a3 = a2 + kstep; const char* b3 = b2 + kstep;
            if (last && has_next) S.a_ready(nxt);
            if constexpr (SP2) {
            PG8_LDB(B0, 0, 0); PG8_LDB(B1, 0, 1); PG8_SCHED; PG8_LDA(At, 0, 0); PG8_STAGE(PG8_SA(1, 1), a1 + hstep, voffA);
            PG8_WAIT_V(8); PG8_WAIT_L(0); PG8_BAR; PG8_MMA(0, 0, At, B0); PG8_MMA(0, 1, At, B1); PG8_BAR; PG8_SCHED;
            PG8_LDA(At, 0, 1); PG8_STAGE(PG8_SB(0, 0), b2, voffB); PG8_STAGE(PG8_SB(0, 1), b2 + hstep, voffB); PG8_STAGE(PG8_SA(0, 0), a2, voffA);
            PG8_WAIT_V(8); PG8_WAIT_L(0); PG8_BAR; PG8_MMA(1, 0, At, B0); PG8_MMA(1, 1, At, B1); PG8_BAR; PG8_SCHED;
            PG8_LDB(B0, 1, 0); PG8_LDB(B1, 1, 1); PG8_SCHED; PG8_LDA(At, 1, 0); PG8_STAGE(PG8_SA(0, 1), a2 + hstep, voffA);
            PG8_WAIT_V(8); PG8_WAIT_L(0); PG8_BAR; PG8_MMA(0, 0, At, B0); PG8_MMA(0, 1, At, B1); PG8_BAR; PG8_SCHED;
            PG8_LDA(At, 1, 1); PG8_STAGE(PG8_SB(1, 0), b3, voffB); PG8_STAGE(PG8_SB(1, 1), b3 + hstep, voffB); PG8_STAGE(PG8_SA(1, 0), a3, voffA);
            PG8_WAIT_V(8); PG8_WAIT_L(0); PG8_BAR; PG8_MMA(1, 0, At, B0); PG8_MMA(1, 1, At, B1); PG8_BAR; PG8_SCHED;
            } else {
            PG8_LDB(B0, 0, 0); PG8_SCHED; PG8_LDA(At, 0, 0); PG8_STAGE(PG8_SA(1, 1), a1 + hstep, voffA);
            PG8_WAIT_L(8); PG8_BAR; PG8_WAIT_L(0); PG8_MMA(0, 0, At, B0); PG8_BAR; PG8_SCHED;
            PG8_LDB(B1, 0, 1); PG8_STAGE(PG8_SB(0, 0), b2, voffB);
            PG8_BAR; PG8_WAIT_L(0); PG8_MMA(0, 1, At, B1); PG8_BAR;
            PG8_LDA(At, 0, 1); PG8_STAGE(PG8_SA(0, 0), a2, voffA);
            PG8_BAR; PG8_WAIT_L(0); PG8_MMA(1, 0, At, B0); PG8_BAR; PG8_SCHED;
            PG8_STAGE(PG8_SB(0, 1), b2 + hstep, voffB);
            PG8_WAIT_V(6); PG8_BAR; PG8_MMA(1, 1, At, B1); PG8_BAR;
            PG8_LDB(B0, 1, 0); PG8_SCHED; PG8_LDA(At, 1, 0); PG8_STAGE(PG8_SA(0, 1), a2 + hstep, voffA);
            PG8_WAIT_L(8); PG8_BAR; PG8_WAIT_L(0); PG8_MMA(0, 0, At, B0); PG8_BAR; PG8_SCHED;
            PG8_LDB(B1, 1, 1); PG8_STAGE(PG8_SB(1, 0), b3, voffB);
            PG8_BAR; PG8_WAIT_L(0); PG8_MMA(0, 1, At, B1); PG8_BAR;
            PG8_LDA(At, 1, 1); PG8_STAGE(PG8_SA(1, 0), a3, voffA);
            PG8_BAR; PG8_WAIT_L(0); PG8_MMA(1, 0, At, B0); PG8_BAR; PG8_SCHED;
            PG8_STAGE(PG8_SB(1, 1), b3 + hstep, voffB);
            PG8_WAIT_V(6); PG8_BAR; PG8_MMA(1, 1, At, B1); PG8_BAR;
            }
        }
        if constexpr (ALIGN_EPI) { if (wr == 0) PG8_BAR; }
        E(acc, cur, wr, wc, fr, fq); S.done(cur);
        if (!has_next) break;
#pragma unroll
        for (int a = 0; a < 2; ++a)
#pragma unroll
            for (int b = 0; b < 2; ++b)
#pragma unroll
                for (int m = 0; m < 4; ++m)
#pragma unroll
                    for (int n = 0; n < 2; ++n) acc[a][b][m][n] = (f32x4){0.f, 0.f, 0.f, 0.f};
        cur = nxt; cA = nA; cB = nB; ++ui;
        if constexpr (ALIGN_EPI) { if (wr == 1) PG8_BAR; }
    }
    PG8_WAIT_V(0);
    if constexpr (!ALIGN_EPI) { if (wr == 0) PG8_BAR; }
    PG8_BAR;
#undef PG8_SA
#undef PG8_SB
#undef PG8_STAGE
#undef PG8_LDA
#undef PG8_LDB
#undef PG8_MMA
#undef PG8_WAIT_V
#undef PG8_WAIT_L
#undef PG8_BAR
#undef PG8_SCHED
}

typedef const f32x4 (&AccRef)[2][2][4][2];
__device__ __forceinline__ u32x4 pack8(f32x4 v0, f32x4 v1) { u32x4 w; w.x = pk2(v0[0], v0[1]); w.y = pk2(v0[2], v0[3]); w.z = pk2(v1[0], v1[1]); w.w = pk2(v1[2], v1[3]); return w; }
__device__ __forceinline__ void unpack8(u32x4 w, f32x4& v0, f32x4& v1) { v0 = (f32x4){bflo(w.x), bfhi(w.x), bflo(w.y), bfhi(w.y)}; v1 = (f32x4){bflo(w.z), bfhi(w.z), bflo(w.w), bfhi(w.w)}; }

struct EpiBf16 {
    static constexpr bool PERM = true, SWAP = false;
    bf16_t* O; int ldc;
    __device__ __forceinline__ void operator()(AccRef acc, const Unit& u, int wr, int wc, int fr, int fq) const {
        const int row0 = u.pm * BM + wr * 64 + fr, col0 = u.pn * BM + wc * 32 + 8 * fq;
#pragma unroll
        for (int ai = 0; ai < 2; ++ai)
#pragma unroll
            for (int m = 0; m < 4; ++m) { bf16_t* rowp = O + (size_t)(row0 + ai * HALF + m * 16) * ldc + col0;
#pragma unroll
                for (int bj = 0; bj < 2; ++bj) *(u32x4*)(rowp + bj * HALF) = pack8(acc[ai][bj][m][0], acc[ai][bj][m][1]); }
    }
};
struct EpiProj {
    static constexpr bool PERM = true, SWAP = false;
    bf16_t* O; const float* rope; bf16_t* KB;
    __device__ __forceinline__ void operator()(AccRef acc, const Unit& u, int wr, int wc, int fr, int fq) const {
        const int row0 = u.pm * BM + wr * 64 + fr, col0 = u.pn * BM + wc * 32 + 8 * fq;
        const int mode = (u.pn >= 27 && u.pn < 43) ? (u.pn < 35 ? 1 : 2) : 0;
        const float sc = (mode == 1) ? QSCALE : 1.0f;
#pragma unroll
        for (int ai = 0; ai < 2; ++ai)
#pragma unroll
            for (int m = 0; m < 4; ++m) { const int row = row0 + ai * HALF + m * 16; bf16_t* rowp = O + (size_t)row * PLD + col0;
#pragma unroll
                for (int bj = 0; bj < 2; ++bj) { f32x4 v0 = acc[ai][bj][m][0], v1 = acc[ai][bj][m][1];
                    if (mode) { const int i0 = ((col0 + bj * HALF) & 127) >> 1; const f32x4* rp = (const f32x4*)(rope + ((size_t)row * 64 + i0) * 2); const f32x4 c0 = rp[0], c1 = rp[1];
                        f32x4 o0, o1;
                        o0[0] = v0[0] * c0[0] - v0[1] * c0[1]; o0[1] = v0[1] * c0[0] + v0[0] * c0[1]; o0[2] = v0[2] * c0[2] - v0[3] * c0[3]; o0[3] = v0[3] * c0[2] + v0[2] * c0[3];
                        o1[0] = v1[0] * c1[0] - v1[1] * c1[1]; o1[1] = v1[1] * c1[0] + v1[0] * c1[1]; o1[2] = v1[2] * c1[2] - v1[3] * c1[3]; o1[3] = v1[3] * c1[2] + v1[2] * c1[3];
                        v0 = o0 * sc; v1 = o1 * sc; }
                    if (mode == 2) *(u32x4*)(KB + ((size_t)((u.pn - 35) * 2 + bj) * T + row) * MD + wc * 32 + 8 * fq) = pack8(v0, v1);
                    else *(u32x4*)(rowp + bj * HALF) = pack8(v0, v1); } }
    }
};
struct EpiVT {
    static constexpr bool PERM = false, SWAP = true;
    bf16_t* VT;
    __device__ __forceinline__ void operator()(AccRef acc, const Unit& u, int wr, int wc, int fr, int fq) const {
        const int tok0 = u.pm * BM + wr * 64 + 4 * fq, col0 = u.pn * BM + wc * 32 + fr;
#pragma unroll
        for (int ai = 0; ai < 2; ++ai)
#pragma unroll
            for (int m = 0; m < 4; ++m)
#pragma unroll
                for (int bj = 0; bj < 2; ++bj)
#pragma unroll
                    for (int n = 0; n < 2; ++n) { const f32x4 v = acc[ai][bj][m][n]; u32x2 w; w.x = pk2(v[0], v[1]); w.y = pk2(v[2], v[3]);
                        const int d = col0 + bj * HALF + n * 16, tl = (u.pm * BM + wr * 64 + ai * HALF) >> 6;
                        *(u32x2*)(VT + ((size_t)((d >> 7) * (T / 64) + tl) * MD + (d & 127)) * 64 + m * 16 + 4 * (((fq & 1) << 1) | (fq >> 1))) = w; }
    }
};
struct EpiDec {
    static constexpr bool PERM = true, SWAP = false;
    float* O; const float* w0;
    __device__ __forceinline__ void operator()(AccRef acc, const Unit& u, int wr, int wc, int fr, int fq) const {
        const int row0 = u.pm * BM + wr * 64 + fr, col0 = u.pn * BM + wc * 32 + 8 * fq;
#pragma unroll
        for (int bj = 0; bj < 2; ++bj) { const f32x4 b0 = *(const f32x4*)(w0 + col0 + bj * HALF), b1 = *(const f32x4*)(w0 + col0 + bj * HALF + 4);
#pragma unroll
            for (int ai = 0; ai < 2; ++ai)
#pragma unroll
                for (int m = 0; m < 4; ++m) { float* rowp = O + (size_t)(row0 + ai * HALF + m * 16) * RW + col0 + bj * HALF;
#pragma unroll
                    for (int n = 0; n < 2; ++n) { const f32x4 x = acc[ai][bj][m][n] + (n ? b1 : b0); f32x4 o;
#pragma unroll
                        for (int e = 0; e < 4; ++e) { const float z = -x[e]; const float sp = fmaxf(z, 0.f) + __logf(1.0f + __expf(-fabsf(z))); o[e] = __expf(-__expf(-sp - 0.5f)); }
                        *(f32x4*)(rowp + 4 * n) = o; }
                    asm volatile("" ::: "memory"); } }
    }
};
struct EpiA {
    static constexpr bool PERM = true, SWAP = false;
    bf16_t* KP; bf16_t* BB; const bf16_t* KKN; const float* a0; const float* k_a;
    __device__ __forceinline__ void operator()(AccRef acc, const Unit& u, int wr, int wc, int fr, int fq) const {
        const int row0 = u.pm * BM + wr * 64 + fr, col0 = u.pn * BM + wc * 32 + 8 * fq;
#pragma unroll
        for (int bj = 0; bj < 2; ++bj) { const int cb = col0 + bj * HALF;
            const f32x4 b0 = *(const f32x4*)(a0 + cb), b1 = *(const f32x4*)(a0 + cb + 4), ka0 = *(const f32x4*)(k_a + cb), ka1 = *(const f32x4*)(k_a + cb + 4);
#pragma unroll
            for (int ai = 0; ai < 2; ++ai)
#pragma unroll
                for (int m = 0; m < 4; ++m) { const size_t off = (size_t)(row0 + ai * HALF + m * 16) * RW + cb;
                    f32x4 zk0, zk1, kn0, kn1; unpack8(*(const u32x4*)(KP + off), zk0, zk1); unpack8(*(const u32x4*)(KKN + off), kn0, kn1);
                    f32x4 a0v, a1v;
#pragma unroll
                    for (int e = 0; e < 4; ++e) { a0v[e] = fsigmoid(acc[ai][bj][m][0][e] + b0[e]); a1v[e] = fsigmoid(acc[ai][bj][m][1][e] + b1[e]); }
                    const f32x4 kp0 = zk0 * (1.0f + (a0v - 1.0f) * ka0), kp1 = zk1 * (1.0f + (a1v - 1.0f) * ka1);
                    *(u32x4*)(KP + off) = pack8(kp0, kp1); *(u32x4*)(BB + off) = pack8(-(kn0 * a0v), -(kn1 * a1v));
                    asm volatile("" ::: "memory"); } }
    }
};
template <bool ADD> struct EpiMix {
    static constexpr bool PERM = true, SWAP = false;
    bf16_t* O; const bf16_t* proj; int gcol0;
    __device__ __forceinline__ void operator()(AccRef acc, const Unit& u, int wr, int wc, int fr, int fq) const {
        const int row0 = u.pm * BM + wr * 64 + fr, col0 = u.pn * BM + wc * 32 + 8 * fq;
#pragma unroll
        for (int ai = 0; ai < 2; ++ai)
#pragma unroll
            for (int m = 0; m < 4; ++m) { const int row = row0 + ai * HALF + m * 16;
#pragma unroll
                for (int bj = 0; bj < 2; ++bj) { f32x4 g0, g1; unpack8(*(const u32x4*)(proj + (size_t)row * PLD + gcol0 + col0 + bj * HALF), g0, g1);
                    f32x4 o0, o1;
#pragma unroll
                    for (int e = 0; e < 4; ++e) { o0[e] = fsigmoid(g0[e]) * acc[ai][bj][m][0][e]; o1[e] = fsigmoid(g1[e]) * acc[ai][bj][m][1][e]; }
                    bf16_t* op = O + (size_t)row * D + col0 + bj * HALF;
                    if (ADD) { f32x4 p0, p1; unpack8(*(const u32x4*)op, p0, p1); o0 += p0; o1 += p1; }
                    *(u32x4*)op = pack8(o0, o1); } }
    }
};
struct EpiRes {
    static constexpr bool PERM = true, SWAP = false;
    float* O; const float* x;
    __device__ __forceinline__ void operator()(AccRef acc, const Unit& u, int wr, int wc, int fr, int fq) const {
        const int row0 = u.pm * BM + wr * 64 + fr, col0 = u.pn * BM + wc * 32 + 8 * fq;
#pragma unroll
        for (int ai = 0; ai < 2; ++ai)
#pragma unroll
            for (int m = 0; m < 4; ++m) { const size_t off = (size_t)(row0 + ai * HALF + m * 16) * D + col0;
#pragma unroll
                for (int bj = 0; bj < 2; ++bj)
#pragma unroll
                    for (int n = 0; n < 2; ++n) *(f32x4*)(O + off + bj * HALF + 4 * n) = *(const f32x4*)(x + off + bj * HALF + 4 * n) + acc[ai][bj][m][n]; }
    }
};
}

#define XB_TMO      128
#define XB_XCNT(j)  (256  + 64 * (j))
#define XB_XSUB(j)  (1280 + 64 * (j))
#define XB_XGEN(j)  (2304 + 64 * (j))
#define XB_TOP      3328
#define XB_TOPGEN   3392
#define XCD_BAR_WORDS 3456
#define XB_SPIN_CAP (1u << 18)
__device__ __forceinline__ unsigned xb_ld(unsigned* p)              { return __hip_atomic_load(p, __ATOMIC_RELAXED, __HIP_MEMORY_SCOPE_AGENT); }
__device__ __forceinline__ unsigned xb_add(unsigned* p, unsigned v) { return __hip_atomic_fetch_add(p, v, __ATOMIC_RELAXED, __HIP_MEMORY_SCOPE_AGENT); }
__device__ __forceinline__ unsigned xb_xcc_id() { return (unsigned)__builtin_amdgcn_s_getreg((3 << 11) | 20) & 0xFu; }
#define XB_SPIN(cond, bar) do { unsigned _sp = 0; while (cond) { __builtin_amdgcn_s_sleep(1); \
    if ((++_sp & 255u) == 0u) { if (xb_ld(&(bar)[XB_TMO])) break; if (_sp > XB_SPIN_CAP) { atomicAdd(&(bar)[XB_TMO], 1u); break; } } } } while (0)
struct XcdBarrier { unsigned* bar; unsigned x; volatile LAS unsigned* st; };
__device__ __forceinline__ XcdBarrier xcd_barrier_post(unsigned* bar, volatile LAS unsigned* st) {
    XcdBarrier b; b.bar = bar; b.x = xb_xcc_id(); b.st = st;
    if (threadIdx.x == 0) (void)xb_add(&bar[XB_XCNT(b.x)], 1u);
    return b;
}
__device__ __forceinline__ void xcd_barrier_complete(unsigned* bar, unsigned x, unsigned& nloc, unsigned& nx) {
    const unsigned G = gridDim.x * gridDim.y * gridDim.z;
    unsigned sum, cnt, mine, sp = 0u;
    for (;;) {
        sum = 0u; cnt = 0u; mine = 0u;
#pragma unroll
        for (unsigned j = 0; j < 16; ++j) { const unsigned c = xb_ld(&bar[XB_XCNT(j)]); sum += c; cnt += (c > 0u) ? 1u : 0u; mine = (j == x) ? c : mine; }
        if (sum == G) break;
        __builtin_amdgcn_s_sleep(1);
        if ((++sp & 255u) == 0u) { if (xb_ld(&bar[XB_TMO])) break; if (sp > XB_SPIN_CAP) { atomicAdd(&bar[XB_TMO], 1u); break; } }
    }
    nloc = mine > 0u ? mine : 1u; nx = cnt > 0u ? cnt : 1u;
}
__device__ __forceinline__ void xcd_barrier(const XcdBarrier& b) {
    asm volatile("s_waitcnt vmcnt(0)" ::: "memory");
    __syncthreads();
    if (threadIdx.x == 0) {
        unsigned* bar = b.bar;
        __builtin_amdgcn_s_waitcnt(0);
        unsigned nloc = b.st[0], nx = b.st[1];
        if (nloc == 0u) { xcd_barrier_complete(bar, b.x, nloc, nx); b.st[0] = nloc; b.st[1] = nx; }
        const unsigned old = xb_add(&bar[XB_XSUB(b.x)], 1u);
        const unsigned gen = old / nloc;
        if (old + 1u == (gen + 1u) * nloc) {
            __builtin_amdgcn_fence(__ATOMIC_RELEASE, "agent");
            asm volatile("s_waitcnt vmcnt(0)" ::: "memory");
            const unsigned og = xb_add(&bar[XB_TOP], 1u);
            const unsigned tg = og / nx;
            if (og + 1u == (tg + 1u) * nx) xb_add(&bar[XB_TOPGEN], 1u);
            else XB_SPIN(xb_ld(&bar[XB_TOPGEN]) == tg, bar);
            __builtin_amdgcn_fence(__ATOMIC_ACQUIRE, "agent");
            xb_add(&bar[XB_XGEN(b.x)], 1u);
            asm volatile("s_waitcnt vmcnt(0)" ::: "memory");
        } else {
            XB_SPIN(xb_ld(&bar[XB_XGEN(b.x)]) == gen, bar);
            __builtin_amdgcn_fence(__ATOMIC_ACQUIRE, "agent");
            asm volatile("s_waitcnt vmcnt(0)" ::: "memory");
        }
    }
    __syncthreads();
}

struct Args {
    const float *x, *norm1_g, *w_in, *mu, *w0, *w_up, *a0, *a_up, *g_up, *k_k, *k_a, *r_k, *lnx_g, *lnx_b, *w_ba, *w_bb, *w_out, *norm2_g, *peer_wq, *sub_keys, *peer_u, *peer_v, *final_g;
    float* out; unsigned char* ws; int ph_lo, ph_hi, li, pad;
};
#define CAS __attribute__((address_space(4)))
typedef const CAS Args* ArgsP;
__device__ __forceinline__ ArgsP get_args() { ArgsP p = (ArgsP)__builtin_amdgcn_kernarg_segment_ptr(); asm volatile("" : "+s"(p)); return p; }
struct Frame { LAS unsigned char* lds; int tid, lane, wave, vcu, G; };

__device__ __forceinline__ int win_dst(int s) {
    if (s < SHIFTW) return s;
    if (s < SHIFTW + 4096) { const int base = (s < SHIFTW + 2048) ? SHIFTW : SHIFTW + 2048; const int m = s - base, head = m >> 7, c = m & 127; const int j = (c < 64) ? 2 * c : 2 * (c - 64) + 1;
        return ((s < SHIFTW + 2048) ? PC_MQ : PC_MK) + head * 128 + j; }
    if (s < SHIFTW + 6144) return PC_MV + (s - (SHIFTW + 4096));
    if (s < SHIFTW + 6144 + 4096) return PC_GA + (s - (SHIFTW + 6144));
    return PC_GB + (s - (SHIFTW + 6144 + 4096));
}
template <bool MAPWIN> __device__ __forceinline__ void p0_transpose_item(const float* W, int K, int N, bf16_t* WT, int Kd, LAS float* scr, int item, int lane) {
    const int nblk = N / 32, kb = item / nblk, nb = item % nblk, k0 = 64 * kb, n0 = 32 * nb;
    { const int krow = lane >> 3, c4 = lane & 7; f32x4 v[8];
#pragma unroll
      for (int i = 0; i < 8; ++i) { const int kk = 8 * i + krow; v[i] = (k0 + kk < K) ? *(const f32x4*)(W + (size_t)(k0 + kk) * N + n0 + 4 * c4) : (f32x4){0.f, 0.f, 0.f, 0.f}; }
#pragma unroll
      for (int i = 0; i < 8; ++i) { LAS float* d = scr + (8 * i + krow) * 33 + 4 * c4; d[0] = v[i].x; d[1] = v[i].y; d[2] = v[i].z; d[3] = v[i].w; } }
    LDS_WAIT(); asm volatile("" ::: "memory");
    const int c = lane & 7;
#pragma unroll
    for (int j = 0; j < 4; ++j) { const int n = (lane >> 3) + 8 * j; const LAS float* s = scr + (8 * c) * 33 + n;
        u32x4 o; o.x = pk2(s[0 * 33], s[1 * 33]); o.y = pk2(s[2 * 33], s[3 * 33]); o.z = pk2(s[4 * 33], s[5 * 33]); o.w = pk2(s[6 * 33], s[7 * 33]);
        const int row = MAPWIN ? win_dst(n0 + n) : (n0 + n);
        *(u32x4*)(WT + (size_t)row * Kd + k0 + 8 * c) = o; }
    LDS_WAIT(); asm volatile("" ::: "memory");
}
__device__ __forceinline__ void rms_rows_to_bf16(const float* x, const float* g, bf16_t* o, int m0, int mstride, int lane) {
    const f32x4* gr = (const f32x4*)g + lane;
    f32x4 v[16], w[16];
    if (m0 < T) {
#pragma unroll
        for (int j = 0; j < 16; ++j) v[j] = ((const f32x4*)(x + (size_t)m0 * D) + lane)[64 * j]; }
    for (int m = m0; m < T; m += mstride) { const bool hasn = m + mstride < T;
        if (hasn) {
#pragma unroll
            for (int j = 0; j < 16; ++j) w[j] = ((const f32x4*)(x + (size_t)(m + mstride) * D) + lane)[64 * j]; }
        float s = 0.f;
#pragma unroll
        for (int j = 0; j < 16; ++j) s += (v[j].x * v[j].x + v[j].y * v[j].y) + (v[j].z * v[j].z + v[j].w * v[j].w);
        const float rs = 1.0f / sqrtf(wave_sum(s) * (1.0f / D) + NORM_EPS);
        u32x2* o8 = (u32x2*)(o + (size_t)m * D) + lane;
#pragma unroll
        for (int j = 0; j < 16; ++j) { const f32x4 gg = gr[64 * j]; u32x2 q; q.x = pk2(v[j].x * rs * gg.x, v[j].y * rs * gg.y); q.y = pk2(v[j].z * rs * gg.z, v[j].w * rs * gg.w); o8[64 * j] = q; }
        if (hasn) {
#pragma unroll
            for (int j = 0; j < 16; ++j) v[j] = w[j]; }
    }
}
__device__ __forceinline__ void cvt_table(const float* src, bf16_t* dst, size_t n8, size_t gtid, size_t nthr) {
    for (size_t i = gtid; i < n8; i += nthr) { const f32x4 a = ((const f32x4*)src)[2 * i], b = ((const f32x4*)src)[2 * i + 1]; ((u32x4*)dst)[i] = pg8::pack8(a, b); }
}
__device__ __forceinline__ void pq_load(ArgsP A, int row, int lane, f32x4 (&v)[16]) {
    const f32x4* src = (const f32x4*)((row >= 16384 ? A->peer_v + (size_t)(row - 16384) * D : A->peer_u + (size_t)row * D)) + lane;
#pragma unroll
    for (int j = 0; j < 16; ++j) v[j] = __builtin_nontemporal_load(src + 64 * j);
}
__device__ __forceinline__ void pq_finish(unsigned char* ws, int row, int lane, const f32x4 (&v)[16]) {
    const bool isv = row >= 16384; const int rr = isv ? row - 16384 : row; float am = 0.f;
#pragma unroll
    for (int j = 0; j < 16; ++j) am = fmaxf(fmaxf(am, fmaxf(fabsf(v[j].x), fabsf(v[j].y))), fmaxf(fabsf(v[j].z), fabsf(v[j].w)));
#pragma unroll
    for (int o = 1; o < 64; o <<= 1) am = fmaxf(am, __shfl_xor(am, o));
    const float inv = am > 0.f ? 127.0f / am : 0.f; unsigned* dst = (unsigned*)(ws + (isv ? WS_PV : WS_PU)) + (size_t)rr * (D / 4) + lane;
    constexpr float MAGIC = 8388608.0f + 128.0f;
#pragma unroll
    for (int j = 0; j < 16; ++j) { const unsigned b0 = __builtin_bit_cast(unsigned, __builtin_fmaf(v[j].x, inv, MAGIC)), b1 = __builtin_bit_cast(unsigned, __builtin_fmaf(v[j].y, inv, MAGIC)),
                                                  b2 = __builtin_bit_cast(unsigned, __builtin_fmaf(v[j].z, inv, MAGIC)), b3 = __builtin_bit_cast(unsigned, __builtin_fmaf(v[j].w, inv, MAGIC));
        dst[64 * j] = __builtin_amdgcn_perm(__builtin_amdgcn_perm(b3, b2, 0x0c0c0400u), __builtin_amdgcn_perm(b1, b0, 0x0c0c0400u), 0x05040100u); }
    if (lane == 0) ((float*)(ws + (isv ? WS_PSV : WS_PSU)))[rr] = am * (1.0f / 127.0f);
}
__device__ __forceinline__ int pq_ra(int G) { constexpr int NT1 = (T / 256) * (PLD / 256); const int nx = NT1 % G, idle = nx ? G - nx : 0, n = idle * NWAVES * 7; return n < 2 * 16384 ? n : 2 * 16384; }
__device__ __forceinline__ void peer_quant(ArgsP A, Frame& F, int r0, int r1, int w0, int wstride) {
    f32x4 v[16], w[16];
    int row = r0 + w0;
    if (row < r1) pq_load(A, row, F.lane, v);
    for (; row < r1; row += wstride) { const bool hasn = row + wstride < r1;
        if (hasn) pq_load(A, row + wstride, F.lane, w);
        pq_finish(A->ws, row, F.lane, v);
        if (hasn) {
#pragma unroll
            for (int j = 0; j < 16; ++j) v[j] = w[j]; }
    }
}
__device__ __forceinline__ void late_weights(ArgsP A, Frame& F, int w0, int wstride) {
    unsigned char* ws = A->ws;
    LAS float* scr = (LAS float*)(F.lds + RING_OFF + F.wave * 16384);
    constexpr int I_BA = 32 * 128, I_OUT = 64 * 128, I_WQ = 64 * 64, I_SK = PH_ * 2 * PNK * PHALF / 512;
    constexpr int NITEMS = 2 * I_BA + I_OUT + I_WQ + I_SK;
    for (int it = w0; it < NITEMS; it += wstride) {
        int r = it;
        if (r < I_BA) { p0_transpose_item<false>(A->w_ba, RW, D, (bf16_t*)(ws + WS_WA), RW, scr, r, F.lane); continue; } r -= I_BA;
        if (r < I_BA) { p0_transpose_item<false>(A->w_bb, RW, D, (bf16_t*)(ws + WS_WB), RW, scr, r, F.lane); continue; } r -= I_BA;
        if (r < I_OUT) { p0_transpose_item<false>(A->w_out, D, D, (bf16_t*)(ws + WS_WOUT), D, scr, r, F.lane); continue; } r -= I_OUT;
        if (r < I_WQ) { p0_transpose_item<false>(A->peer_wq, D, 2048, (bf16_t*)(ws + WS_WQ), D, scr, r, F.lane); continue; } r -= I_WQ;
        { const size_t i = (size_t)r * 64 + F.lane; const f32x4 a = ((const f32x4*)A->sub_keys)[2 * i], b = ((const f32x4*)A->sub_keys)[2 * i + 1]; ((u32x4*)(ws + WS_SUBK))[i] = pg8::pack8(a, b); }
    }
}
__device__ __forceinline__ void ph0_prologue(ArgsP A, Frame& F) {
    unsigned char* ws = A->ws;
    LAS float* scr = (LAS float*)(F.lds + RING_OFF + F.wave * 16384);
    const int gw = F.vcu * NWAVES + F.wave, NGW = F.G * NWAVES;
    constexpr int I_IN = 64 * (INW / 32), I_UP = 2 * 64, I_G = 8 * 64;
    constexpr int NITEMS = I_IN + 2 * I_UP + I_G;
    for (int it = gw; it < NITEMS; it += NGW) {
        int r = it;
        if (r < I_IN) { p0_transpose_item<true>(A->w_in, D, INW, (bf16_t*)(ws + WS_WIN), D, scr, r, F.lane); continue; } r -= I_IN;
        if (r < I_UP) { p0_transpose_item<false>(A->w_up, LW, RW, (bf16_t*)(ws + WS_WUP), LW, scr, r, F.lane); continue; } r -= I_UP;
        if (r < I_UP) { p0_transpose_item<false>(A->a_up, LA, RW, (bf16_t*)(ws + WS_AUP), LA, scr, r, F.lane); continue; } r -= I_UP;
        p0_transpose_item<false>(A->g_up, LG, RW, (bf16_t*)(ws + WS_GUP), LGP, scr, r, F.lane);
    }
    const size_t gtid = (size_t)F.vcu * NTHR + F.tid, nthr = (size_t)F.G * NTHR;
    for (size_t i = gtid; i < (size_t)32 * D / 8; i += nthr) ((u32x4*)((bf16_t*)(ws + WS_WIN) + (size_t)SHIFTW * D))[i] = (u32x4){0u, 0u, 0u, 0u};
    for (size_t i = gtid; i < (size_t)T * 64; i += nthr) { const int pos = (int)(i >> 6), fi = (int)(i & 63); const float inv = powf(10000.0f, -(float)fi / 64.0f); const float ang = (float)pos * inv;
        ((f32x2*)(ws + WS_ROPE))[i] = (f32x2){cosf(ang), sinf(ang)}; }
    rms_rows_to_bf16(A->x, A->norm1_g, (bf16_t*)(ws + WS_XN), gw, NGW, F.lane);
}

__device__ __forceinline__ f32x4 ld4bf(const bf16_t* p) { const u32x2 w = *(const u32x2*)p; return (f32x4){bflo(w.x), bfhi(w.x), bflo(w.y), bfhi(w.y)}; }
__device__ __forceinline__ void st4bf(bf16_t* p, f32x4 v) { u32x2 w; w.x = pk2(v[0], v[1]); w.y = pk2(v[2], v[3]); *(u32x2*)p = w; }
__device__ __forceinline__ void ph2_prep(ArgsP A, Frame& F) {
    unsigned char* ws = A->ws; const bf16_t* PROJ = (const bf16_t*)(ws + WS_PROJ);
    LAS float* red = (LAS float*)(F.lds + RING_OFF);
    for (int it = F.vcu; it < NBLK * MH; it += F.G) { const int n = it / MH, h = it % MH, d = F.tid & 127, part = F.tid >> 7;
        const bf16_t* p = (const bf16_t*)(ws + WS_KB) + ((size_t)h * T + n * MBLK + part * 64) * MD + d; float s = 0.f;
#pragma unroll 8
        for (int i = 0; i < 64; ++i) s += bf1(p[(size_t)i * MD]);
        red[F.tid] = s; WG_BAR();
        if (F.tid < 128) { const float m = (red[F.tid] + red[F.tid + 128] + red[F.tid + 256] + red[F.tid + 384]) * (1.0f / MBLK); const unsigned hi = f2bf(m); const float lo = m - __builtin_bit_cast(float, hi << 16);
            ((bf16_t*)(ws + WS_KMEAN))[(size_t)(h * NBLK + n) * MD + F.tid] = (bf16_t)hi; ((bf16_t*)(ws + WS_KMEAN + 131072))[(size_t)(h * NBLK + n) * MD + F.tid] = (bf16_t)f2bf(lo); }
        WG_BAR(); }
    const int tid = F.tid; const int c = 4 * tid;
    const f32x4 mu_r = *(const f32x4*)(A->mu + PC_R + c), mu_k = *(const f32x4*)(A->mu + PC_K + c), mu_v = *(const f32x4*)(A->mu + PC_V + c), kkw = *(const f32x4*)(A->k_k + c);
    int lc = 0, lcc = 0; if (tid < 32) { lcc = 4 * tid; lc = PC_WL + lcc; } else if (tid < 64) { lcc = 4 * (tid - 32); lc = PC_AL + lcc; } else { lcc = 4 * (tid - 64); lc = PC_GL + lcc; }
    const bool lact = tid < 64 || (tid < 192 && lcc < LG);
    const f32x4 mu_l = lact ? *(const f32x4*)(A->mu + lc) : (f32x4){0.f, 0.f, 0.f, 0.f};
    u32x2 cur[8], nxt[8];
    auto tload = [&](int t, u32x2 (&rg)[8]) { const bf16_t* P = PROJ + (size_t)t * PLD; const bf16_t* PP = t > 0 ? P - PLD : P;
        rg[0] = *(const u32x2*)(P + PC_R + c); rg[1] = *(const u32x2*)(PP + PC_R + c); rg[2] = *(const u32x2*)(P + PC_K + c); rg[3] = *(const u32x2*)(PP + PC_K + c);
        rg[4] = *(const u32x2*)(P + PC_V + c); rg[5] = *(const u32x2*)(PP + PC_V + c);
        if (lact) { rg[6] = *(const u32x2*)(P + lc); rg[7] = *(const u32x2*)(PP + lc); } else { rg[6] = (u32x2){0u, 0u}; rg[7] = (u32x2){0u, 0u}; } };
    auto up4 = [](u32x2 w) { return (f32x4){bflo(w.x), bfhi(w.x), bflo(w.y), bfhi(w.y)}; };
    if (F.vcu < T) tload(F.vcu, cur);
    for (int t = F.vcu; t < T; t += F.G) { const bool hasn = t + F.G < T; if (hasn) tload(t + F.G, nxt);
        const float hp = t > 0 ? 1.0f : 0.0f;
        { const f32x4 p = up4(cur[0]), pp = up4(cur[1]) * hp; st4bf((bf16_t*)(ws + WS_ZR) + (size_t)t * RW + c, p + (pp - p) * mu_r); }
        { const f32x4 p = up4(cur[2]), pp = up4(cur[3]) * hp; const f32x4 zk = p + (pp - p) * mu_k;
          st4bf((bf16_t*)(ws + WS_KP) + (size_t)t * RW + c, zk); const f32x4 kk = zk * kkw;
          const float ss = sum16((kk[0] * kk[0] + kk[1] * kk[1]) + (kk[2] * kk[2] + kk[3] * kk[3])); const float inv = 1.0f / fmaxf(sqrtf(ss), 1e-12f);
          st4bf((bf16_t*)(ws + WS_KKN) + (size_t)t * RW + c, kk * inv); }
        { const f32x4 p = up4(cur[4]), pp = up4(cur[5]) * hp; st4bf((bf16_t*)(ws + WS_ZV) + (size_t)t * RW + c, p + (pp - p) * mu_v); }
        if (tid < 192) { const f32x4 zero = (f32x4){0.f, 0.f, 0.f, 0.f};
            f32x4 z = zero; if (lact) { const f32x4 p = up4(cur[6]), pp = up4(cur[7]) * hp; z = p + (pp - p) * mu_l; }
            if (tid < 32) { f32x4 o;
#pragma unroll
                for (int e = 0; e < 4; ++e) o[e] = 1.0f - 2.0f * __builtin_amdgcn_rcpf(__expf(2.0f * z[e]) + 1.0f);
                st4bf((bf16_t*)(ws + WS_AW) + (size_t)t * LW + lcc, o); }
            else if (tid < 64) st4bf((bf16_t*)(ws + WS_AA) + (size_t)t * LA + lcc, z);
            else { f32x4 o = zero; if (lcc < LG) {
#pragma unroll
                for (int e = 0; e < 4; ++e) o[e] = fsigmoid(z[e]); }
                st4bf((bf16_t*)(ws + WS_AG) + (size_t)t * LGP + lcc, o); }
        }
        if (hasn) {
#pragma unroll
            for (int i = 0; i < 8; ++i) cur[i] = nxt[i]; }
    }
}

__device__ __forceinline__ void ph3_gate(ArgsP A, Frame& F) {
    unsigned char* ws = A->ws; const bf16_t* PROJ = (const bf16_t*)(ws + WS_PROJ); const bf16_t* KMH = (const bf16_t*)(ws + WS_KMEAN); const bf16_t* KML = (const bf16_t*)(ws + WS_KMEAN + 131072); unsigned* MASK = (unsigned*)(ws + WS_MASK);
    const int gw = F.vcu * NWAVES + F.wave, NGW = F.G * NWAVES; const int r = F.lane & 31, hh = F.lane >> 5; const float NEG = -__builtin_inff();
    for (int it = gw; it < (T / 32) * MH; it += NGW) { const int tg = it >> 4, h = it & 15, t = tg * 32 + r, blk = tg >> 3;
        if (blk == 0) { if (hh == 0) MASK[t * MH + h] = 0u; continue; }
        f32x16 acc;
#pragma unroll
        for (int e = 0; e < 16; ++e) acc[e] = 0.f;
#pragma unroll
        for (int ks = 0; ks < 8; ++ks) { const bf16x8 q = *(const bf16x8*)(PROJ + (size_t)t * PLD + PC_MQ + h * MD + 16 * ks + 8 * hh); const size_t ko = (size_t)(h * NBLK + r) * MD + 16 * ks + 8 * hh;
            acc = __builtin_amdgcn_mfma_f32_32x32x16_bf16(*(const bf16x8*)(KMH + ko), q, acc, 0, 0, 0); acc = __builtin_amdgcn_mfma_f32_32x32x16_bf16(*(const bf16x8*)(KML + ko), q, acc, 0, 0, 0); }
        float t0 = NEG, t1 = NEG, t2 = NEG;
#pragma unroll
        for (int e = 0; e < 16; ++e) { const int n = (e & 3) + 8 * (e >> 2) + 4 * hh; float ae = acc[e]; asm volatile("" : "+v"(ae));
            float x = __builtin_bit_cast(float, (__builtin_bit_cast(unsigned, ae) & ~31u) | (unsigned)(31 - n)); x = (n < blk) ? x : NEG;
            t2 = __builtin_amdgcn_fmed3f(t1, t2, x); t1 = __builtin_amdgcn_fmed3f(t0, t1, x); t0 = fmaxf(t0, x); }
        const float o0 = __shfl_xor(t0, 32), o1 = __shfl_xor(t1, 32), o2 = __shfl_xor(t2, 32);
        t2 = __builtin_amdgcn_fmed3f(t1, t2, o0); t1 = __builtin_amdgcn_fmed3f(t0, t1, o0); t0 = fmaxf(t0, o0);
        t2 = __builtin_amdgcn_fmed3f(t1, t2, o1); t1 = __builtin_amdgcn_fmed3f(t0, t1, o1); t0 = fmaxf(t0, o1);
        t2 = __builtin_amdgcn_fmed3f(t1, t2, o2); t1 = __builtin_amdgcn_fmed3f(t0, t1, o2); t0 = fmaxf(t0, o2);
        unsigned sel = 1u << (31 - (__builtin_bit_cast(unsigned, t0) & 31u));
        if (blk > 1) sel |= 1u << (31 - (__builtin_bit_cast(unsigned, t1) & 31u));
        if (blk > 2) sel |= 1u << (31 - (__builtin_bit_cast(unsigned, t2) & 31u));
        if (hh == 0) MASK[t * MH + h] = sel;
        { gu32* cnt = (gu32*)(ws + WS_CTL) + CW_CNT + h * 32; unsigned short* lst = (unsigned short*)(ws + WS_LIST) + (size_t)h * 32 * 8192; const unsigned mysel = hh == 0 ? sel : 0u;
          unsigned mycnt = 0u;
          for (int j = 0; j < blk; ++j) { const unsigned long long bal = __ballot((mysel >> j) & 1u); const unsigned c = (unsigned)__builtin_popcountll(bal); mycnt = (F.lane == j) ? c : mycnt; }
          unsigned base = 0u; if (F.lane < blk && mycnt) base = __hip_atomic_fetch_add(cnt + F.lane, mycnt, __ATOMIC_RELAXED, __HIP_MEMORY_SCOPE_AGENT);
          for (int j = 0; j < blk; ++j) { const unsigned long long bal = __ballot((mysel >> j) & 1u); const unsigned bj = (unsigned)__builtin_amdgcn_readlane((int)base, j);
              if ((mysel >> j) & 1u) { const unsigned off = __builtin_amdgcn_mbcnt_hi((unsigned)(bal >> 32), __builtin_amdgcn_mbcnt_lo((unsigned)bal, 0u)); const unsigned slot = (unsigned)__builtin_popcount(mysel & ((1u << j) - 1u));
                  lst[(size_t)j * 8192 + bj + off] = (unsigned short)((unsigned)t | (slot << 13)); } } } }
}

constexpr int CK = 64, NCHK = T / CK, CP = 144, CPF = 272;
constexpr int L_AT = 0, L_BT = 9216, L_KT = 18432, L_RT = 27648, L_ATT = 36864, L_BTT = 46080, L_V = 55296, L_MKA = 64512, L_MBRT = 73728, L_MKRT = 82944, L_A2 = 92160, L_MBA = 101376, L_PC = 118784, L_WT = 119040, L_MBH = 121088, L_TD = 130304, L_PT = 134912, L_CEND = 139520;
constexpr int L_TT = L_AT, L_A1 = L_BT, L_Y2T = L_MKA, L_G2T = L_ATT;
static_assert(L_CEND <= RING_BYTES, "chunk prep LDS");
constexpr size_t CHW_ITEM = 32768;
__device__ __forceinline__ f32x16 nt_quad(const LAS unsigned char* X, const LAS unsigned char* Y, int qp, int qq, int r, int hh) {
    f32x16 acc;
#pragma unroll
    for (int e = 0; e < 16; ++e) acc[e] = 0.f;
#pragma unroll
    for (int ks = 0; ks < 4; ++ks) { const bf16x8 a = *(const LAS bf16x8*)(Y + (32 * qq + r) * CP + 32 * ks + 16 * hh), b = *(const LAS bf16x8*)(X + (32 * qp + r) * CP + 32 * ks + 16 * hh);
        acc = __builtin_amdgcn_mfma_f32_32x32x16_bf16(a, b, acc, 0, 0, 0); }
    return acc;
}
__device__ __forceinline__ int nt_q(int qq, int e, int hh) { return 32 * qq + (e & 3) + 8 * (e >> 2) + 4 * hh; }
__device__ __forceinline__ void nt_store_bf16(LAS unsigned char* O, int p, int qq, int hh, const f32x16& v) {
#pragma unroll
    for (int g = 0; g < 4; ++g) { u32x2 w; w.x = pk2(v[4 * g], v[4 * g + 1]); w.y = pk2(v[4 * g + 2], v[4 * g + 3]); *(LAS u32x2*)(O + p * CP + (32 * qq + 8 * g + 4 * hh) * 2) = w; }
}
__device__ __forceinline__ void ph4_chunkprep(ArgsP A, Frame& F) {
    unsigned char* ws = A->ws;
    const float* DEC = (const float*)(ws + WS_DEC); const bf16_t* KKN = (const bf16_t*)(ws + WS_KKN); const bf16_t* BBg = (const bf16_t*)(ws + WS_BB); const bf16_t* KPg = (const bf16_t*)(ws + WS_KP);
    const bf16_t* ZR = (const bf16_t*)(ws + WS_ZR); const bf16_t* ZV = (const bf16_t*)(ws + WS_ZV); float* Yg = (float*)(ws + WS_Y); unsigned char* CHW = ws + WS_WIN;
    LAS unsigned char* L = F.lds + RING_OFF; const int wave = F.wave, lane = F.lane, r = lane & 31, hh = lane >> 5;
    const int prod = wave >> 2, qp = (wave >> 1) & 1, qq = wave & 1, p = 32 * qp + r;
    float nwv[8]; unsigned nkk[4], nbb[4], nkp[4], nr[4], nv[4];
    auto request = [&](int h2, int c2) {
#pragma unroll
        for (int k = 0; k < 8; ++k) nwv[k] = DEC[(size_t)(c2 * CK + 8 * wave + k) * RW + (size_t)h2 * RN + lane];
#pragma unroll
        for (int i = 0; i < 4; ++i) { const size_t o = (size_t)(c2 * CK + 8 * wave + 2 * i + hh) * RW + (size_t)h2 * RN + 2 * r;
            nkk[i] = *(const unsigned*)(KKN + o); nbb[i] = *(const unsigned*)(BBg + o); nkp[i] = *(const unsigned*)(KPg + o); nr[i] = *(const unsigned*)(ZR + o); nv[i] = *(const unsigned*)(ZV + o); } };
    if (F.vcu < RH * NCHK) request(F.vcu / NCHK, F.vcu % NCHK);
    if (F.vcu == 0 && wave == 0) {
        const gu32* cnt = (const gu32*)(ws + WS_CTL) + CW_CNT; unsigned* ud = (unsigned*)(ws + WS_UDESC); unsigned np[8], tot = 0u;
#pragma unroll
        for (int k = 0; k < 8; ++k) { const unsigned c = __hip_atomic_load(cnt + 8 * lane + k, __ATOMIC_RELAXED, __HIP_MEMORY_SCOPE_AGENT); np[k] = (c + 255u) >> 8; tot += np[k]; }
        unsigned incl = tot;
#pragma unroll
        for (int o = 1; o < 64; o <<= 1) { const unsigned v = __shfl_up(incl, o); if (lane >= o) incl += v; }
        unsigned pos = incl - tot;
#pragma unroll
        for (int k = 0; k < 8; ++k) { const unsigned c = __hip_atomic_load(cnt + 8 * lane + k, __ATOMIC_RELAXED, __HIP_MEMORY_SCOPE_AGENT); for (unsigned ps = 0; ps < np[k]; ++ps) { ud[1 + 2 * pos] = (unsigned)(8 * lane + k) | (ps << 16); ud[2 + 2 * pos] = c; ++pos; } }
        if (lane == 63) ud[0] = incl; }
    for (int item = F.vcu; item < RH * NCHK; item += F.G) { const int h = item / NCHK, c = item % NCHK; const size_t hc = (size_t)h * RN; const int t0 = c * CK;
        { float wv[8], kkv[8], bbv[8], kpv[8], rv[8]; unsigned vv[8];
#pragma unroll
          for (int k = 0; k < 8; ++k) { const int src = ((k & 1) << 7) | ((lane >> 1) << 2); const bool odd = lane & 1;
              auto mine = [&](unsigned x) { const unsigned w = (unsigned)__builtin_amdgcn_ds_bpermute(src, (int)x); return odd ? (w & 0xffff0000u) : (w << 16); };
              wv[k] = nwv[k]; kkv[k] = __builtin_bit_cast(float, mine(nkk[k >> 1])); bbv[k] = __builtin_bit_cast(float, mine(nbb[k >> 1])); kpv[k] = __builtin_bit_cast(float, mine(nkp[k >> 1]));
              rv[k] = __builtin_bit_cast(float, mine(nr[k >> 1])); vv[k] = mine(nv[k >> 1]) >> 16; }
          { const int nit = item + F.G; if (nit < RH * NCHK) request(nit / NCHK, nit % NCHK); }
          float pl[8]; pl[0] = wv[0];
#pragma unroll
          for (int k = 1; k < 8; ++k) pl[k] = pl[k - 1] * wv[k];
          ((LAS float*)(L + L_WT))[wave * 64 + lane] = pl[7];
          WG_BAR();
          float pre = 1.f;
#pragma unroll
          for (int w2 = 0; w2 < 7; ++w2) { const float x = ((const LAS float*)(L + L_WT))[w2 * 64 + lane]; pre = (w2 < wave) ? pre * x : pre; }
          unsigned atp[4], btp[4], vtp[4];
#pragma unroll
          for (int k = 0; k < 8; ++k) { const float Pt = pre * pl[k], Pm = (k == 0) ? pre : pre * pl[k - 1], ip = __builtin_amdgcn_rcpf(Pt); const int t = 8 * wave + k;
              const unsigned a16 = f2bf(Pm * kkv[k]), b16 = f2bf(bbv[k] * ip), k16 = f2bf(kpv[k] * ip), r16 = f2bf(Pt * rv[k]);
              *(LAS bf16_t*)(L + L_AT + t * CP + 2 * lane) = (bf16_t)a16; *(LAS bf16_t*)(L + L_BT + t * CP + 2 * lane) = (bf16_t)b16; *(LAS bf16_t*)(L + L_KT + t * CP + 2 * lane) = (bf16_t)k16; *(LAS bf16_t*)(L + L_RT + t * CP + 2 * lane) = (bf16_t)r16;
              if (k & 1) { atp[k >> 1] |= a16 << 16; btp[k >> 1] |= b16 << 16; vtp[k >> 1] |= vv[k] << 16; } else { atp[k >> 1] = a16; btp[k >> 1] = b16; vtp[k >> 1] = vv[k]; }
              if (wave == 7 && k == 7) ((LAS float*)(L + L_PC))[lane] = Pt; }
          *(LAS u32x4*)(L + L_ATT + lane * CP + 16 * wave) = (u32x4){atp[0], atp[1], atp[2], atp[3]}; *(LAS u32x4*)(L + L_BTT + lane * CP + 16 * wave) = (u32x4){btp[0], btp[1], btp[2], btp[3]};
          *(LAS u32x4*)(L + L_V + lane * CP + 16 * wave) = (u32x4){vtp[0], vtp[1], vtp[2], vtp[3]}; }
        WG_BAR();
        { const f32x16 v = nt_quad(L + (prod ? L_KT : L_BT), L + L_AT, qp, qq, r, hh); f32x16 m;
#pragma unroll
          for (int e = 0; e < 16; ++e) m[e] = nt_q(qq, e, hh) > p ? v[e] : 0.f;
          if (prod == 0) {
#pragma unroll
              for (int g = 0; g < 4; ++g) *(LAS f32x4*)(L + L_MBA + p * CPF + (32 * qq + 8 * g + 4 * hh) * 4) = (f32x4){m[4 * g], m[4 * g + 1], m[4 * g + 2], m[4 * g + 3]}; }
          if (prod == 0) nt_store_bf16(L + L_MBH, p, qq, hh, m);
          else nt_store_bf16(L + L_MKA, p, qq, hh, m); }
        { const f32x16 v = nt_quad(L + L_RT, L + (prod ? L_KT : L_BT), qp, qq, r, hh); f32x16 m;
#pragma unroll
          for (int e = 0; e < 16; ++e) m[e] = nt_q(qq, e, hh) <= p ? v[e] : 0.f;
          nt_store_bf16(L + (prod ? L_MKRT : L_MBRT), p, qq, hh, m); }
        WG_BAR();
        { const int t = 8 * wave + (lane >> 3), g = lane & 7, base = 32 * (t >> 5); float T4[4] = {0.f, 0.f, 0.f, 0.f};
          const LAS unsigned char* mrow = L + L_MBA + (base + 4 * g) * 4;
          f32x4 m = *(const LAS f32x4*)(mrow + (base + 31) * CPF);
#pragma unroll 1
          for (int Sx = 7; Sx >= 0; --Sx) {
#pragma unroll
              for (int q = 3; q >= 0; --q) { const int sl = 4 * Sx + q, sr = base + sl, sn = sl > 0 ? sr - 1 : sr; const f32x4 n = *(const LAS f32x4*)(mrow + sn * CPF);
                  float part = (m[0] * T4[0] + m[1] * T4[1]) + (m[2] * T4[2] + m[3] * T4[3]);
                  part += dpp_f<0xB1>(part); part += dpp_f<0x4E>(part); part += dpp_f<0x141>(part);
                  const float val = (sr == t) ? 1.0f : part; T4[q] = (g == Sx) ? val : T4[q]; m = n; } }
          const unsigned w0 = pk2(T4[0], T4[1]), w1 = pk2(T4[2], T4[3]);
          *(LAS u32x2*)(L + L_TT + t * CP + (base + 4 * g) * 2) = (u32x2){w0, w1};
          if (base == 0) { *(LAS u32x2*)(L + L_TT + t * CP + (32 + 4 * g) * 2) = (u32x2){0u, 0u};
              *(LAS bf16_t*)(L + L_TD + (4 * g) * CP + 2 * t) = (bf16_t)(w0 & 0xffffu); *(LAS bf16_t*)(L + L_TD + (4 * g + 1) * CP + 2 * t) = (bf16_t)(w0 >> 16);
              *(LAS bf16_t*)(L + L_TD + (4 * g + 2) * CP + 2 * t) = (bf16_t)(w1 & 0xffffu); *(LAS bf16_t*)(L + L_TD + (4 * g + 3) * CP + 2 * t) = (bf16_t)(w1 >> 16); } }
        WG_BAR();
        if (wave == 0) {
            f32x16 acc;
#pragma unroll
            for (int e = 0; e < 16; ++e) acc[e] = 0.f;
#pragma unroll
            for (int ks = 0; ks < 2; ++ks) { const bf16x8 a = *(const LAS bf16x8*)(L + L_MBH + r * CP + 64 + 32 * ks + 16 * hh), b = *(const LAS bf16x8*)(L + L_TT + (32 + r) * CP + 64 + 32 * ks + 16 * hh);
                acc = __builtin_amdgcn_mfma_f32_32x32x16_bf16(a, b, acc, 0, 0, 0); }
            nt_store_bf16(L + L_PT, r, 0, hh, acc);
            LDS_WAIT(); asm volatile("" ::: "memory");
#pragma unroll
            for (int e = 0; e < 16; ++e) acc[e] = 0.f;
#pragma unroll
            for (int ks = 0; ks < 2; ++ks) { const bf16x8 a = *(const LAS bf16x8*)(L + L_TD + r * CP + 32 * ks + 16 * hh), b = *(const LAS bf16x8*)(L + L_PT + r * CP + 32 * ks + 16 * hh);
                acc = __builtin_amdgcn_mfma_f32_32x32x16_bf16(a, b, acc, 0, 0, 0); }
            nt_store_bf16(L + L_TT, 32 + r, 0, hh, acc);
        }
        WG_BAR();
        { const f32x16 v = nt_quad(L + (prod ? L_MKA : L_ATT), L + L_TT, qp, qq, r, hh);
          nt_store_bf16(L + (prod ? L_A2 : L_A1), p, qq, hh, v); }
        WG_BAR();
        unsigned char* cw = CHW + (size_t)item * CHW_ITEM;
        { const f32x16 v = nt_quad(L + L_MBRT, L + (prod ? L_A2 : L_A1), qp, qq, r, hh); f32x16 o;
          const LAS unsigned char* addm = L + (prod ? L_MKRT : L_RT);
#pragma unroll
          for (int g = 0; g < 4; ++g) { const u32x2 w = *(const LAS u32x2*)(addm + p * CP + (32 * qq + 8 * g + 4 * hh) * 2); o[4 * g] = v[4 * g] + bflo(w.x); o[4 * g + 1] = v[4 * g + 1] + bfhi(w.x); o[4 * g + 2] = v[4 * g + 2] + bflo(w.y); o[4 * g + 3] = v[4 * g + 3] + bfhi(w.y); }
          if (prod) nt_store_bf16(L + L_Y2T, p, qq, hh, o);
          else {
#pragma unroll
              for (int g = 0; g < 4; ++g) { u32x2 w; w.x = pk2(o[4 * g], o[4 * g + 1]); w.y = pk2(o[4 * g + 2], o[4 * g + 3]); *(u32x2*)(cw + (size_t)p * 128 + (32 * qq + 8 * g + 4 * hh) * 2) = w; } } }
        { const f32x16 v = nt_quad(L + L_BTT, L + (prod ? L_A2 : L_A1), qp, qq, r, hh); const float pc = ((const LAS float*)(L + L_PC))[p]; f32x16 o;
          if (prod) {
#pragma unroll
              for (int e = 0; e < 16; ++e) o[e] = (v[e] + bf1(*(const LAS bf16_t*)(L + L_KT + nt_q(qq, e, hh) * CP + 2 * p))) * pc;
              nt_store_bf16(L + L_G2T, p, qq, hh, o); }
          else {
#pragma unroll
              for (int e = 0; e < 16; ++e) o[e] = (v[e] + (nt_q(qq, e, hh) == p ? 1.0f : 0.0f)) * pc;
#pragma unroll
              for (int g = 0; g < 4; ++g) { u32x2 w; w.x = pk2(o[4 * g], o[4 * g + 1]); w.y = pk2(o[4 * g + 2], o[4 * g + 3]); *(u32x2*)(cw + 8192 + (size_t)p * 128 + (32 * qq + 8 * g + 4 * hh) * 2) = w; } } }
        WG_BAR();
        { const f32x16 v = prod ? nt_quad(L + L_V, L + L_G2T, qp, qq, r, hh) : nt_quad(L + L_Y2T, L + L_V, qp, qq, r, hh);
          float* dst = prod ? (float*)(cw + 16384) + (size_t)p * 64 : Yg + (size_t)(t0 + p) * RW + hc;
#pragma unroll
          for (int g = 0; g < 4; ++g) *(f32x4*)(dst + 32 * qq + 8 * g + 4 * hh) = (f32x4){v[4 * g], v[4 * g + 1], v[4 * g + 2], v[4 * g + 3]}; }
        WG_BAR();
    }
}
__device__ __forceinline__ void ph5_chain(ArgsP A, Frame& F, int h) {
    unsigned char* ws = A->ws; float* Yg = (float*)(ws + WS_Y); const unsigned char* CHW = ws + WS_WIN;
    LAS unsigned char* L = F.lds + RING_OFF; const int wave = F.wave, lane = F.lane, tid = F.tid, r = lane & 31, hh = lane >> 5;
    const int prod = wave >> 2, qp = (wave >> 1) & 1, qq = wave & 1, p = 32 * qp + r; const size_t hc = (size_t)h * RN;
    constexpr int L_S = 0, L_G = 2 * 9216, L_Y1 = 3 * 9216;
    for (int i = tid; i < 2 * 9216 / 4; i += NTHR) ((LAS unsigned*)(L + L_S))[i] = 0u;
    const int srow = tid >> 3, sc16 = tid & 7; u32x4 sg, sy;
    auto stage_ld = [&](int c) { const unsigned char* cw = CHW + (size_t)(h * NCHK + c) * CHW_ITEM; sy = *(const u32x4*)(cw + srow * 128 + sc16 * 16); sg = *(const u32x4*)(cw + 8192 + srow * 128 + sc16 * 16); };
    f32x4 nad[4];
    auto ad_ld = [&](int c) { const unsigned char* cw2 = CHW + (size_t)(h * NCHK + c) * CHW_ITEM; const float* addp = prod ? Yg + (size_t)(c * CK + p) * RW + hc : (const float*)(cw2 + 16384) + (size_t)p * 64;
#pragma unroll
        for (int g = 0; g < 4; ++g) nad[g] = *(const f32x4*)(addp + 32 * qq + 8 * g + 4 * hh); };
    stage_ld(0); ad_ld(0);
    int sb = 0;
    for (int c = 0; c < NCHK; ++c) {
        *(LAS u32x4*)(L + L_Y1 + srow * CP + sc16 * 16) = sy; *(LAS u32x4*)(L + L_G + srow * CP + sc16 * 16) = sg;
        const unsigned char* cw = CHW + (size_t)(h * NCHK + c) * CHW_ITEM;
        f32x4 ad[4];
#pragma unroll
        for (int g = 0; g < 4; ++g) ad[g] = nad[g];
        if (c + 1 < NCHK) { stage_ld(c + 1); ad_ld(c + 1); }
        WG_BAR();
        const f32x16 v = prod ? nt_quad(L + L_Y1, L + L_S + sb * 9216, qp, qq, r, hh) : nt_quad(L + L_S + sb * 9216, L + L_G, qp, qq, r, hh);
        f32x16 o;
#pragma unroll
        for (int g = 0; g < 4; ++g) { o[4 * g] = v[4 * g] + ad[g][0]; o[4 * g + 1] = v[4 * g + 1] + ad[g][1]; o[4 * g + 2] = v[4 * g + 2] + ad[g][2]; o[4 * g + 3] = v[4 * g + 3] + ad[g][3]; }
        if (prod) { float* yp = Yg + (size_t)(c * CK + p) * RW + hc;
#pragma unroll
            for (int g = 0; g < 4; ++g) *(f32x4*)(yp + 32 * qq + 8 * g + 4 * hh) = (f32x4){o[4 * g], o[4 * g + 1], o[4 * g + 2], o[4 * g + 3]}; }
        else nt_store_bf16(L + L_S + (sb ^ 1) * 9216, p, qq, hh, o);
        sb ^= 1;
        WG_BAR();
    }
}

__device__ __forceinline__ void ph5_ypost(ArgsP A, Frame& F) {
    unsigned char* ws = A->ws; const float* Y = (const float*)(ws + WS_Y); const bf16_t* ZR = (const bf16_t*)(ws + WS_ZR); const bf16_t* KP = (const bf16_t*)(ws + WS_KP); const bf16_t* ZV = (const bf16_t*)(ws + WS_ZV);
    const bf16_t* G = (const bf16_t*)(ws + WS_G); bf16_t* YA = (bf16_t*)(ws + WS_YA);
    const int gw = F.vcu * NWAVES + F.wave, NGW = F.G * NWAVES;
    const int c = F.wave * 256 + 4 * F.lane; const f32x4 rk = *(const f32x4*)(A->r_k + c), lg = *(const f32x4*)(A->lnx_g + c), lb = *(const f32x4*)(A->lnx_b + c);
    for (int tg = F.vcu; tg < T / 32; tg += F.G) for (int tq = 0; tq < 32; tq += 4) {
        f32x4 y[4]; u32x2 rr[4], kk[4], vv[4], gg[4];
#pragma unroll
        for (int u = 0; u < 4; ++u) { const size_t o = (size_t)(tg * 32 + tq + u) * RW + c; y[u] = *(const f32x4*)(Y + o); rr[u] = *(const u32x2*)(ZR + o); kk[u] = *(const u32x2*)(KP + o); vv[u] = *(const u32x2*)(ZV + o); gg[u] = *(const u32x2*)(G + o); }
#pragma unroll
        for (int u = 0; u < 4; ++u) { const size_t o = (size_t)(tg * 32 + tq + u) * RW + c;
            const float mean = sum16((y[u][0] + y[u][1]) + (y[u][2] + y[u][3])) * (1.0f / 64.0f); const f32x4 d = y[u] - mean;
            const float var = sum16((d[0] * d[0] + d[1] * d[1]) + (d[2] * d[2] + d[3] * d[3])) * (1.0f / 64.0f); const float rs = 1.0f / sqrtf(var + LNX_EPS);
            const f32x4 r = (f32x4){bflo(rr[u].x), bfhi(rr[u].x), bflo(rr[u].y), bfhi(rr[u].y)}, k = (f32x4){bflo(kk[u].x), bfhi(kk[u].x), bflo(kk[u].y), bfhi(kk[u].y)};
            const f32x4 v = (f32x4){bflo(vv[u].x), bfhi(vv[u].x), bflo(vv[u].y), bfhi(vv[u].y)}, g = (f32x4){bflo(gg[u].x), bfhi(gg[u].x), bflo(gg[u].y), bfhi(gg[u].y)};
            const f32x4 rkk = r * k * rk; const float bonus = sum16((rkk[0] + rkk[1]) + (rkk[2] + rkk[3]));
            st4bf(YA + o, (d * rs * lg + lb + bonus * v) * g); } }
}

constexpr int AT_KB = 64 * 256, AT_VB = 128 * 128, AT_BUF = AT_KB + AT_VB;
static_assert(3 * AT_BUF <= RING_BYTES, "attention LDS");
__device__ __forceinline__ void q8_load(u32x4 (&q)[8], const void* p) {
    asm volatile("global_load_dwordx4 %0, %8, off\n\tglobal_load_dwordx4 %1, %8, off offset:32\n\tglobal_load_dwordx4 %2, %8, off offset:64\n\tglobal_load_dwordx4 %3, %8, off offset:96\n\t"
                 "global_load_dwordx4 %4, %8, off offset:128\n\tglobal_load_dwordx4 %5, %8, off offset:160\n\tglobal_load_dwordx4 %6, %8, off offset:192\n\tglobal_load_dwordx4 %7, %8, off offset:224"
                 : "=&v"(q[0]), "=&v"(q[1]), "=&v"(q[2]), "=&v"(q[3]), "=&v"(q[4]), "=&v"(q[5]), "=&v"(q[6]), "=&v"(q[7]) : "v"(p) : "memory"); }
__device__ __forceinline__ void q8_settle(u32x4 (&q)[8]) {
#pragma unroll
    for (int i = 0; i < 8; ++i) asm volatile("" : "+v"(q[i])); }
__device__ __forceinline__ unsigned u16_load(const void* p) { unsigned v; asm volatile("global_load_ushort %0, %1, off" : "=&v"(v) : "v"(p) : "memory"); return v; }
__device__ __forceinline__ void ph5_attn(ArgsP A, Frame& F) {
    unsigned char* ws = A->ws; const bf16_t* PROJ = (const bf16_t*)(ws + WS_PROJ); const bf16_t* VT = (const bf16_t*)(ws + WS_VT); const bf16_t* KBp = (const bf16_t*)(ws + WS_KB);
    bf16_t* PO = (bf16_t*)(ws + WS_PARTO); float* PML = (float*)(ws + WS_PARTML); const unsigned short* LST = (const unsigned short*)(ws + WS_LIST); const unsigned* UD = (const unsigned*)(ws + WS_UDESC);
    LAS unsigned char* L = F.lds + RING_OFF; const int wave = F.wave, lane = F.lane, r = lane & 31, hh = lane >> 5;
    const float NEG = -__builtin_inff();
    const int NA = MH * NBLK, N = NA + (int)UD[0], w = F.vcu, nfree = F.G - RH; const bool chainwg = w < RH;
    auto unit_of = [&](int k) { return k * nfree + (w - RH); };
    int k = 0;
    if (chainwg) return;
    if (unit_of(k) >= N) return;
    int h, kblk, qtok, slot; bool typeA, valid, wvalid;
    { const int u = unit_of(k); typeA = u < NA;
      if (typeA) { h = u & 15; kblk = u >> 4; qtok = kblk * MBLK + wave * 32 + r; slot = 3; valid = true; wvalid = true; }
      else { const unsigned d = UD[1 + 2 * (u - NA)]; const int cnt = (int)UD[2 + 2 * (u - NA)]; const int Lx = (int)(d & 0xffffu), ps = (int)(d >> 16); h = Lx >> 5; kblk = Lx & 31;
          const int idx = ps * 256 + wave * 32 + r; valid = idx < cnt; wvalid = ps * 256 + wave * 32 < cnt; unsigned e = u16_load(LST + (size_t)Lx * 8192 + (valid ? idx : 0));
          asm volatile("s_waitcnt vmcnt(0)" ::: "memory"); asm volatile("" : "+v"(e)); qtok = (int)(e & 0x1fffu); slot = (int)(e >> 13); }
      h = __builtin_amdgcn_readfirstlane(h); kblk = __builtin_amdgcn_readfirstlane(kblk); }
    u32x4 qf[8], qfn[8];
    q8_load(qf, PROJ + (size_t)qtok * PLD + PC_MQ + h * MD + 8 * hh);
    const int krow_ = lane >> 4, kslot = lane & 15, vrow_ = lane >> 3, vslot = lane & 7;
    auto dma_tile = [&](int hd, int kb_, int n, int b3) { const int tb = kb_ * MBLK + n * 64; LAS unsigned char* B = L + b3 * AT_BUF;
#pragma unroll
        for (int i = 0; i < 2; ++i) { const int p = wave * 2 + i, row = 4 * p + krow_, c = kslot ^ (row & 15);
            __builtin_amdgcn_global_load_lds((const unsigned*)(KBp + ((size_t)hd * T + tb + row) * MD + 8 * c), (LAS unsigned*)(B + p * 1024), 16, 0, 0); }
#pragma unroll
        for (int i = 0; i < 2; ++i) { const int p = wave * 2 + i, row = 8 * p + vrow_, c = vslot ^ ((row >> 1) & 7);
            __builtin_amdgcn_global_load_lds((const unsigned*)(VT + ((size_t)(hd * (T / 64) + kb_ * 4 + n) * MD + row) * 64 + 8 * c), (LAS unsigned*)(B + AT_KB + p * 1024), 16, 0, 0); } };
    dma_tile(h, kblk, 0, 0); dma_tile(h, kblk, 1, 1);
    asm volatile("s_waitcnt vmcnt(4)" ::: "memory"); q8_settle(qf); WG_BAR();
    int b3 = 0;
    for (;;) {
        const int un = unit_of(k + 1); const bool has_next = un < N, nA = un < NA;
        int hN = 0, kblkN = 0, qtokN = 0, slotN = 3, LxN = 0, idxN = 0, cntN = 0; bool validN = true, wvalidN = true; unsigned udw = 0u, udc = 0u, entN = 0u;
        f32x16 o[4];
#pragma unroll
        for (int db = 0; db < 4; ++db)
#pragma unroll
            for (int e = 0; e < 16; ++e) o[db][e] = 0.f;
        float mrun = NEG, lrun = 0.f;
#pragma unroll
        for (int n = 0; n < 4; ++n) {
            if (has_next) {
                if (n == 0) { if (nA) { hN = un & 15; kblkN = un >> 4; } else { udw = UD[1 + 2 * (un - NA)]; udc = UD[2 + 2 * (un - NA)]; } }
                if (n == 1) { if (nA) { qtokN = kblkN * MBLK + wave * 32 + r; } else { LxN = (int)(udw & 0xffffu); const int ps = (int)(udw >> 16); cntN = (int)udc; hN = LxN >> 5; kblkN = LxN & 31;
                                  idxN = ps * 256 + wave * 32 + r; validN = idxN < cntN; wvalidN = ps * 256 + wave * 32 < cntN; entN = u16_load(LST + (size_t)LxN * 8192 + (validN ? idxN : 0)); }
                              hN = __builtin_amdgcn_readfirstlane(hN); kblkN = __builtin_amdgcn_readfirstlane(kblkN); }
                if (n == 2) { if (!nA) { qtokN = (int)(entN & 0x1fffu); slotN = (int)(entN >> 13); }
                              q8_load(qfn, PROJ + (size_t)qtokN * PLD + PC_MQ + hN * MD + 8 * hh); }
            }
            const int bn = b3 >= 1 ? b3 - 1 : 2; bool issued = false;
            if (n < 2) { dma_tile(h, kblk, n + 2, bn); issued = true; } else if (has_next) { dma_tile(hN, kblkN, n - 2, bn); issued = true; }
            const bool need = typeA ? (n <= (wave >> 1)) : wvalid;
            if (need) {
                const LAS unsigned char* KB = L + b3 * AT_BUF; const LAS unsigned char* VB = KB + AT_KB;
                const bool msk = typeA && 64 * n + 63 > wave * 32; const int qrel = wave * 32 + r;
                auto qk = [&](int kb) { f32x16 a;
#pragma unroll
                    for (int e = 0; e < 16; ++e) a[e] = 0.f;
#pragma unroll
                    for (int ks = 0; ks < 8; ++ks) { const bf16x8 kf = *(const LAS bf16x8*)(KB + (32 * kb + r) * 256 + (((2 * ks + hh) ^ (r & 15)) << 4)); a = __builtin_amdgcn_mfma_f32_32x32x16_bf16(kf, __builtin_bit_cast(bf16x8, qf[ks]), a, 0, 0, 0); }
                    return a; };
                auto causal = [&](f32x16& a, int kb) {
#pragma unroll
                    for (int e = 0; e < 16; ++e) { const int krel = 64 * n + 32 * kb + (e & 3) + 8 * (e >> 2) + 4 * hh; if (krel > qrel) a[e] = NEG; } };
                auto rescale = [&](float alpha) { if (__ballot(alpha != 1.0f) != 0ull) {
#pragma unroll
                        for (int db = 0; db < 4; ++db)
#pragma unroll
                            for (int e = 0; e < 16; ++e) o[db][e] *= alpha; } };
                auto rowmax = [&](const f32x16& a, float mold, float& mnew, float& alpha) {
                    float mx = fmaxf(a[0], a[1]);
#pragma unroll
                    for (int e = 2; e < 16; ++e) mx = fmaxf(mx, a[e]);
                    mx = fmaxf(mx, __shfl_xor(mx, 32)); mnew = fmaxf(mold, mx); alpha = __builtin_amdgcn_exp2f(mold - mnew); };
                f32x16 s0 = qk(0);
                if (msk) causal(s0, 0);
                float m0, al0, m1, al1, ps0 = 0.f, ps1 = 0.f; unsigned pk0[8], pk1[8];
                rowmax(s0, mrun, m0, al0);
                __builtin_amdgcn_sched_barrier(0);
                f32x16 s1;
#pragma unroll
                for (int e = 0; e < 16; ++e) s1[e] = 0.f;
                auto kfrag = [&](int ks) { return *(const LAS bf16x8*)(KB + (32 + r) * 256 + (((2 * ks + hh) ^ (r & 15)) << 4)); };
                bf16x8 kf = kfrag(0), kf1 = kfrag(1), kf2 = kf1;
#pragma unroll
                for (int ks = 0; ks < 8; ++ks) {
                    if (ks < 6) kf2 = kfrag(ks + 2);
                    s1 = __builtin_amdgcn_mfma_f32_32x32x16_bf16(kf, __builtin_bit_cast(bf16x8, qf[ks]), s1, 0, 0, 0); kf = kf1; kf1 = kf2;
                    __builtin_amdgcn_sched_barrier(0);
                    const float p0 = __builtin_amdgcn_exp2f(s0[2 * ks] - m0), p1 = __builtin_amdgcn_exp2f(s0[2 * ks + 1] - m0); ps0 += p0 + p1; pk0[ks] = pk2(p0, p1); asm volatile("" : "+v"(pk0[ks]), "+v"(ps0));
                    __builtin_amdgcn_sched_barrier(0); }
                rescale(al0);
                if (msk) causal(s1, 1);
                rowmax(s1, m0, m1, al1);
                __builtin_amdgcn_sched_barrier(0);
                auto vfrag = [&](int i) { return *(const LAS bf16x8*)(VB + (32 * (i & 3) + r) * 128 + (((2 * (i >> 2) + hh) ^ ((r >> 1) & 7)) << 4)); };
                bf16x8 vf = vfrag(0), vf1 = vfrag(1), vf2 = vf1;
#pragma unroll
                for (int i = 0; i < 8; ++i) { const int st = i >> 2, db = i & 3;
                    const bf16x8 pf = __builtin_bit_cast(bf16x8, (u32x4){pk0[4 * st], pk0[4 * st + 1], pk0[4 * st + 2], pk0[4 * st + 3]});
                    if (i < 6) vf2 = vfrag(i + 2);
                    o[db] = __builtin_amdgcn_mfma_f32_32x32x16_bf16(vf, pf, o[db], 0, 0, 0); vf = vf1; vf1 = vf2;
                    __builtin_amdgcn_sched_barrier(0);
                    const float p0 = __builtin_amdgcn_exp2f(s1[2 * i] - m1), p1 = __builtin_amdgcn_exp2f(s1[2 * i + 1] - m1); ps1 += p0 + p1; pk1[i] = pk2(p0, p1); asm volatile("" : "+v"(pk1[i]), "+v"(ps1));
                    __builtin_amdgcn_sched_barrier(0); }
                rescale(al1);
#pragma unroll
                for (int i = 0; i < 8; ++i) { const int st = i >> 2, db = i & 3;
                    const bf16x8 pf = __builtin_bit_cast(bf16x8, (u32x4){pk1[4 * st], pk1[4 * st + 1], pk1[4 * st + 2], pk1[4 * st + 3]});
                    const bf16x8 vf = *(const LAS bf16x8*)(VB + (32 * db + r) * 128 + (((4 + 2 * st + hh) ^ ((r >> 1) & 7)) << 4)); o[db] = __builtin_amdgcn_mfma_f32_32x32x16_bf16(vf, pf, o[db], 0, 0, 0); }
                lrun = (lrun * al0 + ps0) * al1 + ps1; mrun = m1;
            }
            if (issued) asm volatile("s_waitcnt vmcnt(4)" ::: "memory"); else asm volatile("s_waitcnt vmcnt(0)" ::: "memory");
            if (n == 1) asm volatile("" : "+v"(entN));
            if (n == 2) q8_settle(qfn);
            b3 = b3 == 2 ? 0 : b3 + 1;
            WG_BAR();
        }
        { const float ltot = lrun + __shfl_xor(lrun, 32);
          if (valid) { const float inv = 1.0f / ltot; const size_t pi = ((size_t)qtok * MH + h) * 4 + slot; bf16_t* op = PO + pi * MD;
#pragma unroll
            for (int db = 0; db < 4; ++db)
#pragma unroll
                for (int g = 0; g < 4; ++g) { u32x2 wv; wv.x = pk2(o[db][4 * g] * inv, o[db][4 * g + 1] * inv); wv.y = pk2(o[db][4 * g + 2] * inv, o[db][4 * g + 3] * inv); *(u32x2*)(op + 32 * db + 8 * g + 4 * hh) = wv; }
            if (hh == 0) *(f32x2*)(PML + pi * 2) = (f32x2){mrun, ltot}; } }
        if (!has_next) break;
        h = hN; kblk = kblkN; qtok = qtokN; slot = slotN; typeA = nA; valid = nA ? true : validN; wvalid = nA ? true : wvalidN; ++k;
#pragma unroll
        for (int ks = 0; ks < 8; ++ks) qf[ks] = qfn[ks];
    }
}
__device__ __forceinline__ void ph6_merge(ArgsP A, Frame& F) {
    unsigned char* ws = A->ws; const bf16_t* PO = (const bf16_t*)(ws + WS_PARTO); const float* PML = (const float*)(ws + WS_PARTML); bf16_t* YB = (bf16_t*)(ws + WS_YB);
    const int gw = F.vcu * NWAVES + F.wave, NGW = F.G * NWAVES, hl = F.lane >> 5, dg = F.lane & 31;
    for (int it0 = gw * 4; it0 < T * 8; it0 += NGW * 4) {
        u32x2 ov[4][4]; f32x2 ml[4][4];
#pragma unroll
        for (int k = 0; k < 4; ++k) { const int it = it0 + k, t = it >> 3, h = 2 * (it & 7) + hl; const size_t pi = ((size_t)t * MH + h) * 4;
#pragma unroll
            for (int sl = 0; sl < 4; ++sl) { ov[k][sl] = *(const u32x2*)(PO + (pi + sl) * MD + 4 * dg); ml[k][sl] = *(const f32x2*)(PML + (pi + sl) * 2); } }
#pragma unroll
        for (int k = 0; k < 4; ++k) { const int it = it0 + k, t = it >> 3, h = 2 * (it & 7) + hl, blk = t >> 8, nsel = blk < 3 ? blk : 3;
            float mmax = ml[k][3][0];
#pragma unroll
            for (int sl = 0; sl < 3; ++sl) if (sl < nsel) mmax = fmaxf(mmax, ml[k][sl][0]);
            f32x4 acc = (f32x4){0.f, 0.f, 0.f, 0.f}; float wsum = 0.f;
#pragma unroll
            for (int sl = 0; sl < 4; ++sl) { if (sl == 3 || sl < nsel) { const float w = ml[k][sl][1] * __builtin_amdgcn_exp2f(ml[k][sl][0] - mmax); wsum += w;
                acc += w * (f32x4){bflo(ov[k][sl].x), bfhi(ov[k][sl].x), bflo(ov[k][sl].y), bfhi(ov[k][sl].y)}; } }
            const float inv = 1.0f / wsum; st4bf(YB + (size_t)t * RW + h * MD + 4 * dg, acc * inv); }
    }
}

__device__ __forceinline__ void ins16(float (&top)[16], float x) {
#pragma unroll
    for (int k = 15; k >= 1; --k) top[k] = __builtin_amdgcn_fmed3f(top[k - 1], top[k], x);
    top[0] = fmaxf(top[0], x);
}
__device__ __forceinline__ void ph10_select(ArgsP A, Frame& F) {
    unsigned char* ws = A->ws; const bf16_t* PQ = (const bf16_t*)(ws + WS_PQ); const bf16_t* SK = (const bf16_t*)(ws + WS_SUBK); int* IDX = (int*)(ws + WS_IDX); float* GW = (float*)(ws + WS_GW);
    const int gw = F.vcu * NWAVES + F.wave, NGW = F.G * NWAVES; const int r = F.lane & 31, hh = F.lane >> 5; const float NEG = -__builtin_inff();
    for (int it = gw; it < (T / 32) * PH_; it += NGW) { const int tg = it >> 3, h = it & 7, t = tg * 32 + r;
        float TA[16], TB[16];
        auto topk = [&](int p, float (&dst)[16]) {
            bf16x8 qf[8];
#pragma unroll
            for (int ks = 0; ks < 8; ++ks) qf[ks] = *(const bf16x8*)(PQ + (size_t)t * 2048 + (h * 2 + p) * PHALF + 16 * ks + 8 * hh);
            float top[16];
#pragma unroll
            for (int k = 0; k < 16; ++k) top[k] = NEG;
#pragma unroll 1
            for (int nb = 0; nb < 4; ++nb) { f32x16 acc;
#pragma unroll
                for (int e = 0; e < 16; ++e) acc[e] = 0.f;
#pragma unroll
                for (int ks = 0; ks < 8; ++ks) { const bf16x8 a = *(const bf16x8*)(SK + ((size_t)(h * 2 + p) * PNK + 32 * nb + r) * PHALF + 16 * ks + 8 * hh); acc = __builtin_amdgcn_mfma_f32_32x32x16_bf16(a, qf[ks], acc, 0, 0, 0); }
#pragma unroll
                for (int e = 0; e < 16; ++e) { const unsigned key = 32 * nb + (e & 3) + 8 * (e >> 2) + 4 * hh; float ae = acc[e]; asm volatile("" : "+v"(ae));
                    const float x = __builtin_bit_cast(float, (__builtin_bit_cast(unsigned, ae) & ~0x7Fu) | key); ins16(top, x); } }
            float oth[16];
#pragma unroll
            for (int k = 0; k < 16; ++k) oth[k] = __shfl_xor(top[k], 32);
#pragma unroll
            for (int k = 0; k < 16; ++k) ins16(top, oth[k]);
#pragma unroll
            for (int k = 0; k < 16; ++k) dst[k] = top[k];
        };
        topk(0, TA); asm volatile("" ::: "memory"); __builtin_amdgcn_sched_barrier(0); topk(1, TB); asm volatile("" ::: "memory"); __builtin_amdgcn_sched_barrier(0);
        float fin[16];
#pragma unroll
        for (int k = 0; k < 16; ++k) fin[k] = NEG;
#pragma unroll
        for (int i = 0; i < 16; ++i)
#pragma unroll
            for (int j = 0; j < 16; ++j) if ((i + 1) * (j + 1) <= 16) { const float sm = TA[i] + TB[j]; ins16(fin, __builtin_bit_cast(float, (__builtin_bit_cast(unsigned, sm) & ~0xFFu) | (unsigned)(i * 16 + j))); }
        float e[16], den = 0.f;
#pragma unroll
        for (int k = 0; k < 16; ++k) { e[k] = __expf(fin[k] - fin[0]); den += e[k]; }
        const float rden = 1.0f / den;
        int oi[8]; float og[8];
#pragma unroll
        for (int kk = 0; kk < 8; ++kk) { const float fv = hh ? fin[8 + kk] : fin[kk]; og[kk] = (hh ? e[8 + kk] : e[kk]) * rden; const unsigned id = __builtin_bit_cast(unsigned, fv) & 0xFFu; const unsigned ci = id >> 4, cj = id & 15u;
            unsigned ia = 0u, ib = 0u;
#pragma unroll
            for (int q = 0; q < 16; ++q) { ia = (ci == (unsigned)q) ? (__builtin_bit_cast(unsigned, TA[q]) & 0x7Fu) : ia; ib = (cj == (unsigned)q) ? (__builtin_bit_cast(unsigned, TB[q]) & 0x7Fu) : ib; }
            oi[kk] = (int)(ia * PNK + ib); }
        int* ip = IDX + (size_t)t * 128 + h * 16 + 8 * hh; float* gp = GW + (size_t)t * 128 + h * 16 + 8 * hh;
        *(u32x4*)ip = (u32x4){(unsigned)oi[0], (unsigned)oi[1], (unsigned)oi[2], (unsigned)oi[3]}; *(u32x4*)(ip + 4) = (u32x4){(unsigned)oi[4], (unsigned)oi[5], (unsigned)oi[6], (unsigned)oi[7]};
        *(f32x4*)gp = (f32x4){og[0], og[1], og[2], og[3]}; *(f32x4*)(gp + 4) = (f32x4){og[4], og[5], og[6], og[7]};
    }
}


__device__ __forceinline__ float ub0(unsigned w) { return (float)(w & 0xffu); }
__device__ __forceinline__ float ub1(unsigned w) { return (float)((w >> 8) & 0xffu); }
__device__ __forceinline__ float ub2(unsigned w) { return (float)((w >> 16) & 0xffu); }
__device__ __forceinline__ float ub3(unsigned w) { return (float)(w >> 24); }
__device__ __forceinline__ float dot16q(u32x4 q, const float (&h)[16]) {
    return ((ub0(q.x) * h[0] + ub1(q.x) * h[1]) + (ub2(q.x) * h[2] + ub3(q.x) * h[3])) + ((ub0(q.y) * h[4] + ub1(q.y) * h[5]) + (ub2(q.y) * h[6] + ub3(q.y) * h[7]))
         + ((ub0(q.z) * h[8] + ub1(q.z) * h[9]) + (ub2(q.z) * h[10] + ub3(q.z) * h[11])) + ((ub0(q.w) * h[12] + ub1(q.w) * h[13]) + (ub2(q.w) * h[14] + ub3(q.w) * h[15]));
}
__device__ __forceinline__ void ph11_gather(ArgsP A, Frame& F) {
    unsigned char* ws = A->ws; const bf16_t* H2 = (const bf16_t*)(ws + WS_H2); const unsigned char* PU = (const unsigned char*)(ws + WS_PU); const unsigned char* PV = (const unsigned char*)(ws + WS_PV);
    const float* PSU = (const float*)(ws + WS_PSU); const float* PSV = (const float*)(ws + WS_PSV);
    const int* IDX = (const int*)(ws + WS_IDX); const float* GW = (const float*)(ws + WS_GW); const float* X1 = (const float*)(ws + WS_X1);
    LAS float* coef = (LAS float*)(F.lds + RING_OFF); LAS int* eidx = (LAS int*)(F.lds + RING_OFF + 1024); LAS float* red = (LAS float*)(F.lds + RING_OFF + 2048);
    const int tid = F.tid, wave = F.wave, lane = F.lane; int par = 0;
    for (int tgk = F.vcu * 32; tgk < T; tgk = ((tgk & 31) == 31) ? tgk + (F.G - 1) * 32 + 1 : tgk + 1, par ^= 1) { const int t = tgk;
        float hv[4][16]; float hs = 0.f;
#pragma unroll
        for (int i = 0; i < 4; ++i) { const bf16_t* hp = H2 + (size_t)t * D + i * 1024 + lane * 16; f32x4 a, b, c, d; pg8::unpack8(*(const u32x4*)hp, a, b); pg8::unpack8(*(const u32x4*)(hp + 8), c, d);
#pragma unroll
            for (int e = 0; e < 4; ++e) { hv[i][e] = a[e]; hv[i][4 + e] = b[e]; hv[i][8 + e] = c[e]; hv[i][12 + e] = d[e]; }
            hs += ((a[0] + a[1]) + (a[2] + a[3])) + ((b[0] + b[1]) + (b[2] + b[3])) + ((c[0] + c[1]) + (c[2] + c[3])) + ((d[0] + d[1]) + (d[2] + d[3])); }
        hs = wave_sum(hs);
        const int myidx = (lane < 16) ? IDX[(size_t)t * 128 + wave * 16 + lane] : 0; const float myg = (lane < 16) ? GW[(size_t)t * 128 + wave * 16 + lane] : 0.f;
        float dots = 0.f;
#pragma unroll 1
        for (int k = 0; k < 16; k += 4) {
            u32x4 q[4][4];
#pragma unroll
            for (int x = 0; x < 4; ++x) { const int e = __builtin_amdgcn_readlane(myidx, k + x); const unsigned char* up = PU + (size_t)e * D + lane * 16;
#pragma unroll
                for (int i = 0; i < 4; ++i) q[x][i] = *(const u32x4*)(up + i * 1024); }
#pragma unroll
            for (int x = 0; x < 4; ++x) { float d = 0.f;
#pragma unroll
                for (int i = 0; i < 4; ++i) d += dot16q(q[x][i], hv[i]);
                d = wave_sum(d); if (lane == k + x) dots = d; }
        }
        if (lane < 16) { const float s = PSU[myidx] * (dots - 128.0f * hs); const float act = 0.5f * s * (1.0f + erff(s * 0.70710678118654752f));
            coef[par * 128 + wave * 16 + lane] = myg * act * PSV[myidx]; eidx[par * 128 + wave * 16 + lane] = myidx; }
        WG_BAR();
        float acc[8]; float csum = 0.f;
#pragma unroll
        for (int i = 0; i < 8; ++i) acc[i] = 0.f;
#pragma unroll 1
        for (int e = 0; e < 128; e += 16) { u32x2 v[16]; float c[16];
#pragma unroll
            for (int q = 0; q < 16; ++q) { const int ei = __builtin_amdgcn_readfirstlane(eidx[par * 128 + e + q]); c[q] = coef[par * 128 + e + q]; v[q] = *(const u32x2*)(PV + (size_t)ei * D + tid * 8); }
#pragma unroll
            for (int q = 0; q < 16; ++q) { csum += c[q]; acc[0] += c[q] * ub0(v[q].x); acc[1] += c[q] * ub1(v[q].x); acc[2] += c[q] * ub2(v[q].x); acc[3] += c[q] * ub3(v[q].x); acc[4] += c[q] * ub0(v[q].y); acc[5] += c[q] * ub1(v[q].y); acc[6] += c[q] * ub2(v[q].y); acc[7] += c[q] * ub3(v[q].y); } }
        const float corr = -128.0f * csum;
        const f32x4 x0 = *(const f32x4*)(X1 + (size_t)t * D + tid * 8), x1 = *(const f32x4*)(X1 + (size_t)t * D + tid * 8 + 4);
        f32x4 y0 = x0 + ((f32x4){acc[0], acc[1], acc[2], acc[3]} + corr), y1 = x1 + ((f32x4){acc[4], acc[5], acc[6], acc[7]} + corr);
        float ss = (y0[0] * y0[0] + y0[1] * y0[1]) + (y0[2] * y0[2] + y0[3] * y0[3]) + (y1[0] * y1[0] + y1[1] * y1[1]) + (y1[2] * y1[2] + y1[3] * y1[3]);
        ss = wave_sum(ss); if (lane == 0) red[par * 8 + wave] = ss;
        WG_BAR();
        float tot = 0.f;
#pragma unroll
        for (int w = 0; w < 8; ++w) tot += red[par * 8 + w];
        const float rs = 1.0f / sqrtf(tot * (1.0f / D) + NORM_EPS);
        const f32x4 g0 = *(const f32x4*)(A->final_g + tid * 8), g1 = *(const f32x4*)(A->final_g + tid * 8 + 4);
        *(f32x4*)(A->out + (size_t)t * D + tid * 8) = y0 * rs * g0; *(f32x4*)(A->out + (size_t)t * D + tid * 8 + 4) = y1 * rs * g1;
    }
}

constexpr int NPH = 13;
__device__ __forceinline__ Frame make_frame(unsigned char* lds) {
    Frame F; int t = threadIdx.x; asm volatile("" : "+v"(t));
    F.lds = (LAS unsigned char*)lds; F.tid = t; F.lane = t & 63; F.wave = __builtin_amdgcn_readfirstlane(t >> 6);
    F.G = gridDim.x; { const int bx = blockIdx.x; F.vcu = (F.G % 8 == 0) ? (bx % 8) * (F.G / 8) + bx / 8 : bx; }
    return F;
}
__global__ void __launch_bounds__(NTHR, 2) mk_fwd(Args args_by_value) {
    extern __shared__ __attribute__((aligned(16))) unsigned char lds[];
    ArgsP args = get_args();
    gu32* ctl = (gu32*)(args->ws + WS_CTL);
    for (int u = threadIdx.x; u < (LDS_BYTES - LDSCTL_OFF) / 4; u += NTHR) ((LAS unsigned*)((LAS unsigned char*)lds + LDSCTL_OFF))[u] = 0u;
    __syncthreads();
    const int lo = args->ph_lo, hi = args->ph_hi;
    volatile LAS unsigned* MISC = (volatile LAS unsigned*)((LAS unsigned char*)lds + MISC_OFF);
    XcdBarrier bar; bar.bar = (unsigned*)(ctl + CW_BAR) + args->li * XCD_BAR_WORDS; bar.x = 0; bar.st = nullptr;
    if (hi - lo > 1) bar = xcd_barrier_post((unsigned*)(ctl + CW_BAR) + args->li * XCD_BAR_WORDS, MISC + 8);
#define IN(k) (lo <= (k) && (k) < hi)
#define SEAM(k) do { if (IN(k) && IN((k) + 1)) xcd_barrier(bar); } while (0)
    const int bid = (int)blockIdx.x;

    if (IN(0)) { Frame F = make_frame(lds); ph0_prologue(get_args(), F); SEAM(0); }
    if (IN(1)) { Frame F = make_frame(lds); LAS unsigned char* ring = F.lds + RING_OFF; ArgsP a_ = get_args(); unsigned char* ws = a_->ws;
        { pg8::Gemm g{(const bf16_t*)(ws + WS_XN), (const bf16_t*)(ws + WS_WIN), T, PLD, D}; pg8::StaticOrder S; S.init(T, PLD, F.G, bid);
          pg8::EpiProj E{(bf16_t*)(ws + WS_PROJ), (const float*)(ws + WS_ROPE), (bf16_t*)(ws + WS_KB)}; pg8::gemm_phase<pg8::EpiProj, pg8::StaticOrder, true, true>(ring, g, S, E); }
        { pg8::Gemm g{(const bf16_t*)(ws + WS_XN), (const bf16_t*)(ws + WS_WIN) + (size_t)PC_MV * D, T, 2048, D}; pg8::StaticOrder S; S.init(T, 2048, F.G, bid);
          pg8::EpiVT E{(bf16_t*)(ws + WS_VT)}; pg8::gemm_phase<pg8::EpiVT, pg8::StaticOrder, true, true>(ring, g, S, E); }
        { constexpr int NT1 = (T / 256) * (PLD / 256); const int nx = NT1 % F.G;
          if (bid >= nx) { WG_BAR(); { Frame F2 = make_frame(lds); late_weights(get_args(), F2, (bid - nx) * NWAVES + F2.wave, (F2.G - nx) * NWAVES); }
              if (nx) { Frame F2 = make_frame(lds); peer_quant(get_args(), F2, 0, pq_ra(F2.G), (bid - nx) * NWAVES + F2.wave, (F2.G - nx) * NWAVES); } } }
        SEAM(1); }
    if (IN(2)) { Frame F = make_frame(lds); ph2_prep(get_args(), F); SEAM(2); }
    if (IN(3)) { Frame F = make_frame(lds); LAS unsigned char* ring = F.lds + RING_OFF; ArgsP a_ = get_args(); unsigned char* ws = a_->ws;
        { pg8::Gemm g{(const bf16_t*)(ws + WS_AW), (const bf16_t*)(ws + WS_WUP), T, RW, LW}; pg8::StaticOrder S; S.init(T, RW, F.G, bid);
          pg8::EpiDec E{(float*)(ws + WS_DEC), a_->w0}; pg8::gemm_phase<pg8::EpiDec, pg8::StaticOrder, true, true>(ring, g, S, E); }
        asm volatile("" ::: "memory"); __builtin_amdgcn_sched_barrier(0);
        { pg8::Gemm g{(const bf16_t*)(ws + WS_AA), (const bf16_t*)(ws + WS_AUP), T, RW, LA}; pg8::StaticOrder S; S.init(T, RW, F.G, bid);
          pg8::EpiA E{(bf16_t*)(ws + WS_KP), (bf16_t*)(ws + WS_BB), (const bf16_t*)(ws + WS_KKN), a_->a0, a_->k_a}; pg8::gemm_phase<pg8::EpiA, pg8::StaticOrder, true, true>(ring, g, S, E); }
        asm volatile("" ::: "memory"); __builtin_amdgcn_sched_barrier(0);
        { pg8::Gemm g{(const bf16_t*)(ws + WS_AG), (const bf16_t*)(ws + WS_GUP), T, RW, LGP}; pg8::StaticOrder S; S.init(T, RW, F.G, bid);
          pg8::EpiBf16 E{(bf16_t*)(ws + WS_G), RW}; pg8::gemm_phase<pg8::EpiBf16, pg8::StaticOrder, true, true>(ring, g, S, E); }
        { Frame F2 = make_frame(lds); ph3_gate(get_args(), F2); }
        SEAM(3); }
    if (IN(4)) { Frame F = make_frame(lds); ph4_chunkprep(get_args(), F); SEAM(4); }
    if (IN(5)) {
        { Frame F = make_frame(lds); if (F.vcu < RH) ph5_chain(get_args(), F, F.vcu); }
        { Frame F = make_frame(lds); ph5_attn(get_args(), F); }
        { Frame F = make_frame(lds); if (F.vcu >= RH) peer_quant(get_args(), F, pq_ra(F.G), 2 * 16384, (F.vcu - RH) * NWAVES + F.wave, (F.G - RH) * NWAVES); }
        SEAM(5); }
    if (IN(6)) { { Frame F = make_frame(lds); ph6_merge(get_args(), F); } { Frame F = make_frame(lds); ph5_ypost(get_args(), F); } SEAM(6); }
    if (IN(7)) { Frame F = make_frame(lds); LAS unsigned char* ring = F.lds + RING_OFF; ArgsP a_ = get_args(); unsigned char* ws = a_->ws;
        { pg8::Gemm g{(const bf16_t*)(ws + WS_YA), (const bf16_t*)(ws + WS_WA), T, D, RW}; pg8::StaticOrder S; S.init(T, D, F.G, bid);
          pg8::EpiMix<false> E{(bf16_t*)(ws + WS_MIXED), (const bf16_t*)(ws + WS_PROJ), PC_GA}; pg8::gemm_phase<pg8::EpiMix<false>, pg8::StaticOrder, true, true>(ring, g, S, E); }
        { pg8::Gemm g{(const bf16_t*)(ws + WS_YB), (const bf16_t*)(ws + WS_WB), T, D, RW}; pg8::StaticOrder S; S.init(T, D, F.G, bid);
          pg8::EpiMix<true> E{(bf16_t*)(ws + WS_MIXED), (const bf16_t*)(ws + WS_PROJ), PC_GB}; pg8::gemm_phase<pg8::EpiMix<true>, pg8::StaticOrder, true, true>(ring, g, S, E); }
        SEAM(7); }
    if (IN(8)) { Frame F = make_frame(lds); LAS unsigned char* ring = F.lds + RING_OFF; ArgsP a_ = get_args(); unsigned char* ws = a_->ws;
        pg8::Gemm g{(const bf16_t*)(ws + WS_MIXED), (const bf16_t*)(ws + WS_WOUT), T, D, D}; pg8::StaticOrder S; S.init(T, D, F.G, bid);
        pg8::EpiRes E{(float*)(ws + WS_X1), a_->x}; pg8::gemm_phase<pg8::EpiRes, pg8::StaticOrder, true, true>(ring, g, S, E);
        SEAM(8); }
    if (IN(9)) { Frame F = make_frame(lds); ArgsP a_ = get_args(); unsigned char* ws = a_->ws; const int gw = F.vcu * NWAVES + F.wave, NGW = F.G * NWAVES;
        rms_rows_to_bf16((const float*)(ws + WS_X1), a_->norm2_g, (bf16_t*)(ws + WS_H2), gw, NGW, F.lane);
        SEAM(9); }
    if (IN(10)) { Frame F = make_frame(lds); LAS unsigned char* ring = F.lds + RING_OFF; ArgsP a_ = get_args(); unsigned char* ws = a_->ws;
        pg8::Gemm g{(const bf16_t*)(ws + WS_H2), (const bf16_t*)(ws + WS_WQ), T, 2048, D}; pg8::StaticOrder S; S.init(T, 2048, F.G, bid);
        pg8::EpiBf16 E{(bf16_t*)(ws + WS_PQ), 2048}; pg8::gemm_phase<pg8::EpiBf16, pg8::StaticOrder, true, true>(ring, g, S, E);
        SEAM(10); }
    if (IN(11)) { Frame F = make_frame(lds); ph10_select(get_args(), F);
        if (IN(12)) { __builtin_amdgcn_fence(__ATOMIC_RELEASE, "workgroup"); WG_BAR(); __builtin_amdgcn_fence(__ATOMIC_ACQUIRE, "workgroup"); } }
    if (IN(12)) { Frame F = make_frame(lds); ph11_gather(get_args(), F); }
#undef IN
#undef SEAM
}

extern "C" void kernel_launch(void* const* d_in, const int* in_sizes, int n_in, void* d_out, int out_size, void* d_ws, size_t ws_size, hipStream_t stream) {
    static int grid = 0;
    if (grid == 0) {
        if (n_in != 23 || out_size != T * D || ws_size < WS_END) { fprintf(stderr, "kernel_launch: unexpected shapes (n_in %d out %d ws %zu); nothing launched\n", n_in, out_size, ws_size); grid = -1; return; }
        int dev = 0, cus = 0, per_cu = 0;
        if (hipGetDevice(&dev) != hipSuccess || hipDeviceGetAttribute(&cus, hipDeviceAttributeMultiprocessorCount, dev) != hipSuccess) { grid = -1; return; }
        if (hipFuncSetAttribute((const void*)mk_fwd, hipFuncAttributeMaxDynamicSharedMemorySize, LDS_BYTES) != hipSuccess) { grid = -1; return; }
        if (hipOccupancyMaxActiveBlocksPerMultiprocessor(&per_cu, (const void*)mk_fwd, NTHR, LDS_BYTES) != hipSuccess || per_cu < 1) fprintf(stderr, "kernel_launch: occupancy query reports %d\n", per_cu);
        (void)hipGetLastError();
        grid = cus;
    }
    if (grid < 0) return;
    (void)hipMemsetAsync((char*)d_ws + WS_CTL, 0, CTL_ZERO_BYTES, stream);
    Args a{};
    const float** ap = (const float**)&a;
    for (int i = 0; i < 23; ++i) ap[i] = (const float*)d_in[i];
    a.out = (float*)d_out; a.ws = (unsigned char*)d_ws; a.pad = 0;
    constexpr int NL = MK_N_LAUNCHES;
    for (int li = 0; li < NL; ++li) {
        a.ph_lo = (NL == 1) ? 0 : li; a.ph_hi = (NL == 1) ? NPH : li + 1; a.li = (NL == 1) ? 0 : 0;
        hipLaunchKernelGGL(mk_fwd, dim3(grid), dim3(NTHR), LDS_BYTES, stream, a);
#ifdef DUP_HI
        if (NL > 1 && li == DUP_HI) for (int l2 = DUP_LO; l2 <= DUP_HI; ++l2) { a.ph_lo = l2; a.ph_hi = l2 + 1; hipLaunchKernelGGL(mk_fwd, dim3(grid), dim3(NTHR), LDS_BYTES, stream, a); }
#endif
    }
}
```

```cpp
#include <hip/hip_runtime.h>
#include <cstdio>
#include <cstdint>

#ifndef MK_N_LAUNCHES
#define MK_N_LAUNCHES 1
#endif

#define GAS __attribute__((address_space(1)))
#define LAS __attribute__((address_space(3)))
typedef unsigned short bf16_t;
typedef __bf16 bf16x8 __attribute__((ext_vector_type(8)));
typedef float f32x2 __attribute__((ext_vector_type(2)));
typedef float f32x4 __attribute__((ext_vector_type(4)));
typedef float f32x16 __attribute__((ext_vector_type(16)));
typedef unsigned u32x2 __attribute__((ext_vector_type(2)));
typedef unsigned u32x4 __attribute__((ext_vector_type(4)));
typedef GAS unsigned gu32;

constexpr int T = 8192, D = 4096;
constexpr int RW = 2048, RH = 32, RN = 64;
constexpr int LW = 128, LA = 128, LG = 480, LGP = 512;
constexpr int SHIFTW = 6880;
constexpr int MH = 16, MD = 128, MBLK = 256, NBLK = 32;
constexpr int INW = 21216;
constexpr int PLD = 19200;
constexpr int PC_R = 0, PC_K = 2048, PC_V = 4096, PC_WL = 6144, PC_AL = 6272, PC_GL = 6400, PC_MQ = 6912, PC_MK = 8960, PC_GA = 11008, PC_GB = 15104, PC_MV = 19200;
constexpr int WIN_ROWS = 21248;
constexpr int PQ_SPLIT = 16384;
constexpr int PH_ = 8, PNK = 128, PQD = 256, PHALF = 128, PTOPK = 16;
constexpr float NORM_EPS = 1e-6f, LNX_EPS = 64e-5f;
constexpr float QSCALE = 0.08838834764831845f * 1.4426950408889634f;

constexpr size_t MiB = 1u << 20;
constexpr size_t WS_CTL = 0, CTL_ZERO_BYTES = 1 * MiB;
constexpr size_t WS_WIN = 1 * MiB;
constexpr size_t WS_X1 = 1 * MiB, WS_PQ = 129 * MiB;
constexpr size_t WS_WA = 167 * MiB, WS_WB = 183 * MiB, WS_WOUT = 199 * MiB, WS_WQ = 231 * MiB, WS_WUP = 247 * MiB, WS_AUP = 248 * MiB, WS_GUP = 249 * MiB, WS_SUBK = 251 * MiB;
constexpr size_t WS_PU = 252 * MiB, WS_PV = 380 * MiB;
constexpr size_t WS_XN = 508 * MiB;
constexpr size_t WS_Y = 508 * MiB, WS_RSQ = 508 * MiB, WS_RS = 510 * MiB;
constexpr size_t WS_PROJ = 572 * MiB;
constexpr size_t WS_VT = 872 * MiB;
constexpr size_t WS_ROPE = 904 * MiB, WS_KMEAN = 908 * MiB, WS_MASK = 909 * MiB, WS_AW = 910 * MiB, WS_AA = 912 * MiB, WS_AG = 914 * MiB;
constexpr size_t WS_PSU = 909 * MiB + 512 * 1024, WS_PSV = WS_PSU + 64 * 1024;
constexpr size_t WS_DEC = 922 * MiB;
constexpr size_t WS_MIXED = 922 * MiB;
constexpr size_t WS_KKN = 986 * MiB, WS_BB = 1018 * MiB, WS_KP = 1050 * MiB, WS_ZR = 1082 * MiB, WS_ZV = 1114 * MiB, WS_G = 1146 * MiB;
constexpr size_t WS_YA = 1178 * MiB, WS_YB = 1210 * MiB, WS_IDX = 1242 * MiB, WS_GW = 1246 * MiB, WS_PARTML = 1250 * MiB, WS_LIST = 1254 * MiB, WS_UDESC = 1262 * MiB, WS_KB = 1267 * MiB, WS_END = 1299 * MiB;
constexpr size_t WS_PARTO = 922 * MiB;

constexpr int CW_TMO = 0, CW_CODE = 1, CW_ATTNQ = 64, CW_CNT = 1024, CW_BAR = 4096;

constexpr int RING_OFF = 0, RING_BYTES = 155648;
constexpr int LDSCTL_OFF = RING_BYTES, MISC_OFF = LDSCTL_OFF + 320;
constexpr int LDS_BYTES = 163840;
constexpr int NWAVES = 8, NTHR = 512;

__device__ __forceinline__ unsigned f2bf(float f) { unsigned u = __builtin_bit_cast(unsigned, f); return (u + 0x7fffu + ((u >> 16) & 1u)) >> 16; }
typedef __bf16 bf16x2 __attribute__((ext_vector_type(2)));
__device__ __forceinline__ unsigned pk2(float lo, float hi) { const f32x2 v = {lo, hi}; return __builtin_bit_cast(unsigned, __builtin_convertvector(v, bf16x2)); }
__device__ __forceinline__ float bflo(unsigned u) { return __builtin_bit_cast(float, u << 16); }
__device__ __forceinline__ float bfhi(unsigned u) { return __builtin_bit_cast(float, u & 0xffff0000u); }
__device__ __forceinline__ float bf1(bf16_t b) { return __builtin_bit_cast(float, (unsigned)b << 16); }
__device__ __forceinline__ float fsigmoid(float x) { return __builtin_amdgcn_rcpf(1.0f + __expf(-x)); }
__device__ __forceinline__ float wave_sum(float v) {
#pragma unroll
    for (int o = 1; o < 64; o <<= 1) v += __shfl_xor(v, o);
    return v;
}
template <int CTRL> __device__ __forceinline__ float dpp_f(float v) { return __builtin_bit_cast(float, __builtin_amdgcn_update_dpp(0, __builtin_bit_cast(int, v), CTRL, 0xF, 0xF, true)); }
__device__ __forceinline__ float sum16(float x) {
    x += dpp_f<0xB1>(x); x += dpp_f<0x4E>(x); x += dpp_f<0x141>(x); x += dpp_f<0x140>(x); return x;
}
__device__ __forceinline__ float vmul(float a, float b) { float r; asm("v_mul_f32_e32 %0, %1, %2" : "=v"(r) : "v"(a), "v"(b)); return r; }
__device__ __forceinline__ float vfma(float a, float b, float c) { float r; asm("v_fma_f32 %0, %1, %2, %3" : "=v"(r) : "v"(a), "v"(b), "v"(c)); return r; }
#define LDS_WAIT() asm volatile("s_waitcnt lgkmcnt(0)" ::: "memory")
#define VM_WAIT() asm volatile("s_waitcnt vmcnt(0)" ::: "memory")
#define WG_BAR() do { asm volatile("s_waitcnt lgkmcnt(0)" ::: "memory"); __builtin_amdgcn_s_barrier(); asm volatile("" ::: "memory"); } while (0)

namespace pg8 {
constexpr int BM = 256, BK = 64, HALF = 128, HTB = HALF * BK * 2, STAGE_BYTES = 8 * HTB, NXCD = 8, WGM = 8;
__host__ __device__ __forceinline__ int lds_byte(int r, int c) { const int st = (r >> 4) * 2 + (c >> 5), rr = r & 15, cc = c & 31, ob = rr * 64 + cc * 2; return st * 1024 + (ob ^ (((ob >> 9) & 1) << 5)); }
__host__ __device__ __forceinline__ void stage_rc(int b, int& R, int& C) { const int st = b / 1024, sb = b % 1024, swz = sb ^ (((sb >> 9) & 1) << 5); R = (st >> 1) * 16 + swz / 64; C = (st & 1) * 32 + (swz % 64) / 2; }
__host__ __device__ __forceinline__ int perm32(int rho) { const int n = rho >> 4, i = rho & 15; return 8 * (i >> 2) + 4 * n + (i & 3); }

struct Unit { int pm, pn; };
struct Gemm { const bf16_t* A; const bf16_t* Bt; int M, N, K; };

struct StaticOrder {
    int nM, nN, nwg, G, c;
    __host__ __device__ void init(int M, int N, int G_, int c_) { nM = M / BM; nN = N / BM; nwg = nM * nN; G = G_; c = c_; }
    __host__ __device__ bool next(int i, Unit& u) const {
        const long L = (long)i * G + c; if (L >= nwg) return false;
        int wgid = (int)L; { const int q = nwg / NXCD, r = nwg % NXCD, xcd = wgid % NXCD, off = wgid / NXCD; wgid = (xcd < r ? xcd * (q + 1) : r * (q + 1) + (xcd - r) * q) + off; }
        const int nig = WGM * nN, gid = wgid / nig, fm = gid * WGM, gsz = (nM - fm) < WGM ? (nM - fm) : WGM;
        u.pm = fm + ((wgid % nig) % gsz); u.pn = (wgid % nig) / gsz; return true;
    }
    __device__ __forceinline__ void a_ready(const Unit&) const {}
    __device__ __forceinline__ void done(const Unit&) const {}
};

template <class Epi, class Sched, bool ALIGN_EPI = false, bool SP2 = false>
__device__ __forceinline__ void gemm_phase(LAS unsigned char* lds, const Gemm g, const Sched& S, const Epi& E) {
    int tid_ = threadIdx.x; asm volatile("" : "+v"(tid_));
    const int tid = tid_, wid = __builtin_amdgcn_readfirstlane(tid >> 6), lane = tid & 63, wr = wid >> 2, wc = wid & 3, fr = lane & 15, fq = lane >> 4;
    int K_ = g.K; asm volatile("" : "+s"(K_));
    const int K = K_, nt = K / BK;
    unsigned voffA[2], voffB[2];
#pragma unroll
    for (int i = 0; i < 2; ++i) { int R, C; stage_rc(tid * 16 + i * 8192, R, C); const int Rb = Epi::PERM ? ((R & ~31) + perm32(R & 31)) : R;
        voffA[i] = (unsigned)(R * K + C) * 2u; voffB[i] = (unsigned)(Rb * K + C) * 2u; }
    const size_t kstep = (size_t)(BK * 2);
    const size_t hstep = (size_t)HALF * K * 2;
    const size_t tstep = 2 * hstep;
    const unsigned ldsw = (unsigned)wid * 1024u;
    const int aoff = lds_byte(wr * 64 + fr, fq * 8), boff = lds_byte(wc * 32 + fr, fq * 8);
#define PG8_SA(b, h) (((b) * 2 + (h)) * HTB)
#define PG8_SB(b, h) ((4 + (b) * 2 + (h)) * HTB)
#define PG8_STAGE(bufoff, gbase, voff) do { _Pragma("unroll") for (int _i = 0; _i < 2; ++_i) \
        __builtin_amdgcn_global_load_lds((const unsigned*)((const char*)(gbase) + (voff)[_i]), (LAS unsigned*)(lds + (bufoff) + ldsw + _i * 8192), 16, 0, 0); } while (0)
#define PG8_LDA(dst, b, h) do { _Pragma("unroll") for (int m = 0; m < 4; ++m) _Pragma("unroll") for (int k = 0; k < 2; ++k) dst[m][k] = *(const LAS bf16x8*)(lds + PG8_SA(b, h) + aoff + m * 2048 + k * 1024); } while (0)
#define PG8_LDB(dst, b, h) do { _Pragma("unroll") for (int n = 0; n < 2; ++n) _Pragma("unroll") for (int k = 0; k < 2; ++k) dst[n][k] = *(const LAS bf16x8*)(lds + PG8_SB(b, h) + boff + n * 2048 + k * 1024); } while (0)
#define PG8_MMA(ai, bj, At, Bt) do { __builtin_amdgcn_s_setprio(1); _Pragma("unroll") for (int m = 0; m < 4; ++m) _Pragma("unroll") for (int n = 0; n < 2; ++n) _Pragma("unroll") for (int k = 0; k < 2; ++k) { \
        if constexpr (Epi::SWAP) acc[ai][bj][m][n] = __builtin_amdgcn_mfma_f32_16x16x32_bf16(At[m][k], Bt[n][k], acc[ai][bj][m][n], 0, 0, 0); \
        else acc[ai][bj][m][n] = __builtin_amdgcn_mfma_f32_16x16x32_bf16(Bt[n][k], At[m][k], acc[ai][bj][m][n], 0, 0, 0); } __builtin_amdgcn_s_setprio(0); } while (0)
#define PG8_WAIT_V(n) asm volatile("s_waitcnt vmcnt(" #n ")" ::: "memory")
#define PG8_WAIT_L(n) asm volatile("s_waitcnt lgkmcnt(" #n ")" ::: "memory")
#define PG8_BAR __builtin_amdgcn_s_barrier()
#define PG8_SCHED __builtin_amdgcn_sched_barrier(0)
    Unit cur, nxt; int ui = 0;
    if (!S.next(0, cur)) return;
    f32x4 acc[2][2][4][2];
#pragma unroll
    for (int a = 0; a < 2; ++a)
#pragma unroll
        for (int b = 0; b < 2; ++b)
#pragma unroll
            for (int m = 0; m < 4; ++m)
#pragma unroll
                for (int n = 0; n < 2; ++n) acc[a][b][m][n] = (f32x4){0.f, 0.f, 0.f, 0.f};
    bf16x8 At[4][2], B0[2][2], B1[2][2];
    const char* cA = (const char*)g.A + (size_t)cur.pm * tstep; const char* cB = (const char*)g.Bt + (size_t)cur.pn * tstep;
    S.a_ready(cur);
    if constexpr (SP2) {
        PG8_STAGE(PG8_SB(0, 0), cB, voffB); PG8_STAGE(PG8_SB(0, 1), cB + hstep, voffB); PG8_STAGE(PG8_SA(0, 0), cA, voffA); PG8_STAGE(PG8_SA(0, 1), cA + hstep, voffA);
        if (wr == 1) PG8_BAR;
        PG8_WAIT_V(2); PG8_BAR;
        PG8_STAGE(PG8_SB(1, 0), cB + kstep, voffB); PG8_STAGE(PG8_SA(1, 0), cA + kstep, voffA); PG8_STAGE(PG8_SB(1, 1), cB + hstep + kstep, voffB);
        PG8_WAIT_V(6); PG8_BAR;
    } else {
        PG8_STAGE(PG8_SB(0, 0), cB, voffB); PG8_STAGE(PG8_SA(0, 0), cA, voffA); PG8_STAGE(PG8_SB(0, 1), cB + hstep, voffB); PG8_STAGE(PG8_SA(0, 1), cA + hstep, voffA);
        if (wr == 1) PG8_BAR;
        PG8_WAIT_V(4); PG8_BAR;
        PG8_STAGE(PG8_SB(1, 0), cB + kstep, voffB); PG8_STAGE(PG8_SA(1, 0), cA + kstep, voffA); PG8_STAGE(PG8_SB(1, 1), cB + hstep + kstep, voffB);
        PG8_WAIT_V(6); PG8_BAR;
    }
    for (;;) {
        const bool has_next = S.next(ui + 1, nxt);
        const char* nA = has_next ? (const char*)g.A + (size_t)nxt.pm * tstep : cA; const char* nB = has_next ? (const char*)g.Bt + (size_t)nxt.pn * tstep : cB;
        for (int t = 0; t < nt; t += 2) {
            const bool last = (t == nt - 2);
            const char* a1 = cA + (size_t)(t + 1) * kstep;
            const char* a2 = last ? nA : cA + (size_t)(t + 2) * kstep; const char* b2 = last ? nB : cB + (size_t)(t + 2) * kstep;
            const char* a3 = a2 + kstep; const char* b3 = b2 + kstep;
            if (last && has_next) S.a_ready(nxt);
            if constexpr (SP2) {
            PG8_LDB(B0, 0, 0); PG8_LDB(B1, 0, 1); PG8_SCHED; PG8_LDA(At, 0, 0); PG8_STAGE(PG8_SA(1, 1), a1 + hstep, voffA);
            PG8_WAIT_V(8); PG8_WAIT_L(0); PG8_BAR; PG8_MMA(0, 0, At, B0); PG8_MMA(0, 1, At, B1); PG8_BAR; PG8_SCHED;
            PG8_LDA(At, 0, 1); PG8_STAGE(PG8_SB(0, 0), b2, voffB); PG8_STAGE(PG8_SB(0, 1), b2 + hstep, voffB); PG8_STAGE(PG8_SA(0, 0), a2, voffA);
            PG8_WAIT_V(8); PG8_WAIT_L(0); PG8_BAR; PG8_MMA(1, 0, At, B0); PG8_MMA(1, 1, At, B1); PG8_BAR; PG8_SCHED;
            PG8_LDB(B0, 1, 0); PG8_LDB(B1, 1, 1); PG8_SCHED; PG8_LDA(At, 1, 0); PG8_STAGE(PG8_SA(0, 1), a2 + hstep, voffA);
            PG8_WAIT_V(8); PG8_WAIT_L(0); PG8_BAR; PG8_MMA(0, 0, At, B0); PG8_MMA(0, 1, At, B1); PG8_BAR; PG8_SCHED;
            PG8_LDA(At, 1, 1); PG8_STAGE(PG8_SB(1, 0), b3, voffB); PG8_STAGE(PG8_SB(1, 1), b3 + hstep, voffB); PG8_STAGE(PG8_SA(1, 0), a3, voffA);
            PG8_WAIT_V(8); PG8_WAIT_L(0); PG8_BAR; PG8_MMA(1, 0, At, B0); PG8_MMA(1, 1, At, B1); PG8_BAR; PG8_SCHED;
            } else {
            PG8_LDB(B0, 0, 0); PG8_SCHED; PG8_LDA(At, 0, 0); PG8_STAGE(PG8_SA(1, 1), a1 + hstep, voffA);
            PG8_WAIT_L(8); PG8_BAR; PG8_WAIT_L(0); PG8_MMA(0, 0, At, B0); PG8_BAR; PG8_SCHED;
            PG8_LDB(B1, 0, 1); PG8_STAGE(PG8_SB(0, 0), b2, voffB);
            PG8_BAR; PG8_WAIT_L(0); PG8_MMA(0, 1, At, B1); PG8_BAR;
            PG8_LDA(At, 0, 1); PG8_STAGE(PG8_SA(0, 0), a2, voffA);
            PG8_BAR; PG8_WAIT_L(0); PG8_MMA(1, 0, At, B0); PG8_BAR; PG8_SCHED;
            PG8_STAGE(PG8_SB(0, 1), b2 + hstep, voffB);
            PG8_WAIT_V(6); PG8_BAR; PG8_MMA(1, 1, At, B1); PG8_BAR;
            PG8_LDB(B0, 1, 0); PG8_SCHED; PG8_LDA(At, 1, 0); PG8_STAGE(PG8_SA(0, 1), a2 + hstep, voffA);
            PG8_WAIT_L(8); PG8_BAR; PG8_WAIT_L(0); PG8_MMA(0, 0, At, B0); PG8_BAR; PG8_SCHED;
            PG8_LDB(B1, 1, 1); PG8_STAGE(PG8_SB(1, 0), b3, voffB);
            PG8_BAR; PG8_WAIT_L(0); PG8_MMA(0, 1, At, B1); PG8_BAR;
            PG8_LDA(At, 1, 1); PG8_STAGE(PG8_SA(1, 0), a3, voffA);
            PG8_BAR; PG8_WAIT_L(0); PG8_MMA(1, 0, At, B0); PG8_BAR; PG8_SCHED;
            PG8_STAGE(PG8_SB(1, 1), b3 + hstep, voffB);
            PG8_WAIT_V(6); PG8_BAR; PG8_MMA(1, 1, At, B1); PG8_BAR;
            }
        }
        if constexpr (ALIGN_EPI) { if (wr == 0) PG8_BAR; }
        E(acc, cur, wr, wc, fr, fq); S.done(cur);
        if (!has_next) break;
#pragma unroll
        for (int a = 0; a < 2; ++a)
#pragma unroll
            for (int b = 0; b < 2; ++b)
#pragma unroll
                for (int m = 0; m < 4; ++m)
#pragma unroll
                    for (int n = 0; n < 2; ++n) acc[a][b][m][n] = (f32x4){0.f, 0.f, 0.f, 0.f};
        cur = nxt; cA = nA; cB = nB; ++ui;
        if constexpr (ALIGN_EPI) { if (wr == 1) PG8_BAR; }
    }
    PG8_WAIT_V(0);
    if constexpr (!ALIGN_EPI) { if (wr == 0) PG8_BAR; }
    PG8_BAR;
#undef PG8_SA
#undef PG8_SB
#undef PG8_STAGE
#undef PG8_LDA
#undef PG8_LDB
#undef PG8_MMA
#undef PG8_WAIT_V
#undef PG8_WAIT_L
#undef PG8_BAR
#undef PG8_SCHED
}

typedef const f32x4 (&AccRef)[2][2][4][2];
__device__ __forceinline__ u32x4 pack8(f32x4 v0, f32x4 v1) { u32x4 w; w.x = pk2(v0[0], v0[1]); w.y = pk2(v0[2], v0[3]); w.z = pk2(v1[0], v1[1]); w.w = pk2(v1[2], v1[3]); return w; }
__device__ __forceinline__ void unpack8(u32x4 w, f32x4& v0, f32x4& v1) { v0 = (f32x4){bflo(w.x), bfhi(w.x), bflo(w.y), bfhi(w.y)}; v1 = (f32x4){bflo(w.z), bfhi(w.z), bflo(w.w), bfhi(w.w)}; }

struct EpiBf16 {
    static constexpr bool PERM = true, SWAP = false;
    bf16_t* O; int ldc;
    __device__ __forceinline__ void operator()(AccRef acc, const Unit& u, int wr, int wc, int fr, int fq) const {
        const int row0 = u.pm * BM + wr * 64 + fr, col0 = u.pn * BM + wc * 32 + 8 * fq;
#pragma unroll
        for (int ai = 0; ai < 2; ++ai)
#pragma unroll
            for (int m = 0; m < 4; ++m) { bf16_t* rowp = O + (size_t)(row0 + ai * HALF + m * 16) * ldc + col0;
#pragma unroll
                for (int bj = 0; bj < 2; ++bj) *(u32x4*)(rowp + bj * HALF) = pack8(acc[ai][bj][m][0], acc[ai][bj][m][1]); }
    }
};
struct EpiProj {
    static constexpr bool PERM = true, SWAP = false;
    bf16_t* O; const float* rope; bf16_t* KB;
    __device__ __forceinline__ void operator()(AccRef acc, const Unit& u, int wr, int wc, int fr, int fq) const {
        const int row0 = u.pm * BM + wr * 64 + fr, col0 = u.pn * BM + wc * 32 + 8 * fq;
        const int mode = (u.pn >= 27 && u.pn < 43) ? (u.pn < 35 ? 1 : 2) : 0;
        const float sc = (mode == 1) ? QSCALE : 1.0f;
#pragma unroll
        for (int ai = 0; ai < 2; ++ai)
#pragma unroll
            for (int m = 0; m < 4; ++m) { const int row = row0 + ai * HALF + m * 16; bf16_t* rowp = O + (size_t)row * PLD + col0;
#pragma unroll
                for (int bj = 0; bj < 2; ++bj) { f32x4 v0 = acc[ai][bj][m][0], v1 = acc[ai][bj][m][1];
                    if (mode) { const int i0 = ((col0 + bj * HALF) & 127) >> 1; const f32x4* rp = (const f32x4*)(rope + ((size_t)row * 64 + i0) * 2); const f32x4 c0 = rp[0], c1 = rp[1];
                        f32x4 o0, o1;
                        o0[0] = v0[0] * c0[0] - v0[1] * c0[1]; o0[1] = v0[1] * c0[0] + v0[0] * c0[1]; o0[2] = v0[2] * c0[2] - v0[3] * c0[3]; o0[3] = v0[3] * c0[2] + v0[2] * c0[3];
                        o1[0] = v1[0] * c1[0] - v1[1] * c1[1]; o1[1] = v1[1] * c1[0] + v1[0] * c1[1]; o1[2] = v1[2] * c1[2] - v1[3] * c1[3]; o1[3] = v1[3] * c1[2] + v1[2] * c1[3];
                        v0 = o0 * sc; v1 = o1 * sc; }
                    if (mode == 2) *(u32x4*)(KB + ((size_t)((u.pn - 35) * 2 + bj) * T + row) * MD + wc * 32 + 8 * fq) = pack8(v0, v1);
                    else *(u32x4*)(rowp + bj * HALF) = pack8(v0, v1); } }
    }
};
struct EpiVT {
    static constexpr bool PERM = false, SWAP = true;
    bf16_t* VT;
    __device__ __forceinline__ void operator()(AccRef acc, const Unit& u, int wr, int wc, int fr, int fq) const {
        const int tok0 = u.pm * BM + wr * 64 + 4 * fq, col0 = u.pn * BM + wc * 32 + fr;
#pragma unroll
        for (int ai = 0; ai < 2; ++ai)
#pragma unroll
            for (int m = 0; m < 4; ++m)
#pragma unroll
                for (int bj = 0; bj < 2; ++bj)
#pragma unroll
                    for (int n = 0; n < 2; ++n) { const f32x4 v = acc[ai][bj][m][n]; u32x2 w; w.x = pk2(v[0], v[1]); w.y = pk2(v[2], v[3]);
                        const int d = col0 + bj * HALF + n * 16, tl = (u.pm * BM + wr * 64 + ai * HALF) >> 6;
                        *(u32x2*)(VT + ((size_t)((d >> 7) * (T / 64) + tl) * MD + (d & 127)) * 64 + m * 16 + 4 * (((fq & 1) << 1) | (fq >> 1))) = w; }
    }
};
struct EpiDec {
    static constexpr bool PERM = true, SWAP = false;
    float* O; const float* w0;
    __device__ __forceinline__ void operator()(AccRef acc, const Unit& u, int wr, int wc, int fr, int fq) const {
        const int row0 = u.pm * BM + wr * 64 + fr, col0 = u.pn * BM + wc * 32 + 8 * fq;
#pragma unroll
        for (int bj = 0; bj < 2; ++bj) { const f32x4 b0 = *(const f32x4*)(w0 + col0 + bj * HALF), b1 = *(const f32x4*)(w0 + col0 + bj * HALF + 4);
#pragma unroll
            for (int ai = 0; ai < 2; ++ai)
#pragma unroll
                for (int m = 0; m < 4; ++m) { float* rowp = O + (size_t)(row0 + ai * HALF + m * 16) * RW + col0 + bj * HALF;
#pragma unroll
                    for (int n = 0; n < 2; ++n) { const f32x4 x = acc[ai][bj][m][n] + (n ? b1 : b0); f32x4 o;
#pragma unroll
                        for (int e = 0; e < 4; ++e) { const float z = -x[e]; const float sp = fmaxf(z, 0.f) + __logf(1.0f + __expf(-fabsf(z))); o[e] = __expf(-__expf(-sp - 0.5f)); }
                        *(f32x4*)(rowp + 4 * n) = o; }
                    asm volatile("" ::: "memory"); } }
    }
};
struct EpiA {
    static constexpr bool PERM = true, SWAP = false;
    bf16_t* KP; bf16_t* BB; const bf16_t* KKN; const float* a0; const float* k_a;
    __device__ __forceinline__ void operator()(AccRef acc, const Unit& u, int wr, int wc, int fr, int fq) const {
        const int row0 = u.pm * BM + wr * 64 + fr, col0 = u.pn * BM + wc * 32 + 8 * fq;
#pragma unroll
        for (int bj = 0; bj < 2; ++bj) { const int cb = col0 + bj * HALF;
            const f32x4 b0 = *(const f32x4*)(a0 + cb), b1 = *(const f32x4*)(a0 + cb + 4), ka0 = *(const f32x4*)(k_a + cb), ka1 = *(const f32x4*)(k_a + cb + 4);
#pragma unroll
            for (int ai = 0; ai < 2; ++ai)
#pragma unroll
                for (int m = 0; m < 4; ++m) { const size_t off = (size_t)(row0 + ai * HALF + m * 16) * RW + cb;
                    f32x4 zk0, zk1, kn0, kn1; unpack8(*(const u32x4*)(KP + off), zk0, zk1); unpack8(*(const u32x4*)(KKN + off), kn0, kn1);
                    f32x4 a0v, a1v;
#pragma unroll
                    for (int e = 0; e < 4; ++e) { a0v[e] = fsigmoid(acc[ai][bj][m][0][e] + b0[e]); a1v[e] = fsigmoid(acc[ai][bj][m][1][e] + b1[e]); }
                    const f32x4 kp0 = zk0 * (1.0f + (a0v - 1.0f) * ka0), kp1 = zk1 * (1.0f + (a1v - 1.0f) * ka1);
                    *(u32x4*)(KP + off) = pack8(kp0, kp1); *(u32x4*)(BB + off) = pack8(-(kn0 * a0v), -(kn1 * a1v));
                    asm volatile("" ::: "memory"); } }
    }
};
template <bool ADD> struct EpiMix {
    static constexpr bool PERM = true, SWAP = false;
    bf16_t* O; const bf16_t* proj; int gcol0;
    __device__ __forceinline__ void operator()(AccRef acc, const Unit& u, int wr, int wc, int fr, int fq) const {
        const int row0 = u.pm * BM + wr * 64 + fr, col0 = u.pn * BM + wc * 32 + 8 * fq;
#pragma unroll
        for (int ai = 0; ai < 2; ++ai)
#pragma unroll
            for (int m = 0; m < 4; ++m) { const int row = row0 + ai * HALF + m * 16;
#pragma unroll
                for (int bj = 0; bj < 2; ++bj) { f32x4 g0, g1; unpack8(*(const u32x4*)(proj + (size_t)row * PLD + gcol0 + col0 + bj * HALF), g0, g1);
                    f32x4 o0, o1;
#pragma unroll
                    for (int e = 0; e < 4; ++e) { o0[e] = fsigmoid(g0[e]) * acc[ai][bj][m][0][e]; o1[e] = fsigmoid(g1[e]) * acc[ai][bj][m][1][e]; }
                    bf16_t* op = O + (size_t)row * D + col0 + bj * HALF;
                    if (ADD) { f32x4 p0, p1; unpack8(*(const u32x4*)op, p0, p1); o0 += p0; o1 += p1; }
                    *(u32x4*)op = pack8(o0, o1); } }
    }
};
struct EpiRes {
    static constexpr bool PERM = true, SWAP = false;
    bf16_t* O; const float* x; float* rsq;
    __device__ __forceinline__ void operator()(AccRef acc, const Unit& u, int wr, int wc, int fr, int fq) const {
        const int row0 = u.pm * BM + wr * 64 + fr, col0 = u.pn * BM + wc * 32 + 8 * fq;
#pragma unroll
        for (int ai = 0; ai < 2; ++ai)
#pragma unroll
            for (int m = 0; m < 4; ++m) { const int row = row0 + ai * HALF + m * 16; const size_t off = (size_t)row * D + col0; float ss = 0.f;
#pragma unroll
                for (int bj = 0; bj < 2; ++bj) { const f32x4 a = *(const f32x4*)(x + off + bj * HALF) + acc[ai][bj][m][0], b = *(const f32x4*)(x + off + bj * HALF + 4) + acc[ai][bj][m][1];
                    ss += ((a[0] * a[0] + a[1] * a[1]) + (a[2] * a[2] + a[3] * a[3])) + ((b[0] * b[0] + b[1] * b[1]) + (b[2] * b[2] + b[3] * b[3]));
                    *(u32x4*)(O + off + bj * HALF) = pack8(a, b); }
                ss += __shfl_xor(ss, 16); ss += __shfl_xor(ss, 32);
                if (fq == 0) rsq[(size_t)row * 64 + u.pn * 4 + wc] = ss; }
    }
};
struct EpiBf16Rs {
    static constexpr bool PERM = true, SWAP = false;
    bf16_t* O; int ldc; const float* rs;
    __device__ __forceinline__ void operator()(AccRef acc, const Unit& u, int wr, int wc, int fr, int fq) const {
        const int row0 = u.pm * BM + wr * 64 + fr, col0 = u.pn * BM + wc * 32 + 8 * fq;
#pragma unroll
        for (int ai = 0; ai < 2; ++ai)
#pragma unroll
            for (int m = 0; m < 4; ++m) { const int row = row0 + ai * HALF + m * 16; const float sc = rs[row]; bf16_t* rowp = O + (size_t)row * ldc + col0;
#pragma unroll
                for (int bj = 0; bj < 2; ++bj) *(u32x4*)(rowp + bj * HALF) = pack8(acc[ai][bj][m][0] * sc, acc[ai][bj][m][1] * sc); }
    }
};
}

#define XB_TMO      128
#define XB_XCNT(j)  (256  + 64 * (j))
#define XB_XSUB(j)  (1280 + 64 * (j))
#define XB_XGEN(j)  (2304 + 64 * (j))
#define XB_TOP      3328
#define XB_TOPGEN   3392
#define XCD_BAR_WORDS 3456
#define XB_SPIN_CAP (1u << 18)
__device__ __forceinline__ unsigned xb_ld(unsigned* p)              { return __hip_atomic_load(p, __ATOMIC_RELAXED, __HIP_MEMORY_SCOPE_AGENT); }
__device__ __forceinline__ unsigned xb_add(unsigned* p, unsigned v) { return __hip_atomic_fetch_add(p, v, __ATOMIC_RELAXED, __HIP_MEMORY_SCOPE_AGENT); }
__device__ __forceinline__ unsigned xb_xcc_id() { return (unsigned)__builtin_amdgcn_s_getreg((3 << 11) | 20) & 0xFu; }
#define XB_SPIN(cond, bar) do { unsigned _sp = 0; while (cond) { __builtin_amdgcn_s_sleep(1); \
    if ((++_sp & 255u) == 0u) { if (xb_ld(&(bar)[XB_TMO])) break; if (_sp > XB_SPIN_CAP) { atomicAdd(&(bar)[XB_TMO], 1u); break; } } } } while (0)
struct XcdBarrier { unsigned* bar; unsigned x; volatile LAS unsigned* st; };
__device__ __forceinline__ XcdBarrier xcd_barrier_post(unsigned* bar, volatile LAS unsigned* st) {
    XcdBarrier b; b.bar = bar; b.x = xb_xcc_id(); b.st = st;
    if (threadIdx.x == 0) (void)xb_add(&bar[XB_XCNT(b.x)], 1u);
    return b;
}
__device__ __forceinline__ void xcd_barrier_complete(unsigned* bar, unsigned x, unsigned& nloc, unsigned& nx) {
    const unsigned G = gridDim.x * gridDim.y * gridDim.z;
    unsigned sum, cnt, mine, sp = 0u;
    for (;;) {
        sum = 0u; cnt = 0u; mine = 0u;
#pragma unroll
        for (unsigned j = 0; j < 16; ++j) { const unsigned c = xb_ld(&bar[XB_XCNT(j)]); sum += c; cnt += (c > 0u) ? 1u : 0u; mine = (j == x) ? c : mine; }
        if (sum == G) break;
        __builtin_amdgcn_s_sleep(1);
        if ((++sp & 255u) == 0u) { if (xb_ld(&bar[XB_TMO])) break; if (sp > XB_SPIN_CAP) { atomicAdd(&bar[XB_TMO], 1u); break; } }
    }
    nloc = mine > 0u ? mine : 1u; nx = cnt > 0u ? cnt : 1u;
}
__device__ __forceinline__ void xcd_barrier(const XcdBarrier& b) {
    asm volatile("s_waitcnt vmcnt(0)" ::: "memory");
    __syncthreads();
    if (threadIdx.x == 0) {
        unsigned* bar = b.bar;
        __builtin_amdgcn_s_waitcnt(0);
        unsigned nloc = b.st[0], nx = b.st[1];
        if (nloc == 0u) { xcd_barrier_complete(bar, b.x, nloc, nx); b.st[0] = nloc; b.st[1] = nx; }
        const unsigned old = xb_add(&bar[XB_XSUB(b.x)], 1u);
        const unsigned gen = old / nloc;
        if (old + 1u == (gen + 1u) * nloc) {
            __builtin_amdgcn_fence(__ATOMIC_RELEASE, "agent");
            asm volatile("s_waitcnt vmcnt(0)" ::: "memory");
            const unsigned og = xb_add(&bar[XB_TOP], 1u);
            const unsigned tg = og / nx;
            if (og + 1u == (tg + 1u) * nx) xb_add(&bar[XB_TOPGEN], 1u);
            else XB_SPIN(xb_ld(&bar[XB_TOPGEN]) == tg, bar);
            __builtin_amdgcn_fence(__ATOMIC_ACQUIRE, "agent");
            xb_add(&bar[XB_XGEN(b.x)], 1u);
            asm volatile("s_waitcnt vmcnt(0)" ::: "memory");
        } else {
            XB_SPIN(xb_ld(&bar[XB_XGEN(b.x)]) == gen, bar);
            __builtin_amdgcn_fence(__ATOMIC_ACQUIRE, "agent");
            asm volatile("s_waitcnt vmcnt(0)" ::: "memory");
        }
    }
    __syncthreads();
}

struct Args {
    const float *x, *norm1_g, *w_in, *mu, *w0, *w_up, *a0, *a_up, *g_up, *k_k, *k_a, *r_k, *lnx_g, *lnx_b, *w_ba, *w_bb, *w_out, *norm2_g, *peer_wq, *sub_keys, *peer_u, *peer_v, *final_g;
    float* out; unsigned char* ws; int ph_lo, ph_hi, li, pad;
};
#define CAS __attribute__((address_space(4)))
typedef const CAS Args* ArgsP;
__device__ __forceinline__ ArgsP get_args() { ArgsP p = (ArgsP)__builtin_amdgcn_kernarg_segment_ptr(); asm volatile("" : "+s"(p)); return p; }
struct Frame { LAS unsigned char* lds; int tid, lane, wave, vcu, G; };

__device__ __forceinline__ int win_dst(int s) {
    if (s < SHIFTW) return s;
    if (s < SHIFTW + 4096) { const int base = (s < SHIFTW + 2048) ? SHIFTW : SHIFTW + 2048; const int m = s - base, head = m >> 7, c = m & 127; const int j = (c < 64) ? 2 * c : 2 * (c - 64) + 1;
        return ((s < SHIFTW + 2048) ? PC_MQ : PC_MK) + head * 128 + j; }
    if (s < SHIFTW + 6144) return PC_MV + (s - (SHIFTW + 4096));
    if (s < SHIFTW + 6144 + 4096) return PC_GA + (s - (SHIFTW + 6144));
    return PC_GB + (s - (SHIFTW + 6144 + 4096));
}
template <bool MAPWIN> __device__ __forceinline__ void p0_transpose_item(const float* W, int K, int N, bf16_t* WT, int Kd, LAS float* scr, int item, int lane, const float* kscale = nullptr) {
    const int nblk = N / 32, kb = item / nblk, nb = item % nblk, k0 = 64 * kb, n0 = 32 * nb;
    { const int krow = lane >> 3, c4 = lane & 7; f32x4 v[8];
#pragma unroll
      for (int i = 0; i < 8; ++i) { const int kk = 8 * i + krow; v[i] = (k0 + kk < K) ? *(const f32x4*)(W + (size_t)(k0 + kk) * N + n0 + 4 * c4) : (f32x4){0.f, 0.f, 0.f, 0.f}; }
      if (kscale) {
#pragma unroll
          for (int i = 0; i < 8; ++i) { const int kk = 8 * i + krow; if (k0 + kk < K) v[i] = v[i] * kscale[k0 + kk]; } }
#pragma unroll
      for (int i = 0; i < 8; ++i) { LAS float* d = scr + (8 * i + krow) * 33 + 4 * c4; d[0] = v[i].x; d[1] = v[i].y; d[2] = v[i].z; d[3] = v[i].w; } }
    LDS_WAIT(); asm volatile("" ::: "memory");
    const int c = lane & 7;
#pragma unroll
    for (int j = 0; j < 4; ++j) { const int n = (lane >> 3) + 8 * j; const LAS float* s = scr + (8 * c) * 33 + n;
        u32x4 o; o.x = pk2(s[0 * 33], s[1 * 33]); o.y = pk2(s[2 * 33], s[3 * 33]); o.z = pk2(s[4 * 33], s[5 * 33]); o.w = pk2(s[6 * 33], s[7 * 33]);
        const int row = MAPWIN ? win_dst(n0 + n) : (n0 + n);
        *(u32x4*)(WT + (size_t)row * Kd + k0 + 8 * c) = o; }
    LDS_WAIT(); asm volatile("" ::: "memory");
}
__device__ __forceinline__ void rms_rows_to_bf16(const float* x, const float* g, bf16_t* o, int m0, int mstride, int lane) {
    const f32x4* gr = (const f32x4*)g + lane;
    f32x4 v[16], w[16];
    if (m0 < T) {
#pragma unroll
        for (int j = 0; j < 16; ++j) v[j] = ((const f32x4*)(x + (size_t)m0 * D) + lane)[64 * j]; }
    for (int m = m0; m < T; m += mstride) { const bool hasn = m + mstride < T;
        if (hasn) {
#pragma unroll
            for (int j = 0; j < 16; ++j) w[j] = ((const f32x4*)(x + (size_t)(m + mstride) * D) + lane)[64 * j]; }
        float s = 0.f;
#pragma unroll
        for (int j = 0; j < 16; ++j) s += (v[j].x * v[j].x + v[j].y * v[j].y) + (v[j].z * v[j].z + v[j].w * v[j].w);
        const float rs = 1.0f / sqrtf(wave_sum(s) * (1.0f / D) + NORM_EPS);
        u32x2* o8 = (u32x2*)(o + (size_t)m * D) + lane;
#pragma unroll
        for (int j = 0; j < 16; ++j) { const f32x4 gg = gr[64 * j]; u32x2 q; q.x = pk2(v[j].x * rs * gg.x, v[j].y * rs * gg.y); q.y = pk2(v[j].z * rs * gg.z, v[j].w * rs * gg.w); o8[64 * j] = q; }
        if (hasn) {
#pragma unroll
            for (int j = 0; j < 16; ++j) v[j] = w[j]; }
    }
}
__device__ __forceinline__ void cvt_table(const float* src, bf16_t* dst, size_t n8, size_t gtid, size_t nthr) {
    for (size_t i = gtid; i < n8; i += nthr) { const f32x4 a = ((const f32x4*)src)[2 * i], b = ((const f32x4*)src)[2 * i + 1]; ((u32x4*)dst)[i] = pg8::pack8(a, b); }
}
__device__ __forceinline__ void pq_load(ArgsP A, int row, int lane, f32x4 (&v)[16]) {
    const f32x4* src = (const f32x4*)((row >= 16384 ? A->peer_v + (size_t)(row - 16384) * D : A->peer_u + (size_t)row * D)) + lane;
#pragma unroll
    for (int j = 0; j < 16; ++j) v[j] = __builtin_nontemporal_load(src + 64 * j);
}
__device__ __forceinline__ void pq_finish(unsigned char* ws, int row, int lane, const f32x4 (&v)[16]) {
    const bool isv = row >= 16384; const int rr = isv ? row - 16384 : row; float am = 0.f;
#pragma unroll
    for (int j = 0; j < 16; ++j) am = fmaxf(fmaxf(am, fmaxf(fabsf(v[j].x), fabsf(v[j].y))), fmaxf(fabsf(v[j].z), fabsf(v[j].w)));
#pragma unroll
    for (int o = 1; o < 64; o <<= 1) am = fmaxf(am, __shfl_xor(am, o));
    const float inv = am > 0.f ? 127.0f / am : 0.f; unsigned* dst = (unsigned*)(ws + (isv ? WS_PV : WS_PU)) + (size_t)rr * (D / 4) + lane;
    constexpr float MAGIC = 8388608.0f + 128.0f;
#pragma unroll
    for (int j = 0; j < 16; ++j) { const unsigned b0 = __builtin_bit_cast(unsigned, __builtin_fmaf(v[j].x, inv, MAGIC)), b1 = __builtin_bit_cast(unsigned, __builtin_fmaf(v[j].y, inv, MAGIC)),
                                                  b2 = __builtin_bit_cast(unsigned, __builtin_fmaf(v[j].z, inv, MAGIC)), b3 = __builtin_bit_cast(unsigned, __builtin_fmaf(v[j].w, inv, MAGIC));
        dst[64 * j] = __builtin_amdgcn_perm(__builtin_amdgcn_perm(b3, b2, 0x0c0c0400u), __builtin_amdgcn_perm(b1, b0, 0x0c0c0400u), 0x05040100u); }
    if (lane == 0) ((float*)(ws + (isv ? WS_PSV : WS_PSU)))[rr] = am * (1.0f / 127.0f);
}
__device__ __forceinline__ int pq_ra(int G) { constexpr int NT1 = (T / 256) * (PLD / 256); const int nx = NT1 % G, idle = nx ? G - nx : 0, n = idle * NWAVES * 7; return n < 2 * 16384 ? n : 2 * 16384; }
__device__ __forceinline__ void peer_quant(ArgsP A, Frame& F, int r0, int r1, int w0, int wstride) {
    f32x4 v[16], w[16];
    int row = r0 + w0;
    if (row < r1) pq_load(A, row, F.lane, v);
    for (; row < r1; row += wstride) { const bool hasn = row + wstride < r1;
        if (hasn) pq_load(A, row + wstride, F.lane, w);
        pq_finish(A->ws, row, F.lane, v);
        if (hasn) {
#pragma unroll
            for (int j = 0; j < 16; ++j) v[j] = w[j]; }
    }
}
__device__ __forceinline__ void late_weights(ArgsP A, Frame& F, int w0, int wstride) {
    unsigned char* ws = A->ws;
    LAS float* scr = (LAS float*)(F.lds + RING_OFF + F.wave * 16384);
    constexpr int I_BA = 32 * 128, I_OUT = 64 * 128, I_WQ = 64 * 64, I_SK = PH_ * 2 * PNK * PHALF / 512;
    constexpr int NITEMS = 2 * I_BA + I_OUT + I_WQ + I_SK;
    for (int it = w0; it < NITEMS; it += wstride) {
        int r = it;
        if (r < I_BA) { p0_transpose_item<false>(A->w_ba, RW, D, (bf16_t*)(ws + WS_WA), RW, scr, r, F.lane); continue; } r -= I_BA;
        if (r < I_BA) { p0_transpose_item<false>(A->w_bb, RW, D, (bf16_t*)(ws + WS_WB), RW, scr, r, F.lane); continue; } r -= I_BA;
        if (r < I_OUT) { p0_transpose_item<false>(A->w_out, D, D, (bf16_t*)(ws + WS_WOUT), D, scr, r, F.lane); continue; } r -= I_OUT;
        if (r < I_WQ) { p0_transpose_item<false>(A->peer_wq, D, 2048, (bf16_t*)(ws + WS_WQ), D, scr, r, F.lane, A->norm2_g); continue; } r -= I_WQ;
        { const size_t i = (size_t)r * 64 + F.lane; const f32x4 a = ((const f32x4*)A->sub_keys)[2 * i], b = ((const f32x4*)A->sub_keys)[2 * i + 1]; ((u32x4*)(ws + WS_SUBK))[i] = pg8::pack8(a, b); }
    }
}
__device__ __forceinline__ void ph0_prologue(ArgsP A, Frame& F) {
    unsigned char* ws = A->ws;
    LAS float* scr = (LAS float*)(F.lds + RING_OFF + F.wave * 16384);
    const int gw = F.vcu * NWAVES + F.wave, NGW = F.G * NWAVES;
    constexpr int I_IN = 64 * (INW / 32), I_UP = 2 * 64, I_G = 8 * 64;
    constexpr int NITEMS = I_IN + 2 * I_UP + I_G;
    for (int it = gw; it < NITEMS; it += NGW) {
        int r = it;
        if (r < I_IN) { p0_transpose_item<true>(A->w_in, D, INW, (bf16_t*)(ws + WS_WIN), D, scr, r, F.lane); continue; } r -= I_IN;
        if (r < I_UP) { p0_transpose_item<false>(A->w_up, LW, RW, (bf16_t*)(ws + WS_WUP), LW, scr, r, F.lane); continue; } r -= I_UP;
        if (r < I_UP) { p0_transpose_item<false>(A->a_up, LA, RW, (bf16_t*)(ws + WS_AUP), LA, scr, r, F.lane); continue; } r -= I_UP;
        p0_transpose_item<false>(A->g_up, LG, RW, (bf16_t*)(ws + WS_GUP), LGP, scr, r, F.lane);
    }
    const size_t gtid = (size_t)F.vcu * NTHR + F.tid, nthr = (size_t)F.G * NTHR;
    for (size_t i = gtid; i < (size_t)32 * D / 8; i += nthr) ((u32x4*)((bf16_t*)(ws + WS_WIN) + (size_t)SHIFTW * D))[i] = (u32x4){0u, 0u, 0u, 0u};
    for (size_t i = gtid; i < (size_t)T * 64; i += nthr) { const int pos = (int)(i >> 6), fi = (int)(i & 63); const float inv = powf(10000.0f, -(float)fi / 64.0f); const float ang = (float)pos * inv;
        ((f32x2*)(ws + WS_ROPE))[i] = (f32x2){cosf(ang), sinf(ang)}; }
    rms_rows_to_bf16(A->x, A->norm1_g, (bf16_t*)(ws + WS_XN), gw, NGW, F.lane);
}

__device__ __forceinline__ f32x4 ld4bf(const bf16_t* p) { const u32x2 w = *(const u32x2*)p; return (f32x4){bflo(w.x), bfhi(w.x), bflo(w.y), bfhi(w.y)}; }
__device__ __forceinline__ void st4bf(bf16_t* p, f32x4 v) { u32x2 w; w.x = pk2(v[0], v[1]); w.y = pk2(v[2], v[3]); *(u32x2*)p = w; }
__device__ __forceinline__ void ph2_prep(ArgsP A, Frame& F) {
    unsigned char* ws = A->ws; const bf16_t* PROJ = (const bf16_t*)(ws + WS_PROJ);
    LAS float* red = (LAS float*)(F.lds + RING_OFF);
    for (int it = F.vcu; it < NBLK * MH; it += F.G) { const int n = it / MH, h = it % MH, d = F.tid & 127, part = F.tid >> 7;
        const bf16_t* p = (const bf16_t*)(ws + WS_KB) + ((size_t)h * T + n * MBLK + part * 64) * MD + d; float s = 0.f;
#pragma unroll 8
        for (int i = 0; i < 64; ++i) s += bf1(p[(size_t)i * MD]);
        red[F.tid] = s; WG_BAR();
        if (F.tid < 128) { const float m = (red[F.tid] + red[F.tid + 128] + red[F.tid + 256] + red[F.tid + 384]) * (1.0f / MBLK); const unsigned hi = f2bf(m); const float lo = m - __builtin_bit_cast(float, hi << 16);
            ((bf16_t*)(ws + WS_KMEAN))[(size_t)(h * NBLK + n) * MD + F.tid] = (bf16_t)hi; ((bf16_t*)(ws + WS_KMEAN + 131072))[(size_t)(h * NBLK + n) * MD + F.tid] = (bf16_t)f2bf(lo); }
        WG_BAR(); }
    const int tid = F.tid; const int c = 4 * tid;
    const f32x4 mu_r = *(const f32x4*)(A->mu + PC_R + c), mu_k = *(const f32x4*)(A->mu + PC_K + c), mu_v = *(const f32x4*)(A->mu + PC_V + c), kkw = *(const f32x4*)(A->k_k + c);
    int lc = 0, lcc = 0; if (tid < 32) { lcc = 4 * tid; lc = PC_WL + lcc; } else if (tid < 64) { lcc = 4 * (tid - 32); lc = PC_AL + lcc; } else { lcc = 4 * (tid - 64); lc = PC_GL + lcc; }
    const bool lact = tid < 64 || (tid < 192 && lcc < LG);
    const f32x4 mu_l = lact ? *(const f32x4*)(A->mu + lc) : (f32x4){0.f, 0.f, 0.f, 0.f};
    u32x2 cur[8], nxt[8];
    auto tload = [&](int t, u32x2 (&rg)[8]) { const bf16_t* P = PROJ + (size_t)t * PLD; const bf16_t* PP = t > 0 ? P - PLD : P;
        rg[0] = *(const u32x2*)(P + PC_R + c); rg[1] = *(const u32x2*)(PP + PC_R + c); rg[2] = *(const u32x2*)(P + PC_K + c); rg[3] = *(const u32x2*)(PP + PC_K + c);
        rg[4] = *(const u32x2*)(P + PC_V + c); rg[5] = *(const u32x2*)(PP + PC_V + c);
        if (lact) { rg[6] = *(const u32x2*)(P + lc); rg[7] = *(const u32x2*)(PP + lc); } else { rg[6] = (u32x2){0u, 0u}; rg[7] = (u32x2){0u, 0u}; } };
    auto up4 = [](u32x2 w) { return (f32x4){bflo(w.x), bfhi(w.x), bflo(w.y), bfhi(w.y)}; };
    if (F.vcu < T) tload(F.vcu, cur);
    for (int t = F.vcu; t < T; t += F.G) { const bool hasn = t + F.G < T; if (hasn) tload(t + F.G, nxt);
        const float hp = t > 0 ? 1.0f : 0.0f;
        { const f32x4 p = up4(cur[0]), pp = up4(cur[1]) * hp; st4bf((bf16_t*)(ws + WS_ZR) + (size_t)t * RW + c, p + (pp - p) * mu_r); }
        { const f32x4 p = up4(cur[2]), pp = up4(cur[3]) * hp; const f32x4 zk = p + (pp - p) * mu_k;
          st4bf((bf16_t*)(ws + WS_KP) + (size_t)t * RW + c, zk); const f32x4 kk = zk * kkw;
          const float ss = sum16((kk[0] * kk[0] + kk[1] * kk[1]) + (kk[2] * kk[2] + kk[3] * kk[3])); const float inv = 1.0f / fmaxf(sqrtf(ss), 1e-12f);
          st4bf((bf16_t*)(ws + WS_KKN) + (size_t)t * RW + c, kk * inv); }
        { const f32x4 p = up4(cur[4]), pp = up4(cur[5]) * hp; st4bf((bf16_t*)(ws + WS_ZV) + (size_t)t * RW + c, p + (pp - p) * mu_v); }
        if (tid < 192) { const f32x4 zero = (f32x4){0.f, 0.f, 0.f, 0.f};
            f32x4 z = zero; if (lact) { const f32x4 p = up4(cur[6]), pp = up4(cur[7]) * hp; z = p + (pp - p) * mu_l; }
            if (tid < 32) { f32x4 o;
#pragma unroll
                for (int e = 0; e < 4; ++e) o[e] = 1.0f - 2.0f * __builtin_amdgcn_rcpf(__expf(2.0f * z[e]) + 1.0f);
                st4bf((bf16_t*)(ws + WS_AW) + (size_t)t * LW + lcc, o); }
            else if (tid < 64) st4bf((bf16_t*)(ws + WS_AA) + (size_t)t * LA + lcc, z);
            else { f32x4 o = zero; if (lcc < LG) {
#pragma unroll
                for (int e = 0; e < 4; ++e) o[e] = fsigmoid(z[e]); }
                st4bf((bf16_t*)(ws + WS_AG) + (size_t)t * LGP + lcc, o); }
        }
        if (hasn) {
#pragma unroll
            for (int i = 0; i < 8; ++i) cur[i] = nxt[i]; }
    }
}

__device__ __forceinline__ void ph3_gate(ArgsP A, Frame& F) {
    unsigned char* ws = A->ws; const bf16_t* PROJ = (const bf16_t*)(ws + WS_PROJ); const bf16_t* KMH = (const bf16_t*)(ws + WS_KMEAN); const bf16_t* KML = (const bf16_t*)(ws + WS_KMEAN + 131072); unsigned* MASK = (unsigned*)(ws + WS_MASK);
    const int gw = F.vcu * NWAVES + F.wave, NGW = F.G * NWAVES; const int r = F.lane & 31, hh = F.lane >> 5; const float NEG = -__builtin_inff();
    for (int it = gw; it < (T / 32) * MH; it += NGW) { const int tg = it >> 4, h = it & 15, t = tg * 32 + r, blk = tg >> 3;
        if (blk == 0) { if (hh == 0) MASK[t * MH + h] = 0u; continue; }
        f32x16 acc;
#pragma unroll
        for (int e = 0; e < 16; ++e) acc[e] = 0.f;
#pragma unroll
        for (int ks = 0; ks < 8; ++ks) { const bf16x8 q = *(const bf16x8*)(PROJ + (size_t)t * PLD + PC_MQ + h * MD + 16 * ks + 8 * hh); const size_t ko = (size_t)(h * NBLK + r) * MD + 16 * ks + 8 * hh;
            acc = __builtin_amdgcn_mfma_f32_32x32x16_bf16(*(const bf16x8*)(KMH + ko), q, acc, 0, 0, 0); acc = __builtin_amdgcn_mfma_f32_32x32x16_bf16(*(const bf16x8*)(KML + ko), q, acc, 0, 0, 0); }
        float t0 = NEG, t1 = NEG, t2 = NEG;
#pragma unroll
        for (int e = 0; e < 16; ++e) { const int n = (e & 3) + 8 * (e >> 2) + 4 * hh; float ae = acc[e]; asm volatile("" : "+v"(ae));
            float x = __builtin_bit_cast(float, (__builtin_bit_cast(unsigned, ae) & ~31u) | (unsigned)(31 - n)); x = (n < blk) ? x : NEG;
            t2 = __builtin_amdgcn_fmed3f(t1, t2, x); t1 = __builtin_amdgcn_fmed3f(t0, t1, x); t0 = fmaxf(t0, x); }
        const float o0 = __shfl_xor(t0, 32), o1 = __shfl_xor(t1, 32), o2 = __shfl_xor(t2, 32);
        t2 = __builtin_amdgcn_fmed3f(t1, t2, o0); t1 = __builtin_amdgcn_fmed3f(t0, t1, o0); t0 = fmaxf(t0, o0);
        t2 = __builtin_amdgcn_fmed3f(t1, t2, o1); t1 = __builtin_amdgcn_fmed3f(t0, t1, o1); t0 = fmaxf(t0, o1);
        t2 = __builtin_amdgcn_fmed3f(t1, t2, o2); t1 = __builtin_amdgcn_fmed3f(t0, t1, o2); t0 = fmaxf(t0, o2);
        unsigned sel = 1u << (31 - (__builtin_bit_cast(unsigned, t0) & 31u));
        if (blk > 1) sel |= 1u << (31 - (__builtin_bit_cast(unsigned, t1) & 31u));
        if (blk > 2) sel |= 1u << (31 - (__builtin_bit_cast(unsigned, t2) & 31u));
        if (hh == 0) MASK[t * MH + h] = sel;
        { gu32* cnt = (gu32*)(ws + WS_CTL) + CW_CNT + h * 32; unsigned short* lst = (unsigned short*)(ws + WS_LIST) + (size_t)h * 32 * 8192; const unsigned mysel = hh == 0 ? sel : 0u;
          unsigned mycnt = 0u;
          for (int j = 0; j < blk; ++j) { const unsigned long long bal = __ballot((mysel >> j) & 1u); const unsigned c = (unsigned)__builtin_popcountll(bal); mycnt = (F.lane == j) ? c : mycnt; }
          unsigned base = 0u; if (F.lane < blk && mycnt) base = __hip_atomic_fetch_add(cnt + F.lane, mycnt, __ATOMIC_RELAXED, __HIP_MEMORY_SCOPE_AGENT);
          for (int j = 0; j < blk; ++j) { const unsigned long long bal = __ballot((mysel >> j) & 1u); const unsigned bj = (unsigned)__builtin_amdgcn_readlane((int)base, j);
              if ((mysel >> j) & 1u) { const unsigned off = __builtin_amdgcn_mbcnt_hi((unsigned)(bal >> 32), __builtin_amdgcn_mbcnt_lo((unsigned)bal, 0u)); const unsigned slot = (unsigned)__builtin_popcount(mysel & ((1u << j) - 1u));
                  lst[(size_t)j * 8192 + bj + off] = (unsigned short)((unsigned)t | (slot << 13)); } } } }
}

constexpr int CK = 64, NCHK = T / CK, CP = 144, CPF = 272;
constexpr int L_AT = 0, L_BT = 9216, L_KT = 18432, L_RT = 27648, L_ATT = 36864, L_BTT = 46080, L_V = 55296, L_MKA = 64512, L_MBRT = 73728, L_MKRT = 82944, L_A2 = 92160, L_MBA = 101376, L_PC = 118784, L_WT = 119040, L_MBH = 121088, L_TD = 130304, L_PT = 134912, L_CEND = 139520;
constexpr int L_TT = L_AT, L_A1 = L_BT, L_Y2T = L_MKA, L_G2T = L_ATT;
static_assert(L_CEND <= RING_BYTES, "chunk prep LDS");
constexpr size_t CHW_ITEM = 32768;
__device__ __forceinline__ f32x16 nt_quad(const LAS unsigned char* X, const LAS unsigned char* Y, int qp, int qq, int r, int hh) {
    f32x16 acc;
#pragma unroll
    for (int e = 0; e < 16; ++e) acc[e] = 0.f;
#pragma unroll
    for (int ks = 0; ks < 4; ++ks) { const bf16x8 a = *(const LAS bf16x8*)(Y + (32 * qq + r) * CP + 32 * ks + 16 * hh), b = *(const LAS bf16x8*)(X + (32 * qp + r) * CP + 32 * ks + 16 * hh);
        acc = __builtin_amdgcn_mfma_f32_32x32x16_bf16(a, b, acc, 0, 0, 0); }
    return acc;
}
__device__ __forceinline__ int nt_q(int qq, int e, int hh) { return 32 * qq + (e & 3) + 8 * (e >> 2) + 4 * hh; }
__device__ __forceinline__ void nt_store_bf16(LAS unsigned char* O, int p, int qq, int hh, const f32x16& v) {
#pragma unroll
    for (int g = 0; g < 4; ++g) { u32x2 w; w.x = pk2(v[4 * g], v[4 * g + 1]); w.y = pk2(v[4 * g + 2], v[4 * g + 3]); *(LAS u32x2*)(O + p * CP + (32 * qq + 8 * g + 4 * hh) * 2) = w; }
}
__device__ __forceinline__ void ph4_chunkprep(ArgsP A, Frame& F) {
    unsigned char* ws = A->ws;
    const float* DEC = (const float*)(ws + WS_DEC); const bf16_t* KKN = (const bf16_t*)(ws + WS_KKN); const bf16_t* BBg = (const bf16_t*)(ws + WS_BB); const bf16_t* KPg = (const bf16_t*)(ws + WS_KP);
    const bf16_t* ZR = (const bf16_t*)(ws + WS_ZR); const bf16_t* ZV = (const bf16_t*)(ws + WS_ZV); float* Yg = (float*)(ws + WS_Y); unsigned char* CHW = ws + WS_WIN;
    LAS unsigned char* L = F.lds + RING_OFF; const int wave = F.wave, lane = F.lane, r = lane & 31, hh = lane >> 5;
    const int prod = wave >> 2, qp = (wave >> 1) & 1, qq = wave & 1, p = 32 * qp + r;
    float nwv[8]; unsigned nkk[4], nbb[4], nkp[4], nr[4], nv[4];
    auto request = [&](int h2, int c2) {
#pragma unroll
        for (int k = 0; k < 8; ++k) nwv[k] = DEC[(size_t)(c2 * CK + 8 * wave + k) * RW + (size_t)h2 * RN + lane];
#pragma unroll
        for (int i = 0; i < 4; ++i) { const size_t o = (size_t)(c2 * CK + 8 * wave + 2 * i + hh) * RW + (size_t)h2 * RN + 2 * r;
            nkk[i] = *(const unsigned*)(KKN + o); nbb[i] = *(const unsigned*)(BBg + o); nkp[i] = *(const unsigned*)(KPg + o); nr[i] = *(const unsigned*)(ZR + o); nv[i] = *(const unsigned*)(ZV + o); } };
    if (F.vcu < RH * NCHK) request(F.vcu / NCHK, F.vcu % NCHK);
    if (F.vcu == 0 && wave == 0) {
        const gu32* cnt = (const gu32*)(ws + WS_CTL) + CW_CNT; unsigned* ud = (unsigned*)(ws + WS_UDESC); unsigned np[8], tot = 0u;
#pragma unroll
        for (int k = 0; k < 8; ++k) { const unsigned c = __hip_atomic_load(cnt + 8 * lane + k, __ATOMIC_RELAXED, __HIP_MEMORY_SCOPE_AGENT); np[k] = (c + 255u) >> 8; tot += np[k]; }
        unsigned incl = tot;
#pragma unroll
        for (int o = 1; o < 64; o <<= 1) { const unsigned v = __shfl_up(incl, o); if (lane >= o) incl += v; }
        unsigned pos = incl - tot;
#pragma unroll
        for (int k = 0; k < 8; ++k) { const unsigned c = __hip_atomic_load(cnt + 8 * lane + k, __ATOMIC_RELAXED, __HIP_MEMORY_SCOPE_AGENT); for (unsigned ps = 0; ps < np[k]; ++ps) { ud[1 + 2 * pos] = (unsigned)(8 * lane + k) | (ps << 16); ud[2 + 2 * pos] = c; ++pos; } }
        if (lane == 63) ud[0] = incl; }
    for (int item = F.vcu; item < RH * NCHK; item += F.G) { const int h = item / NCHK, c = item % NCHK; const size_t hc = (size_t)h * RN; const int t0 = c * CK;
        { float wv[8], kkv[8], bbv[8], kpv[8], rv[8]; unsigned vv[8];
#pragma unroll
          for (int k = 0; k < 8; ++k) { const int src = ((k & 1) << 7) | ((lane >> 1) << 2); const bool odd = lane & 1;
              auto mine = [&](unsigned x) { const unsigned w = (unsigned)__builtin_amdgcn_ds_bpermute(src, (int)x); return odd ? (w & 0xffff0000u) : (w << 16); };
              wv[k] = nwv[k]; kkv[k] = __builtin_bit_cast(float, mine(nkk[k >> 1])); bbv[k] = __builtin_bit_cast(float, mine(nbb[k >> 1])); kpv[k] = __builtin_bit_cast(float, mine(nkp[k >> 1]));
              rv[k] = __builtin_bit_cast(float, mine(nr[k >> 1])); vv[k] = mine(nv[k >> 1]) >> 16; }
          { const int nit = item + F.G; if (nit < RH * NCHK) request(nit / NCHK, nit % NCHK); }
          float pl[8]; pl[0] = wv[0];
#pragma unroll
          for (int k = 1; k < 8; ++k) pl[k] = pl[k - 1] * wv[k];
          ((LAS float*)(L + L_WT))[wave * 64 + lane] = pl[7];
          WG_BAR();
          float pre = 1.f;
#pragma unroll
          for (int w2 = 0; w2 < 7; ++w2) { const float x = ((const LAS float*)(L + L_WT))[w2 * 64 + lane]; pre = (w2 < wave) ? pre * x : pre; }
          unsigned atp[4], btp[4], vtp[4];
#pragma unroll
          for (int k = 0; k < 8; ++k) { const float Pt = pre * pl[k], Pm = (k == 0) ? pre : pre * pl[k - 1], ip = __builtin_amdgcn_rcpf(Pt); const int t = 8 * wave + k;
              const unsigned a16 = f2bf(Pm * kkv[k]), b16 = f2bf(bbv[k] * ip), k16 = f2bf(kpv[k] * ip), r16 = f2bf(Pt * rv[k]);
              *(LAS bf16_t*)(L + L_AT + t * CP + 2 * lane) = (bf16_t)a16; *(LAS bf16_t*)(L + L_BT + t * CP + 2 * lane) = (bf16_t)b16; *(LAS bf16_t*)(L + L_KT + t * CP + 2 * lane) = (bf16_t)k16; *(LAS bf16_t*)(L + L_RT + t * CP + 2 * lane) = (bf16_t)r16;
              if (k & 1) { atp[k >> 1] |= a16 << 16; btp[k >> 1] |= b16 << 16; vtp[k >> 1] |= vv[k] << 16; } else { atp[k >> 1] = a16; btp[k >> 1] = b16; vtp[k >> 1] = vv[k]; }
              if (wave == 7 && k == 7) ((LAS float*)(L + L_PC))[lane] = Pt; }
          *(LAS u32x4*)(L + L_ATT + lane * CP + 16 * wave) = (u32x4){atp[0], atp[1], atp[2], atp[3]}; *(LAS u32x4*)(L + L_BTT + lane * CP + 16 * wave) = (u32x4){btp[0], btp[1], btp[2], btp[3]};
          *(LAS u32x4*)(L + L_V + lane * CP + 16 * wave) = (u32x4){vtp[0], vtp[1], vtp[2], vtp[3]}; }
        WG_BAR();
        { const f32x16 v = nt_quad(L + (prod ? L_KT : L_BT), L + L_AT, qp, qq, r, hh); f32x16 m;
#pragma unroll
          for (int e = 0; e < 16; ++e) m[e] = nt_q(qq, e, hh) > p ? v[e] : 0.f;
          if (prod == 0) {
#pragma unroll
              for (int g = 0; g < 4; ++g) *(LAS f32x4*)(L + L_MBA + p * CPF + (32 * qq + 8 * g + 4 * hh) * 4) = (f32x4){m[4 * g], m[4 * g + 1], m[4 * g + 2], m[4 * g + 3]}; }
          if (prod == 0) nt_store_bf16(L + L_MBH, p, qq, hh, m);
          else nt_store_bf16(L + L_MKA, p, qq, hh, m); }
        { const f32x16 v = nt_quad(L + L_RT, L + (prod ? L_KT : L_BT), qp, qq, r, hh); f32x16 m;
#pragma unroll
          for (int e = 0; e < 16; ++e) m[e] = nt_q(qq, e, hh) <= p ? v[e] : 0.f;
          nt_store_bf16(L + (prod ? L_MKRT : L_MBRT), p, qq, hh, m); }
        WG_BAR();
        { const int t = 8 * wave + (lane >> 3), g = lane & 7, base = 32 * (t >> 5); float T4[4] = {0.f, 0.f, 0.f, 0.f};
          const LAS unsigned char* mrow = L + L_MBA + (base + 4 * g) * 4;
          f32x4 m = *(const LAS f32x4*)(mrow + (base + 31) * CPF);
#pragma unroll 1
          for (int Sx = 7; Sx >= 0; --Sx) {
#pragma unroll
              for (int q = 3; q >= 0; --q) { const int sl = 4 * Sx + q, sr = base + sl, sn = sl > 0 ? sr - 1 : sr; const f32x4 n = *(const LAS f32x4*)(mrow + sn * CPF);
                  float part = (m[0] * T4[0] + m[1] * T4[1]) + (m[2] * T4[2] + m[3] * T4[3]);
                  part += dpp_f<0xB1>(part); part += dpp_f<0x4E>(part); part += dpp_f<0x141>(part);
                  const float val = (sr == t) ? 1.0f : part; T4[q] = (g == Sx) ? val : T4[q]; m = n; } }
          const unsigned w0 = pk2(T4[0], T4[1]), w1 = pk2(T4[2], T4[3]);
          *(LAS u32x2*)(L + L_TT + t * CP + (base + 4 * g) * 2) = (u32x2){w0, w1};
          if (base == 0) { *(LAS u32x2*)(L + L_TT + t * CP + (32 + 4 * g) * 2) = (u32x2){0u, 0u};
              *(LAS bf16_t*)(L + L_TD + (4 * g) * CP + 2 * t) = (bf16_t)(w0 & 0xffffu); *(LAS bf16_t*)(L + L_TD + (4 * g + 1) * CP + 2 * t) = (bf16_t)(w0 >> 16);
              *(LAS bf16_t*)(L + L_TD + (4 * g + 2) * CP + 2 * t) = (bf16_t)(w1 & 0xffffu); *(LAS bf16_t*)(L + L_TD + (4 * g + 3) * CP + 2 * t) = (bf16_t)(w1 >> 16); } }
        WG_BAR();
        if (wave == 0) {
            f32x16 acc;
#pragma unroll
            for (int e = 0; e < 16; ++e) acc[e] = 0.f;
#pragma unroll
            for (int ks = 0; ks < 2; ++ks) { const bf16x8 a = *(const LAS bf16x8*)(L + L_MBH + r * CP + 64 + 32 * ks + 16 * hh), b = *(const LAS bf16x8*)(L + L_TT + (32 + r) * CP + 64 + 32 * ks + 16 * hh);
                acc = __builtin_amdgcn_mfma_f32_32x32x16_bf16(a, b, acc, 0, 0, 0); }
            nt_store_bf16(L + L_PT, r, 0, hh, acc);
            LDS_WAIT(); asm volatile("" ::: "memory");
#pragma unroll
            for (int e = 0; e < 16; ++e) acc[e] = 0.f;
#pragma unroll
            for (int ks = 0; ks < 2; ++ks) { const bf16x8 a = *(const LAS bf16x8*)(L + L_TD + r * CP + 32 * ks + 16 * hh), b = *(const LAS bf16x8*)(L + L_PT + r * CP + 32 * ks + 16 * hh);
                acc = __builtin_amdgcn_mfma_f32_32x32x16_bf16(a, b, acc, 0, 0, 0); }
            nt_store_bf16(L + L_TT, 32 + r, 0, hh, acc);
        }
        WG_BAR();
        { const f32x16 v = nt_quad(L + (prod ? L_MKA : L_ATT), L + L_TT, qp, qq, r, hh);
          nt_store_bf16(L + (prod ? L_A2 : L_A1), p, qq, hh, v); }
        WG_BAR();
        unsigned char* cw = CHW + (size_t)item * CHW_ITEM;
        { const f32x16 v = nt_quad(L + L_MBRT, L + (prod ? L_A2 : L_A1), qp, qq, r, hh); f32x16 o;
          const LAS unsigned char* addm = L + (prod ? L_MKRT : L_RT);
#pragma unroll
          for (int g = 0; g < 4; ++g) { const u32x2 w = *(const LAS u32x2*)(addm + p * CP + (32 * qq + 8 * g + 4 * hh) * 2); o[4 * g] = v[4 * g] + bflo(w.x); o[4 * g + 1] = v[4 * g + 1] + bfhi(w.x); o[4 * g + 2] = v[4 * g + 2] + bflo(w.y); o[4 * g + 3] = v[4 * g + 3] + bfhi(w.y); }
          if (prod) nt_store_bf16(L + L_Y2T, p, qq, hh, o);
          else {
#pragma unroll
              for (int g = 0; g < 4; ++g) { u32x2 w; w.x = pk2(o[4 * g], o[4 * g + 1]); w.y = pk2(o[4 * g + 2], o[4 * g + 3]); *(u32x2*)(cw + (size_t)p * 128 + (32 * qq + 8 * g + 4 * hh) * 2) = w; } } }
        { const f32x16 v = nt_quad(L + L_BTT, L + (prod ? L_A2 : L_A1), qp, qq, r, hh); const float pc = ((const LAS float*)(L + L_PC))[p]; f32x16 o;
          if (prod) {
#pragma unroll
              for (int e = 0; e < 16; ++e) o[e] = (v[e] + bf1(*(const LAS bf16_t*)(L + L_KT + nt_q(qq, e, hh) * CP + 2 * p))) * pc;
              nt_store_bf16(L + L_G2T, p, qq, hh, o); }
          else {
#pragma unroll
              for (int e = 0; e < 16; ++e) o[e] = (v[e] + (nt_q(qq, e, hh) == p ? 1.0f : 0.0f)) * pc;
#pragma unroll
              for (int g = 0; g < 4; ++g) { u32x2 w; w.x = pk2(o[4 * g], o[4 * g + 1]); w.y = pk2(o[4 * g + 2], o[4 * g + 3]); *(u32x2*)(cw + 8192 + (size_t)p * 128 + (32 * qq + 8 * g + 4 * hh) * 2) = w; } } }
        WG_BAR();
        { const f32x16 v = prod ? nt_quad(L + L_V, L + L_G2T, qp, qq, r, hh) : nt_quad(L + L_Y2T, L + L_V, qp, qq, r, hh);
          float* dst = prod ? (float*)(cw + 16384) + (size_t)p * 64 : Yg + (size_t)(t0 + p) * RW + hc;
#pragma unroll
          for (int g = 0; g < 4; ++g) *(f32x4*)(dst + 32 * qq + 8 * g + 4 * hh) = (f32x4){v[4 * g], v[4 * g + 1], v[4 * g + 2], v[4 * g + 3]}; }
        WG_BAR();
    }
}
__device__ __forceinline__ void ph5_chain(ArgsP A, Frame& F, int h) {
    unsigned char* ws = A->ws; float* Yg = (float*)(ws + WS_Y); const unsigned char* CHW = ws + WS_WIN;
    LAS unsigned char* L = F.lds + RING_OFF; const int wave = F.wave, lane = F.lane, tid = F.tid, r = lane & 31, hh = lane >> 5;
    const int prod = wave >> 2, qp = (wave >> 1) & 1, qq = wave & 1, p = 32 * qp + r; const size_t hc = (size_t)h * RN;
    constexpr int L_S = 0, L_G = 2 * 9216, L_Y1 = 3 * 9216;
    for (int i = tid; i < 2 * 9216 / 4; i += NTHR) ((LAS unsigned*)(L + L_S))[i] = 0u;
    const int srow = tid >> 3, sc16 = tid & 7; u32x4 sg, sy;
    auto stage_ld = [&](int c) { const unsigned char* cw = CHW + (size_t)(h * NCHK + c) * CHW_ITEM; sy = *(const u32x4*)(cw + srow * 128 + sc16 * 16); sg = *(const u32x4*)(cw + 8192 + srow * 128 + sc16 * 16); };
    f32x4 nad[4];
    auto ad_ld = [&](int c) { const unsigned char* cw2 = CHW + (size_t)(h * NCHK + c) * CHW_ITEM; const float* addp = prod ? Yg + (size_t)(c * CK + p) * RW + hc : (const float*)(cw2 + 16384) + (size_t)p * 64;
#pragma unroll
        for (int g = 0; g < 4; ++g) nad[g] = *(const f32x4*)(addp + 32 * qq + 8 * g + 4 * hh); };
    stage_ld(0); ad_ld(0);
    int sb = 0;
    for (int c = 0; c < NCHK; ++c) {
        *(LAS u32x4*)(L + L_Y1 + srow * CP + sc16 * 16) = sy; *(LAS u32x4*)(L + L_G + srow * CP + sc16 * 16) = sg;
        const unsigned char* cw = CHW + (size_t)(h * NCHK + c) * CHW_ITEM;
        f32x4 ad[4];
#pragma unroll
        for (int g = 0; g < 4; ++g) ad[g] = nad[g];
        if (c + 1 < NCHK) { stage_ld(c + 1); ad_ld(c + 1); }
        WG_BAR();
        const f32x16 v = prod ? nt_quad(L + L_Y1, L + L_S + sb * 9216, qp, qq, r, hh) : nt_quad(L + L_S + sb * 9216, L + L_G, qp, qq, r, hh);
        f32x16 o;
#pragma unroll
        for (int g = 0; g < 4; ++g) { o[4 * g] = v[4 * g] + ad[g][0]; o[4 * g + 1] = v[4 * g + 1] + ad[g][1]; o[4 * g + 2] = v[4 * g + 2] + ad[g][2]; o[4 * g + 3] = v[4 * g + 3] + ad[g][3]; }
        if (prod) { float* yp = Yg + (size_t)(c * CK + p) * RW + hc;
#pragma unroll
            for (int g = 0; g < 4; ++g) *(f32x4*)(yp + 32 * qq + 8 * g + 4 * hh) = (f32x4){o[4 * g], o[4 * g + 1], o[4 * g + 2], o[4 * g + 3]}; }
        else nt_store_bf16(L + L_S + (sb ^ 1) * 9216, p, qq, hh, o);
        sb ^= 1;
        WG_BAR();
    }
}

__device__ __forceinline__ void ph5_ypost(ArgsP A, Frame& F) {
    unsigned char* ws = A->ws; const float* Y = (const float*)(ws + WS_Y); const bf16_t* ZR = (const bf16_t*)(ws + WS_ZR); const bf16_t* KP = (const bf16_t*)(ws + WS_KP); const bf16_t* ZV = (const bf16_t*)(ws + WS_ZV);
    const bf16_t* G = (const bf16_t*)(ws + WS_G); bf16_t* YA = (bf16_t*)(ws + WS_YA);
    const int gw = F.vcu * NWAVES + F.wave, NGW = F.G * NWAVES;
    const int c = F.wave * 256 + 4 * F.lane; const f32x4 rk = *(const f32x4*)(A->r_k + c), lg = *(const f32x4*)(A->lnx_g + c), lb = *(const f32x4*)(A->lnx_b + c);
    for (int tg = F.vcu; tg < T / 32; tg += F.G) for (int tq = 0; tq < 32; tq += 4) {
        f32x4 y[4]; u32x2 rr[4], kk[4], vv[4], gg[4];
#pragma unroll
        for (int u = 0; u < 4; ++u) { const size_t o = (size_t)(tg * 32 + tq + u) * RW + c; y[u] = *(const f32x4*)(Y + o); rr[u] = *(const u32x2*)(ZR + o); kk[u] = *(const u32x2*)(KP + o); vv[u] = *(const u32x2*)(ZV + o); gg[u] = *(const u32x2*)(G + o); }
#pragma unroll
        for (int u = 0; u < 4; ++u) { const size_t o = (size_t)(tg * 32 + tq + u) * RW + c;
            const float mean = sum16((y[u][0] + y[u][1]) + (y[u][2] + y[u][3])) * (1.0f / 64.0f); const f32x4 d = y[u] - mean;
            const float var = sum16((d[0] * d[0] + d[1] * d[1]) + (d[2] * d[2] + d[3] * d[3])) * (1.0f / 64.0f); const float rs = 1.0f / sqrtf(var + LNX_EPS);
            const f32x4 r = (f32x4){bflo(rr[u].x), bfhi(rr[u].x), bflo(rr[u].y), bfhi(rr[u].y)}, k = (f32x4){bflo(kk[u].x), bfhi(kk[u].x), bflo(kk[u].y), bfhi(kk[u].y)};
            const f32x4 v = (f32x4){bflo(vv[u].x), bfhi(vv[u].x), bflo(vv[u].y), bfhi(vv[u].y)}, g = (f32x4){bflo(gg[u].x), bfhi(gg[u].x), bflo(gg[u].y), bfhi(gg[u].y)};
            const f32x4 rkk = r * k * rk; const float bonus = sum16((rkk[0] + rkk[1]) + (rkk[2] + rkk[3]));
            st4bf(YA + o, (d * rs * lg + lb + bonus * v) * g); } }
}

constexpr int AT_KB = 64 * 256, AT_VB = 128 * 128, AT_BUF = AT_KB + AT_VB;
static_assert(3 * AT_BUF <= RING_BYTES, "attention LDS");
__device__ __forceinline__ void q8_load(u32x4 (&q)[8], const void* p) {
    asm volatile("global_load_dwordx4 %0, %8, off\n\tglobal_load_dwordx4 %1, %8, off offset:32\n\tglobal_load_dwordx4 %2, %8, off offset:64\n\tglobal_load_dwordx4 %3, %8, off offset:96\n\t"
                 "global_load_dwordx4 %4, %8, off offset:128\n\tglobal_load_dwordx4 %5, %8, off offset:160\n\tglobal_load_dwordx4 %6, %8, off offset:192\n\tglobal_load_dwordx4 %7, %8, off offset:224"
                 : "=&v"(q[0]), "=&v"(q[1]), "=&v"(q[2]), "=&v"(q[3]), "=&v"(q[4]), "=&v"(q[5]), "=&v"(q[6]), "=&v"(q[7]) : "v"(p) : "memory"); }
__device__ __forceinline__ void q8_settle(u32x4 (&q)[8]) {
#pragma unroll
    for (int i = 0; i < 8; ++i) asm volatile("" : "+v"(q[i])); }
__device__ __forceinline__ unsigned u16_load(const void* p) { unsigned v; asm volatile("global_load_ushort %0, %1, off" : "=&v"(v) : "v"(p) : "memory"); return v; }
__device__ __forceinline__ void ph5_attn(ArgsP A, Frame& F) {
    unsigned char* ws = A->ws; const bf16_t* PROJ = (const bf16_t*)(ws + WS_PROJ); const bf16_t* VT = (const bf16_t*)(ws + WS_VT); const bf16_t* KBp = (const bf16_t*)(ws + WS_KB);
    bf16_t* PO = (bf16_t*)(ws + WS_PARTO); float* PML = (float*)(ws + WS_PARTML); const unsigned short* LST = (const unsigned short*)(ws + WS_LIST); const unsigned* UD = (const unsigned*)(ws + WS_UDESC);
    LAS unsigned char* L = F.lds + RING_OFF; const int wave = F.wave, lane = F.lane, r = lane & 31, hh = lane >> 5;
    const float NEG = -__builtin_inff();
    const int NA = MH * NBLK, N = NA + (int)UD[0], w = F.vcu, nfree = F.G - RH; const bool chainwg = w < RH;
    auto unit_of = [&](int k) { return k * nfree + (w - RH); };
    int k = 0;
    if (chainwg) return;
    if (unit_of(k) >= N) return;
    int h, kblk, qtok, slot; bool typeA, valid, wvalid;
    { const int u = unit_of(k); typeA = u < NA;
      if (typeA) { h = u & 15; kblk = u >> 4; qtok = kblk * MBLK + wave * 32 + r; slot = 3; valid = true; wvalid = true; }
      else { const unsigned d = UD[1 + 2 * (u - NA)]; const int cnt = (int)UD[2 + 2 * (u - NA)]; const int Lx = (int)(d & 0xffffu), ps = (int)(d >> 16); h = Lx >> 5; kblk = Lx & 31;
          const int idx = ps * 256 + wave * 32 + r; valid = idx < cnt; wvalid = ps * 256 + wave * 32 < cnt; unsigned e = u16_load(LST + (size_t)Lx * 8192 + (valid ? idx : 0));
          asm volatile("s_waitcnt vmcnt(0)" ::: "memory"); asm volatile("" : "+v"(e)); qtok = (int)(e & 0x1fffu); slot = (int)(e >> 13); }
      h = __builtin_amdgcn_readfirstlane(h); kblk = __builtin_amdgcn_readfirstlane(kblk); }
    u32x4 qf[8], qfn[8];
    q8_load(qf, PROJ + (size_t)qtok * PLD + PC_MQ + h * MD + 8 * hh);
    const int krow_ = lane >> 4, kslot = lane & 15, vrow_ = lane >> 3, vslot = lane & 7;
    auto dma_tile = [&](int hd, int kb_, int n, int b3) { const int tb = kb_ * MBLK + n * 64; LAS unsigned char* B = L + b3 * AT_BUF;
#pragma unroll
        for (int i = 0; i < 2; ++i) { const int p = wave * 2 + i, row = 4 * p + krow_, c = kslot ^ (row & 15);
            __builtin_amdgcn_global_load_lds((const unsigned*)(KBp + ((size_t)hd * T + tb + row) * MD + 8 * c), (LAS unsigned*)(B + p * 1024), 16, 0, 0); }
#pragma unroll
        for (int i = 0; i < 2; ++i) { const int p = wave * 2 + i, row = 8 * p + vrow_, c = vslot ^ ((row >> 1) & 7);
            __builtin_amdgcn_global_load_lds((const unsigned*)(VT + ((size_t)(hd * (T / 64) + kb_ * 4 + n) * MD + row) * 64 + 8 * c), (LAS unsigned*)(B + AT_KB + p * 1024), 16, 0, 0); } };
    dma_tile(h, kblk, 0, 0); dma_tile(h, kblk, 1, 1);
    asm volatile("s_waitcnt vmcnt(4)" ::: "memory"); q8_settle(qf); WG_BAR();
    int b3 = 0;
    for (;;) {
        const int un = unit_of(k + 1); const bool has_next = un < N, nA = un < NA;
        int hN = 0, kblkN = 0, qtokN = 0, slotN = 3, LxN = 0, idxN = 0, cntN = 0; bool validN = true, wvalidN = true; unsigned udw = 0u, udc = 0u, entN = 0u;
        f32x16 o[4];
#pragma unroll
        for (int db = 0; db < 4; ++db)
#pragma unroll
            for (int e = 0; e < 16; ++e) o[db][e] = 0.f;
        float mrun = NEG, lrun = 0.f;
#pragma unroll
        for (int n = 0; n < 4; ++n) {
            if (has_next) {
                if (n == 0) { if (nA) { hN = un & 15; kblkN = un >> 4; } else { udw = UD[1 + 2 * (un - NA)]; udc = UD[2 + 2 * (un - NA)]; } }
                if (n == 1) { if (nA) { qtokN = kblkN * MBLK + wave * 32 + r; } else { LxN = (int)(udw & 0xffffu); const int ps = (int)(udw >> 16); cntN = (int)udc; hN = LxN >> 5; kblkN = LxN & 31;
                                  idxN = ps * 256 + wave * 32 + r; validN = idxN < cntN; wvalidN = ps * 256 + wave * 32 < cntN; entN = u16_load(LST + (size_t)LxN * 8192 + (validN ? idxN : 0)); }
                              hN = __builtin_amdgcn_readfirstlane(hN); kblkN = __builtin_amdgcn_readfirstlane(kblkN); }
                if (n == 2) { if (!nA) { qtokN = (int)(entN & 0x1fffu); slotN = (int)(entN >> 13); }
                              q8_load(qfn, PROJ + (size_t)qtokN * PLD + PC_MQ + hN * MD + 8 * hh); }
            }
            const int bn = b3 >= 1 ? b3 - 1 : 2; bool issued = false;
            if (n < 2) { dma_tile(h, kblk, n + 2, bn); issued = true; } else if (has_next) { dma_tile(hN, kblkN, n - 2, bn); issued = true; }
            const bool need = typeA ? (n <= (wave >> 1)) : wvalid;
            if (need) {
                const LAS unsigned char* KB = L + b3 * AT_BUF; const LAS unsigned char* VB = KB + AT_KB;
                const bool msk = typeA && 64 * n + 63 > wave * 32; const int qrel = wave * 32 + r;
                auto qk = [&](int kb) { f32x16 a;
#pragma unroll
                    for (int e = 0; e < 16; ++e) a[e] = 0.f;
#pragma unroll
                    for (int ks = 0; ks < 8; ++ks) { const bf16x8 kf = *(const LAS bf16x8*)(KB + (32 * kb + r) * 256 + (((2 * ks + hh) ^ (r & 15)) << 4)); a = __builtin_amdgcn_mfma_f32_32x32x16_bf16(kf, __builtin_bit_cast(bf16x8, qf[ks]), a, 0, 0, 0); }
                    return a; };
                auto causal = [&](f32x16& a, int kb) {
#pragma unroll
                    for (int e = 0; e < 16; ++e) { const int krel = 64 * n + 32 * kb + (e & 3) + 8 * (e >> 2) + 4 * hh; if (krel > qrel) a[e] = NEG; } };
                auto rescale = [&](float alpha) { if (__ballot(alpha != 1.0f) != 0ull) {
#pragma unroll
                        for (int db = 0; db < 4; ++db)
#pragma unroll
                            for (int e = 0; e < 16; ++e) o[db][e] *= alpha; } };
                auto rowmax = [&](const f32x16& a, float mold, float& mnew, float& alpha) {
                    float mx = fmaxf(a[0], a[1]);
#pragma unroll
                    for (int e = 2; e < 16; ++e) mx = fmaxf(mx, a[e]);
                    mx = fmaxf(mx, __shfl_xor(mx, 32)); mnew = fmaxf(mold, mx); alpha = __builtin_amdgcn_exp2f(mold - mnew); };
                f32x16 s0 = qk(0);
                if (msk) causal(s0, 0);
                float m0, al0, m1, al1, ps0 = 0.f, ps1 = 0.f; unsigned pk0[8], pk1[8];
                rowmax(s0, mrun, m0, al0);
                __builtin_amdgcn_sched_barrier(0);
                f32x16 s1;
#pragma unroll
                for (int e = 0; e < 16; ++e) s1[e] = 0.f;
                auto kfrag = [&](int ks) { return *(const LAS bf16x8*)(KB + (32 + r) * 256 + (((2 * ks + hh) ^ (r & 15)) << 4)); };
                bf16x8 kf = kfrag(0), kf1 = kfrag(1), kf2 = kf1;
#pragma unroll
                for (int ks = 0; ks < 8; ++ks) {
                    if (ks < 6) kf2 = kfrag(ks + 2);
                    s1 = __builtin_amdgcn_mfma_f32_32x32x16_bf16(kf, __builtin_bit_cast(bf16x8, qf[ks]), s1, 0, 0, 0); kf = kf1; kf1 = kf2;
                    __builtin_amdgcn_sched_barrier(0);
                    const float p0 = __builtin_amdgcn_exp2f(s0[2 * ks] - m0), p1 = __builtin_amdgcn_exp2f(s0[2 * ks + 1] - m0); ps0 += p0 + p1; pk0[ks] = pk2(p0, p1); asm volatile("" : "+v"(pk0[ks]), "+v"(ps0));
                    __builtin_amdgcn_sched_barrier(0); }
                rescale(al0);
                if (msk) causal(s1, 1);
                rowmax(s1, m0, m1, al1);
                __builtin_amdgcn_sched_barrier(0);
                auto vfrag = [&](int i) { return *(const LAS bf16x8*)(VB + (32 * (i & 3) + r) * 128 + (((2 * (i >> 2) + hh) ^ ((r >> 1) & 7)) << 4)); };
                bf16x8 vf = vfrag(0), vf1 = vfrag(1), vf2 = vf1;
#pragma unroll
                for (int i = 0; i < 8; ++i) { const int st = i >> 2, db = i & 3;
                    const bf16x8 pf = __builtin_bit_cast(bf16x8, (u32x4){pk0[4 * st], pk0[4 * st + 1], pk0[4 * st + 2], pk0[4 * st + 3]});
                    if (i < 6) vf2 = vfrag(i + 2);
                    o[db] = __builtin_amdgcn_mfma_f32_32x32x16_bf16(vf, pf, o[db], 0, 0, 0); vf = vf1; vf1 = vf2;
                    __builtin_amdgcn_sched_barrier(0);
                    const float p0 = __builtin_amdgcn_exp2f(s1[2 * i] - m1), p1 = __builtin_amdgcn_exp2f(s1[2 * i + 1] - m1); ps1 += p0 + p1; pk1[i] = pk2(p0, p1); asm volatile("" : "+v"(pk1[i]), "+v"(ps1));
                    __builtin_amdgcn_sched_barrier(0); }
                rescale(al1);
#pragma unroll
                for (int i = 0; i < 8; ++i) { const int st = i >> 2, db = i & 3;
                    const bf16x8 pf = __builtin_bit_cast(bf16x8, (u32x4){pk1[4 * st], pk1[4 * st + 1], pk1[4 * st + 2], pk1[4 * st + 3]});
                    const bf16x8 vf = *(const LAS bf16x8*)(VB + (32 * db + r) * 128 + (((4 + 2 * st + hh) ^ ((r >> 1) & 7)) << 4)); o[db] = __builtin_amdgcn_mfma_f32_32x32x16_bf16(vf, pf, o[db], 0, 0, 0); }
                lrun = (lrun * al0 + ps0) * al1 + ps1; mrun = m1;
            }
            if (issued) asm volatile("s_waitcnt vmcnt(4)" ::: "memory"); else asm volatile("s_waitcnt vmcnt(0)" ::: "memory");
            if (n == 1) asm volatile("" : "+v"(entN));
            if (n == 2) q8_settle(qfn);
            b3 = b3 == 2 ? 0 : b3 + 1;
            WG_BAR();
        }
        { const float ltot = lrun + __shfl_xor(lrun, 32);
          if (valid) { const float inv = 1.0f / ltot; const size_t pi = ((size_t)qtok * MH + h) * 4 + slot; bf16_t* op = PO + pi * MD;
#pragma unroll
            for (int db = 0; db < 4; ++db)
#pragma unroll
                for (int g = 0; g < 4; ++g) { u32x2 wv; wv.x = pk2(o[db][4 * g] * inv, o[db][4 * g + 1] * inv); wv.y = pk2(o[db][4 * g + 2] * inv, o[db][4 * g + 3] * inv); *(u32x2*)(op + 32 * db + 8 * g + 4 * hh) = wv; }
            if (hh == 0) *(f32x2*)(PML + pi * 2) = (f32x2){mrun, ltot}; } }
        if (!has_next) break;
        h = hN; kblk = kblkN; qtok = qtokN; slot = slotN; typeA = nA; valid = nA ? true : validN; wvalid = nA ? true : wvalidN; ++k;
#pragma unroll
        for (int ks = 0; ks < 8; ++ks) qf[ks] = qfn[ks];
    }
}
__device__ __forceinline__ void ph6_merge(ArgsP A, Frame& F) {
    unsigned char* ws = A->ws; const bf16_t* PO = (const bf16_t*)(ws + WS_PARTO); const float* PML = (const float*)(ws + WS_PARTML); bf16_t* YB = (bf16_t*)(ws + WS_YB);
    const int gw = F.vcu * NWAVES + F.wave, NGW = F.G * NWAVES, hl = F.lane >> 5, dg = F.lane & 31;
    for (int it0 = gw * 4; it0 < T * 8; it0 += NGW * 4) {
        u32x2 ov[4][4]; f32x2 ml[4][4];
#pragma unroll
        for (int k = 0; k < 4; ++k) { const int it = it0 + k, t = it >> 3, h = 2 * (it & 7) + hl; const size_t pi = ((size_t)t * MH + h) * 4;
#pragma unroll
            for (int sl = 0; sl < 4; ++sl) { ov[k][sl] = *(const u32x2*)(PO + (pi + sl) * MD + 4 * dg); ml[k][sl] = *(const f32x2*)(PML + (pi + sl) * 2); } }
#pragma unroll
        for (int k = 0; k < 4; ++k) { const int it = it0 + k, t = it >> 3, h = 2 * (it & 7) + hl, blk = t >> 8, nsel = blk < 3 ? blk : 3;
            float mmax = ml[k][3][0];
#pragma unroll
            for (int sl = 0; sl < 3; ++sl) if (sl < nsel) mmax = fmaxf(mmax, ml[k][sl][0]);
            f32x4 acc = (f32x4){0.f, 0.f, 0.f, 0.f}; float wsum = 0.f;
#pragma unroll
            for (int sl = 0; sl < 4; ++sl) { if (sl == 3 || sl < nsel) { const float w = ml[k][sl][1] * __builtin_amdgcn_exp2f(ml[k][sl][0] - mmax); wsum += w;
                acc += w * (f32x4){bflo(ov[k][sl].x), bfhi(ov[k][sl].x), bflo(ov[k][sl].y), bfhi(ov[k][sl].y)}; } }
            const float inv = 1.0f / wsum; st4bf(YB + (size_t)t * RW + h * MD + 4 * dg, acc * inv); }
    }
}

__device__ __forceinline__ void ins16(float (&top)[16], float x) {
#pragma unroll
    for (int k = 15; k >= 1; --k) top[k] = __builtin_amdgcn_fmed3f(top[k - 1], top[k], x);
    top[0] = fmaxf(top[0], x);
}
__device__ __forceinline__ void ph10_select(ArgsP A, Frame& F) {
    unsigned char* ws = A->ws; const bf16_t* PQ = (const bf16_t*)(ws + WS_PQ); const bf16_t* SK = (const bf16_t*)(ws + WS_SUBK); int* IDX = (int*)(ws + WS_IDX); float* GW = (float*)(ws + WS_GW);
    const int gw = F.vcu * NWAVES + F.wave, NGW = F.G * NWAVES; const int r = F.lane & 31, hh = F.lane >> 5; const float NEG = -__builtin_inff();
    for (int it = gw; it < (T / 32) * PH_; it += NGW) { const int tg = it >> 3, h = it & 7, t = tg * 32 + r;
        float TA[16], TB[16];
        auto topk = [&](int p, float (&dst)[16]) {
            bf16x8 qf[8];
#pragma unroll
            for (int ks = 0; ks < 8; ++ks) qf[ks] = *(const bf16x8*)(PQ + (size_t)t * 2048 + (h * 2 + p) * PHALF + 16 * ks + 8 * hh);
            float top[16];
#pragma unroll
            for (int k = 0; k < 16; ++k) top[k] = NEG;
#pragma unroll 1
            for (int nb = 0; nb < 4; ++nb) { f32x16 acc;
#pragma unroll
                for (int e = 0; e < 16; ++e) acc[e] = 0.f;
#pragma unroll
                for (int ks = 0; ks < 8; ++ks) { const bf16x8 a = *(const bf16x8*)(SK + ((size_t)(h * 2 + p) * PNK + 32 * nb + r) * PHALF + 16 * ks + 8 * hh); acc = __builtin_amdgcn_mfma_f32_32x32x16_bf16(a, qf[ks], acc, 0, 0, 0); }
#pragma unroll
                for (int e = 0; e < 16; ++e) { const unsigned key = 32 * nb + (e & 3) + 8 * (e >> 2) + 4 * hh; float ae = acc[e]; asm volatile("" : "+v"(ae));
                    const float x = __builtin_bit_cast(float, (__builtin_bit_cast(unsigned, ae) & ~0x7Fu) | key); ins16(top, x); } }
            float oth[16];
#pragma unroll
            for (int k = 0; k < 16; ++k) oth[k] = __shfl_xor(top[k], 32);
#pragma unroll
            for (int k = 0; k < 16; ++k) ins16(top, oth[k]);
#pragma unroll
            for (int k = 0; k < 16; ++k) dst[k] = top[k];
        };
        topk(0, TA); asm volatile("" ::: "memory"); __builtin_amdgcn_sched_barrier(0); topk(1, TB); asm volatile("" ::: "memory"); __builtin_amdgcn_sched_barrier(0);
        float fin[16];
#pragma unroll
        for (int k = 0; k < 16; ++k) fin[k] = NEG;
#pragma unroll
        for (int i = 0; i < 16; ++i)
#pragma unroll
            for (int j = 0; j < 16; ++j) if ((i + 1) * (j + 1) <= 16) { const float sm = TA[i] + TB[j]; ins16(fin, __builtin_bit_cast(float, (__builtin_bit_cast(unsigned, sm) & ~0xFFu) | (unsigned)(i * 16 + j))); }
        float e[16], den = 0.f;
#pragma unroll
        for (int k = 0; k < 16; ++k) { e[k] = __expf(fin[k] - fin[0]); den += e[k]; }
        const float rden = 1.0f / den;
        int oi[8]; float og[8];
#pragma unroll
        for (int kk = 0; kk < 8; ++kk) { const float fv = hh ? fin[8 + kk] : fin[kk]; og[kk] = (hh ? e[8 + kk] : e[kk]) * rden; const unsigned id = __builtin_bit_cast(unsigned, fv) & 0xFFu; const unsigned ci = id >> 4, cj = id & 15u;
            unsigned ia = 0u, ib = 0u;
#pragma unroll
            for (int q = 0; q < 16; ++q) { ia = (ci == (unsigned)q) ? (__builtin_bit_cast(unsigned, TA[q]) & 0x7Fu) : ia; ib = (cj == (unsigned)q) ? (__builtin_bit_cast(unsigned, TB[q]) & 0x7Fu) : ib; }
            oi[kk] = (int)(ia * PNK + ib); }
        int* ip = IDX + (size_t)t * 128 + h * 16 + 8 * hh; float* gp = GW + (size_t)t * 128 + h * 16 + 8 * hh;
        *(u32x4*)ip = (u32x4){(unsigned)oi[0], (unsigned)oi[1], (unsigned)oi[2], (unsigned)oi[3]}; *(u32x4*)(ip + 4) = (u32x4){(unsigned)oi[4], (unsigned)oi[5], (unsigned)oi[6], (unsigned)oi[7]};
        *(f32x4*)gp = (f32x4){og[0], og[1], og[2], og[3]}; *(f32x4*)(gp + 4) = (f32x4){og[4], og[5], og[6], og[7]};
    }
}


__device__ __forceinline__ float ub0(unsigned w) { return (float)(w & 0xffu); }
__device__ __forceinline__ float ub1(unsigned w) { return (float)((w >> 8) & 0xffu); }
__device__ __forceinline__ float ub2(unsigned w) { return (float)((w >> 16) & 0xffu); }
__device__ __forceinline__ float ub3(unsigned w) { return (float)(w >> 24); }
__device__ __forceinline__ float dot16q(u32x4 q, const float (&h)[16]) {
    return ((ub0(q.x) * h[0] + ub1(q.x) * h[1]) + (ub2(q.x) * h[2] + ub3(q.x) * h[3])) + ((ub0(q.y) * h[4] + ub1(q.y) * h[5]) + (ub2(q.y) * h[6] + ub3(q.y) * h[7]))
         + ((ub0(q.z) * h[8] + ub1(q.z) * h[9]) + (ub2(q.z) * h[10] + ub3(q.z) * h[11])) + ((ub0(q.w) * h[12] + ub1(q.w) * h[13]) + (ub2(q.w) * h[14] + ub3(q.w) * h[15]));
}
__device__ __forceinline__ void ph11_gather(ArgsP A, Frame& F) {
    unsigned char* ws = A->ws; const bf16_t* X1 = (const bf16_t*)(ws + WS_X1); const float* RS = (const float*)(ws + WS_RS); const unsigned char* PU = (const unsigned char*)(ws + WS_PU); const unsigned char* PV = (const unsigned char*)(ws + WS_PV);
    const float* PSU = (const float*)(ws + WS_PSU); const float* PSV = (const float*)(ws + WS_PSV);
    const int* IDX = (const int*)(ws + WS_IDX); const float* GW = (const float*)(ws + WS_GW);
    LAS float* coef = (LAS float*)(F.lds + RING_OFF); LAS int* eidx = (LAS int*)(F.lds + RING_OFF + 1024); LAS float* red = (LAS float*)(F.lds + RING_OFF + 2048);
    const int tid = F.tid, wave = F.wave, lane = F.lane; int par = 0;
    for (int tgk = F.vcu * 32; tgk < T; tgk = ((tgk & 31) == 31) ? tgk + (F.G - 1) * 32 + 1 : tgk + 1, par ^= 1) { const int t = tgk;
        float hv[4][16]; float hs = 0.f;
        const float rs2 = RS[t];
#pragma unroll
        for (int i = 0; i < 4; ++i) { const bf16_t* hp = X1 + (size_t)t * D + i * 1024 + lane * 16; f32x4 a, b, c, d; pg8::unpack8(*(const u32x4*)hp, a, b); pg8::unpack8(*(const u32x4*)(hp + 8), c, d);
            { const f32x4* gp = (const f32x4*)(A->norm2_g + i * 1024 + lane * 16); a = a * gp[0] * rs2; b = b * gp[1] * rs2; c = c * gp[2] * rs2; d = d * gp[3] * rs2; }
#pragma unroll
            for (int e = 0; e < 4; ++e) { hv[i][e] = a[e]; hv[i][4 + e] = b[e]; hv[i][8 + e] = c[e]; hv[i][12 + e] = d[e]; }
            hs += ((a[0] + a[1]) + (a[2] + a[3])) + ((b[0] + b[1]) + (b[2] + b[3])) + ((c[0] + c[1]) + (c[2] + c[3])) + ((d[0] + d[1]) + (d[2] + d[3])); }
        hs = wave_sum(hs);
        const int myidx = (lane < 16) ? IDX[(size_t)t * 128 + wave * 16 + lane] : 0; const float myg = (lane < 16) ? GW[(size_t)t * 128 + wave * 16 + lane] : 0.f;
        float dots = 0.f;
#pragma unroll 1
        for (int k = 0; k < 16; k += 4) {
            u32x4 q[4][4];
#pragma unroll
            for (int x = 0; x < 4; ++x) { const int e = __builtin_amdgcn_readlane(myidx, k + x); const unsigned char* up = PU + (size_t)e * D + lane * 16;
#pragma unroll
                for (int i = 0; i < 4; ++i) q[x][i] = *(const u32x4*)(up + i * 1024); }
#pragma unroll
            for (int x = 0; x < 4; ++x) { float d = 0.f;
#pragma unroll
                for (int i = 0; i < 4; ++i) d += dot16q(q[x][i], hv[i]);
                d = wave_sum(d); if (lane == k + x) dots = d; }
        }
        if (lane < 16) { const float s = PSU[myidx] * (dots - 128.0f * hs); const float act = 0.5f * s * (1.0f + erff(s * 0.70710678118654752f));
            coef[par * 128 + wave * 16 + lane] = myg * act * PSV[myidx]; eidx[par * 128 + wave * 16 + lane] = myidx; }
        WG_BAR();
        float acc[8]; float csum = 0.f;
#pragma unroll
        for (int i = 0; i < 8; ++i) acc[i] = 0.f;
#pragma unroll 1
        for (int e = 0; e < 128; e += 16) { u32x2 v[16]; float c[16];
#pragma unroll
            for (int q = 0; q < 16; ++q) { const int ei = __builtin_amdgcn_readfirstlane(eidx[par * 128 + e + q]); c[q] = coef[par * 128 + e + q]; v[q] = *(const u32x2*)(PV + (size_t)ei * D + tid * 8); }
#pragma unroll
            for (int q = 0; q < 16; ++q) { csum += c[q]; acc[0] += c[q] * ub0(v[q].x); acc[1] += c[q] * ub1(v[q].x); acc[2] += c[q] * ub2(v[q].x); acc[3] += c[q] * ub3(v[q].x); acc[4] += c[q] * ub0(v[q].y); acc[5] += c[q] * ub1(v[q].y); acc[6] += c[q] * ub2(v[q].y); acc[7] += c[q] * ub3(v[q].y); } }
        const float corr = -128.0f * csum;
        f32x4 x0, x1; pg8::unpack8(*(const u32x4*)(X1 + (size_t)t * D + tid * 8), x0, x1);
        f32x4 y0 = x0 + ((f32x4){acc[0], acc[1], acc[2], acc[3]} + corr), y1 = x1 + ((f32x4){acc[4], acc[5], acc[6], acc[7]} + corr);
        float ss = (y0[0] * y0[0] + y0[1] * y0[1]) + (y0[2] * y0[2] + y0[3] * y0[3]) + (y1[0] * y1[0] + y1[1] * y1[1]) + (y1[2] * y1[2] + y1[3] * y1[3]);
        ss = wave_sum(ss); if (lane == 0) red[par * 8 + wave] = ss;
        WG_BAR();
        float tot = 0.f;
#pragma unroll
        for (int w = 0; w < 8; ++w) tot += red[par * 8 + w];
        const float rs = 1.0f / sqrtf(tot * (1.0f / D) + NORM_EPS);
        const f32x4 g0 = *(const f32x4*)(A->final_g + tid * 8), g1 = *(const f32x4*)(A->final_g + tid * 8 + 4);
        *(f32x4*)(A->out + (size_t)t * D + tid * 8) = y0 * rs * g0; *(f32x4*)(A->out + (size_t)t * D + tid * 8 + 4) = y1 * rs * g1;
    }
}

constexpr int NPH = 13;
__device__ __forceinline__ Frame make_frame(unsigned char* lds) {
    Frame F; int t = threadIdx.x; asm volatile("" : "+v"(t));
    F.lds = (LAS unsigned char*)lds; F.tid = t; F.lane = t & 63; F.wave = __builtin_amdgcn_readfirstlane(t >> 6);
    F.G = gridDim.x; { const int bx = blockIdx.x; F.vcu = (F.G % 8 == 0) ? (bx % 8) * (F.G / 8) + bx / 8 : bx; }
    return F;
}
__global__ void __launch_bounds__(NTHR, 2) mk_fwd(Args args_by_value) {
    extern __shared__ __attribute__((aligned(16))) unsigned char lds[];
    ArgsP args = get_args();
    gu32* ctl = (gu32*)(args->ws + WS_CTL);
    for (int u = threadIdx.x; u < (LDS_BYTES - LDSCTL_OFF) / 4; u += NTHR) ((LAS unsigned*)((LAS unsigned char*)lds + LDSCTL_OFF))[u] = 0u;
    __syncthreads();
    const int lo = args->ph_lo, hi = args->ph_hi;
    volatile LAS unsigned* MISC = (volatile LAS unsigned*)((LAS unsigned char*)lds + MISC_OFF);
    XcdBarrier bar; bar.bar = (unsigned*)(ctl + CW_BAR) + args->li * XCD_BAR_WORDS; bar.x = 0; bar.st = nullptr;
    if (hi - lo > 1) bar = xcd_barrier_post((unsigned*)(ctl + CW_BAR) + args->li * XCD_BAR_WORDS, MISC + 8);
#define IN(k) (lo <= (k) && (k) < hi)
#define SEAM(k) do { if (IN(k) && IN((k) + 1)) xcd_barrier(bar); } while (0)
    const int bid = (int)blockIdx.x;

    if (IN(0)) { Frame F = make_frame(lds); ph0_prologue(get_args(), F); SEAM(0); }
    if (IN(1)) { Frame F = make_frame(lds); LAS unsigned char* ring = F.lds + RING_OFF; ArgsP a_ = get_args(); unsigned char* ws = a_->ws;
        { pg8::Gemm g{(const bf16_t*)(ws + WS_XN), (const bf16_t*)(ws + WS_WIN), T, PLD, D}; pg8::StaticOrder S; S.init(T, PLD, F.G, bid);
          pg8::EpiProj E{(bf16_t*)(ws + WS_PROJ), (const float*)(ws + WS_ROPE), (bf16_t*)(ws + WS_KB)}; pg8::gemm_phase<pg8::EpiProj, pg8::StaticOrder, true, true>(ring, g, S, E); }
        { pg8::Gemm g{(const bf16_t*)(ws + WS_XN), (const bf16_t*)(ws + WS_WIN) + (size_t)PC_MV * D, T, 2048, D}; pg8::StaticOrder S; S.init(T, 2048, F.G, bid);
          pg8::EpiVT E{(bf16_t*)(ws + WS_VT)}; pg8::gemm_phase<pg8::EpiVT, pg8::StaticOrder, true, true>(ring, g, S, E); }
        { constexpr int NT1 = (T / 256) * (PLD / 256); const int nx = NT1 % F.G;
          if (bid >= nx) { WG_BAR(); { Frame F2 = make_frame(lds); late_weights(get_args(), F2, (bid - nx) * NWAVES + F2.wave, (F2.G - nx) * NWAVES); }
              if (nx) { Frame F2 = make_frame(lds); peer_quant(get_args(), F2, 0, pq_ra(F2.G), (bid - nx) * NWAVES + F2.wave, (F2.G - nx) * NWAVES); } } }
        SEAM(1); }
    if (IN(2)) { Frame F = make_frame(lds); ph2_prep(get_args(), F); SEAM(2); }
    if (IN(3)) { Frame F = make_frame(lds); LAS unsigned char* ring = F.lds + RING_OFF; ArgsP a_ = get_args(); unsigned char* ws = a_->ws;
        { pg8::Gemm g{(const bf16_t*)(ws + WS_AW), (const bf16_t*)(ws + WS_WUP), T, RW, LW}; pg8::StaticOrder S; S.init(T, RW, F.G, bid);
          pg8::EpiDec E{(float*)(ws + WS_DEC), a_->w0}; pg8::gemm_phase<pg8::EpiDec, pg8::StaticOrder, true, true>(ring, g, S, E); }
        asm volatile("" ::: "memory"); __builtin_amdgcn_sched_barrier(0);
        { pg8::Gemm g{(const bf16_t*)(ws + WS_AA), (const bf16_t*)(ws + WS_AUP), T, RW, LA}; pg8::StaticOrder S; S.init(T, RW, F.G, bid);
          pg8::EpiA E{(bf16_t*)(ws + WS_KP), (bf16_t*)(ws + WS_BB), (const bf16_t*)(ws + WS_KKN), a_->a0, a_->k_a}; pg8::gemm_phase<pg8::EpiA, pg8::StaticOrder, true, true>(ring, g, S, E); }
        asm volatile("" ::: "memory"); __builtin_amdgcn_sched_barrier(0);
        { pg8::Gemm g{(const bf16_t*)(ws + WS_AG), (const bf16_t*)(ws + WS_GUP), T, RW, LGP}; pg8::StaticOrder S; S.init(T, RW, F.G, bid);
          pg8::EpiBf16 E{(bf16_t*)(ws + WS_G), RW}; pg8::gemm_phase<pg8::EpiBf16, pg8::StaticOrder, true, true>(ring, g, S, E); }
        { Frame F2 = make_frame(lds); ph3_gate(get_args(), F2); }
        SEAM(3); }
    if (IN(4)) { Frame F = make_frame(lds); ph4_chunkprep(get_args(), F); SEAM(4); }
    if (IN(5)) {
        { Frame F = make_frame(lds); if (F.vcu < RH) ph5_chain(get_args(), F, F.vcu); }
        { Frame F = make_frame(lds); ph5_attn(get_args(), F); }
        { Frame F = make_frame(lds); if (F.vcu >= RH) peer_quant(get_args(), F, pq_ra(F.G), 2 * 16384, (F.vcu - RH) * NWAVES + F.wave, (F.G - RH) * NWAVES); }
        SEAM(5); }
    if (IN(6)) { { Frame F = make_frame(lds); ph6_merge(get_args(), F); } { Frame F = make_frame(lds); ph5_ypost(get_args(), F); } SEAM(6); }
    if (IN(7)) { Frame F = make_frame(lds); LAS unsigned char* ring = F.lds + RING_OFF; ArgsP a_ = get_args(); unsigned char* ws = a_->ws;
        { pg8::Gemm g{(const bf16_t*)(ws + WS_YA), (const bf16_t*)(ws + WS_WA), T, D, RW}; pg8::StaticOrder S; S.init(T, D, F.G, bid);
          pg8::EpiMix<false> E{(bf16_t*)(ws + WS_MIXED), (const bf16_t*)(ws + WS_PROJ), PC_GA}; pg8::gemm_phase<pg8::EpiMix<false>, pg8::StaticOrder, true, true>(ring, g, S, E); }
        { pg8::Gemm g{(const bf16_t*)(ws + WS_YB), (const bf16_t*)(ws + WS_WB), T, D, RW}; pg8::StaticOrder S; S.init(T, D, F.G, bid);
          pg8::EpiMix<true> E{(bf16_t*)(ws + WS_MIXED), (const bf16_t*)(ws + WS_PROJ), PC_GB}; pg8::gemm_phase<pg8::EpiMix<true>, pg8::StaticOrder, true, true>(ring, g, S, E); }
        SEAM(7); }
    if (IN(8)) { Frame F = make_frame(lds); LAS unsigned char* ring = F.lds + RING_OFF; ArgsP a_ = get_args(); unsigned char* ws = a_->ws;
        pg8::Gemm g{(const bf16_t*)(ws + WS_MIXED), (const bf16_t*)(ws + WS_WOUT), T, D, D}; pg8::StaticOrder S; S.init(T, D, F.G, bid);
        pg8::EpiRes E{(bf16_t*)(ws + WS_X1), a_->x, (float*)(ws + WS_RSQ)}; pg8::gemm_phase<pg8::EpiRes, pg8::StaticOrder, true, true>(ring, g, S, E);
        SEAM(8); }
    if (IN(9)) { Frame F = make_frame(lds); ArgsP a_ = get_args(); unsigned char* ws = a_->ws; const int gw = F.vcu * NWAVES + F.wave, NGW = F.G * NWAVES;
        { const float* rsq = (const float*)(ws + WS_RSQ); float* rs = (float*)(ws + WS_RS); (void)gw; (void)NGW;
          for (int t = F.vcu * NTHR + F.tid; t < T; t += F.G * NTHR) { float ss = 0.f;
#pragma unroll
              for (int j = 0; j < 16; ++j) { const f32x4 v = *(const f32x4*)(rsq + (size_t)t * 64 + 4 * j); ss += (v[0] + v[1]) + (v[2] + v[3]); }
              rs[t] = 1.0f / sqrtf(ss * (1.0f / D) + NORM_EPS); } }
        SEAM(9); }
    if (IN(10)) { Frame F = make_frame(lds); LAS unsigned char* ring = F.lds + RING_OFF; ArgsP a_ = get_args(); unsigned char* ws = a_->ws;
        pg8::Gemm g{(const bf16_t*)(ws + WS_X1), (const bf16_t*)(ws + WS_WQ), T, 2048, D}; pg8::StaticOrder S; S.init(T, 2048, F.G, bid);
        pg8::EpiBf16Rs E{(bf16_t*)(ws + WS_PQ), 2048, (const float*)(ws + WS_RS)}; pg8::gemm_phase<pg8::EpiBf16Rs, pg8::StaticOrder, true, true>(ring, g, S, E);
        SEAM(10); }
    if (IN(11)) { Frame F = make_frame(lds); ph10_select(get_args(), F);
        if (IN(12)) { __builtin_amdgcn_fence(__ATOMIC_RELEASE, "workgroup"); WG_BAR(); __builtin_amdgcn_fence(__ATOMIC_ACQUIRE, "workgroup"); } }
    if (IN(12)) { Frame F = make_frame(lds); ph11_gather(get_args(), F); }
#undef IN
#undef SEAM
}

extern "C" void kernel_launch(void* const* d_in, const int* in_sizes, int n_in, void* d_out, int out_size, void* d_ws, size_t ws_size, hipStream_t stream) {
    static int grid = 0;
    if (grid == 0) {
        if (n_in != 23 || out_size != T * D || ws_size < WS_END) { fprintf(stderr, "kernel_launch: unexpected shapes (n_in %d out %d ws %zu); nothing launched\n", n_in, out_size, ws_size); grid = -1; return; }
        int dev = 0, cus = 0, per_cu = 0;
        if (hipGetDevice(&dev) != hipSuccess || hipDeviceGetAttribute(&cus, hipDeviceAttributeMultiprocessorCount, dev) != hipSuccess) { grid = -1; return; }
        if (hipFuncSetAttribute((const void*)mk_fwd, hipFuncAttributeMaxDynamicSharedMemorySize, LDS_BYTES) != hipSuccess) { grid = -1; return; }
        if (hipOccupancyMaxActiveBlocksPerMultiprocessor(&per_cu, (const void*)mk_fwd, NTHR, LDS_BYTES) != hipSuccess || per_cu < 1) fprintf(stderr, "kernel_launch: occupancy query reports %d\n", per_cu);
        (void)hipGetLastError();
        grid = cus;
    }
    if (grid < 0) return;
    (void)hipMemsetAsync((char*)d_ws + WS_CTL, 0, CTL_ZERO_BYTES, stream);
    Args a{};
    const float** ap = (const float**)&a;
    for (int i = 0; i < 23; ++i) ap[i] = (const float*)d_in[i];
    a.out = (float*)d_out; a.ws = (unsigned char*)d_ws; a.pad = 0;
    constexpr int NL = MK_N_LAUNCHES;
    for (int li = 0; li < NL; ++li) {
        a.ph_lo = (NL == 1) ? 0 : li; a.ph_hi = (NL == 1) ? NPH : li + 1; a.li = (NL == 1) ? 0 : 0;
        hipLaunchKernelGGL(mk_fwd, dim3(grid), dim3(NTHR), LDS_BYTES, stream, a);
#ifdef DUP_HI
        if (NL > 1 && li == DUP_HI) for (int l2 = DUP_LO; l2 <= DUP_HI; ++l2) { a.ph_lo = l2; a.ph_hi = l2 + 1; hipLaunchKernelGGL(mk_fwd, dim3(grid), dim3(NTHR), LDS_BYTES, stream, a); }
#endif
    }
}
```

```cpp
#include <hip/hip_runtime.h>
#include <cstdio>
#include <cstdint>

#ifndef MK_N_LAUNCHES
#define MK_N_LAUNCHES 1
#endif

#define GAS __attribute__((address_space(1)))
#define LAS __attribute__((address_space(3)))
typedef unsigned short bf16_t;
typedef __bf16 bf16x8 __attribute__((ext_vector_type(8)));
typedef float f32x2 __attribute__((ext_vector_type(2)));
typedef float f32x4 __attribute__((ext_vector_type(4)));
typedef float f32x16 __attribute__((ext_vector_type(16)));
typedef unsigned u32x2 __attribute__((ext_vector_type(2)));
typedef unsigned u32x4 __attribute__((ext_vector_type(4)));
typedef GAS unsigned gu32;

constexpr int T = 8192, D = 4096;
constexpr int RW = 2048, RH = 32, RN = 64;
constexpr int LW = 128, LA = 128, LG = 480, LGP = 512;
constexpr int SHIFTW = 6880;
constexpr int MH = 16, MD = 128, MBLK = 256, NBLK = 32;
constexpr int INW = 21216;
constexpr int PLD = 19200;
constexpr int PC_R = 0, PC_K = 2048, PC_V = 4096, PC_WL = 6144, PC_AL = 6272, PC_GL = 6400, PC_MQ = 6912, PC_MK = 8960, PC_GA = 11008, PC_GB = 15104, PC_MV = 19200;
constexpr int WIN_ROWS = 21248;
constexpr int PQ_SPLIT = 16384;
constexpr int PH_ = 8, PNK = 128, PQD = 256, PHALF = 128, PTOPK = 16;
constexpr float NORM_EPS = 1e-6f, LNX_EPS = 64e-5f;
constexpr float QSCALE = 0.08838834764831845f * 1.4426950408889634f;

constexpr size_t MiB = 1u << 20;
constexpr size_t WS_CTL = 0, CTL_ZERO_BYTES = 1 * MiB;
constexpr size_t WS_WIN = 1 * MiB;
constexpr size_t WS_X1 = 1 * MiB, WS_PQ = 129 * MiB;
constexpr size_t WS_WA = 167 * MiB, WS_WB = 183 * MiB, WS_WOUT = 199 * MiB, WS_WQ = 231 * MiB, WS_WUP = 247 * MiB, WS_AUP = 248 * MiB, WS_GUP = 249 * MiB, WS_SUBK = 251 * MiB;
constexpr size_t WS_PU = 252 * MiB, WS_PV = 380 * MiB;
constexpr size_t WS_XN = 508 * MiB;
constexpr size_t WS_Y = 508 * MiB, WS_RSQ = 508 * MiB, WS_RS = 510 * MiB;
constexpr size_t WS_PROJ = 572 * MiB;
constexpr size_t WS_VT = 872 * MiB;
constexpr size_t WS_ROPE = 904 * MiB, WS_KMEAN = 908 * MiB, WS_MASK = 909 * MiB, WS_AW = 910 * MiB, WS_AA = 912 * MiB, WS_AG = 914 * MiB;
constexpr size_t WS_PSU = 909 * MiB + 512 * 1024, WS_PSV = WS_PSU + 64 * 1024;
constexpr size_t WS_DEC = 922 * MiB;
constexpr size_t WS_MIXED = 922 * MiB;
constexpr size_t WS_KKN = 986 * MiB, WS_BB = 1018 * MiB, WS_KP = 1050 * MiB, WS_ZR = 1082 * MiB, WS_ZV = 1114 * MiB, WS_G = 1146 * MiB;
constexpr size_t WS_YA = 1178 * MiB, WS_YB = 1210 * MiB, WS_IDX = 1242 * MiB, WS_GW = 1246 * MiB, WS_PARTML = 1250 * MiB, WS_LIST = 1254 * MiB, WS_UDESC = 1262 * MiB, WS_KB = 1267 * MiB, WS_END = 1299 * MiB;
constexpr size_t WS_PARTO = 922 * MiB;

constexpr int CW_TMO = 0, CW_CODE = 1, CW_ATTNQ = 64, CW_CNT = 1024, CW_BAR = 4096;

constexpr int RING_OFF = 0, RING_BYTES = 155648;
constexpr int LDSCTL_OFF = RING_BYTES, MISC_OFF = LDSCTL_OFF + 320;
constexpr int LDS_BYTES = 163840;
constexpr int NWAVES = 8, NTHR = 512;

__device__ __forceinline__ unsigned f2bf(float f) { unsigned u = __builtin_bit_cast(unsigned, f); return (u + 0x7fffu + ((u >> 16) & 1u)) >> 16; }
typedef __bf16 bf16x2 __attribute__((ext_vector_type(2)));
__device__ __forceinline__ unsigned pk2(float lo, float hi) { const f32x2 v = {lo, hi}; return __builtin_bit_cast(unsigned, __builtin_convertvector(v, bf16x2)); }
__device__ __forceinline__ float bflo(unsigned u) { return __builtin_bit_cast(float, u << 16); }
__device__ __forceinline__ float bfhi(unsigned u) { return __builtin_bit_cast(float, u & 0xffff0000u); }
__device__ __forceinline__ float bf1(bf16_t b) { return __builtin_bit_cast(float, (unsigned)b << 16); }
__device__ __forceinline__ float fsigmoid(float x) { return __builtin_amdgcn_rcpf(1.0f + __expf(-x)); }
__device__ __forceinline__ float wave_sum(float v) {
#pragma unroll
    for (int o = 1; o < 64; o <<= 1) v += __shfl_xor(v, o);
    return v;
}
template <int CTRL> __device__ __forceinline__ float dpp_f(float v) { return __builtin_bit_cast(float, __builtin_amdgcn_update_dpp(0, __builtin_bit_cast(int, v), CTRL, 0xF, 0xF, true)); }
__device__ __forceinline__ float sum16(float x) {
    x += dpp_f<0xB1>(x); x += dpp_f<0x4E>(x); x += dpp_f<0x141>(x); x += dpp_f<0x140>(x); return x;
}
__device__ __forceinline__ float vmul(float a, float b) { float r; asm("v_mul_f32_e32 %0, %1, %2" : "=v"(r) : "v"(a), "v"(b)); return r; }
__device__ __forceinline__ float vfma(float a, float b, float c) { float r; asm("v_fma_f32 %0, %1, %2, %3" : "=v"(r) : "v"(a), "v"(b), "v"(c)); return r; }
#define LDS_WAIT() asm volatile("s_waitcnt lgkmcnt(0)" ::: "memory")
#define VM_WAIT() asm volatile("s_waitcnt vmcnt(0)" ::: "memory")
#define WG_BAR() do { asm volatile("s_waitcnt lgkmcnt(0)" ::: "memory"); __builtin_amdgcn_s_barrier(); asm volatile("" ::: "memory"); } while (0)

namespace pg8 {
constexpr int BM = 256, BK = 64, HALF = 128, HTB = HALF * BK * 2, STAGE_BYTES = 8 * HTB, NXCD = 8, WGM = 8;
__host__ __device__ __forceinline__ int lds_byte(int r, int c) { const int st = (r >> 4) * 2 + (c >> 5), rr = r & 15, cc = c & 31, ob = rr * 64 + cc * 2; return st * 1024 + (ob ^ (((ob >> 9) & 1) << 5)); }
__host__ __device__ __forceinline__ void stage_rc(int b, int& R, int& C) { const int st = b / 1024, sb = b % 1024, swz = sb ^ (((sb >> 9) & 1) << 5); R = (st >> 1) * 16 + swz / 64; C = (st & 1) * 32 + (swz % 64) / 2; }
__host__ __device__ __forceinline__ int perm32(int rho) { const int n = rho >> 4, i = rho & 15; return 8 * (i >> 2) + 4 * n + (i & 3); }

struct Unit { int pm, pn; };
struct Gemm { const bf16_t* A; const bf16_t* Bt; int M, N, K; };

struct StaticOrder {
    int nM, nN, nwg, G, c;
    __host__ __device__ void init(int M, int N, int G_, int c_) { nM = M / BM; nN = N / BM; nwg = nM * nN; G = G_; c = c_; }
    __host__ __device__ bool next(int i, Unit& u) const {
        const long L = (long)i * G + c; if (L >= nwg) return false;
        int wgid = (int)L; { const int q = nwg / NXCD, r = nwg % NXCD, xcd = wgid % NXCD, off = wgid / NXCD; wgid = (xcd < r ? xcd * (q + 1) : r * (q + 1) + (xcd - r) * q) + off; }
        const int nig = WGM * nN, gid = wgid / nig, fm = gid * WGM, gsz = (nM - fm) < WGM ? (nM - fm) : WGM;
        u.pm = fm + ((wgid % nig) % gsz); u.pn = (wgid % nig) / gsz; return true;
    }
    __device__ __forceinline__ void a_ready(const Unit&) const {}
    __device__ __forceinline__ void done(const Unit&) const {}
};

template <class Epi, class Sched, bool ALIGN_EPI = false, bool SP2 = false>
__device__ __forceinline__ void gemm_phase(LAS unsigned char* lds, const Gemm g, const Sched& S, const Epi& E) {
    int tid_ = threadIdx.x; asm volatile("" : "+v"(tid_));
    const int tid = tid_, wid = __builtin_amdgcn_readfirstlane(tid >> 6), lane = tid & 63, wr = wid >> 2, wc = wid & 3, fr = lane & 15, fq = lane >> 4;
    int K_ = g.K; asm volatile("" : "+s"(K_));
    const int K = K_, nt = K / BK;
    unsigned voffA[2], voffB[2];
#pragma unroll
    for (int i = 0; i < 2; ++i) { int R, C; stage_rc(tid * 16 + i * 8192, R, C); const int Rb = Epi::PERM ? ((R & ~31) + perm32(R & 31)) : R;
        voffA[i] = (unsigned)(R * K + C) * 2u; voffB[i] = (unsigned)(Rb * K + C) * 2u; }
    const size_t kstep = (size_t)(BK * 2);
    const size_t hstep = (size_t)HALF * K * 2;
    const size_t tstep = 2 * hstep;
    const unsigned ldsw = (unsigned)wid * 1024u;
    const int aoff = lds_byte(wr * 64 + fr, fq * 8), boff = lds_byte(wc * 32 + fr, fq * 8);
#define PG8_SA(b, h) (((b) * 2 + (h)) * HTB)
#define PG8_SB(b, h) ((4 + (b) * 2 + (h)) * HTB)
#define PG8_STAGE(bufoff, gbase, voff) do { _Pragma("unroll") for (int _i = 0; _i < 2; ++_i) \
        __builtin_amdgcn_global_load_lds((const unsigned*)((const char*)(gbase) + (voff)[_i]), (LAS unsigned*)(lds + (bufoff) + ldsw + _i * 8192), 16, 0, 0); } while (0)
#define PG8_LDA(dst, b, h) do { _Pragma("unroll") for (int m = 0; m < 4; ++m) _Pragma("unroll") for (int k = 0; k < 2; ++k) dst[m][k] = *(const LAS bf16x8*)(lds + PG8_SA(b, h) + aoff + m * 2048 + k * 1024); } while (0)
#define PG8_LDB(dst, b, h) do { _Pragma("unroll") for (int n = 0; n < 2; ++n) _Pragma("unroll") for (int k = 0; k < 2; ++k) dst[n][k] = *(const LAS bf16x8*)(lds + PG8_SB(b, h) + boff + n * 2048 + k * 1024); } while (0)
#define PG8_MMA(ai, bj, At, Bt) do { __builtin_amdgcn_s_setprio(1); _Pragma("unroll") for (int m = 0; m < 4; ++m) _Pragma("unroll") for (int n = 0; n < 2; ++n) _Pragma("unroll") for (int k = 0; k < 2; ++k) { \
        if constexpr (Epi::SWAP) acc[ai][bj][m][n] = __builtin_amdgcn_mfma_f32_16x16x32_bf16(At[m][k], Bt[n][k], acc[ai][bj][m][n], 0, 0, 0); \
        else acc[ai][bj][m][n] = __builtin_amdgcn_mfma_f32_16x16x32_bf16(Bt[n][k], At[m][k], acc[ai][bj][m][n], 0, 0, 0); } __builtin_amdgcn_s_setprio(0); } while (0)
#define PG8_WAIT_V(n) asm volatile("s_waitcnt vmcnt(" #n ")" ::: "memory")
#define PG8_WAIT_L(n) asm volatile("s_waitcnt lgkmcnt(" #n ")" ::: "memory")
#define PG8_BAR __builtin_amdgcn_s_barrier()
#define PG8_SCHED __builtin_amdgcn_sched_barrier(0)
    Unit cur, nxt; int ui = 0;
    if (!S.next(0, cur)) return;
    f32x4 acc[2][2][4][2];
#pragma unroll
    for (int a = 0; a < 2; ++a)
#pragma unroll
        for (int b = 0; b < 2; ++b)
#pragma unroll
            for (int m = 0; m < 4; ++m)
#pragma unroll
                for (int n = 0; n < 2; ++n) acc[a][b][m][n] = (f32x4){0.f, 0.f, 0.f, 0.f};
    bf16x8 At[4][2], B0[2][2], B1[2][2];
    const char* cA = (const char*)g.A + (size_t)cur.pm * tstep; const char* cB = (const char*)g.Bt + (size_t)cur.pn * tstep;
    S.a_ready(cur);
    if constexpr (SP2) {
        PG8_STAGE(PG8_SB(0, 0), cB, voffB); PG8_STAGE(PG8_SB(0, 1), cB + hstep, voffB); PG8_STAGE(PG8_SA(0, 0), cA, voffA); PG8_STAGE(PG8_SA(0, 1), cA + hstep, voffA);
        if (wr == 1) PG8_BAR;
        PG8_WAIT_V(2); PG8_BAR;
        PG8_STAGE(PG8_SB(1, 0), cB + kstep, voffB); PG8_STAGE(PG8_SA(1, 0), cA + kstep, voffA); PG8_STAGE(PG8_SB(1, 1), cB + hstep + kstep, voffB);
        PG8_WAIT_V(6); PG8_BAR;
    } else {
        PG8_STAGE(PG8_SB(0, 0), cB, voffB); PG8_STAGE(PG8_SA(0, 0), cA, voffA); PG8_STAGE(PG8_SB(0, 1), cB + hstep, voffB); PG8_STAGE(PG8_SA(0, 1), cA + hstep, voffA);
        if (wr == 1) PG8_BAR;
        PG8_WAIT_V(4); PG8_BAR;
        PG8_STAGE(PG8_SB(1, 0), cB + kstep, voffB); PG8_STAGE(PG8_SA(1, 0), cA + kstep, voffA); PG8_STAGE(PG8_SB(1, 1), cB + hstep + kstep, voffB);
        PG8_WAIT_V(6); PG8_BAR;
    }
    for (;;) {
        const bool has_next = S.next(ui + 1, nxt);
        const char* nA = has_next ? (const char*)g.A + (size_t)nxt.pm * tstep : cA; const char* nB = has_next ? (const char*)g.Bt + (size_t)nxt.pn * tstep : cB;
        for (int t = 0; t < nt; t += 2) {
            const bool last = (t == nt - 2);
            const char* a1 = cA + (size_t)(t + 1) * kstep;
            const char* a2 = last ? nA : cA + (size_t)(t + 2) * kstep; const char* b2 = last ? nB : cB + (size_t)(t + 2) * kstep;
            const char* a3 = a2 + kstep; const char* b3 = b2 + kstep;
            if (last && has_next) S.a_ready(nxt);
            if constexpr (SP2) {
            PG8_LDB(B0, 0, 0); PG8_LDB(B1, 0, 1); PG8_SCHED; PG8_LDA(At, 0, 0); PG8_STAGE(PG8_SA(1, 1), a1 + hstep, voffA);
            PG8_WAIT_V(8); PG8_WAIT_L(0); PG8_BAR; PG8_MMA(0, 0, At, B0); PG8_MMA(0, 1, At, B1); PG8_BAR; PG8_SCHED;
            PG8_LDA(At, 0, 1); PG8_STAGE(PG8_SB(0, 0), b2, voffB); PG8_STAGE(PG8_SB(0, 1), b2 + hstep, voffB); PG8_STAGE(PG8_SA(0, 0), a2, voffA);
            PG8_WAIT_V(8); PG8_WAIT_L(0); PG8_BAR; PG8_MMA(1, 0, At, B0); PG8_MMA(1, 1, At, B1); PG8_BAR; PG8_SCHED;
            PG8_LDB(B0, 1, 0); PG8_LDB(B1, 1, 1); PG8_SCHED; PG8_LDA(At, 1, 0); PG8_STAGE(PG8_SA(0, 1), a2 + hstep, voffA);
            PG8_WAIT_V(8); PG8_WAIT_L(0); PG8_BAR; PG8_MMA(0, 0, At, B0); PG8_MMA(0, 1, At, B1); PG8_BAR; PG8_SCHED;
            PG8_LDA(At, 1, 1); PG8_STAGE(PG8_SB(1, 0), b3, voffB); PG8_STAGE(PG8_SB(1, 1), b3 + hstep, voffB); PG8_STAGE(PG8_SA(1, 0), a3, voffA);
            PG8_WAIT_V(8); PG8_WAIT_L(0); PG8_BAR; PG8_MMA(1, 0, At, B0); PG8_MMA(1, 1, At, B1); PG8_BAR; PG8_SCHED;
            } else {
            PG8_LDB(B0, 0, 0); PG8_SCHED; PG8_LDA(At, 0, 0); PG8_STAGE(PG8_SA(1, 1), a1 + hstep, voffA);
            PG8_WAIT_L(8); PG8_BAR; PG8_WAIT_L(0); PG8_MMA(0, 0, At, B0); PG8_BAR; PG8_SCHED;
            PG8_LDB(B1, 0, 1); PG8_STAGE(PG8_SB(0, 0), b2, voffB);
            PG8_BAR; PG8_WAIT_L(0); PG8_MMA(0, 1, At, B1); PG8_BAR;
            PG8_LDA(At, 0, 1); PG8_STAGE(PG8_SA(0, 0), a2, voffA);
            PG8_BAR; PG8_WAIT_L(0); PG8_MMA(1, 0, At, B0); PG8_BAR; PG8_SCHED;
            PG8_STAGE(PG8_SB(0, 1), b2 + hstep, voffB);
            PG8_WAIT_V(6); PG8_BAR; PG8_MMA(1, 1, At, B1); PG8_BAR;
            PG8_LDB(B0, 1, 0); PG8_SCHED; PG8_LDA(At, 1, 0); PG8_STAGE(PG8_SA(0, 1), a2 + hstep, voffA);
            PG8_WAIT_L(8); PG8_BAR; PG8_WAIT_L(0); PG8_MMA(0, 0, At, B0); PG8_BAR; PG8_SCHED;
            PG8_LDB(B1, 1, 1); PG8_STAGE(PG8_SB(1, 0), b3, voffB);
            PG8_BAR; PG8_WAIT_L(0); PG8_MMA(0, 1, At, B1); PG8_BAR;
            PG8_LDA(At, 1, 1); PG8_STAGE(PG8_SA(1, 0), a3, voffA);
            PG8_BAR; PG8_WAIT_L(0); PG8_MMA(1, 0, At, B0); PG8_BAR; PG8_SCHED;
            PG8_STAGE(PG8_SB(1, 1), b3 + hstep, voffB);
            PG8_WAIT_V(6); PG8_BAR; PG8_MMA(1, 1, At, B1); PG8_BAR;
            }
        }
        if constexpr (ALIGN_EPI) { if (wr == 0) PG8_BAR; }
        E(acc, cur, wr, wc, fr, fq); S.done(cur);
        if (!has_next) break;
#pragma unroll
        for (int a = 0; a < 2; ++a)
#pragma unroll
            for (int b = 0; b < 2; ++b)
#pragma unroll
                for (int m = 0; m < 4; ++m)
#pragma unroll
                    for (int n = 0; n < 2; ++n) acc[a][b][m][n] = (f32x4){0.f, 0.f, 0.f, 0.f};
        cur = nxt; cA = nA; cB = nB; ++ui;
        if constexpr (ALIGN_EPI) { if (wr == 1) PG8_BAR; }
    }
    PG8_WAIT_V(0);
    if constexpr (!ALIGN_EPI) { if (wr == 0) PG8_BAR; }
    PG8_BAR;
#undef PG8_SA
#undef PG8_SB
#undef PG8_STAGE
#undef PG8_LDA
#undef PG8_LDB
#undef PG8_MMA
#undef PG8_WAIT_V
#undef PG8_WAIT_L
#undef PG8_BAR
#undef PG8_SCHED
}

typedef const f32x4 (&AccRef)[2][2][4][2];
__device__ __forceinline__ u32x4 pack8(f32x4 v0, f32x4 v1) { u32x4 w; w.x = pk2(v0[0], v0[1]); w.y = pk2(v0[2], v0[3]); w.z = pk2(v1[0], v1[1]); w.w = pk2(v1[2], v1[3]); return w; }
__device__ __forceinline__ void unpack8(u32x4 w, f32x4& v0, f32x4& v1) { v0 = (f32x4){bflo(w.x), bfhi(w.x), bflo(w.y), bfhi(w.y)}; v1 = (f32x4){bflo(w.z), bfhi(w.z), bflo(w.w), bfhi(w.w)}; }

struct EpiBf16 {
    static constexpr bool PERM = true, SWAP = false;
    bf16_t* O; int ldc;
    __device__ __forceinline__ void operator()(AccRef acc, const Unit& u, int wr, int wc, int fr, int fq) const {
        const int row0 = u.pm * BM + wr * 64 + fr, col0 = u.pn * BM + wc * 32 + 8 * fq;
#pragma unroll
        for (int ai = 0; ai < 2; ++ai)
#pragma unroll
            for (int m = 0; m < 4; ++m) { bf16_t* rowp = O + (size_t)(row0 + ai * HALF + m * 16) * ldc + col0;
#pragma unroll
                for (int bj = 0; bj < 2; ++bj) *(u32x4*)(rowp + bj * HALF) = pack8(acc[ai][bj][m][0], acc[ai][bj][m][1]); }
    }
};
struct EpiProj {
    static constexpr bool PERM = true, SWAP = false;
    bf16_t* O; const float* rope; bf16_t* KB;
    __device__ __forceinline__ void operator()(AccRef acc, const Unit& u, int wr, int wc, int fr, int fq) const {
        const int row0 = u.pm * BM + wr * 64 + fr, col0 = u.pn * BM + wc * 32 + 8 * fq;
        const int mode = (u.pn >= 27 && u.pn < 43) ? (u.pn < 35 ? 1 : 2) : 0;
        const float sc = (mode == 1) ? QSCALE : 1.0f;
#pragma unroll
        for (int ai = 0; ai < 2; ++ai)
#pragma unroll
            for (int m = 0; m < 4; ++m) { const int row = row0 + ai * HALF + m * 16; bf16_t* rowp = O + (size_t)row * PLD + col0;
#pragma unroll
                for (int bj = 0; bj < 2; ++bj) { f32x4 v0 = acc[ai][bj][m][0], v1 = acc[ai][bj][m][1];
                    if (mode) { const int i0 = ((col0 + bj * HALF) & 127) >> 1; const f32x4* rp = (const f32x4*)(rope + ((size_t)row * 64 + i0) * 2); const f32x4 c0 = rp[0], c1 = rp[1];
                        f32x4 o0, o1;
                        o0[0] = v0[0] * c0[0] - v0[1] * c0[1]; o0[1] = v0[1] * c0[0] + v0[0] * c0[1]; o0[2] = v0[2] * c0[2] - v0[3] * c0[3]; o0[3] = v0[3] * c0[2] + v0[2] * c0[3];
                        o1[0] = v1[0] * c1[0] - v1[1] * c1[1]; o1[1] = v1[1] * c1[0] + v1[0] * c1[1]; o1[2] = v1[2] * c1[2] - v1[3] * c1[3]; o1[3] = v1[3] * c1[2] + v1[2] * c1[3];
                        v0 = o0 * sc; v1 = o1 * sc; }
                    if (mode == 2) *(u32x4*)(KB + ((size_t)((u.pn - 35) * 2 + bj) * T + row) * MD + wc * 32 + 8 * fq) = pack8(v0, v1);
                    else *(u32x4*)(rowp + bj * HALF) = pack8(v0, v1); } }
    }
};
struct EpiVT {
    static constexpr bool PERM = false, SWAP = true;
    bf16_t* VT;
    __device__ __forceinline__ void operator()(AccRef acc, const Unit& u, int wr, int wc, int fr, int fq) const {
        const int tok0 = u.pm * BM + wr * 64 + 4 * fq, col0 = u.pn * BM + wc * 32 + fr;
#pragma unroll
        for (int ai = 0; ai < 2; ++ai)
#pragma unroll
            for (int m = 0; m < 4; ++m)
#pragma unroll
                for (int bj = 0; bj < 2; ++bj)
#pragma unroll
                    for (int n = 0; n < 2; ++n) { const f32x4 v = acc[ai][bj][m][n]; u32x2 w; w.x = pk2(v[0], v[1]); w.y = pk2(v[2], v[3]);
                        const int d = col0 + bj * HALF + n * 16, tl = (u.pm * BM + wr * 64 + ai * HALF) >> 6;
                        *(u32x2*)(VT + ((size_t)((d >> 7) * (T / 64) + tl) * MD + (d & 127)) * 64 + m * 16 + 4 * (((fq & 1) << 1) | (fq >> 1))) = w; }
    }
};
struct EpiDec {
    static constexpr bool PERM = true, SWAP = false;
    float* O; const float* w0;
    __device__ __forceinline__ void operator()(AccRef acc, const Unit& u, int wr, int wc, int fr, int fq) const {
        const int row0 = u.pm * BM + wr * 64 + fr, col0 = u.pn * BM + wc * 32 + 8 * fq;
#pragma unroll
        for (int bj = 0; bj < 2; ++bj) { const f32x4 b0 = *(const f32x4*)(w0 + col0 + bj * HALF), b1 = *(const f32x4*)(w0 + col0 + bj * HALF + 4);
#pragma unroll
            for (int ai = 0; ai < 2; ++ai)
#pragma unroll
                for (int m = 0; m < 4; ++m) { float* rowp = O + (size_t)(row0 + ai * HALF + m * 16) * RW + col0 + bj * HALF;
#pragma unroll
                    for (int n = 0; n < 2; ++n) { const f32x4 x = acc[ai][bj][m][n] + (n ? b1 : b0); f32x4 o;
#pragma unroll
                        for (int e = 0; e < 4; ++e) { const float z = -x[e]; const float sp = fmaxf(z, 0.f) + __logf(1.0f + __expf(-fabsf(z))); o[e] = __expf(-__expf(-sp - 0.5f)); }
                        *(f32x4*)(rowp + 4 * n) = o; }
                    asm volatile("" ::: "memory"); } }
    }
};
struct EpiA {
    static constexpr bool PERM = true, SWAP = false;
    bf16_t* KP; bf16_t* BB; const bf16_t* KKN; const float* a0; const float* k_a;
    __device__ __forceinline__ void operator()(AccRef acc, const Unit& u, int wr, int wc, int fr, int fq) const {
        const int row0 = u.pm * BM + wr * 64 + fr, col0 = u.pn * BM + wc * 32 + 8 * fq;
#pragma unroll
        for (int bj = 0; bj < 2; ++bj) { const int cb = col0 + bj * HALF;
            const f32x4 b0 = *(const f32x4*)(a0 + cb), b1 = *(const f32x4*)(a0 + cb + 4), ka0 = *(const f32x4*)(k_a + cb), ka1 = *(const f32x4*)(k_a + cb + 4);
#pragma unroll
            for (int ai = 0; ai < 2; ++ai)
#pragma unroll
                for (int m = 0; m < 4; ++m) { const size_t off = (size_t)(row0 + ai * HALF + m * 16) * RW + cb;
                    f32x4 zk0, zk1, kn0, kn1; unpack8(*(const u32x4*)(KP + off), zk0, zk1); unpack8(*(const u32x4*)(KKN + off), kn0, kn1);
                    f32x4 a0v, a1v;
#pragma unroll
                    for (int e = 0; e < 4; ++e) { a0v[e] = fsigmoid(acc[ai][bj][m][0][e] + b0[e]); a1v[e] = fsigmoid(acc[ai][bj][m][1][e] + b1[e]); }
                    const f32x4 kp0 = zk0 * (1.0f + (a0v - 1.0f) * ka0), kp1 = zk1 * (1.0f + (a1v - 1.0f) * ka1);
                    *(u32x4*)(KP + off) = pack8(kp0, kp1); *(u32x4*)(BB + off) = pack8(-(kn0 * a0v), -(kn1 * a1v));
                    asm volatile("" ::: "memory"); } }
    }
};
template <bool ADD> struct EpiMix {
    static constexpr bool PERM = true, SWAP = false;
    bf16_t* O; const bf16_t* proj; int gcol0;
    __device__ __forceinline__ void operator()(AccRef acc, const Unit& u, int wr, int wc, int fr, int fq) const {
        const int row0 = u.pm * BM + wr * 64 + fr, col0 = u.pn * BM + wc * 32 + 8 * fq;
#pragma unroll
        for (int ai = 0; ai < 2; ++ai)
#pragma unroll
            for (int m = 0; m < 4; ++m) { const int row = row0 + ai * HALF + m * 16;
#pragma unroll
                for (int bj = 0; bj < 2; ++bj) { f32x4 g0, g1; unpack8(*(const u32x4*)(proj + (size_t)row * PLD + gcol0 + col0 + bj * HALF), g0, g1);
                    f32x4 o0, o1;
#pragma unroll
                    for (int e = 0; e < 4; ++e) { o0[e] = fsigmoid(g0[e]) * acc[ai][bj][m][0][e]; o1[e] = fsigmoid(g1[e]) * acc[ai][bj][m][1][e]; }
                    bf16_t* op = O + (size_t)row * D + col0 + bj * HALF;
                    if (ADD) { f32x4 p0, p1; unpack8(*(const u32x4*)op, p0, p1); o0 += p0; o1 += p1; }
                    *(u32x4*)op = pack8(o0, o1); } }
    }
};
struct EpiRes {
    static constexpr bool PERM = true, SWAP = false;
    bf16_t* O; const float* x; float* rsq;
    __device__ __forceinline__ void operator()(AccRef acc, const Unit& u, int wr, int wc, int fr, int fq) const {
        const int row0 = u.pm * BM + wr * 64 + fr, col0 = u.pn * BM + wc * 32 + 8 * fq;
#pragma unroll
        for (int ai = 0; ai < 2; ++ai)
#pragma unroll
            for (int m = 0; m < 4; ++m) { const int row = row0 + ai * HALF + m * 16; const size_t off = (size_t)row * D + col0; float ss = 0.f;
#pragma unroll
                for (int bj = 0; bj < 2; ++bj) { const f32x4 a = *(const f32x4*)(x + off + bj * HALF) + acc[ai][bj][m][0], b = *(const f32x4*)(x + off + bj * HALF + 4) + acc[ai][bj][m][1];
                    ss += ((a[0] * a[0] + a[1] * a[1]) + (a[2] * a[2] + a[3] * a[3])) + ((b[0] * b[0] + b[1] * b[1]) + (b[2] * b[2] + b[3] * b[3]));
                    *(u32x4*)(O + off + bj * HALF) = pack8(a, b); }
                ss += __shfl_xor(ss, 16); ss += __shfl_xor(ss, 32);
                if (fq == 0) rsq[(size_t)row * 64 + u.pn * 4 + wc] = ss; }
    }
};
}

#define XB_TMO      128
#define XB_XCNT(j)  (256  + 64 * (j))
#define XB_XSUB(j)  (1280 + 64 * (j))
#define XB_XGEN(j)  (2304 + 64 * (j))
#define XB_TOP      3328
#define XB_TOPGEN   3392
#define XCD_BAR_WORDS 3456
#define XB_SPIN_CAP (1u << 18)
__device__ __forceinline__ unsigned xb_ld(unsigned* p)              { return __hip_atomic_load(p, __ATOMIC_RELAXED, __HIP_MEMORY_SCOPE_AGENT); }
__device__ __forceinline__ unsigned xb_add(unsigned* p, unsigned v) { return __hip_atomic_fetch_add(p, v, __ATOMIC_RELAXED, __HIP_MEMORY_SCOPE_AGENT); }
__device__ __forceinline__ unsigned xb_xcc_id() { return (unsigned)__builtin_amdgcn_s_getreg((3 << 11) | 20) & 0xFu; }
#define XB_SPIN(cond, bar) do { unsigned _sp = 0; while (cond) { __builtin_amdgcn_s_sleep(1); \
    if ((++_sp & 255u) == 0u) { if (xb_ld(&(bar)[XB_TMO])) break; if (_sp > XB_SPIN_CAP) { atomicAdd(&(bar)[XB_TMO], 1u); break; } } } } while (0)
struct XcdBarrier { unsigned* bar; unsigned x; volatile LAS unsigned* st; };
__device__ __forceinline__ XcdBarrier xcd_barrier_post(unsigned* bar, volatile LAS unsigned* st) {
    XcdBarrier b; b.bar = bar; b.x = xb_xcc_id(); b.st = st;
    if (threadIdx.x == 0) (void)xb_add(&bar[XB_XCNT(b.x)], 1u);
    return b;
}
__device__ __forceinline__ void xcd_barrier_complete(unsigned* bar, unsigned x, unsigned& nloc, unsigned& nx) {
    const unsigned G = gridDim.x * gridDim.y * gridDim.z;
    unsigned sum, cnt, mine, sp = 0u;
    for (;;) {
        sum = 0u; cnt = 0u; mine = 0u;
#pragma unroll
        for (unsigned j = 0; j < 16; ++j) { const unsigned c = xb_ld(&bar[XB_XCNT(j)]); sum += c; cnt += (c > 0u) ? 1u : 0u; mine = (j == x) ? c : mine; }
        if (sum == G) break;
        __builtin_amdgcn_s_sleep(1);
        if ((++sp & 255u) == 0u) { if (xb_ld(&bar[XB_TMO])) break; if (sp > XB_SPIN_CAP) { atomicAdd(&bar[XB_TMO], 1u); break; } }
    }
    nloc = mine > 0u ? mine : 1u; nx = cnt > 0u ? cnt : 1u;
}
__device__ __forceinline__ void xcd_barrier(const XcdBarrier& b) {
    asm volatile("s_waitcnt vmcnt(0)" ::: "memory");
    __syncthreads();
    if (threadIdx.x == 0) {
        unsigned* bar = b.bar;
        __builtin_amdgcn_s_waitcnt(0);
        unsigned nloc = b.st[0], nx = b.st[1];
        if (nloc == 0u) { xcd_barrier_complete(bar, b.x, nloc, nx); b.st[0] = nloc; b.st[1] = nx; }
        const unsigned old = xb_add(&bar[XB_XSUB(b.x)], 1u);
        const unsigned gen = old / nloc;
        if (old + 1u == (gen + 1u) * nloc) {
            __builtin_amdgcn_fence(__ATOMIC_RELEASE, "agent");
            asm volatile("s_waitcnt vmcnt(0)" ::: "memory");
            const unsigned og = xb_add(&bar[XB_TOP], 1u);
            const unsigned tg = og / nx;
            if (og + 1u == (tg + 1u) * nx) xb_add(&bar[XB_TOPGEN], 1u);
            else XB_SPIN(xb_ld(&bar[XB_TOPGEN]) == tg, bar);
            __builtin_amdgcn_fence(__ATOMIC_ACQUIRE, "agent");
            xb_add(&bar[XB_XGEN(b.x)], 1u);
            asm volatile("s_waitcnt vmcnt(0)" ::: "memory");
        } else {
            XB_SPIN(xb_ld(&bar[XB_XGEN(b.x)]) == gen, bar);
            __builtin_amdgcn_fence(__ATOMIC_ACQUIRE, "agent");
            asm volatile("s_waitcnt vmcnt(0)" ::: "memory");
        }
    }
    __syncthreads();
}

struct Args {
    const float *x, *norm1_g, *w_in, *mu, *w0, *w_up, *a0, *a_up, *g_up, *k_k, *k_a, *r_k, *lnx_g, *lnx_b, *w_ba, *w_bb, *w_out, *norm2_g, *peer_wq, *sub_keys, *peer_u, *peer_v, *final_g;
    float* out; unsigned char* ws; int ph_lo, ph_hi, li, pad;
};
#define CAS __attribute__((address_space(4)))
typedef const CAS Args* ArgsP;
__device__ __forceinline__ ArgsP get_args() { ArgsP p = (ArgsP)__builtin_amdgcn_kernarg_segment_ptr(); asm volatile("" : "+s"(p)); return p; }
struct Frame { LAS unsigned char* lds; int tid, lane, wave, vcu, G; };

__device__ __forceinline__ int win_dst(int s) {
    if (s < SHIFTW) return s;
    if (s < SHIFTW + 4096) { const int base = (s < SHIFTW + 2048) ? SHIFTW : SHIFTW + 2048; const int m = s - base, head = m >> 7, c = m & 127; const int j = (c < 64) ? 2 * c : 2 * (c - 64) + 1;
        return ((s < SHIFTW + 2048) ? PC_MQ : PC_MK) + head * 128 + j; }
    if (s < SHIFTW + 6144) return PC_MV + (s - (SHIFTW + 4096));
    if (s < SHIFTW + 6144 + 4096) return PC_GA + (s - (SHIFTW + 6144));
    return PC_GB + (s - (SHIFTW + 6144 + 4096));
}
template <bool MAPWIN> __device__ __forceinline__ void p0_transpose_item(const float* W, int K, int N, bf16_t* WT, int Kd, LAS float* scr, int item, int lane, const float* kscale = nullptr) {
    const int nblk = N / 32, kb = item / nblk, nb = item % nblk, k0 = 64 * kb, n0 = 32 * nb;
    { const int krow = lane >> 3, c4 = lane & 7; f32x4 v[8];
#pragma unroll
      for (int i = 0; i < 8; ++i) { const int kk = 8 * i + krow; v[i] = (k0 + kk < K) ? *(const f32x4*)(W + (size_t)(k0 + kk) * N + n0 + 4 * c4) : (f32x4){0.f, 0.f, 0.f, 0.f}; }
      if (kscale) {
#pragma unroll
          for (int i = 0; i < 8; ++i) { const int kk = 8 * i + krow; if (k0 + kk < K) v[i] = v[i] * kscale[k0 + kk]; } }
#pragma unroll
      for (int i = 0; i < 8; ++i) { LAS float* d = scr + (8 * i + krow) * 33 + 4 * c4; d[0] = v[i].x; d[1] = v[i].y; d[2] = v[i].z; d[3] = v[i].w; } }
    LDS_WAIT(); asm volatile("" ::: "memory");
    const int c = lane & 7;
#pragma unroll
    for (int j = 0; j < 4; ++j) { const int n = (lane >> 3) + 8 * j; const LAS float* s = scr + (8 * c) * 33 + n;
        u32x4 o; o.x = pk2(s[0 * 33], s[1 * 33]); o.y = pk2(s[2 * 33], s[3 * 33]); o.z = pk2(s[4 * 33], s[5 * 33]); o.w = pk2(s[6 * 33], s[7 * 33]);
        const int row = MAPWIN ? win_dst(n0 + n) : (n0 + n);
        *(u32x4*)(WT + (size_t)row * Kd + k0 + 8 * c) = o; }
    LDS_WAIT(); asm volatile("" ::: "memory");
}
__device__ __forceinline__ void rms_rows_to_bf16(const float* x, const float* g, bf16_t* o, int m0, int mstride, int lane) {
    const f32x4* gr = (const f32x4*)g + lane;
    f32x4 v[16], w[16];
    if (m0 < T) {
#pragma unroll
        for (int j = 0; j < 16; ++j) v[j] = ((const f32x4*)(x + (size_t)m0 * D) + lane)[64 * j]; }
    for (int m = m0; m < T; m += mstride) { const bool hasn = m + mstride < T;
        if (hasn) {
#pragma unroll
            for (int j = 0; j < 16; ++j) w[j] = ((const f32x4*)(x + (size_t)(m + mstride) * D) + lane)[64 * j]; }
        float s = 0.f;
#pragma unroll
        for (int j = 0; j < 16; ++j) s += (v[j].x * v[j].x + v[j].y * v[j].y) + (v[j].z * v[j].z + v[j].w * v[j].w);
        const float rs = 1.0f / sqrtf(wave_sum(s) * (1.0f / D) + NORM_EPS);
        u32x2* o8 = (u32x2*)(o + (size_t)m * D) + lane;
#pragma unroll
        for (int j = 0; j < 16; ++j) { const f32x4 gg = gr[64 * j]; u32x2 q; q.x = pk2(v[j].x * rs * gg.x, v[j].y * rs * gg.y); q.y = pk2(v[j].z * rs * gg.z, v[j].w * rs * gg.w); o8[64 * j] = q; }
        if (hasn) {
#pragma unroll
            for (int j = 0; j < 16; ++j) v[j] = w[j]; }
    }
}
__device__ __forceinline__ void cvt_table(const float* src, bf16_t* dst, size_t n8, size_t gtid, size_t nthr) {
    for (size_t i = gtid; i < n8; i += nthr) { const f32x4 a = ((const f32x4*)src)[2 * i], b = ((const f32x4*)src)[2 * i + 1]; ((u32x4*)dst)[i] = pg8::pack8(a, b); }
}
__device__ __forceinline__ void pq_load(ArgsP A, int row, int lane, f32x4 (&v)[16]) {
    const f32x4* src = (const f32x4*)((row >= 16384 ? A->peer_v + (size_t)(row - 16384) * D : A->peer_u + (size_t)row * D)) + lane;
#pragma unroll
    for (int j = 0; j < 16; ++j) v[j] = __builtin_nontemporal_load(src + 64 * j);
}
__device__ __forceinline__ void pq_finish(unsigned char* ws, int row, int lane, const f32x4 (&v)[16]) {
    const bool isv = row >= 16384; const int rr = isv ? row - 16384 : row; float am = 0.f;
#pragma unroll
    for (int j = 0; j < 16; ++j) am = fmaxf(fmaxf(am, fmaxf(fabsf(v[j].x), fabsf(v[j].y))), fmaxf(fabsf(v[j].z), fabsf(v[j].w)));
#pragma unroll
    for (int o = 1; o < 64; o <<= 1) am = fmaxf(am, __shfl_xor(am, o));
    const float inv = am > 0.f ? 127.0f / am : 0.f; unsigned* dst = (unsigned*)(ws + (isv ? WS_PV : WS_PU)) + (size_t)rr * (D / 4) + lane;
    constexpr float MAGIC = 8388608.0f + 128.0f;
#pragma unroll
    for (int j = 0; j < 16; ++j) { const unsigned b0 = __builtin_bit_cast(unsigned, __builtin_fmaf(v[j].x, inv, MAGIC)), b1 = __builtin_bit_cast(unsigned, __builtin_fmaf(v[j].y, inv, MAGIC)),
                                                  b2 = __builtin_bit_cast(unsigned, __builtin_fmaf(v[j].z, inv, MAGIC)), b3 = __builtin_bit_cast(unsigned, __builtin_fmaf(v[j].w, inv, MAGIC));
        dst[64 * j] = __builtin_amdgcn_perm(__builtin_amdgcn_perm(b3, b2, 0x0c0c0400u), __builtin_amdgcn_perm(b1, b0, 0x0c0c0400u), 0x05040100u); }
    if (lane == 0) ((float*)(ws + (isv ? WS_PSV : WS_PSU)))[rr] = am * (1.0f / 127.0f);
}
__device__ __forceinline__ int pq_ra(int G) { constexpr int NT1 = (T / 256) * (PLD / 256); const int nx = NT1 % G, idle = nx ? G - nx : 0, n = idle * NWAVES * 7; return n < 2 * 16384 ? n : 2 * 16384; }
__device__ __forceinline__ void peer_quant(ArgsP A, Frame& F, int r0, int r1, int w0, int wstride) {
    f32x4 v[16], w[16];
    int row = r0 + w0;
    if (row < r1) pq_load(A, row, F.lane, v);
    for (; row < r1; row += wstride) { const bool hasn = row + wstride < r1;
        if (hasn) pq_load(A, row + wstride, F.lane, w);
        pq_finish(A->ws, row, F.lane, v);
        if (hasn) {
#pragma unroll
            for (int j = 0; j < 16; ++j) v[j] = w[j]; }
    }
}
__device__ __forceinline__ void late_weights(ArgsP A, Frame& F, int w0, int wstride) {
    unsigned char* ws = A->ws;
    LAS float* scr = (LAS float*)(F.lds + RING_OFF + F.wave * 16384);
    constexpr int I_BA = 32 * 128, I_OUT = 64 * 128, I_WQ = 64 * 64, I_SK = PH_ * 2 * PNK * PHALF / 512;
    constexpr int NITEMS = 2 * I_BA + I_OUT + I_WQ + I_SK;
    for (int it = w0; it < NITEMS; it += wstride) {
        int r = it;
        if (r < I_BA) { p0_transpose_item<false>(A->w_ba, RW, D, (bf16_t*)(ws + WS_WA), RW, scr, r, F.lane); continue; } r -= I_BA;
        if (r < I_BA) { p0_transpose_item<false>(A->w_bb, RW, D, (bf16_t*)(ws + WS_WB), RW, scr, r, F.lane); continue; } r -= I_BA;
        if (r < I_OUT) { p0_transpose_item<false>(A->w_out, D, D, (bf16_t*)(ws + WS_WOUT), D, scr, r, F.lane); continue; } r -= I_OUT;
        if (r < I_WQ) { p0_transpose_item<false>(A->peer_wq, D, 2048, (bf16_t*)(ws + WS_WQ), D, scr, r, F.lane, A->norm2_g); continue; } r -= I_WQ;
        { const size_t i = (size_t)r * 64 + F.lane; const f32x4 a = ((const f32x4*)A->sub_keys)[2 * i], b = ((const f32x4*)A->sub_keys)[2 * i + 1]; ((u32x4*)(ws + WS_SUBK))[i] = pg8::pack8(a, b); }
    }
}
__device__ __forceinline__ void ph0_prologue(ArgsP A, Frame& F) {
    unsigned char* ws = A->ws;
    LAS float* scr = (LAS float*)(F.lds + RING_OFF + F.wave * 16384);
    const int gw = F.vcu * NWAVES + F.wave, NGW = F.G * NWAVES;
    constexpr int I_IN = 64 * (INW / 32), I_UP = 2 * 64, I_G = 8 * 64;
    constexpr int NITEMS = I_IN + 2 * I_UP + I_G;
    for (int it = gw; it < NITEMS; it += NGW) {
        int r = it;
        if (r < I_IN) { p0_transpose_item<true>(A->w_in, D, INW, (bf16_t*)(ws + WS_WIN), D, scr, r, F.lane); continue; } r -= I_IN;
        if (r < I_UP) { p0_transpose_item<false>(A->w_up, LW, RW, (bf16_t*)(ws + WS_WUP), LW, scr, r, F.lane); continue; } r -= I_UP;
        if (r < I_UP) { p0_transpose_item<false>(A->a_up, LA, RW, (bf16_t*)(ws + WS_AUP), LA, scr, r, F.lane); continue; } r -= I_UP;
        p0_transpose_item<false>(A->g_up, LG, RW, (bf16_t*)(ws + WS_GUP), LGP, scr, r, F.lane);
    }
    const size_t gtid = (size_t)F.vcu * NTHR + F.tid, nthr = (size_t)F.G * NTHR;
    for (size_t i = gtid; i < (size_t)32 * D / 8; i += nthr) ((u32x4*)((bf16_t*)(ws + WS_WIN) + (size_t)SHIFTW * D))[i] = (u32x4){0u, 0u, 0u, 0u};
    for (size_t i = gtid; i < (size_t)T * 64; i += nthr) { const int pos = (int)(i >> 6), fi = (int)(i & 63); const float inv = powf(10000.0f, -(float)fi / 64.0f); const float ang = (float)pos * inv;
        ((f32x2*)(ws + WS_ROPE))[i] = (f32x2){cosf(ang), sinf(ang)}; }
    rms_rows_to_bf16(A->x, A->norm1_g, (bf16_t*)(ws + WS_XN), gw, NGW, F.lane);
}

__device__ __forceinline__ f32x4 ld4bf(const bf16_t* p) { const u32x2 w = *(const u32x2*)p; return (f32x4){bflo(w.x), bfhi(w.x), bflo(w.y), bfhi(w.y)}; }
__device__ __forceinline__ void st4bf(bf16_t* p, f32x4 v) { u32x2 w; w.x = pk2(v[0], v[1]); w.y = pk2(v[2], v[3]); *(u32x2*)p = w; }
__device__ __forceinline__ void ph2_prep(ArgsP A, Frame& F) {
    unsigned char* ws = A->ws; const bf16_t* PROJ = (const bf16_t*)(ws + WS_PROJ);
    LAS float* red = (LAS float*)(F.lds + RING_OFF);
    for (int it = F.vcu; it < NBLK * MH; it += F.G) { const int n = it / MH, h = it % MH, d = F.tid & 127, part = F.tid >> 7;
        const bf16_t* p = (const bf16_t*)(ws + WS_KB) + ((size_t)h * T + n * MBLK + part * 64) * MD + d; float s = 0.f;
#pragma unroll 8
        for (int i = 0; i < 64; ++i) s += bf1(p[(size_t)i * MD]);
        red[F.tid] = s; WG_BAR();
        if (F.tid < 128) { const float m = (red[F.tid] + red[F.tid + 128] + red[F.tid + 256] + red[F.tid + 384]) * (1.0f / MBLK); const unsigned hi = f2bf(m); const float lo = m - __builtin_bit_cast(float, hi << 16);
            ((bf16_t*)(ws + WS_KMEAN))[(size_t)(h * NBLK + n) * MD + F.tid] = (bf16_t)hi; ((bf16_t*)(ws + WS_KMEAN + 131072))[(size_t)(h * NBLK + n) * MD + F.tid] = (bf16_t)f2bf(lo); }
        WG_BAR(); }
    const int tid = F.tid; const int c = 4 * tid;
    const f32x4 mu_r = *(const f32x4*)(A->mu + PC_R + c), mu_k = *(const f32x4*)(A->mu + PC_K + c), mu_v = *(const f32x4*)(A->mu + PC_V + c), kkw = *(const f32x4*)(A->k_k + c);
    int lc = 0, lcc = 0; if (tid < 32) { lcc = 4 * tid; lc = PC_WL + lcc; } else if (tid < 64) { lcc = 4 * (tid - 32); lc = PC_AL + lcc; } else { lcc = 4 * (tid - 64); lc = PC_GL + lcc; }
    const bool lact = tid < 64 || (tid < 192 && lcc < LG);
    const f32x4 mu_l = lact ? *(const f32x4*)(A->mu + lc) : (f32x4){0.f, 0.f, 0.f, 0.f};
    u32x2 cur[8], nxt[8];
    auto tload = [&](int t, u32x2 (&rg)[8]) { const bf16_t* P = PROJ + (size_t)t * PLD; const bf16_t* PP = t > 0 ? P - PLD : P;
        rg[0] = *(const u32x2*)(P + PC_R + c); rg[1] = *(const u32x2*)(PP + PC_R + c); rg[2] = *(const u32x2*)(P + PC_K + c); rg[3] = *(const u32x2*)(PP + PC_K + c);
        rg[4] = *(const u32x2*)(P + PC_V + c); rg[5] = *(const u32x2*)(PP + PC_V + c);
        if (lact) { rg[6] = *(const u32x2*)(P + lc); rg[7] = *(const u32x2*)(PP + lc); } else { rg[6] = (u32x2){0u, 0u}; rg[7] = (u32x2){0u, 0u}; } };
    auto up4 = [](u32x2 w) { return (f32x4){bflo(w.x), bfhi(w.x), bflo(w.y), bfhi(w.y)}; };
    if (F.vcu < T) tload(F.vcu, cur);
    for (int t = F.vcu; t < T; t += F.G) { const bool hasn = t + F.G < T; if (hasn) tload(t + F.G, nxt);
        const float hp = t > 0 ? 1.0f : 0.0f;
        { const f32x4 p = up4(cur[0]), pp = up4(cur[1]) * hp; st4bf((bf16_t*)(ws + WS_ZR) + (size_t)t * RW + c, p + (pp - p) * mu_r); }
        { const f32x4 p = up4(cur[2]), pp = up4(cur[3]) * hp; const f32x4 zk = p + (pp - p) * mu_k;
          st4bf((bf16_t*)(ws + WS_KP) + (size_t)t * RW + c, zk); const f32x4 kk = zk * kkw;
          const float ss = sum16((kk[0] * kk[0] + kk[1] * kk[1]) + (kk[2] * kk[2] + kk[3] * kk[3])); const float inv = 1.0f / fmaxf(sqrtf(ss), 1e-12f);
          st4bf((bf16_t*)(ws + WS_KKN) + (size_t)t * RW + c, kk * inv); }
        { const f32x4 p = up4(cur[4]), pp = up4(cur[5]) * hp; st4bf((bf16_t*)(ws + WS_ZV) + (size_t)t * RW + c, p + (pp - p) * mu_v); }
        if (tid < 192) { const f32x4 zero = (f32x4){0.f, 0.f, 0.f, 0.f};
            f32x4 z = zero; if (lact) { const f32x4 p = up4(cur[6]), pp = up4(cur[7]) * hp; z = p + (pp - p) * mu_l; }
            if (tid < 32) { f32x4 o;
#pragma unroll
                for (int e = 0; e < 4; ++e) o[e] = 1.0f - 2.0f * __builtin_amdgcn_rcpf(__expf(2.0f * z[e]) + 1.0f);
                st4bf((bf16_t*)(ws + WS_AW) + (size_t)t * LW + lcc, o); }
            else if (tid < 64) st4bf((bf16_t*)(ws + WS_AA) + (size_t)t * LA + lcc, z);
            else { f32x4 o = zero; if (lcc < LG) {
#pragma unroll
                for (int e = 0; e < 4; ++e) o[e] = fsigmoid(z[e]); }
                st4bf((bf16_t*)(ws + WS_AG) + (size_t)t * LGP + lcc, o); }
        }
        if (hasn) {
#pragma unroll
            for (int i = 0; i < 8; ++i) cur[i] = nxt[i]; }
    }
}

__device__ __forceinline__ void ph3_gate(ArgsP A, Frame& F) {
    unsigned char* ws = A->ws; const bf16_t* PROJ = (const bf16_t*)(ws + WS_PROJ); const bf16_t* KMH = (const bf16_t*)(ws + WS_KMEAN); const bf16_t* KML = (const bf16_t*)(ws + WS_KMEAN + 131072); unsigned* MASK = (unsigned*)(ws + WS_MASK);
    const int gw = F.vcu * NWAVES + F.wave, NGW = F.G * NWAVES; const int r = F.lane & 31, hh = F.lane >> 5; const float NEG = -__builtin_inff();
    for (int it = gw; it < (T / 32) * MH; it += NGW) { const int tg = it >> 4, h = it & 15, t = tg * 32 + r, blk = tg >> 3;
        if (blk == 0) { if (hh == 0) MASK[t * MH + h] = 0u; continue; }
        f32x16 acc;
#pragma unroll
        for (int e = 0; e < 16; ++e) acc[e] = 0.f;
#pragma unroll
        for (int ks = 0; ks < 8; ++ks) { const bf16x8 q = *(const bf16x8*)(PROJ + (size_t)t * PLD + PC_MQ + h * MD + 16 * ks + 8 * hh); const size_t ko = (size_t)(h * NBLK + r) * MD + 16 * ks + 8 * hh;
            acc = __builtin_amdgcn_mfma_f32_32x32x16_bf16(*(const bf16x8*)(KMH + ko), q, acc, 0, 0, 0); acc = __builtin_amdgcn_mfma_f32_32x32x16_bf16(*(const bf16x8*)(KML + ko), q, acc, 0, 0, 0); }
        float t0 = NEG, t1 = NEG, t2 = NEG;
#pragma unroll
        for (int e = 0; e < 16; ++e) { const int n = (e & 3) + 8 * (e >> 2) + 4 * hh; float ae = acc[e]; asm volatile("" : "+v"(ae));
            float x = __builtin_bit_cast(float, (__builtin_bit_cast(unsigned, ae) & ~31u) | (unsigned)(31 - n)); x = (n < blk) ? x : NEG;
            t2 = __builtin_amdgcn_fmed3f(t1, t2, x); t1 = __builtin_amdgcn_fmed3f(t0, t1, x); t0 = fmaxf(t0, x); }
        const float o0 = __shfl_xor(t0, 32), o1 = __shfl_xor(t1, 32), o2 = __shfl_xor(t2, 32);
        t2 = __builtin_amdgcn_fmed3f(t1, t2, o0); t1 = __builtin_amdgcn_fmed3f(t0, t1, o0); t0 = fmaxf(t0, o0);
        t2 = __builtin_amdgcn_fmed3f(t1, t2, o1); t1 = __builtin_amdgcn_fmed3f(t0, t1, o1); t0 = fmaxf(t0, o1);
        t2 = __builtin_amdgcn_fmed3f(t1, t2, o2); t1 = __builtin_amdgcn_fmed3f(t0, t1, o2); t0 = fmaxf(t0, o2);
        unsigned sel = 1u << (31 - (__builtin_bit_cast(unsigned, t0) & 31u));
        if (blk > 1) sel |= 1u << (31 - (__builtin_bit_cast(unsigned, t1) & 31u));
        if (blk > 2) sel |= 1u << (31 - (__builtin_bit_cast(unsigned, t2) & 31u));
        if (hh == 0) MASK[t * MH + h] = sel;
        { gu32* cnt = (gu32*)(ws + WS_CTL) + CW_CNT + h * 32; unsigned short* lst = (unsigned short*)(ws + WS_LIST) + (size_t)h * 32 * 8192; const unsigned mysel = hh == 0 ? sel : 0u;
          unsigned mycnt = 0u;
          for (int j = 0; j < blk; ++j) { const unsigned long long bal = __ballot((mysel >> j) & 1u); const unsigned c = (unsigned)__builtin_popcountll(bal); mycnt = (F.lane == j) ? c : mycnt; }
          unsigned base = 0u; if (F.lane < blk && mycnt) base = __hip_atomic_fetch_add(cnt + F.lane, mycnt, __ATOMIC_RELAXED, __HIP_MEMORY_SCOPE_AGENT);
          for (int j = 0; j < blk; ++j) { const unsigned long long bal = __ballot((mysel >> j) & 1u); const unsigned bj = (unsigned)__builtin_amdgcn_readlane((int)base, j);
              if ((mysel >> j) & 1u) { const unsigned off = __builtin_amdgcn_mbcnt_hi((unsigned)(bal >> 32), __builtin_amdgcn_mbcnt_lo((unsigned)bal, 0u)); const unsigned slot = (unsigned)__builtin_popcount(mysel & ((1u << j) - 1u));
                  lst[(size_t)j * 8192 + bj + off] = (unsigned short)((unsigned)t | (slot << 13)); } } } }
}

constexpr int CK = 64, NCHK = T / CK, CP = 144, CPF = 272;
constexpr int L_AT = 0, L_BT = 9216, L_KT = 18432, L_RT = 27648, L_ATT = 36864, L_BTT = 46080, L_V = 55296, L_MKA = 64512, L_MBRT = 73728, L_MKRT = 82944, L_A2 = 92160, L_MBA = 101376, L_PC = 118784, L_WT = 119040, L_MBH = 121088, L_TD = 130304, L_PT = 134912, L_CEND = 139520;
constexpr int L_TT = L_AT, L_A1 = L_BT, L_Y2T = L_MKA, L_G2T = L_ATT;
static_assert(L_CEND <= RING_BYTES, "chunk prep LDS");
constexpr size_t CHW_ITEM = 32768;
__device__ __forceinline__ f32x16 nt_quad(const LAS unsigned char* X, const LAS unsigned char* Y, int qp, int qq, int r, int hh) {
    f32x16 acc;
#pragma unroll
    for (int e = 0; e < 16; ++e) acc[e] = 0.f;
#pragma unroll
    for (int ks = 0; ks < 4; ++ks) { const bf16x8 a = *(const LAS bf16x8*)(Y + (32 * qq + r) * CP + 32 * ks + 16 * hh), b = *(const LAS bf16x8*)(X + (32 * qp + r) * CP + 32 * ks + 16 * hh);
        acc = __builtin_amdgcn_mfma_f32_32x32x16_bf16(a, b, acc, 0, 0, 0); }
    return acc;
}
__device__ __forceinline__ int nt_q(int qq, int e, int hh) { return 32 * qq + (e & 3) + 8 * (e >> 2) + 4 * hh; }
__device__ __forceinline__ void nt_store_bf16(LAS unsigned char* O, int p, int qq, int hh, const f32x16& v) {
#pragma unroll
    for (int g = 0; g < 4; ++g) { u32x2 w; w.x = pk2(v[4 * g], v[4 * g + 1]); w.y = pk2(v[4 * g + 2], v[4 * g + 3]); *(LAS u32x2*)(O + p * CP + (32 * qq + 8 * g + 4 * hh) * 2) = w; }
}
__device__ __forceinline__ void ph4_chunkprep(ArgsP A, Frame& F) {
    unsigned char* ws = A->ws;
    const float* DEC = (const float*)(ws + WS_DEC); const bf16_t* KKN = (const bf16_t*)(ws + WS_KKN); const bf16_t* BBg = (const bf16_t*)(ws + WS_BB); const bf16_t* KPg = (const bf16_t*)(ws + WS_KP);
    const bf16_t* ZR = (const bf16_t*)(ws + WS_ZR); const bf16_t* ZV = (const bf16_t*)(ws + WS_ZV); float* Yg = (float*)(ws + WS_Y); unsigned char* CHW = ws + WS_WIN;
    LAS unsigned char* L = F.lds + RING_OFF; const int wave = F.wave, lane = F.lane, r = lane & 31, hh = lane >> 5;
    const int prod = wave >> 2, qp = (wave >> 1) & 1, qq = wave & 1, p = 32 * qp + r;
    float nwv[8]; unsigned nkk[4], nbb[4], nkp[4], nr[4], nv[4];
    auto request = [&](int h2, int c2) {
#pragma unroll
        for (int k = 0; k < 8; ++k) nwv[k] = DEC[(size_t)(c2 * CK + 8 * wave + k) * RW + (size_t)h2 * RN + lane];
#pragma unroll
        for (int i = 0; i < 4; ++i) { const size_t o = (size_t)(c2 * CK + 8 * wave + 2 * i + hh) * RW + (size_t)h2 * RN + 2 * r;
            nkk[i] = *(const unsigned*)(KKN + o); nbb[i] = *(const unsigned*)(BBg + o); nkp[i] = *(const unsigned*)(KPg + o); nr[i] = *(const unsigned*)(ZR + o); nv[i] = *(const unsigned*)(ZV + o); } };
    if (F.vcu < RH * NCHK) request(F.vcu / NCHK, F.vcu % NCHK);
    if (F.vcu == 0 && wave == 0) {
        const gu32* cnt = (const gu32*)(ws + WS_CTL) + CW_CNT; unsigned* ud = (unsigned*)(ws + WS_UDESC); unsigned np[8], tot = 0u;
#pragma unroll
        for (int k = 0; k < 8; ++k) { const unsigned c = __hip_atomic_load(cnt + 8 * lane + k, __ATOMIC_RELAXED, __HIP_MEMORY_SCOPE_AGENT); np[k] = (c + 255u) >> 8; tot += np[k]; }
        unsigned incl = tot;
#pragma unroll
        for (int o = 1; o < 64; o <<= 1) { const unsigned v = __shfl_up(incl, o); if (lane >= o) incl += v; }
        unsigned pos = incl - tot;
#pragma unroll
        for (int k = 0; k < 8; ++k) { const unsigned c = __hip_atomic_load(cnt + 8 * lane + k, __ATOMIC_RELAXED, __HIP_MEMORY_SCOPE_AGENT); for (unsigned ps = 0; ps < np[k]; ++ps) { ud[1 + 2 * pos] = (unsigned)(8 * lane + k) | (ps << 16); ud[2 + 2 * pos] = c; ++pos; } }
        if (lane == 63) ud[0] = incl; }
    for (int item = F.vcu; item < RH * NCHK; item += F.G) { const int h = item / NCHK, c = item % NCHK; const size_t hc = (size_t)h * RN; const int t0 = c * CK;
        { float wv[8], kkv[8], bbv[8], kpv[8], rv[8]; unsigned vv[8];
#pragma unroll
          for (int k = 0; k < 8; ++k) { const int src = ((k & 1) << 7) | ((lane >> 1) << 2); const bool odd = lane & 1;
              auto mine = [&](unsigned x) { const unsigned w = (unsigned)__builtin_amdgcn_ds_bpermute(src, (int)x); return odd ? (w & 0xffff0000u) : (w << 16); };
              wv[k] = nwv[k]; kkv[k] = __builtin_bit_cast(float, mine(nkk[k >> 1])); bbv[k] = __builtin_bit_cast(float, mine(nbb[k >> 1])); kpv[k] = __builtin_bit_cast(float, mine(nkp[k >> 1]));
              rv[k] = __builtin_bit_cast(float, mine(nr[k >> 1])); vv[k] = mine(nv[k >> 1]) >> 16; }
          { const int nit = item + F.G; if (nit < RH * NCHK) request(nit / NCHK, nit % NCHK); }
          float pl[8]; pl[0] = wv[0];
#pragma unroll
          for (int k = 1; k < 8; ++k) pl[k] = pl[k - 1] * wv[k];
          ((LAS float*)(L + L_WT))[wave * 64 + lane] = pl[7];
          WG_BAR();
          float pre = 1.f;
#pragma unroll
          for (int w2 = 0; w2 < 7; ++w2) { const float x = ((const LAS float*)(L + L_WT))[w2 * 64 + lane]; pre = (w2 < wave) ? pre * x : pre; }
          unsigned atp[4], btp[4], vtp[4];
#pragma unroll
          for (int k = 0; k < 8; ++k) { const float Pt = pre * pl[k], Pm = (k == 0) ? pre : pre * pl[k - 1], ip = __builtin_amdgcn_rcpf(Pt); const int t = 8 * wave + k;
              const unsigned a16 = f2bf(Pm * kkv[k]), b16 = f2bf(bbv[k] * ip), k16 = f2bf(kpv[k] * ip), r16 = f2bf(Pt * rv[k]);
              *(LAS bf16_t*)(L + L_AT + t * CP + 2 * lane) = (bf16_t)a16; *(LAS bf16_t*)(L + L_BT + t * CP + 2 * lane) = (bf16_t)b16; *(LAS bf16_t*)(L + L_KT + t * CP + 2 * lane) = (bf16_t)k16; *(LAS bf16_t*)(L + L_RT + t * CP + 2 * lane) = (bf16_t)r16;
              if (k & 1) { atp[k >> 1] |= a16 << 16; btp[k >> 1] |= b16 << 16; vtp[k >> 1] |= vv[k] << 16; } else { atp[k >> 1] = a16; btp[k >> 1] = b16; vtp[k >> 1] = vv[k]; }
              if (wave == 7 && k == 7) ((LAS float*)(L + L_PC))[lane] = Pt; }
          *(LAS u32x4*)(L + L_ATT + lane * CP + 16 * wave) = (u32x4){atp[0], atp[1], atp[2], atp[3]}; *(LAS u32x4*)(L + L_BTT + lane * CP + 16 * wave) = (u32x4){btp[0], btp[1], btp[2], btp[3]};
          *(LAS u32x4*)(L + L_V + lane * CP + 16 * wave) = (u32x4){vtp[0], vtp[1], vtp[2], vtp[3]}; }
        WG_BAR();
        { const f32x16 v = nt_quad(L + (prod ? L_KT : L_BT), L + L_AT, qp, qq, r, hh); f32x16 m;
#pragma unroll
          for (int e = 0; e < 16; ++e) m[e] = nt_q(qq, e, hh) > p ? v[e] : 0.f;
          if (prod == 0) {
#pragma unroll
              for (int g = 0; g < 4; ++g) *(LAS f32x4*)(L + L_MBA + p * CPF + (32 * qq + 8 * g + 4 * hh) * 4) = (f32x4){m[4 * g], m[4 * g + 1], m[4 * g + 2], m[4 * g + 3]}; }
          if (prod == 0) nt_store_bf16(L + L_MBH, p, qq, hh, m);
          else nt_store_bf16(L + L_MKA, p, qq, hh, m); }
        { const f32x16 v = nt_quad(L + L_RT, L + (prod ? L_KT : L_BT), qp, qq, r, hh); f32x16 m;
#pragma unroll
          for (int e = 0; e < 16; ++e) m[e] = nt_q(qq, e, hh) <= p ? v[e] : 0.f;
          nt_store_bf16(L + (prod ? L_MKRT : L_MBRT), p, qq, hh, m); }
        WG_BAR();
        { const int t = 8 * wave + (lane >> 3), g = lane & 7, base = 32 * (t >> 5); float T4[4] = {0.f, 0.f, 0.f, 0.f};
          const LAS unsigned char* mrow = L + L_MBA + (base + 4 * g) * 4;
          f32x4 m = *(const LAS f32x4*)(mrow + (base + 31) * CPF);
#pragma unroll 1
          for (int Sx = 7; Sx >= 0; --Sx) {
#pragma unroll
              for (int q = 3; q >= 0; --q) { const int sl = 4 * Sx + q, sr = base + sl, sn = sl > 0 ? sr - 1 : sr; const f32x4 n = *(const LAS f32x4*)(mrow + sn * CPF);
                  float part = (m[0] * T4[0] + m[1] * T4[1]) + (m[2] * T4[2] + m[3] * T4[3]);
                  part += dpp_f<0xB1>(part); part += dpp_f<0x4E>(part); part += dpp_f<0x141>(part);
                  const float val = (sr == t) ? 1.0f : part; T4[q] = (g == Sx) ? val : T4[q]; m = n; } }
          const unsigned w0 = pk2(T4[0], T4[1]), w1 = pk2(T4[2], T4[3]);
          *(LAS u32x2*)(L + L_TT + t * CP + (base + 4 * g) * 2) = (u32x2){w0, w1};
          if (base == 0) { *(LAS u32x2*)(L + L_TT + t * CP + (32 + 4 * g) * 2) = (u32x2){0u, 0u};
              *(LAS bf16_t*)(L + L_TD + (4 * g) * CP + 2 * t) = (bf16_t)(w0 & 0xffffu); *(LAS bf16_t*)(L + L_TD + (4 * g + 1) * CP + 2 * t) = (bf16_t)(w0 >> 16);
              *(LAS bf16_t*)(L + L_TD + (4 * g + 2) * CP + 2 * t) = (bf16_t)(w1 & 0xffffu); *(LAS bf16_t*)(L + L_TD + (4 * g + 3) * CP + 2 * t) = (bf16_t)(w1 >> 16); } }
        WG_BAR();
        if (wave == 0) {
            f32x16 acc;
#pragma unroll
            for (int e = 0; e < 16; ++e) acc[e] = 0.f;
#pragma unroll
            for (int ks = 0; ks < 2; ++ks) { const bf16x8 a = *(const LAS bf16x8*)(L + L_MBH + r * CP + 64 + 32 * ks + 16 * hh), b = *(const LAS bf16x8*)(L + L_TT + (32 + r) * CP + 64 + 32 * ks + 16 * hh);
                acc = __builtin_amdgcn_mfma_f32_32x32x16_bf16(a, b, acc, 0, 0, 0); }
            nt_store_bf16(L + L_PT, r, 0, hh, acc);
            LDS_WAIT(); asm volatile("" ::: "memory");
#pragma unroll
            for (int e = 0; e < 16; ++e) acc[e] = 0.f;
#pragma unroll
            for (int ks = 0; ks < 2; ++ks) { const bf16x8 a = *(const LAS bf16x8*)(L + L_TD + r * CP + 32 * ks + 16 * hh), b = *(const LAS bf16x8*)(L + L_PT + r * CP + 32 * ks + 16 * hh);
                acc = __builtin_amdgcn_mfma_f32_32x32x16_bf16(a, b, acc, 0, 0, 0); }
            nt_store_bf16(L + L_TT, 32 + r, 0, hh, acc);
        }
        WG_BAR();
        { const f32x16 v = nt_quad(L + (prod ? L_MKA : L_ATT), L + L_TT, qp, qq, r, hh);
          nt_store_bf16(L + (prod ? L_A2 : L_A1), p, qq, hh, v); }
        WG_BAR();
        unsigned char* cw = CHW + (size_t)item * CHW_ITEM;
        { const f32x16 v = nt_quad(L + L_MBRT, L + (prod ? L_A2 : L_A1), qp, qq, r, hh); f32x16 o;
          const LAS unsigned char* addm = L + (prod ? L_MKRT : L_RT);
#pragma unroll
          for (int g = 0; g < 4; ++g) { const u32x2 w = *(const LAS u32x2*)(addm + p * CP + (32 * qq + 8 * g + 4 * hh) * 2); o[4 * g] = v[4 * g] + bflo(w.x); o[4 * g + 1] = v[4 * g + 1] + bfhi(w.x); o[4 * g + 2] = v[4 * g + 2] + bflo(w.y); o[4 * g + 3] = v[4 * g + 3] + bfhi(w.y); }
          if (prod) nt_store_bf16(L + L_Y2T, p, qq, hh, o);
          else {
#pragma unroll
              for (int g = 0; g < 4; ++g) { u32x2 w; w.x = pk2(o[4 * g], o[4 * g + 1]); w.y = pk2(o[4 * g + 2], o[4 * g + 3]); *(u32x2*)(cw + (size_t)p * 128 + (32 * qq + 8 * g + 4 * hh) * 2) = w; } } }
        { const f32x16 v = nt_quad(L + L_BTT, L + (prod ? L_A2 : L_A1), qp, qq, r, hh); const float pc = ((const LAS float*)(L + L_PC))[p]; f32x16 o;
          if (prod) {
#pragma unroll
              for (int e = 0; e < 16; ++e) o[e] = (v[e] + bf1(*(const LAS bf16_t*)(L + L_KT + nt_q(qq, e, hh) * CP + 2 * p))) * pc;
              nt_store_bf16(L + L_G2T, p, qq, hh, o); }
          else {
#pragma unroll
              for (int e = 0; e < 16; ++e) o[e] = (v[e] + (nt_q(qq, e, hh) == p ? 1.0f : 0.0f)) * pc;
#pragma unroll
              for (int g = 0; g < 4; ++g) { u32x2 w; w.x = pk2(o[4 * g], o[4 * g + 1]); w.y = pk2(o[4 * g + 2], o[4 * g + 3]); *(u32x2*)(cw + 8192 + (size_t)p * 128 + (32 * qq + 8 * g + 4 * hh) * 2) = w; } } }
        WG_BAR();
        { const f32x16 v = prod ? nt_quad(L + L_V, L + L_G2T, qp, qq, r, hh) : nt_quad(L + L_Y2T, L + L_V, qp, qq, r, hh);
          float* dst = prod ? (float*)(cw + 16384) + (size_t)p * 64 : Yg + (size_t)(t0 + p) * RW + hc;
#pragma unroll
          for (int g = 0; g < 4; ++g) *(f32x4*)(dst + 32 * qq + 8 * g + 4 * hh) = (f32x4){v[4 * g], v[4 * g + 1], v[4 * g + 2], v[4 * g + 3]}; }
        WG_BAR();
    }
}
__device__ __forceinline__ void ph5_chain(ArgsP A, Frame& F, int h) {
    unsigned char* ws = A->ws; float* Yg = (float*)(ws + WS_Y); const unsigned char* CHW = ws + WS_WIN;
    LAS unsigned char* L = F.lds + RING_OFF; const int wave = F.wave, lane = F.lane, tid = F.tid, r = lane & 31, hh = lane >> 5;
    const int prod = wave >> 2, qp = (wave >> 1) & 1, qq = wave & 1, p = 32 * qp + r; const size_t hc = (size_t)h * RN;
    constexpr int L_S = 0, L_G = 2 * 9216, L_Y1 = 3 * 9216;
    for (int i = tid; i < 2 * 9216 / 4; i += NTHR) ((LAS unsigned*)(L + L_S))[i] = 0u;
    const int srow = tid >> 3, sc16 = tid & 7; u32x4 sg, sy;
    auto stage_ld = [&](int c) { const unsigned char* cw = CHW + (size_t)(h * NCHK + c) * CHW_ITEM; sy = *(const u32x4*)(cw + srow * 128 + sc16 * 16); sg = *(const u32x4*)(cw + 8192 + srow * 128 + sc16 * 16); };
    f32x4 nad[4];
    auto ad_ld = [&](int c) { const unsigned char* cw2 = CHW + (size_t)(h * NCHK + c) * CHW_ITEM; const float* addp = prod ? Yg + (size_t)(c * CK + p) * RW + hc : (const float*)(cw2 + 16384) + (size_t)p * 64;
#pragma unroll
        for (int g = 0; g < 4; ++g) nad[g] = *(const f32x4*)(addp + 32 * qq + 8 * g + 4 * hh); };
    stage_ld(0); ad_ld(0);
    int sb = 0;
    for (int c = 0; c < NCHK; ++c) {
        *(LAS u32x4*)(L + L_Y1 + srow * CP + sc16 * 16) = sy; *(LAS u32x4*)(L + L_G + srow * CP + sc16 * 16) = sg;
        const unsigned char* cw = CHW + (size_t)(h * NCHK + c) * CHW_ITEM;
        f32x4 ad[4];
#pragma unroll
        for (int g = 0; g < 4; ++g) ad[g] = nad[g];
        if (c + 1 < NCHK) { stage_ld(c + 1); ad_ld(c + 1); }
        WG_BAR();
        const f32x16 v = prod ? nt_quad(L + L_Y1, L + L_S + sb * 9216, qp, qq, r, hh) : nt_quad(L + L_S + sb * 9216, L + L_G, qp, qq, r, hh);
        f32x16 o;
#pragma unroll
        for (int g = 0; g < 4; ++g) { o[4 * g] = v[4 * g] + ad[g][0]; o[4 * g + 1] = v[4 * g + 1] + ad[g][1]; o[4 * g + 2] = v[4 * g + 2] + ad[g][2]; o[4 * g + 3] = v[4 * g + 3] + ad[g][3]; }
        if (prod) { float* yp = Yg + (size_t)(c * CK + p) * RW + hc;
#pragma unroll
            for (int g = 0; g < 4; ++g) *(f32x4*)(yp + 32 * qq + 8 * g + 4 * hh) = (f32x4){o[4 * g], o[4 * g + 1], o[4 * g + 2], o[4 * g + 3]}; }
        else nt_store_bf16(L + L_S + (sb ^ 1) * 9216, p, qq, hh, o);
        sb ^= 1;
        WG_BAR();
    }
}

__device__ __forceinline__ void ph5_ypost(ArgsP A, Frame& F) {
    unsigned char* ws = A->ws; const float* Y = (const float*)(ws + WS_Y); const bf16_t* ZR = (const bf16_t*)(ws + WS_ZR); const bf16_t* KP = (const bf16_t*)(ws + WS_KP); const bf16_t* ZV = (const bf16_t*)(ws + WS_ZV);
    const bf16_t* G = (const bf16_t*)(ws + WS_G); bf16_t* YA = (bf16_t*)(ws + WS_YA);
    const int gw = F.vcu * NWAVES + F.wave, NGW = F.G * NWAVES;
    const int c = F.wave * 256 + 4 * F.lane; const f32x4 rk = *(const f32x4*)(A->r_k + c), lg = *(const f32x4*)(A->lnx_g + c), lb = *(const f32x4*)(A->lnx_b + c);
    for (int tg = F.vcu; tg < T / 32; tg += F.G) for (int tq = 0; tq < 32; tq += 4) {
        f32x4 y[4]; u32x2 rr[4], kk[4], vv[4], gg[4];
#pragma unroll
        for (int u = 0; u < 4; ++u) { const size_t o = (size_t)(tg * 32 + tq + u) * RW + c; y[u] = *(const f32x4*)(Y + o); rr[u] = *(const u32x2*)(ZR + o); kk[u] = *(const u32x2*)(KP + o); vv[u] = *(const u32x2*)(ZV + o); gg[u] = *(const u32x2*)(G + o); }
#pragma unroll
        for (int u = 0; u < 4; ++u) { const size_t o = (size_t)(tg * 32 + tq + u) * RW + c;
            const float mean = sum16((y[u][0] + y[u][1]) + (y[u][2] + y[u][3])) * (1.0f / 64.0f); const f32x4 d = y[u] - mean;
            const float var = sum16((d[0] * d[0] + d[1] * d[1]) + (d[2] * d[2] + d[3] * d[3])) * (1.0f / 64.0f); const float rs = 1.0f / sqrtf(var + LNX_EPS);
            const f32x4 r = (f32x4){bflo(rr[u].x), bfhi(rr[u].x), bflo(rr[u].y), bfhi(rr[u].y)}, k = (f32x4){bflo(kk[u].x), bfhi(kk[u].x), bflo(kk[u].y), bfhi(kk[u].y)};
            const f32x4 v = (f32x4){bflo(vv[u].x), bfhi(vv[u].x), bflo(vv[u].y), bfhi(vv[u].y)}, g = (f32x4){bflo(gg[u].x), bfhi(gg[u].x), bflo(gg[u].y), bfhi(gg[u].y)};
            const f32x4 rkk = r * k * rk; const float bonus = sum16((rkk[0] + rkk[1]) + (rkk[2] + rkk[3]));
            st4bf(YA + o, (d * rs * lg + lb + bonus * v) * g); } }
}

constexpr int AT_KB = 64 * 256, AT_VB = 128 * 128, AT_BUF = AT_KB + AT_VB;
static_assert(3 * AT_BUF <= RING_BYTES, "attention LDS");
__device__ __forceinline__ void q8_load(u32x4 (&q)[8], const void* p) {
    asm volatile("global_load_dwordx4 %0, %8, off\n\tglobal_load_dwordx4 %1, %8, off offset:32\n\tglobal_load_dwordx4 %2, %8, off offset:64\n\tglobal_load_dwordx4 %3, %8, off offset:96\n\t"
                 "global_load_dwordx4 %4, %8, off offset:128\n\tglobal_load_dwordx4 %5, %8, off offset:160\n\tglobal_load_dwordx4 %6, %8, off offset:192\n\tglobal_load_dwordx4 %7, %8, off offset:224"
                 : "=&v"(q[0]), "=&v"(q[1]), "=&v"(q[2]), "=&v"(q[3]), "=&v"(q[4]), "=&v"(q[5]), "=&v"(q[6]), "=&v"(q[7]) : "v"(p) : "memory"); }
__device__ __forceinline__ void q8_settle(u32x4 (&q)[8]) {
#pragma unroll
    for (int i = 0; i < 8; ++i) asm volatile("" : "+v"(q[i])); }
__device__ __forceinline__ unsigned u16_load(const void* p) { unsigned v; asm volatile("global_load_ushort %0, %1, off" : "=&v"(v) : "v"(p) : "memory"); return v; }
__device__ __forceinline__ void ph5_attn(ArgsP A, Frame& F) {
    unsigned char* ws = A->ws; const bf16_t* PROJ = (const bf16_t*)(ws + WS_PROJ); const bf16_t* VT = (const bf16_t*)(ws + WS_VT); const bf16_t* KBp = (const bf16_t*)(ws + WS_KB);
    bf16_t* PO = (bf16_t*)(ws + WS_PARTO); float* PML = (float*)(ws + WS_PARTML); const unsigned short* LST = (const unsigned short*)(ws + WS_LIST); const unsigned* UD = (const unsigned*)(ws + WS_UDESC);
    LAS unsigned char* L = F.lds + RING_OFF; const int wave = F.wave, lane = F.lane, r = lane & 31, hh = lane >> 5;
    const float NEG = -__builtin_inff();
    const int NA = MH * NBLK, N = NA + (int)UD[0], w = F.vcu, nfree = F.G - RH; const bool chainwg = w < RH;
    auto unit_of = [&](int k) { return k * nfree + (w - RH); };
    int k = 0;
    if (chainwg) return;
    if (unit_of(k) >= N) return;
    int h, kblk, qtok, slot; bool typeA, valid, wvalid;
    { const int u = unit_of(k); typeA = u < NA;
      if (typeA) { h = u & 15; kblk = u >> 4; qtok = kblk * MBLK + wave * 32 + r; slot = 3; valid = true; wvalid = true; }
      else { const unsigned d = UD[1 + 2 * (u - NA)]; const int cnt = (int)UD[2 + 2 * (u - NA)]; const int Lx = (int)(d & 0xffffu), ps = (int)(d >> 16); h = Lx >> 5; kblk = Lx & 31;
          const int idx = ps * 256 + wave * 32 + r; valid = idx < cnt; wvalid = ps * 256 + wave * 32 < cnt; unsigned e = u16_load(LST + (size_t)Lx * 8192 + (valid ? idx : 0));
          asm volatile("s_waitcnt vmcnt(0)" ::: "memory"); asm volatile("" : "+v"(e)); qtok = (int)(e & 0x1fffu); slot = (int)(e >> 13); }
      h = __builtin_amdgcn_readfirstlane(h); kblk = __builtin_amdgcn_readfirstlane(kblk); }
    u32x4 qf[8], qfn[8];
    q8_load(qf, PROJ + (size_t)qtok * PLD + PC_MQ + h * MD + 8 * hh);
    const int krow_ = lane >> 4, kslot = lane & 15, vrow_ = lane >> 3, vslot = lane & 7;
    auto dma_tile = [&](int hd, int kb_, int n, int b3) { const int tb = kb_ * MBLK + n * 64; LAS unsigned char* B = L + b3 * AT_BUF;
#pragma unroll
        for (int i = 0; i < 2; ++i) { const int p = wave * 2 + i, row = 4 * p + krow_, c = kslot ^ (row & 15);
            __builtin_amdgcn_global_load_lds((const unsigned*)(KBp + ((size_t)hd * T + tb + row) * MD + 8 * c), (LAS unsigned*)(B + p * 1024), 16, 0, 0); }
#pragma unroll
        for (int i = 0; i < 2; ++i) { const int p = wave * 2 + i, row = 8 * p + vrow_, c = vslot ^ ((row >> 1) & 7);
            __builtin_amdgcn_global_load_lds((const unsigned*)(VT + ((size_t)(hd * (T / 64) + kb_ * 4 + n) * MD + row) * 64 + 8 * c), (LAS unsigned*)(B + AT_KB + p * 1024), 16, 0, 0); } };
    dma_tile(h, kblk, 0, 0); dma_tile(h, kblk, 1, 1);
    asm volatile("s_waitcnt vmcnt(4)" ::: "memory"); q8_settle(qf); WG_BAR();
    int b3 = 0;
    for (;;) {
        const int un = unit_of(k + 1); const bool has_next = un < N, nA = un < NA;
        int hN = 0, kblkN = 0, qtokN = 0, slotN = 3, LxN = 0, idxN = 0, cntN = 0; bool validN = true, wvalidN = true; unsigned udw = 0u, udc = 0u, entN = 0u;
        f32x16 o[4];
#pragma unroll
        for (int db = 0; db < 4; ++db)
#pragma unroll
            for (int e = 0; e < 16; ++e) o[db][e] = 0.f;
        float mrun = NEG, lrun = 0.f;
#pragma unroll
        for (int n = 0; n < 4; ++n) {
            if (has_next) {
                if (n == 0) { if (nA) { hN = un & 15; kblkN = un >> 4; } else { udw = UD[1 + 2 * (un - NA)]; udc = UD[2 + 2 * (un - NA)]; } }
                if (n == 1) { if (nA) { qtokN = kblkN * MBLK + wave * 32 + r; } else { LxN = (int)(udw & 0xffffu); const int ps = (int)(udw >> 16); cntN = (int)udc; hN = LxN >> 5; kblkN = LxN & 31;
                                  idxN = ps * 256 + wave * 32 + r; validN = idxN < cntN; wvalidN = ps * 256 + wave * 32 < cntN; entN = u16_load(LST + (size_t)LxN * 8192 + (validN ? idxN : 0)); }
                              hN = __builtin_amdgcn_readfirstlane(hN); kblkN = __builtin_amdgcn_readfirstlane(kblkN); }
                if (n == 2) { if (!nA) { qtokN = (int)(entN & 0x1fffu); slotN = (int)(entN >> 13); }
                              q8_load(qfn, PROJ + (size_t)qtokN * PLD + PC_MQ + hN * MD + 8 * hh); }
            }
            const int bn = b3 >= 1 ? b3 - 1 : 2; bool issued = false;
            if (n < 2) { dma_tile(h, kblk, n + 2, bn); issued = true; } else if (has_next) { dma_tile(hN, kblkN, n - 2, bn); issued = true; }
            const bool need = typeA ? (n <= (wave >> 1)) : wvalid;
            if (need) {
                const LAS unsigned char* KB = L + b3 * AT_BUF; const LAS unsigned char* VB = KB + AT_KB;
                const bool msk = typeA && 64 * n + 63 > wave * 32; const int qrel = wave * 32 + r;
                auto qk = [&](int kb) { f32x16 a;
#pragma unroll
                    for (int e = 0; e < 16; ++e) a[e] = 0.f;
#pragma unroll
                    for (int ks = 0; ks < 8; ++ks) { const bf16x8 kf = *(const LAS bf16x8*)(KB + (32 * kb + r) * 256 + (((2 * ks + hh) ^ (r & 15)) << 4)); a = __builtin_amdgcn_mfma_f32_32x32x16_bf16(kf, __builtin_bit_cast(bf16x8, qf[ks]), a, 0, 0, 0); }
                    return a; };
                auto causal = [&](f32x16& a, int kb) {
#pragma unroll
                    for (int e = 0; e < 16; ++e) { const int krel = 64 * n + 32 * kb + (e & 3) + 8 * (e >> 2) + 4 * hh; if (krel > qrel) a[e] = NEG; } };
                auto rescale = [&](float alpha) { if (__ballot(alpha != 1.0f) != 0ull) {
#pragma unroll
                        for (int db = 0; db < 4; ++db)
#pragma unroll
                            for (int e = 0; e < 16; ++e) o[db][e] *= alpha; } };
                auto rowmax = [&](const f32x16& a, float mold, float& mnew, float& alpha) {
                    float mx = fmaxf(a[0], a[1]);
#pragma unroll
                    for (int e = 2; e < 16; ++e) mx = fmaxf(mx, a[e]);
                    mx = fmaxf(mx, __shfl_xor(mx, 32)); mnew = fmaxf(mold, mx); alpha = __builtin_amdgcn_exp2f(mold - mnew); };
                f32x16 s0 = qk(0);
                if (msk) causal(s0, 0);
                float m0, al0, m1, al1, ps0 = 0.f, ps1 = 0.f; unsigned pk0[8], pk1[8];
                rowmax(s0, mrun, m0, al0);
                __builtin_amdgcn_sched_barrier(0);
                f32x16 s1;
#pragma unroll
                for (int e = 0; e < 16; ++e) s1[e] = 0.f;
                auto kfrag = [&](int ks) { return *(const LAS bf16x8*)(KB + (32 + r) * 256 + (((2 * ks + hh) ^ (r & 15)) << 4)); };
                bf16x8 kf = kfrag(0), kf1 = kfrag(1), kf2 = kf1;
#pragma unroll
                for (int ks = 0; ks < 8; ++ks) {
                    if (ks < 6) kf2 = kfrag(ks + 2);
                    s1 = __builtin_amdgcn_mfma_f32_32x32x16_bf16(kf, __builtin_bit_cast(bf16x8, qf[ks]), s1, 0, 0, 0); kf = kf1; kf1 = kf2;
                    __builtin_amdgcn_sched_barrier(0);
                    const float p0 = __builtin_amdgcn_exp2f(s0[2 * ks] - m0), p1 = __builtin_amdgcn_exp2f(s0[2 * ks + 1] - m0); ps0 += p0 + p1; pk0[ks] = pk2(p0, p1); asm volatile("" : "+v"(pk0[ks]), "+v"(ps0));
                    __builtin_amdgcn_sched_barrier(0); }
                rescale(al0);
                if (msk) causal(s1, 1);
                rowmax(s1, m0, m1, al1);
                __builtin_amdgcn_sched_barrier(0);
                auto vfrag = [&](int i) { return *(const LAS bf16x8*)(VB + (32 * (i & 3) + r) * 128 + (((2 * (i >> 2) + hh) ^ ((r >> 1) & 7)) << 4)); };
                bf16x8 vf = vfrag(0), vf1 = vfrag(1), vf2 = vf1;
#pragma unroll
                for (int i = 0; i < 8; ++i) { const int st = i >> 2, db = i & 3;
                    const bf16x8 pf = __builtin_bit_cast(bf16x8, (u32x4){pk0[4 * st], pk0[4 * st + 1], pk0[4 * st + 2], pk0[4 * st + 3]});
                    if (i < 6) vf2 = vfrag(i + 2);
                    o[db] = __builtin_amdgcn_mfma_f32_32x32x16_bf16(vf, pf, o[db], 0, 0, 0); vf = vf1; vf1 = vf2;
                    __builtin_amdgcn_sched_barrier(0);
                    const float p0 = __builtin_amdgcn_exp2f(s1[2 * i] - m1), p1 = __builtin_amdgcn_exp2f(s1[2 * i + 1] - m1); ps1 += p0 + p1; pk1[i] = pk2(p0, p1); asm volatile("" : "+v"(pk1[i]), "+v"(ps1));
                    __builtin_amdgcn_sched_barrier(0); }
                rescale(al1);
#pragma unroll
                for (int i = 0; i < 8; ++i) { const int st = i >> 2, db = i & 3;
                    const bf16x8 pf = __builtin_bit_cast(bf16x8, (u32x4){pk1[4 * st], pk1[4 * st + 1], pk1[4 * st + 2], pk1[4 * st + 3]});
                    const bf16x8 vf = *(const LAS bf16x8*)(VB + (32 * db + r) * 128 + (((4 + 2 * st + hh) ^ ((r >> 1) & 7)) << 4)); o[db] = __builtin_amdgcn_mfma_f32_32x32x16_bf16(vf, pf, o[db], 0, 0, 0); }
                lrun = (lrun * al0 + ps0) * al1 + ps1; mrun = m1;
            }
            if (issued) asm volatile("s_waitcnt vmcnt(4)" ::: "memory"); else asm volatile("s_waitcnt vmcnt(0)" ::: "memory");
            if (n == 1) asm volatile("" : "+v"(entN));
            if (n == 2) q8_settle(qfn);
            b3 = b3 == 2 ? 0 : b3 + 1;
            WG_BAR();
        }
        { const float ltot = lrun + __shfl_xor(lrun, 32);
          if (valid) { const float inv = 1.0f / ltot; const size_t pi = ((size_t)qtok * MH + h) * 4 + slot; bf16_t* op = PO + pi * MD;
#pragma unroll
            for (int db = 0; db < 4; ++db)
#pragma unroll
                for (int g = 0; g < 4; ++g) { u32x2 wv; wv.x = pk2(o[db][4 * g] * inv, o[db][4 * g + 1] * inv); wv.y = pk2(o[db][4 * g + 2] * inv, o[db][4 * g + 3] * inv); *(u32x2*)(op + 32 * db + 8 * g + 4 * hh) = wv; }
            if (hh == 0) *(f32x2*)(PML + pi * 2) = (f32x2){mrun, ltot}; } }
        if (!has_next) break;
        h = hN; kblk = kblkN; qtok = qtokN; slot = slotN; typeA = nA; valid = nA ? true : validN; wvalid = nA ? true : wvalidN; ++k;
#pragma unroll
        for (int ks = 0; ks < 8; ++ks) qf[ks] = qfn[ks];
    }
}
__device__ __forceinline__ void ph6_merge(ArgsP A, Frame& F) {
    unsigned char* ws = A->ws; const bf16_t* PO = (const bf16_t*)(ws + WS_PARTO); const float* PML = (const float*)(ws + WS_PARTML); bf16_t* YB = (bf16_t*)(ws + WS_YB);
    const int gw = F.vcu * NWAVES + F.wave, NGW = F.G * NWAVES, hl = F.lane >> 5, dg = F.lane & 31;
    for (int it0 = gw * 4; it0 < T * 8; it0 += NGW * 4) {
        u32x2 ov[4][4]; f32x2 ml[4][4];
#pragma unroll
        for (int k = 0; k < 4; ++k) { const int it = it0 + k, t = it >> 3, h = 2 * (it & 7) + hl; const size_t pi = ((size_t)t * MH + h) * 4;
#pragma unroll
            for (int sl = 0; sl < 4; ++sl) { ov[k][sl] = *(const u32x2*)(PO + (pi + sl) * MD + 4 * dg); ml[k][sl] = *(const f32x2*)(PML + (pi + sl) * 2); } }
#pragma unroll
        for (int k = 0; k < 4; ++k) { const int it = it0 + k, t = it >> 3, h = 2 * (it & 7) + hl, blk = t >> 8, nsel = blk < 3 ? blk : 3;
            float mmax = ml[k][3][0];
#pragma unroll
            for (int sl = 0; sl < 3; ++sl) if (sl < nsel) mmax = fmaxf(mmax, ml[k][sl][0]);
            f32x4 acc = (f32x4){0.f, 0.f, 0.f, 0.f}; float wsum = 0.f;
#pragma unroll
            for (int sl = 0; sl < 4; ++sl) { if (sl == 3 || sl < nsel) { const float w = ml[k][sl][1] * __builtin_amdgcn_exp2f(ml[k][sl][0] - mmax); wsum += w;
                acc += w * (f32x4){bflo(ov[k][sl].x), bfhi(ov[k][sl].x), bflo(ov[k][sl].y), bfhi(ov[k][sl].y)}; } }
            const float inv = 1.0f / wsum; st4bf(YB + (size_t)t * RW + h * MD + 4 * dg, acc * inv); }
    }
}

__device__ __forceinline__ void ins16(float (&top)[16], float x) {
#pragma unroll
    for (int k = 15; k >= 1; --k) top[k] = __builtin_amdgcn_fmed3f(top[k - 1], top[k], x);
    top[0] = fmaxf(top[0], x);
}
__device__ __forceinline__ void ph10_select(ArgsP A, Frame& F) {
    unsigned char* ws = A->ws; const bf16_t* PQ = (const bf16_t*)(ws + WS_PQ); const bf16_t* SK = (const bf16_t*)(ws + WS_SUBK); int* IDX = (int*)(ws + WS_IDX); float* GW = (float*)(ws + WS_GW);
    const int gw = F.vcu * NWAVES + F.wave, NGW = F.G * NWAVES; const int r = F.lane & 31, hh = F.lane >> 5; const float NEG = -__builtin_inff();
    const float* RSQ = (const float*)(ws + WS_RSQ); float* RS = (float*)(ws + WS_RS);
    for (int it = gw; it < (T / 32) * PH_; it += NGW) { const int tg = it >> 3, h = it & 7, t = tg * 32 + r;
        float rst; { float ss = 0.f;
#pragma unroll
            for (int j = 0; j < 8; ++j) { const f32x4 v = *(const f32x4*)(RSQ + (size_t)t * 64 + 32 * hh + 4 * j); ss += (v[0] + v[1]) + (v[2] + v[3]); }
            ss += __shfl_xor(ss, 32); rst = 1.0f / sqrtf(ss * (1.0f / D) + NORM_EPS); if (h == 0 && hh == 0) RS[t] = rst; }
        float TA[16], TB[16];
        auto topk = [&](int p, float (&dst)[16]) {
            bf16x8 qf[8];
#pragma unroll
            for (int ks = 0; ks < 8; ++ks) qf[ks] = *(const bf16x8*)(PQ + (size_t)t * 2048 + (h * 2 + p) * PHALF + 16 * ks + 8 * hh);
            float top[16];
#pragma unroll
            for (int k = 0; k < 16; ++k) top[k] = NEG;
#pragma unroll 1
            for (int nb = 0; nb < 4; ++nb) { f32x16 acc;
#pragma unroll
                for (int e = 0; e < 16; ++e) acc[e] = 0.f;
#pragma unroll
                for (int ks = 0; ks < 8; ++ks) { const bf16x8 a = *(const bf16x8*)(SK + ((size_t)(h * 2 + p) * PNK + 32 * nb + r) * PHALF + 16 * ks + 8 * hh); acc = __builtin_amdgcn_mfma_f32_32x32x16_bf16(a, qf[ks], acc, 0, 0, 0); }
#pragma unroll
                for (int e = 0; e < 16; ++e) { const unsigned key = 32 * nb + (e & 3) + 8 * (e >> 2) + 4 * hh; float ae = acc[e]; asm volatile("" : "+v"(ae));
                    const float x = __builtin_bit_cast(float, (__builtin_bit_cast(unsigned, ae) & ~0x7Fu) | key); ins16(top, x); } }
            float oth[16];
#pragma unroll
            for (int k = 0; k < 16; ++k) oth[k] = __shfl_xor(top[k], 32);
#pragma unroll
            for (int k = 0; k < 16; ++k) ins16(top, oth[k]);
#pragma unroll
            for (int k = 0; k < 16; ++k) dst[k] = top[k];
        };
        topk(0, TA); asm volatile("" ::: "memory"); __builtin_amdgcn_sched_barrier(0); topk(1, TB); asm volatile("" ::: "memory"); __builtin_amdgcn_sched_barrier(0);
        float fin[16];
#pragma unroll
        for (int k = 0; k < 16; ++k) fin[k] = NEG;
#pragma unroll
        for (int i = 0; i < 16; ++i)
#pragma unroll
            for (int j = 0; j < 16; ++j) if ((i + 1) * (j + 1) <= 16) { const float sm = TA[i] + TB[j]; ins16(fin, __builtin_bit_cast(float, (__builtin_bit_cast(unsigned, sm) & ~0xFFu) | (unsigned)(i * 16 + j))); }
        float e[16], den = 0.f;
#pragma unroll
        for (int k = 0; k < 16; ++k) { e[k] = __expf((fin[k] - fin[0]) * rst); den += e[k]; }
        const float rden = 1.0f / den;
        int oi[8]; float og[8];
#pragma unroll
        for (int kk = 0; kk < 8; ++kk) { const float fv = hh ? fin[8 + kk] : fin[kk]; og[kk] = (hh ? e[8 + kk] : e[kk]) * rden; const unsigned id = __builtin_bit_cast(unsigned, fv) & 0xFFu; const unsigned ci = id >> 4, cj = id & 15u;
            unsigned ia = 0u, ib = 0u;
#pragma unroll
            for (int q = 0; q < 16; ++q) { ia = (ci == (unsigned)q) ? (__builtin_bit_cast(unsigned, TA[q]) & 0x7Fu) : ia; ib = (cj == (unsigned)q) ? (__builtin_bit_cast(unsigned, TB[q]) & 0x7Fu) : ib; }
            oi[kk] = (int)(ia * PNK + ib); }
        int* ip = IDX + (size_t)t * 128 + h * 16 + 8 * hh; float* gp = GW + (size_t)t * 128 + h * 16 + 8 * hh;
        *(u32x4*)ip = (u32x4){(unsigned)oi[0], (unsigned)oi[1], (unsigned)oi[2], (unsigned)oi[3]}; *(u32x4*)(ip + 4) = (u32x4){(unsigned)oi[4], (unsigned)oi[5], (unsigned)oi[6], (unsigned)oi[7]};
        *(f32x4*)gp = (f32x4){og[0], og[1], og[2], og[3]}; *(f32x4*)(gp + 4) = (f32x4){og[4], og[5], og[6], og[7]};
    }
}


__device__ __forceinline__ float ub0(unsigned w) { return (float)(w & 0xffu); }
__device__ __forceinline__ float ub1(unsigned w) { return (float)((w >> 8) & 0xffu); }
__device__ __forceinline__ float ub2(unsigned w) { return (float)((w >> 16) & 0xffu); }
__device__ __forceinline__ float ub3(unsigned w) { return (float)(w >> 24); }
__device__ __forceinline__ float dot16q(u32x4 q, const float (&h)[16]) {
    return ((ub0(q.x) * h[0] + ub1(q.x) * h[1]) + (ub2(q.x) * h[2] + ub3(q.x) * h[3])) + ((ub0(q.y) * h[4] + ub1(q.y) * h[5]) + (ub2(q.y) * h[6] + ub3(q.y) * h[7]))
         + ((ub0(q.z) * h[8] + ub1(q.z) * h[9]) + (ub2(q.z) * h[10] + ub3(q.z) * h[11])) + ((ub0(q.w) * h[12] + ub1(q.w) * h[13]) + (ub2(q.w) * h[14] + ub3(q.w) * h[15]));
}
__device__ __forceinline__ void ph11_gather(ArgsP A, Frame& F) {
    unsigned char* ws = A->ws; const bf16_t* X1 = (const bf16_t*)(ws + WS_X1); const float* RS = (const float*)(ws + WS_RS); const unsigned char* PU = (const unsigned char*)(ws + WS_PU); const unsigned char* PV = (const unsigned char*)(ws + WS_PV);
    const float* PSU = (const float*)(ws + WS_PSU); const float* PSV = (const float*)(ws + WS_PSV);
    const int* IDX = (const int*)(ws + WS_IDX); const float* GW = (const float*)(ws + WS_GW);
    LAS float* coef = (LAS float*)(F.lds + RING_OFF); LAS int* eidx = (LAS int*)(F.lds + RING_OFF + 1024); LAS float* red = (LAS float*)(F.lds + RING_OFF + 2048);
    const int tid = F.tid, wave = F.wave, lane = F.lane; int par = 0;
    for (int tgk = F.vcu * 32; tgk < T; tgk = ((tgk & 31) == 31) ? tgk + (F.G - 1) * 32 + 1 : tgk + 1, par ^= 1) { const int t = tgk;
        float hv[4][16]; float hs = 0.f;
        const float rs2 = RS[t];
#pragma unroll
        for (int i = 0; i < 4; ++i) { const bf16_t* hp = X1 + (size_t)t * D + i * 1024 + lane * 16; f32x4 a, b, c, d; pg8::unpack8(*(const u32x4*)hp, a, b); pg8::unpack8(*(const u32x4*)(hp + 8), c, d);
            { const f32x4* gp = (const f32x4*)(A->norm2_g + i * 1024 + lane * 16); a = a * gp[0] * rs2; b = b * gp[1] * rs2; c = c * gp[2] * rs2; d = d * gp[3] * rs2; }
#pragma unroll
            for (int e = 0; e < 4; ++e) { hv[i][e] = a[e]; hv[i][4 + e] = b[e]; hv[i][8 + e] = c[e]; hv[i][12 + e] = d[e]; }
            hs += ((a[0] + a[1]) + (a[2] + a[3])) + ((b[0] + b[1]) + (b[2] + b[3])) + ((c[0] + c[1]) + (c[2] + c[3])) + ((d[0] + d[1]) + (d[2] + d[3])); }
        hs = wave_sum(hs);
        const int myidx = (lane < 16) ? IDX[(size_t)t * 128 + wave * 16 + lane] : 0; const float myg = (lane < 16) ? GW[(size_t)t * 128 + wave * 16 + lane] : 0.f;
        float dots = 0.f;
#pragma unroll 1
        for (int k = 0; k < 16; k += 4) {
            u32x4 q[4][4];
#pragma unroll
            for (int x = 0; x < 4; ++x) { const int e = __builtin_amdgcn_readlane(myidx, k + x); const unsigned char* up = PU + (size_t)e * D + lane * 16;
#pragma unroll
                for (int i = 0; i < 4; ++i) q[x][i] = *(const u32x4*)(up + i * 1024); }
#pragma unroll
            for (int x = 0; x < 4; ++x) { float d = 0.f;
#pragma unroll
                for (int i = 0; i < 4; ++i) d += dot16q(q[x][i], hv[i]);
                d = wave_sum(d); if (lane == k + x) dots = d; }
        }
        if (lane < 16) { const float s = PSU[myidx] * (dots - 128.0f * hs); const float act = 0.5f * s * (1.0f + erff(s * 0.70710678118654752f));
            coef[par * 128 + wave * 16 + lane] = myg * act * PSV[myidx]; eidx[par * 128 + wave * 16 + lane] = myidx; }
        WG_BAR();
        float acc[8]; float csum = 0.f;
#pragma unroll
        for (int i = 0; i < 8; ++i) acc[i] = 0.f;
#pragma unroll 1
        for (int e = 0; e < 128; e += 16) { u32x2 v[16]; float c[16];
#pragma unroll
            for (int q = 0; q < 16; ++q) { const int ei = __builtin_amdgcn_readfirstlane(eidx[par * 128 + e + q]); c[q] = coef[par * 128 + e + q]; v[q] = *(const u32x2*)(PV + (size_t)ei * D + tid * 8); }
#pragma unroll
            for (int q = 0; q < 16; ++q) { csum += c[q]; acc[0] += c[q] * ub0(v[q].x); acc[1] += c[q] * ub1(v[q].x); acc[2] += c[q] * ub2(v[q].x); acc[3] += c[q] * ub3(v[q].x); acc[4] += c[q] * ub0(v[q].y); acc[5] += c[q] * ub1(v[q].y); acc[6] += c[q] * ub2(v[q].y); acc[7] += c[q] * ub3(v[q].y); } }
        const float corr = -128.0f * csum;
        f32x4 x0, x1; pg8::unpack8(*(const u32x4*)(X1 + (size_t)t * D + tid * 8), x0, x1);
        f32x4 y0 = x0 + ((f32x4){acc[0], acc[1], acc[2], acc[3]} + corr), y1 = x1 + ((f32x4){acc[4], acc[5], acc[6], acc[7]} + corr);
        float ss = (y0[0] * y0[0] + y0[1] * y0[1]) + (y0[2] * y0[2] + y0[3] * y0[3]) + (y1[0] * y1[0] + y1[1] * y1[1]) + (y1[2] * y1[2] + y1[3] * y1[3]);
        ss = wave_sum(ss); if (lane == 0) red[par * 8 + wave] = ss;
        WG_BAR();
        float tot = 0.f;
#pragma unroll
        for (int w = 0; w < 8; ++w) tot += red[par * 8 + w];
        const float rs = 1.0f / sqrtf(tot * (1.0f / D) + NORM_EPS);
        const f32x4 g0 = *(const f32x4*)(A->final_g + tid * 8), g1 = *(const f32x4*)(A->final_g + tid * 8 + 4);
        *(f32x4*)(A->out + (size_t)t * D + tid * 8) = y0 * rs * g0; *(f32x4*)(A->out + (size_t)t * D + tid * 8 + 4) = y1 * rs * g1;
    }
}

constexpr int NPH = 13;
__device__ __forceinline__ Frame make_frame(unsigned char* lds) {
    Frame F; int t = threadIdx.x; asm volatile("" : "+v"(t));
    F.lds = (LAS unsigned char*)lds; F.tid = t; F.lane = t & 63; F.wave = __builtin_amdgcn_readfirstlane(t >> 6);
    F.G = gridDim.x; { const int bx = blockIdx.x; F.vcu = (F.G % 8 == 0) ? (bx % 8) * (F.G / 8) + bx / 8 : bx; }
    return F;
}
__global__ void __launch_bounds__(NTHR, 2) mk_fwd(Args args_by_value) {
    extern __shared__ __attribute__((aligned(16))) unsigned char lds[];
    ArgsP args = get_args();
    gu32* ctl = (gu32*)(args->ws + WS_CTL);
    for (int u = threadIdx.x; u < (LDS_BYTES - LDSCTL_OFF) / 4; u += NTHR) ((LAS unsigned*)((LAS unsigned char*)lds + LDSCTL_OFF))[u] = 0u;
    __syncthreads();
    const int lo = args->ph_lo, hi = args->ph_hi;
    volatile LAS unsigned* MISC = (volatile LAS unsigned*)((LAS unsigned char*)lds + MISC_OFF);
    XcdBarrier bar; bar.bar = (unsigned*)(ctl + CW_BAR) + args->li * XCD_BAR_WORDS; bar.x = 0; bar.st = nullptr;
    if (hi - lo > 1) bar = xcd_barrier_post((unsigned*)(ctl + CW_BAR) + args->li * XCD_BAR_WORDS, MISC + 8);
#define IN(k) (lo <= (k) && (k) < hi)
#define SEAM(k) do { if (IN(k) && IN((k) + 1)) xcd_barrier(bar); } while (0)
    const int bid = (int)blockIdx.x;

    if (IN(0)) { Frame F = make_frame(lds); ph0_prologue(get_args(), F); SEAM(0); }
    if (IN(1)) { Frame F = make_frame(lds); LAS unsigned char* ring = F.lds + RING_OFF; ArgsP a_ = get_args(); unsigned char* ws = a_->ws;
        { pg8::Gemm g{(const bf16_t*)(ws + WS_XN), (const bf16_t*)(ws + WS_WIN), T, PLD, D}; pg8::StaticOrder S; S.init(T, PLD, F.G, bid);
          pg8::EpiProj E{(bf16_t*)(ws + WS_PROJ), (const float*)(ws + WS_ROPE), (bf16_t*)(ws + WS_KB)}; pg8::gemm_phase<pg8::EpiProj, pg8::StaticOrder, true, true>(ring, g, S, E); }
        { pg8::Gemm g{(const bf16_t*)(ws + WS_XN), (const bf16_t*)(ws + WS_WIN) + (size_t)PC_MV * D, T, 2048, D}; pg8::StaticOrder S; S.init(T, 2048, F.G, bid);
          pg8::EpiVT E{(bf16_t*)(ws + WS_VT)}; pg8::gemm_phase<pg8::EpiVT, pg8::StaticOrder, true, true>(ring, g, S, E); }
        { constexpr int NT1 = (T / 256) * (PLD / 256); const int nx = NT1 % F.G;
          if (bid >= nx) { WG_BAR(); { Frame F2 = make_frame(lds); late_weights(get_args(), F2, (bid - nx) * NWAVES + F2.wave, (F2.G - nx) * NWAVES); }
              if (nx) { Frame F2 = make_frame(lds); peer_quant(get_args(), F2, 0, pq_ra(F2.G), (bid - nx) * NWAVES + F2.wave, (F2.G - nx) * NWAVES); } } }
        SEAM(1); }
    if (IN(2)) { Frame F = make_frame(lds); ph2_prep(get_args(), F); SEAM(2); }
    if (IN(3)) { Frame F = make_frame(lds); LAS unsigned char* ring = F.lds + RING_OFF; ArgsP a_ = get_args(); unsigned char* ws = a_->ws;
        { pg8::Gemm g{(const bf16_t*)(ws + WS_AW), (const bf16_t*)(ws + WS_WUP), T, RW, LW}; pg8::StaticOrder S; S.init(T, RW, F.G, bid);
          pg8::EpiDec E{(float*)(ws + WS_DEC), a_->w0}; pg8::gemm_phase<pg8::EpiDec, pg8::StaticOrder, true, true>(ring, g, S, E); }
        asm volatile("" ::: "memory"); __builtin_amdgcn_sched_barrier(0);
        { pg8::Gemm g{(const bf16_t*)(ws + WS_AA), (const bf16_t*)(ws + WS_AUP), T, RW, LA}; pg8::StaticOrder S; S.init(T, RW, F.G, bid);
          pg8::EpiA E{(bf16_t*)(ws + WS_KP), (bf16_t*)(ws + WS_BB), (const bf16_t*)(ws + WS_KKN), a_->a0, a_->k_a}; pg8::gemm_phase<pg8::EpiA, pg8::StaticOrder, true, true>(ring, g, S, E); }
        asm volatile("" ::: "memory"); __builtin_amdgcn_sched_barrier(0);
        { pg8::Gemm g{(const bf16_t*)(ws + WS_AG), (const bf16_t*)(ws + WS_GUP), T, RW, LGP}; pg8::StaticOrder S; S.init(T, RW, F.G, bid);
          pg8::EpiBf16 E{(bf16_t*)(ws + WS_G), RW}; pg8::gemm_phase<pg8::EpiBf16, pg8::StaticOrder, true, true>(ring, g, S, E); }
        { Frame F2 = make_frame(lds); ph3_gate(get_args(), F2); }
        SEAM(3); }
    if (IN(4)) { Frame F = make_frame(lds); ph4_chunkprep(get_args(), F); SEAM(4); }
    if (IN(5)) {
        { Frame F = make_frame(lds); if (F.vcu < RH) ph5_chain(get_args(), F, F.vcu); }
        { Frame F = make_frame(lds); ph5_attn(get_args(), F); }
        { Frame F = make_frame(lds); if (F.vcu >= RH) peer_quant(get_args(), F, pq_ra(F.G), 2 * 16384, (F.vcu - RH) * NWAVES + F.wave, (F.G - RH) * NWAVES); }
        SEAM(5); }
    if (IN(6)) { { Frame F = make_frame(lds); ph6_merge(get_args(), F); } { Frame F = make_frame(lds); ph5_ypost(get_args(), F); } SEAM(6); }
    if (IN(7)) { Frame F = make_frame(lds); LAS unsigned char* ring = F.lds + RING_OFF; ArgsP a_ = get_args(); unsigned char* ws = a_->ws;
        { pg8::Gemm g{(const bf16_t*)(ws + WS_YA), (const bf16_t*)(ws + WS_WA), T, D, RW}; pg8::StaticOrder S; S.init(T, D, F.G, bid);
          pg8::EpiMix<false> E{(bf16_t*)(ws + WS_MIXED), (const bf16_t*)(ws + WS_PROJ), PC_GA}; pg8::gemm_phase<pg8::EpiMix<false>, pg8::StaticOrder, true, true>(ring, g, S, E); }
        { pg8::Gemm g{(const bf16_t*)(ws + WS_YB), (const bf16_t*)(ws + WS_WB), T, D, RW}; pg8::StaticOrder S; S.init(T, D, F.G, bid);
          pg8::EpiMix<true> E{(bf16_t*)(ws + WS_MIXED), (const bf16_t*)(ws + WS_PROJ), PC_GB}; pg8::gemm_phase<pg8::EpiMix<true>, pg8::StaticOrder, true, true>(ring, g, S, E); }
        SEAM(7); }
    if (IN(8)) { Frame F = make_frame(lds); LAS unsigned char* ring = F.lds + RING_OFF; ArgsP a_ = get_args(); unsigned char* ws = a_->ws;
        pg8::Gemm g{(const bf16_t*)(ws + WS_MIXED), (const bf16_t*)(ws + WS_WOUT), T, D, D}; pg8::StaticOrder S; S.init(T, D, F.G, bid);
        pg8::EpiRes E{(bf16_t*)(ws + WS_X1), a_->x, (float*)(ws + WS_RSQ)}; pg8::gemm_phase<pg8::EpiRes, pg8::StaticOrder, true, true>(ring, g, S, E);
        SEAM(8); }
    if (IN(10)) { Frame F = make_frame(lds); LAS unsigned char* ring = F.lds + RING_OFF; ArgsP a_ = get_args(); unsigned char* ws = a_->ws;
        pg8::Gemm g{(const bf16_t*)(ws + WS_X1), (const bf16_t*)(ws + WS_WQ), T, 2048, D}; pg8::StaticOrder S; S.init(T, 2048, F.G, bid);
        pg8::EpiBf16 E{(bf16_t*)(ws + WS_PQ), 2048}; pg8::gemm_phase<pg8::EpiBf16, pg8::StaticOrder, true, true>(ring, g, S, E);
        SEAM(10); }
    if (IN(11)) { Frame F = make_frame(lds); ph10_select(get_args(), F);
        if (IN(12)) { __builtin_amdgcn_fence(__ATOMIC_RELEASE, "workgroup"); WG_BAR(); __builtin_amdgcn_fence(__ATOMIC_ACQUIRE, "workgroup"); } }
    if (IN(12)) { Frame F = make_frame(lds); ph11_gather(get_args(), F); }
#undef IN
#undef SEAM
}

extern "C" void kernel_launch(void* const* d_in, const int* in_sizes, int n_in, void* d_out, int out_size, void* d_ws, size_t ws_size, hipStream_t stream) {
    static int grid = 0;
    if (grid == 0) {
        if (n_in != 23 || out_size != T * D || ws_size < WS_END) { fprintf(stderr, "kernel_launch: unexpected shapes (n_in %d out %d ws %zu); nothing launched\n", n_in, out_size, ws_size); grid = -1; return; }
        int dev = 0, cus = 0, per_cu = 0;
        if (hipGetDevice(&dev) != hipSuccess || hipDeviceGetAttribute(&cus, hipDeviceAttributeMultiprocessorCount, dev) != hipSuccess) { grid = -1; return; }
        if (hipFuncSetAttribute((const void*)mk_fwd, hipFuncAttributeMaxDynamicSharedMemorySize, LDS_BYTES) != hipSuccess) { grid = -1; return; }
        if (hipOccupancyMaxActiveBlocksPerMultiprocessor(&per_cu, (const void*)mk_fwd, NTHR, LDS_BYTES) != hipSuccess || per_cu < 1) fprintf(stderr, "kernel_launch: occupancy query reports %d\n", per_cu);
        (void)hipGetLastError();
        grid = cus;
    }
    if (grid < 0) return;
    (void)hipMemsetAsync((char*)d_ws + WS_CTL, 0, CTL_ZERO_BYTES, stream);
    Args a{};
    const float** ap = (const float**)&a;
    for (int i = 0; i < 23; ++i) ap[i] = (const float*)d_in[i];
    a.out = (float*)d_out; a.ws = (unsigned char*)d_ws; a.pad = 0;
    constexpr int NL = MK_N_LAUNCHES;
    for (int li = 0; li < NL; ++li) {
        a.ph_lo = (NL == 1) ? 0 : li; a.ph_hi = (NL == 1) ? NPH : li + 1; a.li = (NL == 1) ? 0 : 0;
        hipLaunchKernelGGL(mk_fwd, dim3(grid), dim3(NTHR), LDS_BYTES, stream, a);
#ifdef DUP_HI
        if (NL > 1 && li == DUP_HI) for (int l2 = DUP_LO; l2 <= DUP_HI; ++l2) { a.ph_lo = l2; a.ph_hi = l2 + 1; hipLaunchKernelGGL(mk_fwd, dim3(grid), dim3(NTHR), LDS_BYTES, stream, a); }
#endif
    }
}
```

```cpp
#include <hip/hip_runtime.h>
#include <cstdio>
#include <cstdint>

#ifndef MK_N_LAUNCHES
#define MK_N_LAUNCHES 1
#endif

#define GAS __attribute__((address_space(1)))
#define LAS __attribute__((address_space(3)))
typedef unsigned short bf16_t;
typedef __bf16 bf16x8 __attribute__((ext_vector_type(8)));
typedef float f32x2 __attribute__((ext_vector_type(2)));
typedef float f32x4 __attribute__((ext_vector_type(4)));
typedef float f32x16 __attribute__((ext_vector_type(16)));
typedef unsigned u32x2 __attribute__((ext_vector_type(2)));
typedef unsigned u32x4 __attribute__((ext_vector_type(4)));
typedef GAS unsigned gu32;

constexpr int T = 8192, D = 4096;
constexpr int RW = 2048, RH = 32, RN = 64;
constexpr int LW = 128, LA = 128, LG = 480, LGP = 512;
constexpr int SHIFTW = 6880;
constexpr int MH = 16, MD = 128, MBLK = 256, NBLK = 32;
constexpr int INW = 21216;
constexpr int PLD = 19200;
constexpr int PC_R = 0, PC_K = 2048, PC_V = 4096, PC_WL = 6144, PC_AL = 6272, PC_GL = 6400, PC_MQ = 6912, PC_MK = 8960, PC_GA = 11008, PC_GB = 15104, PC_MV = 19200;
constexpr int WIN_ROWS = 21248;
constexpr int PQ_SPLIT = 16384;
constexpr int PH_ = 8, PNK = 128, PQD = 256, PHALF = 128, PTOPK = 16;
constexpr float NORM_EPS = 1e-6f, LNX_EPS = 64e-5f;
constexpr float QSCALE = 0.08838834764831845f * 1.4426950408889634f;

constexpr size_t MiB = 1u << 20;
constexpr size_t WS_CTL = 0, CTL_ZERO_BYTES = 1 * MiB;
constexpr size_t WS_WIN = 1 * MiB;
constexpr size_t WS_X1 = 1 * MiB, WS_PQ = 129 * MiB;
constexpr size_t WS_WA = 167 * MiB, WS_WB = 183 * MiB, WS_WOUT = 199 * MiB, WS_WQ = 231 * MiB, WS_WUP = 247 * MiB, WS_AUP = 248 * MiB, WS_GUP = 249 * MiB, WS_SUBK = 251 * MiB;
constexpr size_t WS_PU = 252 * MiB, WS_PV = 380 * MiB;
constexpr size_t WS_XN = 508 * MiB;
constexpr size_t WS_Y = 508 * MiB, WS_RSQ = 508 * MiB, WS_RS = 510 * MiB;
constexpr size_t WS_PROJ = 572 * MiB;
constexpr size_t WS_VT = 872 * MiB;
constexpr size_t WS_ROPE = 904 * MiB, WS_KMEAN = 908 * MiB, WS_MASK = 909 * MiB, WS_AW = 910 * MiB, WS_AA = 912 * MiB, WS_AG = 914 * MiB;
constexpr size_t WS_PSU = 909 * MiB + 512 * 1024, WS_PSV = WS_PSU + 64 * 1024;
constexpr size_t WS_DEC = 922 * MiB;
constexpr size_t WS_MIXED = 922 * MiB;
constexpr size_t WS_KKN = 986 * MiB, WS_BB = 1018 * MiB, WS_KP = 1050 * MiB, WS_ZR = 1082 * MiB, WS_ZV = 1114 * MiB, WS_G = 1146 * MiB;
constexpr size_t WS_YA = 1178 * MiB, WS_YB = 1210 * MiB, WS_IDX = 1242 * MiB, WS_GW = 1246 * MiB, WS_PARTML = 1250 * MiB, WS_LIST = 1254 * MiB, WS_UDESC = 1262 * MiB, WS_KB = 1267 * MiB, WS_END = 1299 * MiB;
constexpr size_t WS_PARTO = 922 * MiB;

constexpr int CW_TMO = 0, CW_CODE = 1, CW_ATTNQ = 64, CW_CNT = 1024, CW_BAR = 4096;

constexpr int RING_OFF = 0, RING_BYTES = 155648;
constexpr int LDSCTL_OFF = RING_BYTES, MISC_OFF = LDSCTL_OFF + 320;
constexpr int LDS_BYTES = 163840;
constexpr int NWAVES = 8, NTHR = 512;

__device__ __forceinline__ unsigned f2bf(float f) { unsigned u = __builtin_bit_cast(unsigned, f); return (u + 0x7fffu + ((u >> 16) & 1u)) >> 16; }
typedef __bf16 bf16x2 __attribute__((ext_vector_type(2)));
__device__ __forceinline__ unsigned pk2(float lo, float hi) { const f32x2 v = {lo, hi}; return __builtin_bit_cast(unsigned, __builtin_convertvector(v, bf16x2)); }
__device__ __forceinline__ float bflo(unsigned u) { return __builtin_bit_cast(float, u << 16); }
__device__ __forceinline__ float bfhi(unsigned u) { return __builtin_bit_cast(float, u & 0xffff0000u); }
__device__ __forceinline__ float bf1(bf16_t b) { return __builtin_bit_cast(float, (unsigned)b << 16); }
__device__ __forceinline__ float fsigmoid(float x) { return __builtin_amdgcn_rcpf(1.0f + __expf(-x)); }
__device__ __forceinline__ float wave_sum(float v) {
#pragma unroll
    for (int o = 1; o < 64; o <<= 1) v += __shfl_xor(v, o);
    return v;
}
template <int CTRL> __device__ __forceinline__ float dpp_f(float v) { return __builtin_bit_cast(float, __builtin_amdgcn_update_dpp(0, __builtin_bit_cast(int, v), CTRL, 0xF, 0xF, true)); }
__device__ __forceinline__ float sum16(float x) {
    x += dpp_f<0xB1>(x); x += dpp_f<0x4E>(x); x += dpp_f<0x141>(x); x += dpp_f<0x140>(x); return x;
}
__device__ __forceinline__ float vmul(float a, float b) { float r; asm("v_mul_f32_e32 %0, %1, %2" : "=v"(r) : "v"(a), "v"(b)); return r; }
__device__ __forceinline__ float vfma(float a, float b, float c) { float r; asm("v_fma_f32 %0, %1, %2, %3" : "=v"(r) : "v"(a), "v"(b), "v"(c)); return r; }
#define LDS_WAIT() asm volatile("s_waitcnt lgkmcnt(0)" ::: "memory")
#define VM_WAIT() asm volatile("s_waitcnt vmcnt(0)" ::: "memory")
#define WG_BAR() do { asm volatile("s_waitcnt lgkmcnt(0)" ::: "memory"); __builtin_amdgcn_s_barrier(); asm volatile("" ::: "memory"); } while (0)

namespace pg8 {
constexpr int BM = 256, BK = 64, HALF = 128, HTB = HALF * BK * 2, STAGE_BYTES = 8 * HTB, NXCD = 8, WGM = 8;
__host__ __device__ __forceinline__ int lds_byte(int r, int c) { const int st = (r >> 4) * 2 + (c >> 5), rr = r & 15, cc = c & 31, ob = rr * 64 + cc * 2; return st * 1024 + (ob ^ (((ob >> 9) & 1) << 5)); }
__host__ __device__ __forceinline__ void stage_rc(int b, int& R, int& C) { const int st = b / 1024, sb = b % 1024, swz = sb ^ (((sb >> 9) & 1) << 5); R = (st >> 1) * 16 + swz / 64; C = (st & 1) * 32 + (swz % 64) / 2; }
__host__ __device__ __forceinline__ int perm32(int rho) { const int n = rho >> 4, i = rho & 15; return 8 * (i >> 2) + 4 * n + (i & 3); }

struct Unit { int pm, pn; };
struct Gemm { const bf16_t* A; const bf16_t* Bt; int M, N, K; };

struct StaticOrder {
    int nM, nN, nwg, G, c;
    __host__ __device__ void init(int M, int N, int G_, int c_) { nM = M / BM; nN = N / BM; nwg = nM * nN; G = G_; c = c_; }
    __host__ __device__ bool next(int i, Unit& u) const {
        const long L = (long)i * G + c; if (L >= nwg) return false;
        int wgid = (int)L; { const int q = nwg / NXCD, r = nwg % NXCD, xcd = wgid % NXCD, off = wgid / NXCD; wgid = (xcd < r ? xcd * (q + 1) : r * (q + 1) + (xcd - r) * q) + off; }
        const int nig = WGM * nN, gid = wgid / nig, fm = gid * WGM, gsz = (nM - fm) < WGM ? (nM - fm) : WGM;
        u.pm = fm + ((wgid % nig) % gsz); u.pn = (wgid % nig) / gsz; return true;
    }
    __device__ __forceinline__ void a_ready(const Unit&) const {}
    __device__ __forceinline__ void done(const Unit&) const {}
};

template <class Epi, class Sched, bool ALIGN_EPI = false, bool SP2 = false>
__device__ __forceinline__ void gemm_phase(LAS unsigned char* lds, const Gemm g, const Sched& S, const Epi& E) {
    int tid_ = threadIdx.x; asm volatile("" : "+v"(tid_));
    const int tid = tid_, wid = __builtin_amdgcn_readfirstlane(tid >> 6), lane = tid & 63, wr = wid >> 2, wc = wid & 3, fr = lane & 15, fq = lane >> 4;
    int K_ = g.K; asm volatile("" : "+s"(K_));
    const int K = K_, nt = K / BK;
    unsigned voffA[2], voffB[2];
#pragma unroll
    for (int i = 0; i < 2; ++i) { int R, C; stage_rc(tid * 16 + i * 8192, R, C); const int Rb = Epi::PERM ? ((R & ~31) + perm32(R & 31)) : R;
        voffA[i] = (unsigned)(R * K + C) * 2u; voffB[i] = (unsigned)(Rb * K + C) * 2u; }
    const size_t kstep = (size_t)(BK * 2);
    const size_t hstep = (size_t)HALF * K * 2;
    const size_t tstep = 2 * hstep;
    const unsigned ldsw = (unsigned)wid * 1024u;
    const int aoff = lds_byte(wr * 64 + fr, fq * 8), boff = lds_byte(wc * 32 + fr, fq * 8);
#define PG8_SA(b, h) (((b) * 2 + (h)) * HTB)
#define PG8_SB(b, h) ((4 + (b) * 2 + (h)) * HTB)
#define PG8_STAGE(bufoff, gbase, voff) do { _Pragma("unroll") for (int _i = 0; _i < 2; ++_i) \
        __builtin_amdgcn_global_load_lds((const unsigned*)((const char*)(gbase) + (voff)[_i]), (LAS unsigned*)(lds + (bufoff) + ldsw + _i * 8192), 16, 0, 0); } while (0)
#define PG8_LDA(dst, b, h) do { _Pragma("unroll") for (int m = 0; m < 4; ++m) _Pragma("unroll") for (int k = 0; k < 2; ++k) dst[m][k] = *(const LAS bf16x8*)(lds + PG8_SA(b, h) + aoff + m * 2048 + k * 1024); } while (0)
#define PG8_LDB(dst, b, h) do { _Pragma("unroll") for (int n = 0; n < 2; ++n) _Pragma("unroll") for (int k = 0; k < 2; ++k) dst[n][k] = *(const LAS bf16x8*)(lds + PG8_SB(b, h) + boff + n * 2048 + k * 1024); } while (0)
#define PG8_MMA(ai, bj, At, Bt) do { __builtin_amdgcn_s_setprio(1); _Pragma("unroll") for (int m = 0; m < 4; ++m) _Pragma("unroll") for (int n = 0; n < 2; ++n) _Pragma("unroll") for (int k = 0; k < 2; ++k) { \
        if constexpr (Epi::SWAP) acc[ai][bj][m][n] = __builtin_amdgcn_mfma_f32_16x16x32_bf16(At[m][k], Bt[n][k], acc[ai][bj][m][n], 0, 0, 0); \
        else acc[ai][bj][m][n] = __builtin_amdgcn_mfma_f32_16x16x32_bf16(Bt[n][k], At[m][k], acc[ai][bj][m][n], 0, 0, 0); } __builtin_amdgcn_s_setprio(0); } while (0)
#define PG8_WAIT_V(n) asm volatile("s_waitcnt vmcnt(" #n ")" ::: "memory")
#define PG8_WAIT_L(n) asm volatile("s_waitcnt lgkmcnt(" #n ")" ::: "memory")
#define PG8_BAR __builtin_amdgcn_s_barrier()
#define PG8_SCHED __builtin_amdgcn_sched_barrier(0)
    Unit cur, nxt; int ui = 0;
    if (!S.next(0, cur)) return;
    f32x4 acc[2][2][4][2];
#pragma unroll
    for (int a = 0; a < 2; ++a)
#pragma unroll
        for (int b = 0; b < 2; ++b)
#pragma unroll
            for (int m = 0; m < 4; ++m)
#pragma unroll
                for (int n = 0; n < 2; ++n) acc[a][b][m][n] = (f32x4){0.f, 0.f, 0.f, 0.f};
    bf16x8 At[4][2], B0[2][2], B1[2][2];
    const char* cA = (const char*)g.A + (size_t)cur.pm * tstep; const char* cB = (const char*)g.Bt + (size_t)cur.pn * tstep;
    S.a_ready(cur);
    if constexpr (SP2) {
        PG8_STAGE(PG8_SB(0, 0), cB, voffB); PG8_STAGE(PG8_SB(0, 1), cB + hstep, voffB); PG8_STAGE(PG8_SA(0, 0), cA, voffA); PG8_STAGE(PG8_SA(0, 1), cA + hstep, voffA);
        if (wr == 1) PG8_BAR;
        PG8_WAIT_V(2); PG8_BAR;
        PG8_STAGE(PG8_SB(1, 0), cB + kstep, voffB); PG8_STAGE(PG8_SA(1, 0), cA + kstep, voffA); PG8_STAGE(PG8_SB(1, 1), cB + hstep + kstep, voffB);
        PG8_WAIT_V(6); PG8_BAR;
    } else {
        PG8_STAGE(PG8_SB(0, 0), cB, voffB); PG8_STAGE(PG8_SA(0, 0), cA, voffA); PG8_STAGE(PG8_SB(0, 1), cB + hstep, voffB); PG8_STAGE(PG8_SA(0, 1), cA + hstep, voffA);
        if (wr == 1) PG8_BAR;
        PG8_WAIT_V(4); PG8_BAR;
        PG8_STAGE(PG8_SB(1, 0), cB + kstep, voffB); PG8_STAGE(PG8_SA(1, 0), cA + kstep, voffA); PG8_STAGE(PG8_SB(1, 1), cB + hstep + kstep, voffB);
        PG8_WAIT_V(6); PG8_BAR;
    }
    for (;;) {
        const bool has_next = S.next(ui + 1, nxt);
        const char* nA = has_next ? (const char*)g.A + (size_t)nxt.pm * tstep : cA; const char* nB = has_next ? (const char*)g.Bt + (size_t)nxt.pn * tstep : cB;
        for (int t = 0; t < nt; t += 2) {
            const bool last = (t == nt - 2);
            const char* a1 = cA + (size_t)(t + 1) * kstep;
            const char* a2 = last ? nA : cA + (size_t)(t + 2) * kstep; const char* b2 = last ? nB : cB + (size_t)(t + 2) * kstep;
            const char* a3 = a2 + kstep; const char* b3 = b2 + kstep;
            if (last && has_next) S.a_ready(nxt);
            if constexpr (SP2) {
            PG8_LDB(B0, 0, 0); PG8_LDB(B1, 0, 1); PG8_SCHED; PG8_LDA(At, 0, 0); PG8_STAGE(PG8_SA(1, 1), a1 + hstep, voffA);
            PG8_WAIT_V(8); PG8_WAIT_L(0); PG8_BAR; PG8_MMA(0, 0, At, B0); PG8_MMA(0, 1, At, B1); PG8_BAR; PG8_SCHED;
            PG8_LDA(At, 0, 1); PG8_STAGE(PG8_SB(0, 0), b2, voffB); PG8_STAGE(PG8_SB(0, 1), b2 + hstep, voffB); PG8_STAGE(PG8_SA(0, 0), a2, voffA);
            PG8_WAIT_V(8); PG8_WAIT_L(0); PG8_BAR; PG8_MMA(1, 0, At, B0); PG8_MMA(1, 1, At, B1); PG8_BAR; PG8_SCHED;
            PG8_LDB(B0, 1, 0); PG8_LDB(B1, 1, 1); PG8_SCHED; PG8_LDA(At, 1, 0); PG8_STAGE(PG8_SA(0, 1), a2 + hstep, voffA);
            PG8_WAIT_V(8); PG8_WAIT_L(0); PG8_BAR; PG8_MMA(0, 0, At, B0); PG8_MMA(0, 1, At, B1); PG8_BAR; PG8_SCHED;
            PG8_LDA(At, 1, 1); PG8_STAGE(PG8_SB(1, 0), b3, voffB); PG8_STAGE(PG8_SB(1, 1), b3 + hstep, voffB); PG8_STAGE(PG8_SA(1, 0), a3, voffA);
            PG8_WAIT_V(8); PG8_WAIT_L(0); PG8_BAR; PG8_MMA(1, 0, At, B0); PG8_MMA(1, 1, At, B1); PG8_BAR; PG8_SCHED;
            } else {
            PG8_LDB(B0, 0, 0); PG8_SCHED; PG8_LDA(At, 0, 0); PG8_STAGE(PG8_SA(1, 1), a1 + hstep, voffA);
            PG8_WAIT_L(8); PG8_BAR; PG8_WAIT_L(0); PG8_MMA(0, 0, At, B0); PG8_BAR; PG8_SCHED;
            PG8_LDB(B1, 0, 1); PG8_STAGE(PG8_SB(0, 0), b2, voffB);
            PG8_BAR; PG8_WAIT_L(0); PG8_MMA(0, 1, At, B1); PG8_BAR;
            PG8_LDA(At, 0, 1); PG8_STAGE(PG8_SA(0, 0), a2, voffA);
            PG8_BAR; PG8_WAIT_L(0); PG8_MMA(1, 0, At, B0); PG8_BAR; PG8_SCHED;
            PG8_STAGE(PG8_SB(0, 1), b2 + hstep, voffB);
            PG8_WAIT_V(6); PG8_BAR; PG8_MMA(1, 1, At, B1); PG8_BAR;
            PG8_LDB(B0, 1, 0); PG8_SCHED; PG8_LDA(At, 1, 0); PG8_STAGE(PG8_SA(0, 1), a2 + hstep, voffA);
            PG8_WAIT_L(8); PG8_BAR; PG8_WAIT_L(0); PG8_MMA(0, 0, At, B0); PG8_BAR; PG8_SCHED;
            PG8_LDB(B1, 1, 1); PG8_STAGE(PG8_SB(1, 0), b3, voffB);
            PG8_BAR; PG8_WAIT_L(0); PG8_MMA(0, 1, At, B1); PG8_BAR;
            PG8_LDA(At, 1, 1); PG8_STAGE(PG8_SA(1, 0), a3, voffA);
            PG8_BAR; PG8_WAIT_L(0); PG8_MMA(1, 0, At, B0); PG8_BAR; PG8_SCHED;
            PG8_STAGE(PG8_SB(1, 1), b3 + hstep, voffB);
            PG8_WAIT_V(6); PG8_BAR; PG8_MMA(1, 1, At, B1); PG8_BAR;
            }
        }
        if constexpr (ALIGN_EPI) { if (wr == 0) PG8_BAR; }
        E(acc, cur, wr, wc, fr, fq); S.done(cur);
        if (!has_next) break;
#pragma unroll
        for (int a = 0; a < 2; ++a)
#pragma unroll
            for (int b = 0; b < 2; ++b)
#pragma unroll
                for (int m = 0; m < 4; ++m)
#pragma unroll
                    for (int n = 0; n < 2; ++n) acc[a][b][m][n] = (f32x4){0.f, 0.f, 0.f, 0.f};
        cur = nxt; cA = nA; cB = nB; ++ui;
        if constexpr (ALIGN_EPI) { if (wr == 1) PG8_BAR; }
    }
    PG8_WAIT_V(0);
    if constexpr (!ALIGN_EPI) { if (wr == 0) PG8_BAR; }
    PG8_BAR;
#undef PG8_SA
#undef PG8_SB
#undef PG8_STAGE
#undef PG8_LDA
#undef PG8_LDB
#undef PG8_MMA
#undef PG8_WAIT_V
#undef PG8_WAIT_L
#undef PG8_BAR
#undef PG8_SCHED
}

typedef const f32x4 (&AccRef)[2][2][4][2];
__device__ __forceinline__ u32x4 pack8(f32x4 v0, f32x4 v1) { u32x4 w; w.x = pk2(v0[0], v0[1]); w.y = pk2(v0[2], v0[3]); w.z = pk2(v1[0], v1[1]); w.w = pk2(v1[2], v1[3]); return w; }
__device__ __forceinline__ void unpack8(u32x4 w, f32x4& v0, f32x4& v1) { v0 = (f32x4){bflo(w.x), bfhi(w.x), bflo(w.y), bfhi(w.y)}; v1 = (f32x4){bflo(w.z), bfhi(w.z), bflo(w.w), bfhi(w.w)}; }

struct EpiBf16 {
    static constexpr bool PERM = true, SWAP = false;
    bf16_t* O; int ldc;
    __device__ __forceinline__ void operator()(AccRef acc, const Unit& u, int wr, int wc, int fr, int fq) const {
        const int row0 = u.pm * BM + wr * 64 + fr, col0 = u.pn * BM + wc * 32 + 8 * fq;
#pragma unroll
        for (int ai = 0; ai < 2; ++ai)
#pragma unroll
            for (int m = 0; m < 4; ++m) { bf16_t* rowp = O + (size_t)(row0 + ai * HALF + m * 16) * ldc + col0;
#pragma unroll
                for (int bj = 0; bj < 2; ++bj) *(u32x4*)(rowp + bj * HALF) = pack8(acc[ai][bj][m][0], acc[ai][bj][m][1]); }
    }
};
struct EpiProj {
    static constexpr bool PERM = true, SWAP = false;
    bf16_t* O; const float* rope; bf16_t* KB;
    __device__ __forceinline__ void operator()(AccRef acc, const Unit& u, int wr, int wc, int fr, int fq) const {
        const int row0 = u.pm * BM + wr * 64 + fr, col0 = u.pn * BM + wc * 32 + 8 * fq;
        const int mode = (u.pn >= 27 && u.pn < 43) ? (u.pn < 35 ? 1 : 2) : 0;
        const float sc = (mode == 1) ? QSCALE : 1.0f;
#pragma unroll
        for (int ai = 0; ai < 2; ++ai)
#pragma unroll
            for (int m = 0; m < 4; ++m) { const int row = row0 + ai * HALF + m * 16; bf16_t* rowp = O + (size_t)row * PLD + col0;
#pragma unroll
                for (int bj = 0; bj < 2; ++bj) { f32x4 v0 = acc[ai][bj][m][0], v1 = acc[ai][bj][m][1];
                    if (mode) { const int i0 = ((col0 + bj * HALF) & 127) >> 1; const f32x4* rp = (const f32x4*)(rope + ((size_t)row * 64 + i0) * 2); const f32x4 c0 = rp[0], c1 = rp[1];
                        f32x4 o0, o1;
                        o0[0] = v0[0] * c0[0] - v0[1] * c0[1]; o0[1] = v0[1] * c0[0] + v0[0] * c0[1]; o0[2] = v0[2] * c0[2] - v0[3] * c0[3]; o0[3] = v0[3] * c0[2] + v0[2] * c0[3];
                        o1[0] = v1[0] * c1[0] - v1[1] * c1[1]; o1[1] = v1[1] * c1[0] + v1[0] * c1[1]; o1[2] = v1[2] * c1[2] - v1[3] * c1[3]; o1[3] = v1[3] * c1[2] + v1[2] * c1[3];
                        v0 = o0 * sc; v1 = o1 * sc; }
                    if (mode == 2) *(u32x4*)(KB + ((size_t)((u.pn - 35) * 2 + bj) * T + row) * MD + wc * 32 + 8 * fq) = pack8(v0, v1);
                    else *(u32x4*)(rowp + bj * HALF) = pack8(v0, v1); } }
    }
};
struct EpiVT {
    static constexpr bool PERM = false, SWAP = true;
    bf16_t* VT;
    __device__ __forceinline__ void operator()(AccRef acc, const Unit& u, int wr, int wc, int fr, int fq) const {
        const int tok0 = u.pm * BM + wr * 64 + 4 * fq, col0 = u.pn * BM + wc * 32 + fr;
#pragma unroll
        for (int ai = 0; ai < 2; ++ai)
#pragma unroll
            for (int m = 0; m < 4; ++m)
#pragma unroll
                for (int bj = 0; bj < 2; ++bj)
#pragma unroll
                    for (int n = 0; n < 2; ++n) { const f32x4 v = acc[ai][bj][m][n]; u32x2 w; w.x = pk2(v[0], v[1]); w.y = pk2(v[2], v[3]);
                        const int d = col0 + bj * HALF + n * 16, tl = (u.pm * BM + wr * 64 + ai * HALF) >> 6;
                        *(u32x2*)(VT + ((size_t)((d >> 7) * (T / 64) + tl) * MD + (d & 127)) * 64 + m * 16 + 4 * (((fq & 1) << 1) | (fq >> 1))) = w; }
    }
};
struct EpiDec {
    static constexpr bool PERM = true, SWAP = false;
    float* O; const float* w0;
    __device__ __forceinline__ void operator()(AccRef acc, const Unit& u, int wr, int wc, int fr, int fq) const {
        const int row0 = u.pm * BM + wr * 64 + fr, col0 = u.pn * BM + wc * 32 + 8 * fq;
#pragma unroll
        for (int bj = 0; bj < 2; ++bj) { const f32x4 b0 = *(const f32x4*)(w0 + col0 + bj * HALF), b1 = *(const f32x4*)(w0 + col0 + bj * HALF + 4);
#pragma unroll
            for (int ai = 0; ai < 2; ++ai)
#pragma unroll
                for (int m = 0; m < 4; ++m) { float* rowp = O + (size_t)(row0 + ai * HALF + m * 16) * RW + col0 + bj * HALF;
#pragma unroll
                    for (int n = 0; n < 2; ++n) { const f32x4 x = acc[ai][bj][m][n] + (n ? b1 : b0); f32x4 o;
#pragma unroll
                        for (int e = 0; e < 4; ++e) {
                            const float sg = __builtin_amdgcn_rcpf(1.0f + __builtin_amdgcn_exp2f(-1.44269504f * x[e])); o[e] = __builtin_amdgcn_exp2f(-0.875038775f * sg); }
                        *(f32x4*)(rowp + 4 * n) = o; }
                    asm volatile("" ::: "memory"); } }
    }
};
struct EpiA {
    static constexpr bool PERM = true, SWAP = false;
    bf16_t* KP; bf16_t* BB; const bf16_t* KKN; const float* a0; const float* k_a;
    __device__ __forceinline__ void operator()(AccRef acc, const Unit& u, int wr, int wc, int fr, int fq) const {
        const int row0 = u.pm * BM + wr * 64 + fr, col0 = u.pn * BM + wc * 32 + 8 * fq;
#pragma unroll
        for (int bj = 0; bj < 2; ++bj) { const int cb = col0 + bj * HALF;
            const f32x4 b0 = *(const f32x4*)(a0 + cb), b1 = *(const f32x4*)(a0 + cb + 4), ka0 = *(const f32x4*)(k_a + cb), ka1 = *(const f32x4*)(k_a + cb + 4);
#pragma unroll
            for (int ai = 0; ai < 2; ++ai)
#pragma unroll
                for (int m = 0; m < 4; ++m) { const size_t off = (size_t)(row0 + ai * HALF + m * 16) * RW + cb;
                    f32x4 zk0, zk1, kn0, kn1; unpack8(*(const u32x4*)(KP + off), zk0, zk1); unpack8(*(const u32x4*)(KKN + off), kn0, kn1);
                    f32x4 a0v, a1v;
#pragma unroll
                    for (int e = 0; e < 4; ++e) { a0v[e] = fsigmoid(acc[ai][bj][m][0][e] + b0[e]); a1v[e] = fsigmoid(acc[ai][bj][m][1][e] + b1[e]); }
                    const f32x4 kp0 = zk0 * (1.0f + (a0v - 1.0f) * ka0), kp1 = zk1 * (1.0f + (a1v - 1.0f) * ka1);
                    *(u32x4*)(KP + off) = pack8(kp0, kp1); *(u32x4*)(BB + off) = pack8(-(kn0 * a0v), -(kn1 * a1v));
                    asm volatile("" ::: "memory"); } }
    }
};
template <bool ADD> struct EpiMix {
    static constexpr bool PERM = true, SWAP = false;
    bf16_t* O; const bf16_t* proj; int gcol0;
    __device__ __forceinline__ void operator()(AccRef acc, const Unit& u, int wr, int wc, int fr, int fq) const {
        const int row0 = u.pm * BM + wr * 64 + fr, col0 = u.pn * BM + wc * 32 + 8 * fq;
#pragma unroll
        for (int ai = 0; ai < 2; ++ai)
#pragma unroll
            for (int m = 0; m < 4; ++m) { const int row = row0 + ai * HALF + m * 16;
#pragma unroll
                for (int bj = 0; bj < 2; ++bj) { f32x4 g0, g1; unpack8(*(const u32x4*)(proj + (size_t)row * PLD + gcol0 + col0 + bj * HALF), g0, g1);
                    f32x4 o0, o1;
#pragma unroll
                    for (int e = 0; e < 4; ++e) { o0[e] = fsigmoid(g0[e]) * acc[ai][bj][m][0][e]; o1[e] = fsigmoid(g1[e]) * acc[ai][bj][m][1][e]; }
                    bf16_t* op = O + (size_t)row * D + col0 + bj * HALF;
                    if (ADD) { f32x4 p0, p1; unpack8(*(const u32x4*)op, p0, p1); o0 += p0; o1 += p1; }
                    *(u32x4*)op = pack8(o0, o1); } }
    }
};
struct EpiRes {
    static constexpr bool PERM = true, SWAP = false;
    bf16_t* O; const float* x; float* rsq;
    __device__ __forceinline__ void operator()(AccRef acc, const Unit& u, int wr, int wc, int fr, int fq) const {
        const int row0 = u.pm * BM + wr * 64 + fr, col0 = u.pn * BM + wc * 32 + 8 * fq;
#pragma unroll
        for (int ai = 0; ai < 2; ++ai)
#pragma unroll
            for (int m = 0; m < 4; ++m) { const int row = row0 + ai * HALF + m * 16; const size_t off = (size_t)row * D + col0; float ss = 0.f;
#pragma unroll
                for (int bj = 0; bj < 2; ++bj) { const f32x4 a = *(const f32x4*)(x + off + bj * HALF) + acc[ai][bj][m][0], b = *(const f32x4*)(x + off + bj * HALF + 4) + acc[ai][bj][m][1];
                    ss += ((a[0] * a[0] + a[1] * a[1]) + (a[2] * a[2] + a[3] * a[3])) + ((b[0] * b[0] + b[1] * b[1]) + (b[2] * b[2] + b[3] * b[3]));
                    *(u32x4*)(O + off + bj * HALF) = pack8(a, b); }
                ss += __shfl_xor(ss, 16); ss += __shfl_xor(ss, 32);
                if (fq == 0) rsq[(size_t)row * 64 + u.pn * 4 + wc] = ss; }
    }
};
}

#define XB_TMO      128
#define XB_XCNT(j)  (256  + 64 * (j))
#define XB_XSUB(j)  (1280 + 64 * (j))
#define XB_XGEN(j)  (2304 + 64 * (j))
#define XB_TOP      3328
#define XB_TOPGEN   3392
#define XCD_BAR_WORDS 3456
#define XB_SPIN_CAP (1u << 18)
__device__ __forceinline__ unsigned xb_ld(unsigned* p)              { return __hip_atomic_load(p, __ATOMIC_RELAXED, __HIP_MEMORY_SCOPE_AGENT); }
__device__ __forceinline__ unsigned xb_add(unsigned* p, unsigned v) { return __hip_atomic_fetch_add(p, v, __ATOMIC_RELAXED, __HIP_MEMORY_SCOPE_AGENT); }
__device__ __forceinline__ unsigned xb_xcc_id() { return (unsigned)__builtin_amdgcn_s_getreg((3 << 11) | 20) & 0xFu; }
#define XB_SPIN(cond, bar) do { unsigned _sp = 0; while (cond) { __builtin_amdgcn_s_sleep(1); \
    if ((++_sp & 255u) == 0u) { if (xb_ld(&(bar)[XB_TMO])) break; if (_sp > XB_SPIN_CAP) { atomicAdd(&(bar)[XB_TMO], 1u); break; } } } } while (0)
struct XcdBarrier { unsigned* bar; unsigned x; volatile LAS unsigned* st; };
__device__ __forceinline__ XcdBarrier xcd_barrier_post(unsigned* bar, volatile LAS unsigned* st) {
    XcdBarrier b; b.bar = bar; b.x = xb_xcc_id(); b.st = st;
    if (threadIdx.x == 0) (void)xb_add(&bar[XB_XCNT(b.x)], 1u);
    return b;
}
__device__ __forceinline__ void xcd_barrier_complete(unsigned* bar, unsigned x, unsigned& nloc, unsigned& nx) {
    const unsigned G = gridDim.x * gridDim.y * gridDim.z;
    unsigned sum, cnt, mine, sp = 0u;
    for (;;) {
        sum = 0u; cnt = 0u; mine = 0u;
#pragma unroll
        for (unsigned j = 0; j < 16; ++j) { const unsigned c = xb_ld(&bar[XB_XCNT(j)]); sum += c; cnt += (c > 0u) ? 1u : 0u; mine = (j == x) ? c : mine; }
        if (sum == G) break;
        __builtin_amdgcn_s_sleep(1);
        if ((++sp & 255u) == 0u) { if (xb_ld(&bar[XB_TMO])) break; if (sp > XB_SPIN_CAP) { atomicAdd(&bar[XB_TMO], 1u); break; } }
    }
    nloc = mine > 0u ? mine : 1u; nx = cnt > 0u ? cnt : 1u;
}
__device__ __forceinline__ void xcd_barrier(const XcdBarrier& b) {
    asm volatile("s_waitcnt vmcnt(0)" ::: "memory");
    __syncthreads();
    if (threadIdx.x == 0) {
        unsigned* bar = b.bar;
        __builtin_amdgcn_s_waitcnt(0);
        unsigned nloc = b.st[0], nx = b.st[1];
        if (nloc == 0u) { xcd_barrier_complete(bar, b.x, nloc, nx); b.st[0] = nloc; b.st[1] = nx; }
        const unsigned old = xb_add(&bar[XB_XSUB(b.x)], 1u);
        const unsigned gen = old / nloc;
        if (old + 1u == (gen + 1u) * nloc) {
            __builtin_amdgcn_fence(__ATOMIC_RELEASE, "agent");
            asm volatile("s_waitcnt vmcnt(0)" ::: "memory");
            const unsigned og = xb_add(&bar[XB_TOP], 1u);
            const unsigned tg = og / nx;
            if (og + 1u == (tg + 1u) * nx) xb_add(&bar[XB_TOPGEN], 1u);
            else XB_SPIN(xb_ld(&bar[XB_TOPGEN]) == tg, bar);
            __builtin_amdgcn_fence(__ATOMIC_ACQUIRE, "agent");
            xb_add(&bar[XB_XGEN(b.x)], 1u);
            asm volatile("s_waitcnt vmcnt(0)" ::: "memory");
        } else {
            XB_SPIN(xb_ld(&bar[XB_XGEN(b.x)]) == gen, bar);
            __builtin_amdgcn_fence(__ATOMIC_ACQUIRE, "agent");
            asm volatile("s_waitcnt vmcnt(0)" ::: "memory");
        }
    }
    __syncthreads();
}

struct Args {
    const float *x, *norm1_g, *w_in, *mu, *w0, *w_up, *a0, *a_up, *g_up, *k_k, *k_a, *r_k, *lnx_g, *lnx_b, *w_ba, *w_bb, *w_out, *norm2_g, *peer_wq, *sub_keys, *peer_u, *peer_v, *final_g;
    float* out; unsigned char* ws; int ph_lo, ph_hi, li, pad;
};
#define CAS __attribute__((address_space(4)))
typedef const CAS Args* ArgsP;
__device__ __forceinline__ ArgsP get_args() { ArgsP p = (ArgsP)__builtin_amdgcn_kernarg_segment_ptr(); asm volatile("" : "+s"(p)); return p; }
struct Frame { LAS unsigned char* lds; int tid, lane, wave, vcu, G; };

__device__ __forceinline__ int win_dst(int s) {
    if (s < SHIFTW) return s;
    if (s < SHIFTW + 4096) { const int base = (s < SHIFTW + 2048) ? SHIFTW : SHIFTW + 2048; const int m = s - base, head = m >> 7, c = m & 127; const int j = (c < 64) ? 2 * c : 2 * (c - 64) + 1;
        return ((s < SHIFTW + 2048) ? PC_MQ : PC_MK) + head * 128 + j; }
    if (s < SHIFTW + 6144) return PC_MV + (s - (SHIFTW + 4096));
    if (s < SHIFTW + 6144 + 4096) return PC_GA + (s - (SHIFTW + 6144));
    return PC_GB + (s - (SHIFTW + 6144 + 4096));
}
template <bool MAPWIN> __device__ __forceinline__ void p0_transpose_item(const float* W, int K, int N, bf16_t* WT, int Kd, LAS float* scr, int item, int lane, const float* kscale = nullptr) {
    const int nblk = N / 32, kb = item / nblk, nb = item % nblk, k0 = 64 * kb, n0 = 32 * nb;
    { const int krow = lane >> 3, c4 = lane & 7; f32x4 v[8];
#pragma unroll
      for (int i = 0; i < 8; ++i) { const int kk = 8 * i + krow; v[i] = (k0 + kk < K) ? *(const f32x4*)(W + (size_t)(k0 + kk) * N + n0 + 4 * c4) : (f32x4){0.f, 0.f, 0.f, 0.f}; }
      if (kscale) {
#pragma unroll
          for (int i = 0; i < 8; ++i) { const int kk = 8 * i + krow; if (k0 + kk < K) v[i] = v[i] * kscale[k0 + kk]; } }
#pragma unroll
      for (int i = 0; i < 8; ++i) { LAS float* d = scr + (8 * i + krow) * 33 + 4 * c4; d[0] = v[i].x; d[1] = v[i].y; d[2] = v[i].z; d[3] = v[i].w; } }
    LDS_WAIT(); asm volatile("" ::: "memory");
    const int c = lane & 7;
#pragma unroll
    for (int j = 0; j < 4; ++j) { const int n = (lane >> 3) + 8 * j; const LAS float* s = scr + (8 * c) * 33 + n;
        u32x4 o; o.x = pk2(s[0 * 33], s[1 * 33]); o.y = pk2(s[2 * 33], s[3 * 33]); o.z = pk2(s[4 * 33], s[5 * 33]); o.w = pk2(s[6 * 33], s[7 * 33]);
        const int row = MAPWIN ? win_dst(n0 + n) : (n0 + n);
        *(u32x4*)(WT + (size_t)row * Kd + k0 + 8 * c) = o; }
    LDS_WAIT(); asm volatile("" ::: "memory");
}
__device__ __forceinline__ void rms_rows_to_bf16(const float* x, const float* g, bf16_t* o, int m0, int mstride, int lane) {
    const f32x4* gr = (const f32x4*)g + lane;
    f32x4 v[16], w[16];
    if (m0 < T) {
#pragma unroll
        for (int j = 0; j < 16; ++j) v[j] = ((const f32x4*)(x + (size_t)m0 * D) + lane)[64 * j]; }
    for (int m = m0; m < T; m += mstride) { const bool hasn = m + mstride < T;
        if (hasn) {
#pragma unroll
            for (int j = 0; j < 16; ++j) w[j] = ((const f32x4*)(x + (size_t)(m + mstride) * D) + lane)[64 * j]; }
        float s = 0.f;
#pragma unroll
        for (int j = 0; j < 16; ++j) s += (v[j].x * v[j].x + v[j].y * v[j].y) + (v[j].z * v[j].z + v[j].w * v[j].w);
        const float rs = 1.0f / sqrtf(wave_sum(s) * (1.0f / D) + NORM_EPS);
        u32x2* o8 = (u32x2*)(o + (size_t)m * D) + lane;
#pragma unroll
        for (int j = 0; j < 16; ++j) { const f32x4 gg = gr[64 * j]; u32x2 q; q.x = pk2(v[j].x * rs * gg.x, v[j].y * rs * gg.y); q.y = pk2(v[j].z * rs * gg.z, v[j].w * rs * gg.w); o8[64 * j] = q; }
        if (hasn) {
#pragma unroll
            for (int j = 0; j < 16; ++j) v[j] = w[j]; }
    }
}
__device__ __forceinline__ void cvt_table(const float* src, bf16_t* dst, size_t n8, size_t gtid, size_t nthr) {
    for (size_t i = gtid; i < n8; i += nthr) { const f32x4 a = ((const f32x4*)src)[2 * i], b = ((const f32x4*)src)[2 * i + 1]; ((u32x4*)dst)[i] = pg8::pack8(a, b); }
}
__device__ __forceinline__ void pq_load(ArgsP A, int row, int lane, f32x4 (&v)[16]) {
    const f32x4* src = (const f32x4*)((row >= 16384 ? A->peer_v + (size_t)(row - 16384) * D : A->peer_u + (size_t)row * D)) + lane;
#pragma unroll
    for (int j = 0; j < 16; ++j) v[j] = __builtin_nontemporal_load(src + 64 * j);
}
__device__ __forceinline__ void pq_finish(unsigned char* ws, int row, int lane, const f32x4 (&v)[16]) {
    const bool isv = row >= 16384; const int rr = isv ? row - 16384 : row; float am = 0.f;
#pragma unroll
    for (int j = 0; j < 16; ++j) am = fmaxf(fmaxf(am, fmaxf(fabsf(v[j].x), fabsf(v[j].y))), fmaxf(fabsf(v[j].z), fabsf(v[j].w)));
#pragma unroll
    for (int o = 1; o < 64; o <<= 1) am = fmaxf(am, __shfl_xor(am, o));
    const float inv = am > 0.f ? 127.0f / am : 0.f; unsigned* dst = (unsigned*)(ws + (isv ? WS_PV : WS_PU)) + (size_t)rr * (D / 4) + lane;
    constexpr float MAGIC = 8388608.0f + 128.0f;
#pragma unroll
    for (int j = 0; j < 16; ++j) { const unsigned b0 = __builtin_bit_cast(unsigned, __builtin_fmaf(v[j].x, inv, MAGIC)), b1 = __builtin_bit_cast(unsigned, __builtin_fmaf(v[j].y, inv, MAGIC)),
                                                  b2 = __builtin_bit_cast(unsigned, __builtin_fmaf(v[j].z, inv, MAGIC)), b3 = __builtin_bit_cast(unsigned, __builtin_fmaf(v[j].w, inv, MAGIC));
        dst[64 * j] = __builtin_amdgcn_perm(__builtin_amdgcn_perm(b3, b2, 0x0c0c0400u), __builtin_amdgcn_perm(b1, b0, 0x0c0c0400u), 0x05040100u); }
    if (lane == 0) ((float*)(ws + (isv ? WS_PSV : WS_PSU)))[rr] = am * (1.0f / 127.0f);
}
__device__ __forceinline__ int pq_ra(int G) { constexpr int NT1 = (T / 256) * (PLD / 256); const int nx = NT1 % G, idle = nx ? G - nx : 0, n = idle * NWAVES * 7; return n < 2 * 16384 ? n : 2 * 16384; }
__device__ __forceinline__ void peer_quant(ArgsP A, Frame& F, int r0, int r1, int w0, int wstride) {
    f32x4 v[16], w[16];
    int row = r0 + w0;
    if (row < r1) pq_load(A, row, F.lane, v);
    for (; row < r1; row += wstride) { const bool hasn = row + wstride < r1;
        if (hasn) pq_load(A, row + wstride, F.lane, w);
        pq_finish(A->ws, row, F.lane, v);
        if (hasn) {
#pragma unroll
            for (int j = 0; j < 16; ++j) v[j] = w[j]; }
    }
}
__device__ __forceinline__ void late_weights(ArgsP A, Frame& F, int w0, int wstride) {
    unsigned char* ws = A->ws;
    LAS float* scr = (LAS float*)(F.lds + RING_OFF + F.wave * 16384);
    constexpr int I_BA = 32 * 128, I_OUT = 64 * 128, I_WQ = 64 * 64, I_SK = PH_ * 2 * PNK * PHALF / 512;
    constexpr int NITEMS = 2 * I_BA + I_OUT + I_WQ + I_SK;
    for (int it = w0; it < NITEMS; it += wstride) {
        int r = it;
        if (r < I_BA) { p0_transpose_item<false>(A->w_ba, RW, D, (bf16_t*)(ws + WS_WA), RW, scr, r, F.lane); continue; } r -= I_BA;
        if (r < I_BA) { p0_transpose_item<false>(A->w_bb, RW, D, (bf16_t*)(ws + WS_WB), RW, scr, r, F.lane); continue; } r -= I_BA;
        if (r < I_OUT) { p0_transpose_item<false>(A->w_out, D, D, (bf16_t*)(ws + WS_WOUT), D, scr, r, F.lane); continue; } r -= I_OUT;
        if (r < I_WQ) { p0_transpose_item<false>(A->peer_wq, D, 2048, (bf16_t*)(ws + WS_WQ), D, scr, r, F.lane, A->norm2_g); continue; } r -= I_WQ;
        { const size_t i = (size_t)r * 64 + F.lane; const f32x4 a = ((const f32x4*)A->sub_keys)[2 * i], b = ((const f32x4*)A->sub_keys)[2 * i + 1]; ((u32x4*)(ws + WS_SUBK))[i] = pg8::pack8(a, b); }
    }
}
__device__ __forceinline__ void ph0_prologue(ArgsP A, Frame& F) {
    unsigned char* ws = A->ws;
    LAS float* scr = (LAS float*)(F.lds + RING_OFF + F.wave * 16384);
    const int gw = F.vcu * NWAVES + F.wave, NGW = F.G * NWAVES;
    constexpr int I_IN = 64 * (INW / 32), I_UP = 2 * 64, I_G = 8 * 64;
    constexpr int NITEMS = I_IN + 2 * I_UP + I_G;
    for (int it = gw; it < NITEMS; it += NGW) {
        int r = it;
        if (r < I_IN) { p0_transpose_item<true>(A->w_in, D, INW, (bf16_t*)(ws + WS_WIN), D, scr, r, F.lane); continue; } r -= I_IN;
        if (r < I_UP) { p0_transpose_item<false>(A->w_up, LW, RW, (bf16_t*)(ws + WS_WUP), LW, scr, r, F.lane); continue; } r -= I_UP;
        if (r < I_UP) { p0_transpose_item<false>(A->a_up, LA, RW, (bf16_t*)(ws + WS_AUP), LA, scr, r, F.lane); continue; } r -= I_UP;
        p0_transpose_item<false>(A->g_up, LG, RW, (bf16_t*)(ws + WS_GUP), LGP, scr, r, F.lane);
    }
    const size_t gtid = (size_t)F.vcu * NTHR + F.tid, nthr = (size_t)F.G * NTHR;
    for (size_t i = gtid; i < (size_t)32 * D / 8; i += nthr) ((u32x4*)((bf16_t*)(ws + WS_WIN) + (size_t)SHIFTW * D))[i] = (u32x4){0u, 0u, 0u, 0u};
    for (size_t i = gtid; i < (size_t)T * 64; i += nthr) { const int pos = (int)(i >> 6), fi = (int)(i & 63); const float inv = powf(10000.0f, -(float)fi / 64.0f); const float ang = (float)pos * inv;
        ((f32x2*)(ws + WS_ROPE))[i] = (f32x2){cosf(ang), sinf(ang)}; }
    rms_rows_to_bf16(A->x, A->norm1_g, (bf16_t*)(ws + WS_XN), gw, NGW, F.lane);
}

__device__ __forceinline__ f32x4 ld4bf(const bf16_t* p) { const u32x2 w = *(const u32x2*)p; return (f32x4){bflo(w.x), bfhi(w.x), bflo(w.y), bfhi(w.y)}; }
__device__ __forceinline__ void st4bf(bf16_t* p, f32x4 v) { u32x2 w; w.x = pk2(v[0], v[1]); w.y = pk2(v[2], v[3]); *(u32x2*)p = w; }
__device__ __forceinline__ void ph2_prep(ArgsP A, Frame& F) {
    unsigned char* ws = A->ws; const bf16_t* PROJ = (const bf16_t*)(ws + WS_PROJ);
    LAS float* red = (LAS float*)(F.lds + RING_OFF);
    for (int it = F.vcu; it < NBLK * MH; it += F.G) { const int n = it / MH, h = it % MH, d = F.tid & 127, part = F.tid >> 7;
        const bf16_t* p = (const bf16_t*)(ws + WS_KB) + ((size_t)h * T + n * MBLK + part * 64) * MD + d; float s = 0.f;
#pragma unroll 8
        for (int i = 0; i < 64; ++i) s += bf1(p[(size_t)i * MD]);
        red[F.tid] = s; WG_BAR();
        if (F.tid < 128) { const float m = (red[F.tid] + red[F.tid + 128] + red[F.tid + 256] + red[F.tid + 384]) * (1.0f / MBLK); const unsigned hi = f2bf(m); const float lo = m - __builtin_bit_cast(float, hi << 16);
            ((bf16_t*)(ws + WS_KMEAN))[(size_t)(h * NBLK + n) * MD + F.tid] = (bf16_t)hi; ((bf16_t*)(ws + WS_KMEAN + 131072))[(size_t)(h * NBLK + n) * MD + F.tid] = (bf16_t)f2bf(lo); }
        WG_BAR(); }
    const int tid = F.tid; const int c = 4 * tid;
    const f32x4 mu_r = *(const f32x4*)(A->mu + PC_R + c), mu_k = *(const f32x4*)(A->mu + PC_K + c), mu_v = *(const f32x4*)(A->mu + PC_V + c), kkw = *(const f32x4*)(A->k_k + c);
    int lc = 0, lcc = 0; if (tid < 32) { lcc = 4 * tid; lc = PC_WL + lcc; } else if (tid < 64) { lcc = 4 * (tid - 32); lc = PC_AL + lcc; } else { lcc = 4 * (tid - 64); lc = PC_GL + lcc; }
    const bool lact = tid < 64 || (tid < 192 && lcc < LG);
    const f32x4 mu_l = lact ? *(const f32x4*)(A->mu + lc) : (f32x4){0.f, 0.f, 0.f, 0.f};
    u32x2 cur[8], nxt[8];
    auto tload = [&](int t, u32x2 (&rg)[8]) { const bf16_t* P = PROJ + (size_t)t * PLD; const bf16_t* PP = t > 0 ? P - PLD : P;
        rg[0] = *(const u32x2*)(P + PC_R + c); rg[1] = *(const u32x2*)(PP + PC_R + c); rg[2] = *(const u32x2*)(P + PC_K + c); rg[3] = *(const u32x2*)(PP + PC_K + c);
        rg[4] = *(const u32x2*)(P + PC_V + c); rg[5] = *(const u32x2*)(PP + PC_V + c);
        if (lact) { rg[6] = *(const u32x2*)(P + lc); rg[7] = *(const u32x2*)(PP + lc); } else { rg[6] = (u32x2){0u, 0u}; rg[7] = (u32x2){0u, 0u}; } };
    auto up4 = [](u32x2 w) { return (f32x4){bflo(w.x), bfhi(w.x), bflo(w.y), bfhi(w.y)}; };
    if (F.vcu < T) tload(F.vcu, cur);
    for (int t = F.vcu; t < T; t += F.G) { const bool hasn = t + F.G < T; if (hasn) tload(t + F.G, nxt);
        const float hp = t > 0 ? 1.0f : 0.0f;
        { const f32x4 p = up4(cur[0]), pp = up4(cur[1]) * hp; st4bf((bf16_t*)(ws + WS_ZR) + (size_t)t * RW + c, p + (pp - p) * mu_r); }
        { const f32x4 p = up4(cur[2]), pp = up4(cur[3]) * hp; const f32x4 zk = p + (pp - p) * mu_k;
          st4bf((bf16_t*)(ws + WS_KP) + (size_t)t * RW + c, zk); const f32x4 kk = zk * kkw;
          const float ss = sum16((kk[0] * kk[0] + kk[1] * kk[1]) + (kk[2] * kk[2] + kk[3] * kk[3])); const float inv = 1.0f / fmaxf(sqrtf(ss), 1e-12f);
          st4bf((bf16_t*)(ws + WS_KKN) + (size_t)t * RW + c, kk * inv); }
        { const f32x4 p = up4(cur[4]), pp = up4(cur[5]) * hp; st4bf((bf16_t*)(ws + WS_ZV) + (size_t)t * RW + c, p + (pp - p) * mu_v); }
        if (tid < 192) { const f32x4 zero = (f32x4){0.f, 0.f, 0.f, 0.f};
            f32x4 z = zero; if (lact) { const f32x4 p = up4(cur[6]), pp = up4(cur[7]) * hp; z = p + (pp - p) * mu_l; }
            if (tid < 32) { f32x4 o;
#pragma unroll
                for (int e = 0; e < 4; ++e) o[e] = 1.0f - 2.0f * __builtin_amdgcn_rcpf(__expf(2.0f * z[e]) + 1.0f);
                st4bf((bf16_t*)(ws + WS_AW) + (size_t)t * LW + lcc, o); }
            else if (tid < 64) st4bf((bf16_t*)(ws + WS_AA) + (size_t)t * LA + lcc, z);
            else { f32x4 o = zero; if (lcc < LG) {
#pragma unroll
                for (int e = 0; e < 4; ++e) o[e] = fsigmoid(z[e]); }
                st4bf((bf16_t*)(ws + WS_AG) + (size_t)t * LGP + lcc, o); }
        }
        if (hasn) {
#pragma unroll
            for (int i = 0; i < 8; ++i) cur[i] = nxt[i]; }
    }
}

__device__ __forceinline__ void ph3_gate(ArgsP A, Frame& F) {
    unsigned char* ws = A->ws; const bf16_t* PROJ = (const bf16_t*)(ws + WS_PROJ); const bf16_t* KMH = (const bf16_t*)(ws + WS_KMEAN); const bf16_t* KML = (const bf16_t*)(ws + WS_KMEAN + 131072); unsigned* MASK = (unsigned*)(ws + WS_MASK);
    const int gw = F.vcu * NWAVES + F.wave, NGW = F.G * NWAVES; const int r = F.lane & 31, hh = F.lane >> 5; const float NEG = -__builtin_inff();
    for (int it = gw; it < (T / 32) * MH; it += NGW) { const int tg = it >> 4, h = it & 15, t = tg * 32 + r, blk = tg >> 3;
        if (blk == 0) { if (hh == 0) MASK[t * MH + h] = 0u; continue; }
        f32x16 acc;
#pragma unroll
        for (int e = 0; e < 16; ++e) acc[e] = 0.f;
#pragma unroll
        for (int ks = 0; ks < 8; ++ks) { const bf16x8 q = *(const bf16x8*)(PROJ + (size_t)t * PLD + PC_MQ + h * MD + 16 * ks + 8 * hh); const size_t ko = (size_t)(h * NBLK + r) * MD + 16 * ks + 8 * hh;
            acc = __builtin_amdgcn_mfma_f32_32x32x16_bf16(*(const bf16x8*)(KMH + ko), q, acc, 0, 0, 0); acc = __builtin_amdgcn_mfma_f32_32x32x16_bf16(*(const bf16x8*)(KML + ko), q, acc, 0, 0, 0); }
        float t0 = NEG, t1 = NEG, t2 = NEG;
#pragma unroll
        for (int e = 0; e < 16; ++e) { const int n = (e & 3) + 8 * (e >> 2) + 4 * hh; float ae = acc[e]; asm volatile("" : "+v"(ae));
            float x = __builtin_bit_cast(float, (__builtin_bit_cast(unsigned, ae) & ~31u) | (unsigned)(31 - n)); x = (n < blk) ? x : NEG;
            t2 = __builtin_amdgcn_fmed3f(t1, t2, x); t1 = __builtin_amdgcn_fmed3f(t0, t1, x); t0 = fmaxf(t0, x); }
        const float o0 = __shfl_xor(t0, 32), o1 = __shfl_xor(t1, 32), o2 = __shfl_xor(t2, 32);
        t2 = __builtin_amdgcn_fmed3f(t1, t2, o0); t1 = __builtin_amdgcn_fmed3f(t0, t1, o0); t0 = fmaxf(t0, o0);
        t2 = __builtin_amdgcn_fmed3f(t1, t2, o1); t1 = __builtin_amdgcn_fmed3f(t0, t1, o1); t0 = fmaxf(t0, o1);
        t2 = __builtin_amdgcn_fmed3f(t1, t2, o2); t1 = __builtin_amdgcn_fmed3f(t0, t1, o2); t0 = fmaxf(t0, o2);
        unsigned sel = 1u << (31 - (__builtin_bit_cast(unsigned, t0) & 31u));
        if (blk > 1) sel |= 1u << (31 - (__builtin_bit_cast(unsigned, t1) & 31u));
        if (blk > 2) sel |= 1u << (31 - (__builtin_bit_cast(unsigned, t2) & 31u));
        if (hh == 0) MASK[t * MH + h] = sel;
        { gu32* cnt = (gu32*)(ws + WS_CTL) + CW_CNT + h * 32; unsigned short* lst = (unsigned short*)(ws + WS_LIST) + (size_t)h * 32 * 8192; const unsigned mysel = hh == 0 ? sel : 0u;
          unsigned mycnt = 0u;
          for (int j = 0; j < blk; ++j) { const unsigned long long bal = __ballot((mysel >> j) & 1u); const unsigned c = (unsigned)__builtin_popcountll(bal); mycnt = (F.lane == j) ? c : mycnt; }
          unsigned base = 0u; if (F.lane < blk && mycnt) base = __hip_atomic_fetch_add(cnt + F.lane, mycnt, __ATOMIC_RELAXED, __HIP_MEMORY_SCOPE_AGENT);
          for (int j = 0; j < blk; ++j) { const unsigned long long bal = __ballot((mysel >> j) & 1u); const unsigned bj = (unsigned)__builtin_amdgcn_readlane((int)base, j);
              if ((mysel >> j) & 1u) { const unsigned off = __builtin_amdgcn_mbcnt_hi((unsigned)(bal >> 32), __builtin_amdgcn_mbcnt_lo((unsigned)bal, 0u)); const unsigned slot = (unsigned)__builtin_popcount(mysel & ((1u << j) - 1u));
                  lst[(size_t)j * 8192 + bj + off] = (unsigned short)((unsigned)t | (slot << 13)); } } } }
}

constexpr int CK = 64, NCHK = T / CK, CP = 144, CPF = 272;
constexpr int L_AT = 0, L_BT = 9216, L_KT = 18432, L_RT = 27648, L_ATT = 36864, L_BTT = 46080, L_V = 55296, L_MKA = 64512, L_MBRT = 73728, L_MKRT = 82944, L_A2 = 92160, L_MBA = 101376, L_PC = 118784, L_WT = 119040, L_MBH = 121088, L_TD = 130304, L_PT = 134912, L_CEND = 139520;
constexpr int L_TT = L_AT, L_A1 = L_BT, L_Y2T = L_MKA, L_G2T = L_ATT;
static_assert(L_CEND <= RING_BYTES, "chunk prep LDS");
constexpr size_t CHW_ITEM = 32768;
__device__ __forceinline__ f32x16 nt_quad(const LAS unsigned char* X, const LAS unsigned char* Y, int qp, int qq, int r, int hh) {
    f32x16 acc;
#pragma unroll
    for (int e = 0; e < 16; ++e) acc[e] = 0.f;
#pragma unroll
    for (int ks = 0; ks < 4; ++ks) { const bf16x8 a = *(const LAS bf16x8*)(Y + (32 * qq + r) * CP + 32 * ks + 16 * hh), b = *(const LAS bf16x8*)(X + (32 * qp + r) * CP + 32 * ks + 16 * hh);
        acc = __builtin_amdgcn_mfma_f32_32x32x16_bf16(a, b, acc, 0, 0, 0); }
    return acc;
}
__device__ __forceinline__ int nt_q(int qq, int e, int hh) { return 32 * qq + (e & 3) + 8 * (e >> 2) + 4 * hh; }
__device__ __forceinline__ void nt_store_bf16(LAS unsigned char* O, int p, int qq, int hh, const f32x16& v) {
#pragma unroll
    for (int g = 0; g < 4; ++g) { u32x2 w; w.x = pk2(v[4 * g], v[4 * g + 1]); w.y = pk2(v[4 * g + 2], v[4 * g + 3]); *(LAS u32x2*)(O + p * CP + (32 * qq + 8 * g + 4 * hh) * 2) = w; }
}
__device__ __forceinline__ void ph4_chunkprep(ArgsP A, Frame& F) {
    unsigned char* ws = A->ws;
    const float* DEC = (const float*)(ws + WS_DEC); const bf16_t* KKN = (const bf16_t*)(ws + WS_KKN); const bf16_t* BBg = (const bf16_t*)(ws + WS_BB); const bf16_t* KPg = (const bf16_t*)(ws + WS_KP);
    const bf16_t* ZR = (const bf16_t*)(ws + WS_ZR); const bf16_t* ZV = (const bf16_t*)(ws + WS_ZV); float* Yg = (float*)(ws + WS_Y); unsigned char* CHW = ws + WS_WIN;
    LAS unsigned char* L = F.lds + RING_OFF; const int wave = F.wave, lane = F.lane, r = lane & 31, hh = lane >> 5;
    const int prod = wave >> 2, qp = (wave >> 1) & 1, qq = wave & 1, p = 32 * qp + r;
    float nwv[8]; unsigned nkk[4], nbb[4], nkp[4], nr[4], nv[4];
    auto request = [&](int h2, int c2) {
#pragma unroll
        for (int k = 0; k < 8; ++k) nwv[k] = DEC[(size_t)(c2 * CK + 8 * wave + k) * RW + (size_t)h2 * RN + lane];
#pragma unroll
        for (int i = 0; i < 4; ++i) { const size_t o = (size_t)(c2 * CK + 8 * wave + 2 * i + hh) * RW + (size_t)h2 * RN + 2 * r;
            nkk[i] = *(const unsigned*)(KKN + o); nbb[i] = *(const unsigned*)(BBg + o); nkp[i] = *(const unsigned*)(KPg + o); nr[i] = *(const unsigned*)(ZR + o); nv[i] = *(const unsigned*)(ZV + o); } };
    if (F.vcu < RH * NCHK) request(F.vcu / NCHK, F.vcu % NCHK);
    if (F.vcu == 0 && wave == 0) {
        const gu32* cnt = (const gu32*)(ws + WS_CTL) + CW_CNT; unsigned* ud = (unsigned*)(ws + WS_UDESC); unsigned np[8], tot = 0u;
#pragma unroll
        for (int k = 0; k < 8; ++k) { const unsigned c = __hip_atomic_load(cnt + 8 * lane + k, __ATOMIC_RELAXED, __HIP_MEMORY_SCOPE_AGENT); np[k] = (c + 255u) >> 8; tot += np[k]; }
        unsigned incl = tot;
#pragma unroll
        for (int o = 1; o < 64; o <<= 1) { const unsigned v = __shfl_up(incl, o); if (lane >= o) incl += v; }
        unsigned pos = incl - tot;
#pragma unroll
        for (int k = 0; k < 8; ++k) { const unsigned c = __hip_atomic_load(cnt + 8 * lane + k, __ATOMIC_RELAXED, __HIP_MEMORY_SCOPE_AGENT); for (unsigned ps = 0; ps < np[k]; ++ps) { ud[1 + 2 * pos] = (unsigned)(8 * lane + k) | (ps << 16); ud[2 + 2 * pos] = c; ++pos; } }
        if (lane == 63) ud[0] = incl; }
    for (int item = F.vcu; item < RH * NCHK; item += F.G) { const int h = item / NCHK, c = item % NCHK; const size_t hc = (size_t)h * RN; const int t0 = c * CK;
        { float wv[8], kkv[8], bbv[8], kpv[8], rv[8]; unsigned vv[8];
#pragma unroll
          for (int k = 0; k < 8; ++k) { const int src = ((k & 1) << 7) | ((lane >> 1) << 2); const bool odd = lane & 1;
              auto mine = [&](unsigned x) { const unsigned w = (unsigned)__builtin_amdgcn_ds_bpermute(src, (int)x); return odd ? (w & 0xffff0000u) : (w << 16); };
              wv[k] = nwv[k]; kkv[k] = __builtin_bit_cast(float, mine(nkk[k >> 1])); bbv[k] = __builtin_bit_cast(float, mine(nbb[k >> 1])); kpv[k] = __builtin_bit_cast(float, mine(nkp[k >> 1]));
              rv[k] = __builtin_bit_cast(float, mine(nr[k >> 1])); vv[k] = mine(nv[k >> 1]) >> 16; }
          { const int nit = item + F.G; if (nit < RH * NCHK) request(nit / NCHK, nit % NCHK); }
          float pl[8]; pl[0] = wv[0];
#pragma unroll
          for (int k = 1; k < 8; ++k) pl[k] = pl[k - 1] * wv[k];
          ((LAS float*)(L + L_WT))[wave * 64 + lane] = pl[7];
          WG_BAR();
          float pre = 1.f;
#pragma unroll
          for (int w2 = 0; w2 < 7; ++w2) { const float x = ((const LAS float*)(L + L_WT))[w2 * 64 + lane]; pre = (w2 < wave) ? pre * x : pre; }
          unsigned atp[4], btp[4], vtp[4];
#pragma unroll
          for (int k = 0; k < 8; ++k) { const float Pt = pre * pl[k], Pm = (k == 0) ? pre : pre * pl[k - 1], ip = __builtin_amdgcn_rcpf(Pt); const int t = 8 * wave + k;
              const unsigned a16 = f2bf(Pm * kkv[k]), b16 = f2bf(bbv[k] * ip), k16 = f2bf(kpv[k] * ip), r16 = f2bf(Pt * rv[k]);
              *(LAS bf16_t*)(L + L_AT + t * CP + 2 * lane) = (bf16_t)a16; *(LAS bf16_t*)(L + L_BT + t * CP + 2 * lane) = (bf16_t)b16; *(LAS bf16_t*)(L + L_KT + t * CP + 2 * lane) = (bf16_t)k16; *(LAS bf16_t*)(L + L_RT + t * CP + 2 * lane) = (bf16_t)r16;
              if (k & 1) { atp[k >> 1] |= a16 << 16; btp[k >> 1] |= b16 << 16; vtp[k >> 1] |= vv[k] << 16; } else { atp[k >> 1] = a16; btp[k >> 1] = b16; vtp[k >> 1] = vv[k]; }
              if (wave == 7 && k == 7) ((LAS float*)(L + L_PC))[lane] = Pt; }
          *(LAS u32x4*)(L + L_ATT + lane * CP + 16 * wave) = (u32x4){atp[0], atp[1], atp[2], atp[3]}; *(LAS u32x4*)(L + L_BTT + lane * CP + 16 * wave) = (u32x4){btp[0], btp[1], btp[2], btp[3]};
          *(LAS u32x4*)(L + L_V + lane * CP + 16 * wave) = (u32x4){vtp[0], vtp[1], vtp[2], vtp[3]}; }
        WG_BAR();
        { const f32x16 v = nt_quad(L + (prod ? L_KT : L_BT), L + L_AT, qp, qq, r, hh); f32x16 m;
#pragma unroll
          for (int e = 0; e < 16; ++e) m[e] = nt_q(qq, e, hh) > p ? v[e] : 0.f;
          if (prod == 0) {
#pragma unroll
              for (int g = 0; g < 4; ++g) *(LAS f32x4*)(L + L_MBA + p * CPF + (32 * qq + 8 * g + 4 * hh) * 4) = (f32x4){m[4 * g], m[4 * g + 1], m[4 * g + 2], m[4 * g + 3]}; }
          if (prod == 0) nt_store_bf16(L + L_MBH, p, qq, hh, m);
          else nt_store_bf16(L + L_MKA, p, qq, hh, m); }
        { const f32x16 v = nt_quad(L + L_RT, L + (prod ? L_KT : L_BT), qp, qq, r, hh); f32x16 m;
#pragma unroll
          for (int e = 0; e < 16; ++e) m[e] = nt_q(qq, e, hh) <= p ? v[e] : 0.f;
          nt_store_bf16(L + (prod ? L_MKRT : L_MBRT), p, qq, hh, m); }
        WG_BAR();
        { const int t = 8 * wave + (lane >> 3), g = lane & 7, base = 32 * (t >> 5); float T4[4] = {0.f, 0.f, 0.f, 0.f};
          const LAS unsigned char* mrow = L + L_MBA + (base + 4 * g) * 4;
          f32x4 m = *(const LAS f32x4*)(mrow + (base + 31) * CPF);
#pragma unroll 1
          for (int Sx = 7; Sx >= 0; --Sx) {
#pragma unroll
              for (int q = 3; q >= 0; --q) { const int sl = 4 * Sx + q, sr = base + sl, sn = sl > 0 ? sr - 1 : sr; const f32x4 n = *(const LAS f32x4*)(mrow + sn * CPF);
                  float part = (m[0] * T4[0] + m[1] * T4[1]) + (m[2] * T4[2] + m[3] * T4[3]);
                  part += dpp_f<0xB1>(part); part += dpp_f<0x4E>(part); part += dpp_f<0x141>(part);
                  const float val = (sr == t) ? 1.0f : part; T4[q] = (g == Sx) ? val : T4[q]; m = n; } }
          const unsigned w0 = pk2(T4[0], T4[1]), w1 = pk2(T4[2], T4[3]);
          *(LAS u32x2*)(L + L_TT + t * CP + (base + 4 * g) * 2) = (u32x2){w0, w1};
          if (base == 0) { *(LAS u32x2*)(L + L_TT + t * CP + (32 + 4 * g) * 2) = (u32x2){0u, 0u};
              *(LAS bf16_t*)(L + L_TD + (4 * g) * CP + 2 * t) = (bf16_t)(w0 & 0xffffu); *(LAS bf16_t*)(L + L_TD + (4 * g + 1) * CP + 2 * t) = (bf16_t)(w0 >> 16);
              *(LAS bf16_t*)(L + L_TD + (4 * g + 2) * CP + 2 * t) = (bf16_t)(w1 & 0xffffu); *(LAS bf16_t*)(L + L_TD + (4 * g + 3) * CP + 2 * t) = (bf16_t)(w1 >> 16); } }
        WG_BAR();
        if (wave == 0) {
            f32x16 acc;
#pragma unroll
            for (int e = 0; e < 16; ++e) acc[e] = 0.f;
#pragma unroll
            for (int ks = 0; ks < 2; ++ks) { const bf16x8 a = *(const LAS bf16x8*)(L + L_MBH + r * CP + 64 + 32 * ks + 16 * hh), b = *(const LAS bf16x8*)(L + L_TT + (32 + r) * CP + 64 + 32 * ks + 16 * hh);
                acc = __builtin_amdgcn_mfma_f32_32x32x16_bf16(a, b, acc, 0, 0, 0); }
            nt_store_bf16(L + L_PT, r, 0, hh, acc);
            LDS_WAIT(); asm volatile("" ::: "memory");
#pragma unroll
            for (int e = 0; e < 16; ++e) acc[e] = 0.f;
#pragma unroll
            for (int ks = 0; ks < 2; ++ks) { const bf16x8 a = *(const LAS bf16x8*)(L + L_TD + r * CP + 32 * ks + 16 * hh), b = *(const LAS bf16x8*)(L + L_PT + r * CP + 32 * ks + 16 * hh);
                acc = __builtin_amdgcn_mfma_f32_32x32x16_bf16(a, b, acc, 0, 0, 0); }
            nt_store_bf16(L + L_TT, 32 + r, 0, hh, acc);
        }
        WG_BAR();
        { const f32x16 v = nt_quad(L + (prod ? L_MKA : L_ATT), L + L_TT, qp, qq, r, hh);
          nt_store_bf16(L + (prod ? L_A2 : L_A1), p, qq, hh, v); }
        WG_BAR();
        unsigned char* cw = CHW + (size_t)item * CHW_ITEM;
        { const f32x16 v = nt_quad(L + L_MBRT, L + (prod ? L_A2 : L_A1), qp, qq, r, hh); f32x16 o;
          const LAS unsigned char* addm = L + (prod ? L_MKRT : L_RT);
#pragma unroll
          for (int g = 0; g < 4; ++g) { const u32x2 w = *(const LAS u32x2*)(addm + p * CP + (32 * qq + 8 * g + 4 * hh) * 2); o[4 * g] = v[4 * g] + bflo(w.x); o[4 * g + 1] = v[4 * g + 1] + bfhi(w.x); o[4 * g + 2] = v[4 * g + 2] + bflo(w.y); o[4 * g + 3] = v[4 * g + 3] + bfhi(w.y); }
          if (prod) nt_store_bf16(L + L_Y2T, p, qq, hh, o);
          else {
#pragma unroll
              for (int g = 0; g < 4; ++g) { u32x2 w; w.x = pk2(o[4 * g], o[4 * g + 1]); w.y = pk2(o[4 * g + 2], o[4 * g + 3]); *(u32x2*)(cw + (size_t)p * 128 + (32 * qq + 8 * g + 4 * hh) * 2) = w; } } }
        { const f32x16 v = nt_quad(L + L_BTT, L + (prod ? L_A2 : L_A1), qp, qq, r, hh); const float pc = ((const LAS float*)(L + L_PC))[p]; f32x16 o;
          if (prod) {
#pragma unroll
              for (int e = 0; e < 16; ++e) o[e] = (v[e] + bf1(*(const LAS bf16_t*)(L + L_KT + nt_q(qq, e, hh) * CP + 2 * p))) * pc;
              nt_store_bf16(L + L_G2T, p, qq, hh, o); }
          else {
#pragma unroll
              for (int e = 0; e < 16; ++e) o[e] = (v[e] + (nt_q(qq, e, hh) == p ? 1.0f : 0.0f)) * pc;
#pragma unroll
              for (int g = 0; g < 4; ++g) { u32x2 w; w.x = pk2(o[4 * g], o[4 * g + 1]); w.y = pk2(o[4 * g + 2], o[4 * g + 3]); *(u32x2*)(cw + 8192 + (size_t)p * 128 + (32 * qq + 8 * g + 4 * hh) * 2) = w; } } }
        WG_BAR();
        { const f32x16 v = prod ? nt_quad(L + L_V, L + L_G2T, qp, qq, r, hh) : nt_quad(L + L_Y2T, L + L_V, qp, qq, r, hh);
          float* dst = prod ? (float*)(cw + 16384) + (size_t)p * 64 : Yg + (size_t)(t0 + p) * RW + hc;
#pragma unroll
          for (int g = 0; g < 4; ++g) *(f32x4*)(dst + 32 * qq + 8 * g + 4 * hh) = (f32x4){v[4 * g], v[4 * g + 1], v[4 * g + 2], v[4 * g + 3]}; }
        WG_BAR();
    }
}
__device__ __forceinline__ void ph5_chain(ArgsP A, Frame& F, int h) {
    unsigned char* ws = A->ws; float* Yg = (float*)(ws + WS_Y); const unsigned char* CHW = ws + WS_WIN;
    LAS unsigned char* L = F.lds + RING_OFF; const int wave = F.wave, lane = F.lane, tid = F.tid, r = lane & 31, hh = lane >> 5;
    const int prod = wave >> 2, qp = (wave >> 1) & 1, qq = wave & 1, p = 32 * qp + r; const size_t hc = (size_t)h * RN;
    constexpr int L_S = 0, L_G = 2 * 9216, L_Y1 = 3 * 9216;
    for (int i = tid; i < 2 * 9216 / 4; i += NTHR) ((LAS unsigned*)(L + L_S))[i] = 0u;
    const int srow = tid >> 3, sc16 = tid & 7; u32x4 sg, sy;
    auto stage_ld = [&](int c) { const unsigned char* cw = CHW + (size_t)(h * NCHK + c) * CHW_ITEM; sy = *(const u32x4*)(cw + srow * 128 + sc16 * 16); sg = *(const u32x4*)(cw + 8192 + srow * 128 + sc16 * 16); };
    f32x4 nad[4];
    auto ad_ld = [&](int c) { const unsigned char* cw2 = CHW + (size_t)(h * NCHK + c) * CHW_ITEM; const float* addp = prod ? Yg + (size_t)(c * CK + p) * RW + hc : (const float*)(cw2 + 16384) + (size_t)p * 64;
#pragma unroll
        for (int g = 0; g < 4; ++g) nad[g] = *(const f32x4*)(addp + 32 * qq + 8 * g + 4 * hh); };
    stage_ld(0); ad_ld(0);
    int sb = 0;
    for (int c = 0; c < NCHK; ++c) {
        *(LAS u32x4*)(L + L_Y1 + srow * CP + sc16 * 16) = sy; *(LAS u32x4*)(L + L_G + srow * CP + sc16 * 16) = sg;
        const unsigned char* cw = CHW + (size_t)(h * NCHK + c) * CHW_ITEM;
        f32x4 ad[4];
#pragma unroll
        for (int g = 0; g < 4; ++g) ad[g] = nad[g];
        if (c + 1 < NCHK) { stage_ld(c + 1); ad_ld(c + 1); }
        WG_BAR();
        const f32x16 v = prod ? nt_quad(L + L_Y1, L + L_S + sb * 9216, qp, qq, r, hh) : nt_quad(L + L_S + sb * 9216, L + L_G, qp, qq, r, hh);
        f32x16 o;
#pragma unroll
        for (int g = 0; g < 4; ++g) { o[4 * g] = v[4 * g] + ad[g][0]; o[4 * g + 1] = v[4 * g + 1] + ad[g][1]; o[4 * g + 2] = v[4 * g + 2] + ad[g][2]; o[4 * g + 3] = v[4 * g + 3] + ad[g][3]; }
        if (prod) { float* yp = Yg + (size_t)(c * CK + p) * RW + hc;
#pragma unroll
            for (int g = 0; g < 4; ++g) *(f32x4*)(yp + 32 * qq + 8 * g + 4 * hh) = (f32x4){o[4 * g], o[4 * g + 1], o[4 * g + 2], o[4 * g + 3]}; }
        else nt_store_bf16(L + L_S + (sb ^ 1) * 9216, p, qq, hh, o);
        sb ^= 1;
        WG_BAR();
    }
}

__device__ __forceinline__ void ph5_ypost(ArgsP A, Frame& F) {
    unsigned char* ws = A->ws; const float* Y = (const float*)(ws + WS_Y); const bf16_t* ZR = (const bf16_t*)(ws + WS_ZR); const bf16_t* KP = (const bf16_t*)(ws + WS_KP); const bf16_t* ZV = (const bf16_t*)(ws + WS_ZV);
    const bf16_t* G = (const bf16_t*)(ws + WS_G); bf16_t* YA = (bf16_t*)(ws + WS_YA);
    const int gw = F.vcu * NWAVES + F.wave, NGW = F.G * NWAVES;
    const int c = F.wave * 256 + 4 * F.lane; const f32x4 rk = *(const f32x4*)(A->r_k + c), lg = *(const f32x4*)(A->lnx_g + c), lb = *(const f32x4*)(A->lnx_b + c);
    for (int tg = F.vcu; tg < T / 32; tg += F.G) for (int tq = 0; tq < 32; tq += 4) {
        f32x4 y[4]; u32x2 rr[4], kk[4], vv[4], gg[4];
#pragma unroll
        for (int u = 0; u < 4; ++u) { const size_t o = (size_t)(tg * 32 + tq + u) * RW + c; y[u] = *(const f32x4*)(Y + o); rr[u] = *(const u32x2*)(ZR + o); kk[u] = *(const u32x2*)(KP + o); vv[u] = *(const u32x2*)(ZV + o); gg[u] = *(const u32x2*)(G + o); }
#pragma unroll
        for (int u = 0; u < 4; ++u) { const size_t o = (size_t)(tg * 32 + tq + u) * RW + c;
            const float mean = sum16((y[u][0] + y[u][1]) + (y[u][2] + y[u][3])) * (1.0f / 64.0f); const f32x4 d = y[u] - mean;
            const float var = sum16((d[0] * d[0] + d[1] * d[1]) + (d[2] * d[2] + d[3] * d[3])) * (1.0f / 64.0f); const float rs = 1.0f / sqrtf(var + LNX_EPS);
            const f32x4 r = (f32x4){bflo(rr[u].x), bfhi(rr[u].x), bflo(rr[u].y), bfhi(rr[u].y)}, k = (f32x4){bflo(kk[u].x), bfhi(kk[u].x), bflo(kk[u].y), bfhi(kk[u].y)};
            const f32x4 v = (f32x4){bflo(vv[u].x), bfhi(vv[u].x), bflo(vv[u].y), bfhi(vv[u].y)}, g = (f32x4){bflo(gg[u].x), bfhi(gg[u].x), bflo(gg[u].y), bfhi(gg[u].y)};
            const f32x4 rkk = r * k * rk; const float bonus = sum16((rkk[0] + rkk[1]) + (rkk[2] + rkk[3]));
            st4bf(YA + o, (d * rs * lg + lb + bonus * v) * g); } }
}

constexpr int AT_KB = 64 * 256, AT_VB = 128 * 128, AT_BUF = AT_KB + AT_VB;
static_assert(3 * AT_BUF <= RING_BYTES, "attention LDS");
__device__ __forceinline__ void q8_load(u32x4 (&q)[8], const void* p) {
    asm volatile("global_load_dwordx4 %0, %8, off\n\tglobal_load_dwordx4 %1, %8, off offset:32\n\tglobal_load_dwordx4 %2, %8, off offset:64\n\tglobal_load_dwordx4 %3, %8, off offset:96\n\t"
                 "global_load_dwordx4 %4, %8, off offset:128\n\tglobal_load_dwordx4 %5, %8, off offset:160\n\tglobal_load_dwordx4 %6, %8, off offset:192\n\tglobal_load_dwordx4 %7, %8, off offset:224"
                 : "=&v"(q[0]), "=&v"(q[1]), "=&v"(q[2]), "=&v"(q[3]), "=&v"(q[4]), "=&v"(q[5]), "=&v"(q[6]), "=&v"(q[7]) : "v"(p) : "memory"); }
__device__ __forceinline__ void q8_settle(u32x4 (&q)[8]) {
#pragma unroll
    for (int i = 0; i < 8; ++i) asm volatile("" : "+v"(q[i])); }
__device__ __forceinline__ unsigned u16_load(const void* p) { unsigned v; asm volatile("global_load_ushort %0, %1, off" : "=&v"(v) : "v"(p) : "memory"); return v; }
__device__ __forceinline__ void ph5_attn(ArgsP A, Frame& F) {
    unsigned char* ws = A->ws; const bf16_t* PROJ = (const bf16_t*)(ws + WS_PROJ); const bf16_t* VT = (const bf16_t*)(ws + WS_VT); const bf16_t* KBp = (const bf16_t*)(ws + WS_KB);
    bf16_t* PO = (bf16_t*)(ws + WS_PARTO); float* PML = (float*)(ws + WS_PARTML); const unsigned short* LST = (const unsigned short*)(ws + WS_LIST); const unsigned* UD = (const unsigned*)(ws + WS_UDESC);
    LAS unsigned char* L = F.lds + RING_OFF; const int wave = F.wave, lane = F.lane, r = lane & 31, hh = lane >> 5;
    const float NEG = -__builtin_inff();
    const int NA = MH * NBLK, N = NA + (int)UD[0], w = F.vcu, nfree = F.G - RH; const bool chainwg = w < RH;
    auto unit_of = [&](int k) { return k * nfree + (w - RH); };
    int k = 0;
    if (chainwg) return;
    if (unit_of(k) >= N) return;
    int h, kblk, qtok, slot; bool typeA, valid, wvalid;
    { const int u = unit_of(k); typeA = u < NA;
      if (typeA) { h = u & 15; kblk = u >> 4; qtok = kblk * MBLK + wave * 32 + r; slot = 3; valid = true; wvalid = true; }
      else { const unsigned d = UD[1 + 2 * (u - NA)]; const int cnt = (int)UD[2 + 2 * (u - NA)]; const int Lx = (int)(d & 0xffffu), ps = (int)(d >> 16); h = Lx >> 5; kblk = Lx & 31;
          const int idx = ps * 256 + wave * 32 + r; valid = idx < cnt; wvalid = ps * 256 + wave * 32 < cnt; unsigned e = u16_load(LST + (size_t)Lx * 8192 + (valid ? idx : 0));
          asm volatile("s_waitcnt vmcnt(0)" ::: "memory"); asm volatile("" : "+v"(e)); qtok = (int)(e & 0x1fffu); slot = (int)(e >> 13); }
      h = __builtin_amdgcn_readfirstlane(h); kblk = __builtin_amdgcn_readfirstlane(kblk); }
    u32x4 qf[8], qfn[8];
    q8_load(qf, PROJ + (size_t)qtok * PLD + PC_MQ + h * MD + 8 * hh);
    const int krow_ = lane >> 4, kslot = lane & 15, vrow_ = lane >> 3, vslot = lane & 7;
    auto dma_tile = [&](int hd, int kb_, int n, int b3) { const int tb = kb_ * MBLK + n * 64; LAS unsigned char* B = L + b3 * AT_BUF;
#pragma unroll
        for (int i = 0; i < 2; ++i) { const int p = wave * 2 + i, row = 4 * p + krow_, c = kslot ^ (row & 15);
            __builtin_amdgcn_global_load_lds((const unsigned*)(KBp + ((size_t)hd * T + tb + row) * MD + 8 * c), (LAS unsigned*)(B + p * 1024), 16, 0, 0); }
#pragma unroll
        for (int i = 0; i < 2; ++i) { const int p = wave * 2 + i, row = 8 * p + vrow_, c = vslot ^ ((row >> 1) & 7);
            __builtin_amdgcn_global_load_lds((const unsigned*)(VT + ((size_t)(hd * (T / 64) + kb_ * 4 + n) * MD + row) * 64 + 8 * c), (LAS unsigned*)(B + AT_KB + p * 1024), 16, 0, 0); } };
    dma_tile(h, kblk, 0, 0); dma_tile(h, kblk, 1, 1);
    asm volatile("s_waitcnt vmcnt(4)" ::: "memory"); q8_settle(qf); WG_BAR();
    int b3 = 0;
    for (;;) {
        const int un = unit_of(k + 1); const bool has_next = un < N, nA = un < NA;
        int hN = 0, kblkN = 0, qtokN = 0, slotN = 3, LxN = 0, idxN = 0, cntN = 0; bool validN = true, wvalidN = true; unsigned udw = 0u, udc = 0u, entN = 0u;
        f32x16 o[4];
#pragma unroll
        for (int db = 0; db < 4; ++db)
#pragma unroll
            for (int e = 0; e < 16; ++e) o[db][e] = 0.f;
        float mrun = NEG, lrun = 0.f;
#pragma unroll
        for (int n = 0; n < 4; ++n) {
            if (has_next) {
                if (n == 0) { if (nA) { hN = un & 15; kblkN = un >> 4; } else { udw = UD[1 + 2 * (un - NA)]; udc = UD[2 + 2 * (un - NA)]; } }
                if (n == 1) { if (nA) { qtokN = kblkN * MBLK + wave * 32 + r; } else { LxN = (int)(udw & 0xffffu); const int ps = (int)(udw >> 16); cntN = (int)udc; hN = LxN >> 5; kblkN = LxN & 31;
                                  idxN = ps * 256 + wave * 32 + r; validN = idxN < cntN; wvalidN = ps * 256 + wave * 32 < cntN; entN = u16_load(LST + (size_t)LxN * 8192 + (validN ? idxN : 0)); }
                              hN = __builtin_amdgcn_readfirstlane(hN); kblkN = __builtin_amdgcn_readfirstlane(kblkN); }
                if (n == 2) { if (!nA) { qtokN = (int)(entN & 0x1fffu); slotN = (int)(entN >> 13); }
                              q8_load(qfn, PROJ + (size_t)qtokN * PLD + PC_MQ + hN * MD + 8 * hh); }
            }
            const int bn = b3 >= 1 ? b3 - 1 : 2; bool issued = false;
            if (n < 2) { dma_tile(h, kblk, n + 2, bn); issued = true; } else if (has_next) { dma_tile(hN, kblkN, n - 2, bn); issued = true; }
            const bool need = typeA ? (n <= (wave >> 1)) : wvalid;
            if (need) {
                const LAS unsigned char* KB = L + b3 * AT_BUF; const LAS unsigned char* VB = KB + AT_KB;
                const bool msk = typeA && 64 * n + 63 > wave * 32; const int qrel = wave * 32 + r;
                auto qk = [&](int kb) { f32x16 a;
#pragma unroll
                    for (int e = 0; e < 16; ++e) a[e] = 0.f;
#pragma unroll
                    for (int ks = 0; ks < 8; ++ks) { const bf16x8 kf = *(const LAS bf16x8*)(KB + (32 * kb + r) * 256 + (((2 * ks + hh) ^ (r & 15)) << 4)); a = __builtin_amdgcn_mfma_f32_32x32x16_bf16(kf, __builtin_bit_cast(bf16x8, qf[ks]), a, 0, 0, 0); }
                    return a; };
                auto causal = [&](f32x16& a, int kb) {
#pragma unroll
                    for (int e = 0; e < 16; ++e) { const int krel = 64 * n + 32 * kb + (e & 3) + 8 * (e >> 2) + 4 * hh; if (krel > qrel) a[e] = NEG; } };
                auto rescale = [&](float alpha) { if (__ballot(alpha != 1.0f) != 0ull) {
#pragma unroll
                        for (int db = 0; db < 4; ++db)
#pragma unroll
                            for (int e = 0; e < 16; ++e) o[db][e] *= alpha; } };
                auto rowmax = [&](const f32x16& a, float mold, float& mnew, float& alpha) {
                    float mx = fmaxf(a[0], a[1]);
#pragma unroll
                    for (int e = 2; e < 16; ++e) mx = fmaxf(mx, a[e]);
                    mx = fmaxf(mx, __shfl_xor(mx, 32)); mnew = fmaxf(mold, mx); alpha = __builtin_amdgcn_exp2f(mold - mnew); };
                f32x16 s0 = qk(0);
                if (msk) causal(s0, 0);
                float m0, al0, m1, al1, ps0 = 0.f, ps1 = 0.f; unsigned pk0[8], pk1[8];
                rowmax(s0, mrun, m0, al0);
                __builtin_amdgcn_sched_barrier(0);
                f32x16 s1;
#pragma unroll
                for (int e = 0; e < 16; ++e) s1[e] = 0.f;
                auto kfrag = [&](int ks) { return *(const LAS bf16x8*)(KB + (32 + r) * 256 + (((2 * ks + hh) ^ (r & 15)) << 4)); };
                bf16x8 kf = kfrag(0), kf1 = kfrag(1), kf2 = kf1;
#pragma unroll
                for (int ks = 0; ks < 8; ++ks) {
                    if (ks < 6) kf2 = kfrag(ks + 2);
                    s1 = __builtin_amdgcn_mfma_f32_32x32x16_bf16(kf, __builtin_bit_cast(bf16x8, qf[ks]), s1, 0, 0, 0); kf = kf1; kf1 = kf2;
                    __builtin_amdgcn_sched_barrier(0);
                    const float p0 = __builtin_amdgcn_exp2f(s0[2 * ks] - m0), p1 = __builtin_amdgcn_exp2f(s0[2 * ks + 1] - m0); ps0 += p0 + p1; pk0[ks] = pk2(p0, p1); asm volatile("" : "+v"(pk0[ks]), "+v"(ps0));
                    __builtin_amdgcn_sched_barrier(0); }
                rescale(al0);
                if (msk) causal(s1, 1);
                rowmax(s1, m0, m1, al1);
                __builtin_amdgcn_sched_barrier(0);
                auto vfrag = [&](int i) { return *(const LAS bf16x8*)(VB + (32 * (i & 3) + r) * 128 + (((2 * (i >> 2) + hh) ^ ((r >> 1) & 7)) << 4)); };
                bf16x8 vf = vfrag(0), vf1 = vfrag(1), vf2 = vf1;
#pragma unroll
                for (int i = 0; i < 8; ++i) { const int st = i >> 2, db = i & 3;
                    const bf16x8 pf = __builtin_bit_cast(bf16x8, (u32x4){pk0[4 * st], pk0[4 * st + 1], pk0[4 * st + 2], pk0[4 * st + 3]});
                    if (i < 6) vf2 = vfrag(i + 2);
                    o[db] = __builtin_amdgcn_mfma_f32_32x32x16_bf16(vf, pf, o[db], 0, 0, 0); vf = vf1; vf1 = vf2;
                    __builtin_amdgcn_sched_barrier(0);
                    const float p0 = __builtin_amdgcn_exp2f(s1[2 * i] - m1), p1 = __builtin_amdgcn_exp2f(s1[2 * i + 1] - m1); ps1 += p0 + p1; pk1[i] = pk2(p0, p1); asm volatile("" : "+v"(pk1[i]), "+v"(ps1));
                    __builtin_amdgcn_sched_barrier(0); }
                rescale(al1);
#pragma unroll
                for (int i = 0; i < 8; ++i) { const int st = i >> 2, db = i & 3;
                    const bf16x8 pf = __builtin_bit_cast(bf16x8, (u32x4){pk1[4 * st], pk1[4 * st + 1], pk1[4 * st + 2], pk1[4 * st + 3]});
                    const bf16x8 vf = *(const LAS bf16x8*)(VB + (32 * db + r) * 128 + (((4 + 2 * st + hh) ^ ((r >> 1) & 7)) << 4)); o[db] = __builtin_amdgcn_mfma_f32_32x32x16_bf16(vf, pf, o[db], 0, 0, 0); }
                lrun = (lrun * al0 + ps0) * al1 + ps1; mrun = m1;
            }
            if (issued) asm volatile("s_waitcnt vmcnt(4)" ::: "memory"); else asm volatile("s_waitcnt vmcnt(0)" ::: "memory");
            if (n == 1) asm volatile("" : "+v"(entN));
            if (n == 2) q8_settle(qfn);
            b3 = b3 == 2 ? 0 : b3 + 1;
            WG_BAR();
        }
        { const float ltot = lrun + __shfl_xor(lrun, 32);
          if (valid) { const float inv = 1.0f / ltot; const size_t pi = ((size_t)qtok * MH + h) * 4 + slot; bf16_t* op = PO + pi * MD;
#pragma unroll
            for (int db = 0; db < 4; ++db)
#pragma unroll
                for (int g = 0; g < 4; ++g) { u32x2 wv; wv.x = pk2(o[db][4 * g] * inv, o[db][4 * g + 1] * inv); wv.y = pk2(o[db][4 * g + 2] * inv, o[db][4 * g + 3] * inv); *(u32x2*)(op + 32 * db + 8 * g + 4 * hh) = wv; }
            if (hh == 0) *(f32x2*)(PML + pi * 2) = (f32x2){mrun, ltot}; } }
        if (!has_next) break;
        h = hN; kblk = kblkN; qtok = qtokN; slot = slotN; typeA = nA; valid = nA ? true : validN; wvalid = nA ? true : wvalidN; ++k;
#pragma unroll
        for (int ks = 0; ks < 8; ++ks) qf[ks] = qfn[ks];
    }
}
__device__ __forceinline__ void ph6_merge(ArgsP A, Frame& F) {
    unsigned char* ws = A->ws; const bf16_t* PO = (const bf16_t*)(ws + WS_PARTO); const float* PML = (const float*)(ws + WS_PARTML); bf16_t* YB = (bf16_t*)(ws + WS_YB);
    const int gw = F.vcu * NWAVES + F.wave, NGW = F.G * NWAVES, hl = F.lane >> 5, dg = F.lane & 31;
    for (int it0 = gw * 4; it0 < T * 8; it0 += NGW * 4) {
        u32x2 ov[4][4]; f32x2 ml[4][4];
#pragma unroll
        for (int k = 0; k < 4; ++k) { const int it = it0 + k, t = it >> 3, h = 2 * (it & 7) + hl; const size_t pi = ((size_t)t * MH + h) * 4;
#pragma unroll
            for (int sl = 0; sl < 4; ++sl) { ov[k][sl] = *(const u32x2*)(PO + (pi + sl) * MD + 4 * dg); ml[k][sl] = *(const f32x2*)(PML + (pi + sl) * 2); } }
#pragma unroll
        for (int k = 0; k < 4; ++k) { const int it = it0 + k, t = it >> 3, h = 2 * (it & 7) + hl, blk = t >> 8, nsel = blk < 3 ? blk : 3;
            float mmax = ml[k][3][0];
#pragma unroll
            for (int sl = 0; sl < 3; ++sl) if (sl < nsel) mmax = fmaxf(mmax, ml[k][sl][0]);
            f32x4 acc = (f32x4){0.f, 0.f, 0.f, 0.f}; float wsum = 0.f;
#pragma unroll
            for (int sl = 0; sl < 4; ++sl) { if (sl == 3 || sl < nsel) { const float w = ml[k][sl][1] * __builtin_amdgcn_exp2f(ml[k][sl][0] - mmax); wsum += w;
                acc += w * (f32x4){bflo(ov[k][sl].x), bfhi(ov[k][sl].x), bflo(ov[k][sl].y), bfhi(ov[k][sl].y)}; } }
            const float inv = 1.0f / wsum; st4bf(YB + (size_t)t * RW + h * MD + 4 * dg, acc * inv); }
    }
}

__device__ __forceinline__ void ins16(float (&top)[16], float x) {
#pragma unroll
    for (int k = 15; k >= 1; --k) top[k] = __builtin_amdgcn_fmed3f(top[k - 1], top[k], x);
    top[0] = fmaxf(top[0], x);
}
__device__ __forceinline__ void ph10_select(ArgsP A, Frame& F) {
    unsigned char* ws = A->ws; const bf16_t* PQ = (const bf16_t*)(ws + WS_PQ); const bf16_t* SK = (const bf16_t*)(ws + WS_SUBK); int* IDX = (int*)(ws + WS_IDX); float* GW = (float*)(ws + WS_GW);
    const int gw = F.vcu * NWAVES + F.wave, NGW = F.G * NWAVES; const int r = F.lane & 31, hh = F.lane >> 5; const float NEG = -__builtin_inff();
    const float* RSQ = (const float*)(ws + WS_RSQ); float* RS = (float*)(ws + WS_RS);
    for (int it = gw; it < (T / 32) * PH_; it += NGW) { const int tg = it >> 3, h = it & 7, t = tg * 32 + r;
        float rst; { float ss = 0.f;
#pragma unroll
            for (int j = 0; j < 8; ++j) { const f32x4 v = *(const f32x4*)(RSQ + (size_t)t * 64 + 32 * hh + 4 * j); ss += (v[0] + v[1]) + (v[2] + v[3]); }
            ss += __shfl_xor(ss, 32); rst = 1.0f / sqrtf(ss * (1.0f / D) + NORM_EPS); if (h == 0 && hh == 0) RS[t] = rst; }
        float TA[16], TB[16];
        auto topk = [&](int p, float (&dst)[16]) {
            bf16x8 qf[8];
#pragma unroll
            for (int ks = 0; ks < 8; ++ks) qf[ks] = *(const bf16x8*)(PQ + (size_t)t * 2048 + (h * 2 + p) * PHALF + 16 * ks + 8 * hh);
            float top[16];
#pragma unroll
            for (int k = 0; k < 16; ++k) top[k] = NEG;
#pragma unroll 1
            for (int nb = 0; nb < 4; ++nb) { f32x16 acc;
#pragma unroll
                for (int e = 0; e < 16; ++e) acc[e] = 0.f;
#pragma unroll
                for (int ks = 0; ks < 8; ++ks) { const bf16x8 a = *(const bf16x8*)(SK + ((size_t)(h * 2 + p) * PNK + 32 * nb + r) * PHALF + 16 * ks + 8 * hh); acc = __builtin_amdgcn_mfma_f32_32x32x16_bf16(a, qf[ks], acc, 0, 0, 0); }
#pragma unroll
                for (int e = 0; e < 16; ++e) { const unsigned key = 32 * nb + (e & 3) + 8 * (e >> 2) + 4 * hh; float ae = acc[e]; asm volatile("" : "+v"(ae));
                    const float x = __builtin_bit_cast(float, (__builtin_bit_cast(unsigned, ae) & ~0x7Fu) | key); ins16(top, x); } }
            float oth[16];
#pragma unroll
            for (int k = 0; k < 16; ++k) oth[k] = __shfl_xor(top[k], 32);
#pragma unroll
            for (int k = 0; k < 16; ++k) ins16(top, oth[k]);
#pragma unroll
            for (int k = 0; k < 16; ++k) dst[k] = top[k];
        };
        topk(0, TA); asm volatile("" ::: "memory"); __builtin_amdgcn_sched_barrier(0); topk(1, TB); asm volatile("" ::: "memory"); __builtin_amdgcn_sched_barrier(0);
        float fin[16];
#pragma unroll
        for (int k = 0; k < 16; ++k) fin[k] = NEG;
#pragma unroll
        for (int i = 0; i < 16; ++i)
#pragma unroll
            for (int j = 0; j < 16; ++j) if ((i + 1) * (j + 1) <= 16) { const float sm = TA[i] + TB[j]; ins16(fin, __builtin_bit_cast(float, (__builtin_bit_cast(unsigned, sm) & ~0xFFu) | (unsigned)(i * 16 + j))); }
        float e[16], den = 0.f;
#pragma unroll
        for (int k = 0; k < 16; ++k) { e[k] = __expf((fin[k] - fin[0]) * rst); den += e[k]; }
        const float rden = 1.0f / den;
        int oi[8]; float og[8];
#pragma unroll
        for (int kk = 0; kk < 8; ++kk) { const float fv = hh ? fin[8 + kk] : fin[kk]; og[kk] = (hh ? e[8 + kk] : e[kk]) * rden; const unsigned id = __builtin_bit_cast(unsigned, fv) & 0xFFu; const unsigned ci = id >> 4, cj = id & 15u;
            unsigned ia = 0u, ib = 0u;
#pragma unroll
            for (int q = 0; q < 16; ++q) { ia = (ci == (unsigned)q) ? (__builtin_bit_cast(unsigned, TA[q]) & 0x7Fu) : ia; ib = (cj == (unsigned)q) ? (__builtin_bit_cast(unsigned, TB[q]) & 0x7Fu) : ib; }
            oi[kk] = (int)(ia * PNK + ib); }
        int* ip = IDX + (size_t)t * 128 + h * 16 + 8 * hh; float* gp = GW + (size_t)t * 128 + h * 16 + 8 * hh;
        *(u32x4*)ip = (u32x4){(unsigned)oi[0], (unsigned)oi[1], (unsigned)oi[2], (unsigned)oi[3]}; *(u32x4*)(ip + 4) = (u32x4){(unsigned)oi[4], (unsigned)oi[5], (unsigned)oi[6], (unsigned)oi[7]};
        *(f32x4*)gp = (f32x4){og[0], og[1], og[2], og[3]}; *(f32x4*)(gp + 4) = (f32x4){og[4], og[5], og[6], og[7]};
    }
}


__device__ __forceinline__ float ub0(unsigned w) { return (float)(w & 0xffu); }
__device__ __forceinline__ float ub1(unsigned w) { return (float)((w >> 8) & 0xffu); }
__device__ __forceinline__ float ub2(unsigned w) { return (float)((w >> 16) & 0xffu); }
__device__ __forceinline__ float ub3(unsigned w) { return (float)(w >> 24); }
__device__ __forceinline__ float dot16q(u32x4 q, const float (&h)[16]) {
    return ((ub0(q.x) * h[0] + ub1(q.x) * h[1]) + (ub2(q.x) * h[2] + ub3(q.x) * h[3])) + ((ub0(q.y) * h[4] + ub1(q.y) * h[5]) + (ub2(q.y) * h[6] + ub3(q.y) * h[7]))
         + ((ub0(q.z) * h[8] + ub1(q.z) * h[9]) + (ub2(q.z) * h[10] + ub3(q.z) * h[11])) + ((ub0(q.w) * h[12] + ub1(q.w) * h[13]) + (ub2(q.w) * h[14] + ub3(q.w) * h[15]));
}
__device__ __forceinline__ void ph11_gather(ArgsP A, Frame& F) {
    unsigned char* ws = A->ws; const bf16_t* X1 = (const bf16_t*)(ws + WS_X1); const float* RS = (const float*)(ws + WS_RS); const unsigned char* PU = (const unsigned char*)(ws + WS_PU); const unsigned char* PV = (const unsigned char*)(ws + WS_PV);
    const float* PSU = (const float*)(ws + WS_PSU); const float* PSV = (const float*)(ws + WS_PSV);
    const int* IDX = (const int*)(ws + WS_IDX); const float* GW = (const float*)(ws + WS_GW);
    LAS float* coef = (LAS float*)(F.lds + RING_OFF); LAS int* eidx = (LAS int*)(F.lds + RING_OFF + 1024); LAS float* red = (LAS float*)(F.lds + RING_OFF + 2048);
    const int tid = F.tid, wave = F.wave, lane = F.lane; int par = 0;
    for (int tgk = F.vcu * 32; tgk < T; tgk = ((tgk & 31) == 31) ? tgk + (F.G - 1) * 32 + 1 : tgk + 1, par ^= 1) { const int t = tgk;
        float hv[4][16]; float hs = 0.f;
        const float rs2 = RS[t];
#pragma unroll
        for (int i = 0; i < 4; ++i) { const bf16_t* hp = X1 + (size_t)t * D + i * 1024 + lane * 16; f32x4 a, b, c, d; pg8::unpack8(*(const u32x4*)hp, a, b); pg8::unpack8(*(const u32x4*)(hp + 8), c, d);
            { const f32x4* gp = (const f32x4*)(A->norm2_g + i * 1024 + lane * 16); a = a * gp[0] * rs2; b = b * gp[1] * rs2; c = c * gp[2] * rs2; d = d * gp[3] * rs2; }
#pragma unroll
            for (int e = 0; e < 4; ++e) { hv[i][e] = a[e]; hv[i][4 + e] = b[e]; hv[i][8 + e] = c[e]; hv[i][12 + e] = d[e]; }
            hs += ((a[0] + a[1]) + (a[2] + a[3])) + ((b[0] + b[1]) + (b[2] + b[3])) + ((c[0] + c[1]) + (c[2] + c[3])) + ((d[0] + d[1]) + (d[2] + d[3])); }
        hs = wave_sum(hs);
        const int myidx = (lane < 16) ? IDX[(size_t)t * 128 + wave * 16 + lane] : 0; const float myg = (lane < 16) ? GW[(size_t)t * 128 + wave * 16 + lane] : 0.f;
        float dots = 0.f;
#pragma unroll 1
        for (int k = 0; k < 16; k += 4) {
            u32x4 q[4][4];
#pragma unroll
            for (int x = 0; x < 4; ++x) { const int e = __builtin_amdgcn_readlane(myidx, k + x); const unsigned char* up = PU + (size_t)e * D + lane * 16;
#pragma unroll
                for (int i = 0; i < 4; ++i) q[x][i] = *(const u32x4*)(up + i * 1024); }
#pragma unroll
            for (int x = 0; x < 4; ++x) { float d = 0.f;
#pragma unroll
                for (int i = 0; i < 4; ++i) d += dot16q(q[x][i], hv[i]);
                d = wave_sum(d); if (lane == k + x) dots = d; }
        }
        if (lane < 16) { const float s = PSU[myidx] * (dots - 128.0f * hs); const float act = 0.5f * s * (1.0f + erff(s * 0.70710678118654752f));
            coef[par * 128 + wave * 16 + lane] = myg * act * PSV[myidx]; eidx[par * 128 + wave * 16 + lane] = myidx; }
        WG_BAR();
        float acc[8]; float csum = 0.f;
#pragma unroll
        for (int i = 0; i < 8; ++i) acc[i] = 0.f;
#pragma unroll 1
        for (int e = 0; e < 128; e += 16) { u32x2 v[16]; float c[16];
#pragma unroll
            for (int q = 0; q < 16; ++q) { const int ei = __builtin_amdgcn_readfirstlane(eidx[par * 128 + e + q]); c[q] = coef[par * 128 + e + q]; v[q] = *(const u32x2*)(PV + (size_t)ei * D + tid * 8); }
#pragma unroll
            for (int q = 0; q < 16; ++q) { csum += c[q]; acc[0] += c[q] * ub0(v[q].x); acc[1] += c[q] * ub1(v[q].x); acc[2] += c[q] * ub2(v[q].x); acc[3] += c[q] * ub3(v[q].x); acc[4] += c[q] * ub0(v[q].y); acc[5] += c[q] * ub1(v[q].y); acc[6] += c[q] * ub2(v[q].y); acc[7] += c[q] * ub3(v[q].y); } }
        const float corr = -128.0f * csum;
        f32x4 x0, x1; pg8::unpack8(*(const u32x4*)(X1 + (size_t)t * D + tid * 8), x0, x1);
        f32x4 y0 = x0 + ((f32x4){acc[0], acc[1], acc[2], acc[3]} + corr), y1 = x1 + ((f32x4){acc[4], acc[5], acc[6], acc[7]} + corr);
        float ss = (y0[0] * y0[0] + y0[1] * y0[1]) + (y0[2] * y0[2] + y0[3] * y0[3]) + (y1[0] * y1[0] + y1[1] * y1[1]) + (y1[2] * y1[2] + y1[3] * y1[3]);
        ss = wave_sum(ss); if (lane == 0) red[par * 8 + wave] = ss;
        WG_BAR();
        float tot = 0.f;
#pragma unroll
        for (int w = 0; w < 8; ++w) tot += red[par * 8 + w];
        const float rs = 1.0f / sqrtf(tot * (1.0f / D) + NORM_EPS);
        const f32x4 g0 = *(const f32x4*)(A->final_g + tid * 8), g1 = *(const f32x4*)(A->final_g + tid * 8 + 4);
        *(f32x4*)(A->out + (size_t)t * D + tid * 8) = y0 * rs * g0; *(f32x4*)(A->out + (size_t)t * D + tid * 8 + 4) = y1 * rs * g1;
    }
}

constexpr int NPH = 13;
__device__ __forceinline__ Frame make_frame(unsigned char* lds) {
    Frame F; int t = threadIdx.x; asm volatile("" : "+v"(t));
    F.lds = (LAS unsigned char*)lds; F.tid = t; F.lane = t & 63; F.wave = __builtin_amdgcn_readfirstlane(t >> 6);
    F.G = gridDim.x; { const int bx = blockIdx.x; F.vcu = (F.G % 8 == 0) ? (bx % 8) * (F.G / 8) + bx / 8 : bx; }
    return F;
}
__global__ void __launch_bounds__(NTHR, 2) mk_fwd(Args args_by_value) {
    extern __shared__ __attribute__((aligned(16))) unsigned char lds[];
    ArgsP args = get_args();
    gu32* ctl = (gu32*)(args->ws + WS_CTL);
    for (int u = threadIdx.x; u < (LDS_BYTES - LDSCTL_OFF) / 4; u += NTHR) ((LAS unsigned*)((LAS unsigned char*)lds + LDSCTL_OFF))[u] = 0u;
    __syncthreads();
    const int lo = args->ph_lo, hi = args->ph_hi;
    volatile LAS unsigned* MISC = (volatile LAS unsigned*)((LAS unsigned char*)lds + MISC_OFF);
    XcdBarrier bar; bar.bar = (unsigned*)(ctl + CW_BAR) + args->li * XCD_BAR_WORDS; bar.x = 0; bar.st = nullptr;
    if (hi - lo > 1) bar = xcd_barrier_post((unsigned*)(ctl + CW_BAR) + args->li * XCD_BAR_WORDS, MISC + 8);
#define IN(k) (lo <= (k) && (k) < hi)
#define SEAM(k) do { if (IN(k) && IN((k) + 1)) xcd_barrier(bar); } while (0)
    const int bid = (int)blockIdx.x;

    if (IN(0)) { Frame F = make_frame(lds); ph0_prologue(get_args(), F); SEAM(0); }
    if (IN(1)) { Frame F = make_frame(lds); LAS unsigned char* ring = F.lds + RING_OFF; ArgsP a_ = get_args(); unsigned char* ws = a_->ws;
        { pg8::Gemm g{(const bf16_t*)(ws + WS_XN), (const bf16_t*)(ws + WS_WIN), T, PLD, D}; pg8::StaticOrder S; S.init(T, PLD, F.G, bid);
          pg8::EpiProj E{(bf16_t*)(ws + WS_PROJ), (const float*)(ws + WS_ROPE), (bf16_t*)(ws + WS_KB)}; pg8::gemm_phase<pg8::EpiProj, pg8::StaticOrder, true, true>(ring, g, S, E); }
        { pg8::Gemm g{(const bf16_t*)(ws + WS_XN), (const bf16_t*)(ws + WS_WIN) + (size_t)PC_MV * D, T, 2048, D}; pg8::StaticOrder S; S.init(T, 2048, F.G, bid);
          pg8::EpiVT E{(bf16_t*)(ws + WS_VT)}; pg8::gemm_phase<pg8::EpiVT, pg8::StaticOrder, true, true>(ring, g, S, E); }
        { constexpr int NT1 = (T / 256) * (PLD / 256); const int nx = NT1 % F.G;
          if (bid >= nx) { WG_BAR(); { Frame F2 = make_frame(lds); late_weights(get_args(), F2, (bid - nx) * NWAVES + F2.wave, (F2.G - nx) * NWAVES); }
              if (nx) { Frame F2 = make_frame(lds); peer_quant(get_args(), F2, 0, pq_ra(F2.G), (bid - nx) * NWAVES + F2.wave, (F2.G - nx) * NWAVES); } } }
        SEAM(1); }
    if (IN(2)) { Frame F = make_frame(lds); ph2_prep(get_args(), F); SEAM(2); }
    if (IN(3)) { Frame F = make_frame(lds); LAS unsigned char* ring = F.lds + RING_OFF; ArgsP a_ = get_args(); unsigned char* ws = a_->ws;
        { pg8::Gemm g{(const bf16_t*)(ws + WS_AW), (const bf16_t*)(ws + WS_WUP), T, RW, LW}; pg8::StaticOrder S; S.init(T, RW, F.G, bid);
          pg8::EpiDec E{(float*)(ws + WS_DEC), a_->w0}; pg8::gemm_phase<pg8::EpiDec, pg8::StaticOrder, true, true>(ring, g, S, E); }
        asm volatile("" ::: "memory"); __builtin_amdgcn_sched_barrier(0);
        { pg8::Gemm g{(const bf16_t*)(ws + WS_AA), (const bf16_t*)(ws + WS_AUP), T, RW, LA}; pg8::StaticOrder S; S.init(T, RW, F.G, bid);
          pg8::EpiA E{(bf16_t*)(ws + WS_KP), (bf16_t*)(ws + WS_BB), (const bf16_t*)(ws + WS_KKN), a_->a0, a_->k_a}; pg8::gemm_phase<pg8::EpiA, pg8::StaticOrder, true, true>(ring, g, S, E); }
        asm volatile("" ::: "memory"); __builtin_amdgcn_sched_barrier(0);
        { pg8::Gemm g{(const bf16_t*)(ws + WS_AG), (const bf16_t*)(ws + WS_GUP), T, RW, LGP}; pg8::StaticOrder S; S.init(T, RW, F.G, bid);
          pg8::EpiBf16 E{(bf16_t*)(ws + WS_G), RW}; pg8::gemm_phase<pg8::EpiBf16, pg8::StaticOrder, true, true>(ring, g, S, E); }
        { Frame F2 = make_frame(lds); ph3_gate(get_args(), F2); }
        SEAM(3); }
    if (IN(4)) { Frame F = make_frame(lds); ph4_chunkprep(get_args(), F); SEAM(4); }
    if (IN(5)) {
        { Frame F = make_frame(lds); if (F.vcu < RH) ph5_chain(get_args(), F, F.vcu); }
        { Frame F = make_frame(lds); ph5_attn(get_args(), F); }
        { Frame F = make_frame(lds); if (F.vcu >= RH) peer_quant(get_args(), F, pq_ra(F.G), 2 * 16384, (F.vcu - RH) * NWAVES + F.wave, (F.G - RH) * NWAVES); }
        SEAM(5); }
    if (IN(6)) { { Frame F = make_frame(lds); ph6_merge(get_args(), F); } { Frame F = make_frame(lds); ph5_ypost(get_args(), F); } SEAM(6); }
    if (IN(7)) { Frame F = make_frame(lds); LAS unsigned char* ring = F.lds + RING_OFF; ArgsP a_ = get_args(); unsigned char* ws = a_->ws;
        { pg8::Gemm g{(const bf16_t*)(ws + WS_YA), (const bf16_t*)(ws + WS_WA), T, D, RW}; pg8::StaticOrder S; S.init(T, D, F.G, bid);
          pg8::EpiMix<false> E{(bf16_t*)(ws + WS_MIXED), (const bf16_t*)(ws + WS_PROJ), PC_GA}; pg8::gemm_phase<pg8::EpiMix<false>, pg8::StaticOrder, true, true>(ring, g, S, E); }
        { pg8::Gemm g{(const bf16_t*)(ws + WS_YB), (const bf16_t*)(ws + WS_WB), T, D, RW}; pg8::StaticOrder S; S.init(T, D, F.G, bid);
          pg8::EpiMix<true> E{(bf16_t*)(ws + WS_MIXED), (const bf16_t*)(ws + WS_PROJ), PC_GB}; pg8::gemm_phase<pg8::EpiMix<true>, pg8::StaticOrder, true, true>(ring, g, S, E); }
        SEAM(7); }
    if (IN(8)) { Frame F = make_frame(lds); LAS unsigned char* ring = F.lds + RING_OFF; ArgsP a_ = get_args(); unsigned char* ws = a_->ws;
        pg8::Gemm g{(const bf16_t*)(ws + WS_MIXED), (const bf16_t*)(ws + WS_WOUT), T, D, D}; pg8::StaticOrder S; S.init(T, D, F.G, bid);
        pg8::EpiRes E{(bf16_t*)(ws + WS_X1), a_->x, (float*)(ws + WS_RSQ)}; pg8::gemm_phase<pg8::EpiRes, pg8::StaticOrder, true, true>(ring, g, S, E);
        SEAM(8); }
    if (IN(10)) { Frame F = make_frame(lds); LAS unsigned char* ring = F.lds + RING_OFF; ArgsP a_ = get_args(); unsigned char* ws = a_->ws;
        pg8::Gemm g{(const bf16_t*)(ws + WS_X1), (const bf16_t*)(ws + WS_WQ), T, 2048, D}; pg8::StaticOrder S; S.init(T, 2048, F.G, bid);
        pg8::EpiBf16 E{(bf16_t*)(ws + WS_PQ), 2048}; pg8::gemm_phase<pg8::EpiBf16, pg8::StaticOrder, true, true>(ring, g, S, E);
        SEAM(10); }
    if (IN(11)) { Frame F = make_frame(lds); ph10_select(get_args(), F);
        if (IN(12)) { __builtin_amdgcn_fence(__ATOMIC_RELEASE, "workgroup"); WG_BAR(); __builtin_amdgcn_fence(__ATOMIC_ACQUIRE, "workgroup"); } }
    if (IN(12)) { Frame F = make_frame(lds); ph11_gather(get_args(), F); }
#undef IN
#undef SEAM
}

extern "C" void kernel_launch(void* const* d_in, const int* in_sizes, int n_in, void* d_out, int out_size, void* d_ws, size_t ws_size, hipStream_t stream) {
    static int grid = 0;
    if (grid == 0) {
        if (n_in != 23 || out_size != T * D || ws_size < WS_END) { fprintf(stderr, "kernel_launch: unexpected shapes (n_in %d out %d ws %zu); nothing launched\n", n_in, out_size, ws_size); grid = -1; return; }
        int dev = 0, cus = 0, per_cu = 0;
        if (hipGetDevice(&dev) != hipSuccess || hipDeviceGetAttribute(&cus, hipDeviceAttributeMultiprocessorCount, dev) != hipSuccess) { grid = -1; return; }
        if (hipFuncSetAttribute((const void*)mk_fwd, hipFuncAttributeMaxDynamicSharedMemorySize, LDS_BYTES) != hipSuccess) { grid = -1; return; }
        if (hipOccupancyMaxActiveBlocksPerMultiprocessor(&per_cu, (const void*)mk_fwd, NTHR, LDS_BYTES) != hipSuccess || per_cu < 1) fprintf(stderr, "kernel_launch: occupancy query reports %d\n", per_cu);
        (void)hipGetLastError();
        grid = cus;
    }
    if (grid < 0) return;
    (void)hipMemsetAsync((char*)d_ws + WS_CTL, 0, CTL_ZERO_BYTES, stream);
    Args a{};
    const float** ap = (const float**)&a;
    for (int i = 0; i < 23; ++i) ap[i] = (const float*)d_in[i];
    a.out = (float*)d_out; a.ws = (unsigned char*)d_ws; a.pad = 0;
    constexpr int NL = MK_N_LAUNCHES;
    for (int li = 0; li < NL; ++li) {
        a.ph_lo = (NL == 1) ? 0 : li; a.ph_hi = (NL == 1) ? NPH : li + 1; a.li = (NL == 1) ? 0 : 0;
        hipLaunchKernelGGL(mk_fwd, dim3(grid), dim3(NTHR), LDS_BYTES, stream, a);
#ifdef DUP_HI
        if (NL > 1 && li == DUP_HI) for (int l2 = DUP_LO; l2 <= DUP_HI; ++l2) { a.ph_lo = l2; a.ph_hi = l2 + 1; hipLaunchKernelGGL(mk_fwd, dim3(grid), dim3(NTHR), LDS_BYTES, stream, a); }
#endif
    }
}
```

```cpp
#include <hip/hip_runtime.h>
#include <cstdio>
#include <cstdint>

#ifndef MK_N_LAUNCHES
#define MK_N_LAUNCHES 1
#endif

#define GAS __attribute__((address_space(1)))
#define LAS __attribute__((address_space(3)))
typedef unsigned short bf16_t;
typedef __bf16 bf16x8 __attribute__((ext_vector_type(8)));
typedef float f32x2 __attribute__((ext_vector_type(2)));
typedef float f32x4 __attribute__((ext_vector_type(4)));
typedef float f32x16 __attribute__((ext_vector_type(16)));
typedef unsigned u32x2 __attribute__((ext_vector_type(2)));
typedef unsigned u32x4 __attribute__((ext_vector_type(4)));
typedef GAS unsigned gu32;

constexpr int T = 8192, D = 4096;
constexpr int RW = 2048, RH = 32, RN = 64;
constexpr int LW = 128, LA = 128, LG = 480, LGP = 512;
constexpr int SHIFTW = 6880;
constexpr int MH = 16, MD = 128, MBLK = 256, NBLK = 32;
constexpr int INW = 21216;
constexpr int PLD = 19200;
constexpr int PC_R = 0, PC_K = 2048, PC_V = 4096, PC_WL = 6144, PC_AL = 6272, PC_GL = 6400, PC_MQ = 6912, PC_MK = 8960, PC_GA = 11008, PC_GB = 15104, PC_MV = 19200;
constexpr int WIN_ROWS = 21248;
constexpr int PQ_SPLIT = 16384;
constexpr int PH_ = 8, PNK = 128, PQD = 256, PHALF = 128, PTOPK = 16;
constexpr float NORM_EPS = 1e-6f, LNX_EPS = 64e-5f;
constexpr float QSCALE = 0.08838834764831845f * 1.4426950408889634f;

constexpr size_t MiB = 1u << 20;
constexpr size_t WS_CTL = 0, CTL_ZERO_BYTES = 1 * MiB;
constexpr size_t WS_WIN = 1 * MiB;
constexpr size_t WS_X1 = 1 * MiB, WS_PQ = 129 * MiB;
constexpr size_t WS_WA = 167 * MiB, WS_WB = 183 * MiB, WS_WOUT = 199 * MiB, WS_WQ = 231 * MiB, WS_WUP = 247 * MiB, WS_AUP = 248 * MiB, WS_GUP = 249 * MiB, WS_SUBK = 251 * MiB;
constexpr size_t WS_PU = 252 * MiB, WS_PV = 380 * MiB;
constexpr size_t WS_XN = 508 * MiB;
constexpr size_t WS_YH = 444 * MiB;
constexpr size_t WS_SC = 316 * MiB;
constexpr size_t WS_Y = 508 * MiB, WS_RSQ = 508 * MiB, WS_RS = 510 * MiB;
constexpr size_t WS_PROJ = 572 * MiB;
constexpr size_t WS_VT = 872 * MiB;
constexpr size_t WS_ROPE = 904 * MiB, WS_KMEAN = 908 * MiB, WS_MASK = 909 * MiB, WS_AW = 910 * MiB, WS_AA = 912 * MiB, WS_AG = 914 * MiB;
constexpr size_t WS_PSU = 909 * MiB + 512 * 1024, WS_PSV = WS_PSU + 64 * 1024;
constexpr size_t WS_DEC = 922 * MiB;
constexpr size_t WS_MIXED = 922 * MiB;
constexpr size_t WS_KKN = 986 * MiB, WS_BB = 1018 * MiB, WS_KP = 1050 * MiB, WS_ZR = 1082 * MiB, WS_ZV = 1114 * MiB, WS_G = 1146 * MiB;
constexpr size_t WS_YA = 1178 * MiB, WS_YB = 1210 * MiB, WS_IDX = 1242 * MiB, WS_GW = 1246 * MiB, WS_PARTML = 1250 * MiB, WS_LIST = 1254 * MiB, WS_UDESC = 1262 * MiB, WS_KB = 1267 * MiB, WS_END = 1299 * MiB;
constexpr size_t WS_PARTO = 922 * MiB;

constexpr int CW_TMO = 0, CW_CODE = 1, CW_ATTNQ = 64, CW_CNT = 1024, CW_BAR = 4096;

constexpr int RING_OFF = 0, RING_BYTES = 155648;
constexpr int LDSCTL_OFF = RING_BYTES, MISC_OFF = LDSCTL_OFF + 320;
constexpr int LDS_BYTES = 163840;
constexpr int NWAVES = 8, NTHR = 512;

__device__ __forceinline__ unsigned f2bf(float f) { unsigned u = __builtin_bit_cast(unsigned, f); return (u + 0x7fffu + ((u >> 16) & 1u)) >> 16; }
typedef __bf16 bf16x2 __attribute__((ext_vector_type(2)));
__device__ __forceinline__ unsigned pk2(float lo, float hi) { const f32x2 v = {lo, hi}; return __builtin_bit_cast(unsigned, __builtin_convertvector(v, bf16x2)); }
__device__ __forceinline__ float bflo(unsigned u) { return __builtin_bit_cast(float, u << 16); }
__device__ __forceinline__ float bfhi(unsigned u) { return __builtin_bit_cast(float, u & 0xffff0000u); }
__device__ __forceinline__ float bf1(bf16_t b) { return __builtin_bit_cast(float, (unsigned)b << 16); }
__device__ __forceinline__ float fsigmoid(float x) { return __builtin_amdgcn_rcpf(1.0f + __expf(-x)); }
__device__ __forceinline__ float wave_sum(float v) {
#pragma unroll
    for (int o = 1; o < 64; o <<= 1) v += __shfl_xor(v, o);
    return v;
}
template <int CTRL> __device__ __forceinline__ float dpp_f(float v) { return __builtin_bit_cast(float, __builtin_amdgcn_update_dpp(0, __builtin_bit_cast(int, v), CTRL, 0xF, 0xF, true)); }
__device__ __forceinline__ float sum16(float x) {
    x += dpp_f<0xB1>(x); x += dpp_f<0x4E>(x); x += dpp_f<0x141>(x); x += dpp_f<0x140>(x); return x;
}
__device__ __forceinline__ float vmul(float a, float b) { float r; asm("v_mul_f32_e32 %0, %1, %2" : "=v"(r) : "v"(a), "v"(b)); return r; }
__device__ __forceinline__ float vfma(float a, float b, float c) { float r; asm("v_fma_f32 %0, %1, %2, %3" : "=v"(r) : "v"(a), "v"(b), "v"(c)); return r; }
#define LDS_WAIT() asm volatile("s_waitcnt lgkmcnt(0)" ::: "memory")
#define VM_WAIT() asm volatile("s_waitcnt vmcnt(0)" ::: "memory")
#define WG_BAR() do { asm volatile("s_waitcnt lgkmcnt(0)" ::: "memory"); __builtin_amdgcn_s_barrier(); asm volatile("" ::: "memory"); } while (0)

namespace pg8 {
constexpr int BM = 256, BK = 64, HALF = 128, HTB = HALF * BK * 2, STAGE_BYTES = 8 * HTB, NXCD = 8, WGM = 8;
__host__ __device__ __forceinline__ int lds_byte(int r, int c) { const int st = (r >> 4) * 2 + (c >> 5), rr = r & 15, cc = c & 31, ob = rr * 64 + cc * 2; return st * 1024 + (ob ^ (((ob >> 9) & 1) << 5)); }
__host__ __device__ __forceinline__ void stage_rc(int b, int& R, int& C) { const int st = b / 1024, sb = b % 1024, swz = sb ^ (((sb >> 9) & 1) << 5); R = (st >> 1) * 16 + swz / 64; C = (st & 1) * 32 + (swz % 64) / 2; }
__host__ __device__ __forceinline__ int perm32(int rho) { const int n = rho >> 4, i = rho & 15; return 8 * (i >> 2) + 4 * n + (i & 3); }

struct Unit { int pm, pn; };
struct Gemm { const bf16_t* A; const bf16_t* Bt; int M, N, K; };

struct StaticOrder {
    int nM, nN, nwg, G, c;
    __host__ __device__ void init(int M, int N, int G_, int c_) { nM = M / BM; nN = N / BM; nwg = nM * nN; G = G_; c = c_; }
    __host__ __device__ bool next(int i, Unit& u) const {
        const long L = (long)i * G + c; if (L >= nwg) return false;
        int wgid = (int)L; { const int q = nwg / NXCD, r = nwg % NXCD, xcd = wgid % NXCD, off = wgid / NXCD; wgid = (xcd < r ? xcd * (q + 1) : r * (q + 1) + (xcd - r) * q) + off; }
        const int nig = WGM * nN, gid = wgid / nig, fm = gid * WGM, gsz = (nM - fm) < WGM ? (nM - fm) : WGM;
        u.pm = fm + ((wgid % nig) % gsz); u.pn = (wgid % nig) / gsz; return true;
    }
    __device__ __forceinline__ void a_ready(const Unit&) const {}
    __device__ __forceinline__ void done(const Unit&) const {}
};

template <class Epi, class Sched, bool ALIGN_EPI = false, bool SP2 = false>
__device__ __forceinline__ void gemm_phase(LAS unsigned char* lds, const Gemm g, const Sched& S, const Epi& E) {
    int tid_ = threadIdx.x; asm volatile("" : "+v"(tid_));
    const int tid = tid_, wid = __builtin_amdgcn_readfirstlane(tid >> 6), lane = tid & 63, wr = wid >> 2, wc = wid & 3, fr = lane & 15, fq = lane >> 4;
    int K_ = g.K; asm volatile("" : "+s"(K_));
    const int K = K_, nt = K / BK;
    unsigned voffA[2], voffB[2];
#pragma unroll
    for (int i = 0; i < 2; ++i) { int R, C; stage_rc(tid * 16 + i * 8192, R, C); const int Rb = Epi::PERM ? ((R & ~31) + perm32(R & 31)) : R;
        voffA[i] = (unsigned)(R * K + C) * 2u; voffB[i] = (unsigned)(Rb * K + C) * 2u; }
    const size_t kstep = (size_t)(BK * 2);
    const size_t hstep = (size_t)HALF * K * 2;
    const size_t tstep = 2 * hstep;
    const unsigned ldsw = (unsigned)wid * 1024u;
    const int aoff = lds_byte(wr * 64 + fr, fq * 8), boff = lds_byte(wc * 32 + fr, fq * 8);
#define PG8_SA(b, h) (((b) * 2 + (h)) * HTB)
#define PG8_SB(b, h) ((4 + (b) * 2 + (h)) * HTB)
#define PG8_STAGE(bufoff, gbase, voff) do { _Pragma("unroll") for (int _i = 0; _i < 2; ++_i) \
        __builtin_amdgcn_global_load_lds((const unsigned*)((const char*)(gbase) + (voff)[_i]), (LAS unsigned*)(lds + (bufoff) + ldsw + _i * 8192), 16, 0, 0); } while (0)
#define PG8_LDA(dst, b, h) do { _Pragma("unroll") for (int m = 0; m < 4; ++m) _Pragma("unroll") for (int k = 0; k < 2; ++k) dst[m][k] = *(const LAS bf16x8*)(lds + PG8_SA(b, h) + aoff + m * 2048 + k * 1024); } while (0)
#define PG8_LDB(dst, b, h) do { _Pragma("unroll") for (int n = 0; n < 2; ++n) _Pragma("unroll") for (int k = 0; k < 2; ++k) dst[n][k] = *(const LAS bf16x8*)(lds + PG8_SB(b, h) + boff + n * 2048 + k * 1024); } while (0)
#define PG8_MMA(ai, bj, At, Bt) do { __builtin_amdgcn_s_setprio(1); _Pragma("unroll") for (int m = 0; m < 4; ++m) _Pragma("unroll") for (int n = 0; n < 2; ++n) _Pragma("unroll") for (int k = 0; k < 2; ++k) { \
        if constexpr (Epi::SWAP) acc[ai][bj][m][n] = __builtin_amdgcn_mfma_f32_16x16x32_bf16(At[m][k], Bt[n][k], acc[ai][bj][m][n], 0, 0, 0); \
        else acc[ai][bj][m][n] = __builtin_amdgcn_mfma_f32_16x16x32_bf16(Bt[n][k], At[m][k], acc[ai][bj][m][n], 0, 0, 0); } __builtin_amdgcn_s_setprio(0); } while (0)
#define PG8_WAIT_V(n) asm volatile("s_waitcnt vmcnt(" #n ")" ::: "memory")
#define PG8_WAIT_L(n) asm volatile("s_waitcnt lgkmcnt(" #n ")" ::: "memory")
#define PG8_BAR __builtin_amdgcn_s_barrier()
#define PG8_SCHED __builtin_amdgcn_sched_barrier(0)
    Unit cur, nxt; int ui = 0;
    if (!S.next(0, cur)) return;
    f32x4 acc[2][2][4][2];
#pragma unroll
    for (int a = 0; a < 2; ++a)
#pragma unroll
        for (int b = 0; b < 2; ++b)
#pragma unroll
            for (int m = 0; m < 4; ++m)
#pragma unroll
                for (int n = 0; n < 2; ++n) acc[a][b][m][n] = (f32x4){0.f, 0.f, 0.f, 0.f};
    bf16x8 At[4][2], B0[2][2], B1[2][2];
    const char* cA = (const char*)g.A + (size_t)cur.pm * tstep; const char* cB = (const char*)g.Bt + (size_t)cur.pn * tstep;
    S.a_ready(cur);
    if constexpr (SP2) {
        PG8_STAGE(PG8_SB(0, 0), cB, voffB); PG8_STAGE(PG8_SB(0, 1), cB + hstep, voffB); PG8_STAGE(PG8_SA(0, 0), cA, voffA); PG8_STAGE(PG8_SA(0, 1), cA + hstep, voffA);
        if (wr == 1) PG8_BAR;
        PG8_WAIT_V(2); PG8_BAR;
        PG8_STAGE(PG8_SB(1, 0), cB + kstep, voffB); PG8_STAGE(PG8_SA(1, 0), cA + kstep, voffA); PG8_STAGE(PG8_SB(1, 1), cB + hstep + kstep, voffB);
        PG8_WAIT_V(6); PG8_BAR;
    } else {
        PG8_STAGE(PG8_SB(0, 0), cB, voffB); PG8_STAGE(PG8_SA(0, 0), cA, voffA); PG8_STAGE(PG8_SB(0, 1), cB + hstep, voffB); PG8_STAGE(PG8_SA(0, 1), cA + hstep, voffA);
        if (wr == 1) PG8_BAR;
        PG8_WAIT_V(4); PG8_BAR;
        PG8_STAGE(PG8_SB(1, 0), cB + kstep, voffB); PG8_STAGE(PG8_SA(1, 0), cA + kstep, voffA); PG8_STAGE(PG8_SB(1, 1), cB + hstep + kstep, voffB);
        PG8_WAIT_V(6); PG8_BAR;
    }
    for (;;) {
        const bool has_next = S.next(ui + 1, nxt);
        const char* nA = has_next ? (const char*)g.A + (size_t)nxt.pm * tstep : cA; const char* nB = has_next ? (const char*)g.Bt + (size_t)nxt.pn * tstep : cB;
        for (int t = 0; t < nt; t += 2) {
            const bool last = (t == nt - 2);
            const char* a1 = cA + (size_t)(t + 1) * kstep;
            const char* a2 = last ? nA : cA + (size_t)(t + 2) * kstep; const char* b2 = last ? nB : cB + (size_t)(t + 2) * kstep;
            const char* a3 = a2 + kstep; const char* b3 = b2 + kstep;
            if (last && has_next) S.a_ready(nxt);
            if constexpr (SP2) {
            PG8_LDB(B0, 0, 0); PG8_LDB(B1, 0, 1); PG8_SCHED; PG8_LDA(At, 0, 0); PG8_STAGE(PG8_SA(1, 1), a1 + hstep, voffA);
            PG8_WAIT_V(8); PG8_WAIT_L(0); PG8_BAR; PG8_MMA(0, 0, At, B0); PG8_MMA(0, 1, At, B1); PG8_BAR; PG8_SCHED;
            PG8_LDA(At, 0, 1); PG8_STAGE(PG8_SB(0, 0), b2, voffB); PG8_STAGE(PG8_SB(0, 1), b2 + hstep, voffB); PG8_STAGE(PG8_SA(0, 0), a2, voffA);
            PG8_WAIT_V(8); PG8_WAIT_L(0); PG8_BAR; PG8_MMA(1, 0, At, B0); PG8_MMA(1, 1, At, B1); PG8_BAR; PG8_SCHED;
            PG8_LDB(B0, 1, 0); PG8_LDB(B1, 1, 1); PG8_SCHED; PG8_LDA(At, 1, 0); PG8_STAGE(PG8_SA(0, 1), a2 + hstep, voffA);
            PG8_WAIT_V(8); PG8_WAIT_L(0); PG8_BAR; PG8_MMA(0, 0, At, B0); PG8_MMA(0, 1, At, B1); PG8_BAR; PG8_SCHED;
            PG8_LDA(At, 1, 1); PG8_STAGE(PG8_SB(1, 0), b3, voffB); PG8_STAGE(PG8_SB(1, 1), b3 + hstep, voffB); PG8_STAGE(PG8_SA(1, 0), a3, voffA);
            PG8_WAIT_V(8); PG8_WAIT_L(0); PG8_BAR; PG8_MMA(1, 0, At, B0); PG8_MMA(1, 1, At, B1); PG8_BAR; PG8_SCHED;
            } else {
            PG8_LDB(B0, 0, 0); PG8_SCHED; PG8_LDA(At, 0, 0); PG8_STAGE(PG8_SA(1, 1), a1 + hstep, voffA);
            PG8_WAIT_L(8); PG8_BAR; PG8_WAIT_L(0); PG8_MMA(0, 0, At, B0); PG8_BAR; PG8_SCHED;
            PG8_LDB(B1, 0, 1); PG8_STAGE(PG8_SB(0, 0), b2, voffB);
            PG8_BAR; PG8_WAIT_L(0); PG8_MMA(0, 1, At, B1); PG8_BAR;
            PG8_LDA(At, 0, 1); PG8_STAGE(PG8_SA(0, 0), a2, voffA);
            PG8_BAR; PG8_WAIT_L(0); PG8_MMA(1, 0, At, B0); PG8_BAR; PG8_SCHED;
            PG8_STAGE(PG8_SB(0, 1), b2 + hstep, voffB);
            PG8_WAIT_V(6); PG8_BAR; PG8_MMA(1, 1, At, B1); PG8_BAR;
            PG8_LDB(B0, 1, 0); PG8_SCHED; PG8_LDA(At, 1, 0); PG8_STAGE(PG8_SA(0, 1), a2 + hstep, voffA);
            PG8_WAIT_L(8); PG8_BAR; PG8_WAIT_L(0); PG8_MMA(0, 0, At, B0); PG8_BAR; PG8_SCHED;
            PG8_LDB(B1, 1, 1); PG8_STAGE(PG8_SB(1, 0), b3, voffB);
            PG8_BAR; PG8_WAIT_L(0); PG8_MMA(0, 1, At, B1); PG8_BAR;
            PG8_LDA(At, 1, 1); PG8_STAGE(PG8_SA(1, 0), a3, voffA);
            PG8_BAR; PG8_WAIT_L(0); PG8_MMA(1, 0, At, B0); PG8_BAR; PG8_SCHED;
            PG8_STAGE(PG8_SB(1, 1), b3 + hstep, voffB);
            PG8_WAIT_V(6); PG8_BAR; PG8_MMA(1, 1, At, B1); PG8_BAR;
            }
        }
        if constexpr (ALIGN_EPI) { if (wr == 0) PG8_BAR; }
        E(acc, cur, wr, wc, fr, fq); S.done(cur);
        if (!has_next) break;
#pragma unroll
        for (int a = 0; a < 2; ++a)
#pragma unroll
            for (int b = 0; b < 2; ++b)
#pragma unroll
                for (int m = 0; m < 4; ++m)
#pragma unroll
                    for (int n = 0; n < 2; ++n) acc[a][b][m][n] = (f32x4){0.f, 0.f, 0.f, 0.f};
        cur = nxt; cA = nA; cB = nB; ++ui;
        if constexpr (ALIGN_EPI) { if (wr == 1) PG8_BAR; }
    }
    PG8_WAIT_V(0);
    if constexpr (!ALIGN_EPI) { if (wr == 0) PG8_BAR; }
    PG8_BAR;
#undef PG8_SA
#undef PG8_SB
#undef PG8_STAGE
#undef PG8_LDA
#undef PG8_LDB
#undef PG8_MMA
#undef PG8_WAIT_V
#undef PG8_WAIT_L
#undef PG8_BAR
#undef PG8_SCHED
}

typedef const f32x4 (&AccRef)[2][2][4][2];
__device__ __forceinline__ u32x4 pack8(f32x4 v0, f32x4 v1) { u32x4 w; w.x = pk2(v0[0], v0[1]); w.y = pk2(v0[2], v0[3]); w.z = pk2(v1[0], v1[1]); w.w = pk2(v1[2], v1[3]); return w; }
__device__ __forceinline__ void unpack8(u32x4 w, f32x4& v0, f32x4& v1) { v0 = (f32x4){bflo(w.x), bfhi(w.x), bflo(w.y), bfhi(w.y)}; v1 = (f32x4){bflo(w.z), bfhi(w.z), bflo(w.w), bfhi(w.w)}; }

struct EpiBf16 {
    static constexpr bool PERM = true, SWAP = false;
    bf16_t* O; int ldc;
    __device__ __forceinline__ void operator()(AccRef acc, const Unit& u, int wr, int wc, int fr, int fq) const {
        const int row0 = u.pm * BM + wr * 64 + fr, col0 = u.pn * BM + wc * 32 + 8 * fq;
#pragma unroll
        for (int ai = 0; ai < 2; ++ai)
#pragma unroll
            for (int m = 0; m < 4; ++m) { bf16_t* rowp = O + (size_t)(row0 + ai * HALF + m * 16) * ldc + col0;
#pragma unroll
                for (int bj = 0; bj < 2; ++bj) *(u32x4*)(rowp + bj * HALF) = pack8(acc[ai][bj][m][0], acc[ai][bj][m][1]); }
    }
};
struct EpiProj {
    static constexpr bool PERM = true, SWAP = false;
    bf16_t* O; const float* rope; bf16_t* KB;
    __device__ __forceinline__ void operator()(AccRef acc, const Unit& u, int wr, int wc, int fr, int fq) const {
        const int row0 = u.pm * BM + wr * 64 + fr, col0 = u.pn * BM + wc * 32 + 8 * fq;
        const int mode = (u.pn >= 27 && u.pn < 43) ? (u.pn < 35 ? 1 : 2) : 0;
        const float sc = (mode == 1) ? QSCALE : 1.0f;
#pragma unroll
        for (int ai = 0; ai < 2; ++ai)
#pragma unroll
            for (int m = 0; m < 4; ++m) { const int row = row0 + ai * HALF + m * 16; bf16_t* rowp = O + (size_t)row * PLD + col0;
#pragma unroll
                for (int bj = 0; bj < 2; ++bj) { f32x4 v0 = acc[ai][bj][m][0], v1 = acc[ai][bj][m][1];
                    if (mode) { const int i0 = ((col0 + bj * HALF) & 127) >> 1; const f32x4* rp = (const f32x4*)(rope + ((size_t)row * 64 + i0) * 2); const f32x4 c0 = rp[0], c1 = rp[1];
                        f32x4 o0, o1;
                        o0[0] = v0[0] * c0[0] - v0[1] * c0[1]; o0[1] = v0[1] * c0[0] + v0[0] * c0[1]; o0[2] = v0[2] * c0[2] - v0[3] * c0[3]; o0[3] = v0[3] * c0[2] + v0[2] * c0[3];
                        o1[0] = v1[0] * c1[0] - v1[1] * c1[1]; o1[1] = v1[1] * c1[0] + v1[0] * c1[1]; o1[2] = v1[2] * c1[2] - v1[3] * c1[3]; o1[3] = v1[3] * c1[2] + v1[2] * c1[3];
                        v0 = o0 * sc; v1 = o1 * sc; }
                    if (mode == 2) *(u32x4*)(KB + ((size_t)((u.pn - 35) * 2 + bj) * T + row) * MD + wc * 32 + 8 * fq) = pack8(v0, v1);
                    else *(u32x4*)(rowp + bj * HALF) = pack8(v0, v1); } }
    }
};
struct EpiVT {
    static constexpr bool PERM = false, SWAP = true;
    bf16_t* VT;
    __device__ __forceinline__ void operator()(AccRef acc, const Unit& u, int wr, int wc, int fr, int fq) const {
        const int tok0 = u.pm * BM + wr * 64 + 4 * fq, col0 = u.pn * BM + wc * 32 + fr;
#pragma unroll
        for (int ai = 0; ai < 2; ++ai)
#pragma unroll
            for (int m = 0; m < 4; ++m)
#pragma unroll
                for (int bj = 0; bj < 2; ++bj)
#pragma unroll
                    for (int n = 0; n < 2; ++n) { const f32x4 v = acc[ai][bj][m][n]; u32x2 w; w.x = pk2(v[0], v[1]); w.y = pk2(v[2], v[3]);
                        const int d = col0 + bj * HALF + n * 16, tl = (u.pm * BM + wr * 64 + ai * HALF) >> 6;
                        *(u32x2*)(VT + ((size_t)((d >> 7) * (T / 64) + tl) * MD + (d & 127)) * 64 + m * 16 + 4 * (((fq & 1) << 1) | (fq >> 1))) = w; }
    }
};
struct EpiDec {
    static constexpr bool PERM = true, SWAP = false;
    float* O; const float* w0;
    __device__ __forceinline__ void operator()(AccRef acc, const Unit& u, int wr, int wc, int fr, int fq) const {
        const int row0 = u.pm * BM + wr * 64 + fr, col0 = u.pn * BM + wc * 32 + 8 * fq;
#pragma unroll
        for (int bj = 0; bj < 2; ++bj) { const f32x4 b0 = *(const f32x4*)(w0 + col0 + bj * HALF), b1 = *(const f32x4*)(w0 + col0 + bj * HALF + 4);
#pragma unroll
            for (int ai = 0; ai < 2; ++ai)
#pragma unroll
                for (int m = 0; m < 4; ++m) { float* rowp = O + (size_t)(row0 + ai * HALF + m * 16) * RW + col0 + bj * HALF;
#pragma unroll
                    for (int n = 0; n < 2; ++n) { const f32x4 x = acc[ai][bj][m][n] + (n ? b1 : b0); f32x4 o;
#pragma unroll
                        for (int e = 0; e < 4; ++e) {
                            const float sg = __builtin_amdgcn_rcpf(1.0f + __builtin_amdgcn_exp2f(-1.44269504f * x[e])); o[e] = __builtin_amdgcn_exp2f(-0.875038775f * sg); }
                        *(f32x4*)(rowp + 4 * n) = o; }
                    asm volatile("" ::: "memory"); } }
    }
};
struct EpiA {
    static constexpr bool PERM = true, SWAP = false;
    bf16_t* KP; bf16_t* BB; const bf16_t* KKN; const float* a0; const float* k_a;
    __device__ __forceinline__ void operator()(AccRef acc, const Unit& u, int wr, int wc, int fr, int fq) const {
        const int row0 = u.pm * BM + wr * 64 + fr, col0 = u.pn * BM + wc * 32 + 8 * fq;
#pragma unroll
        for (int bj = 0; bj < 2; ++bj) { const int cb = col0 + bj * HALF;
            const f32x4 b0 = *(const f32x4*)(a0 + cb), b1 = *(const f32x4*)(a0 + cb + 4), ka0 = *(const f32x4*)(k_a + cb), ka1 = *(const f32x4*)(k_a + cb + 4);
#pragma unroll
            for (int ai = 0; ai < 2; ++ai)
#pragma unroll
                for (int m = 0; m < 4; ++m) { const size_t off = (size_t)(row0 + ai * HALF + m * 16) * RW + cb;
                    f32x4 zk0, zk1, kn0, kn1; unpack8(*(const u32x4*)(KP + off), zk0, zk1); unpack8(*(const u32x4*)(KKN + off), kn0, kn1);
                    f32x4 a0v, a1v;
#pragma unroll
                    for (int e = 0; e < 4; ++e) { a0v[e] = fsigmoid(acc[ai][bj][m][0][e] + b0[e]); a1v[e] = fsigmoid(acc[ai][bj][m][1][e] + b1[e]); }
                    const f32x4 kp0 = zk0 * (1.0f + (a0v - 1.0f) * ka0), kp1 = zk1 * (1.0f + (a1v - 1.0f) * ka1);
                    *(u32x4*)(KP + off) = pack8(kp0, kp1); *(u32x4*)(BB + off) = pack8(-(kn0 * a0v), -(kn1 * a1v));
                    asm volatile("" ::: "memory"); } }
    }
};
template <bool ADD> struct EpiMix {
    static constexpr bool PERM = true, SWAP = false;
    bf16_t* O; const bf16_t* proj; int gcol0;
    __device__ __forceinline__ void operator()(AccRef acc, const Unit& u, int wr, int wc, int fr, int fq) const {
        const int row0 = u.pm * BM + wr * 64 + fr, col0 = u.pn * BM + wc * 32 + 8 * fq;
#pragma unroll
        for (int ai = 0; ai < 2; ++ai)
#pragma unroll
            for (int m = 0; m < 4; ++m) { const int row = row0 + ai * HALF + m * 16;
#pragma unroll
                for (int bj = 0; bj < 2; ++bj) { f32x4 g0, g1; unpack8(*(const u32x4*)(proj + (size_t)row * PLD + gcol0 + col0 + bj * HALF), g0, g1);
                    f32x4 o0, o1;
#pragma unroll
                    for (int e = 0; e < 4; ++e) { o0[e] = fsigmoid(g0[e]) * acc[ai][bj][m][0][e]; o1[e] = fsigmoid(g1[e]) * acc[ai][bj][m][1][e]; }
                    bf16_t* op = O + (size_t)row * D + col0 + bj * HALF;
                    if (ADD) { f32x4 p0, p1; unpack8(*(const u32x4*)op, p0, p1); o0 += p0; o1 += p1; }
                    *(u32x4*)op = pack8(o0, o1); } }
    }
};
struct EpiRes {
    static constexpr bool PERM = true, SWAP = false;
    bf16_t* O; const float* x; float* rsq;
    __device__ __forceinline__ void operator()(AccRef acc, const Unit& u, int wr, int wc, int fr, int fq) const {
        const int row0 = u.pm * BM + wr * 64 + fr, col0 = u.pn * BM + wc * 32 + 8 * fq;
#pragma unroll
        for (int ai = 0; ai < 2; ++ai)
#pragma unroll
            for (int m = 0; m < 4; ++m) { const int row = row0 + ai * HALF + m * 16; const size_t off = (size_t)row * D + col0; float ss = 0.f;
#pragma unroll
                for (int bj = 0; bj < 2; ++bj) { const f32x4 a = *(const f32x4*)(x + off + bj * HALF) + acc[ai][bj][m][0], b = *(const f32x4*)(x + off + bj * HALF + 4) + acc[ai][bj][m][1];
                    ss += ((a[0] * a[0] + a[1] * a[1]) + (a[2] * a[2] + a[3] * a[3])) + ((b[0] * b[0] + b[1] * b[1]) + (b[2] * b[2] + b[3] * b[3]));
                    *(u32x4*)(O + off + bj * HALF) = pack8(a, b); }
                ss += __shfl_xor(ss, 16); ss += __shfl_xor(ss, 32);
                if (fq == 0) rsq[(size_t)row * 64 + u.pn * 4 + wc] = ss; }
    }
};
}

#define XB_TMO      128
#define XB_XCNT(j)  (256  + 64 * (j))
#define XB_XSUB(j)  (1280 + 64 * (j))
#define XB_XGEN(j)  (2304 + 64 * (j))
#define XB_TOP      3328
#define XB_TOPGEN   3392
#define XCD_BAR_WORDS 3456
#define XB_SPIN_CAP (1u << 18)
__device__ __forceinline__ unsigned xb_ld(unsigned* p)              { return __hip_atomic_load(p, __ATOMIC_RELAXED, __HIP_MEMORY_SCOPE_AGENT); }
__device__ __forceinline__ unsigned xb_add(unsigned* p, unsigned v) { return __hip_atomic_fetch_add(p, v, __ATOMIC_RELAXED, __HIP_MEMORY_SCOPE_AGENT); }
__device__ __forceinline__ unsigned xb_xcc_id() { return (unsigned)__builtin_amdgcn_s_getreg((3 << 11) | 20) & 0xFu; }
#define XB_SPIN(cond, bar) do { unsigned _sp = 0; while (cond) { __builtin_amdgcn_s_sleep(1); \
    if ((++_sp & 255u) == 0u) { if (xb_ld(&(bar)[XB_TMO])) break; if (_sp > XB_SPIN_CAP) { atomicAdd(&(bar)[XB_TMO], 1u); break; } } } } while (0)
struct XcdBarrier { unsigned* bar; unsigned x; volatile LAS unsigned* st; };
__device__ __forceinline__ XcdBarrier xcd_barrier_post(unsigned* bar, volatile LAS unsigned* st) {
    XcdBarrier b; b.bar = bar; b.x = xb_xcc_id(); b.st = st;
    if (threadIdx.x == 0) (void)xb_add(&bar[XB_XCNT(b.x)], 1u);
    return b;
}
__device__ __forceinline__ void xcd_barrier_complete(unsigned* bar, unsigned x, unsigned& nloc, unsigned& nx) {
    const unsigned G = gridDim.x * gridDim.y * gridDim.z;
    unsigned sum, cnt, mine, sp = 0u;
    for (;;) {
        sum = 0u; cnt = 0u; mine = 0u;
#pragma unroll
        for (unsigned j = 0; j < 16; ++j) { const unsigned c = xb_ld(&bar[XB_XCNT(j)]); sum += c; cnt += (c > 0u) ? 1u : 0u; mine = (j == x) ? c : mine; }
        if (sum == G) break;
        __builtin_amdgcn_s_sleep(1);
        if ((++sp & 255u) == 0u) { if (xb_ld(&bar[XB_TMO])) break; if (sp > XB_SPIN_CAP) { atomicAdd(&bar[XB_TMO], 1u); break; } }
    }
    nloc = mine > 0u ? mine : 1u; nx = cnt > 0u ? cnt : 1u;
}
__device__ __forceinline__ void xcd_barrier(const XcdBarrier& b) {
    asm volatile("s_waitcnt vmcnt(0)" ::: "memory");
    __syncthreads();
    if (threadIdx.x == 0) {
        unsigned* bar = b.bar;
        __builtin_amdgcn_s_waitcnt(0);
        unsigned nloc = b.st[0], nx = b.st[1];
        if (nloc == 0u) { xcd_barrier_complete(bar, b.x, nloc, nx); b.st[0] = nloc; b.st[1] = nx; }
        const unsigned old = xb_add(&bar[XB_XSUB(b.x)], 1u);
        const unsigned gen = old / nloc;
        if (old + 1u == (gen + 1u) * nloc) {
            __builtin_amdgcn_fence(__ATOMIC_RELEASE, "agent");
            asm volatile("s_waitcnt vmcnt(0)" ::: "memory");
            const unsigned og = xb_add(&bar[XB_TOP], 1u);
            const unsigned tg = og / nx;
            if (og + 1u == (tg + 1u) * nx) xb_add(&bar[XB_TOPGEN], 1u);
            else XB_SPIN(xb_ld(&bar[XB_TOPGEN]) == tg, bar);
            __builtin_amdgcn_fence(__ATOMIC_ACQUIRE, "agent");
            xb_add(&bar[XB_XGEN(b.x)], 1u);
            asm volatile("s_waitcnt vmcnt(0)" ::: "memory");
        } else {
            XB_SPIN(xb_ld(&bar[XB_XGEN(b.x)]) == gen, bar);
            __builtin_amdgcn_fence(__ATOMIC_ACQUIRE, "agent");
            asm volatile("s_waitcnt vmcnt(0)" ::: "memory");
        }
    }
    __syncthreads();
}

struct Args {
    const float *x, *norm1_g, *w_in, *mu, *w0, *w_up, *a0, *a_up, *g_up, *k_k, *k_a, *r_k, *lnx_g, *lnx_b, *w_ba, *w_bb, *w_out, *norm2_g, *peer_wq, *sub_keys, *peer_u, *peer_v, *final_g;
    float* out; unsigned char* ws; int ph_lo, ph_hi, li, pad;
};
#define CAS __attribute__((address_space(4)))
typedef const CAS Args* ArgsP;
__device__ __forceinline__ ArgsP get_args() { ArgsP p = (ArgsP)__builtin_amdgcn_kernarg_segment_ptr(); asm volatile("" : "+s"(p)); return p; }
struct Frame { LAS unsigned char* lds; int tid, lane, wave, vcu, G; };

__device__ __forceinline__ int win_dst(int s) {
    if (s < SHIFTW) return s;
    if (s < SHIFTW + 4096) { const int base = (s < SHIFTW + 2048) ? SHIFTW : SHIFTW + 2048; const int m = s - base, head = m >> 7, c = m & 127; const int j = (c < 64) ? 2 * c : 2 * (c - 64) + 1;
        return ((s < SHIFTW + 2048) ? PC_MQ : PC_MK) + head * 128 + j; }
    if (s < SHIFTW + 6144) return PC_MV + (s - (SHIFTW + 4096));
    if (s < SHIFTW + 6144 + 4096) return PC_GA + (s - (SHIFTW + 6144));
    return PC_GB + (s - (SHIFTW + 6144 + 4096));
}
template <bool MAPWIN> __device__ __forceinline__ void p0_transpose_item(const float* W, int K, int N, bf16_t* WT, int Kd, LAS float* scr, int item, int lane, const float* kscale = nullptr) {
    const int nblk = N / 32, kb = item / nblk, nb = item % nblk, k0 = 64 * kb, n0 = 32 * nb;
    { const int krow = lane >> 3, c4 = lane & 7; f32x4 v[8];
#pragma unroll
      for (int i = 0; i < 8; ++i) { const int kk = 8 * i + krow; v[i] = (k0 + kk < K) ? *(const f32x4*)(W + (size_t)(k0 + kk) * N + n0 + 4 * c4) : (f32x4){0.f, 0.f, 0.f, 0.f}; }
      if (kscale) {
#pragma unroll
          for (int i = 0; i < 8; ++i) { const int kk = 8 * i + krow; if (k0 + kk < K) v[i] = v[i] * kscale[k0 + kk]; } }
#pragma unroll
      for (int i = 0; i < 8; ++i) { LAS float* d = scr + (8 * i + krow) * 33 + 4 * c4; d[0] = v[i].x; d[1] = v[i].y; d[2] = v[i].z; d[3] = v[i].w; } }
    LDS_WAIT(); asm volatile("" ::: "memory");
    const int c = lane & 7;
#pragma unroll
    for (int j = 0; j < 4; ++j) { const int n = (lane >> 3) + 8 * j; const LAS float* s = scr + (8 * c) * 33 + n;
        u32x4 o; o.x = pk2(s[0 * 33], s[1 * 33]); o.y = pk2(s[2 * 33], s[3 * 33]); o.z = pk2(s[4 * 33], s[5 * 33]); o.w = pk2(s[6 * 33], s[7 * 33]);
        const int row = MAPWIN ? win_dst(n0 + n) : (n0 + n);
        *(u32x4*)(WT + (size_t)row * Kd + k0 + 8 * c) = o; }
    LDS_WAIT(); asm volatile("" ::: "memory");
}
__device__ __forceinline__ void p0_win_load(const float* W, int item, int lane, f32x4 (&v)[8]) {
    constexpr int nblk = INW / 32; const int kb = item / nblk, nb = item % nblk, k0 = 64 * kb, n0 = 32 * nb, krow = lane >> 3, c4 = lane & 7;
#pragma unroll
    for (int i = 0; i < 8; ++i) v[i] = *(const f32x4*)(W + (size_t)(k0 + 8 * i + krow) * INW + n0 + 4 * c4);
}
__device__ __forceinline__ void p0_win_finish(bf16_t* WT, LAS float* scr, int item, int lane, const f32x4 (&v)[8]) {
    constexpr int nblk = INW / 32; const int kb = item / nblk, nb = item % nblk, k0 = 64 * kb, n0 = 32 * nb, krow = lane >> 3, c4 = lane & 7;
#pragma unroll
    for (int i = 0; i < 8; ++i) { LAS float* d = scr + (8 * i + krow) * 33 + 4 * c4; d[0] = v[i].x; d[1] = v[i].y; d[2] = v[i].z; d[3] = v[i].w; }
    LDS_WAIT(); asm volatile("" ::: "memory");
    const int c = lane & 7;
#pragma unroll
    for (int j = 0; j < 4; ++j) { const int n = (lane >> 3) + 8 * j; const LAS float* s = scr + (8 * c) * 33 + n;
        u32x4 o; o.x = pk2(s[0 * 33], s[1 * 33]); o.y = pk2(s[2 * 33], s[3 * 33]); o.z = pk2(s[4 * 33], s[5 * 33]); o.w = pk2(s[6 * 33], s[7 * 33]);
        *(u32x4*)(WT + (size_t)win_dst(n0 + n) * D + k0 + 8 * c) = o; }
    LDS_WAIT(); asm volatile("" ::: "memory");
}
__device__ __forceinline__ void rms_rows_to_bf16(const float* x, const float* g, bf16_t* o, int m0, int mstride, int lane) {
    const f32x4* gr = (const f32x4*)g + lane;
    f32x4 v[16], w[16];
    if (m0 < T) {
#pragma unroll
        for (int j = 0; j < 16; ++j) v[j] = ((const f32x4*)(x + (size_t)m0 * D) + lane)[64 * j]; }
    for (int m = m0; m < T; m += mstride) { const bool hasn = m + mstride < T;
        if (hasn) {
#pragma unroll
            for (int j = 0; j < 16; ++j) w[j] = ((const f32x4*)(x + (size_t)(m + mstride) * D) + lane)[64 * j]; }
        float s = 0.f;
#pragma unroll
        for (int j = 0; j < 16; ++j) s += (v[j].x * v[j].x + v[j].y * v[j].y) + (v[j].z * v[j].z + v[j].w * v[j].w);
        const float rs = 1.0f / sqrtf(wave_sum(s) * (1.0f / D) + NORM_EPS);
        u32x2* o8 = (u32x2*)(o + (size_t)m * D) + lane;
#pragma unroll
        for (int j = 0; j < 16; ++j) { const f32x4 gg = gr[64 * j]; u32x2 q; q.x = pk2(v[j].x * rs * gg.x, v[j].y * rs * gg.y); q.y = pk2(v[j].z * rs * gg.z, v[j].w * rs * gg.w); o8[64 * j] = q; }
        if (hasn) {
#pragma unroll
            for (int j = 0; j < 16; ++j) v[j] = w[j]; }
    }
}
__device__ __forceinline__ void cvt_table(const float* src, bf16_t* dst, size_t n8, size_t gtid, size_t nthr) {
    for (size_t i = gtid; i < n8; i += nthr) { const f32x4 a = ((const f32x4*)src)[2 * i], b = ((const f32x4*)src)[2 * i + 1]; ((u32x4*)dst)[i] = pg8::pack8(a, b); }
}
__device__ __forceinline__ void pq_load(ArgsP A, int row, int lane, f32x4 (&v)[16]) {
    const f32x4* src = (const f32x4*)((row >= 16384 ? A->peer_v + (size_t)(row - 16384) * D : A->peer_u + (size_t)row * D)) + lane;
#pragma unroll
    for (int j = 0; j < 16; ++j) v[j] = __builtin_nontemporal_load(src + 64 * j);
}
__device__ __forceinline__ void pq_finish(unsigned char* ws, int row, int lane, const f32x4 (&v)[16]) {
    const bool isv = row >= 16384; const int rr = isv ? row - 16384 : row; float am = 0.f;
#pragma unroll
    for (int j = 0; j < 16; ++j) am = fmaxf(fmaxf(am, fmaxf(fabsf(v[j].x), fabsf(v[j].y))), fmaxf(fabsf(v[j].z), fabsf(v[j].w)));
#pragma unroll
    for (int o = 1; o < 64; o <<= 1) am = fmaxf(am, __shfl_xor(am, o));
    const float inv = am > 0.f ? 127.0f / am : 0.f; unsigned* dst = (unsigned*)(ws + (isv ? WS_PV : WS_PU)) + (size_t)rr * (D / 4) + lane;
    constexpr float MAGIC = 8388608.0f + 128.0f;
#pragma unroll
    for (int j = 0; j < 16; ++j) { const unsigned b0 = __builtin_bit_cast(unsigned, __builtin_fmaf(v[j].x, inv, MAGIC)), b1 = __builtin_bit_cast(unsigned, __builtin_fmaf(v[j].y, inv, MAGIC)),
                                                  b2 = __builtin_bit_cast(unsigned, __builtin_fmaf(v[j].z, inv, MAGIC)), b3 = __builtin_bit_cast(unsigned, __builtin_fmaf(v[j].w, inv, MAGIC));
        dst[64 * j] = __builtin_amdgcn_perm(__builtin_amdgcn_perm(b3, b2, 0x0c0c0400u), __builtin_amdgcn_perm(b1, b0, 0x0c0c0400u), 0x05040100u); }
    if (lane == 0) ((float*)(ws + (isv ? WS_PSV : WS_PSU)))[rr] = am * (1.0f / 127.0f);
}
__device__ __forceinline__ int pq_ra(int G) { constexpr int NT1 = (T / 256) * (PLD / 256); const int nx = NT1 % G, idle = nx ? G - nx : 0, n = idle * NWAVES * 14; return n < 2 * 16384 ? n : 2 * 16384; }
__device__ __forceinline__ void peer_quant(ArgsP A, Frame& F, int r0, int r1, int w0, int wstride) {
    f32x4 v[16], w[16];
    int row = r0 + w0;
    if (row < r1) pq_load(A, row, F.lane, v);
    for (; row < r1; row += wstride) { const bool hasn = row + wstride < r1;
        if (hasn) pq_load(A, row + wstride, F.lane, w);
        pq_finish(A->ws, row, F.lane, v);
        if (hasn) {
#pragma unroll
            for (int j = 0; j < 16; ++j) v[j] = w[j]; }
    }
}
struct TrJob { const float* W; int N; bf16_t* WT; int Kd; const float* ks; int item; };
__device__ __forceinline__ void tr_load(const TrJob& j, int lane, f32x4 (&v)[8]) {
    const int nblk = j.N / 32, kb = j.item / nblk, nb = j.item % nblk, k0 = 64 * kb, n0 = 32 * nb, krow = lane >> 3, c4 = lane & 7;
#pragma unroll
    for (int i = 0; i < 8; ++i) v[i] = *(const f32x4*)(j.W + (size_t)(k0 + 8 * i + krow) * j.N + n0 + 4 * c4);
}
__device__ __forceinline__ void tr_finish(const TrJob& j, LAS float* scr, int lane, const f32x4 (&v)[8]) {
    const int nblk = j.N / 32, kb = j.item / nblk, nb = j.item % nblk, k0 = 64 * kb, n0 = 32 * nb, krow = lane >> 3, c4 = lane & 7;
#pragma unroll
    for (int i = 0; i < 8; ++i) { const float sc = j.ks ? j.ks[k0 + 8 * i + krow] : 1.0f; LAS float* d = scr + (8 * i + krow) * 33 + 4 * c4; d[0] = v[i].x * sc; d[1] = v[i].y * sc; d[2] = v[i].z * sc; d[3] = v[i].w * sc; }
    LDS_WAIT(); asm volatile("" ::: "memory");
    const int c = lane & 7;
#pragma unroll
    for (int jn = 0; jn < 4; ++jn) { const int n = (lane >> 3) + 8 * jn; const LAS float* s = scr + (8 * c) * 33 + n;
        u32x4 o; o.x = pk2(s[0 * 33], s[1 * 33]); o.y = pk2(s[2 * 33], s[3 * 33]); o.z = pk2(s[4 * 33], s[5 * 33]); o.w = pk2(s[6 * 33], s[7 * 33]);
        *(u32x4*)(j.WT + (size_t)(n0 + n) * j.Kd + k0 + 8 * c) = o; }
    LDS_WAIT(); asm volatile("" ::: "memory");
}
__device__ __forceinline__ void late_weights(ArgsP A, Frame& F, int w0, int wstride) {
    unsigned char* ws = A->ws;
    LAS float* scr = (LAS float*)(F.lds + RING_OFF + F.wave * 16384);
    constexpr int I_BA = 32 * 128, I_OUT = 64 * 128, I_WQ = 64 * 64, I_SK = PH_ * 2 * PNK * PHALF / 512;
    constexpr int NT = 2 * I_BA + I_OUT + I_WQ;
    auto job = [&](int it) { TrJob j; int r = it;
        if (r < I_BA) { j = TrJob{A->w_ba, D, (bf16_t*)(ws + WS_WA), RW, nullptr, r}; return j; } r -= I_BA;
        if (r < I_BA) { j = TrJob{A->w_bb, D, (bf16_t*)(ws + WS_WB), RW, nullptr, r}; return j; } r -= I_BA;
        if (r < I_OUT) { j = TrJob{A->w_out, D, (bf16_t*)(ws + WS_WOUT), D, nullptr, r}; return j; } r -= I_OUT;
        j = TrJob{A->peer_wq, 2048, (bf16_t*)(ws + WS_WQ), D, A->norm2_g, r}; return j; };
    { f32x4 va[8], vb[8], vc[8]; int it = w0;
      if (it < NT) tr_load(job(it), F.lane, va);
      if (it + wstride < NT) tr_load(job(it + wstride), F.lane, vb);
      for (; it < NT; it += wstride) {
          if (it + 2 * wstride < NT) tr_load(job(it + 2 * wstride), F.lane, vc);
          tr_finish(job(it), scr, F.lane, va);
#pragma unroll
          for (int i = 0; i < 8; ++i) { va[i] = vb[i]; vb[i] = vc[i]; } } }
    for (int r = w0; r < I_SK; r += wstride) { const size_t i = (size_t)r * 64 + F.lane; const f32x4 a = ((const f32x4*)A->sub_keys)[2 * i], b = ((const f32x4*)A->sub_keys)[2 * i + 1]; ((u32x4*)(ws + WS_SUBK))[i] = pg8::pack8(a, b); }
}
__device__ __forceinline__ void ph0_prologue(ArgsP A, Frame& F) {
    unsigned char* ws = A->ws;
    LAS float* scr = (LAS float*)(F.lds + RING_OFF + F.wave * 16384);
    const int gw = F.vcu * NWAVES + F.wave, NGW = F.G * NWAVES;
    constexpr int I_IN = 64 * (INW / 32), I_UP = 2 * 64, I_G = 8 * 64;
    constexpr int NITEMS = I_IN + 2 * I_UP + I_G;
    { f32x4 va[8], vb[8], vc[8]; int it = gw;
      if (it < I_IN) p0_win_load(A->w_in, it, F.lane, va);
      if (it + NGW < I_IN) p0_win_load(A->w_in, it + NGW, F.lane, vb);
      for (; it < I_IN; it += NGW) {
          if (it + 2 * NGW < I_IN) p0_win_load(A->w_in, it + 2 * NGW, F.lane, vc);
          p0_win_finish((bf16_t*)(ws + WS_WIN), scr, it, F.lane, va);
#pragma unroll
          for (int i = 0; i < 8; ++i) { va[i] = vb[i]; vb[i] = vc[i]; } } }
    for (int it = gw; it < NITEMS - I_IN; it += NGW) {
        int r = it;
        if (r < I_UP) { p0_transpose_item<false>(A->w_up, LW, RW, (bf16_t*)(ws + WS_WUP), LW, scr, r, F.lane); continue; } r -= I_UP;
        if (r < I_UP) { p0_transpose_item<false>(A->a_up, LA, RW, (bf16_t*)(ws + WS_AUP), LA, scr, r, F.lane); continue; } r -= I_UP;
        p0_transpose_item<false>(A->g_up, LG, RW, (bf16_t*)(ws + WS_GUP), LGP, scr, r, F.lane);
    }
    const size_t gtid = (size_t)F.vcu * NTHR + F.tid, nthr = (size_t)F.G * NTHR;
    for (size_t i = gtid; i < (size_t)32 * D / 8; i += nthr) ((u32x4*)((bf16_t*)(ws + WS_WIN) + (size_t)SHIFTW * D))[i] = (u32x4){0u, 0u, 0u, 0u};
    for (size_t i = gtid; i < (size_t)T * 64; i += nthr) { const int pos = (int)(i >> 6), fi = (int)(i & 63); const float inv = powf(10000.0f, -(float)fi / 64.0f); const float ang = (float)pos * inv;
        ((f32x2*)(ws + WS_ROPE))[i] = (f32x2){cosf(ang), sinf(ang)}; }
    rms_rows_to_bf16(A->x, A->norm1_g, (bf16_t*)(ws + WS_XN), gw, NGW, F.lane);
}

__device__ __forceinline__ f32x4 ld4bf(const bf16_t* p) { const u32x2 w = *(const u32x2*)p; return (f32x4){bflo(w.x), bfhi(w.x), bflo(w.y), bfhi(w.y)}; }
__device__ __forceinline__ void st4bf(bf16_t* p, f32x4 v) { u32x2 w; w.x = pk2(v[0], v[1]); w.y = pk2(v[2], v[3]); *(u32x2*)p = w; }
__device__ __forceinline__ void ph2_prep(ArgsP A, Frame& F) {
    unsigned char* ws = A->ws; const bf16_t* PROJ = (const bf16_t*)(ws + WS_PROJ);
    LAS float* red = (LAS float*)(F.lds + RING_OFF);
    for (int it = F.vcu; it < NBLK * MH; it += F.G) { const int n = it / MH, h = it % MH, d8 = F.tid & 15, rg = F.tid >> 4;
        const bf16_t* p = (const bf16_t*)(ws + WS_KB) + ((size_t)h * T + n * MBLK + rg * 8) * MD + d8 * 8; u32x4 kv[8];
#pragma unroll
        for (int i = 0; i < 8; ++i) kv[i] = *(const u32x4*)(p + (size_t)i * MD);
        f32x4 s0 = (f32x4){0.f, 0.f, 0.f, 0.f}, s1 = s0;
#pragma unroll
        for (int i = 0; i < 8; ++i) { f32x4 a, b; pg8::unpack8(kv[i], a, b); s0 += a; s1 += b; }
        *(LAS f32x4*)(red + rg * 128 + d8 * 8) = s0; *(LAS f32x4*)(red + rg * 128 + d8 * 8 + 4) = s1; WG_BAR();
        if (F.tid < 128) { float m = 0.f;
#pragma unroll
            for (int g = 0; g < 32; ++g) m += red[g * 128 + F.tid];
            m *= (1.0f / MBLK); const unsigned hi = f2bf(m); const float lo = m - __builtin_bit_cast(float, hi << 16);
            ((bf16_t*)(ws + WS_KMEAN))[(size_t)(h * NBLK + n) * MD + F.tid] = (bf16_t)hi; ((bf16_t*)(ws + WS_KMEAN + 131072))[(size_t)(h * NBLK + n) * MD + F.tid] = (bf16_t)f2bf(lo); }
        WG_BAR(); }
    const int tid = F.tid; const int c = 4 * tid;
    const f32x4 mu_r = *(const f32x4*)(A->mu + PC_R + c), mu_k = *(const f32x4*)(A->mu + PC_K + c), mu_v = *(const f32x4*)(A->mu + PC_V + c), kkw = *(const f32x4*)(A->k_k + c);
    int lc = 0, lcc = 0; if (tid < 32) { lcc = 4 * tid; lc = PC_WL + lcc; } else if (tid < 64) { lcc = 4 * (tid - 32); lc = PC_AL + lcc; } else { lcc = 4 * (tid - 64); lc = PC_GL + lcc; }
    const bool lact = tid < 64 || (tid < 192 && lcc < LG);
    const f32x4 mu_l = lact ? *(const f32x4*)(A->mu + lc) : (f32x4){0.f, 0.f, 0.f, 0.f};
    u32x2 prv[4], cur[4], n1[4], n2[4];
    auto tload = [&](int t, u32x2 (&rg)[4]) { const bf16_t* P = PROJ + (size_t)t * PLD;
        rg[0] = *(const u32x2*)(P + PC_R + c); rg[1] = *(const u32x2*)(P + PC_K + c); rg[2] = *(const u32x2*)(P + PC_V + c);
        if (lact) rg[3] = *(const u32x2*)(P + lc); else rg[3] = (u32x2){0u, 0u}; };
    auto up4 = [](u32x2 w) { return (f32x4){bflo(w.x), bfhi(w.x), bflo(w.y), bfhi(w.y)}; };
    const int tb = (int)(((long long)F.vcu * T) / F.G), te = (int)(((long long)(F.vcu + 1) * T) / F.G);
    if (tb < te) { tload(tb > 0 ? tb - 1 : 0, prv); tload(tb, cur); if (tb + 1 < te) tload(tb + 1, n1); }
    for (int t = tb; t < te; ++t) { if (t + 2 < te) tload(t + 2, n2);
        const float hp = t > 0 ? 1.0f : 0.0f;
        { const f32x4 p = up4(cur[0]), pp = up4(prv[0]) * hp; st4bf((bf16_t*)(ws + WS_ZR) + (size_t)t * RW + c, p + (pp - p) * mu_r); }
        { const f32x4 p = up4(cur[1]), pp = up4(prv[1]) * hp; const f32x4 zk = p + (pp - p) * mu_k;
          st4bf((bf16_t*)(ws + WS_KP) + (size_t)t * RW + c, zk); const f32x4 kk = zk * kkw;
          const float ss = sum16((kk[0] * kk[0] + kk[1] * kk[1]) + (kk[2] * kk[2] + kk[3] * kk[3])); const float inv = 1.0f / fmaxf(sqrtf(ss), 1e-12f);
          st4bf((bf16_t*)(ws + WS_KKN) + (size_t)t * RW + c, kk * inv); }
        { const f32x4 p = up4(cur[2]), pp = up4(prv[2]) * hp; st4bf((bf16_t*)(ws + WS_ZV) + (size_t)t * RW + c, p + (pp - p) * mu_v); }
        if (tid < 192) { const f32x4 zero = (f32x4){0.f, 0.f, 0.f, 0.f};
            f32x4 z = zero; if (lact) { const f32x4 p = up4(cur[3]), pp = up4(prv[3]) * hp; z = p + (pp - p) * mu_l; }
            if (tid < 32) { f32x4 o;
#pragma unroll
                for (int e = 0; e < 4; ++e) o[e] = 1.0f - 2.0f * __builtin_amdgcn_rcpf(__expf(2.0f * z[e]) + 1.0f);
                st4bf((bf16_t*)(ws + WS_AW) + (size_t)t * LW + lcc, o); }
            else if (tid < 64) st4bf((bf16_t*)(ws + WS_AA) + (size_t)t * LA + lcc, z);
            else { f32x4 o = zero; if (lcc < LG) {
#pragma unroll
                for (int e = 0; e < 4; ++e) o[e] = fsigmoid(z[e]); }
                st4bf((bf16_t*)(ws + WS_AG) + (size_t)t * LGP + lcc, o); }
        }
#pragma unroll
        for (int i = 0; i < 4; ++i) { prv[i] = cur[i]; cur[i] = n1[i]; n1[i] = n2[i]; }
    }
}

__device__ __forceinline__ void ph3_gate(ArgsP A, Frame& F) {
    unsigned char* ws = A->ws; const bf16_t* PROJ = (const bf16_t*)(ws + WS_PROJ); const bf16_t* KMH = (const bf16_t*)(ws + WS_KMEAN); const bf16_t* KML = (const bf16_t*)(ws + WS_KMEAN + 131072); unsigned* MASK = (unsigned*)(ws + WS_MASK);
    const int gw = F.vcu * NWAVES + F.wave, NGW = F.G * NWAVES; const int r = F.lane & 31, hh = F.lane >> 5; const float NEG = -__builtin_inff();
    for (int it = gw; it < (T / 32) * MH; it += NGW) { const int tg = it >> 4, h = it & 15, t = tg * 32 + r, blk = tg >> 3;
        if (blk == 0) { if (hh == 0) MASK[t * MH + h] = 0u; continue; }
        f32x16 acc;
#pragma unroll
        for (int e = 0; e < 16; ++e) acc[e] = 0.f;
#pragma unroll
        for (int ks = 0; ks < 8; ++ks) { const bf16x8 q = *(const bf16x8*)(PROJ + (size_t)t * PLD + PC_MQ + h * MD + 16 * ks + 8 * hh); const size_t ko = (size_t)(h * NBLK + r) * MD + 16 * ks + 8 * hh;
            acc = __builtin_amdgcn_mfma_f32_32x32x16_bf16(*(const bf16x8*)(KMH + ko), q, acc, 0, 0, 0); acc = __builtin_amdgcn_mfma_f32_32x32x16_bf16(*(const bf16x8*)(KML + ko), q, acc, 0, 0, 0); }
        float t0 = NEG, t1 = NEG, t2 = NEG;
#pragma unroll
        for (int e = 0; e < 16; ++e) { const int n = (e & 3) + 8 * (e >> 2) + 4 * hh; float ae = acc[e]; asm volatile("" : "+v"(ae));
            float x = __builtin_bit_cast(float, (__builtin_bit_cast(unsigned, ae) & ~31u) | (unsigned)(31 - n)); x = (n < blk) ? x : NEG;
            t2 = __builtin_amdgcn_fmed3f(t1, t2, x); t1 = __builtin_amdgcn_fmed3f(t0, t1, x); t0 = fmaxf(t0, x); }
        const float o0 = __shfl_xor(t0, 32), o1 = __shfl_xor(t1, 32), o2 = __shfl_xor(t2, 32);
        t2 = __builtin_amdgcn_fmed3f(t1, t2, o0); t1 = __builtin_amdgcn_fmed3f(t0, t1, o0); t0 = fmaxf(t0, o0);
        t2 = __builtin_amdgcn_fmed3f(t1, t2, o1); t1 = __builtin_amdgcn_fmed3f(t0, t1, o1); t0 = fmaxf(t0, o1);
        t2 = __builtin_amdgcn_fmed3f(t1, t2, o2); t1 = __builtin_amdgcn_fmed3f(t0, t1, o2); t0 = fmaxf(t0, o2);
        unsigned sel = 1u << (31 - (__builtin_bit_cast(unsigned, t0) & 31u));
        if (blk > 1) sel |= 1u << (31 - (__builtin_bit_cast(unsigned, t1) & 31u));
        if (blk > 2) sel |= 1u << (31 - (__builtin_bit_cast(unsigned, t2) & 31u));
        if (hh == 0) MASK[t * MH + h] = sel;
        { gu32* cnt = (gu32*)(ws + WS_CTL) + CW_CNT + h * 32; unsigned short* lst = (unsigned short*)(ws + WS_LIST) + (size_t)h * 32 * 8192; const unsigned mysel = hh == 0 ? sel : 0u;
          unsigned mycnt = 0u;
          for (int j = 0; j < blk; ++j) { const unsigned long long bal = __ballot((mysel >> j) & 1u); const unsigned c = (unsigned)__builtin_popcountll(bal); mycnt = (F.lane == j) ? c : mycnt; }
          unsigned base = 0u; if (F.lane < blk && mycnt) base = __hip_atomic_fetch_add(cnt + F.lane, mycnt, __ATOMIC_RELAXED, __HIP_MEMORY_SCOPE_AGENT);
          for (int j = 0; j < blk; ++j) { const unsigned long long bal = __ballot((mysel >> j) & 1u); const unsigned bj = (unsigned)__builtin_amdgcn_readlane((int)base, j);
              if ((mysel >> j) & 1u) { const unsigned off = __builtin_amdgcn_mbcnt_hi((unsigned)(bal >> 32), __builtin_amdgcn_mbcnt_lo((unsigned)bal, 0u)); const unsigned slot = (unsigned)__builtin_popcount(mysel & ((1u << j) - 1u));
                  lst[(size_t)j * 8192 + bj + off] = (unsigned short)((unsigned)t | (slot << 13)); } } } }
}

constexpr int CK = 64, NCHK = T / CK, CP = 144, CPF = 272;
constexpr int L_AT = 0, L_BT = 9216, L_KT = 18432, L_RT = 27648, L_ATT = 36864, L_BTT = 46080, L_V = 55296, L_MKA = 64512, L_MBRT = 73728, L_MKRT = 82944, L_A2 = 92160, L_MBA = 101376, L_PC = 118784, L_WT = 119040, L_MBH = 121088, L_TD = 130304, L_PT = 134912, L_CEND = 139520;
constexpr int L_TT = L_AT, L_A1 = L_BT, L_Y2T = L_MKA, L_G2T = L_ATT;
static_assert(L_CEND <= RING_BYTES, "chunk prep LDS");
constexpr size_t CHW_ITEM = 32768;
__device__ __forceinline__ f32x16 nt_quad(const LAS unsigned char* X, const LAS unsigned char* Y, int qp, int qq, int r, int hh) {
    f32x16 acc;
#pragma unroll
    for (int e = 0; e < 16; ++e) acc[e] = 0.f;
#pragma unroll
    for (int ks = 0; ks < 4; ++ks) { const bf16x8 a = *(const LAS bf16x8*)(Y + (32 * qq + r) * CP + 32 * ks + 16 * hh), b = *(const LAS bf16x8*)(X + (32 * qp + r) * CP + 32 * ks + 16 * hh);
        acc = __builtin_amdgcn_mfma_f32_32x32x16_bf16(a, b, acc, 0, 0, 0); }
    return acc;
}
__device__ __forceinline__ int nt_q(int qq, int e, int hh) { return 32 * qq + (e & 3) + 8 * (e >> 2) + 4 * hh; }
__device__ __forceinline__ void nt_store_bf16(LAS unsigned char* O, int p, int qq, int hh, const f32x16& v) {
#pragma unroll
    for (int g = 0; g < 4; ++g) { u32x2 w; w.x = pk2(v[4 * g], v[4 * g + 1]); w.y = pk2(v[4 * g + 2], v[4 * g + 3]); *(LAS u32x2*)(O + p * CP + (32 * qq + 8 * g + 4 * hh) * 2) = w; }
}
__device__ __forceinline__ void ph4_chunkprep(ArgsP A, Frame& F) {
    unsigned char* ws = A->ws;
    const float* DEC = (const float*)(ws + WS_DEC); const bf16_t* KKN = (const bf16_t*)(ws + WS_KKN); const bf16_t* BBg = (const bf16_t*)(ws + WS_BB); const bf16_t* KPg = (const bf16_t*)(ws + WS_KP);
    const bf16_t* ZR = (const bf16_t*)(ws + WS_ZR); const bf16_t* ZV = (const bf16_t*)(ws + WS_ZV); float* Yg = (float*)(ws + WS_Y); unsigned char* CHW = ws + WS_WIN;
    LAS unsigned char* L = F.lds + RING_OFF; const int wave = F.wave, lane = F.lane, r = lane & 31, hh = lane >> 5;
    const int prod = wave >> 2, qp = (wave >> 1) & 1, qq = wave & 1, p = 32 * qp + r;
    float nwv[8]; unsigned nkk[4], nbb[4], nkp[4], nr[4], nv[4];
    auto request = [&](int h2, int c2) {
#pragma unroll
        for (int k = 0; k < 8; ++k) nwv[k] = DEC[(size_t)(c2 * CK + 8 * wave + k) * RW + (size_t)h2 * RN + lane];
#pragma unroll
        for (int i = 0; i < 4; ++i) { const size_t o = (size_t)(c2 * CK + 8 * wave + 2 * i + hh) * RW + (size_t)h2 * RN + 2 * r;
            nkk[i] = *(const unsigned*)(KKN + o); nbb[i] = *(const unsigned*)(BBg + o); nkp[i] = *(const unsigned*)(KPg + o); nr[i] = *(const unsigned*)(ZR + o); nv[i] = *(const unsigned*)(ZV + o); } };
    if (F.vcu < RH * NCHK) request(F.vcu / NCHK, F.vcu % NCHK);
    if (F.vcu == 0 && wave == 0) {
        const gu32* cnt = (const gu32*)(ws + WS_CTL) + CW_CNT; unsigned* ud = (unsigned*)(ws + WS_UDESC); unsigned np[8], tot = 0u;
#pragma unroll
        for (int k = 0; k < 8; ++k) { const unsigned c = __hip_atomic_load(cnt + 8 * lane + k, __ATOMIC_RELAXED, __HIP_MEMORY_SCOPE_AGENT); np[k] = 1u + ((c + 255u) >> 8); tot += np[k]; }
        unsigned incl = tot;
#pragma unroll
        for (int o = 1; o < 64; o <<= 1) { const unsigned v = __shfl_up(incl, o); if (lane >= o) incl += v; }
        unsigned pos = incl - tot;
#pragma unroll
        for (int k = 0; k < 8; ++k) { const unsigned c = __hip_atomic_load(cnt + 8 * lane + k, __ATOMIC_RELAXED, __HIP_MEMORY_SCOPE_AGENT); const unsigned Lx = (unsigned)(8 * lane + k);
            ud[1 + 2 * pos] = Lx | 0x80000000u; ud[2 + 2 * pos] = c; ++pos;
            for (unsigned ps = 0; ps + 1 < np[k]; ++ps) { ud[1 + 2 * pos] = Lx | (ps << 16); ud[2 + 2 * pos] = c; ++pos; } }
        if (lane == 63) ud[0] = incl; }
    for (int item = F.vcu; item < RH * NCHK; item += F.G) { const int h = item / NCHK, c = item % NCHK; const size_t hc = (size_t)h * RN; const int t0 = c * CK;
        { float wv[8], kkv[8], bbv[8], kpv[8], rv[8]; unsigned vv[8];
#pragma unroll
          for (int k = 0; k < 8; ++k) { const int src = ((k & 1) << 7) | ((lane >> 1) << 2); const bool odd = lane & 1;
              auto mine = [&](unsigned x) { const unsigned w = (unsigned)__builtin_amdgcn_ds_bpermute(src, (int)x); return odd ? (w & 0xffff0000u) : (w << 16); };
              wv[k] = nwv[k]; kkv[k] = __builtin_bit_cast(float, mine(nkk[k >> 1])); bbv[k] = __builtin_bit_cast(float, mine(nbb[k >> 1])); kpv[k] = __builtin_bit_cast(float, mine(nkp[k >> 1]));
              rv[k] = __builtin_bit_cast(float, mine(nr[k >> 1])); vv[k] = mine(nv[k >> 1]) >> 16; }
          { const int nit = item + F.G; if (nit < RH * NCHK) request(nit / NCHK, nit % NCHK); }
          float pl[8]; pl[0] = wv[0];
#pragma unroll
          for (int k = 1; k < 8; ++k) pl[k] = pl[k - 1] * wv[k];
          ((LAS float*)(L + L_WT))[wave * 64 + lane] = pl[7];
          WG_BAR();
          float pre = 1.f;
#pragma unroll
          for (int w2 = 0; w2 < 7; ++w2) { const float x = ((const LAS float*)(L + L_WT))[w2 * 64 + lane]; pre = (w2 < wave) ? pre * x : pre; }
          unsigned atp[4], btp[4], vtp[4];
#pragma unroll
          for (int k = 0; k < 8; ++k) { const float Pt = pre * pl[k], Pm = (k == 0) ? pre : pre * pl[k - 1], ip = __builtin_amdgcn_rcpf(Pt); const int t = 8 * wave + k;
              const unsigned a16 = f2bf(Pm * kkv[k]), b16 = f2bf(bbv[k] * ip), k16 = f2bf(kpv[k] * ip), r16 = f2bf(Pt * rv[k]);
              *(LAS bf16_t*)(L + L_AT + t * CP + 2 * lane) = (bf16_t)a16; *(LAS bf16_t*)(L + L_BT + t * CP + 2 * lane) = (bf16_t)b16; *(LAS bf16_t*)(L + L_KT + t * CP + 2 * lane) = (bf16_t)k16; *(LAS bf16_t*)(L + L_RT + t * CP + 2 * lane) = (bf16_t)r16;
              if (k & 1) { atp[k >> 1] |= a16 << 16; btp[k >> 1] |= b16 << 16; vtp[k >> 1] |= vv[k] << 16; } else { atp[k >> 1] = a16; btp[k >> 1] = b16; vtp[k >> 1] = vv[k]; }
              if (wave == 7 && k == 7) ((LAS float*)(L + L_PC))[lane] = Pt; }
          *(LAS u32x4*)(L + L_ATT + lane * CP + 16 * wave) = (u32x4){atp[0], atp[1], atp[2], atp[3]}; *(LAS u32x4*)(L + L_BTT + lane * CP + 16 * wave) = (u32x4){btp[0], btp[1], btp[2], btp[3]};
          *(LAS u32x4*)(L + L_V + lane * CP + 16 * wave) = (u32x4){vtp[0], vtp[1], vtp[2], vtp[3]}; }
        WG_BAR();
        { const f32x16 v = nt_quad(L + (prod ? L_KT : L_BT), L + L_AT, qp, qq, r, hh); f32x16 m;
#pragma unroll
          for (int e = 0; e < 16; ++e) m[e] = nt_q(qq, e, hh) > p ? v[e] : 0.f;
          if (prod == 0) {
#pragma unroll
              for (int g = 0; g < 4; ++g) *(LAS f32x4*)(L + L_MBA + p * CPF + (32 * qq + 8 * g + 4 * hh) * 4) = (f32x4){m[4 * g], m[4 * g + 1], m[4 * g + 2], m[4 * g + 3]}; }
          if (prod == 0) nt_store_bf16(L + L_MBH, p, qq, hh, m);
          else nt_store_bf16(L + L_MKA, p, qq, hh, m); }
        { const f32x16 v = nt_quad(L + L_RT, L + (prod ? L_KT : L_BT), qp, qq, r, hh); f32x16 m;
#pragma unroll
          for (int e = 0; e < 16; ++e) m[e] = nt_q(qq, e, hh) <= p ? v[e] : 0.f;
          nt_store_bf16(L + (prod ? L_MKRT : L_MBRT), p, qq, hh, m); }
        WG_BAR();
        { const int t = 8 * wave + (lane >> 3), g = lane & 7, base = 32 * (t >> 5); float T4[4] = {0.f, 0.f, 0.f, 0.f};
          const LAS unsigned char* mrow = L + L_MBA + (base + 4 * g) * 4;
          f32x4 m = *(const LAS f32x4*)(mrow + (base + 31) * CPF);
#pragma unroll 1
          for (int Sx = 7; Sx >= 0; --Sx) {
#pragma unroll
              for (int q = 3; q >= 0; --q) { const int sl = 4 * Sx + q, sr = base + sl, sn = sl > 0 ? sr - 1 : sr; const f32x4 n = *(const LAS f32x4*)(mrow + sn * CPF);
                  float part = (m[0] * T4[0] + m[1] * T4[1]) + (m[2] * T4[2] + m[3] * T4[3]);
                  part += dpp_f<0xB1>(part); part += dpp_f<0x4E>(part); part += dpp_f<0x141>(part);
                  const float val = (sr == t) ? 1.0f : part; T4[q] = (g == Sx) ? val : T4[q]; m = n; } }
          const unsigned w0 = pk2(T4[0], T4[1]), w1 = pk2(T4[2], T4[3]);
          *(LAS u32x2*)(L + L_TT + t * CP + (base + 4 * g) * 2) = (u32x2){w0, w1};
          if (base == 0) { *(LAS u32x2*)(L + L_TT + t * CP + (32 + 4 * g) * 2) = (u32x2){0u, 0u};
              *(LAS bf16_t*)(L + L_TD + (4 * g) * CP + 2 * t) = (bf16_t)(w0 & 0xffffu); *(LAS bf16_t*)(L + L_TD + (4 * g + 1) * CP + 2 * t) = (bf16_t)(w0 >> 16);
              *(LAS bf16_t*)(L + L_TD + (4 * g + 2) * CP + 2 * t) = (bf16_t)(w1 & 0xffffu); *(LAS bf16_t*)(L + L_TD + (4 * g + 3) * CP + 2 * t) = (bf16_t)(w1 >> 16); } }
        WG_BAR();
        if (wave == 0) {
            f32x16 acc;
#pragma unroll
            for (int e = 0; e < 16; ++e) acc[e] = 0.f;
#pragma unroll
            for (int ks = 0; ks < 2; ++ks) { const bf16x8 a = *(const LAS bf16x8*)(L + L_MBH + r * CP + 64 + 32 * ks + 16 * hh), b = *(const LAS bf16x8*)(L + L_TT + (32 + r) * CP + 64 + 32 * ks + 16 * hh);
                acc = __builtin_amdgcn_mfma_f32_32x32x16_bf16(a, b, acc, 0, 0, 0); }
            nt_store_bf16(L + L_PT, r, 0, hh, acc);
            LDS_WAIT(); asm volatile("" ::: "memory");
#pragma unroll
            for (int e = 0; e < 16; ++e) acc[e] = 0.f;
#pragma unroll
            for (int ks = 0; ks < 2; ++ks) { const bf16x8 a = *(const LAS bf16x8*)(L + L_TD + r * CP + 32 * ks + 16 * hh), b = *(const LAS bf16x8*)(L + L_PT + r * CP + 32 * ks + 16 * hh);
                acc = __builtin_amdgcn_mfma_f32_32x32x16_bf16(a, b, acc, 0, 0, 0); }
            nt_store_bf16(L + L_TT, 32 + r, 0, hh, acc);
        }
        WG_BAR();
        { const f32x16 v = nt_quad(L + (prod ? L_MKA : L_ATT), L + L_TT, qp, qq, r, hh);
          nt_store_bf16(L + (prod ? L_A2 : L_A1), p, qq, hh, v); }
        WG_BAR();
        unsigned char* cw = CHW + (size_t)item * CHW_ITEM;
        { const f32x16 v = nt_quad(L + L_MBRT, L + (prod ? L_A2 : L_A1), qp, qq, r, hh); f32x16 o;
          const LAS unsigned char* addm = L + (prod ? L_MKRT : L_RT);
#pragma unroll
          for (int g = 0; g < 4; ++g) { const u32x2 w = *(const LAS u32x2*)(addm + p * CP + (32 * qq + 8 * g + 4 * hh) * 2); o[4 * g] = v[4 * g] + bflo(w.x); o[4 * g + 1] = v[4 * g + 1] + bfhi(w.x); o[4 * g + 2] = v[4 * g + 2] + bflo(w.y); o[4 * g + 3] = v[4 * g + 3] + bfhi(w.y); }
          if (prod) nt_store_bf16(L + L_Y2T, p, qq, hh, o);
          else {
#pragma unroll
              for (int g = 0; g < 4; ++g) { u32x2 w; w.x = pk2(o[4 * g], o[4 * g + 1]); w.y = pk2(o[4 * g + 2], o[4 * g + 3]); *(u32x2*)(cw + (size_t)p * 128 + (32 * qq + 8 * g + 4 * hh) * 2) = w; } } }
        { const f32x16 v = nt_quad(L + L_BTT, L + (prod ? L_A2 : L_A1), qp, qq, r, hh); const float pc = ((const LAS float*)(L + L_PC))[p]; f32x16 o;
          if (prod) {
#pragma unroll
              for (int e = 0; e < 16; ++e) o[e] = (v[e] + bf1(*(const LAS bf16_t*)(L + L_KT + nt_q(qq, e, hh) * CP + 2 * p))) * pc;
              nt_store_bf16(L + L_G2T, p, qq, hh, o); }
          else {
#pragma unroll
              for (int e = 0; e < 16; ++e) o[e] = (v[e] + (nt_q(qq, e, hh) == p ? 1.0f : 0.0f)) * pc;
#pragma unroll
              for (int g = 0; g < 4; ++g) { u32x2 w; w.x = pk2(o[4 * g], o[4 * g + 1]); w.y = pk2(o[4 * g + 2], o[4 * g + 3]); *(u32x2*)(cw + 8192 + (size_t)p * 128 + (32 * qq + 8 * g + 4 * hh) * 2) = w; } } }
        WG_BAR();
        { const f32x16 v = prod ? nt_quad(L + L_V, L + L_G2T, qp, qq, r, hh) : nt_quad(L + L_Y2T, L + L_V, qp, qq, r, hh);
          if (prod) { bf16_t* dstb = (bf16_t*)(cw + 16384) + (size_t)p * 64;
#pragma unroll
              for (int g = 0; g < 4; ++g) { u32x2 w; w.x = pk2(v[4 * g], v[4 * g + 1]); w.y = pk2(v[4 * g + 2], v[4 * g + 3]); *(u32x2*)(dstb + 32 * qq + 8 * g + 4 * hh) = w; } }
          else { bf16_t* dstb = (bf16_t*)Yg + (size_t)(t0 + p) * RW + hc;
#pragma unroll
              for (int g = 0; g < 4; ++g) { u32x2 w; w.x = pk2(v[4 * g], v[4 * g + 1]); w.y = pk2(v[4 * g + 2], v[4 * g + 3]); *(u32x2*)(dstb + 32 * qq + 8 * g + 4 * hh) = w; } } }
        WG_BAR();
    }
}
__device__ __forceinline__ void ph5_chain(ArgsP A, Frame& F, int h) {
    unsigned char* ws = A->ws; const unsigned char* CHW = ws + WS_WIN; bf16_t* SC = (bf16_t*)(ws + WS_SC) + (size_t)h * NCHK * 4096;
    LAS unsigned char* L = F.lds + RING_OFF; const int wave = F.wave, lane = F.lane, tid = F.tid, r = lane & 31, hh = lane >> 5;
    const int qp = (wave >> 1) & 1, qq = wave & 1, p = 32 * qp + r; const bool calc = wave < 4;
    constexpr int L_S = 0, L_G = 2 * 9216;
    for (int i = tid; i < 2 * 9216 / 4; i += NTHR) ((LAS unsigned*)(L + L_S))[i] = 0u;
    constexpr int PD = 8;
    const int t256 = tid & 255, srow = t256 >> 3, sc16 = t256 & 7; u32x4 rb[PD][4];
    auto ring_ld = [&](int slot, int c) { const unsigned char* cw = CHW + (size_t)(h * NCHK + c) * CHW_ITEM;
#pragma unroll
        for (int g = 0; g < 4; ++g) { const unsigned char* pa = calc ? cw + 16384 + ((size_t)p * 64 + 32 * qq + 8 * g) * 2 : cw + 8192 + (srow + 32 * (g & 1)) * 128 + sc16 * 16; rb[slot][g] = *(const u32x4*)pa; } };
#pragma unroll
    for (int s0 = 0; s0 < PD - 1; ++s0) ring_ld(s0, s0);
    int sb = 0;
    for (int c0 = 0; c0 < NCHK; c0 += PD) {
#pragma unroll
        for (int s0 = 0; s0 < PD; ++s0) { const int c = c0 + s0;
            asm volatile("" :: "v"(rb[s0][0]), "v"(rb[s0][1]), "v"(rb[s0][2]), "v"(rb[s0][3]));
            const u32x4 d0 = rb[s0][0], d1 = rb[s0][1], d2 = rb[s0][2], d3 = rb[s0][3];
            if (c + PD - 1 < NCHK) ring_ld((s0 + PD - 1) % PD, c + PD - 1);
            if (!calc) {
                *(LAS u32x4*)(L + L_G + srow * CP + sc16 * 16) = d0; *(LAS u32x4*)(L + L_G + (srow + 32) * CP + sc16 * 16) = d1;
                if (c >= 1) {
#pragma unroll
                    for (int u = 0; u < 2; ++u) { const u32x4 w = *(const LAS u32x4*)(L + L_S + sb * 9216 + (srow + 32 * u) * CP + sc16 * 16); *(u32x4*)((unsigned char*)(SC + (size_t)c * 4096) + (srow + 32 * u) * 128 + sc16 * 16) = w; } } }
            WG_BAR();
            if (calc) {
                const f32x16 v = nt_quad(L + L_S + sb * 9216, L + L_G, qp, qq, r, hh); f32x16 o;
                auto zs4 = [&](const u32x4& d) { const unsigned w0 = hh ? d.z : d.x, w1 = hh ? d.w : d.y; return (f32x4){bflo(w0), bfhi(w0), bflo(w1), bfhi(w1)}; };
                const f32x4 a0 = zs4(d0), a1 = zs4(d1), a2 = zs4(d2), a3 = zs4(d3);
#pragma unroll
                for (int x = 0; x < 4; ++x) { o[x] = v[x] + a0[x]; o[4 + x] = v[4 + x] + a1[x]; o[8 + x] = v[8 + x] + a2[x]; o[12 + x] = v[12 + x] + a3[x]; }
                nt_store_bf16(L + L_S + (sb ^ 1) * 9216, p, qq, hh, o); }
            sb ^= 1;
            WG_BAR();
        }
    }
}
__device__ __forceinline__ void ph6_outputs(ArgsP A, Frame& F) {
    unsigned char* ws = A->ws; const bf16_t* Yg = (const bf16_t*)(ws + WS_Y); const unsigned char* CHW = ws + WS_WIN; const bf16_t* SC = (const bf16_t*)(ws + WS_SC);
    const bf16_t* ZR = (const bf16_t*)(ws + WS_ZR); const bf16_t* KP = (const bf16_t*)(ws + WS_KP); const bf16_t* ZV = (const bf16_t*)(ws + WS_ZV); const bf16_t* G = (const bf16_t*)(ws + WS_G); bf16_t* YA = (bf16_t*)(ws + WS_YA);
    const int wave = F.wave, lane = F.lane, r = lane & 31, hh = lane >> 5, team = wave >> 2, t256 = F.tid & 255;
    const int qp = (wave >> 1) & 1, qq = wave & 1, p = 32 * qp + r;
    LAS unsigned char* L = F.lds + RING_OFF + team * (2 * 9216); constexpr int L_Y1 = 0, L_S = 9216;
    LAS float* XS = (LAS float*)(F.lds + RING_OFF + 4 * 9216) + team * 512;
    const int srow = t256 >> 3, sc16 = t256 & 7; u32x4 ny[2], ns[2]; u32x2 nyq[4], nr[4], nk[4], nv[4], ng[4];
    const int NIT = RH * NCHK, stride = 2 * F.G;
    auto req = [&](int it) { const int h = it / NCHK, c = it % NCHK; const unsigned char* cw = CHW + (size_t)it * CHW_ITEM; const bf16_t* sc = SC + (size_t)it * 4096;
#pragma unroll
        for (int u = 0; u < 2; ++u) { ny[u] = *(const u32x4*)(cw + (srow + 32 * u) * 128 + sc16 * 16); ns[u] = *(const u32x4*)((const unsigned char*)sc + (srow + 32 * u) * 128 + sc16 * 16); }
        const size_t ro = (size_t)(c * CK + p) * RW + (size_t)h * RN + 32 * qq + 4 * hh;
#pragma unroll
        for (int g = 0; g < 4; ++g) { nyq[g] = *(const u32x2*)(Yg + ro + 8 * g); nr[g] = *(const u32x2*)(ZR + ro + 8 * g); nk[g] = *(const u32x2*)(KP + ro + 8 * g); nv[g] = *(const u32x2*)(ZV + ro + 8 * g); ng[g] = *(const u32x2*)(G + ro + 8 * g); } };
    auto up4 = [](u32x2 w) { return (f32x4){bflo(w.x), bfhi(w.x), bflo(w.y), bfhi(w.y)}; };
    if (F.vcu * 2 + team < NIT) req(F.vcu * 2 + team);
    for (int base = F.vcu * 2; base < NIT; base += stride) { const int it = base + team; const bool live = it < NIT; const int h = live ? it / NCHK : 0, c = live ? it % NCHK : 0;
#pragma unroll
        for (int u = 0; u < 2; ++u) { *(LAS u32x4*)(L + L_Y1 + (srow + 32 * u) * CP + sc16 * 16) = ny[u]; *(LAS u32x4*)(L + L_S + (srow + 32 * u) * CP + sc16 * 16) = ns[u]; }
        f32x4 yq[4], rq[4], kq[4], vq[4], gq[4];
#pragma unroll
        for (int g = 0; g < 4; ++g) { yq[g] = up4(nyq[g]); rq[g] = up4(nr[g]); kq[g] = up4(nk[g]); vq[g] = up4(nv[g]); gq[g] = up4(ng[g]); }
        if (it + stride < NIT) req(it + stride);
        const int col = h * RN + 32 * qq + 4 * hh;
        f32x4 rkp[4], lgp[4], lbp[4];
#pragma unroll
        for (int g = 0; g < 4; ++g) { rkp[g] = *(const f32x4*)(A->r_k + col + 8 * g); lgp[g] = *(const f32x4*)(A->lnx_g + col + 8 * g); lbp[g] = *(const f32x4*)(A->lnx_b + col + 8 * g); }
        WG_BAR();
        f32x4 y[4]; float s1 = 0.f, s2 = 0.f, s3 = 0.f;
        if (live) {
            f32x16 v;
            if (c != 0) v = nt_quad(L + L_Y1, L + L_S, qp, qq, r, hh);
            else {
#pragma unroll
                for (int e = 0; e < 16; ++e) v[e] = 0.f; }
#pragma unroll
            for (int g = 0; g < 4; ++g) { y[g] = (f32x4){v[4 * g] + yq[g][0], v[4 * g + 1] + yq[g][1], v[4 * g + 2] + yq[g][2], v[4 * g + 3] + yq[g][3]};
                s1 += (y[g][0] + y[g][1]) + (y[g][2] + y[g][3]); s2 += (y[g][0] * y[g][0] + y[g][1] * y[g][1]) + (y[g][2] * y[g][2] + y[g][3] * y[g][3]);
                const f32x4 t3 = rq[g] * kq[g] * rkp[g]; s3 += (t3[0] + t3[1]) + (t3[2] + t3[3]); }
            s1 += __shfl_xor(s1, 32); s2 += __shfl_xor(s2, 32); s3 += __shfl_xor(s3, 32);
            if (hh == 0) *(LAS f32x4*)(XS + ((qp * 2 + qq) * 32 + r) * 4) = (f32x4){s1, s2, s3, 0.f}; }
        WG_BAR();
        if (live) { const f32x4 o = *(const LAS f32x4*)(XS + ((qp * 2 + (qq ^ 1)) * 32 + r) * 4); s1 += o[0]; s2 += o[1]; s3 += o[2];
            const float mean = s1 * (1.0f / 64.0f), var = fmaxf(s2 * (1.0f / 64.0f) - mean * mean, 0.f), rsd = 1.0f / sqrtf(var + LNX_EPS);
            bf16_t* yp = YA + (size_t)(c * CK + p) * RW + col;
#pragma unroll
            for (int g = 0; g < 4; ++g) { const f32x4 ov = ((y[g] - mean) * rsd * lgp[g] + lbp[g] + s3 * vq[g]) * gq[g]; u32x2 w; w.x = pk2(ov[0], ov[1]); w.y = pk2(ov[2], ov[3]); *(u32x2*)(yp + 8 * g) = w; } }
        WG_BAR();
    }
}

__device__ __forceinline__ void ph5_ypost(ArgsP A, Frame& F) {
    unsigned char* ws = A->ws; const bf16_t* Y = (const bf16_t*)(ws + WS_YH); const bf16_t* ZR = (const bf16_t*)(ws + WS_ZR); const bf16_t* KP = (const bf16_t*)(ws + WS_KP); const bf16_t* ZV = (const bf16_t*)(ws + WS_ZV);
    const bf16_t* G = (const bf16_t*)(ws + WS_G); bf16_t* YA = (bf16_t*)(ws + WS_YA);
    const int gw = F.vcu * NWAVES + F.wave, NGW = F.G * NWAVES;
    const int c = F.wave * 256 + 4 * F.lane; const f32x4 rk = *(const f32x4*)(A->r_k + c), lg = *(const f32x4*)(A->lnx_g + c), lb = *(const f32x4*)(A->lnx_b + c);
    for (int tg = F.vcu; tg < T / 32; tg += F.G) for (int tq = 0; tq < 32; tq += 4) {
        f32x4 y[4]; u32x2 rr[4], kk[4], vv[4], gg[4];
#pragma unroll
        for (int u = 0; u < 4; ++u) { const size_t o = (size_t)(tg * 32 + tq + u) * RW + c; { const u32x2 yw = *(const u32x2*)(Y + o); y[u] = (f32x4){bflo(yw.x), bfhi(yw.x), bflo(yw.y), bfhi(yw.y)}; } rr[u] = *(const u32x2*)(ZR + o); kk[u] = *(const u32x2*)(KP + o); vv[u] = *(const u32x2*)(ZV + o); gg[u] = *(const u32x2*)(G + o); }
#pragma unroll
        for (int u = 0; u < 4; ++u) { const size_t o = (size_t)(tg * 32 + tq + u) * RW + c;
            const float mean = sum16((y[u][0] + y[u][1]) + (y[u][2] + y[u][3])) * (1.0f / 64.0f); const f32x4 d = y[u] - mean;
            const float var = sum16((d[0] * d[0] + d[1] * d[1]) + (d[2] * d[2] + d[3] * d[3])) * (1.0f / 64.0f); const float rs = 1.0f / sqrtf(var + LNX_EPS);
            const f32x4 r = (f32x4){bflo(rr[u].x), bfhi(rr[u].x), bflo(rr[u].y), bfhi(rr[u].y)}, k = (f32x4){bflo(kk[u].x), bfhi(kk[u].x), bflo(kk[u].y), bfhi(kk[u].y)};
            const f32x4 v = (f32x4){bflo(vv[u].x), bfhi(vv[u].x), bflo(vv[u].y), bfhi(vv[u].y)}, g = (f32x4){bflo(gg[u].x), bfhi(gg[u].x), bflo(gg[u].y), bfhi(gg[u].y)};
            const f32x4 rkk = r * k * rk; const float bonus = sum16((rkk[0] + rkk[1]) + (rkk[2] + rkk[3]));
            st4bf(YA + o, (d * rs * lg + lb + bonus * v) * g); } }
}

constexpr int AT_KB = 64 * 256, AT_VB = 128 * 128, AT_BUF = AT_KB + AT_VB;
static_assert(4 * AT_BUF <= RING_BYTES, "attention LDS");
__device__ __forceinline__ void q8_load(u32x4 (&q)[8], const void* p) {
    asm volatile("global_load_dwordx4 %0, %8, off\n\tglobal_load_dwordx4 %1, %8, off offset:32\n\tglobal_load_dwordx4 %2, %8, off offset:64\n\tglobal_load_dwordx4 %3, %8, off offset:96\n\t"
                 "global_load_dwordx4 %4, %8, off offset:128\n\tglobal_load_dwordx4 %5, %8, off offset:160\n\tglobal_load_dwordx4 %6, %8, off offset:192\n\tglobal_load_dwordx4 %7, %8, off offset:224"
                 : "=&v"(q[0]), "=&v"(q[1]), "=&v"(q[2]), "=&v"(q[3]), "=&v"(q[4]), "=&v"(q[5]), "=&v"(q[6]), "=&v"(q[7]) : "v"(p) : "memory"); }
__device__ __forceinline__ void q8_settle(u32x4 (&q)[8]) {
#pragma unroll
    for (int i = 0; i < 8; ++i) asm volatile("" : "+v"(q[i])); }
__device__ __forceinline__ unsigned u16_load(const void* p) { unsigned v; asm volatile("global_load_ushort %0, %1, off" : "=&v"(v) : "v"(p) : "memory"); return v; }
__device__ __forceinline__ int ph5_role(int vcu, int G) {
    if (G % 8 == 0 && G / 8 >= RH / 8 + 1) { const int per = G / 8, x = vcu / per, l = vcu % per, cpx = RH / 8; return l < cpx ? x * cpx + l : -(x * (per - cpx) + (l - cpx)) - 1; }
    return vcu < RH ? vcu : -(vcu - RH) - 1;
}
__device__ __forceinline__ void ph5_attn(ArgsP A, Frame& F) {
    unsigned char* ws = A->ws; const bf16_t* PROJ = (const bf16_t*)(ws + WS_PROJ); const bf16_t* VT = (const bf16_t*)(ws + WS_VT); const bf16_t* KBp = (const bf16_t*)(ws + WS_KB);
    bf16_t* PO = (bf16_t*)(ws + WS_PARTO); float* PML = (float*)(ws + WS_PARTML); const unsigned short* LST = (const unsigned short*)(ws + WS_LIST); const unsigned* UD = (const unsigned*)(ws + WS_UDESC);
    LAS unsigned char* L = F.lds + RING_OFF; const int wave = F.wave, lane = F.lane, r = lane & 31, hh = lane >> 5;
    const float NEG = -__builtin_inff();
    const int role = ph5_role(F.vcu, F.G); if (role >= 0) return;
    const int N = (int)UD[0], wi = -role - 1, nw = F.G - RH;
    const int u0 = (int)(((long long)wi * N) / nw), u1 = (int)(((long long)(wi + 1) * N) / nw);
    if (u0 >= u1) return;
    const int krow_ = lane >> 4, kslot = lane & 15, vrow_ = lane >> 3, vslot = lane & 7;
    auto dma_tile = [&](int hd, int kb_, int n, int b3) { const int tb = kb_ * MBLK + n * 64; LAS unsigned char* B = L + b3 * AT_BUF;
#pragma unroll
        for (int i = 0; i < 2; ++i) { const int p = wave * 2 + i, row = 4 * p + krow_, c = kslot ^ (row & 15);
            __builtin_amdgcn_global_load_lds((const unsigned*)(KBp + ((size_t)hd * T + tb + row) * MD + 8 * c), (LAS unsigned*)(B + p * 1024), 16, 0, 0); }
#pragma unroll
        for (int i = 0; i < 2; ++i) { const int p = wave * 2 + i, row = 8 * p + vrow_, c = vslot ^ ((row >> 1) & 7);
            __builtin_amdgcn_global_load_lds((const unsigned*)(VT + ((size_t)(hd * (T / 64) + kb_ * 4 + n) * MD + row) * 64 + 8 * c), (LAS unsigned*)(B + AT_KB + p * 1024), 16, 0, 0); } };
    int h, kblk, qtok, slot; bool typeA, valid, wvalid;
    { const unsigned d = UD[1 + 2 * u0]; const int cnt = (int)UD[2 + 2 * u0]; const int Lx = (int)(d & 0xffffu), ps = (int)((d >> 16) & 0x7fffu); typeA = (d >> 31) != 0u; h = Lx >> 5; kblk = Lx & 31;
      if (typeA) { qtok = kblk * MBLK + wave * 32 + r; slot = 3; valid = true; wvalid = true; }
      else { const int idx = ps * 256 + wave * 32 + r; valid = idx < cnt; wvalid = ps * 256 + wave * 32 < cnt; unsigned e = u16_load(LST + (size_t)Lx * 8192 + (valid ? idx : 0));
          asm volatile("s_waitcnt vmcnt(0)" ::: "memory"); asm volatile("" : "+v"(e)); qtok = (int)(e & 0x1fffu); slot = (int)(e >> 13); }
      h = __builtin_amdgcn_readfirstlane(h); kblk = __builtin_amdgcn_readfirstlane(kblk); }
    u32x4 qf[8], qfn[8];
    q8_load(qf, PROJ + (size_t)qtok * PLD + PC_MQ + h * MD + 8 * hh);
    int rh = -1, rk = -1;
    for (int u = u0; u < u1; ++u) {
        const bool has_next = u + 1 < u1;
        if (h != rh || kblk != rk) {
            WG_BAR();
#pragma unroll
            for (int n = 0; n < 4; ++n) dma_tile(h, kblk, n, n);
            rh = h; rk = kblk;
            asm volatile("s_waitcnt vmcnt(0)" ::: "memory"); if (u == u0) q8_settle(qf);
            WG_BAR(); }
        int hN = 0, kblkN = 0, qtokN = 0, slotN = 3, LxN = 0, idxN = 0, cntN = 0; bool validN = true, wvalidN = true, nA = true; unsigned entN = 0u;
        f32x16 o[4];
#pragma unroll
        for (int db = 0; db < 4; ++db)
#pragma unroll
            for (int e = 0; e < 16; ++e) o[db][e] = 0.f;
        float mrun = NEG, lrun = 0.f;
#pragma unroll
        for (int n = 0; n < 4; ++n) {
            if (has_next) {
                if (n == 0) { const unsigned d = UD[1 + 2 * (u + 1)]; cntN = (int)UD[2 + 2 * (u + 1)]; LxN = (int)(d & 0xffffu); const int ps = (int)((d >> 16) & 0x7fffu); nA = (d >> 31) != 0u; hN = LxN >> 5; kblkN = LxN & 31;
                              idxN = ps * 256 + wave * 32 + r; validN = nA || idxN < cntN; wvalidN = nA || ps * 256 + wave * 32 < cntN; }
                if (n == 1) { if (nA) { qtokN = kblkN * MBLK + wave * 32 + r; } else { entN = u16_load(LST + (size_t)LxN * 8192 + (validN ? idxN : 0)); }
                              hN = __builtin_amdgcn_readfirstlane(hN); kblkN = __builtin_amdgcn_readfirstlane(kblkN); }
                if (n == 2) { if (!nA) { asm volatile("s_waitcnt vmcnt(0)" ::: "memory"); asm volatile("" : "+v"(entN)); qtokN = (int)(entN & 0x1fffu); slotN = (int)(entN >> 13); }
                              q8_load(qfn, PROJ + (size_t)qtokN * PLD + PC_MQ + hN * MD + 8 * hh); }
            }
            const bool need = typeA ? (n <= (wave >> 1)) : wvalid;
            if (need) {
                const LAS unsigned char* KB = L + n * AT_BUF; const LAS unsigned char* VB = KB + AT_KB;
                const bool msk = typeA && 64 * n + 63 > wave * 32; const int qrel = wave * 32 + r;
                auto qk = [&](int kb) { f32x16 a;
#pragma unroll
                    for (int e = 0; e < 16; ++e) a[e] = 0.f;
#pragma unroll
                    for (int ks = 0; ks < 8; ++ks) { const bf16x8 kf = *(const LAS bf16x8*)(KB + (32 * kb + r) * 256 + (((2 * ks + hh) ^ (r & 15)) << 4)); a = __builtin_amdgcn_mfma_f32_32x32x16_bf16(kf, __builtin_bit_cast(bf16x8, qf[ks]), a, 0, 0, 0); }
                    return a; };
                auto causal = [&](f32x16& a, int kb) {
#pragma unroll
                    for (int e = 0; e < 16; ++e) { const int krel = 64 * n + 32 * kb + (e & 3) + 8 * (e >> 2) + 4 * hh; if (krel > qrel) a[e] = NEG; } };
                auto rescale = [&](float alpha) { if (__ballot(alpha != 1.0f) != 0ull) {
#pragma unroll
                        for (int db = 0; db < 4; ++db)
#pragma unroll
                            for (int e = 0; e < 16; ++e) o[db][e] *= alpha; } };
                auto rowmax = [&](const f32x16& a, float mold, float& mnew, float& alpha) {
                    float mx = fmaxf(a[0], a[1]);
#pragma unroll
                    for (int e = 2; e < 16; ++e) mx = fmaxf(mx, a[e]);
                    mx = fmaxf(mx, __shfl_xor(mx, 32)); mnew = fmaxf(mold, mx); alpha = __builtin_amdgcn_exp2f(mold - mnew); };
                f32x16 s0 = qk(0);
                if (msk) causal(s0, 0);
                float m0, al0, m1, al1, ps0 = 0.f, ps1 = 0.f; unsigned pk0[8], pk1[8];
                rowmax(s0, mrun, m0, al0);
                __builtin_amdgcn_sched_barrier(0);
                f32x16 s1;
#pragma unroll
                for (int e = 0; e < 16; ++e) s1[e] = 0.f;
                auto kfrag = [&](int ks) { return *(const LAS bf16x8*)(KB + (32 + r) * 256 + (((2 * ks + hh) ^ (r & 15)) << 4)); };
                bf16x8 kf = kfrag(0), kf1 = kfrag(1), kf2 = kf1;
#pragma unroll
                for (int ks = 0; ks < 8; ++ks) {
                    if (ks < 6) kf2 = kfrag(ks + 2);
                    s1 = __builtin_amdgcn_mfma_f32_32x32x16_bf16(kf, __builtin_bit_cast(bf16x8, qf[ks]), s1, 0, 0, 0); kf = kf1; kf1 = kf2;
                    __builtin_amdgcn_sched_barrier(0);
                    const float p0 = __builtin_amdgcn_exp2f(s0[2 * ks] - m0), p1 = __builtin_amdgcn_exp2f(s0[2 * ks + 1] - m0); ps0 += p0 + p1; pk0[ks] = pk2(p0, p1); asm volatile("" : "+v"(pk0[ks]), "+v"(ps0));
                    __builtin_amdgcn_sched_barrier(0); }
                rescale(al0);
                if (msk) causal(s1, 1);
                rowmax(s1, m0, m1, al1);
                __builtin_amdgcn_sched_barrier(0);
                auto vfrag = [&](int i) { return *(const LAS bf16x8*)(VB + (32 * (i & 3) + r) * 128 + (((2 * (i >> 2) + hh) ^ ((r >> 1) & 7)) << 4)); };
                bf16x8 vf = vfrag(0), vf1 = vfrag(1), vf2 = vf1;
#pragma unroll
                for (int i = 0; i < 8; ++i) { const int st = i >> 2, db = i & 3;
                    const bf16x8 pf = __builtin_bit_cast(bf16x8, (u32x4){pk0[4 * st], pk0[4 * st + 1], pk0[4 * st + 2], pk0[4 * st + 3]});
                    if (i < 6) vf2 = vfrag(i + 2);
                    o[db] = __builtin_amdgcn_mfma_f32_32x32x16_bf16(vf, pf, o[db], 0, 0, 0); vf = vf1; vf1 = vf2;
                    __builtin_amdgcn_sched_barrier(0);
                    const float p0 = __builtin_amdgcn_exp2f(s1[2 * i] - m1), p1 = __builtin_amdgcn_exp2f(s1[2 * i + 1] - m1); ps1 += p0 + p1; pk1[i] = pk2(p0, p1); asm volatile("" : "+v"(pk1[i]), "+v"(ps1));
                    __builtin_amdgcn_sched_barrier(0); }
                rescale(al1);
#pragma unroll
                for (int i = 0; i < 8; ++i) { const int st = i >> 2, db = i & 3;
                    const bf16x8 pf = __builtin_bit_cast(bf16x8, (u32x4){pk1[4 * st], pk1[4 * st + 1], pk1[4 * st + 2], pk1[4 * st + 3]});
                    const bf16x8 vf = *(const LAS bf16x8*)(VB + (32 * db + r) * 128 + (((4 + 2 * st + hh) ^ ((r >> 1) & 7)) << 4)); o[db] = __builtin_amdgcn_mfma_f32_32x32x16_bf16(vf, pf, o[db], 0, 0, 0); }
                lrun = (lrun * al0 + ps0) * al1 + ps1; mrun = m1;
            }
        }
        if (has_next) { asm volatile("s_waitcnt vmcnt(0)" ::: "memory"); q8_settle(qfn); }
        { const float ltot = lrun + __shfl_xor(lrun, 32);
          if (valid) { const float inv = 1.0f / ltot; const size_t pi = ((size_t)qtok * MH + h) * 4 + slot; bf16_t* op = PO + pi * MD;
#pragma unroll
            for (int db = 0; db < 4; ++db)
#pragma unroll
                for (int g = 0; g < 4; ++g) { u32x2 wv; wv.x = pk2(o[db][4 * g] * inv, o[db][4 * g + 1] * inv); wv.y = pk2(o[db][4 * g + 2] * inv, o[db][4 * g + 3] * inv); *(u32x2*)(op + 32 * db + 8 * g + 4 * hh) = wv; }
            if (hh == 0) *(f32x2*)(PML + pi * 2) = (f32x2){mrun, ltot}; } }
        if (!has_next) break;
        h = hN; kblk = kblkN; qtok = qtokN; slot = slotN; typeA = nA; valid = validN; wvalid = wvalidN;
#pragma unroll
        for (int ks = 0; ks < 8; ++ks) qf[ks] = qfn[ks];
    }
}
__device__ __forceinline__ void ph6_merge(ArgsP A, Frame& F) {
    unsigned char* ws = A->ws; const bf16_t* PO = (const bf16_t*)(ws + WS_PARTO); const float* PML = (const float*)(ws + WS_PARTML); bf16_t* YB = (bf16_t*)(ws + WS_YB);
    const int gw = F.vcu * NWAVES + F.wave, NGW = F.G * NWAVES, pair = F.lane >> 4, dg = F.lane & 15;
    for (int q0 = gw * 16; q0 < T * MH; q0 += NGW * 16) {
        u32x4 ov[4][4]; f32x2 ml[4][4];
#pragma unroll
        for (int k = 0; k < 4; ++k) { const size_t pi = (size_t)(q0 + 4 * k + pair) * 4;
#pragma unroll
            for (int sl = 0; sl < 4; ++sl) { ov[k][sl] = *(const u32x4*)(PO + (pi + sl) * MD + 8 * dg); ml[k][sl] = *(const f32x2*)(PML + (pi + sl) * 2); } }
#pragma unroll
        for (int k = 0; k < 4; ++k) { const int q = q0 + 4 * k + pair, t = q / MH, h = q % MH, blk = t >> 8, nsel = blk < 3 ? blk : 3;
            float mmax = ml[k][3][0];
#pragma unroll
            for (int sl = 0; sl < 3; ++sl) if (sl < nsel) mmax = fmaxf(mmax, ml[k][sl][0]);
            f32x4 a0 = (f32x4){0.f, 0.f, 0.f, 0.f}, a1 = a0; float wsum = 0.f;
#pragma unroll
            for (int sl = 0; sl < 4; ++sl) { if (sl == 3 || sl < nsel) { const float w = ml[k][sl][1] * __builtin_amdgcn_exp2f(ml[k][sl][0] - mmax); wsum += w; f32x4 x0, x1; pg8::unpack8(ov[k][sl], x0, x1); a0 += w * x0; a1 += w * x1; } }
            const float inv = 1.0f / wsum; *(u32x4*)(YB + (size_t)t * RW + h * MD + 8 * dg) = pg8::pack8(a0 * inv, a1 * inv); }
    }
}

__device__ __forceinline__ void ins16(float (&top)[16], float x) {
#pragma unroll
    for (int k = 15; k >= 1; --k) top[k] = __builtin_amdgcn_fmed3f(top[k - 1], top[k], x);
    top[0] = fmaxf(top[0], x);
}
__device__ __forceinline__ void ph10_select(ArgsP A, Frame& F) {
    unsigned char* ws = A->ws; const bf16_t* PQ = (const bf16_t*)(ws + WS_PQ); const bf16_t* SK = (const bf16_t*)(ws + WS_SUBK); int* IDX = (int*)(ws + WS_IDX); float* GW = (float*)(ws + WS_GW);
    const int gw = F.vcu * NWAVES + F.wave, NGW = F.G * NWAVES; const int r = F.lane & 31, hh = F.lane >> 5; const float NEG = -__builtin_inff();
    const float* RSQ = (const float*)(ws + WS_RSQ); float* RS = (float*)(ws + WS_RS);
    for (int it = gw; it < (T / 32) * PH_; it += NGW) { const int tg = it >> 3, h = it & 7, t = tg * 32 + r;
        float rst; { float ss = 0.f;
#pragma unroll
            for (int j = 0; j < 8; ++j) { const f32x4 v = *(const f32x4*)(RSQ + (size_t)t * 64 + 32 * hh + 4 * j); ss += (v[0] + v[1]) + (v[2] + v[3]); }
            ss += __shfl_xor(ss, 32); rst = 1.0f / sqrtf(ss * (1.0f / D) + NORM_EPS); if (h == 0 && hh == 0) RS[t] = rst; }
        float TA[16], TB[16];
        auto topk = [&](int p, float (&dst)[16]) {
            bf16x8 qf[8];
#pragma unroll
            for (int ks = 0; ks < 8; ++ks) qf[ks] = *(const bf16x8*)(PQ + (size_t)t * 2048 + (h * 2 + p) * PHALF + 16 * ks + 8 * hh);
            float top[16];
#pragma unroll
            for (int k = 0; k < 16; ++k) top[k] = NEG;
            bf16x8 af[8], afn[8];
            auto skload = [&](int nb, bf16x8 (&dst)[8]) {
#pragma unroll
                for (int ks = 0; ks < 8; ++ks) dst[ks] = *(const bf16x8*)(SK + ((size_t)(h * 2 + p) * PNK + 32 * nb + r) * PHALF + 16 * ks + 8 * hh); };
            skload(0, af);
#pragma unroll 1
            for (int nb = 0; nb < 4; ++nb) { f32x16 acc;
#pragma unroll
                for (int e = 0; e < 16; ++e) acc[e] = 0.f;
                if (nb < 3) skload(nb + 1, afn);
#pragma unroll
                for (int ks = 0; ks < 8; ++ks) acc = __builtin_amdgcn_mfma_f32_32x32x16_bf16(af[ks], qf[ks], acc, 0, 0, 0);
#pragma unroll
                for (int ks = 0; ks < 8; ++ks) af[ks] = afn[ks];
#pragma unroll
                for (int e = 0; e < 16; ++e) { const unsigned key = 32 * nb + (e & 3) + 8 * (e >> 2) + 4 * hh; float ae = acc[e]; asm volatile("" : "+v"(ae));
                    const float x = __builtin_bit_cast(float, (__builtin_bit_cast(unsigned, ae) & ~0x7Fu) | key); ins16(top, x); } }
            float oth[16];
#pragma unroll
            for (int k = 0; k < 16; ++k) oth[k] = __shfl_xor(top[k], 32);
#pragma unroll
            for (int k = 0; k < 16; ++k) ins16(top, oth[k]);
#pragma unroll
            for (int k = 0; k < 16; ++k) dst[k] = top[k];
        };
        topk(0, TA); asm volatile("" ::: "memory"); __builtin_amdgcn_sched_barrier(0); topk(1, TB); asm volatile("" ::: "memory"); __builtin_amdgcn_sched_barrier(0);
        float fin[16];
#pragma unroll
        for (int k = 0; k < 16; ++k) fin[k] = NEG;
#pragma unroll
        for (int i = 0; i < 16; ++i)
#pragma unroll
            for (int j = 0; j < 16; ++j) if ((i + 1) * (j + 1) <= 16) { const float sm = TA[i] + TB[j]; ins16(fin, __builtin_bit_cast(float, (__builtin_bit_cast(unsigned, sm) & ~0xFFu) | (unsigned)(i * 16 + j))); }
        float e[16], den = 0.f;
#pragma unroll
        for (int k = 0; k < 16; ++k) { e[k] = __expf((fin[k] - fin[0]) * rst); den += e[k]; }
        const float rden = 1.0f / den;
        int oi[8]; float og[8];
#pragma unroll
        for (int kk = 0; kk < 8; ++kk) { const float fv = hh ? fin[8 + kk] : fin[kk]; og[kk] = (hh ? e[8 + kk] : e[kk]) * rden; const unsigned id = __builtin_bit_cast(unsigned, fv) & 0xFFu; const unsigned ci = id >> 4, cj = id & 15u;
            unsigned ia = 0u, ib = 0u;
#pragma unroll
            for (int q = 0; q < 16; ++q) { ia = (ci == (unsigned)q) ? (__builtin_bit_cast(unsigned, TA[q]) & 0x7Fu) : ia; ib = (cj == (unsigned)q) ? (__builtin_bit_cast(unsigned, TB[q]) & 0x7Fu) : ib; }
            oi[kk] = (int)(ia * PNK + ib); }
        int* ip = IDX + (size_t)t * 128 + h * 16 + 8 * hh; float* gp = GW + (size_t)t * 128 + h * 16 + 8 * hh;
        *(u32x4*)ip = (u32x4){(unsigned)oi[0], (unsigned)oi[1], (unsigned)oi[2], (unsigned)oi[3]}; *(u32x4*)(ip + 4) = (u32x4){(unsigned)oi[4], (unsigned)oi[5], (unsigned)oi[6], (unsigned)oi[7]};
        *(f32x4*)gp = (f32x4){og[0], og[1], og[2], og[3]}; *(f32x4*)(gp + 4) = (f32x4){og[4], og[5], og[6], og[7]};
    }
}


__device__ __forceinline__ float ub0(unsigned w) { return (float)(w & 0xffu); }
__device__ __forceinline__ float ub1(unsigned w) { return (float)((w >> 8) & 0xffu); }
__device__ __forceinline__ float ub2(unsigned w) { return (float)((w >> 16) & 0xffu); }
__device__ __forceinline__ float ub3(unsigned w) { return (float)(w >> 24); }
__device__ __forceinline__ float dot16q(u32x4 q, const float (&h)[16]) {
    return ((ub0(q.x) * h[0] + ub1(q.x) * h[1]) + (ub2(q.x) * h[2] + ub3(q.x) * h[3])) + ((ub0(q.y) * h[4] + ub1(q.y) * h[5]) + (ub2(q.y) * h[6] + ub3(q.y) * h[7]))
         + ((ub0(q.z) * h[8] + ub1(q.z) * h[9]) + (ub2(q.z) * h[10] + ub3(q.z) * h[11])) + ((ub0(q.w) * h[12] + ub1(q.w) * h[13]) + (ub2(q.w) * h[14] + ub3(q.w) * h[15]));
}
__device__ __forceinline__ void ph11_gather(ArgsP A, Frame& F) {
    unsigned char* ws = A->ws; const bf16_t* X1 = (const bf16_t*)(ws + WS_X1); const float* RS = (const float*)(ws + WS_RS); const unsigned char* PU = (const unsigned char*)(ws + WS_PU); const unsigned char* PV = (const unsigned char*)(ws + WS_PV);
    const float* PSU = (const float*)(ws + WS_PSU); const float* PSV = (const float*)(ws + WS_PSV);
    const int* IDX = (const int*)(ws + WS_IDX); const float* GW = (const float*)(ws + WS_GW);
    LAS float* coef = (LAS float*)(F.lds + RING_OFF); LAS int* eidx = (LAS int*)(F.lds + RING_OFF + 1024); LAS float* red = (LAS float*)(F.lds + RING_OFF + 2048);
    const int tid = F.tid, wave = F.wave, lane = F.lane; int par = 0;
    const f32x4 fg0 = *(const f32x4*)(A->final_g + tid * 8), fg1 = *(const f32x4*)(A->final_g + tid * 8 + 4);
    int nidx = 0; float ng = 0.f;
    if (F.vcu * 32 < T && lane < 16) { nidx = IDX[(size_t)(F.vcu * 32) * 128 + wave * 16 + lane]; ng = GW[(size_t)(F.vcu * 32) * 128 + wave * 16 + lane]; }
    for (int tgk = F.vcu * 32; tgk < T; tgk = ((tgk & 31) == 31) ? tgk + (F.G - 1) * 32 + 1 : tgk + 1, par ^= 1) { const int t = tgk; const int tnx = ((tgk & 31) == 31) ? tgk + (F.G - 1) * 32 + 1 : tgk + 1;
        float hv[4][16]; float hs = 0.f;
        const float rs2 = RS[t];
#pragma unroll
        for (int i = 0; i < 4; ++i) { const bf16_t* hp = X1 + (size_t)t * D + i * 1024 + lane * 16; f32x4 a, b, c, d; pg8::unpack8(*(const u32x4*)hp, a, b); pg8::unpack8(*(const u32x4*)(hp + 8), c, d);
            { const f32x4* gp = (const f32x4*)(A->norm2_g + i * 1024 + lane * 16); a = a * gp[0]; b = b * gp[1]; c = c * gp[2]; d = d * gp[3]; }
#pragma unroll
            for (int e = 0; e < 4; ++e) { hv[i][e] = a[e]; hv[i][4 + e] = b[e]; hv[i][8 + e] = c[e]; hv[i][12 + e] = d[e]; }
            hs += ((a[0] + a[1]) + (a[2] + a[3])) + ((b[0] + b[1]) + (b[2] + b[3])) + ((c[0] + c[1]) + (c[2] + c[3])) + ((d[0] + d[1]) + (d[2] + d[3])); }
        hs = wave_sum(hs);
        const int myidx = nidx; const float myg = ng;
        float psu = 0.f, psv = 0.f; if (lane < 16) { psu = PSU[myidx]; psv = PSV[myidx]; }
        float dots = 0.f;
        u32x4 q[4][4];
        auto urow = [&](int kx, u32x4 (&dst)[4]) { const int e = __builtin_amdgcn_readlane(myidx, kx); const unsigned char* up = PU + (size_t)e * D + lane * 16;
#pragma unroll
            for (int i = 0; i < 4; ++i) dst[i] = *(const u32x4*)(up + i * 1024); };
#pragma unroll
        for (int x = 0; x < 4; ++x) urow(x, q[x]);
        float dp[16];
#pragma unroll
        for (int k = 0; k < 16; k += 4) {
#pragma unroll
            for (int x = 0; x < 4; ++x) { float d = 0.f;
#pragma unroll
                for (int i = 0; i < 4; ++i) d += dot16q(q[x][i], hv[i]);
                if (k + 4 < 16) urow(k + 4 + x, q[x]);
                dp[k + x] = d; }
        }
        {
            const bool b5 = lane & 32, b4 = lane & 16, b3 = lane & 8, b2 = lane & 4; float r8[8], r4[4], r2[2];
#pragma unroll
            for (int i = 0; i < 8; ++i) { const float keep = b5 ? dp[i + 8] : dp[i], send = b5 ? dp[i] : dp[i + 8]; r8[i] = keep + __shfl_xor(send, 32); }
#pragma unroll
            for (int i = 0; i < 4; ++i) { const float keep = b4 ? r8[i + 4] : r8[i], send = b4 ? r8[i] : r8[i + 4]; r4[i] = keep + __shfl_xor(send, 16); }
#pragma unroll
            for (int i = 0; i < 2; ++i) { const float keep = b3 ? r4[i + 2] : r4[i], send = b3 ? r4[i] : r4[i + 2]; r2[i] = keep + __shfl_xor(send, 8); }
            float r1 = (b2 ? r2[1] : r2[0]) + __shfl_xor(b2 ? r2[0] : r2[1], 4);
            r1 += __shfl_xor(r1, 2); r1 += __shfl_xor(r1, 1);
            const int src = ((lane & 8) << 2) | ((lane & 4) << 2) | ((lane & 2) << 2) | ((lane & 1) << 2);
            dots = __builtin_bit_cast(float, __builtin_amdgcn_ds_bpermute(src << 2, __builtin_bit_cast(int, r1))); }
        { float cv = 0.f;
          if (lane < 16) { const float s = psu * rs2 * (dots - 128.0f * hs); const float act = 0.5f * s * (1.0f + erff(s * 0.70710678118654752f));
              cv = myg * act * psv; coef[par * 128 + wave * 16 + lane] = cv; eidx[par * 128 + wave * 16 + lane] = myidx; }
          cv = wave_sum(cv); if (lane == 0) red[16 + par * 8 + wave] = cv; }
        WG_BAR();
        if (tnx < T && lane < 16) { nidx = IDX[(size_t)tnx * 128 + wave * 16 + lane]; ng = GW[(size_t)tnx * 128 + wave * 16 + lane]; }
        const u32x4 xres = *(const u32x4*)(X1 + (size_t)t * D + tid * 8);
        float acc[8]; float csum = 0.f;
#pragma unroll
        for (int w = 0; w < 8; ++w) csum += red[16 + par * 8 + w];
#pragma unroll
        for (int i = 0; i < 8; ++i) acc[i] = 0.f;
        u32x2 v[16];
        auto vrow = [&](int ei_) { const int ei = __builtin_amdgcn_readfirstlane(eidx[par * 128 + ei_]); return *(const u32x2*)(PV + (size_t)ei * D + tid * 8); };
#pragma unroll
        for (int q = 0; q < 16; ++q) v[q] = vrow(q);
#pragma unroll
        for (int e = 0; e < 128; e += 16) { float c[16];
#pragma unroll
            for (int q = 0; q < 16; ++q) c[q] = coef[par * 128 + e + q];
#pragma unroll
            for (int q = 0; q < 16; ++q) { const u32x2 vq = v[q]; if (e + 16 < 128) v[q] = vrow(e + 16 + q); acc[0] += c[q] * ub0(vq.x); acc[1] += c[q] * ub1(vq.x); acc[2] += c[q] * ub2(vq.x); acc[3] += c[q] * ub3(vq.x); acc[4] += c[q] * ub0(vq.y); acc[5] += c[q] * ub1(vq.y); acc[6] += c[q] * ub2(vq.y); acc[7] += c[q] * ub3(vq.y); } }
        const float corr = -128.0f * csum;
        f32x4 x0, x1; pg8::unpack8(xres, x0, x1);
        f32x4 y0 = x0 + ((f32x4){acc[0], acc[1], acc[2], acc[3]} + corr), y1 = x1 + ((f32x4){acc[4], acc[5], acc[6], acc[7]} + corr);
        float ss = (y0[0] * y0[0] + y0[1] * y0[1]) + (y0[2] * y0[2] + y0[3] * y0[3]) + (y1[0] * y1[0] + y1[1] * y1[1]) + (y1[2] * y1[2] + y1[3] * y1[3]);
        ss = wave_sum(ss); if (lane == 0) red[par * 8 + wave] = ss;
        WG_BAR();
        float tot = 0.f;
#pragma unroll
        for (int w = 0; w < 8; ++w) tot += red[par * 8 + w];
        const float rs = 1.0f / sqrtf(tot * (1.0f / D) + NORM_EPS);
        *(f32x4*)(A->out + (size_t)t * D + tid * 8) = y0 * rs * fg0; *(f32x4*)(A->out + (size_t)t * D + tid * 8 + 4) = y1 * rs * fg1;
    }
}

constexpr int NPH = 13;
__device__ __forceinline__ Frame make_frame(unsigned char* lds) {
    Frame F; int t = threadIdx.x; asm volatile("" : "+v"(t));
    F.lds = (LAS unsigned char*)lds; F.tid = t; F.lane = t & 63; F.wave = __builtin_amdgcn_readfirstlane(t >> 6);
    F.G = gridDim.x; { const int bx = blockIdx.x; F.vcu = (F.G % 8 == 0) ? (bx % 8) * (F.G / 8) + bx / 8 : bx; }
    return F;
}
__global__ void __launch_bounds__(NTHR, 2) mk_fwd(Args args_by_value) {
    extern __shared__ __attribute__((aligned(16))) unsigned char lds[];
    ArgsP args = get_args();
    gu32* ctl = (gu32*)(args->ws + WS_CTL);
    for (int u = threadIdx.x; u < (LDS_BYTES - LDSCTL_OFF) / 4; u += NTHR) ((LAS unsigned*)((LAS unsigned char*)lds + LDSCTL_OFF))[u] = 0u;
    __syncthreads();
    const int lo = args->ph_lo, hi = args->ph_hi;
    volatile LAS unsigned* MISC = (volatile LAS unsigned*)((LAS unsigned char*)lds + MISC_OFF);
    XcdBarrier bar; bar.bar = (unsigned*)(ctl + CW_BAR) + args->li * XCD_BAR_WORDS; bar.x = 0; bar.st = nullptr;
    if (hi - lo > 1) bar = xcd_barrier_post((unsigned*)(ctl + CW_BAR) + args->li * XCD_BAR_WORDS, MISC + 8);
#define IN(k) (lo <= (k) && (k) < hi)
#define SEAM(k) do { if (IN(k) && IN((k) + 1)) xcd_barrier(bar); } while (0)
    const int bid = (int)blockIdx.x;

    if (IN(0)) { Frame F = make_frame(lds); ph0_prologue(get_args(), F); SEAM(0); }
    if (IN(1)) { Frame F = make_frame(lds); LAS unsigned char* ring = F.lds + RING_OFF; ArgsP a_ = get_args(); unsigned char* ws = a_->ws;
        { pg8::Gemm g{(const bf16_t*)(ws + WS_XN), (const bf16_t*)(ws + WS_WIN), T, PLD, D}; pg8::StaticOrder S; S.init(T, PLD, F.G, bid);
          pg8::EpiProj E{(bf16_t*)(ws + WS_PROJ), (const float*)(ws + WS_ROPE), (bf16_t*)(ws + WS_KB)}; pg8::gemm_phase<pg8::EpiProj, pg8::StaticOrder, true, true>(ring, g, S, E); }
        { pg8::Gemm g{(const bf16_t*)(ws + WS_XN), (const bf16_t*)(ws + WS_WIN) + (size_t)PC_MV * D, T, 2048, D}; pg8::StaticOrder S; S.init(T, 2048, F.G, bid);
          pg8::EpiVT E{(bf16_t*)(ws + WS_VT)}; pg8::gemm_phase<pg8::EpiVT, pg8::StaticOrder, true, true>(ring, g, S, E); }
        { constexpr int NT1 = (T / 256) * (PLD / 256); const int nx = NT1 % F.G;
          if (bid >= nx) { WG_BAR(); { Frame F2 = make_frame(lds); late_weights(get_args(), F2, (bid - nx) * NWAVES + F2.wave, (F2.G - nx) * NWAVES); }
              if (nx) { Frame F2 = make_frame(lds); peer_quant(get_args(), F2, 0, pq_ra(F2.G), (bid - nx) * NWAVES + F2.wave, (F2.G - nx) * NWAVES); } } }
        SEAM(1); }
    if (IN(2)) { Frame F = make_frame(lds); ph2_prep(get_args(), F); SEAM(2); }
    if (IN(3)) { Frame F = make_frame(lds); LAS unsigned char* ring = F.lds + RING_OFF; ArgsP a_ = get_args(); unsigned char* ws = a_->ws;
        { pg8::Gemm g{(const bf16_t*)(ws + WS_AW), (const bf16_t*)(ws + WS_WUP), T, RW, LW}; pg8::StaticOrder S; S.init(T, RW, F.G, bid);
          pg8::EpiDec E{(float*)(ws + WS_DEC), a_->w0}; pg8::gemm_phase<pg8::EpiDec, pg8::StaticOrder, true, true>(ring, g, S, E); }
        asm volatile("" ::: "memory"); __builtin_amdgcn_sched_barrier(0);
        { pg8::Gemm g{(const bf16_t*)(ws + WS_AA), (const bf16_t*)(ws + WS_AUP), T, RW, LA}; pg8::StaticOrder S; S.init(T, RW, F.G, bid);
          pg8::EpiA E{(bf16_t*)(ws + WS_KP), (bf16_t*)(ws + WS_BB), (const bf16_t*)(ws + WS_KKN), a_->a0, a_->k_a}; pg8::gemm_phase<pg8::EpiA, pg8::StaticOrder, true, true>(ring, g, S, E); }
        asm volatile("" ::: "memory"); __builtin_amdgcn_sched_barrier(0);
        { pg8::Gemm g{(const bf16_t*)(ws + WS_AG), (const bf16_t*)(ws + WS_GUP), T, RW, LGP}; pg8::StaticOrder S; S.init(T, RW, F.G, bid);
          pg8::EpiBf16 E{(bf16_t*)(ws + WS_G), RW}; pg8::gemm_phase<pg8::EpiBf16, pg8::StaticOrder, true, true>(ring, g, S, E); }
        { Frame F2 = make_frame(lds); ph3_gate(get_args(), F2); }
        SEAM(3); }
    if (IN(4)) { Frame F = make_frame(lds); ph4_chunkprep(get_args(), F); SEAM(4); }
    if (IN(5)) {
        { Frame F = make_frame(lds); const int role = ph5_role(F.vcu, F.G); if (role >= 0) ph5_chain(get_args(), F, role); }
        { Frame F = make_frame(lds); ph5_attn(get_args(), F); }
        { Frame F = make_frame(lds); const int role = ph5_role(F.vcu, F.G); if (role < 0) peer_quant(get_args(), F, pq_ra(F.G), 2 * 16384, (-role - 1) * NWAVES + F.wave, (F.G - RH) * NWAVES); }
        SEAM(5); }
    if (IN(6)) { { Frame F = make_frame(lds); ph6_outputs(get_args(), F); } { Frame F = make_frame(lds); ph6_merge(get_args(), F); } SEAM(6); }
    if (IN(8)) { Frame F = make_frame(lds); LAS unsigned char* ring = F.lds + RING_OFF; ArgsP a_ = get_args(); unsigned char* ws = a_->ws;
        { pg8::Gemm g{(const bf16_t*)(ws + WS_YA), (const bf16_t*)(ws + WS_WA), T, D, RW}; pg8::StaticOrder S; S.init(T, D, F.G, bid);
          pg8::EpiMix<false> E{(bf16_t*)(ws + WS_MIXED), (const bf16_t*)(ws + WS_PROJ), PC_GA}; pg8::gemm_phase<pg8::EpiMix<false>, pg8::StaticOrder, true, true>(ring, g, S, E); }
        { pg8::Gemm g{(const bf16_t*)(ws + WS_YB), (const bf16_t*)(ws + WS_WB), T, D, RW}; pg8::StaticOrder S; S.init(T, D, F.G, bid);
          pg8::EpiMix<true> E{(bf16_t*)(ws + WS_MIXED), (const bf16_t*)(ws + WS_PROJ), PC_GB}; pg8::gemm_phase<pg8::EpiMix<true>, pg8::StaticOrder, true, true>(ring, g, S, E); }
        SEAM(8); }
    if (IN(9)) { Frame F = make_frame(lds); LAS unsigned char* ring = F.lds + RING_OFF; ArgsP a_ = get_args(); unsigned char* ws = a_->ws;
        pg8::Gemm g{(const bf16_t*)(ws + WS_MIXED), (const bf16_t*)(ws + WS_WOUT), T, D, D}; pg8::StaticOrder S; S.init(T, D, F.G, bid);
        pg8::EpiRes E{(bf16_t*)(ws + WS_X1), a_->x, (float*)(ws + WS_RSQ)}; pg8::gemm_phase<pg8::EpiRes, pg8::StaticOrder, true, true>(ring, g, S, E);
        SEAM(9); }
    if (IN(10)) { Frame F = make_frame(lds); LAS unsigned char* ring = F.lds + RING_OFF; ArgsP a_ = get_args(); unsigned char* ws = a_->ws;
        pg8::Gemm g{(const bf16_t*)(ws + WS_X1), (const bf16_t*)(ws + WS_WQ), T, 2048, D}; pg8::StaticOrder S; S.init(T, 2048, F.G, bid);
        pg8::EpiBf16 E{(bf16_t*)(ws + WS_PQ), 2048}; pg8::gemm_phase<pg8::EpiBf16, pg8::StaticOrder, true, true>(ring, g, S, E);
        SEAM(10); }
    if (IN(11)) { Frame F = make_frame(lds); ph10_select(get_args(), F);
        if (IN(12)) { __builtin_amdgcn_fence(__ATOMIC_RELEASE, "workgroup"); WG_BAR(); __builtin_amdgcn_fence(__ATOMIC_ACQUIRE, "workgroup"); } }
    if (IN(12)) { Frame F = make_frame(lds); ph11_gather(get_args(), F); }
#undef IN
#undef SEAM
}

extern "C" void kernel_launch(void* const* d_in, const int* in_sizes, int n_in, void* d_out, int out_size, void* d_ws, size_t ws_size, hipStream_t stream) {
    static int grid = 0;
    if (grid == 0) {
        if (n_in != 23 || out_size != T * D || ws_size < WS_END) { fprintf(stderr, "kernel_launch: unexpected shapes (n_in %d out %d ws %zu); nothing launched\n", n_in, out_size, ws_size); grid = -1; return; }
        int dev = 0, cus = 0, per_cu = 0;
        if (hipGetDevice(&dev) != hipSuccess || hipDeviceGetAttribute(&cus, hipDeviceAttributeMultiprocessorCount, dev) != hipSuccess) { grid = -1; return; }
        if (hipFuncSetAttribute((const void*)mk_fwd, hipFuncAttributeMaxDynamicSharedMemorySize, LDS_BYTES) != hipSuccess) { grid = -1; return; }
        if (hipOccupancyMaxActiveBlocksPerMultiprocessor(&per_cu, (const void*)mk_fwd, NTHR, LDS_BYTES) != hipSuccess || per_cu < 1) fprintf(stderr, "kernel_launch: occupancy query reports %d\n", per_cu);
        (void)hipGetLastError();
        grid = cus;
    }
    if (grid < 0) return;
    (void)hipMemsetAsync((char*)d_ws + WS_CTL, 0, CTL_ZERO_BYTES, stream);
    Args a{};
    const float** ap = (const float**)&a;
    for (int i = 0; i < 23; ++i) ap[i] = (const float*)d_in[i];
    a.out = (float*)d_out; a.ws = (unsigned char*)d_ws; a.pad = 0;
    constexpr int NL = MK_N_LAUNCHES;
    for (int li = 0; li < NL; ++li) {
        a.ph_lo = (NL == 1) ? 0 : li; a.ph_hi = (NL == 1) ? NPH : li + 1; a.li = (NL == 1) ? 0 : 0;
        hipLaunchKernelGGL(mk_fwd, dim3(grid), dim3(NTHR), LDS_BYTES, stream, a);
#ifdef DUP_HI
        if (NL > 1 && li == DUP_HI) for (int l2 = DUP_LO; l2 <= DUP_HI; ++l2) { a.ph_lo = l2; a.ph_hi = l2 + 1; hipLaunchKernelGGL(mk_fwd, dim3(grid), dim3(NTHR), LDS_BYTES, stream, a); }
#endif
    }
}
```
